# Optimizing an MI355X kernel written in HIP

```python
import math
import jax, jax.numpy as jnp
from jax import lax
import numpy as np

D_MODEL = 1024
BATCH = 2
SEQ = 8192
DEPTH = 2
DEC_BATCH = 128
DEC_SEQ = 4
PAST_LEN = 2048
PAGE_SIZE = 128

MIX_W = D_MODEL
ML_W = MIX_W // 2
ML_HEADS = 4
ML_HD = ML_W // ML_HEADS
ML_CHUNK = 64
NSA_W = MIX_W - ML_W
NSA_HEADS = 8
NSA_HD = NSA_W // NSA_HEADS
KV_HEADS = 2
Q_PER_KV = NSA_HEADS // KV_HEADS
KV_W = KV_HEADS * NSA_HD
CMP_BLOCK = 32
CMP_STRIDE = 16
CMP_HIDDEN = 256
SEL_BLOCK = 64
N_SELECT = 16
WINDOW = 512
Q_BLOCK = 128
NUM_BUCKETS = 32
REL_MAX_DIST = 128
D_FF = 4 * D_MODEL
ALPHA = (2 * DEPTH) ** 0.25
BETA = (8 * DEPTH) ** -0.25
LN_EPS = 1e-5
NEG = -1e30
FORCE = 1e9
IN_SIZES = (ML_W, ML_W, ML_W, ML_W, ML_HEADS, ML_HEADS, NSA_W, KV_W, KV_W, KV_W, KV_W, KV_W, KV_W, 3 * NSA_HEADS)
N_IN = sum(IN_SIZES)

kernel_name = 'hymba_mlstm_nsa_deepnorm_step'


def layer_norm(x, g, b):
    xf = x.astype(jnp.float32)
    mu = xf.mean(-1, keepdims=True)
    var = jnp.square(xf - mu).mean(-1, keepdims=True)
    return ((xf - mu) * lax.rsqrt(var + LN_EPS) * g + b).astype(x.dtype)


def head_norm(h, g):
    mu = h.mean(-1, keepdims=True)
    var = jnp.square(h - mu).mean(-1, keepdims=True)
    return (h - mu) * lax.rsqrt(var + LN_EPS) * g.reshape(ML_HEADS, ML_HD).astype(jnp.float32)


def rel_bucket(dist):
    n = jnp.maximum(dist, 0)
    max_exact = NUM_BUCKETS // 2
    nf = jnp.maximum(n, 1).astype(jnp.float32)
    large = max_exact + (jnp.log(nf / max_exact) / math.log(REL_MAX_DIST / max_exact)
                         * (NUM_BUCKETS - max_exact)).astype(jnp.int32)
    large = jnp.minimum(large, NUM_BUCKETS - 1)
    return jnp.where(n < max_exact, n, large)


def masked_softmax(s, mask):
    return jax.nn.softmax(jnp.where(mask, s, NEG), axis=-1) * mask


def mlstm_chunk(carry, inputs):
    C, n, m0 = carry
    q, k, v, ig, lf = inputs
    T = q.shape[1]
    F = jnp.cumsum(lf, axis=1)
    m = F + jnp.maximum(m0[:, None], lax.cummax(ig - F, axis=1))
    causal = (jnp.arange(T)[:, None] >= jnp.arange(T)[None, :])[None, :, :, None]
    log_d = F[:, :, None] - F[:, None, :] + ig[:, None, :] - m[:, :, None]
    dmat = jnp.exp(jnp.where(causal, log_d, NEG))
    w = jnp.einsum('bthd,bshd->btsh', q, k) * dmat
    decay = jnp.exp(F + m0[:, None] - m)
    num = jnp.einsum('btsh,bshd->bthd', w, v) + jnp.einsum('bthk,bhkv->bthv', q, C) * decay[..., None]
    den = w.sum(axis=2) + jnp.einsum('bthk,bhk->bth', q, n) * decay
    h = num / jnp.maximum(jnp.abs(den), jnp.exp(-m))[..., None]
    m_end = m[:, -1]
    f_end = F[:, -1]
    w_end = jnp.exp(f_end[:, None] - F + ig - m_end[:, None])
    carry_decay = jnp.exp(f_end + m0 - m_end)
    C_new = carry_decay[..., None, None] * C + jnp.einsum('bth,bthk,bthv->bhkv', w_end, k, v)
    n_new = carry_decay[..., None] * n + jnp.einsum('bth,bthk->bhk', w_end, k)
    return (C_new, n_new, m_end), h


def mlstm_prompt(q, k, v, ig, lf):
    B, S = q.shape[0], q.shape[1]
    nc = S // ML_CHUNK
    chunks = tuple(a.reshape(B, nc, ML_CHUNK, *a.shape[2:]).swapaxes(0, 1) for a in (q, k, v, ig, lf))
    carry0 = (jnp.zeros((B, ML_HEADS, ML_HD, ML_HD), jnp.float32),
              jnp.zeros((B, ML_HEADS, ML_HD), jnp.float32),
              jnp.zeros((B, ML_HEADS), jnp.float32))
    carry, h = lax.scan(mlstm_chunk, carry0, chunks)
    return h.swapaxes(0, 1).reshape(B, S, ML_HEADS, ML_HD), carry


def mlstm_sample(q, k, v, ig, lf, C, n, m):
    carry = (C.astype(jnp.float32), n.astype(jnp.float32), m.astype(jnp.float32))
    carry, h = mlstm_chunk(carry, (q, k, v, ig, lf))
    return h, carry


def compress_kv(kv, pe, w1, w2):
    L = kv.shape[1]
    n_cmp = (L - CMP_BLOCK) // CMP_STRIDE + 1
    idx = (jnp.arange(n_cmp) * CMP_STRIDE)[:, None] + jnp.arange(CMP_BLOCK)[None, :]
    blocks = kv[:, idx] + pe.transpose(1, 0, 2)[:, :, None, :]
    w1r = w1.reshape(2, CMP_BLOCK, NSA_HD, CMP_HIDDEN)
    hid = jax.nn.gelu(jnp.einsum('bncsgd,scdh->bnsgh', blocks, w1r))
    return jnp.einsum('bnsgh,shd->bnsgd', hid, w2)


def nsa_attend(q, qpos, kc, vc, ks, vs, kw, vw, wpos, gates, rel_bias):
    B, T = q.shape[0], q.shape[1]
    scale = NSA_HD ** -0.5
    tbl = rel_bias.reshape(NUM_BUCKETS, KV_HEADS, Q_PER_KV)
    n_cmp = kc.shape[1]
    c_start = jnp.arange(n_cmp) * CMP_STRIDE
    dist_c = qpos[:, None] - (c_start + CMP_BLOCK - 1)[None, :]
    bias_c = tbl[rel_bucket(dist_c)].transpose(0, 2, 3, 1)[None]
    s_c = jnp.einsum('btgrd,bngd->btgrn', q, kc).astype(jnp.float32) * scale + bias_c
    p_c = masked_softmax(s_c, (dist_c >= 0)[None, :, None, None, :])
    o_c = jnp.einsum('btgrn,bngd->btgrd', p_c.astype(vc.dtype), vc)
    n_sel = ks.shape[1] // SEL_BLOCK
    s_start = jnp.arange(n_sel) * SEL_BLOCK
    cover = ((c_start[:, None] < s_start[None, :] + SEL_BLOCK)
             & (c_start[:, None] + CMP_BLOCK > s_start[None, :])).astype(jnp.float32)
    imp = jnp.einsum('btgrn,nj->btgj', p_c, cover)
    cur = qpos // SEL_BLOCK
    jb = jnp.arange(n_sel)
    forced = (jb[None] == 0) | (jb[None] == cur[:, None]) | (jb[None] == cur[:, None] - 1)
    future = s_start[None, :] > qpos[:, None]
    score = jnp.where(forced[None, :, None, :], FORCE, jnp.where(future[None, :, None, :], -FORCE, imp))
    n_top = min(N_SELECT, n_sel)
    _, top = lax.top_k(score, n_top)
    pos = (top[..., None] * SEL_BLOCK + jnp.arange(SEL_BLOCK)).reshape(B, T, KV_HEADS, n_top * SEL_BLOCK)
    bi = jnp.arange(B)[:, None, None, None]
    gi = jnp.arange(KV_HEADS)[None, None, :, None]
    k_sel = ks[bi, pos, gi]
    v_sel = vs[bi, pos, gi]
    dist_s = qpos[None, :, None, None] - pos
    bias_s = tbl.transpose(1, 0, 2)[gi, rel_bucket(dist_s)]
    s_s = jnp.einsum('btgrd,btgkd->btgrk', q, k_sel).astype(jnp.float32) * scale + jnp.swapaxes(bias_s, -1, -2)
    p_s = masked_softmax(s_s, (dist_s >= 0)[:, :, :, None, :])
    o_s = jnp.einsum('btgrk,btgkd->btgrd', p_s.astype(v_sel.dtype), v_sel)
    dist_w = qpos[:, None] - wpos[None, :]
    valid_w = ((dist_w >= 0) & (dist_w < WINDOW) & (wpos[None, :] >= 0))[None, :, None, None, :]
    bias_w = tbl[rel_bucket(dist_w)].transpose(0, 2, 3, 1)[None]
    s_w = jnp.einsum('btgrd,bwgd->btgrw', q, kw).astype(jnp.float32) * scale + bias_w
    p_w = masked_softmax(s_w, valid_w)
    o_w = jnp.einsum('btgrw,bwgd->btgrd', p_w.astype(vw.dtype), vw)
    return gates[..., 0:1] * o_c + gates[..., 1:2] * o_s + gates[..., 2:3] * o_w


def nsa_prompt(q, kv_c, kv_s, kv_w, gates, pe, w1, w2, rel_bias):
    B, S = q.shape[0], q.shape[1]
    ckv = compress_kv(kv_c, pe, w1, w2)
    kwp = jnp.pad(kv_w, ((0, 0), (WINDOW, 0), (0, 0), (0, 0), (0, 0)))

    def query_block(blk):
        t0 = blk * Q_BLOCK
        qpos = t0 + jnp.arange(Q_BLOCK)
        kw = lax.dynamic_slice_in_dim(kwp, t0, WINDOW + Q_BLOCK, axis=1)
        wpos = t0 - WINDOW + jnp.arange(WINDOW + Q_BLOCK)
        return nsa_attend(lax.dynamic_slice_in_dim(q, t0, Q_BLOCK, axis=1), qpos,
                          ckv[:, :, 0], ckv[:, :, 1], kv_s[:, :, 0], kv_s[:, :, 1],
                          kw[:, :, 0], kw[:, :, 1], wpos,
                          lax.dynamic_slice_in_dim(gates, t0, Q_BLOCK, axis=1), rel_bias)

    o = lax.map(query_block, jnp.arange(S // Q_BLOCK))
    o = jnp.moveaxis(o, 0, 1).reshape(B, S, KV_HEADS, Q_PER_KV, NSA_HD)
    win = min(WINDOW, S)
    return o, (kv_c, kv_s, kv_w[:, S - win:])


def gather_pages(pool, page_table):
    rows = pool[page_table]
    return rows.reshape(page_table.shape[0], page_table.shape[1] * PAGE_SIZE, *pool.shape[2:])


def nsa_sample(q, kv_c, kv_s, kv_w, gates, pool_c, pool_s, win_buf, page_table, pe, w1, w2, rel_bias):
    T = q.shape[1]
    past = page_table.shape[1] * PAGE_SIZE
    full_c = jnp.concatenate([gather_pages(pool_c, page_table), kv_c], axis=1)
    ckv = compress_kv(full_c, pe, w1, w2)
    full_s = jnp.concatenate([gather_pages(pool_s, page_table), kv_s], axis=1)
    pad = -full_s.shape[1] % SEL_BLOCK
    full_s = jnp.pad(full_s, ((0, 0), (0, pad), (0, 0), (0, 0), (0, 0)))
    kw_all = jnp.concatenate([win_buf, kv_w], axis=1)
    wb = win_buf.shape[1]
    wpos = past - wb + jnp.arange(wb + T)
    qpos = past + jnp.arange(T)
    o = nsa_attend(q, qpos, ckv[:, :, 0], ckv[:, :, 1], full_s[:, :, 0], full_s[:, :, 1],
                   kw_all[:, :, 0], kw_all[:, :, 1], wpos, gates, rel_bias)
    return o, (kv_c, kv_s, kw_all[:, -wb:])


def trunk_layer(x, c, w_ada, b_ada, w_in, b_gate, ml_norm_g, w_out, ln_g, ln_b, w_up, w_down, mlstm_fn, nsa_fn):
    B, T = x.shape[0], x.shape[1]
    f32 = jnp.float32
    sh1, sc1, g1, sh2, sc2, g2 = jnp.split((jax.nn.silu(c) @ w_ada + b_ada)[:, None, :], 6, axis=-1)
    u = x * (1 + sc1) + sh1
    split_idx = np.cumsum(IN_SIZES)[:-1].tolist()
    mq, mk, mv, mo, mi, mf, nq, ck, cv, sk, sv, wk, wv, ng = jnp.split(u @ w_in, split_idx, axis=-1)
    heads = (B, T, ML_HEADS, ML_HD)
    q = mq.reshape(heads).astype(f32)
    k = mk.reshape(heads).astype(f32) * ML_HD ** -0.5
    v = mv.reshape(heads).astype(f32)
    ig = (mi + b_gate[:ML_HEADS]).astype(f32)
    lf = jax.nn.log_sigmoid((mf + b_gate[ML_HEADS:]).astype(f32))
    h_ml, ml_state = mlstm_fn(q, k, v, ig, lf)

    def kv_pair(a, b):
        return jnp.stack([a.reshape(B, T, KV_HEADS, NSA_HD), b.reshape(B, T, KV_HEADS, NSA_HD)], axis=2)

    nsa_q = nq.reshape(B, T, KV_HEADS, Q_PER_KV, NSA_HD)
    gates = jax.nn.sigmoid(ng).reshape(B, T, KV_HEADS, Q_PER_KV, 3)
    o_nsa, nsa_state = nsa_fn(nsa_q, kv_pair(ck, cv), kv_pair(sk, sv), kv_pair(wk, wv), gates)
    h_ml = (head_norm(h_ml, ml_norm_g) * jax.nn.sigmoid(mo.reshape(heads).astype(f32))).reshape(B, T, ML_W)
    mixed = jnp.concatenate([h_ml.astype(x.dtype), o_nsa.reshape(B, T, NSA_W).astype(x.dtype)], axis=-1) @ w_out
    x = layer_norm(ALPHA * x + g1 * mixed, ln_g[0], ln_b[0])
    u2 = x * (1 + sc2) + sh2
    ff = jnp.square(jax.nn.relu(u2 @ w_up)) @ w_down
    x = layer_norm(ALPHA * x + g2 * ff, ln_g[1], ln_b[1])
    return x, ml_state, nsa_state


def setup_inputs(seed: int = 0) -> dict:
    key = jax.random.key(seed)
    k = jax.random.split(key, 28)
    nrm = jax.random.normal
    f32 = jnp.float32
    D = D_MODEL
    n_pages = PAST_LEN // PAGE_SIZE
    n_used = DEC_BATCH * n_pages
    n_phys = (5 * n_used + 3) // 4
    win_len = min(WINDOW, PAST_LEN)
    page_table = jax.random.permutation(k[8], n_phys)[:n_used].reshape(DEC_BATCH, n_pages).astype(jnp.int32)
    gate_off = jnp.concatenate([jnp.zeros((2 * D,), f32), jnp.ones((D,), f32),
                                jnp.zeros((2 * D,), f32), jnp.ones((D,), f32)])
    forget_bias = jnp.linspace(3.0, 6.0, ML_HEADS, dtype=f32)
    return {
        'x_prompt': nrm(k[0], (BATCH, SEQ, D), f32),
        'x_sample': nrm(k[1], (DEC_BATCH, DEC_SEQ, D), f32),
        'cache_cmp_kv': nrm(k[2], (DEPTH, n_phys, PAGE_SIZE, 2, KV_HEADS, NSA_HD), f32),
        'cache_slc_kv': nrm(k[3], (DEPTH, n_phys, PAGE_SIZE, 2, KV_HEADS, NSA_HD), f32),
        'cache_win_kv': nrm(k[4], (DEPTH, DEC_BATCH, win_len, 2, KV_HEADS, NSA_HD), f32),
        'state_mlstm_C': 0.3 * nrm(k[5], (DEPTH, DEC_BATCH, ML_HEADS, ML_HD, ML_HD), f32),
        'state_mlstm_n': 0.3 * nrm(k[6], (DEPTH, DEC_BATCH, ML_HEADS, ML_HD), f32),
        'state_mlstm_m': jax.random.uniform(k[7], (DEPTH, DEC_BATCH, ML_HEADS), f32, 0.0, 3.0),
        'page_table': page_table,
        'c_prompt': nrm(k[9], (BATCH, D), f32),
        'c_sample': nrm(k[10], (DEC_BATCH, D), f32),
        'w_ada': 0.2 * D ** -0.5 * nrm(k[11], (DEPTH, D, 6 * D), f32),
        'b_ada': gate_off + 0.02 * nrm(k[12], (DEPTH, 6 * D), f32),
        'w_in': D ** -0.5 * nrm(k[13], (DEPTH, D, N_IN), f32),
        'b_gate': jnp.concatenate([0.1 * nrm(k[14], (DEPTH, ML_HEADS), f32),
                                   forget_bias + 0.1 * nrm(k[15], (DEPTH, ML_HEADS), f32)], axis=1),
        'ml_norm_g': 1.0 + 0.02 * nrm(k[16], (DEPTH, ML_W), f32),
        'cmp_pe': 0.1 * nrm(k[17], (DEPTH, 2, CMP_BLOCK, NSA_HD), f32),
        'cmp_w1': (CMP_BLOCK * NSA_HD) ** -0.5 * nrm(k[18], (DEPTH, 2, CMP_BLOCK * NSA_HD, CMP_HIDDEN), f32),
        'cmp_w2': CMP_HIDDEN ** -0.5 * nrm(k[19], (DEPTH, 2, CMP_HIDDEN, NSA_HD), f32),
        'rel_bias': 0.2 * nrm(k[20], (NUM_BUCKETS, NSA_HEADS), f32),
        'w_out': BETA * MIX_W ** -0.5 * nrm(k[21], (DEPTH, MIX_W, D), f32),
        'ln_g': 1.0 + 0.02 * nrm(k[22], (DEPTH, 2, D), f32),
        'ln_b': 0.02 * nrm(k[23], (DEPTH, 2, D), f32),
        'w_up': D ** -0.5 * nrm(k[24], (DEPTH, D, D_FF), f32),
        'w_down': BETA * D_FF ** -0.5 * nrm(k[25], (DEPTH, D_FF, D), f32),
    }


def reference(x_prompt, x_sample, cache_cmp_kv, cache_slc_kv, cache_win_kv, state_mlstm_C, state_mlstm_n,
              state_mlstm_m, page_table, c_prompt, c_sample, w_ada, b_ada, w_in, b_gate, ml_norm_g, cmp_pe,
              cmp_w1, cmp_w2, rel_bias, w_out, ln_g, ln_b, w_up, w_down):
    xp, xs = x_prompt, x_sample
    cmp_p, cmp_s, slc_p, slc_s, win_p, win_s = [], [], [], [], [], []
    C_p, C_s, n_p, n_s, m_p, m_s = [], [], [], [], [], []
    for l in range(DEPTH):
        lw = (w_ada[l], b_ada[l], w_in[l], b_gate[l], ml_norm_g[l], w_out[l], ln_g[l], ln_b[l], w_up[l], w_down[l])
        cmp_l = (cmp_pe[l], cmp_w1[l], cmp_w2[l])
        xp, mlp_state, nsp_state = trunk_layer(
            xp, c_prompt, *lw, mlstm_prompt,
            lambda *a: nsa_prompt(*a, *cmp_l, rel_bias))
        ml_s = lambda *a: mlstm_sample(*a, state_mlstm_C[l], state_mlstm_n[l], state_mlstm_m[l])
        nsa_s = lambda *a: nsa_sample(*a, cache_cmp_kv[l], cache_slc_kv[l], cache_win_kv[l], page_table,
                                      *cmp_l, rel_bias)
        xs, mls_state, nss_state = trunk_layer(xs, c_sample, *lw, ml_s, nsa_s)
        cmp_p.append(nsp_state[0]); slc_p.append(nsp_state[1]); win_p.append(nsp_state[2])
        cmp_s.append(nss_state[0]); slc_s.append(nss_state[1]); win_s.append(nss_state[2])
        C_p.append(mlp_state[0]); n_p.append(mlp_state[1]); m_p.append(mlp_state[2])
        C_s.append(mls_state[0]); n_s.append(mls_state[1]); m_s.append(mls_state[2])
    return (xp, xs,
            jnp.stack(cmp_p), jnp.stack(cmp_s),
            jnp.stack(slc_p), jnp.stack(slc_s),
            jnp.stack(win_p), jnp.stack(win_s),
            jnp.stack(C_p), jnp.stack(C_s),
            jnp.stack(n_p), jnp.stack(n_s),
            jnp.stack(m_p), jnp.stack(m_s))
```

```cpp
#include <hip/hip_runtime.h>
#include <cstdio>
#include <cstdint>
namespace pg8 {
#define PG8_LAS __attribute__((address_space(3)))
typedef unsigned short bf16_t;
typedef short bf16x8 __attribute__((ext_vector_type(8)));
typedef float f32x4 __attribute__((ext_vector_type(4)));
typedef unsigned u32x4 __attribute__((ext_vector_type(4)));
constexpr int BM = 256, BK = 64, HALF = 128, HTB = HALF * BK * 2  , STAGE_BYTES = 8 * HTB, NXCD = 8, WGM = 8;

__host__ __device__ __forceinline__ int lds_byte(int r, int c) { const int st = (r >> 4) * 2 + (c >> 5), rr = r & 15, cc = c & 31, ob = rr * 64 + cc * 2; return st * 1024 + (ob ^ (((ob >> 9) & 1) << 5)); }
__host__ __device__ __forceinline__ void stage_rc(int b, int& R, int& C) { const int st = b / 1024, sb = b % 1024, swz = sb ^ (((sb >> 9) & 1) << 5); R = (st >> 1) * 16 + swz / 64; C = (st & 1) * 32 + (swz % 64) / 2; }
__host__ __device__ __forceinline__ int perm32(int rho) { const int n = rho >> 4, i = rho & 15; return 8 * (i >> 2) + 4 * n + (i & 3); }

struct Unit { int pm, pn; };
struct Gemm { const bf16_t* A; const bf16_t* Bt; int K, lda, ldb; };

struct StaticOrder {
    int nM, nN, nwg, G, c;
    __host__ __device__ void init(int M, int N, int G_, int c_) { nM = M / BM; nN = N / BM; nwg = nM * nN; G = G_; c = c_; }
    __host__ __device__ bool next(int i, Unit& u) const {
        const long L = (long)i * G + c; if (L >= nwg) return false;
        int wgid = (int)L; { const int q = nwg / NXCD, r = nwg % NXCD, xcd = wgid % NXCD, off = wgid / NXCD; wgid = (xcd < r ? xcd * (q + 1) : r * (q + 1) + (xcd - r) * q) + off; }
        const int nig = WGM * nN, gid = wgid / nig, fm = gid * WGM, gsz = (nM - fm) < WGM ? (nM - fm) : WGM;
        u.pm = fm + ((wgid % nig) % gsz); u.pn = (wgid % nig) / gsz; return true;
    }
    __device__ __forceinline__ void a_ready(const Unit&) const {}
    __device__ __forceinline__ void done(const Unit&) const {}
};

template <class Epi, class Sched, bool ALIGN_EPI = false, bool SP2 = false>
__device__ __forceinline__ void gemm_phase(PG8_LAS unsigned char* lds, const Gemm g, const Sched& S, const Epi& E) {
    const int tid = threadIdx.x, wid = __builtin_amdgcn_readfirstlane(tid >> 6), lane = tid & 63, wr = wid >> 2, wc = wid & 3, fr = lane & 15, fq = lane >> 4;
    const int K = g.K, nt = K / BK;
    unsigned voffA[2], voffB[2];
#pragma unroll
    for (int i = 0; i < 2; ++i) { int R, C; stage_rc(tid * 16 + i * 8192, R, C); const int Rb = Epi::PERM ? ((R & ~31) + perm32(R & 31)) : R;
        voffA[i] = (unsigned)(R * g.lda + C) * 2u; voffB[i] = (unsigned)(Rb * g.ldb + C) * 2u; }
    const size_t kstep = (size_t)(BK * 2);
    const size_t hstepA = (size_t)HALF * g.lda * 2, hstepB = (size_t)HALF * g.ldb * 2;
    const size_t tstepA = 2 * hstepA, tstepB = 2 * hstepB;
    const unsigned ldsw = (unsigned)wid * 1024u;
    const int aoff = lds_byte(wr * 64 + fr, fq * 8), boff = lds_byte(wc * 32 + fr, fq * 8);
#define PG8_SA(b, h) (((b) * 2 + (h)) * HTB)
#define PG8_SB(b, h) ((4 + (b) * 2 + (h)) * HTB)
#define PG8_STAGE(bufoff, gbase, voff) do { _Pragma("unroll") for (int _i = 0; _i < 2; ++_i) \
        __builtin_amdgcn_global_load_lds((const unsigned*)((const char*)(gbase) + (voff)[_i]), (PG8_LAS unsigned*)(lds + (bufoff) + ldsw + _i * 8192), 16, 0, 0); } while (0)
#define PG8_LDA(dst, b, h) do { _Pragma("unroll") for (int m = 0; m < 4; ++m) _Pragma("unroll") for (int k = 0; k < 2; ++k) dst[m][k] = *(const PG8_LAS bf16x8*)(lds + PG8_SA(b, h) + aoff + m * 2048 + k * 1024); } while (0)
#define PG8_LDB(dst, b, h) do { _Pragma("unroll") for (int n = 0; n < 2; ++n) _Pragma("unroll") for (int k = 0; k < 2; ++k) dst[n][k] = *(const PG8_LAS bf16x8*)(lds + PG8_SB(b, h) + boff + n * 2048 + k * 1024); } while (0)
#define PG8_MMA(ai, bj, At, Bt) do { __builtin_amdgcn_s_setprio(1); _Pragma("unroll") for (int m = 0; m < 4; ++m) _Pragma("unroll") for (int n = 0; n < 2; ++n) _Pragma("unroll") for (int k = 0; k < 2; ++k) \
        acc[ai][bj][m][n] = __builtin_amdgcn_mfma_f32_16x16x32_bf16(Bt[n][k], At[m][k], acc[ai][bj][m][n], 0, 0, 0); __builtin_amdgcn_s_setprio(0); } while (0)
#define PG8_WAIT_V(n) asm volatile("s_waitcnt vmcnt(" #n ")" ::: "memory")
#define PG8_WAIT_L(n) asm volatile("s_waitcnt lgkmcnt(" #n ")" ::: "memory")
#define PG8_BAR __builtin_amdgcn_s_barrier()
#define PG8_SCHED __builtin_amdgcn_sched_barrier(0)
    Unit cur, nxt; int ui = 0;
    if (!S.next(0, cur)) return;
    f32x4 acc[2][2][4][2];
#pragma unroll
    for (int a = 0; a < 2; ++a)
#pragma unroll
        for (int b = 0; b < 2; ++b)
#pragma unroll
            for (int m = 0; m < 4; ++m)
#pragma unroll
                for (int n = 0; n < 2; ++n) acc[a][b][m][n] = (f32x4){0.f, 0.f, 0.f, 0.f};
    bf16x8 At[4][2], B0[2][2], B1[2][2];
    const char* cA = (const char*)g.A + (size_t)cur.pm * tstepA; const char* cB = (const char*)g.Bt + (size_t)cur.pn * tstepB;
    S.a_ready(cur);
    if constexpr (SP2) {
        PG8_STAGE(PG8_SB(0, 0), cB, voffB); PG8_STAGE(PG8_SB(0, 1), cB + hstepB, voffB); PG8_STAGE(PG8_SA(0, 0), cA, voffA); PG8_STAGE(PG8_SA(0, 1), cA + hstepA, voffA);
        if (wr == 1) PG8_BAR;
        PG8_WAIT_V(2); PG8_BAR;
        PG8_STAGE(PG8_SB(1, 0), cB + kstep, voffB); PG8_STAGE(PG8_SA(1, 0), cA + kstep, voffA); PG8_STAGE(PG8_SB(1, 1), cB + hstepB + kstep, voffB);
        PG8_WAIT_V(6); PG8_BAR;
    } else {
        PG8_STAGE(PG8_SB(0, 0), cB, voffB); PG8_STAGE(PG8_SA(0, 0), cA, voffA); PG8_STAGE(PG8_SB(0, 1), cB + hstepB, voffB); PG8_STAGE(PG8_SA(0, 1), cA + hstepA, voffA);
        if (wr == 1) PG8_BAR;
        PG8_WAIT_V(4); PG8_BAR;
        PG8_STAGE(PG8_SB(1, 0), cB + kstep, voffB); PG8_STAGE(PG8_SA(1, 0), cA + kstep, voffA); PG8_STAGE(PG8_SB(1, 1), cB + hstepB + kstep, voffB);
        PG8_WAIT_V(6); PG8_BAR;
    }
    for (;;) {
        const bool has_next = S.next(ui + 1, nxt);
        const char* nA = has_next ? (const char*)g.A + (size_t)nxt.pm * tstepA : cA; const char* nB = has_next ? (const char*)g.Bt + (size_t)nxt.pn * tstepB : cB;
        for (int t = 0; t < nt; t += 2) {
            const bool last = (t == nt - 2);
            const char* a1 = cA + (size_t)(t + 1) * kstep;
            const char* a2 = last ? nA : cA + (size_t)(t + 2) * kstep; const char* b2 = last ? nB : cB + (size_t)(t + 2) * kstep;
            const char* a3 = a2 + kstep; const char* b3 = b2 + kstep;
            if (last && has_next) S.a_ready(nxt);
            if constexpr (SP2) {
            PG8_LDB(B0, 0, 0); PG8_LDB(B1, 0, 1); PG8_SCHED; PG8_LDA(At, 0, 0); PG8_STAGE(PG8_SA(1, 1), a1 + hstepA, voffA);
            PG8_WAIT_V(8); PG8_WAIT_L(0); PG8_BAR; PG8_MMA(0, 0, At, B0); PG8_MMA(0, 1, At, B1); PG8_BAR; PG8_SCHED;
            PG8_LDA(At, 0, 1); PG8_STAGE(PG8_SB(0, 0), b2, voffB); PG8_STAGE(PG8_SB(0, 1), b2 + hstepB, voffB); PG8_STAGE(PG8_SA(0, 0), a2, voffA);
            PG8_WAIT_V(8); PG8_WAIT_L(0); PG8_BAR; PG8_MMA(1, 0, At, B0); PG8_MMA(1, 1, At, B1); PG8_BAR; PG8_SCHED;
            PG8_LDB(B0, 1, 0); PG8_LDB(B1, 1, 1); PG8_SCHED; PG8_LDA(At, 1, 0); PG8_STAGE(PG8_SA(0, 1), a2 + hstepA, voffA);
            PG8_WAIT_V(8); PG8_WAIT_L(0); PG8_BAR; PG8_MMA(0, 0, At, B0); PG8_MMA(0, 1, At, B1); PG8_BAR; PG8_SCHED;
            PG8_LDA(At, 1, 1); PG8_STAGE(PG8_SB(1, 0), b3, voffB); PG8_STAGE(PG8_SB(1, 1), b3 + hstepB, voffB); PG8_STAGE(PG8_SA(1, 0), a3, voffA);
            PG8_WAIT_V(8); PG8_WAIT_L(0); PG8_BAR; PG8_MMA(1, 0, At, B0); PG8_MMA(1, 1, At, B1); PG8_BAR; PG8_SCHED;
            } else {
            PG8_LDB(B0, 0, 0); PG8_SCHED; PG8_LDA(At, 0, 0); PG8_STAGE(PG8_SA(1, 1), a1 + hstepA, voffA);
            PG8_WAIT_L(8); PG8_BAR; PG8_WAIT_L(0); PG8_MMA(0, 0, At, B0); PG8_BAR; PG8_SCHED;
            PG8_LDB(B1, 0, 1); PG8_STAGE(PG8_SB(0, 0), b2, voffB);
            PG8_BAR; PG8_WAIT_L(0); PG8_MMA(0, 1, At, B1); PG8_BAR;
            PG8_LDA(At, 0, 1); PG8_STAGE(PG8_SA(0, 0), a2, voffA);
            PG8_BAR; PG8_WAIT_L(0); PG8_MMA(1, 0, At, B0); PG8_BAR; PG8_SCHED;
            PG8_STAGE(PG8_SB(0, 1), b2 + hstepB, voffB);
            PG8_WAIT_V(6); PG8_BAR; PG8_MMA(1, 1, At, B1); PG8_BAR;
            PG8_LDB(B0, 1, 0); PG8_SCHED; PG8_LDA(At, 1, 0); PG8_STAGE(PG8_SA(0, 1), a2 + hstepA, voffA);
            PG8_WAIT_L(8); PG8_BAR; PG8_WAIT_L(0); PG8_MMA(0, 0, At, B0); PG8_BAR; PG8_SCHED;
            PG8_LDB(B1, 1, 1); PG8_STAGE(PG8_SB(1, 0), b3, voffB);
            PG8_BAR; PG8_WAIT_L(0); PG8_MMA(0, 1, At, B1); PG8_BAR;
            PG8_LDA(At, 1, 1); PG8_STAGE(PG8_SA(1, 0), a3, voffA);
            PG8_BAR; PG8_WAIT_L(0); PG8_MMA(1, 0, At, B0); PG8_BAR; PG8_SCHED;
            PG8_STAGE(PG8_SB(1, 1), b3 + hstepB, voffB);
            PG8_WAIT_V(6); PG8_BAR; PG8_MMA(1, 1, At, B1); PG8_BAR;
            }
        }
        if constexpr (ALIGN_EPI) { if (wr == 0) PG8_BAR; }
        if constexpr (!Epi::AFTER_DRAIN) { E(acc, cur, wr, wc, fr, fq); S.done(cur); }
        if (!has_next) break;
#pragma unroll
        for (int a = 0; a < 2; ++a)
#pragma unroll
            for (int b = 0; b < 2; ++b)
#pragma unroll
                for (int m = 0; m < 4; ++m)
#pragma unroll
                    for (int n = 0; n < 2; ++n) acc[a][b][m][n] = (f32x4){0.f, 0.f, 0.f, 0.f};
        cur = nxt; cA = nA; cB = nB; ++ui;
        if constexpr (ALIGN_EPI) { if (wr == 1) PG8_BAR; }
    }
    PG8_WAIT_V(0);
    if constexpr (!ALIGN_EPI) { if (wr == 0) PG8_BAR; }
    PG8_BAR;
    if constexpr (Epi::AFTER_DRAIN) { E.fused(acc, cur, wr, wc, fr, fq, lds, wid, lane); S.done(cur); }
#undef PG8_SA
#undef PG8_SB
#undef PG8_STAGE
#undef PG8_LDA
#undef PG8_LDB
#undef PG8_MMA
#undef PG8_WAIT_V
#undef PG8_WAIT_L
#undef PG8_BAR
#undef PG8_SCHED
}
}

constexpr int D = 1024, BATCH = 2, SEQ = 8192, DEPTH = 2, DB = 128, DS = 4, PAST = 2048, PAGE = 128, NPG = 16, NPHYS = 2560;
constexpr int MP = BATCH * SEQ, MS = DB * DS, M = MP + MS;
constexpr int NINP = 3584, FF = 4096, NCOND = BATCH + DB;
constexpr int NH = 4, HD = 128;
constexpr int LCH = 256, NCH = SEQ / LCH, NUNIT = BATCH * NH * NCH;
constexpr int NCB = 17408;
constexpr int XCP = NCB * 16;
constexpr float ALPHA = 1.4142135623730951f;
constexpr float LN_EPS = 1e-5f;
constexpr size_t O_YP = 0, O_YS = O_YP + (size_t)MP * D, O_CMPP = O_YS + (size_t)MS * D, O_CMPS = O_CMPP + (size_t)DEPTH * MP * 256, O_SLCP = O_CMPS + (size_t)DEPTH * MS * 256,
                 O_SLCS = O_SLCP + (size_t)DEPTH * MP * 256, O_WINP = O_SLCS + (size_t)DEPTH * MS * 256, O_WINS = O_WINP + (size_t)DEPTH * BATCH * 512 * 256,
                 O_CP = O_WINS + (size_t)DEPTH * DB * 512 * 256, O_CS = O_CP + (size_t)DEPTH * BATCH * NH * HD * HD, O_NP = O_CS + (size_t)DEPTH * DB * NH * HD * HD,
                 O_NS = O_NP + (size_t)DEPTH * BATCH * NH * HD, O_MP = O_NS + (size_t)DEPTH * DB * NH * HD, O_MS = O_MP + (size_t)DEPTH * BATCH * NH, O_END = O_MS + (size_t)DEPTH * DB * NH;

constexpr size_t al1m(size_t x) { return (x + 0xFFFFFull) & ~(size_t)0xFFFFFull; }
constexpr size_t WS_CTL = 0, CTL_ZERO_BYTES = 1u << 20;
constexpr size_t WS_WIN  = CTL_ZERO_BYTES;
constexpr size_t WS_WOUT = WS_WIN  + al1m((size_t)DEPTH * NINP * D * 2);
constexpr size_t WS_WUP  = WS_WOUT + al1m((size_t)DEPTH * D * D * 2);
constexpr size_t WS_WDN  = WS_WUP  + al1m((size_t)DEPTH * FF * D * 2);
constexpr size_t WS_W1   = WS_WDN  + al1m((size_t)DEPTH * D * FF * 2);
constexpr size_t WS_ADA  = WS_W1   + al1m((size_t)DEPTH * 2 * 256 * 2048 * 2);
constexpr size_t WS_B1   = WS_ADA  + al1m((size_t)DEPTH * NCOND * 6144 * 4);
constexpr size_t WS_BT   = WS_B1   + al1m(4096);
constexpr size_t WS_X    = WS_BT   + al1m(8 * 132 * 4);
constexpr size_t WS_Z    = WS_X    + al1m((size_t)M * D * 4);
constexpr size_t WS_U    = WS_Z    + al1m((size_t)M * D * 4);
constexpr size_t WS_QKVO = WS_U    + al1m((size_t)M * D * 2);
constexpr size_t WS_NQ   = WS_QKVO + al1m((size_t)M * 2048 * 2);
constexpr size_t WS_GATE = WS_NQ   + al1m((size_t)M * 512 * 2);
constexpr size_t WS_KVR  = WS_GATE + al1m((size_t)M * 32 * 4);
constexpr size_t WS_XC   = WS_KVR  + al1m((size_t)3 * M * 256 * 4);
constexpr size_t WS_HID  = WS_XC   + al1m((size_t)DEPTH * 4 * XCP * 64 * 2 + 4096);
constexpr size_t WS_CKV  = WS_HID  + al1m((size_t)DEPTH * 4 * NCB * 256 * 2);
constexpr size_t WS_MIX  = WS_CKV  + al1m((size_t)DEPTH * 4 * NCB * 64 * 4);
constexpr size_t WS_H    = WS_MIX  + al1m((size_t)M * D * 2);
constexpr size_t WS_DCT  = WS_H    + al1m((size_t)M * FF * 2);
constexpr size_t WS_DN   = WS_DCT  + al1m((size_t)NUNIT * HD * HD * 4);
constexpr size_t WS_CHS  = WS_DN   + al1m((size_t)NUNIT * HD * 4);
constexpr size_t WS_CTP  = WS_CHS  + al1m((size_t)NUNIT * 4 * 4);
constexpr size_t WS_NPV  = WS_CTP  + al1m((size_t)NUNIT * HD * HD * 2);
constexpr size_t WS_WSC  = WS_NPV  + al1m((size_t)NUNIT * HD * 4);
constexpr size_t WS_HRAW = WS_WSC  + al1m((size_t)NUNIT * LCH * LCH * 4);
constexpr size_t WS_END  = WS_HRAW + al1m((size_t)NUNIT * LCH * HD * 4);

constexpr int CW_BAR = 4096;

constexpr int RING_BYTES = 131072, LDSCTL_OFF = RING_BYTES, MISC_OFF = LDSCTL_OFF + 320, LDS_BYTES = 147456;
constexpr int NWAVES = 8, NTHR = NWAVES * 64;

#define GAS __attribute__((address_space(1)))
#define LAS __attribute__((address_space(3)))
typedef unsigned short bf16;
typedef unsigned v4u __attribute__((ext_vector_type(4)));
typedef unsigned v2u __attribute__((ext_vector_type(2)));
typedef float f32x4 __attribute__((ext_vector_type(4)));
typedef float f32x2 __attribute__((ext_vector_type(2)));

__device__ __forceinline__ unsigned f2bf(float f) { unsigned u = __builtin_bit_cast(unsigned, f); return (u + 0x7fffu + ((u >> 16) & 1u)) >> 16; }
__device__ __forceinline__ unsigned pk2(float lo, float hi) { return f2bf(lo) | (f2bf(hi) << 16); }
__device__ __forceinline__ float bflo(unsigned u) { return __builtin_bit_cast(float, u << 16); }
__device__ __forceinline__ float bfhi(unsigned u) { return __builtin_bit_cast(float, u & 0xffff0000u); }
__device__ __forceinline__ float bf2f(bf16 h) { return __builtin_bit_cast(float, (unsigned)h << 16); }
__device__ __forceinline__ float sigmoidf_(float x) { return 1.f / (1.f + __expf(-x)); }
__device__ __forceinline__ float wave_sum(float v) {
#pragma unroll
    for (int o = 1; o < 64; o <<= 1) v += __shfl_xor(v, o);
    return v;
}
__device__ __forceinline__ float wave_max(float v) {
#pragma unroll
    for (int o = 1; o < 64; o <<= 1) v = fmaxf(v, __shfl_xor(v, o));
    return v;
}

#define XB_TMO      128
#define XB_XCNT(j)  (256  + 64 * (j))
#define XB_XSUB(j)  (1280 + 64 * (j))
#define XB_XGEN(j)  (2304 + 64 * (j))
#define XB_TOP      3328
#define XB_TOPGEN   3392
#define XCD_BAR_WORDS 3456
#define XB_SPIN_CAP (1u << 18)

__device__ __forceinline__ unsigned xb_ld(unsigned* p)              { return __hip_atomic_load(p, __ATOMIC_RELAXED, __HIP_MEMORY_SCOPE_AGENT); }
__device__ __forceinline__ unsigned xb_add(unsigned* p, unsigned v) { return __hip_atomic_fetch_add(p, v, __ATOMIC_RELAXED, __HIP_MEMORY_SCOPE_AGENT); }
__device__ __forceinline__ unsigned xb_xcc_id() { return (unsigned)__builtin_amdgcn_s_getreg((3 << 11) | 20) & 0xFu; }
#define XB_SPIN(cond, bar) do { unsigned _sp = 0; while (cond) { __builtin_amdgcn_s_sleep(1); \
    if ((++_sp & 255u) == 0u) { if (xb_ld(&(bar)[XB_TMO])) break; if (_sp > XB_SPIN_CAP) { atomicAdd(&(bar)[XB_TMO], 1u); break; } } } } while (0)

struct XcdBarrier {
    unsigned* bar; unsigned x;
    volatile LAS unsigned* st;
};

__device__ __forceinline__ XcdBarrier xcd_barrier_post(unsigned* bar, volatile LAS unsigned* st) {
    XcdBarrier b; b.bar = bar; b.x = xb_xcc_id(); b.st = st;
    if (threadIdx.x == 0) (void)xb_add(&bar[XB_XCNT(b.x)], 1u);
    return b;
}
__device__ __forceinline__ void xcd_barrier_complete(unsigned* bar, unsigned x, unsigned& nloc, unsigned& nx) {
    const unsigned G = gridDim.x * gridDim.y * gridDim.z;
    unsigned sum, cnt, mine, sp = 0u;
    for (;;) {
        sum = 0u; cnt = 0u; mine = 0u;
#pragma unroll
        for (unsigned j = 0; j < 16; ++j) { const unsigned c = xb_ld(&bar[XB_XCNT(j)]); sum += c; cnt += (c > 0u) ? 1u : 0u; mine = (j == x) ? c : mine; }
        if (sum == G) break;
        __builtin_amdgcn_s_sleep(1);
        if ((++sp & 255u) == 0u) { if (xb_ld(&bar[XB_TMO])) break; if (sp > XB_SPIN_CAP) { atomicAdd(&bar[XB_TMO], 1u); break; } }
    }
    nloc = mine > 0u ? mine : 1u; nx = cnt > 0u ? cnt : 1u;
}

__device__ __forceinline__ void xcd_barrier(const XcdBarrier& b) {
    asm volatile("s_waitcnt vmcnt(0)" ::: "memory");
    __syncthreads();
    if (threadIdx.x == 0) {
        unsigned* bar = b.bar;
        __builtin_amdgcn_s_waitcnt(0);
        unsigned nloc = b.st[0], nx = b.st[1];
        if (nloc == 0u) { xcd_barrier_complete(bar, b.x, nloc, nx); b.st[0] = nloc; b.st[1] = nx; }
        const unsigned old = xb_add(&bar[XB_XSUB(b.x)], 1u);
        const unsigned gen = old / nloc;
        if (old + 1u == (gen + 1u) * nloc) {
            __builtin_amdgcn_fence(__ATOMIC_RELEASE, "agent");
            asm volatile("s_waitcnt vmcnt(0)" ::: "memory");
            const unsigned og = xb_add(&bar[XB_TOP], 1u);
            const unsigned tg = og / nx;
            if (og + 1u == (tg + 1u) * nx) xb_add(&bar[XB_TOPGEN], 1u);
            else XB_SPIN(xb_ld(&bar[XB_TOPGEN]) == tg, bar);
            __builtin_amdgcn_fence(__ATOMIC_ACQUIRE, "agent");
            xb_add(&bar[XB_XGEN(b.x)], 1u);
            asm volatile("s_waitcnt vmcnt(0)" ::: "memory");
        } else {
            XB_SPIN(xb_ld(&bar[XB_XGEN(b.x)]) == gen, bar);
            __builtin_amdgcn_fence(__ATOMIC_ACQUIRE, "agent");
            asm volatile("s_waitcnt vmcnt(0)" ::: "memory");
        }
    }
    __syncthreads();
}

struct Args {
    const float* x_prompt; const float* x_sample; const float* cache_cmp; const float* cache_slc; const float* cache_win;
    const float* st_C; const float* st_n; const float* st_m; const int* page_table; const float* c_prompt; const float* c_sample;
    const float* w_ada; const float* b_ada; const float* w_in; const float* b_gate; const float* ml_norm_g; const float* cmp_pe;
    const float* cmp_w1; const float* cmp_w2; const float* rel_bias; const float* w_out; const float* ln_g; const float* ln_b;
    const float* w_up; const float* w_down;
    float* out; unsigned char* ws; int ph_lo, ph_hi;
};
static_assert(sizeof(Args) == 27 * 8 + 8, "Args has no padding");
typedef const __attribute__((address_space(4))) Args CArgs;

__device__ __forceinline__ int cond_of_row(int r) { return r < MP ? (r >> 13) : BATCH + ((r - MP) >> 2); }

struct EpiInProj {
    static constexpr bool PERM = true, AFTER_DRAIN = false;
    bf16* QKVO; bf16* NQ; float* GATE; float* KVR; bf16* XC; float* out; int l;
    __device__ __forceinline__ void operator()(const f32x4 (&acc)[2][2][4][2], const pg8::Unit& u, int wr, int wc, int fr, int fq) const {
        const int row0 = u.pm * 256 + wr * 64 + fr, pn = u.pn, col8 = wc * 32 + 8 * fq;
#pragma unroll
        for (int ai = 0; ai < 2; ++ai)
#pragma unroll
            for (int m = 0; m < 4; ++m) {
                const int r = row0 + ai * 128 + m * 16;
#pragma unroll
                for (int bj = 0; bj < 2; ++bj) {
                    const f32x4 v0 = acc[ai][bj][m][0], v1 = acc[ai][bj][m][1];
                    const int cc = bj * 128 + col8;
                    if (pn < 10) {
                        v4u w; w.x = pk2(v0[0], v0[1]); w.y = pk2(v0[2], v0[3]); w.z = pk2(v1[0], v1[1]); w.w = pk2(v1[2], v1[3]);
                        if (pn < 8) *(v4u*)(QKVO + (size_t)r * 2048 + pn * 256 + cc) = w;
                        else        *(v4u*)(NQ + (size_t)r * 512 + (pn - 8) * 256 + cc) = w;
                    } else if (pn < 13) {
                        const int kind = pn - 10;
                        float* kr = KVR + ((size_t)kind * M + r) * 256 + cc;
                        *(f32x4*)kr = v0; *(f32x4*)(kr + 4) = v1;
                        float* o = nullptr;
                        if (r < MP) {
                            if (kind < 2) o = out + (kind == 0 ? O_CMPP : O_SLCP) + ((size_t)l * MP + r) * 256 + cc;
                            else { const int t = r & (SEQ - 1); if (t >= SEQ - 512) o = out + O_WINP + (((size_t)l * BATCH + (r >> 13)) * 512 + (t - (SEQ - 512))) * 256 + cc; }
                        } else {
                            const int rs = r - MP;
                            if (kind < 2) o = out + (kind == 0 ? O_CMPS : O_SLCS) + ((size_t)l * MS + rs) * 256 + cc;
                            else o = out + O_WINS + (((size_t)l * DB + (rs >> 2)) * 512 + 508 + (rs & 3)) * 256 + cc;
                        }
                        if (o) { *(f32x4*)o = v0; *(f32x4*)(o + 4) = v1; }
                        if (kind == 0 && r < MP) {
                            v4u w; w.x = pk2(v0[0], v0[1]); w.y = pk2(v0[2], v0[3]); w.z = pk2(v1[0], v1[1]); w.w = pk2(v1[2], v1[3]);
                            *(v4u*)(XC + ((size_t)(bj * 2 + (wc >> 1)) * XCP + r) * 64 + (wc & 1) * 32 + 8 * fq) = w;
                        }
                    } else {
                        if (bj == 0 && wc == 0) { float* gp = GATE + (size_t)r * 32 + 8 * fq; *(f32x4*)gp = v0; *(f32x4*)(gp + 4) = v1; }
                    }
                }
            }
    }
};

struct EpiResid {
    static constexpr bool PERM = true, AFTER_DRAIN = false;
    const float* xa; const float* xb; const float* gate; float* Z;
    __device__ __forceinline__ void operator()(const f32x4 (&acc)[2][2][4][2], const pg8::Unit& u, int wr, int wc, int fr, int fq) const {
        const int row0 = u.pm * 256 + wr * 64 + fr, col0 = u.pn * 256 + wc * 32 + 8 * fq;
#pragma unroll
        for (int ai = 0; ai < 2; ++ai)
#pragma unroll
            for (int m = 0; m < 4; ++m) {
                const int r = row0 + ai * 128 + m * 16;
                const float* xr = (r < MP ? xa + (size_t)r * D : xb + (size_t)(r - MP) * D) + col0;
                const float* gr = gate + (size_t)cond_of_row(r) * 6144 + col0;
                float* zr = Z + (size_t)r * D + col0;
#pragma unroll
                for (int bj = 0; bj < 2; ++bj) {
                    const f32x4 x0 = *(const f32x4*)(xr + bj * 128), x1 = *(const f32x4*)(xr + bj * 128 + 4);
                    const f32x4 g0 = *(const f32x4*)(gr + bj * 128), g1 = *(const f32x4*)(gr + bj * 128 + 4);
                    *(f32x4*)(zr + bj * 128) = x0 * ALPHA + g0 * acc[ai][bj][m][0];
                    *(f32x4*)(zr + bj * 128 + 4) = x1 * ALPHA + g1 * acc[ai][bj][m][1];
                }
            }
    }
};

struct EpiRelu2 {
    static constexpr bool PERM = true, AFTER_DRAIN = false;
    bf16* H;
    __device__ __forceinline__ void operator()(const f32x4 (&acc)[2][2][4][2], const pg8::Unit& u, int wr, int wc, int fr, int fq) const {
        const int row0 = u.pm * 256 + wr * 64 + fr, col0 = u.pn * 256 + wc * 32 + 8 * fq;
#pragma unroll
        for (int ai = 0; ai < 2; ++ai)
#pragma unroll
            for (int m = 0; m < 4; ++m) {
                bf16* hr = H + (size_t)(row0 + ai * 128 + m * 16) * FF + col0;
#pragma unroll
                for (int bj = 0; bj < 2; ++bj) {
                    f32x4 a = acc[ai][bj][m][0], b = acc[ai][bj][m][1];
#pragma unroll
                    for (int i = 0; i < 4; ++i) { a[i] = fmaxf(a[i], 0.f); a[i] *= a[i]; b[i] = fmaxf(b[i], 0.f); b[i] *= b[i]; }
                    v4u w; w.x = pk2(a[0], a[1]); w.y = pk2(a[2], a[3]); w.z = pk2(b[0], b[1]); w.w = pk2(b[2], b[3]);
                    *(v4u*)(hr + bj * 128) = w;
                }
            }
    }
};

__device__ __forceinline__ float gelu_tanh(float x) {
    const float y = 0.7978845608028654f * (x + 0.044715f * x * x * x);
    const float t = 1.f - 2.f / (__expf(2.f * y) + 1.f);
    return 0.5f * x * (1.f + t);
}
struct EpiCmpHid {
    static constexpr bool PERM = true, AFTER_DRAIN = false;
    bf16* HID; const float* B1;
    __device__ __forceinline__ void operator()(const f32x4 (&acc)[2][2][4][2], const pg8::Unit& u, int wr, int wc, int fr, int fq) const {
        const int row0 = u.pm * 256 + wr * 64 + fr, col0 = wc * 32 + 8 * fq;
        const float* bp = B1 + u.pn * 256 + col0;
        f32x4 bv[2][2];
#pragma unroll
        for (int bj = 0; bj < 2; ++bj) { bv[bj][0] = *(const f32x4*)(bp + bj * 128); bv[bj][1] = *(const f32x4*)(bp + bj * 128 + 4); }
#pragma unroll
        for (int ai = 0; ai < 2; ++ai)
#pragma unroll
            for (int m = 0; m < 4; ++m) {
                bf16* hr = HID + (size_t)(row0 + ai * 128 + m * 16) * 256 + col0;
#pragma unroll
                for (int bj = 0; bj < 2; ++bj) {
                    f32x4 a = acc[ai][bj][m][0] + bv[bj][0], b = acc[ai][bj][m][1] + bv[bj][1];
#pragma unroll
                    for (int i = 0; i < 4; ++i) { a[i] = gelu_tanh(a[i]); b[i] = gelu_tanh(b[i]); }
                    v4u w; w.x = pk2(a[0], a[1]); w.y = pk2(a[2], a[3]); w.z = pk2(b[0], b[1]); w.w = pk2(b[2], b[3]);
                    *(v4u*)(hr + bj * 128) = w;
                }
            }
    }
};

struct CmpOrder {
    int G, c, l0, nl, t0, ntile;
    __device__ __forceinline__ bool next(int i, pg8::Unit& u) const {
        const int L = i * G + c; if (L >= nl * 4 * ntile) return false;
        const int blk = L / ntile, tile = L % ntile, l = l0 + (blk >> 2), sg = blk & 3;
        u.pm = (l * 4 + sg) * 68 + t0 + tile; u.pn = l * 2 + (sg >> 1); return true;
    }
    __device__ __forceinline__ void a_ready(const pg8::Unit&) const {}
    __device__ __forceinline__ void done(const pg8::Unit&) const {}
};

#define LDS_WAIT() asm volatile("s_waitcnt lgkmcnt(0)" ::: "memory")
#define VM_WAIT() asm volatile("s_waitcnt vmcnt(0)" ::: "memory")

template <class CM>
__device__ __forceinline__ void transpose_item(const float* W, int ldw, int K, bf16* WT, LAS float* scr, int item, int nblk, int lane, const CM& cm) {
    const int kb = item / nblk, nb = item % nblk, k0 = 64 * kb, n0 = 32 * nb;
    const int sc = cm.col(n0 + (lane & 31)); const float scl = cm.scl(n0 + (lane & 31));
#pragma unroll 8
    for (int i = 0; i < 32; ++i) { const int kk = 2 * i + (lane >> 5); scr[kk * 33 + (lane & 31)] = sc >= 0 ? W[(size_t)(k0 + kk) * ldw + sc] * scl : 0.f; }
    LDS_WAIT();
    const int c = lane & 7;
#pragma unroll
    for (int j = 0; j < 4; ++j) { const int n = (lane >> 3) + 8 * j; const LAS float* s = scr + (8 * c) * 33 + n;
        v4u o; o.x = pk2(s[0 * 33], s[1 * 33]); o.y = pk2(s[2 * 33], s[3 * 33]); o.z = pk2(s[4 * 33], s[5 * 33]); o.w = pk2(s[6 * 33], s[7 * 33]);
        *(v4u*)(WT + (size_t)(n0 + n) * K + k0 + 8 * c) = o; }
    LDS_WAIT();
}
struct CmId { __device__ __forceinline__ int col(int n) const { return n; } __device__ __forceinline__ float scl(int) const { return 1.f; } };
struct CmIn {
    __device__ __forceinline__ int col(int n) const { return n < 2048 ? n : (n < 3328 ? n + 8 : (n < 3336 ? n - 1280 : (n < 3360 ? n : -1))); }
    __device__ __forceinline__ float scl(int n) const { return (n >= 512 && n < 1024) ? 0.08838834764831845f : ((n >= 2048 && n < 2560) ? 0.125f : 1.f); }
};

__device__ __forceinline__ int rel_bucket_dev(int n) {
    if (n < 16) return n;
    const float nf = (float)n;
    int large = 16 + (int)(__logf(nf / 16.f) / 2.0794415416798357f * 16.f);
    return large < 31 ? large : 31;
}

__device__ __forceinline__ void phase_p0a(CArgs& A, LAS unsigned char* lds, int gw, int NGW, int lane, int wave) {
    unsigned char* ws = A.ws;
    LAS float* scr = (LAS float*)(lds + wave * 16384);
    constexpr int I_IN = 16 * 112, I_OUT = 16 * 32, I_UP = 16 * 128, I_DN = 64 * 32, I_W1 = 32 * 8;
    constexpr int I_L = I_IN + I_OUT + I_UP + I_DN + 2 * I_W1;
    for (int it = gw; it < DEPTH * I_L; it += NGW) {
        const int l = it / I_L; int r = it % I_L;
        if (r < I_IN) { transpose_item(A.w_in + (size_t)l * D * 3360, 3360, D, (bf16*)(ws + WS_WIN) + (size_t)l * NINP * D, scr, r, 112, lane, CmIn{}); continue; } r -= I_IN;
        if (r < I_OUT) { transpose_item(A.w_out + (size_t)l * D * D, D, D, (bf16*)(ws + WS_WOUT) + (size_t)l * D * D, scr, r, 32, lane, CmId{}); continue; } r -= I_OUT;
        if (r < I_UP) { transpose_item(A.w_up + (size_t)l * D * FF, FF, D, (bf16*)(ws + WS_WUP) + (size_t)l * FF * D, scr, r, 128, lane, CmId{}); continue; } r -= I_UP;
        if (r < I_DN) { transpose_item(A.w_down + (size_t)l * FF * D, D, FF, (bf16*)(ws + WS_WDN) + (size_t)l * D * FF, scr, r, 32, lane, CmId{}); continue; } r -= I_DN;
        const int s = r / I_W1; r %= I_W1;
        transpose_item(A.cmp_w1 + (size_t)(l * 2 + s) * 2048 * 256, 256, 2048, (bf16*)(ws + WS_W1) + (size_t)(l * 2 + s) * 256 * 2048, scr, r, 8, lane, CmId{});
    }
    for (int it = gw; it < DEPTH * DB * NPG * 2; it += NGW) {
        const int half = it & 1, pg = (it >> 1) & 15, seq = (it >> 5) & 127, l = it >> 12;
        const int phys = A.page_table[seq * NPG + pg];
        const float* src = A.cache_cmp + (((size_t)l * NPHYS + phys) * PAGE + half * 64) * 256 + 4 * lane;
        const int cc = 4 * lane, s = cc >> 7, g = (cc >> 6) & 1, d = cc & 63;
        bf16* dst = (bf16*)(ws + WS_XC) + ((size_t)((l * 2 + s) * 2 + g) * XCP + MP + seq * PAST + pg * PAGE + half * 64) * 64 + d;
#pragma unroll 8
        for (int sl = 0; sl < 64; ++sl) { const f32x4 v = *(const f32x4*)(src + (size_t)sl * 256); v2u w; w.x = pk2(v[0], v[1]); w.y = pk2(v[2], v[3]); *(v2u*)(dst + (size_t)sl * 64) = w; }
    }
    for (int it = gw; it < DEPTH * DB * 8; it += NGW) {
        const int ch = it & 7, ls = it >> 3;
        const float* src = A.cache_win + ((size_t)ls * 512 + 4 + ch * 64) * 256 + 4 * lane;
        float* dst = A.out + O_WINS + ((size_t)ls * 512 + ch * 64) * 256 + 4 * lane;
        const int n = ch == 7 ? 60 : 64;
        for (int i = 0; i < n; ++i) *(f32x4*)(dst + (size_t)i * 256) = *(const f32x4*)(src + (size_t)i * 256);
    }
    for (int it = gw; it < 8; it += NGW) {
        float* BT = (float*)(ws + WS_BT) + it * 132;
        for (int dd = lane; dd < 129; dd += 64) BT[dd] = A.rel_bias[rel_bucket_dev(dd) * 8 + it];
    }
    for (int it = gw; it < DEPTH * 2 * 4; it += NGW) {
        const int ls = it >> 2, h = (it & 3) * 64 + lane;
        const float* pe = A.cmp_pe + (size_t)ls * 2048; const float* w1 = A.cmp_w1 + (size_t)ls * 2048 * 256 + h;
        float acc = 0.f;
        for (int k = 0; k < 2048; ++k) acc += pe[k] * w1[(size_t)k * 256];
        ((float*)(ws + WS_B1))[ls * 256 + h] = acc;
    }
}

__device__ __forceinline__ void phase_ada(CArgs& A, LAS unsigned char* lds, int tid) {
    LAS float* a = (LAS float*)lds;
    for (int task = blockIdx.x; task < DEPTH * 12 * 10; task += gridDim.x) {
        const int rb = task % 10, cb = (task / 10) % 12, l = task / 120;
        __syncthreads();
        for (int i = tid; i < 13 * 1024; i += NTHR) { const int row = rb * 13 + i / 1024, k = i & 1023;
            const float c = row < BATCH ? A.c_prompt[row * D + k] : A.c_sample[(row - BATCH) * D + k]; a[i] = c / (1.f + __expf(-c)); }
        __syncthreads();
        const int j = cb * 512 + tid;
        const float* w = A.w_ada + (size_t)l * D * 6144 + j;
        float acc[13];
#pragma unroll
        for (int r = 0; r < 13; ++r) acc[r] = 0.f;
        for (int k = 0; k < D; ++k) { const float wv = w[(size_t)k * 6144];
#pragma unroll
            for (int r = 0; r < 13; ++r) acc[r] += a[r * 1024 + k] * wv; }
        const float bb = A.b_ada[l * 6144 + j];
        float* o = (float*)(A.ws + WS_ADA) + ((size_t)l * NCOND + rb * 13) * 6144 + j;
#pragma unroll
        for (int r = 0; r < 13; ++r) o[(size_t)r * 6144] = acc[r] + bb;
    }
}

__device__ __forceinline__ void mod_row(const float* xrow, const float* sh, const float* sc, bf16* urow, int lane) {
#pragma unroll
    for (int j = 0; j < 4; ++j) { const int c = 4 * lane + 256 * j;
        const f32x4 x = *(const f32x4*)(xrow + c), a = *(const f32x4*)(sh + c), b = *(const f32x4*)(sc + c);
        v2u w; w.x = pk2(x[0] * (1.f + b[0]) + a[0], x[1] * (1.f + b[1]) + a[1]); w.y = pk2(x[2] * (1.f + b[2]) + a[2], x[3] * (1.f + b[3]) + a[3]);
        *(v2u*)(urow + c) = w; }
}
__device__ __forceinline__ void ln_row(const float* zrow, const float* g, const float* b, float* xout, const float* sh, const float* sc, bf16* urow, int lane) {
    f32x4 v[4]; float s = 0.f;
#pragma unroll
    for (int j = 0; j < 4; ++j) { v[j] = *(const f32x4*)(zrow + 4 * lane + 256 * j); s += (v[j][0] + v[j][1]) + (v[j][2] + v[j][3]); }
    const float mean = wave_sum(s) * (1.f / D); float s2 = 0.f;
#pragma unroll
    for (int j = 0; j < 4; ++j) { v[j] = v[j] - mean; s2 += (v[j][0] * v[j][0] + v[j][1] * v[j][1]) + (v[j][2] * v[j][2] + v[j][3] * v[j][3]); }
    const float rstd = 1.f / sqrtf(wave_sum(s2) * (1.f / D) + LN_EPS);
#pragma unroll
    for (int j = 0; j < 4; ++j) { const int c = 4 * lane + 256 * j;
        const f32x4 gg = *(const f32x4*)(g + c), bb = *(const f32x4*)(b + c);
        const f32x4 x = v[j] * rstd * gg + bb;
        *(f32x4*)(xout + c) = x;
        if (urow) { const f32x4 a = *(const f32x4*)(sh + c), q = *(const f32x4*)(sc + c);
            v2u w; w.x = pk2(x[0] * (1.f + q[0]) + a[0], x[1] * (1.f + q[1]) + a[1]); w.y = pk2(x[2] * (1.f + q[2]) + a[2], x[3] * (1.f + q[3]) + a[3]);
            *(v2u*)(urow + c) = w; } }
}

__device__ __forceinline__ float scan_sum256(float v, LAS float* buf, int tid) {
    const int lane = tid & 63, w = tid >> 6;
#pragma unroll
    for (int o = 1; o < 64; o <<= 1) { const float y = __shfl_up(v, o); if (lane >= o) v += y; }
    __syncthreads();
    if (lane == 63) buf[w] = v;
    __syncthreads();
    float add = 0.f;
#pragma unroll
    for (int i = 0; i < 3; ++i) if (i < w) add += buf[i];
    return v + add;
}
__device__ __forceinline__ float scan_max256(float v, LAS float* buf, int tid) {
    const int lane = tid & 63, w = tid >> 6;
#pragma unroll
    for (int o = 1; o < 64; o <<= 1) { const float y = __shfl_up(v, o); if (lane >= o) v = fmaxf(v, y); }
    __syncthreads();
    if (lane == 63) buf[w] = v;
    __syncthreads();
#pragma unroll
    for (int i = 0; i < 3; ++i) if (i < w) v = fmaxf(v, buf[i]);
    return v;
}
__device__ __forceinline__ void ml_gates(CArgs& A, int l, int r, int h, float& ig, float& lf) {
    const float* G = (const float*)(A.ws + WS_GATE) + (size_t)r * 32;
    ig = G[h] + A.b_gate[l * 8 + h];
    const float fr = G[4 + h] + A.b_gate[l * 8 + 4 + h];
    lf = fminf(fr, 0.f) - log1pf(__expf(-fabsf(fr)));
}

__device__ __forceinline__ void phase_m2(CArgs& A, int l, LAS unsigned char* lds, int tid) {
    LAS float* buf = (LAS float*)lds;
    LAS float* wl = (LAS float*)(lds + 1024);
    const bf16* QKVO = (const bf16*)(A.ws + WS_QKVO);
    for (int unit = blockIdx.x; unit < NUNIT; unit += gridDim.x) {
        const int b = unit >> 7, h = (unit >> 5) & 3, c = unit & 31, r0 = b * SEQ + c * LCH;
        float ig = 0.f, lf = 0.f;
        if (tid < 256) ml_gates(A, l, r0 + tid, h, ig, lf);
        const float F = scan_sum256(lf, buf, tid);
        __syncthreads();
        if (tid == 255) buf[16] = F;
        __syncthreads();
        const float Fend = buf[16];
        const float gl = tid < 256 ? Fend - F + ig : -3.0e38f;
        float mw = wave_max(gl);
        if ((tid & 63) == 0) buf[20 + (tid >> 6)] = mw;
        __syncthreads();
        const float mloc = fmaxf(fmaxf(buf[20], buf[21]), fmaxf(buf[22], buf[23]));
        if (tid < 256) wl[tid] = __expf(gl - mloc);
        if (tid == 0) { float* ch = (float*)(A.ws + WS_CHS) + unit * 4; ch[0] = Fend; ch[1] = mloc; }
        __syncthreads();
        const int k = tid & 127, vq = tid >> 7;
        float acc[32]; float accn = 0.f;
#pragma unroll
        for (int i = 0; i < 32; ++i) acc[i] = 0.f;
        const bf16* kp = QKVO + (size_t)r0 * 2048 + 512 + h * HD + k;
        const bf16* vp = QKVO + (size_t)r0 * 2048 + 1024 + h * HD + 32 * vq;
        for (int s = 0; s < LCH; ++s) {
            const float wk = wl[s] * bf2f(kp[(size_t)s * 2048]);
            accn += wk;
            const v4u* v4 = (const v4u*)(vp + (size_t)s * 2048);
#pragma unroll
            for (int q = 0; q < 4; ++q) { const v4u vv = v4[q];
                acc[8 * q + 0] += wk * bflo(vv.x); acc[8 * q + 1] += wk * bfhi(vv.x); acc[8 * q + 2] += wk * bflo(vv.y); acc[8 * q + 3] += wk * bfhi(vv.y);
                acc[8 * q + 4] += wk * bflo(vv.z); acc[8 * q + 5] += wk * bfhi(vv.z); acc[8 * q + 6] += wk * bflo(vv.w); acc[8 * q + 7] += wk * bfhi(vv.w); }
        }
        float* dct = (float*)(A.ws + WS_DCT) + ((size_t)unit * HD + 32 * vq) * HD + k;
#pragma unroll
        for (int i = 0; i < 32; ++i) dct[(size_t)i * HD] = acc[i];
        if (vq == 0) ((float*)(A.ws + WS_DN))[unit * HD + k] = accn;
        __syncthreads();
    }
}

__device__ __forceinline__ void phase_m3(CArgs& A, int l, int tid) {
    for (int task = blockIdx.x; task < BATCH * NH * 33; task += gridDim.x) {
        const int bh = task / 33, part = task % 33;
        const bool isn = part == 32; if (isn && tid >= HD) continue;
        const int e = isn ? tid : part * 512 + tid;
        const float* chs = (const float*)(A.ws + WS_CHS) + (size_t)bh * NCH * 4;
        float st = 0.f, m0 = 0.f;
        for (int c = 0; c < NCH; ++c) {
            const int unit = bh * NCH + c;
            const float Fend = chs[c * 4], mloc = chs[c * 4 + 1];
            float dv;
            if (isn) { ((float*)(A.ws + WS_NPV))[unit * HD + e] = st; dv = ((const float*)(A.ws + WS_DN))[unit * HD + e]; if (tid == 0) ((float*)(A.ws + WS_CHS))[unit * 4 + 2] = m0; }
            else { ((bf16*)(A.ws + WS_CTP))[(size_t)unit * HD * HD + e] = (bf16)f2bf(st); dv = ((const float*)(A.ws + WS_DCT))[(size_t)unit * HD * HD + e]; }
            const float mend = fmaxf(m0 + Fend, mloc);
            st = __expf(m0 + Fend - mend) * st + __expf(mloc - mend) * dv;
            m0 = mend;
        }
        if (isn) { A.out[O_NP + ((size_t)l * BATCH * NH + bh) * HD + e] = st; if (tid == 0) A.out[O_MP + l * BATCH * NH + bh] = m0; }
        else { const int v = e >> 7, k = e & 127; A.out[O_CP + (((size_t)l * BATCH * NH + bh) * HD + k) * HD + v] = st; }
    }
}

__device__ __forceinline__ void phase_m4(CArgs& A, int l, LAS unsigned char* lds, int tid) {
    LAS float* buf = (LAS float*)lds;
    LAS float* sa = (LAS float*)(lds + 1024);
    LAS float* smx = sa + 256;
    LAS float* sdec = smx + 256;
    LAS float* sem = sdec + 256;
    LAS bf16* sv = (LAS bf16*)(lds + 8192);
    const bf16* QKVO = (const bf16*)(A.ws + WS_QKVO);
    const int lane = tid & 63, wave = tid >> 6;
    for (int unit = blockIdx.x; unit < NUNIT; unit += gridDim.x) {
        const int b = unit >> 7, h = (unit >> 5) & 3, c = unit & 31, r0 = b * SEQ + c * LCH;
        float ig = 0.f, lf = 0.f;
        if (tid < 256) ml_gates(A, l, r0 + tid, h, ig, lf);
        const float F = scan_sum256(lf, buf, tid);
        const float a = tid < 256 ? ig - F : -3.0e38f;
        const float cm = scan_max256(a, buf, tid);
        const float m0 = ((const float*)(A.ws + WS_CHS))[unit * 4 + 2];
        if (tid < 256) { const float mx = fmaxf(m0, cm); sa[tid] = a; smx[tid] = mx; sdec[tid] = __expf(m0 - mx); sem[tid] = __expf(-(F + mx)); }
        for (int i = tid; i < LCH * HD / 8; i += NTHR) { const int s = i >> 4, q = i & 15;
            *(LAS v4u*)(sv + s * HD + 8 * q) = *(const v4u*)(QKVO + (size_t)(r0 + s) * 2048 + 1024 + h * HD + 8 * q); }
        __syncthreads();
        float* W = (float*)(A.ws + WS_WSC) + (size_t)unit * LCH * LCH;
        for (int idx = tid; idx < LCH * LCH; idx += NTHR) {
            const int t = idx >> 8, s = idx & 255; float w = 0.f;
            if (s <= t) {
                const v4u* qp = (const v4u*)(QKVO + (size_t)(r0 + t) * 2048 + h * HD); const v4u* kp = (const v4u*)(QKVO + (size_t)(r0 + s) * 2048 + 512 + h * HD);
                float d = 0.f;
#pragma unroll 4
                for (int q = 0; q < 16; ++q) { const v4u x = qp[q], y = kp[q];
                    d += bflo(x.x) * bflo(y.x) + bfhi(x.x) * bfhi(y.x) + bflo(x.y) * bflo(y.y) + bfhi(x.y) * bfhi(y.y)
                       + bflo(x.z) * bflo(y.z) + bfhi(x.z) * bfhi(y.z) + bflo(x.w) * bflo(y.w) + bfhi(x.w) * bfhi(y.w); }
                w = d * __expf(sa[s] - smx[t]);
            }
            W[idx] = w;
        }
        __syncthreads();
        {
            const int v = tid & 127, tq = tid >> 7;
            const bf16* ctp = (const bf16*)(A.ws + WS_CTP) + ((size_t)unit * HD + v) * HD;
            const float* npv = (const float*)(A.ws + WS_NPV) + unit * HD;
            float* hraw = (float*)(A.ws + WS_HRAW) + (size_t)unit * LCH * HD;
            for (int i = 0; i < 64; ++i) {
                const int t = 4 * i + tq;
                float num = 0.f, den = 0.f;
                const float* wr = W + (size_t)t * LCH;
                for (int s = 0; s <= t; s += 4) { const f32x4 w4 = *(const f32x4*)(wr + s);
                    num += w4[0] * bf2f(sv[(s + 0) * HD + v]) + w4[1] * bf2f(sv[(s + 1) * HD + v]) + w4[2] * bf2f(sv[(s + 2) * HD + v]) + w4[3] * bf2f(sv[(s + 3) * HD + v]);
                    den += (w4[0] + w4[1]) + (w4[2] + w4[3]); }
                float qc = 0.f, qn = 0.f;
                const v4u* qp = (const v4u*)(QKVO + (size_t)(r0 + t) * 2048 + h * HD);
#pragma unroll 4
                for (int q = 0; q < 16; ++q) { const v4u x = qp[q], y = *(const v4u*)(ctp + 8 * q); const f32x4 n0 = *(const f32x4*)(npv + 8 * q), n1 = *(const f32x4*)(npv + 8 * q + 4);
                    qc += bflo(x.x) * bflo(y.x) + bfhi(x.x) * bfhi(y.x) + bflo(x.y) * bflo(y.y) + bfhi(x.y) * bfhi(y.y)
                        + bflo(x.z) * bflo(y.z) + bfhi(x.z) * bfhi(y.z) + bflo(x.w) * bflo(y.w) + bfhi(x.w) * bfhi(y.w);
                    qn += bflo(x.x) * n0[0] + bfhi(x.x) * n0[1] + bflo(x.y) * n0[2] + bfhi(x.y) * n0[3] + bflo(x.z) * n1[0] + bfhi(x.z) * n1[1] + bflo(x.w) * n1[2] + bfhi(x.w) * n1[3]; }
                const float dec = sdec[t];
                const float numt = num + dec * qc, dent = den + dec * qn;
                hraw[(size_t)t * HD + v] = numt / fmaxf(fabsf(dent), sem[t]);
            }
        }
        __syncthreads();
        {
            const float* hraw = (const float*)(A.ws + WS_HRAW) + (size_t)unit * LCH * HD;
            const float g0 = A.ml_norm_g[l * 512 + h * HD + lane], g1 = A.ml_norm_g[l * 512 + h * HD + 64 + lane];
            for (int t = wave; t < LCH; t += NWAVES) {
                const float x0 = hraw[(size_t)t * HD + lane], x1 = hraw[(size_t)t * HD + 64 + lane];
                const float mu = wave_sum(x0 + x1) * (1.f / HD);
                const float d0 = x0 - mu, d1 = x1 - mu;
                const float rstd = 1.f / sqrtf(wave_sum(d0 * d0 + d1 * d1) * (1.f / HD) + LN_EPS);
                const bf16* op = QKVO + (size_t)(r0 + t) * 2048 + 1536 + h * HD;
                bf16* mp = (bf16*)(A.ws + WS_MIX) + (size_t)(r0 + t) * D + h * HD;
                mp[lane] = (bf16)f2bf(d0 * rstd * g0 * sigmoidf_(bf2f(op[lane])));
                mp[64 + lane] = (bf16)f2bf(d1 * rstd * g1 * sigmoidf_(bf2f(op[64 + lane])));
            }
        }
        __syncthreads();
    }
}

__device__ __forceinline__ void phase_mls(CArgs& A, int l, LAS unsigned char* lds, int tid) {
    LAS float* sq = (LAS float*)lds;
    LAS float* sc = sq + 1536;
    LAS float* sw = sc + 64;
    LAS float* part = sw + 16;
    LAS float* red = part + 2048;
    const bf16* QKVO = (const bf16*)(A.ws + WS_QKVO);
    for (int task = blockIdx.x; task < DB * NH; task += gridDim.x) {
        const int seq = task >> 2, h = task & 3, r0 = MP + seq * DS, sidx = (l * DB + seq) * NH + h;
        __syncthreads();
        for (int i = tid; i < 1536; i += NTHR) { const int which = i >> 9, t = (i >> 7) & 3, d = i & 127; sq[i] = bf2f(QKVO[(size_t)(r0 + t) * 2048 + which * 512 + h * HD + d]); }
        const float m0 = A.st_m[sidx];
        if (tid == 0) {
            float F = 0.f, cmx = -3.0e38f, Fs[4], igs[4], mlast = 0.f;
#pragma unroll
            for (int t = 0; t < 4; ++t) { float ig, lf; ml_gates(A, l, r0 + t, h, ig, lf); F += lf; Fs[t] = F; igs[t] = ig; const float a = ig - F; cmx = fmaxf(cmx, a); const float mx = fmaxf(m0, cmx);
                sc[8 + t] = a; sc[12 + t] = mx; sc[16 + t] = __expf(m0 - mx); sc[20 + t] = __expf(-(F + mx)); mlast = F + mx; }
#pragma unroll
            for (int t = 0; t < 4; ++t) sc[24 + t] = __expf(Fs[3] - Fs[t] + igs[t] - mlast);
            sc[28] = __expf(Fs[3] + m0 - mlast); sc[29] = mlast;
        }
        __syncthreads();
        if (tid < 16) { const int t = tid >> 2, s = tid & 3; float w = 0.f;
            if (s <= t) { float d = 0.f; for (int k = 0; k < HD; ++k) d += sq[t * HD + k] * sq[512 + s * HD + k]; w = d * __expf(sc[8 + s] - sc[12 + t]); }
            sw[tid] = w; }
        else if (tid < 20) { const int t = tid - 16; const float* n0 = A.st_n + (size_t)sidx * HD; float d = 0.f; for (int k = 0; k < HD; ++k) d += sq[t * HD + k] * n0[k]; sc[32 + t] = d; }
        __syncthreads();
        {
            const int v = tid & 127, kq = tid >> 7;
            const float* C0 = A.st_C + (size_t)sidx * HD * HD; float* Co = A.out + O_CS + (size_t)sidx * HD * HD;
            const float cd = sc[28];
            float wv[4]; float qc[4] = {0.f, 0.f, 0.f, 0.f};
#pragma unroll
            for (int t = 0; t < 4; ++t) wv[t] = sc[24 + t] * sq[1024 + t * HD + v];
            for (int kk = 0; kk < 32; ++kk) { const int k = kq * 32 + kk; const float c0 = C0[(size_t)k * HD + v];
                float cn = cd * c0;
#pragma unroll
                for (int t = 0; t < 4; ++t) { qc[t] += sq[t * HD + k] * c0; cn += wv[t] * sq[512 + t * HD + k]; }
                Co[(size_t)k * HD + v] = cn; }
#pragma unroll
            for (int t = 0; t < 4; ++t) part[(kq * 4 + t) * HD + v] = qc[t];
        }
        __syncthreads();
        float hv[4] = {0.f, 0.f, 0.f, 0.f};
        if (tid < HD) {
            const int v = tid;
#pragma unroll
            for (int t = 0; t < 4; ++t) { const float qct = part[(0 * 4 + t) * HD + v] + part[(1 * 4 + t) * HD + v] + part[(2 * 4 + t) * HD + v] + part[(3 * 4 + t) * HD + v];
                float num = sc[16 + t] * qct, den = sc[16 + t] * sc[32 + t];
#pragma unroll
                for (int s = 0; s < 4; ++s) { num += sw[t * 4 + s] * sq[1024 + s * HD + v]; den += sw[t * 4 + s]; }
                hv[t] = num / fmaxf(fabsf(den), sc[20 + t]); }
        }
#pragma unroll
        for (int t = 0; t < 4; ++t) { const float s1 = wave_sum(hv[t]); if ((tid & 63) == 0 && tid < HD) red[t * 2 + (tid >> 6)] = s1; }
        __syncthreads();
        float dv[4];
#pragma unroll
        for (int t = 0; t < 4; ++t) { dv[t] = hv[t] - (red[t * 2] + red[t * 2 + 1]) * (1.f / HD); const float s2 = wave_sum(dv[t] * dv[t]); if ((tid & 63) == 0 && tid < HD) red[8 + t * 2 + (tid >> 6)] = s2; }
        __syncthreads();
        if (tid < HD) {
            const int v = tid; const float gn = A.ml_norm_g[l * 512 + h * HD + v];
#pragma unroll
            for (int t = 0; t < 4; ++t) { const float rstd = 1.f / sqrtf((red[8 + t * 2] + red[8 + t * 2 + 1]) * (1.f / HD) + LN_EPS);
                const float og = bf2f(QKVO[(size_t)(r0 + t) * 2048 + 1536 + h * HD + v]);
                ((bf16*)(A.ws + WS_MIX))[(size_t)(r0 + t) * D + h * HD + v] = (bf16)f2bf(dv[t] * rstd * gn * sigmoidf_(og)); }
        } else if (tid < 2 * HD) {
            const int k = tid - HD; float nn = sc[28] * A.st_n[(size_t)sidx * HD + k];
#pragma unroll
            for (int t = 0; t < 4; ++t) nn += sc[24 + t] * sq[512 + t * HD + k];
            A.out[O_NS + (size_t)sidx * HD + k] = nn;
        }
        if (tid == 0) A.out[O_MS + sidx] = sc[29];
    }
}

__device__ __forceinline__ void phase_cmp2(CArgs& A, int l0, int nl, int r_lo, int nrows, int tid) {
    const int d = tid & 63, rr = tid >> 6, ntask_img = nrows / 8;
    for (int task = blockIdx.x; task < nl * 4 * ntask_img; task += gridDim.x) {
        const int img = task / ntask_img, tr = task % ntask_img, l = l0 + (img >> 2), sg = img & 3, s = sg >> 1;
        const size_t row = (size_t)(l * 4 + sg) * NCB + r_lo + tr * 8 + rr;
        const v4u* hp = (const v4u*)((const bf16*)(A.ws + WS_HID) + row * 256);
        const float* w2 = A.cmp_w2 + (size_t)(l * 2 + s) * 256 * 64 + d;
        float acc = 0.f;
#pragma unroll 4
        for (int q = 0; q < 32; ++q) { const v4u x = hp[q]; const float* w = w2 + (size_t)q * 8 * 64;
            acc += bflo(x.x) * w[0] + bfhi(x.x) * w[64] + bflo(x.y) * w[128] + bfhi(x.y) * w[192] + bflo(x.z) * w[256] + bfhi(x.z) * w[320] + bflo(x.w) * w[384] + bfhi(x.w) * w[448]; }
        ((float*)(A.ws + WS_CKV))[row * 64 + d] = acc;
    }
}

#define NEGBIG (-3.0e38f)
template <int NB, class KF>
__device__ __forceinline__ void attend(const KF& kf, int nblk, const LAS float* qs, LAS float* pb, const float* BT, int hbase, int lane, float (&o)[4]) {
    float s[NB][4]; float mx[4] = {NEGBIG, NEGBIG, NEGBIG, NEGBIG};
#pragma unroll
    for (int it = 0; it < NB; ++it) {
        if (it < nblk) {
            const int p = kf.key(it, lane); const bool ok = kf.ok(p); const int pc = kf.clampk(p);
            const float* kr = kf.krow(pc);
            float d0 = 0.f, d1 = 0.f, d2 = 0.f, d3 = 0.f;
#pragma unroll 4
            for (int dd = 0; dd < 64; dd += 4) { const f32x4 k4 = *(const f32x4*)(kr + dd);
                const f32x4 q0 = *(const LAS f32x4*)(qs + dd), q1 = *(const LAS f32x4*)(qs + 64 + dd), q2 = *(const LAS f32x4*)(qs + 128 + dd), q3 = *(const LAS f32x4*)(qs + 192 + dd);
                d0 += k4[0] * q0[0] + k4[1] * q0[1] + k4[2] * q0[2] + k4[3] * q0[3]; d1 += k4[0] * q1[0] + k4[1] * q1[1] + k4[2] * q1[2] + k4[3] * q1[3];
                d2 += k4[0] * q2[0] + k4[1] * q2[1] + k4[2] * q2[2] + k4[3] * q2[3]; d3 += k4[0] * q3[0] + k4[1] * q3[1] + k4[2] * q3[2] + k4[3] * q3[3]; }
            int dist = kf.dist(pc); dist = dist < 0 ? 0 : (dist > 128 ? 128 : dist);
            const float* bt = BT + hbase * 132 + dist;
            s[it][0] = ok ? d0 + bt[0] : NEGBIG; s[it][1] = ok ? d1 + bt[132] : NEGBIG; s[it][2] = ok ? d2 + bt[264] : NEGBIG; s[it][3] = ok ? d3 + bt[396] : NEGBIG;
#pragma unroll
            for (int r = 0; r < 4; ++r) mx[r] = fmaxf(mx[r], s[it][r]);
        } else {
#pragma unroll
            for (int r = 0; r < 4; ++r) s[it][r] = NEGBIG;
        }
    }
    float sum[4], inv[4];
#pragma unroll
    for (int r = 0; r < 4; ++r) { mx[r] = wave_max(mx[r]); sum[r] = 0.f; }
#pragma unroll
    for (int it = 0; it < NB; ++it)
#pragma unroll
        for (int r = 0; r < 4; ++r) { const float e = s[it][r] > -1.0e37f ? __expf(s[it][r] - mx[r]) : 0.f; s[it][r] = e; sum[r] += e; }
#pragma unroll
    for (int r = 0; r < 4; ++r) { sum[r] = wave_sum(sum[r]); inv[r] = sum[r] > 0.f ? 1.f / sum[r] : 0.f; }
#pragma unroll
    for (int it = 0; it < NB; ++it) {
        if (it < nblk) {
            f32x4 p4; p4[0] = s[it][0] * inv[0]; p4[1] = s[it][1] * inv[1]; p4[2] = s[it][2] * inv[2]; p4[3] = s[it][3] * inv[3];
            asm volatile("" ::: "memory");
            *(LAS f32x4*)(pb + 4 * lane) = p4;
            kf.emit(it, lane, p4);
            LDS_WAIT();
            const int nk = kf.nkeys(it);
            for (int kk = 0; kk < nk; ++kk) {
                const float v = kf.vrow(it, kk)[lane];
                const f32x4 w = *(const LAS f32x4*)(pb + 4 * kk);
                o[0] += w[0] * v; o[1] += w[1] * v; o[2] += w[2] * v; o[3] += w[3] * v;
            }
            LDS_WAIT();
        }
    }
}

struct SeqCtx { bool smp; int bs; int qpos; int l; int g; CArgs* A; };

struct KfCmp {
    const float* CK; const float* CV; int ncv, qpos; LAS float* ps;
    __device__ __forceinline__ int key(int it, int lane) const { return 64 * it + lane; }
    __device__ __forceinline__ bool ok(int n) const { return n < ncv; }
    __device__ __forceinline__ int clampk(int n) const { return n < ncv ? n : ncv - 1; }
    __device__ __forceinline__ const float* krow(int n) const { return CK + (size_t)n * 64; }
    __device__ __forceinline__ int dist(int n) const { return qpos - 16 * n - 31; }
    __device__ __forceinline__ void emit(int it, int lane, const f32x4& p) const { ps[64 * it + lane] = (p[0] + p[1]) + (p[2] + p[3]); }
    __device__ __forceinline__ int nkeys(int it) const { const int r = ncv - 64 * it; return r < 64 ? r : 64; }
    __device__ __forceinline__ const float* vrow(int it, int kk) const { return CV + (size_t)(64 * it + kk) * 64; }
};
struct KfSel {
    SeqCtx c; const float* kvr; int j[16];
    __device__ __forceinline__ const float* row(int p) const {
        if (!c.smp) return kvr + ((size_t)(c.bs * SEQ + p)) * 256 + c.g * 64;
        if (p >= PAST) return kvr + ((size_t)(MP + c.bs * DS + p - PAST)) * 256 + c.g * 64;
        return c.A->cache_slc + (((size_t)c.l * NPHYS + c.A->page_table[c.bs * NPG + (p >> 7)]) * PAGE + (p & 127)) * 256 + c.g * 64;
    }
    __device__ __forceinline__ int key(int it, int lane) const { return 64 * j[it] + lane; }
    __device__ __forceinline__ int nkeys(int it) const { const int r = c.qpos - 64 * j[it] + 1; return r < 64 ? (r > 0 ? r : 0) : 64; }
    __device__ __forceinline__ const float* vrow(int it, int kk) const { return row(64 * j[it] + kk) + 128; }
    __device__ __forceinline__ bool ok(int p) const { return p <= c.qpos; }
    __device__ __forceinline__ int clampk(int p) const { return p <= c.qpos ? p : c.qpos; }
    __device__ __forceinline__ const float* krow(int p) const { return row(p); }
    __device__ __forceinline__ int dist(int p) const { return c.qpos - p; }
    __device__ __forceinline__ void emit(int, int, const f32x4&) const {}
};
struct KfWin {
    SeqCtx c; const float* kvr; int lo;
    __device__ __forceinline__ const float* row(int p) const {
        if (!c.smp) return kvr + ((size_t)(c.bs * SEQ + p)) * 256 + c.g * 64;
        if (p >= PAST) return kvr + ((size_t)(MP + c.bs * DS + p - PAST)) * 256 + c.g * 64;
        return c.A->cache_win + (((size_t)c.l * DB + c.bs) * 512 + (p - (PAST - 512))) * 256 + c.g * 64;
    }
    __device__ __forceinline__ int key(int it, int lane) const { return c.qpos - 511 + 64 * it + lane; }
    __device__ __forceinline__ bool ok(int p) const { return p >= lo; }
    __device__ __forceinline__ int clampk(int p) const { return p >= lo ? p : lo; }
    __device__ __forceinline__ const float* krow(int p) const { return row(p); }
    __device__ __forceinline__ int dist(int p) const { return c.qpos - p; }
    __device__ __forceinline__ void emit(int, int, const f32x4&) const {}
    __device__ __forceinline__ int nkeys(int) const { return 64; }
    __device__ __forceinline__ const float* vrow(int it, int kk) const { const int p = c.qpos - 511 + 64 * it + kk; return row(p >= lo ? p : lo) + 128; }
};

__device__ __forceinline__ void topk_sel(float imp0, float imp1, int cur, int lane, unsigned long long& s0, unsigned long long& s1) {
    const int nforced = cur == 0 ? 1 : (cur == 1 ? 2 : 3), need = 16 - nforced, ncand = cur - 2 > 0 ? cur - 2 : 0;
    const unsigned k0 = (lane >= 1 && lane <= cur - 2) ? __builtin_bit_cast(unsigned, imp0) + 1u : 0u;
    const unsigned k1 = (lane + 64 <= cur - 2) ? __builtin_bit_cast(unsigned, imp1) + 1u : 0u;
    unsigned long long c0, c1;
    if (ncand <= need) { c0 = __ballot(k0 != 0u); c1 = __ballot(k1 != 0u); }
    else {
        unsigned T = 0u;
        for (int bit = 31; bit >= 0; --bit) { const unsigned cand = T | (1u << bit);
            const int cnt = __popcll(__ballot(k0 >= cand)) + __popcll(__ballot(k1 >= cand)); if (cnt >= need) T = cand; }
        const unsigned long long g0 = __ballot(k0 > T), g1 = __ballot(k1 > T); unsigned long long e0 = __ballot(k0 == T), e1 = __ballot(k1 == T);
        int rem = need - __popcll(g0) - __popcll(g1);
        unsigned long long t0 = 0ull, t1 = 0ull;
        while (rem > 0 && e0) { const unsigned long long lb = e0 & (~e0 + 1ull); t0 |= lb; e0 ^= lb; --rem; }
        while (rem > 0 && e1) { const unsigned long long lb = e1 & (~e1 + 1ull); t1 |= lb; e1 ^= lb; --rem; }
        c0 = g0 | t0; c1 = g1 | t1;
    }
    unsigned long long f0 = 1ull, f1 = 0ull;
    if (cur < 64) f0 |= 1ull << cur; else f1 |= 1ull << (cur - 64);
    if (cur >= 1) { if (cur - 1 < 64) f0 |= 1ull << (cur - 1); else f1 |= 1ull << (cur - 65); }
    s0 = c0 | f0; s1 = c1 | f1;
}

__device__ __forceinline__ void nsa_wave(CArgs& A, int l, int r, int g, LAS float* wl, int lane) {
    LAS float* qs = wl;
    LAS float* pb = wl + 256;
    LAS float* ps = wl + 512;
    const bool smp = r >= MP; const int bs = smp ? (r - MP) >> 2 : r >> 13; const int qpos = smp ? PAST + ((r - MP) & 3) : (r & (SEQ - 1));
    const float* BT = (const float*)(A.ws + WS_BT);
    const float* KVR = (const float*)(A.ws + WS_KVR);
    {   const bf16* qp = (const bf16*)(A.ws + WS_NQ) + (size_t)r * 512 + g * 256;
#pragma unroll
        for (int i = 0; i < 4; ++i) qs[64 * i + lane] = bf2f(qp[64 * i + lane]); }
    for (int i = lane; i < 520; i += 64) ps[i] = 0.f;
    LDS_WAIT();
    SeqCtx cx{smp, bs, qpos, l, g, &A};
    float out[4] = {0.f, 0.f, 0.f, 0.f};
    const float* gt = (const float*)(A.ws + WS_GATE) + (size_t)r * 32 + 8 + g * 12;
    {
        const int ncv = qpos >= 31 ? ((qpos - 31) >> 4) + 1 : 0;
        const int gc0 = smp ? 1024 + bs * 128 : bs * 512;
        if (ncv > 0) {
            KfCmp kf{(const float*)(A.ws + WS_CKV) + ((size_t)((l * 2 + 0) * 2 + g) * NCB + gc0) * 64, (const float*)(A.ws + WS_CKV) + ((size_t)((l * 2 + 1) * 2 + g) * NCB + gc0) * 64, ncv, qpos, ps};
            float o[4] = {0.f, 0.f, 0.f, 0.f};
            attend<8, KfCmp>(kf, (ncv + 63) >> 6, qs, pb, BT, g * 4, lane, o);
#pragma unroll
            for (int rr = 0; rr < 4; ++rr) out[rr] += sigmoidf_(gt[rr * 3 + 0]) * o[rr];
        }
    }
    LDS_WAIT();
    unsigned long long s0, s1;
    {
        float imp0 = 0.f, imp1 = 0.f;
#pragma unroll
        for (int i = -1; i < 4; ++i) { const int n0 = 4 * lane + i, n1 = 4 * (lane + 64) + i; if (n0 >= 0) imp0 += ps[n0]; imp1 += ps[n1]; }
        topk_sel(imp0, imp1, qpos >> 6, lane, s0, s1);
    }
    {
        KfSel kf; kf.c = cx; kf.kvr = KVR + (size_t)1 * M * 256;
        int nb = 0; unsigned long long m0 = s0, m1 = s1;
#pragma unroll
        for (int it = 0; it < 16; ++it) {
            if (m0) { kf.j[it] = __builtin_ctzll(m0); m0 &= m0 - 1ull; ++nb; }
            else if (m1) { kf.j[it] = 64 + __builtin_ctzll(m1); m1 &= m1 - 1ull; ++nb; }
            else kf.j[it] = 0;
        }
        float o[4] = {0.f, 0.f, 0.f, 0.f};
        attend<16, KfSel>(kf, nb, qs, pb, BT, g * 4, lane, o);
#pragma unroll
        for (int rr = 0; rr < 4; ++rr) out[rr] += sigmoidf_(gt[rr * 3 + 1]) * o[rr];
    }
    {
        KfWin kf{cx, KVR + (size_t)2 * M * 256, smp ? PAST - 512 : 0};
        float o[4] = {0.f, 0.f, 0.f, 0.f};
        attend<8, KfWin>(kf, 8, qs, pb, BT, g * 4, lane, o);
#pragma unroll
        for (int rr = 0; rr < 4; ++rr) out[rr] += sigmoidf_(gt[rr * 3 + 2]) * o[rr];
    }
    bf16* mp = (bf16*)(A.ws + WS_MIX) + (size_t)r * D + 512 + g * 256 + lane;
#pragma unroll
    for (int rr = 0; rr < 4; ++rr) mp[rr * 64] = (bf16)f2bf(out[rr]);
}

constexpr int PH_PER_LAYER = 9, PH_L0 = 3, N_PHASES = PH_L0 + DEPTH * PH_PER_LAYER;
#ifndef MK_PER_PHASE
#define MK_PER_PHASE 1
#endif

__device__ __forceinline__ CArgs* kargs() { unsigned long long p = (unsigned long long)__builtin_amdgcn_kernarg_segment_ptr(); asm volatile("" : "+s"(p)); return (CArgs*)p; }
#define A (*kargs())
#define IN(k) (lo <= (k) && (k) < hi)
#define SEAM(k) do { if (IN(k) && IN((k) + 1)) xcd_barrier(bar); } while (0)
template <int l>
__device__ __forceinline__ void layer_phases(LAS unsigned char* lds, const XcdBarrier& bar, int tid, int lane, int wave, int G, int gw, int NGW, int lo, int hi) {
    unsigned char* ws = A.ws;
    float* const ADA = (float*)(ws + WS_ADA);
    float* const X = (float*)(ws + WS_X);
    float* const Z = (float*)(ws + WS_Z);
    bf16* const U = (bf16*)(ws + WS_U);
        const int pb_ = PH_L0 + l * PH_PER_LAYER;
        const float* adal = ADA + (size_t)l * NCOND * 6144;
        const float* xa = l == 0 ? A.x_prompt : X; const float* xb = l == 0 ? A.x_sample : X + (size_t)MP * D;
        if (IN(pb_ + 0)) {
            {
                pg8::Gemm g{U, (const bf16*)(ws + WS_WIN) + (size_t)l * NINP * D, D, D, D};
                pg8::StaticOrder S; S.init(M, NINP, G, (int)blockIdx.x);
                EpiInProj E{(bf16*)(ws + WS_QKVO), (bf16*)(ws + WS_NQ), (float*)(ws + WS_GATE), (float*)(ws + WS_KVR), (bf16*)(ws + WS_XC) + (size_t)l * 4 * XCP * 64, A.out, l};
                pg8::gemm_phase<EpiInProj, pg8::StaticOrder, true, true>(lds, g, S, E);
            }
            if (l == 0) {
                __syncthreads();
                pg8::Gemm g{(const bf16*)(ws + WS_XC), (const bf16*)(ws + WS_W1), 2048, 1024, 2048};
                CmpOrder S{G, (int)blockIdx.x, 0, DEPTH, 4, 64};
                EpiCmpHid E{(bf16*)(ws + WS_HID), (const float*)(ws + WS_B1)};
                pg8::gemm_phase<EpiCmpHid, CmpOrder, true, true>(lds, g, S, E);
            }
        }
        SEAM(pb_ + 0);
        if (IN(pb_ + 1)) {
            {
                pg8::Gemm g{(const bf16*)(ws + WS_XC), (const bf16*)(ws + WS_W1), 2048, 1024, 2048};
                CmpOrder S{G, (int)blockIdx.x, l, 1, 0, 4};
                EpiCmpHid E{(bf16*)(ws + WS_HID), (const float*)(ws + WS_B1)};
                pg8::gemm_phase<EpiCmpHid, CmpOrder, true, true>(lds, g, S, E);
            }
            __syncthreads();
            phase_m2(A, l, lds, tid);
            if (l == 0) phase_cmp2(A, 0, DEPTH, 1024, NCB - 1024, tid);
        }
        SEAM(pb_ + 1);
        if (IN(pb_ + 2)) {
            phase_m3(A, l, tid);
            phase_cmp2(A, l, 1, 0, 1024, tid);
        }
        SEAM(pb_ + 2);
        if (IN(pb_ + 3)) {
            phase_m4(A, l, lds, tid);
            __syncthreads();
            phase_mls(A, l, lds, tid);
            __syncthreads();
            LAS float* wl = (LAS float*)(lds + wave * 8192);
            for (int t = gw; t < M * 2; t += NGW) nsa_wave(A, l, t >> 1, t & 1, wl, lane);
        }
        SEAM(pb_ + 3);
        if (IN(pb_ + 4)) {
            pg8::Gemm g{(const bf16*)(ws + WS_MIX), (const bf16*)(ws + WS_WOUT) + (size_t)l * D * D, D, D, D};
            pg8::StaticOrder S; S.init(M, D, G, (int)blockIdx.x);
            EpiResid E{xa, xb, adal + 2048, Z};
            pg8::gemm_phase<EpiResid, pg8::StaticOrder, true, true>(lds, g, S, E);
        }
        SEAM(pb_ + 4);
        if (IN(pb_ + 5)) {
            for (int r = gw; r < M; r += NGW) {
                const float* ad = adal + (size_t)cond_of_row(r) * 6144;
                ln_row(Z + (size_t)r * D, A.ln_g + (size_t)(l * 2 + 0) * D, A.ln_b + (size_t)(l * 2 + 0) * D, X + (size_t)r * D, ad + 3072, ad + 4096, U + (size_t)r * D, lane);
            }
        }
        SEAM(pb_ + 5);
        if (IN(pb_ + 6)) {
            pg8::Gemm g{U, (const bf16*)(ws + WS_WUP) + (size_t)l * FF * D, D, D, D};
            pg8::StaticOrder S; S.init(M, FF, G, (int)blockIdx.x);
            EpiRelu2 E{(bf16*)(ws + WS_H)};
            pg8::gemm_phase<EpiRelu2, pg8::StaticOrder, true, true>(lds, g, S, E);
        }
        SEAM(pb_ + 6);
        if (IN(pb_ + 7)) {
            pg8::Gemm g{(const bf16*)(ws + WS_H), (const bf16*)(ws + WS_WDN) + (size_t)l * D * FF, FF, FF, FF};
            pg8::StaticOrder S; S.init(M, D, G, (int)blockIdx.x);
            EpiResid E{X, X + (size_t)MP * D, adal + 5120, Z};
            pg8::gemm_phase<EpiResid, pg8::StaticOrder, true, true>(lds, g, S, E);
        }
        SEAM(pb_ + 7);
        if (IN(pb_ + 8)) {
            const bool last = l == DEPTH - 1;
            for (int r = gw; r < M; r += NGW) {
                const float* ad = adal + (size_t)NCOND * 6144 + (size_t)cond_of_row(r) * 6144;
                float* xo = last ? (r < MP ? A.out + O_YP + (size_t)r * D : A.out + O_YS + (size_t)(r - MP) * D) : X + (size_t)r * D;
                ln_row(Z + (size_t)r * D, A.ln_g + (size_t)(l * 2 + 1) * D, A.ln_b + (size_t)(l * 2 + 1) * D, xo, ad, ad + 1024, last ? (bf16*)nullptr : U + (size_t)r * D, lane);
            }
        }
        SEAM(pb_ + 8);
    }
__global__ void __launch_bounds__(NTHR, 2) fwd_kernel(Args A_unused) {
    extern __shared__ __attribute__((aligned(16))) unsigned char lds_raw[];
    LAS unsigned char* lds = (LAS unsigned char*)lds_raw;
    const int tid = threadIdx.x, lane = tid & 63, wave = __builtin_amdgcn_readfirstlane(tid >> 6);
    const int G = gridDim.x, gw = blockIdx.x * NWAVES + wave, NGW = G * NWAVES;
    unsigned char* ws = A.ws;
    for (int u = tid; u < (LDS_BYTES - LDSCTL_OFF) / 4; u += NTHR) ((LAS unsigned*)(lds + LDSCTL_OFF))[u] = 0u;
    __syncthreads();
    XcdBarrier bar; bar.bar = (unsigned*)(ws + WS_CTL) + CW_BAR; bar.x = 0; bar.st = nullptr;
    if (!MK_PER_PHASE) bar = xcd_barrier_post((unsigned*)(ws + WS_CTL) + CW_BAR, (volatile LAS unsigned*)(lds + MISC_OFF) + 8);
    const int lo = A.ph_lo, hi = A.ph_hi;

    float* const ADA = (float*)(ws + WS_ADA);
    float* const X = (float*)(ws + WS_X);
    float* const Z = (float*)(ws + WS_Z);
    bf16* const U = (bf16*)(ws + WS_U);

    if (IN(0)) { phase_p0a(A, lds, gw, NGW, lane, wave); }
    SEAM(0);
    if (IN(1)) { phase_ada(A, lds, tid); }
    SEAM(1);
    if (IN(2)) {
        for (int r = gw; r < M; r += NGW) {
            const float* ad = ADA + (size_t)cond_of_row(r) * 6144;
            mod_row(r < MP ? A.x_prompt + (size_t)r * D : A.x_sample + (size_t)(r - MP) * D, ad, ad + 1024, U + (size_t)r * D, lane);
        }
    }
    SEAM(2);

    layer_phases<0>(lds, bar, tid, lane, wave, G, gw, NGW, lo, hi);
    layer_phases<1>(lds, bar, tid, lane, wave, G, gw, NGW, lo, hi);
    static_assert(DEPTH == 2, "two layers");
#undef IN
#undef SEAM
#undef A
}

extern "C" void kernel_launch(void* const* d_in, const int* in_sizes, int n_in, void* d_out, int out_size, void* d_ws, size_t ws_size, hipStream_t stream) {
    static int grid = 0;
    if (grid == 0) {
        if (n_in != 25 || (size_t)out_size != O_END || ws_size < WS_END) { fprintf(stderr, "kernel_launch: unexpected shapes: n_in %d out %d (want %zu) ws %zu (want >= %zu)\n", n_in, out_size, (size_t)O_END, ws_size, (size_t)WS_END); grid = -1; return; }
        int dev = 0, cus = 0, per_cu = 0;
        if (hipGetDevice(&dev) != hipSuccess || hipDeviceGetAttribute(&cus, hipDeviceAttributeMultiprocessorCount, dev) != hipSuccess) { grid = -1; return; }
        if (hipFuncSetAttribute((const void*)fwd_kernel, hipFuncAttributeMaxDynamicSharedMemorySize, LDS_BYTES) != hipSuccess) { fprintf(stderr, "kernel_launch: hipFuncSetAttribute failed\n"); grid = -1; return; }
        if (hipOccupancyMaxActiveBlocksPerMultiprocessor(&per_cu, (const void*)fwd_kernel, NTHR, LDS_BYTES) != hipSuccess || per_cu < 1) fprintf(stderr, "kernel_launch: occupancy query reports %d blocks per CU\n", per_cu);
        (void)hipGetLastError();
        grid = cus;
    }
    if (grid < 0) return;
    (void)hipMemsetAsync((char*)d_ws + WS_CTL, 0, CTL_ZERO_BYTES, stream);
    Args a{};
    a.x_prompt = (const float*)d_in[0]; a.x_sample = (const float*)d_in[1]; a.cache_cmp = (const float*)d_in[2]; a.cache_slc = (const float*)d_in[3]; a.cache_win = (const float*)d_in[4];
    a.st_C = (const float*)d_in[5]; a.st_n = (const float*)d_in[6]; a.st_m = (const float*)d_in[7]; a.page_table = (const int*)d_in[8]; a.c_prompt = (const float*)d_in[9]; a.c_sample = (const float*)d_in[10];
    a.w_ada = (const float*)d_in[11]; a.b_ada = (const float*)d_in[12]; a.w_in = (const float*)d_in[13]; a.b_gate = (const float*)d_in[14]; a.ml_norm_g = (const float*)d_in[15]; a.cmp_pe = (const float*)d_in[16];
    a.cmp_w1 = (const float*)d_in[17]; a.cmp_w2 = (const float*)d_in[18]; a.rel_bias = (const float*)d_in[19]; a.w_out = (const float*)d_in[20]; a.ln_g = (const float*)d_in[21]; a.ln_b = (const float*)d_in[22];
    a.w_up = (const float*)d_in[23]; a.w_down = (const float*)d_in[24];
    a.out = (float*)d_out; a.ws = (unsigned char*)d_ws;
#if MK_PER_PHASE
    for (int ph = 0; ph < N_PHASES; ++ph) { a.ph_lo = ph; a.ph_hi = ph + 1; hipLaunchKernelGGL(fwd_kernel, dim3(grid), dim3(NTHR), LDS_BYTES, stream, a); }
#else
    a.ph_lo = 0; a.ph_hi = N_PHASES;
    hipLaunchKernelGGL(fwd_kernel, dim3(grid), dim3(NTHR), LDS_BYTES, stream, a);
#endif
    const hipError_t le = hipPeekAtLastError();
    if (le != hipSuccess) fprintf(stderr, "kernel_launch: launch failed: %s\n", hipGetErrorName(le));
}
```

```cpp
#include <hip/hip_runtime.h>
#include <cstdio>
#include <cstdint>
namespace pg8 {
#define PG8_LAS __attribute__((address_space(3)))
typedef unsigned short bf16_t;
typedef short bf16x8 __attribute__((ext_vector_type(8)));
typedef float f32x4 __attribute__((ext_vector_type(4)));
typedef unsigned u32x4 __attribute__((ext_vector_type(4)));
constexpr int BM = 256, BK = 64, HALF = 128, HTB = HALF * BK * 2  , STAGE_BYTES = 8 * HTB, NXCD = 8, WGM = 8;

__host__ __device__ __forceinline__ int lds_byte(int r, int c) { const int st = (r >> 4) * 2 + (c >> 5), rr = r & 15, cc = c & 31, ob = rr * 64 + cc * 2; return st * 1024 + (ob ^ (((ob >> 9) & 1) << 5)); }
__host__ __device__ __forceinline__ void stage_rc(int b, int& R, int& C) { const int st = b / 1024, sb = b % 1024, swz = sb ^ (((sb >> 9) & 1) << 5); R = (st >> 1) * 16 + swz / 64; C = (st & 1) * 32 + (swz % 64) / 2; }
__host__ __device__ __forceinline__ int perm32(int rho) { const int n = rho >> 4, i = rho & 15; return 8 * (i >> 2) + 4 * n + (i & 3); }

struct Unit { int pm, pn; };
struct Gemm { const bf16_t* A; const bf16_t* Bt; int K, lda, ldb; };

struct StaticOrder {
    int nM, nN, nwg, G, c;
    __host__ __device__ void init(int M, int N, int G_, int c_) { nM = M / BM; nN = N / BM; nwg = nM * nN; G = G_; c = c_; }
    __host__ __device__ bool next(int i, Unit& u) const {
        const long L = (long)i * G + c; if (L >= nwg) return false;
        int wgid = (int)L; { const int q = nwg / NXCD, r = nwg % NXCD, xcd = wgid % NXCD, off = wgid / NXCD; wgid = (xcd < r ? xcd * (q + 1) : r * (q + 1) + (xcd - r) * q) + off; }
        const int nig = WGM * nN, gid = wgid / nig, fm = gid * WGM, gsz = (nM - fm) < WGM ? (nM - fm) : WGM;
        u.pm = fm + ((wgid % nig) % gsz); u.pn = (wgid % nig) / gsz; return true;
    }
    __device__ __forceinline__ void a_ready(const Unit&) const {}
    __device__ __forceinline__ void done(const Unit&) const {}
};

template <class Epi, class Sched, bool ALIGN_EPI = false, bool SP2 = false>
__device__ __forceinline__ void gemm_phase(PG8_LAS unsigned char* lds, const Gemm g, const Sched& S, const Epi& E) {
    const int tid = threadIdx.x, wid = __builtin_amdgcn_readfirstlane(tid >> 6), lane = tid & 63, wr = wid >> 2, wc = wid & 3, fr = lane & 15, fq = lane >> 4;
    const int K = g.K, nt = K / BK;
    unsigned voffA[2], voffB[2];
#pragma unroll
    for (int i = 0; i < 2; ++i) { int R, C; stage_rc(tid * 16 + i * 8192, R, C); const int Rb = Epi::PERM ? ((R & ~31) + perm32(R & 31)) : R;
        voffA[i] = (unsigned)(R * g.lda + C) * 2u; voffB[i] = (unsigned)(Rb * g.ldb + C) * 2u; }
    const size_t kstep = (size_t)(BK * 2);
    const size_t hstepA = (size_t)HALF * g.lda * 2, hstepB = (size_t)HALF * g.ldb * 2;
    const size_t tstepA = 2 * hstepA, tstepB = 2 * hstepB;
    const unsigned ldsw = (unsigned)wid * 1024u;
    const int aoff = lds_byte(wr * 64 + fr, fq * 8), boff = lds_byte(wc * 32 + fr, fq * 8);
#define PG8_SA(b, h) (((b) * 2 + (h)) * HTB)
#define PG8_SB(b, h) ((4 + (b) * 2 + (h)) * HTB)
#define PG8_STAGE(bufoff, gbase, voff) do { _Pragma("unroll") for (int _i = 0; _i < 2; ++_i) \
        __builtin_amdgcn_global_load_lds((const unsigned*)((const char*)(gbase) + (voff)[_i]), (PG8_LAS unsigned*)(lds + (bufoff) + ldsw + _i * 8192), 16, 0, 0); } while (0)
#define PG8_LDA(dst, b, h) do { _Pragma("unroll") for (int m = 0; m < 4; ++m) _Pragma("unroll") for (int k = 0; k < 2; ++k) dst[m][k] = *(const PG8_LAS bf16x8*)(lds + PG8_SA(b, h) + aoff + m * 2048 + k * 1024); } while (0)
#define PG8_LDB(dst, b, h) do { _Pragma("unroll") for (int n = 0; n < 2; ++n) _Pragma("unroll") for (int k = 0; k < 2; ++k) dst[n][k] = *(const PG8_LAS bf16x8*)(lds + PG8_SB(b, h) + boff + n * 2048 + k * 1024); } while (0)
#define PG8_MMA(ai, bj, At, Bt) do { __builtin_amdgcn_s_setprio(1); _Pragma("unroll") for (int m = 0; m < 4; ++m) _Pragma("unroll") for (int n = 0; n < 2; ++n) _Pragma("unroll") for (int k = 0; k < 2; ++k) \
        acc[ai][bj][m][n] = __builtin_amdgcn_mfma_f32_16x16x32_bf16(Bt[n][k], At[m][k], acc[ai][bj][m][n], 0, 0, 0); __builtin_amdgcn_s_setprio(0); } while (0)
#define PG8_WAIT_V(n) asm volatile("s_waitcnt vmcnt(" #n ")" ::: "memory")
#define PG8_WAIT_L(n) asm volatile("s_waitcnt lgkmcnt(" #n ")" ::: "memory")
#define PG8_BAR __builtin_amdgcn_s_barrier()
#define PG8_SCHED __builtin_amdgcn_sched_barrier(0)
    Unit cur, nxt; int ui = 0;
    if (!S.next(0, cur)) return;
    f32x4 acc[2][2][4][2];
#pragma unroll
    for (int a = 0; a < 2; ++a)
#pragma unroll
        for (int b = 0; b < 2; ++b)
#pragma unroll
            for (int m = 0; m < 4; ++m)
#pragma unroll
                for (int n = 0; n < 2; ++n) acc[a][b][m][n] = (f32x4){0.f, 0.f, 0.f, 0.f};
    bf16x8 At[4][2], B0[2][2], B1[2][2];
    const char* cA = (const char*)g.A + (size_t)cur.pm * tstepA; const char* cB = (const char*)g.Bt + (size_t)cur.pn * tstepB;
    S.a_ready(cur);
    if constexpr (SP2) {
        PG8_STAGE(PG8_SB(0, 0), cB, voffB); PG8_STAGE(PG8_SB(0, 1), cB + hstepB, voffB); PG8_STAGE(PG8_SA(0, 0), cA, voffA); PG8_STAGE(PG8_SA(0, 1), cA + hstepA, voffA);
        if (wr == 1) PG8_BAR;
        PG8_WAIT_V(2); PG8_BAR;
        PG8_STAGE(PG8_SB(1, 0), cB + kstep, voffB); PG8_STAGE(PG8_SA(1, 0), cA + kstep, voffA); PG8_STAGE(PG8_SB(1, 1), cB + hstepB + kstep, voffB);
        PG8_WAIT_V(6); PG8_BAR;
    } else {
        PG8_STAGE(PG8_SB(0, 0), cB, voffB); PG8_STAGE(PG8_SA(0, 0), cA, voffA); PG8_STAGE(PG8_SB(0, 1), cB + hstepB, voffB); PG8_STAGE(PG8_SA(0, 1), cA + hstepA, voffA);
        if (wr == 1) PG8_BAR;
        PG8_WAIT_V(4); PG8_BAR;
        PG8_STAGE(PG8_SB(1, 0), cB + kstep, voffB); PG8_STAGE(PG8_SA(1, 0), cA + kstep, voffA); PG8_STAGE(PG8_SB(1, 1), cB + hstepB + kstep, voffB);
        PG8_WAIT_V(6); PG8_BAR;
    }
    for (;;) {
        const bool has_next = S.next(ui + 1, nxt);
        const char* nA = has_next ? (const char*)g.A + (size_t)nxt.pm * tstepA : cA; const char* nB = has_next ? (const char*)g.Bt + (size_t)nxt.pn * tstepB : cB;
        for (int t = 0; t < nt; t += 2) {
            const bool last = (t == nt - 2);
            const char* a1 = cA + (size_t)(t + 1) * kstep;
            const char* a2 = last ? nA : cA + (size_t)(t + 2) * kstep; const char* b2 = last ? nB : cB + (size_t)(t + 2) * kstep;
            const char* a3 = a2 + kstep; const char* b3 = b2 + kstep;
            if (last && has_next) S.a_ready(nxt);
            if constexpr (SP2) {
            PG8_LDB(B0, 0, 0); PG8_LDB(B1, 0, 1); PG8_SCHED; PG8_LDA(At, 0, 0); PG8_STAGE(PG8_SA(1, 1), a1 + hstepA, voffA);
            PG8_WAIT_V(8); PG8_WAIT_L(0); PG8_BAR; PG8_MMA(0, 0, At, B0); PG8_MMA(0, 1, At, B1); PG8_BAR; PG8_SCHED;
            PG8_LDA(At, 0, 1); PG8_STAGE(PG8_SB(0, 0), b2, voffB); PG8_STAGE(PG8_SB(0, 1), b2 + hstepB, voffB); PG8_STAGE(PG8_SA(0, 0), a2, voffA);
            PG8_WAIT_V(8); PG8_WAIT_L(0); PG8_BAR; PG8_MMA(1, 0, At, B0); PG8_MMA(1, 1, At, B1); PG8_BAR; PG8_SCHED;
            PG8_LDB(B0, 1, 0); PG8_LDB(B1, 1, 1); PG8_SCHED; PG8_LDA(At, 1, 0); PG8_STAGE(PG8_SA(0, 1), a2 + hstepA, voffA);
            PG8_WAIT_V(8); PG8_WAIT_L(0); PG8_BAR; PG8_MMA(0, 0, At, B0); PG8_MMA(0, 1, At, B1); PG8_BAR; PG8_SCHED;
            PG8_LDA(At, 1, 1); PG8_STAGE(PG8_SB(1, 0), b3, voffB); PG8_STAGE(PG8_SB(1, 1), b3 + hstepB, voffB); PG8_STAGE(PG8_SA(1, 0), a3, voffA);
            PG8_WAIT_V(8); PG8_WAIT_L(0); PG8_BAR; PG8_MMA(1, 0, At, B0); PG8_MMA(1, 1, At, B1); PG8_BAR; PG8_SCHED;
            } else {
            PG8_LDB(B0, 0, 0); PG8_SCHED; PG8_LDA(At, 0, 0); PG8_STAGE(PG8_SA(1, 1), a1 + hstepA, voffA);
            PG8_WAIT_L(8); PG8_BAR; PG8_WAIT_L(0); PG8_MMA(0, 0, At, B0); PG8_BAR; PG8_SCHED;
            PG8_LDB(B1, 0, 1); PG8_STAGE(PG8_SB(0, 0), b2, voffB);
            PG8_BAR; PG8_WAIT_L(0); PG8_MMA(0, 1, At, B1); PG8_BAR;
            PG8_LDA(At, 0, 1); PG8_STAGE(PG8_SA(0, 0), a2, voffA);
            PG8_BAR; PG8_WAIT_L(0); PG8_MMA(1, 0, At, B0); PG8_BAR; PG8_SCHED;
            PG8_STAGE(PG8_SB(0, 1), b2 + hstepB, voffB);
            PG8_WAIT_V(6); PG8_BAR; PG8_MMA(1, 1, At, B1); PG8_BAR;
            PG8_LDB(B0, 1, 0); PG8_SCHED; PG8_LDA(At, 1, 0); PG8_STAGE(PG8_SA(0, 1), a2 + hstepA, voffA);
            PG8_WAIT_L(8); PG8_BAR; PG8_WAIT_L(0); PG8_MMA(0, 0, At, B0); PG8_BAR; PG8_SCHED;
            PG8_LDB(B1, 1, 1); PG8_STAGE(PG8_SB(1, 0), b3, voffB);
            PG8_BAR; PG8_WAIT_L(0); PG8_MMA(0, 1, At, B1); PG8_BAR;
            PG8_LDA(At, 1, 1); PG8_STAGE(PG8_SA(1, 0), a3, voffA);
            PG8_BAR; PG8_WAIT_L(0); PG8_MMA(1, 0, At, B0); PG8_BAR; PG8_SCHED;
            PG8_STAGE(PG8_SB(1, 1), b3 + hstepB, voffB);
            PG8_WAIT_V(6); PG8_BAR; PG8_MMA(1, 1, At, B1); PG8_BAR;
            }
        }
        if constexpr (ALIGN_EPI) { if (wr == 0) PG8_BAR; }
        if constexpr (!Epi::AFTER_DRAIN) { E(acc, cur, wr, wc, fr, fq); S.done(cur); }
        if (!has_next) break;
#pragma unroll
        for (int a = 0; a < 2; ++a)
#pragma unroll
            for (int b = 0; b < 2; ++b)
#pragma unroll
                for (int m = 0; m < 4; ++m)
#pragma unroll
                    for (int n = 0; n < 2; ++n) acc[a][b][m][n] = (f32x4){0.f, 0.f, 0.f, 0.f};
        cur = nxt; cA = nA; cB = nB; ++ui;
        if constexpr (ALIGN_EPI) { if (wr == 1) PG8_BAR; }
    }
    PG8_WAIT_V(0);
    if constexpr (!ALIGN_EPI) { if (wr == 0) PG8_BAR; }
    PG8_BAR;
    if constexpr (Epi::AFTER_DRAIN) { E.fused(acc, cur, wr, wc, fr, fq, lds, wid, lane); S.done(cur); }
#undef PG8_SA
#undef PG8_SB
#undef PG8_STAGE
#undef PG8_LDA
#undef PG8_LDB
#undef PG8_MMA
#undef PG8_WAIT_V
#undef PG8_WAIT_L
#undef PG8_BAR
#undef PG8_SCHED
}
}

constexpr int D = 1024, BATCH = 2, SEQ = 8192, DEPTH = 2, DB = 128, DS = 4, PAST = 2048, PAGE = 128, NPG = 16, NPHYS = 2560;
constexpr int MP = BATCH * SEQ, MS = DB * DS, M = MP + MS;
constexpr int NINP = 3584, FF = 4096, NCOND = BATCH + DB;
constexpr int NH = 4, HD = 128;
constexpr int LCH = 256, NCH = SEQ / LCH, NUNIT = BATCH * NH * NCH;
constexpr int NCB = 17408;
constexpr int XCP = NCB * 16;
constexpr float ALPHA = 1.4142135623730951f;
constexpr float LN_EPS = 1e-5f;
constexpr size_t O_YP = 0, O_YS = O_YP + (size_t)MP * D, O_CMPP = O_YS + (size_t)MS * D, O_CMPS = O_CMPP + (size_t)DEPTH * MP * 256, O_SLCP = O_CMPS + (size_t)DEPTH * MS * 256,
                 O_SLCS = O_SLCP + (size_t)DEPTH * MP * 256, O_WINP = O_SLCS + (size_t)DEPTH * MS * 256, O_WINS = O_WINP + (size_t)DEPTH * BATCH * 512 * 256,
                 O_CP = O_WINS + (size_t)DEPTH * DB * 512 * 256, O_CS = O_CP + (size_t)DEPTH * BATCH * NH * HD * HD, O_NP = O_CS + (size_t)DEPTH * DB * NH * HD * HD,
                 O_NS = O_NP + (size_t)DEPTH * BATCH * NH * HD, O_MP = O_NS + (size_t)DEPTH * DB * NH * HD, O_MS = O_MP + (size_t)DEPTH * BATCH * NH, O_END = O_MS + (size_t)DEPTH * DB * NH;

constexpr size_t al1m(size_t x) { return (x + 0xFFFFFull) & ~(size_t)0xFFFFFull; }
constexpr size_t WS_CTL = 0, CTL_ZERO_BYTES = 1u << 20;
constexpr size_t WS_WIN  = CTL_ZERO_BYTES;
constexpr size_t WS_WOUT = WS_WIN  + al1m((size_t)DEPTH * NINP * D * 2);
constexpr size_t WS_WUP  = WS_WOUT + al1m((size_t)DEPTH * D * D * 2);
constexpr size_t WS_WDN  = WS_WUP  + al1m((size_t)DEPTH * FF * D * 2);
constexpr size_t WS_W1   = WS_WDN  + al1m((size_t)DEPTH * D * FF * 2);
constexpr size_t WS_ADA  = WS_W1   + al1m((size_t)DEPTH * 2 * 256 * 2048 * 2);
constexpr size_t WS_B1   = WS_ADA  + al1m((size_t)DEPTH * NCOND * 6144 * 4);
constexpr size_t WS_BT   = WS_B1   + al1m(4096);
constexpr size_t WS_X    = WS_BT   + al1m(8 * 132 * 4);
constexpr size_t WS_Z    = WS_X    + al1m((size_t)M * D * 4);
constexpr size_t WS_U    = WS_Z    + al1m((size_t)M * D * 4);
constexpr size_t WS_QKVO = WS_U    + al1m((size_t)M * D * 2);
constexpr size_t WS_NQ   = WS_QKVO + al1m((size_t)M * 2048 * 2);
constexpr size_t WS_GATE = WS_NQ   + al1m((size_t)M * 512 * 2);
constexpr size_t WS_KVR  = WS_GATE + al1m((size_t)M * 32 * 4);
constexpr size_t WS_XC   = WS_KVR  + al1m((size_t)3 * M * 256 * 4);
constexpr size_t WS_HID  = WS_XC   + al1m((size_t)DEPTH * 4 * XCP * 64 * 2 + 4096);
constexpr size_t WS_CKV  = WS_HID  + al1m((size_t)DEPTH * 4 * NCB * 256 * 2);
constexpr size_t WS_MIX  = WS_CKV  + al1m((size_t)DEPTH * 4 * NCB * 64 * 4);
constexpr size_t WS_H    = WS_MIX  + al1m((size_t)M * D * 2);
constexpr size_t WS_DCT  = WS_H    + al1m((size_t)M * FF * 2);
constexpr size_t WS_DN   = WS_DCT  + al1m((size_t)NUNIT * HD * HD * 4);
constexpr size_t WS_CHS  = WS_DN   + al1m((size_t)NUNIT * HD * 4);
constexpr size_t WS_CTP  = WS_CHS  + al1m((size_t)NUNIT * 4 * 4);
constexpr size_t WS_NPV  = WS_CTP  + al1m((size_t)NUNIT * HD * HD * 2);
constexpr size_t WS_WSC  = WS_NPV  + al1m((size_t)NUNIT * HD * 4);
constexpr size_t WS_HRAW = WS_WSC  + al1m((size_t)NUNIT * LCH * LCH * 4);
constexpr size_t WS_END  = WS_HRAW + al1m((size_t)NUNIT * LCH * HD * 4);

constexpr int CW_BAR = 4096;

constexpr int RING_BYTES = 131072, LDSCTL_OFF = RING_BYTES, MISC_OFF = LDSCTL_OFF + 320, LDS_BYTES = 147456;
constexpr int NWAVES = 8, NTHR = NWAVES * 64;

#define GAS __attribute__((address_space(1)))
#define LAS __attribute__((address_space(3)))
typedef unsigned short bf16;
typedef unsigned v4u __attribute__((ext_vector_type(4)));
typedef unsigned v2u __attribute__((ext_vector_type(2)));
typedef float f32x4 __attribute__((ext_vector_type(4)));
typedef float f32x2 __attribute__((ext_vector_type(2)));

__device__ __forceinline__ unsigned f2bf(float f) { unsigned u = __builtin_bit_cast(unsigned, f); return (u + 0x7fffu + ((u >> 16) & 1u)) >> 16; }
__device__ __forceinline__ unsigned pk2(float lo, float hi) { return f2bf(lo) | (f2bf(hi) << 16); }
__device__ __forceinline__ float bflo(unsigned u) { return __builtin_bit_cast(float, u << 16); }
__device__ __forceinline__ float bfhi(unsigned u) { return __builtin_bit_cast(float, u & 0xffff0000u); }
__device__ __forceinline__ float bf2f(bf16 h) { return __builtin_bit_cast(float, (unsigned)h << 16); }
__device__ __forceinline__ float sigmoidf_(float x) { return 1.f / (1.f + __expf(-x)); }
__device__ __forceinline__ float wave_sum(float v) {
#pragma unroll
    for (int o = 1; o < 64; o <<= 1) v += __shfl_xor(v, o);
    return v;
}
__device__ __forceinline__ float wave_max(float v) {
#pragma unroll
    for (int o = 1; o < 64; o <<= 1) v = fmaxf(v, __shfl_xor(v, o));
    return v;
}

#define XB_TMO      128
#define XB_XCNT(j)  (256  + 64 * (j))
#define XB_XSUB(j)  (1280 + 64 * (j))
#define XB_XGEN(j)  (2304 + 64 * (j))
#define XB_TOP      3328
#define XB_TOPGEN   3392
#define XCD_BAR_WORDS 3456
#define XB_SPIN_CAP (1u << 18)

__device__ __forceinline__ unsigned xb_ld(unsigned* p)              { return __hip_atomic_load(p, __ATOMIC_RELAXED, __HIP_MEMORY_SCOPE_AGENT); }
__device__ __forceinline__ unsigned xb_add(unsigned* p, unsigned v) { return __hip_atomic_fetch_add(p, v, __ATOMIC_RELAXED, __HIP_MEMORY_SCOPE_AGENT); }
__device__ __forceinline__ unsigned xb_xcc_id() { return (unsigned)__builtin_amdgcn_s_getreg((3 << 11) | 20) & 0xFu; }
#define XB_SPIN(cond, bar) do { unsigned _sp = 0; while (cond) { __builtin_amdgcn_s_sleep(1); \
    if ((++_sp & 255u) == 0u) { if (xb_ld(&(bar)[XB_TMO])) break; if (_sp > XB_SPIN_CAP) { atomicAdd(&(bar)[XB_TMO], 1u); break; } } } } while (0)

struct XcdBarrier {
    unsigned* bar; unsigned x;
    volatile LAS unsigned* st;
};

__device__ __forceinline__ XcdBarrier xcd_barrier_post(unsigned* bar, volatile LAS unsigned* st) {
    XcdBarrier b; b.bar = bar; b.x = xb_xcc_id(); b.st = st;
    if (threadIdx.x == 0) (void)xb_add(&bar[XB_XCNT(b.x)], 1u);
    return b;
}
__device__ __forceinline__ void xcd_barrier_complete(unsigned* bar, unsigned x, unsigned& nloc, unsigned& nx) {
    const unsigned G = gridDim.x * gridDim.y * gridDim.z;
    unsigned sum, cnt, mine, sp = 0u;
    for (;;) {
        sum = 0u; cnt = 0u; mine = 0u;
#pragma unroll
        for (unsigned j = 0; j < 16; ++j) { const unsigned c = xb_ld(&bar[XB_XCNT(j)]); sum += c; cnt += (c > 0u) ? 1u : 0u; mine = (j == x) ? c : mine; }
        if (sum == G) break;
        __builtin_amdgcn_s_sleep(1);
        if ((++sp & 255u) == 0u) { if (xb_ld(&bar[XB_TMO])) break; if (sp > XB_SPIN_CAP) { atomicAdd(&bar[XB_TMO], 1u); break; } }
    }
    nloc = mine > 0u ? mine : 1u; nx = cnt > 0u ? cnt : 1u;
}

__device__ __forceinline__ void xcd_barrier(const XcdBarrier& b) {
    asm volatile("s_waitcnt vmcnt(0)" ::: "memory");
    __syncthreads();
    if (threadIdx.x == 0) {
        unsigned* bar = b.bar;
        __builtin_amdgcn_s_waitcnt(0);
        unsigned nloc = b.st[0], nx = b.st[1];
        if (nloc == 0u) { xcd_barrier_complete(bar, b.x, nloc, nx); b.st[0] = nloc; b.st[1] = nx; }
        const unsigned old = xb_add(&bar[XB_XSUB(b.x)], 1u);
        const unsigned gen = old / nloc;
        if (old + 1u == (gen + 1u) * nloc) {
            __builtin_amdgcn_fence(__ATOMIC_RELEASE, "agent");
            asm volatile("s_waitcnt vmcnt(0)" ::: "memory");
            const unsigned og = xb_add(&bar[XB_TOP], 1u);
            const unsigned tg = og / nx;
            if (og + 1u == (tg + 1u) * nx) xb_add(&bar[XB_TOPGEN], 1u);
            else XB_SPIN(xb_ld(&bar[XB_TOPGEN]) == tg, bar);
            __builtin_amdgcn_fence(__ATOMIC_ACQUIRE, "agent");
            xb_add(&bar[XB_XGEN(b.x)], 1u);
            asm volatile("s_waitcnt vmcnt(0)" ::: "memory");
        } else {
            XB_SPIN(xb_ld(&bar[XB_XGEN(b.x)]) == gen, bar);
            __builtin_amdgcn_fence(__ATOMIC_ACQUIRE, "agent");
            asm volatile("s_waitcnt vmcnt(0)" ::: "memory");
        }
    }
    __syncthreads();
}

struct Args {
    const float* x_prompt; const float* x_sample; const float* cache_cmp; const float* cache_slc; const float* cache_win;
    const float* st_C; const float* st_n; const float* st_m; const int* page_table; const float* c_prompt; const float* c_sample;
    const float* w_ada; const float* b_ada; const float* w_in; const float* b_gate; const float* ml_norm_g; const float* cmp_pe;
    const float* cmp_w1; const float* cmp_w2; const float* rel_bias; const float* w_out; const float* ln_g; const float* ln_b;
    const float* w_up; const float* w_down;
    float* out; unsigned char* ws; int ph_lo, ph_hi;
};
static_assert(sizeof(Args) == 27 * 8 + 8, "Args has no padding");
typedef const __attribute__((address_space(4))) Args CArgs;

__device__ __forceinline__ int cond_of_row(int r) { return r < MP ? (r >> 13) : BATCH + ((r - MP) >> 2); }

struct EpiInProj {
    static constexpr bool PERM = true, AFTER_DRAIN = false;
    bf16* QKVO; bf16* NQ; float* GATE; float* KVR; bf16* XC; float* out; int l;
    __device__ __forceinline__ void operator()(const f32x4 (&acc)[2][2][4][2], const pg8::Unit& u, int wr, int wc, int fr, int fq) const {
        const int row0 = u.pm * 256 + wr * 64 + fr, pn = u.pn, col8 = wc * 32 + 8 * fq;
#pragma unroll
        for (int ai = 0; ai < 2; ++ai)
#pragma unroll
            for (int m = 0; m < 4; ++m) {
                const int r = row0 + ai * 128 + m * 16;
#pragma unroll
                for (int bj = 0; bj < 2; ++bj) {
                    const f32x4 v0 = acc[ai][bj][m][0], v1 = acc[ai][bj][m][1];
                    const int cc = bj * 128 + col8;
                    if (pn < 10) {
                        v4u w; w.x = pk2(v0[0], v0[1]); w.y = pk2(v0[2], v0[3]); w.z = pk2(v1[0], v1[1]); w.w = pk2(v1[2], v1[3]);
                        if (pn < 8) *(v4u*)(QKVO + (size_t)r * 2048 + pn * 256 + cc) = w;
                        else        *(v4u*)(NQ + (size_t)r * 512 + (pn - 8) * 256 + cc) = w;
                    } else if (pn < 13) {
                        const int kind = pn - 10;
                        float* kr = KVR + ((size_t)kind * M + r) * 256 + cc;
                        *(f32x4*)kr = v0; *(f32x4*)(kr + 4) = v1;
                        float* o = nullptr;
                        if (r < MP) {
                            if (kind < 2) o = out + (kind == 0 ? O_CMPP : O_SLCP) + ((size_t)l * MP + r) * 256 + cc;
                            else { const int t = r & (SEQ - 1); if (t >= SEQ - 512) o = out + O_WINP + (((size_t)l * BATCH + (r >> 13)) * 512 + (t - (SEQ - 512))) * 256 + cc; }
                        } else {
                            const int rs = r - MP;
                            if (kind < 2) o = out + (kind == 0 ? O_CMPS : O_SLCS) + ((size_t)l * MS + rs) * 256 + cc;
                            else o = out + O_WINS + (((size_t)l * DB + (rs >> 2)) * 512 + 508 + (rs & 3)) * 256 + cc;
                        }
                        if (o) { *(f32x4*)o = v0; *(f32x4*)(o + 4) = v1; }
                        if (kind == 0 && r < MP) {
                            v4u w; w.x = pk2(v0[0], v0[1]); w.y = pk2(v0[2], v0[3]); w.z = pk2(v1[0], v1[1]); w.w = pk2(v1[2], v1[3]);
                            *(v4u*)(XC + ((size_t)(bj * 2 + (wc >> 1)) * XCP + r) * 64 + (wc & 1) * 32 + 8 * fq) = w;
                        }
                    } else {
                        if (bj == 0 && wc == 0) { float* gp = GATE + (size_t)r * 32 + 8 * fq; *(f32x4*)gp = v0; *(f32x4*)(gp + 4) = v1; }
                    }
                }
            }
    }
};

struct EpiResid {
    static constexpr bool PERM = true, AFTER_DRAIN = false;
    const float* xa; const float* xb; const float* gate; float* Z;
    __device__ __forceinline__ void operator()(const f32x4 (&acc)[2][2][4][2], const pg8::Unit& u, int wr, int wc, int fr, int fq) const {
        const int row0 = u.pm * 256 + wr * 64 + fr, col0 = u.pn * 256 + wc * 32 + 8 * fq;
#pragma unroll
        for (int ai = 0; ai < 2; ++ai)
#pragma unroll
            for (int m = 0; m < 4; ++m) {
                const int r = row0 + ai * 128 + m * 16;
                const float* xr = (r < MP ? xa + (size_t)r * D : xb + (size_t)(r - MP) * D) + col0;
                const float* gr = gate + (size_t)cond_of_row(r) * 6144 + col0;
                float* zr = Z + (size_t)r * D + col0;
#pragma unroll
                for (int bj = 0; bj < 2; ++bj) {
                    const f32x4 x0 = *(const f32x4*)(xr + bj * 128), x1 = *(const f32x4*)(xr + bj * 128 + 4);
                    const f32x4 g0 = *(const f32x4*)(gr + bj * 128), g1 = *(const f32x4*)(gr + bj * 128 + 4);
                    *(f32x4*)(zr + bj * 128) = x0 * ALPHA + g0 * acc[ai][bj][m][0];
                    *(f32x4*)(zr + bj * 128 + 4) = x1 * ALPHA + g1 * acc[ai][bj][m][1];
                }
            }
    }
};

struct EpiRelu2 {
    static constexpr bool PERM = true, AFTER_DRAIN = false;
    bf16* H;
    __device__ __forceinline__ void operator()(const f32x4 (&acc)[2][2][4][2], const pg8::Unit& u, int wr, int wc, int fr, int fq) const {
        const int row0 = u.pm * 256 + wr * 64 + fr, col0 = u.pn * 256 + wc * 32 + 8 * fq;
#pragma unroll
        for (int ai = 0; ai < 2; ++ai)
#pragma unroll
            for (int m = 0; m < 4; ++m) {
                bf16* hr = H + (size_t)(row0 + ai * 128 + m * 16) * FF + col0;
#pragma unroll
                for (int bj = 0; bj < 2; ++bj) {
                    f32x4 a = acc[ai][bj][m][0], b = acc[ai][bj][m][1];
#pragma unroll
                    for (int i = 0; i < 4; ++i) { a[i] = fmaxf(a[i], 0.f); a[i] *= a[i]; b[i] = fmaxf(b[i], 0.f); b[i] *= b[i]; }
                    v4u w; w.x = pk2(a[0], a[1]); w.y = pk2(a[2], a[3]); w.z = pk2(b[0], b[1]); w.w = pk2(b[2], b[3]);
                    *(v4u*)(hr + bj * 128) = w;
                }
            }
    }
};

__device__ __forceinline__ float gelu_tanh(float x) {
    const float y = 0.7978845608028654f * (x + 0.044715f * x * x * x);
    const float t = 1.f - 2.f / (__expf(2.f * y) + 1.f);
    return 0.5f * x * (1.f + t);
}
struct EpiCmpHid {
    static constexpr bool PERM = true, AFTER_DRAIN = false;
    bf16* HID; const float* B1;
    __device__ __forceinline__ void operator()(const f32x4 (&acc)[2][2][4][2], const pg8::Unit& u, int wr, int wc, int fr, int fq) const {
        const int row0 = u.pm * 256 + wr * 64 + fr, col0 = wc * 32 + 8 * fq;
        const float* bp = B1 + u.pn * 256 + col0;
        f32x4 bv[2][2];
#pragma unroll
        for (int bj = 0; bj < 2; ++bj) { bv[bj][0] = *(const f32x4*)(bp + bj * 128); bv[bj][1] = *(const f32x4*)(bp + bj * 128 + 4); }
#pragma unroll
        for (int ai = 0; ai < 2; ++ai)
#pragma unroll
            for (int m = 0; m < 4; ++m) {
                bf16* hr = HID + (size_t)(row0 + ai * 128 + m * 16) * 256 + col0;
#pragma unroll
                for (int bj = 0; bj < 2; ++bj) {
                    f32x4 a = acc[ai][bj][m][0] + bv[bj][0], b = acc[ai][bj][m][1] + bv[bj][1];
#pragma unroll
                    for (int i = 0; i < 4; ++i) { a[i] = gelu_tanh(a[i]); b[i] = gelu_tanh(b[i]); }
                    v4u w; w.x = pk2(a[0], a[1]); w.y = pk2(a[2], a[3]); w.z = pk2(b[0], b[1]); w.w = pk2(b[2], b[3]);
                    *(v4u*)(hr + bj * 128) = w;
                }
            }
    }
};

struct CmpOrder {
    int G, c, l0, nl, t0, ntile;
    __device__ __forceinline__ bool next(int i, pg8::Unit& u) const {
        const int L = i * G + c; if (L >= nl * 4 * ntile) return false;
        const int blk = L / ntile, tile = L % ntile, l = l0 + (blk >> 2), sg = blk & 3;
        u.pm = (l * 4 + sg) * 68 + t0 + tile; u.pn = l * 2 + (sg >> 1); return true;
    }
    __device__ __forceinline__ void a_ready(const pg8::Unit&) const {}
    __device__ __forceinline__ void done(const pg8::Unit&) const {}
};

#define LDS_WAIT() asm volatile("s_waitcnt lgkmcnt(0)" ::: "memory")
#define VM_WAIT() asm volatile("s_waitcnt vmcnt(0)" ::: "memory")

template <class CM>
__device__ __forceinline__ void transpose_item(const float* W, int ldw, int K, bf16* WT, LAS float* scr, int item, int nblk, int lane, const CM& cm) {
    const int kb = item / nblk, nb = item % nblk, k0 = 64 * kb, n0 = 32 * nb;
    const int sc = cm.col(n0 + (lane & 31)); const float scl = cm.scl(n0 + (lane & 31));
#pragma unroll 8
    for (int i = 0; i < 32; ++i) { const int kk = 2 * i + (lane >> 5); scr[kk * 33 + (lane & 31)] = sc >= 0 ? W[(size_t)(k0 + kk) * ldw + sc] * scl : 0.f; }
    LDS_WAIT();
    const int c = lane & 7;
#pragma unroll
    for (int j = 0; j < 4; ++j) { const int n = (lane >> 3) + 8 * j; const LAS float* s = scr + (8 * c) * 33 + n;
        v4u o; o.x = pk2(s[0 * 33], s[1 * 33]); o.y = pk2(s[2 * 33], s[3 * 33]); o.z = pk2(s[4 * 33], s[5 * 33]); o.w = pk2(s[6 * 33], s[7 * 33]);
        *(v4u*)(WT + (size_t)(n0 + n) * K + k0 + 8 * c) = o; }
    LDS_WAIT();
}
struct CmId { __device__ __forceinline__ int col(int n) const { return n; } __device__ __forceinline__ float scl(int) const { return 1.f; } };
struct CmIn {
    __device__ __forceinline__ int col(int n) const { return n < 2048 ? n : (n < 3328 ? n + 8 : (n < 3336 ? n - 1280 : (n < 3360 ? n : -1))); }
    __device__ __forceinline__ float scl(int n) const { return (n >= 512 && n < 1024) ? 0.08838834764831845f : ((n >= 2048 && n < 2560) ? 0.125f : 1.f); }
};

__device__ __forceinline__ int rel_bucket_dev(int n) {
    if (n < 16) return n;
    const float nf = (float)n;
    int large = 16 + (int)(__logf(nf / 16.f) / 2.0794415416798357f * 16.f);
    return large < 31 ? large : 31;
}

__device__ __forceinline__ void phase_p0a(CArgs& A, LAS unsigned char* lds, int gw, int NGW, int lane, int wave) {
    unsigned char* ws = A.ws;
    LAS float* scr = (LAS float*)(lds + wave * 16384);
    constexpr int I_IN = 16 * 112, I_OUT = 16 * 32, I_UP = 16 * 128, I_DN = 64 * 32, I_W1 = 32 * 8;
    constexpr int I_L = I_IN + I_OUT + I_UP + I_DN + 2 * I_W1;
    for (int it = gw; it < DEPTH * I_L; it += NGW) {
        const int l = it / I_L; int r = it % I_L;
        if (r < I_IN) { transpose_item(A.w_in + (size_t)l * D * 3360, 3360, D, (bf16*)(ws + WS_WIN) + (size_t)l * NINP * D, scr, r, 112, lane, CmIn{}); continue; } r -= I_IN;
        if (r < I_OUT) { transpose_item(A.w_out + (size_t)l * D * D, D, D, (bf16*)(ws + WS_WOUT) + (size_t)l * D * D, scr, r, 32, lane, CmId{}); continue; } r -= I_OUT;
        if (r < I_UP) { transpose_item(A.w_up + (size_t)l * D * FF, FF, D, (bf16*)(ws + WS_WUP) + (size_t)l * FF * D, scr, r, 128, lane, CmId{}); continue; } r -= I_UP;
        if (r < I_DN) { transpose_item(A.w_down + (size_t)l * FF * D, D, FF, (bf16*)(ws + WS_WDN) + (size_t)l * D * FF, scr, r, 32, lane, CmId{}); continue; } r -= I_DN;
        const int s = r / I_W1; r %= I_W1;
        transpose_item(A.cmp_w1 + (size_t)(l * 2 + s) * 2048 * 256, 256, 2048, (bf16*)(ws + WS_W1) + (size_t)(l * 2 + s) * 256 * 2048, scr, r, 8, lane, CmId{});
    }
    for (int it = gw; it < DEPTH * DB * NPG * 2; it += NGW) {
        const int half = it & 1, pg = (it >> 1) & 15, seq = (it >> 5) & 127, l = it >> 12;
        const int phys = A.page_table[seq * NPG + pg];
        const float* src = A.cache_cmp + (((size_t)l * NPHYS + phys) * PAGE + half * 64) * 256 + 4 * lane;
        const int cc = 4 * lane, s = cc >> 7, g = (cc >> 6) & 1, d = cc & 63;
        bf16* dst = (bf16*)(ws + WS_XC) + ((size_t)((l * 2 + s) * 2 + g) * XCP + MP + seq * PAST + pg * PAGE + half * 64) * 64 + d;
#pragma unroll 8
        for (int sl = 0; sl < 64; ++sl) { const f32x4 v = *(const f32x4*)(src + (size_t)sl * 256); v2u w; w.x = pk2(v[0], v[1]); w.y = pk2(v[2], v[3]); *(v2u*)(dst + (size_t)sl * 64) = w; }
    }
    for (int it = gw; it < DEPTH * DB * 8; it += NGW) {
        const int ch = it & 7, ls = it >> 3;
        const float* src = A.cache_win + ((size_t)ls * 512 + 4 + ch * 64) * 256 + 4 * lane;
        float* dst = A.out + O_WINS + ((size_t)ls * 512 + ch * 64) * 256 + 4 * lane;
        const int n = ch == 7 ? 60 : 64;
        for (int i = 0; i < n; ++i) *(f32x4*)(dst + (size_t)i * 256) = *(const f32x4*)(src + (size_t)i * 256);
    }
    for (int it = gw; it < 8; it += NGW) {
        float* BT = (float*)(ws + WS_BT) + it * 132;
        for (int dd = lane; dd < 129; dd += 64) BT[dd] = A.rel_bias[rel_bucket_dev(dd) * 8 + it];
    }
    for (int it = gw; it < DEPTH * 2 * 4; it += NGW) {
        const int ls = it >> 2, h = (it & 3) * 64 + lane;
        const float* pe = A.cmp_pe + (size_t)ls * 2048; const float* w1 = A.cmp_w1 + (size_t)ls * 2048 * 256 + h;
        float acc = 0.f;
        for (int k = 0; k < 2048; ++k) acc += pe[k] * w1[(size_t)k * 256];
        ((float*)(ws + WS_B1))[ls * 256 + h] = acc;
    }
}

__device__ __forceinline__ void phase_ada(CArgs& A, LAS unsigned char* lds, int tid) {
    LAS float* a = (LAS float*)lds;
    for (int task = blockIdx.x; task < DEPTH * 12 * 10; task += gridDim.x) {
        const int rb = task % 10, cb = (task / 10) % 12, l = task / 120;
        __syncthreads();
        for (int i = tid; i < 13 * 1024; i += NTHR) { const int row = rb * 13 + i / 1024, k = i & 1023;
            const float c = row < BATCH ? A.c_prompt[row * D + k] : A.c_sample[(row - BATCH) * D + k]; a[i] = c / (1.f + __expf(-c)); }
        __syncthreads();
        const int j = cb * 512 + tid;
        const float* w = A.w_ada + (size_t)l * D * 6144 + j;
        float acc[13];
#pragma unroll
        for (int r = 0; r < 13; ++r) acc[r] = 0.f;
        for (int k = 0; k < D; ++k) { const float wv = w[(size_t)k * 6144];
#pragma unroll
            for (int r = 0; r < 13; ++r) acc[r] += a[r * 1024 + k] * wv; }
        const float bb = A.b_ada[l * 6144 + j];
        float* o = (float*)(A.ws + WS_ADA) + ((size_t)l * NCOND + rb * 13) * 6144 + j;
#pragma unroll
        for (int r = 0; r < 13; ++r) o[(size_t)r * 6144] = acc[r] + bb;
    }
}

__device__ __forceinline__ void mod_row(const float* xrow, const float* sh, const float* sc, bf16* urow, int lane) {
#pragma unroll
    for (int j = 0; j < 4; ++j) { const int c = 4 * lane + 256 * j;
        const f32x4 x = *(const f32x4*)(xrow + c), a = *(const f32x4*)(sh + c), b = *(const f32x4*)(sc + c);
        v2u w; w.x = pk2(x[0] * (1.f + b[0]) + a[0], x[1] * (1.f + b[1]) + a[1]); w.y = pk2(x[2] * (1.f + b[2]) + a[2], x[3] * (1.f + b[3]) + a[3]);
        *(v2u*)(urow + c) = w; }
}
__device__ __forceinline__ void ln_row(const float* zrow, const float* g, const float* b, float* xout, const float* sh, const float* sc, bf16* urow, int lane) {
    f32x4 v[4]; float s = 0.f;
#pragma unroll
    for (int j = 0; j < 4; ++j) { v[j] = *(const f32x4*)(zrow + 4 * lane + 256 * j); s += (v[j][0] + v[j][1]) + (v[j][2] + v[j][3]); }
    const float mean = wave_sum(s) * (1.f / D); float s2 = 0.f;
#pragma unroll
    for (int j = 0; j < 4; ++j) { v[j] = v[j] - mean; s2 += (v[j][0] * v[j][0] + v[j][1] * v[j][1]) + (v[j][2] * v[j][2] + v[j][3] * v[j][3]); }
    const float rstd = 1.f / sqrtf(wave_sum(s2) * (1.f / D) + LN_EPS);
#pragma unroll
    for (int j = 0; j < 4; ++j) { const int c = 4 * lane + 256 * j;
        const f32x4 gg = *(const f32x4*)(g + c), bb = *(const f32x4*)(b + c);
        const f32x4 x = v[j] * rstd * gg + bb;
        *(f32x4*)(xout + c) = x;
        if (urow) { const f32x4 a = *(const f32x4*)(sh + c), q = *(const f32x4*)(sc + c);
            v2u w; w.x = pk2(x[0] * (1.f + q[0]) + a[0], x[1] * (1.f + q[1]) + a[1]); w.y = pk2(x[2] * (1.f + q[2]) + a[2], x[3] * (1.f + q[3]) + a[3]);
            *(v2u*)(urow + c) = w; } }
}

__device__ __forceinline__ float scan_sum256(float v, LAS float* buf, int tid) {
    const int lane = tid & 63, w = tid >> 6;
#pragma unroll
    for (int o = 1; o < 64; o <<= 1) { const float y = __shfl_up(v, o); if (lane >= o) v += y; }
    __syncthreads();
    if (lane == 63) buf[w] = v;
    __syncthreads();
    float add = 0.f;
#pragma unroll
    for (int i = 0; i < 3; ++i) if (i < w) add += buf[i];
    return v + add;
}
__device__ __forceinline__ float scan_max256(float v, LAS float* buf, int tid) {
    const int lane = tid & 63, w = tid >> 6;
#pragma unroll
    for (int o = 1; o < 64; o <<= 1) { const float y = __shfl_up(v, o); if (lane >= o) v = fmaxf(v, y); }
    __syncthreads();
    if (lane == 63) buf[w] = v;
    __syncthreads();
#pragma unroll
    for (int i = 0; i < 3; ++i) if (i < w) v = fmaxf(v, buf[i]);
    return v;
}
__device__ __forceinline__ void ml_gates(CArgs& A, int l, int r, int h, float& ig, float& lf) {
    const float* G = (const float*)(A.ws + WS_GATE) + (size_t)r * 32;
    ig = G[h] + A.b_gate[l * 8 + h];
    const float fr = G[4 + h] + A.b_gate[l * 8 + 4 + h];
    lf = fminf(fr, 0.f) - log1pf(__expf(-fabsf(fr)));
}

__device__ __forceinline__ void phase_m2(CArgs& A, int l, LAS unsigned char* lds, int tid) {
    LAS float* buf = (LAS float*)lds;
    LAS float* wl = (LAS float*)(lds + 1024);
    const bf16* QKVO = (const bf16*)(A.ws + WS_QKVO);
    for (int unit = blockIdx.x; unit < NUNIT; unit += gridDim.x) {
        const int b = unit >> 7, h = (unit >> 5) & 3, c = unit & 31, r0 = b * SEQ + c * LCH;
        float ig = 0.f, lf = 0.f;
        if (tid < 256) ml_gates(A, l, r0 + tid, h, ig, lf);
        const float F = scan_sum256(lf, buf, tid);
        __syncthreads();
        if (tid == 255) buf[16] = F;
        __syncthreads();
        const float Fend = buf[16];
        const float gl = tid < 256 ? Fend - F + ig : -3.0e38f;
        float mw = wave_max(gl);
        if ((tid & 63) == 0) buf[20 + (tid >> 6)] = mw;
        __syncthreads();
        const float mloc = fmaxf(fmaxf(buf[20], buf[21]), fmaxf(buf[22], buf[23]));
        if (tid < 256) wl[tid] = __expf(gl - mloc);
        if (tid == 0) { float* ch = (float*)(A.ws + WS_CHS) + unit * 4; ch[0] = Fend; ch[1] = mloc; }
        __syncthreads();
        const int k = tid & 127, vq = tid >> 7;
        float acc[32]; float accn = 0.f;
#pragma unroll
        for (int i = 0; i < 32; ++i) acc[i] = 0.f;
        const bf16* kp = QKVO + (size_t)r0 * 2048 + 512 + h * HD + k;
        const bf16* vp = QKVO + (size_t)r0 * 2048 + 1024 + h * HD + 32 * vq;
        for (int s = 0; s < LCH; ++s) {
            const float wk = wl[s] * bf2f(kp[(size_t)s * 2048]);
            accn += wk;
            const v4u* v4 = (const v4u*)(vp + (size_t)s * 2048);
#pragma unroll
            for (int q = 0; q < 4; ++q) { const v4u vv = v4[q];
                acc[8 * q + 0] += wk * bflo(vv.x); acc[8 * q + 1] += wk * bfhi(vv.x); acc[8 * q + 2] += wk * bflo(vv.y); acc[8 * q + 3] += wk * bfhi(vv.y);
                acc[8 * q + 4] += wk * bflo(vv.z); acc[8 * q + 5] += wk * bfhi(vv.z); acc[8 * q + 6] += wk * bflo(vv.w); acc[8 * q + 7] += wk * bfhi(vv.w); }
        }
        float* dct = (float*)(A.ws + WS_DCT) + ((size_t)unit * HD + 32 * vq) * HD + k;
#pragma unroll
        for (int i = 0; i < 32; ++i) dct[(size_t)i * HD] = acc[i];
        if (vq == 0) ((float*)(A.ws + WS_DN))[unit * HD + k] = accn;
        __syncthreads();
    }
}

__device__ __forceinline__ void phase_m3(CArgs& A, int l, int tid) {
    for (int task = blockIdx.x; task < BATCH * NH * 33; task += gridDim.x) {
        const int bh = task / 33, part = task % 33;
        const bool isn = part == 32; if (isn && tid >= HD) continue;
        const int e = isn ? tid : part * 512 + tid;
        const float* chs = (const float*)(A.ws + WS_CHS) + (size_t)bh * NCH * 4;
        float st = 0.f, m0 = 0.f;
        for (int c = 0; c < NCH; ++c) {
            const int unit = bh * NCH + c;
            const float Fend = chs[c * 4], mloc = chs[c * 4 + 1];
            float dv;
            if (isn) { ((float*)(A.ws + WS_NPV))[unit * HD + e] = st; dv = ((const float*)(A.ws + WS_DN))[unit * HD + e]; if (tid == 0) ((float*)(A.ws + WS_CHS))[unit * 4 + 2] = m0; }
            else { ((bf16*)(A.ws + WS_CTP))[(size_t)unit * HD * HD + e] = (bf16)f2bf(st); dv = ((const float*)(A.ws + WS_DCT))[(size_t)unit * HD * HD + e]; }
            const float mend = fmaxf(m0 + Fend, mloc);
            st = __expf(m0 + Fend - mend) * st + __expf(mloc - mend) * dv;
            m0 = mend;
        }
        if (isn) { A.out[O_NP + ((size_t)l * BATCH * NH + bh) * HD + e] = st; if (tid == 0) A.out[O_MP + l * BATCH * NH + bh] = m0; }
        else { const int v = e >> 7, k = e & 127; A.out[O_CP + (((size_t)l * BATCH * NH + bh) * HD + k) * HD + v] = st; }
    }
}

__device__ __forceinline__ void phase_m4(CArgs& A, int l, LAS unsigned char* lds, int tid) {
    LAS float* buf = (LAS float*)lds;
    LAS float* sa = (LAS float*)(lds + 1024);
    LAS float* smx = sa + 256;
    LAS float* sdec = smx + 256;
    LAS float* sem = sdec + 256;
    LAS bf16* sv = (LAS bf16*)(lds + 8192);
    const bf16* QKVO = (const bf16*)(A.ws + WS_QKVO);
    const int lane = tid & 63, wave = tid >> 6;
    for (int unit = blockIdx.x; unit < NUNIT; unit += gridDim.x) {
        const int b = unit >> 7, h = (unit >> 5) & 3, c = unit & 31, r0 = b * SEQ + c * LCH;
        float ig = 0.f, lf = 0.f;
        if (tid < 256) ml_gates(A, l, r0 + tid, h, ig, lf);
        const float F = scan_sum256(lf, buf, tid);
        const float a = tid < 256 ? ig - F : -3.0e38f;
        const float cm = scan_max256(a, buf, tid);
        const float m0 = ((const float*)(A.ws + WS_CHS))[unit * 4 + 2];
        if (tid < 256) { const float mx = fmaxf(m0, cm); sa[tid] = a; smx[tid] = mx; sdec[tid] = __expf(m0 - mx); sem[tid] = __expf(-(F + mx)); }
        for (int i = tid; i < LCH * HD / 8; i += NTHR) { const int s = i >> 4, q = i & 15;
            *(LAS v4u*)(sv + s * HD + 8 * q) = *(const v4u*)(QKVO + (size_t)(r0 + s) * 2048 + 1024 + h * HD + 8 * q); }
        __syncthreads();
        float* W = (float*)(A.ws + WS_WSC) + (size_t)unit * LCH * LCH;
        for (int idx = tid; idx < LCH * LCH; idx += NTHR) {
            const int t = idx >> 8, s = idx & 255; float w = 0.f;
            if (s <= t) {
                const v4u* qp = (const v4u*)(QKVO + (size_t)(r0 + t) * 2048 + h * HD); const v4u* kp = (const v4u*)(QKVO + (size_t)(r0 + s) * 2048 + 512 + h * HD);
                float d = 0.f;
#pragma unroll 4
                for (int q = 0; q < 16; ++q) { const v4u x = qp[q], y = kp[q];
                    d += bflo(x.x) * bflo(y.x) + bfhi(x.x) * bfhi(y.x) + bflo(x.y) * bflo(y.y) + bfhi(x.y) * bfhi(y.y)
                       + bflo(x.z) * bflo(y.z) + bfhi(x.z) * bfhi(y.z) + bflo(x.w) * bflo(y.w) + bfhi(x.w) * bfhi(y.w); }
                w = d * __expf(sa[s] - smx[t]);
            }
            W[idx] = w;
        }
        __syncthreads();
        {
            const int v = tid & 127, tq = tid >> 7;
            const bf16* ctp = (const bf16*)(A.ws + WS_CTP) + ((size_t)unit * HD + v) * HD;
            const float* npv = (const float*)(A.ws + WS_NPV) + unit * HD;
            float* hraw = (float*)(A.ws + WS_HRAW) + (size_t)unit * LCH * HD;
            for (int i = 0; i < 64; ++i) {
                const int t = 4 * i + tq;
                float num = 0.f, den = 0.f;
                const float* wr = W + (size_t)t * LCH;
                for (int s = 0; s <= t; s += 4) { const f32x4 w4 = *(const f32x4*)(wr + s);
                    num += w4[0] * bf2f(sv[(s + 0) * HD + v]) + w4[1] * bf2f(sv[(s + 1) * HD + v]) + w4[2] * bf2f(sv[(s + 2) * HD + v]) + w4[3] * bf2f(sv[(s + 3) * HD + v]);
                    den += (w4[0] + w4[1]) + (w4[2] + w4[3]); }
                float qc = 0.f, qn = 0.f;
                const v4u* qp = (const v4u*)(QKVO + (size_t)(r0 + t) * 2048 + h * HD);
#pragma unroll 4
                for (int q = 0; q < 16; ++q) { const v4u x = qp[q], y = *(const v4u*)(ctp + 8 * q); const f32x4 n0 = *(const f32x4*)(npv + 8 * q), n1 = *(const f32x4*)(npv + 8 * q + 4);
                    qc += bflo(x.x) * bflo(y.x) + bfhi(x.x) * bfhi(y.x) + bflo(x.y) * bflo(y.y) + bfhi(x.y) * bfhi(y.y)
                        + bflo(x.z) * bflo(y.z) + bfhi(x.z) * bfhi(y.z) + bflo(x.w) * bflo(y.w) + bfhi(x.w) * bfhi(y.w);
                    qn += bflo(x.x) * n0[0] + bfhi(x.x) * n0[1] + bflo(x.y) * n0[2] + bfhi(x.y) * n0[3] + bflo(x.z) * n1[0] + bfhi(x.z) * n1[1] + bflo(x.w) * n1[2] + bfhi(x.w) * n1[3]; }
                const float dec = sdec[t];
                const float numt = num + dec * qc, dent = den + dec * qn;
                hraw[(size_t)t * HD + v] = numt / fmaxf(fabsf(dent), sem[t]);
            }
        }
        __syncthreads();
        {
            const float* hraw = (const float*)(A.ws + WS_HRAW) + (size_t)unit * LCH * HD;
            const float g0 = A.ml_norm_g[l * 512 + h * HD + lane], g1 = A.ml_norm_g[l * 512 + h * HD + 64 + lane];
            for (int t = wave; t < LCH; t += NWAVES) {
                const float x0 = hraw[(size_t)t * HD + lane], x1 = hraw[(size_t)t * HD + 64 + lane];
                const float mu = wave_sum(x0 + x1) * (1.f / HD);
                const float d0 = x0 - mu, d1 = x1 - mu;
                const float rstd = 1.f / sqrtf(wave_sum(d0 * d0 + d1 * d1) * (1.f / HD) + LN_EPS);
                const bf16* op = QKVO + (size_t)(r0 + t) * 2048 + 1536 + h * HD;
                bf16* mp = (bf16*)(A.ws + WS_MIX) + (size_t)(r0 + t) * D + h * HD;
                mp[lane] = (bf16)f2bf(d0 * rstd * g0 * sigmoidf_(bf2f(op[lane])));
                mp[64 + lane] = (bf16)f2bf(d1 * rstd * g1 * sigmoidf_(bf2f(op[64 + lane])));
            }
        }
        __syncthreads();
    }
}

__device__ __forceinline__ void phase_mls(CArgs& A, int l, LAS unsigned char* lds, int tid) {
    LAS float* sq = (LAS float*)lds;
    LAS float* sc = sq + 1536;
    LAS float* sw = sc + 64;
    LAS float* part = sw + 16;
    LAS float* red = part + 2048;
    const bf16* QKVO = (const bf16*)(A.ws + WS_QKVO);
    for (int task = blockIdx.x; task < DB * NH; task += gridDim.x) {
        const int seq = task >> 2, h = task & 3, r0 = MP + seq * DS, sidx = (l * DB + seq) * NH + h;
        __syncthreads();
        for (int i = tid; i < 1536; i += NTHR) { const int which = i >> 9, t = (i >> 7) & 3, d = i & 127; sq[i] = bf2f(QKVO[(size_t)(r0 + t) * 2048 + which * 512 + h * HD + d]); }
        const float m0 = A.st_m[sidx];
        if (tid == 0) {
            float F = 0.f, cmx = -3.0e38f, Fs[4], igs[4], mlast = 0.f;
#pragma unroll
            for (int t = 0; t < 4; ++t) { float ig, lf; ml_gates(A, l, r0 + t, h, ig, lf); F += lf; Fs[t] = F; igs[t] = ig; const float a = ig - F; cmx = fmaxf(cmx, a); const float mx = fmaxf(m0, cmx);
                sc[8 + t] = a; sc[12 + t] = mx; sc[16 + t] = __expf(m0 - mx); sc[20 + t] = __expf(-(F + mx)); mlast = F + mx; }
#pragma unroll
            for (int t = 0; t < 4; ++t) sc[24 + t] = __expf(Fs[3] - Fs[t] + igs[t] - mlast);
            sc[28] = __expf(Fs[3] + m0 - mlast); sc[29] = mlast;
        }
        __syncthreads();
        if (tid < 16) { const int t = tid >> 2, s = tid & 3; float w = 0.f;
            if (s <= t) { float d = 0.f; for (int k = 0; k < HD; ++k) d += sq[t * HD + k] * sq[512 + s * HD + k]; w = d * __expf(sc[8 + s] - sc[12 + t]); }
            sw[tid] = w; }
        else if (tid < 20) { const int t = tid - 16; const float* n0 = A.st_n + (size_t)sidx * HD; float d = 0.f; for (int k = 0; k < HD; ++k) d += sq[t * HD + k] * n0[k]; sc[32 + t] = d; }
        __syncthreads();
        {
            const int v = tid & 127, kq = tid >> 7;
            const float* C0 = A.st_C + (size_t)sidx * HD * HD; float* Co = A.out + O_CS + (size_t)sidx * HD * HD;
            const float cd = sc[28];
            float wv[4]; float qc[4] = {0.f, 0.f, 0.f, 0.f};
#pragma unroll
            for (int t = 0; t < 4; ++t) wv[t] = sc[24 + t] * sq[1024 + t * HD + v];
            for (int kk = 0; kk < 32; ++kk) { const int k = kq * 32 + kk; const float c0 = C0[(size_t)k * HD + v];
                float cn = cd * c0;
#pragma unroll
                for (int t = 0; t < 4; ++t) { qc[t] += sq[t * HD + k] * c0; cn += wv[t] * sq[512 + t * HD + k]; }
                Co[(size_t)k * HD + v] = cn; }
#pragma unroll
            for (int t = 0; t < 4; ++t) part[(kq * 4 + t) * HD + v] = qc[t];
        }
        __syncthreads();
        float hv[4] = {0.f, 0.f, 0.f, 0.f};
        if (tid < HD) {
            const int v = tid;
#pragma unroll
            for (int t = 0; t < 4; ++t) { const float qct = part[(0 * 4 + t) * HD + v] + part[(1 * 4 + t) * HD + v] + part[(2 * 4 + t) * HD + v] + part[(3 * 4 + t) * HD + v];
                float num = sc[16 + t] * qct, den = sc[16 + t] * sc[32 + t];
#pragma unroll
                for (int s = 0; s < 4; ++s) { num += sw[t * 4 + s] * sq[1024 + s * HD + v]; den += sw[t * 4 + s]; }
                hv[t] = num / fmaxf(fabsf(den), sc[20 + t]); }
        }
#pragma unroll
        for (int t = 0; t < 4; ++t) { const float s1 = wave_sum(hv[t]); if ((tid & 63) == 0 && tid < HD) red[t * 2 + (tid >> 6)] = s1; }
        __syncthreads();
        float dv[4];
#pragma unroll
        for (int t = 0; t < 4; ++t) { dv[t] = hv[t] - (red[t * 2] + red[t * 2 + 1]) * (1.f / HD); const float s2 = wave_sum(dv[t] * dv[t]); if ((tid & 63) == 0 && tid < HD) red[8 + t * 2 + (tid >> 6)] = s2; }
        __syncthreads();
        if (tid < HD) {
            const int v = tid; const float gn = A.ml_norm_g[l * 512 + h * HD + v];
#pragma unroll
            for (int t = 0; t < 4; ++t) { const float rstd = 1.f / sqrtf((red[8 + t * 2] + red[8 + t * 2 + 1]) * (1.f / HD) + LN_EPS);
                const float og = bf2f(QKVO[(size_t)(r0 + t) * 2048 + 1536 + h * HD + v]);
                ((bf16*)(A.ws + WS_MIX))[(size_t)(r0 + t) * D + h * HD + v] = (bf16)f2bf(dv[t] * rstd * gn * sigmoidf_(og)); }
        } else if (tid < 2 * HD) {
            const int k = tid - HD; float nn = sc[28] * A.st_n[(size_t)sidx * HD + k];
#pragma unroll
            for (int t = 0; t < 4; ++t) nn += sc[24 + t] * sq[512 + t * HD + k];
            A.out[O_NS + (size_t)sidx * HD + k] = nn;
        }
        if (tid == 0) A.out[O_MS + sidx] = sc[29];
    }
}

__device__ __forceinline__ void phase_cmp2(CArgs& A, int l0, int nl, int r_lo, int nrows, int tid) {
    const int d = tid & 63, rr = tid >> 6, ntask_img = nrows / 8;
    for (int task = blockIdx.x; task < nl * 4 * ntask_img; task += gridDim.x) {
        const int img = task / ntask_img, tr = task % ntask_img, l = l0 + (img >> 2), sg = img & 3, s = sg >> 1;
        const size_t row = (size_t)(l * 4 + sg) * NCB + r_lo + tr * 8 + rr;
        const v4u* hp = (const v4u*)((const bf16*)(A.ws + WS_HID) + row * 256);
        const float* w2 = A.cmp_w2 + (size_t)(l * 2 + s) * 256 * 64 + d;
        float acc = 0.f;
#pragma unroll 4
        for (int q = 0; q < 32; ++q) { const v4u x = hp[q]; const float* w = w2 + (size_t)q * 8 * 64;
            acc += bflo(x.x) * w[0] + bfhi(x.x) * w[64] + bflo(x.y) * w[128] + bfhi(x.y) * w[192] + bflo(x.z) * w[256] + bfhi(x.z) * w[320] + bflo(x.w) * w[384] + bfhi(x.w) * w[448]; }
        ((float*)(A.ws + WS_CKV))[row * 64 + d] = acc;
    }
}

#define NEGBIG (-3.0e38f)
template <int NB, class KF>
__device__ __forceinline__ void attend(const KF& kf, int nblk, const LAS float* qs, LAS float* pb, const float* BT, int hbase, int lane, float (&o)[4]) {
    float s[NB][4]; float mx[4] = {NEGBIG, NEGBIG, NEGBIG, NEGBIG};
#pragma unroll
    for (int it = 0; it < NB; ++it) {
        if (it < nblk) {
            const int p = kf.key(it, lane); const bool ok = kf.ok(p); const int pc = kf.clampk(p);
            const float* kr = kf.krow(pc);
            float d0 = 0.f, d1 = 0.f, d2 = 0.f, d3 = 0.f;
#pragma unroll 4
            for (int dd = 0; dd < 64; dd += 4) { const f32x4 k4 = *(const f32x4*)(kr + dd);
                const f32x4 q0 = *(const LAS f32x4*)(qs + dd), q1 = *(const LAS f32x4*)(qs + 64 + dd), q2 = *(const LAS f32x4*)(qs + 128 + dd), q3 = *(const LAS f32x4*)(qs + 192 + dd);
                d0 += k4[0] * q0[0] + k4[1] * q0[1] + k4[2] * q0[2] + k4[3] * q0[3]; d1 += k4[0] * q1[0] + k4[1] * q1[1] + k4[2] * q1[2] + k4[3] * q1[3];
                d2 += k4[0] * q2[0] + k4[1] * q2[1] + k4[2] * q2[2] + k4[3] * q2[3]; d3 += k4[0] * q3[0] + k4[1] * q3[1] + k4[2] * q3[2] + k4[3] * q3[3]; }
            int dist = kf.dist(pc); dist = dist < 0 ? 0 : (dist > 128 ? 128 : dist);
            const float* bt = BT + hbase * 132 + dist;
            s[it][0] = ok ? d0 + bt[0] : NEGBIG; s[it][1] = ok ? d1 + bt[132] : NEGBIG; s[it][2] = ok ? d2 + bt[264] : NEGBIG; s[it][3] = ok ? d3 + bt[396] : NEGBIG;
#pragma unroll
            for (int r = 0; r < 4; ++r) mx[r] = fmaxf(mx[r], s[it][r]);
        } else {
#pragma unroll
            for (int r = 0; r < 4; ++r) s[it][r] = NEGBIG;
        }
    }
    float sum[4], inv[4];
#pragma unroll
    for (int r = 0; r < 4; ++r) { mx[r] = wave_max(mx[r]); sum[r] = 0.f; }
#pragma unroll
    for (int it = 0; it < NB; ++it)
#pragma unroll
        for (int r = 0; r < 4; ++r) { const float e = s[it][r] > -1.0e37f ? __expf(s[it][r] - mx[r]) : 0.f; s[it][r] = e; sum[r] += e; }
#pragma unroll
    for (int r = 0; r < 4; ++r) { sum[r] = wave_sum(sum[r]); inv[r] = sum[r] > 0.f ? 1.f / sum[r] : 0.f; }
#pragma unroll
    for (int it = 0; it < NB; ++it) {
        if (it < nblk) {
            f32x4 p4; p4[0] = s[it][0] * inv[0]; p4[1] = s[it][1] * inv[1]; p4[2] = s[it][2] * inv[2]; p4[3] = s[it][3] * inv[3];
            asm volatile("" ::: "memory");
            *(LAS f32x4*)(pb + 4 * lane) = p4;
            kf.emit(it, lane, p4);
            LDS_WAIT();
            const int nk = kf.nkeys(it);
            for (int kk = 0; kk < nk; ++kk) {
                const float v = kf.vrow(it, kk)[lane];
                const f32x4 w = *(const LAS f32x4*)(pb + 4 * kk);
                o[0] += w[0] * v; o[1] += w[1] * v; o[2] += w[2] * v; o[3] += w[3] * v;
            }
            LDS_WAIT();
        }
    }
}

struct SeqCtx { bool smp; int bs; int qpos; int l; int g; CArgs* A; };

struct KfCmp {
    const float* CK; const float* CV; int ncv, qpos; LAS float* ps;
    __device__ __forceinline__ int key(int it, int lane) const { return 64 * it + lane; }
    __device__ __forceinline__ bool ok(int n) const { return n < ncv; }
    __device__ __forceinline__ int clampk(int n) const { return n < ncv ? n : ncv - 1; }
    __device__ __forceinline__ const float* krow(int n) const { return CK + (size_t)n * 64; }
    __device__ __forceinline__ int dist(int n) const { return qpos - 16 * n - 31; }
    __device__ __forceinline__ void emit(int it, int lane, const f32x4& p) const { ps[64 * it + lane] = (p[0] + p[1]) + (p[2] + p[3]); }
    __device__ __forceinline__ int nkeys(int it) const { const int r = ncv - 64 * it; return r < 64 ? r : 64; }
    __device__ __forceinline__ const float* vrow(int it, int kk) const { return CV + (size_t)(64 * it + kk) * 64; }
};
struct KfSel {
    SeqCtx c; const float* kvr; int j[16];
    __device__ __forceinline__ const float* row(int p) const {
        if (!c.smp) return kvr + ((size_t)(c.bs * SEQ + p)) * 256 + c.g * 64;
        if (p >= PAST) return kvr + ((size_t)(MP + c.bs * DS + p - PAST)) * 256 + c.g * 64;
        return c.A->cache_slc + (((size_t)c.l * NPHYS + c.A->page_table[c.bs * NPG + (p >> 7)]) * PAGE + (p & 127)) * 256 + c.g * 64;
    }
    __device__ __forceinline__ int key(int it, int lane) const { return 64 * j[it] + lane; }
    __device__ __forceinline__ int nkeys(int it) const { const int r = c.qpos - 64 * j[it] + 1; return r < 64 ? (r > 0 ? r : 0) : 64; }
    __device__ __forceinline__ const float* vrow(int it, int kk) const { return row(64 * j[it] + kk) + 128; }
    __device__ __forceinline__ bool ok(int p) const { return p <= c.qpos; }
    __device__ __forceinline__ int clampk(int p) const { return p <= c.qpos ? p : c.qpos; }
    __device__ __forceinline__ const float* krow(int p) const { return row(p); }
    __device__ __forceinline__ int dist(int p) const { return c.qpos - p; }
    __device__ __forceinline__ void emit(int, int, const f32x4&) const {}
};
struct KfWin {
    SeqCtx c; const float* kvr; int lo;
    __device__ __forceinline__ const float* row(int p) const {
        if (!c.smp) return kvr + ((size_t)(c.bs * SEQ + p)) * 256 + c.g * 64;
        if (p >= PAST) return kvr + ((size_t)(MP + c.bs * DS + p - PAST)) * 256 + c.g * 64;
        return c.A->cache_win + (((size_t)c.l * DB + c.bs) * 512 + (p - (PAST - 512))) * 256 + c.g * 64;
    }
    __device__ __forceinline__ int key(int it, int lane) const { return c.qpos - 511 + 64 * it + lane; }
    __device__ __forceinline__ bool ok(int p) const { return p >= lo; }
    __device__ __forceinline__ int clampk(int p) const { return p >= lo ? p : lo; }
    __device__ __forceinline__ const float* krow(int p) const { return row(p); }
    __device__ __forceinline__ int dist(int p) const { return c.qpos - p; }
    __device__ __forceinline__ void emit(int, int, const f32x4&) const {}
    __device__ __forceinline__ int nkeys(int) const { return 64; }
    __device__ __forceinline__ const float* vrow(int it, int kk) const { const int p = c.qpos - 511 + 64 * it + kk; return row(p >= lo ? p : lo) + 128; }
};

__device__ __forceinline__ void topk_sel(float imp0, float imp1, int cur, int lane, unsigned long long& s0, unsigned long long& s1) {
    const int nforced = cur == 0 ? 1 : (cur == 1 ? 2 : 3), need = 16 - nforced, ncand = cur - 2 > 0 ? cur - 2 : 0;
    const unsigned k0 = (lane >= 1 && lane <= cur - 2) ? __builtin_bit_cast(unsigned, imp0) + 1u : 0u;
    const unsigned k1 = (lane + 64 <= cur - 2) ? __builtin_bit_cast(unsigned, imp1) + 1u : 0u;
    unsigned long long c0, c1;
    if (ncand <= need) { c0 = __ballot(k0 != 0u); c1 = __ballot(k1 != 0u); }
    else {
        unsigned T = 0u;
        for (int bit = 31; bit >= 0; --bit) { const unsigned cand = T | (1u << bit);
            const int cnt = __popcll(__ballot(k0 >= cand)) + __popcll(__ballot(k1 >= cand)); if (cnt >= need) T = cand; }
        const unsigned long long g0 = __ballot(k0 > T), g1 = __ballot(k1 > T); unsigned long long e0 = __ballot(k0 == T), e1 = __ballot(k1 == T);
        int rem = need - __popcll(g0) - __popcll(g1);
        unsigned long long t0 = 0ull, t1 = 0ull;
        while (rem > 0 && e0) { const unsigned long long lb = e0 & (~e0 + 1ull); t0 |= lb; e0 ^= lb; --rem; }
        while (rem > 0 && e1) { const unsigned long long lb = e1 & (~e1 + 1ull); t1 |= lb; e1 ^= lb; --rem; }
        c0 = g0 | t0; c1 = g1 | t1;
    }
    unsigned long long f0 = 1ull, f1 = 0ull;
    if (cur < 64) f0 |= 1ull << cur; else f1 |= 1ull << (cur - 64);
    if (cur >= 1) { if (cur - 1 < 64) f0 |= 1ull << (cur - 1); else f1 |= 1ull << (cur - 65); }
    s0 = c0 | f0; s1 = c1 | f1;
}

__device__ __forceinline__ void nsa_wave(CArgs& A, int l, int r, int g, LAS float* wl, int lane) {
    LAS float* qs = wl;
    LAS float* pb = wl + 256;
    LAS float* ps = wl + 512;
    const bool smp = r >= MP; const int bs = smp ? (r - MP) >> 2 : r >> 13; const int qpos = smp ? PAST + ((r - MP) & 3) : (r & (SEQ - 1));
    const float* BT = (const float*)(A.ws + WS_BT);
    const float* KVR = (const float*)(A.ws + WS_KVR);
    {   const bf16* qp = (const bf16*)(A.ws + WS_NQ) + (size_t)r * 512 + g * 256;
#pragma unroll
        for (int i = 0; i < 4; ++i) qs[64 * i + lane] = bf2f(qp[64 * i + lane]); }
    for (int i = lane; i < 520; i += 64) ps[i] = 0.f;
    LDS_WAIT();
    SeqCtx cx{smp, bs, qpos, l, g, &A};
    float out[4] = {0.f, 0.f, 0.f, 0.f};
    const float* gt = (const float*)(A.ws + WS_GATE) + (size_t)r * 32 + 8 + g * 12;
    {
        const int ncv = qpos >= 31 ? ((qpos - 31) >> 4) + 1 : 0;
        const int gc0 = smp ? 1024 + bs * 128 : bs * 512;
        if (ncv > 0) {
            KfCmp kf{(const float*)(A.ws + WS_CKV) + ((size_t)((l * 2 + 0) * 2 + g) * NCB + gc0) * 64, (const float*)(A.ws + WS_CKV) + ((size_t)((l * 2 + 1) * 2 + g) * NCB + gc0) * 64, ncv, qpos, ps};
            float o[4] = {0.f, 0.f, 0.f, 0.f};
            attend<8, KfCmp>(kf, (ncv + 63) >> 6, qs, pb, BT, g * 4, lane, o);
#pragma unroll
            for (int rr = 0; rr < 4; ++rr) out[rr] += sigmoidf_(gt[rr * 3 + 0]) * o[rr];
        }
    }
    LDS_WAIT();
    unsigned long long s0, s1;
    {
        float imp0 = 0.f, imp1 = 0.f;
#pragma unroll
        for (int i = -1; i < 4; ++i) { const int n0 = 4 * lane + i, n1 = 4 * (lane + 64) + i; if (n0 >= 0) imp0 += ps[n0]; imp1 += ps[n1]; }
        topk_sel(imp0, imp1, qpos >> 6, lane, s0, s1);
    }
    {
        KfSel kf; kf.c = cx; kf.kvr = KVR + (size_t)1 * M * 256;
        int nb = 0; unsigned long long m0 = s0, m1 = s1;
#pragma unroll
        for (int it = 0; it < 16; ++it) {
            if (m0) { kf.j[it] = __builtin_ctzll(m0); m0 &= m0 - 1ull; ++nb; }
            else if (m1) { kf.j[it] = 64 + __builtin_ctzll(m1); m1 &= m1 - 1ull; ++nb; }
            else kf.j[it] = 0;
        }
        float o[4] = {0.f, 0.f, 0.f, 0.f};
        attend<16, KfSel>(kf, nb, qs, pb, BT, g * 4, lane, o);
#pragma unroll
        for (int rr = 0; rr < 4; ++rr) out[rr] += sigmoidf_(gt[rr * 3 + 1]) * o[rr];
    }
    {
        KfWin kf{cx, KVR + (size_t)2 * M * 256, smp ? PAST - 512 : 0};
        float o[4] = {0.f, 0.f, 0.f, 0.f};
        attend<8, KfWin>(kf, 8, qs, pb, BT, g * 4, lane, o);
#pragma unroll
        for (int rr = 0; rr < 4; ++rr) out[rr] += sigmoidf_(gt[rr * 3 + 2]) * o[rr];
    }
    bf16* mp = (bf16*)(A.ws + WS_MIX) + (size_t)r * D + 512 + g * 256 + lane;
#pragma unroll
    for (int rr = 0; rr < 4; ++rr) mp[rr * 64] = (bf16)f2bf(out[rr]);
}

constexpr int PH_PER_LAYER = 9, PH_L0 = 3, N_PHASES = PH_L0 + DEPTH * PH_PER_LAYER;
#ifndef MK_PER_PHASE
#define MK_PER_PHASE 0
#endif

__device__ __forceinline__ CArgs* kargs() { unsigned long long p = (unsigned long long)__builtin_amdgcn_kernarg_segment_ptr(); asm volatile("" : "+s"(p)); return (CArgs*)p; }
#define A (*kargs())
#define IN(k) (lo <= (k) && (k) < hi)
#define SEAM(k) do { if (IN(k) && IN((k) + 1)) xcd_barrier(bar); } while (0)
template <int l>
__device__ __forceinline__ void layer_phases(LAS unsigned char* lds, const XcdBarrier& bar, int tid, int lane, int wave, int G, int gw, int NGW, int lo, int hi) {
    unsigned char* ws = A.ws;
    float* const ADA = (float*)(ws + WS_ADA);
    float* const X = (float*)(ws + WS_X);
    float* const Z = (float*)(ws + WS_Z);
    bf16* const U = (bf16*)(ws + WS_U);
        const int pb_ = PH_L0 + l * PH_PER_LAYER;
        const float* adal = ADA + (size_t)l * NCOND * 6144;
        const float* xa = l == 0 ? A.x_prompt : X; const float* xb = l == 0 ? A.x_sample : X + (size_t)MP * D;
        if (IN(pb_ + 0)) {
            {
                pg8::Gemm g{U, (const bf16*)(ws + WS_WIN) + (size_t)l * NINP * D, D, D, D};
                pg8::StaticOrder S; S.init(M, NINP, G, (int)blockIdx.x);
                EpiInProj E{(bf16*)(ws + WS_QKVO), (bf16*)(ws + WS_NQ), (float*)(ws + WS_GATE), (float*)(ws + WS_KVR), (bf16*)(ws + WS_XC) + (size_t)l * 4 * XCP * 64, A.out, l};
                pg8::gemm_phase<EpiInProj, pg8::StaticOrder, true, true>(lds, g, S, E);
            }
            if (l == 0) {
                __syncthreads();
                pg8::Gemm g{(const bf16*)(ws + WS_XC), (const bf16*)(ws + WS_W1), 2048, 1024, 2048};
                CmpOrder S{G, (int)blockIdx.x, 0, DEPTH, 4, 64};
                EpiCmpHid E{(bf16*)(ws + WS_HID), (const float*)(ws + WS_B1)};
                pg8::gemm_phase<EpiCmpHid, CmpOrder, true, true>(lds, g, S, E);
            }
        }
        SEAM(pb_ + 0);
        if (IN(pb_ + 1)) {
            {
                pg8::Gemm g{(const bf16*)(ws + WS_XC), (const bf16*)(ws + WS_W1), 2048, 1024, 2048};
                CmpOrder S{G, (int)blockIdx.x, l, 1, 0, 4};
                EpiCmpHid E{(bf16*)(ws + WS_HID), (const float*)(ws + WS_B1)};
                pg8::gemm_phase<EpiCmpHid, CmpOrder, true, true>(lds, g, S, E);
            }
            __syncthreads();
            phase_m2(A, l, lds, tid);
            if (l == 0) phase_cmp2(A, 0, DEPTH, 1024, NCB - 1024, tid);
        }
        SEAM(pb_ + 1);
        if (IN(pb_ + 2)) {
            phase_m3(A, l, tid);
            phase_cmp2(A, l, 1, 0, 1024, tid);
        }
        SEAM(pb_ + 2);
        if (IN(pb_ + 3)) {
            phase_m4(A, l, lds, tid);
            __syncthreads();
            phase_mls(A, l, lds, tid);
            __syncthreads();
            LAS float* wl = (LAS float*)(lds + wave * 8192);
            for (int t = gw; t < M * 2; t += NGW) nsa_wave(A, l, t >> 1, t & 1, wl, lane);
        }
        SEAM(pb_ + 3);
        if (IN(pb_ + 4)) {
            pg8::Gemm g{(const bf16*)(ws + WS_MIX), (const bf16*)(ws + WS_WOUT) + (size_t)l * D * D, D, D, D};
            pg8::StaticOrder S; S.init(M, D, G, (int)blockIdx.x);
            EpiResid E{xa, xb, adal + 2048, Z};
            pg8::gemm_phase<EpiResid, pg8::StaticOrder, true, true>(lds, g, S, E);
        }
        SEAM(pb_ + 4);
        if (IN(pb_ + 5)) {
            for (int r = gw; r < M; r += NGW) {
                const float* ad = adal + (size_t)cond_of_row(r) * 6144;
                ln_row(Z + (size_t)r * D, A.ln_g + (size_t)(l * 2 + 0) * D, A.ln_b + (size_t)(l * 2 + 0) * D, X + (size_t)r * D, ad + 3072, ad + 4096, U + (size_t)r * D, lane);
            }
        }
        SEAM(pb_ + 5);
        if (IN(pb_ + 6)) {
            pg8::Gemm g{U, (const bf16*)(ws + WS_WUP) + (size_t)l * FF * D, D, D, D};
            pg8::StaticOrder S; S.init(M, FF, G, (int)blockIdx.x);
            EpiRelu2 E{(bf16*)(ws + WS_H)};
            pg8::gemm_phase<EpiRelu2, pg8::StaticOrder, true, true>(lds, g, S, E);
        }
        SEAM(pb_ + 6);
        if (IN(pb_ + 7)) {
            pg8::Gemm g{(const bf16*)(ws + WS_H), (const bf16*)(ws + WS_WDN) + (size_t)l * D * FF, FF, FF, FF};
            pg8::StaticOrder S; S.init(M, D, G, (int)blockIdx.x);
            EpiResid E{X, X + (size_t)MP * D, adal + 5120, Z};
            pg8::gemm_phase<EpiResid, pg8::StaticOrder, true, true>(lds, g, S, E);
        }
        SEAM(pb_ + 7);
        if (IN(pb_ + 8)) {
            const bool last = l == DEPTH - 1;
            for (int r = gw; r < M; r += NGW) {
                const float* ad = adal + (size_t)NCOND * 6144 + (size_t)cond_of_row(r) * 6144;
                float* xo = last ? (r < MP ? A.out + O_YP + (size_t)r * D : A.out + O_YS + (size_t)(r - MP) * D) : X + (size_t)r * D;
                ln_row(Z + (size_t)r * D, A.ln_g + (size_t)(l * 2 + 1) * D, A.ln_b + (size_t)(l * 2 + 1) * D, xo, ad, ad + 1024, last ? (bf16*)nullptr : U + (size_t)r * D, lane);
            }
        }
        SEAM(pb_ + 8);
    }
__global__ void __launch_bounds__(NTHR, 2) fwd_kernel(Args A_unused) {
    extern __shared__ __attribute__((aligned(16))) unsigned char lds_raw[];
    LAS unsigned char* lds = (LAS unsigned char*)lds_raw;
    const int tid = threadIdx.x, lane = tid & 63, wave = __builtin_amdgcn_readfirstlane(tid >> 6);
    const int G = gridDim.x, gw = blockIdx.x * NWAVES + wave, NGW = G * NWAVES;
    unsigned char* ws = A.ws;
    for (int u = tid; u < (LDS_BYTES - LDSCTL_OFF) / 4; u += NTHR) ((LAS unsigned*)(lds + LDSCTL_OFF))[u] = 0u;
    __syncthreads();
    XcdBarrier bar; bar.bar = (unsigned*)(ws + WS_CTL) + CW_BAR; bar.x = 0; bar.st = nullptr;
    if (!MK_PER_PHASE) bar = xcd_barrier_post((unsigned*)(ws + WS_CTL) + CW_BAR, (volatile LAS unsigned*)(lds + MISC_OFF) + 8);
    const int lo = A.ph_lo, hi = A.ph_hi;

    float* const ADA = (float*)(ws + WS_ADA);
    float* const X = (float*)(ws + WS_X);
    float* const Z = (float*)(ws + WS_Z);
    bf16* const U = (bf16*)(ws + WS_U);

    if (IN(0)) { phase_p0a(A, lds, gw, NGW, lane, wave); }
    SEAM(0);
    if (IN(1)) { phase_ada(A, lds, tid); }
    SEAM(1);
    if (IN(2)) {
        for (int r = gw; r < M; r += NGW) {
            const float* ad = ADA + (size_t)cond_of_row(r) * 6144;
            mod_row(r < MP ? A.x_prompt + (size_t)r * D : A.x_sample + (size_t)(r - MP) * D, ad, ad + 1024, U + (size_t)r * D, lane);
        }
    }
    SEAM(2);

    layer_phases<0>(lds, bar, tid, lane, wave, G, gw, NGW, lo, hi);
    layer_phases<1>(lds, bar, tid, lane, wave, G, gw, NGW, lo, hi);
    static_assert(DEPTH == 2, "two layers");
#undef IN
#undef SEAM
#undef A
}

extern "C" void kernel_launch(void* const* d_in, const int* in_sizes, int n_in, void* d_out, int out_size, void* d_ws, size_t ws_size, hipStream_t stream) {
    static int grid = 0;
    if (grid == 0) {
        if (n_in != 25 || (size_t)out_size != O_END || ws_size < WS_END) { fprintf(stderr, "kernel_launch: unexpected shapes: n_in %d out %d (want %zu) ws %zu (want >= %zu)\n", n_in, out_size, (size_t)O_END, ws_size, (size_t)WS_END); grid = -1; return; }
        int dev = 0, cus = 0, per_cu = 0;
        if (hipGetDevice(&dev) != hipSuccess || hipDeviceGetAttribute(&cus, hipDeviceAttributeMultiprocessorCount, dev) != hipSuccess) { grid = -1; return; }
        if (hipFuncSetAttribute((const void*)fwd_kernel, hipFuncAttributeMaxDynamicSharedMemorySize, LDS_BYTES) != hipSuccess) { fprintf(stderr, "kernel_launch: hipFuncSetAttribute failed\n"); grid = -1; return; }
        if (hipOccupancyMaxActiveBlocksPerMultiprocessor(&per_cu, (const void*)fwd_kernel, NTHR, LDS_BYTES) != hipSuccess || per_cu < 1) fprintf(stderr, "kernel_launch: occupancy query reports %d blocks per CU\n", per_cu);
        (void)hipGetLastError();
        grid = cus;
    }
    if (grid < 0) return;
    (void)hipMemsetAsync((char*)d_ws + WS_CTL, 0, CTL_ZERO_BYTES, stream);
    Args a{};
    a.x_prompt = (const float*)d_in[0]; a.x_sample = (const float*)d_in[1]; a.cache_cmp = (const float*)d_in[2]; a.cache_slc = (const float*)d_in[3]; a.cache_win = (const float*)d_in[4];
    a.st_C = (const float*)d_in[5]; a.st_n = (const float*)d_in[6]; a.st_m = (const float*)d_in[7]; a.page_table = (const int*)d_in[8]; a.c_prompt = (const float*)d_in[9]; a.c_sample = (const float*)d_in[10];
    a.w_ada = (const float*)d_in[11]; a.b_ada = (const float*)d_in[12]; a.w_in = (const float*)d_in[13]; a.b_gate = (const float*)d_in[14]; a.ml_norm_g = (const float*)d_in[15]; a.cmp_pe = (const float*)d_in[16];
    a.cmp_w1 = (const float*)d_in[17]; a.cmp_w2 = (const float*)d_in[18]; a.rel_bias = (const float*)d_in[19]; a.w_out = (const float*)d_in[20]; a.ln_g = (const float*)d_in[21]; a.ln_b = (const float*)d_in[22];
    a.w_up = (const float*)d_in[23]; a.w_down = (const float*)d_in[24];
    a.out = (float*)d_out; a.ws = (unsigned char*)d_ws;
#if MK_PER_PHASE
    for (int ph = 0; ph < N_PHASES; ++ph) { a.ph_lo = ph; a.ph_hi = ph + 1; hipLaunchKernelGGL(fwd_kernel, dim3(grid), dim3(NTHR), LDS_BYTES, stream, a); }
#else
    a.ph_lo = 0; a.ph_hi = N_PHASES;
    hipLaunchKernelGGL(fwd_kernel, dim3(grid), dim3(NTHR), LDS_BYTES, stream, a);
#endif
    const hipError_t le = hipPeekAtLastError();
    if (le != hipSuccess) fprintf(stderr, "kernel_launch: launch failed: %s\n", hipGetErrorName(le));
}
```

```cpp
#include <hip/hip_runtime.h>
#include <cstdio>
#include <cstdint>
namespace pg8 {
#define PG8_LAS __attribute__((address_space(3)))
typedef unsigned short bf16_t;
typedef short bf16x8 __attribute__((ext_vector_type(8)));
typedef float f32x4 __attribute__((ext_vector_type(4)));
typedef unsigned u32x4 __attribute__((ext_vector_type(4)));
constexpr int BM = 256, BK = 64, HALF = 128, HTB = HALF * BK * 2  , STAGE_BYTES = 8 * HTB, NXCD = 8, WGM = 8;

__host__ __device__ __forceinline__ int lds_byte(int r, int c) { const int st = (r >> 4) * 2 + (c >> 5), rr = r & 15, cc = c & 31, ob = rr * 64 + cc * 2; return st * 1024 + (ob ^ (((ob >> 9) & 1) << 5)); }
__host__ __device__ __forceinline__ void stage_rc(int b, int& R, int& C) { const int st = b / 1024, sb = b % 1024, swz = sb ^ (((sb >> 9) & 1) << 5); R = (st >> 1) * 16 + swz / 64; C = (st & 1) * 32 + (swz % 64) / 2; }
__host__ __device__ __forceinline__ int perm32(int rho) { const int n = rho >> 4, i = rho & 15; return 8 * (i >> 2) + 4 * n + (i & 3); }

struct Unit { int pm, pn; };
struct Gemm { const bf16_t* A; const bf16_t* Bt; int K, lda, ldb; };

struct StaticOrder {
    int nM, nN, nwg, G, c;
    __host__ __device__ void init(int M, int N, int G_, int c_) { nM = M / BM; nN = N / BM; nwg = nM * nN; G = G_; c = c_; }
    __host__ __device__ bool next(int i, Unit& u) const {
        const long L = (long)i * G + c; if (L >= nwg) return false;
        int wgid = (int)L; { const int q = nwg / NXCD, r = nwg % NXCD, xcd = wgid % NXCD, off = wgid / NXCD; wgid = (xcd < r ? xcd * (q + 1) : r * (q + 1) + (xcd - r) * q) + off; }
        const int nig = WGM * nN, gid = wgid / nig, fm = gid * WGM, gsz = (nM - fm) < WGM ? (nM - fm) : WGM;
        u.pm = fm + ((wgid % nig) % gsz); u.pn = (wgid % nig) / gsz; return true;
    }
    __device__ __forceinline__ void a_ready(const Unit&) const {}
    __device__ __forceinline__ void done(const Unit&) const {}
};

template <class Epi, class Sched, bool ALIGN_EPI = false, bool SP2 = false>
__device__ __forceinline__ void gemm_phase(PG8_LAS unsigned char* lds, const Gemm g, const Sched& S, const Epi& E) {
    const int tid = threadIdx.x, wid = __builtin_amdgcn_readfirstlane(tid >> 6), lane = tid & 63, wr = wid >> 2, wc = wid & 3, fr = lane & 15, fq = lane >> 4;
    const int K = g.K, nt = K / BK;
    unsigned voffA[2], voffB[2];
#pragma unroll
    for (int i = 0; i < 2; ++i) { int R, C; stage_rc(tid * 16 + i * 8192, R, C); const int Rb = Epi::PERM ? ((R & ~31) + perm32(R & 31)) : R;
        voffA[i] = (unsigned)(R * g.lda + C) * 2u; voffB[i] = (unsigned)(Rb * g.ldb + C) * 2u; }
    const size_t kstep = (size_t)(BK * 2);
    const size_t hstepA = (size_t)HALF * g.lda * 2, hstepB = (size_t)HALF * g.ldb * 2;
    const size_t tstepA = 2 * hstepA, tstepB = 2 * hstepB;
    const unsigned ldsw = (unsigned)wid * 1024u;
    const int aoff = lds_byte(wr * 64 + fr, fq * 8), boff = lds_byte(wc * 32 + fr, fq * 8);
#define PG8_SA(b, h) (((b) * 2 + (h)) * HTB)
#define PG8_SB(b, h) ((4 + (b) * 2 + (h)) * HTB)
#define PG8_STAGE(bufoff, gbase, voff) do { _Pragma("unroll") for (int _i = 0; _i < 2; ++_i) \
        __builtin_amdgcn_global_load_lds((const unsigned*)((const char*)(gbase) + (voff)[_i]), (PG8_LAS unsigned*)(lds + (bufoff) + ldsw + _i * 8192), 16, 0, 0); } while (0)
#define PG8_LDA(dst, b, h) do { _Pragma("unroll") for (int m = 0; m < 4; ++m) _Pragma("unroll") for (int k = 0; k < 2; ++k) dst[m][k] = *(const PG8_LAS bf16x8*)(lds + PG8_SA(b, h) + aoff + m * 2048 + k * 1024); } while (0)
#define PG8_LDB(dst, b, h) do { _Pragma("unroll") for (int n = 0; n < 2; ++n) _Pragma("unroll") for (int k = 0; k < 2; ++k) dst[n][k] = *(const PG8_LAS bf16x8*)(lds + PG8_SB(b, h) + boff + n * 2048 + k * 1024); } while (0)
#define PG8_MMA(ai, bj, At, Bt) do { __builtin_amdgcn_s_setprio(1); _Pragma("unroll") for (int m = 0; m < 4; ++m) _Pragma("unroll") for (int n = 0; n < 2; ++n) _Pragma("unroll") for (int k = 0; k < 2; ++k) \
        acc[ai][bj][m][n] = __builtin_amdgcn_mfma_f32_16x16x32_bf16(Bt[n][k], At[m][k], acc[ai][bj][m][n], 0, 0, 0); __builtin_amdgcn_s_setprio(0); } while (0)
#define PG8_WAIT_V(n) asm volatile("s_waitcnt vmcnt(" #n ")" ::: "memory")
#define PG8_WAIT_L(n) asm volatile("s_waitcnt lgkmcnt(" #n ")" ::: "memory")
#define PG8_BAR __builtin_amdgcn_s_barrier()
#define PG8_SCHED __builtin_amdgcn_sched_barrier(0)
    Unit cur, nxt; int ui = 0;
    if (!S.next(0, cur)) return;
    f32x4 acc[2][2][4][2];
#pragma unroll
    for (int a = 0; a < 2; ++a)
#pragma unroll
        for (int b = 0; b < 2; ++b)
#pragma unroll
            for (int m = 0; m < 4; ++m)
#pragma unroll
                for (int n = 0; n < 2; ++n) acc[a][b][m][n] = (f32x4){0.f, 0.f, 0.f, 0.f};
    bf16x8 At[4][2], B0[2][2], B1[2][2];
    const char* cA = (const char*)g.A + (size_t)cur.pm * tstepA; const char* cB = (const char*)g.Bt + (size_t)cur.pn * tstepB;
    S.a_ready(cur);
    if constexpr (SP2) {
        PG8_STAGE(PG8_SB(0, 0), cB, voffB); PG8_STAGE(PG8_SB(0, 1), cB + hstepB, voffB); PG8_STAGE(PG8_SA(0, 0), cA, voffA); PG8_STAGE(PG8_SA(0, 1), cA + hstepA, voffA);
        if (wr == 1) PG8_BAR;
        PG8_WAIT_V(2); PG8_BAR;
        PG8_STAGE(PG8_SB(1, 0), cB + kstep, voffB); PG8_STAGE(PG8_SA(1, 0), cA + kstep, voffA); PG8_STAGE(PG8_SB(1, 1), cB + hstepB + kstep, voffB);
        PG8_WAIT_V(6); PG8_BAR;
    } else {
        PG8_STAGE(PG8_SB(0, 0), cB, voffB); PG8_STAGE(PG8_SA(0, 0), cA, voffA); PG8_STAGE(PG8_SB(0, 1), cB + hstepB, voffB); PG8_STAGE(PG8_SA(0, 1), cA + hstepA, voffA);
        if (wr == 1) PG8_BAR;
        PG8_WAIT_V(4); PG8_BAR;
        PG8_STAGE(PG8_SB(1, 0), cB + kstep, voffB); PG8_STAGE(PG8_SA(1, 0), cA + kstep, voffA); PG8_STAGE(PG8_SB(1, 1), cB + hstepB + kstep, voffB);
        PG8_WAIT_V(6); PG8_BAR;
    }
    for (;;) {
        const bool has_next = S.next(ui + 1, nxt);
        const char* nA = has_next ? (const char*)g.A + (size_t)nxt.pm * tstepA : cA; const char* nB = has_next ? (const char*)g.Bt + (size_t)nxt.pn * tstepB : cB;
        for (int t = 0; t < nt; t += 2) {
            const bool last = (t == nt - 2);
            const char* a1 = cA + (size_t)(t + 1) * kstep;
            const char* a2 = last ? nA : cA + (size_t)(t + 2) * kstep; const char* b2 = last ? nB : cB + (size_t)(t + 2) * kstep;
            const char* a3 = a2 + kstep; const char* b3 = b2 + kstep;
            if (last && has_next) S.a_ready(nxt);
            if constexpr (SP2) {
            PG8_LDB(B0, 0, 0); PG8_LDB(B1, 0, 1); PG8_SCHED; PG8_LDA(At, 0, 0); PG8_STAGE(PG8_SA(1, 1), a1 + hstepA, voffA);
            PG8_WAIT_V(8); PG8_WAIT_L(0); PG8_BAR; PG8_MMA(0, 0, At, B0); PG8_MMA(0, 1, At, B1); PG8_BAR; PG8_SCHED;
            PG8_LDA(At, 0, 1); PG8_STAGE(PG8_SB(0, 0), b2, voffB); PG8_STAGE(PG8_SB(0, 1), b2 + hstepB, voffB); PG8_STAGE(PG8_SA(0, 0), a2, voffA);
            PG8_WAIT_V(8); PG8_WAIT_L(0); PG8_BAR; PG8_MMA(1, 0, At, B0); PG8_MMA(1, 1, At, B1); PG8_BAR; PG8_SCHED;
            PG8_LDB(B0, 1, 0); PG8_LDB(B1, 1, 1); PG8_SCHED; PG8_LDA(At, 1, 0); PG8_STAGE(PG8_SA(0, 1), a2 + hstepA, voffA);
            PG8_WAIT_V(8); PG8_WAIT_L(0); PG8_BAR; PG8_MMA(0, 0, At, B0); PG8_MMA(0, 1, At, B1); PG8_BAR; PG8_SCHED;
            PG8_LDA(At, 1, 1); PG8_STAGE(PG8_SB(1, 0), b3, voffB); PG8_STAGE(PG8_SB(1, 1), b3 + hstepB, voffB); PG8_STAGE(PG8_SA(1, 0), a3, voffA);
            PG8_WAIT_V(8); PG8_WAIT_L(0); PG8_BAR; PG8_MMA(1, 0, At, B0); PG8_MMA(1, 1, At, B1); PG8_BAR; PG8_SCHED;
            } else {
            PG8_LDB(B0, 0, 0); PG8_SCHED; PG8_LDA(At, 0, 0); PG8_STAGE(PG8_SA(1, 1), a1 + hstepA, voffA);
            PG8_WAIT_L(8); PG8_BAR; PG8_WAIT_L(0); PG8_MMA(0, 0, At, B0); PG8_BAR; PG8_SCHED;
            PG8_LDB(B1, 0, 1); PG8_STAGE(PG8_SB(0, 0), b2, voffB);
            PG8_BAR; PG8_WAIT_L(0); PG8_MMA(0, 1, At, B1); PG8_BAR;
            PG8_LDA(At, 0, 1); PG8_STAGE(PG8_SA(0, 0), a2, voffA);
            PG8_BAR; PG8_WAIT_L(0); PG8_MMA(1, 0, At, B0); PG8_BAR; PG8_SCHED;
            PG8_STAGE(PG8_SB(0, 1), b2 + hstepB, voffB);
            PG8_WAIT_V(6); PG8_BAR; PG8_MMA(1, 1, At, B1); PG8_BAR;
            PG8_LDB(B0, 1, 0); PG8_SCHED; PG8_LDA(At, 1, 0); PG8_STAGE(PG8_SA(0, 1), a2 + hstepA, voffA);
            PG8_WAIT_L(8); PG8_BAR; PG8_WAIT_L(0); PG8_MMA(0, 0, At, B0); PG8_BAR; PG8_SCHED;
            PG8_LDB(B1, 1, 1); PG8_STAGE(PG8_SB(1, 0), b3, voffB);
            PG8_BAR; PG8_WAIT_L(0); PG8_MMA(0, 1, At, B1); PG8_BAR;
            PG8_LDA(At, 1, 1); PG8_STAGE(PG8_SA(1, 0), a3, voffA);
            PG8_BAR; PG8_WAIT_L(0); PG8_MMA(1, 0, At, B0); PG8_BAR; PG8_SCHED;
            PG8_STAGE(PG8_SB(1, 1), b3 + hstepB, voffB);
            PG8_WAIT_V(6); PG8_BAR; PG8_MMA(1, 1, At, B1); PG8_BAR;
            }
        }
        if constexpr (ALIGN_EPI) { if (wr == 0) PG8_BAR; }
        if constexpr (!Epi::AFTER_DRAIN) { E(acc, cur, wr, wc, fr, fq); S.done(cur); }
        if (!has_next) break;
#pragma unroll
        for (int a = 0; a < 2; ++a)
#pragma unroll
            for (int b = 0; b < 2; ++b)
#pragma unroll
                for (int m = 0; m < 4; ++m)
#pragma unroll
                    for (int n = 0; n < 2; ++n) acc[a][b][m][n] = (f32x4){0.f, 0.f, 0.f, 0.f};
        cur = nxt; cA = nA; cB = nB; ++ui;
        if constexpr (ALIGN_EPI) { if (wr == 1) PG8_BAR; }
    }
    PG8_WAIT_V(0);
    if constexpr (!ALIGN_EPI) { if (wr == 0) PG8_BAR; }
    PG8_BAR;
    if constexpr (Epi::AFTER_DRAIN) { E.fused(acc, cur, wr, wc, fr, fq, lds, wid, lane); S.done(cur); }
#undef PG8_SA
#undef PG8_SB
#undef PG8_STAGE
#undef PG8_LDA
#undef PG8_LDB
#undef PG8_MMA
#undef PG8_WAIT_V
#undef PG8_WAIT_L
#undef PG8_BAR
#undef PG8_SCHED
}
}

constexpr int D = 1024, BATCH = 2, SEQ = 8192, DEPTH = 2, DB = 128, DS = 4, PAST = 2048, PAGE = 128, NPG = 16, NPHYS = 2560;
constexpr int MP = BATCH * SEQ, MS = DB * DS, M = MP + MS;
constexpr int NINP = 3584, FF = 4096, NCOND = BATCH + DB;
constexpr int NH = 4, HD = 128;
constexpr int LCH = 256, NCH = SEQ / LCH, NUNIT = BATCH * NH * NCH;
constexpr int NCB = 17408;
constexpr int XCP = NCB * 16;
constexpr float ALPHA = 1.4142135623730951f;
constexpr float LN_EPS = 1e-5f;
constexpr size_t O_YP = 0, O_YS = O_YP + (size_t)MP * D, O_CMPP = O_YS + (size_t)MS * D, O_CMPS = O_CMPP + (size_t)DEPTH * MP * 256, O_SLCP = O_CMPS + (size_t)DEPTH * MS * 256,
                 O_SLCS = O_SLCP + (size_t)DEPTH * MP * 256, O_WINP = O_SLCS + (size_t)DEPTH * MS * 256, O_WINS = O_WINP + (size_t)DEPTH * BATCH * 512 * 256,
                 O_CP = O_WINS + (size_t)DEPTH * DB * 512 * 256, O_CS = O_CP + (size_t)DEPTH * BATCH * NH * HD * HD, O_NP = O_CS + (size_t)DEPTH * DB * NH * HD * HD,
                 O_NS = O_NP + (size_t)DEPTH * BATCH * NH * HD, O_MP = O_NS + (size_t)DEPTH * DB * NH * HD, O_MS = O_MP + (size_t)DEPTH * BATCH * NH, O_END = O_MS + (size_t)DEPTH * DB * NH;

constexpr size_t al1m(size_t x) { return (x + 0xFFFFFull) & ~(size_t)0xFFFFFull; }
constexpr size_t WS_CTL = 0, CTL_ZERO_BYTES = 1u << 20;
constexpr size_t WS_WIN  = CTL_ZERO_BYTES;
constexpr size_t WS_WOUT = WS_WIN  + al1m((size_t)DEPTH * NINP * D * 2);
constexpr size_t WS_WUP  = WS_WOUT + al1m((size_t)DEPTH * D * D * 2);
constexpr size_t WS_WDN  = WS_WUP  + al1m((size_t)DEPTH * FF * D * 2);
constexpr size_t WS_W1   = WS_WDN  + al1m((size_t)DEPTH * D * FF * 2);
constexpr size_t WS_ADA  = WS_W1   + al1m((size_t)DEPTH * 2 * 256 * 2048 * 2);
constexpr size_t WS_B1   = WS_ADA  + al1m((size_t)DEPTH * NCOND * 6144 * 4);
constexpr size_t WS_BT   = WS_B1   + al1m(4096);
constexpr size_t WS_X    = WS_BT   + al1m(8 * 132 * 4);
constexpr size_t WS_Z    = WS_X    + al1m((size_t)M * D * 4);
constexpr size_t WS_U    = WS_Z    + al1m((size_t)M * D * 4);
constexpr size_t WS_QKVO = WS_U    + al1m((size_t)M * D * 2);
constexpr size_t WS_NQ   = WS_QKVO + al1m((size_t)M * 2048 * 2);
constexpr size_t WS_GATE = WS_NQ   + al1m((size_t)M * 512 * 2);
constexpr size_t WS_KVR  = WS_GATE + al1m((size_t)M * 32 * 4);
constexpr size_t WS_XC   = WS_KVR  + al1m((size_t)3 * M * 256 * 4);
constexpr size_t WS_HID  = WS_XC   + al1m((size_t)DEPTH * 4 * XCP * 64 * 2 + 4096);
constexpr size_t WS_CKV  = WS_HID  + al1m((size_t)DEPTH * 4 * NCB * 256 * 2);
constexpr size_t WS_KS   = WS_CKV  + al1m((size_t)DEPTH * 4 * NCB * 64 * 4);
constexpr size_t WS_VTS  = WS_KS   + al1m((size_t)DEPTH * 2 * (MP + DB * 2112) * 64 * 2 + 65536);
constexpr size_t WS_KW   = WS_VTS  + al1m((size_t)DEPTH * 2 * (MP + DB * 2112) * 64 * 2 + 65536);
constexpr size_t WS_VTW  = WS_KW   + al1m((size_t)DEPTH * 2 * (MP + DB * 528 + 64) * 64 * 2 + 65536);
constexpr size_t WS_KC   = WS_VTW  + al1m((size_t)DEPTH * 2 * (MP + DB * 528 + 64) * 64 * 2 + 65536);
constexpr size_t WS_VCT  = WS_KC   + al1m((size_t)DEPTH * 2 * NCB * 64 * 2 + 65536);
constexpr size_t WS_MIX  = WS_VCT  + al1m((size_t)DEPTH * 2 * NCB * 64 * 2 + 65536);
constexpr size_t WS_H    = WS_MIX  + al1m((size_t)M * D * 2);
constexpr size_t WS_DCT  = WS_H    + al1m((size_t)M * FF * 2);
constexpr size_t WS_DN   = WS_DCT  + al1m((size_t)NUNIT * HD * HD * 4);
constexpr size_t WS_CHS  = WS_DN   + al1m((size_t)NUNIT * HD * 4);
constexpr size_t WS_CTP  = WS_CHS  + al1m((size_t)NUNIT * 4 * 4);
constexpr size_t WS_NPV  = WS_CTP  + al1m((size_t)NUNIT * HD * HD * 2);
constexpr size_t WS_WSC  = WS_NPV  + al1m((size_t)NUNIT * HD * 4);
constexpr size_t WS_HRAW = WS_WSC  + al1m((size_t)NUNIT * LCH * LCH * 4);
constexpr size_t WS_END  = WS_HRAW + al1m((size_t)NUNIT * LCH * HD * 4);

constexpr int CW_BAR = 4096;

constexpr int RING_BYTES = 131072, LDSCTL_OFF = RING_BYTES, MISC_OFF = LDSCTL_OFF + 320, LDS_BYTES = 147456;
constexpr int NWAVES = 8, NTHR = NWAVES * 64;

#define GAS __attribute__((address_space(1)))
#define LAS __attribute__((address_space(3)))
typedef unsigned short bf16;
typedef unsigned v4u __attribute__((ext_vector_type(4)));
typedef unsigned v2u __attribute__((ext_vector_type(2)));
typedef float f32x4 __attribute__((ext_vector_type(4)));
typedef float f32x2 __attribute__((ext_vector_type(2)));

__device__ __forceinline__ unsigned f2bf(float f) { unsigned u = __builtin_bit_cast(unsigned, f); return (u + 0x7fffu + ((u >> 16) & 1u)) >> 16; }
__device__ __forceinline__ unsigned pk2(float lo, float hi) { return f2bf(lo) | (f2bf(hi) << 16); }
__device__ __forceinline__ float bflo(unsigned u) { return __builtin_bit_cast(float, u << 16); }
__device__ __forceinline__ float bfhi(unsigned u) { return __builtin_bit_cast(float, u & 0xffff0000u); }
__device__ __forceinline__ float bf2f(bf16 h) { return __builtin_bit_cast(float, (unsigned)h << 16); }
__device__ __forceinline__ float sigmoidf_(float x) { return 1.f / (1.f + __expf(-x)); }
__device__ __forceinline__ float wave_sum(float v) {
#pragma unroll
    for (int o = 1; o < 64; o <<= 1) v += __shfl_xor(v, o);
    return v;
}
__device__ __forceinline__ float wave_max(float v) {
#pragma unroll
    for (int o = 1; o < 64; o <<= 1) v = fmaxf(v, __shfl_xor(v, o));
    return v;
}

#define XB_TMO      128
#define XB_XCNT(j)  (256  + 64 * (j))
#define XB_XSUB(j)  (1280 + 64 * (j))
#define XB_XGEN(j)  (2304 + 64 * (j))
#define XB_TOP      3328
#define XB_TOPGEN   3392
#define XCD_BAR_WORDS 3456
#define XB_SPIN_CAP (1u << 18)

__device__ __forceinline__ unsigned xb_ld(unsigned* p)              { return __hip_atomic_load(p, __ATOMIC_RELAXED, __HIP_MEMORY_SCOPE_AGENT); }
__device__ __forceinline__ unsigned xb_add(unsigned* p, unsigned v) { return __hip_atomic_fetch_add(p, v, __ATOMIC_RELAXED, __HIP_MEMORY_SCOPE_AGENT); }
__device__ __forceinline__ unsigned xb_xcc_id() { return (unsigned)__builtin_amdgcn_s_getreg((3 << 11) | 20) & 0xFu; }
#define XB_SPIN(cond, bar) do { unsigned _sp = 0; while (cond) { __builtin_amdgcn_s_sleep(1); \
    if ((++_sp & 255u) == 0u) { if (xb_ld(&(bar)[XB_TMO])) break; if (_sp > XB_SPIN_CAP) { atomicAdd(&(bar)[XB_TMO], 1u); break; } } } } while (0)

struct XcdBarrier {
    unsigned* bar; unsigned x;
    volatile LAS unsigned* st;
};

__device__ __forceinline__ XcdBarrier xcd_barrier_post(unsigned* bar, volatile LAS unsigned* st) {
    XcdBarrier b; b.bar = bar; b.x = xb_xcc_id(); b.st = st;
    if (threadIdx.x == 0) (void)xb_add(&bar[XB_XCNT(b.x)], 1u);
    return b;
}
__device__ __forceinline__ void xcd_barrier_complete(unsigned* bar, unsigned x, unsigned& nloc, unsigned& nx) {
    const unsigned G = gridDim.x * gridDim.y * gridDim.z;
    unsigned sum, cnt, mine, sp = 0u;
    for (;;) {
        sum = 0u; cnt = 0u; mine = 0u;
#pragma unroll
        for (unsigned j = 0; j < 16; ++j) { const unsigned c = xb_ld(&bar[XB_XCNT(j)]); sum += c; cnt += (c > 0u) ? 1u : 0u; mine = (j == x) ? c : mine; }
        if (sum == G) break;
        __builtin_amdgcn_s_sleep(1);
        if ((++sp & 255u) == 0u) { if (xb_ld(&bar[XB_TMO])) break; if (sp > XB_SPIN_CAP) { atomicAdd(&bar[XB_TMO], 1u); break; } }
    }
    nloc = mine > 0u ? mine : 1u; nx = cnt > 0u ? cnt : 1u;
}

__device__ __forceinline__ void xcd_barrier(const XcdBarrier& b) {
    asm volatile("s_waitcnt vmcnt(0)" ::: "memory");
    __syncthreads();
    if (threadIdx.x == 0) {
        unsigned* bar = b.bar;
        __builtin_amdgcn_s_waitcnt(0);
        unsigned nloc = b.st[0], nx = b.st[1];
        if (nloc == 0u) { xcd_barrier_complete(bar, b.x, nloc, nx); b.st[0] = nloc; b.st[1] = nx; }
        const unsigned old = xb_add(&bar[XB_XSUB(b.x)], 1u);
        const unsigned gen = old / nloc;
        if (old + 1u == (gen + 1u) * nloc) {
            __builtin_amdgcn_fence(__ATOMIC_RELEASE, "agent");
            asm volatile("s_waitcnt vmcnt(0)" ::: "memory");
            const unsigned og = xb_add(&bar[XB_TOP], 1u);
            const unsigned tg = og / nx;
            if (og + 1u == (tg + 1u) * nx) xb_add(&bar[XB_TOPGEN], 1u);
            else XB_SPIN(xb_ld(&bar[XB_TOPGEN]) == tg, bar);
            __builtin_amdgcn_fence(__ATOMIC_ACQUIRE, "agent");
            xb_add(&bar[XB_XGEN(b.x)], 1u);
            asm volatile("s_waitcnt vmcnt(0)" ::: "memory");
        } else {
            XB_SPIN(xb_ld(&bar[XB_XGEN(b.x)]) == gen, bar);
            __builtin_amdgcn_fence(__ATOMIC_ACQUIRE, "agent");
            asm volatile("s_waitcnt vmcnt(0)" ::: "memory");
        }
    }
    __syncthreads();
}

struct Args {
    const float* x_prompt; const float* x_sample; const float* cache_cmp; const float* cache_slc; const float* cache_win;
    const float* st_C; const float* st_n; const float* st_m; const int* page_table; const float* c_prompt; const float* c_sample;
    const float* w_ada; const float* b_ada; const float* w_in; const float* b_gate; const float* ml_norm_g; const float* cmp_pe;
    const float* cmp_w1; const float* cmp_w2; const float* rel_bias; const float* w_out; const float* ln_g; const float* ln_b;
    const float* w_up; const float* w_down;
    float* out; unsigned char* ws; int ph_lo, ph_hi;
};
static_assert(sizeof(Args) == 27 * 8 + 8, "Args has no padding");
typedef const __attribute__((address_space(4))) Args CArgs;

__device__ __forceinline__ int cond_of_row(int r) { return r < MP ? (r >> 13) : BATCH + ((r - MP) >> 2); }

struct EpiInProj {
    static constexpr bool PERM = true, AFTER_DRAIN = false;
    bf16* QKVO; bf16* NQ; float* GATE; float* KVR; bf16* XC; float* out; int l;
    __device__ __forceinline__ void operator()(const f32x4 (&acc)[2][2][4][2], const pg8::Unit& u, int wr, int wc, int fr, int fq) const {
        const int row0 = u.pm * 256 + wr * 64 + fr, pn = u.pn, col8 = wc * 32 + 8 * fq;
#pragma unroll
        for (int ai = 0; ai < 2; ++ai)
#pragma unroll
            for (int m = 0; m < 4; ++m) {
                const int r = row0 + ai * 128 + m * 16;
#pragma unroll
                for (int bj = 0; bj < 2; ++bj) {
                    const f32x4 v0 = acc[ai][bj][m][0], v1 = acc[ai][bj][m][1];
                    const int cc = bj * 128 + col8;
                    if (pn < 10) {
                        v4u w; w.x = pk2(v0[0], v0[1]); w.y = pk2(v0[2], v0[3]); w.z = pk2(v1[0], v1[1]); w.w = pk2(v1[2], v1[3]);
                        if (pn < 8) *(v4u*)(QKVO + (size_t)r * 2048 + pn * 256 + cc) = w;
                        else        *(v4u*)(NQ + (size_t)r * 512 + (pn - 8) * 256 + cc) = w;
                    } else if (pn < 13) {
                        const int kind = pn - 10;
                        float* kr = KVR + ((size_t)kind * M + r) * 256 + cc;
                        *(f32x4*)kr = v0; *(f32x4*)(kr + 4) = v1;
                        float* o = nullptr;
                        if (r < MP) {
                            if (kind < 2) o = out + (kind == 0 ? O_CMPP : O_SLCP) + ((size_t)l * MP + r) * 256 + cc;
                            else { const int t = r & (SEQ - 1); if (t >= SEQ - 512) o = out + O_WINP + (((size_t)l * BATCH + (r >> 13)) * 512 + (t - (SEQ - 512))) * 256 + cc; }
                        } else {
                            const int rs = r - MP;
                            if (kind < 2) o = out + (kind == 0 ? O_CMPS : O_SLCS) + ((size_t)l * MS + rs) * 256 + cc;
                            else o = out + O_WINS + (((size_t)l * DB + (rs >> 2)) * 512 + 508 + (rs & 3)) * 256 + cc;
                        }
                        if (o) { *(f32x4*)o = v0; *(f32x4*)(o + 4) = v1; }
                        if (kind == 0 && r < MP) {
                            v4u w; w.x = pk2(v0[0], v0[1]); w.y = pk2(v0[2], v0[3]); w.z = pk2(v1[0], v1[1]); w.w = pk2(v1[2], v1[3]);
                            *(v4u*)(XC + ((size_t)(bj * 2 + (wc >> 1)) * XCP + r) * 64 + (wc & 1) * 32 + 8 * fq) = w;
                        }
                    } else {
                        if (bj == 0 && wc == 0) { float* gp = GATE + (size_t)r * 32 + 8 * fq; *(f32x4*)gp = v0; *(f32x4*)(gp + 4) = v1; }
                    }
                }
            }
    }
};

struct EpiResid {
    static constexpr bool PERM = true, AFTER_DRAIN = false;
    const float* xa; const float* xb; const float* gate; float* Z;
    __device__ __forceinline__ void operator()(const f32x4 (&acc)[2][2][4][2], const pg8::Unit& u, int wr, int wc, int fr, int fq) const {
        const int row0 = u.pm * 256 + wr * 64 + fr, col0 = u.pn * 256 + wc * 32 + 8 * fq;
#pragma unroll
        for (int ai = 0; ai < 2; ++ai)
#pragma unroll
            for (int m = 0; m < 4; ++m) {
                const int r = row0 + ai * 128 + m * 16;
                const float* xr = (r < MP ? xa + (size_t)r * D : xb + (size_t)(r - MP) * D) + col0;
                const float* gr = gate + (size_t)cond_of_row(r) * 6144 + col0;
                float* zr = Z + (size_t)r * D + col0;
#pragma unroll
                for (int bj = 0; bj < 2; ++bj) {
                    const f32x4 x0 = *(const f32x4*)(xr + bj * 128), x1 = *(const f32x4*)(xr + bj * 128 + 4);
                    const f32x4 g0 = *(const f32x4*)(gr + bj * 128), g1 = *(const f32x4*)(gr + bj * 128 + 4);
                    *(f32x4*)(zr + bj * 128) = x0 * ALPHA + g0 * acc[ai][bj][m][0];
                    *(f32x4*)(zr + bj * 128 + 4) = x1 * ALPHA + g1 * acc[ai][bj][m][1];
                }
            }
    }
};

struct EpiRelu2 {
    static constexpr bool PERM = true, AFTER_DRAIN = false;
    bf16* H;
    __device__ __forceinline__ void operator()(const f32x4 (&acc)[2][2][4][2], const pg8::Unit& u, int wr, int wc, int fr, int fq) const {
        const int row0 = u.pm * 256 + wr * 64 + fr, col0 = u.pn * 256 + wc * 32 + 8 * fq;
#pragma unroll
        for (int ai = 0; ai < 2; ++ai)
#pragma unroll
            for (int m = 0; m < 4; ++m) {
                bf16* hr = H + (size_t)(row0 + ai * 128 + m * 16) * FF + col0;
#pragma unroll
                for (int bj = 0; bj < 2; ++bj) {
                    f32x4 a = acc[ai][bj][m][0], b = acc[ai][bj][m][1];
#pragma unroll
                    for (int i = 0; i < 4; ++i) { a[i] = fmaxf(a[i], 0.f); a[i] *= a[i]; b[i] = fmaxf(b[i], 0.f); b[i] *= b[i]; }
                    v4u w; w.x = pk2(a[0], a[1]); w.y = pk2(a[2], a[3]); w.z = pk2(b[0], b[1]); w.w = pk2(b[2], b[3]);
                    *(v4u*)(hr + bj * 128) = w;
                }
            }
    }
};

__device__ __forceinline__ float gelu_tanh(float x) {
    const float y = 0.7978845608028654f * (x + 0.044715f * x * x * x);
    const float t = 1.f - 2.f / (__expf(2.f * y) + 1.f);
    return 0.5f * x * (1.f + t);
}
struct EpiCmpHid {
    static constexpr bool PERM = true, AFTER_DRAIN = false;
    bf16* HID; const float* B1;
    __device__ __forceinline__ void operator()(const f32x4 (&acc)[2][2][4][2], const pg8::Unit& u, int wr, int wc, int fr, int fq) const {
        const int row0 = u.pm * 256 + wr * 64 + fr, col0 = wc * 32 + 8 * fq;
        const float* bp = B1 + u.pn * 256 + col0;
        f32x4 bv[2][2];
#pragma unroll
        for (int bj = 0; bj < 2; ++bj) { bv[bj][0] = *(const f32x4*)(bp + bj * 128); bv[bj][1] = *(const f32x4*)(bp + bj * 128 + 4); }
#pragma unroll
        for (int ai = 0; ai < 2; ++ai)
#pragma unroll
            for (int m = 0; m < 4; ++m) {
                bf16* hr = HID + (size_t)(row0 + ai * 128 + m * 16) * 256 + col0;
#pragma unroll
                for (int bj = 0; bj < 2; ++bj) {
                    f32x4 a = acc[ai][bj][m][0] + bv[bj][0], b = acc[ai][bj][m][1] + bv[bj][1];
#pragma unroll
                    for (int i = 0; i < 4; ++i) { a[i] = gelu_tanh(a[i]); b[i] = gelu_tanh(b[i]); }
                    v4u w; w.x = pk2(a[0], a[1]); w.y = pk2(a[2], a[3]); w.z = pk2(b[0], b[1]); w.w = pk2(b[2], b[3]);
                    *(v4u*)(hr + bj * 128) = w;
                }
            }
    }
};

struct CmpOrder {
    int G, c, l0, nl, t0, ntile;
    __device__ __forceinline__ bool next(int i, pg8::Unit& u) const {
        const int L = i * G + c; if (L >= nl * 4 * ntile) return false;
        const int blk = L / ntile, tile = L % ntile, l = l0 + (blk >> 2), sg = blk & 3;
        u.pm = (l * 4 + sg) * 68 + t0 + tile; u.pn = l * 2 + (sg >> 1); return true;
    }
    __device__ __forceinline__ void a_ready(const pg8::Unit&) const {}
    __device__ __forceinline__ void done(const pg8::Unit&) const {}
};

#define LDS_WAIT() asm volatile("s_waitcnt lgkmcnt(0)" ::: "memory")
#define VM_WAIT() asm volatile("s_waitcnt vmcnt(0)" ::: "memory")

template <class CM>
__device__ __forceinline__ void transpose_item(const float* W, int ldw, int K, bf16* WT, LAS float* scr, int item, int nblk, int lane, const CM& cm) {
    const int kb = item / nblk, nb = item % nblk, k0 = 64 * kb, n0 = 32 * nb;
    const int sc = cm.col(n0 + (lane & 31)); const float scl = cm.scl(n0 + (lane & 31));
#pragma unroll 8
    for (int i = 0; i < 32; ++i) { const int kk = 2 * i + (lane >> 5); scr[kk * 33 + (lane & 31)] = sc >= 0 ? W[(size_t)(k0 + kk) * ldw + sc] * scl : 0.f; }
    LDS_WAIT();
    const int c = lane & 7;
#pragma unroll
    for (int j = 0; j < 4; ++j) { const int n = (lane >> 3) + 8 * j; const LAS float* s = scr + (8 * c) * 33 + n;
        v4u o; o.x = pk2(s[0 * 33], s[1 * 33]); o.y = pk2(s[2 * 33], s[3 * 33]); o.z = pk2(s[4 * 33], s[5 * 33]); o.w = pk2(s[6 * 33], s[7 * 33]);
        *(v4u*)(WT + (size_t)(n0 + n) * K + k0 + 8 * c) = o; }
    LDS_WAIT();
}
struct CmId { __device__ __forceinline__ int col(int n) const { return n; } __device__ __forceinline__ float scl(int) const { return 1.f; } };
struct CmIn {
    __device__ __forceinline__ int col(int n) const { return n < 2048 ? n : (n < 3328 ? n + 8 : (n < 3336 ? n - 1280 : (n < 3360 ? n : -1))); }
    __device__ __forceinline__ float scl(int n) const { return (n >= 512 && n < 1024) ? 0.08838834764831845f : ((n >= 2048 && n < 2560) ? 0.125f : 1.f); }
};

__device__ __forceinline__ int rel_bucket_dev(int n) {
    if (n < 16) return n;
    const float nf = (float)n;
    int large = 16 + (int)(__logf(nf / 16.f) / 2.0794415416798357f * 16.f);
    return large < 31 ? large : 31;
}

__device__ __forceinline__ void phase_p0a(CArgs& A, LAS unsigned char* lds, int gw, int NGW, int lane, int wave) {
    unsigned char* ws = A.ws;
    LAS float* scr = (LAS float*)(lds + wave * 16384);
    constexpr int I_IN = 16 * 112, I_OUT = 16 * 32, I_UP = 16 * 128, I_DN = 64 * 32, I_W1 = 32 * 8;
    constexpr int I_L = I_IN + I_OUT + I_UP + I_DN + 2 * I_W1;
    for (int it = gw; it < DEPTH * I_L; it += NGW) {
        const int l = it / I_L; int r = it % I_L;
        if (r < I_IN) { transpose_item(A.w_in + (size_t)l * D * 3360, 3360, D, (bf16*)(ws + WS_WIN) + (size_t)l * NINP * D, scr, r, 112, lane, CmIn{}); continue; } r -= I_IN;
        if (r < I_OUT) { transpose_item(A.w_out + (size_t)l * D * D, D, D, (bf16*)(ws + WS_WOUT) + (size_t)l * D * D, scr, r, 32, lane, CmId{}); continue; } r -= I_OUT;
        if (r < I_UP) { transpose_item(A.w_up + (size_t)l * D * FF, FF, D, (bf16*)(ws + WS_WUP) + (size_t)l * FF * D, scr, r, 128, lane, CmId{}); continue; } r -= I_UP;
        if (r < I_DN) { transpose_item(A.w_down + (size_t)l * FF * D, D, FF, (bf16*)(ws + WS_WDN) + (size_t)l * D * FF, scr, r, 32, lane, CmId{}); continue; } r -= I_DN;
        const int s = r / I_W1; r %= I_W1;
        transpose_item(A.cmp_w1 + (size_t)(l * 2 + s) * 2048 * 256, 256, 2048, (bf16*)(ws + WS_W1) + (size_t)(l * 2 + s) * 256 * 2048, scr, r, 8, lane, CmId{});
    }
    for (int it = gw; it < DEPTH * DB * NPG * 2; it += NGW) {
        const int half = it & 1, pg = (it >> 1) & 15, seq = (it >> 5) & 127, l = it >> 12;
        const int phys = A.page_table[seq * NPG + pg];
        const float* src = A.cache_cmp + (((size_t)l * NPHYS + phys) * PAGE + half * 64) * 256 + 4 * lane;
        const int cc = 4 * lane, s = cc >> 7, g = (cc >> 6) & 1, d = cc & 63;
        bf16* dst = (bf16*)(ws + WS_XC) + ((size_t)((l * 2 + s) * 2 + g) * XCP + MP + seq * PAST + pg * PAGE + half * 64) * 64 + d;
#pragma unroll 8
        for (int sl = 0; sl < 64; ++sl) { const f32x4 v = *(const f32x4*)(src + (size_t)sl * 256); v2u w; w.x = pk2(v[0], v[1]); w.y = pk2(v[2], v[3]); *(v2u*)(dst + (size_t)sl * 64) = w; }
    }
    for (int it = gw; it < DEPTH * DB * 8; it += NGW) {
        const int ch = it & 7, ls = it >> 3;
        const float* src = A.cache_win + ((size_t)ls * 512 + 4 + ch * 64) * 256 + 4 * lane;
        float* dst = A.out + O_WINS + ((size_t)ls * 512 + ch * 64) * 256 + 4 * lane;
        const int n = ch == 7 ? 60 : 64;
        for (int i = 0; i < n; ++i) *(f32x4*)(dst + (size_t)i * 256) = *(const f32x4*)(src + (size_t)i * 256);
    }
    for (int it = gw; it < 8; it += NGW) {
        float* BT = (float*)(ws + WS_BT) + it * 132;
        for (int dd = lane; dd < 129; dd += 64) BT[dd] = A.rel_bias[rel_bucket_dev(dd) * 8 + it];
    }
    for (int it = gw; it < DEPTH * 2 * 4; it += NGW) {
        const int ls = it >> 2, h = (it & 3) * 64 + lane;
        const float* pe = A.cmp_pe + (size_t)ls * 2048; const float* w1 = A.cmp_w1 + (size_t)ls * 2048 * 256 + h;
        float acc = 0.f;
        for (int k = 0; k < 2048; ++k) acc += pe[k] * w1[(size_t)k * 256];
        ((float*)(ws + WS_B1))[ls * 256 + h] = acc;
    }
}

__device__ __forceinline__ void phase_ada(CArgs& A, LAS unsigned char* lds, int tid) {
    LAS float* a = (LAS float*)lds;
    for (int task = blockIdx.x; task < DEPTH * 12 * 10; task += gridDim.x) {
        const int rb = task % 10, cb = (task / 10) % 12, l = task / 120;
        __syncthreads();
        for (int i = tid; i < 13 * 1024; i += NTHR) { const int row = rb * 13 + i / 1024, k = i & 1023;
            const float c = row < BATCH ? A.c_prompt[row * D + k] : A.c_sample[(row - BATCH) * D + k]; a[i] = c / (1.f + __expf(-c)); }
        __syncthreads();
        const int j = cb * 512 + tid;
        const float* w = A.w_ada + (size_t)l * D * 6144 + j;
        float acc[13];
#pragma unroll
        for (int r = 0; r < 13; ++r) acc[r] = 0.f;
        for (int k = 0; k < D; ++k) { const float wv = w[(size_t)k * 6144];
#pragma unroll
            for (int r = 0; r < 13; ++r) acc[r] += a[r * 1024 + k] * wv; }
        const float bb = A.b_ada[l * 6144 + j];
        float* o = (float*)(A.ws + WS_ADA) + ((size_t)l * NCOND + rb * 13) * 6144 + j;
#pragma unroll
        for (int r = 0; r < 13; ++r) o[(size_t)r * 6144] = acc[r] + bb;
    }
}

__device__ __forceinline__ void mod_row(const float* xrow, const float* sh, const float* sc, bf16* urow, int lane) {
#pragma unroll
    for (int j = 0; j < 4; ++j) { const int c = 4 * lane + 256 * j;
        const f32x4 x = *(const f32x4*)(xrow + c), a = *(const f32x4*)(sh + c), b = *(const f32x4*)(sc + c);
        v2u w; w.x = pk2(x[0] * (1.f + b[0]) + a[0], x[1] * (1.f + b[1]) + a[1]); w.y = pk2(x[2] * (1.f + b[2]) + a[2], x[3] * (1.f + b[3]) + a[3]);
        *(v2u*)(urow + c) = w; }
}
__device__ __forceinline__ void ln_row(const float* zrow, const float* g, const float* b, float* xout, const float* sh, const float* sc, bf16* urow, int lane) {
    f32x4 v[4]; float s = 0.f;
#pragma unroll
    for (int j = 0; j < 4; ++j) { v[j] = *(const f32x4*)(zrow + 4 * lane + 256 * j); s += (v[j][0] + v[j][1]) + (v[j][2] + v[j][3]); }
    const float mean = wave_sum(s) * (1.f / D); float s2 = 0.f;
#pragma unroll
    for (int j = 0; j < 4; ++j) { v[j] = v[j] - mean; s2 += (v[j][0] * v[j][0] + v[j][1] * v[j][1]) + (v[j][2] * v[j][2] + v[j][3] * v[j][3]); }
    const float rstd = 1.f / sqrtf(wave_sum(s2) * (1.f / D) + LN_EPS);
#pragma unroll
    for (int j = 0; j < 4; ++j) { const int c = 4 * lane + 256 * j;
        const f32x4 gg = *(const f32x4*)(g + c), bb = *(const f32x4*)(b + c);
        const f32x4 x = v[j] * rstd * gg + bb;
        *(f32x4*)(xout + c) = x;
        if (urow) { const f32x4 a = *(const f32x4*)(sh + c), q = *(const f32x4*)(sc + c);
            v2u w; w.x = pk2(x[0] * (1.f + q[0]) + a[0], x[1] * (1.f + q[1]) + a[1]); w.y = pk2(x[2] * (1.f + q[2]) + a[2], x[3] * (1.f + q[3]) + a[3]);
            *(v2u*)(urow + c) = w; } }
}

__device__ __forceinline__ float scan_sum256(float v, LAS float* buf, int tid) {
    const int lane = tid & 63, w = tid >> 6;
#pragma unroll
    for (int o = 1; o < 64; o <<= 1) { const float y = __shfl_up(v, o); if (lane >= o) v += y; }
    __syncthreads();
    if (lane == 63) buf[w] = v;
    __syncthreads();
    float add = 0.f;
#pragma unroll
    for (int i = 0; i < 3; ++i) if (i < w) add += buf[i];
    return v + add;
}
__device__ __forceinline__ float scan_max256(float v, LAS float* buf, int tid) {
    const int lane = tid & 63, w = tid >> 6;
#pragma unroll
    for (int o = 1; o < 64; o <<= 1) { const float y = __shfl_up(v, o); if (lane >= o) v = fmaxf(v, y); }
    __syncthreads();
    if (lane == 63) buf[w] = v;
    __syncthreads();
#pragma unroll
    for (int i = 0; i < 3; ++i) if (i < w) v = fmaxf(v, buf[i]);
    return v;
}
__device__ __forceinline__ void ml_gates(CArgs& A, int l, int r, int h, float& ig, float& lf) {
    const float* G = (const float*)(A.ws + WS_GATE) + (size_t)r * 32;
    ig = G[h] + A.b_gate[l * 8 + h];
    const float fr = G[4 + h] + A.b_gate[l * 8 + 4 + h];
    lf = fminf(fr, 0.f) - log1pf(__expf(-fabsf(fr)));
}

__device__ __forceinline__ void phase_m2(CArgs& A, int l, LAS unsigned char* lds, int tid) {
    LAS float* buf = (LAS float*)lds;
    LAS float* wl = (LAS float*)(lds + 1024);
    const bf16* QKVO = (const bf16*)(A.ws + WS_QKVO);
    for (int unit = blockIdx.x; unit < NUNIT; unit += gridDim.x) {
        const int b = unit >> 7, h = (unit >> 5) & 3, c = unit & 31, r0 = b * SEQ + c * LCH;
        float ig = 0.f, lf = 0.f;
        if (tid < 256) ml_gates(A, l, r0 + tid, h, ig, lf);
        const float F = scan_sum256(lf, buf, tid);
        __syncthreads();
        if (tid == 255) buf[16] = F;
        __syncthreads();
        const float Fend = buf[16];
        const float gl = tid < 256 ? Fend - F + ig : -3.0e38f;
        float mw = wave_max(gl);
        if ((tid & 63) == 0) buf[20 + (tid >> 6)] = mw;
        __syncthreads();
        const float mloc = fmaxf(fmaxf(buf[20], buf[21]), fmaxf(buf[22], buf[23]));
        if (tid < 256) wl[tid] = __expf(gl - mloc);
        if (tid == 0) { float* ch = (float*)(A.ws + WS_CHS) + unit * 4; ch[0] = Fend; ch[1] = mloc; }
        __syncthreads();
        const int k = tid & 127, vq = tid >> 7;
        float acc[32]; float accn = 0.f;
#pragma unroll
        for (int i = 0; i < 32; ++i) acc[i] = 0.f;
        const bf16* kp = QKVO + (size_t)r0 * 2048 + 512 + h * HD + k;
        const bf16* vp = QKVO + (size_t)r0 * 2048 + 1024 + h * HD + 32 * vq;
        for (int s = 0; s < LCH; ++s) {
            const float wk = wl[s] * bf2f(kp[(size_t)s * 2048]);
            accn += wk;
            const v4u* v4 = (const v4u*)(vp + (size_t)s * 2048);
#pragma unroll
            for (int q = 0; q < 4; ++q) { const v4u vv = v4[q];
                acc[8 * q + 0] += wk * bflo(vv.x); acc[8 * q + 1] += wk * bfhi(vv.x); acc[8 * q + 2] += wk * bflo(vv.y); acc[8 * q + 3] += wk * bfhi(vv.y);
                acc[8 * q + 4] += wk * bflo(vv.z); acc[8 * q + 5] += wk * bfhi(vv.z); acc[8 * q + 6] += wk * bflo(vv.w); acc[8 * q + 7] += wk * bfhi(vv.w); }
        }
        float* dct = (float*)(A.ws + WS_DCT) + ((size_t)unit * HD + 32 * vq) * HD + k;
#pragma unroll
        for (int i = 0; i < 32; ++i) dct[(size_t)i * HD] = acc[i];
        if (vq == 0) ((float*)(A.ws + WS_DN))[unit * HD + k] = accn;
        __syncthreads();
    }
}

__device__ __forceinline__ void phase_m3(CArgs& A, int l, int tid) {
    for (int task = blockIdx.x; task < BATCH * NH * 33; task += gridDim.x) {
        const int bh = task / 33, part = task % 33;
        const bool isn = part == 32; if (isn && tid >= HD) continue;
        const int e = isn ? tid : part * 512 + tid;
        const float* chs = (const float*)(A.ws + WS_CHS) + (size_t)bh * NCH * 4;
        float st = 0.f, m0 = 0.f;
        for (int c = 0; c < NCH; ++c) {
            const int unit = bh * NCH + c;
            const float Fend = chs[c * 4], mloc = chs[c * 4 + 1];
            float dv;
            if (isn) { ((float*)(A.ws + WS_NPV))[unit * HD + e] = st; dv = ((const float*)(A.ws + WS_DN))[unit * HD + e]; if (tid == 0) ((float*)(A.ws + WS_CHS))[unit * 4 + 2] = m0; }
            else { ((bf16*)(A.ws + WS_CTP))[(size_t)unit * HD * HD + e] = (bf16)f2bf(st); dv = ((const float*)(A.ws + WS_DCT))[(size_t)unit * HD * HD + e]; }
            const float mend = fmaxf(m0 + Fend, mloc);
            st = __expf(m0 + Fend - mend) * st + __expf(mloc - mend) * dv;
            m0 = mend;
        }
        if (isn) { A.out[O_NP + ((size_t)l * BATCH * NH + bh) * HD + e] = st; if (tid == 0) A.out[O_MP + l * BATCH * NH + bh] = m0; }
        else { const int v = e >> 7, k = e & 127; A.out[O_CP + (((size_t)l * BATCH * NH + bh) * HD + k) * HD + v] = st; }
    }
}

__device__ __forceinline__ void phase_m4(CArgs& A, int l, LAS unsigned char* lds, int tid) {
    LAS float* buf = (LAS float*)lds;
    LAS float* sa = (LAS float*)(lds + 1024);
    LAS float* smx = sa + 256;
    LAS float* sdec = smx + 256;
    LAS float* sem = sdec + 256;
    LAS bf16* sv = (LAS bf16*)(lds + 8192);
    const bf16* QKVO = (const bf16*)(A.ws + WS_QKVO);
    const int lane = tid & 63, wave = tid >> 6;
    for (int unit = blockIdx.x; unit < NUNIT; unit += gridDim.x) {
        const int b = unit >> 7, h = (unit >> 5) & 3, c = unit & 31, r0 = b * SEQ + c * LCH;
        float ig = 0.f, lf = 0.f;
        if (tid < 256) ml_gates(A, l, r0 + tid, h, ig, lf);
        const float F = scan_sum256(lf, buf, tid);
        const float a = tid < 256 ? ig - F : -3.0e38f;
        const float cm = scan_max256(a, buf, tid);
        const float m0 = ((const float*)(A.ws + WS_CHS))[unit * 4 + 2];
        if (tid < 256) { const float mx = fmaxf(m0, cm); sa[tid] = a; smx[tid] = mx; sdec[tid] = __expf(m0 - mx); sem[tid] = __expf(-(F + mx)); }
        for (int i = tid; i < LCH * HD / 8; i += NTHR) { const int s = i >> 4, q = i & 15;
            *(LAS v4u*)(sv + s * HD + 8 * q) = *(const v4u*)(QKVO + (size_t)(r0 + s) * 2048 + 1024 + h * HD + 8 * q); }
        __syncthreads();
        float* W = (float*)(A.ws + WS_WSC) + (size_t)unit * LCH * LCH;
        for (int idx = tid; idx < LCH * LCH; idx += NTHR) {
            const int t = idx >> 8, s = idx & 255; float w = 0.f;
            if (s <= t) {
                const v4u* qp = (const v4u*)(QKVO + (size_t)(r0 + t) * 2048 + h * HD); const v4u* kp = (const v4u*)(QKVO + (size_t)(r0 + s) * 2048 + 512 + h * HD);
                float d = 0.f;
#pragma unroll 4
                for (int q = 0; q < 16; ++q) { const v4u x = qp[q], y = kp[q];
                    d += bflo(x.x) * bflo(y.x) + bfhi(x.x) * bfhi(y.x) + bflo(x.y) * bflo(y.y) + bfhi(x.y) * bfhi(y.y)
                       + bflo(x.z) * bflo(y.z) + bfhi(x.z) * bfhi(y.z) + bflo(x.w) * bflo(y.w) + bfhi(x.w) * bfhi(y.w); }
                w = d * __expf(sa[s] - smx[t]);
            }
            W[idx] = w;
        }
        __syncthreads();
        {
            const int v = tid & 127, tq = tid >> 7;
            const bf16* ctp = (const bf16*)(A.ws + WS_CTP) + ((size_t)unit * HD + v) * HD;
            const float* npv = (const float*)(A.ws + WS_NPV) + unit * HD;
            float* hraw = (float*)(A.ws + WS_HRAW) + (size_t)unit * LCH * HD;
            for (int i = 0; i < 64; ++i) {
                const int t = 4 * i + tq;
                float num = 0.f, den = 0.f;
                const float* wr = W + (size_t)t * LCH;
                for (int s = 0; s <= t; s += 4) { const f32x4 w4 = *(const f32x4*)(wr + s);
                    num += w4[0] * bf2f(sv[(s + 0) * HD + v]) + w4[1] * bf2f(sv[(s + 1) * HD + v]) + w4[2] * bf2f(sv[(s + 2) * HD + v]) + w4[3] * bf2f(sv[(s + 3) * HD + v]);
                    den += (w4[0] + w4[1]) + (w4[2] + w4[3]); }
                float qc = 0.f, qn = 0.f;
                const v4u* qp = (const v4u*)(QKVO + (size_t)(r0 + t) * 2048 + h * HD);
#pragma unroll 4
                for (int q = 0; q < 16; ++q) { const v4u x = qp[q], y = *(const v4u*)(ctp + 8 * q); const f32x4 n0 = *(const f32x4*)(npv + 8 * q), n1 = *(const f32x4*)(npv + 8 * q + 4);
                    qc += bflo(x.x) * bflo(y.x) + bfhi(x.x) * bfhi(y.x) + bflo(x.y) * bflo(y.y) + bfhi(x.y) * bfhi(y.y)
                        + bflo(x.z) * bflo(y.z) + bfhi(x.z) * bfhi(y.z) + bflo(x.w) * bflo(y.w) + bfhi(x.w) * bfhi(y.w);
                    qn += bflo(x.x) * n0[0] + bfhi(x.x) * n0[1] + bflo(x.y) * n0[2] + bfhi(x.y) * n0[3] + bflo(x.z) * n1[0] + bfhi(x.z) * n1[1] + bflo(x.w) * n1[2] + bfhi(x.w) * n1[3]; }
                const float dec = sdec[t];
                const float numt = num + dec * qc, dent = den + dec * qn;
                hraw[(size_t)t * HD + v] = numt / fmaxf(fabsf(dent), sem[t]);
            }
        }
        __syncthreads();
        {
            const float* hraw = (const float*)(A.ws + WS_HRAW) + (size_t)unit * LCH * HD;
            const float g0 = A.ml_norm_g[l * 512 + h * HD + lane], g1 = A.ml_norm_g[l * 512 + h * HD + 64 + lane];
            for (int t = wave; t < LCH; t += NWAVES) {
                const float x0 = hraw[(size_t)t * HD + lane], x1 = hraw[(size_t)t * HD + 64 + lane];
                const float mu = wave_sum(x0 + x1) * (1.f / HD);
                const float d0 = x0 - mu, d1 = x1 - mu;
                const float rstd = 1.f / sqrtf(wave_sum(d0 * d0 + d1 * d1) * (1.f / HD) + LN_EPS);
                const bf16* op = QKVO + (size_t)(r0 + t) * 2048 + 1536 + h * HD;
                bf16* mp = (bf16*)(A.ws + WS_MIX) + (size_t)(r0 + t) * D + h * HD;
                mp[lane] = (bf16)f2bf(d0 * rstd * g0 * sigmoidf_(bf2f(op[lane])));
                mp[64 + lane] = (bf16)f2bf(d1 * rstd * g1 * sigmoidf_(bf2f(op[64 + lane])));
            }
        }
        __syncthreads();
    }
}

__device__ __forceinline__ void phase_mls(CArgs& A, int l, LAS unsigned char* lds, int tid) {
    LAS float* sq = (LAS float*)lds;
    LAS float* sc = sq + 1536;
    LAS float* sw = sc + 64;
    LAS float* part = sw + 16;
    LAS float* red = part + 2048;
    const bf16* QKVO = (const bf16*)(A.ws + WS_QKVO);
    for (int task = blockIdx.x; task < DB * NH; task += gridDim.x) {
        const int seq = task >> 2, h = task & 3, r0 = MP + seq * DS, sidx = (l * DB + seq) * NH + h;
        __syncthreads();
        for (int i = tid; i < 1536; i += NTHR) { const int which = i >> 9, t = (i >> 7) & 3, d = i & 127; sq[i] = bf2f(QKVO[(size_t)(r0 + t) * 2048 + which * 512 + h * HD + d]); }
        const float m0 = A.st_m[sidx];
        if (tid == 0) {
            float F = 0.f, cmx = -3.0e38f, Fs[4], igs[4], mlast = 0.f;
#pragma unroll
            for (int t = 0; t < 4; ++t) { float ig, lf; ml_gates(A, l, r0 + t, h, ig, lf); F += lf; Fs[t] = F; igs[t] = ig; const float a = ig - F; cmx = fmaxf(cmx, a); const float mx = fmaxf(m0, cmx);
                sc[8 + t] = a; sc[12 + t] = mx; sc[16 + t] = __expf(m0 - mx); sc[20 + t] = __expf(-(F + mx)); mlast = F + mx; }
#pragma unroll
            for (int t = 0; t < 4; ++t) sc[24 + t] = __expf(Fs[3] - Fs[t] + igs[t] - mlast);
            sc[28] = __expf(Fs[3] + m0 - mlast); sc[29] = mlast;
        }
        __syncthreads();
        if (tid < 16) { const int t = tid >> 2, s = tid & 3; float w = 0.f;
            if (s <= t) { float d = 0.f; for (int k = 0; k < HD; ++k) d += sq[t * HD + k] * sq[512 + s * HD + k]; w = d * __expf(sc[8 + s] - sc[12 + t]); }
            sw[tid] = w; }
        else if (tid < 20) { const int t = tid - 16; const float* n0 = A.st_n + (size_t)sidx * HD; float d = 0.f; for (int k = 0; k < HD; ++k) d += sq[t * HD + k] * n0[k]; sc[32 + t] = d; }
        __syncthreads();
        {
            const int v = tid & 127, kq = tid >> 7;
            const float* C0 = A.st_C + (size_t)sidx * HD * HD; float* Co = A.out + O_CS + (size_t)sidx * HD * HD;
            const float cd = sc[28];
            float wv[4]; float qc[4] = {0.f, 0.f, 0.f, 0.f};
#pragma unroll
            for (int t = 0; t < 4; ++t) wv[t] = sc[24 + t] * sq[1024 + t * HD + v];
            for (int kk = 0; kk < 32; ++kk) { const int k = kq * 32 + kk; const float c0 = C0[(size_t)k * HD + v];
                float cn = cd * c0;
#pragma unroll
                for (int t = 0; t < 4; ++t) { qc[t] += sq[t * HD + k] * c0; cn += wv[t] * sq[512 + t * HD + k]; }
                Co[(size_t)k * HD + v] = cn; }
#pragma unroll
            for (int t = 0; t < 4; ++t) part[(kq * 4 + t) * HD + v] = qc[t];
        }
        __syncthreads();
        float hv[4] = {0.f, 0.f, 0.f, 0.f};
        if (tid < HD) {
            const int v = tid;
#pragma unroll
            for (int t = 0; t < 4; ++t) { const float qct = part[(0 * 4 + t) * HD + v] + part[(1 * 4 + t) * HD + v] + part[(2 * 4 + t) * HD + v] + part[(3 * 4 + t) * HD + v];
                float num = sc[16 + t] * qct, den = sc[16 + t] * sc[32 + t];
#pragma unroll
                for (int s = 0; s < 4; ++s) { num += sw[t * 4 + s] * sq[1024 + s * HD + v]; den += sw[t * 4 + s]; }
                hv[t] = num / fmaxf(fabsf(den), sc[20 + t]); }
        }
#pragma unroll
        for (int t = 0; t < 4; ++t) { const float s1 = wave_sum(hv[t]); if ((tid & 63) == 0 && tid < HD) red[t * 2 + (tid >> 6)] = s1; }
        __syncthreads();
        float dv[4];
#pragma unroll
        for (int t = 0; t < 4; ++t) { dv[t] = hv[t] - (red[t * 2] + red[t * 2 + 1]) * (1.f / HD); const float s2 = wave_sum(dv[t] * dv[t]); if ((tid & 63) == 0 && tid < HD) red[8 + t * 2 + (tid >> 6)] = s2; }
        __syncthreads();
        if (tid < HD) {
            const int v = tid; const float gn = A.ml_norm_g[l * 512 + h * HD + v];
#pragma unroll
            for (int t = 0; t < 4; ++t) { const float rstd = 1.f / sqrtf((red[8 + t * 2] + red[8 + t * 2 + 1]) * (1.f / HD) + LN_EPS);
                const float og = bf2f(QKVO[(size_t)(r0 + t) * 2048 + 1536 + h * HD + v]);
                ((bf16*)(A.ws + WS_MIX))[(size_t)(r0 + t) * D + h * HD + v] = (bf16)f2bf(dv[t] * rstd * gn * sigmoidf_(og)); }
        } else if (tid < 2 * HD) {
            const int k = tid - HD; float nn = sc[28] * A.st_n[(size_t)sidx * HD + k];
#pragma unroll
            for (int t = 0; t < 4; ++t) nn += sc[24 + t] * sq[512 + t * HD + k];
            A.out[O_NS + (size_t)sidx * HD + k] = nn;
        }
        if (tid == 0) A.out[O_MS + sidx] = sc[29];
    }
}

__device__ __forceinline__ void phase_cmp2(CArgs& A, int l0, int nl, int r_lo, int nrows, int tid) {
    const int d = tid & 63, rr = tid >> 6, ntask_img = nrows / 8;
    for (int task = blockIdx.x; task < nl * 4 * ntask_img; task += gridDim.x) {
        const int img = task / ntask_img, tr = task % ntask_img, l = l0 + (img >> 2), sg = img & 3, s = sg >> 1;
        const size_t row = (size_t)(l * 4 + sg) * NCB + r_lo + tr * 8 + rr;
        const v4u* hp = (const v4u*)((const bf16*)(A.ws + WS_HID) + row * 256);
        const float* w2 = A.cmp_w2 + (size_t)(l * 2 + s) * 256 * 64 + d;
        float acc = 0.f;
#pragma unroll 4
        for (int q = 0; q < 32; ++q) { const v4u x = hp[q]; const float* w = w2 + (size_t)q * 8 * 64;
            acc += bflo(x.x) * w[0] + bfhi(x.x) * w[64] + bflo(x.y) * w[128] + bfhi(x.y) * w[192] + bflo(x.z) * w[256] + bfhi(x.z) * w[320] + bflo(x.w) * w[384] + bfhi(x.w) * w[448]; }
        const int g = sg & 1, rimg = r_lo + tr * 8 + rr;
        if (s == 0) ((bf16*)(A.ws + WS_KC))[((size_t)(l * 2 + g) * NCB + rimg) * 64 + d] = (bf16)f2bf(acc);
        else        ((bf16*)(A.ws + WS_VCT))[((size_t)(l * 2 + g) * 64 + d) * NCB + rimg] = (bf16)f2bf(acc);
    }
}

#define NEGBIG (-3.0e38f)
template <int NB, class KF>
__device__ __forceinline__ void attend(const KF& kf, int nblk, const LAS float* qs, LAS float* pb, const float* BT, int hbase, int lane, float (&o)[4]) {
    float s[NB][4]; float mx[4] = {NEGBIG, NEGBIG, NEGBIG, NEGBIG};
#pragma unroll
    for (int it = 0; it < NB; ++it) {
        if (it < nblk) {
            const int p = kf.key(it, lane); const bool ok = kf.ok(p); const int pc = kf.clampk(p);
            const float* kr = kf.krow(pc);
            float d0 = 0.f, d1 = 0.f, d2 = 0.f, d3 = 0.f;
#pragma unroll 4
            for (int dd = 0; dd < 64; dd += 4) { const f32x4 k4 = *(const f32x4*)(kr + dd);
                const f32x4 q0 = *(const LAS f32x4*)(qs + dd), q1 = *(const LAS f32x4*)(qs + 64 + dd), q2 = *(const LAS f32x4*)(qs + 128 + dd), q3 = *(const LAS f32x4*)(qs + 192 + dd);
                d0 += k4[0] * q0[0] + k4[1] * q0[1] + k4[2] * q0[2] + k4[3] * q0[3]; d1 += k4[0] * q1[0] + k4[1] * q1[1] + k4[2] * q1[2] + k4[3] * q1[3];
                d2 += k4[0] * q2[0] + k4[1] * q2[1] + k4[2] * q2[2] + k4[3] * q2[3]; d3 += k4[0] * q3[0] + k4[1] * q3[1] + k4[2] * q3[2] + k4[3] * q3[3]; }
            int dist = kf.dist(pc); dist = dist < 0 ? 0 : (dist > 128 ? 128 : dist);
            const float* bt = BT + hbase * 132 + dist;
            s[it][0] = ok ? d0 + bt[0] : NEGBIG; s[it][1] = ok ? d1 + bt[132] : NEGBIG; s[it][2] = ok ? d2 + bt[264] : NEGBIG; s[it][3] = ok ? d3 + bt[396] : NEGBIG;
#pragma unroll
            for (int r = 0; r < 4; ++r) mx[r] = fmaxf(mx[r], s[it][r]);
        } else {
#pragma unroll
            for (int r = 0; r < 4; ++r) s[it][r] = NEGBIG;
        }
    }
    float sum[4], inv[4];
#pragma unroll
    for (int r = 0; r < 4; ++r) { mx[r] = wave_max(mx[r]); sum[r] = 0.f; }
#pragma unroll
    for (int it = 0; it < NB; ++it)
#pragma unroll
        for (int r = 0; r < 4; ++r) { const float e = s[it][r] > -1.0e37f ? __expf(s[it][r] - mx[r]) : 0.f; s[it][r] = e; sum[r] += e; }
#pragma unroll
    for (int r = 0; r < 4; ++r) { sum[r] = wave_sum(sum[r]); inv[r] = sum[r] > 0.f ? 1.f / sum[r] : 0.f; }
#pragma unroll
    for (int it = 0; it < NB; ++it) {
        if (it < nblk) {
            f32x4 p4; p4[0] = s[it][0] * inv[0]; p4[1] = s[it][1] * inv[1]; p4[2] = s[it][2] * inv[2]; p4[3] = s[it][3] * inv[3];
            asm volatile("" ::: "memory");
            *(LAS f32x4*)(pb + 4 * lane) = p4;
            kf.emit(it, lane, p4);
            LDS_WAIT();
            const int nk = kf.nkeys(it);
            for (int kk = 0; kk < nk; ++kk) {
                const float v = kf.vrow(it, kk)[lane];
                const f32x4 w = *(const LAS f32x4*)(pb + 4 * kk);
                o[0] += w[0] * v; o[1] += w[1] * v; o[2] += w[2] * v; o[3] += w[3] * v;
            }
            LDS_WAIT();
        }
    }
}

struct SeqCtx { bool smp; int bs; int qpos; int l; int g; CArgs* A; };

struct KfCmp {
    const float* CK; const float* CV; int ncv, qpos; LAS float* ps;
    __device__ __forceinline__ int key(int it, int lane) const { return 64 * it + lane; }
    __device__ __forceinline__ bool ok(int n) const { return n < ncv; }
    __device__ __forceinline__ int clampk(int n) const { return n < ncv ? n : ncv - 1; }
    __device__ __forceinline__ const float* krow(int n) const { return CK + (size_t)n * 64; }
    __device__ __forceinline__ int dist(int n) const { return qpos - 16 * n - 31; }
    __device__ __forceinline__ void emit(int it, int lane, const f32x4& p) const { ps[64 * it + lane] = (p[0] + p[1]) + (p[2] + p[3]); }
    __device__ __forceinline__ int nkeys(int it) const { const int r = ncv - 64 * it; return r < 64 ? r : 64; }
    __device__ __forceinline__ const float* vrow(int it, int kk) const { return CV + (size_t)(64 * it + kk) * 64; }
};
struct KfSel {
    SeqCtx c; const float* kvr; int j[16];
    __device__ __forceinline__ const float* row(int p) const {
        if (!c.smp) return kvr + ((size_t)(c.bs * SEQ + p)) * 256 + c.g * 64;
        if (p >= PAST) return kvr + ((size_t)(MP + c.bs * DS + p - PAST)) * 256 + c.g * 64;
        return c.A->cache_slc + (((size_t)c.l * NPHYS + c.A->page_table[c.bs * NPG + (p >> 7)]) * PAGE + (p & 127)) * 256 + c.g * 64;
    }
    __device__ __forceinline__ int key(int it, int lane) const { return 64 * j[it] + lane; }
    __device__ __forceinline__ int nkeys(int it) const { const int r = c.qpos - 64 * j[it] + 1; return r < 64 ? (r > 0 ? r : 0) : 64; }
    __device__ __forceinline__ const float* vrow(int it, int kk) const { return row(64 * j[it] + kk) + 128; }
    __device__ __forceinline__ bool ok(int p) const { return p <= c.qpos; }
    __device__ __forceinline__ int clampk(int p) const { return p <= c.qpos ? p : c.qpos; }
    __device__ __forceinline__ const float* krow(int p) const { return row(p); }
    __device__ __forceinline__ int dist(int p) const { return c.qpos - p; }
    __device__ __forceinline__ void emit(int, int, const f32x4&) const {}
};
struct KfWin {
    SeqCtx c; const float* kvr; int lo;
    __device__ __forceinline__ const float* row(int p) const {
        if (!c.smp) return kvr + ((size_t)(c.bs * SEQ + p)) * 256 + c.g * 64;
        if (p >= PAST) return kvr + ((size_t)(MP + c.bs * DS + p - PAST)) * 256 + c.g * 64;
        return c.A->cache_win + (((size_t)c.l * DB + c.bs) * 512 + (p - (PAST - 512))) * 256 + c.g * 64;
    }
    __device__ __forceinline__ int key(int it, int lane) const { return c.qpos - 511 + 64 * it + lane; }
    __device__ __forceinline__ bool ok(int p) const { return p >= lo; }
    __device__ __forceinline__ int clampk(int p) const { return p >= lo ? p : lo; }
    __device__ __forceinline__ const float* krow(int p) const { return row(p); }
    __device__ __forceinline__ int dist(int p) const { return c.qpos - p; }
    __device__ __forceinline__ void emit(int, int, const f32x4&) const {}
    __device__ __forceinline__ int nkeys(int) const { return 64; }
    __device__ __forceinline__ const float* vrow(int it, int kk) const { const int p = c.qpos - 511 + 64 * it + kk; return row(p >= lo ? p : lo) + 128; }
};

__device__ __forceinline__ void topk_sel(float imp0, float imp1, int cur, int lane, unsigned long long& s0, unsigned long long& s1) {
    const int nforced = cur == 0 ? 1 : (cur == 1 ? 2 : 3), need = 16 - nforced, ncand = cur - 2 > 0 ? cur - 2 : 0;
    const unsigned k0 = (lane >= 1 && lane <= cur - 2) ? __builtin_bit_cast(unsigned, imp0) + 1u : 0u;
    const unsigned k1 = (lane + 64 <= cur - 2) ? __builtin_bit_cast(unsigned, imp1) + 1u : 0u;
    unsigned long long c0, c1;
    if (ncand <= need) { c0 = __ballot(k0 != 0u); c1 = __ballot(k1 != 0u); }
    else {
        unsigned T = 0u;
        for (int bit = 31; bit >= 0; --bit) { const unsigned cand = T | (1u << bit);
            const int cnt = __popcll(__ballot(k0 >= cand)) + __popcll(__ballot(k1 >= cand)); if (cnt >= need) T = cand; }
        const unsigned long long g0 = __ballot(k0 > T), g1 = __ballot(k1 > T); unsigned long long e0 = __ballot(k0 == T), e1 = __ballot(k1 == T);
        int rem = need - __popcll(g0) - __popcll(g1);
        unsigned long long t0 = 0ull, t1 = 0ull;
        while (rem > 0 && e0) { const unsigned long long lb = e0 & (~e0 + 1ull); t0 |= lb; e0 ^= lb; --rem; }
        while (rem > 0 && e1) { const unsigned long long lb = e1 & (~e1 + 1ull); t1 |= lb; e1 ^= lb; --rem; }
        c0 = g0 | t0; c1 = g1 | t1;
    }
    unsigned long long f0 = 1ull, f1 = 0ull;
    if (cur < 64) f0 |= 1ull << cur; else f1 |= 1ull << (cur - 64);
    if (cur >= 1) { if (cur - 1 < 64) f0 |= 1ull << (cur - 1); else f1 |= 1ull << (cur - 65); }
    s0 = c0 | f0; s1 = c1 | f1;
}

__device__ __forceinline__ void nsa_wave(CArgs& A, int l, int r, int g, LAS float* wl, int lane) {
    LAS float* qs = wl;
    LAS float* pb = wl + 256;
    LAS float* ps = wl + 512;
    const bool smp = r >= MP; const int bs = smp ? (r - MP) >> 2 : r >> 13; const int qpos = smp ? PAST + ((r - MP) & 3) : (r & (SEQ - 1));
    const float* BT = (const float*)(A.ws + WS_BT);
    const float* KVR = (const float*)(A.ws + WS_KVR);
    {   const bf16* qp = (const bf16*)(A.ws + WS_NQ) + (size_t)r * 512 + g * 256;
#pragma unroll
        for (int i = 0; i < 4; ++i) qs[64 * i + lane] = bf2f(qp[64 * i + lane]); }
    for (int i = lane; i < 520; i += 64) ps[i] = 0.f;
    LDS_WAIT();
    SeqCtx cx{smp, bs, qpos, l, g, &A};
    float out[4] = {0.f, 0.f, 0.f, 0.f};
    const float* gt = (const float*)(A.ws + WS_GATE) + (size_t)r * 32 + 8 + g * 12;
    {
        const int ncv = qpos >= 31 ? ((qpos - 31) >> 4) + 1 : 0;
        const int gc0 = smp ? 1024 + bs * 128 : bs * 512;
        if (ncv > 0) {
            KfCmp kf{(const float*)(A.ws + WS_CKV) + ((size_t)((l * 2 + 0) * 2 + g) * NCB + gc0) * 64, (const float*)(A.ws + WS_CKV) + ((size_t)((l * 2 + 1) * 2 + g) * NCB + gc0) * 64, ncv, qpos, ps};
            float o[4] = {0.f, 0.f, 0.f, 0.f};
            attend<8, KfCmp>(kf, (ncv + 63) >> 6, qs, pb, BT, g * 4, lane, o);
#pragma unroll
            for (int rr = 0; rr < 4; ++rr) out[rr] += sigmoidf_(gt[rr * 3 + 0]) * o[rr];
        }
    }
    LDS_WAIT();
    unsigned long long s0, s1;
    {
        float imp0 = 0.f, imp1 = 0.f;
#pragma unroll
        for (int i = -1; i < 4; ++i) { const int n0 = 4 * lane + i, n1 = 4 * (lane + 64) + i; if (n0 >= 0) imp0 += ps[n0]; imp1 += ps[n1]; }
        topk_sel(imp0, imp1, qpos >> 6, lane, s0, s1);
    }
    {
        KfSel kf; kf.c = cx; kf.kvr = KVR + (size_t)1 * M * 256;
        int nb = 0; unsigned long long m0 = s0, m1 = s1;
#pragma unroll
        for (int it = 0; it < 16; ++it) {
            if (m0) { kf.j[it] = __builtin_ctzll(m0); m0 &= m0 - 1ull; ++nb; }
            else if (m1) { kf.j[it] = 64 + __builtin_ctzll(m1); m1 &= m1 - 1ull; ++nb; }
            else kf.j[it] = 0;
        }
        float o[4] = {0.f, 0.f, 0.f, 0.f};
        attend<16, KfSel>(kf, nb, qs, pb, BT, g * 4, lane, o);
#pragma unroll
        for (int rr = 0; rr < 4; ++rr) out[rr] += sigmoidf_(gt[rr * 3 + 1]) * o[rr];
    }
    {
        KfWin kf{cx, KVR + (size_t)2 * M * 256, smp ? PAST - 512 : 0};
        float o[4] = {0.f, 0.f, 0.f, 0.f};
        attend<8, KfWin>(kf, 8, qs, pb, BT, g * 4, lane, o);
#pragma unroll
        for (int rr = 0; rr < 4; ++rr) out[rr] += sigmoidf_(gt[rr * 3 + 2]) * o[rr];
    }
    bf16* mp = (bf16*)(A.ws + WS_MIX) + (size_t)r * D + 512 + g * 256 + lane;
#pragma unroll
    for (int rr = 0; rr < 4; ++rr) mp[rr * 64] = (bf16)f2bf(out[rr]);
}

typedef short bf16x8 __attribute__((ext_vector_type(8)));
#define MFMA16(a, b, c) __builtin_amdgcn_mfma_f32_16x16x32_bf16((a), (b), (c), 0, 0, 0)
constexpr int TOTS = MP + DB * 2112, TOTW = MP + DB * 528, TOTWP = TOTW + 64;
constexpr size_t KS_L = (size_t)2 * TOTS * 64, KW_L = (size_t)2 * TOTWP * 64, KC_L = (size_t)2 * NCB * 64;

__device__ __forceinline__ void kv_tile64(const float* src, bf16* Kimg, size_t kgs, bf16* Vt, size_t vgs, size_t vpitch, size_t gp0, LAS bf16* scr, int lane) {
    const int cc = 4 * lane, s = cc >> 7, g = (cc >> 6) & 1, d = cc & 63;
#pragma unroll 8
    for (int sl = 0; sl < 64; ++sl) {
        const f32x4 v = *(const f32x4*)(src + (size_t)sl * 256 + cc);
        v2u w; w.x = pk2(v[0], v[1]); w.y = pk2(v[2], v[3]);
        if (s == 0) *(v2u*)(Kimg + (size_t)g * kgs + (gp0 + sl) * 64 + d) = w;
        else *(LAS v2u*)(scr + sl * 128 + (cc - 128)) = w;
    }
    LDS_WAIT();
#pragma unroll
    for (int g2 = 0; g2 < 2; ++g2) {
        const int gd = lane + 64 * g2;
        bf16* dst = Vt + (size_t)g2 * vgs + (size_t)lane * vpitch + gp0;
#pragma unroll
        for (int oc = 0; oc < 8; ++oc) {
            const LAS bf16* p = scr + (8 * oc) * 128 + gd;
            v4u o; o.x = (unsigned)p[0] | ((unsigned)p[128] << 16); o.y = (unsigned)p[256] | ((unsigned)p[384] << 16); o.z = (unsigned)p[512] | ((unsigned)p[640] << 16); o.w = (unsigned)p[768] | ((unsigned)p[896] << 16);
            *(v4u*)(dst + 8 * oc) = o;
        }
    }
    LDS_WAIT();
}

__device__ __forceinline__ void prep_cache_images(CArgs& A, LAS unsigned char* lds, int gw, int NGW, int lane, int wave) {
    LAS bf16* scr = (LAS bf16*)(lds + wave * 16384);
    bf16* KS = (bf16*)(A.ws + WS_KS); bf16* VTS = (bf16*)(A.ws + WS_VTS); bf16* KW = (bf16*)(A.ws + WS_KW); bf16* VTW = (bf16*)(A.ws + WS_VTW);
    for (int it = gw; it < DEPTH * DB * 32; it += NGW) {
        const int ti = it & 31, seq = (it >> 5) & 127, l = it >> 12;
        const int phys = A.page_table[seq * NPG + (ti >> 1)];
        const float* src = A.cache_slc + (((size_t)l * NPHYS + phys) * PAGE + (ti & 1) * 64) * 256;
        kv_tile64(src, KS + l * KS_L, (size_t)TOTS * 64, VTS + l * KS_L, (size_t)64 * TOTS, TOTS, (size_t)MP + seq * 2112 + ti * 64, scr, lane);
    }
    for (int it = gw; it < DEPTH * DB * 8; it += NGW) {
        const int ti = it & 7, ls = it >> 3, seq = ls & 127, l = ls >> 7;
        const float* src = A.cache_win + ((size_t)ls * 512 + ti * 64) * 256;
        kv_tile64(src, KW + l * KW_L, (size_t)TOTWP * 64, VTW + l * KW_L, (size_t)64 * TOTWP, TOTWP, (size_t)MP + seq * 528 + ti * 64, scr, lane);
    }
}
__device__ __forceinline__ void prep_layer_images(CArgs& A, int l, LAS unsigned char* lds, int gw, int NGW, int lane, int wave) {
    LAS bf16* scr = (LAS bf16*)(lds + wave * 16384);
    bf16* KS = (bf16*)(A.ws + WS_KS) + l * KS_L; bf16* VTS = (bf16*)(A.ws + WS_VTS) + l * KS_L; bf16* KW = (bf16*)(A.ws + WS_KW) + l * KW_L; bf16* VTW = (bf16*)(A.ws + WS_VTW) + l * KW_L;
    const float* KVR = (const float*)(A.ws + WS_KVR);
    for (int it = gw; it < 2 * (MP / 64); it += NGW) {
        const int kind = it / (MP / 64), ti = it % (MP / 64);
        const float* src = KVR + ((size_t)(1 + kind) * M + ti * 64) * 256;
        if (kind == 0) kv_tile64(src, KS, (size_t)TOTS * 64, VTS, (size_t)64 * TOTS, TOTS, (size_t)ti * 64, scr, lane);
        else           kv_tile64(src, KW, (size_t)TOTWP * 64, VTW, (size_t)64 * TOTWP, TOTWP, (size_t)ti * 64, scr, lane);
    }
    for (int it = gw; it < 2 * DB; it += NGW) {
        const int kind = it / DB, seq = it % DB;
        const float* src = KVR + ((size_t)(1 + kind) * M + MP + seq * DS) * 256;
        bf16* Kimg = kind == 0 ? KS : KW; bf16* Vt = kind == 0 ? VTS : VTW;
        const size_t tot = kind == 0 ? TOTS : TOTWP, gp0 = kind == 0 ? (size_t)MP + seq * 2112 + PAST : (size_t)MP + seq * 528 + 512;
        const int cc = 4 * lane, s = cc >> 7, g = (cc >> 6) & 1, d = cc & 63;
#pragma unroll
        for (int t = 0; t < DS; ++t) {
            const f32x4 v = *(const f32x4*)(src + (size_t)t * 256 + cc);
            if (s == 0) { v2u w; w.x = pk2(v[0], v[1]); w.y = pk2(v[2], v[3]); *(v2u*)(Kimg + (size_t)g * tot * 64 + (gp0 + t) * 64 + d) = w; }
            else {
#pragma unroll
                for (int i = 0; i < 4; ++i) Vt[(size_t)g * 64 * tot + (size_t)(d + i) * tot + gp0 + t] = (bf16)f2bf(v[i]);
            }
        }
    }
}

__device__ __forceinline__ void qk_block(const bf16* Kb, const bf16x8 (&q)[2], int fr, int fq, f32x4 (&st)[4]) {
#pragma unroll
    for (int t = 0; t < 4; ++t) {
        const bf16x8 k0 = *(const bf16x8*)(Kb + (size_t)(16 * t + fr) * 64 + 8 * fq), k1 = *(const bf16x8*)(Kb + (size_t)(16 * t + fr) * 64 + 32 + 8 * fq);
        f32x4 z = {0.f, 0.f, 0.f, 0.f};
        z = MFMA16(k0, q[0], z); st[t] = MFMA16(k1, q[1], z);
    }
}
__device__ __forceinline__ void pv_block(const bf16* Vb, size_t pitch, int fr, int fq, const f32x4 (&st)[4], f32x4 (&o)[4]) {
#pragma unroll
    for (int h = 0; h < 2; ++h) {
        v4u pw; pw.x = pk2(st[2 * h][0], st[2 * h][1]); pw.y = pk2(st[2 * h][2], st[2 * h][3]); pw.z = pk2(st[2 * h + 1][0], st[2 * h + 1][1]); pw.w = pk2(st[2 * h + 1][2], st[2 * h + 1][3]);
        const bf16x8 pf = __builtin_bit_cast(bf16x8, pw);
#pragma unroll
        for (int dt = 0; dt < 4; ++dt) {
            const bf16* vp = Vb + (size_t)(16 * dt + fr) * pitch + 32 * h + 4 * fq;
            const v2u a = *(const v2u*)vp, b = *(const v2u*)(vp + 16);
            v4u vw; vw.x = a.x; vw.y = a.y; vw.z = b.x; vw.w = b.y;
            o[dt] = MFMA16(__builtin_bit_cast(bf16x8, vw), pf, o[dt]);
        }
    }
}
__device__ __forceinline__ float xfq_max(float v) { v = fmaxf(v, __shfl_xor(v, 16)); return fmaxf(v, __shfl_xor(v, 32)); }
__device__ __forceinline__ float xfq_sum(float v) { v += __shfl_xor(v, 16); return v + __shfl_xor(v, 32); }
__device__ __forceinline__ float quad_sum(float v) { v += __shfl_xor(v, 1); return v + __shfl_xor(v, 2); }

__device__ __forceinline__ void softmax_pv(const bf16* Vb, size_t pitch, int fr, int fq, f32x4 (&st)[4], f32x4 (&o)[4], float& m, float& ls) {
    float bm = -INFINITY;
#pragma unroll
    for (int t = 0; t < 4; ++t) bm = fmaxf(bm, fmaxf(fmaxf(st[t][0], st[t][1]), fmaxf(st[t][2], st[t][3])));
    bm = xfq_max(bm);
    const float mn = fmaxf(m, bm), sc = __expf(m - mn);
    m = mn; ls *= sc;
#pragma unroll
    for (int dt = 0; dt < 4; ++dt) o[dt] = o[dt] * sc;
#pragma unroll
    for (int t = 0; t < 4; ++t)
#pragma unroll
        for (int i = 0; i < 4; ++i) { const float p = __expf(st[t][i] - mn); st[t][i] = p; ls += p; }
    pv_block(Vb, pitch, fr, fq, st, o);
}

__device__ __forceinline__ void nsa_tile(CArgs& A, int l, int task, LAS float* wl, const LAS float* BT, int lane) {
    const int fr = lane & 15, fq = lane >> 4, tl = fr >> 2, rr = fr & 3;
    bool smp; int bs, g, qpos0, row0;
    if (task < 4 * 2048) { const int c = task >> 11, tq0 = task & 2047, tq = (c & 1) ? 2047 - tq0 : tq0; smp = false; bs = c >> 1; g = c & 1; qpos0 = 4 * tq; row0 = bs * SEQ + qpos0; }
    else { const int t2 = task - 4 * 2048; smp = true; bs = t2 >> 1; g = t2 & 1; qpos0 = PAST; row0 = MP + bs * DS; }
    const int qpos = qpos0 + tl, cur = qpos0 >> 6, h = g * 4 + rr;
    const size_t sbase = smp ? (size_t)MP + bs * 2112 : (size_t)bs * SEQ;
    const long wbase = smp ? (long)MP + bs * 528 - (PAST - 512) : (long)bs * SEQ;
    const size_t cbase = smp ? (size_t)1024 + bs * 128 : (size_t)bs * 512;
    const bf16* KS = (const bf16*)(A.ws + WS_KS) + l * KS_L + (size_t)g * TOTS * 64; const bf16* VTS = (const bf16*)(A.ws + WS_VTS) + l * KS_L + (size_t)g * 64 * TOTS;
    const bf16* KW = (const bf16*)(A.ws + WS_KW) + l * KW_L + (size_t)g * TOTWP * 64; const bf16* VTW = (const bf16*)(A.ws + WS_VTW) + l * KW_L + (size_t)g * 64 * TOTWP;
    const bf16* KC = (const bf16*)(A.ws + WS_KC) + l * KC_L + (size_t)g * NCB * 64; const bf16* VCT = (const bf16*)(A.ws + WS_VCT) + l * KC_L + (size_t)g * 64 * NCB;
    const LAS float* bt = BT + h * 132;
    const float farb = bt[128];
    bf16x8 q[2];
    {   const bf16* qp = (const bf16*)(A.ws + WS_NQ) + (size_t)(row0 + tl) * 512 + g * 256 + rr * 64 + 8 * fq;
        q[0] = *(const bf16x8*)qp; q[1] = *(const bf16x8*)(qp + 32); }
    const float* gt = (const float*)(A.ws + WS_GATE) + (size_t)(row0 + tl) * 32 + 8 + h * 3;
    const float gc = sigmoidf_(gt[0]), gs = sigmoidf_(gt[1]), gwn = sigmoidf_(gt[2]);
    f32x4 out[4];
#pragma unroll
    for (int dt = 0; dt < 4; ++dt) out[dt] = (f32x4){0.f, 0.f, 0.f, 0.f};
    LAS float* impA = wl;
    LAS float* impB = wl + 544;
    for (int i = lane; i < 1088; i += 64) wl[i] = 0.f;
    LDS_WAIT();

    {
        const int ncv_max = qpos0 + 3 >= 31 ? ((qpos0 + 3 - 31) >> 4) + 1 : 0, nb64 = (ncv_max + 63) >> 6;
        float m = -1.0e30f, ls = 0.f;
        for (int ib = 0; ib < nb64; ++ib) {
            f32x4 st[4]; qk_block(KC + (cbase + 64 * ib) * 64, q, fr, fq, st);
            float bm = -INFINITY;
#pragma unroll
            for (int t = 0; t < 4; ++t)
#pragma unroll
                for (int i = 0; i < 4; ++i) { const int n = 64 * ib + 16 * t + 4 * fq + i; const int dist = qpos - 16 * n - 31;
                    const float s = dist >= 0 ? st[t][i] + bt[dist > 128 ? 128 : dist] : -INFINITY; st[t][i] = s; bm = fmaxf(bm, s); }
            bm = xfq_max(bm);
            const float mn = fmaxf(m, bm); ls *= __expf(m - mn); m = mn;
#pragma unroll
            for (int t = 0; t < 4; ++t)
#pragma unroll
                for (int i = 0; i < 4; ++i) ls += __expf(st[t][i] - mn);
        }
        ls = xfq_sum(ls);
        const float inv = ls > 0.f ? 1.f / ls : 0.f;
        f32x4 o[4];
#pragma unroll
        for (int dt = 0; dt < 4; ++dt) o[dt] = (f32x4){0.f, 0.f, 0.f, 0.f};
        for (int ib = 0; ib < nb64; ++ib) {
            f32x4 st[4]; qk_block(KC + (cbase + 64 * ib) * 64, q, fr, fq, st);
#pragma unroll
            for (int t = 0; t < 4; ++t) {
#pragma unroll
                for (int i = 0; i < 4; ++i) { const int n = 64 * ib + 16 * t + 4 * fq + i; const int dist = qpos - 16 * n - 31;
                    st[t][i] = dist >= 0 ? __expf(st[t][i] + bt[dist > 128 ? 128 : dist] - m) * inv : 0.f; }
                const float s4 = quad_sum((st[t][0] + st[t][1]) + (st[t][2] + st[t][3])), s3 = quad_sum(st[t][3]);
                const int j0 = 16 * ib + 4 * t + fq;
                if (rr == 0) { impA[tl * 136 + j0] = s4; impB[tl * 136 + j0 + 1] = s3; }
            }
            pv_block(VCT + cbase + 64 * ib, NCB, fr, fq, st, o);
        }
#pragma unroll
        for (int dt = 0; dt < 4; ++dt) out[dt] = out[dt] + o[dt] * gc;
    }
    LDS_WAIT();
    unsigned long long s0[4], s1[4];
#pragma unroll
    for (int t = 0; t < 4; ++t) topk_sel(impA[t * 136 + lane] + impB[t * 136 + lane], impA[t * 136 + 64 + lane] + impB[t * 136 + 64 + lane], cur, lane, s0[t], s1[t]);
    const unsigned long long my0 = tl == 0 ? s0[0] : (tl == 1 ? s0[1] : (tl == 2 ? s0[2] : s0[3])), my1 = tl == 0 ? s1[0] : (tl == 1 ? s1[1] : (tl == 2 ? s1[2] : s1[3]));
    {
        float m = -1.0e30f, ls = 0.f; f32x4 o[4];
#pragma unroll
        for (int dt = 0; dt < 4; ++dt) o[dt] = (f32x4){0.f, 0.f, 0.f, 0.f};
        unsigned long long u0 = (s0[0] | s0[1]) | (s0[2] | s0[3]), u1 = (s1[0] | s1[1]) | (s1[2] | s1[3]);
        while (u0 | u1) {
            int j; if (u0) { j = __builtin_ctzll(u0); u0 &= u0 - 1ull; } else { j = 64 + __builtin_ctzll(u1); u1 &= u1 - 1ull; }
            const bool mine = j < 64 ? ((my0 >> j) & 1ull) != 0ull : ((my1 >> (j - 64)) & 1ull) != 0ull;
            f32x4 st[4]; qk_block(KS + (sbase + 64 * j) * 64, q, fr, fq, st);
            if (j >= cur - 2) {
#pragma unroll
                for (int t = 0; t < 4; ++t)
#pragma unroll
                    for (int i = 0; i < 4; ++i) { const int dist = qpos - (64 * j + 16 * t + 4 * fq + i);
                        st[t][i] = (mine && dist >= 0) ? st[t][i] + bt[dist > 128 ? 128 : dist] : -INFINITY; }
            } else {
#pragma unroll
                for (int t = 0; t < 4; ++t)
#pragma unroll
                    for (int i = 0; i < 4; ++i) st[t][i] = mine ? st[t][i] + farb : -INFINITY;
            }
            softmax_pv(VTS + sbase + 64 * j, TOTS, fr, fq, st, o, m, ls);
        }
        ls = xfq_sum(ls);
        const float w = ls > 0.f ? gs / ls : 0.f;
#pragma unroll
        for (int dt = 0; dt < 4; ++dt) out[dt] = out[dt] + o[dt] * w;
    }
    {
        float m = -1.0e30f, ls = 0.f; f32x4 o[4];
#pragma unroll
        for (int dt = 0; dt < 4; ++dt) o[dt] = (f32x4){0.f, 0.f, 0.f, 0.f};
        const int lo_blk = smp ? (PAST - 512) >> 6 : 0; int jb = (qpos0 - 511) >> 6; if (jb < lo_blk) jb = lo_blk;
        for (; jb <= cur; ++jb) {
            f32x4 st[4]; qk_block(KW + (size_t)(wbase + 64 * jb) * 64, q, fr, fq, st);
#pragma unroll
            for (int t = 0; t < 4; ++t)
#pragma unroll
                for (int i = 0; i < 4; ++i) { const int dist = qpos - (64 * jb + 16 * t + 4 * fq + i);
                    st[t][i] = (dist >= 0 && dist < 512) ? st[t][i] + bt[dist > 128 ? 128 : dist] : -INFINITY; }
            softmax_pv(VTW + (size_t)(wbase + 64 * jb), TOTWP, fr, fq, st, o, m, ls);
        }
        ls = xfq_sum(ls);
        const float w = ls > 0.f ? gwn / ls : 0.f;
#pragma unroll
        for (int dt = 0; dt < 4; ++dt) out[dt] = out[dt] + o[dt] * w;
    }
    bf16* mp = (bf16*)(A.ws + WS_MIX) + (size_t)(row0 + tl) * D + 512 + h * 64 + 4 * fq;
#pragma unroll
    for (int dt = 0; dt < 4; ++dt) { v2u w; w.x = pk2(out[dt][0], out[dt][1]); w.y = pk2(out[dt][2], out[dt][3]); *(v2u*)(mp + 16 * dt) = w; }
}

constexpr int PH_PER_LAYER = 9, PH_L0 = 3, N_PHASES = PH_L0 + DEPTH * PH_PER_LAYER;
#ifndef MK_PER_PHASE
#define MK_PER_PHASE 0
#endif

__device__ __forceinline__ CArgs* kargs() { unsigned long long p = (unsigned long long)__builtin_amdgcn_kernarg_segment_ptr(); asm volatile("" : "+s"(p)); return (CArgs*)p; }
#define A (*kargs())
#define IN(k) (lo <= (k) && (k) < hi)
#define SEAM(k) do { if (IN(k) && IN((k) + 1)) xcd_barrier(bar); } while (0)
template <int l>
__device__ __forceinline__ void layer_phases(LAS unsigned char* lds, const XcdBarrier& bar, int tid, int lane, int wave, int G, int gw, int NGW, int lo, int hi) {
    unsigned char* ws = A.ws;
    float* const ADA = (float*)(ws + WS_ADA);
    float* const X = (float*)(ws + WS_X);
    float* const Z = (float*)(ws + WS_Z);
    bf16* const U = (bf16*)(ws + WS_U);
        const int pb_ = PH_L0 + l * PH_PER_LAYER;
        const float* adal = ADA + (size_t)l * NCOND * 6144;
        const float* xa = l == 0 ? A.x_prompt : X; const float* xb = l == 0 ? A.x_sample : X + (size_t)MP * D;
        if (IN(pb_ + 0)) {
            {
                pg8::Gemm g{U, (const bf16*)(ws + WS_WIN) + (size_t)l * NINP * D, D, D, D};
                pg8::StaticOrder S; S.init(M, NINP, G, (int)blockIdx.x);
                EpiInProj E{(bf16*)(ws + WS_QKVO), (bf16*)(ws + WS_NQ), (float*)(ws + WS_GATE), (float*)(ws + WS_KVR), (bf16*)(ws + WS_XC) + (size_t)l * 4 * XCP * 64, A.out, l};
                pg8::gemm_phase<EpiInProj, pg8::StaticOrder, true, true>(lds, g, S, E);
            }
            if (l == 0) {
                __syncthreads();
                pg8::Gemm g{(const bf16*)(ws + WS_XC), (const bf16*)(ws + WS_W1), 2048, 1024, 2048};
                CmpOrder S{G, (int)blockIdx.x, 0, DEPTH, 4, 64};
                EpiCmpHid E{(bf16*)(ws + WS_HID), (const float*)(ws + WS_B1)};
                pg8::gemm_phase<EpiCmpHid, CmpOrder, true, true>(lds, g, S, E);
            }
        }
        SEAM(pb_ + 0);
        if (IN(pb_ + 1)) {
            {
                pg8::Gemm g{(const bf16*)(ws + WS_XC), (const bf16*)(ws + WS_W1), 2048, 1024, 2048};
                CmpOrder S{G, (int)blockIdx.x, l, 1, 0, 4};
                EpiCmpHid E{(bf16*)(ws + WS_HID), (const float*)(ws + WS_B1)};
                pg8::gemm_phase<EpiCmpHid, CmpOrder, true, true>(lds, g, S, E);
            }
            __syncthreads();
            phase_m2(A, l, lds, tid);
            __syncthreads();
            prep_layer_images(A, l, lds, gw, NGW, lane, wave);
            if (l == 0) phase_cmp2(A, 0, DEPTH, 1024, NCB - 1024, tid);
        }
        SEAM(pb_ + 1);
        if (IN(pb_ + 2)) {
            phase_m3(A, l, tid);
            phase_cmp2(A, l, 1, 0, 1024, tid);
        }
        SEAM(pb_ + 2);
        if (IN(pb_ + 3)) {
            phase_m4(A, l, lds, tid);
            __syncthreads();
            phase_mls(A, l, lds, tid);
            __syncthreads();
            LAS float* wl = (LAS float*)(lds + wave * 8192); LAS float* btl = (LAS float*)(lds + 65536);
            for (int i = tid; i < 8 * 132; i += NTHR) btl[i] = ((const float*)(ws + WS_BT))[i];
            __syncthreads();
            for (int t = gw; t < 4 * 2048 + 2 * DB; t += NGW) nsa_tile(A, l, t, wl, btl, lane);
        }
        SEAM(pb_ + 3);
        if (IN(pb_ + 4)) {
            pg8::Gemm g{(const bf16*)(ws + WS_MIX), (const bf16*)(ws + WS_WOUT) + (size_t)l * D * D, D, D, D};
            pg8::StaticOrder S; S.init(M, D, G, (int)blockIdx.x);
            EpiResid E{xa, xb, adal + 2048, Z};
            pg8::gemm_phase<EpiResid, pg8::StaticOrder, true, true>(lds, g, S, E);
        }
        SEAM(pb_ + 4);
        if (IN(pb_ + 5)) {
            for (int r = gw; r < M; r += NGW) {
                const float* ad = adal + (size_t)cond_of_row(r) * 6144;
                ln_row(Z + (size_t)r * D, A.ln_g + (size_t)(l * 2 + 0) * D, A.ln_b + (size_t)(l * 2 + 0) * D, X + (size_t)r * D, ad + 3072, ad + 4096, U + (size_t)r * D, lane);
            }
        }
        SEAM(pb_ + 5);
        if (IN(pb_ + 6)) {
            pg8::Gemm g{U, (const bf16*)(ws + WS_WUP) + (size_t)l * FF * D, D, D, D};
            pg8::StaticOrder S; S.init(M, FF, G, (int)blockIdx.x);
            EpiRelu2 E{(bf16*)(ws + WS_H)};
            pg8::gemm_phase<EpiRelu2, pg8::StaticOrder, true, true>(lds, g, S, E);
        }
        SEAM(pb_ + 6);
        if (IN(pb_ + 7)) {
            pg8::Gemm g{(const bf16*)(ws + WS_H), (const bf16*)(ws + WS_WDN) + (size_t)l * D * FF, FF, FF, FF};
            pg8::StaticOrder S; S.init(M, D, G, (int)blockIdx.x);
            EpiResid E{X, X + (size_t)MP * D, adal + 5120, Z};
            pg8::gemm_phase<EpiResid, pg8::StaticOrder, true, true>(lds, g, S, E);
        }
        SEAM(pb_ + 7);
        if (IN(pb_ + 8)) {
            const bool last = l == DEPTH - 1;
            for (int r = gw; r < M; r += NGW) {
                const float* ad = adal + (size_t)NCOND * 6144 + (size_t)cond_of_row(r) * 6144;
                float* xo = last ? (r < MP ? A.out + O_YP + (size_t)r * D : A.out + O_YS + (size_t)(r - MP) * D) : X + (size_t)r * D;
                ln_row(Z + (size_t)r * D, A.ln_g + (size_t)(l * 2 + 1) * D, A.ln_b + (size_t)(l * 2 + 1) * D, xo, ad, ad + 1024, last ? (bf16*)nullptr : U + (size_t)r * D, lane);
            }
        }
        SEAM(pb_ + 8);
    }
__global__ void __launch_bounds__(NTHR, 2) fwd_kernel(Args A_unused) {
    extern __shared__ __attribute__((aligned(16))) unsigned char lds_raw[];
    LAS unsigned char* lds = (LAS unsigned char*)lds_raw;
    const int tid = threadIdx.x, lane = tid & 63, wave = __builtin_amdgcn_readfirstlane(tid >> 6);
    const int G = gridDim.x, gw = blockIdx.x * NWAVES + wave, NGW = G * NWAVES;
    unsigned char* ws = A.ws;
    for (int u = tid; u < (LDS_BYTES - LDSCTL_OFF) / 4; u += NTHR) ((LAS unsigned*)(lds + LDSCTL_OFF))[u] = 0u;
    __syncthreads();
    XcdBarrier bar; bar.bar = (unsigned*)(ws + WS_CTL) + CW_BAR; bar.x = 0; bar.st = nullptr;
    if (!MK_PER_PHASE) bar = xcd_barrier_post((unsigned*)(ws + WS_CTL) + CW_BAR, (volatile LAS unsigned*)(lds + MISC_OFF) + 8);
    const int lo = A.ph_lo, hi = A.ph_hi;

    float* const ADA = (float*)(ws + WS_ADA);
    float* const X = (float*)(ws + WS_X);
    float* const Z = (float*)(ws + WS_Z);
    bf16* const U = (bf16*)(ws + WS_U);

    if (IN(0)) { phase_p0a(A, lds, gw, NGW, lane, wave); prep_cache_images(A, lds, gw, NGW, lane, wave); }
    SEAM(0);
    if (IN(1)) { phase_ada(A, lds, tid); }
    SEAM(1);
    if (IN(2)) {
        for (int r = gw; r < M; r += NGW) {
            const float* ad = ADA + (size_t)cond_of_row(r) * 6144;
            mod_row(r < MP ? A.x_prompt + (size_t)r * D : A.x_sample + (size_t)(r - MP) * D, ad, ad + 1024, U + (size_t)r * D, lane);
        }
    }
    SEAM(2);

    layer_phases<0>(lds, bar, tid, lane, wave, G, gw, NGW, lo, hi);
    layer_phases<1>(lds, bar, tid, lane, wave, G, gw, NGW, lo, hi);
    static_assert(DEPTH == 2, "two layers");
#undef IN
#undef SEAM
#undef A
}

extern "C" void kernel_launch(void* const* d_in, const int* in_sizes, int n_in, void* d_out, int out_size, void* d_ws, size_t ws_size, hipStream_t stream) {
    static int grid = 0;
    if (grid == 0) {
        if (n_in != 25 || (size_t)out_size != O_END || ws_size < WS_END) { fprintf(stderr, "kernel_launch: unexpected shapes: n_in %d out %d (want %zu) ws %zu (want >= %zu)\n", n_in, out_size, (size_t)O_END, ws_size, (size_t)WS_END); grid = -1; return; }
        int dev = 0, cus = 0, per_cu = 0;
        if (hipGetDevice(&dev) != hipSuccess || hipDeviceGetAttribute(&cus, hipDeviceAttributeMultiprocessorCount, dev) != hipSuccess) { grid = -1; return; }
        if (hipFuncSetAttribute((const void*)fwd_kernel, hipFuncAttributeMaxDynamicSharedMemorySize, LDS_BYTES) != hipSuccess) { fprintf(stderr, "kernel_launch: hipFuncSetAttribute failed\n"); grid = -1; return; }
        if (hipOccupancyMaxActiveBlocksPerMultiprocessor(&per_cu, (const void*)fwd_kernel, NTHR, LDS_BYTES) != hipSuccess || per_cu < 1) fprintf(stderr, "kernel_launch: occupancy query reports %d blocks per CU\n", per_cu);
        (void)hipGetLastError();
        grid = cus;
    }
    if (grid < 0) return;
    (void)hipMemsetAsync((char*)d_ws + WS_CTL, 0, CTL_ZERO_BYTES, stream);
    Args a{};
    a.x_prompt = (const float*)d_in[0]; a.x_sample = (const float*)d_in[1]; a.cache_cmp = (const float*)d_in[2]; a.cache_slc = (const float*)d_in[3]; a.cache_win = (const float*)d_in[4];
    a.st_C = (const float*)d_in[5]; a.st_n = (const float*)d_in[6]; a.st_m = (const float*)d_in[7]; a.page_table = (const int*)d_in[8]; a.c_prompt = (const float*)d_in[9]; a.c_sample = (const float*)d_in[10];
    a.w_ada = (const float*)d_in[11]; a.b_ada = (const float*)d_in[12]; a.w_in = (const float*)d_in[13]; a.b_gate = (const float*)d_in[14]; a.ml_norm_g = (const float*)d_in[15]; a.cmp_pe = (const float*)d_in[16];
    a.cmp_w1 = (const float*)d_in[17]; a.cmp_w2 = (const float*)d_in[18]; a.rel_bias = (const float*)d_in[19]; a.w_out = (const float*)d_in[20]; a.ln_g = (const float*)d_in[21]; a.ln_b = (const float*)d_in[22];
    a.w_up = (const float*)d_in[23]; a.w_down = (const float*)d_in[24];
    a.out = (float*)d_out; a.ws = (unsigned char*)d_ws;
#if MK_PER_PHASE
    for (int ph = 0; ph < N_PHASES; ++ph) { a.ph_lo = ph; a.ph_hi = ph + 1; hipLaunchKernelGGL(fwd_kernel, dim3(grid), dim3(NTHR), LDS_BYTES, stream, a); }
#else
    a.ph_lo = 0; a.ph_hi = N_PHASES;
    hipLaunchKernelGGL(fwd_kernel, dim3(grid), dim3(NTHR), LDS_BYTES, stream, a);
#endif
    const hipError_t le = hipPeekAtLastError();
    if (le != hipSuccess) fprintf(stderr, "kernel_launch: launch failed: %s\n", hipGetErrorName(le));
}
```

```cpp
#include <hip/hip_runtime.h>
#include <cstdio>
#include <cstdint>
namespace pg8 {
#define PG8_LAS __attribute__((address_space(3)))
typedef unsigned short bf16_t;
typedef short bf16x8 __attribute__((ext_vector_type(8)));
typedef float f32x4 __attribute__((ext_vector_type(4)));
typedef unsigned u32x4 __attribute__((ext_vector_type(4)));
constexpr int BM = 256, BK = 64, HALF = 128, HTB = HALF * BK * 2  , STAGE_BYTES = 8 * HTB, NXCD = 8, WGM = 8;

__host__ __device__ __forceinline__ int lds_byte(int r, int c) { const int st = (r >> 4) * 2 + (c >> 5), rr = r & 15, cc = c & 31, ob = rr * 64 + cc * 2; return st * 1024 + (ob ^ (((ob >> 9) & 1) << 5)); }
__host__ __device__ __forceinline__ void stage_rc(int b, int& R, int& C) { const int st = b / 1024, sb = b % 1024, swz = sb ^ (((sb >> 9) & 1) << 5); R = (st >> 1) * 16 + swz / 64; C = (st & 1) * 32 + (swz % 64) / 2; }
__host__ __device__ __forceinline__ int perm32(int rho) { const int n = rho >> 4, i = rho & 15; return 8 * (i >> 2) + 4 * n + (i & 3); }

struct Unit { int pm, pn; };
struct Gemm { const bf16_t* A; const bf16_t* Bt; int K, lda, ldb; };

struct StaticOrder {
    int nM, nN, nwg, G, c;
    __host__ __device__ void init(int M, int N, int G_, int c_) { nM = M / BM; nN = N / BM; nwg = nM * nN; G = G_; c = c_; }
    __host__ __device__ bool next(int i, Unit& u) const {
        const long L = (long)i * G + c; if (L >= nwg) return false;
        int wgid = (int)L; { const int q = nwg / NXCD, r = nwg % NXCD, xcd = wgid % NXCD, off = wgid / NXCD; wgid = (xcd < r ? xcd * (q + 1) : r * (q + 1) + (xcd - r) * q) + off; }
        const int nig = WGM * nN, gid = wgid / nig, fm = gid * WGM, gsz = (nM - fm) < WGM ? (nM - fm) : WGM;
        u.pm = fm + ((wgid % nig) % gsz); u.pn = (wgid % nig) / gsz; return true;
    }
    __device__ __forceinline__ void a_ready(const Unit&) const {}
    __device__ __forceinline__ void done(const Unit&) const {}
};

template <class Epi, class Sched, bool ALIGN_EPI = false, bool SP2 = false>
__device__ __forceinline__ void gemm_phase(PG8_LAS unsigned char* lds, const Gemm g, const Sched& S, const Epi& E) {
    const int tid = threadIdx.x, wid = __builtin_amdgcn_readfirstlane(tid >> 6), lane = tid & 63, wr = wid >> 2, wc = wid & 3, fr = lane & 15, fq = lane >> 4;
    const int K = g.K, nt = K / BK;
    unsigned voffA[2], voffB[2];
#pragma unroll
    for (int i = 0; i < 2; ++i) { int R, C; stage_rc(tid * 16 + i * 8192, R, C); const int Rb = Epi::PERM ? ((R & ~31) + perm32(R & 31)) : R;
        voffA[i] = (unsigned)(R * g.lda + C) * 2u; voffB[i] = (unsigned)(Rb * g.ldb + C) * 2u; }
    const size_t kstep = (size_t)(BK * 2);
    const size_t hstepA = (size_t)HALF * g.lda * 2, hstepB = (size_t)HALF * g.ldb * 2;
    const size_t tstepA = 2 * hstepA, tstepB = 2 * hstepB;
    const unsigned ldsw = (unsigned)wid * 1024u;
    const int aoff = lds_byte(wr * 64 + fr, fq * 8), boff = lds_byte(wc * 32 + fr, fq * 8);
#define PG8_SA(b, h) (((b) * 2 + (h)) * HTB)
#define PG8_SB(b, h) ((4 + (b) * 2 + (h)) * HTB)
#define PG8_STAGE(bufoff, gbase, voff) do { _Pragma("unroll") for (int _i = 0; _i < 2; ++_i) \
        __builtin_amdgcn_global_load_lds((const unsigned*)((const char*)(gbase) + (voff)[_i]), (PG8_LAS unsigned*)(lds + (bufoff) + ldsw + _i * 8192), 16, 0, 0); } while (0)
#define PG8_LDA(dst, b, h) do { _Pragma("unroll") for (int m = 0; m < 4; ++m) _Pragma("unroll") for (int k = 0; k < 2; ++k) dst[m][k] = *(const PG8_LAS bf16x8*)(lds + PG8_SA(b, h) + aoff + m * 2048 + k * 1024); } while (0)
#define PG8_LDB(dst, b, h) do { _Pragma("unroll") for (int n = 0; n < 2; ++n) _Pragma("unroll") for (int k = 0; k < 2; ++k) dst[n][k] = *(const PG8_LAS bf16x8*)(lds + PG8_SB(b, h) + boff + n * 2048 + k * 1024); } while (0)
#define PG8_MMA(ai, bj, At, Bt) do { __builtin_amdgcn_s_setprio(1); _Pragma("unroll") for (int m = 0; m < 4; ++m) _Pragma("unroll") for (int n = 0; n < 2; ++n) _Pragma("unroll") for (int k = 0; k < 2; ++k) \
        acc[ai][bj][m][n] = __builtin_amdgcn_mfma_f32_16x16x32_bf16(Bt[n][k], At[m][k], acc[ai][bj][m][n], 0, 0, 0); __builtin_amdgcn_s_setprio(0); } while (0)
#define PG8_WAIT_V(n) asm volatile("s_waitcnt vmcnt(" #n ")" ::: "memory")
#define PG8_WAIT_L(n) asm volatile("s_waitcnt lgkmcnt(" #n ")" ::: "memory")
#define PG8_BAR __builtin_amdgcn_s_barrier()
#define PG8_SCHED __builtin_amdgcn_sched_barrier(0)
    Unit cur, nxt; int ui = 0;
    if (!S.next(0, cur)) return;
    f32x4 acc[2][2][4][2];
#pragma unroll
    for (int a = 0; a < 2; ++a)
#pragma unroll
        for (int b = 0; b < 2; ++b)
#pragma unroll
            for (int m = 0; m < 4; ++m)
#pragma unroll
                for (int n = 0; n < 2; ++n) acc[a][b][m][n] = (f32x4){0.f, 0.f, 0.f, 0.f};
    bf16x8 At[4][2], B0[2][2], B1[2][2];
    const char* cA = (const char*)g.A + (size_t)cur.pm * tstepA; const char* cB = (const char*)g.Bt + (size_t)cur.pn * tstepB;
    S.a_ready(cur);
    if constexpr (SP2) {
        PG8_STAGE(PG8_SB(0, 0), cB, voffB); PG8_STAGE(PG8_SB(0, 1), cB + hstepB, voffB); PG8_STAGE(PG8_SA(0, 0), cA, voffA); PG8_STAGE(PG8_SA(0, 1), cA + hstepA, voffA);
        if (wr == 1) PG8_BAR;
        PG8_WAIT_V(2); PG8_BAR;
        PG8_STAGE(PG8_SB(1, 0), cB + kstep, voffB); PG8_STAGE(PG8_SA(1, 0), cA + kstep, voffA); PG8_STAGE(PG8_SB(1, 1), cB + hstepB + kstep, voffB);
        PG8_WAIT_V(6); PG8_BAR;
    } else {
        PG8_STAGE(PG8_SB(0, 0), cB, voffB); PG8_STAGE(PG8_SA(0, 0), cA, voffA); PG8_STAGE(PG8_SB(0, 1), cB + hstepB, voffB); PG8_STAGE(PG8_SA(0, 1), cA + hstepA, voffA);
        if (wr == 1) PG8_BAR;
        PG8_WAIT_V(4); PG8_BAR;
        PG8_STAGE(PG8_SB(1, 0), cB + kstep, voffB); PG8_STAGE(PG8_SA(1, 0), cA + kstep, voffA); PG8_STAGE(PG8_SB(1, 1), cB + hstepB + kstep, voffB);
        PG8_WAIT_V(6); PG8_BAR;
    }
    for (;;) {
        const bool has_next = S.next(ui + 1, nxt);
        const char* nA = has_next ? (const char*)g.A + (size_t)nxt.pm * tstepA : cA; const char* nB = has_next ? (const char*)g.Bt + (size_t)nxt.pn * tstepB : cB;
        for (int t = 0; t < nt; t += 2) {
            const bool last = (t == nt - 2);
            const char* a1 = cA + (size_t)(t + 1) * kstep;
            const char* a2 = last ? nA : cA + (size_t)(t + 2) * kstep; const char* b2 = last ? nB : cB + (size_t)(t + 2) * kstep;
            const char* a3 = a2 + kstep; const char* b3 = b2 + kstep;
            if (last && has_next) S.a_ready(nxt);
            if constexpr (SP2) {
            PG8_LDB(B0, 0, 0); PG8_LDB(B1, 0, 1); PG8_SCHED; PG8_LDA(At, 0, 0); PG8_STAGE(PG8_SA(1, 1), a1 + hstepA, voffA);
            PG8_WAIT_V(8); PG8_WAIT_L(0); PG8_BAR; PG8_MMA(0, 0, At, B0); PG8_MMA(0, 1, At, B1); PG8_BAR; PG8_SCHED;
            PG8_LDA(At, 0, 1); PG8_STAGE(PG8_SB(0, 0), b2, voffB); PG8_STAGE(PG8_SB(0, 1), b2 + hstepB, voffB); PG8_STAGE(PG8_SA(0, 0), a2, voffA);
            PG8_WAIT_V(8); PG8_WAIT_L(0); PG8_BAR; PG8_MMA(1, 0, At, B0); PG8_MMA(1, 1, At, B1); PG8_BAR; PG8_SCHED;
            PG8_LDB(B0, 1, 0); PG8_LDB(B1, 1, 1); PG8_SCHED; PG8_LDA(At, 1, 0); PG8_STAGE(PG8_SA(0, 1), a2 + hstepA, voffA);
            PG8_WAIT_V(8); PG8_WAIT_L(0); PG8_BAR; PG8_MMA(0, 0, At, B0); PG8_MMA(0, 1, At, B1); PG8_BAR; PG8_SCHED;
            PG8_LDA(At, 1, 1); PG8_STAGE(PG8_SB(1, 0), b3, voffB); PG8_STAGE(PG8_SB(1, 1), b3 + hstepB, voffB); PG8_STAGE(PG8_SA(1, 0), a3, voffA);
            PG8_WAIT_V(8); PG8_WAIT_L(0); PG8_BAR; PG8_MMA(1, 0, At, B0); PG8_MMA(1, 1, At, B1); PG8_BAR; PG8_SCHED;
            } else {
            PG8_LDB(B0, 0, 0); PG8_SCHED; PG8_LDA(At, 0, 0); PG8_STAGE(PG8_SA(1, 1), a1 + hstepA, voffA);
            PG8_WAIT_L(8); PG8_BAR; PG8_WAIT_L(0); PG8_MMA(0, 0, At, B0); PG8_BAR; PG8_SCHED;
            PG8_LDB(B1, 0, 1); PG8_STAGE(PG8_SB(0, 0), b2, voffB);
            PG8_BAR; PG8_WAIT_L(0); PG8_MMA(0, 1, At, B1); PG8_BAR;
            PG8_LDA(At, 0, 1); PG8_STAGE(PG8_SA(0, 0), a2, voffA);
            PG8_BAR; PG8_WAIT_L(0); PG8_MMA(1, 0, At, B0); PG8_BAR; PG8_SCHED;
            PG8_STAGE(PG8_SB(0, 1), b2 + hstepB, voffB);
            PG8_WAIT_V(6); PG8_BAR; PG8_MMA(1, 1, At, B1); PG8_BAR;
            PG8_LDB(B0, 1, 0); PG8_SCHED; PG8_LDA(At, 1, 0); PG8_STAGE(PG8_SA(0, 1), a2 + hstepA, voffA);
            PG8_WAIT_L(8); PG8_BAR; PG8_WAIT_L(0); PG8_MMA(0, 0, At, B0); PG8_BAR; PG8_SCHED;
            PG8_LDB(B1, 1, 1); PG8_STAGE(PG8_SB(1, 0), b3, voffB);
            PG8_BAR; PG8_WAIT_L(0); PG8_MMA(0, 1, At, B1); PG8_BAR;
            PG8_LDA(At, 1, 1); PG8_STAGE(PG8_SA(1, 0), a3, voffA);
            PG8_BAR; PG8_WAIT_L(0); PG8_MMA(1, 0, At, B0); PG8_BAR; PG8_SCHED;
            PG8_STAGE(PG8_SB(1, 1), b3 + hstepB, voffB);
            PG8_WAIT_V(6); PG8_BAR; PG8_MMA(1, 1, At, B1); PG8_BAR;
            }
        }
        if constexpr (ALIGN_EPI) { if (wr == 0) PG8_BAR; }
        if constexpr (!Epi::AFTER_DRAIN) { E(acc, cur, wr, wc, fr, fq); S.done(cur); }
        if (!has_next) break;
#pragma unroll
        for (int a = 0; a < 2; ++a)
#pragma unroll
            for (int b = 0; b < 2; ++b)
#pragma unroll
                for (int m = 0; m < 4; ++m)
#pragma unroll
                    for (int n = 0; n < 2; ++n) acc[a][b][m][n] = (f32x4){0.f, 0.f, 0.f, 0.f};
        cur = nxt; cA = nA; cB = nB; ++ui;
        if constexpr (ALIGN_EPI) { if (wr == 1) PG8_BAR; }
    }
    PG8_WAIT_V(0);
    if constexpr (!ALIGN_EPI) { if (wr == 0) PG8_BAR; }
    PG8_BAR;
    if constexpr (Epi::AFTER_DRAIN) { E.fused(acc, cur, wr, wc, fr, fq, lds, wid, lane); S.done(cur); }
#undef PG8_SA
#undef PG8_SB
#undef PG8_STAGE
#undef PG8_LDA
#undef PG8_LDB
#undef PG8_MMA
#undef PG8_WAIT_V
#undef PG8_WAIT_L
#undef PG8_BAR
#undef PG8_SCHED
}
}

constexpr int D = 1024, BATCH = 2, SEQ = 8192, DEPTH = 2, DB = 128, DS = 4, PAST = 2048, PAGE = 128, NPG = 16, NPHYS = 2560;
constexpr int MP = BATCH * SEQ, MS = DB * DS, M = MP + MS;
constexpr int NINP = 3584, FF = 4096, NCOND = BATCH + DB;
constexpr int NH = 4, HD = 128;
constexpr int LCH = 256, NCH = SEQ / LCH, NUNIT = BATCH * NH * NCH;
constexpr int NCB = 17408;
constexpr int XCP = NCB * 16;
constexpr float ALPHA = 1.4142135623730951f;
constexpr float LN_EPS = 1e-5f;
constexpr size_t O_YP = 0, O_YS = O_YP + (size_t)MP * D, O_CMPP = O_YS + (size_t)MS * D, O_CMPS = O_CMPP + (size_t)DEPTH * MP * 256, O_SLCP = O_CMPS + (size_t)DEPTH * MS * 256,
                 O_SLCS = O_SLCP + (size_t)DEPTH * MP * 256, O_WINP = O_SLCS + (size_t)DEPTH * MS * 256, O_WINS = O_WINP + (size_t)DEPTH * BATCH * 512 * 256,
                 O_CP = O_WINS + (size_t)DEPTH * DB * 512 * 256, O_CS = O_CP + (size_t)DEPTH * BATCH * NH * HD * HD, O_NP = O_CS + (size_t)DEPTH * DB * NH * HD * HD,
                 O_NS = O_NP + (size_t)DEPTH * BATCH * NH * HD, O_MP = O_NS + (size_t)DEPTH * DB * NH * HD, O_MS = O_MP + (size_t)DEPTH * BATCH * NH, O_END = O_MS + (size_t)DEPTH * DB * NH;

constexpr size_t al1m(size_t x) { return (x + 0xFFFFFull) & ~(size_t)0xFFFFFull; }
constexpr size_t WS_CTL = 0, CTL_ZERO_BYTES = 1u << 20;
constexpr size_t WS_WIN  = CTL_ZERO_BYTES;
constexpr size_t WS_WOUT = WS_WIN  + al1m((size_t)DEPTH * NINP * D * 2);
constexpr size_t WS_WUP  = WS_WOUT + al1m((size_t)DEPTH * D * D * 2);
constexpr size_t WS_WDN  = WS_WUP  + al1m((size_t)DEPTH * FF * D * 2);
constexpr size_t WS_W1   = WS_WDN  + al1m((size_t)DEPTH * D * FF * 2);
constexpr size_t WS_ADA  = WS_W1   + al1m((size_t)DEPTH * 2 * 256 * 2048 * 2);
constexpr size_t WS_B1   = WS_ADA  + al1m((size_t)DEPTH * NCOND * 6144 * 4);
constexpr size_t WS_BT   = WS_B1   + al1m(4096);
constexpr size_t WS_X    = WS_BT   + al1m(8 * 132 * 4);
constexpr size_t WS_Z    = WS_X    + al1m((size_t)M * D * 4);
constexpr size_t WS_U    = WS_Z    + al1m((size_t)M * D * 4);
constexpr size_t WS_QKVO = WS_U    + al1m((size_t)M * D * 2);
constexpr size_t WS_NQ   = WS_QKVO + al1m((size_t)M * 2048 * 2);
constexpr size_t WS_GATE = WS_NQ   + al1m((size_t)M * 512 * 2);
constexpr size_t WS_KVR  = WS_GATE + al1m((size_t)M * 32 * 4);
constexpr size_t WS_XC   = WS_KVR  + al1m((size_t)3 * M * 256 * 4);
constexpr size_t WS_HID  = WS_XC   + al1m((size_t)DEPTH * 4 * XCP * 64 * 2 + 4096);
constexpr size_t WS_CKV  = WS_HID  + al1m((size_t)DEPTH * 4 * NCB * 256 * 2);
constexpr size_t WS_KS   = WS_CKV  + al1m((size_t)DEPTH * 4 * NCB * 64 * 4);
constexpr size_t WS_VTS  = WS_KS   + al1m((size_t)DEPTH * 2 * (MP + DB * 2112) * 64 * 2 + 65536);
constexpr size_t WS_KW   = WS_VTS  + al1m((size_t)DEPTH * 2 * (MP + DB * 2112) * 64 * 2 + 65536);
constexpr size_t WS_VTW  = WS_KW   + al1m((size_t)DEPTH * 2 * (MP + DB * 528 + 64) * 64 * 2 + 65536);
constexpr size_t WS_KC   = WS_VTW  + al1m((size_t)DEPTH * 2 * (MP + DB * 528 + 64) * 64 * 2 + 65536);
constexpr size_t WS_VCT  = WS_KC   + al1m((size_t)DEPTH * 2 * NCB * 64 * 2 + 65536);
constexpr size_t WS_W2T  = WS_VCT  + al1m((size_t)DEPTH * 2 * NCB * 64 * 2 + 65536);
constexpr size_t WS_MIX  = WS_W2T  + al1m(65536);
constexpr size_t WS_H    = WS_MIX  + al1m((size_t)M * D * 2);
constexpr size_t WS_DCT  = WS_H    + al1m((size_t)M * FF * 2);
constexpr size_t WS_DN   = WS_DCT  + al1m((size_t)NUNIT * HD * HD * 4);
constexpr size_t WS_CHS  = WS_DN   + al1m((size_t)NUNIT * HD * 4);
constexpr size_t WS_CTP  = WS_CHS  + al1m((size_t)NUNIT * 4 * 4);
constexpr size_t WS_NPV  = WS_CTP  + al1m((size_t)NUNIT * HD * HD * 2);
constexpr size_t WS_WSC  = WS_NPV  + al1m((size_t)NUNIT * HD * 4);
constexpr size_t WS_HRAW = WS_WSC  + al1m((size_t)NUNIT * LCH * LCH * 4);
constexpr size_t WS_END  = WS_HRAW + al1m((size_t)NUNIT * LCH * HD * 4);

constexpr int CW_BAR = 4096;

constexpr int RING_BYTES = 131072, LDSCTL_OFF = RING_BYTES, MISC_OFF = LDSCTL_OFF + 320, LDS_BYTES = 147456;
constexpr int NWAVES = 8, NTHR = NWAVES * 64;

#define GAS __attribute__((address_space(1)))
#define LAS __attribute__((address_space(3)))
typedef unsigned short bf16;
typedef unsigned v4u __attribute__((ext_vector_type(4)));
typedef unsigned v2u __attribute__((ext_vector_type(2)));
typedef float f32x4 __attribute__((ext_vector_type(4)));
typedef float f32x2 __attribute__((ext_vector_type(2)));

__device__ __forceinline__ unsigned f2bf(float f) { unsigned u = __builtin_bit_cast(unsigned, f); return (u + 0x7fffu + ((u >> 16) & 1u)) >> 16; }
__device__ __forceinline__ unsigned pk2(float lo, float hi) { return f2bf(lo) | (f2bf(hi) << 16); }
__device__ __forceinline__ float bflo(unsigned u) { return __builtin_bit_cast(float, u << 16); }
__device__ __forceinline__ float bfhi(unsigned u) { return __builtin_bit_cast(float, u & 0xffff0000u); }
__device__ __forceinline__ float bf2f(bf16 h) { return __builtin_bit_cast(float, (unsigned)h << 16); }
__device__ __forceinline__ float sigmoidf_(float x) { return 1.f / (1.f + __expf(-x)); }
__device__ __forceinline__ float wave_sum(float v) {
#pragma unroll
    for (int o = 1; o < 64; o <<= 1) v += __shfl_xor(v, o);
    return v;
}
__device__ __forceinline__ float wave_max(float v) {
#pragma unroll
    for (int o = 1; o < 64; o <<= 1) v = fmaxf(v, __shfl_xor(v, o));
    return v;
}

#define XB_TMO      128
#define XB_XCNT(j)  (256  + 64 * (j))
#define XB_XSUB(j)  (1280 + 64 * (j))
#define XB_XGEN(j)  (2304 + 64 * (j))
#define XB_TOP      3328
#define XB_TOPGEN   3392
#define XCD_BAR_WORDS 3456
#define XB_SPIN_CAP (1u << 18)

__device__ __forceinline__ unsigned xb_ld(unsigned* p)              { return __hip_atomic_load(p, __ATOMIC_RELAXED, __HIP_MEMORY_SCOPE_AGENT); }
__device__ __forceinline__ unsigned xb_add(unsigned* p, unsigned v) { return __hip_atomic_fetch_add(p, v, __ATOMIC_RELAXED, __HIP_MEMORY_SCOPE_AGENT); }
__device__ __forceinline__ unsigned xb_xcc_id() { return (unsigned)__builtin_amdgcn_s_getreg((3 << 11) | 20) & 0xFu; }
#define XB_SPIN(cond, bar) do { unsigned _sp = 0; while (cond) { __builtin_amdgcn_s_sleep(1); \
    if ((++_sp & 255u) == 0u) { if (xb_ld(&(bar)[XB_TMO])) break; if (_sp > XB_SPIN_CAP) { atomicAdd(&(bar)[XB_TMO], 1u); break; } } } } while (0)

struct XcdBarrier {
    unsigned* bar; unsigned x;
    volatile LAS unsigned* st;
};

__device__ __forceinline__ XcdBarrier xcd_barrier_post(unsigned* bar, volatile LAS unsigned* st) {
    XcdBarrier b; b.bar = bar; b.x = xb_xcc_id(); b.st = st;
    if (threadIdx.x == 0) (void)xb_add(&bar[XB_XCNT(b.x)], 1u);
    return b;
}
__device__ __forceinline__ void xcd_barrier_complete(unsigned* bar, unsigned x, unsigned& nloc, unsigned& nx) {
    const unsigned G = gridDim.x * gridDim.y * gridDim.z;
    unsigned sum, cnt, mine, sp = 0u;
    for (;;) {
        sum = 0u; cnt = 0u; mine = 0u;
#pragma unroll
        for (unsigned j = 0; j < 16; ++j) { const unsigned c = xb_ld(&bar[XB_XCNT(j)]); sum += c; cnt += (c > 0u) ? 1u : 0u; mine = (j == x) ? c : mine; }
        if (sum == G) break;
        __builtin_amdgcn_s_sleep(1);
        if ((++sp & 255u) == 0u) { if (xb_ld(&bar[XB_TMO])) break; if (sp > XB_SPIN_CAP) { atomicAdd(&bar[XB_TMO], 1u); break; } }
    }
    nloc = mine > 0u ? mine : 1u; nx = cnt > 0u ? cnt : 1u;
}

__device__ __forceinline__ void xcd_barrier(const XcdBarrier& b) {
    asm volatile("s_waitcnt vmcnt(0)" ::: "memory");
    __syncthreads();
    if (threadIdx.x == 0) {
        unsigned* bar = b.bar;
        __builtin_amdgcn_s_waitcnt(0);
        unsigned nloc = b.st[0], nx = b.st[1];
        if (nloc == 0u) { xcd_barrier_complete(bar, b.x, nloc, nx); b.st[0] = nloc; b.st[1] = nx; }
        const unsigned old = xb_add(&bar[XB_XSUB(b.x)], 1u);
        const unsigned gen = old / nloc;
        if (old + 1u == (gen + 1u) * nloc) {
            __builtin_amdgcn_fence(__ATOMIC_RELEASE, "agent");
            asm volatile("s_waitcnt vmcnt(0)" ::: "memory");
            const unsigned og = xb_add(&bar[XB_TOP], 1u);
            const unsigned tg = og / nx;
            if (og + 1u == (tg + 1u) * nx) xb_add(&bar[XB_TOPGEN], 1u);
            else XB_SPIN(xb_ld(&bar[XB_TOPGEN]) == tg, bar);
            __builtin_amdgcn_fence(__ATOMIC_ACQUIRE, "agent");
            xb_add(&bar[XB_XGEN(b.x)], 1u);
            asm volatile("s_waitcnt vmcnt(0)" ::: "memory");
        } else {
            XB_SPIN(xb_ld(&bar[XB_XGEN(b.x)]) == gen, bar);
            __builtin_amdgcn_fence(__ATOMIC_ACQUIRE, "agent");
            asm volatile("s_waitcnt vmcnt(0)" ::: "memory");
        }
    }
    __syncthreads();
}

struct Args {
    const float* x_prompt; const float* x_sample; const float* cache_cmp; const float* cache_slc; const float* cache_win;
    const float* st_C; const float* st_n; const float* st_m; const int* page_table; const float* c_prompt; const float* c_sample;
    const float* w_ada; const float* b_ada; const float* w_in; const float* b_gate; const float* ml_norm_g; const float* cmp_pe;
    const float* cmp_w1; const float* cmp_w2; const float* rel_bias; const float* w_out; const float* ln_g; const float* ln_b;
    const float* w_up; const float* w_down;
    float* out; unsigned char* ws; int ph_lo, ph_hi;
};
static_assert(sizeof(Args) == 27 * 8 + 8, "Args has no padding");
typedef const __attribute__((address_space(4))) Args CArgs;

__device__ __forceinline__ int cond_of_row(int r) { return r < MP ? (r >> 13) : BATCH + ((r - MP) >> 2); }

struct EpiInProj {
    static constexpr bool PERM = true, AFTER_DRAIN = false;
    bf16* QKVO; bf16* NQ; float* GATE; float* KVR; bf16* XC; float* out; int l;
    __device__ __forceinline__ void operator()(const f32x4 (&acc)[2][2][4][2], const pg8::Unit& u, int wr, int wc, int fr, int fq) const {
        const int row0 = u.pm * 256 + wr * 64 + fr, pn = u.pn, col8 = wc * 32 + 8 * fq;
#pragma unroll
        for (int ai = 0; ai < 2; ++ai)
#pragma unroll
            for (int m = 0; m < 4; ++m) {
                const int r = row0 + ai * 128 + m * 16;
#pragma unroll
                for (int bj = 0; bj < 2; ++bj) {
                    const f32x4 v0 = acc[ai][bj][m][0], v1 = acc[ai][bj][m][1];
                    const int cc = bj * 128 + col8;
                    if (pn < 10) {
                        v4u w; w.x = pk2(v0[0], v0[1]); w.y = pk2(v0[2], v0[3]); w.z = pk2(v1[0], v1[1]); w.w = pk2(v1[2], v1[3]);
                        if (pn < 8) *(v4u*)(QKVO + (size_t)r * 2048 + pn * 256 + cc) = w;
                        else        *(v4u*)(NQ + (size_t)r * 512 + (pn - 8) * 256 + cc) = w;
                    } else if (pn < 13) {
                        const int kind = pn - 10;
                        float* kr = KVR + ((size_t)kind * M + r) * 256 + cc;
                        *(f32x4*)kr = v0; *(f32x4*)(kr + 4) = v1;
                        float* o = nullptr;
                        if (r < MP) {
                            if (kind < 2) o = out + (kind == 0 ? O_CMPP : O_SLCP) + ((size_t)l * MP + r) * 256 + cc;
                            else { const int t = r & (SEQ - 1); if (t >= SEQ - 512) o = out + O_WINP + (((size_t)l * BATCH + (r >> 13)) * 512 + (t - (SEQ - 512))) * 256 + cc; }
                        } else {
                            const int rs = r - MP;
                            if (kind < 2) o = out + (kind == 0 ? O_CMPS : O_SLCS) + ((size_t)l * MS + rs) * 256 + cc;
                            else o = out + O_WINS + (((size_t)l * DB + (rs >> 2)) * 512 + 508 + (rs & 3)) * 256 + cc;
                        }
                        if (o) { *(f32x4*)o = v0; *(f32x4*)(o + 4) = v1; }
                        if (kind == 0 && r < MP) {
                            v4u w; w.x = pk2(v0[0], v0[1]); w.y = pk2(v0[2], v0[3]); w.z = pk2(v1[0], v1[1]); w.w = pk2(v1[2], v1[3]);
                            *(v4u*)(XC + ((size_t)(bj * 2 + (wc >> 1)) * XCP + r) * 64 + (wc & 1) * 32 + 8 * fq) = w;
                        }
                    } else {
                        if (bj == 0 && wc == 0) { float* gp = GATE + (size_t)r * 32 + 8 * fq; *(f32x4*)gp = v0; *(f32x4*)(gp + 4) = v1; }
                    }
                }
            }
    }
};

struct EpiResid {
    static constexpr bool PERM = true, AFTER_DRAIN = false;
    const float* xa; const float* xb; const float* gate; float* Z;
    __device__ __forceinline__ void operator()(const f32x4 (&acc)[2][2][4][2], const pg8::Unit& u, int wr, int wc, int fr, int fq) const {
        const int row0 = u.pm * 256 + wr * 64 + fr, col0 = u.pn * 256 + wc * 32 + 8 * fq;
#pragma unroll
        for (int ai = 0; ai < 2; ++ai)
#pragma unroll
            for (int m = 0; m < 4; ++m) {
                const int r = row0 + ai * 128 + m * 16;
                const float* xr = (r < MP ? xa + (size_t)r * D : xb + (size_t)(r - MP) * D) + col0;
                const float* gr = gate + (size_t)cond_of_row(r) * 6144 + col0;
                float* zr = Z + (size_t)r * D + col0;
#pragma unroll
                for (int bj = 0; bj < 2; ++bj) {
                    const f32x4 x0 = *(const f32x4*)(xr + bj * 128), x1 = *(const f32x4*)(xr + bj * 128 + 4);
                    const f32x4 g0 = *(const f32x4*)(gr + bj * 128), g1 = *(const f32x4*)(gr + bj * 128 + 4);
                    *(f32x4*)(zr + bj * 128) = x0 * ALPHA + g0 * acc[ai][bj][m][0];
                    *(f32x4*)(zr + bj * 128 + 4) = x1 * ALPHA + g1 * acc[ai][bj][m][1];
                }
            }
    }
};

struct EpiRelu2 {
    static constexpr bool PERM = true, AFTER_DRAIN = false;
    bf16* H;
    __device__ __forceinline__ void operator()(const f32x4 (&acc)[2][2][4][2], const pg8::Unit& u, int wr, int wc, int fr, int fq) const {
        const int row0 = u.pm * 256 + wr * 64 + fr, col0 = u.pn * 256 + wc * 32 + 8 * fq;
#pragma unroll
        for (int ai = 0; ai < 2; ++ai)
#pragma unroll
            for (int m = 0; m < 4; ++m) {
                bf16* hr = H + (size_t)(row0 + ai * 128 + m * 16) * FF + col0;
#pragma unroll
                for (int bj = 0; bj < 2; ++bj) {
                    f32x4 a = acc[ai][bj][m][0], b = acc[ai][bj][m][1];
#pragma unroll
                    for (int i = 0; i < 4; ++i) { a[i] = fmaxf(a[i], 0.f); a[i] *= a[i]; b[i] = fmaxf(b[i], 0.f); b[i] *= b[i]; }
                    v4u w; w.x = pk2(a[0], a[1]); w.y = pk2(a[2], a[3]); w.z = pk2(b[0], b[1]); w.w = pk2(b[2], b[3]);
                    *(v4u*)(hr + bj * 128) = w;
                }
            }
    }
};

__device__ __forceinline__ float gelu_tanh(float x) {
    const float y = 0.7978845608028654f * (x + 0.044715f * x * x * x);
    const float t = 1.f - 2.f / (__expf(2.f * y) + 1.f);
    return 0.5f * x * (1.f + t);
}
struct EpiCmpHid {
    static constexpr bool PERM = true, AFTER_DRAIN = false;
    bf16* HID; const float* B1;
    __device__ __forceinline__ void operator()(const f32x4 (&acc)[2][2][4][2], const pg8::Unit& u, int wr, int wc, int fr, int fq) const {
        const int row0 = u.pm * 256 + wr * 64 + fr, col0 = wc * 32 + 8 * fq;
        const float* bp = B1 + u.pn * 256 + col0;
        f32x4 bv[2][2];
#pragma unroll
        for (int bj = 0; bj < 2; ++bj) { bv[bj][0] = *(const f32x4*)(bp + bj * 128); bv[bj][1] = *(const f32x4*)(bp + bj * 128 + 4); }
#pragma unroll
        for (int ai = 0; ai < 2; ++ai)
#pragma unroll
            for (int m = 0; m < 4; ++m) {
                bf16* hr = HID + (size_t)(row0 + ai * 128 + m * 16) * 256 + col0;
#pragma unroll
                for (int bj = 0; bj < 2; ++bj) {
                    f32x4 a = acc[ai][bj][m][0] + bv[bj][0], b = acc[ai][bj][m][1] + bv[bj][1];
#pragma unroll
                    for (int i = 0; i < 4; ++i) { a[i] = gelu_tanh(a[i]); b[i] = gelu_tanh(b[i]); }
                    v4u w; w.x = pk2(a[0], a[1]); w.y = pk2(a[2], a[3]); w.z = pk2(b[0], b[1]); w.w = pk2(b[2], b[3]);
                    *(v4u*)(hr + bj * 128) = w;
                }
            }
    }
};

struct CmpOrder {
    int G, c, l0, nl, t0, ntile;
    __device__ __forceinline__ bool next(int i, pg8::Unit& u) const {
        const int L = i * G + c; if (L >= nl * 4 * ntile) return false;
        const int blk = L / ntile, tile = L % ntile, l = l0 + (blk >> 2), sg = blk & 3;
        u.pm = (l * 4 + sg) * 68 + t0 + tile; u.pn = l * 2 + (sg >> 1); return true;
    }
    __device__ __forceinline__ void a_ready(const pg8::Unit&) const {}
    __device__ __forceinline__ void done(const pg8::Unit&) const {}
};

#define LDS_WAIT() asm volatile("s_waitcnt lgkmcnt(0)" ::: "memory")
#define VM_WAIT() asm volatile("s_waitcnt vmcnt(0)" ::: "memory")

template <class CM>
__device__ __forceinline__ void transpose_item(const float* W, int ldw, int K, bf16* WT, LAS float* scr, int item, int nblk, int lane, const CM& cm) {
    const int kb = item / nblk, nb = item % nblk, k0 = 64 * kb, n0 = 32 * nb;
    const int sc = cm.col(n0 + (lane & 31)); const float scl = cm.scl(n0 + (lane & 31));
#pragma unroll 8
    for (int i = 0; i < 32; ++i) { const int kk = 2 * i + (lane >> 5); scr[kk * 33 + (lane & 31)] = sc >= 0 ? W[(size_t)(k0 + kk) * ldw + sc] * scl : 0.f; }
    LDS_WAIT();
    const int c = lane & 7;
#pragma unroll
    for (int j = 0; j < 4; ++j) { const int n = (lane >> 3) + 8 * j; const LAS float* s = scr + (8 * c) * 33 + n;
        v4u o; o.x = pk2(s[0 * 33], s[1 * 33]); o.y = pk2(s[2 * 33], s[3 * 33]); o.z = pk2(s[4 * 33], s[5 * 33]); o.w = pk2(s[6 * 33], s[7 * 33]);
        *(v4u*)(WT + (size_t)(n0 + n) * K + k0 + 8 * c) = o; }
    LDS_WAIT();
}
struct CmId { __device__ __forceinline__ int col(int n) const { return n; } __device__ __forceinline__ float scl(int) const { return 1.f; } };
struct CmIn {
    __device__ __forceinline__ int col(int n) const { return n < 2048 ? n : (n < 3328 ? n + 8 : (n < 3336 ? n - 1280 : (n < 3360 ? n : -1))); }
    __device__ __forceinline__ float scl(int n) const { return (n >= 512 && n < 1024) ? 0.08838834764831845f : ((n >= 2048 && n < 2560) ? 0.125f : 1.f); }
};

__device__ __forceinline__ int rel_bucket_dev(int n) {
    if (n < 16) return n;
    const float nf = (float)n;
    int large = 16 + (int)(__logf(nf / 16.f) / 2.0794415416798357f * 16.f);
    return large < 31 ? large : 31;
}

__device__ __forceinline__ void phase_p0a(CArgs& A, LAS unsigned char* lds, int gw, int NGW, int lane, int wave) {
    unsigned char* ws = A.ws;
    LAS float* scr = (LAS float*)(lds + wave * 16384);
    constexpr int I_IN = 16 * 112, I_OUT = 16 * 32, I_UP = 16 * 128, I_DN = 64 * 32, I_W1 = 32 * 8;
    constexpr int I_L = I_IN + I_OUT + I_UP + I_DN + 2 * I_W1;
    for (int it = gw; it < DEPTH * I_L; it += NGW) {
        const int l = it / I_L; int r = it % I_L;
        if (r < I_IN) { transpose_item(A.w_in + (size_t)l * D * 3360, 3360, D, (bf16*)(ws + WS_WIN) + (size_t)l * NINP * D, scr, r, 112, lane, CmIn{}); continue; } r -= I_IN;
        if (r < I_OUT) { transpose_item(A.w_out + (size_t)l * D * D, D, D, (bf16*)(ws + WS_WOUT) + (size_t)l * D * D, scr, r, 32, lane, CmId{}); continue; } r -= I_OUT;
        if (r < I_UP) { transpose_item(A.w_up + (size_t)l * D * FF, FF, D, (bf16*)(ws + WS_WUP) + (size_t)l * FF * D, scr, r, 128, lane, CmId{}); continue; } r -= I_UP;
        if (r < I_DN) { transpose_item(A.w_down + (size_t)l * FF * D, D, FF, (bf16*)(ws + WS_WDN) + (size_t)l * D * FF, scr, r, 32, lane, CmId{}); continue; } r -= I_DN;
        const int s = r / I_W1; r %= I_W1;
        transpose_item(A.cmp_w1 + (size_t)(l * 2 + s) * 2048 * 256, 256, 2048, (bf16*)(ws + WS_W1) + (size_t)(l * 2 + s) * 256 * 2048, scr, r, 8, lane, CmId{});
    }
    for (int it = gw; it < DEPTH * DB * NPG * 2; it += NGW) {
        const int half = it & 1, pg = (it >> 1) & 15, seq = (it >> 5) & 127, l = it >> 12;
        const int phys = A.page_table[seq * NPG + pg];
        const float* src = A.cache_cmp + (((size_t)l * NPHYS + phys) * PAGE + half * 64) * 256 + 4 * lane;
        const int cc = 4 * lane, s = cc >> 7, g = (cc >> 6) & 1, d = cc & 63;
        bf16* dst = (bf16*)(ws + WS_XC) + ((size_t)((l * 2 + s) * 2 + g) * XCP + MP + seq * PAST + pg * PAGE + half * 64) * 64 + d;
#pragma unroll 8
        for (int sl = 0; sl < 64; ++sl) { const f32x4 v = *(const f32x4*)(src + (size_t)sl * 256); v2u w; w.x = pk2(v[0], v[1]); w.y = pk2(v[2], v[3]); *(v2u*)(dst + (size_t)sl * 64) = w; }
    }
    for (int it = gw; it < DEPTH * DB * 8; it += NGW) {
        const int ch = it & 7, ls = it >> 3;
        const float* src = A.cache_win + ((size_t)ls * 512 + 4 + ch * 64) * 256 + 4 * lane;
        float* dst = A.out + O_WINS + ((size_t)ls * 512 + ch * 64) * 256 + 4 * lane;
        const int n = ch == 7 ? 60 : 64;
        for (int i = 0; i < n; ++i) *(f32x4*)(dst + (size_t)i * 256) = *(const f32x4*)(src + (size_t)i * 256);
    }
    for (int it = gw; it < 8; it += NGW) {
        float* BT = (float*)(ws + WS_BT) + it * 132;
        for (int dd = lane; dd < 129; dd += 64) BT[dd] = A.rel_bias[rel_bucket_dev(dd) * 8 + it];
    }
    for (int it = gw; it < DEPTH * 2 * 4 * 16; it += NGW) {
        const int kp = it & 15, hq = (it >> 4) & 3, ls = it >> 6, h = hq * 64 + lane;
        const float* pe = A.cmp_pe + (size_t)ls * 2048 + kp * 128; const float* w1 = A.cmp_w1 + ((size_t)ls * 2048 + kp * 128) * 256 + h;
        float acc = 0.f;
#pragma unroll 16
        for (int k = 0; k < 128; ++k) acc += pe[k] * w1[(size_t)k * 256];
        ((float*)(ws + WS_B1))[2048 + (ls * 16 + kp) * 256 + h] = acc;
    }
    for (int it = gw; it < DEPTH * 2 * 64; it += NGW) {
        const int d = it & 63, ls = it >> 6;
        for (int h = lane; h < 256; h += 64) ((bf16*)(ws + WS_W2T))[((size_t)ls * 64 + d) * 256 + h] = (bf16)f2bf(A.cmp_w2[((size_t)ls * 256 + h) * 64 + d]);
    }
}

__device__ __forceinline__ void phase_ada(CArgs& A, LAS unsigned char* lds, int tid) {
    for (int i = blockIdx.x * NTHR + tid; i < DEPTH * 2 * 256; i += gridDim.x * NTHR) { const float* p = (const float*)(A.ws + WS_B1) + 2048 + (i >> 8) * 16 * 256 + (i & 255);
        float acc = 0.f;
#pragma unroll
        for (int kp = 0; kp < 16; ++kp) acc += p[kp * 256];
        ((float*)(A.ws + WS_B1))[i] = acc; }
    LAS float* a = (LAS float*)lds;
    for (int task = blockIdx.x; task < DEPTH * 12 * 10; task += gridDim.x) {
        const int rb = task % 10, cb = (task / 10) % 12, l = task / 120;
        __syncthreads();
        for (int i = tid; i < 13 * 1024; i += NTHR) { const int row = rb * 13 + i / 1024, k = i & 1023;
            const float c = row < BATCH ? A.c_prompt[row * D + k] : A.c_sample[(row - BATCH) * D + k]; a[i] = c / (1.f + __expf(-c)); }
        __syncthreads();
        const int j = cb * 512 + tid;
        const float* w = A.w_ada + (size_t)l * D * 6144 + j;
        float acc[13];
#pragma unroll
        for (int r = 0; r < 13; ++r) acc[r] = 0.f;
        for (int k = 0; k < D; k += 4) { const float w0 = w[(size_t)k * 6144], w1 = w[(size_t)(k + 1) * 6144], w2 = w[(size_t)(k + 2) * 6144], w3 = w[(size_t)(k + 3) * 6144];
#pragma unroll
            for (int r = 0; r < 13; ++r) { const f32x4 a4 = *(const LAS f32x4*)(a + r * 1024 + k); acc[r] += (a4[0] * w0 + a4[1] * w1) + (a4[2] * w2 + a4[3] * w3); } }
        const float bb = A.b_ada[l * 6144 + j];
        float* o = (float*)(A.ws + WS_ADA) + ((size_t)l * NCOND + rb * 13) * 6144 + j;
#pragma unroll
        for (int r = 0; r < 13; ++r) o[(size_t)r * 6144] = acc[r] + bb;
    }
}

__device__ __forceinline__ void mod_row(const float* xrow, const float* sh, const float* sc, bf16* urow, int lane) {
#pragma unroll
    for (int j = 0; j < 4; ++j) { const int c = 4 * lane + 256 * j;
        const f32x4 x = *(const f32x4*)(xrow + c), a = *(const f32x4*)(sh + c), b = *(const f32x4*)(sc + c);
        v2u w; w.x = pk2(x[0] * (1.f + b[0]) + a[0], x[1] * (1.f + b[1]) + a[1]); w.y = pk2(x[2] * (1.f + b[2]) + a[2], x[3] * (1.f + b[3]) + a[3]);
        *(v2u*)(urow + c) = w; }
}
__device__ __forceinline__ void ln_row(const float* zrow, const float* g, const float* b, float* xout, const float* sh, const float* sc, bf16* urow, int lane) {
    f32x4 v[4]; float s = 0.f;
#pragma unroll
    for (int j = 0; j < 4; ++j) { v[j] = *(const f32x4*)(zrow + 4 * lane + 256 * j); s += (v[j][0] + v[j][1]) + (v[j][2] + v[j][3]); }
    const float mean = wave_sum(s) * (1.f / D); float s2 = 0.f;
#pragma unroll
    for (int j = 0; j < 4; ++j) { v[j] = v[j] - mean; s2 += (v[j][0] * v[j][0] + v[j][1] * v[j][1]) + (v[j][2] * v[j][2] + v[j][3] * v[j][3]); }
    const float rstd = 1.f / sqrtf(wave_sum(s2) * (1.f / D) + LN_EPS);
#pragma unroll
    for (int j = 0; j < 4; ++j) { const int c = 4 * lane + 256 * j;
        const f32x4 gg = *(const f32x4*)(g + c), bb = *(const f32x4*)(b + c);
        const f32x4 x = v[j] * rstd * gg + bb;
        *(f32x4*)(xout + c) = x;
        if (urow) { const f32x4 a = *(const f32x4*)(sh + c), q = *(const f32x4*)(sc + c);
            v2u w; w.x = pk2(x[0] * (1.f + q[0]) + a[0], x[1] * (1.f + q[1]) + a[1]); w.y = pk2(x[2] * (1.f + q[2]) + a[2], x[3] * (1.f + q[3]) + a[3]);
            *(v2u*)(urow + c) = w; } }
}

__device__ __forceinline__ float scan_sum256(float v, LAS float* buf, int tid) {
    const int lane = tid & 63, w = tid >> 6;
#pragma unroll
    for (int o = 1; o < 64; o <<= 1) { const float y = __shfl_up(v, o); if (lane >= o) v += y; }
    __syncthreads();
    if (lane == 63) buf[w] = v;
    __syncthreads();
    float add = 0.f;
#pragma unroll
    for (int i = 0; i < 3; ++i) if (i < w) add += buf[i];
    return v + add;
}
__device__ __forceinline__ float scan_max256(float v, LAS float* buf, int tid) {
    const int lane = tid & 63, w = tid >> 6;
#pragma unroll
    for (int o = 1; o < 64; o <<= 1) { const float y = __shfl_up(v, o); if (lane >= o) v = fmaxf(v, y); }
    __syncthreads();
    if (lane == 63) buf[w] = v;
    __syncthreads();
#pragma unroll
    for (int i = 0; i < 3; ++i) if (i < w) v = fmaxf(v, buf[i]);
    return v;
}
__device__ __forceinline__ void ml_gates(CArgs& A, int l, int r, int h, float& ig, float& lf) {
    const float* G = (const float*)(A.ws + WS_GATE) + (size_t)r * 32;
    ig = G[h] + A.b_gate[l * 8 + h];
    const float fr = G[4 + h] + A.b_gate[l * 8 + 4 + h];
    lf = fminf(fr, 0.f) - log1pf(__expf(-fabsf(fr)));
}

__device__ __forceinline__ void phase_m2(CArgs& A, int l, LAS unsigned char* lds, int tid) {
    LAS float* buf = (LAS float*)lds;
    LAS float* wl = (LAS float*)(lds + 1024);
    const bf16* QKVO = (const bf16*)(A.ws + WS_QKVO);
    for (int unit = blockIdx.x; unit < NUNIT; unit += gridDim.x) {
        const int b = unit >> 7, h = (unit >> 5) & 3, c = unit & 31, r0 = b * SEQ + c * LCH;
        float ig = 0.f, lf = 0.f;
        if (tid < 256) ml_gates(A, l, r0 + tid, h, ig, lf);
        const float F = scan_sum256(lf, buf, tid);
        __syncthreads();
        if (tid == 255) buf[16] = F;
        __syncthreads();
        const float Fend = buf[16];
        const float gl = tid < 256 ? Fend - F + ig : -3.0e38f;
        float mw = wave_max(gl);
        if ((tid & 63) == 0) buf[20 + (tid >> 6)] = mw;
        __syncthreads();
        const float mloc = fmaxf(fmaxf(buf[20], buf[21]), fmaxf(buf[22], buf[23]));
        if (tid < 256) wl[tid] = __expf(gl - mloc);
        if (tid == 0) { float* ch = (float*)(A.ws + WS_CHS) + unit * 4; ch[0] = Fend; ch[1] = mloc; }
        __syncthreads();
        const int k = tid & 127, vq = tid >> 7;
        float acc[32]; float accn = 0.f;
#pragma unroll
        for (int i = 0; i < 32; ++i) acc[i] = 0.f;
        const bf16* kp = QKVO + (size_t)r0 * 2048 + 512 + h * HD + k;
        const bf16* vp = QKVO + (size_t)r0 * 2048 + 1024 + h * HD + 32 * vq;
        for (int s = 0; s < LCH; ++s) {
            const float wk = wl[s] * bf2f(kp[(size_t)s * 2048]);
            accn += wk;
            const v4u* v4 = (const v4u*)(vp + (size_t)s * 2048);
#pragma unroll
            for (int q = 0; q < 4; ++q) { const v4u vv = v4[q];
                acc[8 * q + 0] += wk * bflo(vv.x); acc[8 * q + 1] += wk * bfhi(vv.x); acc[8 * q + 2] += wk * bflo(vv.y); acc[8 * q + 3] += wk * bfhi(vv.y);
                acc[8 * q + 4] += wk * bflo(vv.z); acc[8 * q + 5] += wk * bfhi(vv.z); acc[8 * q + 6] += wk * bflo(vv.w); acc[8 * q + 7] += wk * bfhi(vv.w); }
        }
        float* dct = (float*)(A.ws + WS_DCT) + ((size_t)unit * HD + 32 * vq) * HD + k;
#pragma unroll
        for (int i = 0; i < 32; ++i) dct[(size_t)i * HD] = acc[i];
        if (vq == 0) ((float*)(A.ws + WS_DN))[unit * HD + k] = accn;
        __syncthreads();
    }
}

__device__ __forceinline__ void phase_m3(CArgs& A, int l, int tid) {
    for (int task = blockIdx.x; task < BATCH * NH * 33; task += gridDim.x) {
        const int bh = task / 33, part = task % 33;
        const bool isn = part == 32; if (isn && tid >= HD) continue;
        const int e = isn ? tid : part * 512 + tid;
        const float* chs = (const float*)(A.ws + WS_CHS) + (size_t)bh * NCH * 4;
        float st = 0.f, m0 = 0.f;
        for (int c = 0; c < NCH; ++c) {
            const int unit = bh * NCH + c;
            const float Fend = chs[c * 4], mloc = chs[c * 4 + 1];
            float dv;
            if (isn) { ((float*)(A.ws + WS_NPV))[unit * HD + e] = st; dv = ((const float*)(A.ws + WS_DN))[unit * HD + e]; if (tid == 0) ((float*)(A.ws + WS_CHS))[unit * 4 + 2] = m0; }
            else { ((bf16*)(A.ws + WS_CTP))[(size_t)unit * HD * HD + e] = (bf16)f2bf(st); dv = ((const float*)(A.ws + WS_DCT))[(size_t)unit * HD * HD + e]; }
            const float mend = fmaxf(m0 + Fend, mloc);
            st = __expf(m0 + Fend - mend) * st + __expf(mloc - mend) * dv;
            m0 = mend;
        }
        if (isn) { A.out[O_NP + ((size_t)l * BATCH * NH + bh) * HD + e] = st; if (tid == 0) A.out[O_MP + l * BATCH * NH + bh] = m0; }
        else { const int v = e >> 7, k = e & 127; A.out[O_CP + (((size_t)l * BATCH * NH + bh) * HD + k) * HD + v] = st; }
    }
}

__device__ __forceinline__ void phase_m4(CArgs& A, int l, LAS unsigned char* lds, int tid) {
    LAS float* buf = (LAS float*)lds;
    LAS float* sa = (LAS float*)(lds + 1024);
    LAS float* smx = sa + 256;
    LAS float* sdec = smx + 256;
    LAS float* sem = sdec + 256;
    LAS bf16* sv = (LAS bf16*)(lds + 8192);
    const bf16* QKVO = (const bf16*)(A.ws + WS_QKVO);
    const int lane = tid & 63, wave = tid >> 6;
    for (int unit = blockIdx.x; unit < NUNIT; unit += gridDim.x) {
        const int b = unit >> 7, h = (unit >> 5) & 3, c = unit & 31, r0 = b * SEQ + c * LCH;
        float ig = 0.f, lf = 0.f;
        if (tid < 256) ml_gates(A, l, r0 + tid, h, ig, lf);
        const float F = scan_sum256(lf, buf, tid);
        const float a = tid < 256 ? ig - F : -3.0e38f;
        const float cm = scan_max256(a, buf, tid);
        const float m0 = ((const float*)(A.ws + WS_CHS))[unit * 4 + 2];
        if (tid < 256) { const float mx = fmaxf(m0, cm); sa[tid] = a; smx[tid] = mx; sdec[tid] = __expf(m0 - mx); sem[tid] = __expf(-(F + mx)); }
        for (int i = tid; i < LCH * HD / 8; i += NTHR) { const int s = i >> 4, q = i & 15;
            *(LAS v4u*)(sv + s * HD + 8 * q) = *(const v4u*)(QKVO + (size_t)(r0 + s) * 2048 + 1024 + h * HD + 8 * q); }
        __syncthreads();
        float* W = (float*)(A.ws + WS_WSC) + (size_t)unit * LCH * LCH;
        for (int idx = tid; idx < LCH * LCH; idx += NTHR) {
            const int t = idx >> 8, s = idx & 255; float w = 0.f;
            if (s <= t) {
                const v4u* qp = (const v4u*)(QKVO + (size_t)(r0 + t) * 2048 + h * HD); const v4u* kp = (const v4u*)(QKVO + (size_t)(r0 + s) * 2048 + 512 + h * HD);
                float d = 0.f;
#pragma unroll 4
                for (int q = 0; q < 16; ++q) { const v4u x = qp[q], y = kp[q];
                    d += bflo(x.x) * bflo(y.x) + bfhi(x.x) * bfhi(y.x) + bflo(x.y) * bflo(y.y) + bfhi(x.y) * bfhi(y.y)
                       + bflo(x.z) * bflo(y.z) + bfhi(x.z) * bfhi(y.z) + bflo(x.w) * bflo(y.w) + bfhi(x.w) * bfhi(y.w); }
                w = d * __expf(sa[s] - smx[t]);
            }
            W[idx] = w;
        }
        __syncthreads();
        {
            const int v = tid & 127, tq = tid >> 7;
            const bf16* ctp = (const bf16*)(A.ws + WS_CTP) + ((size_t)unit * HD + v) * HD;
            const float* npv = (const float*)(A.ws + WS_NPV) + unit * HD;
            float* hraw = (float*)(A.ws + WS_HRAW) + (size_t)unit * LCH * HD;
            for (int i = 0; i < 64; ++i) {
                const int t = 4 * i + tq;
                float num = 0.f, den = 0.f;
                const float* wr = W + (size_t)t * LCH;
                for (int s = 0; s <= t; s += 4) { const f32x4 w4 = *(const f32x4*)(wr + s);
                    num += w4[0] * bf2f(sv[(s + 0) * HD + v]) + w4[1] * bf2f(sv[(s + 1) * HD + v]) + w4[2] * bf2f(sv[(s + 2) * HD + v]) + w4[3] * bf2f(sv[(s + 3) * HD + v]);
                    den += (w4[0] + w4[1]) + (w4[2] + w4[3]); }
                float qc = 0.f, qn = 0.f;
                const v4u* qp = (const v4u*)(QKVO + (size_t)(r0 + t) * 2048 + h * HD);
#pragma unroll 4
                for (int q = 0; q < 16; ++q) { const v4u x = qp[q], y = *(const v4u*)(ctp + 8 * q); const f32x4 n0 = *(const f32x4*)(npv + 8 * q), n1 = *(const f32x4*)(npv + 8 * q + 4);
                    qc += bflo(x.x) * bflo(y.x) + bfhi(x.x) * bfhi(y.x) + bflo(x.y) * bflo(y.y) + bfhi(x.y) * bfhi(y.y)
                        + bflo(x.z) * bflo(y.z) + bfhi(x.z) * bfhi(y.z) + bflo(x.w) * bflo(y.w) + bfhi(x.w) * bfhi(y.w);
                    qn += bflo(x.x) * n0[0] + bfhi(x.x) * n0[1] + bflo(x.y) * n0[2] + bfhi(x.y) * n0[3] + bflo(x.z) * n1[0] + bfhi(x.z) * n1[1] + bflo(x.w) * n1[2] + bfhi(x.w) * n1[3]; }
                const float dec = sdec[t];
                const float numt = num + dec * qc, dent = den + dec * qn;
                hraw[(size_t)t * HD + v] = numt / fmaxf(fabsf(dent), sem[t]);
            }
        }
        __syncthreads();
        {
            const float* hraw = (const float*)(A.ws + WS_HRAW) + (size_t)unit * LCH * HD;
            const float g0 = A.ml_norm_g[l * 512 + h * HD + lane], g1 = A.ml_norm_g[l * 512 + h * HD + 64 + lane];
            for (int t = wave; t < LCH; t += NWAVES) {
                const float x0 = hraw[(size_t)t * HD + lane], x1 = hraw[(size_t)t * HD + 64 + lane];
                const float mu = wave_sum(x0 + x1) * (1.f / HD);
                const float d0 = x0 - mu, d1 = x1 - mu;
                const float rstd = 1.f / sqrtf(wave_sum(d0 * d0 + d1 * d1) * (1.f / HD) + LN_EPS);
                const bf16* op = QKVO + (size_t)(r0 + t) * 2048 + 1536 + h * HD;
                bf16* mp = (bf16*)(A.ws + WS_MIX) + (size_t)(r0 + t) * D + h * HD;
                mp[lane] = (bf16)f2bf(d0 * rstd * g0 * sigmoidf_(bf2f(op[lane])));
                mp[64 + lane] = (bf16)f2bf(d1 * rstd * g1 * sigmoidf_(bf2f(op[64 + lane])));
            }
        }
        __syncthreads();
    }
}

__device__ __forceinline__ void phase_mls(CArgs& A, int l, LAS unsigned char* lds, int tid) {
    LAS float* sq = (LAS float*)lds;
    LAS float* sc = sq + 1536;
    LAS float* sw = sc + 64;
    LAS float* part = sw + 16;
    LAS float* red = part + 2048;
    const bf16* QKVO = (const bf16*)(A.ws + WS_QKVO);
    for (int task = blockIdx.x; task < DB * NH; task += gridDim.x) {
        const int seq = task >> 2, h = task & 3, r0 = MP + seq * DS, sidx = (l * DB + seq) * NH + h;
        __syncthreads();
        for (int i = tid; i < 1536; i += NTHR) { const int which = i >> 9, t = (i >> 7) & 3, d = i & 127; sq[i] = bf2f(QKVO[(size_t)(r0 + t) * 2048 + which * 512 + h * HD + d]); }
        const float m0 = A.st_m[sidx];
        if (tid == 0) {
            float F = 0.f, cmx = -3.0e38f, Fs[4], igs[4], mlast = 0.f;
#pragma unroll
            for (int t = 0; t < 4; ++t) { float ig, lf; ml_gates(A, l, r0 + t, h, ig, lf); F += lf; Fs[t] = F; igs[t] = ig; const float a = ig - F; cmx = fmaxf(cmx, a); const float mx = fmaxf(m0, cmx);
                sc[8 + t] = a; sc[12 + t] = mx; sc[16 + t] = __expf(m0 - mx); sc[20 + t] = __expf(-(F + mx)); mlast = F + mx; }
#pragma unroll
            for (int t = 0; t < 4; ++t) sc[24 + t] = __expf(Fs[3] - Fs[t] + igs[t] - mlast);
            sc[28] = __expf(Fs[3] + m0 - mlast); sc[29] = mlast;
        }
        __syncthreads();
        if (tid < 16) { const int t = tid >> 2, s = tid & 3; float w = 0.f;
            if (s <= t) { float d = 0.f; for (int k = 0; k < HD; ++k) d += sq[t * HD + k] * sq[512 + s * HD + k]; w = d * __expf(sc[8 + s] - sc[12 + t]); }
            sw[tid] = w; }
        else if (tid < 20) { const int t = tid - 16; const float* n0 = A.st_n + (size_t)sidx * HD; float d = 0.f; for (int k = 0; k < HD; ++k) d += sq[t * HD + k] * n0[k]; sc[32 + t] = d; }
        __syncthreads();
        {
            const int v = tid & 127, kq = tid >> 7;
            const float* C0 = A.st_C + (size_t)sidx * HD * HD; float* Co = A.out + O_CS + (size_t)sidx * HD * HD;
            const float cd = sc[28];
            float wv[4]; float qc[4] = {0.f, 0.f, 0.f, 0.f};
#pragma unroll
            for (int t = 0; t < 4; ++t) wv[t] = sc[24 + t] * sq[1024 + t * HD + v];
            for (int kk = 0; kk < 32; ++kk) { const int k = kq * 32 + kk; const float c0 = C0[(size_t)k * HD + v];
                float cn = cd * c0;
#pragma unroll
                for (int t = 0; t < 4; ++t) { qc[t] += sq[t * HD + k] * c0; cn += wv[t] * sq[512 + t * HD + k]; }
                Co[(size_t)k * HD + v] = cn; }
#pragma unroll
            for (int t = 0; t < 4; ++t) part[(kq * 4 + t) * HD + v] = qc[t];
        }
        __syncthreads();
        float hv[4] = {0.f, 0.f, 0.f, 0.f};
        if (tid < HD) {
            const int v = tid;
#pragma unroll
            for (int t = 0; t < 4; ++t) { const float qct = part[(0 * 4 + t) * HD + v] + part[(1 * 4 + t) * HD + v] + part[(2 * 4 + t) * HD + v] + part[(3 * 4 + t) * HD + v];
                float num = sc[16 + t] * qct, den = sc[16 + t] * sc[32 + t];
#pragma unroll
                for (int s = 0; s < 4; ++s) { num += sw[t * 4 + s] * sq[1024 + s * HD + v]; den += sw[t * 4 + s]; }
                hv[t] = num / fmaxf(fabsf(den), sc[20 + t]); }
        }
#pragma unroll
        for (int t = 0; t < 4; ++t) { const float s1 = wave_sum(hv[t]); if ((tid & 63) == 0 && tid < HD) red[t * 2 + (tid >> 6)] = s1; }
        __syncthreads();
        float dv[4];
#pragma unroll
        for (int t = 0; t < 4; ++t) { dv[t] = hv[t] - (red[t * 2] + red[t * 2 + 1]) * (1.f / HD); const float s2 = wave_sum(dv[t] * dv[t]); if ((tid & 63) == 0 && tid < HD) red[8 + t * 2 + (tid >> 6)] = s2; }
        __syncthreads();
        if (tid < HD) {
            const int v = tid; const float gn = A.ml_norm_g[l * 512 + h * HD + v];
#pragma unroll
            for (int t = 0; t < 4; ++t) { const float rstd = 1.f / sqrtf((red[8 + t * 2] + red[8 + t * 2 + 1]) * (1.f / HD) + LN_EPS);
                const float og = bf2f(QKVO[(size_t)(r0 + t) * 2048 + 1536 + h * HD + v]);
                ((bf16*)(A.ws + WS_MIX))[(size_t)(r0 + t) * D + h * HD + v] = (bf16)f2bf(dv[t] * rstd * gn * sigmoidf_(og)); }
        } else if (tid < 2 * HD) {
            const int k = tid - HD; float nn = sc[28] * A.st_n[(size_t)sidx * HD + k];
#pragma unroll
            for (int t = 0; t < 4; ++t) nn += sc[24 + t] * sq[512 + t * HD + k];
            A.out[O_NS + (size_t)sidx * HD + k] = nn;
        }
        if (tid == 0) A.out[O_MS + sidx] = sc[29];
    }
}

typedef short bf16x8c __attribute__((ext_vector_type(8)));
__device__ __forceinline__ void phase_cmp2(CArgs& A, int l0, int nl, int r_lo, int nrows, int gw, int NGW, int lane) {
    const int fr = lane & 15, fq = lane >> 4, ntile = nrows / 16;
    for (int task = gw; task < nl * 4 * ntile; task += NGW) {
        const int img = task / ntile, tr = task % ntile, l = l0 + (img >> 2), sg = img & 3, s = sg >> 1, g = sg & 1, R0 = r_lo + tr * 16;
        const bf16* hp = (const bf16*)(A.ws + WS_HID) + ((size_t)(l * 4 + sg) * NCB + R0 + fr) * 256 + 8 * fq;
        const bf16* wp = (const bf16*)(A.ws + WS_W2T) + ((size_t)(l * 2 + s) * 64 + fr) * 256 + 8 * fq;
        f32x4 acc[4];
#pragma unroll
        for (int dt = 0; dt < 4; ++dt) acc[dt] = (f32x4){0.f, 0.f, 0.f, 0.f};
#pragma unroll
        for (int ks = 0; ks < 8; ++ks) {
            const bf16x8c hf = *(const bf16x8c*)(hp + 32 * ks);
#pragma unroll
            for (int dt = 0; dt < 4; ++dt) { const bf16x8c wf = *(const bf16x8c*)(wp + (size_t)dt * 16 * 256 + 32 * ks);
                acc[dt] = s == 0 ? __builtin_amdgcn_mfma_f32_16x16x32_bf16(wf, hf, acc[dt], 0, 0, 0) : __builtin_amdgcn_mfma_f32_16x16x32_bf16(hf, wf, acc[dt], 0, 0, 0); }
        }
        if (s == 0) {
            bf16* o = (bf16*)(A.ws + WS_KC) + ((size_t)(l * 2 + g) * NCB + R0 + fr) * 64 + 4 * fq;
#pragma unroll
            for (int dt = 0; dt < 4; ++dt) { v2u w; w.x = pk2(acc[dt][0], acc[dt][1]); w.y = pk2(acc[dt][2], acc[dt][3]); *(v2u*)(o + 16 * dt) = w; }
        } else {
            bf16* o = (bf16*)(A.ws + WS_VCT) + ((size_t)(l * 2 + g) * 64 + fr) * NCB + R0 + 4 * fq;
#pragma unroll
            for (int dt = 0; dt < 4; ++dt) { v2u w; w.x = pk2(acc[dt][0], acc[dt][1]); w.y = pk2(acc[dt][2], acc[dt][3]); *(v2u*)(o + (size_t)dt * 16 * NCB) = w; }
        }
    }
}

#define NEGBIG (-3.0e38f)
template <int NB, class KF>
__device__ __forceinline__ void attend(const KF& kf, int nblk, const LAS float* qs, LAS float* pb, const float* BT, int hbase, int lane, float (&o)[4]) {
    float s[NB][4]; float mx[4] = {NEGBIG, NEGBIG, NEGBIG, NEGBIG};
#pragma unroll
    for (int it = 0; it < NB; ++it) {
        if (it < nblk) {
            const int p = kf.key(it, lane); const bool ok = kf.ok(p); const int pc = kf.clampk(p);
            const float* kr = kf.krow(pc);
            float d0 = 0.f, d1 = 0.f, d2 = 0.f, d3 = 0.f;
#pragma unroll 4
            for (int dd = 0; dd < 64; dd += 4) { const f32x4 k4 = *(const f32x4*)(kr + dd);
                const f32x4 q0 = *(const LAS f32x4*)(qs + dd), q1 = *(const LAS f32x4*)(qs + 64 + dd), q2 = *(const LAS f32x4*)(qs + 128 + dd), q3 = *(const LAS f32x4*)(qs + 192 + dd);
                d0 += k4[0] * q0[0] + k4[1] * q0[1] + k4[2] * q0[2] + k4[3] * q0[3]; d1 += k4[0] * q1[0] + k4[1] * q1[1] + k4[2] * q1[2] + k4[3] * q1[3];
                d2 += k4[0] * q2[0] + k4[1] * q2[1] + k4[2] * q2[2] + k4[3] * q2[3]; d3 += k4[0] * q3[0] + k4[1] * q3[1] + k4[2] * q3[2] + k4[3] * q3[3]; }
            int dist = kf.dist(pc); dist = dist < 0 ? 0 : (dist > 128 ? 128 : dist);
            const float* bt = BT + hbase * 132 + dist;
            s[it][0] = ok ? d0 + bt[0] : NEGBIG; s[it][1] = ok ? d1 + bt[132] : NEGBIG; s[it][2] = ok ? d2 + bt[264] : NEGBIG; s[it][3] = ok ? d3 + bt[396] : NEGBIG;
#pragma unroll
            for (int r = 0; r < 4; ++r) mx[r] = fmaxf(mx[r], s[it][r]);
        } else {
#pragma unroll
            for (int r = 0; r < 4; ++r) s[it][r] = NEGBIG;
        }
    }
    float sum[4], inv[4];
#pragma unroll
    for (int r = 0; r < 4; ++r) { mx[r] = wave_max(mx[r]); sum[r] = 0.f; }
#pragma unroll
    for (int it = 0; it < NB; ++it)
#pragma unroll
        for (int r = 0; r < 4; ++r) { const float e = s[it][r] > -1.0e37f ? __expf(s[it][r] - mx[r]) : 0.f; s[it][r] = e; sum[r] += e; }
#pragma unroll
    for (int r = 0; r < 4; ++r) { sum[r] = wave_sum(sum[r]); inv[r] = sum[r] > 0.f ? 1.f / sum[r] : 0.f; }
#pragma unroll
    for (int it = 0; it < NB; ++it) {
        if (it < nblk) {
            f32x4 p4; p4[0] = s[it][0] * inv[0]; p4[1] = s[it][1] * inv[1]; p4[2] = s[it][2] * inv[2]; p4[3] = s[it][3] * inv[3];
            asm volatile("" ::: "memory");
            *(LAS f32x4*)(pb + 4 * lane) = p4;
            kf.emit(it, lane, p4);
            LDS_WAIT();
            const int nk = kf.nkeys(it);
            for (int kk = 0; kk < nk; ++kk) {
                const float v = kf.vrow(it, kk)[lane];
                const f32x4 w = *(const LAS f32x4*)(pb + 4 * kk);
                o[0] += w[0] * v; o[1] += w[1] * v; o[2] += w[2] * v; o[3] += w[3] * v;
            }
            LDS_WAIT();
        }
    }
}

struct SeqCtx { bool smp; int bs; int qpos; int l; int g; CArgs* A; };

struct KfCmp {
    const float* CK; const float* CV; int ncv, qpos; LAS float* ps;
    __device__ __forceinline__ int key(int it, int lane) const { return 64 * it + lane; }
    __device__ __forceinline__ bool ok(int n) const { return n < ncv; }
    __device__ __forceinline__ int clampk(int n) const { return n < ncv ? n : ncv - 1; }
    __device__ __forceinline__ const float* krow(int n) const { return CK + (size_t)n * 64; }
    __device__ __forceinline__ int dist(int n) const { return qpos - 16 * n - 31; }
    __device__ __forceinline__ void emit(int it, int lane, const f32x4& p) const { ps[64 * it + lane] = (p[0] + p[1]) + (p[2] + p[3]); }
    __device__ __forceinline__ int nkeys(int it) const { const int r = ncv - 64 * it; return r < 64 ? r : 64; }
    __device__ __forceinline__ const float* vrow(int it, int kk) const { return CV + (size_t)(64 * it + kk) * 64; }
};
struct KfSel {
    SeqCtx c; const float* kvr; int j[16];
    __device__ __forceinline__ const float* row(int p) const {
        if (!c.smp) return kvr + ((size_t)(c.bs * SEQ + p)) * 256 + c.g * 64;
        if (p >= PAST) return kvr + ((size_t)(MP + c.bs * DS + p - PAST)) * 256 + c.g * 64;
        return c.A->cache_slc + (((size_t)c.l * NPHYS + c.A->page_table[c.bs * NPG + (p >> 7)]) * PAGE + (p & 127)) * 256 + c.g * 64;
    }
    __device__ __forceinline__ int key(int it, int lane) const { return 64 * j[it] + lane; }
    __device__ __forceinline__ int nkeys(int it) const { const int r = c.qpos - 64 * j[it] + 1; return r < 64 ? (r > 0 ? r : 0) : 64; }
    __device__ __forceinline__ const float* vrow(int it, int kk) const { return row(64 * j[it] + kk) + 128; }
    __device__ __forceinline__ bool ok(int p) const { return p <= c.qpos; }
    __device__ __forceinline__ int clampk(int p) const { return p <= c.qpos ? p : c.qpos; }
    __device__ __forceinline__ const float* krow(int p) const { return row(p); }
    __device__ __forceinline__ int dist(int p) const { return c.qpos - p; }
    __device__ __forceinline__ void emit(int, int, const f32x4&) const {}
};
struct KfWin {
    SeqCtx c; const float* kvr; int lo;
    __device__ __forceinline__ const float* row(int p) const {
        if (!c.smp) return kvr + ((size_t)(c.bs * SEQ + p)) * 256 + c.g * 64;
        if (p >= PAST) return kvr + ((size_t)(MP + c.bs * DS + p - PAST)) * 256 + c.g * 64;
        return c.A->cache_win + (((size_t)c.l * DB + c.bs) * 512 + (p - (PAST - 512))) * 256 + c.g * 64;
    }
    __device__ __forceinline__ int key(int it, int lane) const { return c.qpos - 511 + 64 * it + lane; }
    __device__ __forceinline__ bool ok(int p) const { return p >= lo; }
    __device__ __forceinline__ int clampk(int p) const { return p >= lo ? p : lo; }
    __device__ __forceinline__ const float* krow(int p) const { return row(p); }
    __device__ __forceinline__ int dist(int p) const { return c.qpos - p; }
    __device__ __forceinline__ void emit(int, int, const f32x4&) const {}
    __device__ __forceinline__ int nkeys(int) const { return 64; }
    __device__ __forceinline__ const float* vrow(int it, int kk) const { const int p = c.qpos - 511 + 64 * it + kk; return row(p >= lo ? p : lo) + 128; }
};

__device__ __forceinline__ void topk_sel(float imp0, float imp1, int cur, int lane, unsigned long long& s0, unsigned long long& s1) {
    const int nforced = cur == 0 ? 1 : (cur == 1 ? 2 : 3), need = 16 - nforced, ncand = cur - 2 > 0 ? cur - 2 : 0;
    const unsigned k0 = (lane >= 1 && lane <= cur - 2) ? __builtin_bit_cast(unsigned, imp0) + 1u : 0u;
    const unsigned k1 = (lane + 64 <= cur - 2) ? __builtin_bit_cast(unsigned, imp1) + 1u : 0u;
    unsigned long long c0, c1;
    if (ncand <= need) { c0 = __ballot(k0 != 0u); c1 = __ballot(k1 != 0u); }
    else {
        unsigned T = 0u;
        for (int bit = 31; bit >= 0; --bit) { const unsigned cand = T | (1u << bit);
            const int cnt = __popcll(__ballot(k0 >= cand)) + __popcll(__ballot(k1 >= cand)); if (cnt >= need) T = cand; }
        const unsigned long long g0 = __ballot(k0 > T), g1 = __ballot(k1 > T); unsigned long long e0 = __ballot(k0 == T), e1 = __ballot(k1 == T);
        int rem = need - __popcll(g0) - __popcll(g1);
        unsigned long long t0 = 0ull, t1 = 0ull;
        while (rem > 0 && e0) { const unsigned long long lb = e0 & (~e0 + 1ull); t0 |= lb; e0 ^= lb; --rem; }
        while (rem > 0 && e1) { const unsigned long long lb = e1 & (~e1 + 1ull); t1 |= lb; e1 ^= lb; --rem; }
        c0 = g0 | t0; c1 = g1 | t1;
    }
    unsigned long long f0 = 1ull, f1 = 0ull;
    if (cur < 64) f0 |= 1ull << cur; else f1 |= 1ull << (cur - 64);
    if (cur >= 1) { if (cur - 1 < 64) f0 |= 1ull << (cur - 1); else f1 |= 1ull << (cur - 65); }
    s0 = c0 | f0; s1 = c1 | f1;
}

__device__ __forceinline__ void nsa_wave(CArgs& A, int l, int r, int g, LAS float* wl, int lane) {
    LAS float* qs = wl;
    LAS float* pb = wl + 256;
    LAS float* ps = wl + 512;
    const bool smp = r >= MP; const int bs = smp ? (r - MP) >> 2 : r >> 13; const int qpos = smp ? PAST + ((r - MP) & 3) : (r & (SEQ - 1));
    const float* BT = (const float*)(A.ws + WS_BT);
    const float* KVR = (const float*)(A.ws + WS_KVR);
    {   const bf16* qp = (const bf16*)(A.ws + WS_NQ) + (size_t)r * 512 + g * 256;
#pragma unroll
        for (int i = 0; i < 4; ++i) qs[64 * i + lane] = bf2f(qp[64 * i + lane]); }
    for (int i = lane; i < 520; i += 64) ps[i] = 0.f;
    LDS_WAIT();
    SeqCtx cx{smp, bs, qpos, l, g, &A};
    float out[4] = {0.f, 0.f, 0.f, 0.f};
    const float* gt = (const float*)(A.ws + WS_GATE) + (size_t)r * 32 + 8 + g * 12;
    {
        const int ncv = qpos >= 31 ? ((qpos - 31) >> 4) + 1 : 0;
        const int gc0 = smp ? 1024 + bs * 128 : bs * 512;
        if (ncv > 0) {
            KfCmp kf{(const float*)(A.ws + WS_CKV) + ((size_t)((l * 2 + 0) * 2 + g) * NCB + gc0) * 64, (const float*)(A.ws + WS_CKV) + ((size_t)((l * 2 + 1) * 2 + g) * NCB + gc0) * 64, ncv, qpos, ps};
            float o[4] = {0.f, 0.f, 0.f, 0.f};
            attend<8, KfCmp>(kf, (ncv + 63) >> 6, qs, pb, BT, g * 4, lane, o);
#pragma unroll
            for (int rr = 0; rr < 4; ++rr) out[rr] += sigmoidf_(gt[rr * 3 + 0]) * o[rr];
        }
    }
    LDS_WAIT();
    unsigned long long s0, s1;
    {
        float imp0 = 0.f, imp1 = 0.f;
#pragma unroll
        for (int i = -1; i < 4; ++i) { const int n0 = 4 * lane + i, n1 = 4 * (lane + 64) + i; if (n0 >= 0) imp0 += ps[n0]; imp1 += ps[n1]; }
        topk_sel(imp0, imp1, qpos >> 6, lane, s0, s1);
    }
    {
        KfSel kf; kf.c = cx; kf.kvr = KVR + (size_t)1 * M * 256;
        int nb = 0; unsigned long long m0 = s0, m1 = s1;
#pragma unroll
        for (int it = 0; it < 16; ++it) {
            if (m0) { kf.j[it] = __builtin_ctzll(m0); m0 &= m0 - 1ull; ++nb; }
            else if (m1) { kf.j[it] = 64 + __builtin_ctzll(m1); m1 &= m1 - 1ull; ++nb; }
            else kf.j[it] = 0;
        }
        float o[4] = {0.f, 0.f, 0.f, 0.f};
        attend<16, KfSel>(kf, nb, qs, pb, BT, g * 4, lane, o);
#pragma unroll
        for (int rr = 0; rr < 4; ++rr) out[rr] += sigmoidf_(gt[rr * 3 + 1]) * o[rr];
    }
    {
        KfWin kf{cx, KVR + (size_t)2 * M * 256, smp ? PAST - 512 : 0};
        float o[4] = {0.f, 0.f, 0.f, 0.f};
        attend<8, KfWin>(kf, 8, qs, pb, BT, g * 4, lane, o);
#pragma unroll
        for (int rr = 0; rr < 4; ++rr) out[rr] += sigmoidf_(gt[rr * 3 + 2]) * o[rr];
    }
    bf16* mp = (bf16*)(A.ws + WS_MIX) + (size_t)r * D + 512 + g * 256 + lane;
#pragma unroll
    for (int rr = 0; rr < 4; ++rr) mp[rr * 64] = (bf16)f2bf(out[rr]);
}

typedef short bf16x8 __attribute__((ext_vector_type(8)));
#define MFMA16(a, b, c) __builtin_amdgcn_mfma_f32_16x16x32_bf16((a), (b), (c), 0, 0, 0)
constexpr int TOTS = MP + DB * 2112, TOTW = MP + DB * 528, TOTWP = TOTW + 64;
constexpr size_t KS_L = (size_t)2 * TOTS * 64, KW_L = (size_t)2 * TOTWP * 64, KC_L = (size_t)2 * NCB * 64;

__device__ __forceinline__ void kv_tile64(const float* src, bf16* Kimg, size_t kgs, bf16* Vt, size_t vgs, size_t vpitch, size_t gp0, LAS bf16* scr, int lane) {
    const int cc = 4 * lane, s = cc >> 7, g = (cc >> 6) & 1, d = cc & 63;
#pragma unroll 8
    for (int sl = 0; sl < 64; ++sl) {
        const f32x4 v = *(const f32x4*)(src + (size_t)sl * 256 + cc);
        v2u w; w.x = pk2(v[0], v[1]); w.y = pk2(v[2], v[3]);
        if (s == 0) *(v2u*)(Kimg + (size_t)g * kgs + (gp0 + sl) * 64 + d) = w;
        else *(LAS v2u*)(scr + sl * 128 + (cc - 128)) = w;
    }
    LDS_WAIT();
#pragma unroll
    for (int g2 = 0; g2 < 2; ++g2) {
        const int gd = lane + 64 * g2;
        bf16* dst = Vt + (size_t)g2 * vgs + (size_t)lane * vpitch + gp0;
#pragma unroll
        for (int oc = 0; oc < 8; ++oc) {
            const LAS bf16* p = scr + (8 * oc) * 128 + gd;
            v4u o; o.x = (unsigned)p[0] | ((unsigned)p[128] << 16); o.y = (unsigned)p[256] | ((unsigned)p[384] << 16); o.z = (unsigned)p[512] | ((unsigned)p[640] << 16); o.w = (unsigned)p[768] | ((unsigned)p[896] << 16);
            *(v4u*)(dst + 8 * oc) = o;
        }
    }
    LDS_WAIT();
}

__device__ __forceinline__ void prep_cache_images(CArgs& A, LAS unsigned char* lds, int gw, int NGW, int lane, int wave) {
    LAS bf16* scr = (LAS bf16*)(lds + wave * 16384);
    bf16* KS = (bf16*)(A.ws + WS_KS); bf16* VTS = (bf16*)(A.ws + WS_VTS); bf16* KW = (bf16*)(A.ws + WS_KW); bf16* VTW = (bf16*)(A.ws + WS_VTW);
    for (int it = gw; it < DEPTH * DB * 32; it += NGW) {
        const int ti = it & 31, seq = (it >> 5) & 127, l = it >> 12;
        const int phys = A.page_table[seq * NPG + (ti >> 1)];
        const float* src = A.cache_slc + (((size_t)l * NPHYS + phys) * PAGE + (ti & 1) * 64) * 256;
        kv_tile64(src, KS + l * KS_L, (size_t)TOTS * 64, VTS + l * KS_L, (size_t)64 * TOTS, TOTS, (size_t)MP + seq * 2112 + ti * 64, scr, lane);
    }
    for (int it = gw; it < DEPTH * DB * 8; it += NGW) {
        const int ti = it & 7, ls = it >> 3, seq = ls & 127, l = ls >> 7;
        const float* src = A.cache_win + ((size_t)ls * 512 + ti * 64) * 256;
        kv_tile64(src, KW + l * KW_L, (size_t)TOTWP * 64, VTW + l * KW_L, (size_t)64 * TOTWP, TOTWP, (size_t)MP + seq * 528 + ti * 64, scr, lane);
    }
}
__device__ __forceinline__ void prep_layer_images(CArgs& A, int l, LAS unsigned char* lds, int gw, int NGW, int lane, int wave) {
    LAS bf16* scr = (LAS bf16*)(lds + wave * 16384);
    bf16* KS = (bf16*)(A.ws + WS_KS) + l * KS_L; bf16* VTS = (bf16*)(A.ws + WS_VTS) + l * KS_L; bf16* KW = (bf16*)(A.ws + WS_KW) + l * KW_L; bf16* VTW = (bf16*)(A.ws + WS_VTW) + l * KW_L;
    const float* KVR = (const float*)(A.ws + WS_KVR);
    for (int it = gw; it < 2 * (MP / 64); it += NGW) {
        const int kind = it / (MP / 64), ti = it % (MP / 64);
        const float* src = KVR + ((size_t)(1 + kind) * M + ti * 64) * 256;
        if (kind == 0) kv_tile64(src, KS, (size_t)TOTS * 64, VTS, (size_t)64 * TOTS, TOTS, (size_t)ti * 64, scr, lane);
        else           kv_tile64(src, KW, (size_t)TOTWP * 64, VTW, (size_t)64 * TOTWP, TOTWP, (size_t)ti * 64, scr, lane);
    }
    for (int it = gw; it < 2 * DB; it += NGW) {
        const int kind = it / DB, seq = it % DB;
        const float* src = KVR + ((size_t)(1 + kind) * M + MP + seq * DS) * 256;
        bf16* Kimg = kind == 0 ? KS : KW; bf16* Vt = kind == 0 ? VTS : VTW;
        const size_t tot = kind == 0 ? TOTS : TOTWP, gp0 = kind == 0 ? (size_t)MP + seq * 2112 + PAST : (size_t)MP + seq * 528 + 512;
        const int cc = 4 * lane, s = cc >> 7, g = (cc >> 6) & 1, d = cc & 63;
#pragma unroll
        for (int t = 0; t < DS; ++t) {
            const f32x4 v = *(const f32x4*)(src + (size_t)t * 256 + cc);
            if (s == 0) { v2u w; w.x = pk2(v[0], v[1]); w.y = pk2(v[2], v[3]); *(v2u*)(Kimg + (size_t)g * tot * 64 + (gp0 + t) * 64 + d) = w; }
            else {
#pragma unroll
                for (int i = 0; i < 4; ++i) Vt[(size_t)g * 64 * tot + (size_t)(d + i) * tot + gp0 + t] = (bf16)f2bf(v[i]);
            }
        }
    }
}

__device__ __forceinline__ void qk_block(const bf16* Kb, const bf16x8 (&q)[2], int fr, int fq, f32x4 (&st)[4]) {
#pragma unroll
    for (int t = 0; t < 4; ++t) {
        const bf16x8 k0 = *(const bf16x8*)(Kb + (size_t)(16 * t + fr) * 64 + 8 * fq), k1 = *(const bf16x8*)(Kb + (size_t)(16 * t + fr) * 64 + 32 + 8 * fq);
        f32x4 z = {0.f, 0.f, 0.f, 0.f};
        z = MFMA16(k0, q[0], z); st[t] = MFMA16(k1, q[1], z);
    }
}
__device__ __forceinline__ void pv_block(const bf16* Vb, size_t pitch, int fr, int fq, const f32x4 (&st)[4], f32x4 (&o)[4]) {
#pragma unroll
    for (int h = 0; h < 2; ++h) {
        v4u pw; pw.x = pk2(st[2 * h][0], st[2 * h][1]); pw.y = pk2(st[2 * h][2], st[2 * h][3]); pw.z = pk2(st[2 * h + 1][0], st[2 * h + 1][1]); pw.w = pk2(st[2 * h + 1][2], st[2 * h + 1][3]);
        const bf16x8 pf = __builtin_bit_cast(bf16x8, pw);
#pragma unroll
        for (int dt = 0; dt < 4; ++dt) {
            const bf16* vp = Vb + (size_t)(16 * dt + fr) * pitch + 32 * h + 4 * fq;
            const v2u a = *(const v2u*)vp, b = *(const v2u*)(vp + 16);
            v4u vw; vw.x = a.x; vw.y = a.y; vw.z = b.x; vw.w = b.y;
            o[dt] = MFMA16(__builtin_bit_cast(bf16x8, vw), pf, o[dt]);
        }
    }
}
__device__ __forceinline__ float xfq_max(float v) { v = fmaxf(v, __shfl_xor(v, 16)); return fmaxf(v, __shfl_xor(v, 32)); }
__device__ __forceinline__ float xfq_sum(float v) { v += __shfl_xor(v, 16); return v + __shfl_xor(v, 32); }
__device__ __forceinline__ float quad_sum(float v) { v += __shfl_xor(v, 1); return v + __shfl_xor(v, 2); }

__device__ __forceinline__ void softmax_pv(const bf16* Vb, size_t pitch, int fr, int fq, f32x4 (&st)[4], f32x4 (&o)[4], float& m, float& ls) {
    float bm = -INFINITY;
#pragma unroll
    for (int t = 0; t < 4; ++t) bm = fmaxf(bm, fmaxf(fmaxf(st[t][0], st[t][1]), fmaxf(st[t][2], st[t][3])));
    bm = xfq_max(bm);
    const float mn = fmaxf(m, bm), sc = __expf(m - mn);
    m = mn; ls *= sc;
#pragma unroll
    for (int dt = 0; dt < 4; ++dt) o[dt] = o[dt] * sc;
#pragma unroll
    for (int t = 0; t < 4; ++t)
#pragma unroll
        for (int i = 0; i < 4; ++i) { const float p = __expf(st[t][i] - mn); st[t][i] = p; ls += p; }
    pv_block(Vb, pitch, fr, fq, st, o);
}

__device__ __forceinline__ void nsa_tile(CArgs& A, int l, int task, LAS float* wl, const LAS float* BT, int lane) {
    const int fr = lane & 15, fq = lane >> 4, tl = fr >> 2, rr = fr & 3;
    bool smp; int bs, g, qpos0, row0;
    if (task < 4 * 2048) { const int c = task >> 11, tq0 = task & 2047, tq = (c & 1) ? 2047 - tq0 : tq0; smp = false; bs = c >> 1; g = c & 1; qpos0 = 4 * tq; row0 = bs * SEQ + qpos0; }
    else { const int t2 = task - 4 * 2048; smp = true; bs = t2 >> 1; g = t2 & 1; qpos0 = PAST; row0 = MP + bs * DS; }
    const int qpos = qpos0 + tl, cur = qpos0 >> 6, h = g * 4 + rr;
    const size_t sbase = smp ? (size_t)MP + bs * 2112 : (size_t)bs * SEQ;
    const long wbase = smp ? (long)MP + bs * 528 - (PAST - 512) : (long)bs * SEQ;
    const size_t cbase = smp ? (size_t)1024 + bs * 128 : (size_t)bs * 512;
    const bf16* KS = (const bf16*)(A.ws + WS_KS) + l * KS_L + (size_t)g * TOTS * 64; const bf16* VTS = (const bf16*)(A.ws + WS_VTS) + l * KS_L + (size_t)g * 64 * TOTS;
    const bf16* KW = (const bf16*)(A.ws + WS_KW) + l * KW_L + (size_t)g * TOTWP * 64; const bf16* VTW = (const bf16*)(A.ws + WS_VTW) + l * KW_L + (size_t)g * 64 * TOTWP;
    const bf16* KC = (const bf16*)(A.ws + WS_KC) + l * KC_L + (size_t)g * NCB * 64; const bf16* VCT = (const bf16*)(A.ws + WS_VCT) + l * KC_L + (size_t)g * 64 * NCB;
    const LAS float* bt = BT + h * 132;
    const float farb = bt[128];
    bf16x8 q[2];
    {   const bf16* qp = (const bf16*)(A.ws + WS_NQ) + (size_t)(row0 + tl) * 512 + g * 256 + rr * 64 + 8 * fq;
        q[0] = *(const bf16x8*)qp; q[1] = *(const bf16x8*)(qp + 32); }
    const float* gt = (const float*)(A.ws + WS_GATE) + (size_t)(row0 + tl) * 32 + 8 + h * 3;
    const float gc = sigmoidf_(gt[0]), gs = sigmoidf_(gt[1]), gwn = sigmoidf_(gt[2]);
    f32x4 out[4];
#pragma unroll
    for (int dt = 0; dt < 4; ++dt) out[dt] = (f32x4){0.f, 0.f, 0.f, 0.f};
    LAS float* impA = wl;
    LAS float* impB = wl + 544;
    for (int i = lane; i < 1088; i += 64) wl[i] = 0.f;
    LDS_WAIT();

    {
        const int ncv_max = qpos0 + 3 >= 31 ? ((qpos0 + 3 - 31) >> 4) + 1 : 0, nb64 = (ncv_max + 63) >> 6;
        float m = -1.0e30f, ls = 0.f;
        for (int ib = 0; ib < nb64; ++ib) {
            f32x4 st[4]; qk_block(KC + (cbase + 64 * ib) * 64, q, fr, fq, st);
            float bm = -INFINITY;
#pragma unroll
            for (int t = 0; t < 4; ++t)
#pragma unroll
                for (int i = 0; i < 4; ++i) { const int n = 64 * ib + 16 * t + 4 * fq + i; const int dist = qpos - 16 * n - 31;
                    const float s = dist >= 0 ? st[t][i] + bt[dist > 128 ? 128 : dist] : -INFINITY; st[t][i] = s; bm = fmaxf(bm, s); }
            bm = xfq_max(bm);
            const float mn = fmaxf(m, bm); ls *= __expf(m - mn); m = mn;
#pragma unroll
            for (int t = 0; t < 4; ++t)
#pragma unroll
                for (int i = 0; i < 4; ++i) ls += __expf(st[t][i] - mn);
        }
        ls = xfq_sum(ls);
        const float inv = ls > 0.f ? 1.f / ls : 0.f;
        f32x4 o[4];
#pragma unroll
        for (int dt = 0; dt < 4; ++dt) o[dt] = (f32x4){0.f, 0.f, 0.f, 0.f};
        for (int ib = 0; ib < nb64; ++ib) {
            f32x4 st[4]; qk_block(KC + (cbase + 64 * ib) * 64, q, fr, fq, st);
#pragma unroll
            for (int t = 0; t < 4; ++t) {
#pragma unroll
                for (int i = 0; i < 4; ++i) { const int n = 64 * ib + 16 * t + 4 * fq + i; const int dist = qpos - 16 * n - 31;
                    st[t][i] = dist >= 0 ? __expf(st[t][i] + bt[dist > 128 ? 128 : dist] - m) * inv : 0.f; }
                const float s4 = quad_sum((st[t][0] + st[t][1]) + (st[t][2] + st[t][3])), s3 = quad_sum(st[t][3]);
                const int j0 = 16 * ib + 4 * t + fq;
                if (rr == 0) { impA[tl * 136 + j0] = s4; impB[tl * 136 + j0 + 1] = s3; }
            }
            pv_block(VCT + cbase + 64 * ib, NCB, fr, fq, st, o);
        }
#pragma unroll
        for (int dt = 0; dt < 4; ++dt) out[dt] = out[dt] + o[dt] * gc;
    }
    LDS_WAIT();
    unsigned long long s0[4], s1[4];
#pragma unroll
    for (int t = 0; t < 4; ++t) topk_sel(impA[t * 136 + lane] + impB[t * 136 + lane], impA[t * 136 + 64 + lane] + impB[t * 136 + 64 + lane], cur, lane, s0[t], s1[t]);
    const unsigned long long my0 = tl == 0 ? s0[0] : (tl == 1 ? s0[1] : (tl == 2 ? s0[2] : s0[3])), my1 = tl == 0 ? s1[0] : (tl == 1 ? s1[1] : (tl == 2 ? s1[2] : s1[3]));
    {
        float m = -1.0e30f, ls = 0.f; f32x4 o[4];
#pragma unroll
        for (int dt = 0; dt < 4; ++dt) o[dt] = (f32x4){0.f, 0.f, 0.f, 0.f};
        unsigned long long u0 = (s0[0] | s0[1]) | (s0[2] | s0[3]), u1 = (s1[0] | s1[1]) | (s1[2] | s1[3]);
        while (u0 | u1) {
            int j; if (u0) { j = __builtin_ctzll(u0); u0 &= u0 - 1ull; } else { j = 64 + __builtin_ctzll(u1); u1 &= u1 - 1ull; }
            const bool mine = j < 64 ? ((my0 >> j) & 1ull) != 0ull : ((my1 >> (j - 64)) & 1ull) != 0ull;
            f32x4 st[4]; qk_block(KS + (sbase + 64 * j) * 64, q, fr, fq, st);
            if (j >= cur - 2) {
#pragma unroll
                for (int t = 0; t < 4; ++t)
#pragma unroll
                    for (int i = 0; i < 4; ++i) { const int dist = qpos - (64 * j + 16 * t + 4 * fq + i);
                        st[t][i] = (mine && dist >= 0) ? st[t][i] + bt[dist > 128 ? 128 : dist] : -INFINITY; }
            } else {
#pragma unroll
                for (int t = 0; t < 4; ++t)
#pragma unroll
                    for (int i = 0; i < 4; ++i) st[t][i] = mine ? st[t][i] + farb : -INFINITY;
            }
            softmax_pv(VTS + sbase + 64 * j, TOTS, fr, fq, st, o, m, ls);
        }
        ls = xfq_sum(ls);
        const float w = ls > 0.f ? gs / ls : 0.f;
#pragma unroll
        for (int dt = 0; dt < 4; ++dt) out[dt] = out[dt] + o[dt] * w;
    }
    {
        float m = -1.0e30f, ls = 0.f; f32x4 o[4];
#pragma unroll
        for (int dt = 0; dt < 4; ++dt) o[dt] = (f32x4){0.f, 0.f, 0.f, 0.f};
        const int lo_blk = smp ? (PAST - 512) >> 6 : 0; int jb = (qpos0 - 511) >> 6; if (jb < lo_blk) jb = lo_blk;
        for (; jb <= cur; ++jb) {
            f32x4 st[4]; qk_block(KW + (size_t)(wbase + 64 * jb) * 64, q, fr, fq, st);
#pragma unroll
            for (int t = 0; t < 4; ++t)
#pragma unroll
                for (int i = 0; i < 4; ++i) { const int dist = qpos - (64 * jb + 16 * t + 4 * fq + i);
                    st[t][i] = (dist >= 0 && dist < 512) ? st[t][i] + bt[dist > 128 ? 128 : dist] : -INFINITY; }
            softmax_pv(VTW + (size_t)(wbase + 64 * jb), TOTWP, fr, fq, st, o, m, ls);
        }
        ls = xfq_sum(ls);
        const float w = ls > 0.f ? gwn / ls : 0.f;
#pragma unroll
        for (int dt = 0; dt < 4; ++dt) out[dt] = out[dt] + o[dt] * w;
    }
    bf16* mp = (bf16*)(A.ws + WS_MIX) + (size_t)(row0 + tl) * D + 512 + h * 64 + 4 * fq;
#pragma unroll
    for (int dt = 0; dt < 4; ++dt) { v2u w; w.x = pk2(out[dt][0], out[dt][1]); w.y = pk2(out[dt][2], out[dt][3]); *(v2u*)(mp + 16 * dt) = w; }
}

__device__ __forceinline__ void phase_m2x(CArgs& A, int l, LAS unsigned char* lds, int tid) {
    LAS float* buf = (LAS float*)lds;
    LAS float* wl = (LAS float*)(lds + 1024);
    LAS float* red = (LAS float*)(lds + 2048);
    LAS bf16* kt = (LAS bf16*)(lds + 8192);
    LAS bf16* vt = (LAS bf16*)(lds + 8192 + 34816);
    const bf16* QKVO = (const bf16*)(A.ws + WS_QKVO);
    const int lane = tid & 63, wave = tid >> 6, fr = lane & 15, fq = lane >> 4;
    for (int unit = blockIdx.x; unit < NUNIT; unit += gridDim.x) {
        const int b = unit >> 7, h = (unit >> 5) & 3, c = unit & 31, r0 = b * SEQ + c * LCH;
        float ig = 0.f, lf = 0.f;
        if (tid < 256) ml_gates(A, l, r0 + tid, h, ig, lf);
        const float F = scan_sum256(lf, buf, tid);
        __syncthreads();
        if (tid == 255) buf[16] = F;
        __syncthreads();
        const float Fend = buf[16];
        const float gl = tid < 256 ? Fend - F + ig : -3.0e38f;
        const float mw = wave_max(gl);
        if (lane == 0) buf[20 + wave] = mw;
        __syncthreads();
        const float mloc = fmaxf(fmaxf(buf[20], buf[21]), fmaxf(buf[22], buf[23]));
        if (tid < 256) wl[tid] = __expf(gl - mloc);
        if (tid == 0) { float* ch = (float*)(A.ws + WS_CHS) + unit * 4; ch[0] = Fend; ch[1] = mloc; }
        f32x4 acc[8];
#pragma unroll
        for (int kt_ = 0; kt_ < 8; ++kt_) acc[kt_] = (f32x4){0.f, 0.f, 0.f, 0.f};
        float dnp = 0.f;
        for (int half = 0; half < 2; ++half) {
            __syncthreads();
            for (int i = tid; i < 4096; i += NTHR) { const int which = i >> 11, oc = (i >> 7) & 15, s = i & 127;
                const v4u x = *(const v4u*)(QKVO + (size_t)(r0 + 128 * half + s) * 2048 + (which ? 1024 : 512) + h * HD + 8 * oc);
                LAS bf16* dst = (which ? vt : kt) + (8 * oc) * 136 + s;
                dst[0] = (bf16)x.x; dst[136] = (bf16)(x.x >> 16); dst[272] = (bf16)x.y; dst[408] = (bf16)(x.y >> 16); dst[544] = (bf16)x.z; dst[680] = (bf16)(x.z >> 16); dst[816] = (bf16)x.w; dst[952] = (bf16)(x.w >> 16); }
            __syncthreads();
#pragma unroll
            for (int ks = 0; ks < 4; ++ks) {
                const int s0 = 32 * ks + 8 * fq;
                const v4u xv = *(const LAS v4u*)(vt + (16 * wave + fr) * 136 + s0);
                const f32x4 w0 = *(const LAS f32x4*)(wl + 128 * half + s0), w1 = *(const LAS f32x4*)(wl + 128 * half + s0 + 4);
                v4u av; av.x = pk2(bflo(xv.x) * w0[0], bfhi(xv.x) * w0[1]); av.y = pk2(bflo(xv.y) * w0[2], bfhi(xv.y) * w0[3]); av.z = pk2(bflo(xv.z) * w1[0], bfhi(xv.z) * w1[1]); av.w = pk2(bflo(xv.w) * w1[2], bfhi(xv.w) * w1[3]);
                const bf16x8 af = __builtin_bit_cast(bf16x8, av);
#pragma unroll
                for (int kt_ = 0; kt_ < 8; ++kt_) { const bf16x8 bfr = *(const LAS bf16x8*)(kt + (16 * kt_ + fr) * 136 + s0); acc[kt_] = MFMA16(af, bfr, acc[kt_]); }
            }
            {   const int k = tid & 127, q = tid >> 7;
#pragma unroll
                for (int e = 0; e < 4; ++e) { const v4u x = *(const LAS v4u*)(kt + k * 136 + 32 * q + 8 * e); const LAS float* w = wl + 128 * half + 32 * q + 8 * e;
                    dnp += bflo(x.x) * w[0] + bfhi(x.x) * w[1] + bflo(x.y) * w[2] + bfhi(x.y) * w[3] + bflo(x.z) * w[4] + bfhi(x.z) * w[5] + bflo(x.w) * w[6] + bfhi(x.w) * w[7]; } }
        }
        float* dct = (float*)(A.ws + WS_DCT) + ((size_t)unit * HD + 16 * wave + 4 * fq) * HD + fr;
#pragma unroll
        for (int kt_ = 0; kt_ < 8; ++kt_)
#pragma unroll
            for (int i = 0; i < 4; ++i) dct[(size_t)i * HD + 16 * kt_] = acc[kt_][i];
        red[(tid >> 7) * 128 + (tid & 127)] = dnp;
        __syncthreads();
        if (tid < HD) ((float*)(A.ws + WS_DN))[unit * HD + tid] = (red[tid] + red[128 + tid]) + (red[256 + tid] + red[384 + tid]);
        __syncthreads();
    }
}

__device__ __forceinline__ void phase_m4x(CArgs& A, int l, LAS unsigned char* lds, int tid) {
    LAS float* buf = (LAS float*)lds;
    LAS float* sa = (LAS float*)(lds + 1024);
    LAS float* smx = sa + 256;
    LAS float* sdec = smx + 256;
    LAS float* sem = sdec + 256;
    LAS bf16* vt = (LAS bf16*)(lds + 8192);
    const bf16* QKVO = (const bf16*)(A.ws + WS_QKVO);
    const int lane = tid & 63, wave = tid >> 6, fr = lane & 15, fq = lane >> 4;
    for (int unit = blockIdx.x; unit < NUNIT; unit += gridDim.x) {
        const int b = unit >> 7, h = (unit >> 5) & 3, c = unit & 31, r0 = b * SEQ + c * LCH;
        float ig = 0.f, lf = 0.f;
        if (tid < 256) ml_gates(A, l, r0 + tid, h, ig, lf);
        const float F = scan_sum256(lf, buf, tid);
        const float a = tid < 256 ? ig - F : -3.0e38f;
        const float cm = scan_max256(a, buf, tid);
        const float m0 = ((const float*)(A.ws + WS_CHS))[unit * 4 + 2];
        if (tid < 256) { const float mx = fmaxf(m0, cm); sa[tid] = a; smx[tid] = mx; sdec[tid] = __expf(m0 - mx); sem[tid] = __expf(-(F + mx)); }
        for (int i = tid; i < 4096; i += NTHR) { const int oc = i >> 8, s = i & 255;
            const v4u x = *(const v4u*)(QKVO + (size_t)(r0 + s) * 2048 + 1024 + h * HD + 8 * oc);
            LAS bf16* dst = vt + (8 * oc) * 264 + s;
            dst[0] = (bf16)x.x; dst[264] = (bf16)(x.x >> 16); dst[528] = (bf16)x.y; dst[792] = (bf16)(x.y >> 16); dst[1056] = (bf16)x.z; dst[1320] = (bf16)(x.z >> 16); dst[1584] = (bf16)x.w; dst[1848] = (bf16)(x.w >> 16); }
        __syncthreads();
        const bf16* ctp = (const bf16*)(A.ws + WS_CTP) + (size_t)unit * HD * HD;
        const float* npv = (const float*)(A.ws + WS_NPV) + unit * HD;
        for (int pass = 0; pass < 2; ++pass) {
            const int sub = pass == 0 ? wave : 15 - wave, t0 = 16 * sub, t = t0 + fr;
            const float mxt = smx[t], dect = sdec[t], emt = sem[t];
            bf16x8 qf[4];
#pragma unroll
            for (int kk = 0; kk < 4; ++kk) qf[kk] = *(const bf16x8*)(QKVO + (size_t)(r0 + t) * 2048 + h * HD + 32 * kk + 8 * fq);
            f32x4 ah[8], ac[8];
#pragma unroll
            for (int v = 0; v < 8; ++v) { ah[v] = (f32x4){0.f, 0.f, 0.f, 0.f}; ac[v] = (f32x4){0.f, 0.f, 0.f, 0.f}; }
            float den = 0.f;
            const int nblk = (t0 + 47) >> 5;
            for (int ib = 0; ib < nblk; ++ib) {
                const int s0 = 32 * ib;
                f32x4 st[2];
#pragma unroll
                for (int j = 0; j < 2; ++j) {
                    f32x4 z = {0.f, 0.f, 0.f, 0.f};
                    const bf16* kp = QKVO + (size_t)(r0 + s0 + 16 * j + fr) * 2048 + 512 + h * HD + 8 * fq;
#pragma unroll
                    for (int kk = 0; kk < 4; ++kk) z = MFMA16(*(const bf16x8*)(kp + 32 * kk), qf[kk], z);
                    const f32x4 a4 = *(const LAS f32x4*)(sa + s0 + 16 * j + 4 * fq);
#pragma unroll
                    for (int i = 0; i < 4; ++i) { const float w = (s0 + 16 * j + 4 * fq + i <= t) ? z[i] * __expf(a4[i] - mxt) : 0.f; z[i] = w; den += w; }
                    st[j] = z;
                }
                v4u pw; pw.x = pk2(st[0][0], st[0][1]); pw.y = pk2(st[0][2], st[0][3]); pw.z = pk2(st[1][0], st[1][1]); pw.w = pk2(st[1][2], st[1][3]);
                const bf16x8 pf = __builtin_bit_cast(bf16x8, pw);
#pragma unroll
                for (int v = 0; v < 8; ++v) { const LAS bf16* vp = vt + (16 * v + fr) * 264 + s0 + 4 * fq;
                    const v2u x = *(const LAS v2u*)vp, y = *(const LAS v2u*)(vp + 16);
                    v4u vw; vw.x = x.x; vw.y = x.y; vw.z = y.x; vw.w = y.y;
                    ah[v] = MFMA16(__builtin_bit_cast(bf16x8, vw), pf, ah[v]); }
            }
            float qn = 0.f;
#pragma unroll
            for (int kk = 0; kk < 4; ++kk) {
                const v4u qx = __builtin_bit_cast(v4u, qf[kk]); const f32x4 n0 = *(const f32x4*)(npv + 32 * kk + 8 * fq), n1 = *(const f32x4*)(npv + 32 * kk + 8 * fq + 4);
                qn += bflo(qx.x) * n0[0] + bfhi(qx.x) * n0[1] + bflo(qx.y) * n0[2] + bfhi(qx.y) * n0[3] + bflo(qx.z) * n1[0] + bfhi(qx.z) * n1[1] + bflo(qx.w) * n1[2] + bfhi(qx.w) * n1[3];
#pragma unroll
                for (int v = 0; v < 8; ++v) ac[v] = MFMA16(*(const bf16x8*)(ctp + (size_t)(16 * v + fr) * HD + 32 * kk + 8 * fq), qf[kk], ac[v]);
            }
            const float dent = xfq_sum(den) + dect * xfq_sum(qn);
            const float rden = 1.f / fmaxf(fabsf(dent), emt);
            float s1 = 0.f;
#pragma unroll
            for (int v = 0; v < 8; ++v) { ah[v] = (ah[v] + ac[v] * dect) * rden; s1 += (ah[v][0] + ah[v][1]) + (ah[v][2] + ah[v][3]); }
            const float mu = xfq_sum(s1) * (1.f / HD);
            float s2 = 0.f;
#pragma unroll
            for (int v = 0; v < 8; ++v) { ah[v] = ah[v] - mu; s2 += (ah[v][0] * ah[v][0] + ah[v][1] * ah[v][1]) + (ah[v][2] * ah[v][2] + ah[v][3] * ah[v][3]); }
            const float rstd = 1.f / sqrtf(xfq_sum(s2) * (1.f / HD) + LN_EPS);
            const bf16* op = QKVO + (size_t)(r0 + t) * 2048 + 1536 + h * HD + 4 * fq;
            bf16* mp = (bf16*)(A.ws + WS_MIX) + (size_t)(r0 + t) * D + h * HD + 4 * fq;
            const float* gp = A.ml_norm_g + l * 512 + h * HD + 4 * fq;
#pragma unroll
            for (int v = 0; v < 8; ++v) { const v2u og = *(const v2u*)(op + 16 * v); const f32x4 gn = *(const f32x4*)(gp + 16 * v);
                v2u w; w.x = pk2(ah[v][0] * rstd * gn[0] * sigmoidf_(bflo(og.x)), ah[v][1] * rstd * gn[1] * sigmoidf_(bfhi(og.x)));
                w.y = pk2(ah[v][2] * rstd * gn[2] * sigmoidf_(bflo(og.y)), ah[v][3] * rstd * gn[3] * sigmoidf_(bfhi(og.y)));
                *(v2u*)(mp + 16 * v) = w; }
        }
        __syncthreads();
    }
}

constexpr int PH_PER_LAYER = 9, PH_L0 = 3, N_PHASES = PH_L0 + DEPTH * PH_PER_LAYER;
#ifndef REP_MASK
#define REP_MASK 0
#endif
#define REPS(b) for (int rep_ = 0; rep_ < (((REP_MASK) >> (b)) & 1) + 1; ++rep_)
#ifndef MK_PER_PHASE
#define MK_PER_PHASE 0
#endif

__device__ __forceinline__ CArgs* kargs() { unsigned long long p = (unsigned long long)__builtin_amdgcn_kernarg_segment_ptr(); asm volatile("" : "+s"(p)); return (CArgs*)p; }
#define A (*kargs())
#define IN(k) (lo <= (k) && (k) < hi)
#define SEAM(k) do { if (IN(k) && IN((k) + 1)) xcd_barrier(bar); } while (0)
template <int l>
__device__ __forceinline__ void layer_phases(LAS unsigned char* lds, const XcdBarrier& bar, int tid, int lane, int wave, int G, int gw, int NGW, int lo, int hi) {
    unsigned char* ws = A.ws;
    float* const ADA = (float*)(ws + WS_ADA);
    float* const X = (float*)(ws + WS_X);
    float* const Z = (float*)(ws + WS_Z);
    bf16* const U = (bf16*)(ws + WS_U);
        const int pb_ = PH_L0 + l * PH_PER_LAYER;
        const float* adal = ADA + (size_t)l * NCOND * 6144;
        const float* xa = l == 0 ? A.x_prompt : X; const float* xb = l == 0 ? A.x_sample : X + (size_t)MP * D;
        if (IN(pb_ + 0)) {
            {
                pg8::Gemm g{U, (const bf16*)(ws + WS_WIN) + (size_t)l * NINP * D, D, D, D};
                pg8::StaticOrder S; S.init(M, NINP, G, (int)blockIdx.x);
                EpiInProj E{(bf16*)(ws + WS_QKVO), (bf16*)(ws + WS_NQ), (float*)(ws + WS_GATE), (float*)(ws + WS_KVR), (bf16*)(ws + WS_XC) + (size_t)l * 4 * XCP * 64, A.out, l};
                pg8::gemm_phase<EpiInProj, pg8::StaticOrder, true, true>(lds, g, S, E);
            }
            if (l == 0) {
                __syncthreads();
                pg8::Gemm g{(const bf16*)(ws + WS_XC), (const bf16*)(ws + WS_W1), 2048, 1024, 2048};
                CmpOrder S{G, (int)blockIdx.x, 0, DEPTH, 4, 64};
                EpiCmpHid E{(bf16*)(ws + WS_HID), (const float*)(ws + WS_B1)};
                pg8::gemm_phase<EpiCmpHid, CmpOrder, true, true>(lds, g, S, E);
            }
        }
        SEAM(pb_ + 0);
        if (IN(pb_ + 1)) {
            {
                pg8::Gemm g{(const bf16*)(ws + WS_XC), (const bf16*)(ws + WS_W1), 2048, 1024, 2048};
                CmpOrder S{G, (int)blockIdx.x, l, 1, 0, 4};
                EpiCmpHid E{(bf16*)(ws + WS_HID), (const float*)(ws + WS_B1)};
                pg8::gemm_phase<EpiCmpHid, CmpOrder, true, true>(lds, g, S, E);
            }
            __syncthreads();
            REPS(1) { phase_m2x(A, l, lds, tid);
            __syncthreads();
            prep_layer_images(A, l, lds, gw, NGW, lane, wave); __syncthreads(); }
            if (l == 0) phase_cmp2(A, 0, DEPTH, 1024, NCB - 1024, gw, NGW, lane);
        }
        SEAM(pb_ + 1);
        if (IN(pb_ + 2)) {
            REPS(2) phase_m3(A, l, tid);
            phase_cmp2(A, l, 1, 0, 1024, gw, NGW, lane);
        }
        SEAM(pb_ + 2);
        if (IN(pb_ + 3)) {
            REPS(3) { phase_m4x(A, l, lds, tid);
            __syncthreads(); }
            REPS(4) { phase_mls(A, l, lds, tid);
            __syncthreads(); }
            LAS float* wl = (LAS float*)(lds + wave * 8192); LAS float* btl = (LAS float*)(lds + 65536);
            for (int i = tid; i < 8 * 132; i += NTHR) btl[i] = ((const float*)(ws + WS_BT))[i];
            __syncthreads();
            REPS(5) for (int t = gw; t < 4 * 2048 + 2 * DB; t += NGW) nsa_tile(A, l, t, wl, btl, lane);
        }
        SEAM(pb_ + 3);
        if (IN(pb_ + 4)) {
            pg8::Gemm g{(const bf16*)(ws + WS_MIX), (const bf16*)(ws + WS_WOUT) + (size_t)l * D * D, D, D, D};
            pg8::StaticOrder S; S.init(M, D, G, (int)blockIdx.x);
            EpiResid E{xa, xb, adal + 2048, Z};
            pg8::gemm_phase<EpiResid, pg8::StaticOrder, true, true>(lds, g, S, E);
        }
        SEAM(pb_ + 4);
        if (IN(pb_ + 5)) {
            REPS(6) for (int r = gw; r < M; r += NGW) {
                const float* ad = adal + (size_t)cond_of_row(r) * 6144;
                ln_row(Z + (size_t)r * D, A.ln_g + (size_t)(l * 2 + 0) * D, A.ln_b + (size_t)(l * 2 + 0) * D, X + (size_t)r * D, ad + 3072, ad + 4096, U + (size_t)r * D, lane);
            }
        }
        SEAM(pb_ + 5);
        if (IN(pb_ + 6)) {
            pg8::Gemm g{U, (const bf16*)(ws + WS_WUP) + (size_t)l * FF * D, D, D, D};
            pg8::StaticOrder S; S.init(M, FF, G, (int)blockIdx.x);
            EpiRelu2 E{(bf16*)(ws + WS_H)};
            pg8::gemm_phase<EpiRelu2, pg8::StaticOrder, true, true>(lds, g, S, E);
        }
        SEAM(pb_ + 6);
        if (IN(pb_ + 7)) {
            pg8::Gemm g{(const bf16*)(ws + WS_H), (const bf16*)(ws + WS_WDN) + (size_t)l * D * FF, FF, FF, FF};
            pg8::StaticOrder S; S.init(M, D, G, (int)blockIdx.x);
            EpiResid E{X, X + (size_t)MP * D, adal + 5120, Z};
            pg8::gemm_phase<EpiResid, pg8::StaticOrder, true, true>(lds, g, S, E);
        }
        SEAM(pb_ + 7);
        if (IN(pb_ + 8)) {
            const bool last = l == DEPTH - 1;
            REPS(6) for (int r = gw; r < M; r += NGW) {
                const float* ad = adal + (size_t)NCOND * 6144 + (size_t)cond_of_row(r) * 6144;
                float* xo = last ? (r < MP ? A.out + O_YP + (size_t)r * D : A.out + O_YS + (size_t)(r - MP) * D) : X + (size_t)r * D;
                ln_row(Z + (size_t)r * D, A.ln_g + (size_t)(l * 2 + 1) * D, A.ln_b + (size_t)(l * 2 + 1) * D, xo, ad, ad + 1024, last ? (bf16*)nullptr : U + (size_t)r * D, lane);
            }
        }
        SEAM(pb_ + 8);
    }
__global__ void __launch_bounds__(NTHR, 2) fwd_kernel(Args A_unused) {
    extern __shared__ __attribute__((aligned(16))) unsigned char lds_raw[];
    LAS unsigned char* lds = (LAS unsigned char*)lds_raw;
    const int tid = threadIdx.x, lane = tid & 63, wave = __builtin_amdgcn_readfirstlane(tid >> 6);
    const int G = gridDim.x, gw = blockIdx.x * NWAVES + wave, NGW = G * NWAVES;
    unsigned char* ws = A.ws;
    for (int u = tid; u < (LDS_BYTES - LDSCTL_OFF) / 4; u += NTHR) ((LAS unsigned*)(lds + LDSCTL_OFF))[u] = 0u;
    __syncthreads();
    XcdBarrier bar; bar.bar = (unsigned*)(ws + WS_CTL) + CW_BAR; bar.x = 0; bar.st = nullptr;
    if (!MK_PER_PHASE) bar = xcd_barrier_post((unsigned*)(ws + WS_CTL) + CW_BAR, (volatile LAS unsigned*)(lds + MISC_OFF) + 8);
    const int lo = A.ph_lo, hi = A.ph_hi;

    float* const ADA = (float*)(ws + WS_ADA);
    float* const X = (float*)(ws + WS_X);
    float* const Z = (float*)(ws + WS_Z);
    bf16* const U = (bf16*)(ws + WS_U);

    if (IN(0)) { REPS(0) { phase_p0a(A, lds, gw, NGW, lane, wave); prep_cache_images(A, lds, gw, NGW, lane, wave); } }
    SEAM(0);
    if (IN(1)) { REPS(7) { phase_ada(A, lds, tid); } }
    SEAM(1);
    if (IN(2)) {
        for (int r = gw; r < M; r += NGW) {
            const float* ad = ADA + (size_t)cond_of_row(r) * 6144;
            mod_row(r < MP ? A.x_prompt + (size_t)r * D : A.x_sample + (size_t)(r - MP) * D, ad, ad + 1024, U + (size_t)r * D, lane);
        }
    }
    SEAM(2);

    layer_phases<0>(lds, bar, tid, lane, wave, G, gw, NGW, lo, hi);
    layer_phases<1>(lds, bar, tid, lane, wave, G, gw, NGW, lo, hi);
    static_assert(DEPTH == 2, "two layers");
#undef IN
#undef SEAM
#undef A
}

extern "C" void kernel_launch(void* const* d_in, const int* in_sizes, int n_in, void* d_out, int out_size, void* d_ws, size_t ws_size, hipStream_t stream) {
    static int grid = 0;
    if (grid == 0) {
        if (n_in != 25 || (size_t)out_size != O_END || ws_size < WS_END) { fprintf(stderr, "kernel_launch: unexpected shapes: n_in %d out %d (want %zu) ws %zu (want >= %zu)\n", n_in, out_size, (size_t)O_END, ws_size, (size_t)WS_END); grid = -1; return; }
        int dev = 0, cus = 0, per_cu = 0;
        if (hipGetDevice(&dev) != hipSuccess || hipDeviceGetAttribute(&cus, hipDeviceAttributeMultiprocessorCount, dev) != hipSuccess) { grid = -1; return; }
        if (hipFuncSetAttribute((const void*)fwd_kernel, hipFuncAttributeMaxDynamicSharedMemorySize, LDS_BYTES) != hipSuccess) { fprintf(stderr, "kernel_launch: hipFuncSetAttribute failed\n"); grid = -1; return; }
        if (hipOccupancyMaxActiveBlocksPerMultiprocessor(&per_cu, (const void*)fwd_kernel, NTHR, LDS_BYTES) != hipSuccess || per_cu < 1) fprintf(stderr, "kernel_launch: occupancy query reports %d blocks per CU\n", per_cu);
        (void)hipGetLastError();
        grid = cus;
    }
    if (grid < 0) return;
    (void)hipMemsetAsync((char*)d_ws + WS_CTL, 0, CTL_ZERO_BYTES, stream);
    Args a{};
    a.x_prompt = (const float*)d_in[0]; a.x_sample = (const float*)d_in[1]; a.cache_cmp = (const float*)d_in[2]; a.cache_slc = (const float*)d_in[3]; a.cache_win = (const float*)d_in[4];
    a.st_C = (const float*)d_in[5]; a.st_n = (const float*)d_in[6]; a.st_m = (const float*)d_in[7]; a.page_table = (const int*)d_in[8]; a.c_prompt = (const float*)d_in[9]; a.c_sample = (const float*)d_in[10];
    a.w_ada = (const float*)d_in[11]; a.b_ada = (const float*)d_in[12]; a.w_in = (const float*)d_in[13]; a.b_gate = (const float*)d_in[14]; a.ml_norm_g = (const float*)d_in[15]; a.cmp_pe = (const float*)d_in[16];
    a.cmp_w1 = (const float*)d_in[17]; a.cmp_w2 = (const float*)d_in[18]; a.rel_bias = (const float*)d_in[19]; a.w_out = (const float*)d_in[20]; a.ln_g = (const float*)d_in[21]; a.ln_b = (const float*)d_in[22];
    a.w_up = (const float*)d_in[23]; a.w_down = (const float*)d_in[24];
    a.out = (float*)d_out; a.ws = (unsigned char*)d_ws;
#if MK_PER_PHASE
    for (int ph = 0; ph < N_PHASES; ++ph) { a.ph_lo = ph; a.ph_hi = ph + 1; hipLaunchKernelGGL(fwd_kernel, dim3(grid), dim3(NTHR), LDS_BYTES, stream, a); }
#else
    a.ph_lo = 0; a.ph_hi = N_PHASES;
    hipLaunchKernelGGL(fwd_kernel, dim3(grid), dim3(NTHR), LDS_BYTES, stream, a);
#endif
    const hipError_t le = hipPeekAtLastError();
    if (le != hipSuccess) fprintf(stderr, "kernel_launch: launch failed: %s\n", hipGetErrorName(le));
}
```

```cpp
#include <hip/hip_runtime.h>
#include <cstdio>
#include <cstdint>
namespace pg8 {
#define PG8_LAS __attribute__((address_space(3)))
typedef unsigned short bf16_t;
typedef short bf16x8 __attribute__((ext_vector_type(8)));
typedef float f32x4 __attribute__((ext_vector_type(4)));
typedef unsigned u32x4 __attribute__((ext_vector_type(4)));
constexpr int BM = 256, BK = 64, HALF = 128, HTB = HALF * BK * 2  , STAGE_BYTES = 8 * HTB, NXCD = 8, WGM = 8;

__host__ __device__ __forceinline__ int lds_byte(int r, int c) { const int st = (r >> 4) * 2 + (c >> 5), rr = r & 15, cc = c & 31, ob = rr * 64 + cc * 2; return st * 1024 + (ob ^ (((ob >> 9) & 1) << 5)); }
__host__ __device__ __forceinline__ void stage_rc(int b, int& R, int& C) { const int st = b / 1024, sb = b % 1024, swz = sb ^ (((sb >> 9) & 1) << 5); R = (st >> 1) * 16 + swz / 64; C = (st & 1) * 32 + (swz % 64) / 2; }
__host__ __device__ __forceinline__ int perm32(int rho) { const int n = rho >> 4, i = rho & 15; return 8 * (i >> 2) + 4 * n + (i & 3); }

struct Unit { int pm, pn; };
struct Gemm { const bf16_t* A; const bf16_t* Bt; int K, lda, ldb; };

struct StaticOrder {
    int nM, nN, nwg, G, c;
    __host__ __device__ void init(int M, int N, int G_, int c_) { nM = M / BM; nN = N / BM; nwg = nM * nN; G = G_; c = c_; }
    __host__ __device__ bool next(int i, Unit& u) const {
        const long L = (long)i * G + c; if (L >= nwg) return false;
        int wgid = (int)L; { const int q = nwg / NXCD, r = nwg % NXCD, xcd = wgid % NXCD, off = wgid / NXCD; wgid = (xcd < r ? xcd * (q + 1) : r * (q + 1) + (xcd - r) * q) + off; }
        const int nig = WGM * nN, gid = wgid / nig, fm = gid * WGM, gsz = (nM - fm) < WGM ? (nM - fm) : WGM;
        u.pm = fm + ((wgid % nig) % gsz); u.pn = (wgid % nig) / gsz; return true;
    }
    __device__ __forceinline__ void a_ready(const Unit&) const {}
    __device__ __forceinline__ void done(const Unit&) const {}
};

template <class Epi, class Sched, bool ALIGN_EPI = false, bool SP2 = false>
__device__ __forceinline__ void gemm_phase(PG8_LAS unsigned char* lds, const Gemm g, const Sched& S, const Epi& E) {
    const int tid = threadIdx.x, wid = __builtin_amdgcn_readfirstlane(tid >> 6), lane = tid & 63, wr = wid >> 2, wc = wid & 3, fr = lane & 15, fq = lane >> 4;
    const int K = g.K, nt = K / BK;
    unsigned voffA[2], voffB[2];
#pragma unroll
    for (int i = 0; i < 2; ++i) { int R, C; stage_rc(tid * 16 + i * 8192, R, C); const int Rb = Epi::PERM ? ((R & ~31) + perm32(R & 31)) : R;
        voffA[i] = (unsigned)(R * g.lda + C) * 2u; voffB[i] = (unsigned)(Rb * g.ldb + C) * 2u; }
    const size_t kstep = (size_t)(BK * 2);
    const size_t hstepA = (size_t)HALF * g.lda * 2, hstepB = (size_t)HALF * g.ldb * 2;
    const size_t tstepA = 2 * hstepA, tstepB = 2 * hstepB;
    const unsigned ldsw = (unsigned)wid * 1024u;
    const int aoff = lds_byte(wr * 64 + fr, fq * 8), boff = lds_byte(wc * 32 + fr, fq * 8);
#define PG8_SA(b, h) (((b) * 2 + (h)) * HTB)
#define PG8_SB(b, h) ((4 + (b) * 2 + (h)) * HTB)
#define PG8_STAGE(bufoff, gbase, voff) do { _Pragma("unroll") for (int _i = 0; _i < 2; ++_i) \
        __builtin_amdgcn_global_load_lds((const unsigned*)((const char*)(gbase) + (voff)[_i]), (PG8_LAS unsigned*)(lds + (bufoff) + ldsw + _i * 8192), 16, 0, 0); } while (0)
#define PG8_LDA(dst, b, h) do { _Pragma("unroll") for (int m = 0; m < 4; ++m) _Pragma("unroll") for (int k = 0; k < 2; ++k) dst[m][k] = *(const PG8_LAS bf16x8*)(lds + PG8_SA(b, h) + aoff + m * 2048 + k * 1024); } while (0)
#define PG8_LDB(dst, b, h) do { _Pragma("unroll") for (int n = 0; n < 2; ++n) _Pragma("unroll") for (int k = 0; k < 2; ++k) dst[n][k] = *(const PG8_LAS bf16x8*)(lds + PG8_SB(b, h) + boff + n * 2048 + k * 1024); } while (0)
#define PG8_MMA(ai, bj, At, Bt) do { __builtin_amdgcn_s_setprio(1); _Pragma("unroll") for (int m = 0; m < 4; ++m) _Pragma("unroll") for (int n = 0; n < 2; ++n) _Pragma("unroll") for (int k = 0; k < 2; ++k) \
        acc[ai][bj][m][n] = __builtin_amdgcn_mfma_f32_16x16x32_bf16(Bt[n][k], At[m][k], acc[ai][bj][m][n], 0, 0, 0); __builtin_amdgcn_s_setprio(0); } while (0)
#define PG8_WAIT_V(n) asm volatile("s_waitcnt vmcnt(" #n ")" ::: "memory")
#define PG8_WAIT_L(n) asm volatile("s_waitcnt lgkmcnt(" #n ")" ::: "memory")
#define PG8_BAR __builtin_amdgcn_s_barrier()
#define PG8_SCHED __builtin_amdgcn_sched_barrier(0)
    Unit cur, nxt; int ui = 0;
    if (!S.next(0, cur)) return;
    f32x4 acc[2][2][4][2];
#pragma unroll
    for (int a = 0; a < 2; ++a)
#pragma unroll
        for (int b = 0; b < 2; ++b)
#pragma unroll
            for (int m = 0; m < 4; ++m)
#pragma unroll
                for (int n = 0; n < 2; ++n) acc[a][b][m][n] = (f32x4){0.f, 0.f, 0.f, 0.f};
    bf16x8 At[4][2], B0[2][2], B1[2][2];
    const char* cA = (const char*)g.A + (size_t)cur.pm * tstepA; const char* cB = (const char*)g.Bt + (size_t)cur.pn * tstepB;
    S.a_ready(cur);
    if constexpr (SP2) {
        PG8_STAGE(PG8_SB(0, 0), cB, voffB); PG8_STAGE(PG8_SB(0, 1), cB + hstepB, voffB); PG8_STAGE(PG8_SA(0, 0), cA, voffA); PG8_STAGE(PG8_SA(0, 1), cA + hstepA, voffA);
        if (wr == 1) PG8_BAR;
        PG8_WAIT_V(2); PG8_BAR;
        PG8_STAGE(PG8_SB(1, 0), cB + kstep, voffB); PG8_STAGE(PG8_SA(1, 0), cA + kstep, voffA); PG8_STAGE(PG8_SB(1, 1), cB + hstepB + kstep, voffB);
        PG8_WAIT_V(6); PG8_BAR;
    } else {
        PG8_STAGE(PG8_SB(0, 0), cB, voffB); PG8_STAGE(PG8_SA(0, 0), cA, voffA); PG8_STAGE(PG8_SB(0, 1), cB + hstepB, voffB); PG8_STAGE(PG8_SA(0, 1), cA + hstepA, voffA);
        if (wr == 1) PG8_BAR;
        PG8_WAIT_V(4); PG8_BAR;
        PG8_STAGE(PG8_SB(1, 0), cB + kstep, voffB); PG8_STAGE(PG8_SA(1, 0), cA + kstep, voffA); PG8_STAGE(PG8_SB(1, 1), cB + hstepB + kstep, voffB);
        PG8_WAIT_V(6); PG8_BAR;
    }
    for (;;) {
        const bool has_next = S.next(ui + 1, nxt);
        const char* nA = has_next ? (const char*)g.A + (size_t)nxt.pm * tstepA : cA; const char* nB = has_next ? (const char*)g.Bt + (size_t)nxt.pn * tstepB : cB;
        for (int t = 0; t < nt; t += 2) {
            const bool last = (t == nt - 2);
            const char* a1 = cA + (size_t)(t + 1) * kstep;
            const char* a2 = last ? nA : cA + (size_t)(t + 2) * kstep; const char* b2 = last ? nB : cB + (size_t)(t + 2) * kstep;
            const char* a3 = a2 + kstep; const char* b3 = b2 + kstep;
            if (last && has_next) S.a_ready(nxt);
            if constexpr (SP2) {
            PG8_LDB(B0, 0, 0); PG8_LDB(B1, 0, 1); PG8_SCHED; PG8_LDA(At, 0, 0); PG8_STAGE(PG8_SA(1, 1), a1 + hstepA, voffA);
            PG8_WAIT_V(8); PG8_WAIT_L(0); PG8_BAR; PG8_MMA(0, 0, At, B0); PG8_MMA(0, 1, At, B1); PG8_BAR; PG8_SCHED;
            PG8_LDA(At, 0, 1); PG8_STAGE(PG8_SB(0, 0), b2, voffB); PG8_STAGE(PG8_SB(0, 1), b2 + hstepB, voffB); PG8_STAGE(PG8_SA(0, 0), a2, voffA);
            PG8_WAIT_V(8); PG8_WAIT_L(0); PG8_BAR; PG8_MMA(1, 0, At, B0); PG8_MMA(1, 1, At, B1); PG8_BAR; PG8_SCHED;
            PG8_LDB(B0, 1, 0); PG8_LDB(B1, 1, 1); PG8_SCHED; PG8_LDA(At, 1, 0); PG8_STAGE(PG8_SA(0, 1), a2 + hstepA, voffA);
            PG8_WAIT_V(8); PG8_WAIT_L(0); PG8_BAR; PG8_MMA(0, 0, At, B0); PG8_MMA(0, 1, At, B1); PG8_BAR; PG8_SCHED;
            PG8_LDA(At, 1, 1); PG8_STAGE(PG8_SB(1, 0), b3, voffB); PG8_STAGE(PG8_SB(1, 1), b3 + hstepB, voffB); PG8_STAGE(PG8_SA(1, 0), a3, voffA);
            PG8_WAIT_V(8); PG8_WAIT_L(0); PG8_BAR; PG8_MMA(1, 0, At, B0); PG8_MMA(1, 1, At, B1); PG8_BAR; PG8_SCHED;
            } else {
            PG8_LDB(B0, 0, 0); PG8_SCHED; PG8_LDA(At, 0, 0); PG8_STAGE(PG8_SA(1, 1), a1 + hstepA, voffA);
            PG8_WAIT_L(8); PG8_BAR; PG8_WAIT_L(0); PG8_MMA(0, 0, At, B0); PG8_BAR; PG8_SCHED;
            PG8_LDB(B1, 0, 1); PG8_STAGE(PG8_SB(0, 0), b2, voffB);
            PG8_BAR; PG8_WAIT_L(0); PG8_MMA(0, 1, At, B1); PG8_BAR;
            PG8_LDA(At, 0, 1); PG8_STAGE(PG8_SA(0, 0), a2, voffA);
            PG8_BAR; PG8_WAIT_L(0); PG8_MMA(1, 0, At, B0); PG8_BAR; PG8_SCHED;
            PG8_STAGE(PG8_SB(0, 1), b2 + hstepB, voffB);
            PG8_WAIT_V(6); PG8_BAR; PG8_MMA(1, 1, At, B1); PG8_BAR;
            PG8_LDB(B0, 1, 0); PG8_SCHED; PG8_LDA(At, 1, 0); PG8_STAGE(PG8_SA(0, 1), a2 + hstepA, voffA);
            PG8_WAIT_L(8); PG8_BAR; PG8_WAIT_L(0); PG8_MMA(0, 0, At, B0); PG8_BAR; PG8_SCHED;
            PG8_LDB(B1, 1, 1); PG8_STAGE(PG8_SB(1, 0), b3, voffB);
            PG8_BAR; PG8_WAIT_L(0); PG8_MMA(0, 1, At, B1); PG8_BAR;
            PG8_LDA(At, 1, 1); PG8_STAGE(PG8_SA(1, 0), a3, voffA);
            PG8_BAR; PG8_WAIT_L(0); PG8_MMA(1, 0, At, B0); PG8_BAR; PG8_SCHED;
            PG8_STAGE(PG8_SB(1, 1), b3 + hstepB, voffB);
            PG8_WAIT_V(6); PG8_BAR; PG8_MMA(1, 1, At, B1); PG8_BAR;
            }
        }
        if constexpr (ALIGN_EPI) { if (wr == 0) PG8_BAR; }
        if constexpr (!Epi::AFTER_DRAIN) { E(acc, cur, wr, wc, fr, fq); S.done(cur); }
        if (!has_next) break;
#pragma unroll
        for (int a = 0; a < 2; ++a)
#pragma unroll
            for (int b = 0; b < 2; ++b)
#pragma unroll
                for (int m = 0; m < 4; ++m)
#pragma unroll
                    for (int n = 0; n < 2; ++n) acc[a][b][m][n] = (f32x4){0.f, 0.f, 0.f, 0.f};
        cur = nxt; cA = nA; cB = nB; ++ui;
        if constexpr (ALIGN_EPI) { if (wr == 1) PG8_BAR; }
    }
    PG8_WAIT_V(0);
    if constexpr (!ALIGN_EPI) { if (wr == 0) PG8_BAR; }
    PG8_BAR;
    if constexpr (Epi::AFTER_DRAIN) { E.fused(acc, cur, wr, wc, fr, fq, lds, wid, lane); S.done(cur); }
#undef PG8_SA
#undef PG8_SB
#undef PG8_STAGE
#undef PG8_LDA
#undef PG8_LDB
#undef PG8_MMA
#undef PG8_WAIT_V
#undef PG8_WAIT_L
#undef PG8_BAR
#undef PG8_SCHED
}
}

constexpr int D = 1024, BATCH = 2, SEQ = 8192, DEPTH = 2, DB = 128, DS = 4, PAST = 2048, PAGE = 128, NPG = 16, NPHYS = 2560;
constexpr int MP = BATCH * SEQ, MS = DB * DS, M = MP + MS;
constexpr int NINP = 3584, FF = 4096, NCOND = BATCH + DB;
constexpr int NH = 4, HD = 128;
constexpr int LCH = 256, NCH = SEQ / LCH, NUNIT = BATCH * NH * NCH;
constexpr int NCB = 17408;
constexpr int XCP = NCB * 16;
constexpr float ALPHA = 1.4142135623730951f;
constexpr float LN_EPS = 1e-5f;
constexpr size_t O_YP = 0, O_YS = O_YP + (size_t)MP * D, O_CMPP = O_YS + (size_t)MS * D, O_CMPS = O_CMPP + (size_t)DEPTH * MP * 256, O_SLCP = O_CMPS + (size_t)DEPTH * MS * 256,
                 O_SLCS = O_SLCP + (size_t)DEPTH * MP * 256, O_WINP = O_SLCS + (size_t)DEPTH * MS * 256, O_WINS = O_WINP + (size_t)DEPTH * BATCH * 512 * 256,
                 O_CP = O_WINS + (size_t)DEPTH * DB * 512 * 256, O_CS = O_CP + (size_t)DEPTH * BATCH * NH * HD * HD, O_NP = O_CS + (size_t)DEPTH * DB * NH * HD * HD,
                 O_NS = O_NP + (size_t)DEPTH * BATCH * NH * HD, O_MP = O_NS + (size_t)DEPTH * DB * NH * HD, O_MS = O_MP + (size_t)DEPTH * BATCH * NH, O_END = O_MS + (size_t)DEPTH * DB * NH;

constexpr size_t al1m(size_t x) { return (x + 0xFFFFFull) & ~(size_t)0xFFFFFull; }
constexpr size_t WS_CTL = 0, CTL_ZERO_BYTES = 1u << 20;
constexpr size_t WS_WIN  = CTL_ZERO_BYTES;
constexpr size_t WS_WOUT = WS_WIN  + al1m((size_t)DEPTH * NINP * D * 2);
constexpr size_t WS_WUP  = WS_WOUT + al1m((size_t)DEPTH * D * D * 2);
constexpr size_t WS_WDN  = WS_WUP  + al1m((size_t)DEPTH * FF * D * 2);
constexpr size_t WS_W1   = WS_WDN  + al1m((size_t)DEPTH * D * FF * 2);
constexpr size_t WS_ADA  = WS_W1   + al1m((size_t)DEPTH * 2 * 256 * 2048 * 2);
constexpr size_t WS_B1   = WS_ADA  + al1m((size_t)DEPTH * NCOND * 6144 * 4);
constexpr size_t WS_BT   = WS_B1   + al1m(4096);
constexpr size_t WS_X    = WS_BT   + al1m(8 * 132 * 4);
constexpr size_t WS_Z    = WS_X    + al1m((size_t)M * D * 4);
constexpr size_t WS_U    = WS_Z    + al1m((size_t)M * D * 4);
constexpr size_t WS_QKVO = WS_U    + al1m((size_t)M * D * 2);
constexpr size_t WS_NQ   = WS_QKVO + al1m((size_t)M * 2048 * 2);
constexpr size_t WS_GATE = WS_NQ   + al1m((size_t)M * 512 * 2);
constexpr size_t WS_KVR  = WS_GATE + al1m((size_t)M * 32 * 4);
constexpr size_t WS_XC   = WS_KVR  + al1m((size_t)3 * M * 256 * 4);
constexpr size_t WS_HID  = WS_XC   + al1m((size_t)DEPTH * 4 * XCP * 64 * 2 + 4096);
constexpr size_t WS_CKV  = WS_HID  + al1m((size_t)DEPTH * 4 * NCB * 256 * 2);
constexpr size_t WS_KS   = WS_CKV  + al1m((size_t)DEPTH * 4 * NCB * 64 * 4);
constexpr size_t WS_VTS  = WS_KS   + al1m((size_t)DEPTH * 2 * (MP + DB * 2112) * 64 * 2 + 65536);
constexpr size_t WS_KW   = WS_VTS  + al1m((size_t)DEPTH * 2 * (MP + DB * 2112) * 64 * 2 + 65536);
constexpr size_t WS_VTW  = WS_KW   + al1m((size_t)DEPTH * 2 * (MP + DB * 528 + 64) * 64 * 2 + 65536);
constexpr size_t WS_KC   = WS_VTW  + al1m((size_t)DEPTH * 2 * (MP + DB * 528 + 64) * 64 * 2 + 65536);
constexpr size_t WS_VCT  = WS_KC   + al1m((size_t)DEPTH * 2 * NCB * 64 * 2 + 65536);
constexpr size_t WS_W2T  = WS_VCT  + al1m((size_t)DEPTH * 2 * NCB * 64 * 2 + 65536);
constexpr size_t WS_MIX  = WS_W2T  + al1m(65536);
constexpr size_t WS_H    = WS_MIX  + al1m((size_t)M * D * 2);
constexpr size_t WS_DCT  = WS_H    + al1m((size_t)M * FF * 2);
constexpr size_t WS_DN   = WS_DCT  + al1m((size_t)NUNIT * HD * HD * 4);
constexpr size_t WS_CHS  = WS_DN   + al1m((size_t)NUNIT * HD * 4);
constexpr size_t WS_CTP  = WS_CHS  + al1m((size_t)NUNIT * 4 * 4);
constexpr size_t WS_NPV  = WS_CTP  + al1m((size_t)NUNIT * HD * HD * 2);
constexpr size_t WS_WSC  = WS_NPV  + al1m((size_t)NUNIT * HD * 4);
constexpr size_t WS_HRAW = WS_WSC  + al1m((size_t)NUNIT * LCH * LCH * 4);
constexpr size_t WS_END  = WS_HRAW + al1m((size_t)NUNIT * LCH * HD * 4);

constexpr int CW_BAR = 4096;

constexpr int RING_BYTES = 131072, LDSCTL_OFF = RING_BYTES, MISC_OFF = LDSCTL_OFF + 320, LDS_BYTES = 147456;
constexpr int NWAVES = 8, NTHR = NWAVES * 64;

#define GAS __attribute__((address_space(1)))
#define LAS __attribute__((address_space(3)))
typedef unsigned short bf16;
typedef unsigned v4u __attribute__((ext_vector_type(4)));
typedef unsigned v2u __attribute__((ext_vector_type(2)));
typedef float f32x4 __attribute__((ext_vector_type(4)));
typedef float f32x2 __attribute__((ext_vector_type(2)));

__device__ __forceinline__ unsigned f2bf(float f) { unsigned u = __builtin_bit_cast(unsigned, f); return (u + 0x7fffu + ((u >> 16) & 1u)) >> 16; }
__device__ __forceinline__ unsigned pk2(float lo, float hi) { return f2bf(lo) | (f2bf(hi) << 16); }
__device__ __forceinline__ float bflo(unsigned u) { return __builtin_bit_cast(float, u << 16); }
__device__ __forceinline__ float bfhi(unsigned u) { return __builtin_bit_cast(float, u & 0xffff0000u); }
__device__ __forceinline__ float bf2f(bf16 h) { return __builtin_bit_cast(float, (unsigned)h << 16); }
__device__ __forceinline__ float sigmoidf_(float x) { return 1.f / (1.f + __expf(-x)); }
__device__ __forceinline__ float wave_sum(float v) {
#pragma unroll
    for (int o = 1; o < 64; o <<= 1) v += __shfl_xor(v, o);
    return v;
}
__device__ __forceinline__ float wave_max(float v) {
#pragma unroll
    for (int o = 1; o < 64; o <<= 1) v = fmaxf(v, __shfl_xor(v, o));
    return v;
}

#define XB_TMO      128
#define XB_XCNT(j)  (256  + 64 * (j))
#define XB_XSUB(j)  (1280 + 64 * (j))
#define XB_XGEN(j)  (2304 + 64 * (j))
#define XB_TOP      3328
#define XB_TOPGEN   3392
#define XCD_BAR_WORDS 3456
#define XB_SPIN_CAP (1u << 18)

__device__ __forceinline__ unsigned xb_ld(unsigned* p)              { return __hip_atomic_load(p, __ATOMIC_RELAXED, __HIP_MEMORY_SCOPE_AGENT); }
__device__ __forceinline__ unsigned xb_add(unsigned* p, unsigned v) { return __hip_atomic_fetch_add(p, v, __ATOMIC_RELAXED, __HIP_MEMORY_SCOPE_AGENT); }
__device__ __forceinline__ unsigned xb_xcc_id() { return (unsigned)__builtin_amdgcn_s_getreg((3 << 11) | 20) & 0xFu; }
#define XB_SPIN(cond, bar) do { unsigned _sp = 0; while (cond) { __builtin_amdgcn_s_sleep(1); \
    if ((++_sp & 255u) == 0u) { if (xb_ld(&(bar)[XB_TMO])) break; if (_sp > XB_SPIN_CAP) { atomicAdd(&(bar)[XB_TMO], 1u); break; } } } } while (0)

struct XcdBarrier {
    unsigned* bar; unsigned x;
    volatile LAS unsigned* st;
};

__device__ __forceinline__ XcdBarrier xcd_barrier_post(unsigned* bar, volatile LAS unsigned* st) {
    XcdBarrier b; b.bar = bar; b.x = xb_xcc_id(); b.st = st;
    if (threadIdx.x == 0) (void)xb_add(&bar[XB_XCNT(b.x)], 1u);
    return b;
}
__device__ __forceinline__ void xcd_barrier_complete(unsigned* bar, unsigned x, unsigned& nloc, unsigned& nx) {
    const unsigned G = gridDim.x * gridDim.y * gridDim.z;
    unsigned sum, cnt, mine, sp = 0u;
    for (;;) {
        sum = 0u; cnt = 0u; mine = 0u;
#pragma unroll
        for (unsigned j = 0; j < 16; ++j) { const unsigned c = xb_ld(&bar[XB_XCNT(j)]); sum += c; cnt += (c > 0u) ? 1u : 0u; mine = (j == x) ? c : mine; }
        if (sum == G) break;
        __builtin_amdgcn_s_sleep(1);
        if ((++sp & 255u) == 0u) { if (xb_ld(&bar[XB_TMO])) break; if (sp > XB_SPIN_CAP) { atomicAdd(&bar[XB_TMO], 1u); break; } }
    }
    nloc = mine > 0u ? mine : 1u; nx = cnt > 0u ? cnt : 1u;
}

__device__ __forceinline__ void xcd_barrier(const XcdBarrier& b) {
    asm volatile("s_waitcnt vmcnt(0)" ::: "memory");
    __syncthreads();
    if (threadIdx.x == 0) {
        unsigned* bar = b.bar;
        __builtin_amdgcn_s_waitcnt(0);
        unsigned nloc = b.st[0], nx = b.st[1];
        if (nloc == 0u) { xcd_barrier_complete(bar, b.x, nloc, nx); b.st[0] = nloc; b.st[1] = nx; }
        const unsigned old = xb_add(&bar[XB_XSUB(b.x)], 1u);
        const unsigned gen = old / nloc;
        if (old + 1u == (gen + 1u) * nloc) {
            __builtin_amdgcn_fence(__ATOMIC_RELEASE, "agent");
            asm volatile("s_waitcnt vmcnt(0)" ::: "memory");
            const unsigned og = xb_add(&bar[XB_TOP], 1u);
            const unsigned tg = og / nx;
            if (og + 1u == (tg + 1u) * nx) xb_add(&bar[XB_TOPGEN], 1u);
            else XB_SPIN(xb_ld(&bar[XB_TOPGEN]) == tg, bar);
            __builtin_amdgcn_fence(__ATOMIC_ACQUIRE, "agent");
            xb_add(&bar[XB_XGEN(b.x)], 1u);
            asm volatile("s_waitcnt vmcnt(0)" ::: "memory");
        } else {
            XB_SPIN(xb_ld(&bar[XB_XGEN(b.x)]) == gen, bar);
            __builtin_amdgcn_fence(__ATOMIC_ACQUIRE, "agent");
            asm volatile("s_waitcnt vmcnt(0)" ::: "memory");
        }
    }
    __syncthreads();
}

struct Args {
    const float* x_prompt; const float* x_sample; const float* cache_cmp; const float* cache_slc; const float* cache_win;
    const float* st_C; const float* st_n; const float* st_m; const int* page_table; const float* c_prompt; const float* c_sample;
    const float* w_ada; const float* b_ada; const float* w_in; const float* b_gate; const float* ml_norm_g; const float* cmp_pe;
    const float* cmp_w1; const float* cmp_w2; const float* rel_bias; const float* w_out; const float* ln_g; const float* ln_b;
    const float* w_up; const float* w_down;
    float* out; unsigned char* ws; int ph_lo, ph_hi;
};
static_assert(sizeof(Args) == 27 * 8 + 8, "Args has no padding");
typedef const __attribute__((address_space(4))) Args CArgs;

__device__ __forceinline__ int cond_of_row(int r) { return r < MP ? (r >> 13) : BATCH + ((r - MP) >> 2); }

struct EpiInProj {
    static constexpr bool PERM = true, AFTER_DRAIN = false;
    bf16* QKVO; bf16* NQ; float* GATE; float* KVR; bf16* XC; float* out; int l;
    __device__ __forceinline__ void operator()(const f32x4 (&acc)[2][2][4][2], const pg8::Unit& u, int wr, int wc, int fr, int fq) const {
        const int row0 = u.pm * 256 + wr * 64 + fr, pn = u.pn, col8 = wc * 32 + 8 * fq;
#pragma unroll
        for (int ai = 0; ai < 2; ++ai)
#pragma unroll
            for (int m = 0; m < 4; ++m) {
                const int r = row0 + ai * 128 + m * 16;
#pragma unroll
                for (int bj = 0; bj < 2; ++bj) {
                    const f32x4 v0 = acc[ai][bj][m][0], v1 = acc[ai][bj][m][1];
                    const int cc = bj * 128 + col8;
                    if (pn < 10) {
                        v4u w; w.x = pk2(v0[0], v0[1]); w.y = pk2(v0[2], v0[3]); w.z = pk2(v1[0], v1[1]); w.w = pk2(v1[2], v1[3]);
                        if (pn < 8) *(v4u*)(QKVO + (size_t)r * 2048 + pn * 256 + cc) = w;
                        else        *(v4u*)(NQ + (size_t)r * 512 + (pn - 8) * 256 + cc) = w;
                    } else if (pn < 13) {
                        const int kind = pn - 10;
                        float* kr = KVR + ((size_t)kind * M + r) * 256 + cc;
                        *(f32x4*)kr = v0; *(f32x4*)(kr + 4) = v1;
                        float* o = nullptr;
                        if (r < MP) {
                            if (kind < 2) o = out + (kind == 0 ? O_CMPP : O_SLCP) + ((size_t)l * MP + r) * 256 + cc;
                            else { const int t = r & (SEQ - 1); if (t >= SEQ - 512) o = out + O_WINP + (((size_t)l * BATCH + (r >> 13)) * 512 + (t - (SEQ - 512))) * 256 + cc; }
                        } else {
                            const int rs = r - MP;
                            if (kind < 2) o = out + (kind == 0 ? O_CMPS : O_SLCS) + ((size_t)l * MS + rs) * 256 + cc;
                            else o = out + O_WINS + (((size_t)l * DB + (rs >> 2)) * 512 + 508 + (rs & 3)) * 256 + cc;
                        }
                        if (o) { *(f32x4*)o = v0; *(f32x4*)(o + 4) = v1; }
                        if (kind == 0 && r < MP) {
                            v4u w; w.x = pk2(v0[0], v0[1]); w.y = pk2(v0[2], v0[3]); w.z = pk2(v1[0], v1[1]); w.w = pk2(v1[2], v1[3]);
                            *(v4u*)(XC + ((size_t)(bj * 2 + (wc >> 1)) * XCP + r) * 64 + (wc & 1) * 32 + 8 * fq) = w;
                        }
                    } else {
                        if (bj == 0 && wc == 0) { float* gp = GATE + (size_t)r * 32 + 8 * fq; *(f32x4*)gp = v0; *(f32x4*)(gp + 4) = v1; }
                    }
                }
            }
    }
};

struct EpiResid {
    static constexpr bool PERM = true, AFTER_DRAIN = false;
    const float* xa; const float* xb; const float* gate; float* Z;
    __device__ __forceinline__ void operator()(const f32x4 (&acc)[2][2][4][2], const pg8::Unit& u, int wr, int wc, int fr, int fq) const {
        const int row0 = u.pm * 256 + wr * 64 + fr, col0 = u.pn * 256 + wc * 32 + 8 * fq;
#pragma unroll
        for (int ai = 0; ai < 2; ++ai)
#pragma unroll
            for (int m = 0; m < 4; ++m) {
                const int r = row0 + ai * 128 + m * 16;
                const float* xr = (r < MP ? xa + (size_t)r * D : xb + (size_t)(r - MP) * D) + col0;
                const float* gr = gate + (size_t)cond_of_row(r) * 6144 + col0;
                float* zr = Z + (size_t)r * D + col0;
#pragma unroll
                for (int bj = 0; bj < 2; ++bj) {
                    const f32x4 x0 = *(const f32x4*)(xr + bj * 128), x1 = *(const f32x4*)(xr + bj * 128 + 4);
                    const f32x4 g0 = *(const f32x4*)(gr + bj * 128), g1 = *(const f32x4*)(gr + bj * 128 + 4);
                    *(f32x4*)(zr + bj * 128) = x0 * ALPHA + g0 * acc[ai][bj][m][0];
                    *(f32x4*)(zr + bj * 128 + 4) = x1 * ALPHA + g1 * acc[ai][bj][m][1];
                }
            }
    }
};

struct EpiRelu2 {
    static constexpr bool PERM = true, AFTER_DRAIN = false;
    bf16* H;
    __device__ __forceinline__ void operator()(const f32x4 (&acc)[2][2][4][2], const pg8::Unit& u, int wr, int wc, int fr, int fq) const {
        const int row0 = u.pm * 256 + wr * 64 + fr, col0 = u.pn * 256 + wc * 32 + 8 * fq;
#pragma unroll
        for (int ai = 0; ai < 2; ++ai)
#pragma unroll
            for (int m = 0; m < 4; ++m) {
                bf16* hr = H + (size_t)(row0 + ai * 128 + m * 16) * FF + col0;
#pragma unroll
                for (int bj = 0; bj < 2; ++bj) {
                    f32x4 a = acc[ai][bj][m][0], b = acc[ai][bj][m][1];
#pragma unroll
                    for (int i = 0; i < 4; ++i) { a[i] = fmaxf(a[i], 0.f); a[i] *= a[i]; b[i] = fmaxf(b[i], 0.f); b[i] *= b[i]; }
                    v4u w; w.x = pk2(a[0], a[1]); w.y = pk2(a[2], a[3]); w.z = pk2(b[0], b[1]); w.w = pk2(b[2], b[3]);
                    *(v4u*)(hr + bj * 128) = w;
                }
            }
    }
};

__device__ __forceinline__ float gelu_tanh(float x) {
    const float y = 0.7978845608028654f * (x + 0.044715f * x * x * x);
    const float t = 1.f - 2.f / (__expf(2.f * y) + 1.f);
    return 0.5f * x * (1.f + t);
}
struct EpiCmpHid {
    static constexpr bool PERM = true, AFTER_DRAIN = false;
    bf16* HID; const float* B1;
    __device__ __forceinline__ void operator()(const f32x4 (&acc)[2][2][4][2], const pg8::Unit& u, int wr, int wc, int fr, int fq) const {
        const int row0 = u.pm * 256 + wr * 64 + fr, col0 = wc * 32 + 8 * fq;
        const float* bp = B1 + u.pn * 256 + col0;
        f32x4 bv[2][2];
#pragma unroll
        for (int bj = 0; bj < 2; ++bj) { bv[bj][0] = *(const f32x4*)(bp + bj * 128); bv[bj][1] = *(const f32x4*)(bp + bj * 128 + 4); }
#pragma unroll
        for (int ai = 0; ai < 2; ++ai)
#pragma unroll
            for (int m = 0; m < 4; ++m) {
                bf16* hr = HID + (size_t)(row0 + ai * 128 + m * 16) * 256 + col0;
#pragma unroll
                for (int bj = 0; bj < 2; ++bj) {
                    f32x4 a = acc[ai][bj][m][0] + bv[bj][0], b = acc[ai][bj][m][1] + bv[bj][1];
#pragma unroll
                    for (int i = 0; i < 4; ++i) { a[i] = gelu_tanh(a[i]); b[i] = gelu_tanh(b[i]); }
                    v4u w; w.x = pk2(a[0], a[1]); w.y = pk2(a[2], a[3]); w.z = pk2(b[0], b[1]); w.w = pk2(b[2], b[3]);
                    *(v4u*)(hr + bj * 128) = w;
                }
            }
    }
};

struct CmpOrder {
    int G, c, l0, nl, t0, ntile;
    __device__ __forceinline__ bool next(int i, pg8::Unit& u) const {
        const int L = i * G + c; if (L >= nl * 4 * ntile) return false;
        const int blk = L / ntile, tile = L % ntile, l = l0 + (blk >> 2), sg = blk & 3;
        u.pm = (l * 4 + sg) * 68 + t0 + tile; u.pn = l * 2 + (sg >> 1); return true;
    }
    __device__ __forceinline__ void a_ready(const pg8::Unit&) const {}
    __device__ __forceinline__ void done(const pg8::Unit&) const {}
};

#define LDS_WAIT() asm volatile("s_waitcnt lgkmcnt(0)" ::: "memory")
#define VM_WAIT() asm volatile("s_waitcnt vmcnt(0)" ::: "memory")

template <class CM>
__device__ __forceinline__ void transpose_item(const float* W, int ldw, int K, bf16* WT, LAS float* scr, int item, int nblk, int lane, const CM& cm) {
    const int kb = item / nblk, nb = item % nblk, k0 = 64 * kb, n0 = 32 * nb;
    const int sc = cm.col(n0 + (lane & 31)); const float scl = cm.scl(n0 + (lane & 31));
#pragma unroll 8
    for (int i = 0; i < 32; ++i) { const int kk = 2 * i + (lane >> 5); scr[kk * 33 + (lane & 31)] = sc >= 0 ? W[(size_t)(k0 + kk) * ldw + sc] * scl : 0.f; }
    LDS_WAIT();
    const int c = lane & 7;
#pragma unroll
    for (int j = 0; j < 4; ++j) { const int n = (lane >> 3) + 8 * j; const LAS float* s = scr + (8 * c) * 33 + n;
        v4u o; o.x = pk2(s[0 * 33], s[1 * 33]); o.y = pk2(s[2 * 33], s[3 * 33]); o.z = pk2(s[4 * 33], s[5 * 33]); o.w = pk2(s[6 * 33], s[7 * 33]);
        *(v4u*)(WT + (size_t)(n0 + n) * K + k0 + 8 * c) = o; }
    LDS_WAIT();
}
struct CmId { __device__ __forceinline__ int col(int n) const { return n; } __device__ __forceinline__ float scl(int) const { return 1.f; } };
struct CmIn {
    __device__ __forceinline__ int col(int n) const { return n < 2048 ? n : (n < 3328 ? n + 8 : (n < 3336 ? n - 1280 : (n < 3360 ? n : -1))); }
    __device__ __forceinline__ float scl(int n) const { return (n >= 512 && n < 1024) ? 0.08838834764831845f : ((n >= 2048 && n < 2560) ? 0.18033688011112042f : 1.f); }
};

__device__ __forceinline__ int rel_bucket_dev(int n) {
    if (n < 16) return n;
    const float nf = (float)n;
    int large = 16 + (int)(__logf(nf / 16.f) / 2.0794415416798357f * 16.f);
    return large < 31 ? large : 31;
}

__device__ __forceinline__ void phase_p0a(CArgs& A, LAS unsigned char* lds, int gw, int NGW, int lane, int wave) {
    unsigned char* ws = A.ws;
    LAS float* scr = (LAS float*)(lds + wave * 16384);
    constexpr int I_IN = 16 * 112, I_OUT = 16 * 32, I_UP = 16 * 128, I_DN = 64 * 32, I_W1 = 32 * 8;
    constexpr int I_L = I_IN + I_OUT + I_UP + I_DN + 2 * I_W1;
    for (int it = gw; it < DEPTH * I_L; it += NGW) {
        const int l = it / I_L; int r = it % I_L;
        if (r < I_IN) { transpose_item(A.w_in + (size_t)l * D * 3360, 3360, D, (bf16*)(ws + WS_WIN) + (size_t)l * NINP * D, scr, r, 112, lane, CmIn{}); continue; } r -= I_IN;
        if (r < I_OUT) { transpose_item(A.w_out + (size_t)l * D * D, D, D, (bf16*)(ws + WS_WOUT) + (size_t)l * D * D, scr, r, 32, lane, CmId{}); continue; } r -= I_OUT;
        if (r < I_UP) { transpose_item(A.w_up + (size_t)l * D * FF, FF, D, (bf16*)(ws + WS_WUP) + (size_t)l * FF * D, scr, r, 128, lane, CmId{}); continue; } r -= I_UP;
        if (r < I_DN) { transpose_item(A.w_down + (size_t)l * FF * D, D, FF, (bf16*)(ws + WS_WDN) + (size_t)l * D * FF, scr, r, 32, lane, CmId{}); continue; } r -= I_DN;
        const int s = r / I_W1; r %= I_W1;
        transpose_item(A.cmp_w1 + (size_t)(l * 2 + s) * 2048 * 256, 256, 2048, (bf16*)(ws + WS_W1) + (size_t)(l * 2 + s) * 256 * 2048, scr, r, 8, lane, CmId{});
    }
    for (int it = gw; it < DEPTH * DB * NPG * 2; it += NGW) {
        const int half = it & 1, pg = (it >> 1) & 15, seq = (it >> 5) & 127, l = it >> 12;
        const int phys = A.page_table[seq * NPG + pg];
        const float* src = A.cache_cmp + (((size_t)l * NPHYS + phys) * PAGE + half * 64) * 256 + 4 * lane;
        const int cc = 4 * lane, s = cc >> 7, g = (cc >> 6) & 1, d = cc & 63;
        bf16* dst = (bf16*)(ws + WS_XC) + ((size_t)((l * 2 + s) * 2 + g) * XCP + MP + seq * PAST + pg * PAGE + half * 64) * 64 + d;
#pragma unroll 8
        for (int sl = 0; sl < 64; ++sl) { const f32x4 v = *(const f32x4*)(src + (size_t)sl * 256); v2u w; w.x = pk2(v[0], v[1]); w.y = pk2(v[2], v[3]); *(v2u*)(dst + (size_t)sl * 64) = w; }
    }
    for (int it = gw; it < DEPTH * DB * 8; it += NGW) {
        const int ch = it & 7, ls = it >> 3;
        const float* src = A.cache_win + ((size_t)ls * 512 + 4 + ch * 64) * 256 + 4 * lane;
        float* dst = A.out + O_WINS + ((size_t)ls * 512 + ch * 64) * 256 + 4 * lane;
        const int n = ch == 7 ? 60 : 64;
        for (int i = 0; i < n; ++i) *(f32x4*)(dst + (size_t)i * 256) = *(const f32x4*)(src + (size_t)i * 256);
    }
    for (int it = gw; it < 8; it += NGW) {
        float* BT = (float*)(ws + WS_BT) + it * 132;
        for (int dd = lane; dd < 129; dd += 64) BT[dd] = A.rel_bias[rel_bucket_dev(dd) * 8 + it] * 1.4426950408889634f;
    }
    for (int it = gw; it < DEPTH * 2 * 4 * 16; it += NGW) {
        const int kp = it & 15, hq = (it >> 4) & 3, ls = it >> 6, h = hq * 64 + lane;
        const float* pe = A.cmp_pe + (size_t)ls * 2048 + kp * 128; const float* w1 = A.cmp_w1 + ((size_t)ls * 2048 + kp * 128) * 256 + h;
        float acc = 0.f;
#pragma unroll 16
        for (int k = 0; k < 128; ++k) acc += pe[k] * w1[(size_t)k * 256];
        ((float*)(ws + WS_B1))[2048 + (ls * 16 + kp) * 256 + h] = acc;
    }
    for (int it = gw; it < DEPTH * 2 * 64; it += NGW) {
        const int d = it & 63, ls = it >> 6;
        for (int h = lane; h < 256; h += 64) ((bf16*)(ws + WS_W2T))[((size_t)ls * 64 + d) * 256 + h] = (bf16)f2bf(A.cmp_w2[((size_t)ls * 256 + h) * 64 + d]);
    }
}

__device__ __forceinline__ void phase_ada(CArgs& A, LAS unsigned char* lds, int tid) {
    for (int i = blockIdx.x * NTHR + tid; i < DEPTH * 2 * 256; i += gridDim.x * NTHR) { const float* p = (const float*)(A.ws + WS_B1) + 2048 + (i >> 8) * 16 * 256 + (i & 255);
        float acc = 0.f;
#pragma unroll
        for (int kp = 0; kp < 16; ++kp) acc += p[kp * 256];
        ((float*)(A.ws + WS_B1))[i] = acc; }
    LAS float* a = (LAS float*)lds;
    for (int task = blockIdx.x; task < DEPTH * 12 * 10; task += gridDim.x) {
        const int rb = task % 10, cb = (task / 10) % 12, l = task / 120;
        __syncthreads();
        for (int i = tid; i < 13 * 1024; i += NTHR) { const int row = rb * 13 + i / 1024, k = i & 1023;
            const float c = row < BATCH ? A.c_prompt[row * D + k] : A.c_sample[(row - BATCH) * D + k]; a[i] = c / (1.f + __expf(-c)); }
        __syncthreads();
        const int j = cb * 512 + tid;
        const float* w = A.w_ada + (size_t)l * D * 6144 + j;
        float acc[13];
#pragma unroll
        for (int r = 0; r < 13; ++r) acc[r] = 0.f;
        for (int k = 0; k < D; k += 4) { const float w0 = w[(size_t)k * 6144], w1 = w[(size_t)(k + 1) * 6144], w2 = w[(size_t)(k + 2) * 6144], w3 = w[(size_t)(k + 3) * 6144];
#pragma unroll
            for (int r = 0; r < 13; ++r) { const f32x4 a4 = *(const LAS f32x4*)(a + r * 1024 + k); acc[r] += (a4[0] * w0 + a4[1] * w1) + (a4[2] * w2 + a4[3] * w3); } }
        const float bb = A.b_ada[l * 6144 + j];
        float* o = (float*)(A.ws + WS_ADA) + ((size_t)l * NCOND + rb * 13) * 6144 + j;
#pragma unroll
        for (int r = 0; r < 13; ++r) o[(size_t)r * 6144] = acc[r] + bb;
    }
}

__device__ __forceinline__ void mod_row(const float* xrow, const float* sh, const float* sc, bf16* urow, int lane) {
#pragma unroll
    for (int j = 0; j < 4; ++j) { const int c = 4 * lane + 256 * j;
        const f32x4 x = *(const f32x4*)(xrow + c), a = *(const f32x4*)(sh + c), b = *(const f32x4*)(sc + c);
        v2u w; w.x = pk2(x[0] * (1.f + b[0]) + a[0], x[1] * (1.f + b[1]) + a[1]); w.y = pk2(x[2] * (1.f + b[2]) + a[2], x[3] * (1.f + b[3]) + a[3]);
        *(v2u*)(urow + c) = w; }
}
__device__ __forceinline__ void ln_row(const float* zrow, const float* g, const float* b, float* xout, const float* sh, const float* sc, bf16* urow, int lane) {
    f32x4 v[4]; float s = 0.f;
#pragma unroll
    for (int j = 0; j < 4; ++j) { v[j] = *(const f32x4*)(zrow + 4 * lane + 256 * j); s += (v[j][0] + v[j][1]) + (v[j][2] + v[j][3]); }
    const float mean = wave_sum(s) * (1.f / D); float s2 = 0.f;
#pragma unroll
    for (int j = 0; j < 4; ++j) { v[j] = v[j] - mean; s2 += (v[j][0] * v[j][0] + v[j][1] * v[j][1]) + (v[j][2] * v[j][2] + v[j][3] * v[j][3]); }
    const float rstd = 1.f / sqrtf(wave_sum(s2) * (1.f / D) + LN_EPS);
#pragma unroll
    for (int j = 0; j < 4; ++j) { const int c = 4 * lane + 256 * j;
        const f32x4 gg = *(const f32x4*)(g + c), bb = *(const f32x4*)(b + c);
        const f32x4 x = v[j] * rstd * gg + bb;
        *(f32x4*)(xout + c) = x;
        if (urow) { const f32x4 a = *(const f32x4*)(sh + c), q = *(const f32x4*)(sc + c);
            v2u w; w.x = pk2(x[0] * (1.f + q[0]) + a[0], x[1] * (1.f + q[1]) + a[1]); w.y = pk2(x[2] * (1.f + q[2]) + a[2], x[3] * (1.f + q[3]) + a[3]);
            *(v2u*)(urow + c) = w; } }
}

__device__ __forceinline__ float scan_sum256(float v, LAS float* buf, int tid) {
    const int lane = tid & 63, w = tid >> 6;
#pragma unroll
    for (int o = 1; o < 64; o <<= 1) { const float y = __shfl_up(v, o); if (lane >= o) v += y; }
    __syncthreads();
    if (lane == 63) buf[w] = v;
    __syncthreads();
    float add = 0.f;
#pragma unroll
    for (int i = 0; i < 3; ++i) if (i < w) add += buf[i];
    return v + add;
}
__device__ __forceinline__ float scan_max256(float v, LAS float* buf, int tid) {
    const int lane = tid & 63, w = tid >> 6;
#pragma unroll
    for (int o = 1; o < 64; o <<= 1) { const float y = __shfl_up(v, o); if (lane >= o) v = fmaxf(v, y); }
    __syncthreads();
    if (lane == 63) buf[w] = v;
    __syncthreads();
#pragma unroll
    for (int i = 0; i < 3; ++i) if (i < w) v = fmaxf(v, buf[i]);
    return v;
}
__device__ __forceinline__ void ml_gates(CArgs& A, int l, int r, int h, float& ig, float& lf) {
    const float* G = (const float*)(A.ws + WS_GATE) + (size_t)r * 32;
    ig = G[h] + A.b_gate[l * 8 + h];
    const float fr = G[4 + h] + A.b_gate[l * 8 + 4 + h];
    lf = fminf(fr, 0.f) - log1pf(__expf(-fabsf(fr)));
}

__device__ __forceinline__ void phase_m2(CArgs& A, int l, LAS unsigned char* lds, int tid) {
    LAS float* buf = (LAS float*)lds;
    LAS float* wl = (LAS float*)(lds + 1024);
    const bf16* QKVO = (const bf16*)(A.ws + WS_QKVO);
    for (int unit = blockIdx.x; unit < NUNIT; unit += gridDim.x) {
        const int b = unit >> 7, h = (unit >> 5) & 3, c = unit & 31, r0 = b * SEQ + c * LCH;
        float ig = 0.f, lf = 0.f;
        if (tid < 256) ml_gates(A, l, r0 + tid, h, ig, lf);
        const float F = scan_sum256(lf, buf, tid);
        __syncthreads();
        if (tid == 255) buf[16] = F;
        __syncthreads();
        const float Fend = buf[16];
        const float gl = tid < 256 ? Fend - F + ig : -3.0e38f;
        float mw = wave_max(gl);
        if ((tid & 63) == 0) buf[20 + (tid >> 6)] = mw;
        __syncthreads();
        const float mloc = fmaxf(fmaxf(buf[20], buf[21]), fmaxf(buf[22], buf[23]));
        if (tid < 256) wl[tid] = __expf(gl - mloc);
        if (tid == 0) { float* ch = (float*)(A.ws + WS_CHS) + unit * 4; ch[0] = Fend; ch[1] = mloc; }
        __syncthreads();
        const int k = tid & 127, vq = tid >> 7;
        float acc[32]; float accn = 0.f;
#pragma unroll
        for (int i = 0; i < 32; ++i) acc[i] = 0.f;
        const bf16* kp = QKVO + (size_t)r0 * 2048 + 512 + h * HD + k;
        const bf16* vp = QKVO + (size_t)r0 * 2048 + 1024 + h * HD + 32 * vq;
        for (int s = 0; s < LCH; ++s) {
            const float wk = wl[s] * bf2f(kp[(size_t)s * 2048]);
            accn += wk;
            const v4u* v4 = (const v4u*)(vp + (size_t)s * 2048);
#pragma unroll
            for (int q = 0; q < 4; ++q) { const v4u vv = v4[q];
                acc[8 * q + 0] += wk * bflo(vv.x); acc[8 * q + 1] += wk * bfhi(vv.x); acc[8 * q + 2] += wk * bflo(vv.y); acc[8 * q + 3] += wk * bfhi(vv.y);
                acc[8 * q + 4] += wk * bflo(vv.z); acc[8 * q + 5] += wk * bfhi(vv.z); acc[8 * q + 6] += wk * bflo(vv.w); acc[8 * q + 7] += wk * bfhi(vv.w); }
        }
        float* dct = (float*)(A.ws + WS_DCT) + ((size_t)unit * HD + 32 * vq) * HD + k;
#pragma unroll
        for (int i = 0; i < 32; ++i) dct[(size_t)i * HD] = acc[i];
        if (vq == 0) ((float*)(A.ws + WS_DN))[unit * HD + k] = accn;
        __syncthreads();
    }
}

__device__ __forceinline__ void phase_m3(CArgs& A, int l, int tid) {
    for (int task = blockIdx.x; task < BATCH * NH * 33; task += gridDim.x) {
        const int bh = task / 33, part = task % 33;
        const bool isn = part == 32; if (isn && tid >= HD) continue;
        const int e = isn ? tid : part * 512 + tid;
        const float* chs = (const float*)(A.ws + WS_CHS) + (size_t)bh * NCH * 4;
        float st = 0.f, m0 = 0.f;
        for (int c = 0; c < NCH; ++c) {
            const int unit = bh * NCH + c;
            const float Fend = chs[c * 4], mloc = chs[c * 4 + 1];
            float dv;
            if (isn) { ((float*)(A.ws + WS_NPV))[unit * HD + e] = st; dv = ((const float*)(A.ws + WS_DN))[unit * HD + e]; if (tid == 0) ((float*)(A.ws + WS_CHS))[unit * 4 + 2] = m0; }
            else { ((bf16*)(A.ws + WS_CTP))[(size_t)unit * HD * HD + e] = (bf16)f2bf(st); dv = ((const float*)(A.ws + WS_DCT))[(size_t)unit * HD * HD + e]; }
            const float mend = fmaxf(m0 + Fend, mloc);
            st = __expf(m0 + Fend - mend) * st + __expf(mloc - mend) * dv;
            m0 = mend;
        }
        if (isn) { A.out[O_NP + ((size_t)l * BATCH * NH + bh) * HD + e] = st; if (tid == 0) A.out[O_MP + l * BATCH * NH + bh] = m0; }
        else { const int v = e >> 7, k = e & 127; A.out[O_CP + (((size_t)l * BATCH * NH + bh) * HD + k) * HD + v] = st; }
    }
}

__device__ __forceinline__ void phase_m4(CArgs& A, int l, LAS unsigned char* lds, int tid) {
    LAS float* buf = (LAS float*)lds;
    LAS float* sa = (LAS float*)(lds + 1024);
    LAS float* smx = sa + 256;
    LAS float* sdec = smx + 256;
    LAS float* sem = sdec + 256;
    LAS bf16* sv = (LAS bf16*)(lds + 8192);
    const bf16* QKVO = (const bf16*)(A.ws + WS_QKVO);
    const int lane = tid & 63, wave = tid >> 6;
    for (int unit = blockIdx.x; unit < NUNIT; unit += gridDim.x) {
        const int b = unit >> 7, h = (unit >> 5) & 3, c = unit & 31, r0 = b * SEQ + c * LCH;
        float ig = 0.f, lf = 0.f;
        if (tid < 256) ml_gates(A, l, r0 + tid, h, ig, lf);
        const float F = scan_sum256(lf, buf, tid);
        const float a = tid < 256 ? ig - F : -3.0e38f;
        const float cm = scan_max256(a, buf, tid);
        const float m0 = ((const float*)(A.ws + WS_CHS))[unit * 4 + 2];
        if (tid < 256) { const float mx = fmaxf(m0, cm); sa[tid] = a; smx[tid] = mx; sdec[tid] = __expf(m0 - mx); sem[tid] = __expf(-(F + mx)); }
        for (int i = tid; i < LCH * HD / 8; i += NTHR) { const int s = i >> 4, q = i & 15;
            *(LAS v4u*)(sv + s * HD + 8 * q) = *(const v4u*)(QKVO + (size_t)(r0 + s) * 2048 + 1024 + h * HD + 8 * q); }
        __syncthreads();
        float* W = (float*)(A.ws + WS_WSC) + (size_t)unit * LCH * LCH;
        for (int idx = tid; idx < LCH * LCH; idx += NTHR) {
            const int t = idx >> 8, s = idx & 255; float w = 0.f;
            if (s <= t) {
                const v4u* qp = (const v4u*)(QKVO + (size_t)(r0 + t) * 2048 + h * HD); const v4u* kp = (const v4u*)(QKVO + (size_t)(r0 + s) * 2048 + 512 + h * HD);
                float d = 0.f;
#pragma unroll 4
                for (int q = 0; q < 16; ++q) { const v4u x = qp[q], y = kp[q];
                    d += bflo(x.x) * bflo(y.x) + bfhi(x.x) * bfhi(y.x) + bflo(x.y) * bflo(y.y) + bfhi(x.y) * bfhi(y.y)
                       + bflo(x.z) * bflo(y.z) + bfhi(x.z) * bfhi(y.z) + bflo(x.w) * bflo(y.w) + bfhi(x.w) * bfhi(y.w); }
                w = d * __expf(sa[s] - smx[t]);
            }
            W[idx] = w;
        }
        __syncthreads();
        {
            const int v = tid & 127, tq = tid >> 7;
            const bf16* ctp = (const bf16*)(A.ws + WS_CTP) + ((size_t)unit * HD + v) * HD;
            const float* npv = (const float*)(A.ws + WS_NPV) + unit * HD;
            float* hraw = (float*)(A.ws + WS_HRAW) + (size_t)unit * LCH * HD;
            for (int i = 0; i < 64; ++i) {
                const int t = 4 * i + tq;
                float num = 0.f, den = 0.f;
                const float* wr = W + (size_t)t * LCH;
                for (int s = 0; s <= t; s += 4) { const f32x4 w4 = *(const f32x4*)(wr + s);
                    num += w4[0] * bf2f(sv[(s + 0) * HD + v]) + w4[1] * bf2f(sv[(s + 1) * HD + v]) + w4[2] * bf2f(sv[(s + 2) * HD + v]) + w4[3] * bf2f(sv[(s + 3) * HD + v]);
                    den += (w4[0] + w4[1]) + (w4[2] + w4[3]); }
                float qc = 0.f, qn = 0.f;
                const v4u* qp = (const v4u*)(QKVO + (size_t)(r0 + t) * 2048 + h * HD);
#pragma unroll 4
                for (int q = 0; q < 16; ++q) { const v4u x = qp[q], y = *(const v4u*)(ctp + 8 * q); const f32x4 n0 = *(const f32x4*)(npv + 8 * q), n1 = *(const f32x4*)(npv + 8 * q + 4);
                    qc += bflo(x.x) * bflo(y.x) + bfhi(x.x) * bfhi(y.x) + bflo(x.y) * bflo(y.y) + bfhi(x.y) * bfhi(y.y)
                        + bflo(x.z) * bflo(y.z) + bfhi(x.z) * bfhi(y.z) + bflo(x.w) * bflo(y.w) + bfhi(x.w) * bfhi(y.w);
                    qn += bflo(x.x) * n0[0] + bfhi(x.x) * n0[1] + bflo(x.y) * n0[2] + bfhi(x.y) * n0[3] + bflo(x.z) * n1[0] + bfhi(x.z) * n1[1] + bflo(x.w) * n1[2] + bfhi(x.w) * n1[3]; }
                const float dec = sdec[t];
                const float numt = num + dec * qc, dent = den + dec * qn;
                hraw[(size_t)t * HD + v] = numt / fmaxf(fabsf(dent), sem[t]);
            }
        }
        __syncthreads();
        {
            const float* hraw = (const float*)(A.ws + WS_HRAW) + (size_t)unit * LCH * HD;
            const float g0 = A.ml_norm_g[l * 512 + h * HD + lane], g1 = A.ml_norm_g[l * 512 + h * HD + 64 + lane];
            for (int t = wave; t < LCH; t += NWAVES) {
                const float x0 = hraw[(size_t)t * HD + lane], x1 = hraw[(size_t)t * HD + 64 + lane];
                const float mu = wave_sum(x0 + x1) * (1.f / HD);
                const float d0 = x0 - mu, d1 = x1 - mu;
                const float rstd = 1.f / sqrtf(wave_sum(d0 * d0 + d1 * d1) * (1.f / HD) + LN_EPS);
                const bf16* op = QKVO + (size_t)(r0 + t) * 2048 + 1536 + h * HD;
                bf16* mp = (bf16*)(A.ws + WS_MIX) + (size_t)(r0 + t) * D + h * HD;
                mp[lane] = (bf16)f2bf(d0 * rstd * g0 * sigmoidf_(bf2f(op[lane])));
                mp[64 + lane] = (bf16)f2bf(d1 * rstd * g1 * sigmoidf_(bf2f(op[64 + lane])));
            }
        }
        __syncthreads();
    }
}

__device__ __forceinline__ void phase_mls(CArgs& A, int l, LAS unsigned char* lds, int tid) {
    LAS float* sq = (LAS float*)lds;
    LAS float* sc = sq + 1536;
    LAS float* sw = sc + 64;
    LAS float* part = sw + 16;
    LAS float* red = part + 2048;
    const bf16* QKVO = (const bf16*)(A.ws + WS_QKVO);
    for (int task = blockIdx.x; task < DB * NH; task += gridDim.x) {
        const int seq = task >> 2, h = task & 3, r0 = MP + seq * DS, sidx = (l * DB + seq) * NH + h;
        __syncthreads();
        for (int i = tid; i < 1536; i += NTHR) { const int which = i >> 9, t = (i >> 7) & 3, d = i & 127; sq[i] = bf2f(QKVO[(size_t)(r0 + t) * 2048 + which * 512 + h * HD + d]); }
        const float m0 = A.st_m[sidx];
        if (tid == 0) {
            float F = 0.f, cmx = -3.0e38f, Fs[4], igs[4], mlast = 0.f;
#pragma unroll
            for (int t = 0; t < 4; ++t) { float ig, lf; ml_gates(A, l, r0 + t, h, ig, lf); F += lf; Fs[t] = F; igs[t] = ig; const float a = ig - F; cmx = fmaxf(cmx, a); const float mx = fmaxf(m0, cmx);
                sc[8 + t] = a; sc[12 + t] = mx; sc[16 + t] = __expf(m0 - mx); sc[20 + t] = __expf(-(F + mx)); mlast = F + mx; }
#pragma unroll
            for (int t = 0; t < 4; ++t) sc[24 + t] = __expf(Fs[3] - Fs[t] + igs[t] - mlast);
            sc[28] = __expf(Fs[3] + m0 - mlast); sc[29] = mlast;
        }
        __syncthreads();
        if (tid < 16) { const int t = tid >> 2, s = tid & 3; float w = 0.f;
            if (s <= t) { float d = 0.f; for (int k = 0; k < HD; ++k) d += sq[t * HD + k] * sq[512 + s * HD + k]; w = d * __expf(sc[8 + s] - sc[12 + t]); }
            sw[tid] = w; }
        else if (tid < 20) { const int t = tid - 16; const float* n0 = A.st_n + (size_t)sidx * HD; float d = 0.f; for (int k = 0; k < HD; ++k) d += sq[t * HD + k] * n0[k]; sc[32 + t] = d; }
        __syncthreads();
        {
            const int v = tid & 127, kq = tid >> 7;
            const float* C0 = A.st_C + (size_t)sidx * HD * HD; float* Co = A.out + O_CS + (size_t)sidx * HD * HD;
            const float cd = sc[28];
            float wv[4]; float qc[4] = {0.f, 0.f, 0.f, 0.f};
#pragma unroll
            for (int t = 0; t < 4; ++t) wv[t] = sc[24 + t] * sq[1024 + t * HD + v];
            for (int kk = 0; kk < 32; ++kk) { const int k = kq * 32 + kk; const float c0 = C0[(size_t)k * HD + v];
                float cn = cd * c0;
#pragma unroll
                for (int t = 0; t < 4; ++t) { qc[t] += sq[t * HD + k] * c0; cn += wv[t] * sq[512 + t * HD + k]; }
                Co[(size_t)k * HD + v] = cn; }
#pragma unroll
            for (int t = 0; t < 4; ++t) part[(kq * 4 + t) * HD + v] = qc[t];
        }
        __syncthreads();
        float hv[4] = {0.f, 0.f, 0.f, 0.f};
        if (tid < HD) {
            const int v = tid;
#pragma unroll
            for (int t = 0; t < 4; ++t) { const float qct = part[(0 * 4 + t) * HD + v] + part[(1 * 4 + t) * HD + v] + part[(2 * 4 + t) * HD + v] + part[(3 * 4 + t) * HD + v];
                float num = sc[16 + t] * qct, den = sc[16 + t] * sc[32 + t];
#pragma unroll
                for (int s = 0; s < 4; ++s) { num += sw[t * 4 + s] * sq[1024 + s * HD + v]; den += sw[t * 4 + s]; }
                hv[t] = num / fmaxf(fabsf(den), sc[20 + t]); }
        }
#pragma unroll
        for (int t = 0; t < 4; ++t) { const float s1 = wave_sum(hv[t]); if ((tid & 63) == 0 && tid < HD) red[t * 2 + (tid >> 6)] = s1; }
        __syncthreads();
        float dv[4];
#pragma unroll
        for (int t = 0; t < 4; ++t) { dv[t] = hv[t] - (red[t * 2] + red[t * 2 + 1]) * (1.f / HD); const float s2 = wave_sum(dv[t] * dv[t]); if ((tid & 63) == 0 && tid < HD) red[8 + t * 2 + (tid >> 6)] = s2; }
        __syncthreads();
        if (tid < HD) {
            const int v = tid; const float gn = A.ml_norm_g[l * 512 + h * HD + v];
#pragma unroll
            for (int t = 0; t < 4; ++t) { const float rstd = 1.f / sqrtf((red[8 + t * 2] + red[8 + t * 2 + 1]) * (1.f / HD) + LN_EPS);
                const float og = bf2f(QKVO[(size_t)(r0 + t) * 2048 + 1536 + h * HD + v]);
                ((bf16*)(A.ws + WS_MIX))[(size_t)(r0 + t) * D + h * HD + v] = (bf16)f2bf(dv[t] * rstd * gn * sigmoidf_(og)); }
        } else if (tid < 2 * HD) {
            const int k = tid - HD; float nn = sc[28] * A.st_n[(size_t)sidx * HD + k];
#pragma unroll
            for (int t = 0; t < 4; ++t) nn += sc[24 + t] * sq[512 + t * HD + k];
            A.out[O_NS + (size_t)sidx * HD + k] = nn;
        }
        if (tid == 0) A.out[O_MS + sidx] = sc[29];
    }
}

typedef short bf16x8c __attribute__((ext_vector_type(8)));
__device__ __forceinline__ void phase_cmp2(CArgs& A, int l0, int nl, int r_lo, int nrows, int gw, int NGW, int lane) {
    const int fr = lane & 15, fq = lane >> 4, ntile = nrows / 16;
    for (int task = gw; task < nl * 4 * ntile; task += NGW) {
        const int img = task / ntile, tr = task % ntile, l = l0 + (img >> 2), sg = img & 3, s = sg >> 1, g = sg & 1, R0 = r_lo + tr * 16;
        const bf16* hp = (const bf16*)(A.ws + WS_HID) + ((size_t)(l * 4 + sg) * NCB + R0 + fr) * 256 + 8 * fq;
        const bf16* wp = (const bf16*)(A.ws + WS_W2T) + ((size_t)(l * 2 + s) * 64 + fr) * 256 + 8 * fq;
        f32x4 acc[4];
#pragma unroll
        for (int dt = 0; dt < 4; ++dt) acc[dt] = (f32x4){0.f, 0.f, 0.f, 0.f};
#pragma unroll
        for (int ks = 0; ks < 8; ++ks) {
            const bf16x8c hf = *(const bf16x8c*)(hp + 32 * ks);
#pragma unroll
            for (int dt = 0; dt < 4; ++dt) { const bf16x8c wf = *(const bf16x8c*)(wp + (size_t)dt * 16 * 256 + 32 * ks);
                acc[dt] = s == 0 ? __builtin_amdgcn_mfma_f32_16x16x32_bf16(wf, hf, acc[dt], 0, 0, 0) : __builtin_amdgcn_mfma_f32_16x16x32_bf16(hf, wf, acc[dt], 0, 0, 0); }
        }
        if (s == 0) {
            bf16* o = (bf16*)(A.ws + WS_KC) + ((size_t)(l * 2 + g) * NCB + R0 + fr) * 64 + 4 * fq;
#pragma unroll
            for (int dt = 0; dt < 4; ++dt) { v2u w; w.x = pk2(acc[dt][0], acc[dt][1]); w.y = pk2(acc[dt][2], acc[dt][3]); *(v2u*)(o + 16 * dt) = w; }
        } else {
            bf16* o = (bf16*)(A.ws + WS_VCT) + ((size_t)(l * 2 + g) * 64 + fr) * NCB + R0 + 4 * fq;
#pragma unroll
            for (int dt = 0; dt < 4; ++dt) { v2u w; w.x = pk2(acc[dt][0], acc[dt][1]); w.y = pk2(acc[dt][2], acc[dt][3]); *(v2u*)(o + (size_t)dt * 16 * NCB) = w; }
        }
    }
}

__device__ __forceinline__ void topk_sel(float imp0, float imp1, int cur, int lane, unsigned long long& s0, unsigned long long& s1) {
    const int nforced = cur == 0 ? 1 : (cur == 1 ? 2 : 3), need = 16 - nforced, ncand = cur - 2 > 0 ? cur - 2 : 0;
    const unsigned k0 = (lane >= 1 && lane <= cur - 2) ? __builtin_bit_cast(unsigned, imp0) + 1u : 0u;
    const unsigned k1 = (lane + 64 <= cur - 2) ? __builtin_bit_cast(unsigned, imp1) + 1u : 0u;
    unsigned long long c0, c1;
    if (ncand <= need) { c0 = __ballot(k0 != 0u); c1 = __ballot(k1 != 0u); }
    else {
        unsigned T = 0u;
        for (int bit = 31; bit >= 0; --bit) { const unsigned cand = T | (1u << bit);
            const int cnt = __popcll(__ballot(k0 >= cand)) + __popcll(__ballot(k1 >= cand)); if (cnt >= need) T = cand; }
        const unsigned long long g0 = __ballot(k0 > T), g1 = __ballot(k1 > T); unsigned long long e0 = __ballot(k0 == T), e1 = __ballot(k1 == T);
        int rem = need - __popcll(g0) - __popcll(g1);
        unsigned long long t0 = 0ull, t1 = 0ull;
        while (rem > 0 && e0) { const unsigned long long lb = e0 & (~e0 + 1ull); t0 |= lb; e0 ^= lb; --rem; }
        while (rem > 0 && e1) { const unsigned long long lb = e1 & (~e1 + 1ull); t1 |= lb; e1 ^= lb; --rem; }
        c0 = g0 | t0; c1 = g1 | t1;
    }
    unsigned long long f0 = 1ull, f1 = 0ull;
    if (cur < 64) f0 |= 1ull << cur; else f1 |= 1ull << (cur - 64);
    if (cur >= 1) { if (cur - 1 < 64) f0 |= 1ull << (cur - 1); else f1 |= 1ull << (cur - 65); }
    s0 = c0 | f0; s1 = c1 | f1;
}


typedef short bf16x8 __attribute__((ext_vector_type(8)));
#define MFMA16(a, b, c) __builtin_amdgcn_mfma_f32_16x16x32_bf16((a), (b), (c), 0, 0, 0)
constexpr int TOTS = MP + DB * 2112, TOTW = MP + DB * 528, TOTWP = TOTW + 64;
constexpr size_t KS_L = (size_t)2 * TOTS * 64, KW_L = (size_t)2 * TOTWP * 64, KC_L = (size_t)2 * NCB * 64;

__device__ __forceinline__ void kv_tile64(const float* src, bf16* Kimg, size_t kgs, bf16* Vt, size_t vgs, size_t vpitch, size_t gp0, LAS bf16* scr, int lane) {
    const int cc = 4 * lane, s = cc >> 7, g = (cc >> 6) & 1, d = cc & 63;
#pragma unroll 8
    for (int sl = 0; sl < 64; ++sl) {
        const f32x4 v = *(const f32x4*)(src + (size_t)sl * 256 + cc);
        v2u w; w.x = pk2(v[0], v[1]); w.y = pk2(v[2], v[3]);
        if (s == 0) *(v2u*)(Kimg + (size_t)g * kgs + (gp0 + sl) * 64 + d) = w;
        else *(LAS v2u*)(scr + sl * 128 + (cc - 128)) = w;
    }
    LDS_WAIT();
#pragma unroll
    for (int g2 = 0; g2 < 2; ++g2) {
        const int gd = lane + 64 * g2;
        bf16* dst = Vt + (size_t)g2 * vgs + (size_t)lane * vpitch + gp0;
#pragma unroll
        for (int oc = 0; oc < 8; ++oc) {
            const LAS bf16* p = scr + (8 * oc) * 128 + gd;
            v4u o; o.x = (unsigned)p[0] | ((unsigned)p[128] << 16); o.y = (unsigned)p[256] | ((unsigned)p[384] << 16); o.z = (unsigned)p[512] | ((unsigned)p[640] << 16); o.w = (unsigned)p[768] | ((unsigned)p[896] << 16);
            *(v4u*)(dst + 8 * oc) = o;
        }
    }
    LDS_WAIT();
}

__device__ __forceinline__ void prep_cache_images(CArgs& A, LAS unsigned char* lds, int gw, int NGW, int lane, int wave) {
    LAS bf16* scr = (LAS bf16*)(lds + wave * 16384);
    bf16* KS = (bf16*)(A.ws + WS_KS); bf16* VTS = (bf16*)(A.ws + WS_VTS); bf16* KW = (bf16*)(A.ws + WS_KW); bf16* VTW = (bf16*)(A.ws + WS_VTW);
    for (int it = gw; it < DEPTH * DB * 32; it += NGW) {
        const int ti = it & 31, seq = (it >> 5) & 127, l = it >> 12;
        const int phys = A.page_table[seq * NPG + (ti >> 1)];
        const float* src = A.cache_slc + (((size_t)l * NPHYS + phys) * PAGE + (ti & 1) * 64) * 256;
        kv_tile64(src, KS + l * KS_L, (size_t)TOTS * 64, VTS + l * KS_L, (size_t)64 * TOTS, TOTS, (size_t)MP + seq * 2112 + ti * 64, scr, lane);
    }
    for (int it = gw; it < DEPTH * DB * 8; it += NGW) {
        const int ti = it & 7, ls = it >> 3, seq = ls & 127, l = ls >> 7;
        const float* src = A.cache_win + ((size_t)ls * 512 + ti * 64) * 256;
        kv_tile64(src, KW + l * KW_L, (size_t)TOTWP * 64, VTW + l * KW_L, (size_t)64 * TOTWP, TOTWP, (size_t)MP + seq * 528 + ti * 64, scr, lane);
    }
}
__device__ __forceinline__ void prep_layer_images(CArgs& A, int l, LAS unsigned char* lds, int gw, int NGW, int lane, int wave) {
    LAS bf16* scr = (LAS bf16*)(lds + wave * 16384);
    bf16* KS = (bf16*)(A.ws + WS_KS) + l * KS_L; bf16* VTS = (bf16*)(A.ws + WS_VTS) + l * KS_L; bf16* KW = (bf16*)(A.ws + WS_KW) + l * KW_L; bf16* VTW = (bf16*)(A.ws + WS_VTW) + l * KW_L;
    const float* KVR = (const float*)(A.ws + WS_KVR);
    for (int it = gw; it < 2 * (MP / 64); it += NGW) {
        const int kind = it / (MP / 64), ti = it % (MP / 64);
        const float* src = KVR + ((size_t)(1 + kind) * M + ti * 64) * 256;
        if (kind == 0) kv_tile64(src, KS, (size_t)TOTS * 64, VTS, (size_t)64 * TOTS, TOTS, (size_t)ti * 64, scr, lane);
        else           kv_tile64(src, KW, (size_t)TOTWP * 64, VTW, (size_t)64 * TOTWP, TOTWP, (size_t)ti * 64, scr, lane);
    }
    for (int it = gw; it < 2 * DB; it += NGW) {
        const int kind = it / DB, seq = it % DB;
        const float* src = KVR + ((size_t)(1 + kind) * M + MP + seq * DS) * 256;
        bf16* Kimg = kind == 0 ? KS : KW; bf16* Vt = kind == 0 ? VTS : VTW;
        const size_t tot = kind == 0 ? TOTS : TOTWP, gp0 = kind == 0 ? (size_t)MP + seq * 2112 + PAST : (size_t)MP + seq * 528 + 512;
        const int cc = 4 * lane, s = cc >> 7, g = (cc >> 6) & 1, d = cc & 63;
#pragma unroll
        for (int t = 0; t < DS; ++t) {
            const f32x4 v = *(const f32x4*)(src + (size_t)t * 256 + cc);
            if (s == 0) { v2u w; w.x = pk2(v[0], v[1]); w.y = pk2(v[2], v[3]); *(v2u*)(Kimg + (size_t)g * tot * 64 + (gp0 + t) * 64 + d) = w; }
            else {
#pragma unroll
                for (int i = 0; i < 4; ++i) Vt[(size_t)g * 64 * tot + (size_t)(d + i) * tot + gp0 + t] = (bf16)f2bf(v[i]);
            }
        }
    }
}

struct KV { bf16x8 k[8]; v4u v[8]; };
__device__ __forceinline__ void k_load(KV& f, const bf16* Kb, int fr, int fq) {
#pragma unroll
    for (int t = 0; t < 4; ++t) { f.k[2 * t] = *(const bf16x8*)(Kb + (size_t)(16 * t + fr) * 64 + 8 * fq); f.k[2 * t + 1] = *(const bf16x8*)(Kb + (size_t)(16 * t + fr) * 64 + 32 + 8 * fq); }
}
__device__ __forceinline__ void v_load(KV& f, const bf16* Vb, size_t pitch, int fr, int fq) {
#pragma unroll
    for (int h = 0; h < 2; ++h)
#pragma unroll
        for (int dt = 0; dt < 4; ++dt) { const bf16* vp = Vb + (size_t)(16 * dt + fr) * pitch + 32 * h + 4 * fq;
            const v2u a = *(const v2u*)vp, b = *(const v2u*)(vp + 16); v4u w; w.x = a.x; w.y = a.y; w.z = b.x; w.w = b.y; f.v[4 * h + dt] = w; }
}
__device__ __forceinline__ void qk_frag(const KV& f, const bf16x8 (&q)[2], f32x4 (&st)[4]) {
#pragma unroll
    for (int t = 0; t < 4; ++t) { f32x4 z = {0.f, 0.f, 0.f, 0.f}; z = MFMA16(f.k[2 * t], q[0], z); st[t] = MFMA16(f.k[2 * t + 1], q[1], z); }
}
__device__ __forceinline__ void pv_frag(const KV& f, const f32x4 (&st)[4], f32x4 (&o)[4]) {
#pragma unroll
    for (int h = 0; h < 2; ++h) {
        v4u pw; pw.x = pk2(st[2 * h][0], st[2 * h][1]); pw.y = pk2(st[2 * h][2], st[2 * h][3]); pw.z = pk2(st[2 * h + 1][0], st[2 * h + 1][1]); pw.w = pk2(st[2 * h + 1][2], st[2 * h + 1][3]);
        const bf16x8 pf = __builtin_bit_cast(bf16x8, pw);
#pragma unroll
        for (int dt = 0; dt < 4; ++dt) o[dt] = MFMA16(__builtin_bit_cast(bf16x8, f.v[4 * h + dt]), pf, o[dt]);
    }
}
__device__ __forceinline__ float xfq_max(float v) { v = fmaxf(v, __shfl_xor(v, 16)); return fmaxf(v, __shfl_xor(v, 32)); }
__device__ __forceinline__ float xfq_sum(float v) { v += __shfl_xor(v, 16); return v + __shfl_xor(v, 32); }
__device__ __forceinline__ float quad_sum(float v) { v += __shfl_xor(v, 1); return v + __shfl_xor(v, 2); }

__device__ __forceinline__ void softmax_pv(const KV& f, f32x4 (&st)[4], f32x4 (&o)[4], float& m, float& ls) {
    float bm = -INFINITY;
#pragma unroll
    for (int t = 0; t < 4; ++t) bm = fmaxf(bm, fmaxf(fmaxf(st[t][0], st[t][1]), fmaxf(st[t][2], st[t][3])));
    bm = xfq_max(bm);
    const float mn = fmaxf(m, bm), sc = __builtin_amdgcn_exp2f(m - mn);
    m = mn; ls *= sc;
#pragma unroll
    for (int dt = 0; dt < 4; ++dt) o[dt] = o[dt] * sc;
#pragma unroll
    for (int t = 0; t < 4; ++t)
#pragma unroll
        for (int i = 0; i < 4; ++i) { const float p = __builtin_amdgcn_exp2f(st[t][i] - mn); st[t][i] = p; ls += p; }
    pv_frag(f, st, o);
}
template <class Br>
__device__ __forceinline__ void run_branch(Br& br, const bf16x8 (&q)[2], int fr, int fq, f32x4 (&o)[4], float& m, float& ls) {
    int j;
    bool has = br.first(j);
    while (has) {
        KV cur; k_load(cur, br.kp(j), fr, fq); v_load(cur, br.vp(j), br.pitch, fr, fq);
        f32x4 st[4]; qk_frag(cur, q, st);
        br.mask(st, j);
        softmax_pv(cur, st, o, m, ls);
        has = br.next(j);
    }
}
struct BrSel {
    const bf16* K; const bf16* V; size_t pitch; unsigned long long u0, u1, my0, my1; int cur, qpos, fq; const LAS float* bt; float farb;
    __device__ __forceinline__ bool pop(int& j) { if (u0) { j = __builtin_ctzll(u0); u0 &= u0 - 1ull; return true; } if (u1) { j = 64 + __builtin_ctzll(u1); u1 &= u1 - 1ull; return true; } return false; }
    __device__ __forceinline__ bool first(int& j) { return pop(j); }
    __device__ __forceinline__ bool next(int& j) { return pop(j); }
    __device__ __forceinline__ const bf16* kp(int j) const { return K + (size_t)j * 64 * 64; }
    __device__ __forceinline__ const bf16* vp(int j) const { return V + (size_t)j * 64; }
    __device__ __forceinline__ void mask(f32x4 (&st)[4], int j) const {
        const bool mine = j < 64 ? ((my0 >> j) & 1ull) != 0ull : ((my1 >> (j - 64)) & 1ull) != 0ull;
        if (j >= cur - 2) {
#pragma unroll
            for (int t = 0; t < 4; ++t)
#pragma unroll
                for (int i = 0; i < 4; ++i) { const int dist = qpos - (64 * j + 16 * t + 4 * fq + i); st[t][i] = (mine && dist >= 0) ? st[t][i] + bt[dist > 128 ? 128 : dist] : -INFINITY; }
        } else {
#pragma unroll
            for (int t = 0; t < 4; ++t)
#pragma unroll
                for (int i = 0; i < 4; ++i) st[t][i] = mine ? st[t][i] + farb : -INFINITY;
        }
    }
};
struct BrWin {
    const bf16* K; const bf16* V; size_t pitch; int jb, cur, qpos, fq; const LAS float* bt;
    __device__ __forceinline__ bool first(int& j) { j = jb; return jb <= cur; }
    __device__ __forceinline__ bool next(int& j) { ++jb; j = jb; return jb <= cur; }
    __device__ __forceinline__ const bf16* kp(int j) const { return K + (long)j * 64 * 64; }
    __device__ __forceinline__ const bf16* vp(int j) const { return V + (long)j * 64; }
    __device__ __forceinline__ void mask(f32x4 (&st)[4], int j) const {
#pragma unroll
        for (int t = 0; t < 4; ++t)
#pragma unroll
            for (int i = 0; i < 4; ++i) { const int dist = qpos - (64 * j + 16 * t + 4 * fq + i); st[t][i] = (dist >= 0 && dist < 512) ? st[t][i] + bt[dist > 128 ? 128 : dist] : -INFINITY; }
    }
};

__device__ __forceinline__ void nsa_tile(CArgs& A, int l, bool smp, int bs, int g, int tq, LAS float* wl, const LAS float* BT, int lane) {
    const int fr = lane & 15, fq = lane >> 4, tl = fr >> 2, rr = fr & 3;
    const int qpos0 = smp ? PAST : 4 * tq, row0 = smp ? MP + bs * DS : bs * SEQ + qpos0;
    const int qpos = qpos0 + tl, cur = qpos0 >> 6, h = g * 4 + rr;
    const size_t sbase = smp ? (size_t)MP + bs * 2112 : (size_t)bs * SEQ;
    const long wbase = smp ? (long)MP + bs * 528 - (PAST - 512) : (long)bs * SEQ;
    const size_t cbase = smp ? (size_t)1024 + bs * 128 : (size_t)bs * 512;
    const bf16* KS = (const bf16*)(A.ws + WS_KS) + l * KS_L + (size_t)g * TOTS * 64; const bf16* VTS = (const bf16*)(A.ws + WS_VTS) + l * KS_L + (size_t)g * 64 * TOTS;
    const bf16* KW = (const bf16*)(A.ws + WS_KW) + l * KW_L + (size_t)g * TOTWP * 64; const bf16* VTW = (const bf16*)(A.ws + WS_VTW) + l * KW_L + (size_t)g * 64 * TOTWP;
    const bf16* KC = (const bf16*)(A.ws + WS_KC) + l * KC_L + (size_t)g * NCB * 64 + cbase * 64; const bf16* VCT = (const bf16*)(A.ws + WS_VCT) + l * KC_L + (size_t)g * 64 * NCB + cbase;
    const LAS float* bt = BT + h * 132;
    const float farb = bt[128];
    bf16x8 q[2];
    {   const bf16* qp = (const bf16*)(A.ws + WS_NQ) + (size_t)(row0 + tl) * 512 + g * 256 + rr * 64 + 8 * fq;
        q[0] = *(const bf16x8*)qp; q[1] = *(const bf16x8*)(qp + 32); }
    const float* gt = (const float*)(A.ws + WS_GATE) + (size_t)(row0 + tl) * 32 + 8 + h * 3;
    const float gc = sigmoidf_(gt[0]), gs = sigmoidf_(gt[1]), gwn = sigmoidf_(gt[2]);
    f32x4 out[4];
#pragma unroll
    for (int dt = 0; dt < 4; ++dt) out[dt] = (f32x4){0.f, 0.f, 0.f, 0.f};
    LAS float* impA = wl;
    LAS float* impB = wl + 544;
    for (int i = lane; i < 1088; i += 64) wl[i] = 0.f;
    LDS_WAIT();

    {
        const int ncv_max = qpos0 + 3 >= 31 ? ((qpos0 + 3 - 31) >> 4) + 1 : 0, nb64 = (ncv_max + 63) >> 6;
        float m = -1.0e30f, ls = 0.f;
        {
            for (int ib = 0; ib < nb64; ++ib) {
                KV cur; k_load(cur, KC + (size_t)ib * 64 * 64, fr, fq);
                f32x4 st[4]; qk_frag(cur, q, st);
                float bm = -INFINITY;
#pragma unroll
                for (int t = 0; t < 4; ++t)
#pragma unroll
                    for (int i = 0; i < 4; ++i) { const int n = 64 * ib + 16 * t + 4 * fq + i; const int dist = qpos - 16 * n - 31;
                        const float s = dist >= 0 ? st[t][i] + bt[dist > 128 ? 128 : dist] : -INFINITY; st[t][i] = s; bm = fmaxf(bm, s); }
                bm = xfq_max(bm);
                const float mn = fmaxf(m, bm); ls *= __builtin_amdgcn_exp2f(m - mn); m = mn;
#pragma unroll
                for (int t = 0; t < 4; ++t)
#pragma unroll
                    for (int i = 0; i < 4; ++i) ls += __builtin_amdgcn_exp2f(st[t][i] - mn);
            }
        }
        ls = xfq_sum(ls);
        const float inv = ls > 0.f ? 1.f / ls : 0.f;
        f32x4 o[4];
#pragma unroll
        for (int dt = 0; dt < 4; ++dt) o[dt] = (f32x4){0.f, 0.f, 0.f, 0.f};
        {
            for (int ib = 0; ib < nb64; ++ib) {
                KV cur; k_load(cur, KC + (size_t)ib * 64 * 64, fr, fq); v_load(cur, VCT + ib * 64, NCB, fr, fq);
                f32x4 st[4]; qk_frag(cur, q, st);
#pragma unroll
                for (int t = 0; t < 4; ++t) {
#pragma unroll
                    for (int i = 0; i < 4; ++i) { const int n = 64 * ib + 16 * t + 4 * fq + i; const int dist = qpos - 16 * n - 31;
                        st[t][i] = dist >= 0 ? __builtin_amdgcn_exp2f(st[t][i] + bt[dist > 128 ? 128 : dist] - m) * inv : 0.f; }
                    const float s4 = quad_sum((st[t][0] + st[t][1]) + (st[t][2] + st[t][3])), s3 = quad_sum(st[t][3]);
                    const int j0 = 16 * ib + 4 * t + fq;
                    if (rr == 0) { impA[tl * 136 + j0] = s4; impB[tl * 136 + j0 + 1] = s3; }
                }
                pv_frag(cur, st, o);
            }
        }
#pragma unroll
        for (int dt = 0; dt < 4; ++dt) out[dt] = out[dt] + o[dt] * gc;
    }
    LDS_WAIT();
    unsigned long long s0[4], s1[4];
#pragma unroll
    for (int t = 0; t < 4; ++t) topk_sel(impA[t * 136 + lane] + impB[t * 136 + lane], impA[t * 136 + 64 + lane] + impB[t * 136 + 64 + lane], cur, lane, s0[t], s1[t]);
    {
        float m = -1.0e30f, ls = 0.f; f32x4 o[4];
#pragma unroll
        for (int dt = 0; dt < 4; ++dt) o[dt] = (f32x4){0.f, 0.f, 0.f, 0.f};
        BrSel br{KS + sbase * 64, VTS + sbase, (size_t)TOTS, (s0[0] | s0[1]) | (s0[2] | s0[3]), (s1[0] | s1[1]) | (s1[2] | s1[3]),
                 tl == 0 ? s0[0] : (tl == 1 ? s0[1] : (tl == 2 ? s0[2] : s0[3])), tl == 0 ? s1[0] : (tl == 1 ? s1[1] : (tl == 2 ? s1[2] : s1[3])), cur, qpos, fq, bt, farb};
        run_branch(br, q, fr, fq, o, m, ls);
        ls = xfq_sum(ls);
        const float w = ls > 0.f ? gs / ls : 0.f;
#pragma unroll
        for (int dt = 0; dt < 4; ++dt) out[dt] = out[dt] + o[dt] * w;
    }
    {
        float m = -1.0e30f, ls = 0.f; f32x4 o[4];
#pragma unroll
        for (int dt = 0; dt < 4; ++dt) o[dt] = (f32x4){0.f, 0.f, 0.f, 0.f};
        const int lo_blk = smp ? (PAST - 512) >> 6 : 0; int jb = (qpos0 - 511) >> 6; if (jb < lo_blk) jb = lo_blk;
        BrWin br{KW + wbase * 64, VTW + wbase, (size_t)TOTWP, jb, cur, qpos, fq, bt};
        run_branch(br, q, fr, fq, o, m, ls);
        ls = xfq_sum(ls);
        const float w = ls > 0.f ? gwn / ls : 0.f;
#pragma unroll
        for (int dt = 0; dt < 4; ++dt) out[dt] = out[dt] + o[dt] * w;
    }
    bf16* mp = (bf16*)(A.ws + WS_MIX) + (size_t)(row0 + tl) * D + 512 + h * 64 + 4 * fq;
#pragma unroll
    for (int dt = 0; dt < 4; ++dt) { v2u w; w.x = pk2(out[dt][0], out[dt][1]); w.y = pk2(out[dt][2], out[dt][3]); *(v2u*)(mp + 16 * dt) = w; }
}
__device__ __forceinline__ void phase_nsa(CArgs& A, int l, LAS float* wl, const LAS float* BT, int lane, int wave) {
    const int G = gridDim.x, bx = blockIdx.x;
    const bool xmap = (G & 7) == 0;
    const int x = bx & 7, nw = (G >> 3) * NWAVES, ww = (bx >> 3) * NWAVES + wave;
    const int gwv = bx * NWAVES + wave, ngw = G * NWAVES;
    for (int it = 0;; ++it) {
        bool smp; int bs, g, tq;
        if (xmap) {
            const int np = ww < 512 ? 2 * ((512 - ww + nw - 1) / nw) : 0;
            if (it < np) { const int i = ww + nw * (it >> 1), tq2 = (it & 1) ? 1023 - i : i; smp = false; bs = x >> 2; g = (x >> 1) & 1; tq = 2 * tq2 + (x & 1); }
            else { const int t = ww * 8 + x + 8 * nw * (it - np); if (t >= 2 * DB) break; smp = true; bs = t >> 1; g = t & 1; tq = 0; }
        } else {
            const int t = gwv + ngw * it; if (t >= 4 * 2048 + 2 * DB) break;
            if (t < 4 * 2048) { smp = false; bs = t >> 12; g = (t >> 11) & 1; tq = t & 2047; } else { smp = true; bs = (t - 4 * 2048) >> 1; g = t & 1; tq = 0; }
        }
        nsa_tile(A, l, smp, bs, g, tq, wl, BT, lane);
    }
}

__device__ __forceinline__ void phase_m2x(CArgs& A, int l, LAS unsigned char* lds, int tid) {
    LAS float* buf = (LAS float*)lds;
    LAS float* wl = (LAS float*)(lds + 1024);
    LAS float* red = (LAS float*)(lds + 2048);
    LAS bf16* kt = (LAS bf16*)(lds + 8192);
    LAS bf16* vt = (LAS bf16*)(lds + 8192 + 34816);
    const bf16* QKVO = (const bf16*)(A.ws + WS_QKVO);
    const int lane = tid & 63, wave = tid >> 6, fr = lane & 15, fq = lane >> 4;
    for (int unit = blockIdx.x; unit < NUNIT; unit += gridDim.x) {
        const int b = unit >> 7, h = (unit >> 5) & 3, c = unit & 31, r0 = b * SEQ + c * LCH;
        float ig = 0.f, lf = 0.f;
        if (tid < 256) ml_gates(A, l, r0 + tid, h, ig, lf);
        const float F = scan_sum256(lf, buf, tid);
        __syncthreads();
        if (tid == 255) buf[16] = F;
        __syncthreads();
        const float Fend = buf[16];
        const float gl = tid < 256 ? Fend - F + ig : -3.0e38f;
        const float mw = wave_max(gl);
        if (lane == 0) buf[20 + wave] = mw;
        __syncthreads();
        const float mloc = fmaxf(fmaxf(buf[20], buf[21]), fmaxf(buf[22], buf[23]));
        if (tid < 256) wl[tid] = __expf(gl - mloc);
        if (tid == 0) { float* ch = (float*)(A.ws + WS_CHS) + unit * 4; ch[0] = Fend; ch[1] = mloc; }
        f32x4 acc[8];
#pragma unroll
        for (int kt_ = 0; kt_ < 8; ++kt_) acc[kt_] = (f32x4){0.f, 0.f, 0.f, 0.f};
        float dnp = 0.f;
        for (int half = 0; half < 2; ++half) {
            __syncthreads();
            for (int i = tid; i < 4096; i += NTHR) { const int which = i >> 11, oc = (i >> 7) & 15, s = i & 127;
                const v4u x = *(const v4u*)(QKVO + (size_t)(r0 + 128 * half + s) * 2048 + (which ? 1024 : 512) + h * HD + 8 * oc);
                LAS bf16* dst = (which ? vt : kt) + (8 * oc) * 136 + s;
                dst[0] = (bf16)x.x; dst[136] = (bf16)(x.x >> 16); dst[272] = (bf16)x.y; dst[408] = (bf16)(x.y >> 16); dst[544] = (bf16)x.z; dst[680] = (bf16)(x.z >> 16); dst[816] = (bf16)x.w; dst[952] = (bf16)(x.w >> 16); }
            __syncthreads();
#pragma unroll
            for (int ks = 0; ks < 4; ++ks) {
                const int s0 = 32 * ks + 8 * fq;
                const v4u xv = *(const LAS v4u*)(vt + (16 * wave + fr) * 136 + s0);
                const f32x4 w0 = *(const LAS f32x4*)(wl + 128 * half + s0), w1 = *(const LAS f32x4*)(wl + 128 * half + s0 + 4);
                v4u av; av.x = pk2(bflo(xv.x) * w0[0], bfhi(xv.x) * w0[1]); av.y = pk2(bflo(xv.y) * w0[2], bfhi(xv.y) * w0[3]); av.z = pk2(bflo(xv.z) * w1[0], bfhi(xv.z) * w1[1]); av.w = pk2(bflo(xv.w) * w1[2], bfhi(xv.w) * w1[3]);
                const bf16x8 af = __builtin_bit_cast(bf16x8, av);
#pragma unroll
                for (int kt_ = 0; kt_ < 8; ++kt_) { const bf16x8 bfr = *(const LAS bf16x8*)(kt + (16 * kt_ + fr) * 136 + s0); acc[kt_] = MFMA16(af, bfr, acc[kt_]); }
            }
            {   const int k = tid & 127, q = tid >> 7;
#pragma unroll
                for (int e = 0; e < 4; ++e) { const v4u x = *(const LAS v4u*)(kt + k * 136 + 32 * q + 8 * e); const LAS float* w = wl + 128 * half + 32 * q + 8 * e;
                    dnp += bflo(x.x) * w[0] + bfhi(x.x) * w[1] + bflo(x.y) * w[2] + bfhi(x.y) * w[3] + bflo(x.z) * w[4] + bfhi(x.z) * w[5] + bflo(x.w) * w[6] + bfhi(x.w) * w[7]; } }
        }
        float* dct = (float*)(A.ws + WS_DCT) + ((size_t)unit * HD + 16 * wave + 4 * fq) * HD + fr;
#pragma unroll
        for (int kt_ = 0; kt_ < 8; ++kt_)
#pragma unroll
            for (int i = 0; i < 4; ++i) dct[(size_t)i * HD + 16 * kt_] = acc[kt_][i];
        red[(tid >> 7) * 128 + (tid & 127)] = dnp;
        __syncthreads();
        if (tid < HD) ((float*)(A.ws + WS_DN))[unit * HD + tid] = (red[tid] + red[128 + tid]) + (red[256 + tid] + red[384 + tid]);
        __syncthreads();
    }
}

__device__ __forceinline__ void phase_m4x(CArgs& A, int l, LAS unsigned char* lds, int tid) {
    LAS float* buf = (LAS float*)lds;
    LAS float* sa = (LAS float*)(lds + 1024);
    LAS float* smx = sa + 256;
    LAS float* sdec = smx + 256;
    LAS float* sem = sdec + 256;
    LAS bf16* vt = (LAS bf16*)(lds + 8192);
    const bf16* QKVO = (const bf16*)(A.ws + WS_QKVO);
    const int lane = tid & 63, wave = tid >> 6, fr = lane & 15, fq = lane >> 4;
    for (int unit = blockIdx.x; unit < NUNIT; unit += gridDim.x) {
        const int b = unit >> 7, h = (unit >> 5) & 3, c = unit & 31, r0 = b * SEQ + c * LCH;
        float ig = 0.f, lf = 0.f;
        if (tid < 256) ml_gates(A, l, r0 + tid, h, ig, lf);
        const float F = scan_sum256(lf, buf, tid);
        const float a = tid < 256 ? ig - F : -3.0e38f;
        const float cm = scan_max256(a, buf, tid);
        const float m0 = ((const float*)(A.ws + WS_CHS))[unit * 4 + 2];
        if (tid < 256) { const float mx = fmaxf(m0, cm); sa[tid] = a; smx[tid] = mx; sdec[tid] = __expf(m0 - mx); sem[tid] = __expf(-(F + mx)); }
        for (int i = tid; i < 4096; i += NTHR) { const int oc = i >> 8, s = i & 255;
            const v4u x = *(const v4u*)(QKVO + (size_t)(r0 + s) * 2048 + 1024 + h * HD + 8 * oc);
            LAS bf16* dst = vt + (8 * oc) * 264 + s;
            dst[0] = (bf16)x.x; dst[264] = (bf16)(x.x >> 16); dst[528] = (bf16)x.y; dst[792] = (bf16)(x.y >> 16); dst[1056] = (bf16)x.z; dst[1320] = (bf16)(x.z >> 16); dst[1584] = (bf16)x.w; dst[1848] = (bf16)(x.w >> 16); }
        __syncthreads();
        const bf16* ctp = (const bf16*)(A.ws + WS_CTP) + (size_t)unit * HD * HD;
        const float* npv = (const float*)(A.ws + WS_NPV) + unit * HD;
        for (int pass = 0; pass < 2; ++pass) {
            const int sub = pass == 0 ? wave : 15 - wave, t0 = 16 * sub, t = t0 + fr;
            const float mxt = smx[t], dect = sdec[t], emt = sem[t];
            bf16x8 qf[4];
#pragma unroll
            for (int kk = 0; kk < 4; ++kk) qf[kk] = *(const bf16x8*)(QKVO + (size_t)(r0 + t) * 2048 + h * HD + 32 * kk + 8 * fq);
            f32x4 ah[8], ac[8];
#pragma unroll
            for (int v = 0; v < 8; ++v) { ah[v] = (f32x4){0.f, 0.f, 0.f, 0.f}; ac[v] = (f32x4){0.f, 0.f, 0.f, 0.f}; }
            float den = 0.f;
            const int nblk = (t0 + 47) >> 5;
            for (int ib = 0; ib < nblk; ++ib) {
                const int s0 = 32 * ib;
                f32x4 st[2];
#pragma unroll
                for (int j = 0; j < 2; ++j) {
                    f32x4 z = {0.f, 0.f, 0.f, 0.f};
                    const bf16* kp = QKVO + (size_t)(r0 + s0 + 16 * j + fr) * 2048 + 512 + h * HD + 8 * fq;
#pragma unroll
                    for (int kk = 0; kk < 4; ++kk) z = MFMA16(*(const bf16x8*)(kp + 32 * kk), qf[kk], z);
                    const f32x4 a4 = *(const LAS f32x4*)(sa + s0 + 16 * j + 4 * fq);
#pragma unroll
                    for (int i = 0; i < 4; ++i) { const float w = (s0 + 16 * j + 4 * fq + i <= t) ? z[i] * __expf(a4[i] - mxt) : 0.f; z[i] = w; den += w; }
                    st[j] = z;
                }
                v4u pw; pw.x = pk2(st[0][0], st[0][1]); pw.y = pk2(st[0][2], st[0][3]); pw.z = pk2(st[1][0], st[1][1]); pw.w = pk2(st[1][2], st[1][3]);
                const bf16x8 pf = __builtin_bit_cast(bf16x8, pw);
#pragma unroll
                for (int v = 0; v < 8; ++v) { const LAS bf16* vp = vt + (16 * v + fr) * 264 + s0 + 4 * fq;
                    const v2u x = *(const LAS v2u*)vp, y = *(const LAS v2u*)(vp + 16);
                    v4u vw; vw.x = x.x; vw.y = x.y; vw.z = y.x; vw.w = y.y;
                    ah[v] = MFMA16(__builtin_bit_cast(bf16x8, vw), pf, ah[v]); }
            }
            float qn = 0.f;
#pragma unroll
            for (int kk = 0; kk < 4; ++kk) {
                const v4u qx = __builtin_bit_cast(v4u, qf[kk]); const f32x4 n0 = *(const f32x4*)(npv + 32 * kk + 8 * fq), n1 = *(const f32x4*)(npv + 32 * kk + 8 * fq + 4);
                qn += bflo(qx.x) * n0[0] + bfhi(qx.x) * n0[1] + bflo(qx.y) * n0[2] + bfhi(qx.y) * n0[3] + bflo(qx.z) * n1[0] + bfhi(qx.z) * n1[1] + bflo(qx.w) * n1[2] + bfhi(qx.w) * n1[3];
#pragma unroll
                for (int v = 0; v < 8; ++v) ac[v] = MFMA16(*(const bf16x8*)(ctp + (size_t)(16 * v + fr) * HD + 32 * kk + 8 * fq), qf[kk], ac[v]);
            }
            const float dent = xfq_sum(den) + dect * xfq_sum(qn);
            const float rden = 1.f / fmaxf(fabsf(dent), emt);
            float s1 = 0.f;
#pragma unroll
            for (int v = 0; v < 8; ++v) { ah[v] = (ah[v] + ac[v] * dect) * rden; s1 += (ah[v][0] + ah[v][1]) + (ah[v][2] + ah[v][3]); }
            const float mu = xfq_sum(s1) * (1.f / HD);
            float s2 = 0.f;
#pragma unroll
            for (int v = 0; v < 8; ++v) { ah[v] = ah[v] - mu; s2 += (ah[v][0] * ah[v][0] + ah[v][1] * ah[v][1]) + (ah[v][2] * ah[v][2] + ah[v][3] * ah[v][3]); }
            const float rstd = 1.f / sqrtf(xfq_sum(s2) * (1.f / HD) + LN_EPS);
            const bf16* op = QKVO + (size_t)(r0 + t) * 2048 + 1536 + h * HD + 4 * fq;
            bf16* mp = (bf16*)(A.ws + WS_MIX) + (size_t)(r0 + t) * D + h * HD + 4 * fq;
            const float* gp = A.ml_norm_g + l * 512 + h * HD + 4 * fq;
#pragma unroll
            for (int v = 0; v < 8; ++v) { const v2u og = *(const v2u*)(op + 16 * v); const f32x4 gn = *(const f32x4*)(gp + 16 * v);
                v2u w; w.x = pk2(ah[v][0] * rstd * gn[0] * sigmoidf_(bflo(og.x)), ah[v][1] * rstd * gn[1] * sigmoidf_(bfhi(og.x)));
                w.y = pk2(ah[v][2] * rstd * gn[2] * sigmoidf_(bflo(og.y)), ah[v][3] * rstd * gn[3] * sigmoidf_(bfhi(og.y)));
                *(v2u*)(mp + 16 * v) = w; }
        }
        __syncthreads();
    }
}

constexpr int SKP = 72;
constexpr int NG_KB = 0, NG_VB = 2 * 64 * SKP * 2, NG_IMP = 2 * NG_VB, NG_BT = NG_IMP + NWAVES * 1088 * 4, NG_MSK = NG_BT + 8 * 132 * 4, NG_TASK = NG_MSK + NWAVES * 16, NG_END = NG_TASK + 16;
static_assert(NG_END <= RING_BYTES, "NSA LDS map");
constexpr int CW_NSAQ = 8192;

__device__ __forceinline__ v4u stage_issue(const bf16* src, size_t pitch, int tid) { return *(const v4u*)(src + (size_t)(tid >> 3) * pitch + (tid & 7) * 8); }
__device__ __forceinline__ void stage_commit(LAS bf16* buf, const v4u& r, int tid) { *(LAS v4u*)(buf + (tid >> 3) * SKP + (tid & 7) * 8) = r; }
__device__ __forceinline__ void qk_lds(const LAS bf16* kb, const bf16x8 (&q)[2], int fr, int fq, f32x4 (&st)[4]) {
#pragma unroll
    for (int t = 0; t < 4; ++t) { const LAS bf16* p = kb + (16 * t + fr) * SKP + 8 * fq;
        f32x4 z = {0.f, 0.f, 0.f, 0.f}; z = MFMA16(*(const LAS bf16x8*)p, q[0], z); st[t] = MFMA16(*(const LAS bf16x8*)(p + 32), q[1], z); }
}
__device__ __forceinline__ void pv_lds(const LAS bf16* vb, int fr, int fq, const f32x4 (&st)[4], f32x4 (&o)[4]) {
#pragma unroll
    for (int h = 0; h < 2; ++h) {
        v4u pw; pw.x = pk2(st[2 * h][0], st[2 * h][1]); pw.y = pk2(st[2 * h][2], st[2 * h][3]); pw.z = pk2(st[2 * h + 1][0], st[2 * h + 1][1]); pw.w = pk2(st[2 * h + 1][2], st[2 * h + 1][3]);
        const bf16x8 pf = __builtin_bit_cast(bf16x8, pw);
#pragma unroll
        for (int dt = 0; dt < 4; ++dt) { const LAS bf16* p = vb + (16 * dt + fr) * SKP + 32 * h + 4 * fq;
            const v2u a = *(const LAS v2u*)p, b = *(const LAS v2u*)(p + 16); v4u w; w.x = a.x; w.y = a.y; w.z = b.x; w.w = b.y;
            o[dt] = MFMA16(__builtin_bit_cast(bf16x8, w), pf, o[dt]); }
    }
}
__device__ __forceinline__ void softmax_pv_lds(const LAS bf16* vb, int fr, int fq, f32x4 (&st)[4], float c, f32x4 (&o)[4], float& m, float& ls) {
    float bm = fmaxf(fmaxf(st[0][0], st[0][1]), fmaxf(st[0][2], st[0][3]));
#pragma unroll
    for (int t = 1; t < 4; ++t) bm = fmaxf(bm, fmaxf(fmaxf(st[t][0], st[t][1]), fmaxf(st[t][2], st[t][3])));
    bm = xfq_max(bm + c);
    if (__any(bm > m)) {
        const float mn = fmaxf(m, bm), sc = __builtin_amdgcn_exp2f(m - mn);
        m = mn; ls *= sc;
#pragma unroll
        for (int dt = 0; dt < 4; ++dt) o[dt] = o[dt] * sc;
    }
    const float d = c - m;
#pragma unroll
    for (int t = 0; t < 4; ++t)
#pragma unroll
        for (int i = 0; i < 4; ++i) { const float p = __builtin_amdgcn_exp2f(st[t][i] + d); st[t][i] = p; ls += p; }
    pv_lds(vb, fr, fq, st, o);
}

__device__ __forceinline__ void nsa_group(CArgs& A, int l, int b, int g, int tg, LAS unsigned char* lds, int tid) {
    const int lane = tid & 63, wave = tid >> 6, fr = lane & 15, fq = lane >> 4, tl = fr >> 2, rr = fr & 3;
    LAS bf16* kbuf = (LAS bf16*)(lds + NG_KB); LAS bf16* vbuf = (LAS bf16*)(lds + NG_VB);
    LAS float* wl = (LAS float*)(lds + NG_IMP) + wave * 1088; const LAS float* BT = (const LAS float*)(lds + NG_BT);
    LAS unsigned long long* msk = (LAS unsigned long long*)(lds + NG_MSK);
    const int qpos0 = 32 * tg + 4 * wave, qpos = qpos0 + tl, cur = tg >> 1, row0 = b * SEQ + qpos0, h = g * 4 + rr;
    const bf16* KS = (const bf16*)(A.ws + WS_KS) + l * KS_L + (size_t)g * TOTS * 64 + (size_t)b * SEQ * 64; const bf16* VTS = (const bf16*)(A.ws + WS_VTS) + l * KS_L + (size_t)g * 64 * TOTS + (size_t)b * SEQ;
    const bf16* KW = (const bf16*)(A.ws + WS_KW) + l * KW_L + (size_t)g * TOTWP * 64 + (size_t)b * SEQ * 64; const bf16* VTW = (const bf16*)(A.ws + WS_VTW) + l * KW_L + (size_t)g * 64 * TOTWP + (size_t)b * SEQ;
    const bf16* KC = (const bf16*)(A.ws + WS_KC) + l * KC_L + (size_t)g * NCB * 64 + (size_t)b * 512 * 64; const bf16* VCT = (const bf16*)(A.ws + WS_VCT) + l * KC_L + (size_t)g * 64 * NCB + (size_t)b * 512;
    const LAS float* bt = BT + h * 132;
    const float farb = bt[128];
    bf16x8 q[2];
    {   const bf16* qp = (const bf16*)(A.ws + WS_NQ) + (size_t)(row0 + tl) * 512 + g * 256 + rr * 64 + 8 * fq;
        q[0] = *(const bf16x8*)qp; q[1] = *(const bf16x8*)(qp + 32); }
    const float* gt = (const float*)(A.ws + WS_GATE) + (size_t)(row0 + tl) * 32 + 8 + h * 3;
    const float gc = sigmoidf_(gt[0]), gs = sigmoidf_(gt[1]), gwn = sigmoidf_(gt[2]);
    f32x4 out[4];
#pragma unroll
    for (int dt = 0; dt < 4; ++dt) out[dt] = (f32x4){0.f, 0.f, 0.f, 0.f};
    LAS float* impA = wl; LAS float* impB = wl + 544;
    for (int i = lane; i < 1088; i += 64) wl[i] = 0.f;

    {
        const int nb64 = (2 * tg + 1 + 63) >> 6;
        float ml = -1.0e30f, lsl = 0.f;
        {   const v4u r0 = stage_issue(KC, 64, tid); stage_commit(kbuf, r0, tid); }
        __syncthreads();
        for (int ib = 0; ib < nb64; ++ib) {
            v4u r; const bool more = ib + 1 < nb64;
            if (more) r = stage_issue(KC + (size_t)(ib + 1) * 64 * 64, 64, tid);
            f32x4 st[4]; qk_lds(kbuf + (ib & 1) * 64 * SKP, q, fr, fq, st);
            float bm = -INFINITY;
#pragma unroll
            for (int t = 0; t < 4; ++t)
#pragma unroll
                for (int i = 0; i < 4; ++i) { const int n = 64 * ib + 16 * t + 4 * fq + i; const int dist = qpos - 16 * n - 31; const int di = dist < 0 ? 0 : (dist > 128 ? 128 : dist);
                    const float bb = bt[di]; const float s = dist >= 0 ? st[t][i] + bb : -INFINITY; st[t][i] = s; bm = fmaxf(bm, s); }
            const float mn = fmaxf(ml, bm); lsl *= __builtin_amdgcn_exp2f(ml - mn); ml = mn;
#pragma unroll
            for (int t = 0; t < 4; ++t)
#pragma unroll
                for (int i = 0; i < 4; ++i) lsl += __builtin_amdgcn_exp2f(st[t][i] - mn);
            if (more) stage_commit(kbuf + ((ib + 1) & 1) * 64 * SKP, r, tid);
            __syncthreads();
        }
        const float m = xfq_max(ml);
        const float ls = xfq_sum(lsl * __builtin_amdgcn_exp2f(ml - m));
        const float inv = ls > 0.f ? 1.f / ls : 0.f;
        f32x4 o[4];
#pragma unroll
        for (int dt = 0; dt < 4; ++dt) o[dt] = (f32x4){0.f, 0.f, 0.f, 0.f};
        {   const v4u rk = stage_issue(KC, 64, tid), rv = stage_issue(VCT, NCB, tid); stage_commit(kbuf, rk, tid); stage_commit(vbuf, rv, tid); }
        __syncthreads();
        for (int ib = 0; ib < nb64; ++ib) {
            v4u rk, rv; const bool more = ib + 1 < nb64;
            if (more) { rk = stage_issue(KC + (size_t)(ib + 1) * 64 * 64, 64, tid); rv = stage_issue(VCT + (ib + 1) * 64, NCB, tid); }
            f32x4 st[4]; qk_lds(kbuf + (ib & 1) * 64 * SKP, q, fr, fq, st);
#pragma unroll
            for (int t = 0; t < 4; ++t) {
#pragma unroll
                for (int i = 0; i < 4; ++i) { const int n = 64 * ib + 16 * t + 4 * fq + i; const int dist = qpos - 16 * n - 31; const int di = dist < 0 ? 0 : (dist > 128 ? 128 : dist);
                    const float bb = bt[di]; st[t][i] = dist >= 0 ? __builtin_amdgcn_exp2f(st[t][i] + bb - m) * inv : 0.f; }
                const float s4 = quad_sum((st[t][0] + st[t][1]) + (st[t][2] + st[t][3])), s3 = quad_sum(st[t][3]);
                const int j0 = 16 * ib + 4 * t + fq;
                if (rr == 0) { impA[tl * 136 + j0] = s4; impB[tl * 136 + j0 + 1] = s3; }
            }
            pv_lds(vbuf + (ib & 1) * 64 * SKP, fr, fq, st, o);
            if (more) { stage_commit(kbuf + ((ib + 1) & 1) * 64 * SKP, rk, tid); stage_commit(vbuf + ((ib + 1) & 1) * 64 * SKP, rv, tid); }
            __syncthreads();
        }
#pragma unroll
        for (int dt = 0; dt < 4; ++dt) out[dt] = out[dt] + o[dt] * gc;
    }
    unsigned long long s0[4], s1[4];
#pragma unroll
    for (int t = 0; t < 4; ++t) topk_sel(impA[t * 136 + lane] + impB[t * 136 + lane], impA[t * 136 + 64 + lane] + impB[t * 136 + 64 + lane], cur, lane, s0[t], s1[t]);
    const unsigned long long wu0 = (s0[0] | s0[1]) | (s0[2] | s0[3]), wu1 = (s1[0] | s1[1]) | (s1[2] | s1[3]);
    const unsigned long long my0 = tl == 0 ? s0[0] : (tl == 1 ? s0[1] : (tl == 2 ? s0[2] : s0[3])), my1 = tl == 0 ? s1[0] : (tl == 1 ? s1[1] : (tl == 2 ? s1[2] : s1[3]));
    if (lane == 0) { msk[2 * wave] = wu0; msk[2 * wave + 1] = wu1; }
    __syncthreads();
    unsigned long long gu0 = 0ull, gu1 = 0ull;
#pragma unroll
    for (int w = 0; w < NWAVES; ++w) { gu0 |= msk[2 * w]; gu1 |= msk[2 * w + 1]; }
    gu0 = __builtin_amdgcn_readfirstlane((unsigned)gu0) | ((unsigned long long)__builtin_amdgcn_readfirstlane((unsigned)(gu0 >> 32)) << 32);
    gu1 = __builtin_amdgcn_readfirstlane((unsigned)gu1) | ((unsigned long long)__builtin_amdgcn_readfirstlane((unsigned)(gu1 >> 32)) << 32);
    {
        float m = -1.0e30f, ls = 0.f; f32x4 o[4];
#pragma unroll
        for (int dt = 0; dt < 4; ++dt) o[dt] = (f32x4){0.f, 0.f, 0.f, 0.f};
        int j = __builtin_ctzll(gu0); gu0 &= gu0 - 1ull;
        {   const v4u rk = stage_issue(KS + (size_t)j * 64 * 64, 64, tid), rv = stage_issue(VTS + (size_t)j * 64, TOTS, tid); stage_commit(kbuf, rk, tid); stage_commit(vbuf, rv, tid); }
        __syncthreads();
        int pb = 0;
        for (;;) {
            int jn = -1;
            if (gu0) { jn = __builtin_ctzll(gu0); gu0 &= gu0 - 1ull; } else if (gu1) { jn = 64 + __builtin_ctzll(gu1); gu1 &= gu1 - 1ull; }
            v4u rk, rv;
            if (jn >= 0) { rk = stage_issue(KS + (size_t)jn * 64 * 64, 64, tid); rv = stage_issue(VTS + (size_t)jn * 64, TOTS, tid); }
            const bool wave_has = j < 64 ? ((wu0 >> j) & 1ull) != 0ull : ((wu1 >> (j - 64)) & 1ull) != 0ull;
            if (wave_has) {
                const bool mine = j < 64 ? ((my0 >> j) & 1ull) != 0ull : ((my1 >> (j - 64)) & 1ull) != 0ull;
                f32x4 st[4]; qk_lds(kbuf + pb * 64 * SKP, q, fr, fq, st);
                float c = mine ? farb : -INFINITY;
                if (j >= cur - 2) {
                    c = mine ? 0.f : -INFINITY;
#pragma unroll
                    for (int t = 0; t < 4; ++t)
#pragma unroll
                        for (int i = 0; i < 4; ++i) { const int dist = qpos - (64 * j + 16 * t + 4 * fq + i); const int di = dist < 0 ? 0 : (dist > 128 ? 128 : dist);
                            const float bb = bt[di]; st[t][i] = dist >= 0 ? st[t][i] + bb : -INFINITY; }
                }
                softmax_pv_lds(vbuf + pb * 64 * SKP, fr, fq, st, c, o, m, ls);
            }
            if (jn < 0) break;
            stage_commit(kbuf + (pb ^ 1) * 64 * SKP, rk, tid); stage_commit(vbuf + (pb ^ 1) * 64 * SKP, rv, tid);
            __syncthreads();
            j = jn; pb ^= 1;
        }
        ls = xfq_sum(ls);
        const float w = ls > 0.f ? gs / ls : 0.f;
#pragma unroll
        for (int dt = 0; dt < 4; ++dt) out[dt] = out[dt] + o[dt] * w;
    }
    __syncthreads();
    {
        float m = -1.0e30f, ls = 0.f; f32x4 o[4];
#pragma unroll
        for (int dt = 0; dt < 4; ++dt) o[dt] = (f32x4){0.f, 0.f, 0.f, 0.f};
        int j = (32 * tg - 511) >> 6; if (j < 0) j = 0;
        {   const v4u rk = stage_issue(KW + (size_t)j * 64 * 64, 64, tid), rv = stage_issue(VTW + (size_t)j * 64, TOTWP, tid); stage_commit(kbuf, rk, tid); stage_commit(vbuf, rv, tid); }
        __syncthreads();
        int pb = 0;
        for (;;) {
            const bool more = j < cur;
            v4u rk, rv;
            if (more) { rk = stage_issue(KW + (size_t)(j + 1) * 64 * 64, 64, tid); rv = stage_issue(VTW + (size_t)(j + 1) * 64, TOTWP, tid); }
            {
                f32x4 st[4]; qk_lds(kbuf + pb * 64 * SKP, q, fr, fq, st);
                float c = farb;
                const bool interior = (qpos0 + 3 - 64 * j < 512) && (qpos0 - (64 * j + 63) >= 128);
                if (!interior) {
                    c = 0.f;
#pragma unroll
                    for (int t = 0; t < 4; ++t)
#pragma unroll
                        for (int i = 0; i < 4; ++i) { const int dist = qpos - (64 * j + 16 * t + 4 * fq + i); const int di = dist < 0 ? 0 : (dist > 128 ? 128 : dist);
                            const float bb = bt[di]; st[t][i] = (dist >= 0 && dist < 512) ? st[t][i] + bb : -INFINITY; }
                }
                softmax_pv_lds(vbuf + pb * 64 * SKP, fr, fq, st, c, o, m, ls);
            }
            if (!more) break;
            stage_commit(kbuf + (pb ^ 1) * 64 * SKP, rk, tid); stage_commit(vbuf + (pb ^ 1) * 64 * SKP, rv, tid);
            __syncthreads();
            ++j; pb ^= 1;
        }
        ls = xfq_sum(ls);
        const float w = ls > 0.f ? gwn / ls : 0.f;
#pragma unroll
        for (int dt = 0; dt < 4; ++dt) out[dt] = out[dt] + o[dt] * w;
    }
    bf16* mp = (bf16*)(A.ws + WS_MIX) + (size_t)(row0 + tl) * D + 512 + h * 64 + 4 * fq;
#pragma unroll
    for (int dt = 0; dt < 4; ++dt) { v2u w; w.x = pk2(out[dt][0], out[dt][1]); w.y = pk2(out[dt][2], out[dt][3]); *(v2u*)(mp + 16 * dt) = w; }
    __syncthreads();
}

__device__ __forceinline__ void phase_nsa2(CArgs& A, int l, LAS unsigned char* lds, int tid) {
    const int lane = tid & 63, wave = tid >> 6;
    LAS float* btl = (LAS float*)(lds + NG_BT);
    LAS int* tw = (LAS int*)(lds + NG_TASK);
    for (int i = tid; i < 8 * 132; i += NTHR) btl[i] = ((const float*)(A.ws + WS_BT))[i];
    unsigned* qh = (unsigned*)(A.ws + WS_CTL) + CW_NSAQ + l * 5 * 64;
    const int own = (blockIdx.x & 7) >> 1;
    for (int qi = 0; qi < 5; ++qi) {
        const int qsel = qi == 0 ? own : (qi == 1 ? 4 : ((own + qi - 1) & 3));
        const int qlen = qsel == 4 ? 2 * DB / NWAVES : 256;
        for (;;) {
            __syncthreads();
            if (tid == 0) tw[0] = (int)__hip_atomic_fetch_add(qh + qsel * 64, 1u, __ATOMIC_RELAXED, __HIP_MEMORY_SCOPE_AGENT);
            __syncthreads();
            const int t = tw[0];
            if (t >= qlen) break;
            if (qsel < 4) nsa_group(A, l, qsel >> 1, qsel & 1, 255 - t, lds, tid);
            else { const int tt = t * NWAVES + wave; nsa_tile(A, l, true, tt >> 1, tt & 1, 0, (LAS float*)(lds + NG_IMP) + wave * 1088, btl, lane); }
        }
    }
}

constexpr int PH_PER_LAYER = 9, PH_L0 = 3, N_PHASES = PH_L0 + DEPTH * PH_PER_LAYER;
#ifndef REP_MASK
#define REP_MASK 0
#endif
#define REPS(b) for (int rep_ = 0; rep_ < (((REP_MASK) >> (b)) & 1) + 1; ++rep_)
#ifndef MK_PER_PHASE
#define MK_PER_PHASE 0
#endif

__device__ __forceinline__ int fresh_tid() { int t = threadIdx.x; asm volatile("" : "+v"(t)); return t; }
__device__ __forceinline__ CArgs* kargs() { unsigned long long p = (unsigned long long)__builtin_amdgcn_kernarg_segment_ptr(); asm volatile("" : "+s"(p)); return (CArgs*)p; }
#define A (*kargs())
#define IN(k) (lo <= (k) && (k) < hi)
#define SEAM(k) do { if (IN(k) && IN((k) + 1)) xcd_barrier(bar); } while (0)
template <int l>
__device__ __forceinline__ void layer_phases(LAS unsigned char* lds, const XcdBarrier& bar, int G, int NGW, int lo, int hi) {
    unsigned char* ws = A.ws;
    float* const ADA = (float*)(ws + WS_ADA);
    float* const X = (float*)(ws + WS_X);
    float* const Z = (float*)(ws + WS_Z);
    bf16* const U = (bf16*)(ws + WS_U);
        const int pb_ = PH_L0 + l * PH_PER_LAYER;
        const float* adal = ADA + (size_t)l * NCOND * 6144;
        const float* xa = l == 0 ? A.x_prompt : X; const float* xb = l == 0 ? A.x_sample : X + (size_t)MP * D;
        if (IN(pb_ + 0)) {
            const int tid = fresh_tid(), lane = tid & 63, wave = __builtin_amdgcn_readfirstlane(tid >> 6), gw = blockIdx.x * NWAVES + wave; (void)lane; (void)gw;
            {
                pg8::Gemm g{U, (const bf16*)(ws + WS_WIN) + (size_t)l * NINP * D, D, D, D};
                pg8::StaticOrder S; S.init(M, NINP, G, (int)blockIdx.x);
                EpiInProj E{(bf16*)(ws + WS_QKVO), (bf16*)(ws + WS_NQ), (float*)(ws + WS_GATE), (float*)(ws + WS_KVR), (bf16*)(ws + WS_XC) + (size_t)l * 4 * XCP * 64, A.out, l};
                pg8::gemm_phase<EpiInProj, pg8::StaticOrder, true, true>(lds, g, S, E);
            }
            if (l == 0) {
                __syncthreads();
                pg8::Gemm g{(const bf16*)(ws + WS_XC), (const bf16*)(ws + WS_W1), 2048, 1024, 2048};
                CmpOrder S{G, (int)blockIdx.x, 0, DEPTH, 4, 64};
                EpiCmpHid E{(bf16*)(ws + WS_HID), (const float*)(ws + WS_B1)};
                pg8::gemm_phase<EpiCmpHid, CmpOrder, true, true>(lds, g, S, E);
            }
        }
        SEAM(pb_ + 0);
        if (IN(pb_ + 1)) {
            const int tid = fresh_tid(), lane = tid & 63, wave = __builtin_amdgcn_readfirstlane(tid >> 6), gw = blockIdx.x * NWAVES + wave; (void)lane; (void)gw;
            {
                pg8::Gemm g{(const bf16*)(ws + WS_XC), (const bf16*)(ws + WS_W1), 2048, 1024, 2048};
                CmpOrder S{G, (int)blockIdx.x, l, 1, 0, 4};
                EpiCmpHid E{(bf16*)(ws + WS_HID), (const float*)(ws + WS_B1)};
                pg8::gemm_phase<EpiCmpHid, CmpOrder, true, true>(lds, g, S, E);
            }
            __syncthreads();
            REPS(1) { phase_m2x(A, l, lds, tid);
            __syncthreads();
            prep_layer_images(A, l, lds, gw, NGW, lane, wave); __syncthreads(); }
            if (l == 0) phase_cmp2(A, 0, DEPTH, 1024, NCB - 1024, gw, NGW, lane);
        }
        SEAM(pb_ + 1);
        if (IN(pb_ + 2)) {
            const int tid = fresh_tid(), lane = tid & 63, wave = __builtin_amdgcn_readfirstlane(tid >> 6), gw = blockIdx.x * NWAVES + wave; (void)lane; (void)gw;
            REPS(2) phase_m3(A, l, tid);
            phase_cmp2(A, l, 1, 0, 1024, gw, NGW, lane);
        }
        SEAM(pb_ + 2);
        if (IN(pb_ + 3)) {
            const int tid = fresh_tid(), lane = tid & 63, wave = __builtin_amdgcn_readfirstlane(tid >> 6), gw = blockIdx.x * NWAVES + wave; (void)lane; (void)gw;
            REPS(3) { phase_m4x(A, l, lds, tid);
            __syncthreads(); }
            REPS(4) { phase_mls(A, l, lds, tid);
            __syncthreads(); }
            phase_nsa2(A, l, lds, tid);
        }
        SEAM(pb_ + 3);
        if (IN(pb_ + 4)) {
            const int tid = fresh_tid(), lane = tid & 63, wave = __builtin_amdgcn_readfirstlane(tid >> 6), gw = blockIdx.x * NWAVES + wave; (void)lane; (void)gw;
            pg8::Gemm g{(const bf16*)(ws + WS_MIX), (const bf16*)(ws + WS_WOUT) + (size_t)l * D * D, D, D, D};
            pg8::StaticOrder S; S.init(M, D, G, (int)blockIdx.x);
            EpiResid E{xa, xb, adal + 2048, Z};
            pg8::gemm_phase<EpiResid, pg8::StaticOrder, true, true>(lds, g, S, E);
        }
        SEAM(pb_ + 4);
        if (IN(pb_ + 5)) {
            const int tid = fresh_tid(), lane = tid & 63, wave = __builtin_amdgcn_readfirstlane(tid >> 6), gw = blockIdx.x * NWAVES + wave; (void)lane; (void)gw;
            REPS(6) for (int r = gw; r < M; r += NGW) {
                const float* ad = adal + (size_t)cond_of_row(r) * 6144;
                ln_row(Z + (size_t)r * D, A.ln_g + (size_t)(l * 2 + 0) * D, A.ln_b + (size_t)(l * 2 + 0) * D, X + (size_t)r * D, ad + 3072, ad + 4096, U + (size_t)r * D, lane);
            }
        }
        SEAM(pb_ + 5);
        if (IN(pb_ + 6)) {
            const int tid = fresh_tid(), lane = tid & 63, wave = __builtin_amdgcn_readfirstlane(tid >> 6), gw = blockIdx.x * NWAVES + wave; (void)lane; (void)gw;
            pg8::Gemm g{U, (const bf16*)(ws + WS_WUP) + (size_t)l * FF * D, D, D, D};
            pg8::StaticOrder S; S.init(M, FF, G, (int)blockIdx.x);
            EpiRelu2 E{(bf16*)(ws + WS_H)};
            pg8::gemm_phase<EpiRelu2, pg8::StaticOrder, true, true>(lds, g, S, E);
        }
        SEAM(pb_ + 6);
        if (IN(pb_ + 7)) {
            const int tid = fresh_tid(), lane = tid & 63, wave = __builtin_amdgcn_readfirstlane(tid >> 6), gw = blockIdx.x * NWAVES + wave; (void)lane; (void)gw;
            pg8::Gemm g{(const bf16*)(ws + WS_H), (const bf16*)(ws + WS_WDN) + (size_t)l * D * FF, FF, FF, FF};
            pg8::StaticOrder S; S.init(M, D, G, (int)blockIdx.x);
            EpiResid E{X, X + (size_t)MP * D, adal + 5120, Z};
            pg8::gemm_phase<EpiResid, pg8::StaticOrder, true, true>(lds, g, S, E);
        }
        SEAM(pb_ + 7);
        if (IN(pb_ + 8)) {
            const int tid = fresh_tid(), lane = tid & 63, wave = __builtin_amdgcn_readfirstlane(tid >> 6), gw = blockIdx.x * NWAVES + wave; (void)lane; (void)gw;
            const bool last = l == DEPTH - 1;
            REPS(6) for (int r = gw; r < M; r += NGW) {
                const float* ad = adal + (size_t)NCOND * 6144 + (size_t)cond_of_row(r) * 6144;
                float* xo = last ? (r < MP ? A.out + O_YP + (size_t)r * D : A.out + O_YS + (size_t)(r - MP) * D) : X + (size_t)r * D;
                ln_row(Z + (size_t)r * D, A.ln_g + (size_t)(l * 2 + 1) * D, A.ln_b + (size_t)(l * 2 + 1) * D, xo, ad, ad + 1024, last ? (bf16*)nullptr : U + (size_t)r * D, lane);
            }
        }
        SEAM(pb_ + 8);
    }
__global__ void __launch_bounds__(NTHR, 2) fwd_kernel(Args A_unused) {
    extern __shared__ __attribute__((aligned(16))) unsigned char lds_raw[];
    LAS unsigned char* lds = (LAS unsigned char*)lds_raw;
    const int G = gridDim.x, NGW = G * NWAVES;
    unsigned char* ws = A.ws;
    for (int u = threadIdx.x; u < (LDS_BYTES - LDSCTL_OFF) / 4; u += NTHR) ((LAS unsigned*)(lds + LDSCTL_OFF))[u] = 0u;
    __syncthreads();
    XcdBarrier bar; bar.bar = (unsigned*)(ws + WS_CTL) + CW_BAR; bar.x = 0; bar.st = nullptr;
    if (!MK_PER_PHASE) bar = xcd_barrier_post((unsigned*)(ws + WS_CTL) + CW_BAR, (volatile LAS unsigned*)(lds + MISC_OFF) + 8);
    const int lo = A.ph_lo, hi = A.ph_hi;

    float* const ADA = (float*)(ws + WS_ADA);
    float* const X = (float*)(ws + WS_X);
    float* const Z = (float*)(ws + WS_Z);
    bf16* const U = (bf16*)(ws + WS_U);

    if (IN(0)) { const int tid = fresh_tid(), lane = tid & 63, wave = __builtin_amdgcn_readfirstlane(tid >> 6), gw = blockIdx.x * NWAVES + wave; (void)tid; REPS(0) { phase_p0a(A, lds, gw, NGW, lane, wave); prep_cache_images(A, lds, gw, NGW, lane, wave); } }
    SEAM(0);
    if (IN(1)) { const int tid = fresh_tid(); REPS(7) { phase_ada(A, lds, tid); } }
    SEAM(1);
    if (IN(2)) {
        const int tid = fresh_tid(), lane = tid & 63, wave = __builtin_amdgcn_readfirstlane(tid >> 6), gw = blockIdx.x * NWAVES + wave;
        for (int r = gw; r < M; r += NGW) {
            const float* ad = ADA + (size_t)cond_of_row(r) * 6144;
            mod_row(r < MP ? A.x_prompt + (size_t)r * D : A.x_sample + (size_t)(r - MP) * D, ad, ad + 1024, U + (size_t)r * D, lane);
        }
    }
    SEAM(2);

    layer_phases<0>(lds, bar, G, NGW, lo, hi);
    layer_phases<1>(lds, bar, G, NGW, lo, hi);
    static_assert(DEPTH == 2, "two layers");
#undef IN
#undef SEAM
#undef A
}

extern "C" void kernel_launch(void* const* d_in, const int* in_sizes, int n_in, void* d_out, int out_size, void* d_ws, size_t ws_size, hipStream_t stream) {
    static int grid = 0;
    if (grid == 0) {
        if (n_in != 25 || (size_t)out_size != O_END || ws_size < WS_END) { fprintf(stderr, "kernel_launch: unexpected shapes: n_in %d out %d (want %zu) ws %zu (want >= %zu)\n", n_in, out_size, (size_t)O_END, ws_size, (size_t)WS_END); grid = -1; return; }
        int dev = 0, cus = 0, per_cu = 0;
        if (hipGetDevice(&dev) != hipSuccess || hipDeviceGetAttribute(&cus, hipDeviceAttributeMultiprocessorCount, dev) != hipSuccess) { grid = -1; return; }
        if (hipFuncSetAttribute((const void*)fwd_kernel, hipFuncAttributeMaxDynamicSharedMemorySize, LDS_BYTES) != hipSuccess) { fprintf(stderr, "kernel_launch: hipFuncSetAttribute failed\n"); grid = -1; return; }
        if (hipOccupancyMaxActiveBlocksPerMultiprocessor(&per_cu, (const void*)fwd_kernel, NTHR, LDS_BYTES) != hipSuccess || per_cu < 1) fprintf(stderr, "kernel_launch: occupancy query reports %d blocks per CU\n", per_cu);
        (void)hipGetLastError();
        grid = cus;
    }
    if (grid < 0) return;
    (void)hipMemsetAsync((char*)d_ws + WS_CTL, 0, CTL_ZERO_BYTES, stream);
    Args a{};
    a.x_prompt = (const float*)d_in[0]; a.x_sample = (const float*)d_in[1]; a.cache_cmp = (const float*)d_in[2]; a.cache_slc = (const float*)d_in[3]; a.cache_win = (const float*)d_in[4];
    a.st_C = (const float*)d_in[5]; a.st_n = (const float*)d_in[6]; a.st_m = (const float*)d_in[7]; a.page_table = (const int*)d_in[8]; a.c_prompt = (const float*)d_in[9]; a.c_sample = (const float*)d_in[10];
    a.w_ada = (const float*)d_in[11]; a.b_ada = (const float*)d_in[12]; a.w_in = (const float*)d_in[13]; a.b_gate = (const float*)d_in[14]; a.ml_norm_g = (const float*)d_in[15]; a.cmp_pe = (const float*)d_in[16];
    a.cmp_w1 = (const float*)d_in[17]; a.cmp_w2 = (const float*)d_in[18]; a.rel_bias = (const float*)d_in[19]; a.w_out = (const float*)d_in[20]; a.ln_g = (const float*)d_in[21]; a.ln_b = (const float*)d_in[22];
    a.w_up = (const float*)d_in[23]; a.w_down = (const float*)d_in[24];
    a.out = (float*)d_out; a.ws = (unsigned char*)d_ws;
#if MK_PER_PHASE
    for (int ph = 0; ph < N_PHASES; ++ph) { a.ph_lo = ph; a.ph_hi = ph + 1; hipLaunchKernelGGL(fwd_kernel, dim3(grid), dim3(NTHR), LDS_BYTES, stream, a); }
#else
    a.ph_lo = 0; a.ph_hi = N_PHASES;
    hipLaunchKernelGGL(fwd_kernel, dim3(grid), dim3(NTHR), LDS_BYTES, stream, a);
#endif
    const hipError_t le = hipPeekAtLastError();
    if (le != hipSuccess) fprintf(stderr, "kernel_launch: launch failed: %s\n", hipGetErrorName(le));
}
```

```cpp
#include <hip/hip_runtime.h>
#include <cstdio>
#include <cstdint>
namespace pg8 {
#define PG8_LAS __attribute__((address_space(3)))
typedef unsigned short bf16_t;
typedef short bf16x8 __attribute__((ext_vector_type(8)));
typedef float f32x4 __attribute__((ext_vector_type(4)));
typedef unsigned u32x4 __attribute__((ext_vector_type(4)));
constexpr int BM = 256, BK = 64, HALF = 128, HTB = HALF * BK * 2  , STAGE_BYTES = 8 * HTB, NXCD = 8, WGM = 8;

__host__ __device__ __forceinline__ int lds_byte(int r, int c) { const int st = (r >> 4) * 2 + (c >> 5), rr = r & 15, cc = c & 31, ob = rr * 64 + cc * 2; return st * 1024 + (ob ^ (((ob >> 9) & 1) << 5)); }
__host__ __device__ __forceinline__ void stage_rc(int b, int& R, int& C) { const int st = b / 1024, sb = b % 1024, swz = sb ^ (((sb >> 9) & 1) << 5); R = (st >> 1) * 16 + swz / 64; C = (st & 1) * 32 + (swz % 64) / 2; }
__host__ __device__ __forceinline__ int perm32(int rho) { const int n = rho >> 4, i = rho & 15; return 8 * (i >> 2) + 4 * n + (i & 3); }

struct Unit { int pm, pn; };
struct Gemm { const bf16_t* A; const bf16_t* Bt; int K, lda, ldb; };

struct StaticOrder {
    int nM, nN, nwg, G, c;
    __host__ __device__ void init(int M, int N, int G_, int c_) { nM = M / BM; nN = N / BM; nwg = nM * nN; G = G_; c = c_; }
    __host__ __device__ bool next(int i, Unit& u) const {
        const long L = (long)i * G + c; if (L >= nwg) return false;
        int wgid = (int)L; { const int q = nwg / NXCD, r = nwg % NXCD, xcd = wgid % NXCD, off = wgid / NXCD; wgid = (xcd < r ? xcd * (q + 1) : r * (q + 1) + (xcd - r) * q) + off; }
        const int nig = WGM * nN, gid = wgid / nig, fm = gid * WGM, gsz = (nM - fm) < WGM ? (nM - fm) : WGM;
        u.pm = fm + ((wgid % nig) % gsz); u.pn = (wgid % nig) / gsz; return true;
    }
    __device__ __forceinline__ void a_ready(const Unit&) const {}
    __device__ __forceinline__ void done(const Unit&) const {}
};

template <class Epi, class Sched, bool ALIGN_EPI = false, bool SP2 = false>
__device__ __forceinline__ void gemm_phase(PG8_LAS unsigned char* lds, const Gemm g, const Sched& S, const Epi& E) {
    const int tid = threadIdx.x, wid = __builtin_amdgcn_readfirstlane(tid >> 6), lane = tid & 63, wr = wid >> 2, wc = wid & 3, fr = lane & 15, fq = lane >> 4;
    const int K = g.K, nt = K / BK;
    unsigned voffA[2], voffB[2];
#pragma unroll
    for (int i = 0; i < 2; ++i) { int R, C; stage_rc(tid * 16 + i * 8192, R, C); const int Rb = Epi::PERM ? ((R & ~31) + perm32(R & 31)) : R;
        voffA[i] = (unsigned)(R * g.lda + C) * 2u; voffB[i] = (unsigned)(Rb * g.ldb + C) * 2u; }
    const size_t kstep = (size_t)(BK * 2);
    const size_t hstepA = (size_t)HALF * g.lda * 2, hstepB = (size_t)HALF * g.ldb * 2;
    const size_t tstepA = 2 * hstepA, tstepB = 2 * hstepB;
    const unsigned ldsw = (unsigned)wid * 1024u;
    const int aoff = lds_byte(wr * 64 + fr, fq * 8), boff = lds_byte(wc * 32 + fr, fq * 8);
#define PG8_SA(b, h) (((b) * 2 + (h)) * HTB)
#define PG8_SB(b, h) ((4 + (b) * 2 + (h)) * HTB)
#define PG8_STAGE(bufoff, gbase, voff) do { _Pragma("unroll") for (int _i = 0; _i < 2; ++_i) \
        __builtin_amdgcn_global_load_lds((const unsigned*)((const char*)(gbase) + (voff)[_i]), (PG8_LAS unsigned*)(lds + (bufoff) + ldsw + _i * 8192), 16, 0, 0); } while (0)
#define PG8_LDA(dst, b, h) do { _Pragma("unroll") for (int m = 0; m < 4; ++m) _Pragma("unroll") for (int k = 0; k < 2; ++k) dst[m][k] = *(const PG8_LAS bf16x8*)(lds + PG8_SA(b, h) + aoff + m * 2048 + k * 1024); } while (0)
#define PG8_LDB(dst, b, h) do { _Pragma("unroll") for (int n = 0; n < 2; ++n) _Pragma("unroll") for (int k = 0; k < 2; ++k) dst[n][k] = *(const PG8_LAS bf16x8*)(lds + PG8_SB(b, h) + boff + n * 2048 + k * 1024); } while (0)
#define PG8_MMA(ai, bj, At, Bt) do { __builtin_amdgcn_s_setprio(1); _Pragma("unroll") for (int m = 0; m < 4; ++m) _Pragma("unroll") for (int n = 0; n < 2; ++n) _Pragma("unroll") for (int k = 0; k < 2; ++k) \
        acc[ai][bj][m][n] = __builtin_amdgcn_mfma_f32_16x16x32_bf16(Bt[n][k], At[m][k], acc[ai][bj][m][n], 0, 0, 0); __builtin_amdgcn_s_setprio(0); } while (0)
#define PG8_WAIT_V(n) asm volatile("s_waitcnt vmcnt(" #n ")" ::: "memory")
#define PG8_WAIT_L(n) asm volatile("s_waitcnt lgkmcnt(" #n ")" ::: "memory")
#define PG8_BAR __builtin_amdgcn_s_barrier()
#define PG8_SCHED __builtin_amdgcn_sched_barrier(0)
    Unit cur, nxt; int ui = 0;
    if (!S.next(0, cur)) return;
    f32x4 acc[2][2][4][2];
#pragma unroll
    for (int a = 0; a < 2; ++a)
#pragma unroll
        for (int b = 0; b < 2; ++b)
#pragma unroll
            for (int m = 0; m < 4; ++m)
#pragma unroll
                for (int n = 0; n < 2; ++n) acc[a][b][m][n] = (f32x4){0.f, 0.f, 0.f, 0.f};
    bf16x8 At[4][2], B0[2][2], B1[2][2];
    const char* cA = (const char*)g.A + (size_t)cur.pm * tstepA; const char* cB = (const char*)g.Bt + (size_t)cur.pn * tstepB;
    S.a_ready(cur);
    if constexpr (SP2) {
        PG8_STAGE(PG8_SB(0, 0), cB, voffB); PG8_STAGE(PG8_SB(0, 1), cB + hstepB, voffB); PG8_STAGE(PG8_SA(0, 0), cA, voffA); PG8_STAGE(PG8_SA(0, 1), cA + hstepA, voffA);
        if (wr == 1) PG8_BAR;
        PG8_WAIT_V(2); PG8_BAR;
        PG8_STAGE(PG8_SB(1, 0), cB + kstep, voffB); PG8_STAGE(PG8_SA(1, 0), cA + kstep, voffA); PG8_STAGE(PG8_SB(1, 1), cB + hstepB + kstep, voffB);
        PG8_WAIT_V(6); PG8_BAR;
    } else {
        PG8_STAGE(PG8_SB(0, 0), cB, voffB); PG8_STAGE(PG8_SA(0, 0), cA, voffA); PG8_STAGE(PG8_SB(0, 1), cB + hstepB, voffB); PG8_STAGE(PG8_SA(0, 1), cA + hstepA, voffA);
        if (wr == 1) PG8_BAR;
        PG8_WAIT_V(4); PG8_BAR;
        PG8_STAGE(PG8_SB(1, 0), cB + kstep, voffB); PG8_STAGE(PG8_SA(1, 0), cA + kstep, voffA); PG8_STAGE(PG8_SB(1, 1), cB + hstepB + kstep, voffB);
        PG8_WAIT_V(6); PG8_BAR;
    }
    for (;;) {
        const bool has_next = S.next(ui + 1, nxt);
        const char* nA = has_next ? (const char*)g.A + (size_t)nxt.pm * tstepA : cA; const char* nB = has_next ? (const char*)g.Bt + (size_t)nxt.pn * tstepB : cB;
        for (int t = 0; t < nt; t += 2) {
            const bool last = (t == nt - 2);
            const char* a1 = cA + (size_t)(t + 1) * kstep;
            const char* a2 = last ? nA : cA + (size_t)(t + 2) * kstep; const char* b2 = last ? nB : cB + (size_t)(t + 2) * kstep;
            const char* a3 = a2 + kstep; const char* b3 = b2 + kstep;
            if (last && has_next) S.a_ready(nxt);
            if constexpr (SP2) {
            PG8_LDB(B0, 0, 0); PG8_LDB(B1, 0, 1); PG8_SCHED; PG8_LDA(At, 0, 0); PG8_STAGE(PG8_SA(1, 1), a1 + hstepA, voffA);
            PG8_WAIT_V(8); PG8_WAIT_L(0); PG8_BAR; PG8_MMA(0, 0, At, B0); PG8_MMA(0, 1, At, B1); PG8_BAR; PG8_SCHED;
            PG8_LDA(At, 0, 1); PG8_STAGE(PG8_SB(0, 0), b2, voffB); PG8_STAGE(PG8_SB(0, 1), b2 + hstepB, voffB); PG8_STAGE(PG8_SA(0, 0), a2, voffA);
            PG8_WAIT_V(8); PG8_WAIT_L(0); PG8_BAR; PG8_MMA(1, 0, At, B0); PG8_MMA(1, 1, At, B1); PG8_BAR; PG8_SCHED;
            PG8_LDB(B0, 1, 0); PG8_LDB(B1, 1, 1); PG8_SCHED; PG8_LDA(At, 1, 0); PG8_STAGE(PG8_SA(0, 1), a2 + hstepA, voffA);
            PG8_WAIT_V(8); PG8_WAIT_L(0); PG8_BAR; PG8_MMA(0, 0, At, B0); PG8_MMA(0, 1, At, B1); PG8_BAR; PG8_SCHED;
            PG8_LDA(At, 1, 1); PG8_STAGE(PG8_SB(1, 0), b3, voffB); PG8_STAGE(PG8_SB(1, 1), b3 + hstepB, voffB); PG8_STAGE(PG8_SA(1, 0), a3, voffA);
            PG8_WAIT_V(8); PG8_WAIT_L(0); PG8_BAR; PG8_MMA(1, 0, At, B0); PG8_MMA(1, 1, At, B1); PG8_BAR; PG8_SCHED;
            } else {
            PG8_LDB(B0, 0, 0); PG8_SCHED; PG8_LDA(At, 0, 0); PG8_STAGE(PG8_SA(1, 1), a1 + hstepA, voffA);
            PG8_WAIT_L(8); PG8_BAR; PG8_WAIT_L(0); PG8_MMA(0, 0, At, B0); PG8_BAR; PG8_SCHED;
            PG8_LDB(B1, 0, 1); PG8_STAGE(PG8_SB(0, 0), b2, voffB);
            PG8_BAR; PG8_WAIT_L(0); PG8_MMA(0, 1, At, B1); PG8_BAR;
            PG8_LDA(At, 0, 1); PG8_STAGE(PG8_SA(0, 0), a2, voffA);
            PG8_BAR; PG8_WAIT_L(0); PG8_MMA(1, 0, At, B0); PG8_BAR; PG8_SCHED;
            PG8_STAGE(PG8_SB(0, 1), b2 + hstepB, voffB);
            PG8_WAIT_V(6); PG8_BAR; PG8_MMA(1, 1, At, B1); PG8_BAR;
            PG8_LDB(B0, 1, 0); PG8_SCHED; PG8_LDA(At, 1, 0); PG8_STAGE(PG8_SA(0, 1), a2 + hstepA, voffA);
            PG8_WAIT_L(8); PG8_BAR; PG8_WAIT_L(0); PG8_MMA(0, 0, At, B0); PG8_BAR; PG8_SCHED;
            PG8_LDB(B1, 1, 1); PG8_STAGE(PG8_SB(1, 0), b3, voffB);
            PG8_BAR; PG8_WAIT_L(0); PG8_MMA(0, 1, At, B1); PG8_BAR;
            PG8_LDA(At, 1, 1); PG8_STAGE(PG8_SA(1, 0), a3, voffA);
            PG8_BAR; PG8_WAIT_L(0); PG8_MMA(1, 0, At, B0); PG8_BAR; PG8_SCHED;
            PG8_STAGE(PG8_SB(1, 1), b3 + hstepB, voffB);
            PG8_WAIT_V(6); PG8_BAR; PG8_MMA(1, 1, At, B1); PG8_BAR;
            }
        }
        if constexpr (ALIGN_EPI) { if (wr == 0) PG8_BAR; }
        if constexpr (!Epi::AFTER_DRAIN) { E(acc, cur, wr, wc, fr, fq); S.done(cur); }
        if (!has_next) break;
#pragma unroll
        for (int a = 0; a < 2; ++a)
#pragma unroll
            for (int b = 0; b < 2; ++b)
#pragma unroll
                for (int m = 0; m < 4; ++m)
#pragma unroll
                    for (int n = 0; n < 2; ++n) acc[a][b][m][n] = (f32x4){0.f, 0.f, 0.f, 0.f};
        cur = nxt; cA = nA; cB = nB; ++ui;
        if constexpr (ALIGN_EPI) { if (wr == 1) PG8_BAR; }
    }
    PG8_WAIT_V(0);
    if constexpr (!ALIGN_EPI) { if (wr == 0) PG8_BAR; }
    PG8_BAR;
    if constexpr (Epi::AFTER_DRAIN) { E.fused(acc, cur, wr, wc, fr, fq, lds, wid, lane); S.done(cur); }
#undef PG8_SA
#undef PG8_SB
#undef PG8_STAGE
#undef PG8_LDA
#undef PG8_LDB
#undef PG8_MMA
#undef PG8_WAIT_V
#undef PG8_WAIT_L
#undef PG8_BAR
#undef PG8_SCHED
}
}

constexpr int D = 1024, BATCH = 2, SEQ = 8192, DEPTH = 2, DB = 128, DS = 4, PAST = 2048, PAGE = 128, NPG = 16, NPHYS = 2560;
constexpr int MP = BATCH * SEQ, MS = DB * DS, M = MP + MS;
constexpr int NINP = 3584, FF = 4096, NCOND = BATCH + DB;
constexpr int NH = 4, HD = 128;
constexpr int LCH = 256, NCH = SEQ / LCH, NUNIT = BATCH * NH * NCH;
constexpr int NCB = 17408;
constexpr int XCP = NCB * 16;
constexpr float ALPHA = 1.4142135623730951f;
constexpr float LN_EPS = 1e-5f;
constexpr size_t O_YP = 0, O_YS = O_YP + (size_t)MP * D, O_CMPP = O_YS + (size_t)MS * D, O_CMPS = O_CMPP + (size_t)DEPTH * MP * 256, O_SLCP = O_CMPS + (size_t)DEPTH * MS * 256,
                 O_SLCS = O_SLCP + (size_t)DEPTH * MP * 256, O_WINP = O_SLCS + (size_t)DEPTH * MS * 256, O_WINS = O_WINP + (size_t)DEPTH * BATCH * 512 * 256,
                 O_CP = O_WINS + (size_t)DEPTH * DB * 512 * 256, O_CS = O_CP + (size_t)DEPTH * BATCH * NH * HD * HD, O_NP = O_CS + (size_t)DEPTH * DB * NH * HD * HD,
                 O_NS = O_NP + (size_t)DEPTH * BATCH * NH * HD, O_MP = O_NS + (size_t)DEPTH * DB * NH * HD, O_MS = O_MP + (size_t)DEPTH * BATCH * NH, O_END = O_MS + (size_t)DEPTH * DB * NH;

constexpr size_t al1m(size_t x) { return (x + 0xFFFFFull) & ~(size_t)0xFFFFFull; }
constexpr size_t WS_CTL = 0, CTL_ZERO_BYTES = 1u << 20;
constexpr size_t WS_WIN  = CTL_ZERO_BYTES;
constexpr size_t WS_WOUT = WS_WIN  + al1m((size_t)DEPTH * NINP * D * 2);
constexpr size_t WS_WUP  = WS_WOUT + al1m((size_t)DEPTH * D * D * 2);
constexpr size_t WS_WDN  = WS_WUP  + al1m((size_t)DEPTH * FF * D * 2);
constexpr size_t WS_W1   = WS_WDN  + al1m((size_t)DEPTH * D * FF * 2);
constexpr size_t WS_ADA  = WS_W1   + al1m((size_t)DEPTH * 2 * 256 * 2048 * 2);
constexpr size_t WS_B1   = WS_ADA  + al1m((size_t)DEPTH * NCOND * 6144 * 4);
constexpr size_t WS_BT   = WS_B1   + al1m(4096);
constexpr size_t WS_X    = WS_BT   + al1m(8 * 132 * 4);
constexpr size_t WS_Z    = WS_X    + al1m((size_t)M * D * 4);
constexpr size_t WS_U    = WS_Z    + al1m((size_t)M * D * 4);
constexpr size_t WS_QKVO = WS_U    + al1m((size_t)M * D * 2);
constexpr size_t WS_NQ   = WS_QKVO + al1m((size_t)M * 2048 * 2);
constexpr size_t WS_GATE = WS_NQ   + al1m((size_t)M * 512 * 2);
constexpr size_t WS_KVR  = WS_GATE + al1m((size_t)M * 32 * 4);
constexpr size_t WS_XC   = WS_KVR  + al1m((size_t)3 * M * 256 * 4);
constexpr size_t WS_HID  = WS_XC   + al1m((size_t)DEPTH * 4 * XCP * 64 * 2 + 4096);
constexpr size_t WS_CKV  = WS_HID  + al1m((size_t)DEPTH * 4 * NCB * 256 * 2);
constexpr size_t WS_KS   = WS_CKV  + al1m((size_t)DEPTH * 4 * NCB * 64 * 4);
constexpr size_t WS_VTS  = WS_KS   + al1m((size_t)DEPTH * 2 * (MP + DB * 2112) * 64 * 2 + 65536);
constexpr size_t WS_KW   = WS_VTS  + al1m((size_t)DEPTH * 2 * (MP + DB * 2112) * 64 * 2 + 65536);
constexpr size_t WS_VTW  = WS_KW   + al1m((size_t)DEPTH * 2 * (MP + DB * 528 + 64) * 64 * 2 + 65536);
constexpr size_t WS_KC   = WS_VTW  + al1m((size_t)DEPTH * 2 * (MP + DB * 528 + 64) * 64 * 2 + 65536);
constexpr size_t WS_VCT  = WS_KC   + al1m((size_t)DEPTH * 2 * NCB * 64 * 2 + 65536);
constexpr size_t WS_W2T  = WS_VCT  + al1m((size_t)DEPTH * 2 * NCB * 64 * 2 + 65536);
constexpr size_t WS_MIX  = WS_W2T  + al1m(65536);
constexpr size_t WS_H    = WS_MIX  + al1m((size_t)M * D * 2);
constexpr size_t WS_DCT  = WS_H    + al1m((size_t)M * FF * 2);
constexpr size_t WS_DN   = WS_DCT  + al1m((size_t)NUNIT * HD * HD * 4);
constexpr size_t WS_CHS  = WS_DN   + al1m((size_t)NUNIT * HD * 4);
constexpr size_t WS_CTP  = WS_CHS  + al1m((size_t)NUNIT * 4 * 4);
constexpr size_t WS_NPV  = WS_CTP  + al1m((size_t)NUNIT * HD * HD * 2);
constexpr size_t WS_WSC  = WS_NPV  + al1m((size_t)NUNIT * HD * 4);
constexpr size_t WS_HRAW = WS_WSC  + al1m((size_t)NUNIT * LCH * LCH * 4);
constexpr size_t WS_END  = WS_HRAW + al1m((size_t)NUNIT * LCH * HD * 4);

constexpr int CW_BAR = 4096;

constexpr int RING_BYTES = 131072, LDSCTL_OFF = RING_BYTES, MISC_OFF = LDSCTL_OFF + 320, LDS_BYTES = 147456;
constexpr int NWAVES = 8, NTHR = NWAVES * 64;

#define GAS __attribute__((address_space(1)))
#define LAS __attribute__((address_space(3)))
typedef unsigned short bf16;
typedef unsigned v4u __attribute__((ext_vector_type(4)));
typedef unsigned v2u __attribute__((ext_vector_type(2)));
typedef float f32x4 __attribute__((ext_vector_type(4)));
typedef float f32x2 __attribute__((ext_vector_type(2)));

__device__ __forceinline__ unsigned f2bf(float f) { unsigned u = __builtin_bit_cast(unsigned, f); return (u + 0x7fffu + ((u >> 16) & 1u)) >> 16; }
__device__ __forceinline__ unsigned pk2(float lo, float hi) { return f2bf(lo) | (f2bf(hi) << 16); }
__device__ __forceinline__ float bflo(unsigned u) { return __builtin_bit_cast(float, u << 16); }
__device__ __forceinline__ float bfhi(unsigned u) { return __builtin_bit_cast(float, u & 0xffff0000u); }
__device__ __forceinline__ float bf2f(bf16 h) { return __builtin_bit_cast(float, (unsigned)h << 16); }
__device__ __forceinline__ float sigmoidf_(float x) { return 1.f / (1.f + __expf(-x)); }
__device__ __forceinline__ float wave_sum(float v) {
#pragma unroll
    for (int o = 1; o < 64; o <<= 1) v += __shfl_xor(v, o);
    return v;
}
__device__ __forceinline__ float wave_max(float v) {
#pragma unroll
    for (int o = 1; o < 64; o <<= 1) v = fmaxf(v, __shfl_xor(v, o));
    return v;
}

#define XB_TMO      128
#define XB_XCNT(j)  (256  + 64 * (j))
#define XB_XSUB(j)  (1280 + 64 * (j))
#define XB_XGEN(j)  (2304 + 64 * (j))
#define XB_TOP      3328
#define XB_TOPGEN   3392
#define XCD_BAR_WORDS 3456
#define XB_SPIN_CAP (1u << 18)

__device__ __forceinline__ unsigned xb_ld(unsigned* p)              { return __hip_atomic_load(p, __ATOMIC_RELAXED, __HIP_MEMORY_SCOPE_AGENT); }
__device__ __forceinline__ unsigned xb_add(unsigned* p, unsigned v) { return __hip_atomic_fetch_add(p, v, __ATOMIC_RELAXED, __HIP_MEMORY_SCOPE_AGENT); }
__device__ __forceinline__ unsigned xb_xcc_id() { return (unsigned)__builtin_amdgcn_s_getreg((3 << 11) | 20) & 0xFu; }
#define XB_SPIN(cond, bar) do { unsigned _sp = 0; while (cond) { __builtin_amdgcn_s_sleep(1); \
    if ((++_sp & 255u) == 0u) { if (xb_ld(&(bar)[XB_TMO])) break; if (_sp > XB_SPIN_CAP) { atomicAdd(&(bar)[XB_TMO], 1u); break; } } } } while (0)

struct XcdBarrier {
    unsigned* bar; unsigned x;
    volatile LAS unsigned* st;
};

__device__ __forceinline__ XcdBarrier xcd_barrier_post(unsigned* bar, volatile LAS unsigned* st) {
    XcdBarrier b; b.bar = bar; b.x = xb_xcc_id(); b.st = st;
    if (threadIdx.x == 0) (void)xb_add(&bar[XB_XCNT(b.x)], 1u);
    return b;
}
__device__ __forceinline__ void xcd_barrier_complete(unsigned* bar, unsigned x, unsigned& nloc, unsigned& nx) {
    const unsigned G = gridDim.x * gridDim.y * gridDim.z;
    unsigned sum, cnt, mine, sp = 0u;
    for (;;) {
        sum = 0u; cnt = 0u; mine = 0u;
#pragma unroll
        for (unsigned j = 0; j < 16; ++j) { const unsigned c = xb_ld(&bar[XB_XCNT(j)]); sum += c; cnt += (c > 0u) ? 1u : 0u; mine = (j == x) ? c : mine; }
        if (sum == G) break;
        __builtin_amdgcn_s_sleep(1);
        if ((++sp & 255u) == 0u) { if (xb_ld(&bar[XB_TMO])) break; if (sp > XB_SPIN_CAP) { atomicAdd(&bar[XB_TMO], 1u); break; } }
    }
    nloc = mine > 0u ? mine : 1u; nx = cnt > 0u ? cnt : 1u;
}

__device__ __forceinline__ void xcd_barrier(const XcdBarrier& b) {
    asm volatile("s_waitcnt vmcnt(0)" ::: "memory");
    __syncthreads();
    if (threadIdx.x == 0) {
        unsigned* bar = b.bar;
        __builtin_amdgcn_s_waitcnt(0);
        unsigned nloc = b.st[0], nx = b.st[1];
        if (nloc == 0u) { xcd_barrier_complete(bar, b.x, nloc, nx); b.st[0] = nloc; b.st[1] = nx; }
        const unsigned old = xb_add(&bar[XB_XSUB(b.x)], 1u);
        const unsigned gen = old / nloc;
        if (old + 1u == (gen + 1u) * nloc) {
            __builtin_amdgcn_fence(__ATOMIC_RELEASE, "agent");
            asm volatile("s_waitcnt vmcnt(0)" ::: "memory");
            const unsigned og = xb_add(&bar[XB_TOP], 1u);
            const unsigned tg = og / nx;
            if (og + 1u == (tg + 1u) * nx) xb_add(&bar[XB_TOPGEN], 1u);
            else XB_SPIN(xb_ld(&bar[XB_TOPGEN]) == tg, bar);
            __builtin_amdgcn_fence(__ATOMIC_ACQUIRE, "agent");
            xb_add(&bar[XB_XGEN(b.x)], 1u);
            asm volatile("s_waitcnt vmcnt(0)" ::: "memory");
        } else {
            XB_SPIN(xb_ld(&bar[XB_XGEN(b.x)]) == gen, bar);
            __builtin_amdgcn_fence(__ATOMIC_ACQUIRE, "agent");
            asm volatile("s_waitcnt vmcnt(0)" ::: "memory");
        }
    }
    __syncthreads();
}

struct Args {
    const float* x_prompt; const float* x_sample; const float* cache_cmp; const float* cache_slc; const float* cache_win;
    const float* st_C; const float* st_n; const float* st_m; const int* page_table; const float* c_prompt; const float* c_sample;
    const float* w_ada; const float* b_ada; const float* w_in; const float* b_gate; const float* ml_norm_g; const float* cmp_pe;
    const float* cmp_w1; const float* cmp_w2; const float* rel_bias; const float* w_out; const float* ln_g; const float* ln_b;
    const float* w_up; const float* w_down;
    float* out; unsigned char* ws; int ph_lo, ph_hi;
};
static_assert(sizeof(Args) == 27 * 8 + 8, "Args has no padding");
typedef const __attribute__((address_space(4))) Args CArgs;

__device__ __forceinline__ int cond_of_row(int r) { return r < MP ? (r >> 13) : BATCH + ((r - MP) >> 2); }

struct EpiInProj {
    static constexpr bool PERM = true, AFTER_DRAIN = false;
    bf16* QKVO; bf16* NQ; float* GATE; float* KVR; bf16* XC; float* out; int l;
    __device__ __forceinline__ void operator()(const f32x4 (&acc)[2][2][4][2], const pg8::Unit& u, int wr, int wc, int fr, int fq) const {
        const int row0 = u.pm * 256 + wr * 64 + fr, pn = u.pn, col8 = wc * 32 + 8 * fq;
#pragma unroll
        for (int ai = 0; ai < 2; ++ai)
#pragma unroll
            for (int m = 0; m < 4; ++m) {
                const int r = row0 + ai * 128 + m * 16;
#pragma unroll
                for (int bj = 0; bj < 2; ++bj) {
                    const f32x4 v0 = acc[ai][bj][m][0], v1 = acc[ai][bj][m][1];
                    const int cc = bj * 128 + col8;
                    if (pn < 10) {
                        v4u w; w.x = pk2(v0[0], v0[1]); w.y = pk2(v0[2], v0[3]); w.z = pk2(v1[0], v1[1]); w.w = pk2(v1[2], v1[3]);
                        if (pn < 8) *(v4u*)(QKVO + (size_t)r * 2048 + pn * 256 + cc) = w;
                        else        *(v4u*)(NQ + (size_t)r * 512 + (pn - 8) * 256 + cc) = w;
                    } else if (pn < 13) {
                        const int kind = pn - 10;
                        float* kr = KVR + ((size_t)kind * M + r) * 256 + cc;
                        *(f32x4*)kr = v0; *(f32x4*)(kr + 4) = v1;
                        float* o = nullptr;
                        if (r < MP) {
                            if (kind < 2) o = out + (kind == 0 ? O_CMPP : O_SLCP) + ((size_t)l * MP + r) * 256 + cc;
                            else { const int t = r & (SEQ - 1); if (t >= SEQ - 512) o = out + O_WINP + (((size_t)l * BATCH + (r >> 13)) * 512 + (t - (SEQ - 512))) * 256 + cc; }
                        } else {
                            const int rs = r - MP;
                            if (kind < 2) o = out + (kind == 0 ? O_CMPS : O_SLCS) + ((size_t)l * MS + rs) * 256 + cc;
                            else o = out + O_WINS + (((size_t)l * DB + (rs >> 2)) * 512 + 508 + (rs & 3)) * 256 + cc;
                        }
                        if (o) { *(f32x4*)o = v0; *(f32x4*)(o + 4) = v1; }
                        if (kind == 0 && r < MP) {
                            v4u w; w.x = pk2(v0[0], v0[1]); w.y = pk2(v0[2], v0[3]); w.z = pk2(v1[0], v1[1]); w.w = pk2(v1[2], v1[3]);
                            *(v4u*)(XC + ((size_t)(bj * 2 + (wc >> 1)) * XCP + r) * 64 + (wc & 1) * 32 + 8 * fq) = w;
                        }
                    } else {
                        if (bj == 0 && wc == 0) { float* gp = GATE + (size_t)r * 32 + 8 * fq; *(f32x4*)gp = v0; *(f32x4*)(gp + 4) = v1; }
                    }
                }
            }
    }
};

struct EpiResid {
    static constexpr bool PERM = true, AFTER_DRAIN = false;
    const float* xa; const float* xb; const float* gate; float* Z;
    __device__ __forceinline__ void operator()(const f32x4 (&acc)[2][2][4][2], const pg8::Unit& u, int wr, int wc, int fr, int fq) const {
        const int row0 = u.pm * 256 + wr * 64 + fr, col0 = u.pn * 256 + wc * 32 + 8 * fq;
#pragma unroll
        for (int ai = 0; ai < 2; ++ai)
#pragma unroll
            for (int m = 0; m < 4; ++m) {
                const int r = row0 + ai * 128 + m * 16;
                const float* xr = (r < MP ? xa + (size_t)r * D : xb + (size_t)(r - MP) * D) + col0;
                const float* gr = gate + (size_t)cond_of_row(r) * 6144 + col0;
                float* zr = Z + (size_t)r * D + col0;
#pragma unroll
                for (int bj = 0; bj < 2; ++bj) {
                    const f32x4 x0 = *(const f32x4*)(xr + bj * 128), x1 = *(const f32x4*)(xr + bj * 128 + 4);
                    const f32x4 g0 = *(const f32x4*)(gr + bj * 128), g1 = *(const f32x4*)(gr + bj * 128 + 4);
                    *(f32x4*)(zr + bj * 128) = x0 * ALPHA + g0 * acc[ai][bj][m][0];
                    *(f32x4*)(zr + bj * 128 + 4) = x1 * ALPHA + g1 * acc[ai][bj][m][1];
                }
            }
    }
};

struct EpiRelu2 {
    static constexpr bool PERM = true, AFTER_DRAIN = false;
    bf16* H;
    __device__ __forceinline__ void operator()(const f32x4 (&acc)[2][2][4][2], const pg8::Unit& u, int wr, int wc, int fr, int fq) const {
        const int row0 = u.pm * 256 + wr * 64 + fr, col0 = u.pn * 256 + wc * 32 + 8 * fq;
#pragma unroll
        for (int ai = 0; ai < 2; ++ai)
#pragma unroll
            for (int m = 0; m < 4; ++m) {
                bf16* hr = H + (size_t)(row0 + ai * 128 + m * 16) * FF + col0;
#pragma unroll
                for (int bj = 0; bj < 2; ++bj) {
                    f32x4 a = acc[ai][bj][m][0], b = acc[ai][bj][m][1];
#pragma unroll
                    for (int i = 0; i < 4; ++i) { a[i] = fmaxf(a[i], 0.f); a[i] *= a[i]; b[i] = fmaxf(b[i], 0.f); b[i] *= b[i]; }
                    v4u w; w.x = pk2(a[0], a[1]); w.y = pk2(a[2], a[3]); w.z = pk2(b[0], b[1]); w.w = pk2(b[2], b[3]);
                    *(v4u*)(hr + bj * 128) = w;
                }
            }
    }
};

__device__ __forceinline__ float gelu_tanh(float x) {
    const float y = 0.7978845608028654f * (x + 0.044715f * x * x * x);
    const float t = 1.f - 2.f / (__expf(2.f * y) + 1.f);
    return 0.5f * x * (1.f + t);
}
struct EpiCmpHid {
    static constexpr bool PERM = true, AFTER_DRAIN = false;
    bf16* HID; const float* B1;
    __device__ __forceinline__ void operator()(const f32x4 (&acc)[2][2][4][2], const pg8::Unit& u, int wr, int wc, int fr, int fq) const {
        const int row0 = u.pm * 256 + wr * 64 + fr, col0 = wc * 32 + 8 * fq;
        const float* bp = B1 + u.pn * 256 + col0;
        f32x4 bv[2][2];
#pragma unroll
        for (int bj = 0; bj < 2; ++bj) { bv[bj][0] = *(const f32x4*)(bp + bj * 128); bv[bj][1] = *(const f32x4*)(bp + bj * 128 + 4); }
#pragma unroll
        for (int ai = 0; ai < 2; ++ai)
#pragma unroll
            for (int m = 0; m < 4; ++m) {
                bf16* hr = HID + (size_t)(row0 + ai * 128 + m * 16) * 256 + col0;
#pragma unroll
                for (int bj = 0; bj < 2; ++bj) {
                    f32x4 a = acc[ai][bj][m][0] + bv[bj][0], b = acc[ai][bj][m][1] + bv[bj][1];
#pragma unroll
                    for (int i = 0; i < 4; ++i) { a[i] = gelu_tanh(a[i]); b[i] = gelu_tanh(b[i]); }
                    v4u w; w.x = pk2(a[0], a[1]); w.y = pk2(a[2], a[3]); w.z = pk2(b[0], b[1]); w.w = pk2(b[2], b[3]);
                    *(v4u*)(hr + bj * 128) = w;
                }
            }
    }
};

struct CmpOrder {
    int G, c, l0, nl, t0, ntile;
    __device__ __forceinline__ bool next(int i, pg8::Unit& u) const {
        const int L = i * G + c; if (L >= nl * 4 * ntile) return false;
        const int blk = L / ntile, tile = L % ntile, l = l0 + (blk >> 2), sg = blk & 3;
        u.pm = (l * 4 + sg) * 68 + t0 + tile; u.pn = l * 2 + (sg >> 1); return true;
    }
    __device__ __forceinline__ void a_ready(const pg8::Unit&) const {}
    __device__ __forceinline__ void done(const pg8::Unit&) const {}
};

typedef short sg_bf16x8 __attribute__((ext_vector_type(8)));
template <class Epi>
__device__ __forceinline__ void small_gemm(const bf16* A, size_t strideA, int lda, const bf16* Bt, size_t strideB, int ldb, int K, int nbatch, int Mrows, int N, const Epi& E, LAS unsigned char* lds, int tid) {
    const int lane = tid & 63, wave = tid >> 6, fr = lane & 15, fq = lane >> 4;
    const int ntn = N / 64, ntm = Mrows / 32, ntask = nbatch * ntm * ntn, kw = K / 8;
    LAS f32x4* red = (LAS f32x4*)lds;
    for (int task = blockIdx.x; task < ntask; task += gridDim.x) {
        const int batch = task / (ntm * ntn), tr = task % (ntm * ntn), tm = tr / ntn, tn = tr % ntn;
        const bf16* ap = A + (size_t)batch * strideA + (size_t)(tm * 32 + fr) * lda + wave * kw + 8 * fq;
        const bf16* bp = Bt + (size_t)E.bsel(batch) * strideB + (size_t)(tn * 64 + fr) * ldb + wave * kw + 8 * fq;
        f32x4 acc[2][4];
#pragma unroll
        for (int i = 0; i < 2; ++i)
#pragma unroll
            for (int j = 0; j < 4; ++j) acc[i][j] = (f32x4){0.f, 0.f, 0.f, 0.f};
#pragma unroll 4
        for (int k = 0; k < kw; k += 32) {
            sg_bf16x8 af[2], bf[4];
#pragma unroll
            for (int i = 0; i < 2; ++i) af[i] = *(const sg_bf16x8*)(ap + (size_t)i * 16 * lda + k);
#pragma unroll
            for (int j = 0; j < 4; ++j) bf[j] = *(const sg_bf16x8*)(bp + (size_t)j * 16 * ldb + k);
#pragma unroll
            for (int i = 0; i < 2; ++i)
#pragma unroll
                for (int j = 0; j < 4; ++j) acc[i][j] = __builtin_amdgcn_mfma_f32_16x16x32_bf16(bf[j], af[i], acc[i][j], 0, 0, 0);
        }
        __syncthreads();
#pragma unroll
        for (int i = 0; i < 2; ++i)
#pragma unroll
            for (int j = 0; j < 4; ++j) red[(wave * 8 + i * 4 + j) * 64 + lane] = acc[i][j];
        __syncthreads();
        f32x4 sum = red[wave * 64 + lane];
#pragma unroll
        for (int w = 1; w < 8; ++w) sum = sum + red[(w * 8 + wave) * 64 + lane];
        E(batch, tm * 32 + (wave >> 2) * 16 + fr, tn * 64 + (wave & 3) * 16 + 4 * fq, sum);
    }
}
struct SgResid {
    const float* xb; const float* gate; float* Z;
    __device__ __forceinline__ int bsel(int) const { return 0; }
    __device__ __forceinline__ void operator()(int, int rl, int c, const f32x4& acc) const {
        const int r = MP + rl;
        const f32x4 x = *(const f32x4*)(xb + (size_t)rl * D + c), gg = *(const f32x4*)(gate + (size_t)cond_of_row(r) * 6144 + c);
        *(f32x4*)(Z + (size_t)r * D + c) = x * ALPHA + gg * acc;
    }
};
struct SgRelu2 {
    bf16* H;
    __device__ __forceinline__ int bsel(int) const { return 0; }
    __device__ __forceinline__ void operator()(int, int rl, int c, const f32x4& acc) const {
        f32x4 a = acc;
#pragma unroll
        for (int i = 0; i < 4; ++i) { a[i] = fmaxf(a[i], 0.f); a[i] *= a[i]; }
        v2u w; w.x = pk2(a[0], a[1]); w.y = pk2(a[2], a[3]);
        *(v2u*)(H + (size_t)(MP + rl) * FF + c) = w;
    }
};
struct SgCmpHid {
    bf16* HIDl; const float* B1l;
    __device__ __forceinline__ int bsel(int img) const { return img >> 1; }
    __device__ __forceinline__ void operator()(int img, int R, int c, const f32x4& acc) const {
        const f32x4 bb = *(const f32x4*)(B1l + (img >> 1) * 256 + c);
        f32x4 a = acc + bb;
#pragma unroll
        for (int i = 0; i < 4; ++i) a[i] = gelu_tanh(a[i]);
        v2u w; w.x = pk2(a[0], a[1]); w.y = pk2(a[2], a[3]);
        *(v2u*)(HIDl + ((size_t)img * NCB + R) * 256 + c) = w;
    }
};

#define LDS_WAIT() asm volatile("s_waitcnt lgkmcnt(0)" ::: "memory")
#define VM_WAIT() asm volatile("s_waitcnt vmcnt(0)" ::: "memory")

template <class CM>
__device__ __forceinline__ void transpose_item(const float* W, int ldw, int K, bf16* WT, LAS float* scr, int item, int nblk, int lane, const CM& cm) {
    const int kb = item / nblk, nb = item % nblk, k0 = 64 * kb, n0 = 32 * nb;
    const int sc = cm.col(n0 + (lane & 31)); const float scl = cm.scl(n0 + (lane & 31));
#pragma unroll 8
    for (int i = 0; i < 32; ++i) { const int kk = 2 * i + (lane >> 5); scr[kk * 33 + (lane & 31)] = sc >= 0 ? W[(size_t)(k0 + kk) * ldw + sc] * scl : 0.f; }
    LDS_WAIT();
    const int c = lane & 7;
#pragma unroll
    for (int j = 0; j < 4; ++j) { const int n = (lane >> 3) + 8 * j; const LAS float* s = scr + (8 * c) * 33 + n;
        v4u o; o.x = pk2(s[0 * 33], s[1 * 33]); o.y = pk2(s[2 * 33], s[3 * 33]); o.z = pk2(s[4 * 33], s[5 * 33]); o.w = pk2(s[6 * 33], s[7 * 33]);
        *(v4u*)(WT + (size_t)(n0 + n) * K + k0 + 8 * c) = o; }
    LDS_WAIT();
}
struct CmId { __device__ __forceinline__ int col(int n) const { return n; } __device__ __forceinline__ float scl(int) const { return 1.f; } };
struct CmIn {
    __device__ __forceinline__ int col(int n) const { return n < 2048 ? n : (n < 3328 ? n + 8 : (n < 3336 ? n - 1280 : (n < 3360 ? n : -1))); }
    __device__ __forceinline__ float scl(int n) const { return (n >= 512 && n < 1024) ? 0.08838834764831845f : ((n >= 2048 && n < 2560) ? 0.18033688011112042f : 1.f); }
};

__device__ __forceinline__ int rel_bucket_dev(int n) {
    if (n < 16) return n;
    const float nf = (float)n;
    int large = 16 + (int)(__logf(nf / 16.f) / 2.0794415416798357f * 16.f);
    return large < 31 ? large : 31;
}

__device__ __forceinline__ void phase_p0a(CArgs& A, LAS unsigned char* lds, int gw, int NGW, int lane, int wave) {
    unsigned char* ws = A.ws;
    LAS float* scr = (LAS float*)(lds + wave * 16384);
    constexpr int I_IN = 16 * 112, I_OUT = 16 * 32, I_UP = 16 * 128, I_DN = 64 * 32, I_W1 = 32 * 8;
    constexpr int I_L = I_IN + I_OUT + I_UP + I_DN + 2 * I_W1;
    for (int it = gw; it < DEPTH * I_L; it += NGW) {
        const int l = it / I_L; int r = it % I_L;
        if (r < I_IN) { transpose_item(A.w_in + (size_t)l * D * 3360, 3360, D, (bf16*)(ws + WS_WIN) + (size_t)l * NINP * D, scr, r, 112, lane, CmIn{}); continue; } r -= I_IN;
        if (r < I_OUT) { transpose_item(A.w_out + (size_t)l * D * D, D, D, (bf16*)(ws + WS_WOUT) + (size_t)l * D * D, scr, r, 32, lane, CmId{}); continue; } r -= I_OUT;
        if (r < I_UP) { transpose_item(A.w_up + (size_t)l * D * FF, FF, D, (bf16*)(ws + WS_WUP) + (size_t)l * FF * D, scr, r, 128, lane, CmId{}); continue; } r -= I_UP;
        if (r < I_DN) { transpose_item(A.w_down + (size_t)l * FF * D, D, FF, (bf16*)(ws + WS_WDN) + (size_t)l * D * FF, scr, r, 32, lane, CmId{}); continue; } r -= I_DN;
        const int s = r / I_W1; r %= I_W1;
        transpose_item(A.cmp_w1 + (size_t)(l * 2 + s) * 2048 * 256, 256, 2048, (bf16*)(ws + WS_W1) + (size_t)(l * 2 + s) * 256 * 2048, scr, r, 8, lane, CmId{});
    }
    for (int it = gw; it < DEPTH * DB * NPG * 2; it += NGW) {
        const int half = it & 1, pg = (it >> 1) & 15, seq = (it >> 5) & 127, l = it >> 12;
        const int phys = A.page_table[seq * NPG + pg];
        const float* src = A.cache_cmp + (((size_t)l * NPHYS + phys) * PAGE + half * 64) * 256 + 4 * lane;
        const int cc = 4 * lane, s = cc >> 7, g = (cc >> 6) & 1, d = cc & 63;
        bf16* dst = (bf16*)(ws + WS_XC) + ((size_t)((l * 2 + s) * 2 + g) * XCP + MP + seq * PAST + pg * PAGE + half * 64) * 64 + d;
#pragma unroll 8
        for (int sl = 0; sl < 64; ++sl) { const f32x4 v = *(const f32x4*)(src + (size_t)sl * 256); v2u w; w.x = pk2(v[0], v[1]); w.y = pk2(v[2], v[3]); *(v2u*)(dst + (size_t)sl * 64) = w; }
    }
    for (int it = gw; it < DEPTH * DB * 8; it += NGW) {
        const int ch = it & 7, ls = it >> 3;
        const float* src = A.cache_win + ((size_t)ls * 512 + 4 + ch * 64) * 256 + 4 * lane;
        float* dst = A.out + O_WINS + ((size_t)ls * 512 + ch * 64) * 256 + 4 * lane;
        const int n = ch == 7 ? 60 : 64;
        for (int i = 0; i < n; ++i) *(f32x4*)(dst + (size_t)i * 256) = *(const f32x4*)(src + (size_t)i * 256);
    }
    for (int it = gw; it < 8; it += NGW) {
        float* BT = (float*)(ws + WS_BT) + it * 132;
        for (int dd = lane; dd < 129; dd += 64) BT[dd] = A.rel_bias[rel_bucket_dev(dd) * 8 + it] * 1.4426950408889634f;
    }
    for (int it = gw; it < DEPTH * 2 * 4 * 16; it += NGW) {
        const int kp = it & 15, hq = (it >> 4) & 3, ls = it >> 6, h = hq * 64 + lane;
        const float* pe = A.cmp_pe + (size_t)ls * 2048 + kp * 128; const float* w1 = A.cmp_w1 + ((size_t)ls * 2048 + kp * 128) * 256 + h;
        float acc = 0.f;
#pragma unroll 16
        for (int k = 0; k < 128; ++k) acc += pe[k] * w1[(size_t)k * 256];
        ((float*)(ws + WS_B1))[2048 + (ls * 16 + kp) * 256 + h] = acc;
    }
    for (int it = gw; it < DEPTH * 2 * 64; it += NGW) {
        const int d = it & 63, ls = it >> 6;
        for (int h = lane; h < 256; h += 64) ((bf16*)(ws + WS_W2T))[((size_t)ls * 64 + d) * 256 + h] = (bf16)f2bf(A.cmp_w2[((size_t)ls * 256 + h) * 64 + d]);
    }
}

__device__ __forceinline__ void phase_ada(CArgs& A, LAS unsigned char* lds, int tid) {
    for (int i = blockIdx.x * NTHR + tid; i < DEPTH * 2 * 256; i += gridDim.x * NTHR) { const float* p = (const float*)(A.ws + WS_B1) + 2048 + (i >> 8) * 16 * 256 + (i & 255);
        float acc = 0.f;
#pragma unroll
        for (int kp = 0; kp < 16; ++kp) acc += p[kp * 256];
        ((float*)(A.ws + WS_B1))[i] = acc; }
    LAS float* a = (LAS float*)lds;
    for (int task = blockIdx.x; task < DEPTH * 12 * 10; task += gridDim.x) {
        const int rb = task % 10, cb = (task / 10) % 12, l = task / 120;
        __syncthreads();
        for (int i = tid; i < 13 * 1024; i += NTHR) { const int row = rb * 13 + i / 1024, k = i & 1023;
            const float c = row < BATCH ? A.c_prompt[row * D + k] : A.c_sample[(row - BATCH) * D + k]; a[i] = c / (1.f + __expf(-c)); }
        __syncthreads();
        const int j = cb * 512 + tid;
        const float* w = A.w_ada + (size_t)l * D * 6144 + j;
        float acc[13];
#pragma unroll
        for (int r = 0; r < 13; ++r) acc[r] = 0.f;
        for (int k = 0; k < D; k += 4) { const float w0 = w[(size_t)k * 6144], w1 = w[(size_t)(k + 1) * 6144], w2 = w[(size_t)(k + 2) * 6144], w3 = w[(size_t)(k + 3) * 6144];
#pragma unroll
            for (int r = 0; r < 13; ++r) { const f32x4 a4 = *(const LAS f32x4*)(a + r * 1024 + k); acc[r] += (a4[0] * w0 + a4[1] * w1) + (a4[2] * w2 + a4[3] * w3); } }
        const float bb = A.b_ada[l * 6144 + j];
        float* o = (float*)(A.ws + WS_ADA) + ((size_t)l * NCOND + rb * 13) * 6144 + j;
#pragma unroll
        for (int r = 0; r < 13; ++r) o[(size_t)r * 6144] = acc[r] + bb;
    }
}

__device__ __forceinline__ void mod_row(const float* xrow, const float* sh, const float* sc, bf16* urow, int lane) {
#pragma unroll
    for (int j = 0; j < 4; ++j) { const int c = 4 * lane + 256 * j;
        const f32x4 x = *(const f32x4*)(xrow + c), a = *(const f32x4*)(sh + c), b = *(const f32x4*)(sc + c);
        v2u w; w.x = pk2(x[0] * (1.f + b[0]) + a[0], x[1] * (1.f + b[1]) + a[1]); w.y = pk2(x[2] * (1.f + b[2]) + a[2], x[3] * (1.f + b[3]) + a[3]);
        *(v2u*)(urow + c) = w; }
}
__device__ __forceinline__ void ln_row(const float* zrow, const float* g, const float* b, float* xout, const float* sh, const float* sc, bf16* urow, int lane) {
    f32x4 v[4]; float s = 0.f;
#pragma unroll
    for (int j = 0; j < 4; ++j) { v[j] = *(const f32x4*)(zrow + 4 * lane + 256 * j); s += (v[j][0] + v[j][1]) + (v[j][2] + v[j][3]); }
    const float mean = wave_sum(s) * (1.f / D); float s2 = 0.f;
#pragma unroll
    for (int j = 0; j < 4; ++j) { v[j] = v[j] - mean; s2 += (v[j][0] * v[j][0] + v[j][1] * v[j][1]) + (v[j][2] * v[j][2] + v[j][3] * v[j][3]); }
    const float rstd = 1.f / sqrtf(wave_sum(s2) * (1.f / D) + LN_EPS);
#pragma unroll
    for (int j = 0; j < 4; ++j) { const int c = 4 * lane + 256 * j;
        const f32x4 gg = *(const f32x4*)(g + c), bb = *(const f32x4*)(b + c);
        const f32x4 x = v[j] * rstd * gg + bb;
        *(f32x4*)(xout + c) = x;
        if (urow) { const f32x4 a = *(const f32x4*)(sh + c), q = *(const f32x4*)(sc + c);
            v2u w; w.x = pk2(x[0] * (1.f + q[0]) + a[0], x[1] * (1.f + q[1]) + a[1]); w.y = pk2(x[2] * (1.f + q[2]) + a[2], x[3] * (1.f + q[3]) + a[3]);
            *(v2u*)(urow + c) = w; } }
}

__device__ __forceinline__ float scan_sum256(float v, LAS float* buf, int tid) {
    const int lane = tid & 63, w = tid >> 6;
#pragma unroll
    for (int o = 1; o < 64; o <<= 1) { const float y = __shfl_up(v, o); if (lane >= o) v += y; }
    __syncthreads();
    if (lane == 63) buf[w] = v;
    __syncthreads();
    float add = 0.f;
#pragma unroll
    for (int i = 0; i < 3; ++i) if (i < w) add += buf[i];
    return v + add;
}
__device__ __forceinline__ float scan_max256(float v, LAS float* buf, int tid) {
    const int lane = tid & 63, w = tid >> 6;
#pragma unroll
    for (int o = 1; o < 64; o <<= 1) { const float y = __shfl_up(v, o); if (lane >= o) v = fmaxf(v, y); }
    __syncthreads();
    if (lane == 63) buf[w] = v;
    __syncthreads();
#pragma unroll
    for (int i = 0; i < 3; ++i) if (i < w) v = fmaxf(v, buf[i]);
    return v;
}
__device__ __forceinline__ void ml_gates(CArgs& A, int l, int r, int h, float& ig, float& lf) {
    const float* G = (const float*)(A.ws + WS_GATE) + (size_t)r * 32;
    ig = G[h] + A.b_gate[l * 8 + h];
    const float fr = G[4 + h] + A.b_gate[l * 8 + 4 + h];
    lf = fminf(fr, 0.f) - log1pf(__expf(-fabsf(fr)));
}

__device__ __forceinline__ void phase_m2(CArgs& A, int l, LAS unsigned char* lds, int tid) {
    LAS float* buf = (LAS float*)lds;
    LAS float* wl = (LAS float*)(lds + 1024);
    const bf16* QKVO = (const bf16*)(A.ws + WS_QKVO);
    for (int unit = blockIdx.x; unit < NUNIT; unit += gridDim.x) {
        const int b = unit >> 7, h = (unit >> 5) & 3, c = unit & 31, r0 = b * SEQ + c * LCH;
        float ig = 0.f, lf = 0.f;
        if (tid < 256) ml_gates(A, l, r0 + tid, h, ig, lf);
        const float F = scan_sum256(lf, buf, tid);
        __syncthreads();
        if (tid == 255) buf[16] = F;
        __syncthreads();
        const float Fend = buf[16];
        const float gl = tid < 256 ? Fend - F + ig : -3.0e38f;
        float mw = wave_max(gl);
        if ((tid & 63) == 0) buf[20 + (tid >> 6)] = mw;
        __syncthreads();
        const float mloc = fmaxf(fmaxf(buf[20], buf[21]), fmaxf(buf[22], buf[23]));
        if (tid < 256) wl[tid] = __expf(gl - mloc);
        if (tid == 0) { float* ch = (float*)(A.ws + WS_CHS) + unit * 4; ch[0] = Fend; ch[1] = mloc; }
        __syncthreads();
        const int k = tid & 127, vq = tid >> 7;
        float acc[32]; float accn = 0.f;
#pragma unroll
        for (int i = 0; i < 32; ++i) acc[i] = 0.f;
        const bf16* kp = QKVO + (size_t)r0 * 2048 + 512 + h * HD + k;
        const bf16* vp = QKVO + (size_t)r0 * 2048 + 1024 + h * HD + 32 * vq;
        for (int s = 0; s < LCH; ++s) {
            const float wk = wl[s] * bf2f(kp[(size_t)s * 2048]);
            accn += wk;
            const v4u* v4 = (const v4u*)(vp + (size_t)s * 2048);
#pragma unroll
            for (int q = 0; q < 4; ++q) { const v4u vv = v4[q];
                acc[8 * q + 0] += wk * bflo(vv.x); acc[8 * q + 1] += wk * bfhi(vv.x); acc[8 * q + 2] += wk * bflo(vv.y); acc[8 * q + 3] += wk * bfhi(vv.y);
                acc[8 * q + 4] += wk * bflo(vv.z); acc[8 * q + 5] += wk * bfhi(vv.z); acc[8 * q + 6] += wk * bflo(vv.w); acc[8 * q + 7] += wk * bfhi(vv.w); }
        }
        float* dct = (float*)(A.ws + WS_DCT) + ((size_t)unit * HD + 32 * vq) * HD + k;
#pragma unroll
        for (int i = 0; i < 32; ++i) dct[(size_t)i * HD] = acc[i];
        if (vq == 0) ((float*)(A.ws + WS_DN))[unit * HD + k] = accn;
        __syncthreads();
    }
}

__device__ __forceinline__ void phase_m3(CArgs& A, int l, int tid) {
    for (int task = blockIdx.x; task < BATCH * NH * 33; task += gridDim.x) {
        const int bh = task / 33, part = task % 33;
        const bool isn = part == 32; if (isn && tid >= HD) continue;
        const int e = isn ? tid : part * 512 + tid;
        const float* chs = (const float*)(A.ws + WS_CHS) + (size_t)bh * NCH * 4;
        float st = 0.f, m0 = 0.f;
        for (int c = 0; c < NCH; ++c) {
            const int unit = bh * NCH + c;
            const float Fend = chs[c * 4], mloc = chs[c * 4 + 1];
            float dv;
            if (isn) { ((float*)(A.ws + WS_NPV))[unit * HD + e] = st; dv = ((const float*)(A.ws + WS_DN))[unit * HD + e]; if (tid == 0) ((float*)(A.ws + WS_CHS))[unit * 4 + 2] = m0; }
            else { ((bf16*)(A.ws + WS_CTP))[(size_t)unit * HD * HD + e] = (bf16)f2bf(st); dv = ((const float*)(A.ws + WS_DCT))[(size_t)unit * HD * HD + e]; }
            const float mend = fmaxf(m0 + Fend, mloc);
            st = __expf(m0 + Fend - mend) * st + __expf(mloc - mend) * dv;
            m0 = mend;
        }
        if (isn) { A.out[O_NP + ((size_t)l * BATCH * NH + bh) * HD + e] = st; if (tid == 0) A.out[O_MP + l * BATCH * NH + bh] = m0; }
        else { const int v = e >> 7, k = e & 127; A.out[O_CP + (((size_t)l * BATCH * NH + bh) * HD + k) * HD + v] = st; }
    }
}

__device__ __forceinline__ void phase_m4(CArgs& A, int l, LAS unsigned char* lds, int tid) {
    LAS float* buf = (LAS float*)lds;
    LAS float* sa = (LAS float*)(lds + 1024);
    LAS float* smx = sa + 256;
    LAS float* sdec = smx + 256;
    LAS float* sem = sdec + 256;
    LAS bf16* sv = (LAS bf16*)(lds + 8192);
    const bf16* QKVO = (const bf16*)(A.ws + WS_QKVO);
    const int lane = tid & 63, wave = tid >> 6;
    for (int unit = blockIdx.x; unit < NUNIT; unit += gridDim.x) {
        const int b = unit >> 7, h = (unit >> 5) & 3, c = unit & 31, r0 = b * SEQ + c * LCH;
        float ig = 0.f, lf = 0.f;
        if (tid < 256) ml_gates(A, l, r0 + tid, h, ig, lf);
        const float F = scan_sum256(lf, buf, tid);
        const float a = tid < 256 ? ig - F : -3.0e38f;
        const float cm = scan_max256(a, buf, tid);
        const float m0 = ((const float*)(A.ws + WS_CHS))[unit * 4 + 2];
        if (tid < 256) { const float mx = fmaxf(m0, cm); sa[tid] = a; smx[tid] = mx; sdec[tid] = __expf(m0 - mx); sem[tid] = __expf(-(F + mx)); }
        for (int i = tid; i < LCH * HD / 8; i += NTHR) { const int s = i >> 4, q = i & 15;
            *(LAS v4u*)(sv + s * HD + 8 * q) = *(const v4u*)(QKVO + (size_t)(r0 + s) * 2048 + 1024 + h * HD + 8 * q); }
        __syncthreads();
        float* W = (float*)(A.ws + WS_WSC) + (size_t)unit * LCH * LCH;
        for (int idx = tid; idx < LCH * LCH; idx += NTHR) {
            const int t = idx >> 8, s = idx & 255; float w = 0.f;
            if (s <= t) {
                const v4u* qp = (const v4u*)(QKVO + (size_t)(r0 + t) * 2048 + h * HD); const v4u* kp = (const v4u*)(QKVO + (size_t)(r0 + s) * 2048 + 512 + h * HD);
                float d = 0.f;
#pragma unroll 4
                for (int q = 0; q < 16; ++q) { const v4u x = qp[q], y = kp[q];
                    d += bflo(x.x) * bflo(y.x) + bfhi(x.x) * bfhi(y.x) + bflo(x.y) * bflo(y.y) + bfhi(x.y) * bfhi(y.y)
                       + bflo(x.z) * bflo(y.z) + bfhi(x.z) * bfhi(y.z) + bflo(x.w) * bflo(y.w) + bfhi(x.w) * bfhi(y.w); }
                w = d * __expf(sa[s] - smx[t]);
            }
            W[idx] = w;
        }
        __syncthreads();
        {
            const int v = tid & 127, tq = tid >> 7;
            const bf16* ctp = (const bf16*)(A.ws + WS_CTP) + ((size_t)unit * HD + v) * HD;
            const float* npv = (const float*)(A.ws + WS_NPV) + unit * HD;
            float* hraw = (float*)(A.ws + WS_HRAW) + (size_t)unit * LCH * HD;
            for (int i = 0; i < 64; ++i) {
                const int t = 4 * i + tq;
                float num = 0.f, den = 0.f;
                const float* wr = W + (size_t)t * LCH;
                for (int s = 0; s <= t; s += 4) { const f32x4 w4 = *(const f32x4*)(wr + s);
                    num += w4[0] * bf2f(sv[(s + 0) * HD + v]) + w4[1] * bf2f(sv[(s + 1) * HD + v]) + w4[2] * bf2f(sv[(s + 2) * HD + v]) + w4[3] * bf2f(sv[(s + 3) * HD + v]);
                    den += (w4[0] + w4[1]) + (w4[2] + w4[3]); }
                float qc = 0.f, qn = 0.f;
                const v4u* qp = (const v4u*)(QKVO + (size_t)(r0 + t) * 2048 + h * HD);
#pragma unroll 4
                for (int q = 0; q < 16; ++q) { const v4u x = qp[q], y = *(const v4u*)(ctp + 8 * q); const f32x4 n0 = *(const f32x4*)(npv + 8 * q), n1 = *(const f32x4*)(npv + 8 * q + 4);
                    qc += bflo(x.x) * bflo(y.x) + bfhi(x.x) * bfhi(y.x) + bflo(x.y) * bflo(y.y) + bfhi(x.y) * bfhi(y.y)
                        + bflo(x.z) * bflo(y.z) + bfhi(x.z) * bfhi(y.z) + bflo(x.w) * bflo(y.w) + bfhi(x.w) * bfhi(y.w);
                    qn += bflo(x.x) * n0[0] + bfhi(x.x) * n0[1] + bflo(x.y) * n0[2] + bfhi(x.y) * n0[3] + bflo(x.z) * n1[0] + bfhi(x.z) * n1[1] + bflo(x.w) * n1[2] + bfhi(x.w) * n1[3]; }
                const float dec = sdec[t];
                const float numt = num + dec * qc, dent = den + dec * qn;
                hraw[(size_t)t * HD + v] = numt / fmaxf(fabsf(dent), sem[t]);
            }
        }
        __syncthreads();
        {
            const float* hraw = (const float*)(A.ws + WS_HRAW) + (size_t)unit * LCH * HD;
            const float g0 = A.ml_norm_g[l * 512 + h * HD + lane], g1 = A.ml_norm_g[l * 512 + h * HD + 64 + lane];
            for (int t = wave; t < LCH; t += NWAVES) {
                const float x0 = hraw[(size_t)t * HD + lane], x1 = hraw[(size_t)t * HD + 64 + lane];
                const float mu = wave_sum(x0 + x1) * (1.f / HD);
                const float d0 = x0 - mu, d1 = x1 - mu;
                const float rstd = 1.f / sqrtf(wave_sum(d0 * d0 + d1 * d1) * (1.f / HD) + LN_EPS);
                const bf16* op = QKVO + (size_t)(r0 + t) * 2048 + 1536 + h * HD;
                bf16* mp = (bf16*)(A.ws + WS_MIX) + (size_t)(r0 + t) * D + h * HD;
                mp[lane] = (bf16)f2bf(d0 * rstd * g0 * sigmoidf_(bf2f(op[lane])));
                mp[64 + lane] = (bf16)f2bf(d1 * rstd * g1 * sigmoidf_(bf2f(op[64 + lane])));
            }
        }
        __syncthreads();
    }
}

__device__ __forceinline__ void phase_mls(CArgs& A, int l, LAS unsigned char* lds, int tid) {
    LAS float* sq = (LAS float*)lds;
    LAS float* sc = sq + 1536;
    LAS float* sw = sc + 64;
    LAS float* part = sw + 16;
    LAS float* red = part + 2048;
    const bf16* QKVO = (const bf16*)(A.ws + WS_QKVO);
    for (int task = blockIdx.x; task < DB * NH; task += gridDim.x) {
        const int seq = task >> 2, h = task & 3, r0 = MP + seq * DS, sidx = (l * DB + seq) * NH + h;
        __syncthreads();
        for (int i = tid; i < 1536; i += NTHR) { const int which = i >> 9, t = (i >> 7) & 3, d = i & 127; sq[i] = bf2f(QKVO[(size_t)(r0 + t) * 2048 + which * 512 + h * HD + d]); }
        const float m0 = A.st_m[sidx];
        if (tid == 0) {
            float F = 0.f, cmx = -3.0e38f, Fs[4], igs[4], mlast = 0.f;
#pragma unroll
            for (int t = 0; t < 4; ++t) { float ig, lf; ml_gates(A, l, r0 + t, h, ig, lf); F += lf; Fs[t] = F; igs[t] = ig; const float a = ig - F; cmx = fmaxf(cmx, a); const float mx = fmaxf(m0, cmx);
                sc[8 + t] = a; sc[12 + t] = mx; sc[16 + t] = __expf(m0 - mx); sc[20 + t] = __expf(-(F + mx)); mlast = F + mx; }
#pragma unroll
            for (int t = 0; t < 4; ++t) sc[24 + t] = __expf(Fs[3] - Fs[t] + igs[t] - mlast);
            sc[28] = __expf(Fs[3] + m0 - mlast); sc[29] = mlast;
        }
        __syncthreads();
        if (tid < 16) { const int t = tid >> 2, s = tid & 3; float w = 0.f;
            if (s <= t) { float d = 0.f; for (int k = 0; k < HD; ++k) d += sq[t * HD + k] * sq[512 + s * HD + k]; w = d * __expf(sc[8 + s] - sc[12 + t]); }
            sw[tid] = w; }
        else if (tid < 20) { const int t = tid - 16; const float* n0 = A.st_n + (size_t)sidx * HD; float d = 0.f; for (int k = 0; k < HD; ++k) d += sq[t * HD + k] * n0[k]; sc[32 + t] = d; }
        __syncthreads();
        {
            const int v = tid & 127, kq = tid >> 7;
            const float* C0 = A.st_C + (size_t)sidx * HD * HD; float* Co = A.out + O_CS + (size_t)sidx * HD * HD;
            const float cd = sc[28];
            float wv[4]; float qc[4] = {0.f, 0.f, 0.f, 0.f};
#pragma unroll
            for (int t = 0; t < 4; ++t) wv[t] = sc[24 + t] * sq[1024 + t * HD + v];
            for (int kk = 0; kk < 32; ++kk) { const int k = kq * 32 + kk; const float c0 = C0[(size_t)k * HD + v];
                float cn = cd * c0;
#pragma unroll
                for (int t = 0; t < 4; ++t) { qc[t] += sq[t * HD + k] * c0; cn += wv[t] * sq[512 + t * HD + k]; }
                Co[(size_t)k * HD + v] = cn; }
#pragma unroll
            for (int t = 0; t < 4; ++t) part[(kq * 4 + t) * HD + v] = qc[t];
        }
        __syncthreads();
        float hv[4] = {0.f, 0.f, 0.f, 0.f};
        if (tid < HD) {
            const int v = tid;
#pragma unroll
            for (int t = 0; t < 4; ++t) { const float qct = part[(0 * 4 + t) * HD + v] + part[(1 * 4 + t) * HD + v] + part[(2 * 4 + t) * HD + v] + part[(3 * 4 + t) * HD + v];
                float num = sc[16 + t] * qct, den = sc[16 + t] * sc[32 + t];
#pragma unroll
                for (int s = 0; s < 4; ++s) { num += sw[t * 4 + s] * sq[1024 + s * HD + v]; den += sw[t * 4 + s]; }
                hv[t] = num / fmaxf(fabsf(den), sc[20 + t]); }
        }
#pragma unroll
        for (int t = 0; t < 4; ++t) { const float s1 = wave_sum(hv[t]); if ((tid & 63) == 0 && tid < HD) red[t * 2 + (tid >> 6)] = s1; }
        __syncthreads();
        float dv[4];
#pragma unroll
        for (int t = 0; t < 4; ++t) { dv[t] = hv[t] - (red[t * 2] + red[t * 2 + 1]) * (1.f / HD); const float s2 = wave_sum(dv[t] * dv[t]); if ((tid & 63) == 0 && tid < HD) red[8 + t * 2 + (tid >> 6)] = s2; }
        __syncthreads();
        if (tid < HD) {
            const int v = tid; const float gn = A.ml_norm_g[l * 512 + h * HD + v];
#pragma unroll
            for (int t = 0; t < 4; ++t) { const float rstd = 1.f / sqrtf((red[8 + t * 2] + red[8 + t * 2 + 1]) * (1.f / HD) + LN_EPS);
                const float og = bf2f(QKVO[(size_t)(r0 + t) * 2048 + 1536 + h * HD + v]);
                ((bf16*)(A.ws + WS_MIX))[(size_t)(r0 + t) * D + h * HD + v] = (bf16)f2bf(dv[t] * rstd * gn * sigmoidf_(og)); }
        } else if (tid < 2 * HD) {
            const int k = tid - HD; float nn = sc[28] * A.st_n[(size_t)sidx * HD + k];
#pragma unroll
            for (int t = 0; t < 4; ++t) nn += sc[24 + t] * sq[512 + t * HD + k];
            A.out[O_NS + (size_t)sidx * HD + k] = nn;
        }
        if (tid == 0) A.out[O_MS + sidx] = sc[29];
    }
}

typedef short bf16x8c __attribute__((ext_vector_type(8)));
__device__ __forceinline__ void phase_cmp2(CArgs& A, int l0, int nl, int r_lo, int nrows, int gw, int NGW, int lane) {
    const int fr = lane & 15, fq = lane >> 4, ntile = nrows / 16;
    for (int task = gw; task < nl * 4 * ntile; task += NGW) {
        const int img = task / ntile, tr = task % ntile, l = l0 + (img >> 2), sg = img & 3, s = sg >> 1, g = sg & 1, R0 = r_lo + tr * 16;
        const bf16* hp = (const bf16*)(A.ws + WS_HID) + ((size_t)(l * 4 + sg) * NCB + R0 + fr) * 256 + 8 * fq;
        const bf16* wp = (const bf16*)(A.ws + WS_W2T) + ((size_t)(l * 2 + s) * 64 + fr) * 256 + 8 * fq;
        f32x4 acc[4];
#pragma unroll
        for (int dt = 0; dt < 4; ++dt) acc[dt] = (f32x4){0.f, 0.f, 0.f, 0.f};
#pragma unroll
        for (int ks = 0; ks < 8; ++ks) {
            const bf16x8c hf = *(const bf16x8c*)(hp + 32 * ks);
#pragma unroll
            for (int dt = 0; dt < 4; ++dt) { const bf16x8c wf = *(const bf16x8c*)(wp + (size_t)dt * 16 * 256 + 32 * ks);
                acc[dt] = s == 0 ? __builtin_amdgcn_mfma_f32_16x16x32_bf16(wf, hf, acc[dt], 0, 0, 0) : __builtin_amdgcn_mfma_f32_16x16x32_bf16(hf, wf, acc[dt], 0, 0, 0); }
        }
        if (s == 0) {
            bf16* o = (bf16*)(A.ws + WS_KC) + ((size_t)(l * 2 + g) * NCB + R0 + fr) * 64 + 4 * fq;
#pragma unroll
            for (int dt = 0; dt < 4; ++dt) { v2u w; w.x = pk2(acc[dt][0], acc[dt][1]); w.y = pk2(acc[dt][2], acc[dt][3]); *(v2u*)(o + 16 * dt) = w; }
        } else {
            bf16* o = (bf16*)(A.ws + WS_VCT) + ((size_t)(l * 2 + g) * 64 + fr) * NCB + R0 + 4 * fq;
#pragma unroll
            for (int dt = 0; dt < 4; ++dt) { v2u w; w.x = pk2(acc[dt][0], acc[dt][1]); w.y = pk2(acc[dt][2], acc[dt][3]); *(v2u*)(o + (size_t)dt * 16 * NCB) = w; }
        }
    }
}

__device__ __forceinline__ void topk_sel(float imp0, float imp1, int cur, int lane, unsigned long long& s0, unsigned long long& s1) {
    const int nforced = cur == 0 ? 1 : (cur == 1 ? 2 : 3), need = 16 - nforced, ncand = cur - 2 > 0 ? cur - 2 : 0;
    const unsigned k0 = (lane >= 1 && lane <= cur - 2) ? __builtin_bit_cast(unsigned, imp0) + 1u : 0u;
    const unsigned k1 = (lane + 64 <= cur - 2) ? __builtin_bit_cast(unsigned, imp1) + 1u : 0u;
    unsigned long long c0, c1;
    if (ncand <= need) { c0 = __ballot(k0 != 0u); c1 = __ballot(k1 != 0u); }
    else {
        unsigned T = 0u;
        for (int bit = 31; bit >= 0; --bit) { const unsigned cand = T | (1u << bit);
            const int cnt = __popcll(__ballot(k0 >= cand)) + __popcll(__ballot(k1 >= cand)); if (cnt >= need) T = cand; }
        const unsigned long long g0 = __ballot(k0 > T), g1 = __ballot(k1 > T); unsigned long long e0 = __ballot(k0 == T), e1 = __ballot(k1 == T);
        int rem = need - __popcll(g0) - __popcll(g1);
        unsigned long long t0 = 0ull, t1 = 0ull;
        while (rem > 0 && e0) { const unsigned long long lb = e0 & (~e0 + 1ull); t0 |= lb; e0 ^= lb; --rem; }
        while (rem > 0 && e1) { const unsigned long long lb = e1 & (~e1 + 1ull); t1 |= lb; e1 ^= lb; --rem; }
        c0 = g0 | t0; c1 = g1 | t1;
    }
    unsigned long long f0 = 1ull, f1 = 0ull;
    if (cur < 64) f0 |= 1ull << cur; else f1 |= 1ull << (cur - 64);
    if (cur >= 1) { if (cur - 1 < 64) f0 |= 1ull << (cur - 1); else f1 |= 1ull << (cur - 65); }
    s0 = c0 | f0; s1 = c1 | f1;
}


typedef short bf16x8 __attribute__((ext_vector_type(8)));
#define MFMA16(a, b, c) __builtin_amdgcn_mfma_f32_16x16x32_bf16((a), (b), (c), 0, 0, 0)
constexpr int TOTS = MP + DB * 2112, TOTW = MP + DB * 528, TOTWP = TOTW + 64;
constexpr size_t KS_L = (size_t)2 * TOTS * 64, KW_L = (size_t)2 * TOTWP * 64, KC_L = (size_t)2 * NCB * 64;

__device__ __forceinline__ void kv_tile64(const float* src, bf16* Kimg, size_t kgs, bf16* Vt, size_t vgs, size_t vpitch, size_t gp0, LAS bf16* scr, int lane) {
    const int cc = 4 * lane, s = cc >> 7, g = (cc >> 6) & 1, d = cc & 63;
#pragma unroll 8
    for (int sl = 0; sl < 64; ++sl) {
        const f32x4 v = *(const f32x4*)(src + (size_t)sl * 256 + cc);
        v2u w; w.x = pk2(v[0], v[1]); w.y = pk2(v[2], v[3]);
        if (s == 0) *(v2u*)(Kimg + (size_t)g * kgs + (gp0 + sl) * 64 + d) = w;
        else *(LAS v2u*)(scr + sl * 128 + (cc - 128)) = w;
    }
    LDS_WAIT();
#pragma unroll
    for (int g2 = 0; g2 < 2; ++g2) {
        const int gd = lane + 64 * g2;
        bf16* dst = Vt + (size_t)g2 * vgs + (size_t)lane * vpitch + gp0;
#pragma unroll
        for (int oc = 0; oc < 8; ++oc) {
            const LAS bf16* p = scr + (8 * oc) * 128 + gd;
            v4u o; o.x = (unsigned)p[0] | ((unsigned)p[128] << 16); o.y = (unsigned)p[256] | ((unsigned)p[384] << 16); o.z = (unsigned)p[512] | ((unsigned)p[640] << 16); o.w = (unsigned)p[768] | ((unsigned)p[896] << 16);
            *(v4u*)(dst + 8 * oc) = o;
        }
    }
    LDS_WAIT();
}

__device__ __forceinline__ void prep_cache_images(CArgs& A, LAS unsigned char* lds, int gw, int NGW, int lane, int wave) {
    LAS bf16* scr = (LAS bf16*)(lds + wave * 16384);
    bf16* KS = (bf16*)(A.ws + WS_KS); bf16* VTS = (bf16*)(A.ws + WS_VTS); bf16* KW = (bf16*)(A.ws + WS_KW); bf16* VTW = (bf16*)(A.ws + WS_VTW);
    for (int it = gw; it < DEPTH * DB * 32; it += NGW) {
        const int ti = it & 31, seq = (it >> 5) & 127, l = it >> 12;
        const int phys = A.page_table[seq * NPG + (ti >> 1)];
        const float* src = A.cache_slc + (((size_t)l * NPHYS + phys) * PAGE + (ti & 1) * 64) * 256;
        kv_tile64(src, KS + l * KS_L, (size_t)TOTS * 64, VTS + l * KS_L, (size_t)64 * TOTS, TOTS, (size_t)MP + seq * 2112 + ti * 64, scr, lane);
    }
    for (int it = gw; it < DEPTH * DB * 8; it += NGW) {
        const int ti = it & 7, ls = it >> 3, seq = ls & 127, l = ls >> 7;
        const float* src = A.cache_win + ((size_t)ls * 512 + ti * 64) * 256;
        kv_tile64(src, KW + l * KW_L, (size_t)TOTWP * 64, VTW + l * KW_L, (size_t)64 * TOTWP, TOTWP, (size_t)MP + seq * 528 + ti * 64, scr, lane);
    }
}
__device__ __forceinline__ void prep_layer_images(CArgs& A, int l, LAS unsigned char* lds, int gw, int NGW, int lane, int wave) {
    LAS bf16* scr = (LAS bf16*)(lds + wave * 16384);
    bf16* KS = (bf16*)(A.ws + WS_KS) + l * KS_L; bf16* VTS = (bf16*)(A.ws + WS_VTS) + l * KS_L; bf16* KW = (bf16*)(A.ws + WS_KW) + l * KW_L; bf16* VTW = (bf16*)(A.ws + WS_VTW) + l * KW_L;
    const float* KVR = (const float*)(A.ws + WS_KVR);
    for (int it = gw; it < 2 * (MP / 64); it += NGW) {
        const int kind = it / (MP / 64), ti = it % (MP / 64);
        const float* src = KVR + ((size_t)(1 + kind) * M + ti * 64) * 256;
        if (kind == 0) kv_tile64(src, KS, (size_t)TOTS * 64, VTS, (size_t)64 * TOTS, TOTS, (size_t)ti * 64, scr, lane);
        else           kv_tile64(src, KW, (size_t)TOTWP * 64, VTW, (size_t)64 * TOTWP, TOTWP, (size_t)ti * 64, scr, lane);
    }
    for (int it = gw; it < 2 * DB; it += NGW) {
        const int kind = it / DB, seq = it % DB;
        const float* src = KVR + ((size_t)(1 + kind) * M + MP + seq * DS) * 256;
        bf16* Kimg = kind == 0 ? KS : KW; bf16* Vt = kind == 0 ? VTS : VTW;
        const size_t tot = kind == 0 ? TOTS : TOTWP, gp0 = kind == 0 ? (size_t)MP + seq * 2112 + PAST : (size_t)MP + seq * 528 + 512;
        const int cc = 4 * lane, s = cc >> 7, g = (cc >> 6) & 1, d = cc & 63;
#pragma unroll
        for (int t = 0; t < DS; ++t) {
            const f32x4 v = *(const f32x4*)(src + (size_t)t * 256 + cc);
            if (s == 0) { v2u w; w.x = pk2(v[0], v[1]); w.y = pk2(v[2], v[3]); *(v2u*)(Kimg + (size_t)g * tot * 64 + (gp0 + t) * 64 + d) = w; }
            else {
#pragma unroll
                for (int i = 0; i < 4; ++i) Vt[(size_t)g * 64 * tot + (size_t)(d + i) * tot + gp0 + t] = (bf16)f2bf(v[i]);
            }
        }
    }
}

struct KV { bf16x8 k[8]; v4u v[8]; };
__device__ __forceinline__ void k_load(KV& f, const bf16* Kb, int fr, int fq) {
#pragma unroll
    for (int t = 0; t < 4; ++t) { f.k[2 * t] = *(const bf16x8*)(Kb + (size_t)(16 * t + fr) * 64 + 8 * fq); f.k[2 * t + 1] = *(const bf16x8*)(Kb + (size_t)(16 * t + fr) * 64 + 32 + 8 * fq); }
}
__device__ __forceinline__ void v_load(KV& f, const bf16* Vb, size_t pitch, int fr, int fq) {
#pragma unroll
    for (int h = 0; h < 2; ++h)
#pragma unroll
        for (int dt = 0; dt < 4; ++dt) { const bf16* vp = Vb + (size_t)(16 * dt + fr) * pitch + 32 * h + 4 * fq;
            const v2u a = *(const v2u*)vp, b = *(const v2u*)(vp + 16); v4u w; w.x = a.x; w.y = a.y; w.z = b.x; w.w = b.y; f.v[4 * h + dt] = w; }
}
__device__ __forceinline__ void qk_frag(const KV& f, const bf16x8 (&q)[2], f32x4 (&st)[4]) {
#pragma unroll
    for (int t = 0; t < 4; ++t) { f32x4 z = {0.f, 0.f, 0.f, 0.f}; z = MFMA16(f.k[2 * t], q[0], z); st[t] = MFMA16(f.k[2 * t + 1], q[1], z); }
}
__device__ __forceinline__ void pv_frag(const KV& f, const f32x4 (&st)[4], f32x4 (&o)[4]) {
#pragma unroll
    for (int h = 0; h < 2; ++h) {
        v4u pw; pw.x = pk2(st[2 * h][0], st[2 * h][1]); pw.y = pk2(st[2 * h][2], st[2 * h][3]); pw.z = pk2(st[2 * h + 1][0], st[2 * h + 1][1]); pw.w = pk2(st[2 * h + 1][2], st[2 * h + 1][3]);
        const bf16x8 pf = __builtin_bit_cast(bf16x8, pw);
#pragma unroll
        for (int dt = 0; dt < 4; ++dt) o[dt] = MFMA16(__builtin_bit_cast(bf16x8, f.v[4 * h + dt]), pf, o[dt]);
    }
}
__device__ __forceinline__ float xfq_max(float v) { v = fmaxf(v, __shfl_xor(v, 16)); return fmaxf(v, __shfl_xor(v, 32)); }
__device__ __forceinline__ float xfq_sum(float v) { v += __shfl_xor(v, 16); return v + __shfl_xor(v, 32); }
__device__ __forceinline__ float quad_sum(float v) { v += __shfl_xor(v, 1); return v + __shfl_xor(v, 2); }

__device__ __forceinline__ void softmax_pv(const KV& f, f32x4 (&st)[4], f32x4 (&o)[4], float& m, float& ls) {
    float bm = -INFINITY;
#pragma unroll
    for (int t = 0; t < 4; ++t) bm = fmaxf(bm, fmaxf(fmaxf(st[t][0], st[t][1]), fmaxf(st[t][2], st[t][3])));
    bm = xfq_max(bm);
    const float mn = fmaxf(m, bm), sc = __builtin_amdgcn_exp2f(m - mn);
    m = mn; ls *= sc;
#pragma unroll
    for (int dt = 0; dt < 4; ++dt) o[dt] = o[dt] * sc;
#pragma unroll
    for (int t = 0; t < 4; ++t)
#pragma unroll
        for (int i = 0; i < 4; ++i) { const float p = __builtin_amdgcn_exp2f(st[t][i] - mn); st[t][i] = p; ls += p; }
    pv_frag(f, st, o);
}
template <class Br>
__device__ __forceinline__ void run_branch(Br& br, const bf16x8 (&q)[2], int fr, int fq, f32x4 (&o)[4], float& m, float& ls) {
    int j;
    if (!br.first(j)) return;
    KV cur; k_load(cur, br.kp(j), fr, fq); v_load(cur, br.vp(j), br.pitch, fr, fq);
    for (;;) {
        int jn = 0; const bool hn = br.next(jn);
        KV nxt;
        if (hn) { k_load(nxt, br.kp(jn), fr, fq); v_load(nxt, br.vp(jn), br.pitch, fr, fq); }
        f32x4 st[4]; qk_frag(cur, q, st);
        br.mask(st, j);
        softmax_pv(cur, st, o, m, ls);
        if (!hn) break;
        cur = nxt; j = jn;
    }
}
struct BrSel {
    const bf16* K; const bf16* V; size_t pitch; unsigned long long u0, u1, my0, my1; int cur, qpos, fq; const LAS float* bt; float farb;
    __device__ __forceinline__ bool pop(int& j) { if (u0) { j = __builtin_ctzll(u0); u0 &= u0 - 1ull; return true; } if (u1) { j = 64 + __builtin_ctzll(u1); u1 &= u1 - 1ull; return true; } return false; }
    __device__ __forceinline__ bool first(int& j) { return pop(j); }
    __device__ __forceinline__ bool next(int& j) { return pop(j); }
    __device__ __forceinline__ const bf16* kp(int j) const { return K + (size_t)j * 64 * 64; }
    __device__ __forceinline__ const bf16* vp(int j) const { return V + (size_t)j * 64; }
    __device__ __forceinline__ void mask(f32x4 (&st)[4], int j) const {
        const bool mine = j < 64 ? ((my0 >> j) & 1ull) != 0ull : ((my1 >> (j - 64)) & 1ull) != 0ull;
        if (j >= cur - 2) {
#pragma unroll
            for (int t = 0; t < 4; ++t)
#pragma unroll
                for (int i = 0; i < 4; ++i) { const int dist = qpos - (64 * j + 16 * t + 4 * fq + i); st[t][i] = (mine && dist >= 0) ? st[t][i] + bt[dist > 128 ? 128 : dist] : -INFINITY; }
        } else {
#pragma unroll
            for (int t = 0; t < 4; ++t)
#pragma unroll
                for (int i = 0; i < 4; ++i) st[t][i] = mine ? st[t][i] + farb : -INFINITY;
        }
    }
};
struct BrWin {
    const bf16* K; const bf16* V; size_t pitch; int jb, cur, qpos, fq; const LAS float* bt;
    __device__ __forceinline__ bool first(int& j) { j = jb; return jb <= cur; }
    __device__ __forceinline__ bool next(int& j) { ++jb; j = jb; return jb <= cur; }
    __device__ __forceinline__ const bf16* kp(int j) const { return K + (long)j * 64 * 64; }
    __device__ __forceinline__ const bf16* vp(int j) const { return V + (long)j * 64; }
    __device__ __forceinline__ void mask(f32x4 (&st)[4], int j) const {
#pragma unroll
        for (int t = 0; t < 4; ++t)
#pragma unroll
            for (int i = 0; i < 4; ++i) { const int dist = qpos - (64 * j + 16 * t + 4 * fq + i); st[t][i] = (dist >= 0 && dist < 512) ? st[t][i] + bt[dist > 128 ? 128 : dist] : -INFINITY; }
    }
};

__device__ __forceinline__ void nsa_tile(CArgs& A, int l, bool smp, int bs, int g, int tq, LAS float* wl, const LAS float* BT, int lane) {
    asm volatile("" : "+v"(lane));
    const int fr = lane & 15, fq = lane >> 4, tl = fr >> 2, rr = fr & 3;
    const int qpos0 = smp ? PAST : 4 * tq, row0 = smp ? MP + bs * DS : bs * SEQ + qpos0;
    const int qpos = qpos0 + tl, cur = qpos0 >> 6, h = g * 4 + rr;
    const size_t sbase = smp ? (size_t)MP + bs * 2112 : (size_t)bs * SEQ;
    const long wbase = smp ? (long)MP + bs * 528 - (PAST - 512) : (long)bs * SEQ;
    const size_t cbase = smp ? (size_t)1024 + bs * 128 : (size_t)bs * 512;
    const bf16* KS = (const bf16*)(A.ws + WS_KS) + l * KS_L + (size_t)g * TOTS * 64; const bf16* VTS = (const bf16*)(A.ws + WS_VTS) + l * KS_L + (size_t)g * 64 * TOTS;
    const bf16* KW = (const bf16*)(A.ws + WS_KW) + l * KW_L + (size_t)g * TOTWP * 64; const bf16* VTW = (const bf16*)(A.ws + WS_VTW) + l * KW_L + (size_t)g * 64 * TOTWP;
    const bf16* KC = (const bf16*)(A.ws + WS_KC) + l * KC_L + (size_t)g * NCB * 64 + cbase * 64; const bf16* VCT = (const bf16*)(A.ws + WS_VCT) + l * KC_L + (size_t)g * 64 * NCB + cbase;
    const LAS float* bt = BT + h * 132;
    const float farb = bt[128];
    bf16x8 q[2];
    {   const bf16* qp = (const bf16*)(A.ws + WS_NQ) + (size_t)(row0 + tl) * 512 + g * 256 + rr * 64 + 8 * fq;
        q[0] = *(const bf16x8*)qp; q[1] = *(const bf16x8*)(qp + 32); }
    const float* gt = (const float*)(A.ws + WS_GATE) + (size_t)(row0 + tl) * 32 + 8 + h * 3;
    const float gc = sigmoidf_(gt[0]), gs = sigmoidf_(gt[1]), gwn = sigmoidf_(gt[2]);
    f32x4 out[4];
#pragma unroll
    for (int dt = 0; dt < 4; ++dt) out[dt] = (f32x4){0.f, 0.f, 0.f, 0.f};
    LAS float* impA = wl;
    LAS float* impB = wl + 544;
    for (int i = lane; i < 1088; i += 64) wl[i] = 0.f;
    LDS_WAIT();

    {
        const int ncv_max = qpos0 + 3 >= 31 ? ((qpos0 + 3 - 31) >> 4) + 1 : 0, nb64 = (ncv_max + 63) >> 6;
        float m = -1.0e30f, ls = 0.f;
        {
            for (int ib = 0; ib < nb64; ++ib) {
                KV cur; k_load(cur, KC + (size_t)ib * 64 * 64, fr, fq);
                f32x4 st[4]; qk_frag(cur, q, st);
                float bm = -INFINITY;
#pragma unroll
                for (int t = 0; t < 4; ++t)
#pragma unroll
                    for (int i = 0; i < 4; ++i) { const int n = 64 * ib + 16 * t + 4 * fq + i; const int dist = qpos - 16 * n - 31;
                        const float s = dist >= 0 ? st[t][i] + bt[dist > 128 ? 128 : dist] : -INFINITY; st[t][i] = s; bm = fmaxf(bm, s); }
                bm = xfq_max(bm);
                const float mn = fmaxf(m, bm); ls *= __builtin_amdgcn_exp2f(m - mn); m = mn;
#pragma unroll
                for (int t = 0; t < 4; ++t)
#pragma unroll
                    for (int i = 0; i < 4; ++i) ls += __builtin_amdgcn_exp2f(st[t][i] - mn);
            }
        }
        ls = xfq_sum(ls);
        const float inv = ls > 0.f ? 1.f / ls : 0.f;
        f32x4 o[4];
#pragma unroll
        for (int dt = 0; dt < 4; ++dt) o[dt] = (f32x4){0.f, 0.f, 0.f, 0.f};
        {
            for (int ib = 0; ib < nb64; ++ib) {
                KV cur; k_load(cur, KC + (size_t)ib * 64 * 64, fr, fq); v_load(cur, VCT + ib * 64, NCB, fr, fq);
                f32x4 st[4]; qk_frag(cur, q, st);
#pragma unroll
                for (int t = 0; t < 4; ++t) {
#pragma unroll
                    for (int i = 0; i < 4; ++i) { const int n = 64 * ib + 16 * t + 4 * fq + i; const int dist = qpos - 16 * n - 31;
                        st[t][i] = dist >= 0 ? __builtin_amdgcn_exp2f(st[t][i] + bt[dist > 128 ? 128 : dist] - m) * inv : 0.f; }
                    const float s4 = quad_sum((st[t][0] + st[t][1]) + (st[t][2] + st[t][3])), s3 = quad_sum(st[t][3]);
                    const int j0 = 16 * ib + 4 * t + fq;
                    if (rr == 0) { impA[tl * 136 + j0] = s4; impB[tl * 136 + j0 + 1] = s3; }
                }
                pv_frag(cur, st, o);
            }
        }
#pragma unroll
        for (int dt = 0; dt < 4; ++dt) out[dt] = out[dt] + o[dt] * gc;
    }
    LDS_WAIT();
    unsigned long long s0[4], s1[4];
#pragma unroll
    for (int t = 0; t < 4; ++t) topk_sel(impA[t * 136 + lane] + impB[t * 136 + lane], impA[t * 136 + 64 + lane] + impB[t * 136 + 64 + lane], cur, lane, s0[t], s1[t]);
    {
        float m = -1.0e30f, ls = 0.f; f32x4 o[4];
#pragma unroll
        for (int dt = 0; dt < 4; ++dt) o[dt] = (f32x4){0.f, 0.f, 0.f, 0.f};
        BrSel br{KS + sbase * 64, VTS + sbase, (size_t)TOTS, (s0[0] | s0[1]) | (s0[2] | s0[3]), (s1[0] | s1[1]) | (s1[2] | s1[3]),
                 tl == 0 ? s0[0] : (tl == 1 ? s0[1] : (tl == 2 ? s0[2] : s0[3])), tl == 0 ? s1[0] : (tl == 1 ? s1[1] : (tl == 2 ? s1[2] : s1[3])), cur, qpos, fq, bt, farb};
        run_branch(br, q, fr, fq, o, m, ls);
        ls = xfq_sum(ls);
        const float w = ls > 0.f ? gs / ls : 0.f;
#pragma unroll
        for (int dt = 0; dt < 4; ++dt) out[dt] = out[dt] + o[dt] * w;
    }
    {
        float m = -1.0e30f, ls = 0.f; f32x4 o[4];
#pragma unroll
        for (int dt = 0; dt < 4; ++dt) o[dt] = (f32x4){0.f, 0.f, 0.f, 0.f};
        const int lo_blk = smp ? (PAST - 512) >> 6 : 0; int jb = (qpos0 - 511) >> 6; if (jb < lo_blk) jb = lo_blk;
        BrWin br{KW + wbase * 64, VTW + wbase, (size_t)TOTWP, jb, cur, qpos, fq, bt};
        run_branch(br, q, fr, fq, o, m, ls);
        ls = xfq_sum(ls);
        const float w = ls > 0.f ? gwn / ls : 0.f;
#pragma unroll
        for (int dt = 0; dt < 4; ++dt) out[dt] = out[dt] + o[dt] * w;
    }
    bf16* mp = (bf16*)(A.ws + WS_MIX) + (size_t)(row0 + tl) * D + 512 + h * 64 + 4 * fq;
#pragma unroll
    for (int dt = 0; dt < 4; ++dt) { v2u w; w.x = pk2(out[dt][0], out[dt][1]); w.y = pk2(out[dt][2], out[dt][3]); *(v2u*)(mp + 16 * dt) = w; }
}
__device__ __forceinline__ void phase_nsa(CArgs& A, int l, LAS float* wl, const LAS float* BT, int lane, int wave) {
    const int G = gridDim.x, bx = blockIdx.x;
    const bool xmap = (G & 7) == 0;
    const int x = bx & 7, nw = (G >> 3) * NWAVES, ww = (bx >> 3) * NWAVES + wave;
    const int gwv = bx * NWAVES + wave, ngw = G * NWAVES;
    for (int it = 0;; ++it) {
        bool smp; int bs, g, tq;
        if (xmap) {
            const int np = ww < 512 ? 2 * ((512 - ww + nw - 1) / nw) : 0;
            if (it < np) { const int i = ww + nw * (it >> 1), tq2 = (it & 1) ? 1023 - i : i; smp = false; bs = x >> 2; g = (x >> 1) & 1; tq = 2 * tq2 + (x & 1); }
            else { const int t = ww * 8 + x + 8 * nw * (it - np); if (t >= 2 * DB) break; smp = true; bs = t >> 1; g = t & 1; tq = 0; }
        } else {
            const int t = gwv + ngw * it; if (t >= 4 * 2048 + 2 * DB) break;
            if (t < 4 * 2048) { smp = false; bs = t >> 12; g = (t >> 11) & 1; tq = t & 2047; } else { smp = true; bs = (t - 4 * 2048) >> 1; g = t & 1; tq = 0; }
        }
        nsa_tile(A, l, smp, bs, g, tq, wl, BT, lane);
    }
}

__device__ __forceinline__ void phase_m2x(CArgs& A, int l, LAS unsigned char* lds, int tid) {
    LAS float* buf = (LAS float*)lds;
    LAS float* wl = (LAS float*)(lds + 1024);
    LAS float* red = (LAS float*)(lds + 2048);
    LAS bf16* kt = (LAS bf16*)(lds + 8192);
    LAS bf16* vt = (LAS bf16*)(lds + 8192 + 34816);
    const bf16* QKVO = (const bf16*)(A.ws + WS_QKVO);
    const int lane = tid & 63, wave = tid >> 6, fr = lane & 15, fq = lane >> 4;
    for (int unit = blockIdx.x; unit < NUNIT; unit += gridDim.x) {
        const int b = unit >> 7, h = (unit >> 5) & 3, c = unit & 31, r0 = b * SEQ + c * LCH;
        float ig = 0.f, lf = 0.f;
        if (tid < 256) ml_gates(A, l, r0 + tid, h, ig, lf);
        const float F = scan_sum256(lf, buf, tid);
        __syncthreads();
        if (tid == 255) buf[16] = F;
        __syncthreads();
        const float Fend = buf[16];
        const float gl = tid < 256 ? Fend - F + ig : -3.0e38f;
        const float mw = wave_max(gl);
        if (lane == 0) buf[20 + wave] = mw;
        __syncthreads();
        const float mloc = fmaxf(fmaxf(buf[20], buf[21]), fmaxf(buf[22], buf[23]));
        if (tid < 256) wl[tid] = __expf(gl - mloc);
        if (tid == 0) { float* ch = (float*)(A.ws + WS_CHS) + unit * 4; ch[0] = Fend; ch[1] = mloc; }
        f32x4 acc[8];
#pragma unroll
        for (int kt_ = 0; kt_ < 8; ++kt_) acc[kt_] = (f32x4){0.f, 0.f, 0.f, 0.f};
        float dnp = 0.f;
        for (int half = 0; half < 2; ++half) {
            __syncthreads();
            for (int i = tid; i < 4096; i += NTHR) { const int which = i >> 11, oc = (i >> 7) & 15, s = i & 127;
                const v4u x = *(const v4u*)(QKVO + (size_t)(r0 + 128 * half + s) * 2048 + (which ? 1024 : 512) + h * HD + 8 * oc);
                LAS bf16* dst = (which ? vt : kt) + (8 * oc) * 136 + s;
                dst[0] = (bf16)x.x; dst[136] = (bf16)(x.x >> 16); dst[272] = (bf16)x.y; dst[408] = (bf16)(x.y >> 16); dst[544] = (bf16)x.z; dst[680] = (bf16)(x.z >> 16); dst[816] = (bf16)x.w; dst[952] = (bf16)(x.w >> 16); }
            __syncthreads();
#pragma unroll
            for (int ks = 0; ks < 4; ++ks) {
                const int s0 = 32 * ks + 8 * fq;
                const v4u xv = *(const LAS v4u*)(vt + (16 * wave + fr) * 136 + s0);
                const f32x4 w0 = *(const LAS f32x4*)(wl + 128 * half + s0), w1 = *(const LAS f32x4*)(wl + 128 * half + s0 + 4);
                v4u av; av.x = pk2(bflo(xv.x) * w0[0], bfhi(xv.x) * w0[1]); av.y = pk2(bflo(xv.y) * w0[2], bfhi(xv.y) * w0[3]); av.z = pk2(bflo(xv.z) * w1[0], bfhi(xv.z) * w1[1]); av.w = pk2(bflo(xv.w) * w1[2], bfhi(xv.w) * w1[3]);
                const bf16x8 af = __builtin_bit_cast(bf16x8, av);
#pragma unroll
                for (int kt_ = 0; kt_ < 8; ++kt_) { const bf16x8 bfr = *(const LAS bf16x8*)(kt + (16 * kt_ + fr) * 136 + s0); acc[kt_] = MFMA16(af, bfr, acc[kt_]); }
            }
            {   const int k = tid & 127, q = tid >> 7;
#pragma unroll
                for (int e = 0; e < 4; ++e) { const v4u x = *(const LAS v4u*)(kt + k * 136 + 32 * q + 8 * e); const LAS float* w = wl + 128 * half + 32 * q + 8 * e;
                    dnp += bflo(x.x) * w[0] + bfhi(x.x) * w[1] + bflo(x.y) * w[2] + bfhi(x.y) * w[3] + bflo(x.z) * w[4] + bfhi(x.z) * w[5] + bflo(x.w) * w[6] + bfhi(x.w) * w[7]; } }
        }
        float* dct = (float*)(A.ws + WS_DCT) + ((size_t)unit * HD + 16 * wave + 4 * fq) * HD + fr;
#pragma unroll
        for (int kt_ = 0; kt_ < 8; ++kt_)
#pragma unroll
            for (int i = 0; i < 4; ++i) dct[(size_t)i * HD + 16 * kt_] = acc[kt_][i];
        red[(tid >> 7) * 128 + (tid & 127)] = dnp;
        __syncthreads();
        if (tid < HD) ((float*)(A.ws + WS_DN))[unit * HD + tid] = (red[tid] + red[128 + tid]) + (red[256 + tid] + red[384 + tid]);
        __syncthreads();
    }
}

__device__ __forceinline__ void phase_m4x(CArgs& A, int l, LAS unsigned char* lds, int tid) {
    LAS float* buf = (LAS float*)lds;
    LAS float* sa = (LAS float*)(lds + 1024);
    LAS float* smx = sa + 256;
    LAS float* sdec = smx + 256;
    LAS float* sem = sdec + 256;
    LAS bf16* vt = (LAS bf16*)(lds + 8192);
    const bf16* QKVO = (const bf16*)(A.ws + WS_QKVO);
    const int lane = tid & 63, wave = tid >> 6, fr = lane & 15, fq = lane >> 4;
    for (int unit = blockIdx.x; unit < NUNIT; unit += gridDim.x) {
        const int b = unit >> 7, h = (unit >> 5) & 3, c = unit & 31, r0 = b * SEQ + c * LCH;
        float ig = 0.f, lf = 0.f;
        if (tid < 256) ml_gates(A, l, r0 + tid, h, ig, lf);
        const float F = scan_sum256(lf, buf, tid);
        const float a = tid < 256 ? ig - F : -3.0e38f;
        const float cm = scan_max256(a, buf, tid);
        const float m0 = ((const float*)(A.ws + WS_CHS))[unit * 4 + 2];
        if (tid < 256) { const float mx = fmaxf(m0, cm); sa[tid] = a; smx[tid] = mx; sdec[tid] = __expf(m0 - mx); sem[tid] = __expf(-(F + mx)); }
        for (int i = tid; i < 4096; i += NTHR) { const int oc = i >> 8, s = i & 255;
            const v4u x = *(const v4u*)(QKVO + (size_t)(r0 + s) * 2048 + 1024 + h * HD + 8 * oc);
            LAS bf16* dst = vt + (8 * oc) * 264 + s;
            dst[0] = (bf16)x.x; dst[264] = (bf16)(x.x >> 16); dst[528] = (bf16)x.y; dst[792] = (bf16)(x.y >> 16); dst[1056] = (bf16)x.z; dst[1320] = (bf16)(x.z >> 16); dst[1584] = (bf16)x.w; dst[1848] = (bf16)(x.w >> 16); }
        __syncthreads();
        const bf16* ctp = (const bf16*)(A.ws + WS_CTP) + (size_t)unit * HD * HD;
        const float* npv = (const float*)(A.ws + WS_NPV) + unit * HD;
        for (int pass = 0; pass < 2; ++pass) {
            const int sub = pass == 0 ? wave : 15 - wave, t0 = 16 * sub, t = t0 + fr;
            const float mxt = smx[t], dect = sdec[t], emt = sem[t];
            bf16x8 qf[4];
#pragma unroll
            for (int kk = 0; kk < 4; ++kk) qf[kk] = *(const bf16x8*)(QKVO + (size_t)(r0 + t) * 2048 + h * HD + 32 * kk + 8 * fq);
            f32x4 ah[8], ac[8];
#pragma unroll
            for (int v = 0; v < 8; ++v) { ah[v] = (f32x4){0.f, 0.f, 0.f, 0.f}; ac[v] = (f32x4){0.f, 0.f, 0.f, 0.f}; }
            float den = 0.f;
            const int nblk = (t0 + 47) >> 5;
            for (int ib = 0; ib < nblk; ++ib) {
                const int s0 = 32 * ib;
                f32x4 st[2];
#pragma unroll
                for (int j = 0; j < 2; ++j) {
                    f32x4 z = {0.f, 0.f, 0.f, 0.f};
                    const bf16* kp = QKVO + (size_t)(r0 + s0 + 16 * j + fr) * 2048 + 512 + h * HD + 8 * fq;
#pragma unroll
                    for (int kk = 0; kk < 4; ++kk) z = MFMA16(*(const bf16x8*)(kp + 32 * kk), qf[kk], z);
                    const f32x4 a4 = *(const LAS f32x4*)(sa + s0 + 16 * j + 4 * fq);
#pragma unroll
                    for (int i = 0; i < 4; ++i) { const float w = (s0 + 16 * j + 4 * fq + i <= t) ? z[i] * __expf(a4[i] - mxt) : 0.f; z[i] = w; den += w; }
                    st[j] = z;
                }
                v4u pw; pw.x = pk2(st[0][0], st[0][1]); pw.y = pk2(st[0][2], st[0][3]); pw.z = pk2(st[1][0], st[1][1]); pw.w = pk2(st[1][2], st[1][3]);
                const bf16x8 pf = __builtin_bit_cast(bf16x8, pw);
#pragma unroll
                for (int v = 0; v < 8; ++v) { const LAS bf16* vp = vt + (16 * v + fr) * 264 + s0 + 4 * fq;
                    const v2u x = *(const LAS v2u*)vp, y = *(const LAS v2u*)(vp + 16);
                    v4u vw; vw.x = x.x; vw.y = x.y; vw.z = y.x; vw.w = y.y;
                    ah[v] = MFMA16(__builtin_bit_cast(bf16x8, vw), pf, ah[v]); }
            }
            float qn = 0.f;
#pragma unroll
            for (int kk = 0; kk < 4; ++kk) {
                const v4u qx = __builtin_bit_cast(v4u, qf[kk]); const f32x4 n0 = *(const f32x4*)(npv + 32 * kk + 8 * fq), n1 = *(const f32x4*)(npv + 32 * kk + 8 * fq + 4);
                qn += bflo(qx.x) * n0[0] + bfhi(qx.x) * n0[1] + bflo(qx.y) * n0[2] + bfhi(qx.y) * n0[3] + bflo(qx.z) * n1[0] + bfhi(qx.z) * n1[1] + bflo(qx.w) * n1[2] + bfhi(qx.w) * n1[3];
#pragma unroll
                for (int v = 0; v < 8; ++v) ac[v] = MFMA16(*(const bf16x8*)(ctp + (size_t)(16 * v + fr) * HD + 32 * kk + 8 * fq), qf[kk], ac[v]);
            }
            const float dent = xfq_sum(den) + dect * xfq_sum(qn);
            const float rden = 1.f / fmaxf(fabsf(dent), emt);
            float s1 = 0.f;
#pragma unroll
            for (int v = 0; v < 8; ++v) { ah[v] = (ah[v] + ac[v] * dect) * rden; s1 += (ah[v][0] + ah[v][1]) + (ah[v][2] + ah[v][3]); }
            const float mu = xfq_sum(s1) * (1.f / HD);
            float s2 = 0.f;
#pragma unroll
            for (int v = 0; v < 8; ++v) { ah[v] = ah[v] - mu; s2 += (ah[v][0] * ah[v][0] + ah[v][1] * ah[v][1]) + (ah[v][2] * ah[v][2] + ah[v][3] * ah[v][3]); }
            const float rstd = 1.f / sqrtf(xfq_sum(s2) * (1.f / HD) + LN_EPS);
            const bf16* op = QKVO + (size_t)(r0 + t) * 2048 + 1536 + h * HD + 4 * fq;
            bf16* mp = (bf16*)(A.ws + WS_MIX) + (size_t)(r0 + t) * D + h * HD + 4 * fq;
            const float* gp = A.ml_norm_g + l * 512 + h * HD + 4 * fq;
#pragma unroll
            for (int v = 0; v < 8; ++v) { const v2u og = *(const v2u*)(op + 16 * v); const f32x4 gn = *(const f32x4*)(gp + 16 * v);
                v2u w; w.x = pk2(ah[v][0] * rstd * gn[0] * sigmoidf_(bflo(og.x)), ah[v][1] * rstd * gn[1] * sigmoidf_(bfhi(og.x)));
                w.y = pk2(ah[v][2] * rstd * gn[2] * sigmoidf_(bflo(og.y)), ah[v][3] * rstd * gn[3] * sigmoidf_(bfhi(og.y)));
                *(v2u*)(mp + 16 * v) = w; }
        }
        __syncthreads();
    }
}

constexpr int SKP = 72;
constexpr int NG_KB = 0, NG_IMP = 2 * 4 * 64 * SKP * 2, NG_BT = NG_IMP + NWAVES * 1088 * 4, NG_MSK = NG_BT + 8 * 132 * 4, NG_TASK = NG_MSK + NWAVES * 16, NG_JL = NG_TASK + 16, NG_END = NG_JL + 136 * 4;
static_assert(NG_END <= RING_BYTES, "NSA LDS map");
constexpr int CW_NSAQ = 8192;

__device__ __forceinline__ v4u stage_issue(const bf16* src, unsigned pitch, int tid) { const unsigned off = (unsigned)(tid >> 3) * pitch + (unsigned)(tid & 7) * 8u; return *(const v4u*)(src + off); }
__device__ __forceinline__ void stage_commit(LAS bf16* buf, const v4u& r, int tid) { *(LAS v4u*)(buf + (tid >> 3) * SKP + (tid & 7) * 8) = r; }
__device__ __forceinline__ void qk_lds(const LAS bf16* kb, const bf16x8 (&q)[2], int fr, int fq, f32x4 (&st)[4]) {
#pragma unroll
    for (int t = 0; t < 4; ++t) { const LAS bf16* p = kb + (16 * t + fr) * SKP + 8 * fq;
        f32x4 z = {0.f, 0.f, 0.f, 0.f}; z = MFMA16(*(const LAS bf16x8*)p, q[0], z); st[t] = MFMA16(*(const LAS bf16x8*)(p + 32), q[1], z); }
}
__device__ __forceinline__ void pv_lds(const LAS bf16* vb, int fr, int fq, const f32x4 (&st)[4], f32x4 (&o)[4]) {
#pragma unroll
    for (int h = 0; h < 2; ++h) {
        v4u pw; pw.x = pk2(st[2 * h][0], st[2 * h][1]); pw.y = pk2(st[2 * h][2], st[2 * h][3]); pw.z = pk2(st[2 * h + 1][0], st[2 * h + 1][1]); pw.w = pk2(st[2 * h + 1][2], st[2 * h + 1][3]);
        const bf16x8 pf = __builtin_bit_cast(bf16x8, pw);
#pragma unroll
        for (int dt = 0; dt < 4; ++dt) { const LAS bf16* p = vb + (16 * dt + fr) * SKP + 32 * h + 4 * fq;
            const v2u a = *(const LAS v2u*)p, b = *(const LAS v2u*)(p + 16); v4u w; w.x = a.x; w.y = a.y; w.z = b.x; w.w = b.y;
            o[dt] = MFMA16(__builtin_bit_cast(bf16x8, w), pf, o[dt]); }
    }
}
__device__ __forceinline__ void softmax_pv_lds(const LAS bf16* vb, int fr, int fq, f32x4 (&st)[4], float c, f32x4 (&o)[4], float& m, float& ls) {
    float bm = fmaxf(fmaxf(st[0][0], st[0][1]), fmaxf(st[0][2], st[0][3]));
#pragma unroll
    for (int t = 1; t < 4; ++t) bm = fmaxf(bm, fmaxf(fmaxf(st[t][0], st[t][1]), fmaxf(st[t][2], st[t][3])));
    bm = xfq_max(bm + c);
    if (__any(bm > m)) {
        const float mn = fmaxf(m, bm), sc = __builtin_amdgcn_exp2f(m - mn);
        m = mn; ls *= sc;
#pragma unroll
        for (int dt = 0; dt < 4; ++dt) o[dt] = o[dt] * sc;
    }
    const float d = c - m;
#pragma unroll
    for (int t = 0; t < 4; ++t)
#pragma unroll
        for (int i = 0; i < 4; ++i) { const float p = __builtin_amdgcn_exp2f(st[t][i] + d); st[t][i] = p; ls += p; }
    pv_lds(vb, fr, fq, st, o);
}

template <bool HASK, bool HASV, class Addr, class Body>
__device__ __forceinline__ void staged_sweep2(int n, const Addr& ad, Body& body, LAS bf16* sbuf, int tid) {
    if (n <= 0) return;
    constexpr int BLK = 64 * SKP, SET = 4 * BLK;
    {   v4u k0, k1, v0, v1;
        if (HASK) { k0 = ad.k(0, tid); if (1 < n) k1 = ad.k(1, tid); }
        if (HASV) { v0 = ad.v(0, tid); if (1 < n) v1 = ad.v(1, tid); }
        if (HASK) { stage_commit(sbuf, k0, tid); if (1 < n) stage_commit(sbuf + BLK, k1, tid); }
        if (HASV) { stage_commit(sbuf + 2 * BLK, v0, tid); if (1 < n) stage_commit(sbuf + 3 * BLK, v1, tid); } }
    __syncthreads();
    const int nstep = (n + 1) >> 1;
    for (int s = 0; s < nstep; ++s) {
        const int i0 = 2 * s, i2 = i0 + 2, i3 = i0 + 3;
        v4u k0, k1, v0, v1;
        if (i2 < n) { if (HASK) k0 = ad.k(i2, tid); if (HASV) v0 = ad.v(i2, tid); }
        if (i3 < n) { if (HASK) k1 = ad.k(i3, tid); if (HASV) v1 = ad.v(i3, tid); }
        LAS bf16* cur = sbuf + (s & 1) * SET; LAS bf16* nxt = sbuf + ((s & 1) ^ 1) * SET;
        body(i0, cur, cur + 2 * BLK);
        if (i0 + 1 < n) body(i0 + 1, cur + BLK, cur + 3 * BLK);
        if (i2 < n) { if (HASK) stage_commit(nxt, k0, tid); if (HASV) stage_commit(nxt + 2 * BLK, v0, tid); }
        if (i3 < n) { if (HASK) stage_commit(nxt + BLK, k1, tid); if (HASV) stage_commit(nxt + 3 * BLK, v1, tid); }
        __syncthreads();
    }
}
struct AdLin {
    const bf16* K; const bf16* V; unsigned vpitch;
    __device__ __forceinline__ v4u k(int i, int tid) const { return stage_issue(K + (size_t)i * 64 * 64, 64, tid); }
    __device__ __forceinline__ v4u v(int i, int tid) const { return stage_issue(V + (size_t)i * 64, vpitch, tid); }
};
struct AdList {
    const bf16* K; const bf16* V; unsigned vpitch; const LAS int* jl;
    __device__ __forceinline__ v4u k(int i, int tid) const { const int j = __builtin_amdgcn_readfirstlane(jl[i]); return stage_issue(K + (size_t)j * 64 * 64, 64, tid); }
    __device__ __forceinline__ v4u v(int i, int tid) const { const int j = __builtin_amdgcn_readfirstlane(jl[i]); return stage_issue(V + (size_t)j * 64, vpitch, tid); }
};
struct TileCtx { int fr, fq, qposA, qposB, qpos0, cur; const LAS float* bt; float farb; };
struct BodyCmpStat2 {
    const bf16x8 (&qa)[2]; const bf16x8 (&qb)[2]; const TileCtx& c; float (&ml)[2]; float (&lsl)[2];
    __device__ __forceinline__ void operator()(int ib, const LAS bf16* kb, const LAS bf16*) {
#pragma unroll
        for (int u = 0; u < 2; ++u) {
            f32x4 st[4]; qk_lds(kb, u ? qb : qa, c.fr, c.fq, st);
            const int qpos = u ? c.qposB : c.qposA;
            float bm = -INFINITY;
#pragma unroll
            for (int t = 0; t < 4; ++t)
#pragma unroll
                for (int i = 0; i < 4; ++i) { const int n = 64 * ib + 16 * t + 4 * c.fq + i; const int dist = qpos - 16 * n - 31; const int di = dist < 0 ? 0 : (dist > 128 ? 128 : dist);
                    const float bb = c.bt[di]; const float sc = dist >= 0 ? st[t][i] + bb : -INFINITY; st[t][i] = sc; bm = fmaxf(bm, sc); }
            const float mn = fmaxf(ml[u], bm); lsl[u] *= __builtin_amdgcn_exp2f(ml[u] - mn); ml[u] = mn;
#pragma unroll
            for (int t = 0; t < 4; ++t)
#pragma unroll
                for (int i = 0; i < 4; ++i) lsl[u] += __builtin_amdgcn_exp2f(st[t][i] - mn);
        }
    }
};
struct BodyCmpProb2 {
    const bf16x8 (&qa)[2]; const bf16x8 (&qb)[2]; const TileCtx& c; f32x4 (&oa)[4]; f32x4 (&ob)[4]; float m0, m1, inv0, inv1; LAS float* imp; int tl, rr;
    __device__ __forceinline__ void operator()(int ib, const LAS bf16* kb, const LAS bf16* vb) {
#pragma unroll
        for (int u = 0; u < 2; ++u) {
            f32x4 st[4]; qk_lds(kb, u ? qb : qa, c.fr, c.fq, st);
            const int qpos = u ? c.qposB : c.qposA; const float m = u ? m1 : m0, inv = u ? inv1 : inv0;
#pragma unroll
            for (int t = 0; t < 4; ++t) {
#pragma unroll
                for (int i = 0; i < 4; ++i) { const int n = 64 * ib + 16 * t + 4 * c.fq + i; const int dist = qpos - 16 * n - 31; const int di = dist < 0 ? 0 : (dist > 128 ? 128 : dist);
                    const float bb = c.bt[di]; st[t][i] = dist >= 0 ? __builtin_amdgcn_exp2f(st[t][i] + bb - m) * inv : 0.f; }
                const float s4 = quad_sum((st[t][0] + st[t][1]) + (st[t][2] + st[t][3])), s3 = quad_sum(st[t][3]);
                const int j0 = 16 * ib + 4 * t + c.fq;
                if (rr == 0) { LAS float* ip = imp + (4 * u + tl) * 136 + j0;
                    __hip_atomic_fetch_add(ip, s4, __ATOMIC_RELAXED, __HIP_MEMORY_SCOPE_WORKGROUP); __hip_atomic_fetch_add(ip + 1, s3, __ATOMIC_RELAXED, __HIP_MEMORY_SCOPE_WORKGROUP); }
            }
            if (u) pv_lds(vb, c.fr, c.fq, st, ob); else pv_lds(vb, c.fr, c.fq, st, oa);
        }
    }
};
struct BodySel2 {
    const bf16x8 (&qa)[2]; const bf16x8 (&qb)[2]; const TileCtx& c; f32x4 (&oa)[4]; f32x4 (&ob)[4]; float (&m)[2]; float (&ls)[2]; const LAS int* jl;
    unsigned long long wu0a, wu1a, wu0b, wu1b, my0a, my1a, my0b, my1b;
    __device__ __forceinline__ void operator()(int i, const LAS bf16* kb, const LAS bf16* vb) {
        const int j = __builtin_amdgcn_readfirstlane(jl[i]);
#pragma unroll
        for (int u = 0; u < 2; ++u) {
            const unsigned long long w0 = u ? wu0b : wu0a, w1 = u ? wu1b : wu1a;
            const bool tile_has = j < 64 ? ((w0 >> j) & 1ull) != 0ull : ((w1 >> (j - 64)) & 1ull) != 0ull;
            if (!tile_has) continue;
            const unsigned long long y0 = u ? my0b : my0a, y1 = u ? my1b : my1a;
            const bool mine = j < 64 ? ((y0 >> j) & 1ull) != 0ull : ((y1 >> (j - 64)) & 1ull) != 0ull;
            const int qpos = u ? c.qposB : c.qposA;
            f32x4 st[4]; qk_lds(kb, u ? qb : qa, c.fr, c.fq, st);
            float cc = mine ? c.farb : -INFINITY;
            if (j >= c.cur - 2) {
                cc = mine ? 0.f : -INFINITY;
#pragma unroll
                for (int t = 0; t < 4; ++t)
#pragma unroll
                    for (int e = 0; e < 4; ++e) { const int dist = qpos - (64 * j + 16 * t + 4 * c.fq + e); const int di = dist < 0 ? 0 : (dist > 128 ? 128 : dist);
                        const float bb = c.bt[di]; st[t][e] = dist >= 0 ? st[t][e] + bb : -INFINITY; }
            }
            if (u) softmax_pv_lds(vb, c.fr, c.fq, st, cc, ob, m[1], ls[1]); else softmax_pv_lds(vb, c.fr, c.fq, st, cc, oa, m[0], ls[0]);
        }
    }
};
struct BodyWin2 {
    const bf16x8 (&qa)[2]; const bf16x8 (&qb)[2]; const TileCtx& c; f32x4 (&oa)[4]; f32x4 (&ob)[4]; float (&m)[2]; float (&ls)[2]; int j0;
    __device__ __forceinline__ void operator()(int i, const LAS bf16* kb, const LAS bf16* vb) {
        const int j = j0 + i;
#pragma unroll
        for (int u = 0; u < 2; ++u) {
            const int qpos = u ? c.qposB : c.qposA, qp0 = c.qpos0 + 4 * u;
            if (qp0 + 3 - 64 * j < 0 || qp0 - (64 * j + 63) >= 512) continue;
            f32x4 st[4]; qk_lds(kb, u ? qb : qa, c.fr, c.fq, st);
            float cc = c.farb;
            const bool interior = (qp0 + 3 - 64 * j < 512) && (qp0 - (64 * j + 63) >= 128);
            if (!interior) {
                cc = 0.f;
#pragma unroll
                for (int t = 0; t < 4; ++t)
#pragma unroll
                    for (int e = 0; e < 4; ++e) { const int dist = qpos - (64 * j + 16 * t + 4 * c.fq + e); const int di = dist < 0 ? 0 : (dist > 128 ? 128 : dist);
                        const float bb = c.bt[di]; st[t][e] = (dist >= 0 && dist < 512) ? st[t][e] + bb : -INFINITY; }
            }
            if (u) softmax_pv_lds(vb, c.fr, c.fq, st, cc, ob, m[1], ls[1]); else softmax_pv_lds(vb, c.fr, c.fq, st, cc, oa, m[0], ls[0]);
        }
    }
};

__device__ __forceinline__ void nsa_group(CArgs& A, int l, int b, int g, int tg, LAS unsigned char* lds, int tid) {
    asm volatile("" : "+v"(tid));
    const int lane = tid & 63, wave = tid >> 6, fr = lane & 15, fq = lane >> 4, tl = fr >> 2, rr = fr & 3;
    LAS bf16* sbuf = (LAS bf16*)(lds + NG_KB);
    LAS float* imp = (LAS float*)(lds + NG_IMP) + wave * 1088; const LAS float* BT = (const LAS float*)(lds + NG_BT);
    LAS unsigned long long* msk = (LAS unsigned long long*)(lds + NG_MSK);
    LAS int* jl = (LAS int*)(lds + NG_JL);
    const int qpos0 = 64 * tg + 8 * wave, cur = tg, row0 = b * SEQ + qpos0, h = g * 4 + rr;
    const LAS float* bt = BT + h * 132;
    const TileCtx cx{fr, fq, qpos0 + tl, qpos0 + 4 + tl, qpos0, cur, bt, bt[128]};
    bf16x8 qa[2], qb[2];
    {   const bf16* qp = (const bf16*)(A.ws + WS_NQ) + (size_t)(row0 + tl) * 512 + g * 256 + rr * 64 + 8 * fq;
        qa[0] = *(const bf16x8*)qp; qa[1] = *(const bf16x8*)(qp + 32); qb[0] = *(const bf16x8*)(qp + 4 * 512); qb[1] = *(const bf16x8*)(qp + 4 * 512 + 32); }
    f32x4 outa[4], outb[4];
    for (int i = lane; i < 1088; i += 64) imp[i] = 0.f;

    {
        const int nb64 = (4 * tg + 3 + 63) >> 6;
        const AdLin ad{(const bf16*)(A.ws + WS_KC) + l * KC_L + (size_t)g * NCB * 64 + (size_t)b * 512 * 64, (const bf16*)(A.ws + WS_VCT) + l * KC_L + (size_t)g * 64 * NCB + (size_t)b * 512, (unsigned)NCB};
        float ml[2] = {-1.0e30f, -1.0e30f}, lsl[2] = {0.f, 0.f};
        { BodyCmpStat2 bd{qa, qb, cx, ml, lsl}; staged_sweep2<true, false>(nb64, ad, bd, sbuf, tid); }
        const float m0 = xfq_max(ml[0]), m1 = xfq_max(ml[1]);
        const float l0 = xfq_sum(lsl[0] * __builtin_amdgcn_exp2f(ml[0] - m0)), l1 = xfq_sum(lsl[1] * __builtin_amdgcn_exp2f(ml[1] - m1));
        f32x4 oa[4], ob[4];
#pragma unroll
        for (int dt = 0; dt < 4; ++dt) { oa[dt] = (f32x4){0.f, 0.f, 0.f, 0.f}; ob[dt] = (f32x4){0.f, 0.f, 0.f, 0.f}; }
        { BodyCmpProb2 bd{qa, qb, cx, oa, ob, m0, m1, l0 > 0.f ? 1.f / l0 : 0.f, l1 > 0.f ? 1.f / l1 : 0.f, imp, tl, rr}; staged_sweep2<true, true>(nb64, ad, bd, sbuf, tid); }
        const float* gt = (const float*)(A.ws + WS_GATE) + (size_t)(row0 + tl) * 32 + 8 + h * 3;
        const float ga = sigmoidf_(gt[0]), gb = sigmoidf_(gt[4 * 32]);
#pragma unroll
        for (int dt = 0; dt < 4; ++dt) { outa[dt] = oa[dt] * ga; outb[dt] = ob[dt] * gb; }
    }
    unsigned long long s0[8], s1[8];
#pragma unroll
    for (int t = 0; t < 8; ++t) topk_sel(imp[t * 136 + lane], imp[t * 136 + 64 + lane], cur, lane, s0[t], s1[t]);
    const unsigned long long wu0a = (s0[0] | s0[1]) | (s0[2] | s0[3]), wu1a = (s1[0] | s1[1]) | (s1[2] | s1[3]), wu0b = (s0[4] | s0[5]) | (s0[6] | s0[7]), wu1b = (s1[4] | s1[5]) | (s1[6] | s1[7]);
    const unsigned long long my0a = tl == 0 ? s0[0] : (tl == 1 ? s0[1] : (tl == 2 ? s0[2] : s0[3])), my1a = tl == 0 ? s1[0] : (tl == 1 ? s1[1] : (tl == 2 ? s1[2] : s1[3]));
    const unsigned long long my0b = tl == 0 ? s0[4] : (tl == 1 ? s0[5] : (tl == 2 ? s0[6] : s0[7])), my1b = tl == 0 ? s1[4] : (tl == 1 ? s1[5] : (tl == 2 ? s1[6] : s1[7]));
    if (lane == 0) { msk[2 * wave] = wu0a | wu0b; msk[2 * wave + 1] = wu1a | wu1b; }
    __syncthreads();
    unsigned long long gu0 = 0ull, gu1 = 0ull;
#pragma unroll
    for (int w = 0; w < NWAVES; ++w) { gu0 |= msk[2 * w]; gu1 |= msk[2 * w + 1]; }
    gu0 = __builtin_amdgcn_readfirstlane((unsigned)gu0) | ((unsigned long long)__builtin_amdgcn_readfirstlane((unsigned)(gu0 >> 32)) << 32);
    gu1 = __builtin_amdgcn_readfirstlane((unsigned)gu1) | ((unsigned long long)__builtin_amdgcn_readfirstlane((unsigned)(gu1 >> 32)) << 32);
    const int nsel0 = __popcll(gu0), nsel = nsel0 + __popcll(gu1);
    if (wave == 0) {
        const unsigned long long below = (1ull << lane) - 1ull;
        if ((gu0 >> lane) & 1ull) jl[__popcll(gu0 & below)] = lane;
        if ((gu1 >> lane) & 1ull) jl[nsel0 + __popcll(gu1 & below)] = 64 + lane;
    }
    __syncthreads();
    const float* gt = (const float*)(A.ws + WS_GATE) + (size_t)(row0 + tl) * 32 + 8 + h * 3;
    {
        float m[2] = {-1.0e30f, -1.0e30f}, ls[2] = {0.f, 0.f}; f32x4 oa[4], ob[4];
#pragma unroll
        for (int dt = 0; dt < 4; ++dt) { oa[dt] = (f32x4){0.f, 0.f, 0.f, 0.f}; ob[dt] = (f32x4){0.f, 0.f, 0.f, 0.f}; }
        const AdList ad{(const bf16*)(A.ws + WS_KS) + l * KS_L + (size_t)g * TOTS * 64 + (size_t)b * SEQ * 64, (const bf16*)(A.ws + WS_VTS) + l * KS_L + (size_t)g * 64 * TOTS + (size_t)b * SEQ, (unsigned)TOTS, jl};
        { BodySel2 bd{qa, qb, cx, oa, ob, m, ls, jl, wu0a, wu1a, wu0b, wu1b, my0a, my1a, my0b, my1b}; staged_sweep2<true, true>(nsel, ad, bd, sbuf, tid); }
        const float la = xfq_sum(ls[0]), lb = xfq_sum(ls[1]);
        const float wa = la > 0.f ? sigmoidf_(gt[1]) / la : 0.f, wb = lb > 0.f ? sigmoidf_(gt[4 * 32 + 1]) / lb : 0.f;
#pragma unroll
        for (int dt = 0; dt < 4; ++dt) { outa[dt] = outa[dt] + oa[dt] * wa; outb[dt] = outb[dt] + ob[dt] * wb; }
    }
    {
        float m[2] = {-1.0e30f, -1.0e30f}, ls[2] = {0.f, 0.f}; f32x4 oa[4], ob[4];
#pragma unroll
        for (int dt = 0; dt < 4; ++dt) { oa[dt] = (f32x4){0.f, 0.f, 0.f, 0.f}; ob[dt] = (f32x4){0.f, 0.f, 0.f, 0.f}; }
        int j0 = (64 * tg - 511) >> 6; if (j0 < 0) j0 = 0;
        const AdLin ad{(const bf16*)(A.ws + WS_KW) + l * KW_L + (size_t)g * TOTWP * 64 + ((size_t)b * SEQ + (size_t)j0 * 64) * 64, (const bf16*)(A.ws + WS_VTW) + l * KW_L + (size_t)g * 64 * TOTWP + (size_t)b * SEQ + (size_t)j0 * 64, (unsigned)TOTWP};
        { BodyWin2 bd{qa, qb, cx, oa, ob, m, ls, j0}; staged_sweep2<true, true>(cur - j0 + 1, ad, bd, sbuf, tid); }
        const float la = xfq_sum(ls[0]), lb = xfq_sum(ls[1]);
        const float wa = la > 0.f ? sigmoidf_(gt[2]) / la : 0.f, wb = lb > 0.f ? sigmoidf_(gt[4 * 32 + 2]) / lb : 0.f;
#pragma unroll
        for (int dt = 0; dt < 4; ++dt) { outa[dt] = outa[dt] + oa[dt] * wa; outb[dt] = outb[dt] + ob[dt] * wb; }
    }
    bf16* mp = (bf16*)(A.ws + WS_MIX) + (size_t)(row0 + tl) * D + 512 + h * 64 + 4 * fq;
#pragma unroll
    for (int dt = 0; dt < 4; ++dt) { v2u w; w.x = pk2(outa[dt][0], outa[dt][1]); w.y = pk2(outa[dt][2], outa[dt][3]); *(v2u*)(mp + 16 * dt) = w;
        v2u w2; w2.x = pk2(outb[dt][0], outb[dt][1]); w2.y = pk2(outb[dt][2], outb[dt][3]); *(v2u*)(mp + 4 * D + 16 * dt) = w2; }
}

__device__ __forceinline__ void phase_nsa2(CArgs& A, int l, int rep, LAS unsigned char* lds, int tid) {
    const int lane = tid & 63, wave = tid >> 6;
    LAS float* btl = (LAS float*)(lds + NG_BT);
    LAS int* tw = (LAS int*)(lds + NG_TASK);
    for (int i = tid; i < 8 * 132; i += NTHR) btl[i] = ((const float*)(A.ws + WS_BT))[i];
    unsigned* qh = (unsigned*)(A.ws + WS_CTL) + CW_NSAQ + (l * 2 + rep) * 5 * 64;
    const int own = (blockIdx.x & 7) >> 1;
    for (int qi = 0; qi < 5; ++qi) {
        const int qsel = qi == 0 ? 4 : (qi == 1 ? own : ((own + qi - 1) & 3));
        const int qlen = qsel == 4 ? 2 * DB / NWAVES : 128;
        for (;;) {
            __syncthreads();
            if (tid == 0) tw[0] = (int)__hip_atomic_fetch_add(qh + qsel * 64, 1u, __ATOMIC_RELAXED, __HIP_MEMORY_SCOPE_AGENT);
            __syncthreads();
            const int t = tw[0];
            if (t >= qlen) break;
            if (qsel < 4) nsa_group(A, l, qsel >> 1, qsel & 1, 127 - t, lds, tid);
            else { const int tt = t * NWAVES + wave; nsa_tile(A, l, true, tt >> 1, tt & 1, 0, (LAS float*)(lds + NG_IMP) + wave * 1088, btl, lane); }
        }
    }
}

constexpr int PH_PER_LAYER = 9, PH_L0 = 3, N_PHASES = PH_L0 + DEPTH * PH_PER_LAYER;
#ifndef REP_MASK
#define REP_MASK 0
#endif
#define REPS(b) for (int rep_ = 0; rep_ < (((REP_MASK) >> (b)) & 1) + 1; ++rep_)
#ifndef MK_PER_PHASE
#define MK_PER_PHASE 0
#endif

__device__ __forceinline__ int fresh_tid() { int t = threadIdx.x; asm volatile("" : "+v"(t)); return t; }
__device__ __forceinline__ CArgs* kargs() { unsigned long long p = (unsigned long long)__builtin_amdgcn_kernarg_segment_ptr(); asm volatile("" : "+s"(p)); return (CArgs*)p; }
#define A (*kargs())
#define IN(k) (lo <= (k) && (k) < hi)
#define SEAM(k) do { if (IN(k) && IN((k) + 1)) xcd_barrier(bar); } while (0)
template <int l>
__device__ __forceinline__ void layer_phases(LAS unsigned char* lds, const XcdBarrier& bar, int G, int NGW, int lo, int hi) {
    unsigned char* ws = A.ws;
    float* const ADA = (float*)(ws + WS_ADA);
    float* const X = (float*)(ws + WS_X);
    float* const Z = (float*)(ws + WS_Z);
    bf16* const U = (bf16*)(ws + WS_U);
        const int pb_ = PH_L0 + l * PH_PER_LAYER;
        const float* adal = ADA + (size_t)l * NCOND * 6144;
        const float* xa = l == 0 ? A.x_prompt : X; const float* xb = l == 0 ? A.x_sample : X + (size_t)MP * D;
        if (IN(pb_ + 0)) {
            const int tid = fresh_tid(), lane = tid & 63, wave = __builtin_amdgcn_readfirstlane(tid >> 6), gw = blockIdx.x * NWAVES + wave; (void)lane; (void)gw;
            {
                pg8::Gemm g{U, (const bf16*)(ws + WS_WIN) + (size_t)l * NINP * D, D, D, D};
                pg8::StaticOrder S; S.init(M, NINP, G, (int)blockIdx.x);
                EpiInProj E{(bf16*)(ws + WS_QKVO), (bf16*)(ws + WS_NQ), (float*)(ws + WS_GATE), (float*)(ws + WS_KVR), (bf16*)(ws + WS_XC) + (size_t)l * 4 * XCP * 64, A.out, l};
                REPS(8) pg8::gemm_phase<EpiInProj, pg8::StaticOrder, true, true>(lds, g, S, E);
            }
            if (l == 0) {
                __syncthreads();
                pg8::Gemm g{(const bf16*)(ws + WS_XC), (const bf16*)(ws + WS_W1), 2048, 1024, 2048};
                CmpOrder S{G, (int)blockIdx.x, 0, DEPTH, 4, 64};
                EpiCmpHid E{(bf16*)(ws + WS_HID), (const float*)(ws + WS_B1)};
                REPS(14) pg8::gemm_phase<EpiCmpHid, CmpOrder, true, true>(lds, g, S, E);
            }
        }
        SEAM(pb_ + 0);
        if (IN(pb_ + 1)) {
            const int tid = fresh_tid(), lane = tid & 63, wave = __builtin_amdgcn_readfirstlane(tid >> 6), gw = blockIdx.x * NWAVES + wave; (void)lane; (void)gw;
            {
                SgCmpHid E{(bf16*)(ws + WS_HID) + (size_t)l * 4 * NCB * 256, (const float*)(ws + WS_B1) + l * 2 * 256};
                REPS(12) small_gemm(((const bf16*)(ws + WS_XC)) + (size_t)l * 4 * XCP * 64, (size_t)XCP * 64, 1024, ((const bf16*)(ws + WS_W1)) + (size_t)l * 2 * 256 * 2048, (size_t)256 * 2048, 2048, 2048, 4, 1024, 256, E, lds, tid);
            }
            REPS(1) { phase_m2x(A, l, lds, tid);
            __syncthreads();
            prep_layer_images(A, l, lds, gw, NGW, lane, wave); __syncthreads(); }
            if (l == 0) phase_cmp2(A, 0, DEPTH, 1024, NCB - 1024, gw, NGW, lane);
        }
        SEAM(pb_ + 1);
        if (IN(pb_ + 2)) {
            const int tid = fresh_tid(), lane = tid & 63, wave = __builtin_amdgcn_readfirstlane(tid >> 6), gw = blockIdx.x * NWAVES + wave; (void)lane; (void)gw;
            REPS(2) phase_m3(A, l, tid);
            phase_cmp2(A, l, 1, 0, 1024, gw, NGW, lane);
        }
        SEAM(pb_ + 2);
        if (IN(pb_ + 3)) {
            const int tid = fresh_tid(), lane = tid & 63, wave = __builtin_amdgcn_readfirstlane(tid >> 6), gw = blockIdx.x * NWAVES + wave; (void)lane; (void)gw;
            REPS(3) { phase_m4x(A, l, lds, tid);
            __syncthreads(); }
            REPS(4) { phase_mls(A, l, lds, tid);
            __syncthreads(); }
            REPS(5) phase_nsa2(A, l, rep_, lds, tid);
        }
        SEAM(pb_ + 3);
        if (IN(pb_ + 4)) {
            const int tid = fresh_tid(), lane = tid & 63, wave = __builtin_amdgcn_readfirstlane(tid >> 6), gw = blockIdx.x * NWAVES + wave; (void)lane; (void)gw;
            pg8::Gemm g{(const bf16*)(ws + WS_MIX), (const bf16*)(ws + WS_WOUT) + (size_t)l * D * D, D, D, D};
            pg8::StaticOrder S; S.init(MP, D, G, (int)blockIdx.x);
            EpiResid E{xa, xb, adal + 2048, Z};
            REPS(9) pg8::gemm_phase<EpiResid, pg8::StaticOrder, true, true>(lds, g, S, E);
            REPS(13) { SgResid E2{xb, adal + 2048, Z}; small_gemm(((const bf16*)(ws + WS_MIX)) + (size_t)MP * D, 0, D, (const bf16*)(ws + WS_WOUT) + (size_t)l * D * D, 0, D, D, 1, MS, D, E2, lds, tid); }
        }
        SEAM(pb_ + 4);
        if (IN(pb_ + 5)) {
            const int tid = fresh_tid(), lane = tid & 63, wave = __builtin_amdgcn_readfirstlane(tid >> 6), gw = blockIdx.x * NWAVES + wave; (void)lane; (void)gw;
            REPS(6) for (int r = gw; r < M; r += NGW) {
                const float* ad = adal + (size_t)cond_of_row(r) * 6144;
                ln_row(Z + (size_t)r * D, A.ln_g + (size_t)(l * 2 + 0) * D, A.ln_b + (size_t)(l * 2 + 0) * D, X + (size_t)r * D, ad + 3072, ad + 4096, U + (size_t)r * D, lane);
            }
        }
        SEAM(pb_ + 5);
        if (IN(pb_ + 6)) {
            const int tid = fresh_tid(), lane = tid & 63, wave = __builtin_amdgcn_readfirstlane(tid >> 6), gw = blockIdx.x * NWAVES + wave; (void)lane; (void)gw;
            pg8::Gemm g{U, (const bf16*)(ws + WS_WUP) + (size_t)l * FF * D, D, D, D};
            pg8::StaticOrder S; S.init(MP, FF, G, (int)blockIdx.x);
            EpiRelu2 E{(bf16*)(ws + WS_H)};
            REPS(10) pg8::gemm_phase<EpiRelu2, pg8::StaticOrder, true, true>(lds, g, S, E);
            REPS(13) { SgRelu2 E2{(bf16*)(ws + WS_H)}; small_gemm(U + (size_t)MP * D, 0, D, (const bf16*)(ws + WS_WUP) + (size_t)l * FF * D, 0, D, D, 1, MS, FF, E2, lds, tid); }
        }
        SEAM(pb_ + 6);
        if (IN(pb_ + 7)) {
            const int tid = fresh_tid(), lane = tid & 63, wave = __builtin_amdgcn_readfirstlane(tid >> 6), gw = blockIdx.x * NWAVES + wave; (void)lane; (void)gw;
            pg8::Gemm g{(const bf16*)(ws + WS_H), (const bf16*)(ws + WS_WDN) + (size_t)l * D * FF, FF, FF, FF};
            pg8::StaticOrder S; S.init(MP, D, G, (int)blockIdx.x);
            EpiResid E{X, X + (size_t)MP * D, adal + 5120, Z};
            REPS(11) pg8::gemm_phase<EpiResid, pg8::StaticOrder, true, true>(lds, g, S, E);
            REPS(13) { SgResid E2{X + (size_t)MP * D, adal + 5120, Z}; small_gemm(((const bf16*)(ws + WS_H)) + (size_t)MP * FF, 0, FF, (const bf16*)(ws + WS_WDN) + (size_t)l * D * FF, 0, FF, FF, 1, MS, D, E2, lds, tid); }
        }
        SEAM(pb_ + 7);
        if (IN(pb_ + 8)) {
            const int tid = fresh_tid(), lane = tid & 63, wave = __builtin_amdgcn_readfirstlane(tid >> 6), gw = blockIdx.x * NWAVES + wave; (void)lane; (void)gw;
            const bool last = l == DEPTH - 1;
            REPS(6) for (int r = gw; r < M; r += NGW) {
                const float* ad = adal + (size_t)NCOND * 6144 + (size_t)cond_of_row(r) * 6144;
                float* xo = last ? (r < MP ? A.out + O_YP + (size_t)r * D : A.out + O_YS + (size_t)(r - MP) * D) : X + (size_t)r * D;
                ln_row(Z + (size_t)r * D, A.ln_g + (size_t)(l * 2 + 1) * D, A.ln_b + (size_t)(l * 2 + 1) * D, xo, ad, ad + 1024, last ? (bf16*)nullptr : U + (size_t)r * D, lane);
            }
        }
        SEAM(pb_ + 8);
    }
__global__ void __launch_bounds__(NTHR, 2) fwd_kernel(Args A_unused) {
    extern __shared__ __attribute__((aligned(16))) unsigned char lds_raw[];
    LAS unsigned char* lds = (LAS unsigned char*)lds_raw;
    const int G = gridDim.x, NGW = G * NWAVES;
    unsigned char* ws = A.ws;
    for (int u = threadIdx.x; u < (LDS_BYTES - LDSCTL_OFF) / 4; u += NTHR) ((LAS unsigned*)(lds + LDSCTL_OFF))[u] = 0u;
    __syncthreads();
    XcdBarrier bar; bar.bar = (unsigned*)(ws + WS_CTL) + CW_BAR; bar.x = 0; bar.st = nullptr;
    if (!MK_PER_PHASE) bar = xcd_barrier_post((unsigned*)(ws + WS_CTL) + CW_BAR, (volatile LAS unsigned*)(lds + MISC_OFF) + 8);
    const int lo = A.ph_lo, hi = A.ph_hi;

    float* const ADA = (float*)(ws + WS_ADA);
    float* const X = (float*)(ws + WS_X);
    float* const Z = (float*)(ws + WS_Z);
    bf16* const U = (bf16*)(ws + WS_U);

    if (IN(0)) { const int tid = fresh_tid(), lane = tid & 63, wave = __builtin_amdgcn_readfirstlane(tid >> 6), gw = blockIdx.x * NWAVES + wave; (void)tid; REPS(0) { phase_p0a(A, lds, gw, NGW, lane, wave); prep_cache_images(A, lds, gw, NGW, lane, wave); } }
    SEAM(0);
    if (IN(1)) { const int tid = fresh_tid(); REPS(7) { phase_ada(A, lds, tid); } }
    SEAM(1);
    if (IN(2)) {
        const int tid = fresh_tid(), lane = tid & 63, wave = __builtin_amdgcn_readfirstlane(tid >> 6), gw = blockIdx.x * NWAVES + wave;
        for (int r = gw; r < M; r += NGW) {
            const float* ad = ADA + (size_t)cond_of_row(r) * 6144;
            mod_row(r < MP ? A.x_prompt + (size_t)r * D : A.x_sample + (size_t)(r - MP) * D, ad, ad + 1024, U + (size_t)r * D, lane);
        }
    }
    SEAM(2);

    layer_phases<0>(lds, bar, G, NGW, lo, hi);
    layer_phases<1>(lds, bar, G, NGW, lo, hi);
    static_assert(DEPTH == 2, "two layers");
#undef IN
#undef SEAM
#undef A
}

extern "C" void kernel_launch(void* const* d_in, const int* in_sizes, int n_in, void* d_out, int out_size, void* d_ws, size_t ws_size, hipStream_t stream) {
    static int grid = 0;
    if (grid == 0) {
        if (n_in != 25 || (size_t)out_size != O_END || ws_size < WS_END) { fprintf(stderr, "kernel_launch: unexpected shapes: n_in %d out %d (want %zu) ws %zu (want >= %zu)\n", n_in, out_size, (size_t)O_END, ws_size, (size_t)WS_END); grid = -1; return; }
        int dev = 0, cus = 0, per_cu = 0;
        if (hipGetDevice(&dev) != hipSuccess || hipDeviceGetAttribute(&cus, hipDeviceAttributeMultiprocessorCount, dev) != hipSuccess) { grid = -1; return; }
        if (hipFuncSetAttribute((const void*)fwd_kernel, hipFuncAttributeMaxDynamicSharedMemorySize, LDS_BYTES) != hipSuccess) { fprintf(stderr, "kernel_launch: hipFuncSetAttribute failed\n"); grid = -1; return; }
        if (hipOccupancyMaxActiveBlocksPerMultiprocessor(&per_cu, (const void*)fwd_kernel, NTHR, LDS_BYTES) != hipSuccess || per_cu < 1) fprintf(stderr, "kernel_launch: occupancy query reports %d blocks per CU\n", per_cu);
        (void)hipGetLastError();
        grid = cus;
    }
    if (grid < 0) return;
    (void)hipMemsetAsync((char*)d_ws + WS_CTL, 0, CTL_ZERO_BYTES, stream);
    Args a{};
    a.x_prompt = (const float*)d_in[0]; a.x_sample = (const float*)d_in[1]; a.cache_cmp = (const float*)d_in[2]; a.cache_slc = (const float*)d_in[3]; a.cache_win = (const float*)d_in[4];
    a.st_C = (const float*)d_in[5]; a.st_n = (const float*)d_in[6]; a.st_m = (const float*)d_in[7]; a.page_table = (const int*)d_in[8]; a.c_prompt = (const float*)d_in[9]; a.c_sample = (const float*)d_in[10];
    a.w_ada = (const float*)d_in[11]; a.b_ada = (const float*)d_in[12]; a.w_in = (const float*)d_in[13]; a.b_gate = (const float*)d_in[14]; a.ml_norm_g = (const float*)d_in[15]; a.cmp_pe = (const float*)d_in[16];
    a.cmp_w1 = (const float*)d_in[17]; a.cmp_w2 = (const float*)d_in[18]; a.rel_bias = (const float*)d_in[19]; a.w_out = (const float*)d_in[20]; a.ln_g = (const float*)d_in[21]; a.ln_b = (const float*)d_in[22];
    a.w_up = (const float*)d_in[23]; a.w_down = (const float*)d_in[24];
    a.out = (float*)d_out; a.ws = (unsigned char*)d_ws;
#if MK_PER_PHASE
    for (int ph = 0; ph < N_PHASES; ++ph) { a.ph_lo = ph; a.ph_hi = ph + 1; hipLaunchKernelGGL(fwd_kernel, dim3(grid), dim3(NTHR), LDS_BYTES, stream, a); }
#else
    a.ph_lo = 0; a.ph_hi = N_PHASES;
    hipLaunchKernelGGL(fwd_kernel, dim3(grid), dim3(NTHR), LDS_BYTES, stream, a);
#endif
    const hipError_t le = hipPeekAtLastError();
    if (le != hipSuccess) fprintf(stderr, "kernel_launch: launch failed: %s\n", hipGetErrorName(le));
}
```

```cpp
#include <hip/hip_runtime.h>
#include <cstdio>
#include <cstdint>
namespace pg8 {
#define PG8_LAS __attribute__((address_space(3)))
typedef unsigned short bf16_t;
typedef short bf16x8 __attribute__((ext_vector_type(8)));
typedef float f32x4 __attribute__((ext_vector_type(4)));
typedef unsigned u32x4 __attribute__((ext_vector_type(4)));
constexpr int BM = 256, BK = 64, HALF = 128, HTB = HALF * BK * 2  , STAGE_BYTES = 8 * HTB, NXCD = 8, WGM = 8;

__host__ __device__ __forceinline__ int lds_byte(int r, int c) { const int st = (r >> 4) * 2 + (c >> 5), rr = r & 15, cc = c & 31, ob = rr * 64 + cc * 2; return st * 1024 + (ob ^ (((ob >> 9) & 1) << 5)); }
__host__ __device__ __forceinline__ void stage_rc(int b, int& R, int& C) { const int st = b / 1024, sb = b % 1024, swz = sb ^ (((sb >> 9) & 1) << 5); R = (st >> 1) * 16 + swz / 64; C = (st & 1) * 32 + (swz % 64) / 2; }
__host__ __device__ __forceinline__ int perm32(int rho) { const int n = rho >> 4, i = rho & 15; return 8 * (i >> 2) + 4 * n + (i & 3); }

struct Unit { int pm, pn; };
struct Gemm { const bf16_t* A; const bf16_t* Bt; int K, lda, ldb; };

struct StaticOrder {
    int nM, nN, nwg, G, c;
    __host__ __device__ void init(int M, int N, int G_, int c_) { nM = M / BM; nN = N / BM; nwg = nM * nN; G = G_; c = c_; }
    __host__ __device__ bool next(int i, Unit& u) const {
        const long L = (long)i * G + c; if (L >= nwg) return false;
        int wgid = (int)L; { const int q = nwg / NXCD, r = nwg % NXCD, xcd = wgid % NXCD, off = wgid / NXCD; wgid = (xcd < r ? xcd * (q + 1) : r * (q + 1) + (xcd - r) * q) + off; }
        const int nig = WGM * nN, gid = wgid / nig, fm = gid * WGM, gsz = (nM - fm) < WGM ? (nM - fm) : WGM;
        u.pm = fm + ((wgid % nig) % gsz); u.pn = (wgid % nig) / gsz; return true;
    }
    __device__ __forceinline__ void a_ready(const Unit&) const {}
    __device__ __forceinline__ void done(const Unit&) const {}
};

template <class Epi, class Sched, bool ALIGN_EPI = false, bool SP2 = false>
__device__ __forceinline__ void gemm_phase(PG8_LAS unsigned char* lds, const Gemm g, const Sched& S, const Epi& E) {
    const int tid = threadIdx.x, wid = __builtin_amdgcn_readfirstlane(tid >> 6), lane = tid & 63, wr = wid >> 2, wc = wid & 3, fr = lane & 15, fq = lane >> 4;
    const int K = g.K, nt = K / BK;
    unsigned voffA[2], voffB[2];
#pragma unroll
    for (int i = 0; i < 2; ++i) { int R, C; stage_rc(tid * 16 + i * 8192, R, C); const int Rb = Epi::PERM ? ((R & ~31) + perm32(R & 31)) : R;
        voffA[i] = (unsigned)(R * g.lda + C) * 2u; voffB[i] = (unsigned)(Rb * g.ldb + C) * 2u; }
    const size_t kstep = (size_t)(BK * 2);
    const size_t hstepA = (size_t)HALF * g.lda * 2, hstepB = (size_t)HALF * g.ldb * 2;
    const size_t tstepA = 2 * hstepA, tstepB = 2 * hstepB;
    const unsigned ldsw = (unsigned)wid * 1024u;
    const int aoff = lds_byte(wr * 64 + fr, fq * 8), boff = lds_byte(wc * 32 + fr, fq * 8);
#define PG8_SA(b, h) (((b) * 2 + (h)) * HTB)
#define PG8_SB(b, h) ((4 + (b) * 2 + (h)) * HTB)
#define PG8_STAGE(bufoff, gbase, voff) do { _Pragma("unroll") for (int _i = 0; _i < 2; ++_i) \
        __builtin_amdgcn_global_load_lds((const unsigned*)((const char*)(gbase) + (voff)[_i]), (PG8_LAS unsigned*)(lds + (bufoff) + ldsw + _i * 8192), 16, 0, 0); } while (0)
#define PG8_LDA(dst, b, h) do { _Pragma("unroll") for (int m = 0; m < 4; ++m) _Pragma("unroll") for (int k = 0; k < 2; ++k) dst[m][k] = *(const PG8_LAS bf16x8*)(lds + PG8_SA(b, h) + aoff + m * 2048 + k * 1024); } while (0)
#define PG8_LDB(dst, b, h) do { _Pragma("unroll") for (int n = 0; n < 2; ++n) _Pragma("unroll") for (int k = 0; k < 2; ++k) dst[n][k] = *(const PG8_LAS bf16x8*)(lds + PG8_SB(b, h) + boff + n * 2048 + k * 1024); } while (0)
#define PG8_MMA(ai, bj, At, Bt) do { __builtin_amdgcn_s_setprio(1); _Pragma("unroll") for (int m = 0; m < 4; ++m) _Pragma("unroll") for (int n = 0; n < 2; ++n) _Pragma("unroll") for (int k = 0; k < 2; ++k) \
        acc[ai][bj][m][n] = __builtin_amdgcn_mfma_f32_16x16x32_bf16(Bt[n][k], At[m][k], acc[ai][bj][m][n], 0, 0, 0); __builtin_amdgcn_s_setprio(0); } while (0)
#define PG8_WAIT_V(n) asm volatile("s_waitcnt vmcnt(" #n ")" ::: "memory")
#define PG8_WAIT_L(n) asm volatile("s_waitcnt lgkmcnt(" #n ")" ::: "memory")
#define PG8_BAR __builtin_amdgcn_s_barrier()
#define PG8_SCHED __builtin_amdgcn_sched_barrier(0)
    Unit cur, nxt; int ui = 0;
    if (!S.next(0, cur)) return;
    f32x4 acc[2][2][4][2];
#pragma unroll
    for (int a = 0; a < 2; ++a)
#pragma unroll
        for (int b = 0; b < 2; ++b)
#pragma unroll
            for (int m = 0; m < 4; ++m)
#pragma unroll
                for (int n = 0; n < 2; ++n) acc[a][b][m][n] = (f32x4){0.f, 0.f, 0.f, 0.f};
    bf16x8 At[4][2], B0[2][2], B1[2][2];
    const char* cA = (const char*)g.A + (size_t)cur.pm * tstepA; const char* cB = (const char*)g.Bt + (size_t)cur.pn * tstepB;
    S.a_ready(cur);
    if constexpr (SP2) {
        PG8_STAGE(PG8_SB(0, 0), cB, voffB); PG8_STAGE(PG8_SB(0, 1), cB + hstepB, voffB); PG8_STAGE(PG8_SA(0, 0), cA, voffA); PG8_STAGE(PG8_SA(0, 1), cA + hstepA, voffA);
        if (wr == 1) PG8_BAR;
        PG8_WAIT_V(2); PG8_BAR;
        PG8_STAGE(PG8_SB(1, 0), cB + kstep, voffB); PG8_STAGE(PG8_SA(1, 0), cA + kstep, voffA); PG8_STAGE(PG8_SB(1, 1), cB + hstepB + kstep, voffB);
        PG8_WAIT_V(6); PG8_BAR;
    } else {
        PG8_STAGE(PG8_SB(0, 0), cB, voffB); PG8_STAGE(PG8_SA(0, 0), cA, voffA); PG8_STAGE(PG8_SB(0, 1), cB + hstepB, voffB); PG8_STAGE(PG8_SA(0, 1), cA + hstepA, voffA);
        if (wr == 1) PG8_BAR;
        PG8_WAIT_V(4); PG8_BAR;
        PG8_STAGE(PG8_SB(1, 0), cB + kstep, voffB); PG8_STAGE(PG8_SA(1, 0), cA + kstep, voffA); PG8_STAGE(PG8_SB(1, 1), cB + hstepB + kstep, voffB);
        PG8_WAIT_V(6); PG8_BAR;
    }
    for (;;) {
        const bool has_next = S.next(ui + 1, nxt);
        const char* nA = has_next ? (const char*)g.A + (size_t)nxt.pm * tstepA : cA; const char* nB = has_next ? (const char*)g.Bt + (size_t)nxt.pn * tstepB : cB;
        for (int t = 0; t < nt; t += 2) {
            const bool last = (t == nt - 2);
            const char* a1 = cA + (size_t)(t + 1) * kstep;
            const char* a2 = last ? nA : cA + (size_t)(t + 2) * kstep; const char* b2 = last ? nB : cB + (size_t)(t + 2) * kstep;
            const char* a3 = a2 + kstep; const char* b3 = b2 + kstep;
            if (last && has_next) S.a_ready(nxt);
            if constexpr (SP2) {
            PG8_LDB(B0, 0, 0); PG8_LDB(B1, 0, 1); PG8_SCHED; PG8_LDA(At, 0, 0); PG8_STAGE(PG8_SA(1, 1), a1 + hstepA, voffA);
            PG8_WAIT_V(8); PG8_WAIT_L(0); PG8_BAR; PG8_MMA(0, 0, At, B0); PG8_MMA(0, 1, At, B1); PG8_BAR; PG8_SCHED;
            PG8_LDA(At, 0, 1); PG8_STAGE(PG8_SB(0, 0), b2, voffB); PG8_STAGE(PG8_SB(0, 1), b2 + hstepB, voffB); PG8_STAGE(PG8_SA(0, 0), a2, voffA);
            PG8_WAIT_V(8); PG8_WAIT_L(0); PG8_BAR; PG8_MMA(1, 0, At, B0); PG8_MMA(1, 1, At, B1); PG8_BAR; PG8_SCHED;
            PG8_LDB(B0, 1, 0); PG8_LDB(B1, 1, 1); PG8_SCHED; PG8_LDA(At, 1, 0); PG8_STAGE(PG8_SA(0, 1), a2 + hstepA, voffA);
            PG8_WAIT_V(8); PG8_WAIT_L(0); PG8_BAR; PG8_MMA(0, 0, At, B0); PG8_MMA(0, 1, At, B1); PG8_BAR; PG8_SCHED;
            PG8_LDA(At, 1, 1); PG8_STAGE(PG8_SB(1, 0), b3, voffB); PG8_STAGE(PG8_SB(1, 1), b3 + hstepB, voffB); PG8_STAGE(PG8_SA(1, 0), a3, voffA);
            PG8_WAIT_V(8); PG8_WAIT_L(0); PG8_BAR; PG8_MMA(1, 0, At, B0); PG8_MMA(1, 1, At, B1); PG8_BAR; PG8_SCHED;
            } else {
            PG8_LDB(B0, 0, 0); PG8_SCHED; PG8_LDA(At, 0, 0); PG8_STAGE(PG8_SA(1, 1), a1 + hstepA, voffA);
            PG8_WAIT_L(8); PG8_BAR; PG8_WAIT_L(0); PG8_MMA(0, 0, At, B0); PG8_BAR; PG8_SCHED;
            PG8_LDB(B1, 0, 1); PG8_STAGE(PG8_SB(0, 0), b2, voffB);
            PG8_BAR; PG8_WAIT_L(0); PG8_MMA(0, 1, At, B1); PG8_BAR;
            PG8_LDA(At, 0, 1); PG8_STAGE(PG8_SA(0, 0), a2, voffA);
            PG8_BAR; PG8_WAIT_L(0); PG8_MMA(1, 0, At, B0); PG8_BAR; PG8_SCHED;
            PG8_STAGE(PG8_SB(0, 1), b2 + hstepB, voffB);
            PG8_WAIT_V(6); PG8_BAR; PG8_MMA(1, 1, At, B1); PG8_BAR;
            PG8_LDB(B0, 1, 0); PG8_SCHED; PG8_LDA(At, 1, 0); PG8_STAGE(PG8_SA(0, 1), a2 + hstepA, voffA);
            PG8_WAIT_L(8); PG8_BAR; PG8_WAIT_L(0); PG8_MMA(0, 0, At, B0); PG8_BAR; PG8_SCHED;
            PG8_LDB(B1, 1, 1); PG8_STAGE(PG8_SB(1, 0), b3, voffB);
            PG8_BAR; PG8_WAIT_L(0); PG8_MMA(0, 1, At, B1); PG8_BAR;
            PG8_LDA(At, 1, 1); PG8_STAGE(PG8_SA(1, 0), a3, voffA);
            PG8_BAR; PG8_WAIT_L(0); PG8_MMA(1, 0, At, B0); PG8_BAR; PG8_SCHED;
            PG8_STAGE(PG8_SB(1, 1), b3 + hstepB, voffB);
            PG8_WAIT_V(6); PG8_BAR; PG8_MMA(1, 1, At, B1); PG8_BAR;
            }
        }
        if constexpr (ALIGN_EPI) { if (wr == 0) PG8_BAR; }
        if constexpr (!Epi::AFTER_DRAIN) { E(acc, cur, wr, wc, fr, fq); S.done(cur); }
        if (!has_next) break;
#pragma unroll
        for (int a = 0; a < 2; ++a)
#pragma unroll
            for (int b = 0; b < 2; ++b)
#pragma unroll
                for (int m = 0; m < 4; ++m)
#pragma unroll
                    for (int n = 0; n < 2; ++n) acc[a][b][m][n] = (f32x4){0.f, 0.f, 0.f, 0.f};
        cur = nxt; cA = nA; cB = nB; ++ui;
        if constexpr (ALIGN_EPI) { if (wr == 1) PG8_BAR; }
    }
    PG8_WAIT_V(0);
    if constexpr (!ALIGN_EPI) { if (wr == 0) PG8_BAR; }
    PG8_BAR;
    if constexpr (Epi::AFTER_DRAIN) { E.fused(acc, cur, wr, wc, fr, fq, lds, wid, lane); S.done(cur); }
#undef PG8_SA
#undef PG8_SB
#undef PG8_STAGE
#undef PG8_LDA
#undef PG8_LDB
#undef PG8_MMA
#undef PG8_WAIT_V
#undef PG8_WAIT_L
#undef PG8_BAR
#undef PG8_SCHED
}
}

constexpr int D = 1024, BATCH = 2, SEQ = 8192, DEPTH = 2, DB = 128, DS = 4, PAST = 2048, PAGE = 128, NPG = 16, NPHYS = 2560;
constexpr int MP = BATCH * SEQ, MS = DB * DS, M = MP + MS;
constexpr int NINP = 3584, FF = 4096, NCOND = BATCH + DB;
constexpr int NH = 4, HD = 128;
constexpr int LCH = 256, NCH = SEQ / LCH, NUNIT = BATCH * NH * NCH;
constexpr int NCB = 17408;
constexpr int XCP = NCB * 16;
constexpr float ALPHA = 1.4142135623730951f;
constexpr float LN_EPS = 1e-5f;
constexpr size_t O_YP = 0, O_YS = O_YP + (size_t)MP * D, O_CMPP = O_YS + (size_t)MS * D, O_CMPS = O_CMPP + (size_t)DEPTH * MP * 256, O_SLCP = O_CMPS + (size_t)DEPTH * MS * 256,
                 O_SLCS = O_SLCP + (size_t)DEPTH * MP * 256, O_WINP = O_SLCS + (size_t)DEPTH * MS * 256, O_WINS = O_WINP + (size_t)DEPTH * BATCH * 512 * 256,
                 O_CP = O_WINS + (size_t)DEPTH * DB * 512 * 256, O_CS = O_CP + (size_t)DEPTH * BATCH * NH * HD * HD, O_NP = O_CS + (size_t)DEPTH * DB * NH * HD * HD,
                 O_NS = O_NP + (size_t)DEPTH * BATCH * NH * HD, O_MP = O_NS + (size_t)DEPTH * DB * NH * HD, O_MS = O_MP + (size_t)DEPTH * BATCH * NH, O_END = O_MS + (size_t)DEPTH * DB * NH;

constexpr size_t al1m(size_t x) { return (x + 0xFFFFFull) & ~(size_t)0xFFFFFull; }
constexpr size_t WS_CTL = 0, CTL_ZERO_BYTES = 1u << 20;
constexpr size_t WS_WIN  = CTL_ZERO_BYTES;
constexpr size_t WS_WOUT = WS_WIN  + al1m((size_t)DEPTH * NINP * D * 2);
constexpr size_t WS_WUP  = WS_WOUT + al1m((size_t)DEPTH * D * D * 2);
constexpr size_t WS_WDN  = WS_WUP  + al1m((size_t)DEPTH * FF * D * 2);
constexpr size_t WS_W1   = WS_WDN  + al1m((size_t)DEPTH * D * FF * 2);
constexpr size_t WS_ADA  = WS_W1   + al1m((size_t)DEPTH * 2 * 256 * 2048 * 2);
constexpr size_t WS_B1   = WS_ADA  + al1m((size_t)DEPTH * NCOND * 6144 * 4);
constexpr size_t WS_BT   = WS_B1   + al1m(4096);
constexpr size_t WS_X    = WS_BT   + al1m(8 * 132 * 4);
constexpr size_t WS_Z    = WS_X    + al1m((size_t)M * D * 4);
constexpr size_t WS_U    = WS_Z    + al1m((size_t)M * D * 4);
constexpr size_t WS_QKVO = WS_U    + al1m((size_t)M * D * 2);
constexpr size_t WS_NQ   = WS_QKVO + al1m((size_t)M * 2048 * 2);
constexpr size_t WS_GATE = WS_NQ   + al1m((size_t)M * 512 * 2);
constexpr size_t WS_KVR  = WS_GATE + al1m((size_t)M * 32 * 4);
constexpr size_t WS_XC   = WS_KVR  + al1m((size_t)3 * M * 256 * 4);
constexpr size_t WS_HID  = WS_XC   + al1m((size_t)DEPTH * 4 * XCP * 64 * 2 + 4096);
constexpr size_t WS_CKV  = WS_HID  + al1m((size_t)DEPTH * 4 * NCB * 256 * 2);
constexpr size_t WS_KS   = WS_CKV  + al1m((size_t)DEPTH * 4 * NCB * 64 * 4);
constexpr size_t WS_VTS  = WS_KS   + al1m((size_t)DEPTH * 2 * (MP + DB * 2112) * 64 * 2 + 65536);
constexpr size_t WS_KW   = WS_VTS  + al1m((size_t)DEPTH * 2 * (MP + DB * 2112) * 64 * 2 + 65536);
constexpr size_t WS_VTW  = WS_KW   + al1m((size_t)DEPTH * 2 * (MP + DB * 528 + 64) * 64 * 2 + 65536);
constexpr size_t WS_KC   = WS_VTW  + al1m((size_t)DEPTH * 2 * (MP + DB * 528 + 64) * 64 * 2 + 65536);
constexpr size_t WS_VCT  = WS_KC   + al1m((size_t)DEPTH * 2 * NCB * 64 * 2 + 65536);
constexpr size_t WS_W2T  = WS_VCT  + al1m((size_t)DEPTH * 2 * NCB * 64 * 2 + 65536);
constexpr size_t WS_MIX  = WS_W2T  + al1m(65536);
constexpr size_t WS_H    = WS_MIX  + al1m((size_t)M * D * 2);
constexpr size_t WS_DCT  = WS_H    + al1m((size_t)M * FF * 2);
constexpr size_t WS_DN   = WS_DCT  + al1m((size_t)NUNIT * HD * HD * 4);
constexpr size_t WS_CHS  = WS_DN   + al1m((size_t)NUNIT * HD * 4);
constexpr size_t WS_CTP  = WS_CHS  + al1m((size_t)NUNIT * 4 * 4);
constexpr size_t WS_NPV  = WS_CTP  + al1m((size_t)NUNIT * HD * HD * 2);
constexpr size_t WS_WSC  = WS_NPV  + al1m((size_t)NUNIT * HD * 4);
constexpr size_t WS_HRAW = WS_WSC  + al1m((size_t)NUNIT * LCH * LCH * 4);
constexpr size_t WS_END  = WS_HRAW + al1m((size_t)NUNIT * LCH * HD * 4);

constexpr int CW_BAR = 4096;

constexpr int RING_BYTES = 131072, LDSCTL_OFF = RING_BYTES, MISC_OFF = LDSCTL_OFF + 320, LDS_BYTES = 147456;
constexpr int NWAVES = 8, NTHR = NWAVES * 64;

#define GAS __attribute__((address_space(1)))
#define LAS __attribute__((address_space(3)))
typedef unsigned short bf16;
typedef unsigned v4u __attribute__((ext_vector_type(4)));
typedef unsigned v2u __attribute__((ext_vector_type(2)));
typedef float f32x4 __attribute__((ext_vector_type(4)));
typedef float f32x2 __attribute__((ext_vector_type(2)));

__device__ __forceinline__ unsigned f2bf(float f) { unsigned u = __builtin_bit_cast(unsigned, f); return (u + 0x7fffu + ((u >> 16) & 1u)) >> 16; }
__device__ __forceinline__ unsigned pk2(float lo, float hi) { return f2bf(lo) | (f2bf(hi) << 16); }
__device__ __forceinline__ float bflo(unsigned u) { return __builtin_bit_cast(float, u << 16); }
__device__ __forceinline__ float bfhi(unsigned u) { return __builtin_bit_cast(float, u & 0xffff0000u); }
__device__ __forceinline__ float bf2f(bf16 h) { return __builtin_bit_cast(float, (unsigned)h << 16); }
__device__ __forceinline__ float sigmoidf_(float x) { return 1.f / (1.f + __expf(-x)); }
__device__ __forceinline__ float wave_sum(float v) {
#pragma unroll
    for (int o = 1; o < 64; o <<= 1) v += __shfl_xor(v, o);
    return v;
}
__device__ __forceinline__ float wave_max(float v) {
#pragma unroll
    for (int o = 1; o < 64; o <<= 1) v = fmaxf(v, __shfl_xor(v, o));
    return v;
}

#define XB_TMO      128
#define XB_XCNT(j)  (256  + 64 * (j))
#define XB_XSUB(j)  (1280 + 64 * (j))
#define XB_XGEN(j)  (2304 + 64 * (j))
#define XB_TOP      3328
#define XB_TOPGEN   3392
#define XCD_BAR_WORDS 3456
#define XB_SPIN_CAP (1u << 18)

__device__ __forceinline__ unsigned xb_ld(unsigned* p)              { return __hip_atomic_load(p, __ATOMIC_RELAXED, __HIP_MEMORY_SCOPE_AGENT); }
__device__ __forceinline__ unsigned xb_add(unsigned* p, unsigned v) { return __hip_atomic_fetch_add(p, v, __ATOMIC_RELAXED, __HIP_MEMORY_SCOPE_AGENT); }
__device__ __forceinline__ unsigned xb_xcc_id() { return (unsigned)__builtin_amdgcn_s_getreg((3 << 11) | 20) & 0xFu; }
#define XB_SPIN(cond, bar) do { unsigned _sp = 0; while (cond) { __builtin_amdgcn_s_sleep(1); \
    if ((++_sp & 255u) == 0u) { if (xb_ld(&(bar)[XB_TMO])) break; if (_sp > XB_SPIN_CAP) { atomicAdd(&(bar)[XB_TMO], 1u); break; } } } } while (0)

struct XcdBarrier {
    unsigned* bar; unsigned x;
    volatile LAS unsigned* st;
};

__device__ __forceinline__ XcdBarrier xcd_barrier_post(unsigned* bar, volatile LAS unsigned* st) {
    XcdBarrier b; b.bar = bar; b.x = xb_xcc_id(); b.st = st;
    if (threadIdx.x == 0) (void)xb_add(&bar[XB_XCNT(b.x)], 1u);
    return b;
}
__device__ __forceinline__ void xcd_barrier_complete(unsigned* bar, unsigned x, unsigned& nloc, unsigned& nx) {
    const unsigned G = gridDim.x * gridDim.y * gridDim.z;
    unsigned sum, cnt, mine, sp = 0u;
    for (;;) {
        sum = 0u; cnt = 0u; mine = 0u;
#pragma unroll
        for (unsigned j = 0; j < 16; ++j) { const unsigned c = xb_ld(&bar[XB_XCNT(j)]); sum += c; cnt += (c > 0u) ? 1u : 0u; mine = (j == x) ? c : mine; }
        if (sum == G) break;
        __builtin_amdgcn_s_sleep(1);
        if ((++sp & 255u) == 0u) { if (xb_ld(&bar[XB_TMO])) break; if (sp > XB_SPIN_CAP) { atomicAdd(&bar[XB_TMO], 1u); break; } }
    }
    nloc = mine > 0u ? mine : 1u; nx = cnt > 0u ? cnt : 1u;
}

__device__ __forceinline__ void xcd_barrier(const XcdBarrier& b) {
    asm volatile("s_waitcnt vmcnt(0)" ::: "memory");
    __syncthreads();
    if (threadIdx.x == 0) {
        unsigned* bar = b.bar;
        __builtin_amdgcn_s_waitcnt(0);
        unsigned nloc = b.st[0], nx = b.st[1];
        if (nloc == 0u) { xcd_barrier_complete(bar, b.x, nloc, nx); b.st[0] = nloc; b.st[1] = nx; }
        const unsigned old = xb_add(&bar[XB_XSUB(b.x)], 1u);
        const unsigned gen = old / nloc;
        if (old + 1u == (gen + 1u) * nloc) {
            __builtin_amdgcn_fence(__ATOMIC_RELEASE, "agent");
            asm volatile("s_waitcnt vmcnt(0)" ::: "memory");
            const unsigned og = xb_add(&bar[XB_TOP], 1u);
            const unsigned tg = og / nx;
            if (og + 1u == (tg + 1u) * nx) xb_add(&bar[XB_TOPGEN], 1u);
            else XB_SPIN(xb_ld(&bar[XB_TOPGEN]) == tg, bar);
            __builtin_amdgcn_fence(__ATOMIC_ACQUIRE, "agent");
            xb_add(&bar[XB_XGEN(b.x)], 1u);
            asm volatile("s_waitcnt vmcnt(0)" ::: "memory");
        } else {
            XB_SPIN(xb_ld(&bar[XB_XGEN(b.x)]) == gen, bar);
            __builtin_amdgcn_fence(__ATOMIC_ACQUIRE, "agent");
            asm volatile("s_waitcnt vmcnt(0)" ::: "memory");
        }
    }
    __syncthreads();
}

struct Args {
    const float* x_prompt; const float* x_sample; const float* cache_cmp; const float* cache_slc; const float* cache_win;
    const float* st_C; const float* st_n; const float* st_m; const int* page_table; const float* c_prompt; const float* c_sample;
    const float* w_ada; const float* b_ada; const float* w_in; const float* b_gate; const float* ml_norm_g; const float* cmp_pe;
    const float* cmp_w1; const float* cmp_w2; const float* rel_bias; const float* w_out; const float* ln_g; const float* ln_b;
    const float* w_up; const float* w_down;
    float* out; unsigned char* ws; int ph_lo, ph_hi;
};
static_assert(sizeof(Args) == 27 * 8 + 8, "Args has no padding");
typedef const __attribute__((address_space(4))) Args CArgs;

__device__ __forceinline__ int cond_of_row(int r) { return r < MP ? (r >> 13) : BATCH + ((r - MP) >> 2); }

struct EpiInProj {
    static constexpr bool PERM = true, AFTER_DRAIN = false;
    bf16* QKVO; bf16* NQ; float* GATE; float* KVR; bf16* XC; float* out; int l;
    __device__ __forceinline__ void operator()(const f32x4 (&acc)[2][2][4][2], const pg8::Unit& u, int wr, int wc, int fr, int fq) const {
        const int row0 = u.pm * 256 + wr * 64 + fr, pn = u.pn, col8 = wc * 32 + 8 * fq;
#pragma unroll
        for (int ai = 0; ai < 2; ++ai)
#pragma unroll
            for (int m = 0; m < 4; ++m) {
                const int r = row0 + ai * 128 + m * 16;
#pragma unroll
                for (int bj = 0; bj < 2; ++bj) {
                    const f32x4 v0 = acc[ai][bj][m][0], v1 = acc[ai][bj][m][1];
                    const int cc = bj * 128 + col8;
                    if (pn < 10) {
                        v4u w; w.x = pk2(v0[0], v0[1]); w.y = pk2(v0[2], v0[3]); w.z = pk2(v1[0], v1[1]); w.w = pk2(v1[2], v1[3]);
                        if (pn < 8) *(v4u*)(QKVO + (size_t)r * 2048 + pn * 256 + cc) = w;
                        else        *(v4u*)(NQ + (size_t)r * 512 + (pn - 8) * 256 + cc) = w;
                    } else if (pn < 13) {
                        const int kind = pn - 10;
                        float* kr = KVR + ((size_t)kind * M + r) * 256 + cc;
                        *(f32x4*)kr = v0; *(f32x4*)(kr + 4) = v1;
                        float* o = nullptr;
                        if (r < MP) {
                            if (kind < 2) o = out + (kind == 0 ? O_CMPP : O_SLCP) + ((size_t)l * MP + r) * 256 + cc;
                            else { const int t = r & (SEQ - 1); if (t >= SEQ - 512) o = out + O_WINP + (((size_t)l * BATCH + (r >> 13)) * 512 + (t - (SEQ - 512))) * 256 + cc; }
                        } else {
                            const int rs = r - MP;
                            if (kind < 2) o = out + (kind == 0 ? O_CMPS : O_SLCS) + ((size_t)l * MS + rs) * 256 + cc;
                            else o = out + O_WINS + (((size_t)l * DB + (rs >> 2)) * 512 + 508 + (rs & 3)) * 256 + cc;
                        }
                        if (o) { *(f32x4*)o = v0; *(f32x4*)(o + 4) = v1; }
                        if (kind == 0 && r < MP) {
                            v4u w; w.x = pk2(v0[0], v0[1]); w.y = pk2(v0[2], v0[3]); w.z = pk2(v1[0], v1[1]); w.w = pk2(v1[2], v1[3]);
                            *(v4u*)(XC + ((size_t)(bj * 2 + (wc >> 1)) * XCP + r) * 64 + (wc & 1) * 32 + 8 * fq) = w;
                        }
                    } else {
                        if (bj == 0 && wc == 0) { float* gp = GATE + (size_t)r * 32 + 8 * fq; *(f32x4*)gp = v0; *(f32x4*)(gp + 4) = v1; }
                    }
                }
            }
    }
};

struct EpiResid {
    static constexpr bool PERM = true, AFTER_DRAIN = false;
    const float* xa; const float* xb; const float* gate; float* Z;
    __device__ __forceinline__ void operator()(const f32x4 (&acc)[2][2][4][2], const pg8::Unit& u, int wr, int wc, int fr, int fq) const {
        const int row0 = u.pm * 256 + wr * 64 + fr, col0 = u.pn * 256 + wc * 32 + 8 * fq;
#pragma unroll
        for (int ai = 0; ai < 2; ++ai)
#pragma unroll
            for (int m = 0; m < 4; ++m) {
                const int r = row0 + ai * 128 + m * 16;
                const float* xr = (r < MP ? xa + (size_t)r * D : xb + (size_t)(r - MP) * D) + col0;
                const float* gr = gate + (size_t)cond_of_row(r) * 6144 + col0;
                float* zr = Z + (size_t)r * D + col0;
#pragma unroll
                for (int bj = 0; bj < 2; ++bj) {
                    const f32x4 x0 = *(const f32x4*)(xr + bj * 128), x1 = *(const f32x4*)(xr + bj * 128 + 4);
                    const f32x4 g0 = *(const f32x4*)(gr + bj * 128), g1 = *(const f32x4*)(gr + bj * 128 + 4);
                    *(f32x4*)(zr + bj * 128) = x0 * ALPHA + g0 * acc[ai][bj][m][0];
                    *(f32x4*)(zr + bj * 128 + 4) = x1 * ALPHA + g1 * acc[ai][bj][m][1];
                }
            }
    }
};

struct EpiRelu2 {
    static constexpr bool PERM = true, AFTER_DRAIN = false;
    bf16* H;
    __device__ __forceinline__ void operator()(const f32x4 (&acc)[2][2][4][2], const pg8::Unit& u, int wr, int wc, int fr, int fq) const {
        const int row0 = u.pm * 256 + wr * 64 + fr, col0 = u.pn * 256 + wc * 32 + 8 * fq;
#pragma unroll
        for (int ai = 0; ai < 2; ++ai)
#pragma unroll
            for (int m = 0; m < 4; ++m) {
                bf16* hr = H + (size_t)(row0 + ai * 128 + m * 16) * FF + col0;
#pragma unroll
                for (int bj = 0; bj < 2; ++bj) {
                    f32x4 a = acc[ai][bj][m][0], b = acc[ai][bj][m][1];
#pragma unroll
                    for (int i = 0; i < 4; ++i) { a[i] = fmaxf(a[i], 0.f); a[i] *= a[i]; b[i] = fmaxf(b[i], 0.f); b[i] *= b[i]; }
                    v4u w; w.x = pk2(a[0], a[1]); w.y = pk2(a[2], a[3]); w.z = pk2(b[0], b[1]); w.w = pk2(b[2], b[3]);
                    *(v4u*)(hr + bj * 128) = w;
                }
            }
    }
};

__device__ __forceinline__ float gelu_tanh(float x) {
    const float y = 0.7978845608028654f * (x + 0.044715f * x * x * x);
    const float t = 1.f - 2.f / (__expf(2.f * y) + 1.f);
    return 0.5f * x * (1.f + t);
}
struct EpiCmpHid {
    static constexpr bool PERM = true, AFTER_DRAIN = false;
    bf16* HID; const float* B1;
    __device__ __forceinline__ void operator()(const f32x4 (&acc)[2][2][4][2], const pg8::Unit& u, int wr, int wc, int fr, int fq) const {
        const int row0 = u.pm * 256 + wr * 64 + fr, col0 = wc * 32 + 8 * fq;
        const float* bp = B1 + u.pn * 256 + col0;
        f32x4 bv[2][2];
#pragma unroll
        for (int bj = 0; bj < 2; ++bj) { bv[bj][0] = *(const f32x4*)(bp + bj * 128); bv[bj][1] = *(const f32x4*)(bp + bj * 128 + 4); }
#pragma unroll
        for (int ai = 0; ai < 2; ++ai)
#pragma unroll
            for (int m = 0; m < 4; ++m) {
                bf16* hr = HID + (size_t)(row0 + ai * 128 + m * 16) * 256 + col0;
#pragma unroll
                for (int bj = 0; bj < 2; ++bj) {
                    f32x4 a = acc[ai][bj][m][0] + bv[bj][0], b = acc[ai][bj][m][1] + bv[bj][1];
#pragma unroll
                    for (int i = 0; i < 4; ++i) { a[i] = gelu_tanh(a[i]); b[i] = gelu_tanh(b[i]); }
                    v4u w; w.x = pk2(a[0], a[1]); w.y = pk2(a[2], a[3]); w.z = pk2(b[0], b[1]); w.w = pk2(b[2], b[3]);
                    *(v4u*)(hr + bj * 128) = w;
                }
            }
    }
};

struct CmpOrder {
    int G, c, l0, nl, t0, ntile;
    __device__ __forceinline__ bool next(int i, pg8::Unit& u) const {
        const int L = i * G + c; if (L >= nl * 4 * ntile) return false;
        const int blk = L / ntile, tile = L % ntile, l = l0 + (blk >> 2), sg = blk & 3;
        u.pm = (l * 4 + sg) * 68 + t0 + tile; u.pn = l * 2 + (sg >> 1); return true;
    }
    __device__ __forceinline__ void a_ready(const pg8::Unit&) const {}
    __device__ __forceinline__ void done(const pg8::Unit&) const {}
};

typedef short sg_bf16x8 __attribute__((ext_vector_type(8)));
template <class Epi>
__device__ __forceinline__ void small_gemm(const bf16* A, size_t strideA, int lda, const bf16* Bt, size_t strideB, int ldb, int K, int nbatch, int Mrows, int N, const Epi& E, LAS unsigned char* lds, int tid) {
    const int lane = tid & 63, wave = tid >> 6, fr = lane & 15, fq = lane >> 4;
    const int ntn = N / 64, ntm = Mrows / 32, ntask = nbatch * ntm * ntn, kw = K / 8;
    LAS f32x4* red = (LAS f32x4*)lds;
    for (int task = blockIdx.x; task < ntask; task += gridDim.x) {
        const int batch = task / (ntm * ntn), tr = task % (ntm * ntn), tm = tr / ntn, tn = tr % ntn;
        const bf16* ap = A + (size_t)batch * strideA + (size_t)(tm * 32 + fr) * lda + wave * kw + 8 * fq;
        const bf16* bp = Bt + (size_t)E.bsel(batch) * strideB + (size_t)(tn * 64 + fr) * ldb + wave * kw + 8 * fq;
        f32x4 acc[2][4];
#pragma unroll
        for (int i = 0; i < 2; ++i)
#pragma unroll
            for (int j = 0; j < 4; ++j) acc[i][j] = (f32x4){0.f, 0.f, 0.f, 0.f};
#pragma unroll 4
        for (int k = 0; k < kw; k += 32) {
            sg_bf16x8 af[2], bf[4];
#pragma unroll
            for (int i = 0; i < 2; ++i) af[i] = *(const sg_bf16x8*)(ap + (size_t)i * 16 * lda + k);
#pragma unroll
            for (int j = 0; j < 4; ++j) bf[j] = *(const sg_bf16x8*)(bp + (size_t)j * 16 * ldb + k);
#pragma unroll
            for (int i = 0; i < 2; ++i)
#pragma unroll
                for (int j = 0; j < 4; ++j) acc[i][j] = __builtin_amdgcn_mfma_f32_16x16x32_bf16(bf[j], af[i], acc[i][j], 0, 0, 0);
        }
        __syncthreads();
#pragma unroll
        for (int i = 0; i < 2; ++i)
#pragma unroll
            for (int j = 0; j < 4; ++j) red[(wave * 8 + i * 4 + j) * 64 + lane] = acc[i][j];
        __syncthreads();
        f32x4 sum = red[wave * 64 + lane];
#pragma unroll
        for (int w = 1; w < 8; ++w) sum = sum + red[(w * 8 + wave) * 64 + lane];
        E(batch, tm * 32 + (wave >> 2) * 16 + fr, tn * 64 + (wave & 3) * 16 + 4 * fq, sum);
    }
}
struct SgResid {
    const float* xb; const float* gate; float* Z;
    __device__ __forceinline__ int bsel(int) const { return 0; }
    __device__ __forceinline__ void operator()(int, int rl, int c, const f32x4& acc) const {
        const int r = MP + rl;
        const f32x4 x = *(const f32x4*)(xb + (size_t)rl * D + c), gg = *(const f32x4*)(gate + (size_t)cond_of_row(r) * 6144 + c);
        *(f32x4*)(Z + (size_t)r * D + c) = x * ALPHA + gg * acc;
    }
};
struct SgRelu2 {
    bf16* H;
    __device__ __forceinline__ int bsel(int) const { return 0; }
    __device__ __forceinline__ void operator()(int, int rl, int c, const f32x4& acc) const {
        f32x4 a = acc;
#pragma unroll
        for (int i = 0; i < 4; ++i) { a[i] = fmaxf(a[i], 0.f); a[i] *= a[i]; }
        v2u w; w.x = pk2(a[0], a[1]); w.y = pk2(a[2], a[3]);
        *(v2u*)(H + (size_t)(MP + rl) * FF + c) = w;
    }
};
struct SgCmpHid {
    bf16* HIDl; const float* B1l;
    __device__ __forceinline__ int bsel(int img) const { return img >> 1; }
    __device__ __forceinline__ void operator()(int img, int R, int c, const f32x4& acc) const {
        const f32x4 bb = *(const f32x4*)(B1l + (img >> 1) * 256 + c);
        f32x4 a = acc + bb;
#pragma unroll
        for (int i = 0; i < 4; ++i) a[i] = gelu_tanh(a[i]);
        v2u w; w.x = pk2(a[0], a[1]); w.y = pk2(a[2], a[3]);
        *(v2u*)(HIDl + ((size_t)img * NCB + R) * 256 + c) = w;
    }
};

#define LDS_WAIT() asm volatile("s_waitcnt lgkmcnt(0)" ::: "memory")
#define VM_WAIT() asm volatile("s_waitcnt vmcnt(0)" ::: "memory")

template <class CM>
__device__ __forceinline__ void transpose_item(const float* W, int ldw, int K, bf16* WT, LAS float* scr, int item, int nblk, int lane, const CM& cm) {
    const int kb = item / nblk, nb = item % nblk, k0 = 64 * kb, n0 = 32 * nb;
    const int sc = cm.col(n0 + (lane & 31)); const float scl = cm.scl(n0 + (lane & 31));
#pragma unroll 8
    for (int i = 0; i < 32; ++i) { const int kk = 2 * i + (lane >> 5); scr[kk * 33 + (lane & 31)] = sc >= 0 ? W[(size_t)(k0 + kk) * ldw + sc] * scl : 0.f; }
    LDS_WAIT();
    const int c = lane & 7;
#pragma unroll
    for (int j = 0; j < 4; ++j) { const int n = (lane >> 3) + 8 * j; const LAS float* s = scr + (8 * c) * 33 + n;
        v4u o; o.x = pk2(s[0 * 33], s[1 * 33]); o.y = pk2(s[2 * 33], s[3 * 33]); o.z = pk2(s[4 * 33], s[5 * 33]); o.w = pk2(s[6 * 33], s[7 * 33]);
        *(v4u*)(WT + (size_t)(n0 + n) * K + k0 + 8 * c) = o; }
    LDS_WAIT();
}
struct CmId { __device__ __forceinline__ int col(int n) const { return n; } __device__ __forceinline__ float scl(int) const { return 1.f; } };
struct CmIn {
    __device__ __forceinline__ int col(int n) const { return n < 2048 ? n : (n < 3328 ? n + 8 : (n < 3336 ? n - 1280 : (n < 3360 ? n : -1))); }
    __device__ __forceinline__ float scl(int n) const { return (n >= 512 && n < 1024) ? 0.08838834764831845f : ((n >= 2048 && n < 2560) ? 0.18033688011112042f : 1.f); }
};

__device__ __forceinline__ int rel_bucket_dev(int n) {
    if (n < 16) return n;
    const float nf = (float)n;
    int large = 16 + (int)(__logf(nf / 16.f) / 2.0794415416798357f * 16.f);
    return large < 31 ? large : 31;
}

__device__ __forceinline__ void phase_p0a(CArgs& A, LAS unsigned char* lds, int gw, int NGW, int lane, int wave) {
    unsigned char* ws = A.ws;
    LAS float* scr = (LAS float*)(lds + wave * 16384);
    constexpr int I_IN = 16 * 112, I_OUT = 16 * 32, I_UP = 16 * 128, I_DN = 64 * 32, I_W1 = 32 * 8;
    constexpr int I_L = I_IN + I_OUT + I_UP + I_DN + 2 * I_W1;
    for (int it = gw; it < DEPTH * I_L; it += NGW) {
        const int l = it / I_L; int r = it % I_L;
        if (r < I_IN) { transpose_item(A.w_in + (size_t)l * D * 3360, 3360, D, (bf16*)(ws + WS_WIN) + (size_t)l * NINP * D, scr, r, 112, lane, CmIn{}); continue; } r -= I_IN;
        if (r < I_OUT) { transpose_item(A.w_out + (size_t)l * D * D, D, D, (bf16*)(ws + WS_WOUT) + (size_t)l * D * D, scr, r, 32, lane, CmId{}); continue; } r -= I_OUT;
        if (r < I_UP) { transpose_item(A.w_up + (size_t)l * D * FF, FF, D, (bf16*)(ws + WS_WUP) + (size_t)l * FF * D, scr, r, 128, lane, CmId{}); continue; } r -= I_UP;
        if (r < I_DN) { transpose_item(A.w_down + (size_t)l * FF * D, D, FF, (bf16*)(ws + WS_WDN) + (size_t)l * D * FF, scr, r, 32, lane, CmId{}); continue; } r -= I_DN;
        const int s = r / I_W1; r %= I_W1;
        transpose_item(A.cmp_w1 + (size_t)(l * 2 + s) * 2048 * 256, 256, 2048, (bf16*)(ws + WS_W1) + (size_t)(l * 2 + s) * 256 * 2048, scr, r, 8, lane, CmId{});
    }
    for (int it = gw; it < DEPTH * DB * NPG * 2; it += NGW) {
        const int half = it & 1, pg = (it >> 1) & 15, seq = (it >> 5) & 127, l = it >> 12;
        const int phys = A.page_table[seq * NPG + pg];
        const float* src = A.cache_cmp + (((size_t)l * NPHYS + phys) * PAGE + half * 64) * 256 + 4 * lane;
        const int cc = 4 * lane, s = cc >> 7, g = (cc >> 6) & 1, d = cc & 63;
        bf16* dst = (bf16*)(ws + WS_XC) + ((size_t)((l * 2 + s) * 2 + g) * XCP + MP + seq * PAST + pg * PAGE + half * 64) * 64 + d;
#pragma unroll 8
        for (int sl = 0; sl < 64; ++sl) { const f32x4 v = *(const f32x4*)(src + (size_t)sl * 256); v2u w; w.x = pk2(v[0], v[1]); w.y = pk2(v[2], v[3]); *(v2u*)(dst + (size_t)sl * 64) = w; }
    }
    for (int it = gw; it < DEPTH * DB * 8; it += NGW) {
        const int ch = it & 7, ls = it >> 3;
        const float* src = A.cache_win + ((size_t)ls * 512 + 4 + ch * 64) * 256 + 4 * lane;
        float* dst = A.out + O_WINS + ((size_t)ls * 512 + ch * 64) * 256 + 4 * lane;
        const int n = ch == 7 ? 60 : 64;
        for (int i = 0; i < n; ++i) *(f32x4*)(dst + (size_t)i * 256) = *(const f32x4*)(src + (size_t)i * 256);
    }
    for (int it = gw; it < 8; it += NGW) {
        float* BT = (float*)(ws + WS_BT) + it * 132;
        for (int dd = lane; dd < 132; dd += 64) BT[dd] = dd <= 128 ? A.rel_bias[rel_bucket_dev(dd) * 8 + it] * 1.4426950408889634f : -INFINITY;
    }
    for (int it = gw; it < DEPTH * 2 * 4 * 16; it += NGW) {
        const int kp = it & 15, hq = (it >> 4) & 3, ls = it >> 6, h = hq * 64 + lane;
        const float* pe = A.cmp_pe + (size_t)ls * 2048 + kp * 128; const float* w1 = A.cmp_w1 + ((size_t)ls * 2048 + kp * 128) * 256 + h;
        float acc = 0.f;
#pragma unroll 16
        for (int k = 0; k < 128; ++k) acc += pe[k] * w1[(size_t)k * 256];
        ((float*)(ws + WS_B1))[2048 + (ls * 16 + kp) * 256 + h] = acc;
    }
    for (int it = gw; it < DEPTH * 2 * 64; it += NGW) {
        const int d = it & 63, ls = it >> 6;
        for (int h = lane; h < 256; h += 64) ((bf16*)(ws + WS_W2T))[((size_t)ls * 64 + d) * 256 + h] = (bf16)f2bf(A.cmp_w2[((size_t)ls * 256 + h) * 64 + d]);
    }
}

__device__ __forceinline__ void b1_reduce(CArgs& A, int tid) {
    for (int i = blockIdx.x * NTHR + tid; i < DEPTH * 2 * 256; i += gridDim.x * NTHR) { const float* p = (const float*)(A.ws + WS_B1) + 2048 + (i >> 8) * 16 * 256 + (i & 255);
        float acc = 0.f;
#pragma unroll
        for (int kp = 0; kp < 16; ++kp) acc += p[kp * 256];
        ((float*)(A.ws + WS_B1))[i] = acc; }
}
__device__ __forceinline__ void phase_ada(CArgs& A, LAS unsigned char* lds, int tid) {
    LAS float* a = (LAS float*)lds;
    for (int task = blockIdx.x; task < DEPTH * 12 * 10; task += gridDim.x) {
        const int rb = task % 10, cb = (task / 10) % 12, l = task / 120;
        __syncthreads();
        for (int i = tid; i < 13 * 1024; i += NTHR) { const int row = rb * 13 + i / 1024, k = i & 1023;
            const float c = row < BATCH ? A.c_prompt[row * D + k] : A.c_sample[(row - BATCH) * D + k]; a[i] = c / (1.f + __expf(-c)); }
        __syncthreads();
        const int j = cb * 512 + tid;
        const float* w = A.w_ada + (size_t)l * D * 6144 + j;
        float acc[13];
#pragma unroll
        for (int r = 0; r < 13; ++r) acc[r] = 0.f;
        for (int k = 0; k < D; k += 4) { const float w0 = w[(size_t)k * 6144], w1 = w[(size_t)(k + 1) * 6144], w2 = w[(size_t)(k + 2) * 6144], w3 = w[(size_t)(k + 3) * 6144];
#pragma unroll
            for (int r = 0; r < 13; ++r) { const f32x4 a4 = *(const LAS f32x4*)(a + r * 1024 + k); acc[r] += (a4[0] * w0 + a4[1] * w1) + (a4[2] * w2 + a4[3] * w3); } }
        const float bb = A.b_ada[l * 6144 + j];
        float* o = (float*)(A.ws + WS_ADA) + ((size_t)l * NCOND + rb * 13) * 6144 + j;
#pragma unroll
        for (int r = 0; r < 13; ++r) o[(size_t)r * 6144] = acc[r] + bb;
    }
}

__device__ __forceinline__ void mod_row(const float* xrow, const float* sh, const float* sc, bf16* urow, int lane) {
#pragma unroll
    for (int j = 0; j < 4; ++j) { const int c = 4 * lane + 256 * j;
        const f32x4 x = *(const f32x4*)(xrow + c), a = *(const f32x4*)(sh + c), b = *(const f32x4*)(sc + c);
        v2u w; w.x = pk2(x[0] * (1.f + b[0]) + a[0], x[1] * (1.f + b[1]) + a[1]); w.y = pk2(x[2] * (1.f + b[2]) + a[2], x[3] * (1.f + b[3]) + a[3]);
        *(v2u*)(urow + c) = w; }
}
__device__ __forceinline__ void ln_row(const float* zrow, const float* g, const float* b, float* xout, const float* sh, const float* sc, bf16* urow, int lane) {
    f32x4 v[4]; float s = 0.f;
#pragma unroll
    for (int j = 0; j < 4; ++j) { v[j] = *(const f32x4*)(zrow + 4 * lane + 256 * j); s += (v[j][0] + v[j][1]) + (v[j][2] + v[j][3]); }
    const float mean = wave_sum(s) * (1.f / D); float s2 = 0.f;
#pragma unroll
    for (int j = 0; j < 4; ++j) { v[j] = v[j] - mean; s2 += (v[j][0] * v[j][0] + v[j][1] * v[j][1]) + (v[j][2] * v[j][2] + v[j][3] * v[j][3]); }
    const float rstd = 1.f / sqrtf(wave_sum(s2) * (1.f / D) + LN_EPS);
#pragma unroll
    for (int j = 0; j < 4; ++j) { const int c = 4 * lane + 256 * j;
        const f32x4 gg = *(const f32x4*)(g + c), bb = *(const f32x4*)(b + c);
        const f32x4 x = v[j] * rstd * gg + bb;
        *(f32x4*)(xout + c) = x;
        if (urow) { const f32x4 a = *(const f32x4*)(sh + c), q = *(const f32x4*)(sc + c);
            v2u w; w.x = pk2(x[0] * (1.f + q[0]) + a[0], x[1] * (1.f + q[1]) + a[1]); w.y = pk2(x[2] * (1.f + q[2]) + a[2], x[3] * (1.f + q[3]) + a[3]);
            *(v2u*)(urow + c) = w; } }
}

__device__ __forceinline__ float scan_sum256(float v, LAS float* buf, int tid) {
    const int lane = tid & 63, w = tid >> 6;
#pragma unroll
    for (int o = 1; o < 64; o <<= 1) { const float y = __shfl_up(v, o); if (lane >= o) v += y; }
    __syncthreads();
    if (lane == 63) buf[w] = v;
    __syncthreads();
    float add = 0.f;
#pragma unroll
    for (int i = 0; i < 3; ++i) if (i < w) add += buf[i];
    return v + add;
}
__device__ __forceinline__ float scan_max256(float v, LAS float* buf, int tid) {
    const int lane = tid & 63, w = tid >> 6;
#pragma unroll
    for (int o = 1; o < 64; o <<= 1) { const float y = __shfl_up(v, o); if (lane >= o) v = fmaxf(v, y); }
    __syncthreads();
    if (lane == 63) buf[w] = v;
    __syncthreads();
#pragma unroll
    for (int i = 0; i < 3; ++i) if (i < w) v = fmaxf(v, buf[i]);
    return v;
}
__device__ __forceinline__ void ml_gates(CArgs& A, int l, int r, int h, float& ig, float& lf) {
    const float* G = (const float*)(A.ws + WS_GATE) + (size_t)r * 32;
    ig = G[h] + A.b_gate[l * 8 + h];
    const float fr = G[4 + h] + A.b_gate[l * 8 + 4 + h];
    lf = fminf(fr, 0.f) - log1pf(__expf(-fabsf(fr)));
}

__device__ __forceinline__ void phase_m2(CArgs& A, int l, LAS unsigned char* lds, int tid) {
    LAS float* buf = (LAS float*)lds;
    LAS float* wl = (LAS float*)(lds + 1024);
    const bf16* QKVO = (const bf16*)(A.ws + WS_QKVO);
    for (int unit = blockIdx.x; unit < NUNIT; unit += gridDim.x) {
        const int b = unit >> 7, h = (unit >> 5) & 3, c = unit & 31, r0 = b * SEQ + c * LCH;
        float ig = 0.f, lf = 0.f;
        if (tid < 256) ml_gates(A, l, r0 + tid, h, ig, lf);
        const float F = scan_sum256(lf, buf, tid);
        __syncthreads();
        if (tid == 255) buf[16] = F;
        __syncthreads();
        const float Fend = buf[16];
        const float gl = tid < 256 ? Fend - F + ig : -3.0e38f;
        float mw = wave_max(gl);
        if ((tid & 63) == 0) buf[20 + (tid >> 6)] = mw;
        __syncthreads();
        const float mloc = fmaxf(fmaxf(buf[20], buf[21]), fmaxf(buf[22], buf[23]));
        if (tid < 256) wl[tid] = __expf(gl - mloc);
        if (tid == 0) { float* ch = (float*)(A.ws + WS_CHS) + unit * 4; ch[0] = Fend; ch[1] = mloc; }
        __syncthreads();
        const int k = tid & 127, vq = tid >> 7;
        float acc[32]; float accn = 0.f;
#pragma unroll
        for (int i = 0; i < 32; ++i) acc[i] = 0.f;
        const bf16* kp = QKVO + (size_t)r0 * 2048 + 512 + h * HD + k;
        const bf16* vp = QKVO + (size_t)r0 * 2048 + 1024 + h * HD + 32 * vq;
        for (int s = 0; s < LCH; ++s) {
            const float wk = wl[s] * bf2f(kp[(size_t)s * 2048]);
            accn += wk;
            const v4u* v4 = (const v4u*)(vp + (size_t)s * 2048);
#pragma unroll
            for (int q = 0; q < 4; ++q) { const v4u vv = v4[q];
                acc[8 * q + 0] += wk * bflo(vv.x); acc[8 * q + 1] += wk * bfhi(vv.x); acc[8 * q + 2] += wk * bflo(vv.y); acc[8 * q + 3] += wk * bfhi(vv.y);
                acc[8 * q + 4] += wk * bflo(vv.z); acc[8 * q + 5] += wk * bfhi(vv.z); acc[8 * q + 6] += wk * bflo(vv.w); acc[8 * q + 7] += wk * bfhi(vv.w); }
        }
        float* dct = (float*)(A.ws + WS_DCT) + ((size_t)unit * HD + 32 * vq) * HD + k;
#pragma unroll
        for (int i = 0; i < 32; ++i) dct[(size_t)i * HD] = acc[i];
        if (vq == 0) ((float*)(A.ws + WS_DN))[unit * HD + k] = accn;
        __syncthreads();
    }
}

__device__ __forceinline__ void phase_m3(CArgs& A, int l, int tid) {
    for (int task = blockIdx.x; task < BATCH * NH * 33; task += gridDim.x) {
        const int bh = task / 33, part = task % 33;
        const bool isn = part == 32; if (isn && tid >= HD) continue;
        const int e = isn ? tid : part * 512 + tid;
        const float* chs = (const float*)(A.ws + WS_CHS) + (size_t)bh * NCH * 4;
        float st = 0.f, m0 = 0.f;
        for (int c = 0; c < NCH; ++c) {
            const int unit = bh * NCH + c;
            const float Fend = chs[c * 4], mloc = chs[c * 4 + 1];
            float dv;
            if (isn) { ((float*)(A.ws + WS_NPV))[unit * HD + e] = st; dv = ((const float*)(A.ws + WS_DN))[unit * HD + e]; if (tid == 0) ((float*)(A.ws + WS_CHS))[unit * 4 + 2] = m0; }
            else { ((bf16*)(A.ws + WS_CTP))[(size_t)unit * HD * HD + e] = (bf16)f2bf(st); dv = ((const float*)(A.ws + WS_DCT))[(size_t)unit * HD * HD + e]; }
            const float mend = fmaxf(m0 + Fend, mloc);
            st = __expf(m0 + Fend - mend) * st + __expf(mloc - mend) * dv;
            m0 = mend;
        }
        if (isn) { A.out[O_NP + ((size_t)l * BATCH * NH + bh) * HD + e] = st; if (tid == 0) A.out[O_MP + l * BATCH * NH + bh] = m0; }
        else { const int v = e >> 7, k = e & 127; A.out[O_CP + (((size_t)l * BATCH * NH + bh) * HD + k) * HD + v] = st; }
    }
}

__device__ __forceinline__ void phase_m4(CArgs& A, int l, LAS unsigned char* lds, int tid) {
    LAS float* buf = (LAS float*)lds;
    LAS float* sa = (LAS float*)(lds + 1024);
    LAS float* smx = sa + 256;
    LAS float* sdec = smx + 256;
    LAS float* sem = sdec + 256;
    LAS bf16* sv = (LAS bf16*)(lds + 8192);
    const bf16* QKVO = (const bf16*)(A.ws + WS_QKVO);
    const int lane = tid & 63, wave = tid >> 6;
    for (int unit = blockIdx.x; unit < NUNIT; unit += gridDim.x) {
        const int b = unit >> 7, h = (unit >> 5) & 3, c = unit & 31, r0 = b * SEQ + c * LCH;
        float ig = 0.f, lf = 0.f;
        if (tid < 256) ml_gates(A, l, r0 + tid, h, ig, lf);
        const float F = scan_sum256(lf, buf, tid);
        const float a = tid < 256 ? ig - F : -3.0e38f;
        const float cm = scan_max256(a, buf, tid);
        const float m0 = ((const float*)(A.ws + WS_CHS))[unit * 4 + 2];
        if (tid < 256) { const float mx = fmaxf(m0, cm); sa[tid] = a; smx[tid] = mx; sdec[tid] = __expf(m0 - mx); sem[tid] = __expf(-(F + mx)); }
        for (int i = tid; i < LCH * HD / 8; i += NTHR) { const int s = i >> 4, q = i & 15;
            *(LAS v4u*)(sv + s * HD + 8 * q) = *(const v4u*)(QKVO + (size_t)(r0 + s) * 2048 + 1024 + h * HD + 8 * q); }
        __syncthreads();
        float* W = (float*)(A.ws + WS_WSC) + (size_t)unit * LCH * LCH;
        for (int idx = tid; idx < LCH * LCH; idx += NTHR) {
            const int t = idx >> 8, s = idx & 255; float w = 0.f;
            if (s <= t) {
                const v4u* qp = (const v4u*)(QKVO + (size_t)(r0 + t) * 2048 + h * HD); const v4u* kp = (const v4u*)(QKVO + (size_t)(r0 + s) * 2048 + 512 + h * HD);
                float d = 0.f;
#pragma unroll 4
                for (int q = 0; q < 16; ++q) { const v4u x = qp[q], y = kp[q];
                    d += bflo(x.x) * bflo(y.x) + bfhi(x.x) * bfhi(y.x) + bflo(x.y) * bflo(y.y) + bfhi(x.y) * bfhi(y.y)
                       + bflo(x.z) * bflo(y.z) + bfhi(x.z) * bfhi(y.z) + bflo(x.w) * bflo(y.w) + bfhi(x.w) * bfhi(y.w); }
                w = d * __expf(sa[s] - smx[t]);
            }
            W[idx] = w;
        }
        __syncthreads();
        {
            const int v = tid & 127, tq = tid >> 7;
            const bf16* ctp = (const bf16*)(A.ws + WS_CTP) + ((size_t)unit * HD + v) * HD;
            const float* npv = (const float*)(A.ws + WS_NPV) + unit * HD;
            float* hraw = (float*)(A.ws + WS_HRAW) + (size_t)unit * LCH * HD;
            for (int i = 0; i < 64; ++i) {
                const int t = 4 * i + tq;
                float num = 0.f, den = 0.f;
                const float* wr = W + (size_t)t * LCH;
                for (int s = 0; s <= t; s += 4) { const f32x4 w4 = *(const f32x4*)(wr + s);
                    num += w4[0] * bf2f(sv[(s + 0) * HD + v]) + w4[1] * bf2f(sv[(s + 1) * HD + v]) + w4[2] * bf2f(sv[(s + 2) * HD + v]) + w4[3] * bf2f(sv[(s + 3) * HD + v]);
                    den += (w4[0] + w4[1]) + (w4[2] + w4[3]); }
                float qc = 0.f, qn = 0.f;
                const v4u* qp = (const v4u*)(QKVO + (size_t)(r0 + t) * 2048 + h * HD);
#pragma unroll 4
                for (int q = 0; q < 16; ++q) { const v4u x = qp[q], y = *(const v4u*)(ctp + 8 * q); const f32x4 n0 = *(const f32x4*)(npv + 8 * q), n1 = *(const f32x4*)(npv + 8 * q + 4);
                    qc += bflo(x.x) * bflo(y.x) + bfhi(x.x) * bfhi(y.x) + bflo(x.y) * bflo(y.y) + bfhi(x.y) * bfhi(y.y)
                        + bflo(x.z) * bflo(y.z) + bfhi(x.z) * bfhi(y.z) + bflo(x.w) * bflo(y.w) + bfhi(x.w) * bfhi(y.w);
                    qn += bflo(x.x) * n0[0] + bfhi(x.x) * n0[1] + bflo(x.y) * n0[2] + bfhi(x.y) * n0[3] + bflo(x.z) * n1[0] + bfhi(x.z) * n1[1] + bflo(x.w) * n1[2] + bfhi(x.w) * n1[3]; }
                const float dec = sdec[t];
                const float numt = num + dec * qc, dent = den + dec * qn;
                hraw[(size_t)t * HD + v] = numt / fmaxf(fabsf(dent), sem[t]);
            }
        }
        __syncthreads();
        {
            const float* hraw = (const float*)(A.ws + WS_HRAW) + (size_t)unit * LCH * HD;
            const float g0 = A.ml_norm_g[l * 512 + h * HD + lane], g1 = A.ml_norm_g[l * 512 + h * HD + 64 + lane];
            for (int t = wave; t < LCH; t += NWAVES) {
                const float x0 = hraw[(size_t)t * HD + lane], x1 = hraw[(size_t)t * HD + 64 + lane];
                const float mu = wave_sum(x0 + x1) * (1.f / HD);
                const float d0 = x0 - mu, d1 = x1 - mu;
                const float rstd = 1.f / sqrtf(wave_sum(d0 * d0 + d1 * d1) * (1.f / HD) + LN_EPS);
                const bf16* op = QKVO + (size_t)(r0 + t) * 2048 + 1536 + h * HD;
                bf16* mp = (bf16*)(A.ws + WS_MIX) + (size_t)(r0 + t) * D + h * HD;
                mp[lane] = (bf16)f2bf(d0 * rstd * g0 * sigmoidf_(bf2f(op[lane])));
                mp[64 + lane] = (bf16)f2bf(d1 * rstd * g1 * sigmoidf_(bf2f(op[64 + lane])));
            }
        }
        __syncthreads();
    }
}

__device__ __forceinline__ void phase_mls(CArgs& A, int l, LAS unsigned char* lds, int tid) {
    LAS float* sq = (LAS float*)lds;
    LAS float* sc = sq + 1536;
    LAS float* sw = sc + 64;
    LAS float* part = sw + 16;
    LAS float* red = part + 2048;
    const bf16* QKVO = (const bf16*)(A.ws + WS_QKVO);
    for (int task = blockIdx.x; task < DB * NH; task += gridDim.x) {
        const int seq = task >> 2, h = task & 3, r0 = MP + seq * DS, sidx = (l * DB + seq) * NH + h;
        __syncthreads();
        for (int i = tid; i < 1536; i += NTHR) { const int which = i >> 9, t = (i >> 7) & 3, d = i & 127; sq[i] = bf2f(QKVO[(size_t)(r0 + t) * 2048 + which * 512 + h * HD + d]); }
        const float m0 = A.st_m[sidx];
        if (tid == 0) {
            float F = 0.f, cmx = -3.0e38f, Fs[4], igs[4], mlast = 0.f;
#pragma unroll
            for (int t = 0; t < 4; ++t) { float ig, lf; ml_gates(A, l, r0 + t, h, ig, lf); F += lf; Fs[t] = F; igs[t] = ig; const float a = ig - F; cmx = fmaxf(cmx, a); const float mx = fmaxf(m0, cmx);
                sc[8 + t] = a; sc[12 + t] = mx; sc[16 + t] = __expf(m0 - mx); sc[20 + t] = __expf(-(F + mx)); mlast = F + mx; }
#pragma unroll
            for (int t = 0; t < 4; ++t) sc[24 + t] = __expf(Fs[3] - Fs[t] + igs[t] - mlast);
            sc[28] = __expf(Fs[3] + m0 - mlast); sc[29] = mlast;
        }
        __syncthreads();
        if (tid < 16) { const int t = tid >> 2, s = tid & 3; float w = 0.f;
            if (s <= t) { float d = 0.f; for (int k = 0; k < HD; ++k) d += sq[t * HD + k] * sq[512 + s * HD + k]; w = d * __expf(sc[8 + s] - sc[12 + t]); }
            sw[tid] = w; }
        else if (tid < 20) { const int t = tid - 16; const float* n0 = A.st_n + (size_t)sidx * HD; float d = 0.f; for (int k = 0; k < HD; ++k) d += sq[t * HD + k] * n0[k]; sc[32 + t] = d; }
        __syncthreads();
        {
            const int v = tid & 127, kq = tid >> 7;
            const float* C0 = A.st_C + (size_t)sidx * HD * HD; float* Co = A.out + O_CS + (size_t)sidx * HD * HD;
            const float cd = sc[28];
            float wv[4]; float qc[4] = {0.f, 0.f, 0.f, 0.f};
#pragma unroll
            for (int t = 0; t < 4; ++t) wv[t] = sc[24 + t] * sq[1024 + t * HD + v];
            for (int kk = 0; kk < 32; ++kk) { const int k = kq * 32 + kk; const float c0 = C0[(size_t)k * HD + v];
                float cn = cd * c0;
#pragma unroll
                for (int t = 0; t < 4; ++t) { qc[t] += sq[t * HD + k] * c0; cn += wv[t] * sq[512 + t * HD + k]; }
                Co[(size_t)k * HD + v] = cn; }
#pragma unroll
            for (int t = 0; t < 4; ++t) part[(kq * 4 + t) * HD + v] = qc[t];
        }
        __syncthreads();
        float hv[4] = {0.f, 0.f, 0.f, 0.f};
        if (tid < HD) {
            const int v = tid;
#pragma unroll
            for (int t = 0; t < 4; ++t) { const float qct = part[(0 * 4 + t) * HD + v] + part[(1 * 4 + t) * HD + v] + part[(2 * 4 + t) * HD + v] + part[(3 * 4 + t) * HD + v];
                float num = sc[16 + t] * qct, den = sc[16 + t] * sc[32 + t];
#pragma unroll
                for (int s = 0; s < 4; ++s) { num += sw[t * 4 + s] * sq[1024 + s * HD + v]; den += sw[t * 4 + s]; }
                hv[t] = num / fmaxf(fabsf(den), sc[20 + t]); }
        }
#pragma unroll
        for (int t = 0; t < 4; ++t) { const float s1 = wave_sum(hv[t]); if ((tid & 63) == 0 && tid < HD) red[t * 2 + (tid >> 6)] = s1; }
        __syncthreads();
        float dv[4];
#pragma unroll
        for (int t = 0; t < 4; ++t) { dv[t] = hv[t] - (red[t * 2] + red[t * 2 + 1]) * (1.f / HD); const float s2 = wave_sum(dv[t] * dv[t]); if ((tid & 63) == 0 && tid < HD) red[8 + t * 2 + (tid >> 6)] = s2; }
        __syncthreads();
        if (tid < HD) {
            const int v = tid; const float gn = A.ml_norm_g[l * 512 + h * HD + v];
#pragma unroll
            for (int t = 0; t < 4; ++t) { const float rstd = 1.f / sqrtf((red[8 + t * 2] + red[8 + t * 2 + 1]) * (1.f / HD) + LN_EPS);
                const float og = bf2f(QKVO[(size_t)(r0 + t) * 2048 + 1536 + h * HD + v]);
                ((bf16*)(A.ws + WS_MIX))[(size_t)(r0 + t) * D + h * HD + v] = (bf16)f2bf(dv[t] * rstd * gn * sigmoidf_(og)); }
        } else if (tid < 2 * HD) {
            const int k = tid - HD; float nn = sc[28] * A.st_n[(size_t)sidx * HD + k];
#pragma unroll
            for (int t = 0; t < 4; ++t) nn += sc[24 + t] * sq[512 + t * HD + k];
            A.out[O_NS + (size_t)sidx * HD + k] = nn;
        }
        if (tid == 0) A.out[O_MS + sidx] = sc[29];
    }
}

typedef short bf16x8c __attribute__((ext_vector_type(8)));
__device__ __forceinline__ void phase_cmp2(CArgs& A, int l0, int nl, int r_lo, int nrows, int gw, int NGW, int lane) {
    const int fr = lane & 15, fq = lane >> 4, ntile = nrows / 16;
    for (int task = gw; task < nl * 4 * ntile; task += NGW) {
        const int img = task / ntile, tr = task % ntile, l = l0 + (img >> 2), sg = img & 3, s = sg >> 1, g = sg & 1, R0 = r_lo + tr * 16;
        const bf16* hp = (const bf16*)(A.ws + WS_HID) + ((size_t)(l * 4 + sg) * NCB + R0 + fr) * 256 + 8 * fq;
        const bf16* wp = (const bf16*)(A.ws + WS_W2T) + ((size_t)(l * 2 + s) * 64 + fr) * 256 + 8 * fq;
        f32x4 acc[4];
#pragma unroll
        for (int dt = 0; dt < 4; ++dt) acc[dt] = (f32x4){0.f, 0.f, 0.f, 0.f};
#pragma unroll
        for (int ks = 0; ks < 8; ++ks) {
            const bf16x8c hf = *(const bf16x8c*)(hp + 32 * ks);
#pragma unroll
            for (int dt = 0; dt < 4; ++dt) { const bf16x8c wf = *(const bf16x8c*)(wp + (size_t)dt * 16 * 256 + 32 * ks);
                acc[dt] = s == 0 ? __builtin_amdgcn_mfma_f32_16x16x32_bf16(wf, hf, acc[dt], 0, 0, 0) : __builtin_amdgcn_mfma_f32_16x16x32_bf16(hf, wf, acc[dt], 0, 0, 0); }
        }
        if (s == 0) {
            bf16* o = (bf16*)(A.ws + WS_KC) + ((size_t)(l * 2 + g) * NCB + R0 + fr) * 64 + 4 * fq;
#pragma unroll
            for (int dt = 0; dt < 4; ++dt) { v2u w; w.x = pk2(acc[dt][0], acc[dt][1]); w.y = pk2(acc[dt][2], acc[dt][3]); *(v2u*)(o + 16 * dt) = w; }
        } else {
            bf16* o = (bf16*)(A.ws + WS_VCT) + ((size_t)(l * 2 + g) * 64 + fr) * NCB + R0 + 4 * fq;
#pragma unroll
            for (int dt = 0; dt < 4; ++dt) { v2u w; w.x = pk2(acc[dt][0], acc[dt][1]); w.y = pk2(acc[dt][2], acc[dt][3]); *(v2u*)(o + (size_t)dt * 16 * NCB) = w; }
        }
    }
}

__device__ __forceinline__ void topk_sel(float imp0, float imp1, int cur, int lane, unsigned long long& s0, unsigned long long& s1) {
    const int nforced = cur == 0 ? 1 : (cur == 1 ? 2 : 3), need = 16 - nforced, ncand = cur - 2 > 0 ? cur - 2 : 0;
    const unsigned k0 = (lane >= 1 && lane <= cur - 2) ? __builtin_bit_cast(unsigned, imp0) + 1u : 0u;
    const unsigned k1 = (lane + 64 <= cur - 2) ? __builtin_bit_cast(unsigned, imp1) + 1u : 0u;
    unsigned long long c0, c1;
    if (ncand <= need) { c0 = __ballot(k0 != 0u); c1 = __ballot(k1 != 0u); }
    else {
        unsigned T = 0u;
        for (int bit = 31; bit >= 0; --bit) { const unsigned cand = T | (1u << bit);
            const int cnt = __popcll(__ballot(k0 >= cand)) + __popcll(__ballot(k1 >= cand)); if (cnt >= need) T = cand; }
        const unsigned long long g0 = __ballot(k0 > T), g1 = __ballot(k1 > T); unsigned long long e0 = __ballot(k0 == T), e1 = __ballot(k1 == T);
        int rem = need - __popcll(g0) - __popcll(g1);
        unsigned long long t0 = 0ull, t1 = 0ull;
        while (rem > 0 && e0) { const unsigned long long lb = e0 & (~e0 + 1ull); t0 |= lb; e0 ^= lb; --rem; }
        while (rem > 0 && e1) { const unsigned long long lb = e1 & (~e1 + 1ull); t1 |= lb; e1 ^= lb; --rem; }
        c0 = g0 | t0; c1 = g1 | t1;
    }
    unsigned long long f0 = 1ull, f1 = 0ull;
    if (cur < 64) f0 |= 1ull << cur; else f1 |= 1ull << (cur - 64);
    if (cur >= 1) { if (cur - 1 < 64) f0 |= 1ull << (cur - 1); else f1 |= 1ull << (cur - 65); }
    s0 = c0 | f0; s1 = c1 | f1;
}


typedef short bf16x8 __attribute__((ext_vector_type(8)));
#define MFMA16(a, b, c) __builtin_amdgcn_mfma_f32_16x16x32_bf16((a), (b), (c), 0, 0, 0)
constexpr int TOTS = MP + DB * 2112, TOTW = MP + DB * 528, TOTWP = TOTW + 64;
constexpr size_t KS_L = (size_t)2 * TOTS * 64, KW_L = (size_t)2 * TOTWP * 64, KC_L = (size_t)2 * NCB * 64;

__device__ __forceinline__ void kv_tile64(const float* src, bf16* Kimg, size_t kgs, bf16* Vt, size_t vgs, size_t vpitch, size_t gp0, LAS bf16* scr, int lane) {
    const int cc = 4 * lane, s = cc >> 7, g = (cc >> 6) & 1, d = cc & 63;
#pragma unroll 8
    for (int sl = 0; sl < 64; ++sl) {
        const f32x4 v = *(const f32x4*)(src + (size_t)sl * 256 + cc);
        v2u w; w.x = pk2(v[0], v[1]); w.y = pk2(v[2], v[3]);
        if (s == 0) *(v2u*)(Kimg + (size_t)g * kgs + (gp0 + sl) * 64 + d) = w;
        else *(LAS v2u*)(scr + sl * 128 + (cc - 128)) = w;
    }
    LDS_WAIT();
#pragma unroll
    for (int g2 = 0; g2 < 2; ++g2) {
        const int gd = lane + 64 * g2;
        bf16* dst = Vt + (size_t)g2 * vgs + (size_t)lane * vpitch + gp0;
#pragma unroll
        for (int oc = 0; oc < 8; ++oc) {
            const LAS bf16* p = scr + (8 * oc) * 128 + gd;
            v4u o; o.x = (unsigned)p[0] | ((unsigned)p[128] << 16); o.y = (unsigned)p[256] | ((unsigned)p[384] << 16); o.z = (unsigned)p[512] | ((unsigned)p[640] << 16); o.w = (unsigned)p[768] | ((unsigned)p[896] << 16);
            *(v4u*)(dst + 8 * oc) = o;
        }
    }
    LDS_WAIT();
}

__device__ __forceinline__ void prep_cache_images(CArgs& A, LAS unsigned char* lds, int gw, int NGW, int lane, int wave) {
    LAS bf16* scr = (LAS bf16*)(lds + wave * 16384);
    bf16* KS = (bf16*)(A.ws + WS_KS); bf16* VTS = (bf16*)(A.ws + WS_VTS); bf16* KW = (bf16*)(A.ws + WS_KW); bf16* VTW = (bf16*)(A.ws + WS_VTW);
    for (int it = gw; it < DEPTH * DB * 32; it += NGW) {
        const int ti = it & 31, seq = (it >> 5) & 127, l = it >> 12;
        const int phys = A.page_table[seq * NPG + (ti >> 1)];
        const float* src = A.cache_slc + (((size_t)l * NPHYS + phys) * PAGE + (ti & 1) * 64) * 256;
        kv_tile64(src, KS + l * KS_L, (size_t)TOTS * 64, VTS + l * KS_L, (size_t)64 * TOTS, TOTS, (size_t)MP + seq * 2112 + ti * 64, scr, lane);
    }
    for (int it = gw; it < DEPTH * DB * 8; it += NGW) {
        const int ti = it & 7, ls = it >> 3, seq = ls & 127, l = ls >> 7;
        const float* src = A.cache_win + ((size_t)ls * 512 + ti * 64) * 256;
        kv_tile64(src, KW + l * KW_L, (size_t)TOTWP * 64, VTW + l * KW_L, (size_t)64 * TOTWP, TOTWP, (size_t)MP + seq * 528 + ti * 64, scr, lane);
    }
}
__device__ __forceinline__ void prep_layer_images(CArgs& A, int l, LAS unsigned char* lds, int gw, int NGW, int lane, int wave) {
    LAS bf16* scr = (LAS bf16*)(lds + wave * 16384);
    bf16* KS = (bf16*)(A.ws + WS_KS) + l * KS_L; bf16* VTS = (bf16*)(A.ws + WS_VTS) + l * KS_L; bf16* KW = (bf16*)(A.ws + WS_KW) + l * KW_L; bf16* VTW = (bf16*)(A.ws + WS_VTW) + l * KW_L;
    const float* KVR = (const float*)(A.ws + WS_KVR);
    for (int it = gw; it < 2 * (MP / 64); it += NGW) {
        const int kind = it / (MP / 64), ti = it % (MP / 64);
        const float* src = KVR + ((size_t)(1 + kind) * M + ti * 64) * 256;
        if (kind == 0) kv_tile64(src, KS, (size_t)TOTS * 64, VTS, (size_t)64 * TOTS, TOTS, (size_t)ti * 64, scr, lane);
        else           kv_tile64(src, KW, (size_t)TOTWP * 64, VTW, (size_t)64 * TOTWP, TOTWP, (size_t)ti * 64, scr, lane);
    }
    for (int it = gw; it < 2 * DB; it += NGW) {
        const int kind = it / DB, seq = it % DB;
        const float* src = KVR + ((size_t)(1 + kind) * M + MP + seq * DS) * 256;
        bf16* Kimg = kind == 0 ? KS : KW; bf16* Vt = kind == 0 ? VTS : VTW;
        const size_t tot = kind == 0 ? TOTS : TOTWP, gp0 = kind == 0 ? (size_t)MP + seq * 2112 + PAST : (size_t)MP + seq * 528 + 512;
        const int cc = 4 * lane, s = cc >> 7, g = (cc >> 6) & 1, d = cc & 63;
#pragma unroll
        for (int t = 0; t < DS; ++t) {
            const f32x4 v = *(const f32x4*)(src + (size_t)t * 256 + cc);
            if (s == 0) { v2u w; w.x = pk2(v[0], v[1]); w.y = pk2(v[2], v[3]); *(v2u*)(Kimg + (size_t)g * tot * 64 + (gp0 + t) * 64 + d) = w; }
            else {
#pragma unroll
                for (int i = 0; i < 4; ++i) Vt[(size_t)g * 64 * tot + (size_t)(d + i) * tot + gp0 + t] = (bf16)f2bf(v[i]);
            }
        }
    }
}

struct KV { bf16x8 k[8]; v4u v[8]; };
__device__ __forceinline__ void k_load(KV& f, const bf16* Kb, int fr, int fq) {
#pragma unroll
    for (int t = 0; t < 4; ++t) { f.k[2 * t] = *(const bf16x8*)(Kb + (size_t)(16 * t + fr) * 64 + 8 * fq); f.k[2 * t + 1] = *(const bf16x8*)(Kb + (size_t)(16 * t + fr) * 64 + 32 + 8 * fq); }
}
__device__ __forceinline__ void v_load(KV& f, const bf16* Vb, size_t pitch, int fr, int fq) {
#pragma unroll
    for (int h = 0; h < 2; ++h)
#pragma unroll
        for (int dt = 0; dt < 4; ++dt) { const bf16* vp = Vb + (size_t)(16 * dt + fr) * pitch + 32 * h + 4 * fq;
            const v2u a = *(const v2u*)vp, b = *(const v2u*)(vp + 16); v4u w; w.x = a.x; w.y = a.y; w.z = b.x; w.w = b.y; f.v[4 * h + dt] = w; }
}
__device__ __forceinline__ void qk_frag(const KV& f, const bf16x8 (&q)[2], f32x4 (&st)[4]) {
#pragma unroll
    for (int t = 0; t < 4; ++t) { f32x4 z = {0.f, 0.f, 0.f, 0.f}; z = MFMA16(f.k[2 * t], q[0], z); st[t] = MFMA16(f.k[2 * t + 1], q[1], z); }
}
__device__ __forceinline__ void pv_frag(const KV& f, const f32x4 (&st)[4], f32x4 (&o)[4]) {
#pragma unroll
    for (int h = 0; h < 2; ++h) {
        v4u pw; pw.x = pk2(st[2 * h][0], st[2 * h][1]); pw.y = pk2(st[2 * h][2], st[2 * h][3]); pw.z = pk2(st[2 * h + 1][0], st[2 * h + 1][1]); pw.w = pk2(st[2 * h + 1][2], st[2 * h + 1][3]);
        const bf16x8 pf = __builtin_bit_cast(bf16x8, pw);
#pragma unroll
        for (int dt = 0; dt < 4; ++dt) o[dt] = MFMA16(__builtin_bit_cast(bf16x8, f.v[4 * h + dt]), pf, o[dt]);
    }
}
__device__ __forceinline__ float xfq_max(float v) { v = fmaxf(v, __shfl_xor(v, 16)); return fmaxf(v, __shfl_xor(v, 32)); }
__device__ __forceinline__ float xfq_sum(float v) { v += __shfl_xor(v, 16); return v + __shfl_xor(v, 32); }
__device__ __forceinline__ float quad_sum(float v) { v += __shfl_xor(v, 1); return v + __shfl_xor(v, 2); }

__device__ __forceinline__ void softmax_pv(const KV& f, f32x4 (&st)[4], f32x4 (&o)[4], float& m, float& ls) {
    float bm = -INFINITY;
#pragma unroll
    for (int t = 0; t < 4; ++t) bm = fmaxf(bm, fmaxf(fmaxf(st[t][0], st[t][1]), fmaxf(st[t][2], st[t][3])));
    bm = xfq_max(bm);
    const float mn = fmaxf(m, bm), sc = __builtin_amdgcn_exp2f(m - mn);
    m = mn; ls *= sc;
#pragma unroll
    for (int dt = 0; dt < 4; ++dt) o[dt] = o[dt] * sc;
#pragma unroll
    for (int t = 0; t < 4; ++t)
#pragma unroll
        for (int i = 0; i < 4; ++i) { const float p = __builtin_amdgcn_exp2f(st[t][i] - mn); st[t][i] = p; ls += p; }
    pv_frag(f, st, o);
}
template <class Br>
__device__ __forceinline__ void run_branch(Br& br, const bf16x8 (&q)[2], int fr, int fq, f32x4 (&o)[4], float& m, float& ls) {
    int j;
    if (!br.first(j)) return;
    KV cur; k_load(cur, br.kp(j), fr, fq); v_load(cur, br.vp(j), br.pitch, fr, fq);
    for (;;) {
        int jn = 0; const bool hn = br.next(jn);
        KV nxt;
        if (hn) { k_load(nxt, br.kp(jn), fr, fq); v_load(nxt, br.vp(jn), br.pitch, fr, fq); }
        f32x4 st[4]; qk_frag(cur, q, st);
        br.mask(st, j);
        softmax_pv(cur, st, o, m, ls);
        if (!hn) break;
        cur = nxt; j = jn;
    }
}
struct BrSel {
    const bf16* K; const bf16* V; size_t pitch; unsigned long long u0, u1, my0, my1; int cur, qpos, fq; const LAS float* bt; float farb;
    __device__ __forceinline__ bool pop(int& j) { if (u0) { j = __builtin_ctzll(u0); u0 &= u0 - 1ull; return true; } if (u1) { j = 64 + __builtin_ctzll(u1); u1 &= u1 - 1ull; return true; } return false; }
    __device__ __forceinline__ bool first(int& j) { return pop(j); }
    __device__ __forceinline__ bool next(int& j) { return pop(j); }
    __device__ __forceinline__ const bf16* kp(int j) const { return K + (size_t)j * 64 * 64; }
    __device__ __forceinline__ const bf16* vp(int j) const { return V + (size_t)j * 64; }
    __device__ __forceinline__ void mask(f32x4 (&st)[4], int j) const {
        const bool mine = j < 64 ? ((my0 >> j) & 1ull) != 0ull : ((my1 >> (j - 64)) & 1ull) != 0ull;
        if (j >= cur - 2) {
#pragma unroll
            for (int t = 0; t < 4; ++t)
#pragma unroll
                for (int i = 0; i < 4; ++i) { const int dist = qpos - (64 * j + 16 * t + 4 * fq + i); st[t][i] = st[t][i] + bt[(!mine || dist < 0) ? 129 : (dist > 128 ? 128 : dist)]; }
        } else {
#pragma unroll
            for (int t = 0; t < 4; ++t)
#pragma unroll
                for (int i = 0; i < 4; ++i) st[t][i] = mine ? st[t][i] + farb : -INFINITY;
        }
    }
};
struct BrWin {
    const bf16* K; const bf16* V; size_t pitch; int jb, cur, qpos, fq; const LAS float* bt;
    __device__ __forceinline__ bool first(int& j) { j = jb; return jb <= cur; }
    __device__ __forceinline__ bool next(int& j) { ++jb; j = jb; return jb <= cur; }
    __device__ __forceinline__ const bf16* kp(int j) const { return K + (long)j * 64 * 64; }
    __device__ __forceinline__ const bf16* vp(int j) const { return V + (long)j * 64; }
    __device__ __forceinline__ void mask(f32x4 (&st)[4], int j) const {
#pragma unroll
        for (int t = 0; t < 4; ++t)
#pragma unroll
            for (int i = 0; i < 4; ++i) { const int dist = qpos - (64 * j + 16 * t + 4 * fq + i); st[t][i] = st[t][i] + bt[(unsigned)dist >= 512u ? 129 : (dist > 128 ? 128 : dist)]; }
    }
};

__device__ __forceinline__ void nsa_tile(CArgs& A, int l, bool smp, int bs, int g, int tq, LAS float* wl, const LAS float* BT, int lane) {
    asm volatile("" : "+v"(lane));
    const int fr = lane & 15, fq = lane >> 4, tl = fr >> 2, rr = fr & 3;
    const int qpos0 = smp ? PAST : 4 * tq, row0 = smp ? MP + bs * DS : bs * SEQ + qpos0;
    const int qpos = qpos0 + tl, cur = qpos0 >> 6, h = g * 4 + rr;
    const size_t sbase = smp ? (size_t)MP + bs * 2112 : (size_t)bs * SEQ;
    const long wbase = smp ? (long)MP + bs * 528 - (PAST - 512) : (long)bs * SEQ;
    const size_t cbase = smp ? (size_t)1024 + bs * 128 : (size_t)bs * 512;
    const bf16* KS = (const bf16*)(A.ws + WS_KS) + l * KS_L + (size_t)g * TOTS * 64; const bf16* VTS = (const bf16*)(A.ws + WS_VTS) + l * KS_L + (size_t)g * 64 * TOTS;
    const bf16* KW = (const bf16*)(A.ws + WS_KW) + l * KW_L + (size_t)g * TOTWP * 64; const bf16* VTW = (const bf16*)(A.ws + WS_VTW) + l * KW_L + (size_t)g * 64 * TOTWP;
    const bf16* KC = (const bf16*)(A.ws + WS_KC) + l * KC_L + (size_t)g * NCB * 64 + cbase * 64; const bf16* VCT = (const bf16*)(A.ws + WS_VCT) + l * KC_L + (size_t)g * 64 * NCB + cbase;
    const LAS float* bt = BT + h * 132;
    const float farb = bt[128];
    bf16x8 q[2];
    {   const bf16* qp = (const bf16*)(A.ws + WS_NQ) + (size_t)(row0 + tl) * 512 + g * 256 + rr * 64 + 8 * fq;
        q[0] = *(const bf16x8*)qp; q[1] = *(const bf16x8*)(qp + 32); }
    const float* gt = (const float*)(A.ws + WS_GATE) + (size_t)(row0 + tl) * 32 + 8 + h * 3;
    const float gc = sigmoidf_(gt[0]), gs = sigmoidf_(gt[1]), gwn = sigmoidf_(gt[2]);
    f32x4 out[4];
#pragma unroll
    for (int dt = 0; dt < 4; ++dt) out[dt] = (f32x4){0.f, 0.f, 0.f, 0.f};
    LAS float* impA = wl;
    LAS float* impB = wl + 544;
    for (int i = lane; i < 1088; i += 64) wl[i] = 0.f;
    LDS_WAIT();

    {
        const int ncv_max = qpos0 + 3 >= 31 ? ((qpos0 + 3 - 31) >> 4) + 1 : 0, nb64 = (ncv_max + 63) >> 6;
        float m = -1.0e30f, ls = 0.f;
        {
            for (int ib = 0; ib < nb64; ++ib) {
                KV cur; k_load(cur, KC + (size_t)ib * 64 * 64, fr, fq);
                f32x4 st[4]; qk_frag(cur, q, st);
                float bm = -INFINITY;
#pragma unroll
                for (int t = 0; t < 4; ++t)
#pragma unroll
                    for (int i = 0; i < 4; ++i) { const int n = 64 * ib + 16 * t + 4 * fq + i; const int dist = qpos - 16 * n - 31;
                        const float s = st[t][i] + bt[dist < 0 ? 129 : (dist > 128 ? 128 : dist)]; st[t][i] = s; bm = fmaxf(bm, s); }
                bm = xfq_max(bm);
                const float mn = fmaxf(m, bm); ls *= __builtin_amdgcn_exp2f(m - mn); m = mn;
#pragma unroll
                for (int t = 0; t < 4; ++t)
#pragma unroll
                    for (int i = 0; i < 4; ++i) ls += __builtin_amdgcn_exp2f(st[t][i] - mn);
            }
        }
        ls = xfq_sum(ls);
        const float inv = ls > 0.f ? 1.f / ls : 0.f;
        f32x4 o[4];
#pragma unroll
        for (int dt = 0; dt < 4; ++dt) o[dt] = (f32x4){0.f, 0.f, 0.f, 0.f};
        {
            for (int ib = 0; ib < nb64; ++ib) {
                KV cur; k_load(cur, KC + (size_t)ib * 64 * 64, fr, fq); v_load(cur, VCT + ib * 64, NCB, fr, fq);
                f32x4 st[4]; qk_frag(cur, q, st);
#pragma unroll
                for (int t = 0; t < 4; ++t) {
#pragma unroll
                    for (int i = 0; i < 4; ++i) { const int n = 64 * ib + 16 * t + 4 * fq + i; const int dist = qpos - 16 * n - 31;
                        st[t][i] = __builtin_amdgcn_exp2f(st[t][i] + bt[dist < 0 ? 129 : (dist > 128 ? 128 : dist)] - m) * inv; }
                    const float s4 = quad_sum((st[t][0] + st[t][1]) + (st[t][2] + st[t][3])), s3 = quad_sum(st[t][3]);
                    const int j0 = 16 * ib + 4 * t + fq;
                    if (rr == 0) { impA[tl * 136 + j0] = s4; impB[tl * 136 + j0 + 1] = s3; }
                }
                pv_frag(cur, st, o);
            }
        }
#pragma unroll
        for (int dt = 0; dt < 4; ++dt) out[dt] = out[dt] + o[dt] * gc;
    }
    LDS_WAIT();
    unsigned long long s0[4], s1[4];
#pragma unroll
    for (int t = 0; t < 4; ++t) topk_sel(impA[t * 136 + lane] + impB[t * 136 + lane], impA[t * 136 + 64 + lane] + impB[t * 136 + 64 + lane], cur, lane, s0[t], s1[t]);
    {
        float m = -1.0e30f, ls = 0.f; f32x4 o[4];
#pragma unroll
        for (int dt = 0; dt < 4; ++dt) o[dt] = (f32x4){0.f, 0.f, 0.f, 0.f};
        BrSel br{KS + sbase * 64, VTS + sbase, (size_t)TOTS, (s0[0] | s0[1]) | (s0[2] | s0[3]), (s1[0] | s1[1]) | (s1[2] | s1[3]),
                 tl == 0 ? s0[0] : (tl == 1 ? s0[1] : (tl == 2 ? s0[2] : s0[3])), tl == 0 ? s1[0] : (tl == 1 ? s1[1] : (tl == 2 ? s1[2] : s1[3])), cur, qpos, fq, bt, farb};
        run_branch(br, q, fr, fq, o, m, ls);
        ls = xfq_sum(ls);
        const float w = ls > 0.f ? gs / ls : 0.f;
#pragma unroll
        for (int dt = 0; dt < 4; ++dt) out[dt] = out[dt] + o[dt] * w;
    }
    {
        float m = -1.0e30f, ls = 0.f; f32x4 o[4];
#pragma unroll
        for (int dt = 0; dt < 4; ++dt) o[dt] = (f32x4){0.f, 0.f, 0.f, 0.f};
        const int lo_blk = smp ? (PAST - 512) >> 6 : 0; int jb = (qpos0 - 511) >> 6; if (jb < lo_blk) jb = lo_blk;
        BrWin br{KW + wbase * 64, VTW + wbase, (size_t)TOTWP, jb, cur, qpos, fq, bt};
        run_branch(br, q, fr, fq, o, m, ls);
        ls = xfq_sum(ls);
        const float w = ls > 0.f ? gwn / ls : 0.f;
#pragma unroll
        for (int dt = 0; dt < 4; ++dt) out[dt] = out[dt] + o[dt] * w;
    }
    bf16* mp = (bf16*)(A.ws + WS_MIX) + (size_t)(row0 + tl) * D + 512 + h * 64 + 4 * fq;
#pragma unroll
    for (int dt = 0; dt < 4; ++dt) { v2u w; w.x = pk2(out[dt][0], out[dt][1]); w.y = pk2(out[dt][2], out[dt][3]); *(v2u*)(mp + 16 * dt) = w; }
}
__device__ __forceinline__ void phase_nsa(CArgs& A, int l, LAS float* wl, const LAS float* BT, int lane, int wave) {
    const int G = gridDim.x, bx = blockIdx.x;
    const bool xmap = (G & 7) == 0;
    const int x = bx & 7, nw = (G >> 3) * NWAVES, ww = (bx >> 3) * NWAVES + wave;
    const int gwv = bx * NWAVES + wave, ngw = G * NWAVES;
    for (int it = 0;; ++it) {
        bool smp; int bs, g, tq;
        if (xmap) {
            const int np = ww < 512 ? 2 * ((512 - ww + nw - 1) / nw) : 0;
            if (it < np) { const int i = ww + nw * (it >> 1), tq2 = (it & 1) ? 1023 - i : i; smp = false; bs = x >> 2; g = (x >> 1) & 1; tq = 2 * tq2 + (x & 1); }
            else { const int t = ww * 8 + x + 8 * nw * (it - np); if (t >= 2 * DB) break; smp = true; bs = t >> 1; g = t & 1; tq = 0; }
        } else {
            const int t = gwv + ngw * it; if (t >= 4 * 2048 + 2 * DB) break;
            if (t < 4 * 2048) { smp = false; bs = t >> 12; g = (t >> 11) & 1; tq = t & 2047; } else { smp = true; bs = (t - 4 * 2048) >> 1; g = t & 1; tq = 0; }
        }
        nsa_tile(A, l, smp, bs, g, tq, wl, BT, lane);
    }
}

__device__ __forceinline__ void phase_m2x(CArgs& A, int l, LAS unsigned char* lds, int tid) {
    LAS float* buf = (LAS float*)lds;
    LAS float* wl = (LAS float*)(lds + 1024);
    LAS float* red = (LAS float*)(lds + 2048);
    LAS bf16* kt = (LAS bf16*)(lds + 8192);
    LAS bf16* vt = (LAS bf16*)(lds + 8192 + 34816);
    const bf16* QKVO = (const bf16*)(A.ws + WS_QKVO);
    const int lane = tid & 63, wave = tid >> 6, fr = lane & 15, fq = lane >> 4;
    for (int unit = blockIdx.x; unit < NUNIT; unit += gridDim.x) {
        const int b = unit >> 7, h = (unit >> 5) & 3, c = unit & 31, r0 = b * SEQ + c * LCH;
        float ig = 0.f, lf = 0.f;
        if (tid < 256) ml_gates(A, l, r0 + tid, h, ig, lf);
        const float F = scan_sum256(lf, buf, tid);
        __syncthreads();
        if (tid == 255) buf[16] = F;
        __syncthreads();
        const float Fend = buf[16];
        const float gl = tid < 256 ? Fend - F + ig : -3.0e38f;
        const float mw = wave_max(gl);
        if (lane == 0) buf[20 + wave] = mw;
        __syncthreads();
        const float mloc = fmaxf(fmaxf(buf[20], buf[21]), fmaxf(buf[22], buf[23]));
        if (tid < 256) wl[tid] = __expf(gl - mloc);
        if (tid == 0) { float* ch = (float*)(A.ws + WS_CHS) + unit * 4; ch[0] = Fend; ch[1] = mloc; }
        f32x4 acc[8];
#pragma unroll
        for (int kt_ = 0; kt_ < 8; ++kt_) acc[kt_] = (f32x4){0.f, 0.f, 0.f, 0.f};
        float dnp = 0.f;
        for (int half = 0; half < 2; ++half) {
            __syncthreads();
            for (int i = tid; i < 4096; i += NTHR) { const int which = i >> 11, oc = (i >> 7) & 15, s = i & 127;
                const v4u x = *(const v4u*)(QKVO + (size_t)(r0 + 128 * half + s) * 2048 + (which ? 1024 : 512) + h * HD + 8 * oc);
                LAS bf16* dst = (which ? vt : kt) + (8 * oc) * 136 + s;
                dst[0] = (bf16)x.x; dst[136] = (bf16)(x.x >> 16); dst[272] = (bf16)x.y; dst[408] = (bf16)(x.y >> 16); dst[544] = (bf16)x.z; dst[680] = (bf16)(x.z >> 16); dst[816] = (bf16)x.w; dst[952] = (bf16)(x.w >> 16); }
            __syncthreads();
#pragma unroll
            for (int ks = 0; ks < 4; ++ks) {
                const int s0 = 32 * ks + 8 * fq;
                const v4u xv = *(const LAS v4u*)(vt + (16 * wave + fr) * 136 + s0);
                const f32x4 w0 = *(const LAS f32x4*)(wl + 128 * half + s0), w1 = *(const LAS f32x4*)(wl + 128 * half + s0 + 4);
                v4u av; av.x = pk2(bflo(xv.x) * w0[0], bfhi(xv.x) * w0[1]); av.y = pk2(bflo(xv.y) * w0[2], bfhi(xv.y) * w0[3]); av.z = pk2(bflo(xv.z) * w1[0], bfhi(xv.z) * w1[1]); av.w = pk2(bflo(xv.w) * w1[2], bfhi(xv.w) * w1[3]);
                const bf16x8 af = __builtin_bit_cast(bf16x8, av);
#pragma unroll
                for (int kt_ = 0; kt_ < 8; ++kt_) { const bf16x8 bfr = *(const LAS bf16x8*)(kt + (16 * kt_ + fr) * 136 + s0); acc[kt_] = MFMA16(af, bfr, acc[kt_]); }
            }
            {   const int k = tid & 127, q = tid >> 7;
#pragma unroll
                for (int e = 0; e < 4; ++e) { const v4u x = *(const LAS v4u*)(kt + k * 136 + 32 * q + 8 * e); const LAS float* w = wl + 128 * half + 32 * q + 8 * e;
                    dnp += bflo(x.x) * w[0] + bfhi(x.x) * w[1] + bflo(x.y) * w[2] + bfhi(x.y) * w[3] + bflo(x.z) * w[4] + bfhi(x.z) * w[5] + bflo(x.w) * w[6] + bfhi(x.w) * w[7]; } }
        }
        float* dct = (float*)(A.ws + WS_DCT) + ((size_t)unit * HD + 16 * wave + 4 * fq) * HD + fr;
#pragma unroll
        for (int kt_ = 0; kt_ < 8; ++kt_)
#pragma unroll
            for (int i = 0; i < 4; ++i) dct[(size_t)i * HD + 16 * kt_] = acc[kt_][i];
        red[(tid >> 7) * 128 + (tid & 127)] = dnp;
        __syncthreads();
        if (tid < HD) ((float*)(A.ws + WS_DN))[unit * HD + tid] = (red[tid] + red[128 + tid]) + (red[256 + tid] + red[384 + tid]);
        __syncthreads();
    }
}

__device__ __forceinline__ void phase_m4x(CArgs& A, int l, LAS unsigned char* lds, int tid) {
    LAS float* buf = (LAS float*)lds;
    LAS float* sa = (LAS float*)(lds + 1024);
    LAS float* smx = sa + 256;
    LAS float* sdec = smx + 256;
    LAS float* sem = sdec + 256;
    LAS bf16* vt = (LAS bf16*)(lds + 8192);
    const bf16* QKVO = (const bf16*)(A.ws + WS_QKVO);
    const int lane = tid & 63, wave = tid >> 6, fr = lane & 15, fq = lane >> 4;
    for (int unit = blockIdx.x; unit < NUNIT; unit += gridDim.x) {
        const int b = unit >> 7, h = (unit >> 5) & 3, c = unit & 31, r0 = b * SEQ + c * LCH;
        float ig = 0.f, lf = 0.f;
        if (tid < 256) ml_gates(A, l, r0 + tid, h, ig, lf);
        const float F = scan_sum256(lf, buf, tid);
        const float a = tid < 256 ? ig - F : -3.0e38f;
        const float cm = scan_max256(a, buf, tid);
        const float m0 = ((const float*)(A.ws + WS_CHS))[unit * 4 + 2];
        if (tid < 256) { const float mx = fmaxf(m0, cm); sa[tid] = a; smx[tid] = mx; sdec[tid] = __expf(m0 - mx); sem[tid] = __expf(-(F + mx)); }
        for (int i = tid; i < 4096; i += NTHR) { const int oc = i >> 8, s = i & 255;
            const v4u x = *(const v4u*)(QKVO + (size_t)(r0 + s) * 2048 + 1024 + h * HD + 8 * oc);
            LAS bf16* dst = vt + (8 * oc) * 264 + s;
            dst[0] = (bf16)x.x; dst[264] = (bf16)(x.x >> 16); dst[528] = (bf16)x.y; dst[792] = (bf16)(x.y >> 16); dst[1056] = (bf16)x.z; dst[1320] = (bf16)(x.z >> 16); dst[1584] = (bf16)x.w; dst[1848] = (bf16)(x.w >> 16); }
        __syncthreads();
        const bf16* ctp = (const bf16*)(A.ws + WS_CTP) + (size_t)unit * HD * HD;
        const float* npv = (const float*)(A.ws + WS_NPV) + unit * HD;
        for (int pass = 0; pass < 2; ++pass) {
            const int sub = pass == 0 ? wave : 15 - wave, t0 = 16 * sub, t = t0 + fr;
            const float mxt = smx[t], dect = sdec[t], emt = sem[t];
            bf16x8 qf[4];
#pragma unroll
            for (int kk = 0; kk < 4; ++kk) qf[kk] = *(const bf16x8*)(QKVO + (size_t)(r0 + t) * 2048 + h * HD + 32 * kk + 8 * fq);
            f32x4 ah[8], ac[8];
#pragma unroll
            for (int v = 0; v < 8; ++v) { ah[v] = (f32x4){0.f, 0.f, 0.f, 0.f}; ac[v] = (f32x4){0.f, 0.f, 0.f, 0.f}; }
            float den = 0.f;
            const int nblk = (t0 + 47) >> 5;
            for (int ib = 0; ib < nblk; ++ib) {
                const int s0 = 32 * ib;
                f32x4 st[2];
#pragma unroll
                for (int j = 0; j < 2; ++j) {
                    f32x4 z = {0.f, 0.f, 0.f, 0.f};
                    const bf16* kp = QKVO + (size_t)(r0 + s0 + 16 * j + fr) * 2048 + 512 + h * HD + 8 * fq;
#pragma unroll
                    for (int kk = 0; kk < 4; ++kk) z = MFMA16(*(const bf16x8*)(kp + 32 * kk), qf[kk], z);
                    const f32x4 a4 = *(const LAS f32x4*)(sa + s0 + 16 * j + 4 * fq);
#pragma unroll
                    for (int i = 0; i < 4; ++i) { const float w = (s0 + 16 * j + 4 * fq + i <= t) ? z[i] * __expf(a4[i] - mxt) : 0.f; z[i] = w; den += w; }
                    st[j] = z;
                }
                v4u pw; pw.x = pk2(st[0][0], st[0][1]); pw.y = pk2(st[0][2], st[0][3]); pw.z = pk2(st[1][0], st[1][1]); pw.w = pk2(st[1][2], st[1][3]);
                const bf16x8 pf = __builtin_bit_cast(bf16x8, pw);
#pragma unroll
                for (int v = 0; v < 8; ++v) { const LAS bf16* vp = vt + (16 * v + fr) * 264 + s0 + 4 * fq;
                    const v2u x = *(const LAS v2u*)vp, y = *(const LAS v2u*)(vp + 16);
                    v4u vw; vw.x = x.x; vw.y = x.y; vw.z = y.x; vw.w = y.y;
                    ah[v] = MFMA16(__builtin_bit_cast(bf16x8, vw), pf, ah[v]); }
            }
            float qn = 0.f;
#pragma unroll
            for (int kk = 0; kk < 4; ++kk) {
                const v4u qx = __builtin_bit_cast(v4u, qf[kk]); const f32x4 n0 = *(const f32x4*)(npv + 32 * kk + 8 * fq), n1 = *(const f32x4*)(npv + 32 * kk + 8 * fq + 4);
                qn += bflo(qx.x) * n0[0] + bfhi(qx.x) * n0[1] + bflo(qx.y) * n0[2] + bfhi(qx.y) * n0[3] + bflo(qx.z) * n1[0] + bfhi(qx.z) * n1[1] + bflo(qx.w) * n1[2] + bfhi(qx.w) * n1[3];
#pragma unroll
                for (int v = 0; v < 8; ++v) ac[v] = MFMA16(*(const bf16x8*)(ctp + (size_t)(16 * v + fr) * HD + 32 * kk + 8 * fq), qf[kk], ac[v]);
            }
            const float dent = xfq_sum(den) + dect * xfq_sum(qn);
            const float rden = 1.f / fmaxf(fabsf(dent), emt);
            float s1 = 0.f;
#pragma unroll
            for (int v = 0; v < 8; ++v) { ah[v] = (ah[v] + ac[v] * dect) * rden; s1 += (ah[v][0] + ah[v][1]) + (ah[v][2] + ah[v][3]); }
            const float mu = xfq_sum(s1) * (1.f / HD);
            float s2 = 0.f;
#pragma unroll
            for (int v = 0; v < 8; ++v) { ah[v] = ah[v] - mu; s2 += (ah[v][0] * ah[v][0] + ah[v][1] * ah[v][1]) + (ah[v][2] * ah[v][2] + ah[v][3] * ah[v][3]); }
            const float rstd = 1.f / sqrtf(xfq_sum(s2) * (1.f / HD) + LN_EPS);
            const bf16* op = QKVO + (size_t)(r0 + t) * 2048 + 1536 + h * HD + 4 * fq;
            bf16* mp = (bf16*)(A.ws + WS_MIX) + (size_t)(r0 + t) * D + h * HD + 4 * fq;
            const float* gp = A.ml_norm_g + l * 512 + h * HD + 4 * fq;
#pragma unroll
            for (int v = 0; v < 8; ++v) { const v2u og = *(const v2u*)(op + 16 * v); const f32x4 gn = *(const f32x4*)(gp + 16 * v);
                v2u w; w.x = pk2(ah[v][0] * rstd * gn[0] * sigmoidf_(bflo(og.x)), ah[v][1] * rstd * gn[1] * sigmoidf_(bfhi(og.x)));
                w.y = pk2(ah[v][2] * rstd * gn[2] * sigmoidf_(bflo(og.y)), ah[v][3] * rstd * gn[3] * sigmoidf_(bfhi(og.y)));
                *(v2u*)(mp + 16 * v) = w; }
        }
        __syncthreads();
    }
}

constexpr int SKP = 72;
constexpr int NG_KB = 0, NG_IMP = 2 * 4 * 64 * SKP * 2, NG_BT = NG_IMP + NWAVES * 1088 * 4, NG_MSK = NG_BT + 8 * 132 * 4, NG_TASK = NG_MSK + NWAVES * 16, NG_JL = NG_TASK + 16, NG_END = NG_JL + 136 * 4;
static_assert(NG_END <= RING_BYTES, "NSA LDS map");
constexpr int CW_NSAQ = 8192;

__device__ __forceinline__ v4u stage_issue(const bf16* src, unsigned pitch, int tid) { const unsigned off = (unsigned)(tid >> 3) * pitch + (unsigned)(tid & 7) * 8u; return *(const v4u*)(src + off); }
__device__ __forceinline__ void stage_commit(LAS bf16* buf, const v4u& r, int tid) { *(LAS v4u*)(buf + (tid >> 3) * SKP + (tid & 7) * 8) = r; }
__device__ __forceinline__ void qk_lds(const LAS bf16* kb, const bf16x8 (&q)[2], int fr, int fq, f32x4 (&st)[4]) {
#pragma unroll
    for (int t = 0; t < 4; ++t) { const LAS bf16* p = kb + (16 * t + fr) * SKP + 8 * fq;
        f32x4 z = {0.f, 0.f, 0.f, 0.f}; z = MFMA16(*(const LAS bf16x8*)p, q[0], z); st[t] = MFMA16(*(const LAS bf16x8*)(p + 32), q[1], z); }
}
__device__ __forceinline__ void pv_lds(const LAS bf16* vb, int fr, int fq, const f32x4 (&st)[4], f32x4 (&o)[4]) {
#pragma unroll
    for (int h = 0; h < 2; ++h) {
        v4u pw; pw.x = pk2(st[2 * h][0], st[2 * h][1]); pw.y = pk2(st[2 * h][2], st[2 * h][3]); pw.z = pk2(st[2 * h + 1][0], st[2 * h + 1][1]); pw.w = pk2(st[2 * h + 1][2], st[2 * h + 1][3]);
        const bf16x8 pf = __builtin_bit_cast(bf16x8, pw);
#pragma unroll
        for (int dt = 0; dt < 4; ++dt) { const LAS bf16* p = vb + (16 * dt + fr) * SKP + 32 * h + 4 * fq;
            const v2u a = *(const LAS v2u*)p, b = *(const LAS v2u*)(p + 16); v4u w; w.x = a.x; w.y = a.y; w.z = b.x; w.w = b.y;
            o[dt] = MFMA16(__builtin_bit_cast(bf16x8, w), pf, o[dt]); }
    }
}
__device__ __forceinline__ void softmax_pv_lds(const LAS bf16* vb, int fr, int fq, f32x4 (&st)[4], float c, f32x4 (&o)[4], float& m, float& ls) {
    float bm = fmaxf(fmaxf(st[0][0], st[0][1]), fmaxf(st[0][2], st[0][3]));
#pragma unroll
    for (int t = 1; t < 4; ++t) bm = fmaxf(bm, fmaxf(fmaxf(st[t][0], st[t][1]), fmaxf(st[t][2], st[t][3])));
    bm = xfq_max(bm + c);
    if (__any(bm > m)) {
        const float mn = fmaxf(m, bm), sc = __builtin_amdgcn_exp2f(m - mn);
        m = mn; ls *= sc;
#pragma unroll
        for (int dt = 0; dt < 4; ++dt) o[dt] = o[dt] * sc;
    }
    const float d = c - m;
#pragma unroll
    for (int t = 0; t < 4; ++t)
#pragma unroll
        for (int i = 0; i < 4; ++i) { const float p = __builtin_amdgcn_exp2f(st[t][i] + d); st[t][i] = p; ls += p; }
    pv_lds(vb, fr, fq, st, o);
}

template <bool HASK, bool HASV, class Addr, class Body>
__device__ __forceinline__ void staged_sweep2(int n, const Addr& ad, Body& body, LAS bf16* sbuf, int tid) {
    if (n <= 0) return;
    constexpr int BLK = 64 * SKP, SET = 4 * BLK;
    {   v4u k0, k1, v0, v1;
        if (HASK) { k0 = ad.k(0, tid); if (1 < n) k1 = ad.k(1, tid); }
        if (HASV) { v0 = ad.v(0, tid); if (1 < n) v1 = ad.v(1, tid); }
        if (HASK) { stage_commit(sbuf, k0, tid); if (1 < n) stage_commit(sbuf + BLK, k1, tid); }
        if (HASV) { stage_commit(sbuf + 2 * BLK, v0, tid); if (1 < n) stage_commit(sbuf + 3 * BLK, v1, tid); } }
    __syncthreads();
    const int nstep = (n + 1) >> 1;
    for (int s = 0; s < nstep; ++s) {
        const int i0 = 2 * s, i2 = i0 + 2, i3 = i0 + 3;
        v4u k0, k1, v0, v1;
        if (i2 < n) { if (HASK) k0 = ad.k(i2, tid); if (HASV) v0 = ad.v(i2, tid); }
        if (i3 < n) { if (HASK) k1 = ad.k(i3, tid); if (HASV) v1 = ad.v(i3, tid); }
        LAS bf16* cur = sbuf + (s & 1) * SET; LAS bf16* nxt = sbuf + ((s & 1) ^ 1) * SET;
        body(i0, cur, cur + 2 * BLK);
        if (i0 + 1 < n) body(i0 + 1, cur + BLK, cur + 3 * BLK);
        if (i2 < n) { if (HASK) stage_commit(nxt, k0, tid); if (HASV) stage_commit(nxt + 2 * BLK, v0, tid); }
        if (i3 < n) { if (HASK) stage_commit(nxt + BLK, k1, tid); if (HASV) stage_commit(nxt + 3 * BLK, v1, tid); }
        __syncthreads();
    }
}
struct AdLin {
    const bf16* K; const bf16* V; unsigned vpitch;
    __device__ __forceinline__ v4u k(int i, int tid) const { return stage_issue(K + (size_t)i * 64 * 64, 64, tid); }
    __device__ __forceinline__ v4u v(int i, int tid) const { return stage_issue(V + (size_t)i * 64, vpitch, tid); }
};
struct AdList {
    const bf16* K; const bf16* V; unsigned vpitch; const LAS int* jl;
    __device__ __forceinline__ v4u k(int i, int tid) const { const int j = __builtin_amdgcn_readfirstlane(jl[i]); return stage_issue(K + (size_t)j * 64 * 64, 64, tid); }
    __device__ __forceinline__ v4u v(int i, int tid) const { const int j = __builtin_amdgcn_readfirstlane(jl[i]); return stage_issue(V + (size_t)j * 64, vpitch, tid); }
};
struct TileCtx { int fr, fq, qposA, qposB, qpos0, cur; const LAS float* bt; float farb; };
struct KF { bf16x8 k[8]; };
struct VF { v4u v[8]; };
__device__ __forceinline__ void kf_load(KF& f, const LAS bf16* kb, int fr, int fq) {
#pragma unroll
    for (int t = 0; t < 4; ++t) { const LAS bf16* p = kb + (16 * t + fr) * SKP + 8 * fq; f.k[2 * t] = *(const LAS bf16x8*)p; f.k[2 * t + 1] = *(const LAS bf16x8*)(p + 32); }
}
__device__ __forceinline__ void vf_load(VF& f, const LAS bf16* vb, int fr, int fq) {
#pragma unroll
    for (int h = 0; h < 2; ++h)
#pragma unroll
        for (int dt = 0; dt < 4; ++dt) { const LAS bf16* p = vb + (16 * dt + fr) * SKP + 32 * h + 4 * fq;
            const v2u a = *(const LAS v2u*)p, b = *(const LAS v2u*)(p + 16); v4u w; w.x = a.x; w.y = a.y; w.z = b.x; w.w = b.y; f.v[4 * h + dt] = w; }
}
__device__ __forceinline__ void qk2(const KF& f, const bf16x8 (&qa)[2], const bf16x8 (&qb)[2], f32x4 (&sa)[4], f32x4 (&sb)[4]) {
#pragma unroll
    for (int t = 0; t < 4; ++t) { const f32x4 z = {0.f, 0.f, 0.f, 0.f};
        sa[t] = MFMA16(f.k[2 * t + 1], qa[1], MFMA16(f.k[2 * t], qa[0], z)); sb[t] = MFMA16(f.k[2 * t + 1], qb[1], MFMA16(f.k[2 * t], qb[0], z)); }
}
__device__ __forceinline__ void pv2(const VF& f, const f32x4 (&sa)[4], const f32x4 (&sb)[4], f32x4 (&oa)[4], f32x4 (&ob)[4]) {
#pragma unroll
    for (int h = 0; h < 2; ++h) {
        v4u pa, pb;
        pa.x = pk2(sa[2 * h][0], sa[2 * h][1]); pa.y = pk2(sa[2 * h][2], sa[2 * h][3]); pa.z = pk2(sa[2 * h + 1][0], sa[2 * h + 1][1]); pa.w = pk2(sa[2 * h + 1][2], sa[2 * h + 1][3]);
        pb.x = pk2(sb[2 * h][0], sb[2 * h][1]); pb.y = pk2(sb[2 * h][2], sb[2 * h][3]); pb.z = pk2(sb[2 * h + 1][0], sb[2 * h + 1][1]); pb.w = pk2(sb[2 * h + 1][2], sb[2 * h + 1][3]);
        const bf16x8 fa = __builtin_bit_cast(bf16x8, pa), fb = __builtin_bit_cast(bf16x8, pb);
#pragma unroll
        for (int dt = 0; dt < 4; ++dt) { const bf16x8 vv = __builtin_bit_cast(bf16x8, f.v[4 * h + dt]); oa[dt] = MFMA16(vv, fa, oa[dt]); ob[dt] = MFMA16(vv, fb, ob[dt]); }
    }
}
__device__ __forceinline__ float max16(const f32x4 (&st)[4]) {
    float bm = fmaxf(fmaxf(st[0][0], st[0][1]), fmaxf(st[0][2], st[0][3]));
#pragma unroll
    for (int t = 1; t < 4; ++t) bm = fmaxf(bm, fmaxf(fmaxf(st[t][0], st[t][1]), fmaxf(st[t][2], st[t][3])));
    return bm;
}
__device__ __forceinline__ void softmax_pv2(const LAS bf16* vb, int fr, int fq, f32x4 (&sa)[4], f32x4 (&sb)[4], float ca, float cb, f32x4 (&oa)[4], f32x4 (&ob)[4], float (&m)[2], float (&ls)[2]) {
    float ba = max16(sa) + ca, bb = max16(sb) + cb;
    ba = fmaxf(ba, __shfl_xor(ba, 16)); bb = fmaxf(bb, __shfl_xor(bb, 16)); ba = fmaxf(ba, __shfl_xor(ba, 32)); bb = fmaxf(bb, __shfl_xor(bb, 32));
    const float ma = fmaxf(m[0], ba), mb = fmaxf(m[1], bb), xa = __builtin_amdgcn_exp2f(m[0] - ma), xb = __builtin_amdgcn_exp2f(m[1] - mb);
    m[0] = ma; m[1] = mb; ls[0] *= xa; ls[1] *= xb;
#pragma unroll
    for (int dt = 0; dt < 4; ++dt) { oa[dt] = oa[dt] * xa; ob[dt] = ob[dt] * xb; }
    const float da = ca - ma, db = cb - mb;
#pragma unroll
    for (int t = 0; t < 4; ++t)
#pragma unroll
        for (int i = 0; i < 4; ++i) { const float pa = __builtin_amdgcn_exp2f(sa[t][i] + da), pb = __builtin_amdgcn_exp2f(sb[t][i] + db); sa[t][i] = pa; sb[t][i] = pb; ls[0] += pa; ls[1] += pb; }
    VF vf; vf_load(vf, vb, fr, fq);
    pv2(vf, sa, sb, oa, ob);
}
struct BodyCmpStat2 {
    const bf16x8 (&qa)[2]; const bf16x8 (&qb)[2]; const TileCtx& c; float (&ml)[2]; float (&lsl)[2];
    __device__ __forceinline__ void operator()(int ib, const LAS bf16* kb, const LAS bf16*) {
        KF kf; kf_load(kf, kb, c.fr, c.fq);
        f32x4 sa[4], sb[4]; qk2(kf, qa, qb, sa, sb);
        if (c.qpos0 - 16 * (64 * ib + 63) - 31 >= 128) {
#pragma unroll
            for (int t = 0; t < 4; ++t) { sa[t] = sa[t] + c.farb; sb[t] = sb[t] + c.farb; }
        } else {
#pragma unroll
            for (int t = 0; t < 4; ++t)
#pragma unroll
                for (int i = 0; i < 4; ++i) { const int n = 64 * ib + 16 * t + 4 * c.fq + i; const int da = c.qposA - 16 * n - 31, db = c.qposB - 16 * n - 31;
                    sa[t][i] += c.bt[da < 0 ? 129 : (da > 128 ? 128 : da)]; sb[t][i] += c.bt[db < 0 ? 129 : (db > 128 ? 128 : db)]; }
        }
        const float ma = fmaxf(ml[0], max16(sa)), mb = fmaxf(ml[1], max16(sb));
        lsl[0] *= __builtin_amdgcn_exp2f(ml[0] - ma); lsl[1] *= __builtin_amdgcn_exp2f(ml[1] - mb); ml[0] = ma; ml[1] = mb;
#pragma unroll
        for (int t = 0; t < 4; ++t)
#pragma unroll
            for (int i = 0; i < 4; ++i) { lsl[0] += __builtin_amdgcn_exp2f(sa[t][i] - ma); lsl[1] += __builtin_amdgcn_exp2f(sb[t][i] - mb); }
    }
};
struct BodyCmpProb2 {
    const bf16x8 (&qa)[2]; const bf16x8 (&qb)[2]; const TileCtx& c; f32x4 (&oa)[4]; f32x4 (&ob)[4]; float m0, m1, inv0, inv1; LAS float* imp; int tl, rr;
    __device__ __forceinline__ void operator()(int ib, const LAS bf16* kb, const LAS bf16* vb) {
        KF kf; kf_load(kf, kb, c.fr, c.fq);
        f32x4 sa[4], sb[4]; qk2(kf, qa, qb, sa, sb);
        if (c.qpos0 - 16 * (64 * ib + 63) - 31 >= 128) {
            const float da = c.farb - m0, db = c.farb - m1;
#pragma unroll
            for (int t = 0; t < 4; ++t)
#pragma unroll
                for (int i = 0; i < 4; ++i) { sa[t][i] = __builtin_amdgcn_exp2f(sa[t][i] + da) * inv0; sb[t][i] = __builtin_amdgcn_exp2f(sb[t][i] + db) * inv1; }
        } else {
#pragma unroll
            for (int t = 0; t < 4; ++t)
#pragma unroll
                for (int i = 0; i < 4; ++i) { const int n = 64 * ib + 16 * t + 4 * c.fq + i; const int da = c.qposA - 16 * n - 31, db = c.qposB - 16 * n - 31;
                    sa[t][i] = __builtin_amdgcn_exp2f(sa[t][i] + c.bt[da < 0 ? 129 : (da > 128 ? 128 : da)] - m0) * inv0;
                    sb[t][i] = __builtin_amdgcn_exp2f(sb[t][i] + c.bt[db < 0 ? 129 : (db > 128 ? 128 : db)] - m1) * inv1; }
        }
#pragma unroll
        for (int t = 0; t < 4; ++t) {
            const float a4 = quad_sum((sa[t][0] + sa[t][1]) + (sa[t][2] + sa[t][3])), a3 = quad_sum(sa[t][3]), b4 = quad_sum((sb[t][0] + sb[t][1]) + (sb[t][2] + sb[t][3])), b3 = quad_sum(sb[t][3]);
            const int j0 = 16 * ib + 4 * t + c.fq;
            if (rr == 0) { LAS float* ip = imp + tl * 136 + j0;
                __hip_atomic_fetch_add(ip, a4, __ATOMIC_RELAXED, __HIP_MEMORY_SCOPE_WORKGROUP); __hip_atomic_fetch_add(ip + 1, a3, __ATOMIC_RELAXED, __HIP_MEMORY_SCOPE_WORKGROUP);
                __hip_atomic_fetch_add(ip + 4 * 136, b4, __ATOMIC_RELAXED, __HIP_MEMORY_SCOPE_WORKGROUP); __hip_atomic_fetch_add(ip + 4 * 136 + 1, b3, __ATOMIC_RELAXED, __HIP_MEMORY_SCOPE_WORKGROUP); }
        }
        VF vf; vf_load(vf, vb, c.fr, c.fq);
        pv2(vf, sa, sb, oa, ob);
    }
};
struct BodySel2 {
    const bf16x8 (&qa)[2]; const bf16x8 (&qb)[2]; const TileCtx& c; f32x4 (&oa)[4]; f32x4 (&ob)[4]; float (&m)[2]; float (&ls)[2]; const LAS int* jl;
    unsigned long long wu0, wu1, my0a, my1a, my0b, my1b;
    __device__ __forceinline__ void operator()(int i, const LAS bf16* kb, const LAS bf16* vb) {
        const int j = __builtin_amdgcn_readfirstlane(jl[i]);
        const bool wave_has = j < 64 ? ((wu0 >> j) & 1ull) != 0ull : ((wu1 >> (j - 64)) & 1ull) != 0ull;
        if (!wave_has) return;
        const bool minea = j < 64 ? ((my0a >> j) & 1ull) != 0ull : ((my1a >> (j - 64)) & 1ull) != 0ull, mineb = j < 64 ? ((my0b >> j) & 1ull) != 0ull : ((my1b >> (j - 64)) & 1ull) != 0ull;
        KF kf; kf_load(kf, kb, c.fr, c.fq);
        f32x4 sa[4], sb[4]; qk2(kf, qa, qb, sa, sb);
        float ca = minea ? c.farb : -INFINITY, cb = mineb ? c.farb : -INFINITY;
        if (j >= c.cur - 2) {
            ca = minea ? 0.f : -INFINITY; cb = mineb ? 0.f : -INFINITY;
#pragma unroll
            for (int t = 0; t < 4; ++t)
#pragma unroll
                for (int e = 0; e < 4; ++e) { const int key = 64 * j + 16 * t + 4 * c.fq + e; const int da = c.qposA - key, db = c.qposB - key;
                    sa[t][e] += c.bt[da < 0 ? 129 : (da > 128 ? 128 : da)]; sb[t][e] += c.bt[db < 0 ? 129 : (db > 128 ? 128 : db)]; }
        }
        softmax_pv2(vb, c.fr, c.fq, sa, sb, ca, cb, oa, ob, m, ls);
    }
};
struct BodyWin2 {
    const bf16x8 (&qa)[2]; const bf16x8 (&qb)[2]; const TileCtx& c; f32x4 (&oa)[4]; f32x4 (&ob)[4]; float (&m)[2]; float (&ls)[2]; int j0;
    __device__ __forceinline__ void operator()(int i, const LAS bf16* kb, const LAS bf16* vb) {
        const int j = j0 + i;
        if (c.qpos0 + 7 - 64 * j < 0 || c.qpos0 - (64 * j + 63) >= 512) return;
        KF kf; kf_load(kf, kb, c.fr, c.fq);
        f32x4 sa[4], sb[4]; qk2(kf, qa, qb, sa, sb);
        float ca = c.farb, cb = c.farb;
        const bool interior = (c.qpos0 + 7 - 64 * j < 512) && (c.qpos0 - (64 * j + 63) >= 128);
        if (!interior) {
            ca = 0.f; cb = 0.f;
#pragma unroll
            for (int t = 0; t < 4; ++t)
#pragma unroll
                for (int e = 0; e < 4; ++e) { const int key = 64 * j + 16 * t + 4 * c.fq + e; const int da = c.qposA - key, db = c.qposB - key;
                    sa[t][e] += c.bt[(unsigned)da >= 512u ? 129 : (da > 128 ? 128 : da)]; sb[t][e] += c.bt[(unsigned)db >= 512u ? 129 : (db > 128 ? 128 : db)]; }
        }
        softmax_pv2(vb, c.fr, c.fq, sa, sb, ca, cb, oa, ob, m, ls);
    }
};

__device__ __forceinline__ void nsa_group(CArgs& A, int l, int b, int g, int tg, LAS unsigned char* lds, int tid) {
    asm volatile("" : "+v"(tid));
    const int lane = tid & 63, wave = tid >> 6, fr = lane & 15, fq = lane >> 4, tl = fr >> 2, rr = fr & 3;
    LAS bf16* sbuf = (LAS bf16*)(lds + NG_KB);
    LAS float* imp = (LAS float*)(lds + NG_IMP) + wave * 1088; const LAS float* BT = (const LAS float*)(lds + NG_BT);
    LAS unsigned long long* msk = (LAS unsigned long long*)(lds + NG_MSK);
    LAS int* jl = (LAS int*)(lds + NG_JL);
    const int qpos0 = 64 * tg + 8 * wave, cur = tg, row0 = b * SEQ + qpos0, h = g * 4 + rr;
    const LAS float* bt = BT + h * 132;
    const TileCtx cx{fr, fq, qpos0 + tl, qpos0 + 4 + tl, qpos0, cur, bt, bt[128]};
    bf16x8 qa[2], qb[2];
    {   const bf16* qp = (const bf16*)(A.ws + WS_NQ) + (size_t)(row0 + tl) * 512 + g * 256 + rr * 64 + 8 * fq;
        qa[0] = *(const bf16x8*)qp; qa[1] = *(const bf16x8*)(qp + 32); qb[0] = *(const bf16x8*)(qp + 4 * 512); qb[1] = *(const bf16x8*)(qp + 4 * 512 + 32); }
    f32x4 outa[4], outb[4];
    for (int i = lane; i < 1088; i += 64) imp[i] = 0.f;

    {
        const int nb64 = (4 * tg + 3 + 63) >> 6;
        const AdLin ad{(const bf16*)(A.ws + WS_KC) + l * KC_L + (size_t)g * NCB * 64 + (size_t)b * 512 * 64, (const bf16*)(A.ws + WS_VCT) + l * KC_L + (size_t)g * 64 * NCB + (size_t)b * 512, (unsigned)NCB};
        float ml[2] = {-1.0e30f, -1.0e30f}, lsl[2] = {0.f, 0.f};
        { BodyCmpStat2 bd{qa, qb, cx, ml, lsl}; staged_sweep2<true, false>(nb64, ad, bd, sbuf, tid); }
        const float m0 = xfq_max(ml[0]), m1 = xfq_max(ml[1]);
        const float l0 = xfq_sum(lsl[0] * __builtin_amdgcn_exp2f(ml[0] - m0)), l1 = xfq_sum(lsl[1] * __builtin_amdgcn_exp2f(ml[1] - m1));
        f32x4 oa[4], ob[4];
#pragma unroll
        for (int dt = 0; dt < 4; ++dt) { oa[dt] = (f32x4){0.f, 0.f, 0.f, 0.f}; ob[dt] = (f32x4){0.f, 0.f, 0.f, 0.f}; }
        { BodyCmpProb2 bd{qa, qb, cx, oa, ob, m0, m1, l0 > 0.f ? 1.f / l0 : 0.f, l1 > 0.f ? 1.f / l1 : 0.f, imp, tl, rr}; staged_sweep2<true, true>(nb64, ad, bd, sbuf, tid); }
        const float* gt = (const float*)(A.ws + WS_GATE) + (size_t)(row0 + tl) * 32 + 8 + h * 3;
        const float ga = sigmoidf_(gt[0]), gb = sigmoidf_(gt[4 * 32]);
#pragma unroll
        for (int dt = 0; dt < 4; ++dt) { outa[dt] = oa[dt] * ga; outb[dt] = ob[dt] * gb; }
    }
    unsigned long long s0[8], s1[8];
#pragma unroll
    for (int t = 0; t < 8; ++t) topk_sel(imp[t * 136 + lane], imp[t * 136 + 64 + lane], cur, lane, s0[t], s1[t]);
    const unsigned long long wu0a = (s0[0] | s0[1]) | (s0[2] | s0[3]), wu1a = (s1[0] | s1[1]) | (s1[2] | s1[3]), wu0b = (s0[4] | s0[5]) | (s0[6] | s0[7]), wu1b = (s1[4] | s1[5]) | (s1[6] | s1[7]);
    const unsigned long long my0a = tl == 0 ? s0[0] : (tl == 1 ? s0[1] : (tl == 2 ? s0[2] : s0[3])), my1a = tl == 0 ? s1[0] : (tl == 1 ? s1[1] : (tl == 2 ? s1[2] : s1[3]));
    const unsigned long long my0b = tl == 0 ? s0[4] : (tl == 1 ? s0[5] : (tl == 2 ? s0[6] : s0[7])), my1b = tl == 0 ? s1[4] : (tl == 1 ? s1[5] : (tl == 2 ? s1[6] : s1[7]));
    if (lane == 0) { msk[2 * wave] = wu0a | wu0b; msk[2 * wave + 1] = wu1a | wu1b; }
    __syncthreads();
    unsigned long long gu0 = 0ull, gu1 = 0ull;
#pragma unroll
    for (int w = 0; w < NWAVES; ++w) { gu0 |= msk[2 * w]; gu1 |= msk[2 * w + 1]; }
    gu0 = __builtin_amdgcn_readfirstlane((unsigned)gu0) | ((unsigned long long)__builtin_amdgcn_readfirstlane((unsigned)(gu0 >> 32)) << 32);
    gu1 = __builtin_amdgcn_readfirstlane((unsigned)gu1) | ((unsigned long long)__builtin_amdgcn_readfirstlane((unsigned)(gu1 >> 32)) << 32);
    const int nsel0 = __popcll(gu0), nsel = nsel0 + __popcll(gu1);
    if (wave == 0) {
        const unsigned long long below = (1ull << lane) - 1ull;
        if ((gu0 >> lane) & 1ull) jl[__popcll(gu0 & below)] = lane;
        if ((gu1 >> lane) & 1ull) jl[nsel0 + __popcll(gu1 & below)] = 64 + lane;
    }
    __syncthreads();
    const float* gt = (const float*)(A.ws + WS_GATE) + (size_t)(row0 + tl) * 32 + 8 + h * 3;
    {
        float m[2] = {-1.0e30f, -1.0e30f}, ls[2] = {0.f, 0.f}; f32x4 oa[4], ob[4];
#pragma unroll
        for (int dt = 0; dt < 4; ++dt) { oa[dt] = (f32x4){0.f, 0.f, 0.f, 0.f}; ob[dt] = (f32x4){0.f, 0.f, 0.f, 0.f}; }
        const AdList ad{(const bf16*)(A.ws + WS_KS) + l * KS_L + (size_t)g * TOTS * 64 + (size_t)b * SEQ * 64, (const bf16*)(A.ws + WS_VTS) + l * KS_L + (size_t)g * 64 * TOTS + (size_t)b * SEQ, (unsigned)TOTS, jl};
        { BodySel2 bd{qa, qb, cx, oa, ob, m, ls, jl, wu0a | wu0b, wu1a | wu1b, my0a, my1a, my0b, my1b}; staged_sweep2<true, true>(nsel, ad, bd, sbuf, tid); }
        const float la = xfq_sum(ls[0]), lb = xfq_sum(ls[1]);
        const float wa = la > 0.f ? sigmoidf_(gt[1]) / la : 0.f, wb = lb > 0.f ? sigmoidf_(gt[4 * 32 + 1]) / lb : 0.f;
#pragma unroll
        for (int dt = 0; dt < 4; ++dt) { outa[dt] = outa[dt] + oa[dt] * wa; outb[dt] = outb[dt] + ob[dt] * wb; }
    }
    {
        float m[2] = {-1.0e30f, -1.0e30f}, ls[2] = {0.f, 0.f}; f32x4 oa[4], ob[4];
#pragma unroll
        for (int dt = 0; dt < 4; ++dt) { oa[dt] = (f32x4){0.f, 0.f, 0.f, 0.f}; ob[dt] = (f32x4){0.f, 0.f, 0.f, 0.f}; }
        int j0 = (64 * tg - 511) >> 6; if (j0 < 0) j0 = 0;
        const AdLin ad{(const bf16*)(A.ws + WS_KW) + l * KW_L + (size_t)g * TOTWP * 64 + ((size_t)b * SEQ + (size_t)j0 * 64) * 64, (const bf16*)(A.ws + WS_VTW) + l * KW_L + (size_t)g * 64 * TOTWP + (size_t)b * SEQ + (size_t)j0 * 64, (unsigned)TOTWP};
        { BodyWin2 bd{qa, qb, cx, oa, ob, m, ls, j0}; staged_sweep2<true, true>(cur - j0 + 1, ad, bd, sbuf, tid); }
        const float la = xfq_sum(ls[0]), lb = xfq_sum(ls[1]);
        const float wa = la > 0.f ? sigmoidf_(gt[2]) / la : 0.f, wb = lb > 0.f ? sigmoidf_(gt[4 * 32 + 2]) / lb : 0.f;
#pragma unroll
        for (int dt = 0; dt < 4; ++dt) { outa[dt] = outa[dt] + oa[dt] * wa; outb[dt] = outb[dt] + ob[dt] * wb; }
    }
    bf16* mp = (bf16*)(A.ws + WS_MIX) + (size_t)(row0 + tl) * D + 512 + h * 64 + 4 * fq;
#pragma unroll
    for (int dt = 0; dt < 4; ++dt) { v2u w; w.x = pk2(outa[dt][0], outa[dt][1]); w.y = pk2(outa[dt][2], outa[dt][3]); *(v2u*)(mp + 16 * dt) = w;
        v2u w2; w2.x = pk2(outb[dt][0], outb[dt][1]); w2.y = pk2(outb[dt][2], outb[dt][3]); *(v2u*)(mp + 4 * D + 16 * dt) = w2; }
}

__device__ __forceinline__ void phase_nsa2(CArgs& A, int l, int rep, LAS unsigned char* lds, int tid) {
    const int lane = tid & 63, wave = tid >> 6;
    LAS float* btl = (LAS float*)(lds + NG_BT);
    LAS int* tw = (LAS int*)(lds + NG_TASK);
    for (int i = tid; i < 8 * 132; i += NTHR) btl[i] = ((const float*)(A.ws + WS_BT))[i];
    unsigned* qh = (unsigned*)(A.ws + WS_CTL) + CW_NSAQ + (l * 2 + rep) * 5 * 64;
    const int own = (blockIdx.x & 7) >> 1;
    for (int qi = 0; qi < 5; ++qi) {
        const int qsel = qi == 0 ? 4 : (qi == 1 ? own : ((own + qi - 1) & 3));
        const int qlen = qsel == 4 ? 2 * DB / NWAVES : 128;
        for (;;) {
            __syncthreads();
            if (tid == 0) tw[0] = (int)__hip_atomic_fetch_add(qh + qsel * 64, 1u, __ATOMIC_RELAXED, __HIP_MEMORY_SCOPE_AGENT);
            __syncthreads();
            const int t = tw[0];
            if (t >= qlen) break;
            if (qsel < 4) nsa_group(A, l, qsel >> 1, qsel & 1, 127 - t, lds, tid);
            else { const int tt = t * NWAVES + wave; nsa_tile(A, l, true, tt >> 1, tt & 1, 0, (LAS float*)(lds + NG_IMP) + wave * 1088, btl, lane); }
        }
    }
}

constexpr int PH_PER_LAYER = 9, PH_L0 = 3, N_PHASES = PH_L0 + DEPTH * PH_PER_LAYER;
#ifndef REP_MASK
#define REP_MASK 0
#endif
__device__ __forceinline__ int rep_count(int b) { int n = (((REP_MASK) >> b) & 1) + 1; asm volatile("" : "+s"(n)); return n; }
#if REP_MASK
#define REPS(b) _Pragma("unroll 1") for (int rep_ = 0, nrep_ = rep_count(b); rep_ < nrep_; ++rep_)
#else
#define REPS(b) for (int rep_ = 0; rep_ < 1; ++rep_)
#endif
#ifndef MK_PER_PHASE
#define MK_PER_PHASE 0
#endif

__device__ __forceinline__ int fresh_tid() { int t = threadIdx.x; asm volatile("" : "+v"(t)); return t; }
__device__ __forceinline__ CArgs* kargs() { unsigned long long p = (unsigned long long)__builtin_amdgcn_kernarg_segment_ptr(); asm volatile("" : "+s"(p)); return (CArgs*)p; }
#define A (*kargs())
#define IN(k) (lo <= (k) && (k) < hi)
#define SEAM(k) do { if (IN(k) && IN((k) + 1)) xcd_barrier(bar); } while (0)
template <int l>
__device__ __forceinline__ void layer_phases(LAS unsigned char* lds, const XcdBarrier& bar, int G, int NGW, int lo, int hi) {
    unsigned char* ws = A.ws;
    float* const ADA = (float*)(ws + WS_ADA);
    float* const X = (float*)(ws + WS_X);
    float* const Z = (float*)(ws + WS_Z);
    bf16* const U = (bf16*)(ws + WS_U);
        const int pb_ = PH_L0 + l * PH_PER_LAYER;
        const float* adal = ADA + (size_t)l * NCOND * 6144;
        const float* xa = l == 0 ? A.x_prompt : X; const float* xb = l == 0 ? A.x_sample : X + (size_t)MP * D;
        if (IN(pb_ + 0)) {
            const int tid = fresh_tid(), lane = tid & 63, wave = __builtin_amdgcn_readfirstlane(tid >> 6), gw = blockIdx.x * NWAVES + wave; (void)lane; (void)gw;
            {
                pg8::Gemm g{U, (const bf16*)(ws + WS_WIN) + (size_t)l * NINP * D, D, D, D};
                pg8::StaticOrder S; S.init(M, NINP, G, (int)blockIdx.x);
                EpiInProj E{(bf16*)(ws + WS_QKVO), (bf16*)(ws + WS_NQ), (float*)(ws + WS_GATE), (float*)(ws + WS_KVR), (bf16*)(ws + WS_XC) + (size_t)l * 4 * XCP * 64, A.out, l};
                REPS(8) pg8::gemm_phase<EpiInProj, pg8::StaticOrder, true, true>(lds, g, S, E);
            }
            if (l == 0) {
                __syncthreads();
                pg8::Gemm g{(const bf16*)(ws + WS_XC), (const bf16*)(ws + WS_W1), 2048, 1024, 2048};
                CmpOrder S{G, (int)blockIdx.x, 0, DEPTH, 4, 64};
                EpiCmpHid E{(bf16*)(ws + WS_HID), (const float*)(ws + WS_B1)};
                REPS(14) pg8::gemm_phase<EpiCmpHid, CmpOrder, true, true>(lds, g, S, E);
            }
        }
        SEAM(pb_ + 0);
        if (IN(pb_ + 1)) {
            const int tid = fresh_tid(), lane = tid & 63, wave = __builtin_amdgcn_readfirstlane(tid >> 6), gw = blockIdx.x * NWAVES + wave; (void)lane; (void)gw;
            {
                SgCmpHid E{(bf16*)(ws + WS_HID) + (size_t)l * 4 * NCB * 256, (const float*)(ws + WS_B1) + l * 2 * 256};
                REPS(12) small_gemm(((const bf16*)(ws + WS_XC)) + (size_t)l * 4 * XCP * 64, (size_t)XCP * 64, 1024, ((const bf16*)(ws + WS_W1)) + (size_t)l * 2 * 256 * 2048, (size_t)256 * 2048, 2048, 2048, 4, 1024, 256, E, lds, tid);
            }
            REPS(1) { phase_m2x(A, l, lds, tid);
            __syncthreads();
            prep_layer_images(A, l, lds, gw, NGW, lane, wave); __syncthreads(); }
            if (l == 0) phase_cmp2(A, 0, DEPTH, 1024, NCB - 1024, gw, NGW, lane);
        }
        SEAM(pb_ + 1);
        if (IN(pb_ + 2)) {
            const int tid = fresh_tid(), lane = tid & 63, wave = __builtin_amdgcn_readfirstlane(tid >> 6), gw = blockIdx.x * NWAVES + wave; (void)lane; (void)gw;
            REPS(2) phase_m3(A, l, tid);
            phase_cmp2(A, l, 1, 0, 1024, gw, NGW, lane);
        }
        SEAM(pb_ + 2);
        if (IN(pb_ + 3)) {
            const int tid = fresh_tid(), lane = tid & 63, wave = __builtin_amdgcn_readfirstlane(tid >> 6), gw = blockIdx.x * NWAVES + wave; (void)lane; (void)gw;
            REPS(3) { phase_m4x(A, l, lds, tid);
            __syncthreads(); }
            REPS(4) { phase_mls(A, l, lds, tid);
            __syncthreads(); }
            REPS(5) phase_nsa2(A, l, rep_, lds, tid);
        }
        SEAM(pb_ + 3);
        if (IN(pb_ + 4)) {
            const int tid = fresh_tid(), lane = tid & 63, wave = __builtin_amdgcn_readfirstlane(tid >> 6), gw = blockIdx.x * NWAVES + wave; (void)lane; (void)gw;
            pg8::Gemm g{(const bf16*)(ws + WS_MIX), (const bf16*)(ws + WS_WOUT) + (size_t)l * D * D, D, D, D};
            pg8::StaticOrder S; S.init(MP, D, G, (int)blockIdx.x);
            EpiResid E{xa, xb, adal + 2048, Z};
            REPS(9) pg8::gemm_phase<EpiResid, pg8::StaticOrder, true, true>(lds, g, S, E);
            REPS(13) { SgResid E2{xb, adal + 2048, Z}; small_gemm(((const bf16*)(ws + WS_MIX)) + (size_t)MP * D, 0, D, (const bf16*)(ws + WS_WOUT) + (size_t)l * D * D, 0, D, D, 1, MS, D, E2, lds, tid); }
        }
        SEAM(pb_ + 4);
        if (IN(pb_ + 5)) {
            const int tid = fresh_tid(), lane = tid & 63, wave = __builtin_amdgcn_readfirstlane(tid >> 6), gw = blockIdx.x * NWAVES + wave; (void)lane; (void)gw;
            REPS(6) for (int r = gw; r < M; r += NGW) {
                const float* ad = adal + (size_t)cond_of_row(r) * 6144;
                ln_row(Z + (size_t)r * D, A.ln_g + (size_t)(l * 2 + 0) * D, A.ln_b + (size_t)(l * 2 + 0) * D, X + (size_t)r * D, ad + 3072, ad + 4096, U + (size_t)r * D, lane);
            }
        }
        SEAM(pb_ + 5);
        if (IN(pb_ + 6)) {
            const int tid = fresh_tid(), lane = tid & 63, wave = __builtin_amdgcn_readfirstlane(tid >> 6), gw = blockIdx.x * NWAVES + wave; (void)lane; (void)gw;
            pg8::Gemm g{U, (const bf16*)(ws + WS_WUP) + (size_t)l * FF * D, D, D, D};
            pg8::StaticOrder S; S.init(MP, FF, G, (int)blockIdx.x);
            EpiRelu2 E{(bf16*)(ws + WS_H)};
            REPS(10) pg8::gemm_phase<EpiRelu2, pg8::StaticOrder, true, true>(lds, g, S, E);
            REPS(13) { SgRelu2 E2{(bf16*)(ws + WS_H)}; small_gemm(U + (size_t)MP * D, 0, D, (const bf16*)(ws + WS_WUP) + (size_t)l * FF * D, 0, D, D, 1, MS, FF, E2, lds, tid); }
        }
        SEAM(pb_ + 6);
        if (IN(pb_ + 7)) {
            const int tid = fresh_tid(), lane = tid & 63, wave = __builtin_amdgcn_readfirstlane(tid >> 6), gw = blockIdx.x * NWAVES + wave; (void)lane; (void)gw;
            pg8::Gemm g{(const bf16*)(ws + WS_H), (const bf16*)(ws + WS_WDN) + (size_t)l * D * FF, FF, FF, FF};
            pg8::StaticOrder S; S.init(MP, D, G, (int)blockIdx.x);
            EpiResid E{X, X + (size_t)MP * D, adal + 5120, Z};
            REPS(11) pg8::gemm_phase<EpiResid, pg8::StaticOrder, true, true>(lds, g, S, E);
            REPS(13) { SgResid E2{X + (size_t)MP * D, adal + 5120, Z}; small_gemm(((const bf16*)(ws + WS_H)) + (size_t)MP * FF, 0, FF, (const bf16*)(ws + WS_WDN) + (size_t)l * D * FF, 0, FF, FF, 1, MS, D, E2, lds, tid); }
        }
        SEAM(pb_ + 7);
        if (IN(pb_ + 8)) {
            const int tid = fresh_tid(), lane = tid & 63, wave = __builtin_amdgcn_readfirstlane(tid >> 6), gw = blockIdx.x * NWAVES + wave; (void)lane; (void)gw;
            const bool last = l == DEPTH - 1;
            REPS(6) for (int r = gw; r < M; r += NGW) {
                const float* ad = adal + (size_t)NCOND * 6144 + (size_t)cond_of_row(r) * 6144;
                float* xo = last ? (r < MP ? A.out + O_YP + (size_t)r * D : A.out + O_YS + (size_t)(r - MP) * D) : X + (size_t)r * D;
                ln_row(Z + (size_t)r * D, A.ln_g + (size_t)(l * 2 + 1) * D, A.ln_b + (size_t)(l * 2 + 1) * D, xo, ad, ad + 1024, last ? (bf16*)nullptr : U + (size_t)r * D, lane);
            }
        }
        SEAM(pb_ + 8);
    }
__global__ void __launch_bounds__(NTHR, 2) fwd_kernel(Args A_unused) {
    extern __shared__ __attribute__((aligned(16))) unsigned char lds_raw[];
    LAS unsigned char* lds = (LAS unsigned char*)lds_raw;
    const int G = gridDim.x, NGW = G * NWAVES;
    unsigned char* ws = A.ws;
    for (int u = threadIdx.x; u < (LDS_BYTES - LDSCTL_OFF) / 4; u += NTHR) ((LAS unsigned*)(lds + LDSCTL_OFF))[u] = 0u;
    __syncthreads();
    XcdBarrier bar; bar.bar = (unsigned*)(ws + WS_CTL) + CW_BAR; bar.x = 0; bar.st = nullptr;
    if (!MK_PER_PHASE) bar = xcd_barrier_post((unsigned*)(ws + WS_CTL) + CW_BAR, (volatile LAS unsigned*)(lds + MISC_OFF) + 8);
    const int lo = A.ph_lo, hi = A.ph_hi;

    float* const ADA = (float*)(ws + WS_ADA);
    float* const X = (float*)(ws + WS_X);
    float* const Z = (float*)(ws + WS_Z);
    bf16* const U = (bf16*)(ws + WS_U);

    if (IN(0)) { const int tid = fresh_tid(), lane = tid & 63, wave = __builtin_amdgcn_readfirstlane(tid >> 6), gw = blockIdx.x * NWAVES + wave;
        REPS(7) { phase_ada(A, lds, tid); } __syncthreads();
        REPS(0) { phase_p0a(A, lds, gw, NGW, lane, wave); prep_cache_images(A, lds, gw, NGW, lane, wave); } }
    SEAM(0);
    if (IN(2)) {
        const int tid = fresh_tid(), lane = tid & 63, wave = __builtin_amdgcn_readfirstlane(tid >> 6), gw = blockIdx.x * NWAVES + wave;
        b1_reduce(A, tid);
        for (int r = gw; r < M; r += NGW) {
            const float* ad = ADA + (size_t)cond_of_row(r) * 6144;
            mod_row(r < MP ? A.x_prompt + (size_t)r * D : A.x_sample + (size_t)(r - MP) * D, ad, ad + 1024, U + (size_t)r * D, lane);
        }
    }
    SEAM(2);

    layer_phases<0>(lds, bar, G, NGW, lo, hi);
    layer_phases<1>(lds, bar, G, NGW, lo, hi);
    static_assert(DEPTH == 2, "two layers");
#undef IN
#undef SEAM
#undef A
}

extern "C" void kernel_launch(void* const* d_in, const int* in_sizes, int n_in, void* d_out, int out_size, void* d_ws, size_t ws_size, hipStream_t stream) {
    static int grid = 0;
    if (grid == 0) {
        if (n_in != 25 || (size_t)out_size != O_END || ws_size < WS_END) { fprintf(stderr, "kernel_launch: unexpected shapes: n_in %d out %d (want %zu) ws %zu (want >= %zu)\n", n_in, out_size, (size_t)O_END, ws_size, (size_t)WS_END); grid = -1; return; }
        int dev = 0, cus = 0, per_cu = 0;
        if (hipGetDevice(&dev) != hipSuccess || hipDeviceGetAttribute(&cus, hipDeviceAttributeMultiprocessorCount, dev) != hipSuccess) { grid = -1; return; }
        if (hipFuncSetAttribute((const void*)fwd_kernel, hipFuncAttributeMaxDynamicSharedMemorySize, LDS_BYTES) != hipSuccess) { fprintf(stderr, "kernel_launch: hipFuncSetAttribute failed\n"); grid = -1; return; }
        if (hipOccupancyMaxActiveBlocksPerMultiprocessor(&per_cu, (const void*)fwd_kernel, NTHR, LDS_BYTES) != hipSuccess || per_cu < 1) fprintf(stderr, "kernel_launch: occupancy query reports %d blocks per CU\n", per_cu);
        (void)hipGetLastError();
        grid = cus;
    }
    if (grid < 0) return;
    (void)hipMemsetAsync((char*)d_ws + WS_CTL, 0, CTL_ZERO_BYTES, stream);
    Args a{};
    a.x_prompt = (const float*)d_in[0]; a.x_sample = (const float*)d_in[1]; a.cache_cmp = (const float*)d_in[2]; a.cache_slc = (const float*)d_in[3]; a.cache_win = (const float*)d_in[4];
    a.st_C = (const float*)d_in[5]; a.st_n = (const float*)d_in[6]; a.st_m = (const float*)d_in[7]; a.page_table = (const int*)d_in[8]; a.c_prompt = (const float*)d_in[9]; a.c_sample = (const float*)d_in[10];
    a.w_ada = (const float*)d_in[11]; a.b_ada = (const float*)d_in[12]; a.w_in = (const float*)d_in[13]; a.b_gate = (const float*)d_in[14]; a.ml_norm_g = (const float*)d_in[15]; a.cmp_pe = (const float*)d_in[16];
    a.cmp_w1 = (const float*)d_in[17]; a.cmp_w2 = (const float*)d_in[18]; a.rel_bias = (const float*)d_in[19]; a.w_out = (const float*)d_in[20]; a.ln_g = (const float*)d_in[21]; a.ln_b = (const float*)d_in[22];
    a.w_up = (const float*)d_in[23]; a.w_down = (const float*)d_in[24];
    a.out = (float*)d_out; a.ws = (unsigned char*)d_ws;
#if MK_PER_PHASE
    for (int ph = 0; ph < N_PHASES; ++ph) { a.ph_lo = ph; a.ph_hi = ph + 1; hipLaunchKernelGGL(fwd_kernel, dim3(grid), dim3(NTHR), LDS_BYTES, stream, a); }
#else
    a.ph_lo = 0; a.ph_hi = N_PHASES;
    hipLaunchKernelGGL(fwd_kernel, dim3(grid), dim3(NTHR), LDS_BYTES, stream, a);
#endif
    const hipError_t le = hipPeekAtLastError();
    if (le != hipSuccess) fprintf(stderr, "kernel_launch: launch failed: %s\n", hipGetErrorName(le));
}
```

```cpp
#include <hip/hip_runtime.h>
#include <cstdio>
#include <cstdint>
namespace pg8 {
#define PG8_LAS __attribute__((address_space(3)))
typedef unsigned short bf16_t;
typedef short bf16x8 __attribute__((ext_vector_type(8)));
typedef float f32x4 __attribute__((ext_vector_type(4)));
typedef unsigned u32x4 __attribute__((ext_vector_type(4)));
constexpr int BM = 256, BK = 64, HALF = 128, HTB = HALF * BK * 2  , STAGE_BYTES = 8 * HTB, NXCD = 8, WGM = 8;

__host__ __device__ __forceinline__ int lds_byte(int r, int c) { const int st = (r >> 4) * 2 + (c >> 5), rr = r & 15, cc = c & 31, ob = rr * 64 + cc * 2; return st * 1024 + (ob ^ (((ob >> 9) & 1) << 5)); }
__host__ __device__ __forceinline__ void stage_rc(int b, int& R, int& C) { const int st = b / 1024, sb = b % 1024, swz = sb ^ (((sb >> 9) & 1) << 5); R = (st >> 1) * 16 + swz / 64; C = (st & 1) * 32 + (swz % 64) / 2; }
__host__ __device__ __forceinline__ int perm32(int rho) { const int n = rho >> 4, i = rho & 15; return 8 * (i >> 2) + 4 * n + (i & 3); }

struct Unit { int pm, pn; };
struct Gemm { const bf16_t* A; const bf16_t* Bt; int K, lda, ldb; };

struct StaticOrder {
    int nM, nN, nwg, G, c;
    __host__ __device__ void init(int M, int N, int G_, int c_) { nM = M / BM; nN = N / BM; nwg = nM * nN; G = G_; c = c_; }
    __host__ __device__ bool next(int i, Unit& u) const {
        const long L = (long)i * G + c; if (L >= nwg) return false;
        int wgid = (int)L; { const int q = nwg / NXCD, r = nwg % NXCD, xcd = wgid % NXCD, off = wgid / NXCD; wgid = (xcd < r ? xcd * (q + 1) : r * (q + 1) + (xcd - r) * q) + off; }
        const int nig = WGM * nN, gid = wgid / nig, fm = gid * WGM, gsz = (nM - fm) < WGM ? (nM - fm) : WGM;
        u.pm = fm + ((wgid % nig) % gsz); u.pn = (wgid % nig) / gsz; return true;
    }
    __device__ __forceinline__ void a_ready(const Unit&) const {}
    __device__ __forceinline__ void done(const Unit&) const {}
};

template <class Epi, class Sched, bool ALIGN_EPI = false, bool SP2 = false>
__device__ __forceinline__ void gemm_phase(PG8_LAS unsigned char* lds, const Gemm g, const Sched& S, const Epi& E, const int tid) {
    const int wid = __builtin_amdgcn_readfirstlane(tid >> 6), lane = tid & 63, wr = wid >> 2, wc = wid & 3, fr = lane & 15, fq = lane >> 4;
    const int K = g.K, nt = K / BK;
    unsigned voffA[2], voffB[2];
#pragma unroll
    for (int i = 0; i < 2; ++i) { int R, C; stage_rc(tid * 16 + i * 8192, R, C); const int Rb = Epi::PERM ? ((R & ~31) + perm32(R & 31)) : R;
        voffA[i] = (unsigned)(R * g.lda + C) * 2u; voffB[i] = (unsigned)(Rb * g.ldb + C) * 2u; }
    const size_t kstep = (size_t)(BK * 2);
    const size_t hstepA = (size_t)HALF * g.lda * 2, hstepB = (size_t)HALF * g.ldb * 2;
    const size_t tstepA = 2 * hstepA, tstepB = 2 * hstepB;
    const unsigned ldsw = (unsigned)wid * 1024u;
    const int aoff = lds_byte(wr * 64 + fr, fq * 8), boff = lds_byte(wc * 32 + fr, fq * 8);
#define PG8_SA(b, h) (((b) * 2 + (h)) * HTB)
#define PG8_SB(b, h) ((4 + (b) * 2 + (h)) * HTB)
#define PG8_STAGE(bufoff, gbase, voff) do { _Pragma("unroll") for (int _i = 0; _i < 2; ++_i) \
        __builtin_amdgcn_global_load_lds((const unsigned*)((const char*)(gbase) + (voff)[_i]), (PG8_LAS unsigned*)(lds + (bufoff) + ldsw + _i * 8192), 16, 0, 0); } while (0)
#define PG8_LDA(dst, b, h) do { _Pragma("unroll") for (int m = 0; m < 4; ++m) _Pragma("unroll") for (int k = 0; k < 2; ++k) dst[m][k] = *(const PG8_LAS bf16x8*)(lds + PG8_SA(b, h) + aoff + m * 2048 + k * 1024); } while (0)
#define PG8_LDB(dst, b, h) do { _Pragma("unroll") for (int n = 0; n < 2; ++n) _Pragma("unroll") for (int k = 0; k < 2; ++k) dst[n][k] = *(const PG8_LAS bf16x8*)(lds + PG8_SB(b, h) + boff + n * 2048 + k * 1024); } while (0)
#define PG8_MMA(ai, bj, At, Bt) do { __builtin_amdgcn_s_setprio(1); _Pragma("unroll") for (int m = 0; m < 4; ++m) _Pragma("unroll") for (int n = 0; n < 2; ++n) _Pragma("unroll") for (int k = 0; k < 2; ++k) \
        acc[ai][bj][m][n] = __builtin_amdgcn_mfma_f32_16x16x32_bf16(Bt[n][k], At[m][k], acc[ai][bj][m][n], 0, 0, 0); __builtin_amdgcn_s_setprio(0); } while (0)
#define PG8_WAIT_V(n) asm volatile("s_waitcnt vmcnt(" #n ")" ::: "memory")
#define PG8_WAIT_L(n) asm volatile("s_waitcnt lgkmcnt(" #n ")" ::: "memory")
#define PG8_BAR __builtin_amdgcn_s_barrier()
#define PG8_SCHED __builtin_amdgcn_sched_barrier(0)
    Unit cur, nxt; int ui = 0;
    if (!S.next(0, cur)) return;
    f32x4 acc[2][2][4][2];
#pragma unroll
    for (int a = 0; a < 2; ++a)
#pragma unroll
        for (int b = 0; b < 2; ++b)
#pragma unroll
            for (int m = 0; m < 4; ++m)
#pragma unroll
                for (int n = 0; n < 2; ++n) acc[a][b][m][n] = (f32x4){0.f, 0.f, 0.f, 0.f};
    bf16x8 At[4][2], B0[2][2], B1[2][2];
    const char* cA = (const char*)g.A + (size_t)cur.pm * tstepA; const char* cB = (const char*)g.Bt + (size_t)cur.pn * tstepB;
    S.a_ready(cur);
    if constexpr (SP2) {
        PG8_STAGE(PG8_SB(0, 0), cB, voffB); PG8_STAGE(PG8_SB(0, 1), cB + hstepB, voffB); PG8_STAGE(PG8_SA(0, 0), cA, voffA); PG8_STAGE(PG8_SA(0, 1), cA + hstepA, voffA);
        if (wr == 1) PG8_BAR;
        PG8_WAIT_V(2); PG8_BAR;
        PG8_STAGE(PG8_SB(1, 0), cB + kstep, voffB); PG8_STAGE(PG8_SA(1, 0), cA + kstep, voffA); PG8_STAGE(PG8_SB(1, 1), cB + hstepB + kstep, voffB);
        PG8_WAIT_V(6); PG8_BAR;
    } else {
        PG8_STAGE(PG8_SB(0, 0), cB, voffB); PG8_STAGE(PG8_SA(0, 0), cA, voffA); PG8_STAGE(PG8_SB(0, 1), cB + hstepB, voffB); PG8_STAGE(PG8_SA(0, 1), cA + hstepA, voffA);
        if (wr == 1) PG8_BAR;
        PG8_WAIT_V(4); PG8_BAR;
        PG8_STAGE(PG8_SB(1, 0), cB + kstep, voffB); PG8_STAGE(PG8_SA(1, 0), cA + kstep, voffA); PG8_STAGE(PG8_SB(1, 1), cB + hstepB + kstep, voffB);
        PG8_WAIT_V(6); PG8_BAR;
    }
    for (;;) {
        const bool has_next = S.next(ui + 1, nxt);
        const char* nA = has_next ? (const char*)g.A + (size_t)nxt.pm * tstepA : cA; const char* nB = has_next ? (const char*)g.Bt + (size_t)nxt.pn * tstepB : cB;
        for (int t = 0; t < nt; t += 2) {
            const bool last = (t == nt - 2);
            const char* a1 = cA + (size_t)(t + 1) * kstep;
            const char* a2 = last ? nA : cA + (size_t)(t + 2) * kstep; const char* b2 = last ? nB : cB + (size_t)(t + 2) * kstep;
            const char* a3 = a2 + kstep; const char* b3 = b2 + kstep;
            if (last && has_next) S.a_ready(nxt);
            if constexpr (SP2) {
            PG8_LDB(B0, 0, 0); PG8_LDB(B1, 0, 1); PG8_SCHED; PG8_LDA(At, 0, 0); PG8_STAGE(PG8_SA(1, 1), a1 + hstepA, voffA);
            PG8_WAIT_V(8); PG8_WAIT_L(0); PG8_BAR; PG8_MMA(0, 0, At, B0); PG8_MMA(0, 1, At, B1); PG8_BAR; PG8_SCHED;
            PG8_LDA(At, 0, 1); PG8_STAGE(PG8_SB(0, 0), b2, voffB); PG8_STAGE(PG8_SB(0, 1), b2 + hstepB, voffB); PG8_STAGE(PG8_SA(0, 0), a2, voffA);
            PG8_WAIT_V(8); PG8_WAIT_L(0); PG8_BAR; PG8_MMA(1, 0, At, B0); PG8_MMA(1, 1, At, B1); PG8_BAR; PG8_SCHED;
            PG8_LDB(B0, 1, 0); PG8_LDB(B1, 1, 1); PG8_SCHED; PG8_LDA(At, 1, 0); PG8_STAGE(PG8_SA(0, 1), a2 + hstepA, voffA);
            PG8_WAIT_V(8); PG8_WAIT_L(0); PG8_BAR; PG8_MMA(0, 0, At, B0); PG8_MMA(0, 1, At, B1); PG8_BAR; PG8_SCHED;
            PG8_LDA(At, 1, 1); PG8_STAGE(PG8_SB(1, 0), b3, voffB); PG8_STAGE(PG8_SB(1, 1), b3 + hstepB, voffB); PG8_STAGE(PG8_SA(1, 0), a3, voffA);
            PG8_WAIT_V(8); PG8_WAIT_L(0); PG8_BAR; PG8_MMA(1, 0, At, B0); PG8_MMA(1, 1, At, B1); PG8_BAR; PG8_SCHED;
            } else {
            PG8_LDB(B0, 0, 0); PG8_SCHED; PG8_LDA(At, 0, 0); PG8_STAGE(PG8_SA(1, 1), a1 + hstepA, voffA);
            PG8_WAIT_L(8); PG8_BAR; PG8_WAIT_L(0); PG8_MMA(0, 0, At, B0); PG8_BAR; PG8_SCHED;
            PG8_LDB(B1, 0, 1); PG8_STAGE(PG8_SB(0, 0), b2, voffB);
            PG8_BAR; PG8_WAIT_L(0); PG8_MMA(0, 1, At, B1); PG8_BAR;
            PG8_LDA(At, 0, 1); PG8_STAGE(PG8_SA(0, 0), a2, voffA);
            PG8_BAR; PG8_WAIT_L(0); PG8_MMA(1, 0, At, B0); PG8_BAR; PG8_SCHED;
            PG8_STAGE(PG8_SB(0, 1), b2 + hstepB, voffB);
            PG8_WAIT_V(6); PG8_BAR; PG8_MMA(1, 1, At, B1); PG8_BAR;
            PG8_LDB(B0, 1, 0); PG8_SCHED; PG8_LDA(At, 1, 0); PG8_STAGE(PG8_SA(0, 1), a2 + hstepA, voffA);
            PG8_WAIT_L(8); PG8_BAR; PG8_WAIT_L(0); PG8_MMA(0, 0, At, B0); PG8_BAR; PG8_SCHED;
            PG8_LDB(B1, 1, 1); PG8_STAGE(PG8_SB(1, 0), b3, voffB);
            PG8_BAR; PG8_WAIT_L(0); PG8_MMA(0, 1, At, B1); PG8_BAR;
            PG8_LDA(At, 1, 1); PG8_STAGE(PG8_SA(1, 0), a3, voffA);
            PG8_BAR; PG8_WAIT_L(0); PG8_MMA(1, 0, At, B0); PG8_BAR; PG8_SCHED;
            PG8_STAGE(PG8_SB(1, 1), b3 + hstepB, voffB);
            PG8_WAIT_V(6); PG8_BAR; PG8_MMA(1, 1, At, B1); PG8_BAR;
            }
        }
        if constexpr (ALIGN_EPI) { if (wr == 0) PG8_BAR; }
        if constexpr (!Epi::AFTER_DRAIN) { E(acc, cur, wr, wc, fr, fq); S.done(cur); }
        if (!has_next) break;
#pragma unroll
        for (int a = 0; a < 2; ++a)
#pragma unroll
            for (int b = 0; b < 2; ++b)
#pragma unroll
                for (int m = 0; m < 4; ++m)
#pragma unroll
                    for (int n = 0; n < 2; ++n) acc[a][b][m][n] = (f32x4){0.f, 0.f, 0.f, 0.f};
        cur = nxt; cA = nA; cB = nB; ++ui;
        if constexpr (ALIGN_EPI) { if (wr == 1) PG8_BAR; }
    }
    PG8_WAIT_V(0);
    if constexpr (!ALIGN_EPI) { if (wr == 0) PG8_BAR; }
    PG8_BAR;
    if constexpr (Epi::AFTER_DRAIN) { E.fused(acc, cur, wr, wc, fr, fq, lds, wid, lane); S.done(cur); }
#undef PG8_SA
#undef PG8_SB
#undef PG8_STAGE
#undef PG8_LDA
#undef PG8_LDB
#undef PG8_MMA
#undef PG8_WAIT_V
#undef PG8_WAIT_L
#undef PG8_BAR
#undef PG8_SCHED
}
}

constexpr int D = 1024, BATCH = 2, SEQ = 8192, DEPTH = 2, DB = 128, DS = 4, PAST = 2048, PAGE = 128, NPG = 16, NPHYS = 2560;
constexpr int MP = BATCH * SEQ, MS = DB * DS, M = MP + MS;
constexpr int NINP = 3584, FF = 4096, NCOND = BATCH + DB;
constexpr int NH = 4, HD = 128;
constexpr int LCH = 256, NCH = SEQ / LCH, NUNIT = BATCH * NH * NCH;
constexpr int NCB = 17408;
constexpr int XCP = NCB * 16;
constexpr float ALPHA = 1.4142135623730951f;
constexpr float LN_EPS = 1e-5f;
constexpr size_t O_YP = 0, O_YS = O_YP + (size_t)MP * D, O_CMPP = O_YS + (size_t)MS * D, O_CMPS = O_CMPP + (size_t)DEPTH * MP * 256, O_SLCP = O_CMPS + (size_t)DEPTH * MS * 256,
                 O_SLCS = O_SLCP + (size_t)DEPTH * MP * 256, O_WINP = O_SLCS + (size_t)DEPTH * MS * 256, O_WINS = O_WINP + (size_t)DEPTH * BATCH * 512 * 256,
                 O_CP = O_WINS + (size_t)DEPTH * DB * 512 * 256, O_CS = O_CP + (size_t)DEPTH * BATCH * NH * HD * HD, O_NP = O_CS + (size_t)DEPTH * DB * NH * HD * HD,
                 O_NS = O_NP + (size_t)DEPTH * BATCH * NH * HD, O_MP = O_NS + (size_t)DEPTH * DB * NH * HD, O_MS = O_MP + (size_t)DEPTH * BATCH * NH, O_END = O_MS + (size_t)DEPTH * DB * NH;

constexpr size_t al1m(size_t x) { return (x + 0xFFFFFull) & ~(size_t)0xFFFFFull; }
constexpr size_t WS_CTL = 0, CTL_ZERO_BYTES = 1u << 20;
constexpr size_t WS_WIN  = CTL_ZERO_BYTES;
constexpr size_t WS_WOUT = WS_WIN  + al1m((size_t)DEPTH * NINP * D * 2);
constexpr size_t WS_WUP  = WS_WOUT + al1m((size_t)DEPTH * D * D * 2);
constexpr size_t WS_WDN  = WS_WUP  + al1m((size_t)DEPTH * FF * D * 2);
constexpr size_t WS_W1   = WS_WDN  + al1m((size_t)DEPTH * D * FF * 2);
constexpr size_t WS_ADA  = WS_W1   + al1m((size_t)DEPTH * 2 * 256 * 2048 * 2);
constexpr size_t WS_B1   = WS_ADA  + al1m((size_t)DEPTH * NCOND * 6144 * 4);
constexpr size_t WS_BT   = WS_B1   + al1m(4096);
constexpr size_t WS_X    = WS_BT   + al1m(8 * 132 * 4);
constexpr size_t WS_Z    = WS_X    + al1m((size_t)M * D * 4);
constexpr size_t WS_U    = WS_Z    + al1m((size_t)M * D * 4);
constexpr size_t WS_QKVO = WS_U    + al1m((size_t)M * D * 2);
constexpr size_t WS_NQ   = WS_QKVO + al1m((size_t)M * 2048 * 2);
constexpr size_t WS_GATE = WS_NQ   + al1m((size_t)M * 512 * 2);
constexpr size_t WS_KVR  = WS_GATE + al1m((size_t)M * 32 * 4);
constexpr size_t WS_XC   = WS_KVR  + al1m((size_t)3 * M * 256 * 4);
constexpr size_t WS_HID  = WS_XC   + al1m((size_t)DEPTH * 4 * XCP * 64 * 2 + 4096);
constexpr size_t WS_CKV  = WS_HID  + al1m((size_t)DEPTH * 4 * NCB * 256 * 2);
constexpr size_t WS_KS   = WS_CKV  + al1m((size_t)DEPTH * 4 * NCB * 64 * 4);
constexpr size_t WS_VTS  = WS_KS   + al1m((size_t)DEPTH * 2 * (MP + DB * 2112) * 64 * 2 + 65536);
constexpr size_t WS_KW   = WS_VTS  + al1m((size_t)DEPTH * 2 * (MP + DB * 2112) * 64 * 2 + 65536);
constexpr size_t WS_VTW  = WS_KW   + al1m((size_t)DEPTH * 2 * (MP + DB * 528 + 64) * 64 * 2 + 65536);
constexpr size_t WS_KC   = WS_VTW  + al1m((size_t)DEPTH * 2 * (MP + DB * 528 + 64) * 64 * 2 + 65536);
constexpr size_t WS_VCT  = WS_KC   + al1m((size_t)DEPTH * 2 * NCB * 64 * 2 + 65536);
constexpr size_t WS_W2T  = WS_VCT  + al1m((size_t)DEPTH * 2 * NCB * 64 * 2 + 65536);
constexpr size_t WS_MIX  = WS_W2T  + al1m(65536);
constexpr size_t WS_H    = WS_MIX  + al1m((size_t)M * D * 2);
constexpr size_t WS_DCT  = WS_H    + al1m((size_t)M * FF * 2);
constexpr size_t WS_DN   = WS_DCT  + al1m((size_t)NUNIT * HD * HD * 4);
constexpr size_t WS_CHS  = WS_DN   + al1m((size_t)NUNIT * HD * 4);
constexpr size_t WS_CTP  = WS_CHS  + al1m((size_t)NUNIT * 4 * 4);
constexpr size_t WS_NPV  = WS_CTP  + al1m((size_t)NUNIT * HD * HD * 2);
constexpr size_t WS_WSC  = WS_NPV  + al1m((size_t)NUNIT * HD * 4);
constexpr size_t WS_HRAW = WS_WSC  + al1m((size_t)NUNIT * LCH * LCH * 4);
constexpr size_t WS_END  = WS_HRAW + al1m((size_t)NUNIT * LCH * HD * 4);

constexpr int CW_BAR = 4096;

constexpr int RING_BYTES = 131072, LDSCTL_OFF = RING_BYTES, MISC_OFF = LDSCTL_OFF + 320, LDS_BYTES = 147456;
constexpr int NWAVES = 8, NTHR = NWAVES * 64;

#define GAS __attribute__((address_space(1)))
#define LAS __attribute__((address_space(3)))
typedef unsigned short bf16;
typedef unsigned v4u __attribute__((ext_vector_type(4)));
typedef unsigned v2u __attribute__((ext_vector_type(2)));
typedef float f32x4 __attribute__((ext_vector_type(4)));
typedef float f32x2 __attribute__((ext_vector_type(2)));

__device__ __forceinline__ unsigned f2bf(float f) { unsigned u = __builtin_bit_cast(unsigned, f); return (u + 0x7fffu + ((u >> 16) & 1u)) >> 16; }
__device__ __forceinline__ unsigned pk2(float lo, float hi) { return f2bf(lo) | (f2bf(hi) << 16); }
__device__ __forceinline__ float bflo(unsigned u) { return __builtin_bit_cast(float, u << 16); }
__device__ __forceinline__ float bfhi(unsigned u) { return __builtin_bit_cast(float, u & 0xffff0000u); }
__device__ __forceinline__ float bf2f(bf16 h) { return __builtin_bit_cast(float, (unsigned)h << 16); }
__device__ __forceinline__ float sigmoidf_(float x) { return 1.f / (1.f + __expf(-x)); }
__device__ __forceinline__ float wave_sum(float v) {
#pragma unroll
    for (int o = 1; o < 64; o <<= 1) v += __shfl_xor(v, o);
    return v;
}
__device__ __forceinline__ float wave_max(float v) {
#pragma unroll
    for (int o = 1; o < 64; o <<= 1) v = fmaxf(v, __shfl_xor(v, o));
    return v;
}

#define XB_TMO      128
#define XB_XCNT(j)  (256  + 64 * (j))
#define XB_XSUB(j)  (1280 + 64 * (j))
#define XB_XGEN(j)  (2304 + 64 * (j))
#define XB_TOP      3328
#define XB_TOPGEN   3392
#define XCD_BAR_WORDS 3456
#define XB_SPIN_CAP (1u << 18)

__device__ __forceinline__ unsigned xb_ld(unsigned* p)              { return __hip_atomic_load(p, __ATOMIC_RELAXED, __HIP_MEMORY_SCOPE_AGENT); }
__device__ __forceinline__ unsigned xb_add(unsigned* p, unsigned v) { return __hip_atomic_fetch_add(p, v, __ATOMIC_RELAXED, __HIP_MEMORY_SCOPE_AGENT); }
__device__ __forceinline__ unsigned xb_xcc_id() { return (unsigned)__builtin_amdgcn_s_getreg((3 << 11) | 20) & 0xFu; }
#define XB_SPIN(cond, bar) do { unsigned _sp = 0; while (cond) { __builtin_amdgcn_s_sleep(1); \
    if ((++_sp & 255u) == 0u) { if (xb_ld(&(bar)[XB_TMO])) break; if (_sp > XB_SPIN_CAP) { atomicAdd(&(bar)[XB_TMO], 1u); break; } } } } while (0)

struct XcdBarrier {
    unsigned* bar; unsigned x;
    volatile LAS unsigned* st;
};

__device__ __forceinline__ XcdBarrier xcd_barrier_post(unsigned* bar, volatile LAS unsigned* st) {
    XcdBarrier b; b.bar = bar; b.x = xb_xcc_id(); b.st = st;
    if (threadIdx.x == 0) (void)xb_add(&bar[XB_XCNT(b.x)], 1u);
    return b;
}
__device__ __forceinline__ void xcd_barrier_complete(unsigned* bar, unsigned x, unsigned& nloc, unsigned& nx) {
    const unsigned G = gridDim.x * gridDim.y * gridDim.z;
    unsigned sum, cnt, mine, sp = 0u;
    for (;;) {
        sum = 0u; cnt = 0u; mine = 0u;
#pragma unroll
        for (unsigned j = 0; j < 16; ++j) { const unsigned c = xb_ld(&bar[XB_XCNT(j)]); sum += c; cnt += (c > 0u) ? 1u : 0u; mine = (j == x) ? c : mine; }
        if (sum == G) break;
        __builtin_amdgcn_s_sleep(1);
        if ((++sp & 255u) == 0u) { if (xb_ld(&bar[XB_TMO])) break; if (sp > XB_SPIN_CAP) { atomicAdd(&bar[XB_TMO], 1u); break; } }
    }
    nloc = mine > 0u ? mine : 1u; nx = cnt > 0u ? cnt : 1u;
}

__device__ __forceinline__ void xcd_barrier(const XcdBarrier& b) {
    asm volatile("s_waitcnt vmcnt(0)" ::: "memory");
    __syncthreads();
    if (threadIdx.x == 0) {
        unsigned* bar = b.bar;
        __builtin_amdgcn_s_waitcnt(0);
        unsigned nloc = b.st[0], nx = b.st[1];
        if (nloc == 0u) { xcd_barrier_complete(bar, b.x, nloc, nx); b.st[0] = nloc; b.st[1] = nx; }
        const unsigned old = xb_add(&bar[XB_XSUB(b.x)], 1u);
        const unsigned gen = old / nloc;
        if (old + 1u == (gen + 1u) * nloc) {
            __builtin_amdgcn_fence(__ATOMIC_RELEASE, "agent");
            asm volatile("s_waitcnt vmcnt(0)" ::: "memory");
            const unsigned og = xb_add(&bar[XB_TOP], 1u);
            const unsigned tg = og / nx;
            if (og + 1u == (tg + 1u) * nx) xb_add(&bar[XB_TOPGEN], 1u);
            else XB_SPIN(xb_ld(&bar[XB_TOPGEN]) == tg, bar);
            __builtin_amdgcn_fence(__ATOMIC_ACQUIRE, "agent");
            xb_add(&bar[XB_XGEN(b.x)], 1u);
            asm volatile("s_waitcnt vmcnt(0)" ::: "memory");
        } else {
            XB_SPIN(xb_ld(&bar[XB_XGEN(b.x)]) == gen, bar);
            __builtin_amdgcn_fence(__ATOMIC_ACQUIRE, "agent");
            asm volatile("s_waitcnt vmcnt(0)" ::: "memory");
        }
    }
    __syncthreads();
}

struct Args {
    const float* x_prompt; const float* x_sample; const float* cache_cmp; const float* cache_slc; const float* cache_win;
    const float* st_C; const float* st_n; const float* st_m; const int* page_table; const float* c_prompt; const float* c_sample;
    const float* w_ada; const float* b_ada; const float* w_in; const float* b_gate; const float* ml_norm_g; const float* cmp_pe;
    const float* cmp_w1; const float* cmp_w2; const float* rel_bias; const float* w_out; const float* ln_g; const float* ln_b;
    const float* w_up; const float* w_down;
    float* out; unsigned char* ws; int ph_lo, ph_hi;
};
static_assert(sizeof(Args) == 27 * 8 + 8, "Args has no padding");
typedef const __attribute__((address_space(4))) Args CArgs;

__device__ __forceinline__ int cond_of_row(int r) { return r < MP ? (r >> 13) : BATCH + ((r - MP) >> 2); }

struct EpiInProj {
    static constexpr bool PERM = true, AFTER_DRAIN = false;
    bf16* QKVO; bf16* NQ; float* GATE; float* KVR; bf16* XC; float* out; int l;
    __device__ __forceinline__ void operator()(const f32x4 (&acc)[2][2][4][2], const pg8::Unit& u, int wr, int wc, int fr, int fq) const {
        const int row0 = u.pm * 256 + wr * 64 + fr, pn = u.pn, col8 = wc * 32 + 8 * fq;
#pragma unroll
        for (int ai = 0; ai < 2; ++ai)
#pragma unroll
            for (int m = 0; m < 4; ++m) {
                const int r = row0 + ai * 128 + m * 16;
#pragma unroll
                for (int bj = 0; bj < 2; ++bj) {
                    const f32x4 v0 = acc[ai][bj][m][0], v1 = acc[ai][bj][m][1];
                    const int cc = bj * 128 + col8;
                    if (pn < 10) {
                        v4u w; w.x = pk2(v0[0], v0[1]); w.y = pk2(v0[2], v0[3]); w.z = pk2(v1[0], v1[1]); w.w = pk2(v1[2], v1[3]);
                        if (pn < 8) *(v4u*)(QKVO + (size_t)r * 2048 + pn * 256 + cc) = w;
                        else        *(v4u*)(NQ + (size_t)r * 512 + (pn - 8) * 256 + cc) = w;
                    } else if (pn < 13) {
                        const int kind = pn - 10;
                        float* kr = KVR + ((size_t)kind * M + r) * 256 + cc;
                        *(f32x4*)kr = v0; *(f32x4*)(kr + 4) = v1;
                        float* o = nullptr;
                        if (r < MP) {
                            if (kind < 2) o = out + (kind == 0 ? O_CMPP : O_SLCP) + ((size_t)l * MP + r) * 256 + cc;
                            else { const int t = r & (SEQ - 1); if (t >= SEQ - 512) o = out + O_WINP + (((size_t)l * BATCH + (r >> 13)) * 512 + (t - (SEQ - 512))) * 256 + cc; }
                        } else {
                            const int rs = r - MP;
                            if (kind < 2) o = out + (kind == 0 ? O_CMPS : O_SLCS) + ((size_t)l * MS + rs) * 256 + cc;
                            else o = out + O_WINS + (((size_t)l * DB + (rs >> 2)) * 512 + 508 + (rs & 3)) * 256 + cc;
                        }
                        if (o) { *(f32x4*)o = v0; *(f32x4*)(o + 4) = v1; }
                        if (kind == 0 && r < MP) {
                            v4u w; w.x = pk2(v0[0], v0[1]); w.y = pk2(v0[2], v0[3]); w.z = pk2(v1[0], v1[1]); w.w = pk2(v1[2], v1[3]);
                            *(v4u*)(XC + ((size_t)(bj * 2 + (wc >> 1)) * XCP + r) * 64 + (wc & 1) * 32 + 8 * fq) = w;
                        }
                    } else {
                        if (bj == 0 && wc == 0) { float* gp = GATE + (size_t)r * 32 + 8 * fq; *(f32x4*)gp = v0; *(f32x4*)(gp + 4) = v1; }
                    }
                }
            }
    }
};

struct EpiResid {
    static constexpr bool PERM = true, AFTER_DRAIN = false;
    const float* xa; const float* xb; const float* gate; float* Z;
    __device__ __forceinline__ void operator()(const f32x4 (&acc)[2][2][4][2], const pg8::Unit& u, int wr, int wc, int fr, int fq) const {
        const int row0 = u.pm * 256 + wr * 64 + fr, col0 = u.pn * 256 + wc * 32 + 8 * fq;
#pragma unroll
        for (int ai = 0; ai < 2; ++ai)
#pragma unroll
            for (int m = 0; m < 4; ++m) {
                const int r = row0 + ai * 128 + m * 16;
                const float* xr = (r < MP ? xa + (size_t)r * D : xb + (size_t)(r - MP) * D) + col0;
                const float* gr = gate + (size_t)cond_of_row(r) * 6144 + col0;
                float* zr = Z + (size_t)r * D + col0;
#pragma unroll
                for (int bj = 0; bj < 2; ++bj) {
                    const f32x4 x0 = *(const f32x4*)(xr + bj * 128), x1 = *(const f32x4*)(xr + bj * 128 + 4);
                    const f32x4 g0 = *(const f32x4*)(gr + bj * 128), g1 = *(const f32x4*)(gr + bj * 128 + 4);
                    *(f32x4*)(zr + bj * 128) = x0 * ALPHA + g0 * acc[ai][bj][m][0];
                    *(f32x4*)(zr + bj * 128 + 4) = x1 * ALPHA + g1 * acc[ai][bj][m][1];
                }
            }
    }
};

struct EpiRelu2 {
    static constexpr bool PERM = true, AFTER_DRAIN = false;
    bf16* H;
    __device__ __forceinline__ void operator()(const f32x4 (&acc)[2][2][4][2], const pg8::Unit& u, int wr, int wc, int fr, int fq) const {
        const int row0 = u.pm * 256 + wr * 64 + fr, col0 = u.pn * 256 + wc * 32 + 8 * fq;
#pragma unroll
        for (int ai = 0; ai < 2; ++ai)
#pragma unroll
            for (int m = 0; m < 4; ++m) {
                bf16* hr = H + (size_t)(row0 + ai * 128 + m * 16) * FF + col0;
#pragma unroll
                for (int bj = 0; bj < 2; ++bj) {
                    f32x4 a = acc[ai][bj][m][0], b = acc[ai][bj][m][1];
#pragma unroll
                    for (int i = 0; i < 4; ++i) { a[i] = fmaxf(a[i], 0.f); a[i] *= a[i]; b[i] = fmaxf(b[i], 0.f); b[i] *= b[i]; }
                    v4u w; w.x = pk2(a[0], a[1]); w.y = pk2(a[2], a[3]); w.z = pk2(b[0], b[1]); w.w = pk2(b[2], b[3]);
                    *(v4u*)(hr + bj * 128) = w;
                }
            }
    }
};

__device__ __forceinline__ float gelu_tanh(float x) {
    const float y = 0.7978845608028654f * (x + 0.044715f * x * x * x);
    const float t = 1.f - 2.f / (__expf(2.f * y) + 1.f);
    return 0.5f * x * (1.f + t);
}
struct EpiCmpHid {
    static constexpr bool PERM = true, AFTER_DRAIN = false;
    bf16* HID; const float* B1;
    __device__ __forceinline__ void operator()(const f32x4 (&acc)[2][2][4][2], const pg8::Unit& u, int wr, int wc, int fr, int fq) const {
        const int row0 = u.pm * 256 + wr * 64 + fr, col0 = wc * 32 + 8 * fq;
        const float* bp = B1 + u.pn * 256 + col0;
        f32x4 bv[2][2];
#pragma unroll
        for (int bj = 0; bj < 2; ++bj) { bv[bj][0] = *(const f32x4*)(bp + bj * 128); bv[bj][1] = *(const f32x4*)(bp + bj * 128 + 4); }
#pragma unroll
        for (int ai = 0; ai < 2; ++ai)
#pragma unroll
            for (int m = 0; m < 4; ++m) {
                bf16* hr = HID + (size_t)(row0 + ai * 128 + m * 16) * 256 + col0;
#pragma unroll
                for (int bj = 0; bj < 2; ++bj) {
                    f32x4 a = acc[ai][bj][m][0] + bv[bj][0], b = acc[ai][bj][m][1] + bv[bj][1];
#pragma unroll
                    for (int i = 0; i < 4; ++i) { a[i] = gelu_tanh(a[i]); b[i] = gelu_tanh(b[i]); }
                    v4u w; w.x = pk2(a[0], a[1]); w.y = pk2(a[2], a[3]); w.z = pk2(b[0], b[1]); w.w = pk2(b[2], b[3]);
                    *(v4u*)(hr + bj * 128) = w;
                }
            }
    }
};

struct CmpOrder {
    int G, c, l0, nl, t0, ntile;
    __device__ __forceinline__ bool next(int i, pg8::Unit& u) const {
        const int L = i * G + c; if (L >= nl * 4 * ntile) return false;
        const int blk = L / ntile, tile = L % ntile, l = l0 + (blk >> 2), sg = blk & 3;
        u.pm = (l * 4 + sg) * 68 + t0 + tile; u.pn = l * 2 + (sg >> 1); return true;
    }
    __device__ __forceinline__ void a_ready(const pg8::Unit&) const {}
    __device__ __forceinline__ void done(const pg8::Unit&) const {}
};

typedef short sg_bf16x8 __attribute__((ext_vector_type(8)));
template <class Epi>
__device__ __forceinline__ void small_gemm(const bf16* A, size_t strideA, int lda, const bf16* Bt, size_t strideB, int ldb, int K, int nbatch, int Mrows, int N, const Epi& E, LAS unsigned char* lds, int tid) {
    const int lane = tid & 63, wave = tid >> 6, fr = lane & 15, fq = lane >> 4;
    const int ntn = N / 64, ntm = Mrows / 32, ntask = nbatch * ntm * ntn, kw = K / 8;
    LAS f32x4* red = (LAS f32x4*)lds;
    for (int task = blockIdx.x; task < ntask; task += gridDim.x) {
        const int batch = task / (ntm * ntn), tr = task % (ntm * ntn), tm = tr / ntn, tn = tr % ntn;
        const bf16* ap = A + (size_t)batch * strideA + (size_t)(tm * 32 + fr) * lda + wave * kw + 8 * fq;
        const bf16* bp = Bt + (size_t)E.bsel(batch) * strideB + (size_t)(tn * 64 + fr) * ldb + wave * kw + 8 * fq;
        f32x4 acc[2][4];
#pragma unroll
        for (int i = 0; i < 2; ++i)
#pragma unroll
            for (int j = 0; j < 4; ++j) acc[i][j] = (f32x4){0.f, 0.f, 0.f, 0.f};
#pragma unroll 4
        for (int k = 0; k < kw; k += 32) {
            sg_bf16x8 af[2], bf[4];
#pragma unroll
            for (int i = 0; i < 2; ++i) af[i] = *(const sg_bf16x8*)(ap + (size_t)i * 16 * lda + k);
#pragma unroll
            for (int j = 0; j < 4; ++j) bf[j] = *(const sg_bf16x8*)(bp + (size_t)j * 16 * ldb + k);
#pragma unroll
            for (int i = 0; i < 2; ++i)
#pragma unroll
                for (int j = 0; j < 4; ++j) acc[i][j] = __builtin_amdgcn_mfma_f32_16x16x32_bf16(bf[j], af[i], acc[i][j], 0, 0, 0);
        }
        __syncthreads();
#pragma unroll
        for (int i = 0; i < 2; ++i)
#pragma unroll
            for (int j = 0; j < 4; ++j) red[(wave * 8 + i * 4 + j) * 64 + lane] = acc[i][j];
        __syncthreads();
        f32x4 sum = red[wave * 64 + lane];
#pragma unroll
        for (int w = 1; w < 8; ++w) sum = sum + red[(w * 8 + wave) * 64 + lane];
        E(batch, tm * 32 + (wave >> 2) * 16 + fr, tn * 64 + (wave & 3) * 16 + 4 * fq, sum);
    }
}
struct SgResid {
    const float* xb; const float* gate; float* Z;
    __device__ __forceinline__ int bsel(int) const { return 0; }
    __device__ __forceinline__ void operator()(int, int rl, int c, const f32x4& acc) const {
        const int r = MP + rl;
        const f32x4 x = *(const f32x4*)(xb + (size_t)rl * D + c), gg = *(const f32x4*)(gate + (size_t)cond_of_row(r) * 6144 + c);
        *(f32x4*)(Z + (size_t)r * D + c) = x * ALPHA + gg * acc;
    }
};
struct SgRelu2 {
    bf16* H;
    __device__ __forceinline__ int bsel(int) const { return 0; }
    __device__ __forceinline__ void operator()(int, int rl, int c, const f32x4& acc) const {
        f32x4 a = acc;
#pragma unroll
        for (int i = 0; i < 4; ++i) { a[i] = fmaxf(a[i], 0.f); a[i] *= a[i]; }
        v2u w; w.x = pk2(a[0], a[1]); w.y = pk2(a[2], a[3]);
        *(v2u*)(H + (size_t)(MP + rl) * FF + c) = w;
    }
};
struct SgCmpHid {
    bf16* HIDl; const float* B1l;
    __device__ __forceinline__ int bsel(int img) const { return img >> 1; }
    __device__ __forceinline__ void operator()(int img, int R, int c, const f32x4& acc) const {
        const f32x4 bb = *(const f32x4*)(B1l + (img >> 1) * 256 + c);
        f32x4 a = acc + bb;
#pragma unroll
        for (int i = 0; i < 4; ++i) a[i] = gelu_tanh(a[i]);
        v2u w; w.x = pk2(a[0], a[1]); w.y = pk2(a[2], a[3]);
        *(v2u*)(HIDl + ((size_t)img * NCB + R) * 256 + c) = w;
    }
};

#define LDS_WAIT() asm volatile("s_waitcnt lgkmcnt(0)" ::: "memory")
#define VM_WAIT() asm volatile("s_waitcnt vmcnt(0)" ::: "memory")

template <class CM>
__device__ __forceinline__ void transpose_item(const float* W, int ldw, int K, bf16* WT, LAS float* scr, int item, int nblk, int lane, const CM& cm) {
    const int kb = item / nblk, nb = item % nblk, k0 = 64 * kb, n0 = 32 * nb;
    const int sc = cm.col(n0 + (lane & 31)); const float scl = cm.scl(n0 + (lane & 31));
#pragma unroll 8
    for (int i = 0; i < 32; ++i) { const int kk = 2 * i + (lane >> 5); scr[kk * 33 + (lane & 31)] = sc >= 0 ? W[(size_t)(k0 + kk) * ldw + sc] * scl : 0.f; }
    LDS_WAIT();
    const int c = lane & 7;
#pragma unroll
    for (int j = 0; j < 4; ++j) { const int n = (lane >> 3) + 8 * j; const LAS float* s = scr + (8 * c) * 33 + n;
        v4u o; o.x = pk2(s[0 * 33], s[1 * 33]); o.y = pk2(s[2 * 33], s[3 * 33]); o.z = pk2(s[4 * 33], s[5 * 33]); o.w = pk2(s[6 * 33], s[7 * 33]);
        *(v4u*)(WT + (size_t)(n0 + n) * K + k0 + 8 * c) = o; }
    LDS_WAIT();
}
struct CmId { __device__ __forceinline__ int col(int n) const { return n; } __device__ __forceinline__ float scl(int) const { return 1.f; } };
struct CmIn {
    __device__ __forceinline__ int col(int n) const { return n < 2048 ? n : (n < 3328 ? n + 8 : (n < 3336 ? n - 1280 : (n < 3360 ? n : -1))); }
    __device__ __forceinline__ float scl(int n) const { return (n >= 512 && n < 1024) ? 0.08838834764831845f : ((n >= 2048 && n < 2560) ? 0.18033688011112042f : 1.f); }
};

__device__ __forceinline__ int rel_bucket_dev(int n) {
    if (n < 16) return n;
    const float nf = (float)n;
    int large = 16 + (int)(__logf(nf / 16.f) / 2.0794415416798357f * 16.f);
    return large < 31 ? large : 31;
}

__device__ __forceinline__ void phase_p0a(CArgs& A, LAS unsigned char* lds, int gw, int NGW, int lane, int wave) {
    unsigned char* ws = A.ws;
    LAS float* scr = (LAS float*)(lds + wave * 16384);
    constexpr int I_IN = 16 * 112, I_OUT = 16 * 32, I_UP = 16 * 128, I_DN = 64 * 32, I_W1 = 32 * 8;
    constexpr int I_L = I_IN + I_OUT + I_UP + I_DN + 2 * I_W1;
    for (int it = gw; it < DEPTH * I_L; it += NGW) {
        const int l = it / I_L; int r = it % I_L;
        if (r < I_IN) { transpose_item(A.w_in + (size_t)l * D * 3360, 3360, D, (bf16*)(ws + WS_WIN) + (size_t)l * NINP * D, scr, r, 112, lane, CmIn{}); continue; } r -= I_IN;
        if (r < I_OUT) { transpose_item(A.w_out + (size_t)l * D * D, D, D, (bf16*)(ws + WS_WOUT) + (size_t)l * D * D, scr, r, 32, lane, CmId{}); continue; } r -= I_OUT;
        if (r < I_UP) { transpose_item(A.w_up + (size_t)l * D * FF, FF, D, (bf16*)(ws + WS_WUP) + (size_t)l * FF * D, scr, r, 128, lane, CmId{}); continue; } r -= I_UP;
        if (r < I_DN) { transpose_item(A.w_down + (size_t)l * FF * D, D, FF, (bf16*)(ws + WS_WDN) + (size_t)l * D * FF, scr, r, 32, lane, CmId{}); continue; } r -= I_DN;
        const int s = r / I_W1; r %= I_W1;
        transpose_item(A.cmp_w1 + (size_t)(l * 2 + s) * 2048 * 256, 256, 2048, (bf16*)(ws + WS_W1) + (size_t)(l * 2 + s) * 256 * 2048, scr, r, 8, lane, CmId{});
    }
    for (int it = gw; it < DEPTH * DB * NPG * 2; it += NGW) {
        const int half = it & 1, pg = (it >> 1) & 15, seq = (it >> 5) & 127, l = it >> 12;
        const int phys = A.page_table[seq * NPG + pg];
        const float* src = A.cache_cmp + (((size_t)l * NPHYS + phys) * PAGE + half * 64) * 256 + 4 * lane;
        const int cc = 4 * lane, s = cc >> 7, g = (cc >> 6) & 1, d = cc & 63;
        bf16* dst = (bf16*)(ws + WS_XC) + ((size_t)((l * 2 + s) * 2 + g) * XCP + MP + seq * PAST + pg * PAGE + half * 64) * 64 + d;
#pragma unroll 16
        for (int sl = 0; sl < 64; ++sl) { const f32x4 v = *(const f32x4*)(src + (size_t)sl * 256); v2u w; w.x = pk2(v[0], v[1]); w.y = pk2(v[2], v[3]); *(v2u*)(dst + (size_t)sl * 64) = w; }
    }
    for (int it = gw; it < DEPTH * DB * 8; it += NGW) {
        const int ch = it & 7, ls = it >> 3;
        const float* src = A.cache_win + ((size_t)ls * 512 + 4 + ch * 64) * 256 + 4 * lane;
        float* dst = A.out + O_WINS + ((size_t)ls * 512 + ch * 64) * 256 + 4 * lane;
        const int n = ch == 7 ? 60 : 64;
#pragma unroll 12
        for (int i = 0; i < n; ++i) *(f32x4*)(dst + (size_t)i * 256) = *(const f32x4*)(src + (size_t)i * 256);
    }
    for (int it = gw; it < 8; it += NGW) {
        float* BT = (float*)(ws + WS_BT) + it * 132;
        for (int dd = lane; dd < 132; dd += 64) BT[dd] = dd <= 128 ? A.rel_bias[rel_bucket_dev(dd) * 8 + it] * 1.4426950408889634f : -INFINITY;
    }
    for (int it = gw; it < DEPTH * 2 * 4 * 16; it += NGW) {
        const int kp = it & 15, hq = (it >> 4) & 3, ls = it >> 6, h = hq * 64 + lane;
        const float* pe = A.cmp_pe + (size_t)ls * 2048 + kp * 128; const float* w1 = A.cmp_w1 + ((size_t)ls * 2048 + kp * 128) * 256 + h;
        float acc = 0.f;
#pragma unroll 16
        for (int k = 0; k < 128; ++k) acc += pe[k] * w1[(size_t)k * 256];
        ((float*)(ws + WS_B1))[2048 + (ls * 16 + kp) * 256 + h] = acc;
    }
    for (int it = gw; it < DEPTH * 2 * 64; it += NGW) {
        const int d = it & 63, ls = it >> 6;
        for (int h = lane; h < 256; h += 64) ((bf16*)(ws + WS_W2T))[((size_t)ls * 64 + d) * 256 + h] = (bf16)f2bf(A.cmp_w2[((size_t)ls * 256 + h) * 64 + d]);
    }
}

__device__ __forceinline__ void b1_reduce(CArgs& A, int tid) {
    for (int i = blockIdx.x * NTHR + tid; i < DEPTH * 2 * 256; i += gridDim.x * NTHR) { const float* p = (const float*)(A.ws + WS_B1) + 2048 + (i >> 8) * 16 * 256 + (i & 255);
        float acc = 0.f;
#pragma unroll
        for (int kp = 0; kp < 16; ++kp) acc += p[kp * 256];
        ((float*)(A.ws + WS_B1))[i] = acc; }
}
__device__ __forceinline__ void phase_ada(CArgs& A, LAS unsigned char* lds, int tid) {
    LAS float* a = (LAS float*)lds;
    for (int task = blockIdx.x; task < DEPTH * 12 * 10; task += gridDim.x) {
        const int rb = task % 10, cb = (task / 10) % 12, l = task / 120;
        __syncthreads();
        for (int i = tid; i < 13 * 1024; i += NTHR) { const int row = rb * 13 + i / 1024, k = i & 1023;
            const float c = row < BATCH ? A.c_prompt[row * D + k] : A.c_sample[(row - BATCH) * D + k]; a[i] = c / (1.f + __expf(-c)); }
        __syncthreads();
        const int j = cb * 512 + tid;
        const float* w = A.w_ada + (size_t)l * D * 6144 + j;
        float acc[13];
#pragma unroll
        for (int r = 0; r < 13; ++r) acc[r] = 0.f;
        for (int k = 0; k < D; k += 4) { const float w0 = w[(size_t)k * 6144], w1 = w[(size_t)(k + 1) * 6144], w2 = w[(size_t)(k + 2) * 6144], w3 = w[(size_t)(k + 3) * 6144];
#pragma unroll
            for (int r = 0; r < 13; ++r) { const f32x4 a4 = *(const LAS f32x4*)(a + r * 1024 + k); acc[r] += (a4[0] * w0 + a4[1] * w1) + (a4[2] * w2 + a4[3] * w3); } }
        const float bb = A.b_ada[l * 6144 + j];
        float* o = (float*)(A.ws + WS_ADA) + ((size_t)l * NCOND + rb * 13) * 6144 + j;
#pragma unroll
        for (int r = 0; r < 13; ++r) o[(size_t)r * 6144] = acc[r] + bb;
    }
}

__device__ __forceinline__ void mod_row(const float* xrow, const float* sh, const float* sc, bf16* urow, int lane) {
#pragma unroll
    for (int j = 0; j < 4; ++j) { const int c = 4 * lane + 256 * j;
        const f32x4 x = *(const f32x4*)(xrow + c), a = *(const f32x4*)(sh + c), b = *(const f32x4*)(sc + c);
        v2u w; w.x = pk2(x[0] * (1.f + b[0]) + a[0], x[1] * (1.f + b[1]) + a[1]); w.y = pk2(x[2] * (1.f + b[2]) + a[2], x[3] * (1.f + b[3]) + a[3]);
        *(v2u*)(urow + c) = w; }
}
__device__ __forceinline__ void ln_row(const float* zrow, const float* g, const float* b, float* xout, const float* sh, const float* sc, bf16* urow, int lane) {
    f32x4 v[4]; float s = 0.f;
#pragma unroll
    for (int j = 0; j < 4; ++j) { v[j] = *(const f32x4*)(zrow + 4 * lane + 256 * j); s += (v[j][0] + v[j][1]) + (v[j][2] + v[j][3]); }
    const float mean = wave_sum(s) * (1.f / D); float s2 = 0.f;
#pragma unroll
    for (int j = 0; j < 4; ++j) { v[j] = v[j] - mean; s2 += (v[j][0] * v[j][0] + v[j][1] * v[j][1]) + (v[j][2] * v[j][2] + v[j][3] * v[j][3]); }
    const float rstd = 1.f / sqrtf(wave_sum(s2) * (1.f / D) + LN_EPS);
#pragma unroll
    for (int j = 0; j < 4; ++j) { const int c = 4 * lane + 256 * j;
        const f32x4 gg = *(const f32x4*)(g + c), bb = *(const f32x4*)(b + c);
        const f32x4 x = v[j] * rstd * gg + bb;
        *(f32x4*)(xout + c) = x;
        if (urow) { const f32x4 a = *(const f32x4*)(sh + c), q = *(const f32x4*)(sc + c);
            v2u w; w.x = pk2(x[0] * (1.f + q[0]) + a[0], x[1] * (1.f + q[1]) + a[1]); w.y = pk2(x[2] * (1.f + q[2]) + a[2], x[3] * (1.f + q[3]) + a[3]);
            *(v2u*)(urow + c) = w; } }
}

__device__ __forceinline__ float scan_sum256(float v, LAS float* buf, int tid) {
    const int lane = tid & 63, w = tid >> 6;
#pragma unroll
    for (int o = 1; o < 64; o <<= 1) { const float y = __shfl_up(v, o); if (lane >= o) v += y; }
    __syncthreads();
    if (lane == 63) buf[w] = v;
    __syncthreads();
    float add = 0.f;
#pragma unroll
    for (int i = 0; i < 3; ++i) if (i < w) add += buf[i];
    return v + add;
}
__device__ __forceinline__ float scan_max256(float v, LAS float* buf, int tid) {
    const int lane = tid & 63, w = tid >> 6;
#pragma unroll
    for (int o = 1; o < 64; o <<= 1) { const float y = __shfl_up(v, o); if (lane >= o) v = fmaxf(v, y); }
    __syncthreads();
    if (lane == 63) buf[w] = v;
    __syncthreads();
#pragma unroll
    for (int i = 0; i < 3; ++i) if (i < w) v = fmaxf(v, buf[i]);
    return v;
}
__device__ __forceinline__ void ml_gates(CArgs& A, int l, int r, int h, float& ig, float& lf) {
    const float* G = (const float*)(A.ws + WS_GATE) + (size_t)r * 32;
    ig = G[h] + A.b_gate[l * 8 + h];
    const float fr = G[4 + h] + A.b_gate[l * 8 + 4 + h];
    lf = fminf(fr, 0.f) - log1pf(__expf(-fabsf(fr)));
}

__device__ __forceinline__ void phase_m2(CArgs& A, int l, LAS unsigned char* lds, int tid) {
    LAS float* buf = (LAS float*)lds;
    LAS float* wl = (LAS float*)(lds + 1024);
    const bf16* QKVO = (const bf16*)(A.ws + WS_QKVO);
    for (int unit = blockIdx.x; unit < NUNIT; unit += gridDim.x) {
        const int b = unit >> 7, h = (unit >> 5) & 3, c = unit & 31, r0 = b * SEQ + c * LCH;
        float ig = 0.f, lf = 0.f;
        if (tid < 256) ml_gates(A, l, r0 + tid, h, ig, lf);
        const float F = scan_sum256(lf, buf, tid);
        __syncthreads();
        if (tid == 255) buf[16] = F;
        __syncthreads();
        const float Fend = buf[16];
        const float gl = tid < 256 ? Fend - F + ig : -3.0e38f;
        float mw = wave_max(gl);
        if ((tid & 63) == 0) buf[20 + (tid >> 6)] = mw;
        __syncthreads();
        const float mloc = fmaxf(fmaxf(buf[20], buf[21]), fmaxf(buf[22], buf[23]));
        if (tid < 256) wl[tid] = __expf(gl - mloc);
        if (tid == 0) { float* ch = (float*)(A.ws + WS_CHS) + unit * 4; ch[0] = Fend; ch[1] = mloc; }
        __syncthreads();
        const int k = tid & 127, vq = tid >> 7;
        float acc[32]; float accn = 0.f;
#pragma unroll
        for (int i = 0; i < 32; ++i) acc[i] = 0.f;
        const bf16* kp = QKVO + (size_t)r0 * 2048 + 512 + h * HD + k;
        const bf16* vp = QKVO + (size_t)r0 * 2048 + 1024 + h * HD + 32 * vq;
        for (int s = 0; s < LCH; ++s) {
            const float wk = wl[s] * bf2f(kp[(size_t)s * 2048]);
            accn += wk;
            const v4u* v4 = (const v4u*)(vp + (size_t)s * 2048);
#pragma unroll
            for (int q = 0; q < 4; ++q) { const v4u vv = v4[q];
                acc[8 * q + 0] += wk * bflo(vv.x); acc[8 * q + 1] += wk * bfhi(vv.x); acc[8 * q + 2] += wk * bflo(vv.y); acc[8 * q + 3] += wk * bfhi(vv.y);
                acc[8 * q + 4] += wk * bflo(vv.z); acc[8 * q + 5] += wk * bfhi(vv.z); acc[8 * q + 6] += wk * bflo(vv.w); acc[8 * q + 7] += wk * bfhi(vv.w); }
        }
        float* dct = (float*)(A.ws + WS_DCT) + ((size_t)unit * HD + 32 * vq) * HD + k;
#pragma unroll
        for (int i = 0; i < 32; ++i) dct[(size_t)i * HD] = acc[i];
        if (vq == 0) ((float*)(A.ws + WS_DN))[unit * HD + k] = accn;
        __syncthreads();
    }
}

__device__ __forceinline__ void phase_m3(CArgs& A, int l, int tid) {
    for (int task = blockIdx.x; task < BATCH * NH * 33; task += gridDim.x) {
        const int bh = task / 33, part = task % 33;
        const bool isn = part == 32; if (isn && tid >= HD) continue;
        const int e = isn ? tid : part * 512 + tid;
        const float* chs = (const float*)(A.ws + WS_CHS) + (size_t)bh * NCH * 4;
        float st = 0.f, m0 = 0.f;
        for (int c = 0; c < NCH; ++c) {
            const int unit = bh * NCH + c;
            const float Fend = chs[c * 4], mloc = chs[c * 4 + 1];
            float dv;
            if (isn) { ((float*)(A.ws + WS_NPV))[unit * HD + e] = st; dv = ((const float*)(A.ws + WS_DN))[unit * HD + e]; if (tid == 0) ((float*)(A.ws + WS_CHS))[unit * 4 + 2] = m0; }
            else { ((bf16*)(A.ws + WS_CTP))[(size_t)unit * HD * HD + e] = (bf16)f2bf(st); dv = ((const float*)(A.ws + WS_DCT))[(size_t)unit * HD * HD + e]; }
            const float mend = fmaxf(m0 + Fend, mloc);
            st = __expf(m0 + Fend - mend) * st + __expf(mloc - mend) * dv;
            m0 = mend;
        }
        if (isn) { A.out[O_NP + ((size_t)l * BATCH * NH + bh) * HD + e] = st; if (tid == 0) A.out[O_MP + l * BATCH * NH + bh] = m0; }
        else { const int v = e >> 7, k = e & 127; A.out[O_CP + (((size_t)l * BATCH * NH + bh) * HD + k) * HD + v] = st; }
    }
}

__device__ __forceinline__ void phase_m4(CArgs& A, int l, LAS unsigned char* lds, int tid) {
    LAS float* buf = (LAS float*)lds;
    LAS float* sa = (LAS float*)(lds + 1024);
    LAS float* smx = sa + 256;
    LAS float* sdec = smx + 256;
    LAS float* sem = sdec + 256;
    LAS bf16* sv = (LAS bf16*)(lds + 8192);
    const bf16* QKVO = (const bf16*)(A.ws + WS_QKVO);
    const int lane = tid & 63, wave = tid >> 6;
    for (int unit = blockIdx.x; unit < NUNIT; unit += gridDim.x) {
        const int b = unit >> 7, h = (unit >> 5) & 3, c = unit & 31, r0 = b * SEQ + c * LCH;
        float ig = 0.f, lf = 0.f;
        if (tid < 256) ml_gates(A, l, r0 + tid, h, ig, lf);
        const float F = scan_sum256(lf, buf, tid);
        const float a = tid < 256 ? ig - F : -3.0e38f;
        const float cm = scan_max256(a, buf, tid);
        const float m0 = ((const float*)(A.ws + WS_CHS))[unit * 4 + 2];
        if (tid < 256) { const float mx = fmaxf(m0, cm); sa[tid] = a; smx[tid] = mx; sdec[tid] = __expf(m0 - mx); sem[tid] = __expf(-(F + mx)); }
        for (int i = tid; i < LCH * HD / 8; i += NTHR) { const int s = i >> 4, q = i & 15;
            *(LAS v4u*)(sv + s * HD + 8 * q) = *(const v4u*)(QKVO + (size_t)(r0 + s) * 2048 + 1024 + h * HD + 8 * q); }
        __syncthreads();
        float* W = (float*)(A.ws + WS_WSC) + (size_t)unit * LCH * LCH;
        for (int idx = tid; idx < LCH * LCH; idx += NTHR) {
            const int t = idx >> 8, s = idx & 255; float w = 0.f;
            if (s <= t) {
                const v4u* qp = (const v4u*)(QKVO + (size_t)(r0 + t) * 2048 + h * HD); const v4u* kp = (const v4u*)(QKVO + (size_t)(r0 + s) * 2048 + 512 + h * HD);
                float d = 0.f;
#pragma unroll 4
                for (int q = 0; q < 16; ++q) { const v4u x = qp[q], y = kp[q];
                    d += bflo(x.x) * bflo(y.x) + bfhi(x.x) * bfhi(y.x) + bflo(x.y) * bflo(y.y) + bfhi(x.y) * bfhi(y.y)
                       + bflo(x.z) * bflo(y.z) + bfhi(x.z) * bfhi(y.z) + bflo(x.w) * bflo(y.w) + bfhi(x.w) * bfhi(y.w); }
                w = d * __expf(sa[s] - smx[t]);
            }
            W[idx] = w;
        }
        __syncthreads();
        {
            const int v = tid & 127, tq = tid >> 7;
            const bf16* ctp = (const bf16*)(A.ws + WS_CTP) + ((size_t)unit * HD + v) * HD;
            const float* npv = (const float*)(A.ws + WS_NPV) + unit * HD;
            float* hraw = (float*)(A.ws + WS_HRAW) + (size_t)unit * LCH * HD;
            for (int i = 0; i < 64; ++i) {
                const int t = 4 * i + tq;
                float num = 0.f, den = 0.f;
                const float* wr = W + (size_t)t * LCH;
                for (int s = 0; s <= t; s += 4) { const f32x4 w4 = *(const f32x4*)(wr + s);
                    num += w4[0] * bf2f(sv[(s + 0) * HD + v]) + w4[1] * bf2f(sv[(s + 1) * HD + v]) + w4[2] * bf2f(sv[(s + 2) * HD + v]) + w4[3] * bf2f(sv[(s + 3) * HD + v]);
                    den += (w4[0] + w4[1]) + (w4[2] + w4[3]); }
                float qc = 0.f, qn = 0.f;
                const v4u* qp = (const v4u*)(QKVO + (size_t)(r0 + t) * 2048 + h * HD);
#pragma unroll 4
                for (int q = 0; q < 16; ++q) { const v4u x = qp[q], y = *(const v4u*)(ctp + 8 * q); const f32x4 n0 = *(const f32x4*)(npv + 8 * q), n1 = *(const f32x4*)(npv + 8 * q + 4);
                    qc += bflo(x.x) * bflo(y.x) + bfhi(x.x) * bfhi(y.x) + bflo(x.y) * bflo(y.y) + bfhi(x.y) * bfhi(y.y)
                        + bflo(x.z) * bflo(y.z) + bfhi(x.z) * bfhi(y.z) + bflo(x.w) * bflo(y.w) + bfhi(x.w) * bfhi(y.w);
                    qn += bflo(x.x) * n0[0] + bfhi(x.x) * n0[1] + bflo(x.y) * n0[2] + bfhi(x.y) * n0[3] + bflo(x.z) * n1[0] + bfhi(x.z) * n1[1] + bflo(x.w) * n1[2] + bfhi(x.w) * n1[3]; }
                const float dec = sdec[t];
                const float numt = num + dec * qc, dent = den + dec * qn;
                hraw[(size_t)t * HD + v] = numt / fmaxf(fabsf(dent), sem[t]);
            }
        }
        __syncthreads();
        {
            const float* hraw = (const float*)(A.ws + WS_HRAW) + (size_t)unit * LCH * HD;
            const float g0 = A.ml_norm_g[l * 512 + h * HD + lane], g1 = A.ml_norm_g[l * 512 + h * HD + 64 + lane];
            for (int t = wave; t < LCH; t += NWAVES) {
                const float x0 = hraw[(size_t)t * HD + lane], x1 = hraw[(size_t)t * HD + 64 + lane];
                const float mu = wave_sum(x0 + x1) * (1.f / HD);
                const float d0 = x0 - mu, d1 = x1 - mu;
                const float rstd = 1.f / sqrtf(wave_sum(d0 * d0 + d1 * d1) * (1.f / HD) + LN_EPS);
                const bf16* op = QKVO + (size_t)(r0 + t) * 2048 + 1536 + h * HD;
                bf16* mp = (bf16*)(A.ws + WS_MIX) + (size_t)(r0 + t) * D + h * HD;
                mp[lane] = (bf16)f2bf(d0 * rstd * g0 * sigmoidf_(bf2f(op[lane])));
                mp[64 + lane] = (bf16)f2bf(d1 * rstd * g1 * sigmoidf_(bf2f(op[64 + lane])));
            }
        }
        __syncthreads();
    }
}

__device__ __forceinline__ void phase_mls(CArgs& A, int l, LAS unsigned char* lds, int tid) {
    LAS float* sq = (LAS float*)lds;
    LAS float* sc = sq + 1536;
    LAS float* sw = sc + 64;
    LAS float* part = sw + 16;
    LAS float* red = part + 2048;
    const bf16* QKVO = (const bf16*)(A.ws + WS_QKVO);
    for (int task = blockIdx.x; task < DB * NH; task += gridDim.x) {
        const int seq = task >> 2, h = task & 3, r0 = MP + seq * DS, sidx = (l * DB + seq) * NH + h;
        __syncthreads();
        for (int i = tid; i < 1536; i += NTHR) { const int which = i >> 9, t = (i >> 7) & 3, d = i & 127; sq[i] = bf2f(QKVO[(size_t)(r0 + t) * 2048 + which * 512 + h * HD + d]); }
        const float m0 = A.st_m[sidx];
        if (tid == 0) {
            float F = 0.f, cmx = -3.0e38f, Fs[4], igs[4], mlast = 0.f;
#pragma unroll
            for (int t = 0; t < 4; ++t) { float ig, lf; ml_gates(A, l, r0 + t, h, ig, lf); F += lf; Fs[t] = F; igs[t] = ig; const float a = ig - F; cmx = fmaxf(cmx, a); const float mx = fmaxf(m0, cmx);
                sc[8 + t] = a; sc[12 + t] = mx; sc[16 + t] = __expf(m0 - mx); sc[20 + t] = __expf(-(F + mx)); mlast = F + mx; }
#pragma unroll
            for (int t = 0; t < 4; ++t) sc[24 + t] = __expf(Fs[3] - Fs[t] + igs[t] - mlast);
            sc[28] = __expf(Fs[3] + m0 - mlast); sc[29] = mlast;
        }
        __syncthreads();
        if (tid < 16) { const int t = tid >> 2, s = tid & 3; float w = 0.f;
            if (s <= t) { float d = 0.f; for (int k = 0; k < HD; ++k) d += sq[t * HD + k] * sq[512 + s * HD + k]; w = d * __expf(sc[8 + s] - sc[12 + t]); }
            sw[tid] = w; }
        else if (tid < 20) { const int t = tid - 16; const float* n0 = A.st_n + (size_t)sidx * HD; float d = 0.f; for (int k = 0; k < HD; ++k) d += sq[t * HD + k] * n0[k]; sc[32 + t] = d; }
        __syncthreads();
        {
            const int v = tid & 127, kq = tid >> 7;
            const float* C0 = A.st_C + (size_t)sidx * HD * HD; float* Co = A.out + O_CS + (size_t)sidx * HD * HD;
            const float cd = sc[28];
            float wv[4]; float qc[4] = {0.f, 0.f, 0.f, 0.f};
#pragma unroll
            for (int t = 0; t < 4; ++t) wv[t] = sc[24 + t] * sq[1024 + t * HD + v];
            for (int kk = 0; kk < 32; ++kk) { const int k = kq * 32 + kk; const float c0 = C0[(size_t)k * HD + v];
                float cn = cd * c0;
#pragma unroll
                for (int t = 0; t < 4; ++t) { qc[t] += sq[t * HD + k] * c0; cn += wv[t] * sq[512 + t * HD + k]; }
                Co[(size_t)k * HD + v] = cn; }
#pragma unroll
            for (int t = 0; t < 4; ++t) part[(kq * 4 + t) * HD + v] = qc[t];
        }
        __syncthreads();
        float hv[4] = {0.f, 0.f, 0.f, 0.f};
        if (tid < HD) {
            const int v = tid;
#pragma unroll
            for (int t = 0; t < 4; ++t) { const float qct = part[(0 * 4 + t) * HD + v] + part[(1 * 4 + t) * HD + v] + part[(2 * 4 + t) * HD + v] + part[(3 * 4 + t) * HD + v];
                float num = sc[16 + t] * qct, den = sc[16 + t] * sc[32 + t];
#pragma unroll
                for (int s = 0; s < 4; ++s) { num += sw[t * 4 + s] * sq[1024 + s * HD + v]; den += sw[t * 4 + s]; }
                hv[t] = num / fmaxf(fabsf(den), sc[20 + t]); }
        }
#pragma unroll
        for (int t = 0; t < 4; ++t) { const float s1 = wave_sum(hv[t]); if ((tid & 63) == 0 && tid < HD) red[t * 2 + (tid >> 6)] = s1; }
        __syncthreads();
        float dv[4];
#pragma unroll
        for (int t = 0; t < 4; ++t) { dv[t] = hv[t] - (red[t * 2] + red[t * 2 + 1]) * (1.f / HD); const float s2 = wave_sum(dv[t] * dv[t]); if ((tid & 63) == 0 && tid < HD) red[8 + t * 2 + (tid >> 6)] = s2; }
        __syncthreads();
        if (tid < HD) {
            const int v = tid; const float gn = A.ml_norm_g[l * 512 + h * HD + v];
#pragma unroll
            for (int t = 0; t < 4; ++t) { const float rstd = 1.f / sqrtf((red[8 + t * 2] + red[8 + t * 2 + 1]) * (1.f / HD) + LN_EPS);
                const float og = bf2f(QKVO[(size_t)(r0 + t) * 2048 + 1536 + h * HD + v]);
                ((bf16*)(A.ws + WS_MIX))[(size_t)(r0 + t) * D + h * HD + v] = (bf16)f2bf(dv[t] * rstd * gn * sigmoidf_(og)); }
        } else if (tid < 2 * HD) {
            const int k = tid - HD; float nn = sc[28] * A.st_n[(size_t)sidx * HD + k];
#pragma unroll
            for (int t = 0; t < 4; ++t) nn += sc[24 + t] * sq[512 + t * HD + k];
            A.out[O_NS + (size_t)sidx * HD + k] = nn;
        }
        if (tid == 0) A.out[O_MS + sidx] = sc[29];
    }
}

typedef short bf16x8c __attribute__((ext_vector_type(8)));
__device__ __forceinline__ void phase_cmp2(CArgs& A, int l0, int nl, int r_lo, int nrows, int gw, int NGW, int lane) {
    const int fr = lane & 15, fq = lane >> 4, ntile = nrows / 16;
    for (int task = gw; task < nl * 4 * ntile; task += NGW) {
        const int img = task / ntile, tr = task % ntile, l = l0 + (img >> 2), sg = img & 3, s = sg >> 1, g = sg & 1, R0 = r_lo + tr * 16;
        const bf16* hp = (const bf16*)(A.ws + WS_HID) + ((size_t)(l * 4 + sg) * NCB + R0 + fr) * 256 + 8 * fq;
        const bf16* wp = (const bf16*)(A.ws + WS_W2T) + ((size_t)(l * 2 + s) * 64 + fr) * 256 + 8 * fq;
        f32x4 acc[4];
#pragma unroll
        for (int dt = 0; dt < 4; ++dt) acc[dt] = (f32x4){0.f, 0.f, 0.f, 0.f};
#pragma unroll
        for (int ks = 0; ks < 8; ++ks) {
            const bf16x8c hf = *(const bf16x8c*)(hp + 32 * ks);
#pragma unroll
            for (int dt = 0; dt < 4; ++dt) { const bf16x8c wf = *(const bf16x8c*)(wp + (size_t)dt * 16 * 256 + 32 * ks);
                acc[dt] = s == 0 ? __builtin_amdgcn_mfma_f32_16x16x32_bf16(wf, hf, acc[dt], 0, 0, 0) : __builtin_amdgcn_mfma_f32_16x16x32_bf16(hf, wf, acc[dt], 0, 0, 0); }
        }
        if (s == 0) {
            bf16* o = (bf16*)(A.ws + WS_KC) + ((size_t)(l * 2 + g) * NCB + R0 + fr) * 64 + 4 * fq;
#pragma unroll
            for (int dt = 0; dt < 4; ++dt) { v2u w; w.x = pk2(acc[dt][0], acc[dt][1]); w.y = pk2(acc[dt][2], acc[dt][3]); *(v2u*)(o + 16 * dt) = w; }
        } else {
            bf16* o = (bf16*)(A.ws + WS_VCT) + ((size_t)(l * 2 + g) * 64 + fr) * NCB + R0 + 4 * fq;
#pragma unroll
            for (int dt = 0; dt < 4; ++dt) { v2u w; w.x = pk2(acc[dt][0], acc[dt][1]); w.y = pk2(acc[dt][2], acc[dt][3]); *(v2u*)(o + (size_t)dt * 16 * NCB) = w; }
        }
    }
}

__device__ __forceinline__ void topk_sel(float imp0, float imp1, int cur, int lane, unsigned long long& s0, unsigned long long& s1) {
    const int nforced = cur == 0 ? 1 : (cur == 1 ? 2 : 3), need = 16 - nforced, ncand = cur - 2 > 0 ? cur - 2 : 0;
    const unsigned k0 = (lane >= 1 && lane <= cur - 2) ? __builtin_bit_cast(unsigned, imp0) + 1u : 0u;
    const unsigned k1 = (lane + 64 <= cur - 2) ? __builtin_bit_cast(unsigned, imp1) + 1u : 0u;
    unsigned long long c0, c1;
    if (ncand <= need) { c0 = __ballot(k0 != 0u); c1 = __ballot(k1 != 0u); }
    else {
        unsigned T = 0u;
        for (int bit = 31; bit >= 0; --bit) { const unsigned cand = T | (1u << bit);
            const int cnt = __popcll(__ballot(k0 >= cand)) + __popcll(__ballot(k1 >= cand)); if (cnt >= need) T = cand; }
        const unsigned long long g0 = __ballot(k0 > T), g1 = __ballot(k1 > T); unsigned long long e0 = __ballot(k0 == T), e1 = __ballot(k1 == T);
        int rem = need - __popcll(g0) - __popcll(g1);
        unsigned long long t0 = 0ull, t1 = 0ull;
        while (rem > 0 && e0) { const unsigned long long lb = e0 & (~e0 + 1ull); t0 |= lb; e0 ^= lb; --rem; }
        while (rem > 0 && e1) { const unsigned long long lb = e1 & (~e1 + 1ull); t1 |= lb; e1 ^= lb; --rem; }
        c0 = g0 | t0; c1 = g1 | t1;
    }
    unsigned long long f0 = 1ull, f1 = 0ull;
    if (cur < 64) f0 |= 1ull << cur; else f1 |= 1ull << (cur - 64);
    if (cur >= 1) { if (cur - 1 < 64) f0 |= 1ull << (cur - 1); else f1 |= 1ull << (cur - 65); }
    s0 = c0 | f0; s1 = c1 | f1;
}


typedef short bf16x8 __attribute__((ext_vector_type(8)));
#define MFMA16(a, b, c) __builtin_amdgcn_mfma_f32_16x16x32_bf16((a), (b), (c), 0, 0, 0)
constexpr int TOTS = MP + DB * 2112, TOTW = MP + DB * 528, TOTWP = TOTW + 64;
constexpr size_t KS_L = (size_t)2 * TOTS * 64, KW_L = (size_t)2 * TOTWP * 64, KC_L = (size_t)2 * NCB * 64;

template <int NP>
__device__ __forceinline__ void kv_tile(const float* src, bf16* Kimg, size_t kgs, bf16* Vt, size_t vgs, size_t vpitch, size_t gp0, LAS bf16* scr, int lane) {
    const int cc = 4 * lane, s = cc >> 7, g = (cc >> 6) & 1, d = cc & 63;
#pragma unroll 16
    for (int sl = 0; sl < NP; ++sl) {
        const f32x4 v = *(const f32x4*)(src + (size_t)sl * 256 + cc);
        v2u w; w.x = pk2(v[0], v[1]); w.y = pk2(v[2], v[3]);
        if (s == 0) *(v2u*)(Kimg + (size_t)g * kgs + (gp0 + sl) * 64 + d) = w;
        else *(LAS v2u*)(scr + sl * 128 + (cc - 128)) = w;
    }
    LDS_WAIT();
#pragma unroll
    for (int g2 = 0; g2 < 2; ++g2) {
        const int gd = lane + 64 * g2;
        bf16* dst = Vt + (size_t)g2 * vgs + (size_t)lane * vpitch + gp0;
#pragma unroll
        for (int oc = 0; oc < NP / 8; ++oc) {
            const LAS bf16* p = scr + (8 * oc) * 128 + gd;
            v4u o; o.x = (unsigned)p[0] | ((unsigned)p[128] << 16); o.y = (unsigned)p[256] | ((unsigned)p[384] << 16); o.z = (unsigned)p[512] | ((unsigned)p[640] << 16); o.w = (unsigned)p[768] | ((unsigned)p[896] << 16);
            *(v4u*)(dst + 8 * oc) = o;
        }
    }
    LDS_WAIT();
}
#define kv_tile64 kv_tile<64>

__device__ __forceinline__ void prep_cache_images(CArgs& A, LAS unsigned char* lds, int gw, int NGW, int lane, int wave) {
    LAS bf16* scr = (LAS bf16*)(lds + wave * 16384);
    bf16* KS = (bf16*)(A.ws + WS_KS); bf16* VTS = (bf16*)(A.ws + WS_VTS); bf16* KW = (bf16*)(A.ws + WS_KW); bf16* VTW = (bf16*)(A.ws + WS_VTW);
    for (int it = gw; it < DEPTH * DB * 32; it += NGW) {
        const int ti = it & 31, seq = (it >> 5) & 127, l = it >> 12;
        const int phys = A.page_table[seq * NPG + (ti >> 1)];
        const float* src = A.cache_slc + (((size_t)l * NPHYS + phys) * PAGE + (ti & 1) * 64) * 256;
        kv_tile64(src, KS + l * KS_L, (size_t)TOTS * 64, VTS + l * KS_L, (size_t)64 * TOTS, TOTS, (size_t)MP + seq * 2112 + ti * 64, scr, lane);
    }
    for (int it = gw; it < DEPTH * DB * 8; it += NGW) {
        const int ti = it & 7, ls = it >> 3, seq = ls & 127, l = ls >> 7;
        const float* src = A.cache_win + ((size_t)ls * 512 + ti * 64) * 256;
        kv_tile64(src, KW + l * KW_L, (size_t)TOTWP * 64, VTW + l * KW_L, (size_t)64 * TOTWP, TOTWP, (size_t)MP + seq * 528 + ti * 64, scr, lane);
    }
}
__device__ __forceinline__ void prep_layer_images(CArgs& A, int l, LAS unsigned char* lds, int gw, int NGW, int lane, int wave) {
    LAS bf16* scr = (LAS bf16*)(lds + wave * 16384);
    bf16* KS = (bf16*)(A.ws + WS_KS) + l * KS_L; bf16* VTS = (bf16*)(A.ws + WS_VTS) + l * KS_L; bf16* KW = (bf16*)(A.ws + WS_KW) + l * KW_L; bf16* VTW = (bf16*)(A.ws + WS_VTW) + l * KW_L;
    const float* KVR = (const float*)(A.ws + WS_KVR);
    for (int it = gw; it < 2 * (MP / 16); it += NGW) {
        const int kind = it / (MP / 16), ti = it % (MP / 16);
        const float* src = KVR + ((size_t)(1 + kind) * M + ti * 16) * 256;
        if (kind == 0) kv_tile<16>(src, KS, (size_t)TOTS * 64, VTS, (size_t)64 * TOTS, TOTS, (size_t)ti * 16, scr, lane);
        else           kv_tile<16>(src, KW, (size_t)TOTWP * 64, VTW, (size_t)64 * TOTWP, TOTWP, (size_t)ti * 16, scr, lane);
    }
    for (int it = gw; it < 2 * DB; it += NGW) {
        const int kind = it / DB, seq = it % DB;
        const float* src = KVR + ((size_t)(1 + kind) * M + MP + seq * DS) * 256;
        bf16* Kimg = kind == 0 ? KS : KW; bf16* Vt = kind == 0 ? VTS : VTW;
        const size_t tot = kind == 0 ? TOTS : TOTWP, gp0 = kind == 0 ? (size_t)MP + seq * 2112 + PAST : (size_t)MP + seq * 528 + 512;
        const int cc = 4 * lane, s = cc >> 7, g = (cc >> 6) & 1, d = cc & 63;
#pragma unroll
        for (int t = 0; t < DS; ++t) {
            const f32x4 v = *(const f32x4*)(src + (size_t)t * 256 + cc);
            if (s == 0) { v2u w; w.x = pk2(v[0], v[1]); w.y = pk2(v[2], v[3]); *(v2u*)(Kimg + (size_t)g * tot * 64 + (gp0 + t) * 64 + d) = w; }
            else {
#pragma unroll
                for (int i = 0; i < 4; ++i) Vt[(size_t)g * 64 * tot + (size_t)(d + i) * tot + gp0 + t] = (bf16)f2bf(v[i]);
            }
        }
    }
}

struct KV { bf16x8 k[8]; v4u v[8]; };
__device__ __forceinline__ void k_load(KV& f, const bf16* Kb, int fr, int fq) {
#pragma unroll
    for (int t = 0; t < 4; ++t) { f.k[2 * t] = *(const bf16x8*)(Kb + (size_t)(16 * t + fr) * 64 + 8 * fq); f.k[2 * t + 1] = *(const bf16x8*)(Kb + (size_t)(16 * t + fr) * 64 + 32 + 8 * fq); }
}
__device__ __forceinline__ void v_load(KV& f, const bf16* Vb, size_t pitch, int fr, int fq) {
#pragma unroll
    for (int h = 0; h < 2; ++h)
#pragma unroll
        for (int dt = 0; dt < 4; ++dt) { const bf16* vp = Vb + (size_t)(16 * dt + fr) * pitch + 32 * h + 4 * fq;
            const v2u a = *(const v2u*)vp, b = *(const v2u*)(vp + 16); v4u w; w.x = a.x; w.y = a.y; w.z = b.x; w.w = b.y; f.v[4 * h + dt] = w; }
}
__device__ __forceinline__ void qk_frag(const KV& f, const bf16x8 (&q)[2], f32x4 (&st)[4]) {
#pragma unroll
    for (int t = 0; t < 4; ++t) { f32x4 z = {0.f, 0.f, 0.f, 0.f}; z = MFMA16(f.k[2 * t], q[0], z); st[t] = MFMA16(f.k[2 * t + 1], q[1], z); }
}
__device__ __forceinline__ void pv_frag(const KV& f, const f32x4 (&st)[4], f32x4 (&o)[4]) {
#pragma unroll
    for (int h = 0; h < 2; ++h) {
        v4u pw; pw.x = pk2(st[2 * h][0], st[2 * h][1]); pw.y = pk2(st[2 * h][2], st[2 * h][3]); pw.z = pk2(st[2 * h + 1][0], st[2 * h + 1][1]); pw.w = pk2(st[2 * h + 1][2], st[2 * h + 1][3]);
        const bf16x8 pf = __builtin_bit_cast(bf16x8, pw);
#pragma unroll
        for (int dt = 0; dt < 4; ++dt) o[dt] = MFMA16(__builtin_bit_cast(bf16x8, f.v[4 * h + dt]), pf, o[dt]);
    }
}
__device__ __forceinline__ float xfq_max(float v) { v = fmaxf(v, __shfl_xor(v, 16)); return fmaxf(v, __shfl_xor(v, 32)); }
__device__ __forceinline__ float xfq_sum(float v) { v += __shfl_xor(v, 16); return v + __shfl_xor(v, 32); }
__device__ __forceinline__ float quad_sum(float v) { v += __shfl_xor(v, 1); return v + __shfl_xor(v, 2); }

__device__ __forceinline__ void softmax_pv(const KV& f, f32x4 (&st)[4], f32x4 (&o)[4], float& m, float& ls) {
    float bm = -INFINITY;
#pragma unroll
    for (int t = 0; t < 4; ++t) bm = fmaxf(bm, fmaxf(fmaxf(st[t][0], st[t][1]), fmaxf(st[t][2], st[t][3])));
    bm = xfq_max(bm);
    const float mn = fmaxf(m, bm), sc = __builtin_amdgcn_exp2f(m - mn);
    m = mn; ls *= sc;
#pragma unroll
    for (int dt = 0; dt < 4; ++dt) o[dt] = o[dt] * sc;
#pragma unroll
    for (int t = 0; t < 4; ++t)
#pragma unroll
        for (int i = 0; i < 4; ++i) { const float p = __builtin_amdgcn_exp2f(st[t][i] - mn); st[t][i] = p; ls += p; }
    pv_frag(f, st, o);
}
template <class Br>
__device__ __forceinline__ void run_branch(Br& br, const bf16x8 (&q)[2], int fr, int fq, f32x4 (&o)[4], float& m, float& ls) {
    int j;
    if (!br.first(j)) return;
    KV cur; k_load(cur, br.kp(j), fr, fq); v_load(cur, br.vp(j), br.pitch, fr, fq);
    for (;;) {
        int jn = 0; const bool hn = br.next(jn);
        KV nxt;
        if (hn) { k_load(nxt, br.kp(jn), fr, fq); v_load(nxt, br.vp(jn), br.pitch, fr, fq); }
        f32x4 st[4]; qk_frag(cur, q, st);
        br.mask(st, j);
        softmax_pv(cur, st, o, m, ls);
        if (!hn) break;
        cur = nxt; j = jn;
    }
}
struct BrSel {
    const bf16* K; const bf16* V; size_t pitch; unsigned long long u0, u1, my0, my1; int cur, qpos, fq; const LAS float* bt; float farb;
    __device__ __forceinline__ bool pop(int& j) { if (u0) { j = __builtin_ctzll(u0); u0 &= u0 - 1ull; return true; } if (u1) { j = 64 + __builtin_ctzll(u1); u1 &= u1 - 1ull; return true; } return false; }
    __device__ __forceinline__ bool first(int& j) { return pop(j); }
    __device__ __forceinline__ bool next(int& j) { return pop(j); }
    __device__ __forceinline__ const bf16* kp(int j) const { return K + (size_t)j * 64 * 64; }
    __device__ __forceinline__ const bf16* vp(int j) const { return V + (size_t)j * 64; }
    __device__ __forceinline__ void mask(f32x4 (&st)[4], int j) const {
        const bool mine = j < 64 ? ((my0 >> j) & 1ull) != 0ull : ((my1 >> (j - 64)) & 1ull) != 0ull;
        if (j >= cur - 2) {
#pragma unroll
            for (int t = 0; t < 4; ++t)
#pragma unroll
                for (int i = 0; i < 4; ++i) { const int dist = qpos - (64 * j + 16 * t + 4 * fq + i); st[t][i] = st[t][i] + bt[(!mine || dist < 0) ? 129 : (dist > 128 ? 128 : dist)]; }
        } else {
#pragma unroll
            for (int t = 0; t < 4; ++t)
#pragma unroll
                for (int i = 0; i < 4; ++i) st[t][i] = mine ? st[t][i] + farb : -INFINITY;
        }
    }
};
struct BrWin {
    const bf16* K; const bf16* V; size_t pitch; int jb, cur, qpos, fq; const LAS float* bt;
    __device__ __forceinline__ bool first(int& j) { j = jb; return jb <= cur; }
    __device__ __forceinline__ bool next(int& j) { ++jb; j = jb; return jb <= cur; }
    __device__ __forceinline__ const bf16* kp(int j) const { return K + (long)j * 64 * 64; }
    __device__ __forceinline__ const bf16* vp(int j) const { return V + (long)j * 64; }
    __device__ __forceinline__ void mask(f32x4 (&st)[4], int j) const {
#pragma unroll
        for (int t = 0; t < 4; ++t)
#pragma unroll
            for (int i = 0; i < 4; ++i) { const int dist = qpos - (64 * j + 16 * t + 4 * fq + i); st[t][i] = st[t][i] + bt[(unsigned)dist >= 512u ? 129 : (dist > 128 ? 128 : dist)]; }
    }
};

__device__ __forceinline__ void nsa_tile(CArgs& A, int l, bool smp, int bs, int g, int tq, LAS float* wl, const LAS float* BT, int lane) {
    asm volatile("" : "+v"(lane));
    const int fr = lane & 15, fq = lane >> 4, tl = fr >> 2, rr = fr & 3;
    const int qpos0 = smp ? PAST : 4 * tq, row0 = smp ? MP + bs * DS : bs * SEQ + qpos0;
    const int qpos = qpos0 + tl, cur = qpos0 >> 6, h = g * 4 + rr;
    const size_t sbase = smp ? (size_t)MP + bs * 2112 : (size_t)bs * SEQ;
    const long wbase = smp ? (long)MP + bs * 528 - (PAST - 512) : (long)bs * SEQ;
    const size_t cbase = smp ? (size_t)1024 + bs * 128 : (size_t)bs * 512;
    const bf16* KS = (const bf16*)(A.ws + WS_KS) + l * KS_L + (size_t)g * TOTS * 64; const bf16* VTS = (const bf16*)(A.ws + WS_VTS) + l * KS_L + (size_t)g * 64 * TOTS;
    const bf16* KW = (const bf16*)(A.ws + WS_KW) + l * KW_L + (size_t)g * TOTWP * 64; const bf16* VTW = (const bf16*)(A.ws + WS_VTW) + l * KW_L + (size_t)g * 64 * TOTWP;
    const bf16* KC = (const bf16*)(A.ws + WS_KC) + l * KC_L + (size_t)g * NCB * 64 + cbase * 64; const bf16* VCT = (const bf16*)(A.ws + WS_VCT) + l * KC_L + (size_t)g * 64 * NCB + cbase;
    const LAS float* bt = BT + h * 132;
    const float farb = bt[128];
    bf16x8 q[2];
    {   const bf16* qp = (const bf16*)(A.ws + WS_NQ) + (size_t)(row0 + tl) * 512 + g * 256 + rr * 64 + 8 * fq;
        q[0] = *(const bf16x8*)qp; q[1] = *(const bf16x8*)(qp + 32); }
    const float* gt = (const float*)(A.ws + WS_GATE) + (size_t)(row0 + tl) * 32 + 8 + h * 3;
    const float gc = sigmoidf_(gt[0]), gs = sigmoidf_(gt[1]), gwn = sigmoidf_(gt[2]);
    f32x4 out[4];
#pragma unroll
    for (int dt = 0; dt < 4; ++dt) out[dt] = (f32x4){0.f, 0.f, 0.f, 0.f};
    LAS float* impA = wl;
    LAS float* impB = wl + 544;
    for (int i = lane; i < 1088; i += 64) wl[i] = 0.f;
    LDS_WAIT();

    {
        const int ncv_max = qpos0 + 3 >= 31 ? ((qpos0 + 3 - 31) >> 4) + 1 : 0, nb64 = (ncv_max + 63) >> 6;
        float m = -1.0e30f, ls = 0.f;
        {
            for (int ib = 0; ib < nb64; ++ib) {
                KV cur; k_load(cur, KC + (size_t)ib * 64 * 64, fr, fq);
                f32x4 st[4]; qk_frag(cur, q, st);
                float bm = -INFINITY;
#pragma unroll
                for (int t = 0; t < 4; ++t)
#pragma unroll
                    for (int i = 0; i < 4; ++i) { const int n = 64 * ib + 16 * t + 4 * fq + i; const int dist = qpos - 16 * n - 31;
                        const float s = st[t][i] + bt[dist < 0 ? 129 : (dist > 128 ? 128 : dist)]; st[t][i] = s; bm = fmaxf(bm, s); }
                bm = xfq_max(bm);
                const float mn = fmaxf(m, bm); ls *= __builtin_amdgcn_exp2f(m - mn); m = mn;
#pragma unroll
                for (int t = 0; t < 4; ++t)
#pragma unroll
                    for (int i = 0; i < 4; ++i) ls += __builtin_amdgcn_exp2f(st[t][i] - mn);
            }
        }
        ls = xfq_sum(ls);
        const float inv = ls > 0.f ? 1.f / ls : 0.f;
        f32x4 o[4];
#pragma unroll
        for (int dt = 0; dt < 4; ++dt) o[dt] = (f32x4){0.f, 0.f, 0.f, 0.f};
        {
            for (int ib = 0; ib < nb64; ++ib) {
                KV cur; k_load(cur, KC + (size_t)ib * 64 * 64, fr, fq); v_load(cur, VCT + ib * 64, NCB, fr, fq);
                f32x4 st[4]; qk_frag(cur, q, st);
#pragma unroll
                for (int t = 0; t < 4; ++t) {
#pragma unroll
                    for (int i = 0; i < 4; ++i) { const int n = 64 * ib + 16 * t + 4 * fq + i; const int dist = qpos - 16 * n - 31;
                        st[t][i] = __builtin_amdgcn_exp2f(st[t][i] + bt[dist < 0 ? 129 : (dist > 128 ? 128 : dist)] - m) * inv; }
                    const float s4 = quad_sum((st[t][0] + st[t][1]) + (st[t][2] + st[t][3])), s3 = quad_sum(st[t][3]);
                    const int j0 = 16 * ib + 4 * t + fq;
                    if (rr == 0) { impA[tl * 136 + j0] = s4; impB[tl * 136 + j0 + 1] = s3; }
                }
                pv_frag(cur, st, o);
            }
        }
#pragma unroll
        for (int dt = 0; dt < 4; ++dt) out[dt] = out[dt] + o[dt] * gc;
    }
    LDS_WAIT();
    unsigned long long s0[4], s1[4];
#pragma unroll
    for (int t = 0; t < 4; ++t) topk_sel(impA[t * 136 + lane] + impB[t * 136 + lane], impA[t * 136 + 64 + lane] + impB[t * 136 + 64 + lane], cur, lane, s0[t], s1[t]);
    {
        float m = -1.0e30f, ls = 0.f; f32x4 o[4];
#pragma unroll
        for (int dt = 0; dt < 4; ++dt) o[dt] = (f32x4){0.f, 0.f, 0.f, 0.f};
        BrSel br{KS + sbase * 64, VTS + sbase, (size_t)TOTS, (s0[0] | s0[1]) | (s0[2] | s0[3]), (s1[0] | s1[1]) | (s1[2] | s1[3]),
                 tl == 0 ? s0[0] : (tl == 1 ? s0[1] : (tl == 2 ? s0[2] : s0[3])), tl == 0 ? s1[0] : (tl == 1 ? s1[1] : (tl == 2 ? s1[2] : s1[3])), cur, qpos, fq, bt, farb};
        run_branch(br, q, fr, fq, o, m, ls);
        ls = xfq_sum(ls);
        const float w = ls > 0.f ? gs / ls : 0.f;
#pragma unroll
        for (int dt = 0; dt < 4; ++dt) out[dt] = out[dt] + o[dt] * w;
    }
    {
        float m = -1.0e30f, ls = 0.f; f32x4 o[4];
#pragma unroll
        for (int dt = 0; dt < 4; ++dt) o[dt] = (f32x4){0.f, 0.f, 0.f, 0.f};
        const int lo_blk = smp ? (PAST - 512) >> 6 : 0; int jb = (qpos0 - 511) >> 6; if (jb < lo_blk) jb = lo_blk;
        BrWin br{KW + wbase * 64, VTW + wbase, (size_t)TOTWP, jb, cur, qpos, fq, bt};
        run_branch(br, q, fr, fq, o, m, ls);
        ls = xfq_sum(ls);
        const float w = ls > 0.f ? gwn / ls : 0.f;
#pragma unroll
        for (int dt = 0; dt < 4; ++dt) out[dt] = out[dt] + o[dt] * w;
    }
    bf16* mp = (bf16*)(A.ws + WS_MIX) + (size_t)(row0 + tl) * D + 512 + h * 64 + 4 * fq;
#pragma unroll
    for (int dt = 0; dt < 4; ++dt) { v2u w; w.x = pk2(out[dt][0], out[dt][1]); w.y = pk2(out[dt][2], out[dt][3]); *(v2u*)(mp + 16 * dt) = w; }
}
__device__ __forceinline__ void phase_nsa(CArgs& A, int l, LAS float* wl, const LAS float* BT, int lane, int wave) {
    const int G = gridDim.x, bx = blockIdx.x;
    const bool xmap = (G & 7) == 0;
    const int x = bx & 7, nw = (G >> 3) * NWAVES, ww = (bx >> 3) * NWAVES + wave;
    const int gwv = bx * NWAVES + wave, ngw = G * NWAVES;
    for (int it = 0;; ++it) {
        bool smp; int bs, g, tq;
        if (xmap) {
            const int np = ww < 512 ? 2 * ((512 - ww + nw - 1) / nw) : 0;
            if (it < np) { const int i = ww + nw * (it >> 1), tq2 = (it & 1) ? 1023 - i : i; smp = false; bs = x >> 2; g = (x >> 1) & 1; tq = 2 * tq2 + (x & 1); }
            else { const int t = ww * 8 + x + 8 * nw * (it - np); if (t >= 2 * DB) break; smp = true; bs = t >> 1; g = t & 1; tq = 0; }
        } else {
            const int t = gwv + ngw * it; if (t >= 4 * 2048 + 2 * DB) break;
            if (t < 4 * 2048) { smp = false; bs = t >> 12; g = (t >> 11) & 1; tq = t & 2047; } else { smp = true; bs = (t - 4 * 2048) >> 1; g = t & 1; tq = 0; }
        }
        nsa_tile(A, l, smp, bs, g, tq, wl, BT, lane);
    }
}

__device__ __forceinline__ void phase_m2x(CArgs& A, int l, LAS unsigned char* lds, int tid) {
    LAS float* buf = (LAS float*)lds;
    LAS float* wl = (LAS float*)(lds + 1024);
    LAS float* red = (LAS float*)(lds + 2048);
    LAS bf16* kt = (LAS bf16*)(lds + 8192);
    LAS bf16* vt = (LAS bf16*)(lds + 8192 + 34816);
    const bf16* QKVO = (const bf16*)(A.ws + WS_QKVO);
    const int lane = tid & 63, wave = tid >> 6, fr = lane & 15, fq = lane >> 4;
    for (int unit = blockIdx.x; unit < NUNIT; unit += gridDim.x) {
        const int b = unit >> 7, h = (unit >> 5) & 3, c = unit & 31, r0 = b * SEQ + c * LCH;
        float ig = 0.f, lf = 0.f;
        if (tid < 256) ml_gates(A, l, r0 + tid, h, ig, lf);
        const float F = scan_sum256(lf, buf, tid);
        __syncthreads();
        if (tid == 255) buf[16] = F;
        __syncthreads();
        const float Fend = buf[16];
        const float gl = tid < 256 ? Fend - F + ig : -3.0e38f;
        const float mw = wave_max(gl);
        if (lane == 0) buf[20 + wave] = mw;
        __syncthreads();
        const float mloc = fmaxf(fmaxf(buf[20], buf[21]), fmaxf(buf[22], buf[23]));
        if (tid < 256) wl[tid] = __expf(gl - mloc);
        if (tid == 0) { float* ch = (float*)(A.ws + WS_CHS) + unit * 4; ch[0] = Fend; ch[1] = mloc; }
        f32x4 acc[8];
#pragma unroll
        for (int kt_ = 0; kt_ < 8; ++kt_) acc[kt_] = (f32x4){0.f, 0.f, 0.f, 0.f};
        float dnp = 0.f;
        for (int half = 0; half < 2; ++half) {
            __syncthreads();
            for (int i = tid; i < 4096; i += NTHR) { const int which = i >> 11, oc = (i >> 7) & 15, s = i & 127;
                const v4u x = *(const v4u*)(QKVO + (size_t)(r0 + 128 * half + s) * 2048 + (which ? 1024 : 512) + h * HD + 8 * oc);
                LAS bf16* dst = (which ? vt : kt) + (8 * oc) * 136 + s;
                dst[0] = (bf16)x.x; dst[136] = (bf16)(x.x >> 16); dst[272] = (bf16)x.y; dst[408] = (bf16)(x.y >> 16); dst[544] = (bf16)x.z; dst[680] = (bf16)(x.z >> 16); dst[816] = (bf16)x.w; dst[952] = (bf16)(x.w >> 16); }
            __syncthreads();
#pragma unroll
            for (int ks = 0; ks < 4; ++ks) {
                const int s0 = 32 * ks + 8 * fq;
                const v4u xv = *(const LAS v4u*)(vt + (16 * wave + fr) * 136 + s0);
                const f32x4 w0 = *(const LAS f32x4*)(wl + 128 * half + s0), w1 = *(const LAS f32x4*)(wl + 128 * half + s0 + 4);
                v4u av; av.x = pk2(bflo(xv.x) * w0[0], bfhi(xv.x) * w0[1]); av.y = pk2(bflo(xv.y) * w0[2], bfhi(xv.y) * w0[3]); av.z = pk2(bflo(xv.z) * w1[0], bfhi(xv.z) * w1[1]); av.w = pk2(bflo(xv.w) * w1[2], bfhi(xv.w) * w1[3]);
                const bf16x8 af = __builtin_bit_cast(bf16x8, av);
#pragma unroll
                for (int kt_ = 0; kt_ < 8; ++kt_) { const bf16x8 bfr = *(const LAS bf16x8*)(kt + (16 * kt_ + fr) * 136 + s0); acc[kt_] = MFMA16(af, bfr, acc[kt_]); }
            }
            {   const int k = tid & 127, q = tid >> 7;
#pragma unroll
                for (int e = 0; e < 4; ++e) { const v4u x = *(const LAS v4u*)(kt + k * 136 + 32 * q + 8 * e); const LAS float* w = wl + 128 * half + 32 * q + 8 * e;
                    dnp += bflo(x.x) * w[0] + bfhi(x.x) * w[1] + bflo(x.y) * w[2] + bfhi(x.y) * w[3] + bflo(x.z) * w[4] + bfhi(x.z) * w[5] + bflo(x.w) * w[6] + bfhi(x.w) * w[7]; } }
        }
        float* dct = (float*)(A.ws + WS_DCT) + ((size_t)unit * HD + 16 * wave + 4 * fq) * HD + fr;
#pragma unroll
        for (int kt_ = 0; kt_ < 8; ++kt_)
#pragma unroll
            for (int i = 0; i < 4; ++i) dct[(size_t)i * HD + 16 * kt_] = acc[kt_][i];
        red[(tid >> 7) * 128 + (tid & 127)] = dnp;
        __syncthreads();
        if (tid < HD) ((float*)(A.ws + WS_DN))[unit * HD + tid] = (red[tid] + red[128 + tid]) + (red[256 + tid] + red[384 + tid]);
        __syncthreads();
    }
}

__device__ __forceinline__ void phase_m4x(CArgs& A, int l, LAS unsigned char* lds, int tid) {
    LAS float* buf = (LAS float*)lds;
    LAS float* sa = (LAS float*)(lds + 1024);
    LAS float* smx = sa + 256;
    LAS float* sdec = smx + 256;
    LAS float* sem = sdec + 256;
    LAS bf16* vt = (LAS bf16*)(lds + 8192);
    const bf16* QKVO = (const bf16*)(A.ws + WS_QKVO);
    const int lane = tid & 63, wave = tid >> 6, fr = lane & 15, fq = lane >> 4;
    for (int unit = blockIdx.x; unit < NUNIT; unit += gridDim.x) {
        const int b = unit >> 7, h = (unit >> 5) & 3, c = unit & 31, r0 = b * SEQ + c * LCH;
        float ig = 0.f, lf = 0.f;
        if (tid < 256) ml_gates(A, l, r0 + tid, h, ig, lf);
        const float F = scan_sum256(lf, buf, tid);
        const float a = tid < 256 ? ig - F : -3.0e38f;
        const float cm = scan_max256(a, buf, tid);
        const float m0 = ((const float*)(A.ws + WS_CHS))[unit * 4 + 2];
        if (tid < 256) { const float mx = fmaxf(m0, cm); sa[tid] = a; smx[tid] = mx; sdec[tid] = __expf(m0 - mx); sem[tid] = __expf(-(F + mx)); }
        for (int i = tid; i < 4096; i += NTHR) { const int oc = i >> 8, s = i & 255;
            const v4u x = *(const v4u*)(QKVO + (size_t)(r0 + s) * 2048 + 1024 + h * HD + 8 * oc);
            LAS bf16* dst = vt + (8 * oc) * 264 + s;
            dst[0] = (bf16)x.x; dst[264] = (bf16)(x.x >> 16); dst[528] = (bf16)x.y; dst[792] = (bf16)(x.y >> 16); dst[1056] = (bf16)x.z; dst[1320] = (bf16)(x.z >> 16); dst[1584] = (bf16)x.w; dst[1848] = (bf16)(x.w >> 16); }
        __syncthreads();
        const bf16* ctp = (const bf16*)(A.ws + WS_CTP) + (size_t)unit * HD * HD;
        const float* npv = (const float*)(A.ws + WS_NPV) + unit * HD;
        for (int pass = 0; pass < 2; ++pass) {
            const int sub = pass == 0 ? wave : 15 - wave, t0 = 16 * sub, t = t0 + fr;
            const float mxt = smx[t], dect = sdec[t], emt = sem[t];
            bf16x8 qf[4];
#pragma unroll
            for (int kk = 0; kk < 4; ++kk) qf[kk] = *(const bf16x8*)(QKVO + (size_t)(r0 + t) * 2048 + h * HD + 32 * kk + 8 * fq);
            f32x4 ah[8], ac[8];
#pragma unroll
            for (int v = 0; v < 8; ++v) { ah[v] = (f32x4){0.f, 0.f, 0.f, 0.f}; ac[v] = (f32x4){0.f, 0.f, 0.f, 0.f}; }
            float den = 0.f;
            const int nblk = (t0 + 47) >> 5;
            for (int ib = 0; ib < nblk; ++ib) {
                const int s0 = 32 * ib;
                f32x4 st[2];
#pragma unroll
                for (int j = 0; j < 2; ++j) {
                    f32x4 z = {0.f, 0.f, 0.f, 0.f};
                    const bf16* kp = QKVO + (size_t)(r0 + s0 + 16 * j + fr) * 2048 + 512 + h * HD + 8 * fq;
#pragma unroll
                    for (int kk = 0; kk < 4; ++kk) z = MFMA16(*(const bf16x8*)(kp + 32 * kk), qf[kk], z);
                    const f32x4 a4 = *(const LAS f32x4*)(sa + s0 + 16 * j + 4 * fq);
#pragma unroll
                    for (int i = 0; i < 4; ++i) { const float w = (s0 + 16 * j + 4 * fq + i <= t) ? z[i] * __expf(a4[i] - mxt) : 0.f; z[i] = w; den += w; }
                    st[j] = z;
                }
                v4u pw; pw.x = pk2(st[0][0], st[0][1]); pw.y = pk2(st[0][2], st[0][3]); pw.z = pk2(st[1][0], st[1][1]); pw.w = pk2(st[1][2], st[1][3]);
                const bf16x8 pf = __builtin_bit_cast(bf16x8, pw);
#pragma unroll
                for (int v = 0; v < 8; ++v) { const LAS bf16* vp = vt + (16 * v + fr) * 264 + s0 + 4 * fq;
                    const v2u x = *(const LAS v2u*)vp, y = *(const LAS v2u*)(vp + 16);
                    v4u vw; vw.x = x.x; vw.y = x.y; vw.z = y.x; vw.w = y.y;
                    ah[v] = MFMA16(__builtin_bit_cast(bf16x8, vw), pf, ah[v]); }
            }
            float qn = 0.f;
#pragma unroll
            for (int kk = 0; kk < 4; ++kk) {
                const v4u qx = __builtin_bit_cast(v4u, qf[kk]); const f32x4 n0 = *(const f32x4*)(npv + 32 * kk + 8 * fq), n1 = *(const f32x4*)(npv + 32 * kk + 8 * fq + 4);
                qn += bflo(qx.x) * n0[0] + bfhi(qx.x) * n0[1] + bflo(qx.y) * n0[2] + bfhi(qx.y) * n0[3] + bflo(qx.z) * n1[0] + bfhi(qx.z) * n1[1] + bflo(qx.w) * n1[2] + bfhi(qx.w) * n1[3];
#pragma unroll
                for (int v = 0; v < 8; ++v) ac[v] = MFMA16(*(const bf16x8*)(ctp + (size_t)(16 * v + fr) * HD + 32 * kk + 8 * fq), qf[kk], ac[v]);
            }
            const float dent = xfq_sum(den) + dect * xfq_sum(qn);
            const float rden = 1.f / fmaxf(fabsf(dent), emt);
            float s1 = 0.f;
#pragma unroll
            for (int v = 0; v < 8; ++v) { ah[v] = (ah[v] + ac[v] * dect) * rden; s1 += (ah[v][0] + ah[v][1]) + (ah[v][2] + ah[v][3]); }
            const float mu = xfq_sum(s1) * (1.f / HD);
            float s2 = 0.f;
#pragma unroll
            for (int v = 0; v < 8; ++v) { ah[v] = ah[v] - mu; s2 += (ah[v][0] * ah[v][0] + ah[v][1] * ah[v][1]) + (ah[v][2] * ah[v][2] + ah[v][3] * ah[v][3]); }
            const float rstd = 1.f / sqrtf(xfq_sum(s2) * (1.f / HD) + LN_EPS);
            const bf16* op = QKVO + (size_t)(r0 + t) * 2048 + 1536 + h * HD + 4 * fq;
            bf16* mp = (bf16*)(A.ws + WS_MIX) + (size_t)(r0 + t) * D + h * HD + 4 * fq;
            const float* gp = A.ml_norm_g + l * 512 + h * HD + 4 * fq;
#pragma unroll
            for (int v = 0; v < 8; ++v) { const v2u og = *(const v2u*)(op + 16 * v); const f32x4 gn = *(const f32x4*)(gp + 16 * v);
                v2u w; w.x = pk2(ah[v][0] * rstd * gn[0] * sigmoidf_(bflo(og.x)), ah[v][1] * rstd * gn[1] * sigmoidf_(bfhi(og.x)));
                w.y = pk2(ah[v][2] * rstd * gn[2] * sigmoidf_(bflo(og.y)), ah[v][3] * rstd * gn[3] * sigmoidf_(bfhi(og.y)));
                *(v2u*)(mp + 16 * v) = w; }
        }
        __syncthreads();
    }
}

constexpr int SKP = 72;
constexpr int NG_KB = 0, NG_IMP = 2 * 4 * 64 * SKP * 2, NG_BT = NG_IMP + NWAVES * 1088 * 4, NG_MSK = NG_BT + 8 * 132 * 4, NG_TASK = NG_MSK + NWAVES * 16, NG_JL = NG_TASK + 16, NG_END = NG_JL + 136 * 4;
static_assert(NG_END <= RING_BYTES, "NSA LDS map");
constexpr int CW_NSAQ = 8192;

__device__ __forceinline__ v4u stage_issue(const bf16* src, unsigned pitch, int tid) { const unsigned off = (unsigned)(tid >> 3) * pitch + (unsigned)(tid & 7) * 8u; return *(const v4u*)(src + off); }
__device__ __forceinline__ void stage_commit(LAS bf16* buf, const v4u& r, int tid) { *(LAS v4u*)(buf + (tid >> 3) * SKP + (tid & 7) * 8) = r; }
__device__ __forceinline__ void qk_lds(const LAS bf16* kb, const bf16x8 (&q)[2], int fr, int fq, f32x4 (&st)[4]) {
#pragma unroll
    for (int t = 0; t < 4; ++t) { const LAS bf16* p = kb + (16 * t + fr) * SKP + 8 * fq;
        f32x4 z = {0.f, 0.f, 0.f, 0.f}; z = MFMA16(*(const LAS bf16x8*)p, q[0], z); st[t] = MFMA16(*(const LAS bf16x8*)(p + 32), q[1], z); }
}
__device__ __forceinline__ void pv_lds(const LAS bf16* vb, int fr, int fq, const f32x4 (&st)[4], f32x4 (&o)[4]) {
#pragma unroll
    for (int h = 0; h < 2; ++h) {
        v4u pw; pw.x = pk2(st[2 * h][0], st[2 * h][1]); pw.y = pk2(st[2 * h][2], st[2 * h][3]); pw.z = pk2(st[2 * h + 1][0], st[2 * h + 1][1]); pw.w = pk2(st[2 * h + 1][2], st[2 * h + 1][3]);
        const bf16x8 pf = __builtin_bit_cast(bf16x8, pw);
#pragma unroll
        for (int dt = 0; dt < 4; ++dt) { const LAS bf16* p = vb + (16 * dt + fr) * SKP + 32 * h + 4 * fq;
            const v2u a = *(const LAS v2u*)p, b = *(const LAS v2u*)(p + 16); v4u w; w.x = a.x; w.y = a.y; w.z = b.x; w.w = b.y;
            o[dt] = MFMA16(__builtin_bit_cast(bf16x8, w), pf, o[dt]); }
    }
}
__device__ __forceinline__ void softmax_pv_lds(const LAS bf16* vb, int fr, int fq, f32x4 (&st)[4], float c, f32x4 (&o)[4], float& m, float& ls) {
    float bm = fmaxf(fmaxf(st[0][0], st[0][1]), fmaxf(st[0][2], st[0][3]));
#pragma unroll
    for (int t = 1; t < 4; ++t) bm = fmaxf(bm, fmaxf(fmaxf(st[t][0], st[t][1]), fmaxf(st[t][2], st[t][3])));
    bm = xfq_max(bm + c);
    if (__any(bm > m)) {
        const float mn = fmaxf(m, bm), sc = __builtin_amdgcn_exp2f(m - mn);
        m = mn; ls *= sc;
#pragma unroll
        for (int dt = 0; dt < 4; ++dt) o[dt] = o[dt] * sc;
    }
    const float d = c - m;
#pragma unroll
    for (int t = 0; t < 4; ++t)
#pragma unroll
        for (int i = 0; i < 4; ++i) { const float p = __builtin_amdgcn_exp2f(st[t][i] + d); st[t][i] = p; ls += p; }
    pv_lds(vb, fr, fq, st, o);
}

template <bool HASK, bool HASV, class Addr, class Body>
__device__ __forceinline__ void staged_sweep2(int n, const Addr& ad, Body& body, LAS bf16* sbuf, int tid) {
    if (n <= 0) return;
    constexpr int BLK = 64 * SKP, SET = 4 * BLK;
    {   v4u k0, k1, v0, v1;
        if (HASK) { k0 = ad.k(0, tid); if (1 < n) k1 = ad.k(1, tid); }
        if (HASV) { v0 = ad.v(0, tid); if (1 < n) v1 = ad.v(1, tid); }
        if (HASK) { stage_commit(sbuf, k0, tid); if (1 < n) stage_commit(sbuf + BLK, k1, tid); }
        if (HASV) { stage_commit(sbuf + 2 * BLK, v0, tid); if (1 < n) stage_commit(sbuf + 3 * BLK, v1, tid); } }
    __syncthreads();
    const int nstep = (n + 1) >> 1;
    for (int s = 0; s < nstep; ++s) {
        const int i0 = 2 * s, i2 = i0 + 2, i3 = i0 + 3;
        v4u k0, k1, v0, v1;
        if (i2 < n) { if (HASK) k0 = ad.k(i2, tid); if (HASV) v0 = ad.v(i2, tid); }
        if (i3 < n) { if (HASK) k1 = ad.k(i3, tid); if (HASV) v1 = ad.v(i3, tid); }
        LAS bf16* cur = sbuf + (s & 1) * SET; LAS bf16* nxt = sbuf + ((s & 1) ^ 1) * SET;
        body(i0, cur, cur + 2 * BLK);
        if (i0 + 1 < n) body(i0 + 1, cur + BLK, cur + 3 * BLK);
        if (i2 < n) { if (HASK) stage_commit(nxt, k0, tid); if (HASV) stage_commit(nxt + 2 * BLK, v0, tid); }
        if (i3 < n) { if (HASK) stage_commit(nxt + BLK, k1, tid); if (HASV) stage_commit(nxt + 3 * BLK, v1, tid); }
        __syncthreads();
    }
}
struct AdLin {
    const bf16* K; const bf16* V; unsigned vpitch;
    __device__ __forceinline__ v4u k(int i, int tid) const { return stage_issue(K + (size_t)i * 64 * 64, 64, tid); }
    __device__ __forceinline__ v4u v(int i, int tid) const { return stage_issue(V + (size_t)i * 64, vpitch, tid); }
};
struct AdList {
    const bf16* K; const bf16* V; unsigned vpitch; const LAS int* jl;
    __device__ __forceinline__ v4u k(int i, int tid) const { const int j = __builtin_amdgcn_readfirstlane(jl[i]); return stage_issue(K + (size_t)j * 64 * 64, 64, tid); }
    __device__ __forceinline__ v4u v(int i, int tid) const { const int j = __builtin_amdgcn_readfirstlane(jl[i]); return stage_issue(V + (size_t)j * 64, vpitch, tid); }
};
struct TileCtx { int fr, fq, qposA, qposB, qpos0, cur; const LAS float* bt; float farb; };
struct KF { bf16x8 k[8]; };
struct VF { v4u v[8]; };
__device__ __forceinline__ void kf_load(KF& f, const LAS bf16* kb, int fr, int fq) {
#pragma unroll
    for (int t = 0; t < 4; ++t) { const LAS bf16* p = kb + (16 * t + fr) * SKP + 8 * fq; f.k[2 * t] = *(const LAS bf16x8*)p; f.k[2 * t + 1] = *(const LAS bf16x8*)(p + 32); }
}
__device__ __forceinline__ void vf_load(VF& f, const LAS bf16* vb, int fr, int fq) {
#pragma unroll
    for (int h = 0; h < 2; ++h)
#pragma unroll
        for (int dt = 0; dt < 4; ++dt) { const LAS bf16* p = vb + (16 * dt + fr) * SKP + 32 * h + 4 * fq;
            const v2u a = *(const LAS v2u*)p, b = *(const LAS v2u*)(p + 16); v4u w; w.x = a.x; w.y = a.y; w.z = b.x; w.w = b.y; f.v[4 * h + dt] = w; }
}
__device__ __forceinline__ void qk2(const KF& f, const bf16x8 (&qa)[2], const bf16x8 (&qb)[2], f32x4 (&sa)[4], f32x4 (&sb)[4]) {
#pragma unroll
    for (int t = 0; t < 4; ++t) { const f32x4 z = {0.f, 0.f, 0.f, 0.f};
        sa[t] = MFMA16(f.k[2 * t + 1], qa[1], MFMA16(f.k[2 * t], qa[0], z)); sb[t] = MFMA16(f.k[2 * t + 1], qb[1], MFMA16(f.k[2 * t], qb[0], z)); }
}
__device__ __forceinline__ void pv2(const VF& f, const f32x4 (&sa)[4], const f32x4 (&sb)[4], f32x4 (&oa)[4], f32x4 (&ob)[4]) {
#pragma unroll
    for (int h = 0; h < 2; ++h) {
        v4u pa, pb;
        pa.x = pk2(sa[2 * h][0], sa[2 * h][1]); pa.y = pk2(sa[2 * h][2], sa[2 * h][3]); pa.z = pk2(sa[2 * h + 1][0], sa[2 * h + 1][1]); pa.w = pk2(sa[2 * h + 1][2], sa[2 * h + 1][3]);
        pb.x = pk2(sb[2 * h][0], sb[2 * h][1]); pb.y = pk2(sb[2 * h][2], sb[2 * h][3]); pb.z = pk2(sb[2 * h + 1][0], sb[2 * h + 1][1]); pb.w = pk2(sb[2 * h + 1][2], sb[2 * h + 1][3]);
        const bf16x8 fa = __builtin_bit_cast(bf16x8, pa), fb = __builtin_bit_cast(bf16x8, pb);
#pragma unroll
        for (int dt = 0; dt < 4; ++dt) { const bf16x8 vv = __builtin_bit_cast(bf16x8, f.v[4 * h + dt]); oa[dt] = MFMA16(vv, fa, oa[dt]); ob[dt] = MFMA16(vv, fb, ob[dt]); }
    }
}
__device__ __forceinline__ float max16(const f32x4 (&st)[4]) {
    float bm = fmaxf(fmaxf(st[0][0], st[0][1]), fmaxf(st[0][2], st[0][3]));
#pragma unroll
    for (int t = 1; t < 4; ++t) bm = fmaxf(bm, fmaxf(fmaxf(st[t][0], st[t][1]), fmaxf(st[t][2], st[t][3])));
    return bm;
}
__device__ __forceinline__ void softmax_pv2(const LAS bf16* vb, int fr, int fq, f32x4 (&sa)[4], f32x4 (&sb)[4], float ca, float cb, f32x4 (&oa)[4], f32x4 (&ob)[4], float (&m)[2], float (&ls)[2]) {
    float ba = max16(sa) + ca, bb = max16(sb) + cb;
    ba = fmaxf(ba, __shfl_xor(ba, 16)); bb = fmaxf(bb, __shfl_xor(bb, 16)); ba = fmaxf(ba, __shfl_xor(ba, 32)); bb = fmaxf(bb, __shfl_xor(bb, 32));
    const float ma = fmaxf(m[0], ba), mb = fmaxf(m[1], bb), xa = __builtin_amdgcn_exp2f(m[0] - ma), xb = __builtin_amdgcn_exp2f(m[1] - mb);
    m[0] = ma; m[1] = mb; ls[0] *= xa; ls[1] *= xb;
#pragma unroll
    for (int dt = 0; dt < 4; ++dt) { oa[dt] = oa[dt] * xa; ob[dt] = ob[dt] * xb; }
    const float da = ca - ma, db = cb - mb;
#pragma unroll
    for (int t = 0; t < 4; ++t)
#pragma unroll
        for (int i = 0; i < 4; ++i) { const float pa = __builtin_amdgcn_exp2f(sa[t][i] + da), pb = __builtin_amdgcn_exp2f(sb[t][i] + db); sa[t][i] = pa; sb[t][i] = pb; ls[0] += pa; ls[1] += pb; }
    VF vf; vf_load(vf, vb, fr, fq);
    pv2(vf, sa, sb, oa, ob);
}
__device__ __forceinline__ void qk1(const KF& f, const bf16x8 (&q)[2], f32x4 (&st)[4]) {
#pragma unroll
    for (int t = 0; t < 4; ++t) { const f32x4 z = {0.f, 0.f, 0.f, 0.f}; st[t] = MFMA16(f.k[2 * t + 1], q[1], MFMA16(f.k[2 * t], q[0], z)); }
}
__device__ __forceinline__ void softmax_pv1(const LAS bf16* vb, int fr, int fq, f32x4 (&st)[4], float c, f32x4 (&o)[4], float& m, float& ls) {
    float bm = max16(st) + c;
    bm = fmaxf(bm, __shfl_xor(bm, 16)); bm = fmaxf(bm, __shfl_xor(bm, 32));
    const float mn = fmaxf(m, bm), x = __builtin_amdgcn_exp2f(m - mn);
    m = mn; ls *= x;
#pragma unroll
    for (int dt = 0; dt < 4; ++dt) o[dt] = o[dt] * x;
    const float d = c - mn;
#pragma unroll
    for (int t = 0; t < 4; ++t)
#pragma unroll
        for (int i = 0; i < 4; ++i) { const float p = __builtin_amdgcn_exp2f(st[t][i] + d); st[t][i] = p; ls += p; }
    pv_lds(vb, fr, fq, st, o);
}
struct BodyCmpStat2 {
    const bf16x8 (&qa)[2]; const bf16x8 (&qb)[2]; const TileCtx& c; float (&ml)[2]; float (&lsl)[2];
    __device__ __forceinline__ void operator()(int ib, const LAS bf16* kb, const LAS bf16*) {
        KF kf; kf_load(kf, kb, c.fr, c.fq);
        f32x4 sa[4], sb[4]; qk2(kf, qa, qb, sa, sb);
        if (c.qpos0 - 16 * (64 * ib + 63) - 31 >= 128) {
#pragma unroll
            for (int t = 0; t < 4; ++t) { sa[t] = sa[t] + c.farb; sb[t] = sb[t] + c.farb; }
        } else {
#pragma unroll
            for (int t = 0; t < 4; ++t)
#pragma unroll
                for (int i = 0; i < 4; ++i) { const int n = 64 * ib + 16 * t + 4 * c.fq + i; const int da = c.qposA - 16 * n - 31, db = c.qposB - 16 * n - 31;
                    sa[t][i] += c.bt[da < 0 ? 129 : (da > 128 ? 128 : da)]; sb[t][i] += c.bt[db < 0 ? 129 : (db > 128 ? 128 : db)]; }
        }
        const float ma = fmaxf(ml[0], max16(sa)), mb = fmaxf(ml[1], max16(sb));
        lsl[0] *= __builtin_amdgcn_exp2f(ml[0] - ma); lsl[1] *= __builtin_amdgcn_exp2f(ml[1] - mb); ml[0] = ma; ml[1] = mb;
#pragma unroll
        for (int t = 0; t < 4; ++t)
#pragma unroll
            for (int i = 0; i < 4; ++i) { lsl[0] += __builtin_amdgcn_exp2f(sa[t][i] - ma); lsl[1] += __builtin_amdgcn_exp2f(sb[t][i] - mb); }
    }
};
struct BodyCmpProb2 {
    const bf16x8 (&qa)[2]; const bf16x8 (&qb)[2]; const TileCtx& c; f32x4 (&oa)[4]; f32x4 (&ob)[4]; float m0, m1, inv0, inv1; LAS float* imp; int tl, rr;
    __device__ __forceinline__ void operator()(int ib, const LAS bf16* kb, const LAS bf16* vb) {
        KF kf; kf_load(kf, kb, c.fr, c.fq);
        f32x4 sa[4], sb[4]; qk2(kf, qa, qb, sa, sb);
        if (c.qpos0 - 16 * (64 * ib + 63) - 31 >= 128) {
            const float da = c.farb - m0, db = c.farb - m1;
#pragma unroll
            for (int t = 0; t < 4; ++t)
#pragma unroll
                for (int i = 0; i < 4; ++i) { sa[t][i] = __builtin_amdgcn_exp2f(sa[t][i] + da) * inv0; sb[t][i] = __builtin_amdgcn_exp2f(sb[t][i] + db) * inv1; }
        } else {
#pragma unroll
            for (int t = 0; t < 4; ++t)
#pragma unroll
                for (int i = 0; i < 4; ++i) { const int n = 64 * ib + 16 * t + 4 * c.fq + i; const int da = c.qposA - 16 * n - 31, db = c.qposB - 16 * n - 31;
                    sa[t][i] = __builtin_amdgcn_exp2f(sa[t][i] + c.bt[da < 0 ? 129 : (da > 128 ? 128 : da)] - m0) * inv0;
                    sb[t][i] = __builtin_amdgcn_exp2f(sb[t][i] + c.bt[db < 0 ? 129 : (db > 128 ? 128 : db)] - m1) * inv1; }
        }
#pragma unroll
        for (int t = 0; t < 4; ++t) {
            const float a4 = quad_sum((sa[t][0] + sa[t][1]) + (sa[t][2] + sa[t][3])), a3 = quad_sum(sa[t][3]), b4 = quad_sum((sb[t][0] + sb[t][1]) + (sb[t][2] + sb[t][3])), b3 = quad_sum(sb[t][3]);
            const int j0 = 16 * ib + 4 * t + c.fq;
            if (rr == 0) { LAS float* ip = imp + tl * 136 + j0;
                __hip_atomic_fetch_add(ip, a4, __ATOMIC_RELAXED, __HIP_MEMORY_SCOPE_WORKGROUP); __hip_atomic_fetch_add(ip + 1, a3, __ATOMIC_RELAXED, __HIP_MEMORY_SCOPE_WORKGROUP);
                __hip_atomic_fetch_add(ip + 4 * 136, b4, __ATOMIC_RELAXED, __HIP_MEMORY_SCOPE_WORKGROUP); __hip_atomic_fetch_add(ip + 4 * 136 + 1, b3, __ATOMIC_RELAXED, __HIP_MEMORY_SCOPE_WORKGROUP); }
        }
        VF vf; vf_load(vf, vb, c.fr, c.fq);
        pv2(vf, sa, sb, oa, ob);
    }
};
struct BodySel2 {
    const bf16x8 (&qa)[2]; const bf16x8 (&qb)[2]; const TileCtx& c; f32x4 (&oa)[4]; f32x4 (&ob)[4]; float (&m)[2]; float (&ls)[2]; const LAS int* jl;
    unsigned long long wu0a, wu1a, wu0b, wu1b, my0a, my1a, my0b, my1b;
    __device__ __forceinline__ void operator()(int i, const LAS bf16* kb, const LAS bf16* vb) {
        const int j = __builtin_amdgcn_readfirstlane(jl[i]);
        const bool hasa = j < 64 ? ((wu0a >> j) & 1ull) != 0ull : ((wu1a >> (j - 64)) & 1ull) != 0ull, hasb = j < 64 ? ((wu0b >> j) & 1ull) != 0ull : ((wu1b >> (j - 64)) & 1ull) != 0ull;
        if (!(hasa || hasb)) return;
        const bool minea = j < 64 ? ((my0a >> j) & 1ull) != 0ull : ((my1a >> (j - 64)) & 1ull) != 0ull, mineb = j < 64 ? ((my0b >> j) & 1ull) != 0ull : ((my1b >> (j - 64)) & 1ull) != 0ull;
        const bool near = j >= c.cur - 2;
        if (hasa && hasb) {
            KF kf; kf_load(kf, kb, c.fr, c.fq);
            f32x4 sa[4], sb[4]; qk2(kf, qa, qb, sa, sb);
            float ca = minea ? c.farb : -INFINITY, cb = mineb ? c.farb : -INFINITY;
            if (near) {
                ca = minea ? 0.f : -INFINITY; cb = mineb ? 0.f : -INFINITY;
#pragma unroll
                for (int t = 0; t < 4; ++t)
#pragma unroll
                    for (int e = 0; e < 4; ++e) { const int key = 64 * j + 16 * t + 4 * c.fq + e; const int da = c.qposA - key, db = c.qposB - key;
                        sa[t][e] += c.bt[da < 0 ? 129 : (da > 128 ? 128 : da)]; sb[t][e] += c.bt[db < 0 ? 129 : (db > 128 ? 128 : db)]; }
            }
            softmax_pv2(vb, c.fr, c.fq, sa, sb, ca, cb, oa, ob, m, ls);
        } else {
            const bool mine = hasa ? minea : mineb; const int qpos = hasa ? c.qposA : c.qposB;
            f32x4 st[4];
            if (hasa) qk_lds(kb, qa, c.fr, c.fq, st); else qk_lds(kb, qb, c.fr, c.fq, st);
            float cc = mine ? c.farb : -INFINITY;
            if (near) {
                cc = mine ? 0.f : -INFINITY;
#pragma unroll
                for (int t = 0; t < 4; ++t)
#pragma unroll
                    for (int e = 0; e < 4; ++e) { const int d1 = qpos - (64 * j + 16 * t + 4 * c.fq + e); st[t][e] += c.bt[d1 < 0 ? 129 : (d1 > 128 ? 128 : d1)]; }
            }
            if (hasa) softmax_pv1(vb, c.fr, c.fq, st, cc, oa, m[0], ls[0]); else softmax_pv1(vb, c.fr, c.fq, st, cc, ob, m[1], ls[1]);
        }
    }
};
struct BodyWin2 {
    const bf16x8 (&qa)[2]; const bf16x8 (&qb)[2]; const TileCtx& c; f32x4 (&oa)[4]; f32x4 (&ob)[4]; float (&m)[2]; float (&ls)[2]; int j0;
    __device__ __forceinline__ void operator()(int i, const LAS bf16* kb, const LAS bf16* vb) {
        const int j = j0 + i;
        if (c.qpos0 + 7 - 64 * j < 0 || c.qpos0 - (64 * j + 63) >= 512) return;
        KF kf; kf_load(kf, kb, c.fr, c.fq);
        f32x4 sa[4], sb[4]; qk2(kf, qa, qb, sa, sb);
        float ca = c.farb, cb = c.farb;
        const bool interior = (c.qpos0 + 7 - 64 * j < 512) && (c.qpos0 - (64 * j + 63) >= 128);
        if (!interior) {
            ca = 0.f; cb = 0.f;
#pragma unroll
            for (int t = 0; t < 4; ++t)
#pragma unroll
                for (int e = 0; e < 4; ++e) { const int key = 64 * j + 16 * t + 4 * c.fq + e; const int da = c.qposA - key, db = c.qposB - key;
                    sa[t][e] += c.bt[(unsigned)da >= 512u ? 129 : (da > 128 ? 128 : da)]; sb[t][e] += c.bt[(unsigned)db >= 512u ? 129 : (db > 128 ? 128 : db)]; }
        }
        softmax_pv2(vb, c.fr, c.fq, sa, sb, ca, cb, oa, ob, m, ls);
    }
};

__device__ __forceinline__ void nsa_group(CArgs& A, int l, int b, int g, int tg, LAS unsigned char* lds, int tid) {
    asm volatile("" : "+v"(tid));
    const int lane = tid & 63, wave = tid >> 6, fr = lane & 15, fq = lane >> 4, tl = fr >> 2, rr = fr & 3;
    LAS bf16* sbuf = (LAS bf16*)(lds + NG_KB);
    LAS float* imp = (LAS float*)(lds + NG_IMP) + wave * 1088; const LAS float* BT = (const LAS float*)(lds + NG_BT);
    LAS unsigned long long* msk = (LAS unsigned long long*)(lds + NG_MSK);
    LAS int* jl = (LAS int*)(lds + NG_JL);
    const int qpos0 = 64 * tg + 8 * wave, cur = tg, row0 = b * SEQ + qpos0, h = g * 4 + rr;
    const LAS float* bt = BT + h * 132;
    const TileCtx cx{fr, fq, qpos0 + tl, qpos0 + 4 + tl, qpos0, cur, bt, bt[128]};
    bf16x8 qa[2], qb[2];
    {   const bf16* qp = (const bf16*)(A.ws + WS_NQ) + (size_t)(row0 + tl) * 512 + g * 256 + rr * 64 + 8 * fq;
        qa[0] = *(const bf16x8*)qp; qa[1] = *(const bf16x8*)(qp + 32); qb[0] = *(const bf16x8*)(qp + 4 * 512); qb[1] = *(const bf16x8*)(qp + 4 * 512 + 32); }
    f32x4 outa[4], outb[4];
    for (int i = lane; i < 1088; i += 64) imp[i] = 0.f;

    {
        const int nb64 = (4 * tg + 3 + 63) >> 6;
        const AdLin ad{(const bf16*)(A.ws + WS_KC) + l * KC_L + (size_t)g * NCB * 64 + (size_t)b * 512 * 64, (const bf16*)(A.ws + WS_VCT) + l * KC_L + (size_t)g * 64 * NCB + (size_t)b * 512, (unsigned)NCB};
        float ml[2] = {-1.0e30f, -1.0e30f}, lsl[2] = {0.f, 0.f};
        { BodyCmpStat2 bd{qa, qb, cx, ml, lsl}; staged_sweep2<true, false>(nb64, ad, bd, sbuf, tid); }
        const float m0 = xfq_max(ml[0]), m1 = xfq_max(ml[1]);
        const float l0 = xfq_sum(lsl[0] * __builtin_amdgcn_exp2f(ml[0] - m0)), l1 = xfq_sum(lsl[1] * __builtin_amdgcn_exp2f(ml[1] - m1));
        f32x4 oa[4], ob[4];
#pragma unroll
        for (int dt = 0; dt < 4; ++dt) { oa[dt] = (f32x4){0.f, 0.f, 0.f, 0.f}; ob[dt] = (f32x4){0.f, 0.f, 0.f, 0.f}; }
        { BodyCmpProb2 bd{qa, qb, cx, oa, ob, m0, m1, l0 > 0.f ? 1.f / l0 : 0.f, l1 > 0.f ? 1.f / l1 : 0.f, imp, tl, rr}; staged_sweep2<true, true>(nb64, ad, bd, sbuf, tid); }
        const float* gt = (const float*)(A.ws + WS_GATE) + (size_t)(row0 + tl) * 32 + 8 + h * 3;
        const float ga = sigmoidf_(gt[0]), gb = sigmoidf_(gt[4 * 32]);
#pragma unroll
        for (int dt = 0; dt < 4; ++dt) { outa[dt] = oa[dt] * ga; outb[dt] = ob[dt] * gb; }
    }
    unsigned long long s0[8], s1[8];
#pragma unroll
    for (int t = 0; t < 8; ++t) topk_sel(imp[t * 136 + lane], imp[t * 136 + 64 + lane], cur, lane, s0[t], s1[t]);
    const unsigned long long wu0a = (s0[0] | s0[1]) | (s0[2] | s0[3]), wu1a = (s1[0] | s1[1]) | (s1[2] | s1[3]), wu0b = (s0[4] | s0[5]) | (s0[6] | s0[7]), wu1b = (s1[4] | s1[5]) | (s1[6] | s1[7]);
    const unsigned long long my0a = tl == 0 ? s0[0] : (tl == 1 ? s0[1] : (tl == 2 ? s0[2] : s0[3])), my1a = tl == 0 ? s1[0] : (tl == 1 ? s1[1] : (tl == 2 ? s1[2] : s1[3]));
    const unsigned long long my0b = tl == 0 ? s0[4] : (tl == 1 ? s0[5] : (tl == 2 ? s0[6] : s0[7])), my1b = tl == 0 ? s1[4] : (tl == 1 ? s1[5] : (tl == 2 ? s1[6] : s1[7]));
    if (lane == 0) { msk[2 * wave] = wu0a | wu0b; msk[2 * wave + 1] = wu1a | wu1b; }
    __syncthreads();
    unsigned long long gu0 = 0ull, gu1 = 0ull;
#pragma unroll
    for (int w = 0; w < NWAVES; ++w) { gu0 |= msk[2 * w]; gu1 |= msk[2 * w + 1]; }
    gu0 = __builtin_amdgcn_readfirstlane((unsigned)gu0) | ((unsigned long long)__builtin_amdgcn_readfirstlane((unsigned)(gu0 >> 32)) << 32);
    gu1 = __builtin_amdgcn_readfirstlane((unsigned)gu1) | ((unsigned long long)__builtin_amdgcn_readfirstlane((unsigned)(gu1 >> 32)) << 32);
    const int nsel0 = __popcll(gu0), nsel = nsel0 + __popcll(gu1);
    if (wave == 0) {
        const unsigned long long below = (1ull << lane) - 1ull;
        if ((gu0 >> lane) & 1ull) jl[__popcll(gu0 & below)] = lane;
        if ((gu1 >> lane) & 1ull) jl[nsel0 + __popcll(gu1 & below)] = 64 + lane;
    }
    __syncthreads();
    const float* gt = (const float*)(A.ws + WS_GATE) + (size_t)(row0 + tl) * 32 + 8 + h * 3;
    {
        float m[2] = {-1.0e30f, -1.0e30f}, ls[2] = {0.f, 0.f}; f32x4 oa[4], ob[4];
#pragma unroll
        for (int dt = 0; dt < 4; ++dt) { oa[dt] = (f32x4){0.f, 0.f, 0.f, 0.f}; ob[dt] = (f32x4){0.f, 0.f, 0.f, 0.f}; }
        const AdList ad{(const bf16*)(A.ws + WS_KS) + l * KS_L + (size_t)g * TOTS * 64 + (size_t)b * SEQ * 64, (const bf16*)(A.ws + WS_VTS) + l * KS_L + (size_t)g * 64 * TOTS + (size_t)b * SEQ, (unsigned)TOTS, jl};
        { BodySel2 bd{qa, qb, cx, oa, ob, m, ls, jl, wu0a, wu1a, wu0b, wu1b, my0a, my1a, my0b, my1b}; staged_sweep2<true, true>(nsel, ad, bd, sbuf, tid); }
        const float la = xfq_sum(ls[0]), lb = xfq_sum(ls[1]);
        const float wa = la > 0.f ? sigmoidf_(gt[1]) / la : 0.f, wb = lb > 0.f ? sigmoidf_(gt[4 * 32 + 1]) / lb : 0.f;
#pragma unroll
        for (int dt = 0; dt < 4; ++dt) { outa[dt] = outa[dt] + oa[dt] * wa; outb[dt] = outb[dt] + ob[dt] * wb; }
    }
    {
        float m[2] = {-1.0e30f, -1.0e30f}, ls[2] = {0.f, 0.f}; f32x4 oa[4], ob[4];
#pragma unroll
        for (int dt = 0; dt < 4; ++dt) { oa[dt] = (f32x4){0.f, 0.f, 0.f, 0.f}; ob[dt] = (f32x4){0.f, 0.f, 0.f, 0.f}; }
        int j0 = (64 * tg - 511) >> 6; if (j0 < 0) j0 = 0;
        const AdLin ad{(const bf16*)(A.ws + WS_KW) + l * KW_L + (size_t)g * TOTWP * 64 + ((size_t)b * SEQ + (size_t)j0 * 64) * 64, (const bf16*)(A.ws + WS_VTW) + l * KW_L + (size_t)g * 64 * TOTWP + (size_t)b * SEQ + (size_t)j0 * 64, (unsigned)TOTWP};
        { BodyWin2 bd{qa, qb, cx, oa, ob, m, ls, j0}; staged_sweep2<true, true>(cur - j0 + 1, ad, bd, sbuf, tid); }
        const float la = xfq_sum(ls[0]), lb = xfq_sum(ls[1]);
        const float wa = la > 0.f ? sigmoidf_(gt[2]) / la : 0.f, wb = lb > 0.f ? sigmoidf_(gt[4 * 32 + 2]) / lb : 0.f;
#pragma unroll
        for (int dt = 0; dt < 4; ++dt) { outa[dt] = outa[dt] + oa[dt] * wa; outb[dt] = outb[dt] + ob[dt] * wb; }
    }
    bf16* mp = (bf16*)(A.ws + WS_MIX) + (size_t)(row0 + tl) * D + 512 + h * 64 + 4 * fq;
#pragma unroll
    for (int dt = 0; dt < 4; ++dt) { v2u w; w.x = pk2(outa[dt][0], outa[dt][1]); w.y = pk2(outa[dt][2], outa[dt][3]); *(v2u*)(mp + 16 * dt) = w;
        v2u w2; w2.x = pk2(outb[dt][0], outb[dt][1]); w2.y = pk2(outb[dt][2], outb[dt][3]); *(v2u*)(mp + 4 * D + 16 * dt) = w2; }
}

__device__ __forceinline__ void phase_nsa2(CArgs& A, int l, int rep, LAS unsigned char* lds, int tid) {
    const int lane = tid & 63, wave = tid >> 6;
    LAS float* btl = (LAS float*)(lds + NG_BT);
    LAS int* tw = (LAS int*)(lds + NG_TASK);
    for (int i = tid; i < 8 * 132; i += NTHR) btl[i] = ((const float*)(A.ws + WS_BT))[i];
    unsigned* qh = (unsigned*)(A.ws + WS_CTL) + CW_NSAQ + (l * 2 + rep) * 5 * 64;
    const int own = (blockIdx.x & 7) >> 1;
    for (int qi = 0; qi < 5; ++qi) {
        const int qsel = qi == 0 ? 4 : (qi == 1 ? own : ((own + qi - 1) & 3));
        const int qlen = qsel == 4 ? 2 * DB / NWAVES : 128;
        for (;;) {
            __syncthreads();
            if (tid == 0) tw[0] = (int)__hip_atomic_fetch_add(qh + qsel * 64, 1u, __ATOMIC_RELAXED, __HIP_MEMORY_SCOPE_AGENT);
            __syncthreads();
            const int t = tw[0];
            if (t >= qlen) break;
            if (qsel < 4) nsa_group(A, l, qsel >> 1, qsel & 1, 127 - t, lds, tid);
            else { const int tt = t * NWAVES + wave; nsa_tile(A, l, true, tt >> 1, tt & 1, 0, (LAS float*)(lds + NG_IMP) + wave * 1088, btl, lane); }
        }
    }
}

constexpr int PH_PER_LAYER = 9, PH_L0 = 3, N_PHASES = PH_L0 + DEPTH * PH_PER_LAYER;
#ifndef REP_MASK
#define REP_MASK 0
#endif
__device__ __forceinline__ int rep_count(int b) { int n = (((REP_MASK) >> b) & 1) + 1; asm volatile("" : "+s"(n)); return n; }
#if REP_MASK
#define REPS(b) _Pragma("unroll 1") for (int rep_ = 0, nrep_ = rep_count(b); rep_ < nrep_; ++rep_)
#else
#define REPS(b) for (int rep_ = 0; rep_ < 1; ++rep_)
#endif
#ifndef MK_PER_PHASE
#define MK_PER_PHASE 0
#endif

__device__ __forceinline__ int fresh_tid(int wave_s) { int lane = __builtin_amdgcn_mbcnt_hi(~0u, __builtin_amdgcn_mbcnt_lo(~0u, 0u)); asm volatile("" : "+v"(lane)); return wave_s * 64 + lane; }
__device__ __forceinline__ CArgs* kargs() { unsigned long long p = (unsigned long long)__builtin_amdgcn_kernarg_segment_ptr(); asm volatile("" : "+s"(p)); return (CArgs*)p; }
#define A (*kargs())
#define IN(k) (lo <= (k) && (k) < hi)
#define SEAM(k) do { if (IN(k) && IN((k) + 1)) xcd_barrier(bar); } while (0)
template <int l>
__device__ __forceinline__ void layer_phases(LAS unsigned char* lds, const XcdBarrier& bar, int wave_s, int G, int NGW, int lo, int hi) {
    unsigned char* ws = A.ws;
    float* const ADA = (float*)(ws + WS_ADA);
    float* const X = (float*)(ws + WS_X);
    float* const Z = (float*)(ws + WS_Z);
    bf16* const U = (bf16*)(ws + WS_U);
        const int pb_ = PH_L0 + l * PH_PER_LAYER;
        const float* adal = ADA + (size_t)l * NCOND * 6144;
        const float* xa = l == 0 ? A.x_prompt : X; const float* xb = l == 0 ? A.x_sample : X + (size_t)MP * D;
        if (IN(pb_ + 0)) {
            const int tid = fresh_tid(wave_s), lane = tid & 63, wave = __builtin_amdgcn_readfirstlane(tid >> 6), gw = blockIdx.x * NWAVES + wave; (void)lane; (void)gw;
            {
                pg8::Gemm g{U, (const bf16*)(ws + WS_WIN) + (size_t)l * NINP * D, D, D, D};
                pg8::StaticOrder S; S.init(M, NINP, G, (int)blockIdx.x);
                EpiInProj E{(bf16*)(ws + WS_QKVO), (bf16*)(ws + WS_NQ), (float*)(ws + WS_GATE), (float*)(ws + WS_KVR), (bf16*)(ws + WS_XC) + (size_t)l * 4 * XCP * 64, A.out, l};
                REPS(8) pg8::gemm_phase<EpiInProj, pg8::StaticOrder, true, true>(lds, g, S, E, tid);
            }
            if (l == 0) {
                __syncthreads();
                pg8::Gemm g{(const bf16*)(ws + WS_XC), (const bf16*)(ws + WS_W1), 2048, 1024, 2048};
                CmpOrder S{G, (int)blockIdx.x, 0, DEPTH, 4, 64};
                EpiCmpHid E{(bf16*)(ws + WS_HID), (const float*)(ws + WS_B1)};
                REPS(14) pg8::gemm_phase<EpiCmpHid, CmpOrder, true, true>(lds, g, S, E, tid);
            }
        }
        SEAM(pb_ + 0);
        if (IN(pb_ + 1)) {
            const int tid = fresh_tid(wave_s), lane = tid & 63, wave = __builtin_amdgcn_readfirstlane(tid >> 6), gw = blockIdx.x * NWAVES + wave; (void)lane; (void)gw;
            {
                SgCmpHid E{(bf16*)(ws + WS_HID) + (size_t)l * 4 * NCB * 256, (const float*)(ws + WS_B1) + l * 2 * 256};
                REPS(12) small_gemm(((const bf16*)(ws + WS_XC)) + (size_t)l * 4 * XCP * 64, (size_t)XCP * 64, 1024, ((const bf16*)(ws + WS_W1)) + (size_t)l * 2 * 256 * 2048, (size_t)256 * 2048, 2048, 2048, 4, 1024, 256, E, lds, tid);
            }
            REPS(1) { phase_m2x(A, l, lds, tid);
            __syncthreads();
            prep_layer_images(A, l, lds, gw, NGW, lane, wave); __syncthreads(); }
            if (l == 0) phase_cmp2(A, 0, DEPTH, 1024, NCB - 1024, gw, NGW, lane);
        }
        SEAM(pb_ + 1);
        if (IN(pb_ + 2)) {
            const int tid = fresh_tid(wave_s), lane = tid & 63, wave = __builtin_amdgcn_readfirstlane(tid >> 6), gw = blockIdx.x * NWAVES + wave; (void)lane; (void)gw;
            REPS(2) phase_m3(A, l, tid);
            phase_cmp2(A, l, 1, 0, 1024, gw, NGW, lane);
        }
        SEAM(pb_ + 2);
        if (IN(pb_ + 3)) {
            const int tid = fresh_tid(wave_s), lane = tid & 63, wave = __builtin_amdgcn_readfirstlane(tid >> 6), gw = blockIdx.x * NWAVES + wave; (void)lane; (void)gw;
            REPS(3) { phase_m4x(A, l, lds, tid);
            __syncthreads(); }
            REPS(4) { phase_mls(A, l, lds, tid);
            __syncthreads(); }
            REPS(5) phase_nsa2(A, l, rep_, lds, tid);
        }
        SEAM(pb_ + 3);
        if (IN(pb_ + 4)) {
            const int tid = fresh_tid(wave_s), lane = tid & 63, wave = __builtin_amdgcn_readfirstlane(tid >> 6), gw = blockIdx.x * NWAVES + wave; (void)lane; (void)gw;
            pg8::Gemm g{(const bf16*)(ws + WS_MIX), (const bf16*)(ws + WS_WOUT) + (size_t)l * D * D, D, D, D};
            pg8::StaticOrder S; S.init(MP, D, G, (int)blockIdx.x);
            EpiResid E{xa, xb, adal + 2048, Z};
            REPS(9) pg8::gemm_phase<EpiResid, pg8::StaticOrder, true, true>(lds, g, S, E, tid);
            REPS(13) { SgResid E2{xb, adal + 2048, Z}; small_gemm(((const bf16*)(ws + WS_MIX)) + (size_t)MP * D, 0, D, (const bf16*)(ws + WS_WOUT) + (size_t)l * D * D, 0, D, D, 1, MS, D, E2, lds, tid); }
        }
        SEAM(pb_ + 4);
        if (IN(pb_ + 5)) {
            const int tid = fresh_tid(wave_s), lane = tid & 63, wave = __builtin_amdgcn_readfirstlane(tid >> 6), gw = blockIdx.x * NWAVES + wave; (void)lane; (void)gw;
            REPS(6) for (int r = gw; r < M; r += NGW) {
                const float* ad = adal + (size_t)cond_of_row(r) * 6144;
                ln_row(Z + (size_t)r * D, A.ln_g + (size_t)(l * 2 + 0) * D, A.ln_b + (size_t)(l * 2 + 0) * D, X + (size_t)r * D, ad + 3072, ad + 4096, U + (size_t)r * D, lane);
            }
        }
        SEAM(pb_ + 5);
        if (IN(pb_ + 6)) {
            const int tid = fresh_tid(wave_s), lane = tid & 63, wave = __builtin_amdgcn_readfirstlane(tid >> 6), gw = blockIdx.x * NWAVES + wave; (void)lane; (void)gw;
            pg8::Gemm g{U, (const bf16*)(ws + WS_WUP) + (size_t)l * FF * D, D, D, D};
            pg8::StaticOrder S; S.init(MP, FF, G, (int)blockIdx.x);
            EpiRelu2 E{(bf16*)(ws + WS_H)};
            REPS(10) pg8::gemm_phase<EpiRelu2, pg8::StaticOrder, true, true>(lds, g, S, E, tid);
            REPS(13) { SgRelu2 E2{(bf16*)(ws + WS_H)}; small_gemm(U + (size_t)MP * D, 0, D, (const bf16*)(ws + WS_WUP) + (size_t)l * FF * D, 0, D, D, 1, MS, FF, E2, lds, tid); }
        }
        SEAM(pb_ + 6);
        if (IN(pb_ + 7)) {
            const int tid = fresh_tid(wave_s), lane = tid & 63, wave = __builtin_amdgcn_readfirstlane(tid >> 6), gw = blockIdx.x * NWAVES + wave; (void)lane; (void)gw;
            pg8::Gemm g{(const bf16*)(ws + WS_H), (const bf16*)(ws + WS_WDN) + (size_t)l * D * FF, FF, FF, FF};
            pg8::StaticOrder S; S.init(MP, D, G, (int)blockIdx.x);
            EpiResid E{X, X + (size_t)MP * D, adal + 5120, Z};
            REPS(11) pg8::gemm_phase<EpiResid, pg8::StaticOrder, true, true>(lds, g, S, E, tid);
            REPS(13) { SgResid E2{X + (size_t)MP * D, adal + 5120, Z}; small_gemm(((const bf16*)(ws + WS_H)) + (size_t)MP * FF, 0, FF, (const bf16*)(ws + WS_WDN) + (size_t)l * D * FF, 0, FF, FF, 1, MS, D, E2, lds, tid); }
        }
        SEAM(pb_ + 7);
        if (IN(pb_ + 8)) {
            const int tid = fresh_tid(wave_s), lane = tid & 63, wave = __builtin_amdgcn_readfirstlane(tid >> 6), gw = blockIdx.x * NWAVES + wave; (void)lane; (void)gw;
            const bool last = l == DEPTH - 1;
            REPS(6) for (int r = gw; r < M; r += NGW) {
                const float* ad = adal + (size_t)NCOND * 6144 + (size_t)cond_of_row(r) * 6144;
                float* xo = last ? (r < MP ? A.out + O_YP + (size_t)r * D : A.out + O_YS + (size_t)(r - MP) * D) : X + (size_t)r * D;
                ln_row(Z + (size_t)r * D, A.ln_g + (size_t)(l * 2 + 1) * D, A.ln_b + (size_t)(l * 2 + 1) * D, xo, ad, ad + 1024, last ? (bf16*)nullptr : U + (size_t)r * D, lane);
            }
        }
        SEAM(pb_ + 8);
    }
__global__ void __launch_bounds__(NTHR, 2) fwd_kernel(Args A_unused) {
    extern __shared__ __attribute__((aligned(16))) unsigned char lds_raw[];
    LAS unsigned char* lds = (LAS unsigned char*)lds_raw;
    const int G = gridDim.x, NGW = G * NWAVES, wave_s = __builtin_amdgcn_readfirstlane(threadIdx.x >> 6);
    unsigned char* ws = A.ws;
    for (int u = threadIdx.x; u < (LDS_BYTES - LDSCTL_OFF) / 4; u += NTHR) ((LAS unsigned*)(lds + LDSCTL_OFF))[u] = 0u;
    __syncthreads();
    XcdBarrier bar; bar.bar = (unsigned*)(ws + WS_CTL) + CW_BAR; bar.x = 0; bar.st = nullptr;
    if (!MK_PER_PHASE) bar = xcd_barrier_post((unsigned*)(ws + WS_CTL) + CW_BAR, (volatile LAS unsigned*)(lds + MISC_OFF) + 8);
    const int lo = A.ph_lo, hi = A.ph_hi;

    float* const ADA = (float*)(ws + WS_ADA);
    float* const X = (float*)(ws + WS_X);
    float* const Z = (float*)(ws + WS_Z);
    bf16* const U = (bf16*)(ws + WS_U);

    if (IN(0)) { const int tid = fresh_tid(wave_s), lane = tid & 63, wave = __builtin_amdgcn_readfirstlane(tid >> 6), gw = blockIdx.x * NWAVES + wave;
        REPS(7) { phase_ada(A, lds, tid); } __syncthreads();
        REPS(0) { phase_p0a(A, lds, gw, NGW, lane, wave); prep_cache_images(A, lds, gw, NGW, lane, wave); } }
    SEAM(0);
    if (IN(2)) {
        const int tid = fresh_tid(wave_s), lane = tid & 63, wave = __builtin_amdgcn_readfirstlane(tid >> 6), gw = blockIdx.x * NWAVES + wave;
        b1_reduce(A, tid);
        for (int r = gw; r < M; r += NGW) {
            const float* ad = ADA + (size_t)cond_of_row(r) * 6144;
            mod_row(r < MP ? A.x_prompt + (size_t)r * D : A.x_sample + (size_t)(r - MP) * D, ad, ad + 1024, U + (size_t)r * D, lane);
        }
    }
    SEAM(2);

    layer_phases<0>(lds, bar, wave_s, G, NGW, lo, hi);
    layer_phases<1>(lds, bar, wave_s, G, NGW, lo, hi);
    static_assert(DEPTH == 2, "two layers");
#undef IN
#undef SEAM
#undef A
}

extern "C" void kernel_launch(void* const* d_in, const int* in_sizes, int n_in, void* d_out, int out_size, void* d_ws, size_t ws_size, hipStream_t stream) {
    static int grid = 0;
    if (grid == 0) {
        if (n_in != 25 || (size_t)out_size != O_END || ws_size < WS_END) { fprintf(stderr, "kernel_launch: unexpected shapes: n_in %d out %d (want %zu) ws %zu (want >= %zu)\n", n_in, out_size, (size_t)O_END, ws_size, (size_t)WS_END); grid = -1; return; }
        int dev = 0, cus = 0, per_cu = 0;
        if (hipGetDevice(&dev) != hipSuccess || hipDeviceGetAttribute(&cus, hipDeviceAttributeMultiprocessorCount, dev) != hipSuccess) { grid = -1; return; }
        if (hipFuncSetAttribute((const void*)fwd_kernel, hipFuncAttributeMaxDynamicSharedMemorySize, LDS_BYTES) != hipSuccess) { fprintf(stderr, "kernel_launch: hipFuncSetAttribute failed\n"); grid = -1; return; }
        if (hipOccupancyMaxActiveBlocksPerMultiprocessor(&per_cu, (const void*)fwd_kernel, NTHR, LDS_BYTES) != hipSuccess || per_cu < 1) fprintf(stderr, "kernel_launch: occupancy query reports %d blocks per CU\n", per_cu);
        (void)hipGetLastError();
        grid = cus;
    }
    if (grid < 0) return;
    (void)hipMemsetAsync((char*)d_ws + WS_CTL, 0, CTL_ZERO_BYTES, stream);
    Args a{};
    a.x_prompt = (const float*)d_in[0]; a.x_sample = (const float*)d_in[1]; a.cache_cmp = (const float*)d_in[2]; a.cache_slc = (const float*)d_in[3]; a.cache_win = (const float*)d_in[4];
    a.st_C = (const float*)d_in[5]; a.st_n = (const float*)d_in[6]; a.st_m = (const float*)d_in[7]; a.page_table = (const int*)d_in[8]; a.c_prompt = (const float*)d_in[9]; a.c_sample = (const float*)d_in[10];
    a.w_ada = (const float*)d_in[11]; a.b_ada = (const float*)d_in[12]; a.w_in = (const float*)d_in[13]; a.b_gate = (const float*)d_in[14]; a.ml_norm_g = (const float*)d_in[15]; a.cmp_pe = (const float*)d_in[16];
    a.cmp_w1 = (const float*)d_in[17]; a.cmp_w2 = (const float*)d_in[18]; a.rel_bias = (const float*)d_in[19]; a.w_out = (const float*)d_in[20]; a.ln_g = (const float*)d_in[21]; a.ln_b = (const float*)d_in[22];
    a.w_up = (const float*)d_in[23]; a.w_down = (const float*)d_in[24];
    a.out = (float*)d_out; a.ws = (unsigned char*)d_ws;
#if MK_PER_PHASE
    for (int ph = 0; ph < N_PHASES; ++ph) { a.ph_lo = ph; a.ph_hi = ph + 1; hipLaunchKernelGGL(fwd_kernel, dim3(grid), dim3(NTHR), LDS_BYTES, stream, a); }
#else
    a.ph_lo = 0; a.ph_hi = N_PHASES;
    hipLaunchKernelGGL(fwd_kernel, dim3(grid), dim3(NTHR), LDS_BYTES, stream, a);
#endif
    const hipError_t le = hipPeekAtLastError();
    if (le != hipSuccess) fprintf(stderr, "kernel_launch: launch failed: %s\n", hipGetErrorName(le));
}
```

```cpp
#include <hip/hip_runtime.h>
#include <cstdio>
#include <cstdint>
namespace pg8 {
#define PG8_LAS __attribute__((address_space(3)))
typedef unsigned short bf16_t;
typedef short bf16x8 __attribute__((ext_vector_type(8)));
typedef float f32x4 __attribute__((ext_vector_type(4)));
typedef unsigned u32x4 __attribute__((ext_vector_type(4)));
constexpr int BM = 256, BK = 64, HALF = 128, HTB = HALF * BK * 2  , STAGE_BYTES = 8 * HTB, NXCD = 8, WGM = 8;

__host__ __device__ __forceinline__ int lds_byte(int r, int c) { const int st = (r >> 4) * 2 + (c >> 5), rr = r & 15, cc = c & 31, ob = rr * 64 + cc * 2; return st * 1024 + (ob ^ (((ob >> 9) & 1) << 5)); }
__host__ __device__ __forceinline__ void stage_rc(int b, int& R, int& C) { const int st = b / 1024, sb = b % 1024, swz = sb ^ (((sb >> 9) & 1) << 5); R = (st >> 1) * 16 + swz / 64; C = (st & 1) * 32 + (swz % 64) / 2; }
__host__ __device__ __forceinline__ int perm32(int rho) { const int n = rho >> 4, i = rho & 15; return 8 * (i >> 2) + 4 * n + (i & 3); }

struct Unit { int pm, pn; };
struct Gemm { const bf16_t* A; const bf16_t* Bt; int K, lda, ldb; };

struct StaticOrder {
    int nM, nN, nwg, G, c;
    __host__ __device__ void init(int M, int N, int G_, int c_) { nM = M / BM; nN = N / BM; nwg = nM * nN; G = G_; c = c_; }
    __host__ __device__ bool next(int i, Unit& u) const {
        const long L = (long)i * G + c; if (L >= nwg) return false;
        int wgid = (int)L; { const int q = nwg / NXCD, r = nwg % NXCD, xcd = wgid % NXCD, off = wgid / NXCD; wgid = (xcd < r ? xcd * (q + 1) : r * (q + 1) + (xcd - r) * q) + off; }
        const int nig = WGM * nN, gid = wgid / nig, fm = gid * WGM, gsz = (nM - fm) < WGM ? (nM - fm) : WGM;
        u.pm = fm + ((wgid % nig) % gsz); u.pn = (wgid % nig) / gsz; return true;
    }
    __device__ __forceinline__ void a_ready(const Unit&) const {}
    __device__ __forceinline__ void done(const Unit&) const {}
};

template <class Epi, class Sched, bool ALIGN_EPI = false, bool SP2 = false>
__device__ __forceinline__ void gemm_phase(PG8_LAS unsigned char* lds, const Gemm g, const Sched& S, const Epi& E, const int tid) {
    const int wid = __builtin_amdgcn_readfirstlane(tid >> 6), lane = tid & 63, wr = wid >> 2, wc = wid & 3, fr = lane & 15, fq = lane >> 4;
    const int K = g.K, nt = K / BK;
    unsigned voffA[2], voffB[2];
#pragma unroll
    for (int i = 0; i < 2; ++i) { int R, C; stage_rc(tid * 16 + i * 8192, R, C); const int Rb = Epi::PERM ? ((R & ~31) + perm32(R & 31)) : R;
        voffA[i] = (unsigned)(R * g.lda + C) * 2u; voffB[i] = (unsigned)(Rb * g.ldb + C) * 2u; }
    const size_t kstep = (size_t)(BK * 2);
    const size_t hstepA = (size_t)HALF * g.lda * 2, hstepB = (size_t)HALF * g.ldb * 2;
    const size_t tstepA = 2 * hstepA, tstepB = 2 * hstepB;
    const unsigned ldsw = (unsigned)wid * 1024u;
    const int aoff = lds_byte(wr * 64 + fr, fq * 8), boff = lds_byte(wc * 32 + fr, fq * 8);
#define PG8_SA(b, h) (((b) * 2 + (h)) * HTB)
#define PG8_SB(b, h) ((4 + (b) * 2 + (h)) * HTB)
#define PG8_STAGE(bufoff, gbase, voff) do { _Pragma("unroll") for (int _i = 0; _i < 2; ++_i) \
        __builtin_amdgcn_global_load_lds((const unsigned*)((const char*)(gbase) + (voff)[_i]), (PG8_LAS unsigned*)(lds + (bufoff) + ldsw + _i * 8192), 16, 0, 0); } while (0)
#define PG8_LDA(dst, b, h) do { _Pragma("unroll") for (int m = 0; m < 4; ++m) _Pragma("unroll") for (int k = 0; k < 2; ++k) dst[m][k] = *(const PG8_LAS bf16x8*)(lds + PG8_SA(b, h) + aoff + m * 2048 + k * 1024); } while (0)
#define PG8_LDB(dst, b, h) do { _Pragma("unroll") for (int n = 0; n < 2; ++n) _Pragma("unroll") for (int k = 0; k < 2; ++k) dst[n][k] = *(const PG8_LAS bf16x8*)(lds + PG8_SB(b, h) + boff + n * 2048 + k * 1024); } while (0)
#define PG8_MMA(ai, bj, At, Bt) do { __builtin_amdgcn_s_setprio(1); _Pragma("unroll") for (int m = 0; m < 4; ++m) _Pragma("unroll") for (int n = 0; n < 2; ++n) _Pragma("unroll") for (int k = 0; k < 2; ++k) \
        acc[ai][bj][m][n] = __builtin_amdgcn_mfma_f32_16x16x32_bf16(Bt[n][k], At[m][k], acc[ai][bj][m][n], 0, 0, 0); __builtin_amdgcn_s_setprio(0); } while (0)
#define PG8_WAIT_V(n) asm volatile("s_waitcnt vmcnt(" #n ")" ::: "memory")
#define PG8_WAIT_L(n) asm volatile("s_waitcnt lgkmcnt(" #n ")" ::: "memory")
#define PG8_BAR __builtin_amdgcn_s_barrier()
#define PG8_SCHED __builtin_amdgcn_sched_barrier(0)
    Unit cur, nxt; int ui = 0;
    if (!S.next(0, cur)) return;
    f32x4 acc[2][2][4][2];
#pragma unroll
    for (int a = 0; a < 2; ++a)
#pragma unroll
        for (int b = 0; b < 2; ++b)
#pragma unroll
            for (int m = 0; m < 4; ++m)
#pragma unroll
                for (int n = 0; n < 2; ++n) acc[a][b][m][n] = (f32x4){0.f, 0.f, 0.f, 0.f};
    bf16x8 At[4][2], B0[2][2], B1[2][2];
    const char* cA = (const char*)g.A + (size_t)cur.pm * tstepA; const char* cB = (const char*)g.Bt + (size_t)cur.pn * tstepB;
    S.a_ready(cur);
    if constexpr (SP2) {
        PG8_STAGE(PG8_SB(0, 0), cB, voffB); PG8_STAGE(PG8_SB(0, 1), cB + hstepB, voffB); PG8_STAGE(PG8_SA(0, 0), cA, voffA); PG8_STAGE(PG8_SA(0, 1), cA + hstepA, voffA);
        if (wr == 1) PG8_BAR;
        PG8_WAIT_V(2); PG8_BAR;
        PG8_STAGE(PG8_SB(1, 0), cB + kstep, voffB); PG8_STAGE(PG8_SA(1, 0), cA + kstep, voffA); PG8_STAGE(PG8_SB(1, 1), cB + hstepB + kstep, voffB);
        PG8_WAIT_V(6); PG8_BAR;
    } else {
        PG8_STAGE(PG8_SB(0, 0), cB, voffB); PG8_STAGE(PG8_SA(0, 0), cA, voffA); PG8_STAGE(PG8_SB(0, 1), cB + hstepB, voffB); PG8_STAGE(PG8_SA(0, 1), cA + hstepA, voffA);
        if (wr == 1) PG8_BAR;
        PG8_WAIT_V(4); PG8_BAR;
        PG8_STAGE(PG8_SB(1, 0), cB + kstep, voffB); PG8_STAGE(PG8_SA(1, 0), cA + kstep, voffA); PG8_STAGE(PG8_SB(1, 1), cB + hstepB + kstep, voffB);
        PG8_WAIT_V(6); PG8_BAR;
    }
    for (;;) {
        const bool has_next = S.next(ui + 1, nxt);
        const char* nA = has_next ? (const char*)g.A + (size_t)nxt.pm * tstepA : cA; const char* nB = has_next ? (const char*)g.Bt + (size_t)nxt.pn * tstepB : cB;
        for (int t = 0; t < nt; t += 2) {
            const bool last = (t == nt - 2);
            const char* a1 = cA + (size_t)(t + 1) * kstep;
            const char* a2 = last ? nA : cA + (size_t)(t + 2) * kstep; const char* b2 = last ? nB : cB + (size_t)(t + 2) * kstep;
            const char* a3 = a2 + kstep; const char* b3 = b2 + kstep;
            if (last && has_next) S.a_ready(nxt);
            if constexpr (SP2) {
            PG8_LDB(B0, 0, 0); PG8_LDB(B1, 0, 1); PG8_SCHED; PG8_LDA(At, 0, 0); PG8_STAGE(PG8_SA(1, 1), a1 + hstepA, voffA);
            PG8_WAIT_V(8); PG8_WAIT_L(0); PG8_BAR; PG8_MMA(0, 0, At, B0); PG8_MMA(0, 1, At, B1); PG8_BAR; PG8_SCHED;
            PG8_LDA(At, 0, 1); PG8_STAGE(PG8_SB(0, 0), b2, voffB); PG8_STAGE(PG8_SB(0, 1), b2 + hstepB, voffB); PG8_STAGE(PG8_SA(0, 0), a2, voffA);
            PG8_WAIT_V(8); PG8_WAIT_L(0); PG8_BAR; PG8_MMA(1, 0, At, B0); PG8_MMA(1, 1, At, B1); PG8_BAR; PG8_SCHED;
            PG8_LDB(B0, 1, 0); PG8_LDB(B1, 1, 1); PG8_SCHED; PG8_LDA(At, 1, 0); PG8_STAGE(PG8_SA(0, 1), a2 + hstepA, voffA);
            PG8_WAIT_V(8); PG8_WAIT_L(0); PG8_BAR; PG8_MMA(0, 0, At, B0); PG8_MMA(0, 1, At, B1); PG8_BAR; PG8_SCHED;
            PG8_LDA(At, 1, 1); PG8_STAGE(PG8_SB(1, 0), b3, voffB); PG8_STAGE(PG8_SB(1, 1), b3 + hstepB, voffB); PG8_STAGE(PG8_SA(1, 0), a3, voffA);
            PG8_WAIT_V(8); PG8_WAIT_L(0); PG8_BAR; PG8_MMA(1, 0, At, B0); PG8_MMA(1, 1, At, B1); PG8_BAR; PG8_SCHED;
            } else {
            PG8_LDB(B0, 0, 0); PG8_SCHED; PG8_LDA(At, 0, 0); PG8_STAGE(PG8_SA(1, 1), a1 + hstepA, voffA);
            PG8_WAIT_L(8); PG8_BAR; PG8_WAIT_L(0); PG8_MMA(0, 0, At, B0); PG8_BAR; PG8_SCHED;
            PG8_LDB(B1, 0, 1); PG8_STAGE(PG8_SB(0, 0), b2, voffB);
            PG8_BAR; PG8_WAIT_L(0); PG8_MMA(0, 1, At, B1); PG8_BAR;
            PG8_LDA(At, 0, 1); PG8_STAGE(PG8_SA(0, 0), a2, voffA);
            PG8_BAR; PG8_WAIT_L(0); PG8_MMA(1, 0, At, B0); PG8_BAR; PG8_SCHED;
            PG8_STAGE(PG8_SB(0, 1), b2 + hstepB, voffB);
            PG8_WAIT_V(6); PG8_BAR; PG8_MMA(1, 1, At, B1); PG8_BAR;
            PG8_LDB(B0, 1, 0); PG8_SCHED; PG8_LDA(At, 1, 0); PG8_STAGE(PG8_SA(0, 1), a2 + hstepA, voffA);
            PG8_WAIT_L(8); PG8_BAR; PG8_WAIT_L(0); PG8_MMA(0, 0, At, B0); PG8_BAR; PG8_SCHED;
            PG8_LDB(B1, 1, 1); PG8_STAGE(PG8_SB(1, 0), b3, voffB);
            PG8_BAR; PG8_WAIT_L(0); PG8_MMA(0, 1, At, B1); PG8_BAR;
            PG8_LDA(At, 1, 1); PG8_STAGE(PG8_SA(1, 0), a3, voffA);
            PG8_BAR; PG8_WAIT_L(0); PG8_MMA(1, 0, At, B0); PG8_BAR; PG8_SCHED;
            PG8_STAGE(PG8_SB(1, 1), b3 + hstepB, voffB);
            PG8_WAIT_V(6); PG8_BAR; PG8_MMA(1, 1, At, B1); PG8_BAR;
            }
        }
        if constexpr (ALIGN_EPI) { if (wr == 0) PG8_BAR; }
        if constexpr (!Epi::AFTER_DRAIN) { E(acc, cur, wr, wc, fr, fq); S.done(cur); }
        if (!has_next) break;
#pragma unroll
        for (int a = 0; a < 2; ++a)
#pragma unroll
            for (int b = 0; b < 2; ++b)
#pragma unroll
                for (int m = 0; m < 4; ++m)
#pragma unroll
                    for (int n = 0; n < 2; ++n) acc[a][b][m][n] = (f32x4){0.f, 0.f, 0.f, 0.f};
        cur = nxt; cA = nA; cB = nB; ++ui;
        if constexpr (ALIGN_EPI) { if (wr == 1) PG8_BAR; }
    }
    PG8_WAIT_V(0);
    if constexpr (!ALIGN_EPI) { if (wr == 0) PG8_BAR; }
    PG8_BAR;
    if constexpr (Epi::AFTER_DRAIN) { E.fused(acc, cur, wr, wc, fr, fq, lds, wid, lane); S.done(cur); }
#undef PG8_SA
#undef PG8_SB
#undef PG8_STAGE
#undef PG8_LDA
#undef PG8_LDB
#undef PG8_MMA
#undef PG8_WAIT_V
#undef PG8_WAIT_L
#undef PG8_BAR
#undef PG8_SCHED
}
}

#ifndef REP_MASK
#define REP_MASK 0
#endif

constexpr int D = 1024, BATCH = 2, SEQ = 8192, DEPTH = 2, DB = 128, DS = 4, PAST = 2048, PAGE = 128, NPG = 16, NPHYS = 2560;
constexpr int MP = BATCH * SEQ, MS = DB * DS, M = MP + MS;
constexpr int NINP = 3584, FF = 4096, NCOND = BATCH + DB;
constexpr int NH = 4, HD = 128;
constexpr int LCH = 256, NCH = SEQ / LCH, NUNIT = BATCH * NH * NCH;
constexpr int NCB = 17408;
constexpr int XCP = NCB * 16;
constexpr float ALPHA = 1.4142135623730951f;
constexpr float LN_EPS = 1e-5f;
constexpr size_t O_YP = 0, O_YS = O_YP + (size_t)MP * D, O_CMPP = O_YS + (size_t)MS * D, O_CMPS = O_CMPP + (size_t)DEPTH * MP * 256, O_SLCP = O_CMPS + (size_t)DEPTH * MS * 256,
                 O_SLCS = O_SLCP + (size_t)DEPTH * MP * 256, O_WINP = O_SLCS + (size_t)DEPTH * MS * 256, O_WINS = O_WINP + (size_t)DEPTH * BATCH * 512 * 256,
                 O_CP = O_WINS + (size_t)DEPTH * DB * 512 * 256, O_CS = O_CP + (size_t)DEPTH * BATCH * NH * HD * HD, O_NP = O_CS + (size_t)DEPTH * DB * NH * HD * HD,
                 O_NS = O_NP + (size_t)DEPTH * BATCH * NH * HD, O_MP = O_NS + (size_t)DEPTH * DB * NH * HD, O_MS = O_MP + (size_t)DEPTH * BATCH * NH, O_END = O_MS + (size_t)DEPTH * DB * NH;

constexpr size_t al1m(size_t x) { return (x + 0xFFFFFull) & ~(size_t)0xFFFFFull; }
constexpr size_t WS_CTL = 0, CTL_ZERO_BYTES = 1u << 20;
constexpr size_t WS_WIN  = CTL_ZERO_BYTES;
constexpr size_t WS_WOUT = WS_WIN  + al1m((size_t)DEPTH * NINP * D * 2);
constexpr size_t WS_WUP  = WS_WOUT + al1m((size_t)DEPTH * D * D * 2);
constexpr size_t WS_WDN  = WS_WUP  + al1m((size_t)DEPTH * FF * D * 2);
constexpr size_t WS_W1   = WS_WDN  + al1m((size_t)DEPTH * D * FF * 2);
constexpr size_t WS_ADA  = WS_W1   + al1m((size_t)DEPTH * 2 * 256 * 2048 * 2);
constexpr size_t WS_B1   = WS_ADA  + al1m((size_t)DEPTH * NCOND * 6144 * 4);
constexpr size_t WS_BT   = WS_B1   + al1m(4096);
constexpr size_t WS_X    = WS_BT   + al1m(8 * 132 * 4);
constexpr size_t WS_Z    = WS_X    + al1m((size_t)M * D * 4);
constexpr size_t WS_U    = WS_Z    + al1m((size_t)M * D * 4);
constexpr size_t WS_QKVO = WS_U    + al1m((size_t)M * D * 2);
constexpr size_t WS_NQ   = WS_QKVO + al1m((size_t)M * 2048 * 2);
constexpr size_t WS_GATE = WS_NQ   + al1m((size_t)M * 512 * 2);
constexpr size_t WS_KVR  = WS_GATE + al1m((size_t)M * 32 * 4);
constexpr size_t WS_XC   = WS_KVR  + al1m((size_t)3 * M * 256 * 4);
constexpr size_t WS_HID  = WS_XC   + al1m((size_t)DEPTH * 4 * XCP * 64 * 2 + 4096);
constexpr size_t WS_CKV  = WS_HID  + al1m((size_t)DEPTH * 4 * NCB * 256 * 2);
constexpr size_t WS_KS   = WS_CKV  + al1m((size_t)DEPTH * 4 * NCB * 64 * 4);
constexpr size_t WS_VTS  = WS_KS   + al1m((size_t)DEPTH * 2 * (MP + DB * 2112) * 64 * 2 + 65536);
constexpr size_t WS_KW   = WS_VTS  + al1m((size_t)DEPTH * 2 * (MP + DB * 2112) * 64 * 2 + 65536);
constexpr size_t WS_VTW  = WS_KW   + al1m((size_t)DEPTH * 2 * (MP + DB * 576 + 64) * 64 * 2 + 65536);
constexpr size_t WS_KC   = WS_VTW  + al1m((size_t)DEPTH * 2 * (MP + DB * 576 + 64) * 64 * 2 + 65536);
constexpr size_t WS_VCT  = WS_KC   + al1m((size_t)DEPTH * 2 * NCB * 64 * 2 + 65536);
constexpr size_t WS_W2T  = WS_VCT  + al1m((size_t)DEPTH * 2 * NCB * 64 * 2 + 65536);
constexpr size_t WS_MIX  = WS_W2T  + al1m(65536);
constexpr size_t WS_H    = WS_MIX  + al1m((size_t)M * D * 2);
constexpr size_t WS_DCT  = WS_H    + al1m((size_t)M * FF * 2);
constexpr size_t WS_DN   = WS_DCT  + al1m((size_t)NUNIT * HD * HD * 4);
constexpr size_t WS_CHS  = WS_DN   + al1m((size_t)NUNIT * HD * 4);
constexpr size_t WS_CTP  = WS_CHS  + al1m((size_t)NUNIT * 4 * 4);
constexpr size_t WS_NPV  = WS_CTP  + al1m((size_t)NUNIT * HD * HD * 2);
constexpr size_t WS_WSC  = WS_NPV  + al1m((size_t)NUNIT * HD * 4);
constexpr size_t WS_HRAW = WS_WSC  + al1m((size_t)NUNIT * LCH * LCH * 4);
constexpr size_t WS_END  = WS_HRAW + al1m((size_t)NUNIT * LCH * HD * 4);

constexpr int CW_BAR = 4096;

constexpr int RING_BYTES = 131072, LDSCTL_OFF = RING_BYTES, MISC_OFF = LDSCTL_OFF + 320, LDS_BYTES = 147456;
constexpr int NWAVES = 8, NTHR = NWAVES * 64;

#define GAS __attribute__((address_space(1)))
#define LAS __attribute__((address_space(3)))
typedef unsigned short bf16;
typedef unsigned v4u __attribute__((ext_vector_type(4)));
typedef unsigned v2u __attribute__((ext_vector_type(2)));
typedef float f32x4 __attribute__((ext_vector_type(4)));
typedef float f32x2 __attribute__((ext_vector_type(2)));

__device__ __forceinline__ unsigned f2bf(float f) { unsigned u = __builtin_bit_cast(unsigned, f); return (u + 0x7fffu + ((u >> 16) & 1u)) >> 16; }
__device__ __forceinline__ unsigned pk2(float lo, float hi) { return f2bf(lo) | (f2bf(hi) << 16); }
__device__ __forceinline__ float bflo(unsigned u) { return __builtin_bit_cast(float, u << 16); }
__device__ __forceinline__ float bfhi(unsigned u) { return __builtin_bit_cast(float, u & 0xffff0000u); }
__device__ __forceinline__ float bf2f(bf16 h) { return __builtin_bit_cast(float, (unsigned)h << 16); }
__device__ __forceinline__ float sigmoidf_(float x) { return 1.f / (1.f + __expf(-x)); }
__device__ __forceinline__ float wave_sum(float v) {
#pragma unroll
    for (int o = 1; o < 64; o <<= 1) v += __shfl_xor(v, o);
    return v;
}
__device__ __forceinline__ float wave_max(float v) {
#pragma unroll
    for (int o = 1; o < 64; o <<= 1) v = fmaxf(v, __shfl_xor(v, o));
    return v;
}

#define XB_TMO      128
#define XB_XCNT(j)  (256  + 64 * (j))
#define XB_XSUB(j)  (1280 + 64 * (j))
#define XB_XGEN(j)  (2304 + 64 * (j))
#define XB_TOP      3328
#define XB_TOPGEN   3392
#define XCD_BAR_WORDS 3456
#define XB_SPIN_CAP (1u << 18)

__device__ __forceinline__ unsigned xb_ld(unsigned* p)              { return __hip_atomic_load(p, __ATOMIC_RELAXED, __HIP_MEMORY_SCOPE_AGENT); }
__device__ __forceinline__ unsigned xb_add(unsigned* p, unsigned v) { return __hip_atomic_fetch_add(p, v, __ATOMIC_RELAXED, __HIP_MEMORY_SCOPE_AGENT); }
__device__ __forceinline__ unsigned xb_xcc_id() { return (unsigned)__builtin_amdgcn_s_getreg((3 << 11) | 20) & 0xFu; }
#define XB_SPIN(cond, bar) do { unsigned _sp = 0; while (cond) { __builtin_amdgcn_s_sleep(1); \
    if ((++_sp & 255u) == 0u) { if (xb_ld(&(bar)[XB_TMO])) break; if (_sp > XB_SPIN_CAP) { atomicAdd(&(bar)[XB_TMO], 1u); break; } } } } while (0)

struct XcdBarrier {
    unsigned* bar; unsigned x;
    volatile LAS unsigned* st;
};

__device__ __forceinline__ XcdBarrier xcd_barrier_post(unsigned* bar, volatile LAS unsigned* st) {
    XcdBarrier b; b.bar = bar; b.x = xb_xcc_id(); b.st = st;
    if (threadIdx.x == 0) (void)xb_add(&bar[XB_XCNT(b.x)], 1u);
    return b;
}
__device__ __forceinline__ void xcd_barrier_complete(unsigned* bar, unsigned x, unsigned& nloc, unsigned& nx) {
    const unsigned G = gridDim.x * gridDim.y * gridDim.z;
    unsigned sum, cnt, mine, sp = 0u;
    for (;;) {
        sum = 0u; cnt = 0u; mine = 0u;
#pragma unroll
        for (unsigned j = 0; j < 16; ++j) { const unsigned c = xb_ld(&bar[XB_XCNT(j)]); sum += c; cnt += (c > 0u) ? 1u : 0u; mine = (j == x) ? c : mine; }
        if (sum == G) break;
        __builtin_amdgcn_s_sleep(1);
        if ((++sp & 255u) == 0u) { if (xb_ld(&bar[XB_TMO])) break; if (sp > XB_SPIN_CAP) { atomicAdd(&bar[XB_TMO], 1u); break; } }
    }
    nloc = mine > 0u ? mine : 1u; nx = cnt > 0u ? cnt : 1u;
}

__device__ __forceinline__ void xcd_barrier(const XcdBarrier& b) {
    asm volatile("s_waitcnt vmcnt(0)" ::: "memory");
    __syncthreads();
    if (threadIdx.x == 0) {
        unsigned* bar = b.bar;
        __builtin_amdgcn_s_waitcnt(0);
        unsigned nloc = b.st[0], nx = b.st[1];
        if (nloc == 0u) { xcd_barrier_complete(bar, b.x, nloc, nx); b.st[0] = nloc; b.st[1] = nx; }
        const unsigned old = xb_add(&bar[XB_XSUB(b.x)], 1u);
        const unsigned gen = old / nloc;
        if (old + 1u == (gen + 1u) * nloc) {
            __builtin_amdgcn_fence(__ATOMIC_RELEASE, "agent");
            asm volatile("s_waitcnt vmcnt(0)" ::: "memory");
            const unsigned og = xb_add(&bar[XB_TOP], 1u);
            const unsigned tg = og / nx;
            if (og + 1u == (tg + 1u) * nx) xb_add(&bar[XB_TOPGEN], 1u);
            else XB_SPIN(xb_ld(&bar[XB_TOPGEN]) == tg, bar);
            __builtin_amdgcn_fence(__ATOMIC_ACQUIRE, "agent");
            xb_add(&bar[XB_XGEN(b.x)], 1u);
            asm volatile("s_waitcnt vmcnt(0)" ::: "memory");
        } else {
            XB_SPIN(xb_ld(&bar[XB_XGEN(b.x)]) == gen, bar);
            __builtin_amdgcn_fence(__ATOMIC_ACQUIRE, "agent");
            asm volatile("s_waitcnt vmcnt(0)" ::: "memory");
        }
    }
    __syncthreads();
}

struct Args {
    const float* x_prompt; const float* x_sample; const float* cache_cmp; const float* cache_slc; const float* cache_win;
    const float* st_C; const float* st_n; const float* st_m; const int* page_table; const float* c_prompt; const float* c_sample;
    const float* w_ada; const float* b_ada; const float* w_in; const float* b_gate; const float* ml_norm_g; const float* cmp_pe;
    const float* cmp_w1; const float* cmp_w2; const float* rel_bias; const float* w_out; const float* ln_g; const float* ln_b;
    const float* w_up; const float* w_down;
    float* out; unsigned char* ws; int ph_lo, ph_hi;
};
static_assert(sizeof(Args) == 27 * 8 + 8, "Args has no padding");
typedef const __attribute__((address_space(4))) Args CArgs;

__device__ __forceinline__ int cond_of_row(int r) { return r < MP ? (r >> 13) : BATCH + ((r - MP) >> 2); }

struct EpiInProj {
    static constexpr bool PERM = true, AFTER_DRAIN = false;
    bf16* QKVO; bf16* NQ; float* GATE; float* KVR; bf16* XC; float* out; int l;
    __device__ __forceinline__ void operator()(const f32x4 (&acc)[2][2][4][2], const pg8::Unit& u, int wr, int wc, int fr, int fq) const {
        const int row0 = u.pm * 256 + wr * 64 + fr, pn = u.pn, col8 = wc * 32 + 8 * fq;
#pragma unroll
        for (int ai = 0; ai < 2; ++ai)
#pragma unroll
            for (int m = 0; m < 4; ++m) {
                const int r = row0 + ai * 128 + m * 16;
#pragma unroll
                for (int bj = 0; bj < 2; ++bj) {
                    const f32x4 v0 = acc[ai][bj][m][0], v1 = acc[ai][bj][m][1];
                    const int cc = bj * 128 + col8;
                    if (pn < 10) {
                        v4u w; w.x = pk2(v0[0], v0[1]); w.y = pk2(v0[2], v0[3]); w.z = pk2(v1[0], v1[1]); w.w = pk2(v1[2], v1[3]);
                        if (pn < 8) *(v4u*)(QKVO + (size_t)r * 2048 + pn * 256 + cc) = w;
                        else        *(v4u*)(NQ + (size_t)r * 512 + (pn - 8) * 256 + cc) = w;
                    } else if (pn < 13) {
                        const int kind = pn - 10;
                        float* kr = KVR + ((size_t)kind * M + r) * 256 + cc;
                        *(f32x4*)kr = v0; *(f32x4*)(kr + 4) = v1;
                        float* o = nullptr;
                        if (r < MP) {
                            if (kind < 2) o = out + (kind == 0 ? O_CMPP : O_SLCP) + ((size_t)l * MP + r) * 256 + cc;
                            else { const int t = r & (SEQ - 1); if (t >= SEQ - 512) o = out + O_WINP + (((size_t)l * BATCH + (r >> 13)) * 512 + (t - (SEQ - 512))) * 256 + cc; }
                        } else {
                            const int rs = r - MP;
                            if (kind < 2) o = out + (kind == 0 ? O_CMPS : O_SLCS) + ((size_t)l * MS + rs) * 256 + cc;
                            else o = out + O_WINS + (((size_t)l * DB + (rs >> 2)) * 512 + 508 + (rs & 3)) * 256 + cc;
                        }
                        if (o) { *(f32x4*)o = v0; *(f32x4*)(o + 4) = v1; }
                        if (kind == 0 && r < MP) {
                            v4u w; w.x = pk2(v0[0], v0[1]); w.y = pk2(v0[2], v0[3]); w.z = pk2(v1[0], v1[1]); w.w = pk2(v1[2], v1[3]);
                            *(v4u*)(XC + ((size_t)(bj * 2 + (wc >> 1)) * XCP + r) * 64 + (wc & 1) * 32 + 8 * fq) = w;
                        }
                    } else {
                        if (bj == 0 && wc == 0) { float* gp = GATE + (size_t)r * 32 + 8 * fq; *(f32x4*)gp = v0; *(f32x4*)(gp + 4) = v1; }
                    }
                }
            }
    }
};

struct EpiResid {
    static constexpr bool PERM = true, AFTER_DRAIN = false;
    const float* xa; const float* xb; const float* gate; bf16* Z;
    __device__ __forceinline__ void operator()(const f32x4 (&acc)[2][2][4][2], const pg8::Unit& u, int wr, int wc, int fr, int fq) const {
        const int row0 = u.pm * 256 + wr * 64 + fr, col0 = u.pn * 256 + wc * 32 + 8 * fq;
#pragma unroll
        for (int ai = 0; ai < 2; ++ai)
#pragma unroll
            for (int m = 0; m < 4; ++m) {
                const int r = row0 + ai * 128 + m * 16;
                const float* xr = (r < MP ? xa + (size_t)r * D : xb + (size_t)(r - MP) * D) + col0;
                const float* gr = gate + (size_t)cond_of_row(r) * 6144 + col0;
                bf16* zr = Z + (size_t)r * D + col0;
#pragma unroll
                for (int bj = 0; bj < 2; ++bj) {
                    const f32x4 x0 = *(const f32x4*)(xr + bj * 128), x1 = *(const f32x4*)(xr + bj * 128 + 4);
                    const f32x4 g0 = *(const f32x4*)(gr + bj * 128), g1 = *(const f32x4*)(gr + bj * 128 + 4);
                    const f32x4 z0 = x0 * ALPHA + g0 * acc[ai][bj][m][0], z1 = x1 * ALPHA + g1 * acc[ai][bj][m][1];
                    v4u w; w.x = pk2(z0[0], z0[1]); w.y = pk2(z0[2], z0[3]); w.z = pk2(z1[0], z1[1]); w.w = pk2(z1[2], z1[3]);
                    *(v4u*)(zr + bj * 128) = w;
                }
            }
    }
};

struct EpiRelu2 {
    static constexpr bool PERM = true, AFTER_DRAIN = false;
    bf16* H;
    __device__ __forceinline__ void operator()(const f32x4 (&acc)[2][2][4][2], const pg8::Unit& u, int wr, int wc, int fr, int fq) const {
        const int row0 = u.pm * 256 + wr * 64 + fr, col0 = u.pn * 256 + wc * 32 + 8 * fq;
#pragma unroll
        for (int ai = 0; ai < 2; ++ai)
#pragma unroll
            for (int m = 0; m < 4; ++m) {
                bf16* hr = H + (size_t)(row0 + ai * 128 + m * 16) * FF + col0;
#pragma unroll
                for (int bj = 0; bj < 2; ++bj) {
                    f32x4 a = acc[ai][bj][m][0], b = acc[ai][bj][m][1];
#pragma unroll
                    for (int i = 0; i < 4; ++i) { a[i] = fmaxf(a[i], 0.f); a[i] *= a[i]; b[i] = fmaxf(b[i], 0.f); b[i] *= b[i]; }
                    v4u w; w.x = pk2(a[0], a[1]); w.y = pk2(a[2], a[3]); w.z = pk2(b[0], b[1]); w.w = pk2(b[2], b[3]);
                    *(v4u*)(hr + bj * 128) = w;
                }
            }
    }
};

__device__ __forceinline__ float gelu_tanh(float x) {
    const float y = 0.7978845608028654f * (x + 0.044715f * x * x * x);
    const float t = 1.f - 2.f / (__expf(2.f * y) + 1.f);
    return 0.5f * x * (1.f + t);
}
struct EpiCmpHid {
    static constexpr bool PERM = true, AFTER_DRAIN = false;
    bf16* HID; const float* B1;
    __device__ __forceinline__ void operator()(const f32x4 (&acc)[2][2][4][2], const pg8::Unit& u, int wr, int wc, int fr, int fq) const {
        const int row0 = u.pm * 256 + wr * 64 + fr, col0 = wc * 32 + 8 * fq;
        const float* bp = B1 + u.pn * 256 + col0;
        f32x4 bv[2][2];
#pragma unroll
        for (int bj = 0; bj < 2; ++bj) { bv[bj][0] = *(const f32x4*)(bp + bj * 128); bv[bj][1] = *(const f32x4*)(bp + bj * 128 + 4); }
#pragma unroll
        for (int ai = 0; ai < 2; ++ai)
#pragma unroll
            for (int m = 0; m < 4; ++m) {
                bf16* hr = HID + (size_t)(row0 + ai * 128 + m * 16) * 256 + col0;
#pragma unroll
                for (int bj = 0; bj < 2; ++bj) {
                    f32x4 a = acc[ai][bj][m][0] + bv[bj][0], b = acc[ai][bj][m][1] + bv[bj][1];
#pragma unroll
                    for (int i = 0; i < 4; ++i) { a[i] = gelu_tanh(a[i]); b[i] = gelu_tanh(b[i]); }
                    v4u w; w.x = pk2(a[0], a[1]); w.y = pk2(a[2], a[3]); w.z = pk2(b[0], b[1]); w.w = pk2(b[2], b[3]);
                    *(v4u*)(hr + bj * 128) = w;
                }
            }
    }
};

struct CmpOrder {
    int G, c, l0, nl, t0, ntile;
    __device__ __forceinline__ bool next(int i, pg8::Unit& u) const {
        const int L = i * G + c; if (L >= nl * 4 * ntile) return false;
        const int blk = L / ntile, tile = L % ntile, l = l0 + (blk >> 2), sg = blk & 3;
        u.pm = (l * 4 + sg) * 68 + t0 + tile; u.pn = l * 2 + (sg >> 1); return true;
    }
    __device__ __forceinline__ void a_ready(const pg8::Unit&) const {}
    __device__ __forceinline__ void done(const pg8::Unit&) const {}
};

typedef short sg_bf16x8 __attribute__((ext_vector_type(8)));
template <class Epi>
__device__ __forceinline__ void small_gemm(const bf16* A, size_t strideA, int lda, const bf16* Bt, size_t strideB, int ldb, int K, int nbatch, int Mrows, int N, const Epi& E, LAS unsigned char* lds, int tid) {
    const int lane = tid & 63, wave = tid >> 6, fr = lane & 15, fq = lane >> 4;
    const int ntn = N / 64, ntm = Mrows / 32, ntask = nbatch * ntm * ntn, kw = K / 8;
    LAS f32x4* red = (LAS f32x4*)lds;
    for (int task = blockIdx.x; task < ntask; task += gridDim.x) {
        const int batch = task / (ntm * ntn), tr = task % (ntm * ntn), tm = tr / ntn, tn = tr % ntn;
        const bf16* ap = A + (size_t)batch * strideA + (size_t)(tm * 32 + fr) * lda + wave * kw + 8 * fq;
        const bf16* bp = Bt + (size_t)E.bsel(batch) * strideB + (size_t)(tn * 64 + fr) * ldb + wave * kw + 8 * fq;
        f32x4 acc[2][4];
#pragma unroll
        for (int i = 0; i < 2; ++i)
#pragma unroll
            for (int j = 0; j < 4; ++j) acc[i][j] = (f32x4){0.f, 0.f, 0.f, 0.f};
#pragma unroll 4
        for (int k = 0; k < kw; k += 32) {
            sg_bf16x8 af[2], bf[4];
#pragma unroll
            for (int i = 0; i < 2; ++i) af[i] = *(const sg_bf16x8*)(ap + (size_t)i * 16 * lda + k);
#pragma unroll
            for (int j = 0; j < 4; ++j) bf[j] = *(const sg_bf16x8*)(bp + (size_t)j * 16 * ldb + k);
#pragma unroll
            for (int i = 0; i < 2; ++i)
#pragma unroll
                for (int j = 0; j < 4; ++j) acc[i][j] = __builtin_amdgcn_mfma_f32_16x16x32_bf16(bf[j], af[i], acc[i][j], 0, 0, 0);
        }
        __syncthreads();
#pragma unroll
        for (int i = 0; i < 2; ++i)
#pragma unroll
            for (int j = 0; j < 4; ++j) red[(wave * 8 + i * 4 + j) * 64 + lane] = acc[i][j];
        __syncthreads();
        f32x4 sum = red[wave * 64 + lane];
#pragma unroll
        for (int w = 1; w < 8; ++w) sum = sum + red[(w * 8 + wave) * 64 + lane];
        E(batch, tm * 32 + (wave >> 2) * 16 + fr, tn * 64 + (wave & 3) * 16 + 4 * fq, sum);
    }
}
struct SgResid {
    const float* xb; const float* gate; bf16* Z;
    __device__ __forceinline__ int bsel(int) const { return 0; }
    __device__ __forceinline__ void operator()(int, int rl, int c, const f32x4& acc) const {
        const int r = MP + rl;
        const f32x4 x = *(const f32x4*)(xb + (size_t)rl * D + c), gg = *(const f32x4*)(gate + (size_t)cond_of_row(r) * 6144 + c);
        const f32x4 z = x * ALPHA + gg * acc; v2u w; w.x = pk2(z[0], z[1]); w.y = pk2(z[2], z[3]);
        *(v2u*)(Z + (size_t)r * D + c) = w;
    }
};
struct SgRelu2 {
    bf16* H;
    __device__ __forceinline__ int bsel(int) const { return 0; }
    __device__ __forceinline__ void operator()(int, int rl, int c, const f32x4& acc) const {
        f32x4 a = acc;
#pragma unroll
        for (int i = 0; i < 4; ++i) { a[i] = fmaxf(a[i], 0.f); a[i] *= a[i]; }
        v2u w; w.x = pk2(a[0], a[1]); w.y = pk2(a[2], a[3]);
        *(v2u*)(H + (size_t)(MP + rl) * FF + c) = w;
    }
};
struct SgCmpHid {
    bf16* HIDl; const float* B1l;
    __device__ __forceinline__ int bsel(int img) const { return img >> 1; }
    __device__ __forceinline__ void operator()(int img, int R, int c, const f32x4& acc) const {
        const f32x4 bb = *(const f32x4*)(B1l + (img >> 1) * 256 + c);
        f32x4 a = acc + bb;
#pragma unroll
        for (int i = 0; i < 4; ++i) a[i] = gelu_tanh(a[i]);
        v2u w; w.x = pk2(a[0], a[1]); w.y = pk2(a[2], a[3]);
        *(v2u*)(HIDl + ((size_t)img * NCB + R) * 256 + c) = w;
    }
};

#define LDS_WAIT() asm volatile("s_waitcnt lgkmcnt(0)" ::: "memory")
#define VM_WAIT() asm volatile("s_waitcnt vmcnt(0)" ::: "memory")

template <class CM>
__device__ __forceinline__ void transpose_item(const float* W, int ldw, int K, bf16* WT, LAS float* scr, int item, int nblk, int lane, const CM& cm) {
    const int kb = item / nblk, nb = item % nblk, k0 = 32 * kb, n0 = 64 * nb, c4 = (lane & 15) * 4;
    const int sc = cm.col(n0 + c4); const float scl = cm.scl(n0 + c4);
    f32x4 v[8];
#pragma unroll
    for (int i = 0; i < 8; ++i) { const int kk = 4 * i + (lane >> 4); v[i] = sc >= 0 ? *(const f32x4*)(W + (size_t)(k0 + kk) * ldw + sc) : (f32x4){0.f, 0.f, 0.f, 0.f}; }
#pragma unroll
    for (int i = 0; i < 8; ++i) { const int kk = 4 * i + (lane >> 4); LAS float* p = scr + kk * 65 + c4; p[0] = v[i][0] * scl; p[1] = v[i][1] * scl; p[2] = v[i][2] * scl; p[3] = v[i][3] * scl; }
    LDS_WAIT();
    const LAS float* s = scr + lane;
#pragma unroll
    for (int c = 0; c < 4; ++c) {
        v4u o; o.x = pk2(s[(8 * c + 0) * 65], s[(8 * c + 1) * 65]); o.y = pk2(s[(8 * c + 2) * 65], s[(8 * c + 3) * 65]); o.z = pk2(s[(8 * c + 4) * 65], s[(8 * c + 5) * 65]); o.w = pk2(s[(8 * c + 6) * 65], s[(8 * c + 7) * 65]);
        *(v4u*)(WT + (size_t)(n0 + lane) * K + k0 + 8 * c) = o; }
    LDS_WAIT();
}
struct CmId { __device__ __forceinline__ int col(int n) const { return n; } __device__ __forceinline__ float scl(int) const { return 1.f; } };
struct CmIn {
    __device__ __forceinline__ int col(int n) const { return n < 2048 ? n : (n < 3328 ? n + 8 : (n < 3336 ? n - 1280 : (n < 3360 ? n : -1))); }
    __device__ __forceinline__ float scl(int n) const { return (n >= 512 && n < 1024) ? 0.08838834764831845f : ((n >= 2048 && n < 2560) ? 0.18033688011112042f : 1.f); }
};

__device__ __forceinline__ int rel_bucket_dev(int n) {
    if (n < 16) return n;
    const float nf = (float)n;
    int large = 16 + (int)(__logf(nf / 16.f) / 2.0794415416798357f * 16.f);
    return large < 31 ? large : 31;
}

__device__ __forceinline__ void phase_p0a(CArgs& A, LAS unsigned char* lds, int gw, int NGW, int lane, int wave) {
    unsigned char* ws = A.ws;
    LAS float* scr = (LAS float*)(lds + wave * 16384);
    constexpr int I_IN = 16 * 112, I_OUT = 16 * 32, I_UP = 16 * 128, I_DN = 64 * 32, I_W1 = 32 * 8;
    constexpr int I_L = I_IN + I_OUT + I_UP + I_DN + 2 * I_W1;
    for (int it = gw; it < DEPTH * I_L; it += NGW) {
        const int l = it / I_L; int r = it % I_L;
        if (r < I_IN) { transpose_item(A.w_in + (size_t)l * D * 3360, 3360, D, (bf16*)(ws + WS_WIN) + (size_t)l * NINP * D, scr, r, 56, lane, CmIn{}); continue; } r -= I_IN;
        if (r < I_OUT) { transpose_item(A.w_out + (size_t)l * D * D, D, D, (bf16*)(ws + WS_WOUT) + (size_t)l * D * D, scr, r, 16, lane, CmId{}); continue; } r -= I_OUT;
        if (r < I_UP) { transpose_item(A.w_up + (size_t)l * D * FF, FF, D, (bf16*)(ws + WS_WUP) + (size_t)l * FF * D, scr, r, 64, lane, CmId{}); continue; } r -= I_UP;
        if (r < I_DN) { transpose_item(A.w_down + (size_t)l * FF * D, D, FF, (bf16*)(ws + WS_WDN) + (size_t)l * D * FF, scr, r, 16, lane, CmId{}); continue; } r -= I_DN;
        const int s = r / I_W1; r %= I_W1;
        transpose_item(A.cmp_w1 + (size_t)(l * 2 + s) * 2048 * 256, 256, 2048, (bf16*)(ws + WS_W1) + (size_t)(l * 2 + s) * 256 * 2048, scr, r, 4, lane, CmId{});
    }
    for (int it = gw; it < DEPTH * DB * NPG * 2; it += NGW) {
        const int half = it & 1, pg = (it >> 1) & 15, seq = (it >> 5) & 127, l = it >> 12;
        const int phys = A.page_table[seq * NPG + pg];
        const float* src = A.cache_cmp + (((size_t)l * NPHYS + phys) * PAGE + half * 64) * 256 + 4 * lane;
        const int cc = 4 * lane, s = cc >> 7, g = (cc >> 6) & 1, d = cc & 63;
        bf16* dst = (bf16*)(ws + WS_XC) + ((size_t)((l * 2 + s) * 2 + g) * XCP + MP + seq * PAST + pg * PAGE + half * 64) * 64 + d;
#pragma unroll 16
        for (int sl = 0; sl < 64; ++sl) { const f32x4 v = *(const f32x4*)(src + (size_t)sl * 256); v2u w; w.x = pk2(v[0], v[1]); w.y = pk2(v[2], v[3]); *(v2u*)(dst + (size_t)sl * 64) = w; }
    }
    for (int it = gw; it < 8; it += NGW) {
        float* BT = (float*)(ws + WS_BT) + it * 132;
        for (int dd = lane; dd < 132; dd += 64) BT[dd] = dd <= 128 ? A.rel_bias[rel_bucket_dev(dd) * 8 + it] * 1.4426950408889634f : -INFINITY;
    }
    for (int it = gw; it < DEPTH * 2 * 4 * 16; it += NGW) {
        const int kp = it & 15, hq = (it >> 4) & 3, ls = it >> 6, h = hq * 64 + lane;
        const float* pe = A.cmp_pe + (size_t)ls * 2048 + kp * 128; const float* w1 = A.cmp_w1 + ((size_t)ls * 2048 + kp * 128) * 256 + h;
        float acc = 0.f;
#pragma unroll 16
        for (int k = 0; k < 128; ++k) acc += pe[k] * w1[(size_t)k * 256];
        ((float*)(ws + WS_B1))[2048 + (ls * 16 + kp) * 256 + h] = acc;
    }
    for (int it = gw; it < DEPTH * 2 * 64; it += NGW) {
        const int d = it & 63, ls = it >> 6;
        for (int h = lane; h < 256; h += 64) ((bf16*)(ws + WS_W2T))[((size_t)ls * 64 + d) * 256 + h] = (bf16)f2bf(A.cmp_w2[((size_t)ls * 256 + h) * 64 + d]);
    }
}

__device__ __forceinline__ void b1_reduce(CArgs& A, int tid) {
    for (int i = blockIdx.x * NTHR + tid; i < DEPTH * 2 * 256; i += gridDim.x * NTHR) { const float* p = (const float*)(A.ws + WS_B1) + 2048 + (i >> 8) * 16 * 256 + (i & 255);
        float acc = 0.f;
#pragma unroll
        for (int kp = 0; kp < 16; ++kp) acc += p[kp * 256];
        ((float*)(A.ws + WS_B1))[i] = acc; }
}
__device__ __forceinline__ void phase_ada(CArgs& A, LAS unsigned char* lds, int tid) {
    LAS float* a = (LAS float*)lds;
    for (int task = blockIdx.x; task < DEPTH * 12 * 10; task += gridDim.x) {
        const int rb = task % 10, cb = (task / 10) % 12, l = task / 120;
        __syncthreads();
        for (int i = tid; i < 13 * 1024; i += NTHR) { const int row = rb * 13 + i / 1024, k = i & 1023;
            const float c = row < BATCH ? A.c_prompt[row * D + k] : A.c_sample[(row - BATCH) * D + k]; a[i] = c / (1.f + __expf(-c)); }
        __syncthreads();
        const int j = cb * 512 + tid;
        const float* w = A.w_ada + (size_t)l * D * 6144 + j;
        float acc[13];
#pragma unroll
        for (int r = 0; r < 13; ++r) acc[r] = 0.f;
        for (int k = 0; k < D; k += 4) { const float w0 = w[(size_t)k * 6144], w1 = w[(size_t)(k + 1) * 6144], w2 = w[(size_t)(k + 2) * 6144], w3 = w[(size_t)(k + 3) * 6144];
#pragma unroll
            for (int r = 0; r < 13; ++r) { const f32x4 a4 = *(const LAS f32x4*)(a + r * 1024 + k); acc[r] += (a4[0] * w0 + a4[1] * w1) + (a4[2] * w2 + a4[3] * w3); } }
        const float bb = A.b_ada[l * 6144 + j];
        float* o = (float*)(A.ws + WS_ADA) + ((size_t)l * NCOND + rb * 13) * 6144 + j;
#pragma unroll
        for (int r = 0; r < 13; ++r) o[(size_t)r * 6144] = acc[r] + bb;
    }
}

__device__ __forceinline__ void mod_row(const float* xrow, const float* sh, const float* sc, bf16* urow, int lane) {
#pragma unroll
    for (int j = 0; j < 4; ++j) { const int c = 4 * lane + 256 * j;
        const f32x4 x = *(const f32x4*)(xrow + c), a = *(const f32x4*)(sh + c), b = *(const f32x4*)(sc + c);
        v2u w; w.x = pk2(x[0] * (1.f + b[0]) + a[0], x[1] * (1.f + b[1]) + a[1]); w.y = pk2(x[2] * (1.f + b[2]) + a[2], x[3] * (1.f + b[3]) + a[3]);
        *(v2u*)(urow + c) = w; }
}
__device__ __forceinline__ void ln_row(const bf16* zrow, const float* g, const float* b, float* xout, const float* sh, const float* sc, bf16* urow, int lane) {
    f32x4 v[4]; float s = 0.f;
#pragma unroll
    for (int j = 0; j < 4; ++j) { const v2u z = *(const v2u*)(zrow + 4 * lane + 256 * j); v[j][0] = bflo(z.x); v[j][1] = bfhi(z.x); v[j][2] = bflo(z.y); v[j][3] = bfhi(z.y); s += (v[j][0] + v[j][1]) + (v[j][2] + v[j][3]); }
    const float mean = wave_sum(s) * (1.f / D); float s2 = 0.f;
#pragma unroll
    for (int j = 0; j < 4; ++j) { v[j] = v[j] - mean; s2 += (v[j][0] * v[j][0] + v[j][1] * v[j][1]) + (v[j][2] * v[j][2] + v[j][3] * v[j][3]); }
    const float rstd = 1.f / sqrtf(wave_sum(s2) * (1.f / D) + LN_EPS);
#pragma unroll
    for (int j = 0; j < 4; ++j) { const int c = 4 * lane + 256 * j;
        const f32x4 gg = *(const f32x4*)(g + c), bb = *(const f32x4*)(b + c);
        const f32x4 x = v[j] * rstd * gg + bb;
        *(f32x4*)(xout + c) = x;
        if (urow) { const f32x4 a = *(const f32x4*)(sh + c), q = *(const f32x4*)(sc + c);
            v2u w; w.x = pk2(x[0] * (1.f + q[0]) + a[0], x[1] * (1.f + q[1]) + a[1]); w.y = pk2(x[2] * (1.f + q[2]) + a[2], x[3] * (1.f + q[3]) + a[3]);
            *(v2u*)(urow + c) = w; } }
}

__device__ __forceinline__ float scan_sum256(float v, LAS float* buf, int tid) {
    const int lane = tid & 63, w = tid >> 6;
#pragma unroll
    for (int o = 1; o < 64; o <<= 1) { const float y = __shfl_up(v, o); if (lane >= o) v += y; }
    __syncthreads();
    if (lane == 63) buf[w] = v;
    __syncthreads();
    float add = 0.f;
#pragma unroll
    for (int i = 0; i < 3; ++i) if (i < w) add += buf[i];
    return v + add;
}
__device__ __forceinline__ float scan_max256(float v, LAS float* buf, int tid) {
    const int lane = tid & 63, w = tid >> 6;
#pragma unroll
    for (int o = 1; o < 64; o <<= 1) { const float y = __shfl_up(v, o); if (lane >= o) v = fmaxf(v, y); }
    __syncthreads();
    if (lane == 63) buf[w] = v;
    __syncthreads();
#pragma unroll
    for (int i = 0; i < 3; ++i) if (i < w) v = fmaxf(v, buf[i]);
    return v;
}
__device__ __forceinline__ void ml_gates(CArgs& A, int l, int r, int h, float& ig, float& lf) {
    const float* G = (const float*)(A.ws + WS_GATE) + (size_t)r * 32;
    ig = G[h] + A.b_gate[l * 8 + h];
    const float fr = G[4 + h] + A.b_gate[l * 8 + 4 + h];
    lf = fminf(fr, 0.f) - log1pf(__expf(-fabsf(fr)));
}

__device__ __forceinline__ void phase_m2(CArgs& A, int l, LAS unsigned char* lds, int tid) {
    LAS float* buf = (LAS float*)lds;
    LAS float* wl = (LAS float*)(lds + 1024);
    const bf16* QKVO = (const bf16*)(A.ws + WS_QKVO);
    for (int unit = blockIdx.x; unit < NUNIT; unit += gridDim.x) {
        const int b = unit >> 7, h = (unit >> 5) & 3, c = unit & 31, r0 = b * SEQ + c * LCH;
        float ig = 0.f, lf = 0.f;
        if (tid < 256) ml_gates(A, l, r0 + tid, h, ig, lf);
        const float F = scan_sum256(lf, buf, tid);
        __syncthreads();
        if (tid == 255) buf[16] = F;
        __syncthreads();
        const float Fend = buf[16];
        const float gl = tid < 256 ? Fend - F + ig : -3.0e38f;
        float mw = wave_max(gl);
        if ((tid & 63) == 0) buf[20 + (tid >> 6)] = mw;
        __syncthreads();
        const float mloc = fmaxf(fmaxf(buf[20], buf[21]), fmaxf(buf[22], buf[23]));
        if (tid < 256) wl[tid] = __expf(gl - mloc);
        if (tid == 0) { float* ch = (float*)(A.ws + WS_CHS) + unit * 4; ch[0] = Fend; ch[1] = mloc; }
        __syncthreads();
        const int k = tid & 127, vq = tid >> 7;
        float acc[32]; float accn = 0.f;
#pragma unroll
        for (int i = 0; i < 32; ++i) acc[i] = 0.f;
        const bf16* kp = QKVO + (size_t)r0 * 2048 + 512 + h * HD + k;
        const bf16* vp = QKVO + (size_t)r0 * 2048 + 1024 + h * HD + 32 * vq;
        for (int s = 0; s < LCH; ++s) {
            const float wk = wl[s] * bf2f(kp[(size_t)s * 2048]);
            accn += wk;
            const v4u* v4 = (const v4u*)(vp + (size_t)s * 2048);
#pragma unroll
            for (int q = 0; q < 4; ++q) { const v4u vv = v4[q];
                acc[8 * q + 0] += wk * bflo(vv.x); acc[8 * q + 1] += wk * bfhi(vv.x); acc[8 * q + 2] += wk * bflo(vv.y); acc[8 * q + 3] += wk * bfhi(vv.y);
                acc[8 * q + 4] += wk * bflo(vv.z); acc[8 * q + 5] += wk * bfhi(vv.z); acc[8 * q + 6] += wk * bflo(vv.w); acc[8 * q + 7] += wk * bfhi(vv.w); }
        }
        float* dct = (float*)(A.ws + WS_DCT) + ((size_t)unit * HD + 32 * vq) * HD + k;
#pragma unroll
        for (int i = 0; i < 32; ++i) dct[(size_t)i * HD] = acc[i];
        if (vq == 0) ((float*)(A.ws + WS_DN))[unit * HD + k] = accn;
        __syncthreads();
    }
}

__device__ __forceinline__ void phase_m3(CArgs& A, int l, int tid) {
    for (int task = blockIdx.x; task < BATCH * NH * 33; task += gridDim.x) {
        const int bh = task / 33, part = task % 33;
        const bool isn = part == 32; if (isn && tid >= HD) continue;
        const int e = isn ? tid : part * 512 + tid;
        const float* chs = (const float*)(A.ws + WS_CHS) + (size_t)bh * NCH * 4;
        float st = 0.f, m0 = 0.f;
        for (int c = 0; c < NCH; ++c) {
            const int unit = bh * NCH + c;
            const float Fend = chs[c * 4], mloc = chs[c * 4 + 1];
            float dv;
            if (isn) { ((float*)(A.ws + WS_NPV))[unit * HD + e] = st; dv = ((const float*)(A.ws + WS_DN))[unit * HD + e]; if (tid == 0) ((float*)(A.ws + WS_CHS))[unit * 4 + 2] = m0; }
            else { ((bf16*)(A.ws + WS_CTP))[(size_t)unit * HD * HD + e] = (bf16)f2bf(st); dv = ((const float*)(A.ws + WS_DCT))[(size_t)unit * HD * HD + e]; }
            const float mend = fmaxf(m0 + Fend, mloc);
            st = __expf(m0 + Fend - mend) * st + __expf(mloc - mend) * dv;
            m0 = mend;
        }
        if (isn) { A.out[O_NP + ((size_t)l * BATCH * NH + bh) * HD + e] = st; if (tid == 0) A.out[O_MP + l * BATCH * NH + bh] = m0; }
        else { const int v = e >> 7, k = e & 127; A.out[O_CP + (((size_t)l * BATCH * NH + bh) * HD + k) * HD + v] = st; }
    }
}

__device__ __forceinline__ void phase_m4(CArgs& A, int l, LAS unsigned char* lds, int tid) {
    LAS float* buf = (LAS float*)lds;
    LAS float* sa = (LAS float*)(lds + 1024);
    LAS float* smx = sa + 256;
    LAS float* sdec = smx + 256;
    LAS float* sem = sdec + 256;
    LAS bf16* sv = (LAS bf16*)(lds + 8192);
    const bf16* QKVO = (const bf16*)(A.ws + WS_QKVO);
    const int lane = tid & 63, wave = tid >> 6;
    for (int unit = blockIdx.x; unit < NUNIT; unit += gridDim.x) {
        const int b = unit >> 7, h = (unit >> 5) & 3, c = unit & 31, r0 = b * SEQ + c * LCH;
        float ig = 0.f, lf = 0.f;
        if (tid < 256) ml_gates(A, l, r0 + tid, h, ig, lf);
        const float F = scan_sum256(lf, buf, tid);
        const float a = tid < 256 ? ig - F : -3.0e38f;
        const float cm = scan_max256(a, buf, tid);
        const float m0 = ((const float*)(A.ws + WS_CHS))[unit * 4 + 2];
        if (tid < 256) { const float mx = fmaxf(m0, cm); sa[tid] = a; smx[tid] = mx; sdec[tid] = __expf(m0 - mx); sem[tid] = __expf(-(F + mx)); }
        for (int i = tid; i < LCH * HD / 8; i += NTHR) { const int s = i >> 4, q = i & 15;
            *(LAS v4u*)(sv + s * HD + 8 * q) = *(const v4u*)(QKVO + (size_t)(r0 + s) * 2048 + 1024 + h * HD + 8 * q); }
        __syncthreads();
        float* W = (float*)(A.ws + WS_WSC) + (size_t)unit * LCH * LCH;
        for (int idx = tid; idx < LCH * LCH; idx += NTHR) {
            const int t = idx >> 8, s = idx & 255; float w = 0.f;
            if (s <= t) {
                const v4u* qp = (const v4u*)(QKVO + (size_t)(r0 + t) * 2048 + h * HD); const v4u* kp = (const v4u*)(QKVO + (size_t)(r0 + s) * 2048 + 512 + h * HD);
                float d = 0.f;
#pragma unroll 4
                for (int q = 0; q < 16; ++q) { const v4u x = qp[q], y = kp[q];
                    d += bflo(x.x) * bflo(y.x) + bfhi(x.x) * bfhi(y.x) + bflo(x.y) * bflo(y.y) + bfhi(x.y) * bfhi(y.y)
                       + bflo(x.z) * bflo(y.z) + bfhi(x.z) * bfhi(y.z) + bflo(x.w) * bflo(y.w) + bfhi(x.w) * bfhi(y.w); }
                w = d * __expf(sa[s] - smx[t]);
            }
            W[idx] = w;
        }
        __syncthreads();
        {
            const int v = tid & 127, tq = tid >> 7;
            const bf16* ctp = (const bf16*)(A.ws + WS_CTP) + ((size_t)unit * HD + v) * HD;
            const float* npv = (const float*)(A.ws + WS_NPV) + unit * HD;
            float* hraw = (float*)(A.ws + WS_HRAW) + (size_t)unit * LCH * HD;
            for (int i = 0; i < 64; ++i) {
                const int t = 4 * i + tq;
                float num = 0.f, den = 0.f;
                const float* wr = W + (size_t)t * LCH;
                for (int s = 0; s <= t; s += 4) { const f32x4 w4 = *(const f32x4*)(wr + s);
                    num += w4[0] * bf2f(sv[(s + 0) * HD + v]) + w4[1] * bf2f(sv[(s + 1) * HD + v]) + w4[2] * bf2f(sv[(s + 2) * HD + v]) + w4[3] * bf2f(sv[(s + 3) * HD + v]);
                    den += (w4[0] + w4[1]) + (w4[2] + w4[3]); }
                float qc = 0.f, qn = 0.f;
                const v4u* qp = (const v4u*)(QKVO + (size_t)(r0 + t) * 2048 + h * HD);
#pragma unroll 4
                for (int q = 0; q < 16; ++q) { const v4u x = qp[q], y = *(const v4u*)(ctp + 8 * q); const f32x4 n0 = *(const f32x4*)(npv + 8 * q), n1 = *(const f32x4*)(npv + 8 * q + 4);
                    qc += bflo(x.x) * bflo(y.x) + bfhi(x.x) * bfhi(y.x) + bflo(x.y) * bflo(y.y) + bfhi(x.y) * bfhi(y.y)
                        + bflo(x.z) * bflo(y.z) + bfhi(x.z) * bfhi(y.z) + bflo(x.w) * bflo(y.w) + bfhi(x.w) * bfhi(y.w);
                    qn += bflo(x.x) * n0[0] + bfhi(x.x) * n0[1] + bflo(x.y) * n0[2] + bfhi(x.y) * n0[3] + bflo(x.z) * n1[0] + bfhi(x.z) * n1[1] + bflo(x.w) * n1[2] + bfhi(x.w) * n1[3]; }
                const float dec = sdec[t];
                const float numt = num + dec * qc, dent = den + dec * qn;
                hraw[(size_t)t * HD + v] = numt / fmaxf(fabsf(dent), sem[t]);
            }
        }
        __syncthreads();
        {
            const float* hraw = (const float*)(A.ws + WS_HRAW) + (size_t)unit * LCH * HD;
            const float g0 = A.ml_norm_g[l * 512 + h * HD + lane], g1 = A.ml_norm_g[l * 512 + h * HD + 64 + lane];
            for (int t = wave; t < LCH; t += NWAVES) {
                const float x0 = hraw[(size_t)t * HD + lane], x1 = hraw[(size_t)t * HD + 64 + lane];
                const float mu = wave_sum(x0 + x1) * (1.f / HD);
                const float d0 = x0 - mu, d1 = x1 - mu;
                const float rstd = 1.f / sqrtf(wave_sum(d0 * d0 + d1 * d1) * (1.f / HD) + LN_EPS);
                const bf16* op = QKVO + (size_t)(r0 + t) * 2048 + 1536 + h * HD;
                bf16* mp = (bf16*)(A.ws + WS_MIX) + (size_t)(r0 + t) * D + h * HD;
                mp[lane] = (bf16)f2bf(d0 * rstd * g0 * sigmoidf_(bf2f(op[lane])));
                mp[64 + lane] = (bf16)f2bf(d1 * rstd * g1 * sigmoidf_(bf2f(op[64 + lane])));
            }
        }
        __syncthreads();
    }
}

__device__ __forceinline__ void phase_mls(CArgs& A, int l, LAS unsigned char* lds, int tid) {
    LAS float* sq = (LAS float*)lds;
    LAS float* sc = sq + 1536;
    LAS float* sw = sc + 64;
    LAS float* part = sw + 16;
    LAS float* red = part + 2048;
    const bf16* QKVO = (const bf16*)(A.ws + WS_QKVO);
    for (int task = blockIdx.x; task < DB * NH; task += gridDim.x) {
        const int seq = task >> 2, h = task & 3, r0 = MP + seq * DS, sidx = (l * DB + seq) * NH + h;
        __syncthreads();
        for (int i = tid; i < 1536; i += NTHR) { const int which = i >> 9, t = (i >> 7) & 3, d = i & 127; sq[i] = bf2f(QKVO[(size_t)(r0 + t) * 2048 + which * 512 + h * HD + d]); }
        const float m0 = A.st_m[sidx];
        if (tid == 0) {
            float F = 0.f, cmx = -3.0e38f, Fs[4], igs[4], mlast = 0.f;
#pragma unroll
            for (int t = 0; t < 4; ++t) { float ig, lf; ml_gates(A, l, r0 + t, h, ig, lf); F += lf; Fs[t] = F; igs[t] = ig; const float a = ig - F; cmx = fmaxf(cmx, a); const float mx = fmaxf(m0, cmx);
                sc[8 + t] = a; sc[12 + t] = mx; sc[16 + t] = __expf(m0 - mx); sc[20 + t] = __expf(-(F + mx)); mlast = F + mx; }
#pragma unroll
            for (int t = 0; t < 4; ++t) sc[24 + t] = __expf(Fs[3] - Fs[t] + igs[t] - mlast);
            sc[28] = __expf(Fs[3] + m0 - mlast); sc[29] = mlast;
        }
        __syncthreads();
        if (tid < 16) { const int t = tid >> 2, s = tid & 3; float w = 0.f;
            if (s <= t) { float d = 0.f; for (int k = 0; k < HD; ++k) d += sq[t * HD + k] * sq[512 + s * HD + k]; w = d * __expf(sc[8 + s] - sc[12 + t]); }
            sw[tid] = w; }
        else if (tid < 20) { const int t = tid - 16; const float* n0 = A.st_n + (size_t)sidx * HD; float d = 0.f; for (int k = 0; k < HD; ++k) d += sq[t * HD + k] * n0[k]; sc[32 + t] = d; }
        __syncthreads();
        {
            const int v = tid & 127, kq = tid >> 7;
            const float* C0 = A.st_C + (size_t)sidx * HD * HD; float* Co = A.out + O_CS + (size_t)sidx * HD * HD;
            const float cd = sc[28];
            float wv[4]; float qc[4] = {0.f, 0.f, 0.f, 0.f};
#pragma unroll
            for (int t = 0; t < 4; ++t) wv[t] = sc[24 + t] * sq[1024 + t * HD + v];
            for (int kk = 0; kk < 32; ++kk) { const int k = kq * 32 + kk; const float c0 = C0[(size_t)k * HD + v];
                float cn = cd * c0;
#pragma unroll
                for (int t = 0; t < 4; ++t) { qc[t] += sq[t * HD + k] * c0; cn += wv[t] * sq[512 + t * HD + k]; }
                Co[(size_t)k * HD + v] = cn; }
#pragma unroll
            for (int t = 0; t < 4; ++t) part[(kq * 4 + t) * HD + v] = qc[t];
        }
        __syncthreads();
        float hv[4] = {0.f, 0.f, 0.f, 0.f};
        if (tid < HD) {
            const int v = tid;
#pragma unroll
            for (int t = 0; t < 4; ++t) { const float qct = part[(0 * 4 + t) * HD + v] + part[(1 * 4 + t) * HD + v] + part[(2 * 4 + t) * HD + v] + part[(3 * 4 + t) * HD + v];
                float num = sc[16 + t] * qct, den = sc[16 + t] * sc[32 + t];
#pragma unroll
                for (int s = 0; s < 4; ++s) { num += sw[t * 4 + s] * sq[1024 + s * HD + v]; den += sw[t * 4 + s]; }
                hv[t] = num / fmaxf(fabsf(den), sc[20 + t]); }
        }
#pragma unroll
        for (int t = 0; t < 4; ++t) { const float s1 = wave_sum(hv[t]); if ((tid & 63) == 0 && tid < HD) red[t * 2 + (tid >> 6)] = s1; }
        __syncthreads();
        float dv[4];
#pragma unroll
        for (int t = 0; t < 4; ++t) { dv[t] = hv[t] - (red[t * 2] + red[t * 2 + 1]) * (1.f / HD); const float s2 = wave_sum(dv[t] * dv[t]); if ((tid & 63) == 0 && tid < HD) red[8 + t * 2 + (tid >> 6)] = s2; }
        __syncthreads();
        if (tid < HD) {
            const int v = tid; const float gn = A.ml_norm_g[l * 512 + h * HD + v];
#pragma unroll
            for (int t = 0; t < 4; ++t) { const float rstd = 1.f / sqrtf((red[8 + t * 2] + red[8 + t * 2 + 1]) * (1.f / HD) + LN_EPS);
                const float og = bf2f(QKVO[(size_t)(r0 + t) * 2048 + 1536 + h * HD + v]);
                ((bf16*)(A.ws + WS_MIX))[(size_t)(r0 + t) * D + h * HD + v] = (bf16)f2bf(dv[t] * rstd * gn * sigmoidf_(og)); }
        } else if (tid < 2 * HD) {
            const int k = tid - HD; float nn = sc[28] * A.st_n[(size_t)sidx * HD + k];
#pragma unroll
            for (int t = 0; t < 4; ++t) nn += sc[24 + t] * sq[512 + t * HD + k];
            A.out[O_NS + (size_t)sidx * HD + k] = nn;
        }
        if (tid == 0) A.out[O_MS + sidx] = sc[29];
    }
}

typedef short bf16x8c __attribute__((ext_vector_type(8)));
__device__ __forceinline__ void phase_cmp2(CArgs& A, int l0, int nl, int r_lo, int nrows, int gw, int NGW, int lane) {
    const int fr = lane & 15, fq = lane >> 4, ntile = nrows / 16;
    for (int task = gw; task < nl * 4 * ntile; task += NGW) {
        const int img = task / ntile, tr = task % ntile, l = l0 + (img >> 2), sg = img & 3, s = sg >> 1, g = sg & 1, R0 = r_lo + tr * 16;
        const bf16* hp = (const bf16*)(A.ws + WS_HID) + ((size_t)(l * 4 + sg) * NCB + R0 + fr) * 256 + 8 * fq;
        const bf16* wp = (const bf16*)(A.ws + WS_W2T) + ((size_t)(l * 2 + s) * 64 + fr) * 256 + 8 * fq;
        f32x4 acc[4];
#pragma unroll
        for (int dt = 0; dt < 4; ++dt) acc[dt] = (f32x4){0.f, 0.f, 0.f, 0.f};
#pragma unroll
        for (int ks = 0; ks < 8; ++ks) {
            const bf16x8c hf = *(const bf16x8c*)(hp + 32 * ks);
#pragma unroll
            for (int dt = 0; dt < 4; ++dt) { const bf16x8c wf = *(const bf16x8c*)(wp + (size_t)dt * 16 * 256 + 32 * ks);
                acc[dt] = s == 0 ? __builtin_amdgcn_mfma_f32_16x16x32_bf16(wf, hf, acc[dt], 0, 0, 0) : __builtin_amdgcn_mfma_f32_16x16x32_bf16(hf, wf, acc[dt], 0, 0, 0); }
        }
        if (s == 0) {
            bf16* o = (bf16*)(A.ws + WS_KC) + ((size_t)(l * 2 + g) * NCB + R0 + fr) * 64 + 4 * fq;
#pragma unroll
            for (int dt = 0; dt < 4; ++dt) { v2u w; w.x = pk2(acc[dt][0], acc[dt][1]); w.y = pk2(acc[dt][2], acc[dt][3]); *(v2u*)(o + 16 * dt) = w; }
        } else {
            bf16* o = (bf16*)(A.ws + WS_VCT) + (size_t)(l * 2 + g) * 64 * NCB + (size_t)(R0 >> 6) * 4096 + fr * 64 + (R0 & 63) + 4 * fq;
#pragma unroll
            for (int dt = 0; dt < 4; ++dt) { v2u w; w.x = pk2(acc[dt][0], acc[dt][1]); w.y = pk2(acc[dt][2], acc[dt][3]); *(v2u*)(o + dt * 16 * 64) = w; }
        }
    }
}

__device__ __forceinline__ void topk_sel(float imp0, float imp1, int cur, int lane, unsigned long long& s0, unsigned long long& s1) {
    const int nforced = cur == 0 ? 1 : (cur == 1 ? 2 : 3), need = 16 - nforced, ncand = cur - 2 > 0 ? cur - 2 : 0;
    const unsigned k0 = (lane >= 1 && lane <= cur - 2) ? __builtin_bit_cast(unsigned, imp0) + 1u : 0u;
    const unsigned k1 = (lane + 64 <= cur - 2) ? __builtin_bit_cast(unsigned, imp1) + 1u : 0u;
    unsigned long long c0, c1;
    if (ncand <= need) { c0 = __ballot(k0 != 0u); c1 = __ballot(k1 != 0u); }
    else {
        unsigned T = 0u;
        for (int bit = 31; bit >= 0; --bit) { const unsigned cand = T | (1u << bit);
            const int cnt = __popcll(__ballot(k0 >= cand)) + __popcll(__ballot(k1 >= cand)); if (cnt >= need) T = cand; }
        const unsigned long long g0 = __ballot(k0 > T), g1 = __ballot(k1 > T); unsigned long long e0 = __ballot(k0 == T), e1 = __ballot(k1 == T);
        int rem = need - __popcll(g0) - __popcll(g1);
        unsigned long long t0 = 0ull, t1 = 0ull;
        while (rem > 0 && e0) { const unsigned long long lb = e0 & (~e0 + 1ull); t0 |= lb; e0 ^= lb; --rem; }
        while (rem > 0 && e1) { const unsigned long long lb = e1 & (~e1 + 1ull); t1 |= lb; e1 ^= lb; --rem; }
        c0 = g0 | t0; c1 = g1 | t1;
    }
    unsigned long long f0 = 1ull, f1 = 0ull;
    if (cur < 64) f0 |= 1ull << cur; else f1 |= 1ull << (cur - 64);
    if (cur >= 1) { if (cur - 1 < 64) f0 |= 1ull << (cur - 1); else f1 |= 1ull << (cur - 65); }
    s0 = c0 | f0; s1 = c1 | f1;
}


typedef short bf16x8 __attribute__((ext_vector_type(8)));
#define MFMA16(a, b, c) __builtin_amdgcn_mfma_f32_16x16x32_bf16((a), (b), (c), 0, 0, 0)
constexpr int TOTS = MP + DB * 2112, WSTR = 576, TOTW = MP + DB * WSTR, TOTWP = TOTW + 64;
constexpr size_t KS_L = (size_t)2 * TOTS * 64, KW_L = (size_t)2 * TOTWP * 64, KC_L = (size_t)2 * NCB * 64;

template <int NP>
__device__ __forceinline__ void kv_tile(const float* src, bf16* Kimg, size_t kgs, bf16* Vt, size_t vgs, size_t vpitch, size_t gp0, LAS bf16* scr, int lane, float* cdst = nullptr, int cskip = 0) {
    const int cc = 4 * lane, s = cc >> 7, g = (cc >> 6) & 1, d = cc & 63;
#pragma unroll 16
    for (int sl = 0; sl < NP; ++sl) {
        const f32x4 v = *(const f32x4*)(src + (size_t)sl * 256 + cc);
        if (cdst && sl >= cskip) *(f32x4*)(cdst + (size_t)sl * 256 + cc) = v;
        v2u w; w.x = pk2(v[0], v[1]); w.y = pk2(v[2], v[3]);
        if (s == 0) *(v2u*)(Kimg + (size_t)g * kgs + (gp0 + sl) * 64 + d) = w;
        else *(LAS v2u*)(scr + sl * 128 + (cc - 128)) = w;
    }
    LDS_WAIT();
#pragma unroll
    for (int g2 = 0; g2 < 2; ++g2) {
        const int gd = lane + 64 * g2;
        bf16* dst = Vt + (size_t)g2 * vgs + (gp0 >> 6) * 4096 + (size_t)lane * 64 + (gp0 & 63);
#pragma unroll
        for (int oc = 0; oc < NP / 8; ++oc) {
            const LAS bf16* p = scr + (8 * oc) * 128 + gd;
            v4u o; o.x = (unsigned)p[0] | ((unsigned)p[128] << 16); o.y = (unsigned)p[256] | ((unsigned)p[384] << 16); o.z = (unsigned)p[512] | ((unsigned)p[640] << 16); o.w = (unsigned)p[768] | ((unsigned)p[896] << 16);
            *(v4u*)(dst + 8 * oc) = o;
        }
    }
    LDS_WAIT();
}
#define kv_tile64 kv_tile<64>

__device__ __forceinline__ void prep_cache_images(CArgs& A, LAS unsigned char* lds, int gw, int NGW, int lane, int wave) {
    LAS bf16* scr = (LAS bf16*)(lds + wave * 16384);
    bf16* KS = (bf16*)(A.ws + WS_KS); bf16* VTS = (bf16*)(A.ws + WS_VTS); bf16* KW = (bf16*)(A.ws + WS_KW); bf16* VTW = (bf16*)(A.ws + WS_VTW);
    for (int it = gw; it < DEPTH * DB * 32; it += NGW) {
        const int ti = it & 31, seq = (it >> 5) & 127, l = it >> 12;
        const int phys = A.page_table[seq * NPG + (ti >> 1)];
        const float* src = A.cache_slc + (((size_t)l * NPHYS + phys) * PAGE + (ti & 1) * 64) * 256;
        kv_tile64(src, KS + l * KS_L, (size_t)TOTS * 64, VTS + l * KS_L, (size_t)64 * TOTS, TOTS, (size_t)MP + seq * 2112 + ti * 64, scr, lane);
    }
    for (int it = gw; it < DEPTH * DB * 8; it += NGW) {
        const int ti = it & 7, ls = it >> 3, seq = ls & 127, l = ls >> 7;
        const float* src = A.cache_win + ((size_t)ls * 512 + ti * 64) * 256;
        kv_tile64(src, KW + l * KW_L, (size_t)TOTWP * 64, VTW + l * KW_L, (size_t)64 * TOTWP, TOTWP, (size_t)MP + seq * WSTR + ti * 64, scr, lane,
                  A.out + O_WINS + ((size_t)ls * 512 + ti * 64) * 256 - 4 * 256, ti == 0 ? 4 : 0);
    }
}
__device__ __forceinline__ void prep_layer_images(CArgs& A, int l, LAS unsigned char* lds, int gw, int NGW, int lane, int wave) {
    LAS bf16* scr = (LAS bf16*)(lds + wave * 16384);
    bf16* KS = (bf16*)(A.ws + WS_KS) + l * KS_L; bf16* VTS = (bf16*)(A.ws + WS_VTS) + l * KS_L; bf16* KW = (bf16*)(A.ws + WS_KW) + l * KW_L; bf16* VTW = (bf16*)(A.ws + WS_VTW) + l * KW_L;
    const float* KVR = (const float*)(A.ws + WS_KVR);
    for (int it = gw; it < 2 * (MP / 16); it += NGW) {
        const int kind = it / (MP / 16), ti = it % (MP / 16);
        const float* src = KVR + ((size_t)(1 + kind) * M + ti * 16) * 256;
        if (kind == 0) kv_tile<16>(src, KS, (size_t)TOTS * 64, VTS, (size_t)64 * TOTS, TOTS, (size_t)ti * 16, scr, lane);
        else           kv_tile<16>(src, KW, (size_t)TOTWP * 64, VTW, (size_t)64 * TOTWP, TOTWP, (size_t)ti * 16, scr, lane);
    }
    for (int it = gw; it < 2 * DB; it += NGW) {
        const int kind = it / DB, seq = it % DB;
        const float* src = KVR + ((size_t)(1 + kind) * M + MP + seq * DS) * 256;
        bf16* Kimg = kind == 0 ? KS : KW; bf16* Vt = kind == 0 ? VTS : VTW;
        const size_t tot = kind == 0 ? TOTS : TOTWP, gp0 = kind == 0 ? (size_t)MP + seq * 2112 + PAST : (size_t)MP + seq * WSTR + 512;
        const int cc = 4 * lane, s = cc >> 7, g = (cc >> 6) & 1, d = cc & 63;
#pragma unroll
        for (int t = 0; t < DS; ++t) {
            const f32x4 v = *(const f32x4*)(src + (size_t)t * 256 + cc);
            if (s == 0) { v2u w; w.x = pk2(v[0], v[1]); w.y = pk2(v[2], v[3]); *(v2u*)(Kimg + (size_t)g * tot * 64 + (gp0 + t) * 64 + d) = w; }
            else {
#pragma unroll
                for (int i = 0; i < 4; ++i) Vt[(size_t)g * 64 * tot + ((gp0 + t) >> 6) * 4096 + (size_t)(d + i) * 64 + ((gp0 + t) & 63)] = (bf16)f2bf(v[i]);
            }
        }
    }
}

struct KV { bf16x8 k[8]; v4u v[8]; };
__device__ __forceinline__ void k_load(KV& f, const bf16* Kb, int fr, int fq) {
#pragma unroll
    for (int t = 0; t < 4; ++t) { f.k[2 * t] = *(const bf16x8*)(Kb + (size_t)(16 * t + fr) * 64 + 8 * fq); f.k[2 * t + 1] = *(const bf16x8*)(Kb + (size_t)(16 * t + fr) * 64 + 32 + 8 * fq); }
}
__device__ __forceinline__ void v_load(KV& f, const bf16* Vb, size_t pitch, int fr, int fq) {
#pragma unroll
    for (int h = 0; h < 2; ++h)
#pragma unroll
        for (int dt = 0; dt < 4; ++dt) { const bf16* vp = Vb + (size_t)(16 * dt + fr) * pitch + 32 * h + 4 * fq;
            const v2u a = *(const v2u*)vp, b = *(const v2u*)(vp + 16); v4u w; w.x = a.x; w.y = a.y; w.z = b.x; w.w = b.y; f.v[4 * h + dt] = w; }
}
__device__ __forceinline__ void qk_frag(const KV& f, const bf16x8 (&q)[2], f32x4 (&st)[4]) {
#pragma unroll
    for (int t = 0; t < 4; ++t) { f32x4 z = {0.f, 0.f, 0.f, 0.f}; z = MFMA16(f.k[2 * t], q[0], z); st[t] = MFMA16(f.k[2 * t + 1], q[1], z); }
}
__device__ __forceinline__ void pv_frag(const KV& f, const f32x4 (&st)[4], f32x4 (&o)[4]) {
#pragma unroll
    for (int h = 0; h < 2; ++h) {
        v4u pw; pw.x = pk2(st[2 * h][0], st[2 * h][1]); pw.y = pk2(st[2 * h][2], st[2 * h][3]); pw.z = pk2(st[2 * h + 1][0], st[2 * h + 1][1]); pw.w = pk2(st[2 * h + 1][2], st[2 * h + 1][3]);
        const bf16x8 pf = __builtin_bit_cast(bf16x8, pw);
#pragma unroll
        for (int dt = 0; dt < 4; ++dt) o[dt] = MFMA16(__builtin_bit_cast(bf16x8, f.v[4 * h + dt]), pf, o[dt]);
    }
}
__device__ __forceinline__ float xfq_max(float v) { v = fmaxf(v, __shfl_xor(v, 16)); return fmaxf(v, __shfl_xor(v, 32)); }
__device__ __forceinline__ float xfq_sum(float v) { v += __shfl_xor(v, 16); return v + __shfl_xor(v, 32); }
__device__ __forceinline__ float quad_sum(float v) { v += __shfl_xor(v, 1); return v + __shfl_xor(v, 2); }

__device__ __forceinline__ void softmax_pv(const KV& f, f32x4 (&st)[4], f32x4 (&o)[4], float& m, float& ls) {
    float bm = -INFINITY;
#pragma unroll
    for (int t = 0; t < 4; ++t) bm = fmaxf(bm, fmaxf(fmaxf(st[t][0], st[t][1]), fmaxf(st[t][2], st[t][3])));
    bm = xfq_max(bm);
    const float mn = fmaxf(m, bm), sc = __builtin_amdgcn_exp2f(m - mn);
    m = mn; ls *= sc;
#pragma unroll
    for (int dt = 0; dt < 4; ++dt) o[dt] = o[dt] * sc;
#pragma unroll
    for (int t = 0; t < 4; ++t)
#pragma unroll
        for (int i = 0; i < 4; ++i) { const float p = __builtin_amdgcn_exp2f(st[t][i] - mn); st[t][i] = p; ls += p; }
    pv_frag(f, st, o);
}
template <class Br>
__device__ __forceinline__ void run_branch(Br& br, const bf16x8 (&q)[2], int fr, int fq, f32x4 (&o)[4], float& m, float& ls) {
    int j;
    if (!br.first(j)) return;
    KV cur; k_load(cur, br.kp(j), fr, fq); v_load(cur, br.vp(j), br.pitch, fr, fq);
    for (;;) {
        int jn = 0; const bool hn = br.next(jn);
        KV nxt;
        if (hn) { k_load(nxt, br.kp(jn), fr, fq); v_load(nxt, br.vp(jn), br.pitch, fr, fq); }
        f32x4 st[4]; qk_frag(cur, q, st);
        br.mask(st, j);
        softmax_pv(cur, st, o, m, ls);
        if (!hn) break;
        cur = nxt; j = jn;
    }
}
struct BrSel {
    const bf16* K; const bf16* V; size_t pitch; unsigned long long u0, u1, my0, my1; int cur, qpos, fq; const LAS float* bt; float farb;
    __device__ __forceinline__ bool pop(int& j) { if (u0) { j = __builtin_ctzll(u0); u0 &= u0 - 1ull; return true; } if (u1) { j = 64 + __builtin_ctzll(u1); u1 &= u1 - 1ull; return true; } return false; }
    __device__ __forceinline__ bool first(int& j) { return pop(j); }
    __device__ __forceinline__ bool next(int& j) { return pop(j); }
    __device__ __forceinline__ const bf16* kp(int j) const { return K + (size_t)j * 64 * 64; }
    __device__ __forceinline__ const bf16* vp(int j) const { return V + (size_t)j * 4096; }
    __device__ __forceinline__ void mask(f32x4 (&st)[4], int j) const {
        const bool mine = j < 64 ? ((my0 >> j) & 1ull) != 0ull : ((my1 >> (j - 64)) & 1ull) != 0ull;
        if (j >= cur - 2) {
#pragma unroll
            for (int t = 0; t < 4; ++t)
#pragma unroll
                for (int i = 0; i < 4; ++i) { const int dist = qpos - (64 * j + 16 * t + 4 * fq + i); st[t][i] = st[t][i] + bt[(!mine || dist < 0) ? 129 : (dist > 128 ? 128 : dist)]; }
        } else {
#pragma unroll
            for (int t = 0; t < 4; ++t)
#pragma unroll
                for (int i = 0; i < 4; ++i) st[t][i] = mine ? st[t][i] + farb : -INFINITY;
        }
    }
};
struct BrWin {
    const bf16* K; const bf16* V; size_t pitch; int jb, cur, qpos, fq; const LAS float* bt;
    __device__ __forceinline__ bool first(int& j) { j = jb; return jb <= cur; }
    __device__ __forceinline__ bool next(int& j) { ++jb; j = jb; return jb <= cur; }
    __device__ __forceinline__ const bf16* kp(int j) const { return K + (long)j * 64 * 64; }
    __device__ __forceinline__ const bf16* vp(int j) const { return V + (long)j * 4096; }
    __device__ __forceinline__ void mask(f32x4 (&st)[4], int j) const {
#pragma unroll
        for (int t = 0; t < 4; ++t)
#pragma unroll
            for (int i = 0; i < 4; ++i) { const int dist = qpos - (64 * j + 16 * t + 4 * fq + i); st[t][i] = st[t][i] + bt[(unsigned)dist >= 512u ? 129 : (dist > 128 ? 128 : dist)]; }
    }
};

__device__ __forceinline__ void nsa_tile(CArgs& A, int l, bool smp, int bs, int g, int tq, LAS float* wl, const LAS float* BT, int lane) {
    asm volatile("" : "+v"(lane));
    const int fr = lane & 15, fq = lane >> 4, tl = fr >> 2, rr = fr & 3;
    const int qpos0 = smp ? PAST : 4 * tq, row0 = smp ? MP + bs * DS : bs * SEQ + qpos0;
    const int qpos = qpos0 + tl, cur = qpos0 >> 6, h = g * 4 + rr;
    const size_t sbase = smp ? (size_t)MP + bs * 2112 : (size_t)bs * SEQ;
    const long wbase = smp ? (long)MP + bs * WSTR - (PAST - 512) : (long)bs * SEQ;
    const size_t cbase = smp ? (size_t)1024 + bs * 128 : (size_t)bs * 512;
    const bf16* KS = (const bf16*)(A.ws + WS_KS) + l * KS_L + (size_t)g * TOTS * 64; const bf16* VTS = (const bf16*)(A.ws + WS_VTS) + l * KS_L + (size_t)g * 64 * TOTS;
    const bf16* KW = (const bf16*)(A.ws + WS_KW) + l * KW_L + (size_t)g * TOTWP * 64; const bf16* VTW = (const bf16*)(A.ws + WS_VTW) + l * KW_L + (size_t)g * 64 * TOTWP;
    const bf16* KC = (const bf16*)(A.ws + WS_KC) + l * KC_L + (size_t)g * NCB * 64 + cbase * 64; const bf16* VCT = (const bf16*)(A.ws + WS_VCT) + l * KC_L + (size_t)g * 64 * NCB + (cbase >> 6) * 4096;
    const LAS float* bt = BT + h * 132;
    const float farb = bt[128];
    bf16x8 q[2];
    {   const bf16* qp = (const bf16*)(A.ws + WS_NQ) + (size_t)(row0 + tl) * 512 + g * 256 + rr * 64 + 8 * fq;
        q[0] = *(const bf16x8*)qp; q[1] = *(const bf16x8*)(qp + 32); }
    const float* gt = (const float*)(A.ws + WS_GATE) + (size_t)(row0 + tl) * 32 + 8 + h * 3;
    const float gc = sigmoidf_(gt[0]), gs = sigmoidf_(gt[1]), gwn = sigmoidf_(gt[2]);
    f32x4 out[4];
#pragma unroll
    for (int dt = 0; dt < 4; ++dt) out[dt] = (f32x4){0.f, 0.f, 0.f, 0.f};
    LAS float* impA = wl;
    LAS float* impB = wl + 544;
    for (int i = lane; i < 1088; i += 64) wl[i] = 0.f;
    LDS_WAIT();

    {
        const int ncv_max = qpos0 + 3 >= 31 ? ((qpos0 + 3 - 31) >> 4) + 1 : 0, nb64 = (ncv_max + 63) >> 6;
        float m = -1.0e30f, ls = 0.f;
        {
            for (int ib = 0; ib < nb64; ++ib) {
                KV cur; k_load(cur, KC + (size_t)ib * 64 * 64, fr, fq);
                f32x4 st[4]; qk_frag(cur, q, st);
                float bm = -INFINITY;
#pragma unroll
                for (int t = 0; t < 4; ++t)
#pragma unroll
                    for (int i = 0; i < 4; ++i) { const int n = 64 * ib + 16 * t + 4 * fq + i; const int dist = qpos - 16 * n - 31;
                        const float s = st[t][i] + bt[dist < 0 ? 129 : (dist > 128 ? 128 : dist)]; st[t][i] = s; bm = fmaxf(bm, s); }
                bm = xfq_max(bm);
                const float mn = fmaxf(m, bm); ls *= __builtin_amdgcn_exp2f(m - mn); m = mn;
#pragma unroll
                for (int t = 0; t < 4; ++t)
#pragma unroll
                    for (int i = 0; i < 4; ++i) ls += __builtin_amdgcn_exp2f(st[t][i] - mn);
            }
        }
        ls = xfq_sum(ls);
        const float inv = ls > 0.f ? 1.f / ls : 0.f;
        f32x4 o[4];
#pragma unroll
        for (int dt = 0; dt < 4; ++dt) o[dt] = (f32x4){0.f, 0.f, 0.f, 0.f};
        {
            for (int ib = 0; ib < nb64; ++ib) {
                KV cur; k_load(cur, KC + (size_t)ib * 64 * 64, fr, fq); v_load(cur, VCT + (size_t)ib * 4096, 64, fr, fq);
                f32x4 st[4]; qk_frag(cur, q, st);
#pragma unroll
                for (int t = 0; t < 4; ++t) {
#pragma unroll
                    for (int i = 0; i < 4; ++i) { const int n = 64 * ib + 16 * t + 4 * fq + i; const int dist = qpos - 16 * n - 31;
                        st[t][i] = __builtin_amdgcn_exp2f(st[t][i] + bt[dist < 0 ? 129 : (dist > 128 ? 128 : dist)] - m) * inv; }
                    const float s4 = quad_sum((st[t][0] + st[t][1]) + (st[t][2] + st[t][3])), s3 = quad_sum(st[t][3]);
                    const int j0 = 16 * ib + 4 * t + fq;
                    if (rr == 0) { impA[tl * 136 + j0] = s4; impB[tl * 136 + j0 + 1] = s3; }
                }
                pv_frag(cur, st, o);
            }
        }
#pragma unroll
        for (int dt = 0; dt < 4; ++dt) out[dt] = out[dt] + o[dt] * gc;
    }
    LDS_WAIT();
    unsigned long long s0[4], s1[4];
#pragma unroll
    for (int t = 0; t < 4; ++t) topk_sel(impA[t * 136 + lane] + impB[t * 136 + lane], impA[t * 136 + 64 + lane] + impB[t * 136 + 64 + lane], cur, lane, s0[t], s1[t]);
    {
        float m = -1.0e30f, ls = 0.f; f32x4 o[4];
#pragma unroll
        for (int dt = 0; dt < 4; ++dt) o[dt] = (f32x4){0.f, 0.f, 0.f, 0.f};
        BrSel br{KS + sbase * 64, VTS + (sbase >> 6) * 4096, (size_t)64, (s0[0] | s0[1]) | (s0[2] | s0[3]), (s1[0] | s1[1]) | (s1[2] | s1[3]),
                 tl == 0 ? s0[0] : (tl == 1 ? s0[1] : (tl == 2 ? s0[2] : s0[3])), tl == 0 ? s1[0] : (tl == 1 ? s1[1] : (tl == 2 ? s1[2] : s1[3])), cur, qpos, fq, bt, farb};
        run_branch(br, q, fr, fq, o, m, ls);
        ls = xfq_sum(ls);
        const float w = ls > 0.f ? gs / ls : 0.f;
#pragma unroll
        for (int dt = 0; dt < 4; ++dt) out[dt] = out[dt] + o[dt] * w;
    }
    {
        float m = -1.0e30f, ls = 0.f; f32x4 o[4];
#pragma unroll
        for (int dt = 0; dt < 4; ++dt) o[dt] = (f32x4){0.f, 0.f, 0.f, 0.f};
        const int lo_blk = smp ? (PAST - 512) >> 6 : 0; int jb = (qpos0 - 511) >> 6; if (jb < lo_blk) jb = lo_blk;
        BrWin br{KW + wbase * 64, VTW + (wbase >> 6) * 4096, (size_t)64, jb, cur, qpos, fq, bt};
        run_branch(br, q, fr, fq, o, m, ls);
        ls = xfq_sum(ls);
        const float w = ls > 0.f ? gwn / ls : 0.f;
#pragma unroll
        for (int dt = 0; dt < 4; ++dt) out[dt] = out[dt] + o[dt] * w;
    }
    bf16* mp = (bf16*)(A.ws + WS_MIX) + (size_t)(row0 + tl) * D + 512 + h * 64 + 4 * fq;
#pragma unroll
    for (int dt = 0; dt < 4; ++dt) { v2u w; w.x = pk2(out[dt][0], out[dt][1]); w.y = pk2(out[dt][2], out[dt][3]); *(v2u*)(mp + 16 * dt) = w; }
}
__device__ __forceinline__ void phase_nsa(CArgs& A, int l, LAS float* wl, const LAS float* BT, int lane, int wave) {
    const int G = gridDim.x, bx = blockIdx.x;
    const bool xmap = (G & 7) == 0;
    const int x = bx & 7, nw = (G >> 3) * NWAVES, ww = (bx >> 3) * NWAVES + wave;
    const int gwv = bx * NWAVES + wave, ngw = G * NWAVES;
    for (int it = 0;; ++it) {
        bool smp; int bs, g, tq;
        if (xmap) {
            const int np = ww < 512 ? 2 * ((512 - ww + nw - 1) / nw) : 0;
            if (it < np) { const int i = ww + nw * (it >> 1), tq2 = (it & 1) ? 1023 - i : i; smp = false; bs = x >> 2; g = (x >> 1) & 1; tq = 2 * tq2 + (x & 1); }
            else { const int t = ww * 8 + x + 8 * nw * (it - np); if (t >= 2 * DB) break; smp = true; bs = t >> 1; g = t & 1; tq = 0; }
        } else {
            const int t = gwv + ngw * it; if (t >= 4 * 2048 + 2 * DB) break;
            if (t < 4 * 2048) { smp = false; bs = t >> 12; g = (t >> 11) & 1; tq = t & 2047; } else { smp = true; bs = (t - 4 * 2048) >> 1; g = t & 1; tq = 0; }
        }
        nsa_tile(A, l, smp, bs, g, tq, wl, BT, lane);
    }
}

__device__ __forceinline__ void phase_m2x(CArgs& A, int l, LAS unsigned char* lds, int tid) {
    LAS float* buf = (LAS float*)lds;
    LAS float* wl = (LAS float*)(lds + 1024);
    LAS float* red = (LAS float*)(lds + 2048);
    LAS bf16* kt = (LAS bf16*)(lds + 8192);
    LAS bf16* vt = (LAS bf16*)(lds + 8192 + 34816);
    const bf16* QKVO = (const bf16*)(A.ws + WS_QKVO);
    const int lane = tid & 63, wave = tid >> 6, fr = lane & 15, fq = lane >> 4;
    for (int unit = blockIdx.x; unit < NUNIT; unit += gridDim.x) {
        const int b = unit >> 7, h = (unit >> 5) & 3, c = unit & 31, r0 = b * SEQ + c * LCH;
        float ig = 0.f, lf = 0.f;
        if (tid < 256) ml_gates(A, l, r0 + tid, h, ig, lf);
        const float F = scan_sum256(lf, buf, tid);
        __syncthreads();
        if (tid == 255) buf[16] = F;
        __syncthreads();
        const float Fend = buf[16];
        const float gl = tid < 256 ? Fend - F + ig : -3.0e38f;
        const float mw = wave_max(gl);
        if (lane == 0) buf[20 + wave] = mw;
        __syncthreads();
        const float mloc = fmaxf(fmaxf(buf[20], buf[21]), fmaxf(buf[22], buf[23]));
        if (tid < 256) wl[tid] = __expf(gl - mloc);
        if (tid == 0) { float* ch = (float*)(A.ws + WS_CHS) + unit * 4; ch[0] = Fend; ch[1] = mloc; }
        f32x4 acc[8];
#pragma unroll
        for (int kt_ = 0; kt_ < 8; ++kt_) acc[kt_] = (f32x4){0.f, 0.f, 0.f, 0.f};
        float dnp = 0.f;
        for (int half = 0; half < 2; ++half) {
            __syncthreads();
            for (int i = tid; i < 4096; i += NTHR) { const int which = i >> 11, oc = (i >> 7) & 15, s = i & 127;
                const v4u x = *(const v4u*)(QKVO + (size_t)(r0 + 128 * half + s) * 2048 + (which ? 1024 : 512) + h * HD + 8 * oc);
                LAS bf16* dst = (which ? vt : kt) + (8 * oc) * 136 + s;
                dst[0] = (bf16)x.x; dst[136] = (bf16)(x.x >> 16); dst[272] = (bf16)x.y; dst[408] = (bf16)(x.y >> 16); dst[544] = (bf16)x.z; dst[680] = (bf16)(x.z >> 16); dst[816] = (bf16)x.w; dst[952] = (bf16)(x.w >> 16); }
            __syncthreads();
#pragma unroll
            for (int ks = 0; ks < 4; ++ks) {
                const int s0 = 32 * ks + 8 * fq;
                const v4u xv = *(const LAS v4u*)(vt + (16 * wave + fr) * 136 + s0);
                const f32x4 w0 = *(const LAS f32x4*)(wl + 128 * half + s0), w1 = *(const LAS f32x4*)(wl + 128 * half + s0 + 4);
                v4u av; av.x = pk2(bflo(xv.x) * w0[0], bfhi(xv.x) * w0[1]); av.y = pk2(bflo(xv.y) * w0[2], bfhi(xv.y) * w0[3]); av.z = pk2(bflo(xv.z) * w1[0], bfhi(xv.z) * w1[1]); av.w = pk2(bflo(xv.w) * w1[2], bfhi(xv.w) * w1[3]);
                const bf16x8 af = __builtin_bit_cast(bf16x8, av);
#pragma unroll
                for (int kt_ = 0; kt_ < 8; ++kt_) { const bf16x8 bfr = *(const LAS bf16x8*)(kt + (16 * kt_ + fr) * 136 + s0); acc[kt_] = MFMA16(af, bfr, acc[kt_]); }
            }
            {   const int k = tid & 127, q = tid >> 7;
#pragma unroll
                for (int e = 0; e < 4; ++e) { const v4u x = *(const LAS v4u*)(kt + k * 136 + 32 * q + 8 * e); const LAS float* w = wl + 128 * half + 32 * q + 8 * e;
                    dnp += bflo(x.x) * w[0] + bfhi(x.x) * w[1] + bflo(x.y) * w[2] + bfhi(x.y) * w[3] + bflo(x.z) * w[4] + bfhi(x.z) * w[5] + bflo(x.w) * w[6] + bfhi(x.w) * w[7]; } }
        }
        float* dct = (float*)(A.ws + WS_DCT) + ((size_t)unit * HD + 16 * wave + 4 * fq) * HD + fr;
#pragma unroll
        for (int kt_ = 0; kt_ < 8; ++kt_)
#pragma unroll
            for (int i = 0; i < 4; ++i) dct[(size_t)i * HD + 16 * kt_] = acc[kt_][i];
        red[(tid >> 7) * 128 + (tid & 127)] = dnp;
        __syncthreads();
        if (tid < HD) ((float*)(A.ws + WS_DN))[unit * HD + tid] = (red[tid] + red[128 + tid]) + (red[256 + tid] + red[384 + tid]);
        __syncthreads();
    }
}

__device__ __forceinline__ void phase_m4x(CArgs& A, int l, LAS unsigned char* lds, int tid) {
    LAS float* buf = (LAS float*)lds;
    LAS float* sa = (LAS float*)(lds + 1024);
    LAS float* smx = sa + 256;
    LAS float* sdec = smx + 256;
    LAS float* sem = sdec + 256;
    LAS bf16* vt = (LAS bf16*)(lds + 8192);
    const bf16* QKVO = (const bf16*)(A.ws + WS_QKVO);
    const int lane = tid & 63, wave = tid >> 6, fr = lane & 15, fq = lane >> 4;
    for (int unit = blockIdx.x; unit < NUNIT; unit += gridDim.x) {
        const int b = unit >> 7, h = (unit >> 5) & 3, c = unit & 31, r0 = b * SEQ + c * LCH;
        float ig = 0.f, lf = 0.f;
        if (tid < 256) ml_gates(A, l, r0 + tid, h, ig, lf);
        const float F = scan_sum256(lf, buf, tid);
        const float a = tid < 256 ? ig - F : -3.0e38f;
        const float cm = scan_max256(a, buf, tid);
        const float m0 = ((const float*)(A.ws + WS_CHS))[unit * 4 + 2];
        if (tid < 256) { const float mx = fmaxf(m0, cm); sa[tid] = a; smx[tid] = mx; sdec[tid] = __expf(m0 - mx); sem[tid] = __expf(-(F + mx)); }
        for (int i = tid; i < 4096; i += NTHR) { const int oc = i >> 8, s = i & 255;
            const v4u x = *(const v4u*)(QKVO + (size_t)(r0 + s) * 2048 + 1024 + h * HD + 8 * oc);
            LAS bf16* dst = vt + (8 * oc) * 264 + s;
            dst[0] = (bf16)x.x; dst[264] = (bf16)(x.x >> 16); dst[528] = (bf16)x.y; dst[792] = (bf16)(x.y >> 16); dst[1056] = (bf16)x.z; dst[1320] = (bf16)(x.z >> 16); dst[1584] = (bf16)x.w; dst[1848] = (bf16)(x.w >> 16); }
        __syncthreads();
        const bf16* ctp = (const bf16*)(A.ws + WS_CTP) + (size_t)unit * HD * HD;
        const float* npv = (const float*)(A.ws + WS_NPV) + unit * HD;
        for (int pass = 0; pass < 2; ++pass) {
            const int sub = pass == 0 ? wave : 15 - wave, t0 = 16 * sub, t = t0 + fr;
            const float mxt = smx[t], dect = sdec[t], emt = sem[t];
            bf16x8 qf[4];
#pragma unroll
            for (int kk = 0; kk < 4; ++kk) qf[kk] = *(const bf16x8*)(QKVO + (size_t)(r0 + t) * 2048 + h * HD + 32 * kk + 8 * fq);
            f32x4 ah[8], ac[8];
#pragma unroll
            for (int v = 0; v < 8; ++v) { ah[v] = (f32x4){0.f, 0.f, 0.f, 0.f}; ac[v] = (f32x4){0.f, 0.f, 0.f, 0.f}; }
            float den = 0.f;
            const int nblk = (t0 + 47) >> 5;
            for (int ib = 0; ib < nblk; ++ib) {
                const int s0 = 32 * ib;
                f32x4 st[2];
#pragma unroll
                for (int j = 0; j < 2; ++j) {
                    f32x4 z = {0.f, 0.f, 0.f, 0.f};
                    const bf16* kp = QKVO + (size_t)(r0 + s0 + 16 * j + fr) * 2048 + 512 + h * HD + 8 * fq;
#pragma unroll
                    for (int kk = 0; kk < 4; ++kk) z = MFMA16(*(const bf16x8*)(kp + 32 * kk), qf[kk], z);
                    const f32x4 a4 = *(const LAS f32x4*)(sa + s0 + 16 * j + 4 * fq);
#pragma unroll
                    for (int i = 0; i < 4; ++i) { const float w = (s0 + 16 * j + 4 * fq + i <= t) ? z[i] * __expf(a4[i] - mxt) : 0.f; z[i] = w; den += w; }
                    st[j] = z;
                }
                v4u pw; pw.x = pk2(st[0][0], st[0][1]); pw.y = pk2(st[0][2], st[0][3]); pw.z = pk2(st[1][0], st[1][1]); pw.w = pk2(st[1][2], st[1][3]);
                const bf16x8 pf = __builtin_bit_cast(bf16x8, pw);
#pragma unroll
                for (int v = 0; v < 8; ++v) { const LAS bf16* vp = vt + (16 * v + fr) * 264 + s0 + 4 * fq;
                    const v2u x = *(const LAS v2u*)vp, y = *(const LAS v2u*)(vp + 16);
                    v4u vw; vw.x = x.x; vw.y = x.y; vw.z = y.x; vw.w = y.y;
                    ah[v] = MFMA16(__builtin_bit_cast(bf16x8, vw), pf, ah[v]); }
            }
            float qn = 0.f;
#pragma unroll
            for (int kk = 0; kk < 4; ++kk) {
                const v4u qx = __builtin_bit_cast(v4u, qf[kk]); const f32x4 n0 = *(const f32x4*)(npv + 32 * kk + 8 * fq), n1 = *(const f32x4*)(npv + 32 * kk + 8 * fq + 4);
                qn += bflo(qx.x) * n0[0] + bfhi(qx.x) * n0[1] + bflo(qx.y) * n0[2] + bfhi(qx.y) * n0[3] + bflo(qx.z) * n1[0] + bfhi(qx.z) * n1[1] + bflo(qx.w) * n1[2] + bfhi(qx.w) * n1[3];
#pragma unroll
                for (int v = 0; v < 8; ++v) ac[v] = MFMA16(*(const bf16x8*)(ctp + (size_t)(16 * v + fr) * HD + 32 * kk + 8 * fq), qf[kk], ac[v]);
            }
            const float dent = xfq_sum(den) + dect * xfq_sum(qn);
            const float rden = 1.f / fmaxf(fabsf(dent), emt);
            float s1 = 0.f;
#pragma unroll
            for (int v = 0; v < 8; ++v) { ah[v] = (ah[v] + ac[v] * dect) * rden; s1 += (ah[v][0] + ah[v][1]) + (ah[v][2] + ah[v][3]); }
            const float mu = xfq_sum(s1) * (1.f / HD);
            float s2 = 0.f;
#pragma unroll
            for (int v = 0; v < 8; ++v) { ah[v] = ah[v] - mu; s2 += (ah[v][0] * ah[v][0] + ah[v][1] * ah[v][1]) + (ah[v][2] * ah[v][2] + ah[v][3] * ah[v][3]); }
            const float rstd = 1.f / sqrtf(xfq_sum(s2) * (1.f / HD) + LN_EPS);
            const bf16* op = QKVO + (size_t)(r0 + t) * 2048 + 1536 + h * HD + 4 * fq;
            bf16* mp = (bf16*)(A.ws + WS_MIX) + (size_t)(r0 + t) * D + h * HD + 4 * fq;
            const float* gp = A.ml_norm_g + l * 512 + h * HD + 4 * fq;
#pragma unroll
            for (int v = 0; v < 8; ++v) { const v2u og = *(const v2u*)(op + 16 * v); const f32x4 gn = *(const f32x4*)(gp + 16 * v);
                v2u w; w.x = pk2(ah[v][0] * rstd * gn[0] * sigmoidf_(bflo(og.x)), ah[v][1] * rstd * gn[1] * sigmoidf_(bfhi(og.x)));
                w.y = pk2(ah[v][2] * rstd * gn[2] * sigmoidf_(bflo(og.y)), ah[v][3] * rstd * gn[3] * sigmoidf_(bfhi(og.y)));
                *(v2u*)(mp + 16 * v) = w; }
        }
        __syncthreads();
    }
}

constexpr int SKP = 72;
constexpr int NG_KB = 0, NG_IMP = 2 * 4 * 64 * SKP * 2, NG_BT = NG_IMP + NWAVES * 1088 * 4, NG_MSK = NG_BT + 8 * 132 * 4, NG_TASK = NG_MSK + NWAVES * 16, NG_JL = NG_TASK + 16, NG_END = NG_JL + 136 * 4;
static_assert(NG_END <= RING_BYTES, "NSA LDS map");
constexpr int CW_NSAQ = 8192;

__device__ __forceinline__ v4u stage_issue(const bf16* src, unsigned pitch, int tid) { const unsigned off = (unsigned)(tid >> 3) * pitch + (unsigned)(tid & 7) * 8u; return *(const v4u*)(src + off); }
__device__ __forceinline__ void stage_commit(LAS bf16* buf, const v4u& r, int tid) { *(LAS v4u*)(buf + (tid >> 3) * SKP + (tid & 7) * 8) = r; }
__device__ __forceinline__ void qk_lds(const LAS bf16* kb, const bf16x8 (&q)[2], int fr, int fq, f32x4 (&st)[4]) {
#pragma unroll
    for (int t = 0; t < 4; ++t) { const LAS bf16* p = kb + (16 * t + fr) * SKP + 8 * fq;
        f32x4 z = {0.f, 0.f, 0.f, 0.f}; z = MFMA16(*(const LAS bf16x8*)p, q[0], z); st[t] = MFMA16(*(const LAS bf16x8*)(p + 32), q[1], z); }
}
__device__ __forceinline__ void pv_lds(const LAS bf16* vb, int fr, int fq, const f32x4 (&st)[4], f32x4 (&o)[4]) {
#pragma unroll
    for (int h = 0; h < 2; ++h) {
        v4u pw; pw.x = pk2(st[2 * h][0], st[2 * h][1]); pw.y = pk2(st[2 * h][2], st[2 * h][3]); pw.z = pk2(st[2 * h + 1][0], st[2 * h + 1][1]); pw.w = pk2(st[2 * h + 1][2], st[2 * h + 1][3]);
        const bf16x8 pf = __builtin_bit_cast(bf16x8, pw);
#pragma unroll
        for (int dt = 0; dt < 4; ++dt) { const LAS bf16* p = vb + (16 * dt + fr) * SKP + 32 * h + 4 * fq;
            const v2u a = *(const LAS v2u*)p, b = *(const LAS v2u*)(p + 16); v4u w; w.x = a.x; w.y = a.y; w.z = b.x; w.w = b.y;
            o[dt] = MFMA16(__builtin_bit_cast(bf16x8, w), pf, o[dt]); }
    }
}
__device__ __forceinline__ void softmax_pv_lds(const LAS bf16* vb, int fr, int fq, f32x4 (&st)[4], float c, f32x4 (&o)[4], float& m, float& ls) {
    float bm = fmaxf(fmaxf(st[0][0], st[0][1]), fmaxf(st[0][2], st[0][3]));
#pragma unroll
    for (int t = 1; t < 4; ++t) bm = fmaxf(bm, fmaxf(fmaxf(st[t][0], st[t][1]), fmaxf(st[t][2], st[t][3])));
    bm = xfq_max(bm + c);
    if (__any(bm > m)) {
        const float mn = fmaxf(m, bm), sc = __builtin_amdgcn_exp2f(m - mn);
        m = mn; ls *= sc;
#pragma unroll
        for (int dt = 0; dt < 4; ++dt) o[dt] = o[dt] * sc;
    }
    const float d = c - m;
#pragma unroll
    for (int t = 0; t < 4; ++t)
#pragma unroll
        for (int i = 0; i < 4; ++i) { const float p = __builtin_amdgcn_exp2f(st[t][i] + d); st[t][i] = p; ls += p; }
    pv_lds(vb, fr, fq, st, o);
}

template <bool HASK, bool HASV, class Addr, class Body>
__device__ __forceinline__ void staged_sweep2(int n, const Addr& ad, Body& body, LAS bf16* sbuf, int tid) {
    if (n <= 0) return;
    constexpr int BLK = 64 * SKP, SET = 4 * BLK;
    {   v4u k0, k1, v0, v1;
        if (HASK) { k0 = ad.k(0, tid); if (1 < n) k1 = ad.k(1, tid); }
        if (HASV) { v0 = ad.v(0, tid); if (1 < n) v1 = ad.v(1, tid); }
        if (HASK) { stage_commit(sbuf, k0, tid); if (1 < n) stage_commit(sbuf + BLK, k1, tid); }
        if (HASV) { stage_commit(sbuf + 2 * BLK, v0, tid); if (1 < n) stage_commit(sbuf + 3 * BLK, v1, tid); } }
    __syncthreads();
    const int nstep = (n + 1) >> 1;
    for (int s = 0; s < nstep; ++s) {
        const int i0 = 2 * s, i2 = i0 + 2, i3 = i0 + 3;
        v4u k0, k1, v0, v1;
        if (i2 < n) { if (HASK) k0 = ad.k(i2, tid); if (HASV) v0 = ad.v(i2, tid); }
        if (i3 < n) { if (HASK) k1 = ad.k(i3, tid); if (HASV) v1 = ad.v(i3, tid); }
        LAS bf16* cur = sbuf + (s & 1) * SET; LAS bf16* nxt = sbuf + ((s & 1) ^ 1) * SET;
        body(i0, cur, cur + 2 * BLK);
        if (i0 + 1 < n) body(i0 + 1, cur + BLK, cur + 3 * BLK);
        if (i2 < n) { if (HASK) stage_commit(nxt, k0, tid); if (HASV) stage_commit(nxt + 2 * BLK, v0, tid); }
        if (i3 < n) { if (HASK) stage_commit(nxt + BLK, k1, tid); if (HASV) stage_commit(nxt + 3 * BLK, v1, tid); }
        __syncthreads();
    }
}
struct AdLin {
    const bf16* K; const bf16* V; unsigned vpitch;
    __device__ __forceinline__ v4u k(int i, int tid) const { return stage_issue(K + (size_t)i * 64 * 64, 64, tid); }
    __device__ __forceinline__ v4u v(int i, int tid) const { return stage_issue(V + (size_t)i * 4096, 64, tid); }
};
struct AdList {
    const bf16* K; const bf16* V; unsigned vpitch; const LAS int* jl;
    __device__ __forceinline__ v4u k(int i, int tid) const { const int j = __builtin_amdgcn_readfirstlane(jl[i]); return stage_issue(K + (size_t)j * 64 * 64, 64, tid); }
    __device__ __forceinline__ v4u v(int i, int tid) const { const int j = __builtin_amdgcn_readfirstlane(jl[i]); return stage_issue(V + (size_t)j * 4096, 64, tid); }
};
struct TileCtx { int fr, fq, qposA, qposB, qpos0, cur; const LAS float* bt; float farb; };
struct KF { bf16x8 k[8]; };
struct VF { v4u v[8]; };
__device__ __forceinline__ void kf_load(KF& f, const LAS bf16* kb, int fr, int fq) {
#pragma unroll
    for (int t = 0; t < 4; ++t) { const LAS bf16* p = kb + (16 * t + fr) * SKP + 8 * fq; f.k[2 * t] = *(const LAS bf16x8*)p; f.k[2 * t + 1] = *(const LAS bf16x8*)(p + 32); }
}
__device__ __forceinline__ void vf_load(VF& f, const LAS bf16* vb, int fr, int fq) {
#pragma unroll
    for (int h = 0; h < 2; ++h)
#pragma unroll
        for (int dt = 0; dt < 4; ++dt) { const LAS bf16* p = vb + (16 * dt + fr) * SKP + 32 * h + 4 * fq;
            const v2u a = *(const LAS v2u*)p, b = *(const LAS v2u*)(p + 16); v4u w; w.x = a.x; w.y = a.y; w.z = b.x; w.w = b.y; f.v[4 * h + dt] = w; }
}
__device__ __forceinline__ void qk2(const KF& f, const bf16x8 (&qa)[2], const bf16x8 (&qb)[2], f32x4 (&sa)[4], f32x4 (&sb)[4]) {
#pragma unroll
    for (int t = 0; t < 4; ++t) { const f32x4 z = {0.f, 0.f, 0.f, 0.f};
        sa[t] = MFMA16(f.k[2 * t + 1], qa[1], MFMA16(f.k[2 * t], qa[0], z)); sb[t] = MFMA16(f.k[2 * t + 1], qb[1], MFMA16(f.k[2 * t], qb[0], z)); }
}
__device__ __forceinline__ void pv2(const VF& f, const f32x4 (&sa)[4], const f32x4 (&sb)[4], f32x4 (&oa)[4], f32x4 (&ob)[4]) {
#pragma unroll
    for (int h = 0; h < 2; ++h) {
        v4u pa, pb;
        pa.x = pk2(sa[2 * h][0], sa[2 * h][1]); pa.y = pk2(sa[2 * h][2], sa[2 * h][3]); pa.z = pk2(sa[2 * h + 1][0], sa[2 * h + 1][1]); pa.w = pk2(sa[2 * h + 1][2], sa[2 * h + 1][3]);
        pb.x = pk2(sb[2 * h][0], sb[2 * h][1]); pb.y = pk2(sb[2 * h][2], sb[2 * h][3]); pb.z = pk2(sb[2 * h + 1][0], sb[2 * h + 1][1]); pb.w = pk2(sb[2 * h + 1][2], sb[2 * h + 1][3]);
        const bf16x8 fa = __builtin_bit_cast(bf16x8, pa), fb = __builtin_bit_cast(bf16x8, pb);
#pragma unroll
        for (int dt = 0; dt < 4; ++dt) { const bf16x8 vv = __builtin_bit_cast(bf16x8, f.v[4 * h + dt]); oa[dt] = MFMA16(vv, fa, oa[dt]); ob[dt] = MFMA16(vv, fb, ob[dt]); }
    }
}
__device__ __forceinline__ float max16(const f32x4 (&st)[4]) {
    float bm = fmaxf(fmaxf(st[0][0], st[0][1]), fmaxf(st[0][2], st[0][3]));
#pragma unroll
    for (int t = 1; t < 4; ++t) bm = fmaxf(bm, fmaxf(fmaxf(st[t][0], st[t][1]), fmaxf(st[t][2], st[t][3])));
    return bm;
}
__device__ __forceinline__ void softmax_pv2(const LAS bf16* vb, int fr, int fq, f32x4 (&sa)[4], f32x4 (&sb)[4], float ca, float cb, f32x4 (&oa)[4], f32x4 (&ob)[4], float (&m)[2], float (&ls)[2]) {
    float ba = max16(sa) + ca, bb = max16(sb) + cb;
    ba = fmaxf(ba, __shfl_xor(ba, 16)); bb = fmaxf(bb, __shfl_xor(bb, 16)); ba = fmaxf(ba, __shfl_xor(ba, 32)); bb = fmaxf(bb, __shfl_xor(bb, 32));
    const float ma = fmaxf(m[0], ba), mb = fmaxf(m[1], bb), xa = __builtin_amdgcn_exp2f(m[0] - ma), xb = __builtin_amdgcn_exp2f(m[1] - mb);
    m[0] = ma; m[1] = mb; ls[0] *= xa; ls[1] *= xb;
#pragma unroll
    for (int dt = 0; dt < 4; ++dt) { oa[dt] = oa[dt] * xa; ob[dt] = ob[dt] * xb; }
    const float da = ca - ma, db = cb - mb;
#pragma unroll
    for (int t = 0; t < 4; ++t)
#pragma unroll
        for (int i = 0; i < 4; ++i) { const float pa = __builtin_amdgcn_exp2f(sa[t][i] + da), pb = __builtin_amdgcn_exp2f(sb[t][i] + db); sa[t][i] = pa; sb[t][i] = pb; ls[0] += pa; ls[1] += pb; }
    VF vf; vf_load(vf, vb, fr, fq);
    pv2(vf, sa, sb, oa, ob);
}
__device__ __forceinline__ void qk1(const KF& f, const bf16x8 (&q)[2], f32x4 (&st)[4]) {
#pragma unroll
    for (int t = 0; t < 4; ++t) { const f32x4 z = {0.f, 0.f, 0.f, 0.f}; st[t] = MFMA16(f.k[2 * t + 1], q[1], MFMA16(f.k[2 * t], q[0], z)); }
}
__device__ __forceinline__ void softmax_pv1(const LAS bf16* vb, int fr, int fq, f32x4 (&st)[4], float c, f32x4 (&o)[4], float& m, float& ls) {
    float bm = max16(st) + c;
    bm = fmaxf(bm, __shfl_xor(bm, 16)); bm = fmaxf(bm, __shfl_xor(bm, 32));
    const float mn = fmaxf(m, bm), x = __builtin_amdgcn_exp2f(m - mn);
    m = mn; ls *= x;
#pragma unroll
    for (int dt = 0; dt < 4; ++dt) o[dt] = o[dt] * x;
    const float d = c - mn;
#pragma unroll
    for (int t = 0; t < 4; ++t)
#pragma unroll
        for (int i = 0; i < 4; ++i) { const float p = __builtin_amdgcn_exp2f(st[t][i] + d); st[t][i] = p; ls += p; }
    pv_lds(vb, fr, fq, st, o);
}
struct BodyCmpStat2 {
    const bf16x8 (&qa)[2]; const bf16x8 (&qb)[2]; const TileCtx& c; float (&ml)[2]; float (&lsl)[2];
    __device__ __forceinline__ void operator()(int ib, const LAS bf16* kb, const LAS bf16*) {
        KF kf; kf_load(kf, kb, c.fr, c.fq);
        f32x4 sa[4], sb[4]; qk2(kf, qa, qb, sa, sb);
        if (c.qpos0 - 16 * (64 * ib + 63) - 31 >= 128) {
#pragma unroll
            for (int t = 0; t < 4; ++t) { sa[t] = sa[t] + c.farb; sb[t] = sb[t] + c.farb; }
        } else {
#pragma unroll
            for (int t = 0; t < 4; ++t)
#pragma unroll
                for (int i = 0; i < 4; ++i) { const int n = 64 * ib + 16 * t + 4 * c.fq + i; const int da = c.qposA - 16 * n - 31, db = c.qposB - 16 * n - 31;
                    sa[t][i] += c.bt[da < 0 ? 129 : (da > 128 ? 128 : da)]; sb[t][i] += c.bt[db < 0 ? 129 : (db > 128 ? 128 : db)]; }
        }
        const float ma = fmaxf(ml[0], max16(sa)), mb = fmaxf(ml[1], max16(sb));
        lsl[0] *= __builtin_amdgcn_exp2f(ml[0] - ma); lsl[1] *= __builtin_amdgcn_exp2f(ml[1] - mb); ml[0] = ma; ml[1] = mb;
#pragma unroll
        for (int t = 0; t < 4; ++t)
#pragma unroll
            for (int i = 0; i < 4; ++i) { lsl[0] += __builtin_amdgcn_exp2f(sa[t][i] - ma); lsl[1] += __builtin_amdgcn_exp2f(sb[t][i] - mb); }
    }
};
struct BodyCmpProb2 {
    const bf16x8 (&qa)[2]; const bf16x8 (&qb)[2]; const TileCtx& c; f32x4 (&oa)[4]; f32x4 (&ob)[4]; float m0, m1, inv0, inv1; LAS float* imp; int tl, rr;
    __device__ __forceinline__ void operator()(int ib, const LAS bf16* kb, const LAS bf16* vb) {
        KF kf; kf_load(kf, kb, c.fr, c.fq);
        f32x4 sa[4], sb[4]; qk2(kf, qa, qb, sa, sb);
        if (c.qpos0 - 16 * (64 * ib + 63) - 31 >= 128) {
            const float da = c.farb - m0, db = c.farb - m1;
#pragma unroll
            for (int t = 0; t < 4; ++t)
#pragma unroll
                for (int i = 0; i < 4; ++i) { sa[t][i] = __builtin_amdgcn_exp2f(sa[t][i] + da) * inv0; sb[t][i] = __builtin_amdgcn_exp2f(sb[t][i] + db) * inv1; }
        } else {
#pragma unroll
            for (int t = 0; t < 4; ++t)
#pragma unroll
                for (int i = 0; i < 4; ++i) { const int n = 64 * ib + 16 * t + 4 * c.fq + i; const int da = c.qposA - 16 * n - 31, db = c.qposB - 16 * n - 31;
                    sa[t][i] = __builtin_amdgcn_exp2f(sa[t][i] + c.bt[da < 0 ? 129 : (da > 128 ? 128 : da)] - m0) * inv0;
                    sb[t][i] = __builtin_amdgcn_exp2f(sb[t][i] + c.bt[db < 0 ? 129 : (db > 128 ? 128 : db)] - m1) * inv1; }
        }
#pragma unroll
        for (int t = 0; t < 4; ++t) {
            const float a4 = quad_sum((sa[t][0] + sa[t][1]) + (sa[t][2] + sa[t][3])), a3 = quad_sum(sa[t][3]), b4 = quad_sum((sb[t][0] + sb[t][1]) + (sb[t][2] + sb[t][3])), b3 = quad_sum(sb[t][3]);
            const int j0 = 16 * ib + 4 * t + c.fq;
            if (rr == 0) { LAS float* ip = imp + tl * 136 + j0;
                __hip_atomic_fetch_add(ip, a4, __ATOMIC_RELAXED, __HIP_MEMORY_SCOPE_WORKGROUP); __hip_atomic_fetch_add(ip + 1, a3, __ATOMIC_RELAXED, __HIP_MEMORY_SCOPE_WORKGROUP);
                __hip_atomic_fetch_add(ip + 4 * 136, b4, __ATOMIC_RELAXED, __HIP_MEMORY_SCOPE_WORKGROUP); __hip_atomic_fetch_add(ip + 4 * 136 + 1, b3, __ATOMIC_RELAXED, __HIP_MEMORY_SCOPE_WORKGROUP); }
        }
        VF vf; vf_load(vf, vb, c.fr, c.fq);
        pv2(vf, sa, sb, oa, ob);
    }
};
struct BodySel2 {
    const bf16x8 (&qa)[2]; const bf16x8 (&qb)[2]; const TileCtx& c; f32x4 (&oa)[4]; f32x4 (&ob)[4]; float (&m)[2]; float (&ls)[2]; const LAS int* jl;
    unsigned long long wu0a, wu1a, wu0b, wu1b, my0a, my1a, my0b, my1b; bool dead;
    __device__ __forceinline__ void operator()(int i, const LAS bf16* kb, const LAS bf16* vb) {
        const int j = __builtin_amdgcn_readfirstlane(jl[i]);
        const bool hasa = j < 64 ? ((wu0a >> j) & 1ull) != 0ull : ((wu1a >> (j - 64)) & 1ull) != 0ull, hasb = j < 64 ? ((wu0b >> j) & 1ull) != 0ull : ((wu1b >> (j - 64)) & 1ull) != 0ull;
        if (!(hasa || hasb)) return;
        const bool minea = !dead && (j < 64 ? ((my0a >> j) & 1ull) != 0ull : ((my1a >> (j - 64)) & 1ull) != 0ull), mineb = !dead && (j < 64 ? ((my0b >> j) & 1ull) != 0ull : ((my1b >> (j - 64)) & 1ull) != 0ull);
        const bool near = j >= c.cur - 2;
        if (hasa && hasb) {
            KF kf; kf_load(kf, kb, c.fr, c.fq);
            f32x4 sa[4], sb[4]; qk2(kf, qa, qb, sa, sb);
            float ca = minea ? c.farb : -INFINITY, cb = mineb ? c.farb : -INFINITY;
            if (near) {
                ca = minea ? 0.f : -INFINITY; cb = mineb ? 0.f : -INFINITY;
#pragma unroll
                for (int t = 0; t < 4; ++t)
#pragma unroll
                    for (int e = 0; e < 4; ++e) { const int key = 64 * j + 16 * t + 4 * c.fq + e; const int da = c.qposA - key, db = c.qposB - key;
                        sa[t][e] += c.bt[da < 0 ? 129 : (da > 128 ? 128 : da)]; sb[t][e] += c.bt[db < 0 ? 129 : (db > 128 ? 128 : db)]; }
            }
            softmax_pv2(vb, c.fr, c.fq, sa, sb, ca, cb, oa, ob, m, ls);
        } else {
            const bool mine = hasa ? minea : mineb; const int qpos = hasa ? c.qposA : c.qposB;
            f32x4 st[4];
            if (hasa) qk_lds(kb, qa, c.fr, c.fq, st); else qk_lds(kb, qb, c.fr, c.fq, st);
            float cc = mine ? c.farb : -INFINITY;
            if (near) {
                cc = mine ? 0.f : -INFINITY;
#pragma unroll
                for (int t = 0; t < 4; ++t)
#pragma unroll
                    for (int e = 0; e < 4; ++e) { const int d1 = qpos - (64 * j + 16 * t + 4 * c.fq + e); st[t][e] += c.bt[d1 < 0 ? 129 : (d1 > 128 ? 128 : d1)]; }
            }
            if (hasa) softmax_pv1(vb, c.fr, c.fq, st, cc, oa, m[0], ls[0]); else softmax_pv1(vb, c.fr, c.fq, st, cc, ob, m[1], ls[1]);
        }
    }
};
struct BodyWin2 {
    const bf16x8 (&qa)[2]; const bf16x8 (&qb)[2]; const TileCtx& c; f32x4 (&oa)[4]; f32x4 (&ob)[4]; float (&m)[2]; float (&ls)[2]; int j0;
    __device__ __forceinline__ void operator()(int i, const LAS bf16* kb, const LAS bf16* vb) {
        const int j = j0 + i;
        if (c.qpos0 + 7 - 64 * j < 0 || c.qpos0 - (64 * j + 63) >= 512) return;
        KF kf; kf_load(kf, kb, c.fr, c.fq);
        f32x4 sa[4], sb[4]; qk2(kf, qa, qb, sa, sb);
        float ca = c.farb, cb = c.farb;
        const bool interior = (c.qpos0 + 7 - 64 * j < 512) && (c.qpos0 - (64 * j + 63) >= 128);
        if (!interior) {
            ca = 0.f; cb = 0.f;
#pragma unroll
            for (int t = 0; t < 4; ++t)
#pragma unroll
                for (int e = 0; e < 4; ++e) { const int key = 64 * j + 16 * t + 4 * c.fq + e; const int da = c.qposA - key, db = c.qposB - key;
                    sa[t][e] += c.bt[(unsigned)da >= 512u ? 129 : (da > 128 ? 128 : da)]; sb[t][e] += c.bt[(unsigned)db >= 512u ? 129 : (db > 128 ? 128 : db)]; }
        }
        softmax_pv2(vb, c.fr, c.fq, sa, sb, ca, cb, oa, ob, m, ls);
    }
};

__device__ __forceinline__ void nsa_group(CArgs& A, int l, int b, int g, int tg, LAS unsigned char* lds, int tid) {
    asm volatile("" : "+v"(tid));
    const int lane = tid & 63, wave = tid >> 6, fr = lane & 15, fq = lane >> 4, tl = fr >> 2, rr = fr & 3;
    LAS bf16* sbuf = (LAS bf16*)(lds + NG_KB);
    LAS float* imp = (LAS float*)(lds + NG_IMP) + wave * 1088; const LAS float* BT = (const LAS float*)(lds + NG_BT);
    LAS unsigned long long* msk = (LAS unsigned long long*)(lds + NG_MSK);
    LAS int* jl = (LAS int*)(lds + NG_JL);
    const int qpos0 = 64 * tg + 8 * wave, cur = tg, row0 = b * SEQ + qpos0, h = g * 4 + rr;
    const LAS float* bt = BT + h * 132;
    const TileCtx cx{fr, fq, qpos0 + tl, qpos0 + 4 + tl, qpos0, cur, bt, bt[128]};
    bf16x8 qa[2], qb[2];
    {   const bf16* qp = (const bf16*)(A.ws + WS_NQ) + (size_t)(row0 + tl) * 512 + g * 256 + rr * 64 + 8 * fq;
        qa[0] = *(const bf16x8*)qp; qa[1] = *(const bf16x8*)(qp + 32); qb[0] = *(const bf16x8*)(qp + 4 * 512); qb[1] = *(const bf16x8*)(qp + 4 * 512 + 32); }
    f32x4 outa[4], outb[4];
    for (int i = lane; i < 1088; i += 64) imp[i] = 0.f;

    {
        const int nb64 = (4 * tg + 3 + 63) >> 6;
        const AdLin ad{(const bf16*)(A.ws + WS_KC) + l * KC_L + (size_t)g * NCB * 64 + (size_t)b * 512 * 64, (const bf16*)(A.ws + WS_VCT) + l * KC_L + (size_t)g * 64 * NCB + (size_t)b * 8 * 4096, 64u};
        float ml[2] = {-1.0e30f, -1.0e30f}, lsl[2] = {0.f, 0.f};
        { BodyCmpStat2 bd{qa, qb, cx, ml, lsl}; staged_sweep2<true, false>(nb64, ad, bd, sbuf, tid); }
        const float m0 = xfq_max(ml[0]), m1 = xfq_max(ml[1]);
        const float l0 = xfq_sum(lsl[0] * __builtin_amdgcn_exp2f(ml[0] - m0)), l1 = xfq_sum(lsl[1] * __builtin_amdgcn_exp2f(ml[1] - m1));
        f32x4 oa[4], ob[4];
#pragma unroll
        for (int dt = 0; dt < 4; ++dt) { oa[dt] = (f32x4){0.f, 0.f, 0.f, 0.f}; ob[dt] = (f32x4){0.f, 0.f, 0.f, 0.f}; }
        { BodyCmpProb2 bd{qa, qb, cx, oa, ob, m0, m1, l0 > 0.f ? 1.f / l0 : 0.f, l1 > 0.f ? 1.f / l1 : 0.f, imp, tl, rr}; staged_sweep2<true, true>(nb64, ad, bd, sbuf, tid); }
        const float* gt = (const float*)(A.ws + WS_GATE) + (size_t)(row0 + tl) * 32 + 8 + h * 3;
        const float ga = sigmoidf_(gt[0]), gb = sigmoidf_(gt[4 * 32]);
#pragma unroll
        for (int dt = 0; dt < 4; ++dt) { outa[dt] = oa[dt] * ga; outb[dt] = ob[dt] * gb; }
    }
    unsigned long long s0[8], s1[8];
#pragma unroll
    for (int t = 0; t < 8; ++t) topk_sel(imp[t * 136 + lane], imp[t * 136 + 64 + lane], cur, lane, s0[t], s1[t]);
    const unsigned long long wu0a = (s0[0] | s0[1]) | (s0[2] | s0[3]), wu1a = (s1[0] | s1[1]) | (s1[2] | s1[3]), wu0b = (s0[4] | s0[5]) | (s0[6] | s0[7]), wu1b = (s1[4] | s1[5]) | (s1[6] | s1[7]);
    const unsigned long long my0a = tl == 0 ? s0[0] : (tl == 1 ? s0[1] : (tl == 2 ? s0[2] : s0[3])), my1a = tl == 0 ? s1[0] : (tl == 1 ? s1[1] : (tl == 2 ? s1[2] : s1[3]));
    const unsigned long long my0b = tl == 0 ? s0[4] : (tl == 1 ? s0[5] : (tl == 2 ? s0[6] : s0[7])), my1b = tl == 0 ? s1[4] : (tl == 1 ? s1[5] : (tl == 2 ? s1[6] : s1[7]));
    if (lane == 0) { msk[2 * wave] = wu0a | wu0b; msk[2 * wave + 1] = wu1a | wu1b; }
    __syncthreads();
    unsigned long long gu0 = 0ull, gu1 = 0ull;
#pragma unroll
    for (int w = 0; w < NWAVES; ++w) { gu0 |= msk[2 * w]; gu1 |= msk[2 * w + 1]; }
    gu0 = __builtin_amdgcn_readfirstlane((unsigned)gu0) | ((unsigned long long)__builtin_amdgcn_readfirstlane((unsigned)(gu0 >> 32)) << 32);
    gu1 = __builtin_amdgcn_readfirstlane((unsigned)gu1) | ((unsigned long long)__builtin_amdgcn_readfirstlane((unsigned)(gu1 >> 32)) << 32);
    const int nsel0 = __popcll(gu0), nsel = nsel0 + __popcll(gu1);
    if (wave == 0) {
        const unsigned long long below = (1ull << lane) - 1ull;
        if ((gu0 >> lane) & 1ull) jl[__popcll(gu0 & below)] = lane;
        if ((gu1 >> lane) & 1ull) jl[nsel0 + __popcll(gu1 & below)] = 64 + lane;
    }
    __syncthreads();
    const float* gt = (const float*)(A.ws + WS_GATE) + (size_t)(row0 + tl) * 32 + 8 + h * 3;
    {
        float m[2] = {-1.0e30f, -1.0e30f}, ls[2] = {0.f, 0.f}; f32x4 oa[4], ob[4];
#pragma unroll
        for (int dt = 0; dt < 4; ++dt) { oa[dt] = (f32x4){0.f, 0.f, 0.f, 0.f}; ob[dt] = (f32x4){0.f, 0.f, 0.f, 0.f}; }
        const AdList ad{(const bf16*)(A.ws + WS_KS) + l * KS_L + (size_t)g * TOTS * 64 + (size_t)b * SEQ * 64, (const bf16*)(A.ws + WS_VTS) + l * KS_L + (size_t)g * 64 * TOTS + (size_t)b * 128 * 4096, 64u, jl};
        { BodySel2 bd{qa, qb, cx, oa, ob, m, ls, jl, wu0a, wu1a, wu0b, wu1b, my0a, my1a, my0b, my1b, false}; staged_sweep2<true, true>(nsel, ad, bd, sbuf, tid);
#if defined(REP_MASK) && ((REP_MASK >> 15) & 1)
          bd.dead = true; staged_sweep2<true, true>(nsel, ad, bd, sbuf, tid);
#endif
        }
        const float la = xfq_sum(ls[0]), lb = xfq_sum(ls[1]);
        const float wa = la > 0.f ? sigmoidf_(gt[1]) / la : 0.f, wb = lb > 0.f ? sigmoidf_(gt[4 * 32 + 1]) / lb : 0.f;
#pragma unroll
        for (int dt = 0; dt < 4; ++dt) { outa[dt] = outa[dt] + oa[dt] * wa; outb[dt] = outb[dt] + ob[dt] * wb; }
    }
    {
        float m[2] = {-1.0e30f, -1.0e30f}, ls[2] = {0.f, 0.f}; f32x4 oa[4], ob[4];
#pragma unroll
        for (int dt = 0; dt < 4; ++dt) { oa[dt] = (f32x4){0.f, 0.f, 0.f, 0.f}; ob[dt] = (f32x4){0.f, 0.f, 0.f, 0.f}; }
        int j0 = (64 * tg - 511) >> 6; if (j0 < 0) j0 = 0;
        const AdLin ad{(const bf16*)(A.ws + WS_KW) + l * KW_L + (size_t)g * TOTWP * 64 + ((size_t)b * SEQ + (size_t)j0 * 64) * 64, (const bf16*)(A.ws + WS_VTW) + l * KW_L + (size_t)g * 64 * TOTWP + ((size_t)b * 128 + j0) * 4096, 64u};
        { BodyWin2 bd{qa, qb, cx, oa, ob, m, ls, j0}; staged_sweep2<true, true>(cur - j0 + 1, ad, bd, sbuf, tid); }
        const float la = xfq_sum(ls[0]), lb = xfq_sum(ls[1]);
        const float wa = la > 0.f ? sigmoidf_(gt[2]) / la : 0.f, wb = lb > 0.f ? sigmoidf_(gt[4 * 32 + 2]) / lb : 0.f;
#pragma unroll
        for (int dt = 0; dt < 4; ++dt) { outa[dt] = outa[dt] + oa[dt] * wa; outb[dt] = outb[dt] + ob[dt] * wb; }
    }
    bf16* mp = (bf16*)(A.ws + WS_MIX) + (size_t)(row0 + tl) * D + 512 + h * 64 + 4 * fq;
#pragma unroll
    for (int dt = 0; dt < 4; ++dt) { v2u w; w.x = pk2(outa[dt][0], outa[dt][1]); w.y = pk2(outa[dt][2], outa[dt][3]); *(v2u*)(mp + 16 * dt) = w;
        v2u w2; w2.x = pk2(outb[dt][0], outb[dt][1]); w2.y = pk2(outb[dt][2], outb[dt][3]); *(v2u*)(mp + 4 * D + 16 * dt) = w2; }
}

__device__ __forceinline__ void phase_nsa2(CArgs& A, int l, int rep, LAS unsigned char* lds, int tid) {
    const int lane = tid & 63, wave = tid >> 6;
    LAS float* btl = (LAS float*)(lds + NG_BT);
    LAS int* tw = (LAS int*)(lds + NG_TASK);
    for (int i = tid; i < 8 * 132; i += NTHR) btl[i] = ((const float*)(A.ws + WS_BT))[i];
    unsigned* qh = (unsigned*)(A.ws + WS_CTL) + CW_NSAQ + (l * 2 + rep) * 5 * 64;
    const int own = (blockIdx.x & 7) >> 1;
    for (int qi = 0; qi < 5; ++qi) {
        const int qsel = qi == 0 ? 4 : (qi == 1 ? own : ((own + qi - 1) & 3));
        const int qlen = qsel == 4 ? 2 * DB / NWAVES : 128;
        for (;;) {
            __syncthreads();
            if (tid == 0) tw[0] = (int)__hip_atomic_fetch_add(qh + qsel * 64, 1u, __ATOMIC_RELAXED, __HIP_MEMORY_SCOPE_AGENT);
            __syncthreads();
            const int t = tw[0];
            if (t >= qlen) break;
            if (qsel < 4) nsa_group(A, l, qsel >> 1, qsel & 1, 127 - t, lds, tid);
            else { const int tt = t * NWAVES + wave; nsa_tile(A, l, true, tt >> 1, tt & 1, 0, (LAS float*)(lds + NG_IMP) + wave * 1088, btl, lane); }
        }
    }
}

constexpr int PH_PER_LAYER = 9, PH_L0 = 3, N_PHASES = PH_L0 + DEPTH * PH_PER_LAYER;
#ifndef REP_MASK
#define REP_MASK 0
#endif
__device__ __forceinline__ int rep_count(int b) { int n = (((REP_MASK) >> b) & 1) + 1; asm volatile("" : "+s"(n)); return n; }
#if REP_MASK
#define REPS(b) _Pragma("unroll 1") for (int rep_ = 0, nrep_ = rep_count(b); rep_ < nrep_; ++rep_)
#else
#define REPS(b) for (int rep_ = 0; rep_ < 1; ++rep_)
#endif
#ifndef MK_PER_PHASE
#define MK_PER_PHASE 0
#endif

__device__ __forceinline__ int fresh_tid(int wave_s) { int lane = __builtin_amdgcn_mbcnt_hi(~0u, __builtin_amdgcn_mbcnt_lo(~0u, 0u)); asm volatile("" : "+v"(lane)); return wave_s * 64 + lane; }
__device__ __forceinline__ CArgs* kargs() { unsigned long long p = (unsigned long long)__builtin_amdgcn_kernarg_segment_ptr(); asm volatile("" : "+s"(p)); return (CArgs*)p; }
#define A (*kargs())
#define IN(k) (lo <= (k) && (k) < hi)
#define SEAM(k) do { if (IN(k) && IN((k) + 1)) xcd_barrier(bar); } while (0)
template <int l>
__device__ __forceinline__ void layer_phases(LAS unsigned char* lds, const XcdBarrier& bar, int wave_s, int G, int NGW, int lo, int hi) {
    unsigned char* ws = A.ws;
    float* const ADA = (float*)(ws + WS_ADA);
    float* const X = (float*)(ws + WS_X);
    bf16* const Z = (bf16*)(ws + WS_Z);
    bf16* const U = (bf16*)(ws + WS_U);
        const int pb_ = PH_L0 + l * PH_PER_LAYER;
        const float* adal = ADA + (size_t)l * NCOND * 6144;
        const float* xa = l == 0 ? A.x_prompt : X; const float* xb = l == 0 ? A.x_sample : X + (size_t)MP * D;
        if (IN(pb_ + 0)) {
            const int tid = fresh_tid(wave_s), lane = tid & 63, wave = __builtin_amdgcn_readfirstlane(tid >> 6), gw = blockIdx.x * NWAVES + wave; (void)lane; (void)gw;
            {
                pg8::Gemm g{U, (const bf16*)(ws + WS_WIN) + (size_t)l * NINP * D, D, D, D};
                pg8::StaticOrder S; S.init(M, NINP, G, (int)blockIdx.x);
                EpiInProj E{(bf16*)(ws + WS_QKVO), (bf16*)(ws + WS_NQ), (float*)(ws + WS_GATE), (float*)(ws + WS_KVR), (bf16*)(ws + WS_XC) + (size_t)l * 4 * XCP * 64, A.out, l};
                REPS(8) pg8::gemm_phase<EpiInProj, pg8::StaticOrder, true, true>(lds, g, S, E, tid);
            }
            if (l == 0) {
                __syncthreads();
                pg8::Gemm g{(const bf16*)(ws + WS_XC), (const bf16*)(ws + WS_W1), 2048, 1024, 2048};
                CmpOrder S{G, (int)blockIdx.x, 0, DEPTH, 4, 64};
                EpiCmpHid E{(bf16*)(ws + WS_HID), (const float*)(ws + WS_B1)};
                REPS(14) pg8::gemm_phase<EpiCmpHid, CmpOrder, true, true>(lds, g, S, E, tid);
            }
        }
        SEAM(pb_ + 0);
        if (IN(pb_ + 1)) {
            const int tid = fresh_tid(wave_s), lane = tid & 63, wave = __builtin_amdgcn_readfirstlane(tid >> 6), gw = blockIdx.x * NWAVES + wave; (void)lane; (void)gw;
            {
                SgCmpHid E{(bf16*)(ws + WS_HID) + (size_t)l * 4 * NCB * 256, (const float*)(ws + WS_B1) + l * 2 * 256};
                REPS(12) small_gemm(((const bf16*)(ws + WS_XC)) + (size_t)l * 4 * XCP * 64, (size_t)XCP * 64, 1024, ((const bf16*)(ws + WS_W1)) + (size_t)l * 2 * 256 * 2048, (size_t)256 * 2048, 2048, 2048, 4, 1024, 256, E, lds, tid);
            }
            REPS(1) { phase_m2x(A, l, lds, tid);
            __syncthreads();
            prep_layer_images(A, l, lds, gw, NGW, lane, wave); __syncthreads(); }
            if (l == 0) phase_cmp2(A, 0, DEPTH, 1024, NCB - 1024, gw, NGW, lane);
        }
        SEAM(pb_ + 1);
        if (IN(pb_ + 2)) {
            const int tid = fresh_tid(wave_s), lane = tid & 63, wave = __builtin_amdgcn_readfirstlane(tid >> 6), gw = blockIdx.x * NWAVES + wave; (void)lane; (void)gw;
            REPS(2) phase_m3(A, l, tid);
            phase_cmp2(A, l, 1, 0, 1024, gw, NGW, lane);
        }
        SEAM(pb_ + 2);
        if (IN(pb_ + 3)) {
            const int tid = fresh_tid(wave_s), lane = tid & 63, wave = __builtin_amdgcn_readfirstlane(tid >> 6), gw = blockIdx.x * NWAVES + wave; (void)lane; (void)gw;
            REPS(3) { phase_m4x(A, l, lds, tid);
            __syncthreads(); }
            REPS(4) { phase_mls(A, l, lds, tid);
            __syncthreads(); }
            REPS(5) phase_nsa2(A, l, rep_, lds, tid);
        }
        SEAM(pb_ + 3);
        if (IN(pb_ + 4)) {
            const int tid = fresh_tid(wave_s), lane = tid & 63, wave = __builtin_amdgcn_readfirstlane(tid >> 6), gw = blockIdx.x * NWAVES + wave; (void)lane; (void)gw;
            pg8::Gemm g{(const bf16*)(ws + WS_MIX), (const bf16*)(ws + WS_WOUT) + (size_t)l * D * D, D, D, D};
            pg8::StaticOrder S; S.init(MP, D, G, (int)blockIdx.x);
            EpiResid E{xa, xb, adal + 2048, Z};
            REPS(9) pg8::gemm_phase<EpiResid, pg8::StaticOrder, true, true>(lds, g, S, E, tid);
            REPS(13) { SgResid E2{xb, adal + 2048, Z}; small_gemm(((const bf16*)(ws + WS_MIX)) + (size_t)MP * D, 0, D, (const bf16*)(ws + WS_WOUT) + (size_t)l * D * D, 0, D, D, 1, MS, D, E2, lds, tid); }
        }
        SEAM(pb_ + 4);
        if (IN(pb_ + 5)) {
            const int tid = fresh_tid(wave_s), lane = tid & 63, wave = __builtin_amdgcn_readfirstlane(tid >> 6), gw = blockIdx.x * NWAVES + wave; (void)lane; (void)gw;
            REPS(6) for (int r = gw; r < M; r += NGW) {
                const float* ad = adal + (size_t)cond_of_row(r) * 6144;
                ln_row(Z + (size_t)r * D, A.ln_g + (size_t)(l * 2 + 0) * D, A.ln_b + (size_t)(l * 2 + 0) * D, X + (size_t)r * D, ad + 3072, ad + 4096, U + (size_t)r * D, lane);
            }
        }
        SEAM(pb_ + 5);
        if (IN(pb_ + 6)) {
            const int tid = fresh_tid(wave_s), lane = tid & 63, wave = __builtin_amdgcn_readfirstlane(tid >> 6), gw = blockIdx.x * NWAVES + wave; (void)lane; (void)gw;
            pg8::Gemm g{U, (const bf16*)(ws + WS_WUP) + (size_t)l * FF * D, D, D, D};
            pg8::StaticOrder S; S.init(MP, FF, G, (int)blockIdx.x);
            EpiRelu2 E{(bf16*)(ws + WS_H)};
            REPS(10) pg8::gemm_phase<EpiRelu2, pg8::StaticOrder, true, true>(lds, g, S, E, tid);
            REPS(13) { SgRelu2 E2{(bf16*)(ws + WS_H)}; small_gemm(U + (size_t)MP * D, 0, D, (const bf16*)(ws + WS_WUP) + (size_t)l * FF * D, 0, D, D, 1, MS, FF, E2, lds, tid); }
        }
        SEAM(pb_ + 6);
        if (IN(pb_ + 7)) {
            const int tid = fresh_tid(wave_s), lane = tid & 63, wave = __builtin_amdgcn_readfirstlane(tid >> 6), gw = blockIdx.x * NWAVES + wave; (void)lane; (void)gw;
            pg8::Gemm g{(const bf16*)(ws + WS_H), (const bf16*)(ws + WS_WDN) + (size_t)l * D * FF, FF, FF, FF};
            pg8::StaticOrder S; S.init(MP, D, G, (int)blockIdx.x);
            EpiResid E{X, X + (size_t)MP * D, adal + 5120, Z};
            REPS(11) pg8::gemm_phase<EpiResid, pg8::StaticOrder, true, true>(lds, g, S, E, tid);
            REPS(13) { SgResid E2{X + (size_t)MP * D, adal + 5120, Z}; small_gemm(((const bf16*)(ws + WS_H)) + (size_t)MP * FF, 0, FF, (const bf16*)(ws + WS_WDN) + (size_t)l * D * FF, 0, FF, FF, 1, MS, D, E2, lds, tid); }
        }
        SEAM(pb_ + 7);
        if (IN(pb_ + 8)) {
            const int tid = fresh_tid(wave_s), lane = tid & 63, wave = __builtin_amdgcn_readfirstlane(tid >> 6), gw = blockIdx.x * NWAVES + wave; (void)lane; (void)gw;
            const bool last = l == DEPTH - 1;
            REPS(6) for (int r = gw; r < M; r += NGW) {
                const float* ad = adal + (size_t)NCOND * 6144 + (size_t)cond_of_row(r) * 6144;
                float* xo = last ? (r < MP ? A.out + O_YP + (size_t)r * D : A.out + O_YS + (size_t)(r - MP) * D) : X + (size_t)r * D;
                ln_row(Z + (size_t)r * D, A.ln_g + (size_t)(l * 2 + 1) * D, A.ln_b + (size_t)(l * 2 + 1) * D, xo, ad, ad + 1024, last ? (bf16*)nullptr : U + (size_t)r * D, lane);
            }
        }
        SEAM(pb_ + 8);
    }
__global__ void __launch_bounds__(NTHR, 2) fwd_kernel(Args A_unused) {
    extern __shared__ __attribute__((aligned(16))) unsigned char lds_raw[];
    LAS unsigned char* lds = (LAS unsigned char*)lds_raw;
    const int G = gridDim.x, NGW = G * NWAVES, wave_s = __builtin_amdgcn_readfirstlane(threadIdx.x >> 6);
    unsigned char* ws = A.ws;
    for (int u = threadIdx.x; u < (LDS_BYTES - LDSCTL_OFF) / 4; u += NTHR) ((LAS unsigned*)(lds + LDSCTL_OFF))[u] = 0u;
    __syncthreads();
    XcdBarrier bar; bar.bar = (unsigned*)(ws + WS_CTL) + CW_BAR; bar.x = 0; bar.st = nullptr;
    if (!MK_PER_PHASE) bar = xcd_barrier_post((unsigned*)(ws + WS_CTL) + CW_BAR, (volatile LAS unsigned*)(lds + MISC_OFF) + 8);
    const int lo = A.ph_lo, hi = A.ph_hi;

    float* const ADA = (float*)(ws + WS_ADA);
    float* const X = (float*)(ws + WS_X);
    bf16* const Z = (bf16*)(ws + WS_Z);
    bf16* const U = (bf16*)(ws + WS_U);

    if (IN(0)) { const int tid = fresh_tid(wave_s), lane = tid & 63, wave = __builtin_amdgcn_readfirstlane(tid >> 6), gw = blockIdx.x * NWAVES + wave;
        REPS(7) { phase_ada(A, lds, tid); } __syncthreads();
        REPS(0) { phase_p0a(A, lds, gw, NGW, lane, wave); prep_cache_images(A, lds, gw, NGW, lane, wave); } }
    SEAM(0);
    if (IN(2)) {
        const int tid = fresh_tid(wave_s), lane = tid & 63, wave = __builtin_amdgcn_readfirstlane(tid >> 6), gw = blockIdx.x * NWAVES + wave;
        b1_reduce(A, tid);
        for (int r = gw; r < M; r += NGW) {
            const float* ad = ADA + (size_t)cond_of_row(r) * 6144;
            mod_row(r < MP ? A.x_prompt + (size_t)r * D : A.x_sample + (size_t)(r - MP) * D, ad, ad + 1024, U + (size_t)r * D, lane);
        }
    }
    SEAM(2);

    layer_phases<0>(lds, bar, wave_s, G, NGW, lo, hi);
    layer_phases<1>(lds, bar, wave_s, G, NGW, lo, hi);
    static_assert(DEPTH == 2, "two layers");
#undef IN
#undef SEAM
#undef A
}

extern "C" void kernel_launch(void* const* d_in, const int* in_sizes, int n_in, void* d_out, int out_size, void* d_ws, size_t ws_size, hipStream_t stream) {
    static int grid = 0;
    if (grid == 0) {
        if (n_in != 25 || (size_t)out_size != O_END || ws_size < WS_END) { fprintf(stderr, "kernel_launch: unexpected shapes: n_in %d out %d (want %zu) ws %zu (want >= %zu)\n", n_in, out_size, (size_t)O_END, ws_size, (size_t)WS_END); grid = -1; return; }
        int dev = 0, cus = 0, per_cu = 0;
        if (hipGetDevice(&dev) != hipSuccess || hipDeviceGetAttribute(&cus, hipDeviceAttributeMultiprocessorCount, dev) != hipSuccess) { grid = -1; return; }
        if (hipFuncSetAttribute((const void*)fwd_kernel, hipFuncAttributeMaxDynamicSharedMemorySize, LDS_BYTES) != hipSuccess) { fprintf(stderr, "kernel_launch: hipFuncSetAttribute failed\n"); grid = -1; return; }
        if (hipOccupancyMaxActiveBlocksPerMultiprocessor(&per_cu, (const void*)fwd_kernel, NTHR, LDS_BYTES) != hipSuccess || per_cu < 1) fprintf(stderr, "kernel_launch: occupancy query reports %d blocks per CU\n", per_cu);
        (void)hipGetLastError();
        grid = cus;
    }
    if (grid < 0) return;
    (void)hipMemsetAsync((char*)d_ws + WS_CTL, 0, CTL_ZERO_BYTES, stream);
    Args a{};
    a.x_prompt = (const float*)d_in[0]; a.x_sample = (const float*)d_in[1]; a.cache_cmp = (const float*)d_in[2]; a.cache_slc = (const float*)d_in[3]; a.cache_win = (const float*)d_in[4];
    a.st_C = (const float*)d_in[5]; a.st_n = (const float*)d_in[6]; a.st_m = (const float*)d_in[7]; a.page_table = (const int*)d_in[8]; a.c_prompt = (const float*)d_in[9]; a.c_sample = (const float*)d_in[10];
    a.w_ada = (const float*)d_in[11]; a.b_ada = (const float*)d_in[12]; a.w_in = (const float*)d_in[13]; a.b_gate = (const float*)d_in[14]; a.ml_norm_g = (const float*)d_in[15]; a.cmp_pe = (const float*)d_in[16];
    a.cmp_w1 = (const float*)d_in[17]; a.cmp_w2 = (const float*)d_in[18]; a.rel_bias = (const float*)d_in[19]; a.w_out = (const float*)d_in[20]; a.ln_g = (const float*)d_in[21]; a.ln_b = (const float*)d_in[22];
    a.w_up = (const float*)d_in[23]; a.w_down = (const float*)d_in[24];
    a.out = (float*)d_out; a.ws = (unsigned char*)d_ws;
#if MK_PER_PHASE
    for (int ph = 0; ph < N_PHASES; ++ph) { a.ph_lo = ph; a.ph_hi = ph + 1; hipLaunchKernelGGL(fwd_kernel, dim3(grid), dim3(NTHR), LDS_BYTES, stream, a); }
#else
    a.ph_lo = 0; a.ph_hi = N_PHASES;
    hipLaunchKernelGGL(fwd_kernel, dim3(grid), dim3(NTHR), LDS_BYTES, stream, a);
#endif
    const hipError_t le = hipPeekAtLastError();
    if (le != hipSuccess) fprintf(stderr, "kernel_launch: launch failed: %s\n", hipGetErrorName(le));
}
```

```cpp
#include <hip/hip_runtime.h>
#include <cstdio>
#include <cstdint>
namespace pg8 {
#define PG8_LAS __attribute__((address_space(3)))
typedef unsigned short bf16_t;
typedef short bf16x8 __attribute__((ext_vector_type(8)));
typedef float f32x4 __attribute__((ext_vector_type(4)));
typedef unsigned u32x4 __attribute__((ext_vector_type(4)));
constexpr int BM = 256, BK = 64, HALF = 128, HTB = HALF * BK * 2  , STAGE_BYTES = 8 * HTB, NXCD = 8, WGM = 8;

__host__ __device__ __forceinline__ int lds_byte(int r, int c) { const int st = (r >> 4) * 2 + (c >> 5), rr = r & 15, cc = c & 31, ob = rr * 64 + cc * 2; return st * 1024 + (ob ^ (((ob >> 9) & 1) << 5)); }
__host__ __device__ __forceinline__ void stage_rc(int b, int& R, int& C) { const int st = b / 1024, sb = b % 1024, swz = sb ^ (((sb >> 9) & 1) << 5); R = (st >> 1) * 16 + swz / 64; C = (st & 1) * 32 + (swz % 64) / 2; }
__host__ __device__ __forceinline__ int perm32(int rho) { const int n = rho >> 4, i = rho & 15; return 8 * (i >> 2) + 4 * n + (i & 3); }

struct Unit { int pm, pn; };
struct Gemm { const bf16_t* A; const bf16_t* Bt; int K, lda, ldb; };

struct StaticOrder {
    int nM, nN, nwg, G, c;
    __host__ __device__ void init(int M, int N, int G_, int c_) { nM = M / BM; nN = N / BM; nwg = nM * nN; G = G_; c = c_; }
    __host__ __device__ bool next(int i, Unit& u) const {
        const long L = (long)i * G + c; if (L >= nwg) return false;
        int wgid = (int)L; { const int q = nwg / NXCD, r = nwg % NXCD, xcd = wgid % NXCD, off = wgid / NXCD; wgid = (xcd < r ? xcd * (q + 1) : r * (q + 1) + (xcd - r) * q) + off; }
        const int nig = WGM * nN, gid = wgid / nig, fm = gid * WGM, gsz = (nM - fm) < WGM ? (nM - fm) : WGM;
        u.pm = fm + ((wgid % nig) % gsz); u.pn = (wgid % nig) / gsz; return true;
    }
    __device__ __forceinline__ void a_ready(const Unit&) const {}
    __device__ __forceinline__ void done(const Unit&) const {}
};

template <class Epi, class Sched, bool ALIGN_EPI = false, bool SP2 = false>
__device__ __forceinline__ void gemm_phase(PG8_LAS unsigned char* lds, const Gemm g, const Sched& S, const Epi& E, const int tid) {
    const int wid = __builtin_amdgcn_readfirstlane(tid >> 6), lane = tid & 63, wr = wid >> 2, wc = wid & 3, fr = lane & 15, fq = lane >> 4;
    const int K = g.K, nt = K / BK;
    unsigned voffA[2], voffB[2];
#pragma unroll
    for (int i = 0; i < 2; ++i) { int R, C; stage_rc(tid * 16 + i * 8192, R, C); const int Rb = Epi::PERM ? ((R & ~31) + perm32(R & 31)) : R;
        voffA[i] = (unsigned)(R * g.lda + C) * 2u; voffB[i] = (unsigned)(Rb * g.ldb + C) * 2u; }
    const size_t kstep = (size_t)(BK * 2);
    const size_t hstepA = (size_t)HALF * g.lda * 2, hstepB = (size_t)HALF * g.ldb * 2;
    const size_t tstepA = 2 * hstepA, tstepB = 2 * hstepB;
    const unsigned ldsw = (unsigned)wid * 1024u;
    const int aoff = lds_byte(wr * 64 + fr, fq * 8), boff = lds_byte(wc * 32 + fr, fq * 8);
#define PG8_SA(b, h) (((b) * 2 + (h)) * HTB)
#define PG8_SB(b, h) ((4 + (b) * 2 + (h)) * HTB)
#define PG8_STAGE(bufoff, gbase, voff) do { _Pragma("unroll") for (int _i = 0; _i < 2; ++_i) \
        __builtin_amdgcn_global_load_lds((const unsigned*)((const char*)(gbase) + (voff)[_i]), (PG8_LAS unsigned*)(lds + (bufoff) + ldsw + _i * 8192), 16, 0, 0); } while (0)
#define PG8_LDA(dst, b, h) do { _Pragma("unroll") for (int m = 0; m < 4; ++m) _Pragma("unroll") for (int k = 0; k < 2; ++k) dst[m][k] = *(const PG8_LAS bf16x8*)(lds + PG8_SA(b, h) + aoff + m * 2048 + k * 1024); } while (0)
#define PG8_LDB(dst, b, h) do { _Pragma("unroll") for (int n = 0; n < 2; ++n) _Pragma("unroll") for (int k = 0; k < 2; ++k) dst[n][k] = *(const PG8_LAS bf16x8*)(lds + PG8_SB(b, h) + boff + n * 2048 + k * 1024); } while (0)
#define PG8_MMA(ai, bj, At, Bt) do { __builtin_amdgcn_s_setprio(1); _Pragma("unroll") for (int m = 0; m < 4; ++m) _Pragma("unroll") for (int n = 0; n < 2; ++n) _Pragma("unroll") for (int k = 0; k < 2; ++k) \
        acc[ai][bj][m][n] = __builtin_amdgcn_mfma_f32_16x16x32_bf16(Bt[n][k], At[m][k], acc[ai][bj][m][n], 0, 0, 0); __builtin_amdgcn_s_setprio(0); } while (0)
#define PG8_WAIT_V(n) asm volatile("s_waitcnt vmcnt(" #n ")" ::: "memory")
#define PG8_WAIT_L(n) asm volatile("s_waitcnt lgkmcnt(" #n ")" ::: "memory")
#define PG8_BAR __builtin_amdgcn_s_barrier()
#define PG8_SCHED __builtin_amdgcn_sched_barrier(0)
    Unit cur, nxt; int ui = 0;
    if (!S.next(0, cur)) return;
    f32x4 acc[2][2][4][2];
#pragma unroll
    for (int a = 0; a < 2; ++a)
#pragma unroll
        for (int b = 0; b < 2; ++b)
#pragma unroll
            for (int m = 0; m < 4; ++m)
#pragma unroll
                for (int n = 0; n < 2; ++n) acc[a][b][m][n] = (f32x4){0.f, 0.f, 0.f, 0.f};
    bf16x8 At[4][2], B0[2][2], B1[2][2];
    const char* cA = (const char*)g.A + (size_t)cur.pm * tstepA; const char* cB = (const char*)g.Bt + (size_t)cur.pn * tstepB;
    S.a_ready(cur);
    if constexpr (SP2) {
        PG8_STAGE(PG8_SB(0, 0), cB, voffB); PG8_STAGE(PG8_SB(0, 1), cB + hstepB, voffB); PG8_STAGE(PG8_SA(0, 0), cA, voffA); PG8_STAGE(PG8_SA(0, 1), cA + hstepA, voffA);
        if (wr == 1) PG8_BAR;
        PG8_WAIT_V(2); PG8_BAR;
        PG8_STAGE(PG8_SB(1, 0), cB + kstep, voffB); PG8_STAGE(PG8_SA(1, 0), cA + kstep, voffA); PG8_STAGE(PG8_SB(1, 1), cB + hstepB + kstep, voffB);
        PG8_WAIT_V(6); PG8_BAR;
    } else {
        PG8_STAGE(PG8_SB(0, 0), cB, voffB); PG8_STAGE(PG8_SA(0, 0), cA, voffA); PG8_STAGE(PG8_SB(0, 1), cB + hstepB, voffB); PG8_STAGE(PG8_SA(0, 1), cA + hstepA, voffA);
        if (wr == 1) PG8_BAR;
        PG8_WAIT_V(4); PG8_BAR;
        PG8_STAGE(PG8_SB(1, 0), cB + kstep, voffB); PG8_STAGE(PG8_SA(1, 0), cA + kstep, voffA); PG8_STAGE(PG8_SB(1, 1), cB + hstepB + kstep, voffB);
        PG8_WAIT_V(6); PG8_BAR;
    }
    for (;;) {
        const bool has_next = S.next(ui + 1, nxt);
        const char* nA = has_next ? (const char*)g.A + (size_t)nxt.pm * tstepA : cA; const char* nB = has_next ? (const char*)g.Bt + (size_t)nxt.pn * tstepB : cB;
        for (int t = 0; t < nt; t += 2) {
            const bool last = (t == nt - 2);
            const char* a1 = cA + (size_t)(t + 1) * kstep;
            const char* a2 = last ? nA : cA + (size_t)(t + 2) * kstep; const char* b2 = last ? nB : cB + (size_t)(t + 2) * kstep;
            const char* a3 = a2 + kstep; const char* b3 = b2 + kstep;
            if (last && has_next) S.a_ready(nxt);
            if constexpr (SP2) {
            PG8_LDB(B0, 0, 0); PG8_LDB(B1, 0, 1); PG8_SCHED; PG8_LDA(At, 0, 0); PG8_STAGE(PG8_SA(1, 1), a1 + hstepA, voffA);
            PG8_WAIT_V(8); PG8_WAIT_L(0); PG8_BAR; PG8_MMA(0, 0, At, B0); PG8_MMA(0, 1, At, B1); PG8_BAR; PG8_SCHED;
            PG8_LDA(At, 0, 1); PG8_STAGE(PG8_SB(0, 0), b2, voffB); PG8_STAGE(PG8_SB(0, 1), b2 + hstepB, voffB); PG8_STAGE(PG8_SA(0, 0), a2, voffA);
            PG8_WAIT_V(8); PG8_WAIT_L(0); PG8_BAR; PG8_MMA(1, 0, At, B0); PG8_MMA(1, 1, At, B1); PG8_BAR; PG8_SCHED;
            PG8_LDB(B0, 1, 0); PG8_LDB(B1, 1, 1); PG8_SCHED; PG8_LDA(At, 1, 0); PG8_STAGE(PG8_SA(0, 1), a2 + hstepA, voffA);
            PG8_WAIT_V(8); PG8_WAIT_L(0); PG8_BAR; PG8_MMA(0, 0, At, B0); PG8_MMA(0, 1, At, B1); PG8_BAR; PG8_SCHED;
            PG8_LDA(At, 1, 1); PG8_STAGE(PG8_SB(1, 0), b3, voffB); PG8_STAGE(PG8_SB(1, 1), b3 + hstepB, voffB); PG8_STAGE(PG8_SA(1, 0), a3, voffA);
            PG8_WAIT_V(8); PG8_WAIT_L(0); PG8_BAR; PG8_MMA(1, 0, At, B0); PG8_MMA(1, 1, At, B1); PG8_BAR; PG8_SCHED;
            } else {
            PG8_LDB(B0, 0, 0); PG8_SCHED; PG8_LDA(At, 0, 0); PG8_STAGE(PG8_SA(1, 1), a1 + hstepA, voffA);
            PG8_WAIT_L(8); PG8_BAR; PG8_WAIT_L(0); PG8_MMA(0, 0, At, B0); PG8_BAR; PG8_SCHED;
            PG8_LDB(B1, 0, 1); PG8_STAGE(PG8_SB(0, 0), b2, voffB);
            PG8_BAR; PG8_WAIT_L(0); PG8_MMA(0, 1, At, B1); PG8_BAR;
            PG8_LDA(At, 0, 1); PG8_STAGE(PG8_SA(0, 0), a2, voffA);
            PG8_BAR; PG8_WAIT_L(0); PG8_MMA(1, 0, At, B0); PG8_BAR; PG8_SCHED;
            PG8_STAGE(PG8_SB(0, 1), b2 + hstepB, voffB);
            PG8_WAIT_V(6); PG8_BAR; PG8_MMA(1, 1, At, B1); PG8_BAR;
            PG8_LDB(B0, 1, 0); PG8_SCHED; PG8_LDA(At, 1, 0); PG8_STAGE(PG8_SA(0, 1), a2 + hstepA, voffA);
            PG8_WAIT_L(8); PG8_BAR; PG8_WAIT_L(0); PG8_MMA(0, 0, At, B0); PG8_BAR; PG8_SCHED;
            PG8_LDB(B1, 1, 1); PG8_STAGE(PG8_SB(1, 0), b3, voffB);
            PG8_BAR; PG8_WAIT_L(0); PG8_MMA(0, 1, At, B1); PG8_BAR;
            PG8_LDA(At, 1, 1); PG8_STAGE(PG8_SA(1, 0), a3, voffA);
            PG8_BAR; PG8_WAIT_L(0); PG8_MMA(1, 0, At, B0); PG8_BAR; PG8_SCHED;
            PG8_STAGE(PG8_SB(1, 1), b3 + hstepB, voffB);
            PG8_WAIT_V(6); PG8_BAR; PG8_MMA(1, 1, At, B1); PG8_BAR;
            }
        }
        if constexpr (ALIGN_EPI) { if (wr == 0) PG8_BAR; }
        if constexpr (!Epi::AFTER_DRAIN) { E(acc, cur, wr, wc, fr, fq); S.done(cur); }
        if (!has_next) break;
#pragma unroll
        for (int a = 0; a < 2; ++a)
#pragma unroll
            for (int b = 0; b < 2; ++b)
#pragma unroll
                for (int m = 0; m < 4; ++m)
#pragma unroll
                    for (int n = 0; n < 2; ++n) acc[a][b][m][n] = (f32x4){0.f, 0.f, 0.f, 0.f};
        cur = nxt; cA = nA; cB = nB; ++ui;
        if constexpr (ALIGN_EPI) { if (wr == 1) PG8_BAR; }
    }
    PG8_WAIT_V(0);
    if constexpr (!ALIGN_EPI) { if (wr == 0) PG8_BAR; }
    PG8_BAR;
    if constexpr (Epi::AFTER_DRAIN) { E.fused(acc, cur, wr, wc, fr, fq, lds, wid, lane); S.done(cur); }
#undef PG8_SA
#undef PG8_SB
#undef PG8_STAGE
#undef PG8_LDA
#undef PG8_LDB
#undef PG8_MMA
#undef PG8_WAIT_V
#undef PG8_WAIT_L
#undef PG8_BAR
#undef PG8_SCHED
}
}

#ifndef REP_MASK
#define REP_MASK 0
#endif

constexpr int D = 1024, BATCH = 2, SEQ = 8192, DEPTH = 2, DB = 128, DS = 4, PAST = 2048, PAGE = 128, NPG = 16, NPHYS = 2560;
constexpr int MP = BATCH * SEQ, MS = DB * DS, M = MP + MS;
constexpr int NINP = 3584, FF = 4096, NCOND = BATCH + DB;
constexpr int NH = 4, HD = 128;
constexpr int LCH = 256, NCH = SEQ / LCH, NUNIT = BATCH * NH * NCH;
constexpr int NCB = 17408;
constexpr int XCP = NCB * 16;
constexpr float ALPHA = 1.4142135623730951f;
constexpr float LN_EPS = 1e-5f;
constexpr size_t O_YP = 0, O_YS = O_YP + (size_t)MP * D, O_CMPP = O_YS + (size_t)MS * D, O_CMPS = O_CMPP + (size_t)DEPTH * MP * 256, O_SLCP = O_CMPS + (size_t)DEPTH * MS * 256,
                 O_SLCS = O_SLCP + (size_t)DEPTH * MP * 256, O_WINP = O_SLCS + (size_t)DEPTH * MS * 256, O_WINS = O_WINP + (size_t)DEPTH * BATCH * 512 * 256,
                 O_CP = O_WINS + (size_t)DEPTH * DB * 512 * 256, O_CS = O_CP + (size_t)DEPTH * BATCH * NH * HD * HD, O_NP = O_CS + (size_t)DEPTH * DB * NH * HD * HD,
                 O_NS = O_NP + (size_t)DEPTH * BATCH * NH * HD, O_MP = O_NS + (size_t)DEPTH * DB * NH * HD, O_MS = O_MP + (size_t)DEPTH * BATCH * NH, O_END = O_MS + (size_t)DEPTH * DB * NH;

constexpr size_t al1m(size_t x) { return (x + 0xFFFFFull) & ~(size_t)0xFFFFFull; }
constexpr size_t WS_CTL = 0, CTL_ZERO_BYTES = 1u << 20;
constexpr size_t WS_WIN  = CTL_ZERO_BYTES;
constexpr size_t WS_WOUT = WS_WIN  + al1m((size_t)DEPTH * NINP * D * 2);
constexpr size_t WS_WUP  = WS_WOUT + al1m((size_t)DEPTH * D * D * 2);
constexpr size_t WS_WDN  = WS_WUP  + al1m((size_t)DEPTH * FF * D * 2);
constexpr size_t WS_W1   = WS_WDN  + al1m((size_t)DEPTH * D * FF * 2);
constexpr size_t WS_ADA  = WS_W1   + al1m((size_t)DEPTH * 2 * 256 * 2048 * 2);
constexpr size_t WS_B1   = WS_ADA  + al1m((size_t)DEPTH * NCOND * 6144 * 4);
constexpr size_t WS_BT   = WS_B1   + al1m(4096);
constexpr size_t WS_X    = WS_BT   + al1m(8 * 132 * 4);
constexpr size_t WS_Z    = WS_X    + al1m((size_t)M * D * 4);
constexpr size_t WS_U    = WS_Z    + al1m((size_t)M * D * 4);
constexpr size_t WS_QKVO = WS_U    + al1m((size_t)M * D * 2);
constexpr size_t WS_NQ   = WS_QKVO + al1m((size_t)M * 2048 * 2);
constexpr size_t WS_GATE = WS_NQ   + al1m((size_t)M * 512 * 2);
constexpr size_t WS_KVR  = WS_GATE + al1m((size_t)M * 32 * 4);
constexpr size_t WS_XC   = WS_KVR  + al1m((size_t)3 * M * 256 * 4);
constexpr size_t WS_HID  = WS_XC   + al1m((size_t)DEPTH * 4 * XCP * 64 * 2 + 4096);
constexpr size_t WS_CKV  = WS_HID  + al1m((size_t)DEPTH * 4 * NCB * 256 * 2);
constexpr size_t WS_KS   = WS_CKV  + al1m((size_t)DEPTH * 4 * NCB * 64 * 4);
constexpr size_t WS_VTS  = WS_KS   + al1m((size_t)DEPTH * 2 * (MP + DB * 2112) * 64 * 2 + 65536);
constexpr size_t WS_KW   = WS_VTS  + al1m((size_t)DEPTH * 2 * (MP + DB * 2112) * 64 * 2 + 65536);
constexpr size_t WS_VTW  = WS_KW   + al1m((size_t)DEPTH * 2 * (MP + DB * 576 + 64) * 64 * 2 + 65536);
constexpr size_t WS_KC   = WS_VTW  + al1m((size_t)DEPTH * 2 * (MP + DB * 576 + 64) * 64 * 2 + 65536);
constexpr size_t WS_VCT  = WS_KC   + al1m((size_t)DEPTH * 2 * NCB * 64 * 2 + 65536);
constexpr size_t WS_W2T  = WS_VCT  + al1m((size_t)DEPTH * 2 * NCB * 64 * 2 + 65536);
constexpr size_t WS_MIX  = WS_W2T  + al1m(65536);
constexpr size_t WS_H    = WS_MIX  + al1m((size_t)M * D * 2);
constexpr size_t WS_DCT  = WS_H    + al1m((size_t)M * FF * 2);
constexpr size_t WS_DN   = WS_DCT  + al1m((size_t)NUNIT * HD * HD * 4);
constexpr size_t WS_CHS  = WS_DN   + al1m((size_t)NUNIT * HD * 4);
constexpr size_t WS_CTP  = WS_CHS  + al1m((size_t)NUNIT * 4 * 4);
constexpr size_t WS_NPV  = WS_CTP  + al1m((size_t)NUNIT * HD * HD * 2);
constexpr size_t WS_WSC  = WS_NPV  + al1m((size_t)NUNIT * HD * 4);
constexpr size_t WS_HRAW = WS_WSC  + al1m((size_t)NUNIT * LCH * LCH * 4);
constexpr size_t WS_END  = WS_HRAW + al1m((size_t)NUNIT * LCH * HD * 4);

constexpr int CW_BAR = 4096;

constexpr int RING_BYTES = 131072, LDSCTL_OFF = RING_BYTES, MISC_OFF = LDSCTL_OFF + 320, LDS_BYTES = 147456;
constexpr int NWAVES = 8, NTHR = NWAVES * 64;

#define GAS __attribute__((address_space(1)))
#define LAS __attribute__((address_space(3)))
typedef unsigned short bf16;
typedef unsigned v4u __attribute__((ext_vector_type(4)));
typedef unsigned v2u __attribute__((ext_vector_type(2)));
typedef float f32x4 __attribute__((ext_vector_type(4)));
typedef float f32x2 __attribute__((ext_vector_type(2)));

__device__ __forceinline__ unsigned f2bf(float f) { unsigned u = __builtin_bit_cast(unsigned, f); return (u + 0x7fffu + ((u >> 16) & 1u)) >> 16; }
__device__ __forceinline__ unsigned pk2(float lo, float hi) { unsigned r; asm("v_cvt_pk_bf16_f32 %0, %1, %2" : "=v"(r) : "v"(lo), "v"(hi)); return r; }
__device__ __forceinline__ float bflo(unsigned u) { return __builtin_bit_cast(float, u << 16); }
__device__ __forceinline__ float bfhi(unsigned u) { return __builtin_bit_cast(float, u & 0xffff0000u); }
__device__ __forceinline__ float bf2f(bf16 h) { return __builtin_bit_cast(float, (unsigned)h << 16); }
__device__ __forceinline__ float sigmoidf_(float x) { return 1.f / (1.f + __expf(-x)); }
__device__ __forceinline__ float wave_sum(float v) {
#pragma unroll
    for (int o = 1; o < 64; o <<= 1) v += __shfl_xor(v, o);
    return v;
}
__device__ __forceinline__ float wave_max(float v) {
#pragma unroll
    for (int o = 1; o < 64; o <<= 1) v = fmaxf(v, __shfl_xor(v, o));
    return v;
}

#define XB_TMO      128
#define XB_XCNT(j)  (256  + 64 * (j))
#define XB_XSUB(j)  (1280 + 64 * (j))
#define XB_XGEN(j)  (2304 + 64 * (j))
#define XB_TOP      3328
#define XB_TOPGEN   3392
#define XCD_BAR_WORDS 3456
#define XB_SPIN_CAP (1u << 18)

__device__ __forceinline__ unsigned xb_ld(unsigned* p)              { return __hip_atomic_load(p, __ATOMIC_RELAXED, __HIP_MEMORY_SCOPE_AGENT); }
__device__ __forceinline__ unsigned xb_add(unsigned* p, unsigned v) { return __hip_atomic_fetch_add(p, v, __ATOMIC_RELAXED, __HIP_MEMORY_SCOPE_AGENT); }
__device__ __forceinline__ unsigned xb_xcc_id() { return (unsigned)__builtin_amdgcn_s_getreg((3 << 11) | 20) & 0xFu; }
#define XB_SPIN(cond, bar) do { unsigned _sp = 0; while (cond) { __builtin_amdgcn_s_sleep(1); \
    if ((++_sp & 255u) == 0u) { if (xb_ld(&(bar)[XB_TMO])) break; if (_sp > XB_SPIN_CAP) { atomicAdd(&(bar)[XB_TMO], 1u); break; } } } } while (0)

struct XcdBarrier {
    unsigned* bar; unsigned x;
    volatile LAS unsigned* st;
};

__device__ __forceinline__ XcdBarrier xcd_barrier_post(unsigned* bar, volatile LAS unsigned* st) {
    XcdBarrier b; b.bar = bar; b.x = xb_xcc_id(); b.st = st;
    if (threadIdx.x == 0) (void)xb_add(&bar[XB_XCNT(b.x)], 1u);
    return b;
}
__device__ __forceinline__ void xcd_barrier_complete(unsigned* bar, unsigned x, unsigned& nloc, unsigned& nx) {
    const unsigned G = gridDim.x * gridDim.y * gridDim.z;
    unsigned sum, cnt, mine, sp = 0u;
    for (;;) {
        sum = 0u; cnt = 0u; mine = 0u;
#pragma unroll
        for (unsigned j = 0; j < 16; ++j) { const unsigned c = xb_ld(&bar[XB_XCNT(j)]); sum += c; cnt += (c > 0u) ? 1u : 0u; mine = (j == x) ? c : mine; }
        if (sum == G) break;
        __builtin_amdgcn_s_sleep(1);
        if ((++sp & 255u) == 0u) { if (xb_ld(&bar[XB_TMO])) break; if (sp > XB_SPIN_CAP) { atomicAdd(&bar[XB_TMO], 1u); break; } }
    }
    nloc = mine > 0u ? mine : 1u; nx = cnt > 0u ? cnt : 1u;
}

__device__ __forceinline__ void xcd_barrier(const XcdBarrier& b) {
    asm volatile("s_waitcnt vmcnt(0)" ::: "memory");
    __syncthreads();
    if (threadIdx.x == 0) {
        unsigned* bar = b.bar;
        __builtin_amdgcn_s_waitcnt(0);
        unsigned nloc = b.st[0], nx = b.st[1];
        if (nloc == 0u) { xcd_barrier_complete(bar, b.x, nloc, nx); b.st[0] = nloc; b.st[1] = nx; }
        const unsigned old = xb_add(&bar[XB_XSUB(b.x)], 1u);
        const unsigned gen = old / nloc;
        if (old + 1u == (gen + 1u) * nloc) {
            __builtin_amdgcn_fence(__ATOMIC_RELEASE, "agent");
            asm volatile("s_waitcnt vmcnt(0)" ::: "memory");
            const unsigned og = xb_add(&bar[XB_TOP], 1u);
            const unsigned tg = og / nx;
            if (og + 1u == (tg + 1u) * nx) xb_add(&bar[XB_TOPGEN], 1u);
            else XB_SPIN(xb_ld(&bar[XB_TOPGEN]) == tg, bar);
            __builtin_amdgcn_fence(__ATOMIC_ACQUIRE, "agent");
            xb_add(&bar[XB_XGEN(b.x)], 1u);
            asm volatile("s_waitcnt vmcnt(0)" ::: "memory");
        } else {
            XB_SPIN(xb_ld(&bar[XB_XGEN(b.x)]) == gen, bar);
            __builtin_amdgcn_fence(__ATOMIC_ACQUIRE, "agent");
            asm volatile("s_waitcnt vmcnt(0)" ::: "memory");
        }
    }
    __syncthreads();
}

struct Args {
    const float* x_prompt; const float* x_sample; const float* cache_cmp; const float* cache_slc; const float* cache_win;
    const float* st_C; const float* st_n; const float* st_m; const int* page_table; const float* c_prompt; const float* c_sample;
    const float* w_ada; const float* b_ada; const float* w_in; const float* b_gate; const float* ml_norm_g; const float* cmp_pe;
    const float* cmp_w1; const float* cmp_w2; const float* rel_bias; const float* w_out; const float* ln_g; const float* ln_b;
    const float* w_up; const float* w_down;
    float* out; unsigned char* ws; int ph_lo, ph_hi, bar_region, pad_;
};
static_assert(sizeof(Args) == 27 * 8 + 16, "Args has no padding");
typedef const __attribute__((address_space(4))) Args CArgs;

__device__ __forceinline__ int cond_of_row(int r) { return r < MP ? (r >> 13) : BATCH + ((r - MP) >> 2); }

struct EpiInProj {
    static constexpr bool PERM = true, AFTER_DRAIN = false;
    bf16* QKVO; bf16* NQ; float* GATE; float* KVR; bf16* XC; float* out; int l;
    __device__ __forceinline__ void operator()(const f32x4 (&acc)[2][2][4][2], const pg8::Unit& u, int wr, int wc, int fr, int fq) const {
        const int row0 = u.pm * 256 + wr * 64 + fr, pn = u.pn, col8 = wc * 32 + 8 * fq;
#pragma unroll
        for (int ai = 0; ai < 2; ++ai)
#pragma unroll
            for (int m = 0; m < 4; ++m) {
                const int r = row0 + ai * 128 + m * 16;
#pragma unroll
                for (int bj = 0; bj < 2; ++bj) {
                    const f32x4 v0 = acc[ai][bj][m][0], v1 = acc[ai][bj][m][1];
                    const int cc = bj * 128 + col8;
                    if (pn < 10) {
                        v4u w; w.x = pk2(v0[0], v0[1]); w.y = pk2(v0[2], v0[3]); w.z = pk2(v1[0], v1[1]); w.w = pk2(v1[2], v1[3]);
                        if (pn < 8) *(v4u*)(QKVO + (size_t)r * 2048 + pn * 256 + cc) = w;
                        else        *(v4u*)(NQ + (size_t)r * 512 + (pn - 8) * 256 + cc) = w;
                    } else if (pn < 13) {
                        const int kind = pn - 10;
                        float* kr = KVR + ((size_t)kind * M + r) * 256 + cc;
                        *(f32x4*)kr = v0; *(f32x4*)(kr + 4) = v1;
                        float* o = nullptr;
                        if (r < MP) {
                            if (kind < 2) o = out + (kind == 0 ? O_CMPP : O_SLCP) + ((size_t)l * MP + r) * 256 + cc;
                            else { const int t = r & (SEQ - 1); if (t >= SEQ - 512) o = out + O_WINP + (((size_t)l * BATCH + (r >> 13)) * 512 + (t - (SEQ - 512))) * 256 + cc; }
                        } else {
                            const int rs = r - MP;
                            if (kind < 2) o = out + (kind == 0 ? O_CMPS : O_SLCS) + ((size_t)l * MS + rs) * 256 + cc;
                            else o = out + O_WINS + (((size_t)l * DB + (rs >> 2)) * 512 + 508 + (rs & 3)) * 256 + cc;
                        }
                        if (o) { *(f32x4*)o = v0; *(f32x4*)(o + 4) = v1; }
                        if (kind == 0 && r < MP) {
                            v4u w; w.x = pk2(v0[0], v0[1]); w.y = pk2(v0[2], v0[3]); w.z = pk2(v1[0], v1[1]); w.w = pk2(v1[2], v1[3]);
                            *(v4u*)(XC + ((size_t)(bj * 2 + (wc >> 1)) * XCP + r) * 64 + (wc & 1) * 32 + 8 * fq) = w;
                        }
                    } else {
                        if (bj == 0 && wc == 0) { float* gp = GATE + (size_t)r * 32 + 8 * fq; *(f32x4*)gp = v0; *(f32x4*)(gp + 4) = v1; }
                    }
                }
            }
    }
};

struct EpiResid {
    static constexpr bool PERM = true, AFTER_DRAIN = false;
    const float* xa; const float* xb; const float* gate; bf16* Z;
    __device__ __forceinline__ void operator()(const f32x4 (&acc)[2][2][4][2], const pg8::Unit& u, int wr, int wc, int fr, int fq) const {
        const int row0 = u.pm * 256 + wr * 64 + fr, col0 = u.pn * 256 + wc * 32 + 8 * fq;
#pragma unroll
        for (int ai = 0; ai < 2; ++ai)
#pragma unroll
            for (int m = 0; m < 4; ++m) {
                const int r = row0 + ai * 128 + m * 16;
                const float* xr = (r < MP ? xa + (size_t)r * D : xb + (size_t)(r - MP) * D) + col0;
                const float* gr = gate + (size_t)cond_of_row(r) * 6144 + col0;
                bf16* zr = Z + (size_t)r * D + col0;
#pragma unroll
                for (int bj = 0; bj < 2; ++bj) {
                    const f32x4 x0 = *(const f32x4*)(xr + bj * 128), x1 = *(const f32x4*)(xr + bj * 128 + 4);
                    const f32x4 g0 = *(const f32x4*)(gr + bj * 128), g1 = *(const f32x4*)(gr + bj * 128 + 4);
                    const f32x4 z0 = x0 * ALPHA + g0 * acc[ai][bj][m][0], z1 = x1 * ALPHA + g1 * acc[ai][bj][m][1];
                    v4u w; w.x = pk2(z0[0], z0[1]); w.y = pk2(z0[2], z0[3]); w.z = pk2(z1[0], z1[1]); w.w = pk2(z1[2], z1[3]);
                    *(v4u*)(zr + bj * 128) = w;
                }
            }
    }
};

struct EpiRelu2 {
    static constexpr bool PERM = true, AFTER_DRAIN = false;
    bf16* H;
    __device__ __forceinline__ void operator()(const f32x4 (&acc)[2][2][4][2], const pg8::Unit& u, int wr, int wc, int fr, int fq) const {
        const int row0 = u.pm * 256 + wr * 64 + fr, col0 = u.pn * 256 + wc * 32 + 8 * fq;
#pragma unroll
        for (int ai = 0; ai < 2; ++ai)
#pragma unroll
            for (int m = 0; m < 4; ++m) {
                bf16* hr = H + (size_t)(row0 + ai * 128 + m * 16) * FF + col0;
#pragma unroll
                for (int bj = 0; bj < 2; ++bj) {
                    f32x4 a = acc[ai][bj][m][0], b = acc[ai][bj][m][1];
#pragma unroll
                    for (int i = 0; i < 4; ++i) { a[i] = fmaxf(a[i], 0.f); a[i] *= a[i]; b[i] = fmaxf(b[i], 0.f); b[i] *= b[i]; }
                    v4u w; w.x = pk2(a[0], a[1]); w.y = pk2(a[2], a[3]); w.z = pk2(b[0], b[1]); w.w = pk2(b[2], b[3]);
                    *(v4u*)(hr + bj * 128) = w;
                }
            }
    }
};

__device__ __forceinline__ float gelu_tanh(float x) {
    const float y = 0.7978845608028654f * (x + 0.044715f * x * x * x);
    const float t = 1.f - 2.f / (__expf(2.f * y) + 1.f);
    return 0.5f * x * (1.f + t);
}
struct EpiCmpHid {
    static constexpr bool PERM = true, AFTER_DRAIN = false;
    bf16* HID; const float* B1;
    __device__ __forceinline__ void operator()(const f32x4 (&acc)[2][2][4][2], const pg8::Unit& u, int wr, int wc, int fr, int fq) const {
        const int row0 = u.pm * 256 + wr * 64 + fr, col0 = wc * 32 + 8 * fq;
        const float* bp = B1 + u.pn * 256 + col0;
        f32x4 bv[2][2];
#pragma unroll
        for (int bj = 0; bj < 2; ++bj) { bv[bj][0] = *(const f32x4*)(bp + bj * 128); bv[bj][1] = *(const f32x4*)(bp + bj * 128 + 4); }
#pragma unroll
        for (int ai = 0; ai < 2; ++ai)
#pragma unroll
            for (int m = 0; m < 4; ++m) {
                bf16* hr = HID + (size_t)(row0 + ai * 128 + m * 16) * 256 + col0;
#pragma unroll
                for (int bj = 0; bj < 2; ++bj) {
                    f32x4 a = acc[ai][bj][m][0] + bv[bj][0], b = acc[ai][bj][m][1] + bv[bj][1];
#pragma unroll
                    for (int i = 0; i < 4; ++i) { a[i] = gelu_tanh(a[i]); b[i] = gelu_tanh(b[i]); }
                    v4u w; w.x = pk2(a[0], a[1]); w.y = pk2(a[2], a[3]); w.z = pk2(b[0], b[1]); w.w = pk2(b[2], b[3]);
                    *(v4u*)(hr + bj * 128) = w;
                }
            }
    }
};

struct CmpOrder {
    int G, c, l0, nl, t0, ntile;
    __device__ __forceinline__ bool next(int i, pg8::Unit& u) const {
        const int L = i * G + c; if (L >= nl * 4 * ntile) return false;
        const int blk = L / ntile, tile = L % ntile, l = l0 + (blk >> 2), sg = blk & 3;
        u.pm = (l * 4 + sg) * 68 + t0 + tile; u.pn = l * 2 + (sg >> 1); return true;
    }
    __device__ __forceinline__ void a_ready(const pg8::Unit&) const {}
    __device__ __forceinline__ void done(const pg8::Unit&) const {}
};

typedef short sg_bf16x8 __attribute__((ext_vector_type(8)));
template <class Epi>
__device__ __forceinline__ void small_gemm(const bf16* A, size_t strideA, int lda, const bf16* Bt, size_t strideB, int ldb, int K, int nbatch, int Mrows, int N, const Epi& E, LAS unsigned char* lds, int tid) {
    const int lane = tid & 63, wave = tid >> 6, fr = lane & 15, fq = lane >> 4;
    const int ntn = N / 64, ntm = Mrows / 32, ntask = nbatch * ntm * ntn, kw = K / 8;
    LAS f32x4* red = (LAS f32x4*)lds;
    for (int task = blockIdx.x; task < ntask; task += gridDim.x) {
        const int batch = task / (ntm * ntn), tr = task % (ntm * ntn), tm = tr / ntn, tn = tr % ntn;
        const bf16* ap = A + (size_t)batch * strideA + (size_t)(tm * 32 + fr) * lda + wave * kw + 8 * fq;
        const bf16* bp = Bt + (size_t)E.bsel(batch) * strideB + (size_t)(tn * 64 + fr) * ldb + wave * kw + 8 * fq;
        f32x4 acc[2][4];
#pragma unroll
        for (int i = 0; i < 2; ++i)
#pragma unroll
            for (int j = 0; j < 4; ++j) acc[i][j] = (f32x4){0.f, 0.f, 0.f, 0.f};
#pragma unroll 4
        for (int k = 0; k < kw; k += 32) {
            sg_bf16x8 af[2], bf[4];
#pragma unroll
            for (int i = 0; i < 2; ++i) af[i] = *(const sg_bf16x8*)(ap + (size_t)i * 16 * lda + k);
#pragma unroll
            for (int j = 0; j < 4; ++j) bf[j] = *(const sg_bf16x8*)(bp + (size_t)j * 16 * ldb + k);
#pragma unroll
            for (int i = 0; i < 2; ++i)
#pragma unroll
                for (int j = 0; j < 4; ++j) acc[i][j] = __builtin_amdgcn_mfma_f32_16x16x32_bf16(bf[j], af[i], acc[i][j], 0, 0, 0);
        }
        __syncthreads();
#pragma unroll
        for (int i = 0; i < 2; ++i)
#pragma unroll
            for (int j = 0; j < 4; ++j) red[(wave * 8 + i * 4 + j) * 64 + lane] = acc[i][j];
        __syncthreads();
        f32x4 sum = red[wave * 64 + lane];
#pragma unroll
        for (int w = 1; w < 8; ++w) sum = sum + red[(w * 8 + wave) * 64 + lane];
        E(batch, tm * 32 + (wave >> 2) * 16 + fr, tn * 64 + (wave & 3) * 16 + 4 * fq, sum);
    }
}
struct SgResid {
    const float* xb; const float* gate; bf16* Z;
    __device__ __forceinline__ int bsel(int) const { return 0; }
    __device__ __forceinline__ void operator()(int, int rl, int c, const f32x4& acc) const {
        const int r = MP + rl;
        const f32x4 x = *(const f32x4*)(xb + (size_t)rl * D + c), gg = *(const f32x4*)(gate + (size_t)cond_of_row(r) * 6144 + c);
        const f32x4 z = x * ALPHA + gg * acc; v2u w; w.x = pk2(z[0], z[1]); w.y = pk2(z[2], z[3]);
        *(v2u*)(Z + (size_t)r * D + c) = w;
    }
};
struct SgRelu2 {
    bf16* H;
    __device__ __forceinline__ int bsel(int) const { return 0; }
    __device__ __forceinline__ void operator()(int, int rl, int c, const f32x4& acc) const {
        f32x4 a = acc;
#pragma unroll
        for (int i = 0; i < 4; ++i) { a[i] = fmaxf(a[i], 0.f); a[i] *= a[i]; }
        v2u w; w.x = pk2(a[0], a[1]); w.y = pk2(a[2], a[3]);
        *(v2u*)(H + (size_t)(MP + rl) * FF + c) = w;
    }
};
struct SgCmpHid {
    bf16* HIDl; const float* B1l;
    __device__ __forceinline__ int bsel(int img) const { return img >> 1; }
    __device__ __forceinline__ void operator()(int img, int R, int c, const f32x4& acc) const {
        const f32x4 bb = *(const f32x4*)(B1l + (img >> 1) * 256 + c);
        f32x4 a = acc + bb;
#pragma unroll
        for (int i = 0; i < 4; ++i) a[i] = gelu_tanh(a[i]);
        v2u w; w.x = pk2(a[0], a[1]); w.y = pk2(a[2], a[3]);
        *(v2u*)(HIDl + ((size_t)img * NCB + R) * 256 + c) = w;
    }
};

#define LDS_WAIT() asm volatile("s_waitcnt lgkmcnt(0)" ::: "memory")
#define VM_WAIT() asm volatile("s_waitcnt vmcnt(0)" ::: "memory")

template <class CM>
__device__ __forceinline__ void transpose_item(const float* W, int ldw, int K, bf16* WT, LAS float* scr, int item, int nblk, int lane, const CM& cm) {
    const int kb = item / nblk, nb = item % nblk, k0 = 32 * kb, n0 = 64 * nb, c4 = (lane & 15) * 4;
    const int sc = cm.col(n0 + c4); const float scl = cm.scl(n0 + c4);
    f32x4 v[8];
#pragma unroll
    for (int i = 0; i < 8; ++i) { const int kk = 4 * i + (lane >> 4); v[i] = sc >= 0 ? *(const f32x4*)(W + (size_t)(k0 + kk) * ldw + sc) : (f32x4){0.f, 0.f, 0.f, 0.f}; }
#pragma unroll
    for (int i = 0; i < 8; ++i) { const int kk = 4 * i + (lane >> 4); LAS float* p = scr + kk * 65 + c4; p[0] = v[i][0] * scl; p[1] = v[i][1] * scl; p[2] = v[i][2] * scl; p[3] = v[i][3] * scl; }
    LDS_WAIT();
    const LAS float* s = scr + lane;
#pragma unroll
    for (int c = 0; c < 4; ++c) {
        v4u o; o.x = pk2(s[(8 * c + 0) * 65], s[(8 * c + 1) * 65]); o.y = pk2(s[(8 * c + 2) * 65], s[(8 * c + 3) * 65]); o.z = pk2(s[(8 * c + 4) * 65], s[(8 * c + 5) * 65]); o.w = pk2(s[(8 * c + 6) * 65], s[(8 * c + 7) * 65]);
        *(v4u*)(WT + (size_t)(n0 + lane) * K + k0 + 8 * c) = o; }
    LDS_WAIT();
}
struct CmId { __device__ __forceinline__ int col(int n) const { return n; } __device__ __forceinline__ float scl(int) const { return 1.f; } };
struct CmIn {
    __device__ __forceinline__ int col(int n) const { return n < 2048 ? n : (n < 3328 ? n + 8 : (n < 3336 ? n - 1280 : (n < 3360 ? n : -1))); }
    __device__ __forceinline__ float scl(int n) const { return (n >= 512 && n < 1024) ? 0.08838834764831845f : ((n >= 2048 && n < 2560) ? 0.18033688011112042f : 1.f); }
};

__device__ __forceinline__ int rel_bucket_dev(int n) {
    if (n < 16) return n;
    const float nf = (float)n;
    int large = 16 + (int)(__logf(nf / 16.f) / 2.0794415416798357f * 16.f);
    return large < 31 ? large : 31;
}

__device__ __forceinline__ void phase_p0a(CArgs& A, LAS unsigned char* lds, int gw, int NGW, int lane, int wave) {
    unsigned char* ws = A.ws;
    LAS float* scr = (LAS float*)(lds + wave * 16384);
    constexpr int I_IN = 16 * 112, I_OUT = 16 * 32, I_UP = 16 * 128, I_DN = 64 * 32, I_W1 = 32 * 8;
    constexpr int I_L = I_IN + I_OUT + I_UP + I_DN + 2 * I_W1;
    for (int it = gw; it < DEPTH * I_L; it += NGW) {
        const int l = it / I_L; int r = it % I_L;
        if (r < I_IN) { transpose_item(A.w_in + (size_t)l * D * 3360, 3360, D, (bf16*)(ws + WS_WIN) + (size_t)l * NINP * D, scr, r, 56, lane, CmIn{}); continue; } r -= I_IN;
        if (r < I_OUT) { transpose_item(A.w_out + (size_t)l * D * D, D, D, (bf16*)(ws + WS_WOUT) + (size_t)l * D * D, scr, r, 16, lane, CmId{}); continue; } r -= I_OUT;
        if (r < I_UP) { transpose_item(A.w_up + (size_t)l * D * FF, FF, D, (bf16*)(ws + WS_WUP) + (size_t)l * FF * D, scr, r, 64, lane, CmId{}); continue; } r -= I_UP;
        if (r < I_DN) { transpose_item(A.w_down + (size_t)l * FF * D, D, FF, (bf16*)(ws + WS_WDN) + (size_t)l * D * FF, scr, r, 16, lane, CmId{}); continue; } r -= I_DN;
        const int s = r / I_W1; r %= I_W1;
        transpose_item(A.cmp_w1 + (size_t)(l * 2 + s) * 2048 * 256, 256, 2048, (bf16*)(ws + WS_W1) + (size_t)(l * 2 + s) * 256 * 2048, scr, r, 4, lane, CmId{});
    }
    for (int it = gw; it < DEPTH * DB * NPG * 2; it += NGW) {
        const int half = it & 1, pg = (it >> 1) & 15, seq = (it >> 5) & 127, l = it >> 12;
        const int phys = A.page_table[seq * NPG + pg];
        const float* src = A.cache_cmp + (((size_t)l * NPHYS + phys) * PAGE + half * 64) * 256 + 4 * lane;
        const int cc = 4 * lane, s = cc >> 7, g = (cc >> 6) & 1, d = cc & 63;
        bf16* dst = (bf16*)(ws + WS_XC) + ((size_t)((l * 2 + s) * 2 + g) * XCP + MP + seq * PAST + pg * PAGE + half * 64) * 64 + d;
#pragma unroll 16
        for (int sl = 0; sl < 64; ++sl) { const f32x4 v = *(const f32x4*)(src + (size_t)sl * 256); v2u w; w.x = pk2(v[0], v[1]); w.y = pk2(v[2], v[3]); *(v2u*)(dst + (size_t)sl * 64) = w; }
    }
    for (int it = gw; it < 8; it += NGW) {
        float* BT = (float*)(ws + WS_BT) + it * 132;
        for (int dd = lane; dd < 132; dd += 64) BT[dd] = dd <= 128 ? A.rel_bias[rel_bucket_dev(dd) * 8 + it] * 1.4426950408889634f : -INFINITY;
    }
    for (int it = gw; it < DEPTH * 2 * 4 * 16; it += NGW) {
        const int kp = it & 15, hq = (it >> 4) & 3, ls = it >> 6, h = hq * 64 + lane;
        const float* pe = A.cmp_pe + (size_t)ls * 2048 + kp * 128; const float* w1 = A.cmp_w1 + ((size_t)ls * 2048 + kp * 128) * 256 + h;
        float acc = 0.f;
#pragma unroll 16
        for (int k = 0; k < 128; ++k) acc += pe[k] * w1[(size_t)k * 256];
        ((float*)(ws + WS_B1))[2048 + (ls * 16 + kp) * 256 + h] = acc;
    }
    for (int it = gw; it < DEPTH * 2 * 64; it += NGW) {
        const int d = it & 63, ls = it >> 6;
        for (int h = lane; h < 256; h += 64) ((bf16*)(ws + WS_W2T))[((size_t)ls * 64 + d) * 256 + h] = (bf16)f2bf(A.cmp_w2[((size_t)ls * 256 + h) * 64 + d]);
    }
}

__device__ __forceinline__ void b1_reduce(CArgs& A, int tid) {
    for (int i = blockIdx.x * NTHR + tid; i < DEPTH * 2 * 256; i += gridDim.x * NTHR) { const float* p = (const float*)(A.ws + WS_B1) + 2048 + (i >> 8) * 16 * 256 + (i & 255);
        float acc = 0.f;
#pragma unroll
        for (int kp = 0; kp < 16; ++kp) acc += p[kp * 256];
        ((float*)(A.ws + WS_B1))[i] = acc; }
}
__device__ __forceinline__ void phase_ada(CArgs& A, LAS unsigned char* lds, int tid) {
    LAS float* a = (LAS float*)lds;
    for (int task = blockIdx.x; task < DEPTH * 12 * 10; task += gridDim.x) {
        const int rb = task % 10, cb = (task / 10) % 12, l = task / 120;
        __syncthreads();
        for (int i = tid; i < 13 * 1024; i += NTHR) { const int row = rb * 13 + i / 1024, k = i & 1023;
            const float c = row < BATCH ? A.c_prompt[row * D + k] : A.c_sample[(row - BATCH) * D + k]; a[i] = c / (1.f + __expf(-c)); }
        __syncthreads();
        const int j = cb * 512 + tid;
        const float* w = A.w_ada + (size_t)l * D * 6144 + j;
        float acc[13];
#pragma unroll
        for (int r = 0; r < 13; ++r) acc[r] = 0.f;
        for (int k = 0; k < D; k += 4) { const float w0 = w[(size_t)k * 6144], w1 = w[(size_t)(k + 1) * 6144], w2 = w[(size_t)(k + 2) * 6144], w3 = w[(size_t)(k + 3) * 6144];
#pragma unroll
            for (int r = 0; r < 13; ++r) { const f32x4 a4 = *(const LAS f32x4*)(a + r * 1024 + k); acc[r] += (a4[0] * w0 + a4[1] * w1) + (a4[2] * w2 + a4[3] * w3); } }
        const float bb = A.b_ada[l * 6144 + j];
        float* o = (float*)(A.ws + WS_ADA) + ((size_t)l * NCOND + rb * 13) * 6144 + j;
#pragma unroll
        for (int r = 0; r < 13; ++r) o[(size_t)r * 6144] = acc[r] + bb;
    }
}

__device__ __forceinline__ void mod_row(const float* xrow, const float* sh, const float* sc, bf16* urow, int lane) {
#pragma unroll
    for (int j = 0; j < 4; ++j) { const int c = 4 * lane + 256 * j;
        const f32x4 x = *(const f32x4*)(xrow + c), a = *(const f32x4*)(sh + c), b = *(const f32x4*)(sc + c);
        v2u w; w.x = pk2(x[0] * (1.f + b[0]) + a[0], x[1] * (1.f + b[1]) + a[1]); w.y = pk2(x[2] * (1.f + b[2]) + a[2], x[3] * (1.f + b[3]) + a[3]);
        *(v2u*)(urow + c) = w; }
}
__device__ __forceinline__ void ln_row(const bf16* zrow, const float* g, const float* b, float* xout, const float* sh, const float* sc, bf16* urow, int lane) {
    f32x4 v[4]; float s = 0.f;
#pragma unroll
    for (int j = 0; j < 4; ++j) { const v2u z = *(const v2u*)(zrow + 4 * lane + 256 * j); v[j][0] = bflo(z.x); v[j][1] = bfhi(z.x); v[j][2] = bflo(z.y); v[j][3] = bfhi(z.y); s += (v[j][0] + v[j][1]) + (v[j][2] + v[j][3]); }
    const float mean = wave_sum(s) * (1.f / D); float s2 = 0.f;
#pragma unroll
    for (int j = 0; j < 4; ++j) { v[j] = v[j] - mean; s2 += (v[j][0] * v[j][0] + v[j][1] * v[j][1]) + (v[j][2] * v[j][2] + v[j][3] * v[j][3]); }
    const float rstd = 1.f / sqrtf(wave_sum(s2) * (1.f / D) + LN_EPS);
#pragma unroll
    for (int j = 0; j < 4; ++j) { const int c = 4 * lane + 256 * j;
        const f32x4 gg = *(const f32x4*)(g + c), bb = *(const f32x4*)(b + c);
        const f32x4 x = v[j] * rstd * gg + bb;
        *(f32x4*)(xout + c) = x;
        if (urow) { const f32x4 a = *(const f32x4*)(sh + c), q = *(const f32x4*)(sc + c);
            v2u w; w.x = pk2(x[0] * (1.f + q[0]) + a[0], x[1] * (1.f + q[1]) + a[1]); w.y = pk2(x[2] * (1.f + q[2]) + a[2], x[3] * (1.f + q[3]) + a[3]);
            *(v2u*)(urow + c) = w; } }
}

__device__ __forceinline__ float scan_sum256(float v, LAS float* buf, int tid) {
    const int lane = tid & 63, w = tid >> 6;
#pragma unroll
    for (int o = 1; o < 64; o <<= 1) { const float y = __shfl_up(v, o); if (lane >= o) v += y; }
    __syncthreads();
    if (lane == 63) buf[w] = v;
    __syncthreads();
    float add = 0.f;
#pragma unroll
    for (int i = 0; i < 3; ++i) if (i < w) add += buf[i];
    return v + add;
}
__device__ __forceinline__ float scan_max256(float v, LAS float* buf, int tid) {
    const int lane = tid & 63, w = tid >> 6;
#pragma unroll
    for (int o = 1; o < 64; o <<= 1) { const float y = __shfl_up(v, o); if (lane >= o) v = fmaxf(v, y); }
    __syncthreads();
    if (lane == 63) buf[w] = v;
    __syncthreads();
#pragma unroll
    for (int i = 0; i < 3; ++i) if (i < w) v = fmaxf(v, buf[i]);
    return v;
}
__device__ __forceinline__ void ml_gates(CArgs& A, int l, int r, int h, float& ig, float& lf) {
    const float* G = (const float*)(A.ws + WS_GATE) + (size_t)r * 32;
    ig = G[h] + A.b_gate[l * 8 + h];
    const float fr = G[4 + h] + A.b_gate[l * 8 + 4 + h];
    lf = fminf(fr, 0.f) - log1pf(__expf(-fabsf(fr)));
}

__device__ __forceinline__ void phase_m2(CArgs& A, int l, LAS unsigned char* lds, int tid) {
    LAS float* buf = (LAS float*)lds;
    LAS float* wl = (LAS float*)(lds + 1024);
    const bf16* QKVO = (const bf16*)(A.ws + WS_QKVO);
    for (int unit = blockIdx.x; unit < NUNIT; unit += gridDim.x) {
        const int b = unit >> 7, h = (unit >> 5) & 3, c = unit & 31, r0 = b * SEQ + c * LCH;
        float ig = 0.f, lf = 0.f;
        if (tid < 256) ml_gates(A, l, r0 + tid, h, ig, lf);
        const float F = scan_sum256(lf, buf, tid);
        __syncthreads();
        if (tid == 255) buf[16] = F;
        __syncthreads();
        const float Fend = buf[16];
        const float gl = tid < 256 ? Fend - F + ig : -3.0e38f;
        float mw = wave_max(gl);
        if ((tid & 63) == 0) buf[20 + (tid >> 6)] = mw;
        __syncthreads();
        const float mloc = fmaxf(fmaxf(buf[20], buf[21]), fmaxf(buf[22], buf[23]));
        if (tid < 256) wl[tid] = __expf(gl - mloc);
        if (tid == 0) { float* ch = (float*)(A.ws + WS_CHS) + unit * 4; ch[0] = Fend; ch[1] = mloc; }
        __syncthreads();
        const int k = tid & 127, vq = tid >> 7;
        float acc[32]; float accn = 0.f;
#pragma unroll
        for (int i = 0; i < 32; ++i) acc[i] = 0.f;
        const bf16* kp = QKVO + (size_t)r0 * 2048 + 512 + h * HD + k;
        const bf16* vp = QKVO + (size_t)r0 * 2048 + 1024 + h * HD + 32 * vq;
        for (int s = 0; s < LCH; ++s) {
            const float wk = wl[s] * bf2f(kp[(size_t)s * 2048]);
            accn += wk;
            const v4u* v4 = (const v4u*)(vp + (size_t)s * 2048);
#pragma unroll
            for (int q = 0; q < 4; ++q) { const v4u vv = v4[q];
                acc[8 * q + 0] += wk * bflo(vv.x); acc[8 * q + 1] += wk * bfhi(vv.x); acc[8 * q + 2] += wk * bflo(vv.y); acc[8 * q + 3] += wk * bfhi(vv.y);
                acc[8 * q + 4] += wk * bflo(vv.z); acc[8 * q + 5] += wk * bfhi(vv.z); acc[8 * q + 6] += wk * bflo(vv.w); acc[8 * q + 7] += wk * bfhi(vv.w); }
        }
        float* dct = (float*)(A.ws + WS_DCT) + ((size_t)unit * HD + 32 * vq) * HD + k;
#pragma unroll
        for (int i = 0; i < 32; ++i) dct[(size_t)i * HD] = acc[i];
        if (vq == 0) ((float*)(A.ws + WS_DN))[unit * HD + k] = accn;
        __syncthreads();
    }
}

__device__ __forceinline__ void phase_m3(CArgs& A, int l, int tid) {
    for (int task = blockIdx.x; task < BATCH * NH * 33; task += gridDim.x) {
        const int bh = task / 33, part = task % 33;
        const bool isn = part == 32; if (isn && tid >= HD) continue;
        const int e = isn ? tid : part * 512 + tid;
        const float* chs = (const float*)(A.ws + WS_CHS) + (size_t)bh * NCH * 4;
        float st = 0.f, m0 = 0.f;
        for (int c = 0; c < NCH; ++c) {
            const int unit = bh * NCH + c;
            const float Fend = chs[c * 4], mloc = chs[c * 4 + 1];
            float dv;
            if (isn) { ((float*)(A.ws + WS_NPV))[unit * HD + e] = st; dv = ((const float*)(A.ws + WS_DN))[unit * HD + e]; if (tid == 0) ((float*)(A.ws + WS_CHS))[unit * 4 + 2] = m0; }
            else { ((bf16*)(A.ws + WS_CTP))[(size_t)unit * HD * HD + e] = (bf16)f2bf(st); dv = ((const float*)(A.ws + WS_DCT))[(size_t)unit * HD * HD + e]; }
            const float mend = fmaxf(m0 + Fend, mloc);
            st = __expf(m0 + Fend - mend) * st + __expf(mloc - mend) * dv;
            m0 = mend;
        }
        if (isn) { A.out[O_NP + ((size_t)l * BATCH * NH + bh) * HD + e] = st; if (tid == 0) A.out[O_MP + l * BATCH * NH + bh] = m0; }
        else { const int v = e >> 7, k = e & 127; A.out[O_CP + (((size_t)l * BATCH * NH + bh) * HD + k) * HD + v] = st; }
    }
}

__device__ __forceinline__ void phase_m4(CArgs& A, int l, LAS unsigned char* lds, int tid) {
    LAS float* buf = (LAS float*)lds;
    LAS float* sa = (LAS float*)(lds + 1024);
    LAS float* smx = sa + 256;
    LAS float* sdec = smx + 256;
    LAS float* sem = sdec + 256;
    LAS bf16* sv = (LAS bf16*)(lds + 8192);
    const bf16* QKVO = (const bf16*)(A.ws + WS_QKVO);
    const int lane = tid & 63, wave = tid >> 6;
    for (int unit = blockIdx.x; unit < NUNIT; unit += gridDim.x) {
        const int b = unit >> 7, h = (unit >> 5) & 3, c = unit & 31, r0 = b * SEQ + c * LCH;
        float ig = 0.f, lf = 0.f;
        if (tid < 256) ml_gates(A, l, r0 + tid, h, ig, lf);
        const float F = scan_sum256(lf, buf, tid);
        const float a = tid < 256 ? ig - F : -3.0e38f;
        const float cm = scan_max256(a, buf, tid);
        const float m0 = ((const float*)(A.ws + WS_CHS))[unit * 4 + 2];
        if (tid < 256) { const float mx = fmaxf(m0, cm); sa[tid] = a; smx[tid] = mx; sdec[tid] = __expf(m0 - mx); sem[tid] = __expf(-(F + mx)); }
        for (int i = tid; i < LCH * HD / 8; i += NTHR) { const int s = i >> 4, q = i & 15;
            *(LAS v4u*)(sv + s * HD + 8 * q) = *(const v4u*)(QKVO + (size_t)(r0 + s) * 2048 + 1024 + h * HD + 8 * q); }
        __syncthreads();
        float* W = (float*)(A.ws + WS_WSC) + (size_t)unit * LCH * LCH;
        for (int idx = tid; idx < LCH * LCH; idx += NTHR) {
            const int t = idx >> 8, s = idx & 255; float w = 0.f;
            if (s <= t) {
                const v4u* qp = (const v4u*)(QKVO + (size_t)(r0 + t) * 2048 + h * HD); const v4u* kp = (const v4u*)(QKVO + (size_t)(r0 + s) * 2048 + 512 + h * HD);
                float d = 0.f;
#pragma unroll 4
                for (int q = 0; q < 16; ++q) { const v4u x = qp[q], y = kp[q];
                    d += bflo(x.x) * bflo(y.x) + bfhi(x.x) * bfhi(y.x) + bflo(x.y) * bflo(y.y) + bfhi(x.y) * bfhi(y.y)
                       + bflo(x.z) * bflo(y.z) + bfhi(x.z) * bfhi(y.z) + bflo(x.w) * bflo(y.w) + bfhi(x.w) * bfhi(y.w); }
                w = d * __expf(sa[s] - smx[t]);
            }
            W[idx] = w;
        }
        __syncthreads();
        {
            const int v = tid & 127, tq = tid >> 7;
            const bf16* ctp = (const bf16*)(A.ws + WS_CTP) + ((size_t)unit * HD + v) * HD;
            const float* npv = (const float*)(A.ws + WS_NPV) + unit * HD;
            float* hraw = (float*)(A.ws + WS_HRAW) + (size_t)unit * LCH * HD;
            for (int i = 0; i < 64; ++i) {
                const int t = 4 * i + tq;
                float num = 0.f, den = 0.f;
                const float* wr = W + (size_t)t * LCH;
                for (int s = 0; s <= t; s += 4) { const f32x4 w4 = *(const f32x4*)(wr + s);
                    num += w4[0] * bf2f(sv[(s + 0) * HD + v]) + w4[1] * bf2f(sv[(s + 1) * HD + v]) + w4[2] * bf2f(sv[(s + 2) * HD + v]) + w4[3] * bf2f(sv[(s + 3) * HD + v]);
                    den += (w4[0] + w4[1]) + (w4[2] + w4[3]); }
                float qc = 0.f, qn = 0.f;
                const v4u* qp = (const v4u*)(QKVO + (size_t)(r0 + t) * 2048 + h * HD);
#pragma unroll 4
                for (int q = 0; q < 16; ++q) { const v4u x = qp[q], y = *(const v4u*)(ctp + 8 * q); const f32x4 n0 = *(const f32x4*)(npv + 8 * q), n1 = *(const f32x4*)(npv + 8 * q + 4);
                    qc += bflo(x.x) * bflo(y.x) + bfhi(x.x) * bfhi(y.x) + bflo(x.y) * bflo(y.y) + bfhi(x.y) * bfhi(y.y)
                        + bflo(x.z) * bflo(y.z) + bfhi(x.z) * bfhi(y.z) + bflo(x.w) * bflo(y.w) + bfhi(x.w) * bfhi(y.w);
                    qn += bflo(x.x) * n0[0] + bfhi(x.x) * n0[1] + bflo(x.y) * n0[2] + bfhi(x.y) * n0[3] + bflo(x.z) * n1[0] + bfhi(x.z) * n1[1] + bflo(x.w) * n1[2] + bfhi(x.w) * n1[3]; }
                const float dec = sdec[t];
                const float numt = num + dec * qc, dent = den + dec * qn;
                hraw[(size_t)t * HD + v] = numt / fmaxf(fabsf(dent), sem[t]);
            }
        }
        __syncthreads();
        {
            const float* hraw = (const float*)(A.ws + WS_HRAW) + (size_t)unit * LCH * HD;
            const float g0 = A.ml_norm_g[l * 512 + h * HD + lane], g1 = A.ml_norm_g[l * 512 + h * HD + 64 + lane];
            for (int t = wave; t < LCH; t += NWAVES) {
                const float x0 = hraw[(size_t)t * HD + lane], x1 = hraw[(size_t)t * HD + 64 + lane];
                const float mu = wave_sum(x0 + x1) * (1.f / HD);
                const float d0 = x0 - mu, d1 = x1 - mu;
                const float rstd = 1.f / sqrtf(wave_sum(d0 * d0 + d1 * d1) * (1.f / HD) + LN_EPS);
                const bf16* op = QKVO + (size_t)(r0 + t) * 2048 + 1536 + h * HD;
                bf16* mp = (bf16*)(A.ws + WS_MIX) + (size_t)(r0 + t) * D + h * HD;
                mp[lane] = (bf16)f2bf(d0 * rstd * g0 * sigmoidf_(bf2f(op[lane])));
                mp[64 + lane] = (bf16)f2bf(d1 * rstd * g1 * sigmoidf_(bf2f(op[64 + lane])));
            }
        }
        __syncthreads();
    }
}

__device__ __forceinline__ void phase_mls(CArgs& A, int l, LAS unsigned char* lds, int tid) {
    LAS float* sq = (LAS float*)lds;
    LAS float* sc = sq + 1536;
    LAS float* sw = sc + 64;
    LAS float* part = sw + 16;
    LAS float* red = part + 2048;
    const bf16* QKVO = (const bf16*)(A.ws + WS_QKVO);
    for (int task = blockIdx.x; task < DB * NH; task += gridDim.x) {
        const int seq = task >> 2, h = task & 3, r0 = MP + seq * DS, sidx = (l * DB + seq) * NH + h;
        __syncthreads();
        for (int i = tid; i < 1536; i += NTHR) { const int which = i >> 9, t = (i >> 7) & 3, d = i & 127; sq[i] = bf2f(QKVO[(size_t)(r0 + t) * 2048 + which * 512 + h * HD + d]); }
        const float m0 = A.st_m[sidx];
        if (tid == 0) {
            float F = 0.f, cmx = -3.0e38f, Fs[4], igs[4], mlast = 0.f;
#pragma unroll
            for (int t = 0; t < 4; ++t) { float ig, lf; ml_gates(A, l, r0 + t, h, ig, lf); F += lf; Fs[t] = F; igs[t] = ig; const float a = ig - F; cmx = fmaxf(cmx, a); const float mx = fmaxf(m0, cmx);
                sc[8 + t] = a; sc[12 + t] = mx; sc[16 + t] = __expf(m0 - mx); sc[20 + t] = __expf(-(F + mx)); mlast = F + mx; }
#pragma unroll
            for (int t = 0; t < 4; ++t) sc[24 + t] = __expf(Fs[3] - Fs[t] + igs[t] - mlast);
            sc[28] = __expf(Fs[3] + m0 - mlast); sc[29] = mlast;
        }
        __syncthreads();
        {
            const int lane = tid & 63, wv_ = tid >> 6;
            const float* n0 = A.st_n + (size_t)sidx * HD;
#pragma unroll
            for (int j = 0; j < 3; ++j) {
                const int p = wv_ * 3 + j;
                if (p < 20) {
                    const int t = p < 16 ? p >> 2 : p - 16, s = p & 3;
                    const float x0 = sq[t * HD + lane], x1 = sq[t * HD + 64 + lane];
                    const float y0 = p < 16 ? sq[512 + s * HD + lane] : n0[lane], y1 = p < 16 ? sq[512 + s * HD + 64 + lane] : n0[64 + lane];
                    const float d = wave_sum(x0 * y0 + x1 * y1);
                    if (lane == 0) { if (p < 16) sw[p] = s <= t ? d * __expf(sc[8 + s] - sc[12 + t]) : 0.f; else sc[32 + t] = d; }
                }
            }
        }
        __syncthreads();
        {
            const int v = tid & 127, kq = tid >> 7;
            const float* C0 = A.st_C + (size_t)sidx * HD * HD + (size_t)kq * 32 * HD + v; float* Co = A.out + O_CS + (size_t)sidx * HD * HD + (size_t)kq * 32 * HD + v;
            const float cd = sc[28];
            float wv[4]; float qc[4] = {0.f, 0.f, 0.f, 0.f};
#pragma unroll
            for (int t = 0; t < 4; ++t) wv[t] = sc[24 + t] * sq[1024 + t * HD + v];
#pragma unroll
            for (int k8 = 0; k8 < 32; k8 += 8) {
                float c0[8];
#pragma unroll
                for (int i = 0; i < 8; ++i) c0[i] = C0[(size_t)(k8 + i) * HD];
#pragma unroll
                for (int i = 0; i < 8; ++i) { const int k = kq * 32 + k8 + i; float cn = cd * c0[i];
#pragma unroll
                    for (int t = 0; t < 4; ++t) { qc[t] += sq[t * HD + k] * c0[i]; cn += wv[t] * sq[512 + t * HD + k]; }
                    Co[(size_t)(k8 + i) * HD] = cn; }
            }
#pragma unroll
            for (int t = 0; t < 4; ++t) part[(kq * 4 + t) * HD + v] = qc[t];
        }
        __syncthreads();
        float hv[4] = {0.f, 0.f, 0.f, 0.f};
        if (tid < HD) {
            const int v = tid;
#pragma unroll
            for (int t = 0; t < 4; ++t) { const float qct = part[(0 * 4 + t) * HD + v] + part[(1 * 4 + t) * HD + v] + part[(2 * 4 + t) * HD + v] + part[(3 * 4 + t) * HD + v];
                float num = sc[16 + t] * qct, den = sc[16 + t] * sc[32 + t];
#pragma unroll
                for (int s = 0; s < 4; ++s) { num += sw[t * 4 + s] * sq[1024 + s * HD + v]; den += sw[t * 4 + s]; }
                hv[t] = num / fmaxf(fabsf(den), sc[20 + t]); }
        }
#pragma unroll
        for (int t = 0; t < 4; ++t) { const float s1 = wave_sum(hv[t]); if ((tid & 63) == 0 && tid < HD) red[t * 2 + (tid >> 6)] = s1; }
        __syncthreads();
        float dv[4];
#pragma unroll
        for (int t = 0; t < 4; ++t) { dv[t] = hv[t] - (red[t * 2] + red[t * 2 + 1]) * (1.f / HD); const float s2 = wave_sum(dv[t] * dv[t]); if ((tid & 63) == 0 && tid < HD) red[8 + t * 2 + (tid >> 6)] = s2; }
        __syncthreads();
        if (tid < HD) {
            const int v = tid; const float gn = A.ml_norm_g[l * 512 + h * HD + v];
#pragma unroll
            for (int t = 0; t < 4; ++t) { const float rstd = 1.f / sqrtf((red[8 + t * 2] + red[8 + t * 2 + 1]) * (1.f / HD) + LN_EPS);
                const float og = bf2f(QKVO[(size_t)(r0 + t) * 2048 + 1536 + h * HD + v]);
                ((bf16*)(A.ws + WS_MIX))[(size_t)(r0 + t) * D + h * HD + v] = (bf16)f2bf(dv[t] * rstd * gn * sigmoidf_(og)); }
        } else if (tid < 2 * HD) {
            const int k = tid - HD; float nn = sc[28] * A.st_n[(size_t)sidx * HD + k];
#pragma unroll
            for (int t = 0; t < 4; ++t) nn += sc[24 + t] * sq[512 + t * HD + k];
            A.out[O_NS + (size_t)sidx * HD + k] = nn;
        }
        if (tid == 0) A.out[O_MS + sidx] = sc[29];
    }
}

typedef short bf16x8c __attribute__((ext_vector_type(8)));
template <bool FROMY>
__device__ __forceinline__ void phase_cmp2(CArgs& A, int l0, int nl, int r_lo, int nrows, int gw, int NGW, int lane) {
    const int fr = lane & 15, fq = lane >> 4, ntile = nrows / 16;
    for (int task = gw; task < nl * 4 * ntile; task += NGW) {
        const int img = task / ntile, tr = task % ntile, l = l0 + (img >> 2), sg = img & 3, s = sg >> 1, g = sg & 1, R0 = r_lo + tr * 16;
        const bf16* hp = (const bf16*)(A.ws + WS_HID) + ((size_t)(l * 4 + sg) * NCB + R0 + fr) * 256 + 8 * fq;
        const bf16* wp = (const bf16*)(A.ws + WS_W2T) + ((size_t)(l * 2 + s) * 64 + fr) * 256 + 8 * fq;
        f32x4 acc[4];
#pragma unroll
        for (int dt = 0; dt < 4; ++dt) acc[dt] = (f32x4){0.f, 0.f, 0.f, 0.f};
#pragma unroll
        for (int ks = 0; ks < 8; ++ks) {
            bf16x8c hf;
            if (FROMY) {
                const bf16* yp = (const bf16*)(A.ws + WS_HID) + ((size_t)(l * 4 + sg) * NCB + R0 + fr) * 512 + 32 * ks + 8 * fq;
                const v4u yt = *(const v4u*)yp, yb = *(const v4u*)(yp + 512 + 256);
                const float* bp = (const float*)(A.ws + WS_B1) + (l * 2 + s) * 256 + 32 * ks + 8 * fq;
                const f32x4 b0 = *(const f32x4*)bp, b1 = *(const f32x4*)(bp + 4);
                v4u hw;
                hw.x = pk2(gelu_tanh(bflo(yt.x) + bflo(yb.x) + b0[0]), gelu_tanh(bfhi(yt.x) + bfhi(yb.x) + b0[1])); hw.y = pk2(gelu_tanh(bflo(yt.y) + bflo(yb.y) + b0[2]), gelu_tanh(bfhi(yt.y) + bfhi(yb.y) + b0[3]));
                hw.z = pk2(gelu_tanh(bflo(yt.z) + bflo(yb.z) + b1[0]), gelu_tanh(bfhi(yt.z) + bfhi(yb.z) + b1[1])); hw.w = pk2(gelu_tanh(bflo(yt.w) + bflo(yb.w) + b1[2]), gelu_tanh(bfhi(yt.w) + bfhi(yb.w) + b1[3]));
                hf = __builtin_bit_cast(bf16x8c, hw);
            } else hf = *(const bf16x8c*)(hp + 32 * ks);
#pragma unroll
            for (int dt = 0; dt < 4; ++dt) { const bf16x8c wf = *(const bf16x8c*)(wp + (size_t)dt * 16 * 256 + 32 * ks);
                acc[dt] = s == 0 ? __builtin_amdgcn_mfma_f32_16x16x32_bf16(wf, hf, acc[dt], 0, 0, 0) : __builtin_amdgcn_mfma_f32_16x16x32_bf16(hf, wf, acc[dt], 0, 0, 0); }
        }
        if (s == 0) {
            bf16* o = (bf16*)(A.ws + WS_KC) + ((size_t)(l * 2 + g) * NCB + R0 + fr) * 64 + 4 * fq;
#pragma unroll
            for (int dt = 0; dt < 4; ++dt) { v2u w; w.x = pk2(acc[dt][0], acc[dt][1]); w.y = pk2(acc[dt][2], acc[dt][3]); *(v2u*)(o + 16 * dt) = w; }
        } else {
            bf16* o = (bf16*)(A.ws + WS_VCT) + (size_t)(l * 2 + g) * 64 * NCB + (size_t)(R0 >> 6) * 4096 + fr * 64 + (R0 & 63) + 4 * fq;
#pragma unroll
            for (int dt = 0; dt < 4; ++dt) { v2u w; w.x = pk2(acc[dt][0], acc[dt][1]); w.y = pk2(acc[dt][2], acc[dt][3]); *(v2u*)(o + dt * 16 * 64) = w; }
        }
    }
}

__device__ __forceinline__ void topk_sel(float imp0, float imp1, int cur, int lane, unsigned long long& s0, unsigned long long& s1) {
    const int nforced = cur == 0 ? 1 : (cur == 1 ? 2 : 3), need = 16 - nforced, ncand = cur - 2 > 0 ? cur - 2 : 0;
    const unsigned k0 = (lane >= 1 && lane <= cur - 2) ? __builtin_bit_cast(unsigned, imp0) + 1u : 0u;
    const unsigned k1 = (lane + 64 <= cur - 2) ? __builtin_bit_cast(unsigned, imp1) + 1u : 0u;
    unsigned long long c0, c1;
    if (ncand <= need) { c0 = __ballot(k0 != 0u); c1 = __ballot(k1 != 0u); }
    else {
        unsigned T = 0u;
        for (int bit = 31; bit >= 0; --bit) { const unsigned cand = T | (1u << bit);
            const int cnt = __popcll(__ballot(k0 >= cand)) + __popcll(__ballot(k1 >= cand)); if (cnt >= need) T = cand; }
        const unsigned long long g0 = __ballot(k0 > T), g1 = __ballot(k1 > T); unsigned long long e0 = __ballot(k0 == T), e1 = __ballot(k1 == T);
        int rem = need - __popcll(g0) - __popcll(g1);
        unsigned long long t0 = 0ull, t1 = 0ull;
        while (rem > 0 && e0) { const unsigned long long lb = e0 & (~e0 + 1ull); t0 |= lb; e0 ^= lb; --rem; }
        while (rem > 0 && e1) { const unsigned long long lb = e1 & (~e1 + 1ull); t1 |= lb; e1 ^= lb; --rem; }
        c0 = g0 | t0; c1 = g1 | t1;
    }
    unsigned long long f0 = 1ull, f1 = 0ull;
    if (cur < 64) f0 |= 1ull << cur; else f1 |= 1ull << (cur - 64);
    if (cur >= 1) { if (cur - 1 < 64) f0 |= 1ull << (cur - 1); else f1 |= 1ull << (cur - 65); }
    s0 = c0 | f0; s1 = c1 | f1;
}


typedef short bf16x8 __attribute__((ext_vector_type(8)));
#define MFMA16(a, b, c) __builtin_amdgcn_mfma_f32_16x16x32_bf16((a), (b), (c), 0, 0, 0)
constexpr int TOTS = MP + DB * 2112, WSTR = 576, TOTW = MP + DB * WSTR, TOTWP = TOTW + 64;
constexpr size_t KS_L = (size_t)2 * TOTS * 64, KW_L = (size_t)2 * TOTWP * 64, KC_L = (size_t)2 * NCB * 64;

template <int NP>
__device__ __forceinline__ void kv_tile(const float* src, bf16* Kimg, size_t kgs, bf16* Vt, size_t vgs, size_t vpitch, size_t gp0, LAS bf16* scr, int lane, float* cdst = nullptr, int cskip = 0) {
    const int cc = 4 * lane, s = cc >> 7, g = (cc >> 6) & 1, d = cc & 63;
#pragma unroll 16
    for (int sl = 0; sl < NP; ++sl) {
        const f32x4 v = *(const f32x4*)(src + (size_t)sl * 256 + cc);
        if (cdst && sl >= cskip) *(f32x4*)(cdst + (size_t)sl * 256 + cc) = v;
        v2u w; w.x = pk2(v[0], v[1]); w.y = pk2(v[2], v[3]);
        if (s == 0) *(v2u*)(Kimg + (size_t)g * kgs + (gp0 + sl) * 64 + d) = w;
        else *(LAS v2u*)(scr + sl * 128 + (cc - 128)) = w;
    }
    LDS_WAIT();
#pragma unroll
    for (int g2 = 0; g2 < 2; ++g2) {
        const int gd = lane + 64 * g2;
        bf16* dst = Vt + (size_t)g2 * vgs + (gp0 >> 6) * 4096 + (size_t)lane * 64 + (gp0 & 63);
#pragma unroll
        for (int oc = 0; oc < NP / 8; ++oc) {
            const LAS bf16* p = scr + (8 * oc) * 128 + gd;
            v4u o; o.x = (unsigned)p[0] | ((unsigned)p[128] << 16); o.y = (unsigned)p[256] | ((unsigned)p[384] << 16); o.z = (unsigned)p[512] | ((unsigned)p[640] << 16); o.w = (unsigned)p[768] | ((unsigned)p[896] << 16);
            *(v4u*)(dst + 8 * oc) = o;
        }
    }
    LDS_WAIT();
}
#define kv_tile64 kv_tile<64>

__device__ __forceinline__ void prep_cache_images(CArgs& A, LAS unsigned char* lds, int gw, int NGW, int lane, int wave) {
    LAS bf16* scr = (LAS bf16*)(lds + wave * 16384);
    bf16* KS = (bf16*)(A.ws + WS_KS); bf16* VTS = (bf16*)(A.ws + WS_VTS); bf16* KW = (bf16*)(A.ws + WS_KW); bf16* VTW = (bf16*)(A.ws + WS_VTW);
    for (int it = gw; it < DEPTH * DB * 32; it += NGW) {
        const int ti = it & 31, seq = (it >> 5) & 127, l = it >> 12;
        const int phys = A.page_table[seq * NPG + (ti >> 1)];
        const float* src = A.cache_slc + (((size_t)l * NPHYS + phys) * PAGE + (ti & 1) * 64) * 256;
        kv_tile64(src, KS + l * KS_L, (size_t)TOTS * 64, VTS + l * KS_L, (size_t)64 * TOTS, TOTS, (size_t)MP + seq * 2112 + ti * 64, scr, lane);
    }
    for (int it = gw; it < DEPTH * DB * 8; it += NGW) {
        const int ti = it & 7, ls = it >> 3, seq = ls & 127, l = ls >> 7;
        const float* src = A.cache_win + ((size_t)ls * 512 + ti * 64) * 256;
        kv_tile64(src, KW + l * KW_L, (size_t)TOTWP * 64, VTW + l * KW_L, (size_t)64 * TOTWP, TOTWP, (size_t)MP + seq * WSTR + ti * 64, scr, lane,
                  A.out + O_WINS + ((size_t)ls * 512 + ti * 64) * 256 - 4 * 256, ti == 0 ? 4 : 0);
    }
}
__device__ __forceinline__ void prep_layer_images(CArgs& A, int l, LAS unsigned char* lds, int gw, int NGW, int lane, int wave) {
    LAS bf16* scr = (LAS bf16*)(lds + wave * 16384);
    bf16* KS = (bf16*)(A.ws + WS_KS) + l * KS_L; bf16* VTS = (bf16*)(A.ws + WS_VTS) + l * KS_L; bf16* KW = (bf16*)(A.ws + WS_KW) + l * KW_L; bf16* VTW = (bf16*)(A.ws + WS_VTW) + l * KW_L;
    const float* KVR = (const float*)(A.ws + WS_KVR);
    for (int it = gw; it < 2 * (MP / 16); it += NGW) {
        const int kind = it / (MP / 16), ti = it % (MP / 16);
        const float* src = KVR + ((size_t)(1 + kind) * M + ti * 16) * 256;
        if (kind == 0) kv_tile<16>(src, KS, (size_t)TOTS * 64, VTS, (size_t)64 * TOTS, TOTS, (size_t)ti * 16, scr, lane);
        else           kv_tile<16>(src, KW, (size_t)TOTWP * 64, VTW, (size_t)64 * TOTWP, TOTWP, (size_t)ti * 16, scr, lane);
    }
    for (int it = gw; it < 2 * DB; it += NGW) {
        const int kind = it / DB, seq = it % DB;
        const float* src = KVR + ((size_t)(1 + kind) * M + MP + seq * DS) * 256;
        bf16* Kimg = kind == 0 ? KS : KW; bf16* Vt = kind == 0 ? VTS : VTW;
        const size_t tot = kind == 0 ? TOTS : TOTWP, gp0 = kind == 0 ? (size_t)MP + seq * 2112 + PAST : (size_t)MP + seq * WSTR + 512;
        const int cc = 4 * lane, s = cc >> 7, g = (cc >> 6) & 1, d = cc & 63;
#pragma unroll
        for (int t = 0; t < DS; ++t) {
            const f32x4 v = *(const f32x4*)(src + (size_t)t * 256 + cc);
            if (s == 0) { v2u w; w.x = pk2(v[0], v[1]); w.y = pk2(v[2], v[3]); *(v2u*)(Kimg + (size_t)g * tot * 64 + (gp0 + t) * 64 + d) = w; }
            else {
#pragma unroll
                for (int i = 0; i < 4; ++i) Vt[(size_t)g * 64 * tot + ((gp0 + t) >> 6) * 4096 + (size_t)(d + i) * 64 + ((gp0 + t) & 63)] = (bf16)f2bf(v[i]);
            }
        }
    }
}

struct KV { bf16x8 k[8]; v4u v[8]; };
__device__ __forceinline__ void k_load(KV& f, const bf16* Kb, int fr, int fq) {
#pragma unroll
    for (int t = 0; t < 4; ++t) { f.k[2 * t] = *(const bf16x8*)(Kb + (size_t)(16 * t + fr) * 64 + 8 * fq); f.k[2 * t + 1] = *(const bf16x8*)(Kb + (size_t)(16 * t + fr) * 64 + 32 + 8 * fq); }
}
__device__ __forceinline__ void v_load(KV& f, const bf16* Vb, size_t pitch, int fr, int fq) {
#pragma unroll
    for (int h = 0; h < 2; ++h)
#pragma unroll
        for (int dt = 0; dt < 4; ++dt) { const bf16* vp = Vb + (size_t)(16 * dt + fr) * pitch + 32 * h + 4 * fq;
            const v2u a = *(const v2u*)vp, b = *(const v2u*)(vp + 16); v4u w; w.x = a.x; w.y = a.y; w.z = b.x; w.w = b.y; f.v[4 * h + dt] = w; }
}
__device__ __forceinline__ void qk_frag(const KV& f, const bf16x8 (&q)[2], f32x4 (&st)[4]) {
#pragma unroll
    for (int t = 0; t < 4; ++t) { f32x4 z = {0.f, 0.f, 0.f, 0.f}; z = MFMA16(f.k[2 * t], q[0], z); st[t] = MFMA16(f.k[2 * t + 1], q[1], z); }
}
__device__ __forceinline__ void pv_frag(const KV& f, const f32x4 (&st)[4], f32x4 (&o)[4]) {
#pragma unroll
    for (int h = 0; h < 2; ++h) {
        v4u pw; pw.x = pk2(st[2 * h][0], st[2 * h][1]); pw.y = pk2(st[2 * h][2], st[2 * h][3]); pw.z = pk2(st[2 * h + 1][0], st[2 * h + 1][1]); pw.w = pk2(st[2 * h + 1][2], st[2 * h + 1][3]);
        const bf16x8 pf = __builtin_bit_cast(bf16x8, pw);
#pragma unroll
        for (int dt = 0; dt < 4; ++dt) o[dt] = MFMA16(__builtin_bit_cast(bf16x8, f.v[4 * h + dt]), pf, o[dt]);
    }
}
__device__ __forceinline__ float xfq_max(float v) { v = fmaxf(v, __shfl_xor(v, 16)); return fmaxf(v, __shfl_xor(v, 32)); }
__device__ __forceinline__ float xfq_sum(float v) { v += __shfl_xor(v, 16); return v + __shfl_xor(v, 32); }
__device__ __forceinline__ float quad_sum(float v) { v += __shfl_xor(v, 1); return v + __shfl_xor(v, 2); }

__device__ __forceinline__ void softmax_pv(const KV& f, f32x4 (&st)[4], f32x4 (&o)[4], float& m, float& ls) {
    float bm = -INFINITY;
#pragma unroll
    for (int t = 0; t < 4; ++t) bm = fmaxf(bm, fmaxf(fmaxf(st[t][0], st[t][1]), fmaxf(st[t][2], st[t][3])));
    bm = xfq_max(bm);
    const float mn = fmaxf(m, bm), sc = __builtin_amdgcn_exp2f(m - mn);
    m = mn; ls *= sc;
#pragma unroll
    for (int dt = 0; dt < 4; ++dt) o[dt] = o[dt] * sc;
#pragma unroll
    for (int t = 0; t < 4; ++t)
#pragma unroll
        for (int i = 0; i < 4; ++i) { const float p = __builtin_amdgcn_exp2f(st[t][i] - mn); st[t][i] = p; ls += p; }
    pv_frag(f, st, o);
}
template <class Br>
__device__ __forceinline__ void run_branch(Br& br, const bf16x8 (&q)[2], int fr, int fq, f32x4 (&o)[4], float& m, float& ls) {
    int j;
    if (!br.first(j)) return;
    KV cur; k_load(cur, br.kp(j), fr, fq); v_load(cur, br.vp(j), br.pitch, fr, fq);
    for (;;) {
        int jn = 0; const bool hn = br.next(jn);
        KV nxt;
        if (hn) { k_load(nxt, br.kp(jn), fr, fq); v_load(nxt, br.vp(jn), br.pitch, fr, fq); }
        f32x4 st[4]; qk_frag(cur, q, st);
        br.mask(st, j);
        softmax_pv(cur, st, o, m, ls);
        if (!hn) break;
        cur = nxt; j = jn;
    }
}
struct BrSel {
    const bf16* K; const bf16* V; size_t pitch; unsigned long long u0, u1, my0, my1; int cur, qpos, fq; const LAS float* bt; float farb;
    __device__ __forceinline__ bool pop(int& j) { if (u0) { j = __builtin_ctzll(u0); u0 &= u0 - 1ull; return true; } if (u1) { j = 64 + __builtin_ctzll(u1); u1 &= u1 - 1ull; return true; } return false; }
    __device__ __forceinline__ bool first(int& j) { return pop(j); }
    __device__ __forceinline__ bool next(int& j) { return pop(j); }
    __device__ __forceinline__ const bf16* kp(int j) const { return K + (size_t)j * 64 * 64; }
    __device__ __forceinline__ const bf16* vp(int j) const { return V + (size_t)j * 4096; }
    __device__ __forceinline__ void mask(f32x4 (&st)[4], int j) const {
        const bool mine = j < 64 ? ((my0 >> j) & 1ull) != 0ull : ((my1 >> (j - 64)) & 1ull) != 0ull;
        if (j >= cur - 2) {
#pragma unroll
            for (int t = 0; t < 4; ++t)
#pragma unroll
                for (int i = 0; i < 4; ++i) { const int dist = qpos - (64 * j + 16 * t + 4 * fq + i); st[t][i] = st[t][i] + bt[(!mine || dist < 0) ? 129 : (dist > 128 ? 128 : dist)]; }
        } else {
#pragma unroll
            for (int t = 0; t < 4; ++t)
#pragma unroll
                for (int i = 0; i < 4; ++i) st[t][i] = mine ? st[t][i] + farb : -INFINITY;
        }
    }
};
struct BrWin {
    const bf16* K; const bf16* V; size_t pitch; int jb, cur, qpos, fq; const LAS float* bt;
    __device__ __forceinline__ bool first(int& j) { j = jb; return jb <= cur; }
    __device__ __forceinline__ bool next(int& j) { ++jb; j = jb; return jb <= cur; }
    __device__ __forceinline__ const bf16* kp(int j) const { return K + (long)j * 64 * 64; }
    __device__ __forceinline__ const bf16* vp(int j) const { return V + (long)j * 4096; }
    __device__ __forceinline__ void mask(f32x4 (&st)[4], int j) const {
#pragma unroll
        for (int t = 0; t < 4; ++t)
#pragma unroll
            for (int i = 0; i < 4; ++i) { const int dist = qpos - (64 * j + 16 * t + 4 * fq + i); st[t][i] = st[t][i] + bt[(unsigned)dist >= 512u ? 129 : (dist > 128 ? 128 : dist)]; }
    }
};

__device__ __forceinline__ void nsa_tile(CArgs& A, int l, bool smp, int bs, int g, int tq, LAS float* wl, const LAS float* BT, int lane) {
    asm volatile("" : "+v"(lane));
    const int fr = lane & 15, fq = lane >> 4, tl = fr >> 2, rr = fr & 3;
    const int qpos0 = smp ? PAST : 4 * tq, row0 = smp ? MP + bs * DS : bs * SEQ + qpos0;
    const int qpos = qpos0 + tl, cur = qpos0 >> 6, h = g * 4 + rr;
    const size_t sbase = smp ? (size_t)MP + bs * 2112 : (size_t)bs * SEQ;
    const long wbase = smp ? (long)MP + bs * WSTR - (PAST - 512) : (long)bs * SEQ;
    const size_t cbase = smp ? (size_t)1024 + bs * 128 : (size_t)bs * 512;
    const bf16* KS = (const bf16*)(A.ws + WS_KS) + l * KS_L + (size_t)g * TOTS * 64; const bf16* VTS = (const bf16*)(A.ws + WS_VTS) + l * KS_L + (size_t)g * 64 * TOTS;
    const bf16* KW = (const bf16*)(A.ws + WS_KW) + l * KW_L + (size_t)g * TOTWP * 64; const bf16* VTW = (const bf16*)(A.ws + WS_VTW) + l * KW_L + (size_t)g * 64 * TOTWP;
    const bf16* KC = (const bf16*)(A.ws + WS_KC) + l * KC_L + (size_t)g * NCB * 64 + cbase * 64; const bf16* VCT = (const bf16*)(A.ws + WS_VCT) + l * KC_L + (size_t)g * 64 * NCB + (cbase >> 6) * 4096;
    const LAS float* bt = BT + h * 132;
    const float farb = bt[128];
    bf16x8 q[2];
    {   const bf16* qp = (const bf16*)(A.ws + WS_NQ) + (size_t)(row0 + tl) * 512 + g * 256 + rr * 64 + 8 * fq;
        q[0] = *(const bf16x8*)qp; q[1] = *(const bf16x8*)(qp + 32); }
    const float* gt = (const float*)(A.ws + WS_GATE) + (size_t)(row0 + tl) * 32 + 8 + h * 3;
    const float gc = sigmoidf_(gt[0]), gs = sigmoidf_(gt[1]), gwn = sigmoidf_(gt[2]);
    f32x4 out[4];
#pragma unroll
    for (int dt = 0; dt < 4; ++dt) out[dt] = (f32x4){0.f, 0.f, 0.f, 0.f};
    LAS float* impA = wl;
    LAS float* impB = wl + 544;
    for (int i = lane; i < 1088; i += 64) wl[i] = 0.f;
    LDS_WAIT();

    {
        const int ncv_max = qpos0 + 3 >= 31 ? ((qpos0 + 3 - 31) >> 4) + 1 : 0, nb64 = (ncv_max + 63) >> 6;
        float m = -1.0e30f, ls = 0.f;
        {
            for (int ib = 0; ib < nb64; ++ib) {
                KV cur; k_load(cur, KC + (size_t)ib * 64 * 64, fr, fq);
                f32x4 st[4]; qk_frag(cur, q, st);
                float bm = -INFINITY;
#pragma unroll
                for (int t = 0; t < 4; ++t)
#pragma unroll
                    for (int i = 0; i < 4; ++i) { const int n = 64 * ib + 16 * t + 4 * fq + i; const int dist = qpos - 16 * n - 31;
                        const float s = st[t][i] + bt[dist < 0 ? 129 : (dist > 128 ? 128 : dist)]; st[t][i] = s; bm = fmaxf(bm, s); }
                bm = xfq_max(bm);
                const float mn = fmaxf(m, bm); ls *= __builtin_amdgcn_exp2f(m - mn); m = mn;
#pragma unroll
                for (int t = 0; t < 4; ++t)
#pragma unroll
                    for (int i = 0; i < 4; ++i) ls += __builtin_amdgcn_exp2f(st[t][i] - mn);
            }
        }
        ls = xfq_sum(ls);
        const float inv = ls > 0.f ? 1.f / ls : 0.f;
        f32x4 o[4];
#pragma unroll
        for (int dt = 0; dt < 4; ++dt) o[dt] = (f32x4){0.f, 0.f, 0.f, 0.f};
        {
            for (int ib = 0; ib < nb64; ++ib) {
                KV cur; k_load(cur, KC + (size_t)ib * 64 * 64, fr, fq); v_load(cur, VCT + (size_t)ib * 4096, 64, fr, fq);
                f32x4 st[4]; qk_frag(cur, q, st);
#pragma unroll
                for (int t = 0; t < 4; ++t) {
#pragma unroll
                    for (int i = 0; i < 4; ++i) { const int n = 64 * ib + 16 * t + 4 * fq + i; const int dist = qpos - 16 * n - 31;
                        st[t][i] = __builtin_amdgcn_exp2f(st[t][i] + bt[dist < 0 ? 129 : (dist > 128 ? 128 : dist)] - m) * inv; }
                    const float s4 = quad_sum((st[t][0] + st[t][1]) + (st[t][2] + st[t][3])), s3 = quad_sum(st[t][3]);
                    const int j0 = 16 * ib + 4 * t + fq;
                    if (rr == 0) { impA[tl * 136 + j0] = s4; impB[tl * 136 + j0 + 1] = s3; }
                }
                pv_frag(cur, st, o);
            }
        }
#pragma unroll
        for (int dt = 0; dt < 4; ++dt) out[dt] = out[dt] + o[dt] * gc;
    }
    LDS_WAIT();
    unsigned long long s0[4], s1[4];
#pragma unroll
    for (int t = 0; t < 4; ++t) topk_sel(impA[t * 136 + lane] + impB[t * 136 + lane], impA[t * 136 + 64 + lane] + impB[t * 136 + 64 + lane], cur, lane, s0[t], s1[t]);
    {
        float m = -1.0e30f, ls = 0.f; f32x4 o[4];
#pragma unroll
        for (int dt = 0; dt < 4; ++dt) o[dt] = (f32x4){0.f, 0.f, 0.f, 0.f};
        BrSel br{KS + sbase * 64, VTS + (sbase >> 6) * 4096, (size_t)64, (s0[0] | s0[1]) | (s0[2] | s0[3]), (s1[0] | s1[1]) | (s1[2] | s1[3]),
                 tl == 0 ? s0[0] : (tl == 1 ? s0[1] : (tl == 2 ? s0[2] : s0[3])), tl == 0 ? s1[0] : (tl == 1 ? s1[1] : (tl == 2 ? s1[2] : s1[3])), cur, qpos, fq, bt, farb};
        run_branch(br, q, fr, fq, o, m, ls);
        ls = xfq_sum(ls);
        const float w = ls > 0.f ? gs / ls : 0.f;
#pragma unroll
        for (int dt = 0; dt < 4; ++dt) out[dt] = out[dt] + o[dt] * w;
    }
    {
        float m = -1.0e30f, ls = 0.f; f32x4 o[4];
#pragma unroll
        for (int dt = 0; dt < 4; ++dt) o[dt] = (f32x4){0.f, 0.f, 0.f, 0.f};
        const int lo_blk = smp ? (PAST - 512) >> 6 : 0; int jb = (qpos0 - 511) >> 6; if (jb < lo_blk) jb = lo_blk;
        BrWin br{KW + wbase * 64, VTW + (wbase >> 6) * 4096, (size_t)64, jb, cur, qpos, fq, bt};
        run_branch(br, q, fr, fq, o, m, ls);
        ls = xfq_sum(ls);
        const float w = ls > 0.f ? gwn / ls : 0.f;
#pragma unroll
        for (int dt = 0; dt < 4; ++dt) out[dt] = out[dt] + o[dt] * w;
    }
    bf16* mp = (bf16*)(A.ws + WS_MIX) + (size_t)(row0 + tl) * D + 512 + h * 64 + 4 * fq;
#pragma unroll
    for (int dt = 0; dt < 4; ++dt) { v2u w; w.x = pk2(out[dt][0], out[dt][1]); w.y = pk2(out[dt][2], out[dt][3]); *(v2u*)(mp + 16 * dt) = w; }
}
__device__ __forceinline__ void phase_nsa(CArgs& A, int l, LAS float* wl, const LAS float* BT, int lane, int wave) {
    const int G = gridDim.x, bx = blockIdx.x;
    const bool xmap = (G & 7) == 0;
    const int x = bx & 7, nw = (G >> 3) * NWAVES, ww = (bx >> 3) * NWAVES + wave;
    const int gwv = bx * NWAVES + wave, ngw = G * NWAVES;
    for (int it = 0;; ++it) {
        bool smp; int bs, g, tq;
        if (xmap) {
            const int np = ww < 512 ? 2 * ((512 - ww + nw - 1) / nw) : 0;
            if (it < np) { const int i = ww + nw * (it >> 1), tq2 = (it & 1) ? 1023 - i : i; smp = false; bs = x >> 2; g = (x >> 1) & 1; tq = 2 * tq2 + (x & 1); }
            else { const int t = ww * 8 + x + 8 * nw * (it - np); if (t >= 2 * DB) break; smp = true; bs = t >> 1; g = t & 1; tq = 0; }
        } else {
            const int t = gwv + ngw * it; if (t >= 4 * 2048 + 2 * DB) break;
            if (t < 4 * 2048) { smp = false; bs = t >> 12; g = (t >> 11) & 1; tq = t & 2047; } else { smp = true; bs = (t - 4 * 2048) >> 1; g = t & 1; tq = 0; }
        }
        nsa_tile(A, l, smp, bs, g, tq, wl, BT, lane);
    }
}

__device__ __forceinline__ void phase_m2x(CArgs& A, int l, LAS unsigned char* lds, int tid) {
    LAS float* buf = (LAS float*)lds;
    LAS float* wl = (LAS float*)(lds + 1024);
    LAS float* red = (LAS float*)(lds + 2048);
    LAS bf16* kt = (LAS bf16*)(lds + 8192);
    LAS bf16* vt = (LAS bf16*)(lds + 8192 + 34816);
    const bf16* QKVO = (const bf16*)(A.ws + WS_QKVO);
    const int lane = tid & 63, wave = tid >> 6, fr = lane & 15, fq = lane >> 4;
    for (int unit = blockIdx.x; unit < NUNIT; unit += gridDim.x) {
        const int b = unit >> 7, h = (unit >> 5) & 3, c = unit & 31, r0 = b * SEQ + c * LCH;
        float ig = 0.f, lf = 0.f;
        if (tid < 256) ml_gates(A, l, r0 + tid, h, ig, lf);
        const float F = scan_sum256(lf, buf, tid);
        __syncthreads();
        if (tid == 255) buf[16] = F;
        __syncthreads();
        const float Fend = buf[16];
        const float gl = tid < 256 ? Fend - F + ig : -3.0e38f;
        const float mw = wave_max(gl);
        if (lane == 0) buf[20 + wave] = mw;
        __syncthreads();
        const float mloc = fmaxf(fmaxf(buf[20], buf[21]), fmaxf(buf[22], buf[23]));
        if (tid < 256) wl[tid] = __expf(gl - mloc);
        if (tid == 0) { float* ch = (float*)(A.ws + WS_CHS) + unit * 4; ch[0] = Fend; ch[1] = mloc; }
        f32x4 acc[8];
#pragma unroll
        for (int kt_ = 0; kt_ < 8; ++kt_) acc[kt_] = (f32x4){0.f, 0.f, 0.f, 0.f};
        float dnp = 0.f;
        for (int half = 0; half < 2; ++half) {
            __syncthreads();
            for (int i = tid; i < 4096; i += NTHR) { const int which = i >> 11, oc = (i >> 7) & 15, s = i & 127;
                const v4u x = *(const v4u*)(QKVO + (size_t)(r0 + 128 * half + s) * 2048 + (which ? 1024 : 512) + h * HD + 8 * oc);
                LAS bf16* dst = (which ? vt : kt) + (8 * oc) * 136 + s;
                dst[0] = (bf16)x.x; dst[136] = (bf16)(x.x >> 16); dst[272] = (bf16)x.y; dst[408] = (bf16)(x.y >> 16); dst[544] = (bf16)x.z; dst[680] = (bf16)(x.z >> 16); dst[816] = (bf16)x.w; dst[952] = (bf16)(x.w >> 16); }
            __syncthreads();
#pragma unroll
            for (int ks = 0; ks < 4; ++ks) {
                const int s0 = 32 * ks + 8 * fq;
                const v4u xv = *(const LAS v4u*)(vt + (16 * wave + fr) * 136 + s0);
                const f32x4 w0 = *(const LAS f32x4*)(wl + 128 * half + s0), w1 = *(const LAS f32x4*)(wl + 128 * half + s0 + 4);
                v4u av; av.x = pk2(bflo(xv.x) * w0[0], bfhi(xv.x) * w0[1]); av.y = pk2(bflo(xv.y) * w0[2], bfhi(xv.y) * w0[3]); av.z = pk2(bflo(xv.z) * w1[0], bfhi(xv.z) * w1[1]); av.w = pk2(bflo(xv.w) * w1[2], bfhi(xv.w) * w1[3]);
                const bf16x8 af = __builtin_bit_cast(bf16x8, av);
#pragma unroll
                for (int kt_ = 0; kt_ < 8; ++kt_) { const bf16x8 bfr = *(const LAS bf16x8*)(kt + (16 * kt_ + fr) * 136 + s0); acc[kt_] = MFMA16(af, bfr, acc[kt_]); }
            }
            {   const int k = tid & 127, q = tid >> 7;
#pragma unroll
                for (int e = 0; e < 4; ++e) { const v4u x = *(const LAS v4u*)(kt + k * 136 + 32 * q + 8 * e); const LAS float* w = wl + 128 * half + 32 * q + 8 * e;
                    dnp += bflo(x.x) * w[0] + bfhi(x.x) * w[1] + bflo(x.y) * w[2] + bfhi(x.y) * w[3] + bflo(x.z) * w[4] + bfhi(x.z) * w[5] + bflo(x.w) * w[6] + bfhi(x.w) * w[7]; } }
        }
        float* dct = (float*)(A.ws + WS_DCT) + ((size_t)unit * HD + 16 * wave + 4 * fq) * HD + fr;
#pragma unroll
        for (int kt_ = 0; kt_ < 8; ++kt_)
#pragma unroll
            for (int i = 0; i < 4; ++i) dct[(size_t)i * HD + 16 * kt_] = acc[kt_][i];
        red[(tid >> 7) * 128 + (tid & 127)] = dnp;
        __syncthreads();
        if (tid < HD) ((float*)(A.ws + WS_DN))[unit * HD + tid] = (red[tid] + red[128 + tid]) + (red[256 + tid] + red[384 + tid]);
        __syncthreads();
    }
}

__device__ __forceinline__ void phase_m4x(CArgs& A, int l, LAS unsigned char* lds, int tid) {
    LAS float* buf = (LAS float*)lds;
    LAS float* sa = (LAS float*)(lds + 1024);
    LAS float* smx = sa + 256;
    LAS float* sdec = smx + 256;
    LAS float* sem = sdec + 256;
    LAS bf16* vt = (LAS bf16*)(lds + 8192);
    const bf16* QKVO = (const bf16*)(A.ws + WS_QKVO);
    const int lane = tid & 63, wave = tid >> 6, fr = lane & 15, fq = lane >> 4;
    for (int unit = blockIdx.x; unit < NUNIT; unit += gridDim.x) {
        const int b = unit >> 7, h = (unit >> 5) & 3, c = unit & 31, r0 = b * SEQ + c * LCH;
        float ig = 0.f, lf = 0.f;
        if (tid < 256) ml_gates(A, l, r0 + tid, h, ig, lf);
        const float F = scan_sum256(lf, buf, tid);
        const float a = tid < 256 ? ig - F : -3.0e38f;
        const float cm = scan_max256(a, buf, tid);
        const float m0 = ((const float*)(A.ws + WS_CHS))[unit * 4 + 2];
        if (tid < 256) { const float mx = fmaxf(m0, cm); sa[tid] = a; smx[tid] = mx; sdec[tid] = __expf(m0 - mx); sem[tid] = __expf(-(F + mx)); }
        for (int i = tid; i < 4096; i += NTHR) { const int oc = i >> 8, s = i & 255;
            const v4u x = *(const v4u*)(QKVO + (size_t)(r0 + s) * 2048 + 1024 + h * HD + 8 * oc);
            LAS bf16* dst = vt + (8 * oc) * 264 + s;
            dst[0] = (bf16)x.x; dst[264] = (bf16)(x.x >> 16); dst[528] = (bf16)x.y; dst[792] = (bf16)(x.y >> 16); dst[1056] = (bf16)x.z; dst[1320] = (bf16)(x.z >> 16); dst[1584] = (bf16)x.w; dst[1848] = (bf16)(x.w >> 16); }
        __syncthreads();
        const bf16* ctp = (const bf16*)(A.ws + WS_CTP) + (size_t)unit * HD * HD;
        const float* npv = (const float*)(A.ws + WS_NPV) + unit * HD;
        for (int pass = 0; pass < 2; ++pass) {
            const int sub = pass == 0 ? wave : 15 - wave, t0 = 16 * sub, t = t0 + fr;
            const float mxt = smx[t], dect = sdec[t], emt = sem[t];
            bf16x8 qf[4];
#pragma unroll
            for (int kk = 0; kk < 4; ++kk) qf[kk] = *(const bf16x8*)(QKVO + (size_t)(r0 + t) * 2048 + h * HD + 32 * kk + 8 * fq);
            f32x4 ah[8], ac[8];
#pragma unroll
            for (int v = 0; v < 8; ++v) { ah[v] = (f32x4){0.f, 0.f, 0.f, 0.f}; ac[v] = (f32x4){0.f, 0.f, 0.f, 0.f}; }
            float den = 0.f;
            const int nblk = (t0 + 47) >> 5;
            for (int ib = 0; ib < nblk; ++ib) {
                const int s0 = 32 * ib;
                f32x4 st[2];
#pragma unroll
                for (int j = 0; j < 2; ++j) {
                    f32x4 z = {0.f, 0.f, 0.f, 0.f};
                    const bf16* kp = QKVO + (size_t)(r0 + s0 + 16 * j + fr) * 2048 + 512 + h * HD + 8 * fq;
#pragma unroll
                    for (int kk = 0; kk < 4; ++kk) z = MFMA16(*(const bf16x8*)(kp + 32 * kk), qf[kk], z);
                    const f32x4 a4 = *(const LAS f32x4*)(sa + s0 + 16 * j + 4 * fq);
#pragma unroll
                    for (int i = 0; i < 4; ++i) { const float w = (s0 + 16 * j + 4 * fq + i <= t) ? z[i] * __expf(a4[i] - mxt) : 0.f; z[i] = w; den += w; }
                    st[j] = z;
                }
                v4u pw; pw.x = pk2(st[0][0], st[0][1]); pw.y = pk2(st[0][2], st[0][3]); pw.z = pk2(st[1][0], st[1][1]); pw.w = pk2(st[1][2], st[1][3]);
                const bf16x8 pf = __builtin_bit_cast(bf16x8, pw);
#pragma unroll
                for (int v = 0; v < 8; ++v) { const LAS bf16* vp = vt + (16 * v + fr) * 264 + s0 + 4 * fq;
                    const v2u x = *(const LAS v2u*)vp, y = *(const LAS v2u*)(vp + 16);
                    v4u vw; vw.x = x.x; vw.y = x.y; vw.z = y.x; vw.w = y.y;
                    ah[v] = MFMA16(__builtin_bit_cast(bf16x8, vw), pf, ah[v]); }
            }
            float qn = 0.f;
#pragma unroll
            for (int kk = 0; kk < 4; ++kk) {
                const v4u qx = __builtin_bit_cast(v4u, qf[kk]); const f32x4 n0 = *(const f32x4*)(npv + 32 * kk + 8 * fq), n1 = *(const f32x4*)(npv + 32 * kk + 8 * fq + 4);
                qn += bflo(qx.x) * n0[0] + bfhi(qx.x) * n0[1] + bflo(qx.y) * n0[2] + bfhi(qx.y) * n0[3] + bflo(qx.z) * n1[0] + bfhi(qx.z) * n1[1] + bflo(qx.w) * n1[2] + bfhi(qx.w) * n1[3];
#pragma unroll
                for (int v = 0; v < 8; ++v) ac[v] = MFMA16(*(const bf16x8*)(ctp + (size_t)(16 * v + fr) * HD + 32 * kk + 8 * fq), qf[kk], ac[v]);
            }
            const float dent = xfq_sum(den) + dect * xfq_sum(qn);
            const float rden = 1.f / fmaxf(fabsf(dent), emt);
            float s1 = 0.f;
#pragma unroll
            for (int v = 0; v < 8; ++v) { ah[v] = (ah[v] + ac[v] * dect) * rden; s1 += (ah[v][0] + ah[v][1]) + (ah[v][2] + ah[v][3]); }
            const float mu = xfq_sum(s1) * (1.f / HD);
            float s2 = 0.f;
#pragma unroll
            for (int v = 0; v < 8; ++v) { ah[v] = ah[v] - mu; s2 += (ah[v][0] * ah[v][0] + ah[v][1] * ah[v][1]) + (ah[v][2] * ah[v][2] + ah[v][3] * ah[v][3]); }
            const float rstd = 1.f / sqrtf(xfq_sum(s2) * (1.f / HD) + LN_EPS);
            const bf16* op = QKVO + (size_t)(r0 + t) * 2048 + 1536 + h * HD + 4 * fq;
            bf16* mp = (bf16*)(A.ws + WS_MIX) + (size_t)(r0 + t) * D + h * HD + 4 * fq;
            const float* gp = A.ml_norm_g + l * 512 + h * HD + 4 * fq;
#pragma unroll
            for (int v = 0; v < 8; ++v) { const v2u og = *(const v2u*)(op + 16 * v); const f32x4 gn = *(const f32x4*)(gp + 16 * v);
                v2u w; w.x = pk2(ah[v][0] * rstd * gn[0] * sigmoidf_(bflo(og.x)), ah[v][1] * rstd * gn[1] * sigmoidf_(bfhi(og.x)));
                w.y = pk2(ah[v][2] * rstd * gn[2] * sigmoidf_(bflo(og.y)), ah[v][3] * rstd * gn[3] * sigmoidf_(bfhi(og.y)));
                *(v2u*)(mp + 16 * v) = w; }
        }
        __syncthreads();
    }
}

constexpr int SLOT = 8192;
constexpr int NG_KB = 0, NG_IMP = 4 * SLOT * 2, NG_RING_END = 7 * SLOT * 2, NG_BT = NG_RING_END, NG_MSK = NG_BT + 8 * 132 * 4, NG_TASK = NG_MSK + NWAVES * 16, NG_JL = NG_TASK + 16, NG_END = NG_JL + 136 * 4;
static_assert(NG_IMP + NWAVES * 1088 * 4 <= NG_RING_END && NG_END <= RING_BYTES, "NSA LDS map");
constexpr int CW_NSAQ = 16384;

__device__ __forceinline__ void dma_k(const bf16* Kblk, LAS bf16* slot, int wave, int lane) {
    const int row = 8 * wave + (lane >> 3), c = (lane & 7) ^ ((row >> 1) & 7);
    __builtin_amdgcn_global_load_lds((const unsigned*)(Kblk + row * 64 + c * 8), (LAS unsigned*)(slot + wave * 512), 16, 0, 0);
}
__device__ __forceinline__ void dma_v(const bf16* Vblk, LAS bf16* slot, int wave, int lane) {
    const int row = 8 * wave + (lane >> 3), c = (lane & 7) ^ ((row >> 1) & 7);
    __builtin_amdgcn_global_load_lds((const unsigned*)(Vblk + row * 64 + c * 8), (LAS unsigned*)(slot + 4096 + wave * 512), 16, 0, 0);
}
__device__ __forceinline__ void qk_lds(const LAS bf16* kb, const bf16x8 (&q)[2], int fr, int fq, f32x4 (&st)[4]) {
    const int sw = (fr >> 1) & 7;
#pragma unroll
    for (int t = 0; t < 4; ++t) { const LAS bf16* p = kb + (16 * t + fr) * 64;
        f32x4 z = {0.f, 0.f, 0.f, 0.f}; z = MFMA16(*(const LAS bf16x8*)(p + ((fq ^ sw) << 3)), q[0], z); st[t] = MFMA16(*(const LAS bf16x8*)(p + (((4 + fq) ^ sw) << 3)), q[1], z); }
}
__device__ __forceinline__ void pv_lds(const LAS bf16* vb, int fr, int fq, const f32x4 (&st)[4], f32x4 (&o)[4]) {
    const int sw = (fr >> 1) & 7, sub = 4 * (fq & 1);
#pragma unroll
    for (int h = 0; h < 2; ++h) {
        v4u pw; pw.x = pk2(st[2 * h][0], st[2 * h][1]); pw.y = pk2(st[2 * h][2], st[2 * h][3]); pw.z = pk2(st[2 * h + 1][0], st[2 * h + 1][1]); pw.w = pk2(st[2 * h + 1][2], st[2 * h + 1][3]);
        const bf16x8 pf = __builtin_bit_cast(bf16x8, pw);
        const int c0 = 4 * h + (fq >> 1);
#pragma unroll
        for (int dt = 0; dt < 4; ++dt) { const LAS bf16* p = vb + (16 * dt + fr) * 64 + sub;
            const v2u a = *(const LAS v2u*)(p + ((c0 ^ sw) << 3)), b = *(const LAS v2u*)(p + (((c0 + 2) ^ sw) << 3)); v4u w; w.x = a.x; w.y = a.y; w.z = b.x; w.w = b.y;
            o[dt] = MFMA16(__builtin_bit_cast(bf16x8, w), pf, o[dt]); }
    }
}
__device__ __forceinline__ void softmax_pv_lds(const LAS bf16* vb, int fr, int fq, f32x4 (&st)[4], float c, f32x4 (&o)[4], float& m, float& ls) {
    float bm = fmaxf(fmaxf(st[0][0], st[0][1]), fmaxf(st[0][2], st[0][3]));
#pragma unroll
    for (int t = 1; t < 4; ++t) bm = fmaxf(bm, fmaxf(fmaxf(st[t][0], st[t][1]), fmaxf(st[t][2], st[t][3])));
    bm = xfq_max(bm + c);
    if (__any(bm > m)) {
        const float mn = fmaxf(m, bm), sc = __builtin_amdgcn_exp2f(m - mn);
        m = mn; ls *= sc;
#pragma unroll
        for (int dt = 0; dt < 4; ++dt) o[dt] = o[dt] * sc;
    }
    const float d = c - m;
#pragma unroll
    for (int t = 0; t < 4; ++t)
#pragma unroll
        for (int i = 0; i < 4; ++i) { const float p = __builtin_amdgcn_exp2f(st[t][i] + d); st[t][i] = p; ls += p; }
    pv_lds(vb, fr, fq, st, o);
}

template <int RS, bool HASV, class Addr, class Body>
__device__ __forceinline__ void staged_sweep2(int n, const Addr& ad, Body& body, LAS bf16* ring, int tid) {
    if (n <= 0) return;
    const int lane = tid & 63, wave = tid >> 6;
    constexpr int DPB = HASV ? 2 : 1;
#pragma unroll 1
    for (int i = 0; i < RS - 2 && i < n; ++i) { dma_k(ad.k(i), ring + i * SLOT, wave, lane); if (HASV) dma_v(ad.v(i), ring + i * SLOT, wave, lane); }
    const int nstep = (n + 1) >> 1;
#pragma unroll 1
    for (int s = 0; s < nstep; ++s) {
        const int i0 = 2 * s;
        if (i0 + RS - 2 <= n) { if (RS == 7) asm volatile("s_waitcnt vmcnt(%0) lgkmcnt(0)\n\ts_barrier" :: "n"((RS - 4) * DPB) : "memory"); else asm volatile("s_waitcnt vmcnt(0) lgkmcnt(0)\n\ts_barrier" ::: "memory"); }
        else asm volatile("s_waitcnt vmcnt(0) lgkmcnt(0)\n\ts_barrier" ::: "memory");
        {   const int j0 = i0 + RS - 2, j1 = j0 + 1;
            if (j0 < n) { dma_k(ad.k(j0), ring + (j0 % RS) * SLOT, wave, lane); if (HASV) dma_v(ad.v(j0), ring + (j0 % RS) * SLOT, wave, lane); }
            if (j1 < n) { dma_k(ad.k(j1), ring + (j1 % RS) * SLOT, wave, lane); if (HASV) dma_v(ad.v(j1), ring + (j1 % RS) * SLOT, wave, lane); } }
        const LAS bf16* b0 = ring + (i0 % RS) * SLOT;
        body(i0, b0, b0 + 4096);
        if (i0 + 1 < n) { const LAS bf16* b1 = ring + ((i0 + 1) % RS) * SLOT; body(i0 + 1, b1, b1 + 4096); }
    }
    asm volatile("s_waitcnt vmcnt(0) lgkmcnt(0)\n\ts_barrier" ::: "memory");
}
struct AdLin {
    const bf16* K; const bf16* V;
    __device__ __forceinline__ const bf16* k(int i) const { return K + (size_t)i * 4096; }
    __device__ __forceinline__ const bf16* v(int i) const { return V + (size_t)i * 4096; }
};
struct AdList {
    const bf16* K; const bf16* V; const LAS int* jl;
    __device__ __forceinline__ const bf16* k(int i) const { const int j = __builtin_amdgcn_readfirstlane(jl[i]); return K + (size_t)j * 4096; }
    __device__ __forceinline__ const bf16* v(int i) const { const int j = __builtin_amdgcn_readfirstlane(jl[i]); return V + (size_t)j * 4096; }
};
struct TileCtx { int fr, fq, qposA, qposB, qpos0, cur; const LAS float* bt; float farb; };
struct KF { bf16x8 k[8]; };
struct VF { v4u v[8]; };
__device__ __forceinline__ void kf_load(KF& f, const LAS bf16* kb, int fr, int fq) {
    const int sw = (fr >> 1) & 7;
#pragma unroll
    for (int t = 0; t < 4; ++t) { const LAS bf16* p = kb + (16 * t + fr) * 64; f.k[2 * t] = *(const LAS bf16x8*)(p + ((fq ^ sw) << 3)); f.k[2 * t + 1] = *(const LAS bf16x8*)(p + (((4 + fq) ^ sw) << 3)); }
}
__device__ __forceinline__ void vf_load(VF& f, const LAS bf16* vb, int fr, int fq) {
    const int sw = (fr >> 1) & 7, sub = 4 * (fq & 1);
#pragma unroll
    for (int h = 0; h < 2; ++h) {
        const int c0 = 4 * h + (fq >> 1);
#pragma unroll
        for (int dt = 0; dt < 4; ++dt) { const LAS bf16* p = vb + (16 * dt + fr) * 64 + sub;
            const v2u a = *(const LAS v2u*)(p + ((c0 ^ sw) << 3)), b = *(const LAS v2u*)(p + (((c0 + 2) ^ sw) << 3)); v4u w; w.x = a.x; w.y = a.y; w.z = b.x; w.w = b.y; f.v[4 * h + dt] = w; }
    }
}
__device__ __forceinline__ void qk2(const KF& f, const bf16x8 (&qa)[2], const bf16x8 (&qb)[2], f32x4 (&sa)[4], f32x4 (&sb)[4]) {
#pragma unroll
    for (int t = 0; t < 4; ++t) { const f32x4 z = {0.f, 0.f, 0.f, 0.f};
        sa[t] = MFMA16(f.k[2 * t + 1], qa[1], MFMA16(f.k[2 * t], qa[0], z)); sb[t] = MFMA16(f.k[2 * t + 1], qb[1], MFMA16(f.k[2 * t], qb[0], z)); }
}
__device__ __forceinline__ void pv2(const VF& f, const f32x4 (&sa)[4], const f32x4 (&sb)[4], f32x4 (&oa)[4], f32x4 (&ob)[4]) {
#pragma unroll
    for (int h = 0; h < 2; ++h) {
        v4u pa, pb;
        pa.x = pk2(sa[2 * h][0], sa[2 * h][1]); pa.y = pk2(sa[2 * h][2], sa[2 * h][3]); pa.z = pk2(sa[2 * h + 1][0], sa[2 * h + 1][1]); pa.w = pk2(sa[2 * h + 1][2], sa[2 * h + 1][3]);
        pb.x = pk2(sb[2 * h][0], sb[2 * h][1]); pb.y = pk2(sb[2 * h][2], sb[2 * h][3]); pb.z = pk2(sb[2 * h + 1][0], sb[2 * h + 1][1]); pb.w = pk2(sb[2 * h + 1][2], sb[2 * h + 1][3]);
        const bf16x8 fa = __builtin_bit_cast(bf16x8, pa), fb = __builtin_bit_cast(bf16x8, pb);
#pragma unroll
        for (int dt = 0; dt < 4; ++dt) { const bf16x8 vv = __builtin_bit_cast(bf16x8, f.v[4 * h + dt]); oa[dt] = MFMA16(vv, fa, oa[dt]); ob[dt] = MFMA16(vv, fb, ob[dt]); }
    }
}
__device__ __forceinline__ float max16(const f32x4 (&st)[4]) {
    float bm = fmaxf(fmaxf(st[0][0], st[0][1]), fmaxf(st[0][2], st[0][3]));
#pragma unroll
    for (int t = 1; t < 4; ++t) bm = fmaxf(bm, fmaxf(fmaxf(st[t][0], st[t][1]), fmaxf(st[t][2], st[t][3])));
    return bm;
}
__device__ __forceinline__ void softmax_pv2(const LAS bf16* vb, int fr, int fq, f32x4 (&sa)[4], f32x4 (&sb)[4], float ca, float cb, f32x4 (&oa)[4], f32x4 (&ob)[4], float (&m)[2], float (&ls)[2]) {
    float ba = max16(sa) + ca, bb = max16(sb) + cb;
    ba = xfq_max(ba); bb = xfq_max(bb);
    const float ma = fmaxf(m[0], ba), mb = fmaxf(m[1], bb), xa = __builtin_amdgcn_exp2f(m[0] - ma), xb = __builtin_amdgcn_exp2f(m[1] - mb);
    m[0] = ma; m[1] = mb; ls[0] *= xa; ls[1] *= xb;
#pragma unroll
    for (int dt = 0; dt < 4; ++dt) { oa[dt] = oa[dt] * xa; ob[dt] = ob[dt] * xb; }
    const float da = ca - ma, db = cb - mb;
#pragma unroll
    for (int t = 0; t < 4; ++t)
#pragma unroll
        for (int i = 0; i < 4; ++i) { const float pa = __builtin_amdgcn_exp2f(sa[t][i] + da), pb = __builtin_amdgcn_exp2f(sb[t][i] + db); sa[t][i] = pa; sb[t][i] = pb; ls[0] += pa; ls[1] += pb; }
    VF vf; vf_load(vf, vb, fr, fq);
    pv2(vf, sa, sb, oa, ob);
}
__device__ __forceinline__ void qk1(const KF& f, const bf16x8 (&q)[2], f32x4 (&st)[4]) {
#pragma unroll
    for (int t = 0; t < 4; ++t) { const f32x4 z = {0.f, 0.f, 0.f, 0.f}; st[t] = MFMA16(f.k[2 * t + 1], q[1], MFMA16(f.k[2 * t], q[0], z)); }
}
__device__ __forceinline__ void softmax_pv1(const LAS bf16* vb, int fr, int fq, f32x4 (&st)[4], float c, f32x4 (&o)[4], float& m, float& ls) {
    float bm = max16(st) + c;
    bm = xfq_max(bm);
    const float mn = fmaxf(m, bm), x = __builtin_amdgcn_exp2f(m - mn);
    m = mn; ls *= x;
#pragma unroll
    for (int dt = 0; dt < 4; ++dt) o[dt] = o[dt] * x;
    const float d = c - mn;
#pragma unroll
    for (int t = 0; t < 4; ++t)
#pragma unroll
        for (int i = 0; i < 4; ++i) { const float p = __builtin_amdgcn_exp2f(st[t][i] + d); st[t][i] = p; ls += p; }
    pv_lds(vb, fr, fq, st, o);
}
struct BodyCmpStat2 {
    const bf16x8 (&qa)[2]; const bf16x8 (&qb)[2]; const TileCtx& c; float (&ml)[2]; float (&lsl)[2];
    __device__ __forceinline__ void operator()(int ib, const LAS bf16* kb, const LAS bf16*) {
        KF kf; kf_load(kf, kb, c.fr, c.fq);
        f32x4 sa[4], sb[4]; qk2(kf, qa, qb, sa, sb);
        if (c.qpos0 - 16 * (64 * ib + 63) - 31 >= 128) {
#pragma unroll
            for (int t = 0; t < 4; ++t) { sa[t] = sa[t] + c.farb; sb[t] = sb[t] + c.farb; }
        } else {
#pragma unroll
            for (int t = 0; t < 4; ++t)
#pragma unroll
                for (int i = 0; i < 4; ++i) { const int n = 64 * ib + 16 * t + 4 * c.fq + i; const int da = c.qposA - 16 * n - 31, db = c.qposB - 16 * n - 31;
                    sa[t][i] += c.bt[da < 0 ? 129 : (da > 128 ? 128 : da)]; sb[t][i] += c.bt[db < 0 ? 129 : (db > 128 ? 128 : db)]; }
        }
        const float ma = fmaxf(ml[0], max16(sa)), mb = fmaxf(ml[1], max16(sb));
        lsl[0] *= __builtin_amdgcn_exp2f(ml[0] - ma); lsl[1] *= __builtin_amdgcn_exp2f(ml[1] - mb); ml[0] = ma; ml[1] = mb;
#pragma unroll
        for (int t = 0; t < 4; ++t)
#pragma unroll
            for (int i = 0; i < 4; ++i) { lsl[0] += __builtin_amdgcn_exp2f(sa[t][i] - ma); lsl[1] += __builtin_amdgcn_exp2f(sb[t][i] - mb); }
    }
};
struct BodyCmpProb2 {
    const bf16x8 (&qa)[2]; const bf16x8 (&qb)[2]; const TileCtx& c; f32x4 (&oa)[4]; f32x4 (&ob)[4]; float m0, m1, inv0, inv1; LAS float* imp; int tl, rr;
    __device__ __forceinline__ void operator()(int ib, const LAS bf16* kb, const LAS bf16* vb) {
        KF kf; kf_load(kf, kb, c.fr, c.fq);
        f32x4 sa[4], sb[4]; qk2(kf, qa, qb, sa, sb);
        if (c.qpos0 - 16 * (64 * ib + 63) - 31 >= 128) {
            const float da = c.farb - m0, db = c.farb - m1;
#pragma unroll
            for (int t = 0; t < 4; ++t)
#pragma unroll
                for (int i = 0; i < 4; ++i) { sa[t][i] = __builtin_amdgcn_exp2f(sa[t][i] + da) * inv0; sb[t][i] = __builtin_amdgcn_exp2f(sb[t][i] + db) * inv1; }
        } else {
#pragma unroll
            for (int t = 0; t < 4; ++t)
#pragma unroll
                for (int i = 0; i < 4; ++i) { const int n = 64 * ib + 16 * t + 4 * c.fq + i; const int da = c.qposA - 16 * n - 31, db = c.qposB - 16 * n - 31;
                    sa[t][i] = __builtin_amdgcn_exp2f(sa[t][i] + c.bt[da < 0 ? 129 : (da > 128 ? 128 : da)] - m0) * inv0;
                    sb[t][i] = __builtin_amdgcn_exp2f(sb[t][i] + c.bt[db < 0 ? 129 : (db > 128 ? 128 : db)] - m1) * inv1; }
        }
#pragma unroll
        for (int t = 0; t < 4; ++t) {
            const float a4 = quad_sum((sa[t][0] + sa[t][1]) + (sa[t][2] + sa[t][3])), a3 = quad_sum(sa[t][3]), b4 = quad_sum((sb[t][0] + sb[t][1]) + (sb[t][2] + sb[t][3])), b3 = quad_sum(sb[t][3]);
            const int j0 = 16 * ib + 4 * t + c.fq;
            if (rr == 0) { LAS float* ip = imp + tl * 136 + j0;
                __hip_atomic_fetch_add(ip, a4, __ATOMIC_RELAXED, __HIP_MEMORY_SCOPE_WORKGROUP); __hip_atomic_fetch_add(ip + 1, a3, __ATOMIC_RELAXED, __HIP_MEMORY_SCOPE_WORKGROUP);
                __hip_atomic_fetch_add(ip + 4 * 136, b4, __ATOMIC_RELAXED, __HIP_MEMORY_SCOPE_WORKGROUP); __hip_atomic_fetch_add(ip + 4 * 136 + 1, b3, __ATOMIC_RELAXED, __HIP_MEMORY_SCOPE_WORKGROUP); }
        }
        VF vf; vf_load(vf, vb, c.fr, c.fq);
        pv2(vf, sa, sb, oa, ob);
    }
};
struct BodySel2 {
    const bf16x8 (&qa)[2]; const bf16x8 (&qb)[2]; const TileCtx& c; f32x4 (&oa)[4]; f32x4 (&ob)[4]; float (&m)[2]; float (&ls)[2]; const LAS int* jl;
    unsigned long long wu0a, wu1a, wu0b, wu1b, my0a, my1a, my0b, my1b; bool dead;
    __device__ __forceinline__ void operator()(int i, const LAS bf16* kb, const LAS bf16* vb) {
        const int j = __builtin_amdgcn_readfirstlane(jl[i]);
        const bool hasa = j < 64 ? ((wu0a >> j) & 1ull) != 0ull : ((wu1a >> (j - 64)) & 1ull) != 0ull, hasb = j < 64 ? ((wu0b >> j) & 1ull) != 0ull : ((wu1b >> (j - 64)) & 1ull) != 0ull;
        if (!(hasa || hasb)) return;
        const bool minea = !dead && (j < 64 ? ((my0a >> j) & 1ull) != 0ull : ((my1a >> (j - 64)) & 1ull) != 0ull), mineb = !dead && (j < 64 ? ((my0b >> j) & 1ull) != 0ull : ((my1b >> (j - 64)) & 1ull) != 0ull);
        const bool near = j >= c.cur - 2;
        if (hasa && hasb) {
            KF kf; kf_load(kf, kb, c.fr, c.fq);
            f32x4 sa[4], sb[4]; qk2(kf, qa, qb, sa, sb);
            float ca = minea ? c.farb : -INFINITY, cb = mineb ? c.farb : -INFINITY;
            if (near) {
                ca = minea ? 0.f : -INFINITY; cb = mineb ? 0.f : -INFINITY;
#pragma unroll
                for (int t = 0; t < 4; ++t)
#pragma unroll
                    for (int e = 0; e < 4; ++e) { const int key = 64 * j + 16 * t + 4 * c.fq + e; const int da = c.qposA - key, db = c.qposB - key;
                        sa[t][e] += c.bt[da < 0 ? 129 : (da > 128 ? 128 : da)]; sb[t][e] += c.bt[db < 0 ? 129 : (db > 128 ? 128 : db)]; }
            }
            softmax_pv2(vb, c.fr, c.fq, sa, sb, ca, cb, oa, ob, m, ls);
        } else {
            const bool mine = hasa ? minea : mineb; const int qpos = hasa ? c.qposA : c.qposB;
            f32x4 st[4];
            if (hasa) qk_lds(kb, qa, c.fr, c.fq, st); else qk_lds(kb, qb, c.fr, c.fq, st);
            float cc = mine ? c.farb : -INFINITY;
            if (near) {
                cc = mine ? 0.f : -INFINITY;
#pragma unroll
                for (int t = 0; t < 4; ++t)
#pragma unroll
                    for (int e = 0; e < 4; ++e) { const int d1 = qpos - (64 * j + 16 * t + 4 * c.fq + e); st[t][e] += c.bt[d1 < 0 ? 129 : (d1 > 128 ? 128 : d1)]; }
            }
            if (hasa) softmax_pv1(vb, c.fr, c.fq, st, cc, oa, m[0], ls[0]); else softmax_pv1(vb, c.fr, c.fq, st, cc, ob, m[1], ls[1]);
        }
    }
};
struct BodyWin2 {
    const bf16x8 (&qa)[2]; const bf16x8 (&qb)[2]; const TileCtx& c; f32x4 (&oa)[4]; f32x4 (&ob)[4]; float (&m)[2]; float (&ls)[2]; int j0;
    __device__ __forceinline__ void operator()(int i, const LAS bf16* kb, const LAS bf16* vb) {
        const int j = j0 + i;
        if (c.qpos0 + 7 - 64 * j < 0 || c.qpos0 - (64 * j + 63) >= 512) return;
        KF kf; kf_load(kf, kb, c.fr, c.fq);
        f32x4 sa[4], sb[4]; qk2(kf, qa, qb, sa, sb);
        float ca = c.farb, cb = c.farb;
        const bool interior = (c.qpos0 + 7 - 64 * j < 512) && (c.qpos0 - (64 * j + 63) >= 128);
        if (!interior) {
            ca = 0.f; cb = 0.f;
#pragma unroll
            for (int t = 0; t < 4; ++t)
#pragma unroll
                for (int e = 0; e < 4; ++e) { const int key = 64 * j + 16 * t + 4 * c.fq + e; const int da = c.qposA - key, db = c.qposB - key;
                    sa[t][e] += c.bt[(unsigned)da >= 512u ? 129 : (da > 128 ? 128 : da)]; sb[t][e] += c.bt[(unsigned)db >= 512u ? 129 : (db > 128 ? 128 : db)]; }
        }
        softmax_pv2(vb, c.fr, c.fq, sa, sb, ca, cb, oa, ob, m, ls);
    }
};

__device__ __forceinline__ void nsa_group(CArgs& A, int l, int b, int g, int tg, int dbg, LAS unsigned char* lds, int tid) {
    asm volatile("" : "+v"(tid));
    const int lane = tid & 63, wave = tid >> 6, fr = lane & 15, fq = lane >> 4, tl = fr >> 2, rr = fr & 3;
    LAS bf16* ring = (LAS bf16*)(lds + NG_KB);
    LAS float* imp = (LAS float*)(lds + NG_IMP) + wave * 1088; const LAS float* BT = (const LAS float*)(lds + NG_BT);
    LAS unsigned long long* msk = (LAS unsigned long long*)(lds + NG_MSK);
    LAS int* jl = (LAS int*)(lds + NG_JL);
    const int qpos0 = 64 * tg + 8 * wave, cur = tg, row0 = b * SEQ + qpos0, h = g * 4 + rr;
    const LAS float* bt = BT + h * 132;
    const TileCtx cx{fr, fq, qpos0 + tl, qpos0 + 4 + tl, qpos0, cur, bt, bt[128]};
    bf16x8 qa[2], qb[2];
    {   const bf16* qp = (const bf16*)(A.ws + WS_NQ) + (size_t)(row0 + tl) * 512 + g * 256 + rr * 64 + 8 * fq;
        qa[0] = *(const bf16x8*)qp; qa[1] = *(const bf16x8*)(qp + 32); qb[0] = *(const bf16x8*)(qp + 4 * 512); qb[1] = *(const bf16x8*)(qp + 4 * 512 + 32); }
    f32x4 outa[4], outb[4];
    for (int i = lane; i < 1088; i += 64) imp[i] = 0.f;

    {
        const int nb64 = (4 * tg + 3 + 63) >> 6;
        const AdLin ad{(const bf16*)(A.ws + WS_KC) + l * KC_L + (size_t)g * NCB * 64 + (size_t)b * 512 * 64, (const bf16*)(A.ws + WS_VCT) + l * KC_L + (size_t)g * 64 * NCB + (size_t)b * 8 * 4096};
        float ml[2] = {-1.0e30f, -1.0e30f}, lsl[2] = {0.f, 0.f};
        { BodyCmpStat2 bd{qa, qb, cx, ml, lsl}; staged_sweep2<4, false>(nb64, ad, bd, ring, tid); }
        const float m0 = xfq_max(ml[0]), m1 = xfq_max(ml[1]);
        const float l0 = xfq_sum(lsl[0] * __builtin_amdgcn_exp2f(ml[0] - m0)), l1 = xfq_sum(lsl[1] * __builtin_amdgcn_exp2f(ml[1] - m1));
        f32x4 oa[4], ob[4];
#pragma unroll
        for (int dt = 0; dt < 4; ++dt) { oa[dt] = (f32x4){0.f, 0.f, 0.f, 0.f}; ob[dt] = (f32x4){0.f, 0.f, 0.f, 0.f}; }
        { BodyCmpProb2 bd{qa, qb, cx, oa, ob, m0, m1, l0 > 0.f ? 1.f / l0 : 0.f, l1 > 0.f ? 1.f / l1 : 0.f, imp, tl, rr}; staged_sweep2<4, true>(nb64, ad, bd, ring, tid); }
        const float* gt = (const float*)(A.ws + WS_GATE) + (size_t)(row0 + tl) * 32 + 8 + h * 3;
        const float ga = sigmoidf_(gt[0]), gb = sigmoidf_(gt[4 * 32]);
#pragma unroll
        for (int dt = 0; dt < 4; ++dt) { outa[dt] = oa[dt] * ga; outb[dt] = ob[dt] * gb; }
    }
    unsigned long long s0[8], s1[8];
#pragma unroll
    for (int t = 0; t < 8; ++t) topk_sel(imp[t * 136 + lane], imp[t * 136 + 64 + lane], cur, lane, s0[t], s1[t]);
    const unsigned long long wu0a = (s0[0] | s0[1]) | (s0[2] | s0[3]), wu1a = (s1[0] | s1[1]) | (s1[2] | s1[3]), wu0b = (s0[4] | s0[5]) | (s0[6] | s0[7]), wu1b = (s1[4] | s1[5]) | (s1[6] | s1[7]);
    const unsigned long long my0a = tl == 0 ? s0[0] : (tl == 1 ? s0[1] : (tl == 2 ? s0[2] : s0[3])), my1a = tl == 0 ? s1[0] : (tl == 1 ? s1[1] : (tl == 2 ? s1[2] : s1[3]));
    const unsigned long long my0b = tl == 0 ? s0[4] : (tl == 1 ? s0[5] : (tl == 2 ? s0[6] : s0[7])), my1b = tl == 0 ? s1[4] : (tl == 1 ? s1[5] : (tl == 2 ? s1[6] : s1[7]));
    if (lane == 0) { msk[2 * wave] = wu0a | wu0b; msk[2 * wave + 1] = wu1a | wu1b; }
    __syncthreads();
    unsigned long long gu0 = 0ull, gu1 = 0ull;
#pragma unroll
    for (int w = 0; w < NWAVES; ++w) { gu0 |= msk[2 * w]; gu1 |= msk[2 * w + 1]; }
    gu0 = __builtin_amdgcn_readfirstlane((unsigned)gu0) | ((unsigned long long)__builtin_amdgcn_readfirstlane((unsigned)(gu0 >> 32)) << 32);
    gu1 = __builtin_amdgcn_readfirstlane((unsigned)gu1) | ((unsigned long long)__builtin_amdgcn_readfirstlane((unsigned)(gu1 >> 32)) << 32);
    const int nsel0 = __popcll(gu0), nsel = nsel0 + __popcll(gu1);
    if (wave == 0) {
        const unsigned long long below = (1ull << lane) - 1ull;
        if ((gu0 >> lane) & 1ull) jl[__popcll(gu0 & below)] = lane;
        if ((gu1 >> lane) & 1ull) jl[nsel0 + __popcll(gu1 & below)] = 64 + lane;
    }
    __syncthreads();
    const float* gt = (const float*)(A.ws + WS_GATE) + (size_t)(row0 + tl) * 32 + 8 + h * 3;
    if (!(dbg & 32)) {
        float m[2] = {-1.0e30f, -1.0e30f}, ls[2] = {0.f, 0.f}; f32x4 oa[4], ob[4];
#pragma unroll
        for (int dt = 0; dt < 4; ++dt) { oa[dt] = (f32x4){0.f, 0.f, 0.f, 0.f}; ob[dt] = (f32x4){0.f, 0.f, 0.f, 0.f}; }
        const AdList ad{(const bf16*)(A.ws + WS_KS) + l * KS_L + (size_t)g * TOTS * 64 + (size_t)b * SEQ * 64, (const bf16*)(A.ws + WS_VTS) + l * KS_L + (size_t)g * 64 * TOTS + (size_t)b * 128 * 4096, jl};
        { BodySel2 bd{qa, qb, cx, oa, ob, m, ls, jl, wu0a, wu1a, wu0b, wu1b, my0a, my1a, my0b, my1b, false}; staged_sweep2<7, true>(nsel, ad, bd, ring, tid);
#if defined(REP_MASK) && ((REP_MASK >> 15) & 1)
          bd.dead = true; staged_sweep2<7, true>(nsel, ad, bd, ring, tid);
#endif
        }
        const float la = xfq_sum(ls[0]), lb = xfq_sum(ls[1]);
        const float wa = la > 0.f ? sigmoidf_(gt[1]) / la : 0.f, wb = lb > 0.f ? sigmoidf_(gt[4 * 32 + 1]) / lb : 0.f;
#pragma unroll
        for (int dt = 0; dt < 4; ++dt) { outa[dt] = outa[dt] + oa[dt] * wa; outb[dt] = outb[dt] + ob[dt] * wb; }
    }
    if (!(dbg & 64)) {
        float m[2] = {-1.0e30f, -1.0e30f}, ls[2] = {0.f, 0.f}; f32x4 oa[4], ob[4];
#pragma unroll
        for (int dt = 0; dt < 4; ++dt) { oa[dt] = (f32x4){0.f, 0.f, 0.f, 0.f}; ob[dt] = (f32x4){0.f, 0.f, 0.f, 0.f}; }
        int j0 = (64 * tg - 511) >> 6; if (j0 < 0) j0 = 0;
        const AdLin ad{(const bf16*)(A.ws + WS_KW) + l * KW_L + (size_t)g * TOTWP * 64 + ((size_t)b * SEQ + (size_t)j0 * 64) * 64, (const bf16*)(A.ws + WS_VTW) + l * KW_L + (size_t)g * 64 * TOTWP + ((size_t)b * 128 + j0) * 4096};
        { BodyWin2 bd{qa, qb, cx, oa, ob, m, ls, j0}; staged_sweep2<7, true>(cur - j0 + 1, ad, bd, ring, tid); }
        const float la = xfq_sum(ls[0]), lb = xfq_sum(ls[1]);
        const float wa = la > 0.f ? sigmoidf_(gt[2]) / la : 0.f, wb = lb > 0.f ? sigmoidf_(gt[4 * 32 + 2]) / lb : 0.f;
#pragma unroll
        for (int dt = 0; dt < 4; ++dt) { outa[dt] = outa[dt] + oa[dt] * wa; outb[dt] = outb[dt] + ob[dt] * wb; }
    }
    bf16* mp = (bf16*)(A.ws + (dbg ? WS_HRAW : WS_MIX)) + (size_t)(row0 + tl) * D + 512 + h * 64 + 4 * fq;
#pragma unroll
    for (int dt = 0; dt < 4; ++dt) { v2u w; w.x = pk2(outa[dt][0], outa[dt][1]); w.y = pk2(outa[dt][2], outa[dt][3]); *(v2u*)(mp + 16 * dt) = w;
        v2u w2; w2.x = pk2(outb[dt][0], outb[dt][1]); w2.y = pk2(outb[dt][2], outb[dt][3]); *(v2u*)(mp + 4 * D + 16 * dt) = w2; }
}

__device__ __forceinline__ void phase_nsa2(CArgs& A, int l, int rep, int sub, LAS unsigned char* lds, int tid) {
    const int lane = tid & 63, wave = tid >> 6;
    LAS float* btl = (LAS float*)(lds + NG_BT);
    LAS int* tw = (LAS int*)(lds + NG_TASK);
    for (int i = tid; i < 8 * 132; i += NTHR) btl[i] = ((const float*)(A.ws + WS_BT))[i];
    unsigned* qh = (unsigned*)(A.ws + WS_CTL) + CW_NSAQ + (l * 2 + rep) * 5 * 64;
    const int own = (blockIdx.x & 7) >> 1;
    for (int qi = 0; qi < 5; ++qi) {
        const int qsel = qi == 0 ? 4 : (qi == 1 ? own : ((own + qi - 1) & 3));
        const int qlen = qsel == 4 ? ((sub & 8) ? 2 * DB / NWAVES : 0) : ((sub & 4) ? 128 : 0);
        for (;;) {
            __syncthreads();
            if (tid == 0) tw[0] = (int)__hip_atomic_fetch_add(qh + qsel * 64, 1u, __ATOMIC_RELAXED, __HIP_MEMORY_SCOPE_AGENT);
            __syncthreads();
            const int t = tw[0];
            if (t >= qlen) break;
            if (qsel < 4) nsa_group(A, l, qsel >> 1, qsel & 1, 127 - t, A.bar_region == 1 ? (sub & ~15) : 0, lds, tid);
            else { const int tt = t * NWAVES + wave; nsa_tile(A, l, true, tt >> 1, tt & 1, 0, (LAS float*)(lds + NG_IMP) + wave * 1088, btl, lane); }
        }
    }
}

constexpr int PH_PER_LAYER = 9, PH_L0 = 3, N_PHASES = PH_L0 + DEPTH * PH_PER_LAYER;
#ifndef REP_MASK
#define REP_MASK 0
#endif
__device__ __forceinline__ int rep_count(int b) { int n = (((REP_MASK) >> b) & 1) + 1; asm volatile("" : "+s"(n)); return n; }
#if REP_MASK
#define REPS(b) _Pragma("unroll 1") for (int rep_ = 0, nrep_ = rep_count(b); rep_ < nrep_; ++rep_)
#else
#define REPS(b) for (int rep_ = 0; rep_ < 1; ++rep_)
#endif
#ifndef MK_PER_PHASE
#define MK_PER_PHASE 0
#endif

__device__ __forceinline__ int fresh_tid(int wave_s) { int lane = __builtin_amdgcn_mbcnt_hi(~0u, __builtin_amdgcn_mbcnt_lo(~0u, 0u)); asm volatile("" : "+v"(lane)); return wave_s * 64 + lane; }
__device__ __forceinline__ CArgs* kargs() { unsigned long long p = (unsigned long long)__builtin_amdgcn_kernarg_segment_ptr(); asm volatile("" : "+s"(p)); return (CArgs*)p; }
#define A (*kargs())
#define IN(k) (lo <= (k) && (k) < hi)
#define SEAM(k) do { if (IN(k) && IN((k) + 1)) xcd_barrier(bar); } while (0)
template <int l>
__device__ __forceinline__ void layer_phases(LAS unsigned char* lds, const XcdBarrier& bar, int wave_s, int G, int NGW, int lo, int hi) {
    unsigned char* ws = A.ws;
    float* const ADA = (float*)(ws + WS_ADA);
    float* const X = (float*)(ws + WS_X);
    bf16* const Z = (bf16*)(ws + WS_Z);
    bf16* const U = (bf16*)(ws + WS_U);
        const int pb_ = PH_L0 + l * PH_PER_LAYER;
        const float* adal = ADA + (size_t)l * NCOND * 6144;
        const float* xa = l == 0 ? A.x_prompt : X; const float* xb = l == 0 ? A.x_sample : X + (size_t)MP * D;
        if (IN(pb_ + 0)) {
            const int tid = fresh_tid(wave_s), lane = tid & 63, wave = __builtin_amdgcn_readfirstlane(tid >> 6), gw = blockIdx.x * NWAVES + wave; (void)lane; (void)gw;
            {
                pg8::Gemm g{U, (const bf16*)(ws + WS_WIN) + (size_t)l * NINP * D, D, D, D};
                pg8::StaticOrder S; S.init(M, NINP, G, (int)blockIdx.x);
                EpiInProj E{(bf16*)(ws + WS_QKVO), (bf16*)(ws + WS_NQ), (float*)(ws + WS_GATE), (float*)(ws + WS_KVR), (bf16*)(ws + WS_XC) + (size_t)l * 4 * XCP * 64, A.out, l};
                REPS(8) pg8::gemm_phase<EpiInProj, pg8::StaticOrder, true, true>(lds, g, S, E, tid);
            }
            if (l == 0) {
                __syncthreads();
                pg8::Gemm g{(const bf16*)(ws + WS_XC), (const bf16*)(ws + WS_W1), 2048, 1024, 2048};
                CmpOrder S{G, (int)blockIdx.x, 0, DEPTH, 4, 64};
                EpiCmpHid E{(bf16*)(ws + WS_HID), (const float*)(ws + WS_B1)};
                REPS(14) pg8::gemm_phase<EpiCmpHid, CmpOrder, true, true>(lds, g, S, E, tid);
            }
        }
        SEAM(pb_ + 0);
        if (IN(pb_ + 1)) {
            const int tid = fresh_tid(wave_s), lane = tid & 63, wave = __builtin_amdgcn_readfirstlane(tid >> 6), gw = blockIdx.x * NWAVES + wave; (void)lane; (void)gw;
            {
                SgCmpHid E{(bf16*)(ws + WS_HID) + (size_t)l * 4 * NCB * 256, (const float*)(ws + WS_B1) + l * 2 * 256};
                REPS(12) small_gemm(((const bf16*)(ws + WS_XC)) + (size_t)l * 4 * XCP * 64, (size_t)XCP * 64, 1024, ((const bf16*)(ws + WS_W1)) + (size_t)l * 2 * 256 * 2048, (size_t)256 * 2048, 2048, 2048, 4, 1024, 256, E, lds, tid);
            }
            REPS(1) { phase_m2x(A, l, lds, tid);
            __syncthreads();
            prep_layer_images(A, l, lds, gw, NGW, lane, wave); __syncthreads(); }
            if (l == 0) phase_cmp2<false>(A, 0, DEPTH, 1024, NCB - 1024, gw, NGW, lane);
        }
        SEAM(pb_ + 1);
        if (IN(pb_ + 2)) {
            const int tid = fresh_tid(wave_s), lane = tid & 63, wave = __builtin_amdgcn_readfirstlane(tid >> 6), gw = blockIdx.x * NWAVES + wave; (void)lane; (void)gw;
            REPS(2) phase_m3(A, l, tid);
            phase_cmp2<false>(A, l, 1, 0, 1024, gw, NGW, lane);
        }
        SEAM(pb_ + 2);
        if (IN(pb_ + 3)) {
            const int tid = fresh_tid(wave_s), lane = tid & 63, wave = __builtin_amdgcn_readfirstlane(tid >> 6), gw = blockIdx.x * NWAVES + wave; (void)lane; (void)gw;
            const int sub = A.pad_;
            if (sub & 1) REPS(3) { phase_m4x(A, l, lds, tid);
            __syncthreads(); }
            if (sub & 2) REPS(4) { phase_mls(A, l, lds, tid);
            __syncthreads(); }
            if (sub & 12)
            REPS(5) phase_nsa2(A, l, rep_ + (A.bar_region == 1 ? 1 : 0), sub, lds, tid);
        }
        SEAM(pb_ + 3);
        if (IN(pb_ + 4)) {
            const int tid = fresh_tid(wave_s), lane = tid & 63, wave = __builtin_amdgcn_readfirstlane(tid >> 6), gw = blockIdx.x * NWAVES + wave; (void)lane; (void)gw;
            pg8::Gemm g{(const bf16*)(ws + WS_MIX), (const bf16*)(ws + WS_WOUT) + (size_t)l * D * D, D, D, D};
            pg8::StaticOrder S; S.init(MP, D, G, (int)blockIdx.x);
            EpiResid E{xa, xb, adal + 2048, Z};
            REPS(9) pg8::gemm_phase<EpiResid, pg8::StaticOrder, true, true>(lds, g, S, E, tid);
            REPS(13) { SgResid E2{xb, adal + 2048, Z}; small_gemm(((const bf16*)(ws + WS_MIX)) + (size_t)MP * D, 0, D, (const bf16*)(ws + WS_WOUT) + (size_t)l * D * D, 0, D, D, 1, MS, D, E2, lds, tid); }
        }
        SEAM(pb_ + 4);
        if (IN(pb_ + 5)) {
            const int tid = fresh_tid(wave_s), lane = tid & 63, wave = __builtin_amdgcn_readfirstlane(tid >> 6), gw = blockIdx.x * NWAVES + wave; (void)lane; (void)gw;
            REPS(6) for (int r = gw; r < M; r += NGW) {
                const float* ad = adal + (size_t)cond_of_row(r) * 6144;
                ln_row(Z + (size_t)r * D, A.ln_g + (size_t)(l * 2 + 0) * D, A.ln_b + (size_t)(l * 2 + 0) * D, X + (size_t)r * D, ad + 3072, ad + 4096, U + (size_t)r * D, lane);
            }
        }
        SEAM(pb_ + 5);
        if (IN(pb_ + 6)) {
            const int tid = fresh_tid(wave_s), lane = tid & 63, wave = __builtin_amdgcn_readfirstlane(tid >> 6), gw = blockIdx.x * NWAVES + wave; (void)lane; (void)gw;
            pg8::Gemm g{U, (const bf16*)(ws + WS_WUP) + (size_t)l * FF * D, D, D, D};
            pg8::StaticOrder S; S.init(MP, FF, G, (int)blockIdx.x);
            EpiRelu2 E{(bf16*)(ws + WS_H)};
            REPS(10) pg8::gemm_phase<EpiRelu2, pg8::StaticOrder, true, true>(lds, g, S, E, tid);
            REPS(13) { SgRelu2 E2{(bf16*)(ws + WS_H)}; small_gemm(U + (size_t)MP * D, 0, D, (const bf16*)(ws + WS_WUP) + (size_t)l * FF * D, 0, D, D, 1, MS, FF, E2, lds, tid); }
        }
        SEAM(pb_ + 6);
        if (IN(pb_ + 7)) {
            const int tid = fresh_tid(wave_s), lane = tid & 63, wave = __builtin_amdgcn_readfirstlane(tid >> 6), gw = blockIdx.x * NWAVES + wave; (void)lane; (void)gw;
            pg8::Gemm g{(const bf16*)(ws + WS_H), (const bf16*)(ws + WS_WDN) + (size_t)l * D * FF, FF, FF, FF};
            pg8::StaticOrder S; S.init(MP, D, G, (int)blockIdx.x);
            EpiResid E{X, X + (size_t)MP * D, adal + 5120, Z};
            REPS(11) pg8::gemm_phase<EpiResid, pg8::StaticOrder, true, true>(lds, g, S, E, tid);
            REPS(13) { SgResid E2{X + (size_t)MP * D, adal + 5120, Z}; small_gemm(((const bf16*)(ws + WS_H)) + (size_t)MP * FF, 0, FF, (const bf16*)(ws + WS_WDN) + (size_t)l * D * FF, 0, FF, FF, 1, MS, D, E2, lds, tid); }
        }
        SEAM(pb_ + 7);
        if (IN(pb_ + 8)) {
            const int tid = fresh_tid(wave_s), lane = tid & 63, wave = __builtin_amdgcn_readfirstlane(tid >> 6), gw = blockIdx.x * NWAVES + wave; (void)lane; (void)gw;
            const bool last = l == DEPTH - 1;
            REPS(6) for (int r = gw; r < M; r += NGW) {
                const float* ad = adal + (size_t)NCOND * 6144 + (size_t)cond_of_row(r) * 6144;
                float* xo = last ? (r < MP ? A.out + O_YP + (size_t)r * D : A.out + O_YS + (size_t)(r - MP) * D) : X + (size_t)r * D;
                ln_row(Z + (size_t)r * D, A.ln_g + (size_t)(l * 2 + 1) * D, A.ln_b + (size_t)(l * 2 + 1) * D, xo, ad, ad + 1024, last ? (bf16*)nullptr : U + (size_t)r * D, lane);
            }
        }
        SEAM(pb_ + 8);
    }
__global__ void __launch_bounds__(NTHR, 2) fwd_kernel(Args A_unused) {
    extern __shared__ __attribute__((aligned(16))) unsigned char lds_raw[];
    LAS unsigned char* lds = (LAS unsigned char*)lds_raw;
    const int G = gridDim.x, NGW = G * NWAVES, wave_s = __builtin_amdgcn_readfirstlane(threadIdx.x >> 6);
    unsigned char* ws = A.ws;
    for (int u = threadIdx.x; u < (LDS_BYTES - LDSCTL_OFF) / 4; u += NTHR) ((LAS unsigned*)(lds + LDSCTL_OFF))[u] = 0u;
    __syncthreads();
    unsigned* barw = (unsigned*)(ws + WS_CTL) + CW_BAR + A.bar_region * XCD_BAR_WORDS;
    XcdBarrier bar; bar.bar = barw; bar.x = 0; bar.st = nullptr;
    if (!MK_PER_PHASE) bar = xcd_barrier_post(barw, (volatile LAS unsigned*)(lds + MISC_OFF) + 8);
    const int lo = A.ph_lo, hi = A.ph_hi;

    float* const ADA = (float*)(ws + WS_ADA);
    float* const X = (float*)(ws + WS_X);
    bf16* const Z = (bf16*)(ws + WS_Z);
    bf16* const U = (bf16*)(ws + WS_U);

    if (IN(0)) { const int tid = fresh_tid(wave_s), lane = tid & 63, wave = __builtin_amdgcn_readfirstlane(tid >> 6), gw = blockIdx.x * NWAVES + wave;
        REPS(7) { phase_ada(A, lds, tid); } __syncthreads();
        REPS(0) { phase_p0a(A, lds, gw, NGW, lane, wave); prep_cache_images(A, lds, gw, NGW, lane, wave); } }
    SEAM(0);
    if (IN(2)) {
        const int tid = fresh_tid(wave_s), lane = tid & 63, wave = __builtin_amdgcn_readfirstlane(tid >> 6), gw = blockIdx.x * NWAVES + wave;
        b1_reduce(A, tid);
        for (int r = gw; r < M; r += NGW) {
            const float* ad = ADA + (size_t)cond_of_row(r) * 6144;
            mod_row(r < MP ? A.x_prompt + (size_t)r * D : A.x_sample + (size_t)(r - MP) * D, ad, ad + 1024, U + (size_t)r * D, lane);
        }
    }
    SEAM(2);

    layer_phases<0>(lds, bar, wave_s, G, NGW, lo, hi);
    layer_phases<1>(lds, bar, wave_s, G, NGW, lo, hi);
    static_assert(DEPTH == 2, "two layers");
#undef IN
#undef SEAM
#undef A
}

extern "C" void kernel_launch(void* const* d_in, const int* in_sizes, int n_in, void* d_out, int out_size, void* d_ws, size_t ws_size, hipStream_t stream) {
    static int grid = 0;
    if (grid == 0) {
        if (n_in != 25 || (size_t)out_size != O_END || ws_size < WS_END) { fprintf(stderr, "kernel_launch: unexpected shapes: n_in %d out %d (want %zu) ws %zu (want >= %zu)\n", n_in, out_size, (size_t)O_END, ws_size, (size_t)WS_END); grid = -1; return; }
        int dev = 0, cus = 0, per_cu = 0;
        if (hipGetDevice(&dev) != hipSuccess || hipDeviceGetAttribute(&cus, hipDeviceAttributeMultiprocessorCount, dev) != hipSuccess) { grid = -1; return; }
        if (hipFuncSetAttribute((const void*)fwd_kernel, hipFuncAttributeMaxDynamicSharedMemorySize, LDS_BYTES) != hipSuccess) { fprintf(stderr, "kernel_launch: hipFuncSetAttribute failed\n"); grid = -1; return; }
        if (hipOccupancyMaxActiveBlocksPerMultiprocessor(&per_cu, (const void*)fwd_kernel, NTHR, LDS_BYTES) != hipSuccess || per_cu < 1) fprintf(stderr, "kernel_launch: occupancy query reports %d blocks per CU\n", per_cu);
        (void)hipGetLastError();
        grid = cus;
    }
    if (grid < 0) return;
    (void)hipMemsetAsync((char*)d_ws + WS_CTL, 0, CTL_ZERO_BYTES, stream);
    Args a{};
    a.x_prompt = (const float*)d_in[0]; a.x_sample = (const float*)d_in[1]; a.cache_cmp = (const float*)d_in[2]; a.cache_slc = (const float*)d_in[3]; a.cache_win = (const float*)d_in[4];
    a.st_C = (const float*)d_in[5]; a.st_n = (const float*)d_in[6]; a.st_m = (const float*)d_in[7]; a.page_table = (const int*)d_in[8]; a.c_prompt = (const float*)d_in[9]; a.c_sample = (const float*)d_in[10];
    a.w_ada = (const float*)d_in[11]; a.b_ada = (const float*)d_in[12]; a.w_in = (const float*)d_in[13]; a.b_gate = (const float*)d_in[14]; a.ml_norm_g = (const float*)d_in[15]; a.cmp_pe = (const float*)d_in[16];
    a.cmp_w1 = (const float*)d_in[17]; a.cmp_w2 = (const float*)d_in[18]; a.rel_bias = (const float*)d_in[19]; a.w_out = (const float*)d_in[20]; a.ln_g = (const float*)d_in[21]; a.ln_b = (const float*)d_in[22];
    a.w_up = (const float*)d_in[23]; a.w_down = (const float*)d_in[24];
    a.out = (float*)d_out; a.ws = (unsigned char*)d_ws; a.pad_ = 15;
#if MK_PER_PHASE
    for (int ph = 0; ph < N_PHASES; ++ph) { a.ph_lo = ph; a.ph_hi = ph + 1; hipLaunchKernelGGL(fwd_kernel, dim3(grid), dim3(NTHR), LDS_BYTES, stream, a); }
#else
#ifdef PROBE_DUP_PHASE
    a.ph_lo = 0; a.ph_hi = PROBE_DUP_PHASE + 1; a.bar_region = 0; hipLaunchKernelGGL(fwd_kernel, dim3(grid), dim3(NTHR), LDS_BYTES, stream, a);
    a.ph_lo = PROBE_DUP_PHASE; a.ph_hi = PROBE_DUP_PHASE + 1; a.bar_region = 1;
#ifdef PROBE_SUB
    a.pad_ = PROBE_SUB;
#endif
    hipLaunchKernelGGL(fwd_kernel, dim3(grid), dim3(NTHR), LDS_BYTES, stream, a);
    a.pad_ = 15; a.ph_lo = PROBE_DUP_PHASE + 1; a.ph_hi = N_PHASES; a.bar_region = 2; hipLaunchKernelGGL(fwd_kernel, dim3(grid), dim3(NTHR), LDS_BYTES, stream, a);
#else
    a.ph_lo = 0; a.ph_hi = N_PHASES;
    hipLaunchKernelGGL(fwd_kernel, dim3(grid), dim3(NTHR), LDS_BYTES, stream, a);
#endif
#endif
    const hipError_t le = hipPeekAtLastError();
    if (le != hipSuccess) fprintf(stderr, "kernel_launch: launch failed: %s\n", hipGetErrorName(le));
}
```

```cpp
#include <hip/hip_runtime.h>
#include <cstdio>
#include <cstdint>
namespace pg8 {
#define PG8_LAS __attribute__((address_space(3)))
typedef unsigned short bf16_t;
typedef short bf16x8 __attribute__((ext_vector_type(8)));
typedef float f32x4 __attribute__((ext_vector_type(4)));
typedef unsigned u32x4 __attribute__((ext_vector_type(4)));
constexpr int BM = 256, BK = 64, HALF = 128, HTB = HALF * BK * 2  , STAGE_BYTES = 8 * HTB, NXCD = 8, WGM = 8;

__host__ __device__ __forceinline__ int lds_byte(int r, int c) { const int st = (r >> 4) * 2 + (c >> 5), rr = r & 15, cc = c & 31, ob = rr * 64 + cc * 2; return st * 1024 + (ob ^ (((ob >> 9) & 1) << 5)); }
__host__ __device__ __forceinline__ void stage_rc(int b, int& R, int& C) { const int st = b / 1024, sb = b % 1024, swz = sb ^ (((sb >> 9) & 1) << 5); R = (st >> 1) * 16 + swz / 64; C = (st & 1) * 32 + (swz % 64) / 2; }
__host__ __device__ __forceinline__ int perm32(int rho) { const int n = rho >> 4, i = rho & 15; return 8 * (i >> 2) + 4 * n + (i & 3); }

struct Unit { int pm, pn; };
struct Gemm { const bf16_t* A; const bf16_t* Bt; int K, lda, ldb; };

struct StaticOrder {
    int nM, nN, nwg, G, c;
    __host__ __device__ void init(int M, int N, int G_, int c_) { nM = M / BM; nN = N / BM; nwg = nM * nN; G = G_; c = c_; }
    __host__ __device__ bool next(int i, Unit& u) const {
        const long L = (long)i * G + c; if (L >= nwg) return false;
        int wgid = (int)L; { const int q = nwg / NXCD, r = nwg % NXCD, xcd = wgid % NXCD, off = wgid / NXCD; wgid = (xcd < r ? xcd * (q + 1) : r * (q + 1) + (xcd - r) * q) + off; }
        const int nig = WGM * nN, gid = wgid / nig, fm = gid * WGM, gsz = (nM - fm) < WGM ? (nM - fm) : WGM;
        u.pm = fm + ((wgid % nig) % gsz); u.pn = (wgid % nig) / gsz; return true;
    }
    __device__ __forceinline__ void a_ready(const Unit&) const {}
    __device__ __forceinline__ void done(const Unit&) const {}
};

template <class Epi, class Sched, bool ALIGN_EPI = false, bool SP2 = false>
__device__ __forceinline__ void gemm_phase(PG8_LAS unsigned char* lds, const Gemm g, const Sched& S, const Epi& E, const int tid) {
    const int wid = __builtin_amdgcn_readfirstlane(tid >> 6), lane = tid & 63, wr = wid >> 2, wc = wid & 3, fr = lane & 15, fq = lane >> 4;
    const int K = g.K, nt = K / BK;
    unsigned voffA[2], voffB[2];
#pragma unroll
    for (int i = 0; i < 2; ++i) { int R, C; stage_rc(tid * 16 + i * 8192, R, C); const int Rb = Epi::PERM ? ((R & ~31) + perm32(R & 31)) : R;
        voffA[i] = (unsigned)(R * g.lda + C) * 2u; voffB[i] = (unsigned)(Rb * g.ldb + C) * 2u; }
    const size_t kstep = (size_t)(BK * 2);
    const size_t hstepA = (size_t)HALF * g.lda * 2, hstepB = (size_t)HALF * g.ldb * 2;
    const size_t tstepA = 2 * hstepA, tstepB = 2 * hstepB;
    const unsigned ldsw = (unsigned)wid * 1024u;
    const int aoff = lds_byte(wr * 64 + fr, fq * 8), boff = lds_byte(wc * 32 + fr, fq * 8);
#define PG8_SA(b, h) (((b) * 2 + (h)) * HTB)
#define PG8_SB(b, h) ((4 + (b) * 2 + (h)) * HTB)
#define PG8_STAGE(bufoff, gbase, voff) do { _Pragma("unroll") for (int _i = 0; _i < 2; ++_i) \
        __builtin_amdgcn_global_load_lds((const unsigned*)((const char*)(gbase) + (voff)[_i]), (PG8_LAS unsigned*)(lds + (bufoff) + ldsw + _i * 8192), 16, 0, 0); } while (0)
#define PG8_LDA(dst, b, h) do { _Pragma("unroll") for (int m = 0; m < 4; ++m) _Pragma("unroll") for (int k = 0; k < 2; ++k) dst[m][k] = *(const PG8_LAS bf16x8*)(lds + PG8_SA(b, h) + aoff + m * 2048 + k * 1024); } while (0)
#define PG8_LDB(dst, b, h) do { _Pragma("unroll") for (int n = 0; n < 2; ++n) _Pragma("unroll") for (int k = 0; k < 2; ++k) dst[n][k] = *(const PG8_LAS bf16x8*)(lds + PG8_SB(b, h) + boff + n * 2048 + k * 1024); } while (0)
#define PG8_MMA(ai, bj, At, Bt) do { __builtin_amdgcn_s_setprio(1); _Pragma("unroll") for (int m = 0; m < 4; ++m) _Pragma("unroll") for (int n = 0; n < 2; ++n) _Pragma("unroll") for (int k = 0; k < 2; ++k) \
        acc[ai][bj][m][n] = __builtin_amdgcn_mfma_f32_16x16x32_bf16(Bt[n][k], At[m][k], acc[ai][bj][m][n], 0, 0, 0); __builtin_amdgcn_s_setprio(0); } while (0)
#define PG8_WAIT_V(n) asm volatile("s_waitcnt vmcnt(" #n ")" ::: "memory")
#define PG8_WAIT_L(n) asm volatile("s_waitcnt lgkmcnt(" #n ")" ::: "memory")
#define PG8_BAR __builtin_amdgcn_s_barrier()
#define PG8_SCHED __builtin_amdgcn_sched_barrier(0)
    Unit cur, nxt; int ui = 0;
    if (!S.next(0, cur)) return;
    f32x4 acc[2][2][4][2];
#pragma unroll
    for (int a = 0; a < 2; ++a)
#pragma unroll
        for (int b = 0; b < 2; ++b)
#pragma unroll
            for (int m = 0; m < 4; ++m)
#pragma unroll
                for (int n = 0; n < 2; ++n) acc[a][b][m][n] = (f32x4){0.f, 0.f, 0.f, 0.f};
    bf16x8 At[4][2], B0[2][2], B1[2][2];
    const char* cA = (const char*)g.A + (size_t)cur.pm * tstepA; const char* cB = (const char*)g.Bt + (size_t)cur.pn * tstepB;
    S.a_ready(cur);
    if constexpr (SP2) {
        PG8_STAGE(PG8_SB(0, 0), cB, voffB); PG8_STAGE(PG8_SB(0, 1), cB + hstepB, voffB); PG8_STAGE(PG8_SA(0, 0), cA, voffA); PG8_STAGE(PG8_SA(0, 1), cA + hstepA, voffA);
        if (wr == 1) PG8_BAR;
        PG8_WAIT_V(2); PG8_BAR;
        PG8_STAGE(PG8_SB(1, 0), cB + kstep, voffB); PG8_STAGE(PG8_SA(1, 0), cA + kstep, voffA); PG8_STAGE(PG8_SB(1, 1), cB + hstepB + kstep, voffB);
        PG8_WAIT_V(6); PG8_BAR;
    } else {
        PG8_STAGE(PG8_SB(0, 0), cB, voffB); PG8_STAGE(PG8_SA(0, 0), cA, voffA); PG8_STAGE(PG8_SB(0, 1), cB + hstepB, voffB); PG8_STAGE(PG8_SA(0, 1), cA + hstepA, voffA);
        if (wr == 1) PG8_BAR;
        PG8_WAIT_V(4); PG8_BAR;
        PG8_STAGE(PG8_SB(1, 0), cB + kstep, voffB); PG8_STAGE(PG8_SA(1, 0), cA + kstep, voffA); PG8_STAGE(PG8_SB(1, 1), cB + hstepB + kstep, voffB);
        PG8_WAIT_V(6); PG8_BAR;
    }
    for (;;) {
        const bool has_next = S.next(ui + 1, nxt);
        const char* nA = has_next ? (const char*)g.A + (size_t)nxt.pm * tstepA : cA; const char* nB = has_next ? (const char*)g.Bt + (size_t)nxt.pn * tstepB : cB;
        for (int t = 0; t < nt; t += 2) {
            const bool last = (t == nt - 2);
            const char* a1 = cA + (size_t)(t + 1) * kstep;
            const char* a2 = last ? nA : cA + (size_t)(t + 2) * kstep; const char* b2 = last ? nB : cB + (size_t)(t + 2) * kstep;
            const char* a3 = a2 + kstep; const char* b3 = b2 + kstep;
            if (last && has_next) S.a_ready(nxt);
            if constexpr (SP2) {
            PG8_LDB(B0, 0, 0); PG8_LDB(B1, 0, 1); PG8_SCHED; PG8_LDA(At, 0, 0); PG8_STAGE(PG8_SA(1, 1), a1 + hstepA, voffA);
            PG8_WAIT_V(8); PG8_WAIT_L(0); PG8_BAR; PG8_MMA(0, 0, At, B0); PG8_MMA(0, 1, At, B1); PG8_BAR; PG8_SCHED;
            PG8_LDA(At, 0, 1); PG8_STAGE(PG8_SB(0, 0), b2, voffB); PG8_STAGE(PG8_SB(0, 1), b2 + hstepB, voffB); PG8_STAGE(PG8_SA(0, 0), a2, voffA);
            PG8_WAIT_V(8); PG8_WAIT_L(0); PG8_BAR; PG8_MMA(1, 0, At, B0); PG8_MMA(1, 1, At, B1); PG8_BAR; PG8_SCHED;
            PG8_LDB(B0, 1, 0); PG8_LDB(B1, 1, 1); PG8_SCHED; PG8_LDA(At, 1, 0); PG8_STAGE(PG8_SA(0, 1), a2 + hstepA, voffA);
            PG8_WAIT_V(8); PG8_WAIT_L(0); PG8_BAR; PG8_MMA(0, 0, At, B0); PG8_MMA(0, 1, At, B1); PG8_BAR; PG8_SCHED;
            PG8_LDA(At, 1, 1); PG8_STAGE(PG8_SB(1, 0), b3, voffB); PG8_STAGE(PG8_SB(1, 1), b3 + hstepB, voffB); PG8_STAGE(PG8_SA(1, 0), a3, voffA);
            PG8_WAIT_V(8); PG8_WAIT_L(0); PG8_BAR; PG8_MMA(1, 0, At, B0); PG8_MMA(1, 1, At, B1); PG8_BAR; PG8_SCHED;
            } else {
            PG8_LDB(B0, 0, 0); PG8_SCHED; PG8_LDA(At, 0, 0); PG8_STAGE(PG8_SA(1, 1), a1 + hstepA, voffA);
            PG8_WAIT_L(8); PG8_BAR; PG8_WAIT_L(0); PG8_MMA(0, 0, At, B0); PG8_BAR; PG8_SCHED;
            PG8_LDB(B1, 0, 1); PG8_STAGE(PG8_SB(0, 0), b2, voffB);
            PG8_BAR; PG8_WAIT_L(0); PG8_MMA(0, 1, At, B1); PG8_BAR;
            PG8_LDA(At, 0, 1); PG8_STAGE(PG8_SA(0, 0), a2, voffA);
            PG8_BAR; PG8_WAIT_L(0); PG8_MMA(1, 0, At, B0); PG8_BAR; PG8_SCHED;
            PG8_STAGE(PG8_SB(0, 1), b2 + hstepB, voffB);
            PG8_WAIT_V(6); PG8_BAR; PG8_MMA(1, 1, At, B1); PG8_BAR;
            PG8_LDB(B0, 1, 0); PG8_SCHED; PG8_LDA(At, 1, 0); PG8_STAGE(PG8_SA(0, 1), a2 + hstepA, voffA);
            PG8_WAIT_L(8); PG8_BAR; PG8_WAIT_L(0); PG8_MMA(0, 0, At, B0); PG8_BAR; PG8_SCHED;
            PG8_LDB(B1, 1, 1); PG8_STAGE(PG8_SB(1, 0), b3, voffB);
            PG8_BAR; PG8_WAIT_L(0); PG8_MMA(0, 1, At, B1); PG8_BAR;
            PG8_LDA(At, 1, 1); PG8_STAGE(PG8_SA(1, 0), a3, voffA);
            PG8_BAR; PG8_WAIT_L(0); PG8_MMA(1, 0, At, B0); PG8_BAR; PG8_SCHED;
            PG8_STAGE(PG8_SB(1, 1), b3 + hstepB, voffB);
            PG8_WAIT_V(6); PG8_BAR; PG8_MMA(1, 1, At, B1); PG8_BAR;
            }
        }
        if constexpr (ALIGN_EPI) { if (wr == 0) PG8_BAR; }
        if constexpr (!Epi::AFTER_DRAIN) { E(acc, cur, wr, wc, fr, fq); S.done(cur); }
        if (!has_next) break;
#pragma unroll
        for (int a = 0; a < 2; ++a)
#pragma unroll
            for (int b = 0; b < 2; ++b)
#pragma unroll
                for (int m = 0; m < 4; ++m)
#pragma unroll
                    for (int n = 0; n < 2; ++n) acc[a][b][m][n] = (f32x4){0.f, 0.f, 0.f, 0.f};
        cur = nxt; cA = nA; cB = nB; ++ui;
        if constexpr (ALIGN_EPI) { if (wr == 1) PG8_BAR; }
    }
    PG8_WAIT_V(0);
    if constexpr (!ALIGN_EPI) { if (wr == 0) PG8_BAR; }
    PG8_BAR;
    if constexpr (Epi::AFTER_DRAIN) { E.fused(acc, cur, wr, wc, fr, fq, lds, wid, lane); S.done(cur); }
#undef PG8_SA
#undef PG8_SB
#undef PG8_STAGE
#undef PG8_LDA
#undef PG8_LDB
#undef PG8_MMA
#undef PG8_WAIT_V
#undef PG8_WAIT_L
#undef PG8_BAR
#undef PG8_SCHED
}
}

#ifndef REP_MASK
#define REP_MASK 0
#endif

constexpr int D = 1024, BATCH = 2, SEQ = 8192, DEPTH = 2, DB = 128, DS = 4, PAST = 2048, PAGE = 128, NPG = 16, NPHYS = 2560;
constexpr int MP = BATCH * SEQ, MS = DB * DS, M = MP + MS;
constexpr int NINP = 3584, FF = 4096, NCOND = BATCH + DB;
constexpr int NH = 4, HD = 128;
constexpr int LCH = 256, NCH = SEQ / LCH, NUNIT = BATCH * NH * NCH;
constexpr int NCB = 17408;
constexpr int XCP = NCB * 16;
constexpr float ALPHA = 1.4142135623730951f;
constexpr float LN_EPS = 1e-5f;
constexpr size_t O_YP = 0, O_YS = O_YP + (size_t)MP * D, O_CMPP = O_YS + (size_t)MS * D, O_CMPS = O_CMPP + (size_t)DEPTH * MP * 256, O_SLCP = O_CMPS + (size_t)DEPTH * MS * 256,
                 O_SLCS = O_SLCP + (size_t)DEPTH * MP * 256, O_WINP = O_SLCS + (size_t)DEPTH * MS * 256, O_WINS = O_WINP + (size_t)DEPTH * BATCH * 512 * 256,
                 O_CP = O_WINS + (size_t)DEPTH * DB * 512 * 256, O_CS = O_CP + (size_t)DEPTH * BATCH * NH * HD * HD, O_NP = O_CS + (size_t)DEPTH * DB * NH * HD * HD,
                 O_NS = O_NP + (size_t)DEPTH * BATCH * NH * HD, O_MP = O_NS + (size_t)DEPTH * DB * NH * HD, O_MS = O_MP + (size_t)DEPTH * BATCH * NH, O_END = O_MS + (size_t)DEPTH * DB * NH;

constexpr size_t al1m(size_t x) { return (x + 0xFFFFFull) & ~(size_t)0xFFFFFull; }
constexpr size_t WS_CTL = 0, CTL_ZERO_BYTES = 1u << 20;
constexpr size_t WS_WIN  = CTL_ZERO_BYTES;
constexpr size_t WS_WOUT = WS_WIN  + al1m((size_t)DEPTH * NINP * D * 2);
constexpr size_t WS_WUP  = WS_WOUT + al1m((size_t)DEPTH * D * D * 2);
constexpr size_t WS_WDN  = WS_WUP  + al1m((size_t)DEPTH * FF * D * 2);
constexpr size_t WS_W1   = WS_WDN  + al1m((size_t)DEPTH * D * FF * 2);
constexpr size_t WS_ADA  = WS_W1   + al1m((size_t)DEPTH * 2 * 256 * 2048 * 2);
constexpr size_t WS_B1   = WS_ADA  + al1m((size_t)DEPTH * NCOND * 6144 * 4);
constexpr size_t WS_BT   = WS_B1   + al1m(4096);
constexpr size_t WS_X    = WS_BT   + al1m(8 * 132 * 4);
constexpr size_t WS_Z    = WS_X    + al1m((size_t)M * D * 4);
constexpr size_t WS_U    = WS_Z    + al1m((size_t)M * D * 4);
constexpr size_t WS_QKVO = WS_U    + al1m((size_t)M * D * 2);
constexpr size_t WS_NQ   = WS_QKVO + al1m((size_t)M * 2048 * 2);
constexpr size_t WS_GATE = WS_NQ   + al1m((size_t)M * 512 * 2);
constexpr size_t WS_KVR  = WS_GATE + al1m((size_t)M * 32 * 4);
constexpr size_t WS_XC   = WS_KVR  + al1m((size_t)3 * M * 256 * 4);
constexpr size_t WS_HID  = WS_XC   + al1m((size_t)DEPTH * 4 * XCP * 64 * 2 + 4096);
constexpr size_t WS_CKV  = WS_HID  + al1m((size_t)DEPTH * 4 * NCB * 256 * 2);
constexpr size_t WS_KS   = WS_CKV  + al1m((size_t)DEPTH * 4 * NCB * 64 * 4);
constexpr size_t WS_VTS  = WS_KS   + al1m((size_t)DEPTH * 2 * (MP + DB * 2112) * 64 * 2 + 65536);
constexpr size_t WS_KW   = WS_VTS  + al1m((size_t)DEPTH * 2 * (MP + DB * 2112) * 64 * 2 + 65536);
constexpr size_t WS_VTW  = WS_KW   + al1m((size_t)DEPTH * 2 * (MP + DB * 576 + 64) * 64 * 2 + 65536);
constexpr size_t WS_KC   = WS_VTW  + al1m((size_t)DEPTH * 2 * (MP + DB * 576 + 64) * 64 * 2 + 65536);
constexpr size_t WS_VCT  = WS_KC   + al1m((size_t)DEPTH * 2 * NCB * 64 * 2 + 65536);
constexpr size_t WS_W2T  = WS_VCT  + al1m((size_t)DEPTH * 2 * NCB * 64 * 2 + 65536);
constexpr size_t WS_MIX  = WS_W2T  + al1m(65536);
constexpr size_t WS_H    = WS_MIX  + al1m((size_t)M * D * 2);
constexpr size_t WS_DCT  = WS_H    + al1m((size_t)M * FF * 2);
constexpr size_t WS_DN   = WS_DCT  + al1m((size_t)NUNIT * HD * HD * 4);
constexpr size_t WS_CHS  = WS_DN   + al1m((size_t)NUNIT * HD * 4);
constexpr size_t WS_CTP  = WS_CHS  + al1m((size_t)NUNIT * 4 * 4);
constexpr size_t WS_NPV  = WS_CTP  + al1m((size_t)NUNIT * HD * HD * 2);
constexpr size_t WS_WSC  = WS_NPV  + al1m((size_t)NUNIT * HD * 4);
constexpr size_t WS_HRAW = WS_WSC  + al1m((size_t)NUNIT * LCH * LCH * 4);
constexpr size_t WS_END  = WS_HRAW + al1m((size_t)NUNIT * LCH * HD * 4);

constexpr int CW_BAR = 4096;

constexpr int RING_BYTES = 131072, LDSCTL_OFF = RING_BYTES, MISC_OFF = LDSCTL_OFF + 320, LDS_BYTES = 147456;
constexpr int NWAVES = 8, NTHR = NWAVES * 64;

#define GAS __attribute__((address_space(1)))
#define LAS __attribute__((address_space(3)))
typedef unsigned short bf16;
typedef unsigned v4u __attribute__((ext_vector_type(4)));
typedef unsigned v2u __attribute__((ext_vector_type(2)));
typedef float f32x4 __attribute__((ext_vector_type(4)));
typedef float f32x2 __attribute__((ext_vector_type(2)));

__device__ __forceinline__ unsigned f2bf(float f) { unsigned u = __builtin_bit_cast(unsigned, f); return (u + 0x7fffu + ((u >> 16) & 1u)) >> 16; }
__device__ __forceinline__ unsigned pk2(float lo, float hi) { unsigned r; asm("v_cvt_pk_bf16_f32 %0, %1, %2" : "=v"(r) : "v"(lo), "v"(hi)); return r; }
__device__ __forceinline__ float bflo(unsigned u) { return __builtin_bit_cast(float, u << 16); }
__device__ __forceinline__ float bfhi(unsigned u) { return __builtin_bit_cast(float, u & 0xffff0000u); }
__device__ __forceinline__ float bf2f(bf16 h) { return __builtin_bit_cast(float, (unsigned)h << 16); }
__device__ __forceinline__ float sigmoidf_(float x) { return 1.f / (1.f + __expf(-x)); }
__device__ __forceinline__ float wave_sum(float v) {
#pragma unroll
    for (int o = 1; o < 64; o <<= 1) v += __shfl_xor(v, o);
    return v;
}
__device__ __forceinline__ float wave_max(float v) {
#pragma unroll
    for (int o = 1; o < 64; o <<= 1) v = fmaxf(v, __shfl_xor(v, o));
    return v;
}

#define XB_TMO      128
#define XB_XCNT(j)  (256  + 64 * (j))
#define XB_XSUB(j)  (1280 + 64 * (j))
#define XB_XGEN(j)  (2304 + 64 * (j))
#define XB_TOP      3328
#define XB_TOPGEN   3392
#define XCD_BAR_WORDS 3456
#define XB_SPIN_CAP (1u << 18)

__device__ __forceinline__ unsigned xb_ld(unsigned* p)              { return __hip_atomic_load(p, __ATOMIC_RELAXED, __HIP_MEMORY_SCOPE_AGENT); }
__device__ __forceinline__ unsigned xb_add(unsigned* p, unsigned v) { return __hip_atomic_fetch_add(p, v, __ATOMIC_RELAXED, __HIP_MEMORY_SCOPE_AGENT); }
__device__ __forceinline__ unsigned xb_xcc_id() { return (unsigned)__builtin_amdgcn_s_getreg((3 << 11) | 20) & 0xFu; }
#define XB_SPIN(cond, bar) do { unsigned _sp = 0; while (cond) { __builtin_amdgcn_s_sleep(1); \
    if ((++_sp & 255u) == 0u) { if (xb_ld(&(bar)[XB_TMO])) break; if (_sp > XB_SPIN_CAP) { atomicAdd(&(bar)[XB_TMO], 1u); break; } } } } while (0)

struct XcdBarrier {
    unsigned* bar; unsigned x;
    volatile LAS unsigned* st;
};

__device__ __forceinline__ XcdBarrier xcd_barrier_post(unsigned* bar, volatile LAS unsigned* st) {
    XcdBarrier b; b.bar = bar; b.x = xb_xcc_id(); b.st = st;
    if (threadIdx.x == 0) (void)xb_add(&bar[XB_XCNT(b.x)], 1u);
    return b;
}
__device__ __forceinline__ void xcd_barrier_complete(unsigned* bar, unsigned x, unsigned& nloc, unsigned& nx) {
    const unsigned G = gridDim.x * gridDim.y * gridDim.z;
    unsigned sum, cnt, mine, sp = 0u;
    for (;;) {
        sum = 0u; cnt = 0u; mine = 0u;
#pragma unroll
        for (unsigned j = 0; j < 16; ++j) { const unsigned c = xb_ld(&bar[XB_XCNT(j)]); sum += c; cnt += (c > 0u) ? 1u : 0u; mine = (j == x) ? c : mine; }
        if (sum == G) break;
        __builtin_amdgcn_s_sleep(1);
        if ((++sp & 255u) == 0u) { if (xb_ld(&bar[XB_TMO])) break; if (sp > XB_SPIN_CAP) { atomicAdd(&bar[XB_TMO], 1u); break; } }
    }
    nloc = mine > 0u ? mine : 1u; nx = cnt > 0u ? cnt : 1u;
}

__device__ __forceinline__ void xcd_barrier(const XcdBarrier& b) {
    asm volatile("s_waitcnt vmcnt(0)" ::: "memory");
    __syncthreads();
    if (threadIdx.x == 0) {
        unsigned* bar = b.bar;
        __builtin_amdgcn_s_waitcnt(0);
        unsigned nloc = b.st[0], nx = b.st[1];
        if (nloc == 0u) { xcd_barrier_complete(bar, b.x, nloc, nx); b.st[0] = nloc; b.st[1] = nx; }
        const unsigned old = xb_add(&bar[XB_XSUB(b.x)], 1u);
        const unsigned gen = old / nloc;
        if (old + 1u == (gen + 1u) * nloc) {
            __builtin_amdgcn_fence(__ATOMIC_RELEASE, "agent");
            asm volatile("s_waitcnt vmcnt(0)" ::: "memory");
            const unsigned og = xb_add(&bar[XB_TOP], 1u);
            const unsigned tg = og / nx;
            if (og + 1u == (tg + 1u) * nx) xb_add(&bar[XB_TOPGEN], 1u);
            else XB_SPIN(xb_ld(&bar[XB_TOPGEN]) == tg, bar);
            __builtin_amdgcn_fence(__ATOMIC_ACQUIRE, "agent");
            xb_add(&bar[XB_XGEN(b.x)], 1u);
            asm volatile("s_waitcnt vmcnt(0)" ::: "memory");
        } else {
            XB_SPIN(xb_ld(&bar[XB_XGEN(b.x)]) == gen, bar);
            __builtin_amdgcn_fence(__ATOMIC_ACQUIRE, "agent");
            asm volatile("s_waitcnt vmcnt(0)" ::: "memory");
        }
    }
    __syncthreads();
}

struct Args {
    const float* x_prompt; const float* x_sample; const float* cache_cmp; const float* cache_slc; const float* cache_win;
    const float* st_C; const float* st_n; const float* st_m; const int* page_table; const float* c_prompt; const float* c_sample;
    const float* w_ada; const float* b_ada; const float* w_in; const float* b_gate; const float* ml_norm_g; const float* cmp_pe;
    const float* cmp_w1; const float* cmp_w2; const float* rel_bias; const float* w_out; const float* ln_g; const float* ln_b;
    const float* w_up; const float* w_down;
    float* out; unsigned char* ws; int ph_lo, ph_hi, bar_region, pad_;
};
static_assert(sizeof(Args) == 27 * 8 + 16, "Args has no padding");
typedef const __attribute__((address_space(4))) Args CArgs;

__device__ __forceinline__ int cond_of_row(int r) { return r < MP ? (r >> 13) : BATCH + ((r - MP) >> 2); }

struct EpiInProj {
    static constexpr bool PERM = true, AFTER_DRAIN = false;
    bf16* QKVO; bf16* NQ; float* GATE; float* KVR; bf16* XC; float* out; int l;
    __device__ __forceinline__ void operator()(const f32x4 (&acc)[2][2][4][2], const pg8::Unit& u, int wr, int wc, int fr, int fq) const {
        const int row0 = u.pm * 256 + wr * 64 + fr, pn = u.pn, col8 = wc * 32 + 8 * fq;
#pragma unroll
        for (int ai = 0; ai < 2; ++ai)
#pragma unroll
            for (int m = 0; m < 4; ++m) {
                const int r = row0 + ai * 128 + m * 16;
#pragma unroll
                for (int bj = 0; bj < 2; ++bj) {
                    const f32x4 v0 = acc[ai][bj][m][0], v1 = acc[ai][bj][m][1];
                    const int cc = bj * 128 + col8;
                    if (pn < 10) {
                        v4u w; w.x = pk2(v0[0], v0[1]); w.y = pk2(v0[2], v0[3]); w.z = pk2(v1[0], v1[1]); w.w = pk2(v1[2], v1[3]);
                        if (pn < 8) *(v4u*)(QKVO + (size_t)r * 2048 + pn * 256 + cc) = w;
                        else        *(v4u*)(NQ + (size_t)r * 512 + (pn - 8) * 256 + cc) = w;
                    } else if (pn < 13) {
                        const int kind = pn - 10;
                        float* kr = KVR + ((size_t)kind * M + r) * 256 + cc;
                        *(f32x4*)kr = v0; *(f32x4*)(kr + 4) = v1;
                        float* o = nullptr;
                        if (r < MP) {
                            if (kind < 2) o = out + (kind == 0 ? O_CMPP : O_SLCP) + ((size_t)l * MP + r) * 256 + cc;
                            else { const int t = r & (SEQ - 1); if (t >= SEQ - 512) o = out + O_WINP + (((size_t)l * BATCH + (r >> 13)) * 512 + (t - (SEQ - 512))) * 256 + cc; }
                        } else {
                            const int rs = r - MP;
                            if (kind < 2) o = out + (kind == 0 ? O_CMPS : O_SLCS) + ((size_t)l * MS + rs) * 256 + cc;
                            else o = out + O_WINS + (((size_t)l * DB + (rs >> 2)) * 512 + 508 + (rs & 3)) * 256 + cc;
                        }
                        if (o) { *(f32x4*)o = v0; *(f32x4*)(o + 4) = v1; }
                        if (kind == 0 && r < MP) {
                            v4u w; w.x = pk2(v0[0], v0[1]); w.y = pk2(v0[2], v0[3]); w.z = pk2(v1[0], v1[1]); w.w = pk2(v1[2], v1[3]);
                            *(v4u*)(XC + ((size_t)(bj * 2 + (wc >> 1)) * XCP + r) * 64 + (wc & 1) * 32 + 8 * fq) = w;
                        }
                    } else {
                        if (bj == 0 && wc == 0) { float* gp = GATE + (size_t)r * 32 + 8 * fq; *(f32x4*)gp = v0; *(f32x4*)(gp + 4) = v1; }
                    }
                }
            }
    }
};

struct EpiResid {
    static constexpr bool PERM = true, AFTER_DRAIN = false;
    const float* xa; const float* xb; const float* gate; bf16* Z;
    __device__ __forceinline__ void operator()(const f32x4 (&acc)[2][2][4][2], const pg8::Unit& u, int wr, int wc, int fr, int fq) const {
        const int row0 = u.pm * 256 + wr * 64 + fr, col0 = u.pn * 256 + wc * 32 + 8 * fq;
#pragma unroll
        for (int ai = 0; ai < 2; ++ai)
#pragma unroll
            for (int m = 0; m < 4; ++m) {
                const int r = row0 + ai * 128 + m * 16;
                const float* xr = (r < MP ? xa + (size_t)r * D : xb + (size_t)(r - MP) * D) + col0;
                const float* gr = gate + (size_t)cond_of_row(r) * 6144 + col0;
                bf16* zr = Z + (size_t)r * D + col0;
#pragma unroll
                for (int bj = 0; bj < 2; ++bj) {
                    const f32x4 x0 = *(const f32x4*)(xr + bj * 128), x1 = *(const f32x4*)(xr + bj * 128 + 4);
                    const f32x4 g0 = *(const f32x4*)(gr + bj * 128), g1 = *(const f32x4*)(gr + bj * 128 + 4);
                    const f32x4 z0 = x0 * ALPHA + g0 * acc[ai][bj][m][0], z1 = x1 * ALPHA + g1 * acc[ai][bj][m][1];
                    v4u w; w.x = pk2(z0[0], z0[1]); w.y = pk2(z0[2], z0[3]); w.z = pk2(z1[0], z1[1]); w.w = pk2(z1[2], z1[3]);
                    *(v4u*)(zr + bj * 128) = w;
                }
            }
    }
};

struct EpiRelu2 {
    static constexpr bool PERM = true, AFTER_DRAIN = false;
    bf16* H;
    __device__ __forceinline__ void operator()(const f32x4 (&acc)[2][2][4][2], const pg8::Unit& u, int wr, int wc, int fr, int fq) const {
        const int row0 = u.pm * 256 + wr * 64 + fr, col0 = u.pn * 256 + wc * 32 + 8 * fq;
#pragma unroll
        for (int ai = 0; ai < 2; ++ai)
#pragma unroll
            for (int m = 0; m < 4; ++m) {
                bf16* hr = H + (size_t)(row0 + ai * 128 + m * 16) * FF + col0;
#pragma unroll
                for (int bj = 0; bj < 2; ++bj) {
                    f32x4 a = acc[ai][bj][m][0], b = acc[ai][bj][m][1];
#pragma unroll
                    for (int i = 0; i < 4; ++i) { a[i] = fmaxf(a[i], 0.f); a[i] *= a[i]; b[i] = fmaxf(b[i], 0.f); b[i] *= b[i]; }
                    v4u w; w.x = pk2(a[0], a[1]); w.y = pk2(a[2], a[3]); w.z = pk2(b[0], b[1]); w.w = pk2(b[2], b[3]);
                    *(v4u*)(hr + bj * 128) = w;
                }
            }
    }
};

__device__ __forceinline__ float gelu_tanh(float x) {
    const float y = 0.7978845608028654f * (x + 0.044715f * x * x * x);
    const float t = 1.f - 2.f / (__expf(2.f * y) + 1.f);
    return 0.5f * x * (1.f + t);
}
struct EpiCmpHid {
    static constexpr bool PERM = true, AFTER_DRAIN = false;
    bf16* HID; const float* B1;
    __device__ __forceinline__ void operator()(const f32x4 (&acc)[2][2][4][2], const pg8::Unit& u, int wr, int wc, int fr, int fq) const {
        const int row0 = u.pm * 256 + wr * 64 + fr, col0 = wc * 32 + 8 * fq;
        const float* bp = B1 + u.pn * 256 + col0;
        f32x4 bv[2][2];
#pragma unroll
        for (int bj = 0; bj < 2; ++bj) { bv[bj][0] = *(const f32x4*)(bp + bj * 128); bv[bj][1] = *(const f32x4*)(bp + bj * 128 + 4); }
#pragma unroll
        for (int ai = 0; ai < 2; ++ai)
#pragma unroll
            for (int m = 0; m < 4; ++m) {
                bf16* hr = HID + (size_t)(row0 + ai * 128 + m * 16) * 256 + col0;
#pragma unroll
                for (int bj = 0; bj < 2; ++bj) {
                    f32x4 a = acc[ai][bj][m][0] + bv[bj][0], b = acc[ai][bj][m][1] + bv[bj][1];
#pragma unroll
                    for (int i = 0; i < 4; ++i) { a[i] = gelu_tanh(a[i]); b[i] = gelu_tanh(b[i]); }
                    v4u w; w.x = pk2(a[0], a[1]); w.y = pk2(a[2], a[3]); w.z = pk2(b[0], b[1]); w.w = pk2(b[2], b[3]);
                    *(v4u*)(hr + bj * 128) = w;
                }
            }
    }
};

struct CmpOrder {
    int G, c, l0, nl, t0, ntile;
    __device__ __forceinline__ bool next(int i, pg8::Unit& u) const {
        const int L = i * G + c; if (L >= nl * 4 * ntile) return false;
        const int blk = L / ntile, tile = L % ntile, l = l0 + (blk >> 2), sg = blk & 3;
        u.pm = (l * 4 + sg) * 68 + t0 + tile; u.pn = l * 2 + (sg >> 1); return true;
    }
    __device__ __forceinline__ void a_ready(const pg8::Unit&) const {}
    __device__ __forceinline__ void done(const pg8::Unit&) const {}
};

typedef short sg_bf16x8 __attribute__((ext_vector_type(8)));
template <class Epi>
__device__ __forceinline__ void small_gemm(const bf16* A, size_t strideA, int lda, const bf16* Bt, size_t strideB, int ldb, int K, int nbatch, int Mrows, int N, const Epi& E, LAS unsigned char* lds, int tid) {
    const int lane = tid & 63, wave = tid >> 6, fr = lane & 15, fq = lane >> 4;
    const int ntn = N / 64, ntm = Mrows / 32, ntask = nbatch * ntm * ntn, kw = K / 8;
    LAS f32x4* red = (LAS f32x4*)lds;
    for (int task = blockIdx.x; task < ntask; task += gridDim.x) {
        const int batch = task / (ntm * ntn), tr = task % (ntm * ntn), tm = tr / ntn, tn = tr % ntn;
        const bf16* ap = A + (size_t)batch * strideA + (size_t)(tm * 32 + fr) * lda + wave * kw + 8 * fq;
        const bf16* bp = Bt + (size_t)E.bsel(batch) * strideB + (size_t)(tn * 64 + fr) * ldb + wave * kw + 8 * fq;
        f32x4 acc[2][4];
#pragma unroll
        for (int i = 0; i < 2; ++i)
#pragma unroll
            for (int j = 0; j < 4; ++j) acc[i][j] = (f32x4){0.f, 0.f, 0.f, 0.f};
#pragma unroll 4
        for (int k = 0; k < kw; k += 32) {
            sg_bf16x8 af[2], bf[4];
#pragma unroll
            for (int i = 0; i < 2; ++i) af[i] = *(const sg_bf16x8*)(ap + (size_t)i * 16 * lda + k);
#pragma unroll
            for (int j = 0; j < 4; ++j) bf[j] = *(const sg_bf16x8*)(bp + (size_t)j * 16 * ldb + k);
#pragma unroll
            for (int i = 0; i < 2; ++i)
#pragma unroll
                for (int j = 0; j < 4; ++j) acc[i][j] = __builtin_amdgcn_mfma_f32_16x16x32_bf16(bf[j], af[i], acc[i][j], 0, 0, 0);
        }
        __syncthreads();
#pragma unroll
        for (int i = 0; i < 2; ++i)
#pragma unroll
            for (int j = 0; j < 4; ++j) red[(wave * 8 + i * 4 + j) * 64 + lane] = acc[i][j];
        __syncthreads();
        f32x4 sum = red[wave * 64 + lane];
#pragma unroll
        for (int w = 1; w < 8; ++w) sum = sum + red[(w * 8 + wave) * 64 + lane];
        E(batch, tm * 32 + (wave >> 2) * 16 + fr, tn * 64 + (wave & 3) * 16 + 4 * fq, sum);
    }
}
struct SgResid {
    const float* xb; const float* gate; bf16* Z;
    __device__ __forceinline__ int bsel(int) const { return 0; }
    __device__ __forceinline__ void operator()(int, int rl, int c, const f32x4& acc) const {
        const int r = MP + rl;
        const f32x4 x = *(const f32x4*)(xb + (size_t)rl * D + c), gg = *(const f32x4*)(gate + (size_t)cond_of_row(r) * 6144 + c);
        const f32x4 z = x * ALPHA + gg * acc; v2u w; w.x = pk2(z[0], z[1]); w.y = pk2(z[2], z[3]);
        *(v2u*)(Z + (size_t)r * D + c) = w;
    }
};
struct SgRelu2 {
    bf16* H;
    __device__ __forceinline__ int bsel(int) const { return 0; }
    __device__ __forceinline__ void operator()(int, int rl, int c, const f32x4& acc) const {
        f32x4 a = acc;
#pragma unroll
        for (int i = 0; i < 4; ++i) { a[i] = fmaxf(a[i], 0.f); a[i] *= a[i]; }
        v2u w; w.x = pk2(a[0], a[1]); w.y = pk2(a[2], a[3]);
        *(v2u*)(H + (size_t)(MP + rl) * FF + c) = w;
    }
};
struct SgCmpHid {
    bf16* HIDl; const float* B1l;
    __device__ __forceinline__ int bsel(int img) const { return img >> 1; }
    __device__ __forceinline__ void operator()(int img, int R, int c, const f32x4& acc) const {
        const f32x4 bb = *(const f32x4*)(B1l + (img >> 1) * 256 + c);
        f32x4 a = acc + bb;
#pragma unroll
        for (int i = 0; i < 4; ++i) a[i] = gelu_tanh(a[i]);
        v2u w; w.x = pk2(a[0], a[1]); w.y = pk2(a[2], a[3]);
        *(v2u*)(HIDl + ((size_t)img * NCB + R) * 256 + c) = w;
    }
};

#define LDS_WAIT() asm volatile("s_waitcnt lgkmcnt(0)" ::: "memory")
#define VM_WAIT() asm volatile("s_waitcnt vmcnt(0)" ::: "memory")

template <class CM>
__device__ __forceinline__ void transpose_item(const float* W, int ldw, int K, bf16* WT, LAS float* scr, int item, int nblk, int lane, const CM& cm) {
    const int kb = item / nblk, nb = item % nblk, k0 = 32 * kb, n0 = 64 * nb, c4 = (lane & 15) * 4;
    const int sc = cm.col(n0 + c4); const float scl = cm.scl(n0 + c4);
    f32x4 v[8];
#pragma unroll
    for (int i = 0; i < 8; ++i) { const int kk = 4 * i + (lane >> 4); v[i] = sc >= 0 ? *(const f32x4*)(W + (size_t)(k0 + kk) * ldw + sc) : (f32x4){0.f, 0.f, 0.f, 0.f}; }
#pragma unroll
    for (int i = 0; i < 8; ++i) { const int kk = 4 * i + (lane >> 4); LAS float* p = scr + kk * 65 + c4; p[0] = v[i][0] * scl; p[1] = v[i][1] * scl; p[2] = v[i][2] * scl; p[3] = v[i][3] * scl; }
    LDS_WAIT();
    const LAS float* s = scr + lane;
#pragma unroll
    for (int c = 0; c < 4; ++c) {
        v4u o; o.x = pk2(s[(8 * c + 0) * 65], s[(8 * c + 1) * 65]); o.y = pk2(s[(8 * c + 2) * 65], s[(8 * c + 3) * 65]); o.z = pk2(s[(8 * c + 4) * 65], s[(8 * c + 5) * 65]); o.w = pk2(s[(8 * c + 6) * 65], s[(8 * c + 7) * 65]);
        *(v4u*)(WT + (size_t)(n0 + lane) * K + k0 + 8 * c) = o; }
    LDS_WAIT();
}
struct CmId { __device__ __forceinline__ int col(int n) const { return n; } __device__ __forceinline__ float scl(int) const { return 1.f; } };
struct CmIn {
    __device__ __forceinline__ int col(int n) const { return n < 2048 ? n : (n < 3328 ? n + 8 : (n < 3336 ? n - 1280 : (n < 3360 ? n : -1))); }
    __device__ __forceinline__ float scl(int n) const { return (n >= 512 && n < 1024) ? 0.08838834764831845f : ((n >= 2048 && n < 2560) ? 0.18033688011112042f : 1.f); }
};

__device__ __forceinline__ int rel_bucket_dev(int n) {
    if (n < 16) return n;
    const float nf = (float)n;
    int large = 16 + (int)(__logf(nf / 16.f) / 2.0794415416798357f * 16.f);
    return large < 31 ? large : 31;
}

__device__ __forceinline__ void phase_p0a(CArgs& A, LAS unsigned char* lds, int gw, int NGW, int lane, int wave) {
    unsigned char* ws = A.ws;
    LAS float* scr = (LAS float*)(lds + wave * 16384);
    constexpr int I_IN = 16 * 112, I_OUT = 16 * 32, I_UP = 16 * 128, I_DN = 64 * 32, I_W1 = 32 * 8;
    constexpr int I_L = I_IN + I_OUT + I_UP + I_DN + 2 * I_W1;
    for (int it = gw; it < DEPTH * I_L; it += NGW) {
        const int l = it / I_L; int r = it % I_L;
        if (r < I_IN) { transpose_item(A.w_in + (size_t)l * D * 3360, 3360, D, (bf16*)(ws + WS_WIN) + (size_t)l * NINP * D, scr, r, 56, lane, CmIn{}); continue; } r -= I_IN;
        if (r < I_OUT) { transpose_item(A.w_out + (size_t)l * D * D, D, D, (bf16*)(ws + WS_WOUT) + (size_t)l * D * D, scr, r, 16, lane, CmId{}); continue; } r -= I_OUT;
        if (r < I_UP) { transpose_item(A.w_up + (size_t)l * D * FF, FF, D, (bf16*)(ws + WS_WUP) + (size_t)l * FF * D, scr, r, 64, lane, CmId{}); continue; } r -= I_UP;
        if (r < I_DN) { transpose_item(A.w_down + (size_t)l * FF * D, D, FF, (bf16*)(ws + WS_WDN) + (size_t)l * D * FF, scr, r, 16, lane, CmId{}); continue; } r -= I_DN;
        const int s = r / I_W1; r %= I_W1;
        transpose_item(A.cmp_w1 + (size_t)(l * 2 + s) * 2048 * 256, 256, 2048, (bf16*)(ws + WS_W1) + (size_t)(l * 2 + s) * 256 * 2048, scr, r, 4, lane, CmId{});
    }
    for (int it = gw; it < DEPTH * DB * NPG * 2; it += NGW) {
        const int half = it & 1, pg = (it >> 1) & 15, seq = (it >> 5) & 127, l = it >> 12;
        const int phys = A.page_table[seq * NPG + pg];
        const float* src = A.cache_cmp + (((size_t)l * NPHYS + phys) * PAGE + half * 64) * 256 + 4 * lane;
        const int cc = 4 * lane, s = cc >> 7, g = (cc >> 6) & 1, d = cc & 63;
        bf16* dst = (bf16*)(ws + WS_XC) + ((size_t)((l * 2 + s) * 2 + g) * XCP + MP + seq * PAST + pg * PAGE + half * 64) * 64 + d;
#pragma unroll 16
        for (int sl = 0; sl < 64; ++sl) { const f32x4 v = __builtin_nontemporal_load((const f32x4*)(src + (size_t)sl * 256)); v2u w; w.x = pk2(v[0], v[1]); w.y = pk2(v[2], v[3]); *(v2u*)(dst + (size_t)sl * 64) = w; }
    }
    for (int it = gw; it < 8; it += NGW) {
        float* BT = (float*)(ws + WS_BT) + it * 132;
        for (int dd = lane; dd < 132; dd += 64) BT[dd] = dd <= 128 ? A.rel_bias[rel_bucket_dev(dd) * 8 + it] * 1.4426950408889634f : -INFINITY;
    }
    for (int it = gw; it < DEPTH * 2 * 4 * 16; it += NGW) {
        const int kp = it & 15, hq = (it >> 4) & 3, ls = it >> 6, h = hq * 64 + lane;
        const float* pe = A.cmp_pe + (size_t)ls * 2048 + kp * 128; const float* w1 = A.cmp_w1 + ((size_t)ls * 2048 + kp * 128) * 256 + h;
        float acc = 0.f;
#pragma unroll 16
        for (int k = 0; k < 128; ++k) acc += pe[k] * w1[(size_t)k * 256];
        ((float*)(ws + WS_B1))[2048 + (ls * 16 + kp) * 256 + h] = acc;
    }
    for (int it = gw; it < DEPTH * 2 * 64; it += NGW) {
        const int d = it & 63, ls = it >> 6;
        for (int h = lane; h < 256; h += 64) ((bf16*)(ws + WS_W2T))[((size_t)ls * 64 + d) * 256 + h] = (bf16)f2bf(A.cmp_w2[((size_t)ls * 256 + h) * 64 + d]);
    }
}

__device__ __forceinline__ void b1_reduce(CArgs& A, int tid) {
    for (int i = blockIdx.x * NTHR + tid; i < DEPTH * 2 * 256; i += gridDim.x * NTHR) { const float* p = (const float*)(A.ws + WS_B1) + 2048 + (i >> 8) * 16 * 256 + (i & 255);
        float acc = 0.f;
#pragma unroll
        for (int kp = 0; kp < 16; ++kp) acc += p[kp * 256];
        ((float*)(A.ws + WS_B1))[i] = acc; }
}
__device__ __forceinline__ void phase_ada(CArgs& A, LAS unsigned char* lds, int tid) {
    LAS float* a = (LAS float*)lds;
    for (int task = blockIdx.x; task < DEPTH * 12 * 10; task += gridDim.x) {
        const int rb = task % 10, cb = (task / 10) % 12, l = task / 120;
        __syncthreads();
        for (int i = tid; i < 13 * 1024; i += NTHR) { const int row = rb * 13 + i / 1024, k = i & 1023;
            const float c = row < BATCH ? A.c_prompt[row * D + k] : A.c_sample[(row - BATCH) * D + k]; a[i] = c / (1.f + __expf(-c)); }
        __syncthreads();
        const int j = cb * 512 + tid;
        const float* w = A.w_ada + (size_t)l * D * 6144 + j;
        float acc[13];
#pragma unroll
        for (int r = 0; r < 13; ++r) acc[r] = 0.f;
        for (int k = 0; k < D; k += 4) { const float w0 = w[(size_t)k * 6144], w1 = w[(size_t)(k + 1) * 6144], w2 = w[(size_t)(k + 2) * 6144], w3 = w[(size_t)(k + 3) * 6144];
#pragma unroll
            for (int r = 0; r < 13; ++r) { const f32x4 a4 = *(const LAS f32x4*)(a + r * 1024 + k); acc[r] += (a4[0] * w0 + a4[1] * w1) + (a4[2] * w2 + a4[3] * w3); } }
        const float bb = A.b_ada[l * 6144 + j];
        float* o = (float*)(A.ws + WS_ADA) + ((size_t)l * NCOND + rb * 13) * 6144 + j;
#pragma unroll
        for (int r = 0; r < 13; ++r) o[(size_t)r * 6144] = acc[r] + bb;
    }
}

__device__ __forceinline__ void mod_row(const float* xrow, const float* sh, const float* sc, bf16* urow, int lane) {
#pragma unroll
    for (int j = 0; j < 4; ++j) { const int c = 4 * lane + 256 * j;
        const f32x4 x = *(const f32x4*)(xrow + c), a = *(const f32x4*)(sh + c), b = *(const f32x4*)(sc + c);
        v2u w; w.x = pk2(x[0] * (1.f + b[0]) + a[0], x[1] * (1.f + b[1]) + a[1]); w.y = pk2(x[2] * (1.f + b[2]) + a[2], x[3] * (1.f + b[3]) + a[3]);
        *(v2u*)(urow + c) = w; }
}
__device__ __forceinline__ void ln_row(const bf16* zrow, const float* g, const float* b, float* xout, const float* sh, const float* sc, bf16* urow, int lane) {
    f32x4 v[4]; float s = 0.f;
#pragma unroll
    for (int j = 0; j < 4; ++j) { const v2u z = *(const v2u*)(zrow + 4 * lane + 256 * j); v[j][0] = bflo(z.x); v[j][1] = bfhi(z.x); v[j][2] = bflo(z.y); v[j][3] = bfhi(z.y); s += (v[j][0] + v[j][1]) + (v[j][2] + v[j][3]); }
    const float mean = wave_sum(s) * (1.f / D); float s2 = 0.f;
#pragma unroll
    for (int j = 0; j < 4; ++j) { v[j] = v[j] - mean; s2 += (v[j][0] * v[j][0] + v[j][1] * v[j][1]) + (v[j][2] * v[j][2] + v[j][3] * v[j][3]); }
    const float rstd = 1.f / sqrtf(wave_sum(s2) * (1.f / D) + LN_EPS);
#pragma unroll
    for (int j = 0; j < 4; ++j) { const int c = 4 * lane + 256 * j;
        const f32x4 gg = *(const f32x4*)(g + c), bb = *(const f32x4*)(b + c);
        const f32x4 x = v[j] * rstd * gg + bb;
        *(f32x4*)(xout + c) = x;
        if (urow) { const f32x4 a = *(const f32x4*)(sh + c), q = *(const f32x4*)(sc + c);
            v2u w; w.x = pk2(x[0] * (1.f + q[0]) + a[0], x[1] * (1.f + q[1]) + a[1]); w.y = pk2(x[2] * (1.f + q[2]) + a[2], x[3] * (1.f + q[3]) + a[3]);
            *(v2u*)(urow + c) = w; } }
}

__device__ __forceinline__ float scan_sum256(float v, LAS float* buf, int tid) {
    const int lane = tid & 63, w = tid >> 6;
#pragma unroll
    for (int o = 1; o < 64; o <<= 1) { const float y = __shfl_up(v, o); if (lane >= o) v += y; }
    __syncthreads();
    if (lane == 63) buf[w] = v;
    __syncthreads();
    float add = 0.f;
#pragma unroll
    for (int i = 0; i < 3; ++i) if (i < w) add += buf[i];
    return v + add;
}
__device__ __forceinline__ float scan_max256(float v, LAS float* buf, int tid) {
    const int lane = tid & 63, w = tid >> 6;
#pragma unroll
    for (int o = 1; o < 64; o <<= 1) { const float y = __shfl_up(v, o); if (lane >= o) v = fmaxf(v, y); }
    __syncthreads();
    if (lane == 63) buf[w] = v;
    __syncthreads();
#pragma unroll
    for (int i = 0; i < 3; ++i) if (i < w) v = fmaxf(v, buf[i]);
    return v;
}
__device__ __forceinline__ void ml_gates(CArgs& A, int l, int r, int h, float& ig, float& lf) {
    const float* G = (const float*)(A.ws + WS_GATE) + (size_t)r * 32;
    ig = G[h] + A.b_gate[l * 8 + h];
    const float fr = G[4 + h] + A.b_gate[l * 8 + 4 + h];
    lf = fminf(fr, 0.f) - log1pf(__expf(-fabsf(fr)));
}

__device__ __forceinline__ void phase_m2(CArgs& A, int l, LAS unsigned char* lds, int tid) {
    LAS float* buf = (LAS float*)lds;
    LAS float* wl = (LAS float*)(lds + 1024);
    const bf16* QKVO = (const bf16*)(A.ws + WS_QKVO);
    for (int unit = blockIdx.x; unit < NUNIT; unit += gridDim.x) {
        const int b = unit >> 7, h = (unit >> 5) & 3, c = unit & 31, r0 = b * SEQ + c * LCH;
        float ig = 0.f, lf = 0.f;
        if (tid < 256) ml_gates(A, l, r0 + tid, h, ig, lf);
        const float F = scan_sum256(lf, buf, tid);
        __syncthreads();
        if (tid == 255) buf[16] = F;
        __syncthreads();
        const float Fend = buf[16];
        const float gl = tid < 256 ? Fend - F + ig : -3.0e38f;
        float mw = wave_max(gl);
        if ((tid & 63) == 0) buf[20 + (tid >> 6)] = mw;
        __syncthreads();
        const float mloc = fmaxf(fmaxf(buf[20], buf[21]), fmaxf(buf[22], buf[23]));
        if (tid < 256) wl[tid] = __expf(gl - mloc);
        if (tid == 0) { float* ch = (float*)(A.ws + WS_CHS) + unit * 4; ch[0] = Fend; ch[1] = mloc; }
        __syncthreads();
        const int k = tid & 127, vq = tid >> 7;
        float acc[32]; float accn = 0.f;
#pragma unroll
        for (int i = 0; i < 32; ++i) acc[i] = 0.f;
        const bf16* kp = QKVO + (size_t)r0 * 2048 + 512 + h * HD + k;
        const bf16* vp = QKVO + (size_t)r0 * 2048 + 1024 + h * HD + 32 * vq;
        for (int s = 0; s < LCH; ++s) {
            const float wk = wl[s] * bf2f(kp[(size_t)s * 2048]);
            accn += wk;
            const v4u* v4 = (const v4u*)(vp + (size_t)s * 2048);
#pragma unroll
            for (int q = 0; q < 4; ++q) { const v4u vv = v4[q];
                acc[8 * q + 0] += wk * bflo(vv.x); acc[8 * q + 1] += wk * bfhi(vv.x); acc[8 * q + 2] += wk * bflo(vv.y); acc[8 * q + 3] += wk * bfhi(vv.y);
                acc[8 * q + 4] += wk * bflo(vv.z); acc[8 * q + 5] += wk * bfhi(vv.z); acc[8 * q + 6] += wk * bflo(vv.w); acc[8 * q + 7] += wk * bfhi(vv.w); }
        }
        float* dct = (float*)(A.ws + WS_DCT) + ((size_t)unit * HD + 32 * vq) * HD + k;
#pragma unroll
        for (int i = 0; i < 32; ++i) dct[(size_t)i * HD] = acc[i];
        if (vq == 0) ((float*)(A.ws + WS_DN))[unit * HD + k] = accn;
        __syncthreads();
    }
}

__device__ __forceinline__ void phase_m3(CArgs& A, int l, int tid) {
    for (int task = blockIdx.x; task < BATCH * NH * 33; task += gridDim.x) {
        const int bh = task / 33, part = task % 33;
        const bool isn = part == 32; if (isn && tid >= HD) continue;
        const int e = isn ? tid : part * 512 + tid;
        const float* chs = (const float*)(A.ws + WS_CHS) + (size_t)bh * NCH * 4;
        float st = 0.f, m0 = 0.f;
        for (int c = 0; c < NCH; ++c) {
            const int unit = bh * NCH + c;
            const float Fend = chs[c * 4], mloc = chs[c * 4 + 1];
            float dv;
            if (isn) { ((float*)(A.ws + WS_NPV))[unit * HD + e] = st; dv = ((const float*)(A.ws + WS_DN))[unit * HD + e]; if (tid == 0) ((float*)(A.ws + WS_CHS))[unit * 4 + 2] = m0; }
            else { ((bf16*)(A.ws + WS_CTP))[(size_t)unit * HD * HD + e] = (bf16)f2bf(st); dv = ((const float*)(A.ws + WS_DCT))[(size_t)unit * HD * HD + e]; }
            const float mend = fmaxf(m0 + Fend, mloc);
            st = __expf(m0 + Fend - mend) * st + __expf(mloc - mend) * dv;
            m0 = mend;
        }
        if (isn) { A.out[O_NP + ((size_t)l * BATCH * NH + bh) * HD + e] = st; if (tid == 0) A.out[O_MP + l * BATCH * NH + bh] = m0; }
        else { const int v = e >> 7, k = e & 127; A.out[O_CP + (((size_t)l * BATCH * NH + bh) * HD + k) * HD + v] = st; }
    }
}

__device__ __forceinline__ void phase_m4(CArgs& A, int l, LAS unsigned char* lds, int tid) {
    LAS float* buf = (LAS float*)lds;
    LAS float* sa = (LAS float*)(lds + 1024);
    LAS float* smx = sa + 256;
    LAS float* sdec = smx + 256;
    LAS float* sem = sdec + 256;
    LAS bf16* sv = (LAS bf16*)(lds + 8192);
    const bf16* QKVO = (const bf16*)(A.ws + WS_QKVO);
    const int lane = tid & 63, wave = tid >> 6;
    for (int unit = blockIdx.x; unit < NUNIT; unit += gridDim.x) {
        const int b = unit >> 7, h = (unit >> 5) & 3, c = unit & 31, r0 = b * SEQ + c * LCH;
        float ig = 0.f, lf = 0.f;
        if (tid < 256) ml_gates(A, l, r0 + tid, h, ig, lf);
        const float F = scan_sum256(lf, buf, tid);
        const float a = tid < 256 ? ig - F : -3.0e38f;
        const float cm = scan_max256(a, buf, tid);
        const float m0 = ((const float*)(A.ws + WS_CHS))[unit * 4 + 2];
        if (tid < 256) { const float mx = fmaxf(m0, cm); sa[tid] = a; smx[tid] = mx; sdec[tid] = __expf(m0 - mx); sem[tid] = __expf(-(F + mx)); }
        for (int i = tid; i < LCH * HD / 8; i += NTHR) { const int s = i >> 4, q = i & 15;
            *(LAS v4u*)(sv + s * HD + 8 * q) = *(const v4u*)(QKVO + (size_t)(r0 + s) * 2048 + 1024 + h * HD + 8 * q); }
        __syncthreads();
        float* W = (float*)(A.ws + WS_WSC) + (size_t)unit * LCH * LCH;
        for (int idx = tid; idx < LCH * LCH; idx += NTHR) {
            const int t = idx >> 8, s = idx & 255; float w = 0.f;
            if (s <= t) {
                const v4u* qp = (const v4u*)(QKVO + (size_t)(r0 + t) * 2048 + h * HD); const v4u* kp = (const v4u*)(QKVO + (size_t)(r0 + s) * 2048 + 512 + h * HD);
                float d = 0.f;
#pragma unroll 4
                for (int q = 0; q < 16; ++q) { const v4u x = qp[q], y = kp[q];
                    d += bflo(x.x) * bflo(y.x) + bfhi(x.x) * bfhi(y.x) + bflo(x.y) * bflo(y.y) + bfhi(x.y) * bfhi(y.y)
                       + bflo(x.z) * bflo(y.z) + bfhi(x.z) * bfhi(y.z) + bflo(x.w) * bflo(y.w) + bfhi(x.w) * bfhi(y.w); }
                w = d * __expf(sa[s] - smx[t]);
            }
            W[idx] = w;
        }
        __syncthreads();
        {
            const int v = tid & 127, tq = tid >> 7;
            const bf16* ctp = (const bf16*)(A.ws + WS_CTP) + ((size_t)unit * HD + v) * HD;
            const float* npv = (const float*)(A.ws + WS_NPV) + unit * HD;
            float* hraw = (float*)(A.ws + WS_HRAW) + (size_t)unit * LCH * HD;
            for (int i = 0; i < 64; ++i) {
                const int t = 4 * i + tq;
                float num = 0.f, den = 0.f;
                const float* wr = W + (size_t)t * LCH;
                for (int s = 0; s <= t; s += 4) { const f32x4 w4 = *(const f32x4*)(wr + s);
                    num += w4[0] * bf2f(sv[(s + 0) * HD + v]) + w4[1] * bf2f(sv[(s + 1) * HD + v]) + w4[2] * bf2f(sv[(s + 2) * HD + v]) + w4[3] * bf2f(sv[(s + 3) * HD + v]);
                    den += (w4[0] + w4[1]) + (w4[2] + w4[3]); }
                float qc = 0.f, qn = 0.f;
                const v4u* qp = (const v4u*)(QKVO + (size_t)(r0 + t) * 2048 + h * HD);
#pragma unroll 4
                for (int q = 0; q < 16; ++q) { const v4u x = qp[q], y = *(const v4u*)(ctp + 8 * q); const f32x4 n0 = *(const f32x4*)(npv + 8 * q), n1 = *(const f32x4*)(npv + 8 * q + 4);
                    qc += bflo(x.x) * bflo(y.x) + bfhi(x.x) * bfhi(y.x) + bflo(x.y) * bflo(y.y) + bfhi(x.y) * bfhi(y.y)
                        + bflo(x.z) * bflo(y.z) + bfhi(x.z) * bfhi(y.z) + bflo(x.w) * bflo(y.w) + bfhi(x.w) * bfhi(y.w);
                    qn += bflo(x.x) * n0[0] + bfhi(x.x) * n0[1] + bflo(x.y) * n0[2] + bfhi(x.y) * n0[3] + bflo(x.z) * n1[0] + bfhi(x.z) * n1[1] + bflo(x.w) * n1[2] + bfhi(x.w) * n1[3]; }
                const float dec = sdec[t];
                const float numt = num + dec * qc, dent = den + dec * qn;
                hraw[(size_t)t * HD + v] = numt / fmaxf(fabsf(dent), sem[t]);
            }
        }
        __syncthreads();
        {
            const float* hraw = (const float*)(A.ws + WS_HRAW) + (size_t)unit * LCH * HD;
            const float g0 = A.ml_norm_g[l * 512 + h * HD + lane], g1 = A.ml_norm_g[l * 512 + h * HD + 64 + lane];
            for (int t = wave; t < LCH; t += NWAVES) {
                const float x0 = hraw[(size_t)t * HD + lane], x1 = hraw[(size_t)t * HD + 64 + lane];
                const float mu = wave_sum(x0 + x1) * (1.f / HD);
                const float d0 = x0 - mu, d1 = x1 - mu;
                const float rstd = 1.f / sqrtf(wave_sum(d0 * d0 + d1 * d1) * (1.f / HD) + LN_EPS);
                const bf16* op = QKVO + (size_t)(r0 + t) * 2048 + 1536 + h * HD;
                bf16* mp = (bf16*)(A.ws + WS_MIX) + (size_t)(r0 + t) * D + h * HD;
                mp[lane] = (bf16)f2bf(d0 * rstd * g0 * sigmoidf_(bf2f(op[lane])));
                mp[64 + lane] = (bf16)f2bf(d1 * rstd * g1 * sigmoidf_(bf2f(op[64 + lane])));
            }
        }
        __syncthreads();
    }
}

__device__ __forceinline__ void phase_mls(CArgs& A, int l, LAS unsigned char* lds, int tid) {
    LAS float* sq = (LAS float*)lds;
    LAS float* sc = sq + 1536;
    LAS float* sw = sc + 64;
    LAS float* part = sw + 16;
    LAS float* red = part + 2048;
    const bf16* QKVO = (const bf16*)(A.ws + WS_QKVO);
    for (int task = blockIdx.x; task < DB * NH; task += gridDim.x) {
        const int seq = task >> 2, h = task & 3, r0 = MP + seq * DS, sidx = (l * DB + seq) * NH + h;
        __syncthreads();
        for (int i = tid; i < 1536; i += NTHR) { const int which = i >> 9, t = (i >> 7) & 3, d = i & 127; sq[i] = bf2f(QKVO[(size_t)(r0 + t) * 2048 + which * 512 + h * HD + d]); }
        const float m0 = A.st_m[sidx];
        if (tid == 0) {
            float F = 0.f, cmx = -3.0e38f, Fs[4], igs[4], mlast = 0.f;
#pragma unroll
            for (int t = 0; t < 4; ++t) { float ig, lf; ml_gates(A, l, r0 + t, h, ig, lf); F += lf; Fs[t] = F; igs[t] = ig; const float a = ig - F; cmx = fmaxf(cmx, a); const float mx = fmaxf(m0, cmx);
                sc[8 + t] = a; sc[12 + t] = mx; sc[16 + t] = __expf(m0 - mx); sc[20 + t] = __expf(-(F + mx)); mlast = F + mx; }
#pragma unroll
            for (int t = 0; t < 4; ++t) sc[24 + t] = __expf(Fs[3] - Fs[t] + igs[t] - mlast);
            sc[28] = __expf(Fs[3] + m0 - mlast); sc[29] = mlast;
        }
        __syncthreads();
        {
            const int lane = tid & 63, wv_ = tid >> 6;
            const float* n0 = A.st_n + (size_t)sidx * HD;
#pragma unroll
            for (int j = 0; j < 3; ++j) {
                const int p = wv_ * 3 + j;
                if (p < 20) {
                    const int t = p < 16 ? p >> 2 : p - 16, s = p & 3;
                    const float x0 = sq[t * HD + lane], x1 = sq[t * HD + 64 + lane];
                    const float y0 = p < 16 ? sq[512 + s * HD + lane] : n0[lane], y1 = p < 16 ? sq[512 + s * HD + 64 + lane] : n0[64 + lane];
                    const float d = wave_sum(x0 * y0 + x1 * y1);
                    if (lane == 0) { if (p < 16) sw[p] = s <= t ? d * __expf(sc[8 + s] - sc[12 + t]) : 0.f; else sc[32 + t] = d; }
                }
            }
        }
        __syncthreads();
        {
            const int v = tid & 127, kq = tid >> 7;
            const float* C0 = A.st_C + (size_t)sidx * HD * HD + (size_t)kq * 32 * HD + v; float* Co = A.out + O_CS + (size_t)sidx * HD * HD + (size_t)kq * 32 * HD + v;
            const float cd = sc[28];
            float wv[4]; float qc[4] = {0.f, 0.f, 0.f, 0.f};
#pragma unroll
            for (int t = 0; t < 4; ++t) wv[t] = sc[24 + t] * sq[1024 + t * HD + v];
#pragma unroll
            for (int k8 = 0; k8 < 32; k8 += 8) {
                float c0[8];
#pragma unroll
                for (int i = 0; i < 8; ++i) c0[i] = C0[(size_t)(k8 + i) * HD];
#pragma unroll
                for (int i = 0; i < 8; ++i) { const int k = kq * 32 + k8 + i; float cn = cd * c0[i];
#pragma unroll
                    for (int t = 0; t < 4; ++t) { qc[t] += sq[t * HD + k] * c0[i]; cn += wv[t] * sq[512 + t * HD + k]; }
                    Co[(size_t)(k8 + i) * HD] = cn; }
            }
#pragma unroll
            for (int t = 0; t < 4; ++t) part[(kq * 4 + t) * HD + v] = qc[t];
        }
        __syncthreads();
        float hv[4] = {0.f, 0.f, 0.f, 0.f};
        if (tid < HD) {
            const int v = tid;
#pragma unroll
            for (int t = 0; t < 4; ++t) { const float qct = part[(0 * 4 + t) * HD + v] + part[(1 * 4 + t) * HD + v] + part[(2 * 4 + t) * HD + v] + part[(3 * 4 + t) * HD + v];
                float num = sc[16 + t] * qct, den = sc[16 + t] * sc[32 + t];
#pragma unroll
                for (int s = 0; s < 4; ++s) { num += sw[t * 4 + s] * sq[1024 + s * HD + v]; den += sw[t * 4 + s]; }
                hv[t] = num / fmaxf(fabsf(den), sc[20 + t]); }
        }
#pragma unroll
        for (int t = 0; t < 4; ++t) { const float s1 = wave_sum(hv[t]); if ((tid & 63) == 0 && tid < HD) red[t * 2 + (tid >> 6)] = s1; }
        __syncthreads();
        float dv[4];
#pragma unroll
        for (int t = 0; t < 4; ++t) { dv[t] = hv[t] - (red[t * 2] + red[t * 2 + 1]) * (1.f / HD); const float s2 = wave_sum(dv[t] * dv[t]); if ((tid & 63) == 0 && tid < HD) red[8 + t * 2 + (tid >> 6)] = s2; }
        __syncthreads();
        if (tid < HD) {
            const int v = tid; const float gn = A.ml_norm_g[l * 512 + h * HD + v];
#pragma unroll
            for (int t = 0; t < 4; ++t) { const float rstd = 1.f / sqrtf((red[8 + t * 2] + red[8 + t * 2 + 1]) * (1.f / HD) + LN_EPS);
                const float og = bf2f(QKVO[(size_t)(r0 + t) * 2048 + 1536 + h * HD + v]);
                ((bf16*)(A.ws + WS_MIX))[(size_t)(r0 + t) * D + h * HD + v] = (bf16)f2bf(dv[t] * rstd * gn * sigmoidf_(og)); }
        } else if (tid < 2 * HD) {
            const int k = tid - HD; float nn = sc[28] * A.st_n[(size_t)sidx * HD + k];
#pragma unroll
            for (int t = 0; t < 4; ++t) nn += sc[24 + t] * sq[512 + t * HD + k];
            A.out[O_NS + (size_t)sidx * HD + k] = nn;
        }
        if (tid == 0) A.out[O_MS + sidx] = sc[29];
    }
}

typedef short bf16x8c __attribute__((ext_vector_type(8)));
template <bool FROMY>
__device__ __forceinline__ void phase_cmp2(CArgs& A, int l0, int nl, int r_lo, int nrows, int gw, int NGW, int lane) {
    const int fr = lane & 15, fq = lane >> 4, ntile = nrows / 16;
    for (int task = gw; task < nl * 4 * ntile; task += NGW) {
        const int img = task / ntile, tr = task % ntile, l = l0 + (img >> 2), sg = img & 3, s = sg >> 1, g = sg & 1, R0 = r_lo + tr * 16;
        const bf16* hp = (const bf16*)(A.ws + WS_HID) + ((size_t)(l * 4 + sg) * NCB + R0 + fr) * 256 + 8 * fq;
        const bf16* wp = (const bf16*)(A.ws + WS_W2T) + ((size_t)(l * 2 + s) * 64 + fr) * 256 + 8 * fq;
        f32x4 acc[4];
#pragma unroll
        for (int dt = 0; dt < 4; ++dt) acc[dt] = (f32x4){0.f, 0.f, 0.f, 0.f};
#pragma unroll
        for (int ks = 0; ks < 8; ++ks) {
            bf16x8c hf;
            if (FROMY) {
                const bf16* yp = (const bf16*)(A.ws + WS_HID) + ((size_t)(l * 4 + sg) * NCB + R0 + fr) * 512 + 32 * ks + 8 * fq;
                const v4u yt = *(const v4u*)yp, yb = *(const v4u*)(yp + 512 + 256);
                const float* bp = (const float*)(A.ws + WS_B1) + (l * 2 + s) * 256 + 32 * ks + 8 * fq;
                const f32x4 b0 = *(const f32x4*)bp, b1 = *(const f32x4*)(bp + 4);
                v4u hw;
                hw.x = pk2(gelu_tanh(bflo(yt.x) + bflo(yb.x) + b0[0]), gelu_tanh(bfhi(yt.x) + bfhi(yb.x) + b0[1])); hw.y = pk2(gelu_tanh(bflo(yt.y) + bflo(yb.y) + b0[2]), gelu_tanh(bfhi(yt.y) + bfhi(yb.y) + b0[3]));
                hw.z = pk2(gelu_tanh(bflo(yt.z) + bflo(yb.z) + b1[0]), gelu_tanh(bfhi(yt.z) + bfhi(yb.z) + b1[1])); hw.w = pk2(gelu_tanh(bflo(yt.w) + bflo(yb.w) + b1[2]), gelu_tanh(bfhi(yt.w) + bfhi(yb.w) + b1[3]));
                hf = __builtin_bit_cast(bf16x8c, hw);
            } else hf = *(const bf16x8c*)(hp + 32 * ks);
#pragma unroll
            for (int dt = 0; dt < 4; ++dt) { const bf16x8c wf = *(const bf16x8c*)(wp + (size_t)dt * 16 * 256 + 32 * ks);
                acc[dt] = s == 0 ? __builtin_amdgcn_mfma_f32_16x16x32_bf16(wf, hf, acc[dt], 0, 0, 0) : __builtin_amdgcn_mfma_f32_16x16x32_bf16(hf, wf, acc[dt], 0, 0, 0); }
        }
        if (s == 0) {
            bf16* o = (bf16*)(A.ws + WS_KC) + ((size_t)(l * 2 + g) * NCB + R0 + fr) * 64 + 4 * fq;
#pragma unroll
            for (int dt = 0; dt < 4; ++dt) { v2u w; w.x = pk2(acc[dt][0], acc[dt][1]); w.y = pk2(acc[dt][2], acc[dt][3]); *(v2u*)(o + 16 * dt) = w; }
        } else {
            bf16* o = (bf16*)(A.ws + WS_VCT) + (size_t)(l * 2 + g) * 64 * NCB + (size_t)(R0 >> 6) * 4096 + fr * 64 + (R0 & 63) + 4 * fq;
#pragma unroll
            for (int dt = 0; dt < 4; ++dt) { v2u w; w.x = pk2(acc[dt][0], acc[dt][1]); w.y = pk2(acc[dt][2], acc[dt][3]); *(v2u*)(o + dt * 16 * 64) = w; }
        }
    }
}

__device__ __forceinline__ void topk_sel(float imp0, float imp1, int cur, int lane, unsigned long long& s0, unsigned long long& s1) {
    const int nforced = cur == 0 ? 1 : (cur == 1 ? 2 : 3), need = 16 - nforced, ncand = cur - 2 > 0 ? cur - 2 : 0;
    const unsigned k0 = (lane >= 1 && lane <= cur - 2) ? __builtin_bit_cast(unsigned, imp0) + 1u : 0u;
    const unsigned k1 = (lane + 64 <= cur - 2) ? __builtin_bit_cast(unsigned, imp1) + 1u : 0u;
    unsigned long long c0, c1;
    if (ncand <= need) { c0 = __ballot(k0 != 0u); c1 = __ballot(k1 != 0u); }
    else {
        unsigned T = 0u;
        for (int bit = 31; bit >= 0; --bit) { const unsigned cand = T | (1u << bit);
            const int cnt = __popcll(__ballot(k0 >= cand)) + __popcll(__ballot(k1 >= cand)); if (cnt >= need) T = cand; }
        const unsigned long long g0 = __ballot(k0 > T), g1 = __ballot(k1 > T); unsigned long long e0 = __ballot(k0 == T), e1 = __ballot(k1 == T);
        int rem = need - __popcll(g0) - __popcll(g1);
        unsigned long long t0 = 0ull, t1 = 0ull;
        while (rem > 0 && e0) { const unsigned long long lb = e0 & (~e0 + 1ull); t0 |= lb; e0 ^= lb; --rem; }
        while (rem > 0 && e1) { const unsigned long long lb = e1 & (~e1 + 1ull); t1 |= lb; e1 ^= lb; --rem; }
        c0 = g0 | t0; c1 = g1 | t1;
    }
    unsigned long long f0 = 1ull, f1 = 0ull;
    if (cur < 64) f0 |= 1ull << cur; else f1 |= 1ull << (cur - 64);
    if (cur >= 1) { if (cur - 1 < 64) f0 |= 1ull << (cur - 1); else f1 |= 1ull << (cur - 65); }
    s0 = c0 | f0; s1 = c1 | f1;
}


typedef short bf16x8 __attribute__((ext_vector_type(8)));
#define MFMA16(a, b, c) __builtin_amdgcn_mfma_f32_16x16x32_bf16((a), (b), (c), 0, 0, 0)
constexpr int TOTS = MP + DB * 2112, WSTR = 576, TOTW = MP + DB * WSTR, TOTWP = TOTW + 64;
constexpr size_t KS_L = (size_t)2 * TOTS * 64, KW_L = (size_t)2 * TOTWP * 64, KC_L = (size_t)2 * NCB * 64;

template <int NP>
__device__ __forceinline__ void kv_tile(const float* src, bf16* Kimg, size_t kgs, bf16* Vt, size_t vgs, size_t vpitch, size_t gp0, LAS bf16* scr, int lane, float* cdst = nullptr, int cskip = 0) {
    const int cc = 4 * lane, s = cc >> 7, g = (cc >> 6) & 1, d = cc & 63;
#pragma unroll 16
    for (int sl = 0; sl < NP; ++sl) {
        const f32x4 v = __builtin_nontemporal_load((const f32x4*)(src + (size_t)sl * 256 + cc));
        if (cdst && sl >= cskip) __builtin_nontemporal_store(v, (f32x4*)(cdst + (size_t)sl * 256 + cc));
        v2u w; w.x = pk2(v[0], v[1]); w.y = pk2(v[2], v[3]);
        if (s == 0) *(v2u*)(Kimg + (size_t)g * kgs + (gp0 + sl) * 64 + d) = w;
        else *(LAS v2u*)(scr + sl * 128 + (cc - 128)) = w;
    }
    LDS_WAIT();
#pragma unroll
    for (int g2 = 0; g2 < 2; ++g2) {
        const int gd = lane + 64 * g2;
        bf16* dst = Vt + (size_t)g2 * vgs + (gp0 >> 6) * 4096 + (size_t)lane * 64 + (gp0 & 63);
#pragma unroll
        for (int oc = 0; oc < NP / 8; ++oc) {
            const LAS bf16* p = scr + (8 * oc) * 128 + gd;
            v4u o; o.x = (unsigned)p[0] | ((unsigned)p[128] << 16); o.y = (unsigned)p[256] | ((unsigned)p[384] << 16); o.z = (unsigned)p[512] | ((unsigned)p[640] << 16); o.w = (unsigned)p[768] | ((unsigned)p[896] << 16);
            *(v4u*)(dst + 8 * oc) = o;
        }
    }
    LDS_WAIT();
}
#define kv_tile64 kv_tile<64>

__device__ __forceinline__ void prep_cache_images(CArgs& A, LAS unsigned char* lds, int gw, int NGW, int lane, int wave) {
    LAS bf16* scr = (LAS bf16*)(lds + wave * 16384);
    bf16* KS = (bf16*)(A.ws + WS_KS); bf16* VTS = (bf16*)(A.ws + WS_VTS); bf16* KW = (bf16*)(A.ws + WS_KW); bf16* VTW = (bf16*)(A.ws + WS_VTW);
    for (int it = gw; it < DEPTH * DB * 32; it += NGW) {
        const int ti = it & 31, seq = (it >> 5) & 127, l = it >> 12;
        const int phys = A.page_table[seq * NPG + (ti >> 1)];
        const float* src = A.cache_slc + (((size_t)l * NPHYS + phys) * PAGE + (ti & 1) * 64) * 256;
        kv_tile64(src, KS + l * KS_L, (size_t)TOTS * 64, VTS + l * KS_L, (size_t)64 * TOTS, TOTS, (size_t)MP + seq * 2112 + ti * 64, scr, lane);
    }
    for (int it = gw; it < DEPTH * DB * 8; it += NGW) {
        const int ti = it & 7, ls = it >> 3, seq = ls & 127, l = ls >> 7;
        const float* src = A.cache_win + ((size_t)ls * 512 + ti * 64) * 256;
        kv_tile64(src, KW + l * KW_L, (size_t)TOTWP * 64, VTW + l * KW_L, (size_t)64 * TOTWP, TOTWP, (size_t)MP + seq * WSTR + ti * 64, scr, lane,
                  A.out + O_WINS + ((size_t)ls * 512 + ti * 64) * 256 - 4 * 256, ti == 0 ? 4 : 0);
    }
}
__device__ __forceinline__ void prep_layer_images(CArgs& A, int l, LAS unsigned char* lds, int gw, int NGW, int lane, int wave) {
    LAS bf16* scr = (LAS bf16*)(lds + wave * 16384);
    bf16* KS = (bf16*)(A.ws + WS_KS) + l * KS_L; bf16* VTS = (bf16*)(A.ws + WS_VTS) + l * KS_L; bf16* KW = (bf16*)(A.ws + WS_KW) + l * KW_L; bf16* VTW = (bf16*)(A.ws + WS_VTW) + l * KW_L;
    const float* KVR = (const float*)(A.ws + WS_KVR);
    for (int it = gw; it < 2 * (MP / 16); it += NGW) {
        const int kind = it / (MP / 16), ti = it % (MP / 16);
        const float* src = KVR + ((size_t)(1 + kind) * M + ti * 16) * 256;
        if (kind == 0) kv_tile<16>(src, KS, (size_t)TOTS * 64, VTS, (size_t)64 * TOTS, TOTS, (size_t)ti * 16, scr, lane);
        else           kv_tile<16>(src, KW, (size_t)TOTWP * 64, VTW, (size_t)64 * TOTWP, TOTWP, (size_t)ti * 16, scr, lane);
    }
    for (int it = gw; it < 2 * DB; it += NGW) {
        const int kind = it / DB, seq = it % DB;
        const float* src = KVR + ((size_t)(1 + kind) * M + MP + seq * DS) * 256;
        bf16* Kimg = kind == 0 ? KS : KW; bf16* Vt = kind == 0 ? VTS : VTW;
        const size_t tot = kind == 0 ? TOTS : TOTWP, gp0 = kind == 0 ? (size_t)MP + seq * 2112 + PAST : (size_t)MP + seq * WSTR + 512;
        const int cc = 4 * lane, s = cc >> 7, g = (cc >> 6) & 1, d = cc & 63;
#pragma unroll
        for (int t = 0; t < DS; ++t) {
            const f32x4 v = *(const f32x4*)(src + (size_t)t * 256 + cc);
            if (s == 0) { v2u w; w.x = pk2(v[0], v[1]); w.y = pk2(v[2], v[3]); *(v2u*)(Kimg + (size_t)g * tot * 64 + (gp0 + t) * 64 + d) = w; }
            else {
#pragma unroll
                for (int i = 0; i < 4; ++i) Vt[(size_t)g * 64 * tot + ((gp0 + t) >> 6) * 4096 + (size_t)(d + i) * 64 + ((gp0 + t) & 63)] = (bf16)f2bf(v[i]);
            }
        }
    }
}

struct KV { bf16x8 k[8]; v4u v[8]; };
__device__ __forceinline__ void k_load(KV& f, const bf16* Kb, int fr, int fq) {
#pragma unroll
    for (int t = 0; t < 4; ++t) { f.k[2 * t] = *(const bf16x8*)(Kb + (size_t)(16 * t + fr) * 64 + 8 * fq); f.k[2 * t + 1] = *(const bf16x8*)(Kb + (size_t)(16 * t + fr) * 64 + 32 + 8 * fq); }
}
__device__ __forceinline__ void v_load(KV& f, const bf16* Vb, size_t pitch, int fr, int fq) {
#pragma unroll
    for (int h = 0; h < 2; ++h)
#pragma unroll
        for (int dt = 0; dt < 4; ++dt) { const bf16* vp = Vb + (size_t)(16 * dt + fr) * pitch + 32 * h + 4 * fq;
            const v2u a = *(const v2u*)vp, b = *(const v2u*)(vp + 16); v4u w; w.x = a.x; w.y = a.y; w.z = b.x; w.w = b.y; f.v[4 * h + dt] = w; }
}
__device__ __forceinline__ void qk_frag(const KV& f, const bf16x8 (&q)[2], f32x4 (&st)[4]) {
#pragma unroll
    for (int t = 0; t < 4; ++t) { f32x4 z = {0.f, 0.f, 0.f, 0.f}; z = MFMA16(f.k[2 * t], q[0], z); st[t] = MFMA16(f.k[2 * t + 1], q[1], z); }
}
__device__ __forceinline__ void pv_frag(const KV& f, const f32x4 (&st)[4], f32x4 (&o)[4]) {
#pragma unroll
    for (int h = 0; h < 2; ++h) {
        v4u pw; pw.x = pk2(st[2 * h][0], st[2 * h][1]); pw.y = pk2(st[2 * h][2], st[2 * h][3]); pw.z = pk2(st[2 * h + 1][0], st[2 * h + 1][1]); pw.w = pk2(st[2 * h + 1][2], st[2 * h + 1][3]);
        const bf16x8 pf = __builtin_bit_cast(bf16x8, pw);
#pragma unroll
        for (int dt = 0; dt < 4; ++dt) o[dt] = MFMA16(__builtin_bit_cast(bf16x8, f.v[4 * h + dt]), pf, o[dt]);
    }
}
__device__ __forceinline__ float xfq_max(float v) { v = fmaxf(v, __shfl_xor(v, 16)); return fmaxf(v, __shfl_xor(v, 32)); }
__device__ __forceinline__ float xfq_sum(float v) { v += __shfl_xor(v, 16); return v + __shfl_xor(v, 32); }
__device__ __forceinline__ float quad_sum(float v) { v += __shfl_xor(v, 1); return v + __shfl_xor(v, 2); }

__device__ __forceinline__ void softmax_pv(const KV& f, f32x4 (&st)[4], f32x4 (&o)[4], float& m, float& ls) {
    float bm = -INFINITY;
#pragma unroll
    for (int t = 0; t < 4; ++t) bm = fmaxf(bm, fmaxf(fmaxf(st[t][0], st[t][1]), fmaxf(st[t][2], st[t][3])));
    bm = xfq_max(bm);
    const float mn = fmaxf(m, bm), sc = __builtin_amdgcn_exp2f(m - mn);
    m = mn; ls *= sc;
#pragma unroll
    for (int dt = 0; dt < 4; ++dt) o[dt] = o[dt] * sc;
#pragma unroll
    for (int t = 0; t < 4; ++t)
#pragma unroll
        for (int i = 0; i < 4; ++i) { const float p = __builtin_amdgcn_exp2f(st[t][i] - mn); st[t][i] = p; ls += p; }
    pv_frag(f, st, o);
}
template <class Br>
__device__ __forceinline__ void run_branch(Br& br, const bf16x8 (&q)[2], int fr, int fq, f32x4 (&o)[4], float& m, float& ls) {
    int j;
    if (!br.first(j)) return;
    KV cur; k_load(cur, br.kp(j), fr, fq); v_load(cur, br.vp(j), br.pitch, fr, fq);
    for (;;) {
        int jn = 0; const bool hn = br.next(jn);
        KV nxt;
        if (hn) { k_load(nxt, br.kp(jn), fr, fq); v_load(nxt, br.vp(jn), br.pitch, fr, fq); }
        f32x4 st[4]; qk_frag(cur, q, st);
        br.mask(st, j);
        softmax_pv(cur, st, o, m, ls);
        if (!hn) break;
        cur = nxt; j = jn;
    }
}
struct BrSel {
    const bf16* K; const bf16* V; size_t pitch; unsigned long long u0, u1, my0, my1; int cur, qpos, fq; const LAS float* bt; float farb;
    __device__ __forceinline__ bool pop(int& j) { if (u0) { j = __builtin_ctzll(u0); u0 &= u0 - 1ull; return true; } if (u1) { j = 64 + __builtin_ctzll(u1); u1 &= u1 - 1ull; return true; } return false; }
    __device__ __forceinline__ bool first(int& j) { return pop(j); }
    __device__ __forceinline__ bool next(int& j) { return pop(j); }
    __device__ __forceinline__ const bf16* kp(int j) const { return K + (size_t)j * 64 * 64; }
    __device__ __forceinline__ const bf16* vp(int j) const { return V + (size_t)j * 4096; }
    __device__ __forceinline__ void mask(f32x4 (&st)[4], int j) const {
        const bool mine = j < 64 ? ((my0 >> j) & 1ull) != 0ull : ((my1 >> (j - 64)) & 1ull) != 0ull;
        if (j >= cur - 2) {
#pragma unroll
            for (int t = 0; t < 4; ++t)
#pragma unroll
                for (int i = 0; i < 4; ++i) { const int dist = qpos - (64 * j + 16 * t + 4 * fq + i); st[t][i] = st[t][i] + bt[(!mine || dist < 0) ? 129 : (dist > 128 ? 128 : dist)]; }
        } else {
#pragma unroll
            for (int t = 0; t < 4; ++t)
#pragma unroll
                for (int i = 0; i < 4; ++i) st[t][i] = mine ? st[t][i] + farb : -INFINITY;
        }
    }
};
struct BrWin {
    const bf16* K; const bf16* V; size_t pitch; int jb, cur, qpos, fq; const LAS float* bt;
    __device__ __forceinline__ bool first(int& j) { j = jb; return jb <= cur; }
    __device__ __forceinline__ bool next(int& j) { ++jb; j = jb; return jb <= cur; }
    __device__ __forceinline__ const bf16* kp(int j) const { return K + (long)j * 64 * 64; }
    __device__ __forceinline__ const bf16* vp(int j) const { return V + (long)j * 4096; }
    __device__ __forceinline__ void mask(f32x4 (&st)[4], int j) const {
#pragma unroll
        for (int t = 0; t < 4; ++t)
#pragma unroll
            for (int i = 0; i < 4; ++i) { const int dist = qpos - (64 * j + 16 * t + 4 * fq + i); st[t][i] = st[t][i] + bt[(unsigned)dist >= 512u ? 129 : (dist > 128 ? 128 : dist)]; }
    }
};

__device__ __forceinline__ void nsa_tile(CArgs& A, int l, bool smp, int bs, int g, int tq, LAS float* wl, const LAS float* BT, int lane) {
    asm volatile("" : "+v"(lane));
    const int fr = lane & 15, fq = lane >> 4, tl = fr >> 2, rr = fr & 3;
    const int qpos0 = smp ? PAST : 4 * tq, row0 = smp ? MP + bs * DS : bs * SEQ + qpos0;
    const int qpos = qpos0 + tl, cur = qpos0 >> 6, h = g * 4 + rr;
    const size_t sbase = smp ? (size_t)MP + bs * 2112 : (size_t)bs * SEQ;
    const long wbase = smp ? (long)MP + bs * WSTR - (PAST - 512) : (long)bs * SEQ;
    const size_t cbase = smp ? (size_t)1024 + bs * 128 : (size_t)bs * 512;
    const bf16* KS = (const bf16*)(A.ws + WS_KS) + l * KS_L + (size_t)g * TOTS * 64; const bf16* VTS = (const bf16*)(A.ws + WS_VTS) + l * KS_L + (size_t)g * 64 * TOTS;
    const bf16* KW = (const bf16*)(A.ws + WS_KW) + l * KW_L + (size_t)g * TOTWP * 64; const bf16* VTW = (const bf16*)(A.ws + WS_VTW) + l * KW_L + (size_t)g * 64 * TOTWP;
    const bf16* KC = (const bf16*)(A.ws + WS_KC) + l * KC_L + (size_t)g * NCB * 64 + cbase * 64; const bf16* VCT = (const bf16*)(A.ws + WS_VCT) + l * KC_L + (size_t)g * 64 * NCB + (cbase >> 6) * 4096;
    const LAS float* bt = BT + h * 132;
    const float farb = bt[128];
    bf16x8 q[2];
    {   const bf16* qp = (const bf16*)(A.ws + WS_NQ) + (size_t)(row0 + tl) * 512 + g * 256 + rr * 64 + 8 * fq;
        q[0] = *(const bf16x8*)qp; q[1] = *(const bf16x8*)(qp + 32); }
    const float* gt = (const float*)(A.ws + WS_GATE) + (size_t)(row0 + tl) * 32 + 8 + h * 3;
    const float gc = sigmoidf_(gt[0]), gs = sigmoidf_(gt[1]), gwn = sigmoidf_(gt[2]);
    f32x4 out[4];
#pragma unroll
    for (int dt = 0; dt < 4; ++dt) out[dt] = (f32x4){0.f, 0.f, 0.f, 0.f};
    LAS float* impA = wl;
    LAS float* impB = wl + 544;
    for (int i = lane; i < 1088; i += 64) wl[i] = 0.f;
    LDS_WAIT();

    {
        const int ncv_max = qpos0 + 3 >= 31 ? ((qpos0 + 3 - 31) >> 4) + 1 : 0, nb64 = (ncv_max + 63) >> 6;
        float m = -1.0e30f, ls = 0.f;
        {
            for (int ib = 0; ib < nb64; ++ib) {
                KV cur; k_load(cur, KC + (size_t)ib * 64 * 64, fr, fq);
                f32x4 st[4]; qk_frag(cur, q, st);
                float bm = -INFINITY;
#pragma unroll
                for (int t = 0; t < 4; ++t)
#pragma unroll
                    for (int i = 0; i < 4; ++i) { const int n = 64 * ib + 16 * t + 4 * fq + i; const int dist = qpos - 16 * n - 31;
                        const float s = st[t][i] + bt[dist < 0 ? 129 : (dist > 128 ? 128 : dist)]; st[t][i] = s; bm = fmaxf(bm, s); }
                bm = xfq_max(bm);
                const float mn = fmaxf(m, bm); ls *= __builtin_amdgcn_exp2f(m - mn); m = mn;
#pragma unroll
                for (int t = 0; t < 4; ++t)
#pragma unroll
                    for (int i = 0; i < 4; ++i) ls += __builtin_amdgcn_exp2f(st[t][i] - mn);
            }
        }
        ls = xfq_sum(ls);
        const float inv = ls > 0.f ? 1.f / ls : 0.f;
        f32x4 o[4];
#pragma unroll
        for (int dt = 0; dt < 4; ++dt) o[dt] = (f32x4){0.f, 0.f, 0.f, 0.f};
        {
            for (int ib = 0; ib < nb64; ++ib) {
                KV cur; k_load(cur, KC + (size_t)ib * 64 * 64, fr, fq); v_load(cur, VCT + (size_t)ib * 4096, 64, fr, fq);
                f32x4 st[4]; qk_frag(cur, q, st);
#pragma unroll
                for (int t = 0; t < 4; ++t) {
#pragma unroll
                    for (int i = 0; i < 4; ++i) { const int n = 64 * ib + 16 * t + 4 * fq + i; const int dist = qpos - 16 * n - 31;
                        st[t][i] = __builtin_amdgcn_exp2f(st[t][i] + bt[dist < 0 ? 129 : (dist > 128 ? 128 : dist)] - m) * inv; }
                    const float s4 = quad_sum((st[t][0] + st[t][1]) + (st[t][2] + st[t][3])), s3 = quad_sum(st[t][3]);
                    const int j0 = 16 * ib + 4 * t + fq;
                    if (rr == 0) { impA[tl * 136 + j0] = s4; impB[tl * 136 + j0 + 1] = s3; }
                }
                pv_frag(cur, st, o);
            }
        }
#pragma unroll
        for (int dt = 0; dt < 4; ++dt) out[dt] = out[dt] + o[dt] * gc;
    }
    LDS_WAIT();
    unsigned long long s0[4], s1[4];
#pragma unroll
    for (int t = 0; t < 4; ++t) topk_sel(impA[t * 136 + lane] + impB[t * 136 + lane], impA[t * 136 + 64 + lane] + impB[t * 136 + 64 + lane], cur, lane, s0[t], s1[t]);
    {
        float m = -1.0e30f, ls = 0.f; f32x4 o[4];
#pragma unroll
        for (int dt = 0; dt < 4; ++dt) o[dt] = (f32x4){0.f, 0.f, 0.f, 0.f};
        BrSel br{KS + sbase * 64, VTS + (sbase >> 6) * 4096, (size_t)64, (s0[0] | s0[1]) | (s0[2] | s0[3]), (s1[0] | s1[1]) | (s1[2] | s1[3]),
                 tl == 0 ? s0[0] : (tl == 1 ? s0[1] : (tl == 2 ? s0[2] : s0[3])), tl == 0 ? s1[0] : (tl == 1 ? s1[1] : (tl == 2 ? s1[2] : s1[3])), cur, qpos, fq, bt, farb};
        run_branch(br, q, fr, fq, o, m, ls);
        ls = xfq_sum(ls);
        const float w = ls > 0.f ? gs / ls : 0.f;
#pragma unroll
        for (int dt = 0; dt < 4; ++dt) out[dt] = out[dt] + o[dt] * w;
    }
    {
        float m = -1.0e30f, ls = 0.f; f32x4 o[4];
#pragma unroll
        for (int dt = 0; dt < 4; ++dt) o[dt] = (f32x4){0.f, 0.f, 0.f, 0.f};
        const int lo_blk = smp ? (PAST - 512) >> 6 : 0; int jb = (qpos0 - 511) >> 6; if (jb < lo_blk) jb = lo_blk;
        BrWin br{KW + wbase * 64, VTW + (wbase >> 6) * 4096, (size_t)64, jb, cur, qpos, fq, bt};
        run_branch(br, q, fr, fq, o, m, ls);
        ls = xfq_sum(ls);
        const float w = ls > 0.f ? gwn / ls : 0.f;
#pragma unroll
        for (int dt = 0; dt < 4; ++dt) out[dt] = out[dt] + o[dt] * w;
    }
    bf16* mp = (bf16*)(A.ws + WS_MIX) + (size_t)(row0 + tl) * D + 512 + h * 64 + 4 * fq;
#pragma unroll
    for (int dt = 0; dt < 4; ++dt) { v2u w; w.x = pk2(out[dt][0], out[dt][1]); w.y = pk2(out[dt][2], out[dt][3]); *(v2u*)(mp + 16 * dt) = w; }
}
__device__ __forceinline__ void phase_nsa(CArgs& A, int l, LAS float* wl, const LAS float* BT, int lane, int wave) {
    const int G = gridDim.x, bx = blockIdx.x;
    const bool xmap = (G & 7) == 0;
    const int x = bx & 7, nw = (G >> 3) * NWAVES, ww = (bx >> 3) * NWAVES + wave;
    const int gwv = bx * NWAVES + wave, ngw = G * NWAVES;
    for (int it = 0;; ++it) {
        bool smp; int bs, g, tq;
        if (xmap) {
            const int np = ww < 512 ? 2 * ((512 - ww + nw - 1) / nw) : 0;
            if (it < np) { const int i = ww + nw * (it >> 1), tq2 = (it & 1) ? 1023 - i : i; smp = false; bs = x >> 2; g = (x >> 1) & 1; tq = 2 * tq2 + (x & 1); }
            else { const int t = ww * 8 + x + 8 * nw * (it - np); if (t >= 2 * DB) break; smp = true; bs = t >> 1; g = t & 1; tq = 0; }
        } else {
            const int t = gwv + ngw * it; if (t >= 4 * 2048 + 2 * DB) break;
            if (t < 4 * 2048) { smp = false; bs = t >> 12; g = (t >> 11) & 1; tq = t & 2047; } else { smp = true; bs = (t - 4 * 2048) >> 1; g = t & 1; tq = 0; }
        }
        nsa_tile(A, l, smp, bs, g, tq, wl, BT, lane);
    }
}

__device__ __forceinline__ void phase_m2x(CArgs& A, int l, LAS unsigned char* lds, int tid) {
    LAS float* buf = (LAS float*)lds;
    LAS float* wl = (LAS float*)(lds + 1024);
    LAS float* red = (LAS float*)(lds + 2048);
    LAS bf16* kt = (LAS bf16*)(lds + 8192);
    LAS bf16* vt = (LAS bf16*)(lds + 8192 + 34816);
    const bf16* QKVO = (const bf16*)(A.ws + WS_QKVO);
    const int lane = tid & 63, wave = tid >> 6, fr = lane & 15, fq = lane >> 4;
    for (int unit = blockIdx.x; unit < NUNIT; unit += gridDim.x) {
        const int b = unit >> 7, h = (unit >> 5) & 3, c = unit & 31, r0 = b * SEQ + c * LCH;
        float ig = 0.f, lf = 0.f;
        if (tid < 256) ml_gates(A, l, r0 + tid, h, ig, lf);
        const float F = scan_sum256(lf, buf, tid);
        __syncthreads();
        if (tid == 255) buf[16] = F;
        __syncthreads();
        const float Fend = buf[16];
        const float gl = tid < 256 ? Fend - F + ig : -3.0e38f;
        const float mw = wave_max(gl);
        if (lane == 0) buf[20 + wave] = mw;
        __syncthreads();
        const float mloc = fmaxf(fmaxf(buf[20], buf[21]), fmaxf(buf[22], buf[23]));
        if (tid < 256) wl[tid] = __expf(gl - mloc);
        if (tid == 0) { float* ch = (float*)(A.ws + WS_CHS) + unit * 4; ch[0] = Fend; ch[1] = mloc; }
        f32x4 acc[8];
#pragma unroll
        for (int kt_ = 0; kt_ < 8; ++kt_) acc[kt_] = (f32x4){0.f, 0.f, 0.f, 0.f};
        float dnp = 0.f;
        for (int half = 0; half < 2; ++half) {
            __syncthreads();
            for (int i = tid; i < 4096; i += NTHR) { const int which = i >> 11, oc = (i >> 7) & 15, s = i & 127;
                const v4u x = *(const v4u*)(QKVO + (size_t)(r0 + 128 * half + s) * 2048 + (which ? 1024 : 512) + h * HD + 8 * oc);
                LAS bf16* dst = (which ? vt : kt) + (8 * oc) * 136 + s;
                dst[0] = (bf16)x.x; dst[136] = (bf16)(x.x >> 16); dst[272] = (bf16)x.y; dst[408] = (bf16)(x.y >> 16); dst[544] = (bf16)x.z; dst[680] = (bf16)(x.z >> 16); dst[816] = (bf16)x.w; dst[952] = (bf16)(x.w >> 16); }
            __syncthreads();
#pragma unroll
            for (int ks = 0; ks < 4; ++ks) {
                const int s0 = 32 * ks + 8 * fq;
                const v4u xv = *(const LAS v4u*)(vt + (16 * wave + fr) * 136 + s0);
                const f32x4 w0 = *(const LAS f32x4*)(wl + 128 * half + s0), w1 = *(const LAS f32x4*)(wl + 128 * half + s0 + 4);
                v4u av; av.x = pk2(bflo(xv.x) * w0[0], bfhi(xv.x) * w0[1]); av.y = pk2(bflo(xv.y) * w0[2], bfhi(xv.y) * w0[3]); av.z = pk2(bflo(xv.z) * w1[0], bfhi(xv.z) * w1[1]); av.w = pk2(bflo(xv.w) * w1[2], bfhi(xv.w) * w1[3]);
                const bf16x8 af = __builtin_bit_cast(bf16x8, av);
#pragma unroll
                for (int kt_ = 0; kt_ < 8; ++kt_) { const bf16x8 bfr = *(const LAS bf16x8*)(kt + (16 * kt_ + fr) * 136 + s0); acc[kt_] = MFMA16(af, bfr, acc[kt_]); }
            }
            {   const int k = tid & 127, q = tid >> 7;
#pragma unroll
                for (int e = 0; e < 4; ++e) { const v4u x = *(const LAS v4u*)(kt + k * 136 + 32 * q + 8 * e); const LAS float* w = wl + 128 * half + 32 * q + 8 * e;
                    dnp += bflo(x.x) * w[0] + bfhi(x.x) * w[1] + bflo(x.y) * w[2] + bfhi(x.y) * w[3] + bflo(x.z) * w[4] + bfhi(x.z) * w[5] + bflo(x.w) * w[6] + bfhi(x.w) * w[7]; } }
        }
        float* dct = (float*)(A.ws + WS_DCT) + ((size_t)unit * HD + 16 * wave + 4 * fq) * HD + fr;
#pragma unroll
        for (int kt_ = 0; kt_ < 8; ++kt_)
#pragma unroll
            for (int i = 0; i < 4; ++i) dct[(size_t)i * HD + 16 * kt_] = acc[kt_][i];
        red[(tid >> 7) * 128 + (tid & 127)] = dnp;
        __syncthreads();
        if (tid < HD) ((float*)(A.ws + WS_DN))[unit * HD + tid] = (red[tid] + red[128 + tid]) + (red[256 + tid] + red[384 + tid]);
        __syncthreads();
    }
}

__device__ __forceinline__ void phase_m4x(CArgs& A, int l, LAS unsigned char* lds, int tid) {
    LAS float* buf = (LAS float*)lds;
    LAS float* sa = (LAS float*)(lds + 1024);
    LAS float* smx = sa + 256;
    LAS float* sdec = smx + 256;
    LAS float* sem = sdec + 256;
    LAS bf16* vt = (LAS bf16*)(lds + 8192);
    const bf16* QKVO = (const bf16*)(A.ws + WS_QKVO);
    const int lane = tid & 63, wave = tid >> 6, fr = lane & 15, fq = lane >> 4;
    for (int unit = blockIdx.x; unit < NUNIT; unit += gridDim.x) {
        const int b = unit >> 7, h = (unit >> 5) & 3, c = unit & 31, r0 = b * SEQ + c * LCH;
        float ig = 0.f, lf = 0.f;
        if (tid < 256) ml_gates(A, l, r0 + tid, h, ig, lf);
        const float F = scan_sum256(lf, buf, tid);
        const float a = tid < 256 ? ig - F : -3.0e38f;
        const float cm = scan_max256(a, buf, tid);
        const float m0 = ((const float*)(A.ws + WS_CHS))[unit * 4 + 2];
        if (tid < 256) { const float mx = fmaxf(m0, cm); sa[tid] = a; smx[tid] = mx; sdec[tid] = __expf(m0 - mx); sem[tid] = __expf(-(F + mx)); }
        for (int i = tid; i < 4096; i += NTHR) { const int oc = i >> 8, s = i & 255;
            const v4u x = *(const v4u*)(QKVO + (size_t)(r0 + s) * 2048 + 1024 + h * HD + 8 * oc);
            LAS bf16* dst = vt + (8 * oc) * 264 + s;
            dst[0] = (bf16)x.x; dst[264] = (bf16)(x.x >> 16); dst[528] = (bf16)x.y; dst[792] = (bf16)(x.y >> 16); dst[1056] = (bf16)x.z; dst[1320] = (bf16)(x.z >> 16); dst[1584] = (bf16)x.w; dst[1848] = (bf16)(x.w >> 16); }
        __syncthreads();
        const bf16* ctp = (const bf16*)(A.ws + WS_CTP) + (size_t)unit * HD * HD;
        const float* npv = (const float*)(A.ws + WS_NPV) + unit * HD;
        for (int pass = 0; pass < 2; ++pass) {
            const int sub = pass == 0 ? wave : 15 - wave, t0 = 16 * sub, t = t0 + fr;
            const float mxt = smx[t], dect = sdec[t], emt = sem[t];
            bf16x8 qf[4];
#pragma unroll
            for (int kk = 0; kk < 4; ++kk) qf[kk] = *(const bf16x8*)(QKVO + (size_t)(r0 + t) * 2048 + h * HD + 32 * kk + 8 * fq);
            f32x4 ah[8], ac[8];
#pragma unroll
            for (int v = 0; v < 8; ++v) { ah[v] = (f32x4){0.f, 0.f, 0.f, 0.f}; ac[v] = (f32x4){0.f, 0.f, 0.f, 0.f}; }
            float den = 0.f;
            const int nblk = (t0 + 47) >> 5;
            for (int ib = 0; ib < nblk; ++ib) {
                const int s0 = 32 * ib;
                f32x4 st[2];
#pragma unroll
                for (int j = 0; j < 2; ++j) {
                    f32x4 z = {0.f, 0.f, 0.f, 0.f};
                    const bf16* kp = QKVO + (size_t)(r0 + s0 + 16 * j + fr) * 2048 + 512 + h * HD + 8 * fq;
#pragma unroll
                    for (int kk = 0; kk < 4; ++kk) z = MFMA16(*(const bf16x8*)(kp + 32 * kk), qf[kk], z);
                    const f32x4 a4 = *(const LAS f32x4*)(sa + s0 + 16 * j + 4 * fq);
#pragma unroll
                    for (int i = 0; i < 4; ++i) { const float w = (s0 + 16 * j + 4 * fq + i <= t) ? z[i] * __expf(a4[i] - mxt) : 0.f; z[i] = w; den += w; }
                    st[j] = z;
                }
                v4u pw; pw.x = pk2(st[0][0], st[0][1]); pw.y = pk2(st[0][2], st[0][3]); pw.z = pk2(st[1][0], st[1][1]); pw.w = pk2(st[1][2], st[1][3]);
                const bf16x8 pf = __builtin_bit_cast(bf16x8, pw);
#pragma unroll
                for (int v = 0; v < 8; ++v) { const LAS bf16* vp = vt + (16 * v + fr) * 264 + s0 + 4 * fq;
                    const v2u x = *(const LAS v2u*)vp, y = *(const LAS v2u*)(vp + 16);
                    v4u vw; vw.x = x.x; vw.y = x.y; vw.z = y.x; vw.w = y.y;
                    ah[v] = MFMA16(__builtin_bit_cast(bf16x8, vw), pf, ah[v]); }
            }
            float qn = 0.f;
#pragma unroll
            for (int kk = 0; kk < 4; ++kk) {
                const v4u qx = __builtin_bit_cast(v4u, qf[kk]); const f32x4 n0 = *(const f32x4*)(npv + 32 * kk + 8 * fq), n1 = *(const f32x4*)(npv + 32 * kk + 8 * fq + 4);
                qn += bflo(qx.x) * n0[0] + bfhi(qx.x) * n0[1] + bflo(qx.y) * n0[2] + bfhi(qx.y) * n0[3] + bflo(qx.z) * n1[0] + bfhi(qx.z) * n1[1] + bflo(qx.w) * n1[2] + bfhi(qx.w) * n1[3];
#pragma unroll
                for (int v = 0; v < 8; ++v) ac[v] = MFMA16(*(const bf16x8*)(ctp + (size_t)(16 * v + fr) * HD + 32 * kk + 8 * fq), qf[kk], ac[v]);
            }
            const float dent = xfq_sum(den) + dect * xfq_sum(qn);
            const float rden = 1.f / fmaxf(fabsf(dent), emt);
            float s1 = 0.f;
#pragma unroll
            for (int v = 0; v < 8; ++v) { ah[v] = (ah[v] + ac[v] * dect) * rden; s1 += (ah[v][0] + ah[v][1]) + (ah[v][2] + ah[v][3]); }
            const float mu = xfq_sum(s1) * (1.f / HD);
            float s2 = 0.f;
#pragma unroll
            for (int v = 0; v < 8; ++v) { ah[v] = ah[v] - mu; s2 += (ah[v][0] * ah[v][0] + ah[v][1] * ah[v][1]) + (ah[v][2] * ah[v][2] + ah[v][3] * ah[v][3]); }
            const float rstd = 1.f / sqrtf(xfq_sum(s2) * (1.f / HD) + LN_EPS);
            const bf16* op = QKVO + (size_t)(r0 + t) * 2048 + 1536 + h * HD + 4 * fq;
            bf16* mp = (bf16*)(A.ws + WS_MIX) + (size_t)(r0 + t) * D + h * HD + 4 * fq;
            const float* gp = A.ml_norm_g + l * 512 + h * HD + 4 * fq;
#pragma unroll
            for (int v = 0; v < 8; ++v) { const v2u og = *(const v2u*)(op + 16 * v); const f32x4 gn = *(const f32x4*)(gp + 16 * v);
                v2u w; w.x = pk2(ah[v][0] * rstd * gn[0] * sigmoidf_(bflo(og.x)), ah[v][1] * rstd * gn[1] * sigmoidf_(bfhi(og.x)));
                w.y = pk2(ah[v][2] * rstd * gn[2] * sigmoidf_(bflo(og.y)), ah[v][3] * rstd * gn[3] * sigmoidf_(bfhi(og.y)));
                *(v2u*)(mp + 16 * v) = w; }
        }
        __syncthreads();
    }
}

constexpr int SLOT = 8192;
constexpr int NG_KB = 0, NG_IMP = 4 * SLOT * 2, NG_RING_END = 7 * SLOT * 2, NG_BT = NG_RING_END, NG_MSK = NG_BT + 8 * 132 * 4, NG_TASK = NG_MSK + NWAVES * 16, NG_JL = NG_TASK + 16, NG_END = NG_JL + 136 * 4;
static_assert(NG_IMP + NWAVES * 1088 * 4 <= NG_RING_END && NG_END <= RING_BYTES, "NSA LDS map");
constexpr int CW_NSAQ = 16384;

__device__ __forceinline__ void dma_k(const bf16* Kblk, LAS bf16* slot, int wave, int lane) {
    const int row = 8 * wave + (lane >> 3), c = (lane & 7) ^ ((row >> 1) & 7);
    __builtin_amdgcn_global_load_lds((const unsigned*)(Kblk + row * 64 + c * 8), (LAS unsigned*)(slot + wave * 512), 16, 0, 0);
}
__device__ __forceinline__ void dma_v(const bf16* Vblk, LAS bf16* slot, int wave, int lane) {
    const int row = 8 * wave + (lane >> 3), c = (lane & 7) ^ ((row >> 1) & 7);
    __builtin_amdgcn_global_load_lds((const unsigned*)(Vblk + row * 64 + c * 8), (LAS unsigned*)(slot + 4096 + wave * 512), 16, 0, 0);
}
__device__ __forceinline__ void qk_lds(const LAS bf16* kb, const bf16x8 (&q)[2], int fr, int fq, f32x4 (&st)[4]) {
    const int sw = (fr >> 1) & 7;
#pragma unroll
    for (int t = 0; t < 4; ++t) { const LAS bf16* p = kb + (16 * t + fr) * 64;
        f32x4 z = {0.f, 0.f, 0.f, 0.f}; z = MFMA16(*(const LAS bf16x8*)(p + ((fq ^ sw) << 3)), q[0], z); st[t] = MFMA16(*(const LAS bf16x8*)(p + (((4 + fq) ^ sw) << 3)), q[1], z); }
}
__device__ __forceinline__ void pv_lds(const LAS bf16* vb, int fr, int fq, const f32x4 (&st)[4], f32x4 (&o)[4]) {
    const int sw = (fr >> 1) & 7, sub = 4 * (fq & 1);
#pragma unroll
    for (int h = 0; h < 2; ++h) {
        v4u pw; pw.x = pk2(st[2 * h][0], st[2 * h][1]); pw.y = pk2(st[2 * h][2], st[2 * h][3]); pw.z = pk2(st[2 * h + 1][0], st[2 * h + 1][1]); pw.w = pk2(st[2 * h + 1][2], st[2 * h + 1][3]);
        const bf16x8 pf = __builtin_bit_cast(bf16x8, pw);
        const int c0 = 4 * h + (fq >> 1);
#pragma unroll
        for (int dt = 0; dt < 4; ++dt) { const LAS bf16* p = vb + (16 * dt + fr) * 64 + sub;
            const v2u a = *(const LAS v2u*)(p + ((c0 ^ sw) << 3)), b = *(const LAS v2u*)(p + (((c0 + 2) ^ sw) << 3)); v4u w; w.x = a.x; w.y = a.y; w.z = b.x; w.w = b.y;
            o[dt] = MFMA16(__builtin_bit_cast(bf16x8, w), pf, o[dt]); }
    }
}
__device__ __forceinline__ void softmax_pv_lds(const LAS bf16* vb, int fr, int fq, f32x4 (&st)[4], float c, f32x4 (&o)[4], float& m, float& ls) {
    float bm = fmaxf(fmaxf(st[0][0], st[0][1]), fmaxf(st[0][2], st[0][3]));
#pragma unroll
    for (int t = 1; t < 4; ++t) bm = fmaxf(bm, fmaxf(fmaxf(st[t][0], st[t][1]), fmaxf(st[t][2], st[t][3])));
    bm = xfq_max(bm + c);
    if (__any(bm > m)) {
        const float mn = fmaxf(m, bm), sc = __builtin_amdgcn_exp2f(m - mn);
        m = mn; ls *= sc;
#pragma unroll
        for (int dt = 0; dt < 4; ++dt) o[dt] = o[dt] * sc;
    }
    const float d = c - m;
#pragma unroll
    for (int t = 0; t < 4; ++t)
#pragma unroll
        for (int i = 0; i < 4; ++i) { const float p = __builtin_amdgcn_exp2f(st[t][i] + d); st[t][i] = p; ls += p; }
    pv_lds(vb, fr, fq, st, o);
}

template <int RS, bool HASV, class Addr, class Body>
__device__ __forceinline__ void staged_sweep2(int n, const Addr& ad, Body& body, LAS bf16* ring, int tid) {
    if (n <= 0) return;
    const int lane = tid & 63, wave = tid >> 6;
    constexpr int DPB = HASV ? 2 : 1;
#pragma unroll 1
    for (int i = 0; i < RS - 2 && i < n; ++i) { dma_k(ad.k(i), ring + i * SLOT, wave, lane); if (HASV) dma_v(ad.v(i), ring + i * SLOT, wave, lane); }
    const int nstep = (n + 1) >> 1;
#pragma unroll 1
    for (int s = 0; s < nstep; ++s) {
        const int i0 = 2 * s;
        if (i0 + RS - 2 <= n) { if (RS == 7) asm volatile("s_waitcnt vmcnt(%0) lgkmcnt(0)\n\ts_barrier" :: "n"((RS - 4) * DPB) : "memory"); else asm volatile("s_waitcnt vmcnt(0) lgkmcnt(0)\n\ts_barrier" ::: "memory"); }
        else asm volatile("s_waitcnt vmcnt(0) lgkmcnt(0)\n\ts_barrier" ::: "memory");
        {   const int j0 = i0 + RS - 2, j1 = j0 + 1;
            if (j0 < n) { dma_k(ad.k(j0), ring + (j0 % RS) * SLOT, wave, lane); if (HASV) dma_v(ad.v(j0), ring + (j0 % RS) * SLOT, wave, lane); }
            if (j1 < n) { dma_k(ad.k(j1), ring + (j1 % RS) * SLOT, wave, lane); if (HASV) dma_v(ad.v(j1), ring + (j1 % RS) * SLOT, wave, lane); } }
        const LAS bf16* b0 = ring + (i0 % RS) * SLOT;
        body(i0, b0, b0 + 4096);
        if (i0 + 1 < n) { const LAS bf16* b1 = ring + ((i0 + 1) % RS) * SLOT; body(i0 + 1, b1, b1 + 4096); }
    }
    asm volatile("s_waitcnt vmcnt(0) lgkmcnt(0)\n\ts_barrier" ::: "memory");
}
struct AdLin {
    const bf16* K; const bf16* V;
    __device__ __forceinline__ const bf16* k(int i) const { return K + (size_t)i * 4096; }
    __device__ __forceinline__ const bf16* v(int i) const { return V + (size_t)i * 4096; }
};
struct AdList {
    const bf16* K; const bf16* V; const LAS int* jl;
    __device__ __forceinline__ const bf16* k(int i) const { const int j = __builtin_amdgcn_readfirstlane(jl[i]); return K + (size_t)j * 4096; }
    __device__ __forceinline__ const bf16* v(int i) const { const int j = __builtin_amdgcn_readfirstlane(jl[i]); return V + (size_t)j * 4096; }
};
struct TileCtx { int fr, fq, qposA, qposB, qpos0, cur; const LAS float* bt; float farb; };
struct KF { bf16x8 k[8]; };
struct VF { v4u v[8]; };
__device__ __forceinline__ void kf_load(KF& f, const LAS bf16* kb, int fr, int fq) {
    const int sw = (fr >> 1) & 7;
#pragma unroll
    for (int t = 0; t < 4; ++t) { const LAS bf16* p = kb + (16 * t + fr) * 64; f.k[2 * t] = *(const LAS bf16x8*)(p + ((fq ^ sw) << 3)); f.k[2 * t + 1] = *(const LAS bf16x8*)(p + (((4 + fq) ^ sw) << 3)); }
}
__device__ __forceinline__ void vf_load(VF& f, const LAS bf16* vb, int fr, int fq) {
    const int sw = (fr >> 1) & 7, sub = 4 * (fq & 1);
#pragma unroll
    for (int h = 0; h < 2; ++h) {
        const int c0 = 4 * h + (fq >> 1);
#pragma unroll
        for (int dt = 0; dt < 4; ++dt) { const LAS bf16* p = vb + (16 * dt + fr) * 64 + sub;
            const v2u a = *(const LAS v2u*)(p + ((c0 ^ sw) << 3)), b = *(const LAS v2u*)(p + (((c0 + 2) ^ sw) << 3)); v4u w; w.x = a.x; w.y = a.y; w.z = b.x; w.w = b.y; f.v[4 * h + dt] = w; }
    }
}
__device__ __forceinline__ void qk2(const KF& f, const bf16x8 (&qa)[2], const bf16x8 (&qb)[2], f32x4 (&sa)[4], f32x4 (&sb)[4]) {
#pragma unroll
    for (int t = 0; t < 4; ++t) { const f32x4 z = {0.f, 0.f, 0.f, 0.f};
        sa[t] = MFMA16(f.k[2 * t + 1], qa[1], MFMA16(f.k[2 * t], qa[0], z)); sb[t] = MFMA16(f.k[2 * t + 1], qb[1], MFMA16(f.k[2 * t], qb[0], z)); }
}
__device__ __forceinline__ void pv2(const VF& f, const f32x4 (&sa)[4], const f32x4 (&sb)[4], f32x4 (&oa)[4], f32x4 (&ob)[4]) {
#pragma unroll
    for (int h = 0; h < 2; ++h) {
        v4u pa, pb;
        pa.x = pk2(sa[2 * h][0], sa[2 * h][1]); pa.y = pk2(sa[2 * h][2], sa[2 * h][3]); pa.z = pk2(sa[2 * h + 1][0], sa[2 * h + 1][1]); pa.w = pk2(sa[2 * h + 1][2], sa[2 * h + 1][3]);
        pb.x = pk2(sb[2 * h][0], sb[2 * h][1]); pb.y = pk2(sb[2 * h][2], sb[2 * h][3]); pb.z = pk2(sb[2 * h + 1][0], sb[2 * h + 1][1]); pb.w = pk2(sb[2 * h + 1][2], sb[2 * h + 1][3]);
        const bf16x8 fa = __builtin_bit_cast(bf16x8, pa), fb = __builtin_bit_cast(bf16x8, pb);
#pragma unroll
        for (int dt = 0; dt < 4; ++dt) { const bf16x8 vv = __builtin_bit_cast(bf16x8, f.v[4 * h + dt]); oa[dt] = MFMA16(vv, fa, oa[dt]); ob[dt] = MFMA16(vv, fb, ob[dt]); }
    }
}
__device__ __forceinline__ float max16(const f32x4 (&st)[4]) {
    float bm = fmaxf(fmaxf(st[0][0], st[0][1]), fmaxf(st[0][2], st[0][3]));
#pragma unroll
    for (int t = 1; t < 4; ++t) bm = fmaxf(bm, fmaxf(fmaxf(st[t][0], st[t][1]), fmaxf(st[t][2], st[t][3])));
    return bm;
}
__device__ __forceinline__ void softmax_pv2(const LAS bf16* vb, int fr, int fq, f32x4 (&sa)[4], f32x4 (&sb)[4], float ca, float cb, f32x4 (&oa)[4], f32x4 (&ob)[4], float (&m)[2], float (&ls)[2]) {
    float ba = max16(sa) + ca, bb = max16(sb) + cb;
    ba = xfq_max(ba); bb = xfq_max(bb);
    const float ma = fmaxf(m[0], ba), mb = fmaxf(m[1], bb), xa = __builtin_amdgcn_exp2f(m[0] - ma), xb = __builtin_amdgcn_exp2f(m[1] - mb);
    m[0] = ma; m[1] = mb; ls[0] *= xa; ls[1] *= xb;
#pragma unroll
    for (int dt = 0; dt < 4; ++dt) { oa[dt] = oa[dt] * xa; ob[dt] = ob[dt] * xb; }
    const float da = ca - ma, db = cb - mb;
#pragma unroll
    for (int t = 0; t < 4; ++t)
#pragma unroll
        for (int i = 0; i < 4; ++i) { const float pa = __builtin_amdgcn_exp2f(sa[t][i] + da), pb = __builtin_amdgcn_exp2f(sb[t][i] + db); sa[t][i] = pa; sb[t][i] = pb; ls[0] += pa; ls[1] += pb; }
    VF vf; vf_load(vf, vb, fr, fq);
    pv2(vf, sa, sb, oa, ob);
}
__device__ __forceinline__ void qk1(const KF& f, const bf16x8 (&q)[2], f32x4 (&st)[4]) {
#pragma unroll
    for (int t = 0; t < 4; ++t) { const f32x4 z = {0.f, 0.f, 0.f, 0.f}; st[t] = MFMA16(f.k[2 * t + 1], q[1], MFMA16(f.k[2 * t], q[0], z)); }
}
__device__ __forceinline__ void softmax_pv1(const LAS bf16* vb, int fr, int fq, f32x4 (&st)[4], float c, f32x4 (&o)[4], float& m, float& ls) {
    float bm = max16(st) + c;
    bm = xfq_max(bm);
    const float mn = fmaxf(m, bm), x = __builtin_amdgcn_exp2f(m - mn);
    m = mn; ls *= x;
#pragma unroll
    for (int dt = 0; dt < 4; ++dt) o[dt] = o[dt] * x;
    const float d = c - mn;
#pragma unroll
    for (int t = 0; t < 4; ++t)
#pragma unroll
        for (int i = 0; i < 4; ++i) { const float p = __builtin_amdgcn_exp2f(st[t][i] + d); st[t][i] = p; ls += p; }
    pv_lds(vb, fr, fq, st, o);
}
struct BodyCmpStat2 {
    const bf16x8 (&qa)[2]; const bf16x8 (&qb)[2]; const TileCtx& c; float (&ml)[2]; float (&lsl)[2];
    __device__ __forceinline__ void operator()(int ib, const LAS bf16* kb, const LAS bf16*) {
        KF kf; kf_load(kf, kb, c.fr, c.fq);
        f32x4 sa[4], sb[4]; qk2(kf, qa, qb, sa, sb);
        if (c.qpos0 - 16 * (64 * ib + 63) - 31 >= 128) {
#pragma unroll
            for (int t = 0; t < 4; ++t) { sa[t] = sa[t] + c.farb; sb[t] = sb[t] + c.farb; }
        } else {
#pragma unroll
            for (int t = 0; t < 4; ++t)
#pragma unroll
                for (int i = 0; i < 4; ++i) { const int n = 64 * ib + 16 * t + 4 * c.fq + i; const int da = c.qposA - 16 * n - 31, db = c.qposB - 16 * n - 31;
                    sa[t][i] += c.bt[da < 0 ? 129 : (da > 128 ? 128 : da)]; sb[t][i] += c.bt[db < 0 ? 129 : (db > 128 ? 128 : db)]; }
        }
        const float ma = fmaxf(ml[0], max16(sa)), mb = fmaxf(ml[1], max16(sb));
        lsl[0] *= __builtin_amdgcn_exp2f(ml[0] - ma); lsl[1] *= __builtin_amdgcn_exp2f(ml[1] - mb); ml[0] = ma; ml[1] = mb;
#pragma unroll
        for (int t = 0; t < 4; ++t)
#pragma unroll
            for (int i = 0; i < 4; ++i) { lsl[0] += __builtin_amdgcn_exp2f(sa[t][i] - ma); lsl[1] += __builtin_amdgcn_exp2f(sb[t][i] - mb); }
    }
};
struct BodyCmpProb2 {
    const bf16x8 (&qa)[2]; const bf16x8 (&qb)[2]; const TileCtx& c; f32x4 (&oa)[4]; f32x4 (&ob)[4]; float m0, m1, inv0, inv1; LAS float* imp; int tl, rr;
    __device__ __forceinline__ void operator()(int ib, const LAS bf16* kb, const LAS bf16* vb) {
        KF kf; kf_load(kf, kb, c.fr, c.fq);
        f32x4 sa[4], sb[4]; qk2(kf, qa, qb, sa, sb);
        if (c.qpos0 - 16 * (64 * ib + 63) - 31 >= 128) {
            const float da = c.farb - m0, db = c.farb - m1;
#pragma unroll
            for (int t = 0; t < 4; ++t)
#pragma unroll
                for (int i = 0; i < 4; ++i) { sa[t][i] = __builtin_amdgcn_exp2f(sa[t][i] + da) * inv0; sb[t][i] = __builtin_amdgcn_exp2f(sb[t][i] + db) * inv1; }
        } else {
#pragma unroll
            for (int t = 0; t < 4; ++t)
#pragma unroll
                for (int i = 0; i < 4; ++i) { const int n = 64 * ib + 16 * t + 4 * c.fq + i; const int da = c.qposA - 16 * n - 31, db = c.qposB - 16 * n - 31;
                    sa[t][i] = __builtin_amdgcn_exp2f(sa[t][i] + c.bt[da < 0 ? 129 : (da > 128 ? 128 : da)] - m0) * inv0;
                    sb[t][i] = __builtin_amdgcn_exp2f(sb[t][i] + c.bt[db < 0 ? 129 : (db > 128 ? 128 : db)] - m1) * inv1; }
        }
#pragma unroll
        for (int t = 0; t < 4; ++t) {
            const float a4 = quad_sum((sa[t][0] + sa[t][1]) + (sa[t][2] + sa[t][3])), a3 = quad_sum(sa[t][3]), b4 = quad_sum((sb[t][0] + sb[t][1]) + (sb[t][2] + sb[t][3])), b3 = quad_sum(sb[t][3]);
            const int j0 = 16 * ib + 4 * t + c.fq;
            if (rr == 0) { LAS float* ip = imp + tl * 136 + j0;
                __hip_atomic_fetch_add(ip, a4, __ATOMIC_RELAXED, __HIP_MEMORY_SCOPE_WORKGROUP); __hip_atomic_fetch_add(ip + 1, a3, __ATOMIC_RELAXED, __HIP_MEMORY_SCOPE_WORKGROUP);
                __hip_atomic_fetch_add(ip + 4 * 136, b4, __ATOMIC_RELAXED, __HIP_MEMORY_SCOPE_WORKGROUP); __hip_atomic_fetch_add(ip + 4 * 136 + 1, b3, __ATOMIC_RELAXED, __HIP_MEMORY_SCOPE_WORKGROUP); }
        }
        VF vf; vf_load(vf, vb, c.fr, c.fq);
        pv2(vf, sa, sb, oa, ob);
    }
};
struct BodySel2 {
    const bf16x8 (&qa)[2]; const bf16x8 (&qb)[2]; const TileCtx& c; f32x4 (&oa)[4]; f32x4 (&ob)[4]; float (&m)[2]; float (&ls)[2]; const LAS int* jl;
    unsigned long long wu0a, wu1a, wu0b, wu1b, my0a, my1a, my0b, my1b; bool dead;
    __device__ __forceinline__ void operator()(int i, const LAS bf16* kb, const LAS bf16* vb) {
        const int j = __builtin_amdgcn_readfirstlane(jl[i]);
        const bool hasa = j < 64 ? ((wu0a >> j) & 1ull) != 0ull : ((wu1a >> (j - 64)) & 1ull) != 0ull, hasb = j < 64 ? ((wu0b >> j) & 1ull) != 0ull : ((wu1b >> (j - 64)) & 1ull) != 0ull;
        if (!(hasa || hasb)) return;
        const bool minea = !dead && (j < 64 ? ((my0a >> j) & 1ull) != 0ull : ((my1a >> (j - 64)) & 1ull) != 0ull), mineb = !dead && (j < 64 ? ((my0b >> j) & 1ull) != 0ull : ((my1b >> (j - 64)) & 1ull) != 0ull);
        const bool near = j >= c.cur - 2;
        if (hasa && hasb) {
            KF kf; kf_load(kf, kb, c.fr, c.fq);
            f32x4 sa[4], sb[4]; qk2(kf, qa, qb, sa, sb);
            float ca = minea ? c.farb : -INFINITY, cb = mineb ? c.farb : -INFINITY;
            if (near) {
                ca = minea ? 0.f : -INFINITY; cb = mineb ? 0.f : -INFINITY;
#pragma unroll
                for (int t = 0; t < 4; ++t)
#pragma unroll
                    for (int e = 0; e < 4; ++e) { const int key = 64 * j + 16 * t + 4 * c.fq + e; const int da = c.qposA - key, db = c.qposB - key;
                        sa[t][e] += c.bt[da < 0 ? 129 : (da > 128 ? 128 : da)]; sb[t][e] += c.bt[db < 0 ? 129 : (db > 128 ? 128 : db)]; }
            }
            softmax_pv2(vb, c.fr, c.fq, sa, sb, ca, cb, oa, ob, m, ls);
        } else {
            const bool mine = hasa ? minea : mineb; const int qpos = hasa ? c.qposA : c.qposB;
            f32x4 st[4];
            if (hasa) qk_lds(kb, qa, c.fr, c.fq, st); else qk_lds(kb, qb, c.fr, c.fq, st);
            float cc = mine ? c.farb : -INFINITY;
            if (near) {
                cc = mine ? 0.f : -INFINITY;
#pragma unroll
                for (int t = 0; t < 4; ++t)
#pragma unroll
                    for (int e = 0; e < 4; ++e) { const int d1 = qpos - (64 * j + 16 * t + 4 * c.fq + e); st[t][e] += c.bt[d1 < 0 ? 129 : (d1 > 128 ? 128 : d1)]; }
            }
            if (hasa) softmax_pv1(vb, c.fr, c.fq, st, cc, oa, m[0], ls[0]); else softmax_pv1(vb, c.fr, c.fq, st, cc, ob, m[1], ls[1]);
        }
    }
};
struct BodyWin2 {
    const bf16x8 (&qa)[2]; const bf16x8 (&qb)[2]; const TileCtx& c; f32x4 (&oa)[4]; f32x4 (&ob)[4]; float (&m)[2]; float (&ls)[2]; int j0;
    __device__ __forceinline__ void operator()(int i, const LAS bf16* kb, const LAS bf16* vb) {
        const int j = j0 + i;
        if (c.qpos0 + 7 - 64 * j < 0 || c.qpos0 - (64 * j + 63) >= 512) return;
        KF kf; kf_load(kf, kb, c.fr, c.fq);
        f32x4 sa[4], sb[4]; qk2(kf, qa, qb, sa, sb);
        float ca = c.farb, cb = c.farb;
        const bool interior = (c.qpos0 + 7 - 64 * j < 512) && (c.qpos0 - (64 * j + 63) >= 128);
        if (!interior) {
            ca = 0.f; cb = 0.f;
#pragma unroll
            for (int t = 0; t < 4; ++t)
#pragma unroll
                for (int e = 0; e < 4; ++e) { const int key = 64 * j + 16 * t + 4 * c.fq + e; const int da = c.qposA - key, db = c.qposB - key;
                    sa[t][e] += c.bt[(unsigned)da >= 512u ? 129 : (da > 128 ? 128 : da)]; sb[t][e] += c.bt[(unsigned)db >= 512u ? 129 : (db > 128 ? 128 : db)]; }
        }
        softmax_pv2(vb, c.fr, c.fq, sa, sb, ca, cb, oa, ob, m, ls);
    }
};

__device__ __forceinline__ void nsa_group(CArgs& A, int l, int b, int g, int tg, int dbg, LAS unsigned char* lds, int tid) {
    asm volatile("" : "+v"(tid));
    const int lane = tid & 63, wave = tid >> 6, fr = lane & 15, fq = lane >> 4, tl = fr >> 2, rr = fr & 3;
    LAS bf16* ring = (LAS bf16*)(lds + NG_KB);
    LAS float* imp = (LAS float*)(lds + NG_IMP) + wave * 1088; const LAS float* BT = (const LAS float*)(lds + NG_BT);
    LAS unsigned long long* msk = (LAS unsigned long long*)(lds + NG_MSK);
    LAS int* jl = (LAS int*)(lds + NG_JL);
    const int qpos0 = 64 * tg + 8 * wave, cur = tg, row0 = b * SEQ + qpos0, h = g * 4 + rr;
    const LAS float* bt = BT + h * 132;
    const TileCtx cx{fr, fq, qpos0 + tl, qpos0 + 4 + tl, qpos0, cur, bt, bt[128]};
    bf16x8 qa[2], qb[2];
    {   const bf16* qp = (const bf16*)(A.ws + WS_NQ) + (size_t)(row0 + tl) * 512 + g * 256 + rr * 64 + 8 * fq;
        qa[0] = *(const bf16x8*)qp; qa[1] = *(const bf16x8*)(qp + 32); qb[0] = *(const bf16x8*)(qp + 4 * 512); qb[1] = *(const bf16x8*)(qp + 4 * 512 + 32); }
    f32x4 outa[4], outb[4];
    for (int i = lane; i < 1088; i += 64) imp[i] = 0.f;

    {
        const int nb64 = (4 * tg + 3 + 63) >> 6;
        const AdLin ad{(const bf16*)(A.ws + WS_KC) + l * KC_L + (size_t)g * NCB * 64 + (size_t)b * 512 * 64, (const bf16*)(A.ws + WS_VCT) + l * KC_L + (size_t)g * 64 * NCB + (size_t)b * 8 * 4096};
        float ml[2] = {-1.0e30f, -1.0e30f}, lsl[2] = {0.f, 0.f};
        { BodyCmpStat2 bd{qa, qb, cx, ml, lsl}; staged_sweep2<4, false>(nb64, ad, bd, ring, tid); }
        const float m0 = xfq_max(ml[0]), m1 = xfq_max(ml[1]);
        const float l0 = xfq_sum(lsl[0] * __builtin_amdgcn_exp2f(ml[0] - m0)), l1 = xfq_sum(lsl[1] * __builtin_amdgcn_exp2f(ml[1] - m1));
        f32x4 oa[4], ob[4];
#pragma unroll
        for (int dt = 0; dt < 4; ++dt) { oa[dt] = (f32x4){0.f, 0.f, 0.f, 0.f}; ob[dt] = (f32x4){0.f, 0.f, 0.f, 0.f}; }
        { BodyCmpProb2 bd{qa, qb, cx, oa, ob, m0, m1, l0 > 0.f ? 1.f / l0 : 0.f, l1 > 0.f ? 1.f / l1 : 0.f, imp, tl, rr}; staged_sweep2<4, true>(nb64, ad, bd, ring, tid); }
        const float* gt = (const float*)(A.ws + WS_GATE) + (size_t)(row0 + tl) * 32 + 8 + h * 3;
        const float ga = sigmoidf_(gt[0]), gb = sigmoidf_(gt[4 * 32]);
#pragma unroll
        for (int dt = 0; dt < 4; ++dt) { outa[dt] = oa[dt] * ga; outb[dt] = ob[dt] * gb; }
    }
    unsigned long long s0[8], s1[8];
#pragma unroll
    for (int t = 0; t < 8; ++t) topk_sel(imp[t * 136 + lane], imp[t * 136 + 64 + lane], cur, lane, s0[t], s1[t]);
    const unsigned long long wu0a = (s0[0] | s0[1]) | (s0[2] | s0[3]), wu1a = (s1[0] | s1[1]) | (s1[2] | s1[3]), wu0b = (s0[4] | s0[5]) | (s0[6] | s0[7]), wu1b = (s1[4] | s1[5]) | (s1[6] | s1[7]);
    const unsigned long long my0a = tl == 0 ? s0[0] : (tl == 1 ? s0[1] : (tl == 2 ? s0[2] : s0[3])), my1a = tl == 0 ? s1[0] : (tl == 1 ? s1[1] : (tl == 2 ? s1[2] : s1[3]));
    const unsigned long long my0b = tl == 0 ? s0[4] : (tl == 1 ? s0[5] : (tl == 2 ? s0[6] : s0[7])), my1b = tl == 0 ? s1[4] : (tl == 1 ? s1[5] : (tl == 2 ? s1[6] : s1[7]));
    if (lane == 0) { msk[2 * wave] = wu0a | wu0b; msk[2 * wave + 1] = wu1a | wu1b; }
    __syncthreads();
    unsigned long long gu0 = 0ull, gu1 = 0ull;
#pragma unroll
    for (int w = 0; w < NWAVES; ++w) { gu0 |= msk[2 * w]; gu1 |= msk[2 * w + 1]; }
    gu0 = __builtin_amdgcn_readfirstlane((unsigned)gu0) | ((unsigned long long)__builtin_amdgcn_readfirstlane((unsigned)(gu0 >> 32)) << 32);
    gu1 = __builtin_amdgcn_readfirstlane((unsigned)gu1) | ((unsigned long long)__builtin_amdgcn_readfirstlane((unsigned)(gu1 >> 32)) << 32);
    const int nsel0 = __popcll(gu0), nsel = nsel0 + __popcll(gu1);
    if (wave == 0) {
        const unsigned long long below = (1ull << lane) - 1ull;
        if ((gu0 >> lane) & 1ull) jl[__popcll(gu0 & below)] = lane;
        if ((gu1 >> lane) & 1ull) jl[nsel0 + __popcll(gu1 & below)] = 64 + lane;
    }
    __syncthreads();
    const float* gt = (const float*)(A.ws + WS_GATE) + (size_t)(row0 + tl) * 32 + 8 + h * 3;
    if (!(dbg & 32)) {
        float m[2] = {-1.0e30f, -1.0e30f}, ls[2] = {0.f, 0.f}; f32x4 oa[4], ob[4];
#pragma unroll
        for (int dt = 0; dt < 4; ++dt) { oa[dt] = (f32x4){0.f, 0.f, 0.f, 0.f}; ob[dt] = (f32x4){0.f, 0.f, 0.f, 0.f}; }
        const AdList ad{(const bf16*)(A.ws + WS_KS) + l * KS_L + (size_t)g * TOTS * 64 + (size_t)b * SEQ * 64, (const bf16*)(A.ws + WS_VTS) + l * KS_L + (size_t)g * 64 * TOTS + (size_t)b * 128 * 4096, jl};
        { BodySel2 bd{qa, qb, cx, oa, ob, m, ls, jl, wu0a, wu1a, wu0b, wu1b, my0a, my1a, my0b, my1b, false}; staged_sweep2<7, true>(nsel, ad, bd, ring, tid);
#if defined(REP_MASK) && ((REP_MASK >> 15) & 1)
          bd.dead = true; staged_sweep2<7, true>(nsel, ad, bd, ring, tid);
#endif
        }
        const float la = xfq_sum(ls[0]), lb = xfq_sum(ls[1]);
        const float wa = la > 0.f ? sigmoidf_(gt[1]) / la : 0.f, wb = lb > 0.f ? sigmoidf_(gt[4 * 32 + 1]) / lb : 0.f;
#pragma unroll
        for (int dt = 0; dt < 4; ++dt) { outa[dt] = outa[dt] + oa[dt] * wa; outb[dt] = outb[dt] + ob[dt] * wb; }
    }
    if (!(dbg & 64)) {
        float m[2] = {-1.0e30f, -1.0e30f}, ls[2] = {0.f, 0.f}; f32x4 oa[4], ob[4];
#pragma unroll
        for (int dt = 0; dt < 4; ++dt) { oa[dt] = (f32x4){0.f, 0.f, 0.f, 0.f}; ob[dt] = (f32x4){0.f, 0.f, 0.f, 0.f}; }
        int j0 = (64 * tg - 511) >> 6; if (j0 < 0) j0 = 0;
        const AdLin ad{(const bf16*)(A.ws + WS_KW) + l * KW_L + (size_t)g * TOTWP * 64 + ((size_t)b * SEQ + (size_t)j0 * 64) * 64, (const bf16*)(A.ws + WS_VTW) + l * KW_L + (size_t)g * 64 * TOTWP + ((size_t)b * 128 + j0) * 4096};
        { BodyWin2 bd{qa, qb, cx, oa, ob, m, ls, j0}; staged_sweep2<7, true>(cur - j0 + 1, ad, bd, ring, tid); }
        const float la = xfq_sum(ls[0]), lb = xfq_sum(ls[1]);
        const float wa = la > 0.f ? sigmoidf_(gt[2]) / la : 0.f, wb = lb > 0.f ? sigmoidf_(gt[4 * 32 + 2]) / lb : 0.f;
#pragma unroll
        for (int dt = 0; dt < 4; ++dt) { outa[dt] = outa[dt] + oa[dt] * wa; outb[dt] = outb[dt] + ob[dt] * wb; }
    }
    bf16* mp = (bf16*)(A.ws + (dbg ? WS_HRAW : WS_MIX)) + (size_t)(row0 + tl) * D + 512 + h * 64 + 4 * fq;
#pragma unroll
    for (int dt = 0; dt < 4; ++dt) { v2u w; w.x = pk2(outa[dt][0], outa[dt][1]); w.y = pk2(outa[dt][2], outa[dt][3]); *(v2u*)(mp + 16 * dt) = w;
        v2u w2; w2.x = pk2(outb[dt][0], outb[dt][1]); w2.y = pk2(outb[dt][2], outb[dt][3]); *(v2u*)(mp + 4 * D + 16 * dt) = w2; }
}

__device__ __forceinline__ void phase_nsa2(CArgs& A, int l, int rep, int sub, LAS unsigned char* lds, int tid) {
    const int lane = tid & 63, wave = tid >> 6;
    LAS float* btl = (LAS float*)(lds + NG_BT);
    LAS int* tw = (LAS int*)(lds + NG_TASK);
    for (int i = tid; i < 8 * 132; i += NTHR) btl[i] = ((const float*)(A.ws + WS_BT))[i];
    unsigned* qh = (unsigned*)(A.ws + WS_CTL) + CW_NSAQ + (l * 2 + rep) * 5 * 64;
    const int own = (blockIdx.x & 7) >> 1;
    for (int qi = 0; qi < 5; ++qi) {
        const int qsel = qi == 0 ? 4 : (qi == 1 ? own : ((own + qi - 1) & 3));
        const int qlen = qsel == 4 ? ((sub & 8) ? 2 * DB / NWAVES : 0) : ((sub & 4) ? 128 : 0);
        for (;;) {
            __syncthreads();
            if (tid == 0) tw[0] = (int)__hip_atomic_fetch_add(qh + qsel * 64, 1u, __ATOMIC_RELAXED, __HIP_MEMORY_SCOPE_AGENT);
            __syncthreads();
            const int t = tw[0];
            if (t >= qlen) break;
            if (qsel < 4) nsa_group(A, l, qsel >> 1, qsel & 1, 127 - t, A.bar_region == 1 ? (sub & ~15) : 0, lds, tid);
            else { const int tt = t * NWAVES + wave; nsa_tile(A, l, true, tt >> 1, tt & 1, 0, (LAS float*)(lds + NG_IMP) + wave * 1088, btl, lane); }
        }
    }
}

constexpr int PH_PER_LAYER = 9, PH_L0 = 3, N_PHASES = PH_L0 + DEPTH * PH_PER_LAYER;
#ifndef REP_MASK
#define REP_MASK 0
#endif
__device__ __forceinline__ int rep_count(int b) { int n = (((REP_MASK) >> b) & 1) + 1; asm volatile("" : "+s"(n)); return n; }
#if REP_MASK
#define REPS(b) _Pragma("unroll 1") for (int rep_ = 0, nrep_ = rep_count(b); rep_ < nrep_; ++rep_)
#else
#define REPS(b) for (int rep_ = 0; rep_ < 1; ++rep_)
#endif
#ifndef MK_PER_PHASE
#define MK_PER_PHASE 0
#endif

__device__ __forceinline__ int fresh_tid(int wave_s) { int lane = __builtin_amdgcn_mbcnt_hi(~0u, __builtin_amdgcn_mbcnt_lo(~0u, 0u)); asm volatile("" : "+v"(lane)); return wave_s * 64 + lane; }
__device__ __forceinline__ CArgs* kargs() { unsigned long long p = (unsigned long long)__builtin_amdgcn_kernarg_segment_ptr(); asm volatile("" : "+s"(p)); return (CArgs*)p; }
#define A (*kargs())
#define IN(k) (lo <= (k) && (k) < hi)
#define SEAM(k) do { if (IN(k) && IN((k) + 1)) xcd_barrier(bar); } while (0)
template <int l>
__device__ __forceinline__ void layer_phases(LAS unsigned char* lds, const XcdBarrier& bar, int wave_s, int G, int NGW, int lo, int hi) {
    unsigned char* ws = A.ws;
    float* const ADA = (float*)(ws + WS_ADA);
    float* const X = (float*)(ws + WS_X);
    bf16* const Z = (bf16*)(ws + WS_Z);
    bf16* const U = (bf16*)(ws + WS_U);
        const int pb_ = PH_L0 + l * PH_PER_LAYER;
        const float* adal = ADA + (size_t)l * NCOND * 6144;
        const float* xa = l == 0 ? A.x_prompt : X; const float* xb = l == 0 ? A.x_sample : X + (size_t)MP * D;
        if (IN(pb_ + 0)) {
            const int tid = fresh_tid(wave_s), lane = tid & 63, wave = __builtin_amdgcn_readfirstlane(tid >> 6), gw = blockIdx.x * NWAVES + wave; (void)lane; (void)gw;
            {
                pg8::Gemm g{U, (const bf16*)(ws + WS_WIN) + (size_t)l * NINP * D, D, D, D};
                pg8::StaticOrder S; S.init(M, NINP, G, (int)blockIdx.x);
                EpiInProj E{(bf16*)(ws + WS_QKVO), (bf16*)(ws + WS_NQ), (float*)(ws + WS_GATE), (float*)(ws + WS_KVR), (bf16*)(ws + WS_XC) + (size_t)l * 4 * XCP * 64, A.out, l};
                REPS(8) pg8::gemm_phase<EpiInProj, pg8::StaticOrder, true, true>(lds, g, S, E, tid);
            }
            if (l == 0) {
                __syncthreads();
                pg8::Gemm g{(const bf16*)(ws + WS_XC), (const bf16*)(ws + WS_W1), 2048, 1024, 2048};
                CmpOrder S{G, (int)blockIdx.x, 0, DEPTH, 4, 64};
                EpiCmpHid E{(bf16*)(ws + WS_HID), (const float*)(ws + WS_B1)};
                REPS(14) pg8::gemm_phase<EpiCmpHid, CmpOrder, true, true>(lds, g, S, E, tid);
            }
        }
        SEAM(pb_ + 0);
        if (IN(pb_ + 1)) {
            const int tid = fresh_tid(wave_s), lane = tid & 63, wave = __builtin_amdgcn_readfirstlane(tid >> 6), gw = blockIdx.x * NWAVES + wave; (void)lane; (void)gw;
            {
                SgCmpHid E{(bf16*)(ws + WS_HID) + (size_t)l * 4 * NCB * 256, (const float*)(ws + WS_B1) + l * 2 * 256};
                REPS(12) small_gemm(((const bf16*)(ws + WS_XC)) + (size_t)l * 4 * XCP * 64, (size_t)XCP * 64, 1024, ((const bf16*)(ws + WS_W1)) + (size_t)l * 2 * 256 * 2048, (size_t)256 * 2048, 2048, 2048, 4, 1024, 256, E, lds, tid);
            }
            REPS(1) { phase_m2x(A, l, lds, tid);
            __syncthreads();
            prep_layer_images(A, l, lds, gw, NGW, lane, wave); __syncthreads(); }
            if (l == 0) phase_cmp2<false>(A, 0, DEPTH, 1024, NCB - 1024, gw, NGW, lane);
        }
        SEAM(pb_ + 1);
        if (IN(pb_ + 2)) {
            const int tid = fresh_tid(wave_s), lane = tid & 63, wave = __builtin_amdgcn_readfirstlane(tid >> 6), gw = blockIdx.x * NWAVES + wave; (void)lane; (void)gw;
            REPS(2) phase_m3(A, l, tid);
            phase_cmp2<false>(A, l, 1, 0, 1024, gw, NGW, lane);
        }
        SEAM(pb_ + 2);
        if (IN(pb_ + 3)) {
            const int tid = fresh_tid(wave_s), lane = tid & 63, wave = __builtin_amdgcn_readfirstlane(tid >> 6), gw = blockIdx.x * NWAVES + wave; (void)lane; (void)gw;
            const int sub = A.pad_;
            if (sub & 1) REPS(3) { phase_m4x(A, l, lds, tid);
            __syncthreads(); }
            if (sub & 2) REPS(4) { phase_mls(A, l, lds, tid);
            __syncthreads(); }
            if (sub & 12)
            REPS(5) phase_nsa2(A, l, rep_ + (A.bar_region == 1 ? 1 : 0), sub, lds, tid);
        }
        SEAM(pb_ + 3);
        if (IN(pb_ + 4)) {
            const int tid = fresh_tid(wave_s), lane = tid & 63, wave = __builtin_amdgcn_readfirstlane(tid >> 6), gw = blockIdx.x * NWAVES + wave; (void)lane; (void)gw;
            pg8::Gemm g{(const bf16*)(ws + WS_MIX), (const bf16*)(ws + WS_WOUT) + (size_t)l * D * D, D, D, D};
            pg8::StaticOrder S; S.init(MP, D, G, (int)blockIdx.x);
            EpiResid E{xa, xb, adal + 2048, Z};
            REPS(9) pg8::gemm_phase<EpiResid, pg8::StaticOrder, true, true>(lds, g, S, E, tid);
            REPS(13) { SgResid E2{xb, adal + 2048, Z}; small_gemm(((const bf16*)(ws + WS_MIX)) + (size_t)MP * D, 0, D, (const bf16*)(ws + WS_WOUT) + (size_t)l * D * D, 0, D, D, 1, MS, D, E2, lds, tid); }
        }
        SEAM(pb_ + 4);
        if (IN(pb_ + 5)) {
            const int tid = fresh_tid(wave_s), lane = tid & 63, wave = __builtin_amdgcn_readfirstlane(tid >> 6), gw = blockIdx.x * NWAVES + wave; (void)lane; (void)gw;
            REPS(6) for (int r = gw; r < M; r += NGW) {
                const float* ad = adal + (size_t)cond_of_row(r) * 6144;
                ln_row(Z + (size_t)r * D, A.ln_g + (size_t)(l * 2 + 0) * D, A.ln_b + (size_t)(l * 2 + 0) * D, X + (size_t)r * D, ad + 3072, ad + 4096, U + (size_t)r * D, lane);
            }
        }
        SEAM(pb_ + 5);
        if (IN(pb_ + 6)) {
            const int tid = fresh_tid(wave_s), lane = tid & 63, wave = __builtin_amdgcn_readfirstlane(tid >> 6), gw = blockIdx.x * NWAVES + wave; (void)lane; (void)gw;
            pg8::Gemm g{U, (const bf16*)(ws + WS_WUP) + (size_t)l * FF * D, D, D, D};
            pg8::StaticOrder S; S.init(MP, FF, G, (int)blockIdx.x);
            EpiRelu2 E{(bf16*)(ws + WS_H)};
            REPS(10) pg8::gemm_phase<EpiRelu2, pg8::StaticOrder, true, true>(lds, g, S, E, tid);
            REPS(13) { SgRelu2 E2{(bf16*)(ws + WS_H)}; small_gemm(U + (size_t)MP * D, 0, D, (const bf16*)(ws + WS_WUP) + (size_t)l * FF * D, 0, D, D, 1, MS, FF, E2, lds, tid); }
        }
        SEAM(pb_ + 6);
        if (IN(pb_ + 7)) {
            const int tid = fresh_tid(wave_s), lane = tid & 63, wave = __builtin_amdgcn_readfirstlane(tid >> 6), gw = blockIdx.x * NWAVES + wave; (void)lane; (void)gw;
            pg8::Gemm g{(const bf16*)(ws + WS_H), (const bf16*)(ws + WS_WDN) + (size_t)l * D * FF, FF, FF, FF};
            pg8::StaticOrder S; S.init(MP, D, G, (int)blockIdx.x);
            EpiResid E{X, X + (size_t)MP * D, adal + 5120, Z};
            REPS(11) pg8::gemm_phase<EpiResid, pg8::StaticOrder, true, true>(lds, g, S, E, tid);
            REPS(13) { SgResid E2{X + (size_t)MP * D, adal + 5120, Z}; small_gemm(((const bf16*)(ws + WS_H)) + (size_t)MP * FF, 0, FF, (const bf16*)(ws + WS_WDN) + (size_t)l * D * FF, 0, FF, FF, 1, MS, D, E2, lds, tid); }
        }
        SEAM(pb_ + 7);
        if (IN(pb_ + 8)) {
            const int tid = fresh_tid(wave_s), lane = tid & 63, wave = __builtin_amdgcn_readfirstlane(tid >> 6), gw = blockIdx.x * NWAVES + wave; (void)lane; (void)gw;
            const bool last = l == DEPTH - 1;
            REPS(6) for (int r = gw; r < M; r += NGW) {
                const float* ad = adal + (size_t)NCOND * 6144 + (size_t)cond_of_row(r) * 6144;
                float* xo = last ? (r < MP ? A.out + O_YP + (size_t)r * D : A.out + O_YS + (size_t)(r - MP) * D) : X + (size_t)r * D;
                ln_row(Z + (size_t)r * D, A.ln_g + (size_t)(l * 2 + 1) * D, A.ln_b + (size_t)(l * 2 + 1) * D, xo, ad, ad + 1024, last ? (bf16*)nullptr : U + (size_t)r * D, lane);
            }
        }
        SEAM(pb_ + 8);
    }
__global__ void __launch_bounds__(NTHR, 2) fwd_kernel(Args A_unused) {
    extern __shared__ __attribute__((aligned(16))) unsigned char lds_raw[];
    LAS unsigned char* lds = (LAS unsigned char*)lds_raw;
    const int G = gridDim.x, NGW = G * NWAVES, wave_s = __builtin_amdgcn_readfirstlane(threadIdx.x >> 6);
    unsigned char* ws = A.ws;
    for (int u = threadIdx.x; u < (LDS_BYTES - LDSCTL_OFF) / 4; u += NTHR) ((LAS unsigned*)(lds + LDSCTL_OFF))[u] = 0u;
    __syncthreads();
    unsigned* barw = (unsigned*)(ws + WS_CTL) + CW_BAR + A.bar_region * XCD_BAR_WORDS;
    XcdBarrier bar; bar.bar = barw; bar.x = 0; bar.st = nullptr;
    if (!MK_PER_PHASE) bar = xcd_barrier_post(barw, (volatile LAS unsigned*)(lds + MISC_OFF) + 8);
    const int lo = A.ph_lo, hi = A.ph_hi;

    float* const ADA = (float*)(ws + WS_ADA);
    float* const X = (float*)(ws + WS_X);
    bf16* const Z = (bf16*)(ws + WS_Z);
    bf16* const U = (bf16*)(ws + WS_U);

    if (IN(0)) { const int tid = fresh_tid(wave_s), lane = tid & 63, wave = __builtin_amdgcn_readfirstlane(tid >> 6), gw = blockIdx.x * NWAVES + wave;
        REPS(7) { phase_ada(A, lds, tid); } __syncthreads();
        REPS(0) { phase_p0a(A, lds, gw, NGW, lane, wave); prep_cache_images(A, lds, gw, NGW, lane, wave); } }
    SEAM(0);
    if (IN(2)) {
        const int tid = fresh_tid(wave_s), lane = tid & 63, wave = __builtin_amdgcn_readfirstlane(tid >> 6), gw = blockIdx.x * NWAVES + wave;
        b1_reduce(A, tid);
        for (int r = gw; r < M; r += NGW) {
            const float* ad = ADA + (size_t)cond_of_row(r) * 6144;
            mod_row(r < MP ? A.x_prompt + (size_t)r * D : A.x_sample + (size_t)(r - MP) * D, ad, ad + 1024, U + (size_t)r * D, lane);
        }
    }
    SEAM(2);

    layer_phases<0>(lds, bar, wave_s, G, NGW, lo, hi);
    layer_phases<1>(lds, bar, wave_s, G, NGW, lo, hi);
    static_assert(DEPTH == 2, "two layers");
#undef IN
#undef SEAM
#undef A
}

extern "C" void kernel_launch(void* const* d_in, const int* in_sizes, int n_in, void* d_out, int out_size, void* d_ws, size_t ws_size, hipStream_t stream) {
    static int grid = 0;
    if (grid == 0) {
        if (n_in != 25 || (size_t)out_size != O_END || ws_size < WS_END) { fprintf(stderr, "kernel_launch: unexpected shapes: n_in %d out %d (want %zu) ws %zu (want >= %zu)\n", n_in, out_size, (size_t)O_END, ws_size, (size_t)WS_END); grid = -1; return; }
        int dev = 0, cus = 0, per_cu = 0;
        if (hipGetDevice(&dev) != hipSuccess || hipDeviceGetAttribute(&cus, hipDeviceAttributeMultiprocessorCount, dev) != hipSuccess) { grid = -1; return; }
        if (hipFuncSetAttribute((const void*)fwd_kernel, hipFuncAttributeMaxDynamicSharedMemorySize, LDS_BYTES) != hipSuccess) { fprintf(stderr, "kernel_launch: hipFuncSetAttribute failed\n"); grid = -1; return; }
        if (hipOccupancyMaxActiveBlocksPerMultiprocessor(&per_cu, (const void*)fwd_kernel, NTHR, LDS_BYTES) != hipSuccess || per_cu < 1) fprintf(stderr, "kernel_launch: occupancy query reports %d blocks per CU\n", per_cu);
        (void)hipGetLastError();
        grid = cus;
    }
    if (grid < 0) return;
    (void)hipMemsetAsync((char*)d_ws + WS_CTL, 0, CTL_ZERO_BYTES, stream);
    Args a{};
    a.x_prompt = (const float*)d_in[0]; a.x_sample = (const float*)d_in[1]; a.cache_cmp = (const float*)d_in[2]; a.cache_slc = (const float*)d_in[3]; a.cache_win = (const float*)d_in[4];
    a.st_C = (const float*)d_in[5]; a.st_n = (const float*)d_in[6]; a.st_m = (const float*)d_in[7]; a.page_table = (const int*)d_in[8]; a.c_prompt = (const float*)d_in[9]; a.c_sample = (const float*)d_in[10];
    a.w_ada = (const float*)d_in[11]; a.b_ada = (const float*)d_in[12]; a.w_in = (const float*)d_in[13]; a.b_gate = (const float*)d_in[14]; a.ml_norm_g = (const float*)d_in[15]; a.cmp_pe = (const float*)d_in[16];
    a.cmp_w1 = (const float*)d_in[17]; a.cmp_w2 = (const float*)d_in[18]; a.rel_bias = (const float*)d_in[19]; a.w_out = (const float*)d_in[20]; a.ln_g = (const float*)d_in[21]; a.ln_b = (const float*)d_in[22];
    a.w_up = (const float*)d_in[23]; a.w_down = (const float*)d_in[24];
    a.out = (float*)d_out; a.ws = (unsigned char*)d_ws; a.pad_ = 15;
#if MK_PER_PHASE
    for (int ph = 0; ph < N_PHASES; ++ph) { a.ph_lo = ph; a.ph_hi = ph + 1; hipLaunchKernelGGL(fwd_kernel, dim3(grid), dim3(NTHR), LDS_BYTES, stream, a); }
#else
#ifdef PROBE_DUP_PHASE
    a.ph_lo = 0; a.ph_hi = PROBE_DUP_PHASE + 1; a.bar_region = 0; hipLaunchKernelGGL(fwd_kernel, dim3(grid), dim3(NTHR), LDS_BYTES, stream, a);
    a.ph_lo = PROBE_DUP_PHASE; a.ph_hi = PROBE_DUP_PHASE + 1; a.bar_region = 1;
#ifdef PROBE_SUB
    a.pad_ = PROBE_SUB;
#endif
    hipLaunchKernelGGL(fwd_kernel, dim3(grid), dim3(NTHR), LDS_BYTES, stream, a);
    a.pad_ = 15; a.ph_lo = PROBE_DUP_PHASE + 1; a.ph_hi = N_PHASES; a.bar_region = 2; hipLaunchKernelGGL(fwd_kernel, dim3(grid), dim3(NTHR), LDS_BYTES, stream, a);
#else
    a.ph_lo = 0; a.ph_hi = N_PHASES;
    hipLaunchKernelGGL(fwd_kernel, dim3(grid), dim3(NTHR), LDS_BYTES, stream, a);
#endif
#endif
    const hipError_t le = hipPeekAtLastError();
    if (le != hipSuccess) fprintf(stderr, "kernel_launch: launch failed: %s\n", hipGetErrorName(le));
}
```

```cpp
#include <hip/hip_runtime.h>
#include <cstdio>
#include <cstdint>
namespace pg8 {
#define PG8_LAS __attribute__((address_space(3)))
typedef unsigned short bf16_t;
typedef short bf16x8 __attribute__((ext_vector_type(8)));
typedef float f32x4 __attribute__((ext_vector_type(4)));
typedef unsigned u32x4 __attribute__((ext_vector_type(4)));
constexpr int BM = 256, BK = 64, HALF = 128, HTB = HALF * BK * 2  , STAGE_BYTES = 8 * HTB, NXCD = 8, WGM = 8;

__host__ __device__ __forceinline__ int lds_byte(int r, int c) { const int st = (r >> 4) * 2 + (c >> 5), rr = r & 15, cc = c & 31, ob = rr * 64 + cc * 2; return st * 1024 + (ob ^ (((ob >> 9) & 1) << 5)); }
__host__ __device__ __forceinline__ void stage_rc(int b, int& R, int& C) { const int st = b / 1024, sb = b % 1024, swz = sb ^ (((sb >> 9) & 1) << 5); R = (st >> 1) * 16 + swz / 64; C = (st & 1) * 32 + (swz % 64) / 2; }
__host__ __device__ __forceinline__ int perm32(int rho) { const int n = rho >> 4, i = rho & 15; return 8 * (i >> 2) + 4 * n + (i & 3); }

struct Unit { int pm, pn; };
struct Gemm { const bf16_t* A; const bf16_t* Bt; int K, lda, ldb; };

struct StaticOrder {
    int nM, nN, nwg, G, c;
    __host__ __device__ void init(int M, int N, int G_, int c_) { nM = M / BM; nN = N / BM; nwg = nM * nN; G = G_; c = c_; }
    __host__ __device__ bool next(int i, Unit& u) const {
        const long L = (long)i * G + c; if (L >= nwg) return false;
        int wgid = (int)L; { const int q = nwg / NXCD, r = nwg % NXCD, xcd = wgid % NXCD, off = wgid / NXCD; wgid = (xcd < r ? xcd * (q + 1) : r * (q + 1) + (xcd - r) * q) + off; }
        const int nig = WGM * nN, gid = wgid / nig, fm = gid * WGM, gsz = (nM - fm) < WGM ? (nM - fm) : WGM;
        u.pm = fm + ((wgid % nig) % gsz); u.pn = (wgid % nig) / gsz; return true;
    }
    __device__ __forceinline__ void a_ready(const Unit&) const {}
    __device__ __forceinline__ void done(const Unit&) const {}
};

template <class Epi, class Sched, bool ALIGN_EPI = false, bool SP2 = false>
__device__ __forceinline__ void gemm_phase(PG8_LAS unsigned char* lds, const Gemm g, const Sched& S, const Epi& E, const int tid) {
    const int wid = __builtin_amdgcn_readfirstlane(tid >> 6), lane = tid & 63, wr = wid >> 2, wc = wid & 3, fr = lane & 15, fq = lane >> 4;
    const int K = g.K, nt = K / BK;
    unsigned voffA[2], voffB[2];
#pragma unroll
    for (int i = 0; i < 2; ++i) { int R, C; stage_rc(tid * 16 + i * 8192, R, C); const int Rb = Epi::PERM ? ((R & ~31) + perm32(R & 31)) : R;
        voffA[i] = (unsigned)(R * g.lda + C) * 2u; voffB[i] = (unsigned)(Rb * g.ldb + C) * 2u; }
    const size_t kstep = (size_t)(BK * 2);
    const size_t hstepA = (size_t)HALF * g.lda * 2, hstepB = (size_t)HALF * g.ldb * 2;
    const size_t tstepA = 2 * hstepA, tstepB = 2 * hstepB;
    const unsigned ldsw = (unsigned)wid * 1024u;
    const int aoff = lds_byte(wr * 64 + fr, fq * 8), boff = lds_byte(wc * 32 + fr, fq * 8);
#define PG8_SA(b, h) (((b) * 2 + (h)) * HTB)
#define PG8_SB(b, h) ((4 + (b) * 2 + (h)) * HTB)
#define PG8_STAGE(bufoff, gbase, voff) do { _Pragma("unroll") for (int _i = 0; _i < 2; ++_i) \
        __builtin_amdgcn_global_load_lds((const unsigned*)((const char*)(gbase) + (voff)[_i]), (PG8_LAS unsigned*)(lds + (bufoff) + ldsw + _i * 8192), 16, 0, 0); } while (0)
#define PG8_LDA(dst, b, h) do { _Pragma("unroll") for (int m = 0; m < 4; ++m) _Pragma("unroll") for (int k = 0; k < 2; ++k) dst[m][k] = *(const PG8_LAS bf16x8*)(lds + PG8_SA(b, h) + aoff + m * 2048 + k * 1024); } while (0)
#define PG8_LDB(dst, b, h) do { _Pragma("unroll") for (int n = 0; n < 2; ++n) _Pragma("unroll") for (int k = 0; k < 2; ++k) dst[n][k] = *(const PG8_LAS bf16x8*)(lds + PG8_SB(b, h) + boff + n * 2048 + k * 1024); } while (0)
#define PG8_MMA(ai, bj, At, Bt) do { __builtin_amdgcn_s_setprio(1); _Pragma("unroll") for (int m = 0; m < 4; ++m) _Pragma("unroll") for (int n = 0; n < 2; ++n) _Pragma("unroll") for (int k = 0; k < 2; ++k) \
        acc[ai][bj][m][n] = __builtin_amdgcn_mfma_f32_16x16x32_bf16(Bt[n][k], At[m][k], acc[ai][bj][m][n], 0, 0, 0); __builtin_amdgcn_s_setprio(0); } while (0)
#define PG8_WAIT_V(n) asm volatile("s_waitcnt vmcnt(" #n ")" ::: "memory")
#define PG8_WAIT_L(n) asm volatile("s_waitcnt lgkmcnt(" #n ")" ::: "memory")
#define PG8_BAR __builtin_amdgcn_s_barrier()
#define PG8_SCHED __builtin_amdgcn_sched_barrier(0)
    Unit cur, nxt; int ui = 0;
    if (!S.next(0, cur)) return;
    f32x4 acc[2][2][4][2];
#pragma unroll
    for (int a = 0; a < 2; ++a)
#pragma unroll
        for (int b = 0; b < 2; ++b)
#pragma unroll
            for (int m = 0; m < 4; ++m)
#pragma unroll
                for (int n = 0; n < 2; ++n) acc[a][b][m][n] = (f32x4){0.f, 0.f, 0.f, 0.f};
    bf16x8 At[4][2], B0[2][2], B1[2][2];
    const char* cA = (const char*)g.A + (size_t)cur.pm * tstepA; const char* cB = (const char*)g.Bt + (size_t)cur.pn * tstepB;
    S.a_ready(cur);
    if constexpr (SP2) {
        PG8_STAGE(PG8_SB(0, 0), cB, voffB); PG8_STAGE(PG8_SB(0, 1), cB + hstepB, voffB); PG8_STAGE(PG8_SA(0, 0), cA, voffA); PG8_STAGE(PG8_SA(0, 1), cA + hstepA, voffA);
        if (wr == 1) PG8_BAR;
        PG8_WAIT_V(2); PG8_BAR;
        PG8_STAGE(PG8_SB(1, 0), cB + kstep, voffB); PG8_STAGE(PG8_SA(1, 0), cA + kstep, voffA); PG8_STAGE(PG8_SB(1, 1), cB + hstepB + kstep, voffB);
        PG8_WAIT_V(6); PG8_BAR;
    } else {
        PG8_STAGE(PG8_SB(0, 0), cB, voffB); PG8_STAGE(PG8_SA(0, 0), cA, voffA); PG8_STAGE(PG8_SB(0, 1), cB + hstepB, voffB); PG8_STAGE(PG8_SA(0, 1), cA + hstepA, voffA);
        if (wr == 1) PG8_BAR;
        PG8_WAIT_V(4); PG8_BAR;
        PG8_STAGE(PG8_SB(1, 0), cB + kstep, voffB); PG8_STAGE(PG8_SA(1, 0), cA + kstep, voffA); PG8_STAGE(PG8_SB(1, 1), cB + hstepB + kstep, voffB);
        PG8_WAIT_V(6); PG8_BAR;
    }
    for (;;) {
        const bool has_next = S.next(ui + 1, nxt);
        const char* nA = has_next ? (const char*)g.A + (size_t)nxt.pm * tstepA : cA; const char* nB = has_next ? (const char*)g.Bt + (size_t)nxt.pn * tstepB : cB;
        for (int t = 0; t < nt; t += 2) {
            const bool last = (t == nt - 2);
            const char* a1 = cA + (size_t)(t + 1) * kstep;
            const char* a2 = last ? nA : cA + (size_t)(t + 2) * kstep; const char* b2 = last ? nB : cB + (size_t)(t + 2) * kstep;
            const char* a3 = a2 + kstep; const char* b3 = b2 + kstep;
            if (last && has_next) S.a_ready(nxt);
            if constexpr (SP2) {
            PG8_LDB(B0, 0, 0); PG8_LDB(B1, 0, 1); PG8_SCHED; PG8_LDA(At, 0, 0); PG8_STAGE(PG8_SA(1, 1), a1 + hstepA, voffA);
            PG8_WAIT_V(8); PG8_WAIT_L(0); PG8_BAR; PG8_MMA(0, 0, At, B0); PG8_MMA(0, 1, At, B1); PG8_BAR; PG8_SCHED;
            PG8_LDA(At, 0, 1); PG8_STAGE(PG8_SB(0, 0), b2, voffB); PG8_STAGE(PG8_SB(0, 1), b2 + hstepB, voffB); PG8_STAGE(PG8_SA(0, 0), a2, voffA);
            PG8_WAIT_V(8); PG8_WAIT_L(0); PG8_BAR; PG8_MMA(1, 0, At, B0); PG8_MMA(1, 1, At, B1); PG8_BAR; PG8_SCHED;
            PG8_LDB(B0, 1, 0); PG8_LDB(B1, 1, 1); PG8_SCHED; PG8_LDA(At, 1, 0); PG8_STAGE(PG8_SA(0, 1), a2 + hstepA, voffA);
            PG8_WAIT_V(8); PG8_WAIT_L(0); PG8_BAR; PG8_MMA(0, 0, At, B0); PG8_MMA(0, 1, At, B1); PG8_BAR; PG8_SCHED;
            PG8_LDA(At, 1, 1); PG8_STAGE(PG8_SB(1, 0), b3, voffB); PG8_STAGE(PG8_SB(1, 1), b3 + hstepB, voffB); PG8_STAGE(PG8_SA(1, 0), a3, voffA);
            PG8_WAIT_V(8); PG8_WAIT_L(0); PG8_BAR; PG8_MMA(1, 0, At, B0); PG8_MMA(1, 1, At, B1); PG8_BAR; PG8_SCHED;
            } else {
            PG8_LDB(B0, 0, 0); PG8_SCHED; PG8_LDA(At, 0, 0); PG8_STAGE(PG8_SA(1, 1), a1 + hstepA, voffA);
            PG8_WAIT_L(8); PG8_BAR; PG8_WAIT_L(0); PG8_MMA(0, 0, At, B0); PG8_BAR; PG8_SCHED;
            PG8_LDB(B1, 0, 1); PG8_STAGE(PG8_SB(0, 0), b2, voffB);
            PG8_BAR; PG8_WAIT_L(0); PG8_MMA(0, 1, At, B1); PG8_BAR;
            PG8_LDA(At, 0, 1); PG8_STAGE(PG8_SA(0, 0), a2, voffA);
            PG8_BAR; PG8_WAIT_L(0); PG8_MMA(1, 0, At, B0); PG8_BAR; PG8_SCHED;
            PG8_STAGE(PG8_SB(0, 1), b2 + hstepB, voffB);
            PG8_WAIT_V(6); PG8_BAR; PG8_MMA(1, 1, At, B1); PG8_BAR;
            PG8_LDB(B0, 1, 0); PG8_SCHED; PG8_LDA(At, 1, 0); PG8_STAGE(PG8_SA(0, 1), a2 + hstepA, voffA);
            PG8_WAIT_L(8); PG8_BAR; PG8_WAIT_L(0); PG8_MMA(0, 0, At, B0); PG8_BAR; PG8_SCHED;
            PG8_LDB(B1, 1, 1); PG8_STAGE(PG8_SB(1, 0), b3, voffB);
            PG8_BAR; PG8_WAIT_L(0); PG8_MMA(0, 1, At, B1); PG8_BAR;
            PG8_LDA(At, 1, 1); PG8_STAGE(PG8_SA(1, 0), a3, voffA);
            PG8_BAR; PG8_WAIT_L(0); PG8_MMA(1, 0, At, B0); PG8_BAR; PG8_SCHED;
            PG8_STAGE(PG8_SB(1, 1), b3 + hstepB, voffB);
            PG8_WAIT_V(6); PG8_BAR; PG8_MMA(1, 1, At, B1); PG8_BAR;
            }
        }
        if constexpr (ALIGN_EPI) { if (wr == 0) PG8_BAR; }
        if constexpr (!Epi::AFTER_DRAIN) { E(acc, cur, wr, wc, fr, fq); S.done(cur); }
        if (!has_next) break;
#pragma unroll
        for (int a = 0; a < 2; ++a)
#pragma unroll
            for (int b = 0; b < 2; ++b)
#pragma unroll
                for (int m = 0; m < 4; ++m)
#pragma unroll
                    for (int n = 0; n < 2; ++n) acc[a][b][m][n] = (f32x4){0.f, 0.f, 0.f, 0.f};
        cur = nxt; cA = nA; cB = nB; ++ui;
        if constexpr (ALIGN_EPI) { if (wr == 1) PG8_BAR; }
    }
    PG8_WAIT_V(0);
    if constexpr (!ALIGN_EPI) { if (wr == 0) PG8_BAR; }
    PG8_BAR;
    if constexpr (Epi::AFTER_DRAIN) { E.fused(acc, cur, wr, wc, fr, fq, lds, wid, lane); S.done(cur); }
#undef PG8_SA
#undef PG8_SB
#undef PG8_STAGE
#undef PG8_LDA
#undef PG8_LDB
#undef PG8_MMA
#undef PG8_WAIT_V
#undef PG8_WAIT_L
#undef PG8_BAR
#undef PG8_SCHED
}
}

#ifndef REP_MASK
#define REP_MASK 0
#endif

constexpr int D = 1024, BATCH = 2, SEQ = 8192, DEPTH = 2, DB = 128, DS = 4, PAST = 2048, PAGE = 128, NPG = 16, NPHYS = 2560;
constexpr int MP = BATCH * SEQ, MS = DB * DS, M = MP + MS;
constexpr int NINP = 3584, FF = 4096, NCOND = BATCH + DB;
constexpr int NH = 4, HD = 128;
constexpr int LCH = 256, NCH = SEQ / LCH, NUNIT = BATCH * NH * NCH;
constexpr int NCB = 17408;
constexpr int XCP = NCB * 16;
constexpr float ALPHA = 1.4142135623730951f;
constexpr float LN_EPS = 1e-5f;
constexpr size_t O_YP = 0, O_YS = O_YP + (size_t)MP * D, O_CMPP = O_YS + (size_t)MS * D, O_CMPS = O_CMPP + (size_t)DEPTH * MP * 256, O_SLCP = O_CMPS + (size_t)DEPTH * MS * 256,
                 O_SLCS = O_SLCP + (size_t)DEPTH * MP * 256, O_WINP = O_SLCS + (size_t)DEPTH * MS * 256, O_WINS = O_WINP + (size_t)DEPTH * BATCH * 512 * 256,
                 O_CP = O_WINS + (size_t)DEPTH * DB * 512 * 256, O_CS = O_CP + (size_t)DEPTH * BATCH * NH * HD * HD, O_NP = O_CS + (size_t)DEPTH * DB * NH * HD * HD,
                 O_NS = O_NP + (size_t)DEPTH * BATCH * NH * HD, O_MP = O_NS + (size_t)DEPTH * DB * NH * HD, O_MS = O_MP + (size_t)DEPTH * BATCH * NH, O_END = O_MS + (size_t)DEPTH * DB * NH;

constexpr size_t al1m(size_t x) { return (x + 0xFFFFFull) & ~(size_t)0xFFFFFull; }
constexpr size_t WS_CTL = 0, CTL_ZERO_BYTES = 1u << 20;
constexpr size_t WS_WIN  = CTL_ZERO_BYTES;
constexpr size_t WS_WOUT = WS_WIN  + al1m((size_t)DEPTH * NINP * D * 2);
constexpr size_t WS_WUP  = WS_WOUT + al1m((size_t)DEPTH * D * D * 2);
constexpr size_t WS_WDN  = WS_WUP  + al1m((size_t)DEPTH * FF * D * 2);
constexpr size_t WS_W1   = WS_WDN  + al1m((size_t)DEPTH * D * FF * 2);
constexpr size_t WS_ADA  = WS_W1   + al1m((size_t)DEPTH * 2 * 256 * 2048 * 2);
constexpr size_t WS_B1   = WS_ADA  + al1m((size_t)DEPTH * NCOND * 6144 * 4);
constexpr size_t WS_BT   = WS_B1   + al1m(4096);
constexpr size_t WS_X    = WS_BT   + al1m(8 * 132 * 4);
constexpr size_t WS_Z    = WS_X    + al1m((size_t)M * D * 4);
constexpr size_t WS_U    = WS_Z    + al1m((size_t)M * D * 4);
constexpr size_t WS_QKVO = WS_U    + al1m((size_t)M * D * 2);
constexpr size_t WS_NQ   = WS_QKVO + al1m((size_t)M * 2048 * 2);
constexpr size_t WS_GATE = WS_NQ   + al1m((size_t)M * 512 * 2);
constexpr size_t WS_KVR  = WS_GATE + al1m((size_t)M * 32 * 4);
constexpr size_t WS_XC   = WS_KVR  + al1m((size_t)3 * M * 256 * 4);
constexpr size_t WS_HID  = WS_XC   + al1m((size_t)DEPTH * 4 * XCP * 64 * 2 + 4096);
constexpr size_t WS_CKV  = WS_HID  + al1m((size_t)DEPTH * 4 * NCB * 256 * 2);
constexpr size_t WS_KS   = WS_CKV  + al1m((size_t)DEPTH * 4 * NCB * 64 * 4);
constexpr size_t WS_VTS  = WS_KS   + al1m((size_t)DEPTH * 2 * (MP + DB * 2112) * 64 * 2 + 65536);
constexpr size_t WS_KW   = WS_VTS  + al1m((size_t)DEPTH * 2 * (MP + DB * 2112) * 64 * 2 + 65536);
constexpr size_t WS_VTW  = WS_KW   + al1m((size_t)DEPTH * 2 * (MP + DB * 576 + 64) * 64 * 2 + 65536);
constexpr size_t WS_KC   = WS_VTW  + al1m((size_t)DEPTH * 2 * (MP + DB * 576 + 64) * 64 * 2 + 65536);
constexpr size_t WS_VCT  = WS_KC   + al1m((size_t)DEPTH * 2 * NCB * 64 * 2 + 65536);
constexpr size_t WS_W2T  = WS_VCT  + al1m((size_t)DEPTH * 2 * NCB * 64 * 2 + 65536);
constexpr size_t WS_MIX  = WS_W2T  + al1m(65536);
constexpr size_t WS_H    = WS_MIX  + al1m((size_t)M * D * 2);
constexpr size_t WS_DCT  = WS_H    + al1m((size_t)M * FF * 2);
constexpr size_t WS_DN   = WS_DCT  + al1m((size_t)NUNIT * HD * HD * 4);
constexpr size_t WS_CHS  = WS_DN   + al1m((size_t)NUNIT * HD * 4);
constexpr size_t WS_CTP  = WS_CHS  + al1m((size_t)NUNIT * 4 * 4);
constexpr size_t WS_NPV  = WS_CTP  + al1m((size_t)NUNIT * HD * HD * 2);
constexpr size_t WS_WSC  = WS_NPV  + al1m((size_t)NUNIT * HD * 4);
constexpr size_t WS_HRAW = WS_WSC  + al1m((size_t)NUNIT * LCH * LCH * 4);
constexpr size_t WS_END  = WS_HRAW + al1m((size_t)NUNIT * LCH * HD * 4);

constexpr int CW_BAR = 4096;

constexpr int RING_BYTES = 131072, LDSCTL_OFF = RING_BYTES, MISC_OFF = LDSCTL_OFF + 320, LDS_BYTES = 147456;
constexpr int NWAVES = 8, NTHR = NWAVES * 64;

#define GAS __attribute__((address_space(1)))
#define LAS __attribute__((address_space(3)))
typedef unsigned short bf16;
typedef unsigned v4u __attribute__((ext_vector_type(4)));
typedef unsigned v2u __attribute__((ext_vector_type(2)));
typedef float f32x4 __attribute__((ext_vector_type(4)));
typedef float f32x2 __attribute__((ext_vector_type(2)));

__device__ __forceinline__ unsigned f2bf(float f) { unsigned u = __builtin_bit_cast(unsigned, f); return (u + 0x7fffu + ((u >> 16) & 1u)) >> 16; }
__device__ __forceinline__ unsigned pk2(float lo, float hi) { unsigned r; asm("v_cvt_pk_bf16_f32 %0, %1, %2" : "=v"(r) : "v"(lo), "v"(hi)); return r; }
__device__ __forceinline__ float bflo(unsigned u) { return __builtin_bit_cast(float, u << 16); }
__device__ __forceinline__ float bfhi(unsigned u) { return __builtin_bit_cast(float, u & 0xffff0000u); }
__device__ __forceinline__ float bf2f(bf16 h) { return __builtin_bit_cast(float, (unsigned)h << 16); }
__device__ __forceinline__ float sigmoidf_(float x) { return 1.f / (1.f + __expf(-x)); }
__device__ __forceinline__ float wave_sum(float v) {
#pragma unroll
    for (int o = 1; o < 64; o <<= 1) v += __shfl_xor(v, o);
    return v;
}
__device__ __forceinline__ float wave_max(float v) {
#pragma unroll
    for (int o = 1; o < 64; o <<= 1) v = fmaxf(v, __shfl_xor(v, o));
    return v;
}

#define XB_TMO      128
#define XB_XCNT(j)  (256  + 64 * (j))
#define XB_XSUB(j)  (1280 + 64 * (j))
#define XB_XGEN(j)  (2304 + 64 * (j))
#define XB_TOP      3328
#define XB_TOPGEN   3392
#define XCD_BAR_WORDS 3456
#define XB_SPIN_CAP (1u << 18)

__device__ __forceinline__ unsigned xb_ld(unsigned* p)              { return __hip_atomic_load(p, __ATOMIC_RELAXED, __HIP_MEMORY_SCOPE_AGENT); }
__device__ __forceinline__ unsigned xb_add(unsigned* p, unsigned v) { return __hip_atomic_fetch_add(p, v, __ATOMIC_RELAXED, __HIP_MEMORY_SCOPE_AGENT); }
__device__ __forceinline__ unsigned xb_xcc_id() { return (unsigned)__builtin_amdgcn_s_getreg((3 << 11) | 20) & 0xFu; }
#define XB_SPIN(cond, bar) do { unsigned _sp = 0; while (cond) { __builtin_amdgcn_s_sleep(1); \
    if ((++_sp & 255u) == 0u) { if (xb_ld(&(bar)[XB_TMO])) break; if (_sp > XB_SPIN_CAP) { atomicAdd(&(bar)[XB_TMO], 1u); break; } } } } while (0)

struct XcdBarrier {
    unsigned* bar; unsigned x;
    volatile LAS unsigned* st;
};

__device__ __forceinline__ XcdBarrier xcd_barrier_post(unsigned* bar, volatile LAS unsigned* st) {
    XcdBarrier b; b.bar = bar; b.x = xb_xcc_id(); b.st = st;
    if (threadIdx.x == 0) (void)xb_add(&bar[XB_XCNT(b.x)], 1u);
    return b;
}
__device__ __forceinline__ void xcd_barrier_complete(unsigned* bar, unsigned x, unsigned& nloc, unsigned& nx) {
    const unsigned G = gridDim.x * gridDim.y * gridDim.z;
    unsigned sum, cnt, mine, sp = 0u;
    for (;;) {
        sum = 0u; cnt = 0u; mine = 0u;
#pragma unroll
        for (unsigned j = 0; j < 16; ++j) { const unsigned c = xb_ld(&bar[XB_XCNT(j)]); sum += c; cnt += (c > 0u) ? 1u : 0u; mine = (j == x) ? c : mine; }
        if (sum == G) break;
        __builtin_amdgcn_s_sleep(1);
        if ((++sp & 255u) == 0u) { if (xb_ld(&bar[XB_TMO])) break; if (sp > XB_SPIN_CAP) { atomicAdd(&bar[XB_TMO], 1u); break; } }
    }
    nloc = mine > 0u ? mine : 1u; nx = cnt > 0u ? cnt : 1u;
}

__device__ __forceinline__ void xcd_barrier(const XcdBarrier& b) {
    asm volatile("s_waitcnt vmcnt(0)" ::: "memory");
    __syncthreads();
    if (threadIdx.x == 0) {
        unsigned* bar = b.bar;
        __builtin_amdgcn_s_waitcnt(0);
        unsigned nloc = b.st[0], nx = b.st[1];
        if (nloc == 0u) { xcd_barrier_complete(bar, b.x, nloc, nx); b.st[0] = nloc; b.st[1] = nx; }
        const unsigned old = xb_add(&bar[XB_XSUB(b.x)], 1u);
        const unsigned gen = old / nloc;
        if (old + 1u == (gen + 1u) * nloc) {
            __builtin_amdgcn_fence(__ATOMIC_RELEASE, "agent");
            asm volatile("s_waitcnt vmcnt(0)" ::: "memory");
            const unsigned og = xb_add(&bar[XB_TOP], 1u);
            const unsigned tg = og / nx;
            if (og + 1u == (tg + 1u) * nx) xb_add(&bar[XB_TOPGEN], 1u);
            else XB_SPIN(xb_ld(&bar[XB_TOPGEN]) == tg, bar);
            __builtin_amdgcn_fence(__ATOMIC_ACQUIRE, "agent");
            xb_add(&bar[XB_XGEN(b.x)], 1u);
            asm volatile("s_waitcnt vmcnt(0)" ::: "memory");
        } else {
            XB_SPIN(xb_ld(&bar[XB_XGEN(b.x)]) == gen, bar);
            __builtin_amdgcn_fence(__ATOMIC_ACQUIRE, "agent");
            asm volatile("s_waitcnt vmcnt(0)" ::: "memory");
        }
    }
    __syncthreads();
}

struct Args {
    const float* x_prompt; const float* x_sample; const float* cache_cmp; const float* cache_slc; const float* cache_win;
    const float* st_C; const float* st_n; const float* st_m; const int* page_table; const float* c_prompt; const float* c_sample;
    const float* w_ada; const float* b_ada; const float* w_in; const float* b_gate; const float* ml_norm_g; const float* cmp_pe;
    const float* cmp_w1; const float* cmp_w2; const float* rel_bias; const float* w_out; const float* ln_g; const float* ln_b;
    const float* w_up; const float* w_down;
    float* out; unsigned char* ws; int ph_lo, ph_hi, bar_region, pad_;
};
static_assert(sizeof(Args) == 27 * 8 + 16, "Args has no padding");
typedef const __attribute__((address_space(4))) Args CArgs;

__device__ __forceinline__ int cond_of_row(int r) { return r < MP ? (r >> 13) : BATCH + ((r - MP) >> 2); }

struct EpiInProj {
    static constexpr bool PERM = true, AFTER_DRAIN = false;
    bf16* QKVO; bf16* NQ; float* GATE; float* KVR; bf16* XC; float* out; int l;
    __device__ __forceinline__ void operator()(const f32x4 (&acc)[2][2][4][2], const pg8::Unit& u, int wr, int wc, int fr, int fq) const {
        const int row0 = u.pm * 256 + wr * 64 + fr, pn = u.pn, col8 = wc * 32 + 8 * fq;
#pragma unroll
        for (int ai = 0; ai < 2; ++ai)
#pragma unroll
            for (int m = 0; m < 4; ++m) {
                const int r = row0 + ai * 128 + m * 16;
#pragma unroll
                for (int bj = 0; bj < 2; ++bj) {
                    const f32x4 v0 = acc[ai][bj][m][0], v1 = acc[ai][bj][m][1];
                    const int cc = bj * 128 + col8;
                    if (pn < 10) {
                        v4u w; w.x = pk2(v0[0], v0[1]); w.y = pk2(v0[2], v0[3]); w.z = pk2(v1[0], v1[1]); w.w = pk2(v1[2], v1[3]);
                        if (pn < 8) *(v4u*)(QKVO + (size_t)r * 2048 + pn * 256 + cc) = w;
                        else        *(v4u*)(NQ + (size_t)r * 512 + (pn - 8) * 256 + cc) = w;
                    } else if (pn < 13) {
                        const int kind = pn - 10;
                        float* kr = KVR + ((size_t)kind * M + r) * 256 + cc;
                        *(f32x4*)kr = v0; *(f32x4*)(kr + 4) = v1;
                        float* o = nullptr;
                        if (r < MP) {
                            if (kind < 2) o = out + (kind == 0 ? O_CMPP : O_SLCP) + ((size_t)l * MP + r) * 256 + cc;
                            else { const int t = r & (SEQ - 1); if (t >= SEQ - 512) o = out + O_WINP + (((size_t)l * BATCH + (r >> 13)) * 512 + (t - (SEQ - 512))) * 256 + cc; }
                        } else {
                            const int rs = r - MP;
                            if (kind < 2) o = out + (kind == 0 ? O_CMPS : O_SLCS) + ((size_t)l * MS + rs) * 256 + cc;
                            else o = out + O_WINS + (((size_t)l * DB + (rs >> 2)) * 512 + 508 + (rs & 3)) * 256 + cc;
                        }
                        if (o) { *(f32x4*)o = v0; *(f32x4*)(o + 4) = v1; }
                        if (kind == 0 && r < MP) {
                            v4u w; w.x = pk2(v0[0], v0[1]); w.y = pk2(v0[2], v0[3]); w.z = pk2(v1[0], v1[1]); w.w = pk2(v1[2], v1[3]);
                            *(v4u*)(XC + ((size_t)(bj * 2 + (wc >> 1)) * XCP + r) * 64 + (wc & 1) * 32 + 8 * fq) = w;
                        }
                    } else {
                        if (bj == 0 && wc == 0) { float* gp = GATE + (size_t)r * 32 + 8 * fq; *(f32x4*)gp = v0; *(f32x4*)(gp + 4) = v1; }
                    }
                }
            }
    }
};

struct EpiResid {
    static constexpr bool PERM = true, AFTER_DRAIN = false;
    const float* xa; const float* xb; const float* gate; bf16* Z;
    __device__ __forceinline__ void operator()(const f32x4 (&acc)[2][2][4][2], const pg8::Unit& u, int wr, int wc, int fr, int fq) const {
        const int row0 = u.pm * 256 + wr * 64 + fr, col0 = u.pn * 256 + wc * 32 + 8 * fq;
#pragma unroll
        for (int ai = 0; ai < 2; ++ai)
#pragma unroll
            for (int m = 0; m < 4; ++m) {
                const int r = row0 + ai * 128 + m * 16;
                const float* xr = (r < MP ? xa + (size_t)r * D : xb + (size_t)(r - MP) * D) + col0;
                const float* gr = gate + (size_t)cond_of_row(r) * 6144 + col0;
                bf16* zr = Z + (size_t)r * D + col0;
#pragma unroll
                for (int bj = 0; bj < 2; ++bj) {
                    const f32x4 x0 = *(const f32x4*)(xr + bj * 128), x1 = *(const f32x4*)(xr + bj * 128 + 4);
                    const f32x4 g0 = *(const f32x4*)(gr + bj * 128), g1 = *(const f32x4*)(gr + bj * 128 + 4);
                    const f32x4 z0 = x0 * ALPHA + g0 * acc[ai][bj][m][0], z1 = x1 * ALPHA + g1 * acc[ai][bj][m][1];
                    v4u w; w.x = pk2(z0[0], z0[1]); w.y = pk2(z0[2], z0[3]); w.z = pk2(z1[0], z1[1]); w.w = pk2(z1[2], z1[3]);
                    *(v4u*)(zr + bj * 128) = w;
                }
            }
    }
};

struct EpiRelu2 {
    static constexpr bool PERM = true, AFTER_DRAIN = false;
    bf16* H;
    __device__ __forceinline__ void operator()(const f32x4 (&acc)[2][2][4][2], const pg8::Unit& u, int wr, int wc, int fr, int fq) const {
        const int row0 = u.pm * 256 + wr * 64 + fr, col0 = u.pn * 256 + wc * 32 + 8 * fq;
#pragma unroll
        for (int ai = 0; ai < 2; ++ai)
#pragma unroll
            for (int m = 0; m < 4; ++m) {
                bf16* hr = H + (size_t)(row0 + ai * 128 + m * 16) * FF + col0;
#pragma unroll
                for (int bj = 0; bj < 2; ++bj) {
                    f32x4 a = acc[ai][bj][m][0], b = acc[ai][bj][m][1];
#pragma unroll
                    for (int i = 0; i < 4; ++i) { a[i] = fmaxf(a[i], 0.f); a[i] *= a[i]; b[i] = fmaxf(b[i], 0.f); b[i] *= b[i]; }
                    v4u w; w.x = pk2(a[0], a[1]); w.y = pk2(a[2], a[3]); w.z = pk2(b[0], b[1]); w.w = pk2(b[2], b[3]);
                    *(v4u*)(hr + bj * 128) = w;
                }
            }
    }
};

__device__ __forceinline__ float gelu_tanh(float x) {
    const float y = 0.7978845608028654f * (x + 0.044715f * x * x * x);
    const float t = 1.f - 2.f / (__expf(2.f * y) + 1.f);
    return 0.5f * x * (1.f + t);
}
struct EpiCmpHid {
    static constexpr bool PERM = true, AFTER_DRAIN = false;
    bf16* HID; const float* B1;
    __device__ __forceinline__ void operator()(const f32x4 (&acc)[2][2][4][2], const pg8::Unit& u, int wr, int wc, int fr, int fq) const {
        const int row0 = u.pm * 256 + wr * 64 + fr, col0 = wc * 32 + 8 * fq;
        const float* bp = B1 + u.pn * 256 + col0;
        f32x4 bv[2][2];
#pragma unroll
        for (int bj = 0; bj < 2; ++bj) { bv[bj][0] = *(const f32x4*)(bp + bj * 128); bv[bj][1] = *(const f32x4*)(bp + bj * 128 + 4); }
#pragma unroll
        for (int ai = 0; ai < 2; ++ai)
#pragma unroll
            for (int m = 0; m < 4; ++m) {
                bf16* hr = HID + (size_t)(row0 + ai * 128 + m * 16) * 256 + col0;
#pragma unroll
                for (int bj = 0; bj < 2; ++bj) {
                    f32x4 a = acc[ai][bj][m][0] + bv[bj][0], b = acc[ai][bj][m][1] + bv[bj][1];
#pragma unroll
                    for (int i = 0; i < 4; ++i) { a[i] = gelu_tanh(a[i]); b[i] = gelu_tanh(b[i]); }
                    v4u w; w.x = pk2(a[0], a[1]); w.y = pk2(a[2], a[3]); w.z = pk2(b[0], b[1]); w.w = pk2(b[2], b[3]);
                    *(v4u*)(hr + bj * 128) = w;
                }
            }
    }
};

struct CmpOrder {
    int G, c, l0, nl, t0, ntile;
    __device__ __forceinline__ bool next(int i, pg8::Unit& u) const {
        const int L = i * G + c; if (L >= nl * 4 * ntile) return false;
        const int blk = L / ntile, tile = L % ntile, l = l0 + (blk >> 2), sg = blk & 3;
        u.pm = (l * 4 + sg) * 68 + t0 + tile; u.pn = l * 2 + (sg >> 1); return true;
    }
    __device__ __forceinline__ void a_ready(const pg8::Unit&) const {}
    __device__ __forceinline__ void done(const pg8::Unit&) const {}
};

typedef short sg_bf16x8 __attribute__((ext_vector_type(8)));
template <class Epi>
__device__ __forceinline__ void small_gemm(const bf16* A, size_t strideA, int lda, const bf16* Bt, size_t strideB, int ldb, int K, int nbatch, int Mrows, int N, const Epi& E, LAS unsigned char* lds, int tid) {
    const int lane = tid & 63, wave = tid >> 6, fr = lane & 15, fq = lane >> 4;
    const int ntn = N / 64, ntm = Mrows / 32, ntask = nbatch * ntm * ntn, kw = K / 8;
    LAS f32x4* red = (LAS f32x4*)lds;
    for (int task = blockIdx.x; task < ntask; task += gridDim.x) {
        const int batch = task / (ntm * ntn), tr = task % (ntm * ntn), tm = tr / ntn, tn = tr % ntn;
        const bf16* ap = A + (size_t)batch * strideA + (size_t)(tm * 32 + fr) * lda + wave * kw + 8 * fq;
        const bf16* bp = Bt + (size_t)E.bsel(batch) * strideB + (size_t)(tn * 64 + fr) * ldb + wave * kw + 8 * fq;
        f32x4 acc[2][4];
#pragma unroll
        for (int i = 0; i < 2; ++i)
#pragma unroll
            for (int j = 0; j < 4; ++j) acc[i][j] = (f32x4){0.f, 0.f, 0.f, 0.f};
#pragma unroll 4
        for (int k = 0; k < kw; k += 32) {
            sg_bf16x8 af[2], bf[4];
#pragma unroll
            for (int i = 0; i < 2; ++i) af[i] = *(const sg_bf16x8*)(ap + (size_t)i * 16 * lda + k);
#pragma unroll
            for (int j = 0; j < 4; ++j) bf[j] = *(const sg_bf16x8*)(bp + (size_t)j * 16 * ldb + k);
#pragma unroll
            for (int i = 0; i < 2; ++i)
#pragma unroll
                for (int j = 0; j < 4; ++j) acc[i][j] = __builtin_amdgcn_mfma_f32_16x16x32_bf16(bf[j], af[i], acc[i][j], 0, 0, 0);
        }
        __syncthreads();
#pragma unroll
        for (int i = 0; i < 2; ++i)
#pragma unroll
            for (int j = 0; j < 4; ++j) red[(wave * 8 + i * 4 + j) * 64 + lane] = acc[i][j];
        __syncthreads();
        f32x4 sum = red[wave * 64 + lane];
#pragma unroll
        for (int w = 1; w < 8; ++w) sum = sum + red[(w * 8 + wave) * 64 + lane];
        E(batch, tm * 32 + (wave >> 2) * 16 + fr, tn * 64 + (wave & 3) * 16 + 4 * fq, sum);
    }
}
struct SgResid {
    const float* xb; const float* gate; bf16* Z;
    __device__ __forceinline__ int bsel(int) const { return 0; }
    __device__ __forceinline__ void operator()(int, int rl, int c, const f32x4& acc) const {
        const int r = MP + rl;
        const f32x4 x = *(const f32x4*)(xb + (size_t)rl * D + c), gg = *(const f32x4*)(gate + (size_t)cond_of_row(r) * 6144 + c);
        const f32x4 z = x * ALPHA + gg * acc; v2u w; w.x = pk2(z[0], z[1]); w.y = pk2(z[2], z[3]);
        *(v2u*)(Z + (size_t)r * D + c) = w;
    }
};
struct SgRelu2 {
    bf16* H;
    __device__ __forceinline__ int bsel(int) const { return 0; }
    __device__ __forceinline__ void operator()(int, int rl, int c, const f32x4& acc) const {
        f32x4 a = acc;
#pragma unroll
        for (int i = 0; i < 4; ++i) { a[i] = fmaxf(a[i], 0.f); a[i] *= a[i]; }
        v2u w; w.x = pk2(a[0], a[1]); w.y = pk2(a[2], a[3]);
        *(v2u*)(H + (size_t)(MP + rl) * FF + c) = w;
    }
};
struct SgCmpHid {
    bf16* HIDl; const float* B1l;
    __device__ __forceinline__ int bsel(int img) const { return img >> 1; }
    __device__ __forceinline__ void operator()(int img, int R, int c, const f32x4& acc) const {
        const f32x4 bb = *(const f32x4*)(B1l + (img >> 1) * 256 + c);
        f32x4 a = acc + bb;
#pragma unroll
        for (int i = 0; i < 4; ++i) a[i] = gelu_tanh(a[i]);
        v2u w; w.x = pk2(a[0], a[1]); w.y = pk2(a[2], a[3]);
        *(v2u*)(HIDl + ((size_t)img * NCB + R) * 256 + c) = w;
    }
};

#define LDS_WAIT() asm volatile("s_waitcnt lgkmcnt(0)" ::: "memory")
#define VM_WAIT() asm volatile("s_waitcnt vmcnt(0)" ::: "memory")

template <class CM>
__device__ __forceinline__ void transpose_item(const float* W, int ldw, int K, bf16* WT, LAS float* scr, int item, int nblk, int lane, const CM& cm) {
    const int kb = item / nblk, nb = item % nblk, k0 = 32 * kb, n0 = 64 * nb, c4 = (lane & 15) * 4;
    const int sc = cm.col(n0 + c4); const float scl = cm.scl(n0 + c4);
    f32x4 v[8];
#pragma unroll
    for (int i = 0; i < 8; ++i) { const int kk = 4 * i + (lane >> 4); v[i] = sc >= 0 ? *(const f32x4*)(W + (size_t)(k0 + kk) * ldw + sc) : (f32x4){0.f, 0.f, 0.f, 0.f}; }
#pragma unroll
    for (int i = 0; i < 8; ++i) { const int kk = 4 * i + (lane >> 4); LAS float* p = scr + kk * 65 + c4; p[0] = v[i][0] * scl; p[1] = v[i][1] * scl; p[2] = v[i][2] * scl; p[3] = v[i][3] * scl; }
    LDS_WAIT();
    const LAS float* s = scr + lane;
#pragma unroll
    for (int c = 0; c < 4; ++c) {
        v4u o; o.x = pk2(s[(8 * c + 0) * 65], s[(8 * c + 1) * 65]); o.y = pk2(s[(8 * c + 2) * 65], s[(8 * c + 3) * 65]); o.z = pk2(s[(8 * c + 4) * 65], s[(8 * c + 5) * 65]); o.w = pk2(s[(8 * c + 6) * 65], s[(8 * c + 7) * 65]);
        *(v4u*)(WT + (size_t)(n0 + lane) * K + k0 + 8 * c) = o; }
    LDS_WAIT();
}
struct CmId { __device__ __forceinline__ int col(int n) const { return n; } __device__ __forceinline__ float scl(int) const { return 1.f; } };
struct CmIn {
    __device__ __forceinline__ int col(int n) const { return n < 2048 ? n : (n < 3328 ? n + 8 : (n < 3336 ? n - 1280 : (n < 3360 ? n : -1))); }
    __device__ __forceinline__ float scl(int n) const { return (n >= 512 && n < 1024) ? 0.08838834764831845f : ((n >= 2048 && n < 2560) ? 0.18033688011112042f : 1.f); }
};

__device__ __forceinline__ int rel_bucket_dev(int n) {
    if (n < 16) return n;
    const float nf = (float)n;
    int large = 16 + (int)(__logf(nf / 16.f) / 2.0794415416798357f * 16.f);
    return large < 31 ? large : 31;
}

__device__ __forceinline__ void phase_p0a(CArgs& A, LAS unsigned char* lds, int gw, int NGW, int lane, int wave) {
    unsigned char* ws = A.ws;
    LAS float* scr = (LAS float*)(lds + wave * 16384);
    constexpr int I_IN = 16 * 112, I_OUT = 16 * 32, I_UP = 16 * 128, I_DN = 64 * 32, I_W1 = 32 * 8;
    constexpr int I_L = I_IN + I_OUT + I_UP + I_DN + 2 * I_W1;
    for (int it = gw; it < DEPTH * I_L; it += NGW) {
        const int l = it / I_L; int r = it % I_L;
        if (r < I_IN) { transpose_item(A.w_in + (size_t)l * D * 3360, 3360, D, (bf16*)(ws + WS_WIN) + (size_t)l * NINP * D, scr, r, 56, lane, CmIn{}); continue; } r -= I_IN;
        if (r < I_OUT) { transpose_item(A.w_out + (size_t)l * D * D, D, D, (bf16*)(ws + WS_WOUT) + (size_t)l * D * D, scr, r, 16, lane, CmId{}); continue; } r -= I_OUT;
        if (r < I_UP) { transpose_item(A.w_up + (size_t)l * D * FF, FF, D, (bf16*)(ws + WS_WUP) + (size_t)l * FF * D, scr, r, 64, lane, CmId{}); continue; } r -= I_UP;
        if (r < I_DN) { transpose_item(A.w_down + (size_t)l * FF * D, D, FF, (bf16*)(ws + WS_WDN) + (size_t)l * D * FF, scr, r, 16, lane, CmId{}); continue; } r -= I_DN;
        const int s = r / I_W1; r %= I_W1;
        transpose_item(A.cmp_w1 + (size_t)(l * 2 + s) * 2048 * 256, 256, 2048, (bf16*)(ws + WS_W1) + (size_t)(l * 2 + s) * 256 * 2048, scr, r, 4, lane, CmId{});
    }
    for (int it = gw; it < DEPTH * DB * NPG * 2; it += NGW) {
        const int half = it & 1, pg = (it >> 1) & 15, seq = (it >> 5) & 127, l = it >> 12;
        const int phys = A.page_table[seq * NPG + pg];
        const float* src = A.cache_cmp + (((size_t)l * NPHYS + phys) * PAGE + half * 64) * 256 + 4 * lane;
        const int cc = 4 * lane, s = cc >> 7, g = (cc >> 6) & 1, d = cc & 63;
        bf16* dst = (bf16*)(ws + WS_XC) + ((size_t)((l * 2 + s) * 2 + g) * XCP + MP + seq * PAST + pg * PAGE + half * 64) * 64 + d;
#pragma unroll 16
        for (int sl = 0; sl < 64; ++sl) { const f32x4 v = __builtin_nontemporal_load((const f32x4*)(src + (size_t)sl * 256)); v2u w; w.x = pk2(v[0], v[1]); w.y = pk2(v[2], v[3]); *(v2u*)(dst + (size_t)sl * 64) = w; }
    }
    for (int it = gw; it < 8; it += NGW) {
        float* BT = (float*)(ws + WS_BT) + it * 132;
        for (int dd = lane; dd < 132; dd += 64) BT[dd] = dd <= 128 ? A.rel_bias[rel_bucket_dev(dd) * 8 + it] * 1.4426950408889634f : -INFINITY;
    }
    for (int it = gw; it < DEPTH * 2 * 4 * 16; it += NGW) {
        const int kp = it & 15, hq = (it >> 4) & 3, ls = it >> 6, h = hq * 64 + lane;
        const float* pe = A.cmp_pe + (size_t)ls * 2048 + kp * 128; const float* w1 = A.cmp_w1 + ((size_t)ls * 2048 + kp * 128) * 256 + h;
        float acc = 0.f;
#pragma unroll 16
        for (int k = 0; k < 128; ++k) acc += pe[k] * w1[(size_t)k * 256];
        ((float*)(ws + WS_B1))[2048 + (ls * 16 + kp) * 256 + h] = acc;
    }
    for (int it = gw; it < DEPTH * 2 * 64; it += NGW) {
        const int d = it & 63, ls = it >> 6;
        for (int h = lane; h < 256; h += 64) ((bf16*)(ws + WS_W2T))[((size_t)ls * 64 + d) * 256 + h] = (bf16)f2bf(A.cmp_w2[((size_t)ls * 256 + h) * 64 + d]);
    }
}

__device__ __forceinline__ void b1_reduce(CArgs& A, int tid) {
    for (int i = blockIdx.x * NTHR + tid; i < DEPTH * 2 * 256; i += gridDim.x * NTHR) { const float* p = (const float*)(A.ws + WS_B1) + 2048 + (i >> 8) * 16 * 256 + (i & 255);
        float acc = 0.f;
#pragma unroll
        for (int kp = 0; kp < 16; ++kp) acc += p[kp * 256];
        ((float*)(A.ws + WS_B1))[i] = acc; }
}
__device__ __forceinline__ void phase_ada(CArgs& A, LAS unsigned char* lds, int tid) {
    LAS float* a = (LAS float*)lds;
    for (int task = blockIdx.x; task < DEPTH * 12 * 10; task += gridDim.x) {
        const int rb = task % 10, cb = (task / 10) % 12, l = task / 120;
        __syncthreads();
        for (int i = tid; i < 13 * 1024; i += NTHR) { const int row = rb * 13 + i / 1024, k = i & 1023;
            const float c = row < BATCH ? A.c_prompt[row * D + k] : A.c_sample[(row - BATCH) * D + k]; a[i] = c / (1.f + __expf(-c)); }
        __syncthreads();
        const int j = cb * 512 + tid;
        const float* w = A.w_ada + (size_t)l * D * 6144 + j;
        float acc[13];
#pragma unroll
        for (int r = 0; r < 13; ++r) acc[r] = 0.f;
        for (int k = 0; k < D; k += 4) { const float w0 = w[(size_t)k * 6144], w1 = w[(size_t)(k + 1) * 6144], w2 = w[(size_t)(k + 2) * 6144], w3 = w[(size_t)(k + 3) * 6144];
#pragma unroll
            for (int r = 0; r < 13; ++r) { const f32x4 a4 = *(const LAS f32x4*)(a + r * 1024 + k); acc[r] += (a4[0] * w0 + a4[1] * w1) + (a4[2] * w2 + a4[3] * w3); } }
        const float bb = A.b_ada[l * 6144 + j];
        float* o = (float*)(A.ws + WS_ADA) + ((size_t)l * NCOND + rb * 13) * 6144 + j;
#pragma unroll
        for (int r = 0; r < 13; ++r) o[(size_t)r * 6144] = acc[r] + bb;
    }
}

__device__ __forceinline__ void mod_row(const float* xrow, const float* sh, const float* sc, bf16* urow, int lane) {
#pragma unroll
    for (int j = 0; j < 4; ++j) { const int c = 4 * lane + 256 * j;
        const f32x4 x = *(const f32x4*)(xrow + c), a = *(const f32x4*)(sh + c), b = *(const f32x4*)(sc + c);
        v2u w; w.x = pk2(x[0] * (1.f + b[0]) + a[0], x[1] * (1.f + b[1]) + a[1]); w.y = pk2(x[2] * (1.f + b[2]) + a[2], x[3] * (1.f + b[3]) + a[3]);
        *(v2u*)(urow + c) = w; }
}
__device__ __forceinline__ void ln_row(const bf16* zrow, const float* g, const float* b, float* xout, const float* sh, const float* sc, bf16* urow, int lane) {
    f32x4 v[4]; float s = 0.f;
#pragma unroll
    for (int j = 0; j < 4; ++j) { const v2u z = *(const v2u*)(zrow + 4 * lane + 256 * j); v[j][0] = bflo(z.x); v[j][1] = bfhi(z.x); v[j][2] = bflo(z.y); v[j][3] = bfhi(z.y); s += (v[j][0] + v[j][1]) + (v[j][2] + v[j][3]); }
    const float mean = wave_sum(s) * (1.f / D); float s2 = 0.f;
#pragma unroll
    for (int j = 0; j < 4; ++j) { v[j] = v[j] - mean; s2 += (v[j][0] * v[j][0] + v[j][1] * v[j][1]) + (v[j][2] * v[j][2] + v[j][3] * v[j][3]); }
    const float rstd = 1.f / sqrtf(wave_sum(s2) * (1.f / D) + LN_EPS);
#pragma unroll
    for (int j = 0; j < 4; ++j) { const int c = 4 * lane + 256 * j;
        const f32x4 gg = *(const f32x4*)(g + c), bb = *(const f32x4*)(b + c);
        const f32x4 x = v[j] * rstd * gg + bb;
        *(f32x4*)(xout + c) = x;
        if (urow) { const f32x4 a = *(const f32x4*)(sh + c), q = *(const f32x4*)(sc + c);
            v2u w; w.x = pk2(x[0] * (1.f + q[0]) + a[0], x[1] * (1.f + q[1]) + a[1]); w.y = pk2(x[2] * (1.f + q[2]) + a[2], x[3] * (1.f + q[3]) + a[3]);
            *(v2u*)(urow + c) = w; } }
}

__device__ __forceinline__ float scan_sum256(float v, LAS float* buf, int tid) {
    const int lane = tid & 63, w = tid >> 6;
#pragma unroll
    for (int o = 1; o < 64; o <<= 1) { const float y = __shfl_up(v, o); if (lane >= o) v += y; }
    __syncthreads();
    if (lane == 63) buf[w] = v;
    __syncthreads();
    float add = 0.f;
#pragma unroll
    for (int i = 0; i < 3; ++i) if (i < w) add += buf[i];
    return v + add;
}
__device__ __forceinline__ float scan_max256(float v, LAS float* buf, int tid) {
    const int lane = tid & 63, w = tid >> 6;
#pragma unroll
    for (int o = 1; o < 64; o <<= 1) { const float y = __shfl_up(v, o); if (lane >= o) v = fmaxf(v, y); }
    __syncthreads();
    if (lane == 63) buf[w] = v;
    __syncthreads();
#pragma unroll
    for (int i = 0; i < 3; ++i) if (i < w) v = fmaxf(v, buf[i]);
    return v;
}
__device__ __forceinline__ void ml_gates(CArgs& A, int l, int r, int h, float& ig, float& lf) {
    const float* G = (const float*)(A.ws + WS_GATE) + (size_t)r * 32;
    ig = G[h] + A.b_gate[l * 8 + h];
    const float fr = G[4 + h] + A.b_gate[l * 8 + 4 + h];
    lf = fminf(fr, 0.f) - log1pf(__expf(-fabsf(fr)));
}

__device__ __forceinline__ void phase_m2(CArgs& A, int l, LAS unsigned char* lds, int tid) {
    LAS float* buf = (LAS float*)lds;
    LAS float* wl = (LAS float*)(lds + 1024);
    const bf16* QKVO = (const bf16*)(A.ws + WS_QKVO);
    for (int unit = blockIdx.x; unit < NUNIT; unit += gridDim.x) {
        const int b = unit >> 7, h = (unit >> 5) & 3, c = unit & 31, r0 = b * SEQ + c * LCH;
        float ig = 0.f, lf = 0.f;
        if (tid < 256) ml_gates(A, l, r0 + tid, h, ig, lf);
        const float F = scan_sum256(lf, buf, tid);
        __syncthreads();
        if (tid == 255) buf[16] = F;
        __syncthreads();
        const float Fend = buf[16];
        const float gl = tid < 256 ? Fend - F + ig : -3.0e38f;
        float mw = wave_max(gl);
        if ((tid & 63) == 0) buf[20 + (tid >> 6)] = mw;
        __syncthreads();
        const float mloc = fmaxf(fmaxf(buf[20], buf[21]), fmaxf(buf[22], buf[23]));
        if (tid < 256) wl[tid] = __expf(gl - mloc);
        if (tid == 0) { float* ch = (float*)(A.ws + WS_CHS) + unit * 4; ch[0] = Fend; ch[1] = mloc; }
        __syncthreads();
        const int k = tid & 127, vq = tid >> 7;
        float acc[32]; float accn = 0.f;
#pragma unroll
        for (int i = 0; i < 32; ++i) acc[i] = 0.f;
        const bf16* kp = QKVO + (size_t)r0 * 2048 + 512 + h * HD + k;
        const bf16* vp = QKVO + (size_t)r0 * 2048 + 1024 + h * HD + 32 * vq;
        for (int s = 0; s < LCH; ++s) {
            const float wk = wl[s] * bf2f(kp[(size_t)s * 2048]);
            accn += wk;
            const v4u* v4 = (const v4u*)(vp + (size_t)s * 2048);
#pragma unroll
            for (int q = 0; q < 4; ++q) { const v4u vv = v4[q];
                acc[8 * q + 0] += wk * bflo(vv.x); acc[8 * q + 1] += wk * bfhi(vv.x); acc[8 * q + 2] += wk * bflo(vv.y); acc[8 * q + 3] += wk * bfhi(vv.y);
                acc[8 * q + 4] += wk * bflo(vv.z); acc[8 * q + 5] += wk * bfhi(vv.z); acc[8 * q + 6] += wk * bflo(vv.w); acc[8 * q + 7] += wk * bfhi(vv.w); }
        }
        float* dct = (float*)(A.ws + WS_DCT) + ((size_t)unit * HD + 32 * vq) * HD + k;
#pragma unroll
        for (int i = 0; i < 32; ++i) dct[(size_t)i * HD] = acc[i];
        if (vq == 0) ((float*)(A.ws + WS_DN))[unit * HD + k] = accn;
        __syncthreads();
    }
}

__device__ __forceinline__ void phase_m3(CArgs& A, int l, int tid) {
    for (int task = blockIdx.x; task < BATCH * NH * 33; task += gridDim.x) {
        const int bh = task / 33, part = task % 33;
        const bool isn = part == 32; if (isn && tid >= HD) continue;
        const int e = isn ? tid : part * 512 + tid;
        const float* chs = (const float*)(A.ws + WS_CHS) + (size_t)bh * NCH * 4;
        float st = 0.f, m0 = 0.f;
        for (int c = 0; c < NCH; ++c) {
            const int unit = bh * NCH + c;
            const float Fend = chs[c * 4], mloc = chs[c * 4 + 1];
            float dv;
            if (isn) { ((float*)(A.ws + WS_NPV))[unit * HD + e] = st; dv = ((const float*)(A.ws + WS_DN))[unit * HD + e]; if (tid == 0) ((float*)(A.ws + WS_CHS))[unit * 4 + 2] = m0; }
            else { ((bf16*)(A.ws + WS_CTP))[(size_t)unit * HD * HD + e] = (bf16)f2bf(st); dv = ((const float*)(A.ws + WS_DCT))[(size_t)unit * HD * HD + e]; }
            const float mend = fmaxf(m0 + Fend, mloc);
            st = __expf(m0 + Fend - mend) * st + __expf(mloc - mend) * dv;
            m0 = mend;
        }
        if (isn) { A.out[O_NP + ((size_t)l * BATCH * NH + bh) * HD + e] = st; if (tid == 0) A.out[O_MP + l * BATCH * NH + bh] = m0; }
        else { const int v = e >> 7, k = e & 127; A.out[O_CP + (((size_t)l * BATCH * NH + bh) * HD + k) * HD + v] = st; }
    }
}

__device__ __forceinline__ void phase_m4(CArgs& A, int l, LAS unsigned char* lds, int tid) {
    LAS float* buf = (LAS float*)lds;
    LAS float* sa = (LAS float*)(lds + 1024);
    LAS float* smx = sa + 256;
    LAS float* sdec = smx + 256;
    LAS float* sem = sdec + 256;
    LAS bf16* sv = (LAS bf16*)(lds + 8192);
    const bf16* QKVO = (const bf16*)(A.ws + WS_QKVO);
    const int lane = tid & 63, wave = tid >> 6;
    for (int unit = blockIdx.x; unit < NUNIT; unit += gridDim.x) {
        const int b = unit >> 7, h = (unit >> 5) & 3, c = unit & 31, r0 = b * SEQ + c * LCH;
        float ig = 0.f, lf = 0.f;
        if (tid < 256) ml_gates(A, l, r0 + tid, h, ig, lf);
        const float F = scan_sum256(lf, buf, tid);
        const float a = tid < 256 ? ig - F : -3.0e38f;
        const float cm = scan_max256(a, buf, tid);
        const float m0 = ((const float*)(A.ws + WS_CHS))[unit * 4 + 2];
        if (tid < 256) { const float mx = fmaxf(m0, cm); sa[tid] = a; smx[tid] = mx; sdec[tid] = __expf(m0 - mx); sem[tid] = __expf(-(F + mx)); }
        for (int i = tid; i < LCH * HD / 8; i += NTHR) { const int s = i >> 4, q = i & 15;
            *(LAS v4u*)(sv + s * HD + 8 * q) = *(const v4u*)(QKVO + (size_t)(r0 + s) * 2048 + 1024 + h * HD + 8 * q); }
        __syncthreads();
        float* W = (float*)(A.ws + WS_WSC) + (size_t)unit * LCH * LCH;
        for (int idx = tid; idx < LCH * LCH; idx += NTHR) {
            const int t = idx >> 8, s = idx & 255; float w = 0.f;
            if (s <= t) {
                const v4u* qp = (const v4u*)(QKVO + (size_t)(r0 + t) * 2048 + h * HD); const v4u* kp = (const v4u*)(QKVO + (size_t)(r0 + s) * 2048 + 512 + h * HD);
                float d = 0.f;
#pragma unroll 4
                for (int q = 0; q < 16; ++q) { const v4u x = qp[q], y = kp[q];
                    d += bflo(x.x) * bflo(y.x) + bfhi(x.x) * bfhi(y.x) + bflo(x.y) * bflo(y.y) + bfhi(x.y) * bfhi(y.y)
                       + bflo(x.z) * bflo(y.z) + bfhi(x.z) * bfhi(y.z) + bflo(x.w) * bflo(y.w) + bfhi(x.w) * bfhi(y.w); }
                w = d * __expf(sa[s] - smx[t]);
            }
            W[idx] = w;
        }
        __syncthreads();
        {
            const int v = tid & 127, tq = tid >> 7;
            const bf16* ctp = (const bf16*)(A.ws + WS_CTP) + ((size_t)unit * HD + v) * HD;
            const float* npv = (const float*)(A.ws + WS_NPV) + unit * HD;
            float* hraw = (float*)(A.ws + WS_HRAW) + (size_t)unit * LCH * HD;
            for (int i = 0; i < 64; ++i) {
                const int t = 4 * i + tq;
                float num = 0.f, den = 0.f;
                const float* wr = W + (size_t)t * LCH;
                for (int s = 0; s <= t; s += 4) { const f32x4 w4 = *(const f32x4*)(wr + s);
                    num += w4[0] * bf2f(sv[(s + 0) * HD + v]) + w4[1] * bf2f(sv[(s + 1) * HD + v]) + w4[2] * bf2f(sv[(s + 2) * HD + v]) + w4[3] * bf2f(sv[(s + 3) * HD + v]);
                    den += (w4[0] + w4[1]) + (w4[2] + w4[3]); }
                float qc = 0.f, qn = 0.f;
                const v4u* qp = (const v4u*)(QKVO + (size_t)(r0 + t) * 2048 + h * HD);
#pragma unroll 4
                for (int q = 0; q < 16; ++q) { const v4u x = qp[q], y = *(const v4u*)(ctp + 8 * q); const f32x4 n0 = *(const f32x4*)(npv + 8 * q), n1 = *(const f32x4*)(npv + 8 * q + 4);
                    qc += bflo(x.x) * bflo(y.x) + bfhi(x.x) * bfhi(y.x) + bflo(x.y) * bflo(y.y) + bfhi(x.y) * bfhi(y.y)
                        + bflo(x.z) * bflo(y.z) + bfhi(x.z) * bfhi(y.z) + bflo(x.w) * bflo(y.w) + bfhi(x.w) * bfhi(y.w);
                    qn += bflo(x.x) * n0[0] + bfhi(x.x) * n0[1] + bflo(x.y) * n0[2] + bfhi(x.y) * n0[3] + bflo(x.z) * n1[0] + bfhi(x.z) * n1[1] + bflo(x.w) * n1[2] + bfhi(x.w) * n1[3]; }
                const float dec = sdec[t];
                const float numt = num + dec * qc, dent = den + dec * qn;
                hraw[(size_t)t * HD + v] = numt / fmaxf(fabsf(dent), sem[t]);
            }
        }
        __syncthreads();
        {
            const float* hraw = (const float*)(A.ws + WS_HRAW) + (size_t)unit * LCH * HD;
            const float g0 = A.ml_norm_g[l * 512 + h * HD + lane], g1 = A.ml_norm_g[l * 512 + h * HD + 64 + lane];
            for (int t = wave; t < LCH; t += NWAVES) {
                const float x0 = hraw[(size_t)t * HD + lane], x1 = hraw[(size_t)t * HD + 64 + lane];
                const float mu = wave_sum(x0 + x1) * (1.f / HD);
                const float d0 = x0 - mu, d1 = x1 - mu;
                const float rstd = 1.f / sqrtf(wave_sum(d0 * d0 + d1 * d1) * (1.f / HD) + LN_EPS);
                const bf16* op = QKVO + (size_t)(r0 + t) * 2048 + 1536 + h * HD;
                bf16* mp = (bf16*)(A.ws + WS_MIX) + (size_t)(r0 + t) * D + h * HD;
                mp[lane] = (bf16)f2bf(d0 * rstd * g0 * sigmoidf_(bf2f(op[lane])));
                mp[64 + lane] = (bf16)f2bf(d1 * rstd * g1 * sigmoidf_(bf2f(op[64 + lane])));
            }
        }
        __syncthreads();
    }
}

__device__ __forceinline__ void phase_mls(CArgs& A, int l, LAS unsigned char* lds, int tid) {
    LAS float* sq = (LAS float*)lds;
    LAS float* sc = sq + 1536;
    LAS float* sw = sc + 64;
    LAS float* part = sw + 16;
    LAS float* red = part + 2048;
    const bf16* QKVO = (const bf16*)(A.ws + WS_QKVO);
    for (int task = blockIdx.x; task < DB * NH; task += gridDim.x) {
        const int seq = task >> 2, h = task & 3, r0 = MP + seq * DS, sidx = (l * DB + seq) * NH + h;
        __syncthreads();
        for (int i = tid; i < 1536; i += NTHR) { const int which = i >> 9, t = (i >> 7) & 3, d = i & 127; sq[i] = bf2f(QKVO[(size_t)(r0 + t) * 2048 + which * 512 + h * HD + d]); }
        const float m0 = A.st_m[sidx];
        if (tid == 0) {
            float F = 0.f, cmx = -3.0e38f, Fs[4], igs[4], mlast = 0.f;
#pragma unroll
            for (int t = 0; t < 4; ++t) { float ig, lf; ml_gates(A, l, r0 + t, h, ig, lf); F += lf; Fs[t] = F; igs[t] = ig; const float a = ig - F; cmx = fmaxf(cmx, a); const float mx = fmaxf(m0, cmx);
                sc[8 + t] = a; sc[12 + t] = mx; sc[16 + t] = __expf(m0 - mx); sc[20 + t] = __expf(-(F + mx)); mlast = F + mx; }
#pragma unroll
            for (int t = 0; t < 4; ++t) sc[24 + t] = __expf(Fs[3] - Fs[t] + igs[t] - mlast);
            sc[28] = __expf(Fs[3] + m0 - mlast); sc[29] = mlast;
        }
        __syncthreads();
        {
            const int lane = tid & 63, wv_ = tid >> 6;
            const float* n0 = A.st_n + (size_t)sidx * HD;
#pragma unroll
            for (int j = 0; j < 3; ++j) {
                const int p = wv_ * 3 + j;
                if (p < 20) {
                    const int t = p < 16 ? p >> 2 : p - 16, s = p & 3;
                    const float x0 = sq[t * HD + lane], x1 = sq[t * HD + 64 + lane];
                    const float y0 = p < 16 ? sq[512 + s * HD + lane] : n0[lane], y1 = p < 16 ? sq[512 + s * HD + 64 + lane] : n0[64 + lane];
                    const float d = wave_sum(x0 * y0 + x1 * y1);
                    if (lane == 0) { if (p < 16) sw[p] = s <= t ? d * __expf(sc[8 + s] - sc[12 + t]) : 0.f; else sc[32 + t] = d; }
                }
            }
        }
        __syncthreads();
        {
            const int v = tid & 127, kq = tid >> 7;
            const float* C0 = A.st_C + (size_t)sidx * HD * HD + (size_t)kq * 32 * HD + v; float* Co = A.out + O_CS + (size_t)sidx * HD * HD + (size_t)kq * 32 * HD + v;
            const float cd = sc[28];
            float wv[4]; float qc[4] = {0.f, 0.f, 0.f, 0.f};
#pragma unroll
            for (int t = 0; t < 4; ++t) wv[t] = sc[24 + t] * sq[1024 + t * HD + v];
#pragma unroll
            for (int k8 = 0; k8 < 32; k8 += 8) {
                float c0[8];
#pragma unroll
                for (int i = 0; i < 8; ++i) c0[i] = C0[(size_t)(k8 + i) * HD];
#pragma unroll
                for (int i = 0; i < 8; ++i) { const int k = kq * 32 + k8 + i; float cn = cd * c0[i];
#pragma unroll
                    for (int t = 0; t < 4; ++t) { qc[t] += sq[t * HD + k] * c0[i]; cn += wv[t] * sq[512 + t * HD + k]; }
                    Co[(size_t)(k8 + i) * HD] = cn; }
            }
#pragma unroll
            for (int t = 0; t < 4; ++t) part[(kq * 4 + t) * HD + v] = qc[t];
        }
        __syncthreads();
        float hv[4] = {0.f, 0.f, 0.f, 0.f};
        if (tid < HD) {
            const int v = tid;
#pragma unroll
            for (int t = 0; t < 4; ++t) { const float qct = part[(0 * 4 + t) * HD + v] + part[(1 * 4 + t) * HD + v] + part[(2 * 4 + t) * HD + v] + part[(3 * 4 + t) * HD + v];
                float num = sc[16 + t] * qct, den = sc[16 + t] * sc[32 + t];
#pragma unroll
                for (int s = 0; s < 4; ++s) { num += sw[t * 4 + s] * sq[1024 + s * HD + v]; den += sw[t * 4 + s]; }
                hv[t] = num / fmaxf(fabsf(den), sc[20 + t]); }
        }
#pragma unroll
        for (int t = 0; t < 4; ++t) { const float s1 = wave_sum(hv[t]); if ((tid & 63) == 0 && tid < HD) red[t * 2 + (tid >> 6)] = s1; }
        __syncthreads();
        float dv[4];
#pragma unroll
        for (int t = 0; t < 4; ++t) { dv[t] = hv[t] - (red[t * 2] + red[t * 2 + 1]) * (1.f / HD); const float s2 = wave_sum(dv[t] * dv[t]); if ((tid & 63) == 0 && tid < HD) red[8 + t * 2 + (tid >> 6)] = s2; }
        __syncthreads();
        if (tid < HD) {
            const int v = tid; const float gn = A.ml_norm_g[l * 512 + h * HD + v];
#pragma unroll
            for (int t = 0; t < 4; ++t) { const float rstd = 1.f / sqrtf((red[8 + t * 2] + red[8 + t * 2 + 1]) * (1.f / HD) + LN_EPS);
                const float og = bf2f(QKVO[(size_t)(r0 + t) * 2048 + 1536 + h * HD + v]);
                ((bf16*)(A.ws + WS_MIX))[(size_t)(r0 + t) * D + h * HD + v] = (bf16)f2bf(dv[t] * rstd * gn * sigmoidf_(og)); }
        } else if (tid < 2 * HD) {
            const int k = tid - HD; float nn = sc[28] * A.st_n[(size_t)sidx * HD + k];
#pragma unroll
            for (int t = 0; t < 4; ++t) nn += sc[24 + t] * sq[512 + t * HD + k];
            A.out[O_NS + (size_t)sidx * HD + k] = nn;
        }
        if (tid == 0) A.out[O_MS + sidx] = sc[29];
    }
}

typedef short bf16x8c __attribute__((ext_vector_type(8)));
template <bool FROMY>
__device__ __forceinline__ void phase_cmp2(CArgs& A, int l0, int nl, int r_lo, int nrows, int gw, int NGW, int lane) {
    const int fr = lane & 15, fq = lane >> 4, ntile = nrows / 16;
    for (int task = gw; task < nl * 4 * ntile; task += NGW) {
        const int img = task / ntile, tr = task % ntile, l = l0 + (img >> 2), sg = img & 3, s = sg >> 1, g = sg & 1, R0 = r_lo + tr * 16;
        const bf16* hp = (const bf16*)(A.ws + WS_HID) + ((size_t)(l * 4 + sg) * NCB + R0 + fr) * 256 + 8 * fq;
        const bf16* wp = (const bf16*)(A.ws + WS_W2T) + ((size_t)(l * 2 + s) * 64 + fr) * 256 + 8 * fq;
        f32x4 acc[4];
#pragma unroll
        for (int dt = 0; dt < 4; ++dt) acc[dt] = (f32x4){0.f, 0.f, 0.f, 0.f};
#pragma unroll
        for (int ks = 0; ks < 8; ++ks) {
            bf16x8c hf;
            if (FROMY) {
                const bf16* yp = (const bf16*)(A.ws + WS_HID) + ((size_t)(l * 4 + sg) * NCB + R0 + fr) * 512 + 32 * ks + 8 * fq;
                const v4u yt = *(const v4u*)yp, yb = *(const v4u*)(yp + 512 + 256);
                const float* bp = (const float*)(A.ws + WS_B1) + (l * 2 + s) * 256 + 32 * ks + 8 * fq;
                const f32x4 b0 = *(const f32x4*)bp, b1 = *(const f32x4*)(bp + 4);
                v4u hw;
                hw.x = pk2(gelu_tanh(bflo(yt.x) + bflo(yb.x) + b0[0]), gelu_tanh(bfhi(yt.x) + bfhi(yb.x) + b0[1])); hw.y = pk2(gelu_tanh(bflo(yt.y) + bflo(yb.y) + b0[2]), gelu_tanh(bfhi(yt.y) + bfhi(yb.y) + b0[3]));
                hw.z = pk2(gelu_tanh(bflo(yt.z) + bflo(yb.z) + b1[0]), gelu_tanh(bfhi(yt.z) + bfhi(yb.z) + b1[1])); hw.w = pk2(gelu_tanh(bflo(yt.w) + bflo(yb.w) + b1[2]), gelu_tanh(bfhi(yt.w) + bfhi(yb.w) + b1[3]));
                hf = __builtin_bit_cast(bf16x8c, hw);
            } else hf = *(const bf16x8c*)(hp + 32 * ks);
#pragma unroll
            for (int dt = 0; dt < 4; ++dt) { const bf16x8c wf = *(const bf16x8c*)(wp + (size_t)dt * 16 * 256 + 32 * ks);
                acc[dt] = s == 0 ? __builtin_amdgcn_mfma_f32_16x16x32_bf16(wf, hf, acc[dt], 0, 0, 0) : __builtin_amdgcn_mfma_f32_16x16x32_bf16(hf, wf, acc[dt], 0, 0, 0); }
        }
        if (s == 0) {
            bf16* o = (bf16*)(A.ws + WS_KC) + ((size_t)(l * 2 + g) * NCB + R0 + fr) * 64 + 4 * fq;
#pragma unroll
            for (int dt = 0; dt < 4; ++dt) { v2u w; w.x = pk2(acc[dt][0], acc[dt][1]); w.y = pk2(acc[dt][2], acc[dt][3]); *(v2u*)(o + 16 * dt) = w; }
        } else {
            bf16* o = (bf16*)(A.ws + WS_VCT) + (size_t)(l * 2 + g) * 64 * NCB + (size_t)(R0 >> 6) * 4096 + fr * 64 + (R0 & 63) + 4 * fq;
#pragma unroll
            for (int dt = 0; dt < 4; ++dt) { v2u w; w.x = pk2(acc[dt][0], acc[dt][1]); w.y = pk2(acc[dt][2], acc[dt][3]); *(v2u*)(o + dt * 16 * 64) = w; }
        }
    }
}

__device__ __forceinline__ void topk_sel(float imp0, float imp1, int cur, int lane, unsigned long long& s0, unsigned long long& s1) {
    const int nforced = cur == 0 ? 1 : (cur == 1 ? 2 : 3), need = 16 - nforced, ncand = cur - 2 > 0 ? cur - 2 : 0;
    const unsigned k0 = (lane >= 1 && lane <= cur - 2) ? __builtin_bit_cast(unsigned, imp0) + 1u : 0u;
    const unsigned k1 = (lane + 64 <= cur - 2) ? __builtin_bit_cast(unsigned, imp1) + 1u : 0u;
    unsigned long long c0, c1;
    if (ncand <= need) { c0 = __ballot(k0 != 0u); c1 = __ballot(k1 != 0u); }
    else {
        unsigned T = 0u;
        for (int bit = 31; bit >= 0; --bit) { const unsigned cand = T | (1u << bit);
            const int cnt = __popcll(__ballot(k0 >= cand)) + __popcll(__ballot(k1 >= cand)); if (cnt >= need) T = cand; }
        const unsigned long long g0 = __ballot(k0 > T), g1 = __ballot(k1 > T); unsigned long long e0 = __ballot(k0 == T), e1 = __ballot(k1 == T);
        int rem = need - __popcll(g0) - __popcll(g1);
        unsigned long long t0 = 0ull, t1 = 0ull;
        while (rem > 0 && e0) { const unsigned long long lb = e0 & (~e0 + 1ull); t0 |= lb; e0 ^= lb; --rem; }
        while (rem > 0 && e1) { const unsigned long long lb = e1 & (~e1 + 1ull); t1 |= lb; e1 ^= lb; --rem; }
        c0 = g0 | t0; c1 = g1 | t1;
    }
    unsigned long long f0 = 1ull, f1 = 0ull;
    if (cur < 64) f0 |= 1ull << cur; else f1 |= 1ull << (cur - 64);
    if (cur >= 1) { if (cur - 1 < 64) f0 |= 1ull << (cur - 1); else f1 |= 1ull << (cur - 65); }
    s0 = c0 | f0; s1 = c1 | f1;
}


typedef short bf16x8 __attribute__((ext_vector_type(8)));
#define MFMA16(a, b, c) __builtin_amdgcn_mfma_f32_16x16x32_bf16((a), (b), (c), 0, 0, 0)
constexpr int TOTS = MP + DB * 2112, WSTR = 576, TOTW = MP + DB * WSTR, TOTWP = TOTW + 64;
constexpr size_t KS_L = (size_t)2 * TOTS * 64, KW_L = (size_t)2 * TOTWP * 64, KC_L = (size_t)2 * NCB * 64;

template <int NP>
__device__ __forceinline__ void kv_tile(const float* src, bf16* Kimg, size_t kgs, bf16* Vt, size_t vgs, size_t vpitch, size_t gp0, LAS bf16* scr, int lane, float* cdst = nullptr, int cskip = 0) {
    const int cc = 4 * lane, s = cc >> 7, g = (cc >> 6) & 1, d = cc & 63;
#pragma unroll 16
    for (int sl = 0; sl < NP; ++sl) {
        const f32x4 v = __builtin_nontemporal_load((const f32x4*)(src + (size_t)sl * 256 + cc));
        if (cdst && sl >= cskip) __builtin_nontemporal_store(v, (f32x4*)(cdst + (size_t)sl * 256 + cc));
        v2u w; w.x = pk2(v[0], v[1]); w.y = pk2(v[2], v[3]);
        if (s == 0) *(v2u*)(Kimg + (size_t)g * kgs + (gp0 + sl) * 64 + d) = w;
        else *(LAS v2u*)(scr + sl * 128 + (cc - 128)) = w;
    }
    LDS_WAIT();
#pragma unroll
    for (int g2 = 0; g2 < 2; ++g2) {
        const int gd = lane + 64 * g2;
        bf16* dst = Vt + (size_t)g2 * vgs + (gp0 >> 6) * 4096 + (size_t)lane * 64 + (gp0 & 63);
#pragma unroll
        for (int oc = 0; oc < NP / 8; ++oc) {
            const LAS bf16* p = scr + (8 * oc) * 128 + gd;
            v4u o; o.x = (unsigned)p[0] | ((unsigned)p[128] << 16); o.y = (unsigned)p[256] | ((unsigned)p[384] << 16); o.z = (unsigned)p[512] | ((unsigned)p[640] << 16); o.w = (unsigned)p[768] | ((unsigned)p[896] << 16);
            *(v4u*)(dst + 8 * oc) = o;
        }
    }
    LDS_WAIT();
}
#define kv_tile64 kv_tile<64>

__device__ __forceinline__ void prep_cache_images(CArgs& A, LAS unsigned char* lds, int gw, int NGW, int lane, int wave) {
    LAS bf16* scr = (LAS bf16*)(lds + wave * 16384);
    bf16* KS = (bf16*)(A.ws + WS_KS); bf16* VTS = (bf16*)(A.ws + WS_VTS); bf16* KW = (bf16*)(A.ws + WS_KW); bf16* VTW = (bf16*)(A.ws + WS_VTW);
    for (int it = gw; it < DEPTH * DB * 32; it += NGW) {
        const int ti = it & 31, seq = (it >> 5) & 127, l = it >> 12;
        const int phys = A.page_table[seq * NPG + (ti >> 1)];
        const float* src = A.cache_slc + (((size_t)l * NPHYS + phys) * PAGE + (ti & 1) * 64) * 256;
        kv_tile64(src, KS + l * KS_L, (size_t)TOTS * 64, VTS + l * KS_L, (size_t)64 * TOTS, TOTS, (size_t)MP + seq * 2112 + ti * 64, scr, lane);
    }
    for (int it = gw; it < DEPTH * DB * 8; it += NGW) {
        const int ti = it & 7, ls = it >> 3, seq = ls & 127, l = ls >> 7;
        const float* src = A.cache_win + ((size_t)ls * 512 + ti * 64) * 256;
        kv_tile64(src, KW + l * KW_L, (size_t)TOTWP * 64, VTW + l * KW_L, (size_t)64 * TOTWP, TOTWP, (size_t)MP + seq * WSTR + ti * 64, scr, lane,
                  A.out + O_WINS + ((size_t)ls * 512 + ti * 64) * 256 - 4 * 256, ti == 0 ? 4 : 0);
    }
}
__device__ __forceinline__ void prep_layer_images(CArgs& A, int l, LAS unsigned char* lds, int gw, int NGW, int lane, int wave) {
    LAS bf16* scr = (LAS bf16*)(lds + wave * 16384);
    bf16* KS = (bf16*)(A.ws + WS_KS) + l * KS_L; bf16* VTS = (bf16*)(A.ws + WS_VTS) + l * KS_L; bf16* KW = (bf16*)(A.ws + WS_KW) + l * KW_L; bf16* VTW = (bf16*)(A.ws + WS_VTW) + l * KW_L;
    const float* KVR = (const float*)(A.ws + WS_KVR);
    for (int it = gw; it < 2 * (MP / 16); it += NGW) {
        const int kind = it / (MP / 16), ti = it % (MP / 16);
        const float* src = KVR + ((size_t)(1 + kind) * M + ti * 16) * 256;
        if (kind == 0) kv_tile<16>(src, KS, (size_t)TOTS * 64, VTS, (size_t)64 * TOTS, TOTS, (size_t)ti * 16, scr, lane);
        else           kv_tile<16>(src, KW, (size_t)TOTWP * 64, VTW, (size_t)64 * TOTWP, TOTWP, (size_t)ti * 16, scr, lane);
    }
    for (int it = gw; it < 2 * DB; it += NGW) {
        const int kind = it / DB, seq = it % DB;
        const float* src = KVR + ((size_t)(1 + kind) * M + MP + seq * DS) * 256;
        bf16* Kimg = kind == 0 ? KS : KW; bf16* Vt = kind == 0 ? VTS : VTW;
        const size_t tot = kind == 0 ? TOTS : TOTWP, gp0 = kind == 0 ? (size_t)MP + seq * 2112 + PAST : (size_t)MP + seq * WSTR + 512;
        const int cc = 4 * lane, s = cc >> 7, g = (cc >> 6) & 1, d = cc & 63;
#pragma unroll
        for (int t = 0; t < DS; ++t) {
            const f32x4 v = *(const f32x4*)(src + (size_t)t * 256 + cc);
            if (s == 0) { v2u w; w.x = pk2(v[0], v[1]); w.y = pk2(v[2], v[3]); *(v2u*)(Kimg + (size_t)g * tot * 64 + (gp0 + t) * 64 + d) = w; }
            else {
#pragma unroll
                for (int i = 0; i < 4; ++i) Vt[(size_t)g * 64 * tot + ((gp0 + t) >> 6) * 4096 + (size_t)(d + i) * 64 + ((gp0 + t) & 63)] = (bf16)f2bf(v[i]);
            }
        }
    }
}

struct KV { bf16x8 k[8]; v4u v[8]; };
__device__ __forceinline__ void k_load(KV& f, const bf16* Kb, int fr, int fq) {
#pragma unroll
    for (int t = 0; t < 4; ++t) { f.k[2 * t] = *(const bf16x8*)(Kb + (size_t)(16 * t + fr) * 64 + 8 * fq); f.k[2 * t + 1] = *(const bf16x8*)(Kb + (size_t)(16 * t + fr) * 64 + 32 + 8 * fq); }
}
__device__ __forceinline__ void v_load(KV& f, const bf16* Vb, size_t pitch, int fr, int fq) {
#pragma unroll
    for (int h = 0; h < 2; ++h)
#pragma unroll
        for (int dt = 0; dt < 4; ++dt) { const bf16* vp = Vb + (size_t)(16 * dt + fr) * pitch + 32 * h + 4 * fq;
            const v2u a = *(const v2u*)vp, b = *(const v2u*)(vp + 16); v4u w; w.x = a.x; w.y = a.y; w.z = b.x; w.w = b.y; f.v[4 * h + dt] = w; }
}
__device__ __forceinline__ void qk_frag(const KV& f, const bf16x8 (&q)[2], f32x4 (&st)[4]) {
#pragma unroll
    for (int t = 0; t < 4; ++t) { f32x4 z = {0.f, 0.f, 0.f, 0.f}; z = MFMA16(f.k[2 * t], q[0], z); st[t] = MFMA16(f.k[2 * t + 1], q[1], z); }
}
__device__ __forceinline__ void pv_frag(const KV& f, const f32x4 (&st)[4], f32x4 (&o)[4]) {
#pragma unroll
    for (int h = 0; h < 2; ++h) {
        v4u pw; pw.x = pk2(st[2 * h][0], st[2 * h][1]); pw.y = pk2(st[2 * h][2], st[2 * h][3]); pw.z = pk2(st[2 * h + 1][0], st[2 * h + 1][1]); pw.w = pk2(st[2 * h + 1][2], st[2 * h + 1][3]);
        const bf16x8 pf = __builtin_bit_cast(bf16x8, pw);
#pragma unroll
        for (int dt = 0; dt < 4; ++dt) o[dt] = MFMA16(__builtin_bit_cast(bf16x8, f.v[4 * h + dt]), pf, o[dt]);
    }
}
__device__ __forceinline__ float xfq_max(float v) { v = fmaxf(v, __shfl_xor(v, 16)); return fmaxf(v, __shfl_xor(v, 32)); }
__device__ __forceinline__ float xfq_sum(float v) { v += __shfl_xor(v, 16); return v + __shfl_xor(v, 32); }
__device__ __forceinline__ float quad_sum(float v) { v += __shfl_xor(v, 1); return v + __shfl_xor(v, 2); }

__device__ __forceinline__ void softmax_pv(const KV& f, f32x4 (&st)[4], f32x4 (&o)[4], float& m, float& ls) {
    float bm = -INFINITY;
#pragma unroll
    for (int t = 0; t < 4; ++t) bm = fmaxf(bm, fmaxf(fmaxf(st[t][0], st[t][1]), fmaxf(st[t][2], st[t][3])));
    bm = xfq_max(bm);
    const float mn = fmaxf(m, bm), sc = __builtin_amdgcn_exp2f(m - mn);
    m = mn; ls *= sc;
#pragma unroll
    for (int dt = 0; dt < 4; ++dt) o[dt] = o[dt] * sc;
#pragma unroll
    for (int t = 0; t < 4; ++t)
#pragma unroll
        for (int i = 0; i < 4; ++i) { const float p = __builtin_amdgcn_exp2f(st[t][i] - mn); st[t][i] = p; ls += p; }
    pv_frag(f, st, o);
}
template <class Br>
__device__ __forceinline__ void run_branch(Br& br, const bf16x8 (&q)[2], int fr, int fq, f32x4 (&o)[4], float& m, float& ls) {
    int j;
    if (!br.first(j)) return;
    KV cur; k_load(cur, br.kp(j), fr, fq); v_load(cur, br.vp(j), br.pitch, fr, fq);
    for (;;) {
        int jn = 0; const bool hn = br.next(jn);
        KV nxt;
        if (hn) { k_load(nxt, br.kp(jn), fr, fq); v_load(nxt, br.vp(jn), br.pitch, fr, fq); }
        f32x4 st[4]; qk_frag(cur, q, st);
        br.mask(st, j);
        softmax_pv(cur, st, o, m, ls);
        if (!hn) break;
        cur = nxt; j = jn;
    }
}
struct BrSel {
    const bf16* K; const bf16* V; size_t pitch; unsigned long long u0, u1, my0, my1; int cur, qpos, fq; const LAS float* bt; float farb;
    __device__ __forceinline__ bool pop(int& j) { if (u0) { j = __builtin_ctzll(u0); u0 &= u0 - 1ull; return true; } if (u1) { j = 64 + __builtin_ctzll(u1); u1 &= u1 - 1ull; return true; } return false; }
    __device__ __forceinline__ bool first(int& j) { return pop(j); }
    __device__ __forceinline__ bool next(int& j) { return pop(j); }
    __device__ __forceinline__ const bf16* kp(int j) const { return K + (size_t)j * 64 * 64; }
    __device__ __forceinline__ const bf16* vp(int j) const { return V + (size_t)j * 4096; }
    __device__ __forceinline__ void mask(f32x4 (&st)[4], int j) const {
        const bool mine = j < 64 ? ((my0 >> j) & 1ull) != 0ull : ((my1 >> (j - 64)) & 1ull) != 0ull;
        if (j >= cur - 2) {
#pragma unroll
            for (int t = 0; t < 4; ++t)
#pragma unroll
                for (int i = 0; i < 4; ++i) { const int dist = qpos - (64 * j + 16 * t + 4 * fq + i); st[t][i] = st[t][i] + bt[(!mine || dist < 0) ? 129 : (dist > 128 ? 128 : dist)]; }
        } else {
#pragma unroll
            for (int t = 0; t < 4; ++t)
#pragma unroll
                for (int i = 0; i < 4; ++i) st[t][i] = mine ? st[t][i] + farb : -INFINITY;
        }
    }
};
struct BrWin {
    const bf16* K; const bf16* V; size_t pitch; int jb, cur, qpos, fq; const LAS float* bt;
    __device__ __forceinline__ bool first(int& j) { j = jb; return jb <= cur; }
    __device__ __forceinline__ bool next(int& j) { ++jb; j = jb; return jb <= cur; }
    __device__ __forceinline__ const bf16* kp(int j) const { return K + (long)j * 64 * 64; }
    __device__ __forceinline__ const bf16* vp(int j) const { return V + (long)j * 4096; }
    __device__ __forceinline__ void mask(f32x4 (&st)[4], int j) const {
#pragma unroll
        for (int t = 0; t < 4; ++t)
#pragma unroll
            for (int i = 0; i < 4; ++i) { const int dist = qpos - (64 * j + 16 * t + 4 * fq + i); st[t][i] = st[t][i] + bt[(unsigned)dist >= 512u ? 129 : (dist > 128 ? 128 : dist)]; }
    }
};

__device__ __forceinline__ void nsa_tile(CArgs& A, int l, bool smp, int bs, int g, int tq, LAS float* wl, const LAS float* BT, int lane) {
    asm volatile("" : "+v"(lane));
    const int fr = lane & 15, fq = lane >> 4, tl = fr >> 2, rr = fr & 3;
    const int qpos0 = smp ? PAST : 4 * tq, row0 = smp ? MP + bs * DS : bs * SEQ + qpos0;
    const int qpos = qpos0 + tl, cur = qpos0 >> 6, h = g * 4 + rr;
    const size_t sbase = smp ? (size_t)MP + bs * 2112 : (size_t)bs * SEQ;
    const long wbase = smp ? (long)MP + bs * WSTR - (PAST - 512) : (long)bs * SEQ;
    const size_t cbase = smp ? (size_t)1024 + bs * 128 : (size_t)bs * 512;
    const bf16* KS = (const bf16*)(A.ws + WS_KS) + l * KS_L + (size_t)g * TOTS * 64; const bf16* VTS = (const bf16*)(A.ws + WS_VTS) + l * KS_L + (size_t)g * 64 * TOTS;
    const bf16* KW = (const bf16*)(A.ws + WS_KW) + l * KW_L + (size_t)g * TOTWP * 64; const bf16* VTW = (const bf16*)(A.ws + WS_VTW) + l * KW_L + (size_t)g * 64 * TOTWP;
    const bf16* KC = (const bf16*)(A.ws + WS_KC) + l * KC_L + (size_t)g * NCB * 64 + cbase * 64; const bf16* VCT = (const bf16*)(A.ws + WS_VCT) + l * KC_L + (size_t)g * 64 * NCB + (cbase >> 6) * 4096;
    const LAS float* bt = BT + h * 132;
    const float farb = bt[128];
    bf16x8 q[2];
    {   const bf16* qp = (const bf16*)(A.ws + WS_NQ) + (size_t)(row0 + tl) * 512 + g * 256 + rr * 64 + 8 * fq;
        q[0] = *(const bf16x8*)qp; q[1] = *(const bf16x8*)(qp + 32); }
    const float* gt = (const float*)(A.ws + WS_GATE) + (size_t)(row0 + tl) * 32 + 8 + h * 3;
    const float gc = sigmoidf_(gt[0]), gs = sigmoidf_(gt[1]), gwn = sigmoidf_(gt[2]);
    f32x4 out[4];
#pragma unroll
    for (int dt = 0; dt < 4; ++dt) out[dt] = (f32x4){0.f, 0.f, 0.f, 0.f};
    LAS float* impA = wl;
    LAS float* impB = wl + 544;
    for (int i = lane; i < 1088; i += 64) wl[i] = 0.f;
    LDS_WAIT();

    {
        const int ncv_max = qpos0 + 3 >= 31 ? ((qpos0 + 3 - 31) >> 4) + 1 : 0, nb64 = (ncv_max + 63) >> 6;
        float m = -1.0e30f, ls = 0.f;
        {
            for (int ib = 0; ib < nb64; ++ib) {
                KV cur; k_load(cur, KC + (size_t)ib * 64 * 64, fr, fq);
                f32x4 st[4]; qk_frag(cur, q, st);
                float bm = -INFINITY;
#pragma unroll
                for (int t = 0; t < 4; ++t)
#pragma unroll
                    for (int i = 0; i < 4; ++i) { const int n = 64 * ib + 16 * t + 4 * fq + i; const int dist = qpos - 16 * n - 31;
                        const float s = st[t][i] + bt[dist < 0 ? 129 : (dist > 128 ? 128 : dist)]; st[t][i] = s; bm = fmaxf(bm, s); }
                bm = xfq_max(bm);
                const float mn = fmaxf(m, bm); ls *= __builtin_amdgcn_exp2f(m - mn); m = mn;
#pragma unroll
                for (int t = 0; t < 4; ++t)
#pragma unroll
                    for (int i = 0; i < 4; ++i) ls += __builtin_amdgcn_exp2f(st[t][i] - mn);
            }
        }
        ls = xfq_sum(ls);
        const float inv = ls > 0.f ? 1.f / ls : 0.f;
        f32x4 o[4];
#pragma unroll
        for (int dt = 0; dt < 4; ++dt) o[dt] = (f32x4){0.f, 0.f, 0.f, 0.f};
        {
            for (int ib = 0; ib < nb64; ++ib) {
                KV cur; k_load(cur, KC + (size_t)ib * 64 * 64, fr, fq); v_load(cur, VCT + (size_t)ib * 4096, 64, fr, fq);
                f32x4 st[4]; qk_frag(cur, q, st);
#pragma unroll
                for (int t = 0; t < 4; ++t) {
#pragma unroll
                    for (int i = 0; i < 4; ++i) { const int n = 64 * ib + 16 * t + 4 * fq + i; const int dist = qpos - 16 * n - 31;
                        st[t][i] = __builtin_amdgcn_exp2f(st[t][i] + bt[dist < 0 ? 129 : (dist > 128 ? 128 : dist)] - m) * inv; }
                    const float s4 = quad_sum((st[t][0] + st[t][1]) + (st[t][2] + st[t][3])), s3 = quad_sum(st[t][3]);
                    const int j0 = 16 * ib + 4 * t + fq;
                    if (rr == 0) { impA[tl * 136 + j0] = s4; impB[tl * 136 + j0 + 1] = s3; }
                }
                pv_frag(cur, st, o);
            }
        }
#pragma unroll
        for (int dt = 0; dt < 4; ++dt) out[dt] = out[dt] + o[dt] * gc;
    }
    LDS_WAIT();
    unsigned long long s0[4], s1[4];
#pragma unroll
    for (int t = 0; t < 4; ++t) topk_sel(impA[t * 136 + lane] + impB[t * 136 + lane], impA[t * 136 + 64 + lane] + impB[t * 136 + 64 + lane], cur, lane, s0[t], s1[t]);
    {
        float m = -1.0e30f, ls = 0.f; f32x4 o[4];
#pragma unroll
        for (int dt = 0; dt < 4; ++dt) o[dt] = (f32x4){0.f, 0.f, 0.f, 0.f};
        BrSel br{KS + sbase * 64, VTS + (sbase >> 6) * 4096, (size_t)64, (s0[0] | s0[1]) | (s0[2] | s0[3]), (s1[0] | s1[1]) | (s1[2] | s1[3]),
                 tl == 0 ? s0[0] : (tl == 1 ? s0[1] : (tl == 2 ? s0[2] : s0[3])), tl == 0 ? s1[0] : (tl == 1 ? s1[1] : (tl == 2 ? s1[2] : s1[3])), cur, qpos, fq, bt, farb};
        run_branch(br, q, fr, fq, o, m, ls);
        ls = xfq_sum(ls);
        const float w = ls > 0.f ? gs / ls : 0.f;
#pragma unroll
        for (int dt = 0; dt < 4; ++dt) out[dt] = out[dt] + o[dt] * w;
    }
    {
        float m = -1.0e30f, ls = 0.f; f32x4 o[4];
#pragma unroll
        for (int dt = 0; dt < 4; ++dt) o[dt] = (f32x4){0.f, 0.f, 0.f, 0.f};
        const int lo_blk = smp ? (PAST - 512) >> 6 : 0; int jb = (qpos0 - 511) >> 6; if (jb < lo_blk) jb = lo_blk;
        BrWin br{KW + wbase * 64, VTW + (wbase >> 6) * 4096, (size_t)64, jb, cur, qpos, fq, bt};
        run_branch(br, q, fr, fq, o, m, ls);
        ls = xfq_sum(ls);
        const float w = ls > 0.f ? gwn / ls : 0.f;
#pragma unroll
        for (int dt = 0; dt < 4; ++dt) out[dt] = out[dt] + o[dt] * w;
    }
    bf16* mp = (bf16*)(A.ws + WS_MIX) + (size_t)(row0 + tl) * D + 512 + h * 64 + 4 * fq;
#pragma unroll
    for (int dt = 0; dt < 4; ++dt) { v2u w; w.x = pk2(out[dt][0], out[dt][1]); w.y = pk2(out[dt][2], out[dt][3]); *(v2u*)(mp + 16 * dt) = w; }
}
__device__ __forceinline__ void phase_nsa(CArgs& A, int l, LAS float* wl, const LAS float* BT, int lane, int wave) {
    const int G = gridDim.x, bx = blockIdx.x;
    const bool xmap = (G & 7) == 0;
    const int x = bx & 7, nw = (G >> 3) * NWAVES, ww = (bx >> 3) * NWAVES + wave;
    const int gwv = bx * NWAVES + wave, ngw = G * NWAVES;
    for (int it = 0;; ++it) {
        bool smp; int bs, g, tq;
        if (xmap) {
            const int np = ww < 512 ? 2 * ((512 - ww + nw - 1) / nw) : 0;
            if (it < np) { const int i = ww + nw * (it >> 1), tq2 = (it & 1) ? 1023 - i : i; smp = false; bs = x >> 2; g = (x >> 1) & 1; tq = 2 * tq2 + (x & 1); }
            else { const int t = ww * 8 + x + 8 * nw * (it - np); if (t >= 2 * DB) break; smp = true; bs = t >> 1; g = t & 1; tq = 0; }
        } else {
            const int t = gwv + ngw * it; if (t >= 4 * 2048 + 2 * DB) break;
            if (t < 4 * 2048) { smp = false; bs = t >> 12; g = (t >> 11) & 1; tq = t & 2047; } else { smp = true; bs = (t - 4 * 2048) >> 1; g = t & 1; tq = 0; }
        }
        nsa_tile(A, l, smp, bs, g, tq, wl, BT, lane);
    }
}

__device__ __forceinline__ void phase_m2x(CArgs& A, int l, LAS unsigned char* lds, int tid) {
    LAS float* buf = (LAS float*)lds;
    LAS float* wl = (LAS float*)(lds + 1024);
    LAS float* red = (LAS float*)(lds + 2048);
    LAS bf16* kt = (LAS bf16*)(lds + 8192);
    LAS bf16* vt = (LAS bf16*)(lds + 8192 + 34816);
    const bf16* QKVO = (const bf16*)(A.ws + WS_QKVO);
    const int lane = tid & 63, wave = tid >> 6, fr = lane & 15, fq = lane >> 4;
    for (int unit = blockIdx.x; unit < NUNIT; unit += gridDim.x) {
        const int b = unit >> 7, h = (unit >> 5) & 3, c = unit & 31, r0 = b * SEQ + c * LCH;
        float ig = 0.f, lf = 0.f;
        if (tid < 256) ml_gates(A, l, r0 + tid, h, ig, lf);
        const float F = scan_sum256(lf, buf, tid);
        __syncthreads();
        if (tid == 255) buf[16] = F;
        __syncthreads();
        const float Fend = buf[16];
        const float gl = tid < 256 ? Fend - F + ig : -3.0e38f;
        const float mw = wave_max(gl);
        if (lane == 0) buf[20 + wave] = mw;
        __syncthreads();
        const float mloc = fmaxf(fmaxf(buf[20], buf[21]), fmaxf(buf[22], buf[23]));
        if (tid < 256) wl[tid] = __expf(gl - mloc);
        if (tid == 0) { float* ch = (float*)(A.ws + WS_CHS) + unit * 4; ch[0] = Fend; ch[1] = mloc; }
        f32x4 acc[8];
#pragma unroll
        for (int kt_ = 0; kt_ < 8; ++kt_) acc[kt_] = (f32x4){0.f, 0.f, 0.f, 0.f};
        float dnp = 0.f;
        for (int half = 0; half < 2; ++half) {
            __syncthreads();
            for (int i = tid; i < 4096; i += NTHR) { const int which = i >> 11, oc = (i >> 7) & 15, s = i & 127;
                const v4u x = *(const v4u*)(QKVO + (size_t)(r0 + 128 * half + s) * 2048 + (which ? 1024 : 512) + h * HD + 8 * oc);
                LAS bf16* dst = (which ? vt : kt) + (8 * oc) * 136 + s;
                dst[0] = (bf16)x.x; dst[136] = (bf16)(x.x >> 16); dst[272] = (bf16)x.y; dst[408] = (bf16)(x.y >> 16); dst[544] = (bf16)x.z; dst[680] = (bf16)(x.z >> 16); dst[816] = (bf16)x.w; dst[952] = (bf16)(x.w >> 16); }
            __syncthreads();
#pragma unroll
            for (int ks = 0; ks < 4; ++ks) {
                const int s0 = 32 * ks + 8 * fq;
                const v4u xv = *(const LAS v4u*)(vt + (16 * wave + fr) * 136 + s0);
                const f32x4 w0 = *(const LAS f32x4*)(wl + 128 * half + s0), w1 = *(const LAS f32x4*)(wl + 128 * half + s0 + 4);
                v4u av; av.x = pk2(bflo(xv.x) * w0[0], bfhi(xv.x) * w0[1]); av.y = pk2(bflo(xv.y) * w0[2], bfhi(xv.y) * w0[3]); av.z = pk2(bflo(xv.z) * w1[0], bfhi(xv.z) * w1[1]); av.w = pk2(bflo(xv.w) * w1[2], bfhi(xv.w) * w1[3]);
                const bf16x8 af = __builtin_bit_cast(bf16x8, av);
#pragma unroll
                for (int kt_ = 0; kt_ < 8; ++kt_) { const bf16x8 bfr = *(const LAS bf16x8*)(kt + (16 * kt_ + fr) * 136 + s0); acc[kt_] = MFMA16(af, bfr, acc[kt_]); }
            }
            {   const int k = tid & 127, q = tid >> 7;
#pragma unroll
                for (int e = 0; e < 4; ++e) { const v4u x = *(const LAS v4u*)(kt + k * 136 + 32 * q + 8 * e); const LAS float* w = wl + 128 * half + 32 * q + 8 * e;
                    dnp += bflo(x.x) * w[0] + bfhi(x.x) * w[1] + bflo(x.y) * w[2] + bfhi(x.y) * w[3] + bflo(x.z) * w[4] + bfhi(x.z) * w[5] + bflo(x.w) * w[6] + bfhi(x.w) * w[7]; } }
        }
        float* dct = (float*)(A.ws + WS_DCT) + ((size_t)unit * HD + 16 * wave + 4 * fq) * HD + fr;
#pragma unroll
        for (int kt_ = 0; kt_ < 8; ++kt_)
#pragma unroll
            for (int i = 0; i < 4; ++i) dct[(size_t)i * HD + 16 * kt_] = acc[kt_][i];
        red[(tid >> 7) * 128 + (tid & 127)] = dnp;
        __syncthreads();
        if (tid < HD) ((float*)(A.ws + WS_DN))[unit * HD + tid] = (red[tid] + red[128 + tid]) + (red[256 + tid] + red[384 + tid]);
        __syncthreads();
    }
}

__device__ __forceinline__ void phase_m4x(CArgs& A, int l, LAS unsigned char* lds, int tid) {
    LAS float* buf = (LAS float*)lds;
    LAS float* sa = (LAS float*)(lds + 1024);
    LAS float* smx = sa + 256;
    LAS float* sdec = smx + 256;
    LAS float* sem = sdec + 256;
    LAS bf16* vt = (LAS bf16*)(lds + 8192);
    const bf16* QKVO = (const bf16*)(A.ws + WS_QKVO);
    const int lane = tid & 63, wave = tid >> 6, fr = lane & 15, fq = lane >> 4;
    for (int unit = blockIdx.x; unit < NUNIT; unit += gridDim.x) {
        const int b = unit >> 7, h = (unit >> 5) & 3, c = unit & 31, r0 = b * SEQ + c * LCH;
        float ig = 0.f, lf = 0.f;
        if (tid < 256) ml_gates(A, l, r0 + tid, h, ig, lf);
        const float F = scan_sum256(lf, buf, tid);
        const float a = tid < 256 ? ig - F : -3.0e38f;
        const float cm = scan_max256(a, buf, tid);
        const float m0 = ((const float*)(A.ws + WS_CHS))[unit * 4 + 2];
        if (tid < 256) { const float mx = fmaxf(m0, cm); sa[tid] = a; smx[tid] = mx; sdec[tid] = __expf(m0 - mx); sem[tid] = __expf(-(F + mx)); }
        for (int i = tid; i < 4096; i += NTHR) { const int oc = i >> 8, s = i & 255;
            const v4u x = *(const v4u*)(QKVO + (size_t)(r0 + s) * 2048 + 1024 + h * HD + 8 * oc);
            LAS bf16* dst = vt + (8 * oc) * 264 + s;
            dst[0] = (bf16)x.x; dst[264] = (bf16)(x.x >> 16); dst[528] = (bf16)x.y; dst[792] = (bf16)(x.y >> 16); dst[1056] = (bf16)x.z; dst[1320] = (bf16)(x.z >> 16); dst[1584] = (bf16)x.w; dst[1848] = (bf16)(x.w >> 16); }
        __syncthreads();
        const bf16* ctp = (const bf16*)(A.ws + WS_CTP) + (size_t)unit * HD * HD;
        const float* npv = (const float*)(A.ws + WS_NPV) + unit * HD;
        for (int pass = 0; pass < 2; ++pass) {
            const int sub = pass == 0 ? wave : 15 - wave, t0 = 16 * sub, t = t0 + fr;
            const float mxt = smx[t], dect = sdec[t], emt = sem[t];
            bf16x8 qf[4];
#pragma unroll
            for (int kk = 0; kk < 4; ++kk) qf[kk] = *(const bf16x8*)(QKVO + (size_t)(r0 + t) * 2048 + h * HD + 32 * kk + 8 * fq);
            f32x4 ah[8], ac[8];
#pragma unroll
            for (int v = 0; v < 8; ++v) { ah[v] = (f32x4){0.f, 0.f, 0.f, 0.f}; ac[v] = (f32x4){0.f, 0.f, 0.f, 0.f}; }
            float den = 0.f;
            const int nblk = (t0 + 47) >> 5;
            for (int ib = 0; ib < nblk; ++ib) {
                const int s0 = 32 * ib;
                f32x4 st[2];
#pragma unroll
                for (int j = 0; j < 2; ++j) {
                    f32x4 z = {0.f, 0.f, 0.f, 0.f};
                    const bf16* kp = QKVO + (size_t)(r0 + s0 + 16 * j + fr) * 2048 + 512 + h * HD + 8 * fq;
#pragma unroll
                    for (int kk = 0; kk < 4; ++kk) z = MFMA16(*(const bf16x8*)(kp + 32 * kk), qf[kk], z);
                    const f32x4 a4 = *(const LAS f32x4*)(sa + s0 + 16 * j + 4 * fq);
#pragma unroll
                    for (int i = 0; i < 4; ++i) { const float w = (s0 + 16 * j + 4 * fq + i <= t) ? z[i] * __expf(a4[i] - mxt) : 0.f; z[i] = w; den += w; }
                    st[j] = z;
                }
                v4u pw; pw.x = pk2(st[0][0], st[0][1]); pw.y = pk2(st[0][2], st[0][3]); pw.z = pk2(st[1][0], st[1][1]); pw.w = pk2(st[1][2], st[1][3]);
                const bf16x8 pf = __builtin_bit_cast(bf16x8, pw);
#pragma unroll
                for (int v = 0; v < 8; ++v) { const LAS bf16* vp = vt + (16 * v + fr) * 264 + s0 + 4 * fq;
                    const v2u x = *(const LAS v2u*)vp, y = *(const LAS v2u*)(vp + 16);
                    v4u vw; vw.x = x.x; vw.y = x.y; vw.z = y.x; vw.w = y.y;
                    ah[v] = MFMA16(__builtin_bit_cast(bf16x8, vw), pf, ah[v]); }
            }
            float qn = 0.f;
#pragma unroll
            for (int kk = 0; kk < 4; ++kk) {
                const v4u qx = __builtin_bit_cast(v4u, qf[kk]); const f32x4 n0 = *(const f32x4*)(npv + 32 * kk + 8 * fq), n1 = *(const f32x4*)(npv + 32 * kk + 8 * fq + 4);
                qn += bflo(qx.x) * n0[0] + bfhi(qx.x) * n0[1] + bflo(qx.y) * n0[2] + bfhi(qx.y) * n0[3] + bflo(qx.z) * n1[0] + bfhi(qx.z) * n1[1] + bflo(qx.w) * n1[2] + bfhi(qx.w) * n1[3];
#pragma unroll
                for (int v = 0; v < 8; ++v) ac[v] = MFMA16(*(const bf16x8*)(ctp + (size_t)(16 * v + fr) * HD + 32 * kk + 8 * fq), qf[kk], ac[v]);
            }
            const float dent = xfq_sum(den) + dect * xfq_sum(qn);
            const float rden = 1.f / fmaxf(fabsf(dent), emt);
            float s1 = 0.f;
#pragma unroll
            for (int v = 0; v < 8; ++v) { ah[v] = (ah[v] + ac[v] * dect) * rden; s1 += (ah[v][0] + ah[v][1]) + (ah[v][2] + ah[v][3]); }
            const float mu = xfq_sum(s1) * (1.f / HD);
            float s2 = 0.f;
#pragma unroll
            for (int v = 0; v < 8; ++v) { ah[v] = ah[v] - mu; s2 += (ah[v][0] * ah[v][0] + ah[v][1] * ah[v][1]) + (ah[v][2] * ah[v][2] + ah[v][3] * ah[v][3]); }
            const float rstd = 1.f / sqrtf(xfq_sum(s2) * (1.f / HD) + LN_EPS);
            const bf16* op = QKVO + (size_t)(r0 + t) * 2048 + 1536 + h * HD + 4 * fq;
            bf16* mp = (bf16*)(A.ws + WS_MIX) + (size_t)(r0 + t) * D + h * HD + 4 * fq;
            const float* gp = A.ml_norm_g + l * 512 + h * HD + 4 * fq;
#pragma unroll
            for (int v = 0; v < 8; ++v) { const v2u og = *(const v2u*)(op + 16 * v); const f32x4 gn = *(const f32x4*)(gp + 16 * v);
                v2u w; w.x = pk2(ah[v][0] * rstd * gn[0] * sigmoidf_(bflo(og.x)), ah[v][1] * rstd * gn[1] * sigmoidf_(bfhi(og.x)));
                w.y = pk2(ah[v][2] * rstd * gn[2] * sigmoidf_(bflo(og.y)), ah[v][3] * rstd * gn[3] * sigmoidf_(bfhi(og.y)));
                *(v2u*)(mp + 16 * v) = w; }
        }
        __syncthreads();
    }
}

constexpr int SLOT = 8192;
constexpr int NG_KB = 0, NG_IMP = 4 * SLOT * 2, NG_RING_END = 7 * SLOT * 2, NG_BT = NG_RING_END, NG_MSK = NG_BT + 8 * 132 * 4, NG_TASK = NG_MSK + NWAVES * 16, NG_JL = NG_TASK + 16, NG_END = NG_JL + 136 * 4;
static_assert(NG_IMP + NWAVES * 1088 * 4 <= NG_RING_END && NG_END <= RING_BYTES, "NSA LDS map");
constexpr int CW_NSAQ = 16384;

__device__ __forceinline__ void dma_k(const bf16* Kblk, LAS bf16* slot, int wave, int lane) {
    const int row = 8 * wave + (lane >> 3), c = (lane & 7) ^ ((row >> 1) & 7);
    __builtin_amdgcn_global_load_lds((const unsigned*)(Kblk + row * 64 + c * 8), (LAS unsigned*)(slot + wave * 512), 16, 0, 0);
}
__device__ __forceinline__ void dma_v(const bf16* Vblk, LAS bf16* slot, int wave, int lane) {
    const int row = 8 * wave + (lane >> 3), c = (lane & 7) ^ ((row >> 1) & 7);
    __builtin_amdgcn_global_load_lds((const unsigned*)(Vblk + row * 64 + c * 8), (LAS unsigned*)(slot + 4096 + wave * 512), 16, 0, 0);
}
__device__ __forceinline__ void qk_lds(const LAS bf16* kb, const bf16x8 (&q)[2], int fr, int fq, f32x4 (&st)[4]) {
    const int sw = (fr >> 1) & 7;
#pragma unroll
    for (int t = 0; t < 4; ++t) { const LAS bf16* p = kb + (16 * t + fr) * 64;
        f32x4 z = {0.f, 0.f, 0.f, 0.f}; z = MFMA16(*(const LAS bf16x8*)(p + ((fq ^ sw) << 3)), q[0], z); st[t] = MFMA16(*(const LAS bf16x8*)(p + (((4 + fq) ^ sw) << 3)), q[1], z); }
}
__device__ __forceinline__ void pv_lds(const LAS bf16* vb, int fr, int fq, const f32x4 (&st)[4], f32x4 (&o)[4]) {
    const int sw = (fr >> 1) & 7, sub = 4 * (fq & 1);
#pragma unroll
    for (int h = 0; h < 2; ++h) {
        v4u pw; pw.x = pk2(st[2 * h][0], st[2 * h][1]); pw.y = pk2(st[2 * h][2], st[2 * h][3]); pw.z = pk2(st[2 * h + 1][0], st[2 * h + 1][1]); pw.w = pk2(st[2 * h + 1][2], st[2 * h + 1][3]);
        const bf16x8 pf = __builtin_bit_cast(bf16x8, pw);
        const int c0 = 4 * h + (fq >> 1);
#pragma unroll
        for (int dt = 0; dt < 4; ++dt) { const LAS bf16* p = vb + (16 * dt + fr) * 64 + sub;
            const v2u a = *(const LAS v2u*)(p + ((c0 ^ sw) << 3)), b = *(const LAS v2u*)(p + (((c0 + 2) ^ sw) << 3)); v4u w; w.x = a.x; w.y = a.y; w.z = b.x; w.w = b.y;
            o[dt] = MFMA16(__builtin_bit_cast(bf16x8, w), pf, o[dt]); }
    }
}
__device__ __forceinline__ void softmax_pv_lds(const LAS bf16* vb, int fr, int fq, f32x4 (&st)[4], float c, f32x4 (&o)[4], float& m, float& ls) {
    float bm = fmaxf(fmaxf(st[0][0], st[0][1]), fmaxf(st[0][2], st[0][3]));
#pragma unroll
    for (int t = 1; t < 4; ++t) bm = fmaxf(bm, fmaxf(fmaxf(st[t][0], st[t][1]), fmaxf(st[t][2], st[t][3])));
    bm = xfq_max(bm + c);
    if (__any(bm > m)) {
        const float mn = fmaxf(m, bm), sc = __builtin_amdgcn_exp2f(m - mn);
        m = mn; ls *= sc;
#pragma unroll
        for (int dt = 0; dt < 4; ++dt) o[dt] = o[dt] * sc;
    }
    const float d = c - m;
#pragma unroll
    for (int t = 0; t < 4; ++t)
#pragma unroll
        for (int i = 0; i < 4; ++i) { const float p = __builtin_amdgcn_exp2f(st[t][i] + d); st[t][i] = p; ls += p; }
    pv_lds(vb, fr, fq, st, o);
}

template <int RS, bool HASV, class Addr, class Body>
__device__ __forceinline__ void staged_sweep2(int n, const Addr& ad, Body& body, LAS bf16* ring, int tid) {
    if (n <= 0) return;
    const int lane = tid & 63, wave = tid >> 6;
    constexpr int DPB = HASV ? 2 : 1;
#pragma unroll 1
    for (int i = 0; i < RS - 2 && i < n; ++i) { dma_k(ad.k(i), ring + i * SLOT, wave, lane); if (HASV) dma_v(ad.v(i), ring + i * SLOT, wave, lane); }
    const int nstep = (n + 1) >> 1;
#pragma unroll 1
    for (int s = 0; s < nstep; ++s) {
        const int i0 = 2 * s;
        if (i0 + RS - 2 <= n) { if (RS == 7) asm volatile("s_waitcnt vmcnt(%0) lgkmcnt(0)\n\ts_barrier" :: "n"((RS - 4) * DPB) : "memory"); else asm volatile("s_waitcnt vmcnt(0) lgkmcnt(0)\n\ts_barrier" ::: "memory"); }
        else asm volatile("s_waitcnt vmcnt(0) lgkmcnt(0)\n\ts_barrier" ::: "memory");
        {   const int j0 = i0 + RS - 2, j1 = j0 + 1;
            if (j0 < n) { dma_k(ad.k(j0), ring + (j0 % RS) * SLOT, wave, lane); if (HASV) dma_v(ad.v(j0), ring + (j0 % RS) * SLOT, wave, lane); }
            if (j1 < n) { dma_k(ad.k(j1), ring + (j1 % RS) * SLOT, wave, lane); if (HASV) dma_v(ad.v(j1), ring + (j1 % RS) * SLOT, wave, lane); } }
        const LAS bf16* b0 = ring + (i0 % RS) * SLOT;
        body(i0, b0, b0 + 4096);
        if (i0 + 1 < n) { const LAS bf16* b1 = ring + ((i0 + 1) % RS) * SLOT; body(i0 + 1, b1, b1 + 4096); }
    }
    asm volatile("s_waitcnt vmcnt(0) lgkmcnt(0)\n\ts_barrier" ::: "memory");
}
struct AdLin {
    const bf16* K; const bf16* V;
    __device__ __forceinline__ const bf16* k(int i) const { return K + (size_t)i * 4096; }
    __device__ __forceinline__ const bf16* v(int i) const { return V + (size_t)i * 4096; }
};
struct AdList {
    const bf16* K; const bf16* V; const LAS int* jl;
    __device__ __forceinline__ const bf16* k(int i) const { const int j = __builtin_amdgcn_readfirstlane(jl[i]); return K + (size_t)j * 4096; }
    __device__ __forceinline__ const bf16* v(int i) const { const int j = __builtin_amdgcn_readfirstlane(jl[i]); return V + (size_t)j * 4096; }
};
struct TileCtx { int fr, fq, qposA, qposB, qpos0, cur; const LAS float* bt; float farb; };
struct KF { bf16x8 k[8]; };
struct VF { v4u v[8]; };
__device__ __forceinline__ void kf_load(KF& f, const LAS bf16* kb, int fr, int fq) {
    const int sw = (fr >> 1) & 7;
#pragma unroll
    for (int t = 0; t < 4; ++t) { const LAS bf16* p = kb + (16 * t + fr) * 64; f.k[2 * t] = *(const LAS bf16x8*)(p + ((fq ^ sw) << 3)); f.k[2 * t + 1] = *(const LAS bf16x8*)(p + (((4 + fq) ^ sw) << 3)); }
}
__device__ __forceinline__ void vf_load(VF& f, const LAS bf16* vb, int fr, int fq) {
    const int sw = (fr >> 1) & 7, sub = 4 * (fq & 1);
#pragma unroll
    for (int h = 0; h < 2; ++h) {
        const int c0 = 4 * h + (fq >> 1);
#pragma unroll
        for (int dt = 0; dt < 4; ++dt) { const LAS bf16* p = vb + (16 * dt + fr) * 64 + sub;
            const v2u a = *(const LAS v2u*)(p + ((c0 ^ sw) << 3)), b = *(const LAS v2u*)(p + (((c0 + 2) ^ sw) << 3)); v4u w; w.x = a.x; w.y = a.y; w.z = b.x; w.w = b.y; f.v[4 * h + dt] = w; }
    }
}
__device__ __forceinline__ void qk2(const KF& f, const bf16x8 (&qa)[2], const bf16x8 (&qb)[2], f32x4 (&sa)[4], f32x4 (&sb)[4]) {
#pragma unroll
    for (int t = 0; t < 4; ++t) { const f32x4 z = {0.f, 0.f, 0.f, 0.f};
        sa[t] = MFMA16(f.k[2 * t + 1], qa[1], MFMA16(f.k[2 * t], qa[0], z)); sb[t] = MFMA16(f.k[2 * t + 1], qb[1], MFMA16(f.k[2 * t], qb[0], z)); }
}
__device__ __forceinline__ void pv2(const VF& f, const f32x4 (&sa)[4], const f32x4 (&sb)[4], f32x4 (&oa)[4], f32x4 (&ob)[4]) {
#pragma unroll
    for (int h = 0; h < 2; ++h) {
        v4u pa, pb;
        pa.x = pk2(sa[2 * h][0], sa[2 * h][1]); pa.y = pk2(sa[2 * h][2], sa[2 * h][3]); pa.z = pk2(sa[2 * h + 1][0], sa[2 * h + 1][1]); pa.w = pk2(sa[2 * h + 1][2], sa[2 * h + 1][3]);
        pb.x = pk2(sb[2 * h][0], sb[2 * h][1]); pb.y = pk2(sb[2 * h][2], sb[2 * h][3]); pb.z = pk2(sb[2 * h + 1][0], sb[2 * h + 1][1]); pb.w = pk2(sb[2 * h + 1][2], sb[2 * h + 1][3]);
        const bf16x8 fa = __builtin_bit_cast(bf16x8, pa), fb = __builtin_bit_cast(bf16x8, pb);
#pragma unroll
        for (int dt = 0; dt < 4; ++dt) { const bf16x8 vv = __builtin_bit_cast(bf16x8, f.v[4 * h + dt]); oa[dt] = MFMA16(vv, fa, oa[dt]); ob[dt] = MFMA16(vv, fb, ob[dt]); }
    }
}
__device__ __forceinline__ float max16(const f32x4 (&st)[4]) {
    float bm = fmaxf(fmaxf(st[0][0], st[0][1]), fmaxf(st[0][2], st[0][3]));
#pragma unroll
    for (int t = 1; t < 4; ++t) bm = fmaxf(bm, fmaxf(fmaxf(st[t][0], st[t][1]), fmaxf(st[t][2], st[t][3])));
    return bm;
}
constexpr float RESCALE_THR = 8.f;
__device__ __forceinline__ void softmax_pv2(const LAS bf16* vb, int fr, int fq, f32x4 (&sa)[4], f32x4 (&sb)[4], float ca, float cb, f32x4 (&oa)[4], f32x4 (&ob)[4], float (&m)[2], float (&ls)[2]) {
    float ba = max16(sa) + ca, bb = max16(sb) + cb;
    ba = xfq_max(ba); bb = xfq_max(bb);
    if (__any(ba - m[0] > RESCALE_THR || bb - m[1] > RESCALE_THR)) {
        const float ma = fmaxf(m[0], ba), mb = fmaxf(m[1], bb), xa = __builtin_amdgcn_exp2f(m[0] - ma), xb = __builtin_amdgcn_exp2f(m[1] - mb);
        m[0] = ma; m[1] = mb; ls[0] *= xa; ls[1] *= xb;
#pragma unroll
        for (int dt = 0; dt < 4; ++dt) { oa[dt] = oa[dt] * xa; ob[dt] = ob[dt] * xb; }
    }
    const float da = ca - m[0], db = cb - m[1];
#pragma unroll
    for (int t = 0; t < 4; ++t)
#pragma unroll
        for (int i = 0; i < 4; ++i) { const float pa = __builtin_amdgcn_exp2f(sa[t][i] + da), pb = __builtin_amdgcn_exp2f(sb[t][i] + db); sa[t][i] = pa; sb[t][i] = pb; ls[0] += pa; ls[1] += pb; }
    VF vf; vf_load(vf, vb, fr, fq);
    pv2(vf, sa, sb, oa, ob);
}
__device__ __forceinline__ void qk1(const KF& f, const bf16x8 (&q)[2], f32x4 (&st)[4]) {
#pragma unroll
    for (int t = 0; t < 4; ++t) { const f32x4 z = {0.f, 0.f, 0.f, 0.f}; st[t] = MFMA16(f.k[2 * t + 1], q[1], MFMA16(f.k[2 * t], q[0], z)); }
}
__device__ __forceinline__ void softmax_pv1(const LAS bf16* vb, int fr, int fq, f32x4 (&st)[4], float c, f32x4 (&o)[4], float& m, float& ls) {
    float bm = max16(st) + c;
    bm = xfq_max(bm);
    if (__any(bm - m > RESCALE_THR)) {
        const float mn = fmaxf(m, bm), x = __builtin_amdgcn_exp2f(m - mn);
        m = mn; ls *= x;
#pragma unroll
        for (int dt = 0; dt < 4; ++dt) o[dt] = o[dt] * x;
    }
    const float d = c - m;
#pragma unroll
    for (int t = 0; t < 4; ++t)
#pragma unroll
        for (int i = 0; i < 4; ++i) { const float p = __builtin_amdgcn_exp2f(st[t][i] + d); st[t][i] = p; ls += p; }
    pv_lds(vb, fr, fq, st, o);
}
struct BodyCmpStat2 {
    const bf16x8 (&qa)[2]; const bf16x8 (&qb)[2]; const TileCtx& c; float (&ml)[2]; float (&lsl)[2];
    __device__ __forceinline__ void operator()(int ib, const LAS bf16* kb, const LAS bf16*) {
        KF kf; kf_load(kf, kb, c.fr, c.fq);
        f32x4 sa[4], sb[4]; qk2(kf, qa, qb, sa, sb);
        if (c.qpos0 - 16 * (64 * ib + 63) - 31 >= 128) {
#pragma unroll
            for (int t = 0; t < 4; ++t) { sa[t] = sa[t] + c.farb; sb[t] = sb[t] + c.farb; }
        } else {
#pragma unroll
            for (int t = 0; t < 4; ++t)
#pragma unroll
                for (int i = 0; i < 4; ++i) { const int n = 64 * ib + 16 * t + 4 * c.fq + i; const int da = c.qposA - 16 * n - 31, db = c.qposB - 16 * n - 31;
                    sa[t][i] += c.bt[da < 0 ? 129 : (da > 128 ? 128 : da)]; sb[t][i] += c.bt[db < 0 ? 129 : (db > 128 ? 128 : db)]; }
        }
        const float ma = fmaxf(ml[0], max16(sa)), mb = fmaxf(ml[1], max16(sb));
        lsl[0] *= __builtin_amdgcn_exp2f(ml[0] - ma); lsl[1] *= __builtin_amdgcn_exp2f(ml[1] - mb); ml[0] = ma; ml[1] = mb;
#pragma unroll
        for (int t = 0; t < 4; ++t)
#pragma unroll
            for (int i = 0; i < 4; ++i) { lsl[0] += __builtin_amdgcn_exp2f(sa[t][i] - ma); lsl[1] += __builtin_amdgcn_exp2f(sb[t][i] - mb); }
    }
};
struct BodyCmpProb2 {
    const bf16x8 (&qa)[2]; const bf16x8 (&qb)[2]; const TileCtx& c; f32x4 (&oa)[4]; f32x4 (&ob)[4]; float m0, m1, inv0, inv1; LAS float* imp; int tl, rr;
    __device__ __forceinline__ void operator()(int ib, const LAS bf16* kb, const LAS bf16* vb) {
        KF kf; kf_load(kf, kb, c.fr, c.fq);
        f32x4 sa[4], sb[4]; qk2(kf, qa, qb, sa, sb);
        if (c.qpos0 - 16 * (64 * ib + 63) - 31 >= 128) {
            const float da = c.farb - m0, db = c.farb - m1;
#pragma unroll
            for (int t = 0; t < 4; ++t)
#pragma unroll
                for (int i = 0; i < 4; ++i) { sa[t][i] = __builtin_amdgcn_exp2f(sa[t][i] + da) * inv0; sb[t][i] = __builtin_amdgcn_exp2f(sb[t][i] + db) * inv1; }
        } else {
#pragma unroll
            for (int t = 0; t < 4; ++t)
#pragma unroll
                for (int i = 0; i < 4; ++i) { const int n = 64 * ib + 16 * t + 4 * c.fq + i; const int da = c.qposA - 16 * n - 31, db = c.qposB - 16 * n - 31;
                    sa[t][i] = __builtin_amdgcn_exp2f(sa[t][i] + c.bt[da < 0 ? 129 : (da > 128 ? 128 : da)] - m0) * inv0;
                    sb[t][i] = __builtin_amdgcn_exp2f(sb[t][i] + c.bt[db < 0 ? 129 : (db > 128 ? 128 : db)] - m1) * inv1; }
        }
#pragma unroll
        for (int t = 0; t < 4; ++t) {
            const float a4 = quad_sum((sa[t][0] + sa[t][1]) + (sa[t][2] + sa[t][3])), a3 = quad_sum(sa[t][3]), b4 = quad_sum((sb[t][0] + sb[t][1]) + (sb[t][2] + sb[t][3])), b3 = quad_sum(sb[t][3]);
            const int j0 = 16 * ib + 4 * t + c.fq;
            if (rr == 0) { LAS float* ip = imp + tl * 136 + j0;
                __hip_atomic_fetch_add(ip, a4, __ATOMIC_RELAXED, __HIP_MEMORY_SCOPE_WORKGROUP); __hip_atomic_fetch_add(ip + 1, a3, __ATOMIC_RELAXED, __HIP_MEMORY_SCOPE_WORKGROUP);
                __hip_atomic_fetch_add(ip + 4 * 136, b4, __ATOMIC_RELAXED, __HIP_MEMORY_SCOPE_WORKGROUP); __hip_atomic_fetch_add(ip + 4 * 136 + 1, b3, __ATOMIC_RELAXED, __HIP_MEMORY_SCOPE_WORKGROUP); }
        }
        VF vf; vf_load(vf, vb, c.fr, c.fq);
        pv2(vf, sa, sb, oa, ob);
    }
};
struct BodySel2 {
    const bf16x8 (&qa)[2]; const bf16x8 (&qb)[2]; const TileCtx& c; f32x4 (&oa)[4]; f32x4 (&ob)[4]; float (&m)[2]; float (&ls)[2]; const LAS int* jl;
    unsigned long long wu0a, wu1a, wu0b, wu1b, my0a, my1a, my0b, my1b; bool dead;
    __device__ __forceinline__ void operator()(int i, const LAS bf16* kb, const LAS bf16* vb) {
        const int j = __builtin_amdgcn_readfirstlane(jl[i]);
        const bool hasa = j < 64 ? ((wu0a >> j) & 1ull) != 0ull : ((wu1a >> (j - 64)) & 1ull) != 0ull, hasb = j < 64 ? ((wu0b >> j) & 1ull) != 0ull : ((wu1b >> (j - 64)) & 1ull) != 0ull;
        if (!(hasa || hasb)) return;
        const bool minea = !dead && (j < 64 ? ((my0a >> j) & 1ull) != 0ull : ((my1a >> (j - 64)) & 1ull) != 0ull), mineb = !dead && (j < 64 ? ((my0b >> j) & 1ull) != 0ull : ((my1b >> (j - 64)) & 1ull) != 0ull);
        const bool near = j >= c.cur - 2;
        if (hasa && hasb) {
            KF kf; kf_load(kf, kb, c.fr, c.fq);
            f32x4 sa[4], sb[4]; qk2(kf, qa, qb, sa, sb);
            float ca = minea ? c.farb : -INFINITY, cb = mineb ? c.farb : -INFINITY;
            if (near) {
                ca = minea ? 0.f : -INFINITY; cb = mineb ? 0.f : -INFINITY;
#pragma unroll
                for (int t = 0; t < 4; ++t)
#pragma unroll
                    for (int e = 0; e < 4; ++e) { const int key = 64 * j + 16 * t + 4 * c.fq + e; const int da = c.qposA - key, db = c.qposB - key;
                        sa[t][e] += c.bt[da < 0 ? 129 : (da > 128 ? 128 : da)]; sb[t][e] += c.bt[db < 0 ? 129 : (db > 128 ? 128 : db)]; }
            }
            softmax_pv2(vb, c.fr, c.fq, sa, sb, ca, cb, oa, ob, m, ls);
        } else {
            const bool mine = hasa ? minea : mineb; const int qpos = hasa ? c.qposA : c.qposB;
            f32x4 st[4];
            if (hasa) qk_lds(kb, qa, c.fr, c.fq, st); else qk_lds(kb, qb, c.fr, c.fq, st);
            float cc = mine ? c.farb : -INFINITY;
            if (near) {
                cc = mine ? 0.f : -INFINITY;
#pragma unroll
                for (int t = 0; t < 4; ++t)
#pragma unroll
                    for (int e = 0; e < 4; ++e) { const int d1 = qpos - (64 * j + 16 * t + 4 * c.fq + e); st[t][e] += c.bt[d1 < 0 ? 129 : (d1 > 128 ? 128 : d1)]; }
            }
            if (hasa) softmax_pv1(vb, c.fr, c.fq, st, cc, oa, m[0], ls[0]); else softmax_pv1(vb, c.fr, c.fq, st, cc, ob, m[1], ls[1]);
        }
    }
};
struct BodyWin2 {
    const bf16x8 (&qa)[2]; const bf16x8 (&qb)[2]; const TileCtx& c; f32x4 (&oa)[4]; f32x4 (&ob)[4]; float (&m)[2]; float (&ls)[2]; int j0;
    __device__ __forceinline__ void operator()(int i, const LAS bf16* kb, const LAS bf16* vb) {
        const int j = j0 + i;
        if (c.qpos0 + 7 - 64 * j < 0 || c.qpos0 - (64 * j + 63) >= 512) return;
        KF kf; kf_load(kf, kb, c.fr, c.fq);
        f32x4 sa[4], sb[4]; qk2(kf, qa, qb, sa, sb);
        float ca = c.farb, cb = c.farb;
        const bool interior = (c.qpos0 + 7 - 64 * j < 512) && (c.qpos0 - (64 * j + 63) >= 128);
        if (!interior) {
            ca = 0.f; cb = 0.f;
#pragma unroll
            for (int t = 0; t < 4; ++t)
#pragma unroll
                for (int e = 0; e < 4; ++e) { const int key = 64 * j + 16 * t + 4 * c.fq + e; const int da = c.qposA - key, db = c.qposB - key;
                    sa[t][e] += c.bt[(unsigned)da >= 512u ? 129 : (da > 128 ? 128 : da)]; sb[t][e] += c.bt[(unsigned)db >= 512u ? 129 : (db > 128 ? 128 : db)]; }
        }
        softmax_pv2(vb, c.fr, c.fq, sa, sb, ca, cb, oa, ob, m, ls);
    }
};

__device__ __forceinline__ void nsa_group(CArgs& A, int l, int b, int g, int tg, int dbg, LAS unsigned char* lds, int tid) {
    asm volatile("" : "+v"(tid));
    const int lane = tid & 63, wave = tid >> 6, fr = lane & 15, fq = lane >> 4, tl = fr >> 2, rr = fr & 3;
    LAS bf16* ring = (LAS bf16*)(lds + NG_KB);
    LAS float* imp = (LAS float*)(lds + NG_IMP) + wave * 1088; const LAS float* BT = (const LAS float*)(lds + NG_BT);
    LAS unsigned long long* msk = (LAS unsigned long long*)(lds + NG_MSK);
    LAS int* jl = (LAS int*)(lds + NG_JL);
    const int qpos0 = 64 * tg + 8 * wave, cur = tg, row0 = b * SEQ + qpos0, h = g * 4 + rr;
    const LAS float* bt = BT + h * 132;
    const TileCtx cx{fr, fq, qpos0 + tl, qpos0 + 4 + tl, qpos0, cur, bt, bt[128]};
    bf16x8 qa[2], qb[2];
    {   const bf16* qp = (const bf16*)(A.ws + WS_NQ) + (size_t)(row0 + tl) * 512 + g * 256 + rr * 64 + 8 * fq;
        qa[0] = *(const bf16x8*)qp; qa[1] = *(const bf16x8*)(qp + 32); qb[0] = *(const bf16x8*)(qp + 4 * 512); qb[1] = *(const bf16x8*)(qp + 4 * 512 + 32); }
    f32x4 outa[4], outb[4];
    for (int i = lane; i < 1088; i += 64) imp[i] = 0.f;

    {
        const int nb64 = (4 * tg + 3 + 63) >> 6;
        const AdLin ad{(const bf16*)(A.ws + WS_KC) + l * KC_L + (size_t)g * NCB * 64 + (size_t)b * 512 * 64, (const bf16*)(A.ws + WS_VCT) + l * KC_L + (size_t)g * 64 * NCB + (size_t)b * 8 * 4096};
        float ml[2] = {-1.0e30f, -1.0e30f}, lsl[2] = {0.f, 0.f};
        { BodyCmpStat2 bd{qa, qb, cx, ml, lsl}; staged_sweep2<4, false>(nb64, ad, bd, ring, tid); }
        const float m0 = xfq_max(ml[0]), m1 = xfq_max(ml[1]);
        const float l0 = xfq_sum(lsl[0] * __builtin_amdgcn_exp2f(ml[0] - m0)), l1 = xfq_sum(lsl[1] * __builtin_amdgcn_exp2f(ml[1] - m1));
        f32x4 oa[4], ob[4];
#pragma unroll
        for (int dt = 0; dt < 4; ++dt) { oa[dt] = (f32x4){0.f, 0.f, 0.f, 0.f}; ob[dt] = (f32x4){0.f, 0.f, 0.f, 0.f}; }
        { BodyCmpProb2 bd{qa, qb, cx, oa, ob, m0, m1, l0 > 0.f ? 1.f / l0 : 0.f, l1 > 0.f ? 1.f / l1 : 0.f, imp, tl, rr}; staged_sweep2<4, true>(nb64, ad, bd, ring, tid); }
        const float* gt = (const float*)(A.ws + WS_GATE) + (size_t)(row0 + tl) * 32 + 8 + h * 3;
        const float ga = sigmoidf_(gt[0]), gb = sigmoidf_(gt[4 * 32]);
#pragma unroll
        for (int dt = 0; dt < 4; ++dt) { outa[dt] = oa[dt] * ga; outb[dt] = ob[dt] * gb; }
    }
    unsigned long long s0[8], s1[8];
#pragma unroll
    for (int t = 0; t < 8; ++t) topk_sel(imp[t * 136 + lane], imp[t * 136 + 64 + lane], cur, lane, s0[t], s1[t]);
    const unsigned long long wu0a = (s0[0] | s0[1]) | (s0[2] | s0[3]), wu1a = (s1[0] | s1[1]) | (s1[2] | s1[3]), wu0b = (s0[4] | s0[5]) | (s0[6] | s0[7]), wu1b = (s1[4] | s1[5]) | (s1[6] | s1[7]);
    const unsigned long long my0a = tl == 0 ? s0[0] : (tl == 1 ? s0[1] : (tl == 2 ? s0[2] : s0[3])), my1a = tl == 0 ? s1[0] : (tl == 1 ? s1[1] : (tl == 2 ? s1[2] : s1[3]));
    const unsigned long long my0b = tl == 0 ? s0[4] : (tl == 1 ? s0[5] : (tl == 2 ? s0[6] : s0[7])), my1b = tl == 0 ? s1[4] : (tl == 1 ? s1[5] : (tl == 2 ? s1[6] : s1[7]));
    if (lane == 0) { msk[2 * wave] = wu0a | wu0b; msk[2 * wave + 1] = wu1a | wu1b; }
    __syncthreads();
    unsigned long long gu0 = 0ull, gu1 = 0ull;
#pragma unroll
    for (int w = 0; w < NWAVES; ++w) { gu0 |= msk[2 * w]; gu1 |= msk[2 * w + 1]; }
    gu0 = __builtin_amdgcn_readfirstlane((unsigned)gu0) | ((unsigned long long)__builtin_amdgcn_readfirstlane((unsigned)(gu0 >> 32)) << 32);
    gu1 = __builtin_amdgcn_readfirstlane((unsigned)gu1) | ((unsigned long long)__builtin_amdgcn_readfirstlane((unsigned)(gu1 >> 32)) << 32);
    const int nsel0 = __popcll(gu0), nsel = nsel0 + __popcll(gu1);
    if (wave == 0) {
        const unsigned long long below = (1ull << lane) - 1ull;
        if ((gu0 >> lane) & 1ull) jl[__popcll(gu0 & below)] = lane;
        if ((gu1 >> lane) & 1ull) jl[nsel0 + __popcll(gu1 & below)] = 64 + lane;
    }
    __syncthreads();
    const float* gt = (const float*)(A.ws + WS_GATE) + (size_t)(row0 + tl) * 32 + 8 + h * 3;
    if (!(dbg & 32)) {
        float m[2] = {-1.0e30f, -1.0e30f}, ls[2] = {0.f, 0.f}; f32x4 oa[4], ob[4];
#pragma unroll
        for (int dt = 0; dt < 4; ++dt) { oa[dt] = (f32x4){0.f, 0.f, 0.f, 0.f}; ob[dt] = (f32x4){0.f, 0.f, 0.f, 0.f}; }
        const AdList ad{(const bf16*)(A.ws + WS_KS) + l * KS_L + (size_t)g * TOTS * 64 + (size_t)b * SEQ * 64, (const bf16*)(A.ws + WS_VTS) + l * KS_L + (size_t)g * 64 * TOTS + (size_t)b * 128 * 4096, jl};
        { BodySel2 bd{qa, qb, cx, oa, ob, m, ls, jl, wu0a, wu1a, wu0b, wu1b, my0a, my1a, my0b, my1b, false}; staged_sweep2<7, true>(nsel, ad, bd, ring, tid);
#if defined(REP_MASK) && ((REP_MASK >> 15) & 1)
          bd.dead = true; staged_sweep2<7, true>(nsel, ad, bd, ring, tid);
#endif
        }
        const float la = xfq_sum(ls[0]), lb = xfq_sum(ls[1]);
        const float wa = la > 0.f ? sigmoidf_(gt[1]) / la : 0.f, wb = lb > 0.f ? sigmoidf_(gt[4 * 32 + 1]) / lb : 0.f;
#pragma unroll
        for (int dt = 0; dt < 4; ++dt) { outa[dt] = outa[dt] + oa[dt] * wa; outb[dt] = outb[dt] + ob[dt] * wb; }
    }
    if (!(dbg & 64)) {
        float m[2] = {-1.0e30f, -1.0e30f}, ls[2] = {0.f, 0.f}; f32x4 oa[4], ob[4];
#pragma unroll
        for (int dt = 0; dt < 4; ++dt) { oa[dt] = (f32x4){0.f, 0.f, 0.f, 0.f}; ob[dt] = (f32x4){0.f, 0.f, 0.f, 0.f}; }
        int j0 = (64 * tg - 511) >> 6; if (j0 < 0) j0 = 0;
        const AdLin ad{(const bf16*)(A.ws + WS_KW) + l * KW_L + (size_t)g * TOTWP * 64 + ((size_t)b * SEQ + (size_t)j0 * 64) * 64, (const bf16*)(A.ws + WS_VTW) + l * KW_L + (size_t)g * 64 * TOTWP + ((size_t)b * 128 + j0) * 4096};
        { BodyWin2 bd{qa, qb, cx, oa, ob, m, ls, j0}; staged_sweep2<7, true>(cur - j0 + 1, ad, bd, ring, tid); }
        const float la = xfq_sum(ls[0]), lb = xfq_sum(ls[1]);
        const float wa = la > 0.f ? sigmoidf_(gt[2]) / la : 0.f, wb = lb > 0.f ? sigmoidf_(gt[4 * 32 + 2]) / lb : 0.f;
#pragma unroll
        for (int dt = 0; dt < 4; ++dt) { outa[dt] = outa[dt] + oa[dt] * wa; outb[dt] = outb[dt] + ob[dt] * wb; }
    }
    bf16* mp = (bf16*)(A.ws + (dbg ? WS_HRAW : WS_MIX)) + (size_t)(row0 + tl) * D + 512 + h * 64 + 4 * fq;
#pragma unroll
    for (int dt = 0; dt < 4; ++dt) { v2u w; w.x = pk2(outa[dt][0], outa[dt][1]); w.y = pk2(outa[dt][2], outa[dt][3]); *(v2u*)(mp + 16 * dt) = w;
        v2u w2; w2.x = pk2(outb[dt][0], outb[dt][1]); w2.y = pk2(outb[dt][2], outb[dt][3]); *(v2u*)(mp + 4 * D + 16 * dt) = w2; }
}

__device__ __forceinline__ void phase_nsa2(CArgs& A, int l, int rep, int sub, LAS unsigned char* lds, int tid) {
    const int lane = tid & 63, wave = tid >> 6;
    LAS float* btl = (LAS float*)(lds + NG_BT);
    LAS int* tw = (LAS int*)(lds + NG_TASK);
    for (int i = tid; i < 8 * 132; i += NTHR) btl[i] = ((const float*)(A.ws + WS_BT))[i];
    unsigned* qh = (unsigned*)(A.ws + WS_CTL) + CW_NSAQ + (l * 2 + rep) * 5 * 64;
    const int own = (blockIdx.x & 7) >> 1;
    for (int qi = 0; qi < 5; ++qi) {
        const int qsel = qi == 0 ? 4 : (qi == 1 ? own : ((own + qi - 1) & 3));
        const int qlen = qsel == 4 ? ((sub & 8) ? 2 * DB / NWAVES : 0) : ((sub & 4) ? 128 : 0);
        for (;;) {
            __syncthreads();
            if (tid == 0) tw[0] = (int)__hip_atomic_fetch_add(qh + qsel * 64, 1u, __ATOMIC_RELAXED, __HIP_MEMORY_SCOPE_AGENT);
            __syncthreads();
            const int t = tw[0];
            if (t >= qlen) break;
            if (qsel < 4) nsa_group(A, l, qsel >> 1, qsel & 1, 127 - t, A.bar_region == 1 ? (sub & ~15) : 0, lds, tid);
            else { const int tt = t * NWAVES + wave; nsa_tile(A, l, true, tt >> 1, tt & 1, 0, (LAS float*)(lds + NG_IMP) + wave * 1088, btl, lane); }
        }
    }
}

constexpr int PH_PER_LAYER = 9, PH_L0 = 3, N_PHASES = PH_L0 + DEPTH * PH_PER_LAYER;
#ifndef REP_MASK
#define REP_MASK 0
#endif
__device__ __forceinline__ int rep_count(int b) { int n = (((REP_MASK) >> b) & 1) + 1; asm volatile("" : "+s"(n)); return n; }
#if REP_MASK
#define REPS(b) _Pragma("unroll 1") for (int rep_ = 0, nrep_ = rep_count(b); rep_ < nrep_; ++rep_)
#else
#define REPS(b) for (int rep_ = 0; rep_ < 1; ++rep_)
#endif
#ifndef MK_PER_PHASE
#define MK_PER_PHASE 0
#endif

__device__ __forceinline__ int fresh_tid(int wave_s) { int lane = __builtin_amdgcn_mbcnt_hi(~0u, __builtin_amdgcn_mbcnt_lo(~0u, 0u)); asm volatile("" : "+v"(lane)); return wave_s * 64 + lane; }
__device__ __forceinline__ CArgs* kargs() { unsigned long long p = (unsigned long long)__builtin_amdgcn_kernarg_segment_ptr(); asm volatile("" : "+s"(p)); return (CArgs*)p; }
#define A (*kargs())
#define IN(k) (lo <= (k) && (k) < hi)
#define SEAM(k) do { if (IN(k) && IN((k) + 1)) xcd_barrier(bar); } while (0)
template <int l>
__device__ __forceinline__ void layer_phases(LAS unsigned char* lds, const XcdBarrier& bar, int wave_s, int G, int NGW, int lo, int hi) {
    unsigned char* ws = A.ws;
    float* const ADA = (float*)(ws + WS_ADA);
    float* const X = (float*)(ws + WS_X);
    bf16* const Z = (bf16*)(ws + WS_Z);
    bf16* const U = (bf16*)(ws + WS_U);
        const int pb_ = PH_L0 + l * PH_PER_LAYER;
        const float* adal = ADA + (size_t)l * NCOND * 6144;
        const float* xa = l == 0 ? A.x_prompt : X; const float* xb = l == 0 ? A.x_sample : X + (size_t)MP * D;
        if (IN(pb_ + 0)) {
            const int tid = fresh_tid(wave_s), lane = tid & 63, wave = __builtin_amdgcn_readfirstlane(tid >> 6), gw = blockIdx.x * NWAVES + wave; (void)lane; (void)gw;
            {
                pg8::Gemm g{U, (const bf16*)(ws + WS_WIN) + (size_t)l * NINP * D, D, D, D};
                pg8::StaticOrder S; S.init(M, NINP, G, (int)blockIdx.x);
                EpiInProj E{(bf16*)(ws + WS_QKVO), (bf16*)(ws + WS_NQ), (float*)(ws + WS_GATE), (float*)(ws + WS_KVR), (bf16*)(ws + WS_XC) + (size_t)l * 4 * XCP * 64, A.out, l};
                REPS(8) pg8::gemm_phase<EpiInProj, pg8::StaticOrder, true, true>(lds, g, S, E, tid);
            }
            if (l == 0) {
                __syncthreads();
                pg8::Gemm g{(const bf16*)(ws + WS_XC), (const bf16*)(ws + WS_W1), 2048, 1024, 2048};
                CmpOrder S{G, (int)blockIdx.x, 0, DEPTH, 4, 64};
                EpiCmpHid E{(bf16*)(ws + WS_HID), (const float*)(ws + WS_B1)};
                REPS(14) pg8::gemm_phase<EpiCmpHid, CmpOrder, true, true>(lds, g, S, E, tid);
            }
        }
        SEAM(pb_ + 0);
        if (IN(pb_ + 1)) {
            const int tid = fresh_tid(wave_s), lane = tid & 63, wave = __builtin_amdgcn_readfirstlane(tid >> 6), gw = blockIdx.x * NWAVES + wave; (void)lane; (void)gw;
            {
                SgCmpHid E{(bf16*)(ws + WS_HID) + (size_t)l * 4 * NCB * 256, (const float*)(ws + WS_B1) + l * 2 * 256};
                REPS(12) small_gemm(((const bf16*)(ws + WS_XC)) + (size_t)l * 4 * XCP * 64, (size_t)XCP * 64, 1024, ((const bf16*)(ws + WS_W1)) + (size_t)l * 2 * 256 * 2048, (size_t)256 * 2048, 2048, 2048, 4, 1024, 256, E, lds, tid);
            }
            REPS(1) { phase_m2x(A, l, lds, tid);
            __syncthreads();
            prep_layer_images(A, l, lds, gw, NGW, lane, wave); __syncthreads(); }
            if (l == 0) phase_cmp2<false>(A, 0, DEPTH, 1024, NCB - 1024, gw, NGW, lane);
        }
        SEAM(pb_ + 1);
        if (IN(pb_ + 2)) {
            const int tid = fresh_tid(wave_s), lane = tid & 63, wave = __builtin_amdgcn_readfirstlane(tid >> 6), gw = blockIdx.x * NWAVES + wave; (void)lane; (void)gw;
            REPS(2) phase_m3(A, l, tid);
            phase_cmp2<false>(A, l, 1, 0, 1024, gw, NGW, lane);
        }
        SEAM(pb_ + 2);
        if (IN(pb_ + 3)) {
            const int tid = fresh_tid(wave_s), lane = tid & 63, wave = __builtin_amdgcn_readfirstlane(tid >> 6), gw = blockIdx.x * NWAVES + wave; (void)lane; (void)gw;
            const int sub = A.pad_;
            if (sub & 1) REPS(3) { phase_m4x(A, l, lds, tid);
            __syncthreads(); }
            if (sub & 2) REPS(4) { phase_mls(A, l, lds, tid);
            __syncthreads(); }
            if (sub & 12)
            REPS(5) phase_nsa2(A, l, rep_ + (A.bar_region == 1 ? 1 : 0), sub, lds, tid);
        }
        SEAM(pb_ + 3);
        if (IN(pb_ + 4)) {
            const int tid = fresh_tid(wave_s), lane = tid & 63, wave = __builtin_amdgcn_readfirstlane(tid >> 6), gw = blockIdx.x * NWAVES + wave; (void)lane; (void)gw;
            pg8::Gemm g{(const bf16*)(ws + WS_MIX), (const bf16*)(ws + WS_WOUT) + (size_t)l * D * D, D, D, D};
            pg8::StaticOrder S; S.init(MP, D, G, (int)blockIdx.x);
            EpiResid E{xa, xb, adal + 2048, Z};
            REPS(9) pg8::gemm_phase<EpiResid, pg8::StaticOrder, true, true>(lds, g, S, E, tid);
            REPS(13) { SgResid E2{xb, adal + 2048, Z}; small_gemm(((const bf16*)(ws + WS_MIX)) + (size_t)MP * D, 0, D, (const bf16*)(ws + WS_WOUT) + (size_t)l * D * D, 0, D, D, 1, MS, D, E2, lds, tid); }
        }
        SEAM(pb_ + 4);
        if (IN(pb_ + 5)) {
            const int tid = fresh_tid(wave_s), lane = tid & 63, wave = __builtin_amdgcn_readfirstlane(tid >> 6), gw = blockIdx.x * NWAVES + wave; (void)lane; (void)gw;
            REPS(6) for (int r = gw; r < M; r += NGW) {
                const float* ad = adal + (size_t)cond_of_row(r) * 6144;
                ln_row(Z + (size_t)r * D, A.ln_g + (size_t)(l * 2 + 0) * D, A.ln_b + (size_t)(l * 2 + 0) * D, X + (size_t)r * D, ad + 3072, ad + 4096, U + (size_t)r * D, lane);
            }
        }
        SEAM(pb_ + 5);
        if (IN(pb_ + 6)) {
            const int tid = fresh_tid(wave_s), lane = tid & 63, wave = __builtin_amdgcn_readfirstlane(tid >> 6), gw = blockIdx.x * NWAVES + wave; (void)lane; (void)gw;
            pg8::Gemm g{U, (const bf16*)(ws + WS_WUP) + (size_t)l * FF * D, D, D, D};
            pg8::StaticOrder S; S.init(MP, FF, G, (int)blockIdx.x);
            EpiRelu2 E{(bf16*)(ws + WS_H)};
            REPS(10) pg8::gemm_phase<EpiRelu2, pg8::StaticOrder, true, true>(lds, g, S, E, tid);
            REPS(13) { SgRelu2 E2{(bf16*)(ws + WS_H)}; small_gemm(U + (size_t)MP * D, 0, D, (const bf16*)(ws + WS_WUP) + (size_t)l * FF * D, 0, D, D, 1, MS, FF, E2, lds, tid); }
        }
        SEAM(pb_ + 6);
        if (IN(pb_ + 7)) {
            const int tid = fresh_tid(wave_s), lane = tid & 63, wave = __builtin_amdgcn_readfirstlane(tid >> 6), gw = blockIdx.x * NWAVES + wave; (void)lane; (void)gw;
            pg8::Gemm g{(const bf16*)(ws + WS_H), (const bf16*)(ws + WS_WDN) + (size_t)l * D * FF, FF, FF, FF};
            pg8::StaticOrder S; S.init(MP, D, G, (int)blockIdx.x);
            EpiResid E{X, X + (size_t)MP * D, adal + 5120, Z};
            REPS(11) pg8::gemm_phase<EpiResid, pg8::StaticOrder, true, true>(lds, g, S, E, tid);
            REPS(13) { SgResid E2{X + (size_t)MP * D, adal + 5120, Z}; small_gemm(((const bf16*)(ws + WS_H)) + (size_t)MP * FF, 0, FF, (const bf16*)(ws + WS_WDN) + (size_t)l * D * FF, 0, FF, FF, 1, MS, D, E2, lds, tid); }
        }
        SEAM(pb_ + 7);
        if (IN(pb_ + 8)) {
            const int tid = fresh_tid(wave_s), lane = tid & 63, wave = __builtin_amdgcn_readfirstlane(tid >> 6), gw = blockIdx.x * NWAVES + wave; (void)lane; (void)gw;
            const bool last = l == DEPTH - 1;
            REPS(6) for (int r = gw; r < M; r += NGW) {
                const float* ad = adal + (size_t)NCOND * 6144 + (size_t)cond_of_row(r) * 6144;
                float* xo = last ? (r < MP ? A.out + O_YP + (size_t)r * D : A.out + O_YS + (size_t)(r - MP) * D) : X + (size_t)r * D;
                ln_row(Z + (size_t)r * D, A.ln_g + (size_t)(l * 2 + 1) * D, A.ln_b + (size_t)(l * 2 + 1) * D, xo, ad, ad + 1024, last ? (bf16*)nullptr : U + (size_t)r * D, lane);
            }
        }
        SEAM(pb_ + 8);
    }
__global__ void __launch_bounds__(NTHR, 2) fwd_kernel(Args A_unused) {
    extern __shared__ __attribute__((aligned(16))) unsigned char lds_raw[];
    LAS unsigned char* lds = (LAS unsigned char*)lds_raw;
    const int G = gridDim.x, NGW = G * NWAVES, wave_s = __builtin_amdgcn_readfirstlane(threadIdx.x >> 6);
    unsigned char* ws = A.ws;
    for (int u = threadIdx.x; u < (LDS_BYTES - LDSCTL_OFF) / 4; u += NTHR) ((LAS unsigned*)(lds + LDSCTL_OFF))[u] = 0u;
    __syncthreads();
    unsigned* barw = (unsigned*)(ws + WS_CTL) + CW_BAR + A.bar_region * XCD_BAR_WORDS;
    XcdBarrier bar; bar.bar = barw; bar.x = 0; bar.st = nullptr;
    if (!MK_PER_PHASE) bar = xcd_barrier_post(barw, (volatile LAS unsigned*)(lds + MISC_OFF) + 8);
    const int lo = A.ph_lo, hi = A.ph_hi;

    float* const ADA = (float*)(ws + WS_ADA);
    float* const X = (float*)(ws + WS_X);
    bf16* const Z = (bf16*)(ws + WS_Z);
    bf16* const U = (bf16*)(ws + WS_U);

    if (IN(0)) { const int tid = fresh_tid(wave_s), lane = tid & 63, wave = __builtin_amdgcn_readfirstlane(tid >> 6), gw = blockIdx.x * NWAVES + wave;
        REPS(7) { phase_ada(A, lds, tid); } __syncthreads();
        REPS(0) { phase_p0a(A, lds, gw, NGW, lane, wave); prep_cache_images(A, lds, gw, NGW, lane, wave); } }
    SEAM(0);
    if (IN(2)) {
        const int tid = fresh_tid(wave_s), lane = tid & 63, wave = __builtin_amdgcn_readfirstlane(tid >> 6), gw = blockIdx.x * NWAVES + wave;
        b1_reduce(A, tid);
        for (int r = gw; r < M; r += NGW) {
            const float* ad = ADA + (size_t)cond_of_row(r) * 6144;
            mod_row(r < MP ? A.x_prompt + (size_t)r * D : A.x_sample + (size_t)(r - MP) * D, ad, ad + 1024, U + (size_t)r * D, lane);
        }
    }
    SEAM(2);

    layer_phases<0>(lds, bar, wave_s, G, NGW, lo, hi);
    layer_phases<1>(lds, bar, wave_s, G, NGW, lo, hi);
    static_assert(DEPTH == 2, "two layers");
#undef IN
#undef SEAM
#undef A
}

extern "C" void kernel_launch(void* const* d_in, const int* in_sizes, int n_in, void* d_out, int out_size, void* d_ws, size_t ws_size, hipStream_t stream) {
    static int grid = 0;
    if (grid == 0) {
        if (n_in != 25 || (size_t)out_size != O_END || ws_size < WS_END) { fprintf(stderr, "kernel_launch: unexpected shapes: n_in %d out %d (want %zu) ws %zu (want >= %zu)\n", n_in, out_size, (size_t)O_END, ws_size, (size_t)WS_END); grid = -1; return; }
        int dev = 0, cus = 0, per_cu = 0;
        if (hipGetDevice(&dev) != hipSuccess || hipDeviceGetAttribute(&cus, hipDeviceAttributeMultiprocessorCount, dev) != hipSuccess) { grid = -1; return; }
        if (hipFuncSetAttribute((const void*)fwd_kernel, hipFuncAttributeMaxDynamicSharedMemorySize, LDS_BYTES) != hipSuccess) { fprintf(stderr, "kernel_launch: hipFuncSetAttribute failed\n"); grid = -1; return; }
        if (hipOccupancyMaxActiveBlocksPerMultiprocessor(&per_cu, (const void*)fwd_kernel, NTHR, LDS_BYTES) != hipSuccess || per_cu < 1) fprintf(stderr, "kernel_launch: occupancy query reports %d blocks per CU\n", per_cu);
        (void)hipGetLastError();
        grid = cus;
    }
    if (grid < 0) return;
    (void)hipMemsetAsync((char*)d_ws + WS_CTL, 0, CTL_ZERO_BYTES, stream);
    Args a{};
    a.x_prompt = (const float*)d_in[0]; a.x_sample = (const float*)d_in[1]; a.cache_cmp = (const float*)d_in[2]; a.cache_slc = (const float*)d_in[3]; a.cache_win = (const float*)d_in[4];
    a.st_C = (const float*)d_in[5]; a.st_n = (const float*)d_in[6]; a.st_m = (const float*)d_in[7]; a.page_table = (const int*)d_in[8]; a.c_prompt = (const float*)d_in[9]; a.c_sample = (const float*)d_in[10];
    a.w_ada = (const float*)d_in[11]; a.b_ada = (const float*)d_in[12]; a.w_in = (const float*)d_in[13]; a.b_gate = (const float*)d_in[14]; a.ml_norm_g = (const float*)d_in[15]; a.cmp_pe = (const float*)d_in[16];
    a.cmp_w1 = (const float*)d_in[17]; a.cmp_w2 = (const float*)d_in[18]; a.rel_bias = (const float*)d_in[19]; a.w_out = (const float*)d_in[20]; a.ln_g = (const float*)d_in[21]; a.ln_b = (const float*)d_in[22];
    a.w_up = (const float*)d_in[23]; a.w_down = (const float*)d_in[24];
    a.out = (float*)d_out; a.ws = (unsigned char*)d_ws; a.pad_ = 15;
#if MK_PER_PHASE
    for (int ph = 0; ph < N_PHASES; ++ph) { a.ph_lo = ph; a.ph_hi = ph + 1; hipLaunchKernelGGL(fwd_kernel, dim3(grid), dim3(NTHR), LDS_BYTES, stream, a); }
#else
#ifdef PROBE_DUP_PHASE
    a.ph_lo = 0; a.ph_hi = PROBE_DUP_PHASE + 1; a.bar_region = 0; hipLaunchKernelGGL(fwd_kernel, dim3(grid), dim3(NTHR), LDS_BYTES, stream, a);
    a.ph_lo = PROBE_DUP_PHASE; a.ph_hi = PROBE_DUP_PHASE + 1; a.bar_region = 1;
#ifdef PROBE_SUB
    a.pad_ = PROBE_SUB;
#endif
    hipLaunchKernelGGL(fwd_kernel, dim3(grid), dim3(NTHR), LDS_BYTES, stream, a);
    a.pad_ = 15; a.ph_lo = PROBE_DUP_PHASE + 1; a.ph_hi = N_PHASES; a.bar_region = 2; hipLaunchKernelGGL(fwd_kernel, dim3(grid), dim3(NTHR), LDS_BYTES, stream, a);
#else
    a.ph_lo = 0; a.ph_hi = N_PHASES;
    hipLaunchKernelGGL(fwd_kernel, dim3(grid), dim3(NTHR), LDS_BYTES, stream, a);
#endif
#endif
    const hipError_t le = hipPeekAtLastError();
    if (le != hipSuccess) fprintf(stderr, "kernel_launch: launch failed: %s\n", hipGetErrorName(le));
}
```
